# Optimizing an MI355X kernel written in HIP

```python
import math
import jax, jax.numpy as jnp
from jax import lax
import numpy as np

D_MODEL = 1024
BATCH = 8
SEQ = 2048
DEPTH = 1
DEC_BATCH = 128
DEC_SEQ = 1
PAST_LEN = 16384
PAGE_SIZE = 128

D_MIX = 2 * D_MODEL
W_A = D_MIX // 2
H_A = 8
DH_A = W_A // H_A
W_B = D_MIX - W_A
H_B = 4
DH_B = W_B // H_B
CHUNK = 128
CONV_W = 4
D_PLE = 256
N_IN = 3 * W_A + 3 * W_B
EPS = 1e-6

kernel_name = 'hymba_gmlp_mlstm_decode_step'


def rmsnorm(x, g):
    xf = x.astype(jnp.float32)
    y = xf * lax.rsqrt(jnp.mean(xf * xf, axis=-1, keepdims=True) + EPS)
    return (y * g.astype(jnp.float32)).astype(x.dtype)


def head_norm(x, g, b=None):
    xf = x.astype(jnp.float32)
    mu = jnp.mean(xf, axis=-1, keepdims=True)
    var = jnp.mean(jnp.square(xf - mu), axis=-1, keepdims=True)
    y = (xf - mu) * lax.rsqrt(var + EPS) * g.astype(jnp.float32)
    if b is not None:
        y = y + b.astype(jnp.float32)
    return y


def causal_conv(x, buf, w, b):
    T = x.shape[1]
    xpad = jnp.concatenate([buf.astype(x.dtype), x], axis=1)
    y = xpad[:, 0:T] * w[0]
    for j in range(1, CONV_W):
        y = y + xpad[:, j:j + T] * w[j]
    return y + b, xpad[:, -(CONV_W - 1):]


def chunk_spatial(v, w_s, b_s):
    B, T = v.shape[0], v.shape[1]
    L = min(CHUNK, T)
    nc = T // L
    w = w_s[:, :L, :L] * jnp.tril(jnp.ones((L, L), w_s.dtype))
    vc = v.reshape(B, nc, L, H_A, DH_A)
    out = jnp.einsum('hts,bcshd->bcthd', w, vc) + b_s[:, :L].T[None, None, :, :, None]
    return out.reshape(B, T, H_A, DH_A)


def mlstm_chunk(carry, inp):
    C, n, m = carry
    q, k, v, li, lf = inp
    L = q.shape[1]
    b = jnp.cumsum(lf, axis=1)
    causal = jnp.tril(jnp.ones((L, L), bool))
    dmat = b[:, :, None, :] - b[:, None, :, :] + li[:, None, :, :]
    dmat = jnp.where(causal[None, :, :, None], dmat, -jnp.inf)
    inter = b + m[:, None, :]
    m_t = jnp.maximum(inter, jnp.max(dmat, axis=2))
    s = jnp.exp(dmat - m_t[:, :, None, :]) * jnp.einsum('bthd,bshd->btsh', q, k)
    g = jnp.exp(inter - m_t)
    num = jnp.einsum('btsh,bshe->bthe', s, v) + g[..., None] * jnp.einsum('bhed,bthd->bthe', C, q)
    den = jnp.sum(s, axis=2) + g * jnp.einsum('bhd,bthd->bth', n, q)
    h = num / jnp.maximum(jnp.abs(den), jnp.exp(-m_t))[..., None]
    m_new = m_t[:, -1]
    w_end = jnp.exp(b[:, -1:, :] - b + li - m_new[:, None, :])
    g_end = jnp.exp(b[:, -1] + m - m_new)
    C_new = g_end[..., None, None] * C + jnp.einsum('bsh,bshe,bshd->bhed', w_end, v, k)
    n_new = g_end[..., None] * n + jnp.einsum('bsh,bshd->bhd', w_end, k)
    return (C_new, n_new, m_new), h


def mlstm_seq(q, k, v, li, lf, C, n, m):
    B, T = q.shape[0], q.shape[1]
    L = min(CHUNK, T)
    nc = T // L

    def chunks(a):
        return jnp.moveaxis(a.reshape((B, nc, L) + a.shape[2:]), 1, 0)

    (C, n, m), h = lax.scan(mlstm_chunk, (C, n, m), (chunks(q), chunks(k), chunks(v), chunks(li), chunks(lf)))
    h = jnp.moveaxis(h, 0, 1).reshape((B, T) + h.shape[3:])
    return h, C, n, m


def mixer_layer(x, p, norm_g, w_in, ln_v_g, ln_v_b, w_sp, b_sp, conv_w, conv_b, w_q, w_k, w_v,
                w_if, b_if, gn_g, skip, w_out, w_pg, b_pg, w_pp, ple_g, C0, n0, m0, conv0):
    B, T = x.shape[0], x.shape[1]
    h = rmsnorm(x, norm_g)
    proj = h @ w_in
    u, v, z_a, x_b, o_b, z_b = jnp.split(
        proj, [W_A, 2 * W_A, 3 * W_A, 3 * W_A + W_B, 3 * W_A + 2 * W_B], axis=-1)
    u = jax.nn.gelu(u, approximate=False)
    v = jax.nn.gelu(v, approximate=False)
    v_n = head_norm(v.reshape(B, T, H_A, DH_A), ln_v_g, ln_v_b).astype(x.dtype)
    sp = chunk_spatial(v_n, w_sp, b_sp).reshape(B, T, W_A)
    y_a = u * sp * jax.nn.silu(z_a)
    xc, conv_tail = causal_conv(x_b, conv0, conv_w, conv_b)
    xc = jax.nn.silu(xc)
    xch = xc.reshape(B, T, H_B, DH_B)
    xbh = x_b.reshape(B, T, H_B, DH_B)
    q = jnp.einsum('bthd,hde->bthe', xch, w_q)
    k = jnp.einsum('bthd,hde->bthe', xch, w_k)
    vv = jnp.einsum('bthd,hde->bthe', xbh, w_v)
    gin = jnp.concatenate([q.reshape(B, T, W_B), k.reshape(B, T, W_B), vv.reshape(B, T, W_B)], axis=-1)
    gates = (gin @ w_if + b_if).astype(jnp.float32)
    li = gates[..., :H_B]
    lf = jax.nn.log_sigmoid(gates[..., H_B:])
    hb, C, n, m = mlstm_seq(q.astype(jnp.float32), (k * (DH_B ** -0.5)).astype(jnp.float32),
                            vv.astype(jnp.float32), li, lf, C0.astype(jnp.float32),
                            n0.astype(jnp.float32), m0.astype(jnp.float32))
    hb = hb * jax.nn.sigmoid(o_b.reshape(B, T, H_B, DH_B).astype(jnp.float32))
    hb = head_norm(hb, gn_g).reshape(B, T, W_B).astype(x.dtype)
    y_b = (hb + skip * xc) * jax.nn.silu(z_b)
    x = x + jnp.concatenate([y_a, y_b], axis=-1) @ w_out
    e = rmsnorm(p @ w_pp, ple_g)
    x = x + jax.nn.sigmoid(x @ w_pg + b_pg) * e
    return x, C.astype(x.dtype), n.astype(x.dtype), m.astype(x.dtype), conv_tail, v_n.reshape(B, T, W_A)


def setup_inputs(seed: int = 0) -> dict:
    key = jax.random.key(seed)
    ks = jax.random.split(key, 32)

    def nrm(k, shape, s):
        return s * jax.random.normal(k, shape, jnp.float32)

    b_if = jnp.concatenate([
        nrm(ks[20], (DEPTH, H_B), 0.1),
        jnp.linspace(3.0, 6.0, H_B, dtype=jnp.float32)[None, :] + nrm(ks[21], (DEPTH, H_B), 0.01)], axis=-1)
    return {
        'x_prompt': nrm(ks[0], (BATCH, SEQ, D_MODEL), 1.0),
        'x_sample': nrm(ks[1], (DEC_BATCH, DEC_SEQ, D_MODEL), 1.0),
        'state_mlstm_C': nrm(ks[2], (DEPTH, DEC_BATCH, H_B, DH_B, DH_B), 0.1),
        'state_mlstm_n': nrm(ks[3], (DEPTH, DEC_BATCH, H_B, DH_B), 0.1),
        'state_mlstm_m': nrm(ks[4], (DEPTH, DEC_BATCH, H_B), 0.5),
        'state_conv': nrm(ks[5], (DEPTH, DEC_BATCH, CONV_W - 1, W_B), 1.0),
        'p_prompt': nrm(ks[6], (DEPTH, BATCH, SEQ, D_PLE), 1.0),
        'p_sample': nrm(ks[7], (DEPTH, DEC_BATCH, DEC_SEQ, D_PLE), 1.0),
        'norm_in_g': 1.0 + nrm(ks[8], (DEPTH, D_MODEL), 0.02),
        'w_in': nrm(ks[9], (DEPTH, D_MODEL, N_IN), D_MODEL ** -0.5),
        'ln_v_g': 1.0 + nrm(ks[10], (DEPTH, H_A, DH_A), 0.02),
        'ln_v_b': nrm(ks[11], (DEPTH, H_A, DH_A), 0.02),
        'w_spatial': nrm(ks[12], (DEPTH, H_A, CHUNK, CHUNK), CHUNK ** -0.5),
        'b_spatial': 1.0 + nrm(ks[13], (DEPTH, H_A, CHUNK), 0.1),
        'conv_w': nrm(ks[14], (DEPTH, CONV_W, W_B), CONV_W ** -0.5),
        'conv_b': nrm(ks[15], (DEPTH, W_B), 0.02),
        'w_q': nrm(ks[16], (DEPTH, H_B, DH_B, DH_B), DH_B ** -0.5),
        'w_k': nrm(ks[17], (DEPTH, H_B, DH_B, DH_B), DH_B ** -0.5),
        'w_v': nrm(ks[18], (DEPTH, H_B, DH_B, DH_B), DH_B ** -0.5),
        'w_if': nrm(ks[19], (DEPTH, 3 * W_B, 2 * H_B), (3 * W_B) ** -0.5),
        'b_if': b_if,
        'gn_g': 1.0 + nrm(ks[22], (DEPTH, H_B, DH_B), 0.02),
        'skip': 1.0 + nrm(ks[23], (DEPTH, W_B), 0.02),
        'w_out': nrm(ks[24], (DEPTH, D_MIX, D_MODEL), D_MIX ** -0.5),
        'w_ple_gate': nrm(ks[25], (DEPTH, D_MODEL, D_MODEL), D_MODEL ** -0.5),
        'b_ple_gate': nrm(ks[26], (DEPTH, D_MODEL), 0.01),
        'w_ple_proj': nrm(ks[27], (DEPTH, D_PLE, D_MODEL), D_PLE ** -0.5),
        'ple_norm_g': 1.0 + nrm(ks[28], (DEPTH, D_MODEL), 0.02),
        'final_norm_g': 1.0 + nrm(ks[29], (D_MODEL,), 0.02),
    }


def reference(x_prompt, x_sample, state_mlstm_C, state_mlstm_n, state_mlstm_m, state_conv,
              p_prompt, p_sample, norm_in_g, w_in, ln_v_g, ln_v_b, w_spatial, b_spatial,
              conv_w, conv_b, w_q, w_k, w_v, w_if, b_if, gn_g, skip, w_out, w_ple_gate,
              b_ple_gate, w_ple_proj, ple_norm_g, final_norm_g):
    xp, xs = x_prompt, x_sample
    bp = x_prompt.shape[0]
    Cp_l, np_l, mp_l, cp_l = [], [], [], []
    Cs_l, ns_l, ms_l, cs_l, vs_l = [], [], [], [], []
    for i in range(DEPTH):
        lw = (norm_in_g[i], w_in[i], ln_v_g[i], ln_v_b[i], w_spatial[i], b_spatial[i], conv_w[i],
              conv_b[i], w_q[i], w_k[i], w_v[i], w_if[i], b_if[i], gn_g[i], skip[i], w_out[i],
              w_ple_gate[i], b_ple_gate[i], w_ple_proj[i], ple_norm_g[i])
        C0 = jnp.zeros((bp, H_B, DH_B, DH_B), jnp.float32)
        n0 = jnp.zeros((bp, H_B, DH_B), jnp.float32)
        m0 = jnp.zeros((bp, H_B), jnp.float32)
        cb0 = jnp.zeros((bp, CONV_W - 1, W_B), xp.dtype)
        xp, Cp, np_, mp, cp, _ = mixer_layer(xp, p_prompt[i], *lw, C0, n0, m0, cb0)
        xs, Cs, ns, ms, cs, vs = mixer_layer(xs, p_sample[i], *lw, state_mlstm_C[i], state_mlstm_n[i],
                                             state_mlstm_m[i], state_conv[i])
        Cp_l.append(Cp); np_l.append(np_); mp_l.append(mp); cp_l.append(cp)
        Cs_l.append(Cs); ns_l.append(ns); ms_l.append(ms); cs_l.append(cs); vs_l.append(vs)
    y_prompt = rmsnorm(xp, final_norm_g)
    y_sample = rmsnorm(xs, final_norm_g)
    return (y_prompt, y_sample,
            jnp.stack(Cp_l), jnp.stack(np_l), jnp.stack(mp_l), jnp.stack(cp_l),
            jnp.stack(Cs_l), jnp.stack(ns_l), jnp.stack(ms_l), jnp.stack(cs_l), jnp.stack(vs_l))
```

```cpp
#include <hip/hip_runtime.h>
#include <hip/hip_cooperative_groups.h>
#include <cstdio>
#include <cstdint>
namespace cg = cooperative_groups;

#define LAS __attribute__((address_space(3)))
typedef unsigned short bf16_t;
typedef short bf16x8 __attribute__((ext_vector_type(8)));
typedef float f32x4 __attribute__((ext_vector_type(4)));
typedef float f32x2 __attribute__((ext_vector_type(2)));
typedef unsigned u32x4 __attribute__((ext_vector_type(4)));
typedef unsigned u32x2 __attribute__((ext_vector_type(2)));

constexpr int DM = 1024, SEQ = 2048, NB = 8, MP = NB * SEQ, MS = 128, MA = MP + 256, NTILE = MA / 256;
constexpr int NIN = 6144, WA = 1024, WB = 1024, HA = 8, DHA = 128, HB = 4, DHB = 256, DPLE = 256, DMIX = 2048;
constexpr int LC = 256, NCH = SEQ / LC;
constexpr int NUNIT = NB * HB * NCH;
constexpr float EPS = 1e-6f;

constexpr size_t O_Y = 0, O_YS = 16777216, O_CP = 16908288, O_NP = 19005440, O_MP = 19013632, O_CVP = 19013664, O_CS = 19038240, O_NS = 52592672, O_MS = 52723744, O_CVS = 52724256, O_VS = 53117472, O_END = 53248544;

constexpr size_t MiB = 1u << 20;
constexpr size_t WS_CTL = 0, WS_WIN = 1 * MiB, WS_WQ = 13 * MiB, WS_WK = WS_WQ + MiB / 2, WS_WV = 14 * MiB, WS_WOUT = WS_WV + MiB / 2, WS_WPG = WS_WOUT + 4 * MiB, WS_WPP = WS_WPG + 2 * MiB,
    WS_WSP = 21 * MiB, WS_WG = WS_WSP + MiB / 4, WS_RS = WS_WG + MiB / 4, WS_GLI = 22 * MiB, WS_GLF = WS_GLI + MiB / 2, WS_DA = 23 * MiB, WS_DR = WS_DA + MiB / 2, WS_DG = 24 * MiB, WS_DEM = WS_DG + MiB / 2,
    WS_DW = 25 * MiB, WS_QN = WS_DW + MiB / 2, WS_DENP = 26 * MiB, WS_DN = 27 * MiB, WS_VS = WS_DN + MiB / 2, WS_PB = 28 * MiB, WS_XB = 37 * MiB, WS_PROJA = 70 * MiB, WS_PROJB = 168 * MiB,
    WS_PQ = 266 * MiB, WS_VC = 330 * MiB, WS_Y = 394 * MiB, WS_END = 460 * MiB;
constexpr size_t WS_Q = WS_PROJA, WS_K = WS_Q + 33 * MiB, WS_WKT = WS_K + 33 * MiB;
constexpr size_t WS_X1B = WS_PROJA, WS_GB = WS_X1B + 33 * MiB, WS_EB = WS_GB + 33 * MiB;
static_assert(WS_WKT + 32 * MiB <= WS_PROJB && WS_EB + 33 * MiB <= WS_PQ, "ws map");

__device__ __forceinline__ unsigned cvt_pk_bf16(float lo, float hi) { unsigned r; asm volatile("v_cvt_pk_bf16_f32 %0, %1, %2" : "=v"(r) : "v"(lo), "v"(hi)); return r; }
__device__ __forceinline__ float bf_lo(unsigned w) { return __uint_as_float(w << 16); }
__device__ __forceinline__ float bf_hi(unsigned w) { return __uint_as_float(w & 0xffff0000u); }
__device__ __forceinline__ float bf2f(bf16_t b) { return __uint_as_float(((unsigned)b) << 16); }
__device__ __forceinline__ bf16_t f2bf(float f) { return (bf16_t)(cvt_pk_bf16(f, 0.f) & 0xffffu); }
__device__ __forceinline__ float fast_exp(float x) { return __builtin_amdgcn_exp2f(x * 1.4426950408889634f); }
__device__ __forceinline__ float sigmoidf_(float x) { return __builtin_amdgcn_rcpf(1.0f + fast_exp(-x)); }
__device__ __forceinline__ float siluf_(float x) { return x * sigmoidf_(x); }
__device__ __forceinline__ f32x2 gelu_pk(f32x2 v) {
    const f32x2 av = __builtin_elementwise_abs(v), d = av * 0.2316418882f + 1.0f;
    f32x2 t; t.x = __builtin_amdgcn_rcpf(d.x); t.y = __builtin_amdgcn_rcpf(d.y);
    f32x2 q = t * 0.5307027145f + (-0.7265760135f); q = q * t + 0.7107068705f; q = q * t + (-0.142248368f); q = q * t + 0.127414796f; q = q * t;
    const f32x2 s = (v * v) * (-0.72134752044f);
    f32x2 e; e.x = __builtin_amdgcn_exp2f(s.x); e.y = __builtin_amdgcn_exp2f(s.y);
    const f32x2 m = v * (q * e), r = v - m;
    f32x2 o; o.x = v.x < 0.f ? m.x : r.x; o.y = v.y < 0.f ? m.y : r.y; return o;
}
__device__ __forceinline__ float wave_sum(float v) {
#pragma unroll
    for (int o = 1; o < 64; o <<= 1) v += __shfl_xor(v, o);
    return v;
}
#define LDS_WAIT() asm volatile("s_waitcnt lgkmcnt(0)" ::: "memory")

namespace pg8 {
constexpr int BM = 256, BK = 64, HALF = 128, HTB = HALF * BK * 2, STAGE_BYTES = 8 * HTB;
__host__ __device__ __forceinline__ int lds_byte(int r, int c) { const int st = (r >> 4) * 2 + (c >> 5), rr = r & 15, cc = c & 31, ob = rr * 64 + cc * 2; return st * 1024 + (ob ^ (((ob >> 9) & 1) << 5)); }
__host__ __device__ __forceinline__ void stage_rc(int b, int& R, int& C) { const int st = b / 1024, sb = b % 1024, swz = sb ^ (((sb >> 9) & 1) << 5); R = (st >> 1) * 16 + swz / 64; C = (st & 1) * 32 + (swz % 64) / 2; }
__host__ __device__ __forceinline__ int perm32(int rho) { const int n = rho >> 4, i = rho & 15; return 8 * (i >> 2) + 4 * n + (i & 3); }

struct Unit { const char* a; const char* b; int pm, pn, aux; };
struct Gemm { int lda, ldb, K; };

template <class Epi, class Sched, bool ALIGN_EPI = true, bool SP2 = true>
__device__ __forceinline__ void gemm_phase(LAS unsigned char* lds, const Gemm g, const Sched& S, const Epi& E) {
    const int tid = threadIdx.x, wid = __builtin_amdgcn_readfirstlane(tid >> 6), lane = tid & 63, wr = wid >> 2, wc = wid & 3, fr = lane & 15, fq = lane >> 4;
    const int K = g.K, nt = K / BK;
    unsigned voffA[2], voffB[2];
#pragma unroll
    for (int i = 0; i < 2; ++i) { int R, C; stage_rc(tid * 16 + i * 8192, R, C); const int Rb = Epi::PERM ? ((R & ~31) + perm32(R & 31)) : R;
        voffA[i] = (unsigned)(R * g.lda + C) * 2u; voffB[i] = (unsigned)(Rb * g.ldb + C) * 2u; }
    const size_t kstep = (size_t)(BK * 2);
    const size_t hstepA = (size_t)HALF * g.lda * 2, hstepB = (size_t)HALF * g.ldb * 2;
    const unsigned ldsw = (unsigned)wid * 1024u;
    const int aoff = lds_byte(wr * 64 + fr, fq * 8), boff = lds_byte(wc * 32 + fr, fq * 8);
#define PG8_SA(b, h) (((b) * 2 + (h)) * HTB)
#define PG8_SB(b, h) ((4 + (b) * 2 + (h)) * HTB)
#define PG8_STAGE(bufoff, gbase, voff) do { _Pragma("unroll") for (int _i = 0; _i < 2; ++_i) \
        __builtin_amdgcn_global_load_lds((const unsigned*)((const char*)(gbase) + (voff)[_i]), (LAS unsigned*)(lds + (bufoff) + ldsw + _i * 8192), 16, 0, 0); } while (0)
#define PG8_LDA(dst, b, h) do { _Pragma("unroll") for (int m = 0; m < 4; ++m) _Pragma("unroll") for (int k = 0; k < 2; ++k) dst[m][k] = *(const LAS bf16x8*)(lds + PG8_SA(b, h) + aoff + m * 2048 + k * 1024); } while (0)
#define PG8_LDB(dst, b, h) do { _Pragma("unroll") for (int n = 0; n < 2; ++n) _Pragma("unroll") for (int k = 0; k < 2; ++k) dst[n][k] = *(const LAS bf16x8*)(lds + PG8_SB(b, h) + boff + n * 2048 + k * 1024); } while (0)
#define PG8_MMA(ai, bj, At, Bt) do { __builtin_amdgcn_s_setprio(1); _Pragma("unroll") for (int m = 0; m < 4; ++m) _Pragma("unroll") for (int n = 0; n < 2; ++n) _Pragma("unroll") for (int k = 0; k < 2; ++k) \
        acc[ai][bj][m][n] = __builtin_amdgcn_mfma_f32_16x16x32_bf16(Bt[n][k], At[m][k], acc[ai][bj][m][n], 0, 0, 0); __builtin_amdgcn_s_setprio(0); } while (0)
#define PG8_WAIT_V(n) asm volatile("s_waitcnt vmcnt(" #n ")" ::: "memory")
#define PG8_WAIT_L(n) asm volatile("s_waitcnt lgkmcnt(" #n ")" ::: "memory")
#define PG8_BAR __builtin_amdgcn_s_barrier()
#define PG8_SCHED __builtin_amdgcn_sched_barrier(0)
    Unit cur, nxt; int ui = 0;
    if (!S.next(0, cur)) return;
    f32x4 acc[2][2][4][2];
#pragma unroll
    for (int a = 0; a < 2; ++a)
#pragma unroll
        for (int b = 0; b < 2; ++b)
#pragma unroll
            for (int m = 0; m < 4; ++m)
#pragma unroll
                for (int n = 0; n < 2; ++n) acc[a][b][m][n] = (f32x4){0.f, 0.f, 0.f, 0.f};
    bf16x8 At[4][2], B0[2][2], B1[2][2];
    const char* cA = cur.a; const char* cB = cur.b;
    if constexpr (SP2) {
        PG8_STAGE(PG8_SB(0, 0), cB, voffB); PG8_STAGE(PG8_SB(0, 1), cB + hstepB, voffB); PG8_STAGE(PG8_SA(0, 0), cA, voffA); PG8_STAGE(PG8_SA(0, 1), cA + hstepA, voffA);
        if (wr == 1) PG8_BAR;
        PG8_WAIT_V(2); PG8_BAR;
        PG8_STAGE(PG8_SB(1, 0), cB + kstep, voffB); PG8_STAGE(PG8_SA(1, 0), cA + kstep, voffA); PG8_STAGE(PG8_SB(1, 1), cB + hstepB + kstep, voffB);
        PG8_WAIT_V(6); PG8_BAR;
    } else {
        PG8_STAGE(PG8_SB(0, 0), cB, voffB); PG8_STAGE(PG8_SA(0, 0), cA, voffA); PG8_STAGE(PG8_SB(0, 1), cB + hstepB, voffB); PG8_STAGE(PG8_SA(0, 1), cA + hstepA, voffA);
        if (wr == 1) PG8_BAR;
        PG8_WAIT_V(4); PG8_BAR;
        PG8_STAGE(PG8_SB(1, 0), cB + kstep, voffB); PG8_STAGE(PG8_SA(1, 0), cA + kstep, voffA); PG8_STAGE(PG8_SB(1, 1), cB + hstepB + kstep, voffB);
        PG8_WAIT_V(6); PG8_BAR;
    }
    for (;;) {
        const bool has_next = S.next(ui + 1, nxt);
        const char* nA = has_next ? nxt.a : cA; const char* nB = has_next ? nxt.b : cB;
        for (int t = 0; t < nt; t += 2) {
            const bool last = (t == nt - 2);
            const char* a1 = cA + (size_t)(t + 1) * kstep;
            const char* a2 = last ? nA : cA + (size_t)(t + 2) * kstep; const char* b2 = last ? nB : cB + (size_t)(t + 2) * kstep;
            const char* a3 = a2 + kstep; const char* b3 = b2 + kstep;
            if constexpr (SP2) {
            PG8_LDB(B0, 0, 0); PG8_LDB(B1, 0, 1); PG8_SCHED; PG8_LDA(At, 0, 0); PG8_STAGE(PG8_SA(1, 1), a1 + hstepA, voffA);
            PG8_WAIT_V(8); PG8_WAIT_L(0); PG8_BAR; PG8_MMA(0, 0, At, B0); PG8_MMA(0, 1, At, B1); PG8_BAR; PG8_SCHED;
            PG8_LDA(At, 0, 1); PG8_STAGE(PG8_SB(0, 0), b2, voffB); PG8_STAGE(PG8_SB(0, 1), b2 + hstepB, voffB); PG8_STAGE(PG8_SA(0, 0), a2, voffA);
            PG8_WAIT_V(8); PG8_WAIT_L(0); PG8_BAR; PG8_MMA(1, 0, At, B0); PG8_MMA(1, 1, At, B1); PG8_BAR; PG8_SCHED;
            PG8_LDB(B0, 1, 0); PG8_LDB(B1, 1, 1); PG8_SCHED; PG8_LDA(At, 1, 0); PG8_STAGE(PG8_SA(0, 1), a2 + hstepA, voffA);
            PG8_WAIT_V(8); PG8_WAIT_L(0); PG8_BAR; PG8_MMA(0, 0, At, B0); PG8_MMA(0, 1, At, B1); PG8_BAR; PG8_SCHED;
            PG8_LDA(At, 1, 1); PG8_STAGE(PG8_SB(1, 0), b3, voffB); PG8_STAGE(PG8_SB(1, 1), b3 + hstepB, voffB); PG8_STAGE(PG8_SA(1, 0), a3, voffA);
            PG8_WAIT_V(8); PG8_WAIT_L(0); PG8_BAR; PG8_MMA(1, 0, At, B0); PG8_MMA(1, 1, At, B1); PG8_BAR; PG8_SCHED;
            } else {
            PG8_LDB(B0, 0, 0); PG8_SCHED; PG8_LDA(At, 0, 0); PG8_STAGE(PG8_SA(1, 1), a1 + hstepA, voffA);
            PG8_WAIT_L(8); PG8_BAR; PG8_WAIT_L(0); PG8_MMA(0, 0, At, B0); PG8_BAR; PG8_SCHED;
            PG8_LDB(B1, 0, 1); PG8_STAGE(PG8_SB(0, 0), b2, voffB);
            PG8_BAR; PG8_WAIT_L(0); PG8_MMA(0, 1, At, B1); PG8_BAR;
            PG8_LDA(At, 0, 1); PG8_STAGE(PG8_SA(0, 0), a2, voffA);
            PG8_BAR; PG8_WAIT_L(0); PG8_MMA(1, 0, At, B0); PG8_BAR; PG8_SCHED;
            PG8_STAGE(PG8_SB(0, 1), b2 + hstepB, voffB);
            PG8_WAIT_V(6); PG8_BAR; PG8_MMA(1, 1, At, B1); PG8_BAR;
            PG8_LDB(B0, 1, 0); PG8_SCHED; PG8_LDA(At, 1, 0); PG8_STAGE(PG8_SA(0, 1), a2 + hstepA, voffA);
            PG8_WAIT_L(8); PG8_BAR; PG8_WAIT_L(0); PG8_MMA(0, 0, At, B0); PG8_BAR; PG8_SCHED;
            PG8_LDB(B1, 1, 1); PG8_STAGE(PG8_SB(1, 0), b3, voffB);
            PG8_BAR; PG8_WAIT_L(0); PG8_MMA(0, 1, At, B1); PG8_BAR;
            PG8_LDA(At, 1, 1); PG8_STAGE(PG8_SA(1, 0), a3, voffA);
            PG8_BAR; PG8_WAIT_L(0); PG8_MMA(1, 0, At, B0); PG8_BAR; PG8_SCHED;
            PG8_STAGE(PG8_SB(1, 1), b3 + hstepB, voffB);
            PG8_WAIT_V(6); PG8_BAR; PG8_MMA(1, 1, At, B1); PG8_BAR;
            }
        }
        if constexpr (ALIGN_EPI) { if (wr == 0) PG8_BAR; }
        if constexpr (!Epi::AFTER_DRAIN) { E(acc, cur, wr, wc, fr, fq); }
        if (!has_next) break;
#pragma unroll
        for (int a = 0; a < 2; ++a)
#pragma unroll
            for (int b = 0; b < 2; ++b)
#pragma unroll
                for (int m = 0; m < 4; ++m)
#pragma unroll
                    for (int n = 0; n < 2; ++n) acc[a][b][m][n] = (f32x4){0.f, 0.f, 0.f, 0.f};
        cur = nxt; cA = nA; cB = nB; ++ui;
        if constexpr (ALIGN_EPI) { if (wr == 1) PG8_BAR; }
    }
    PG8_WAIT_V(0);
    if constexpr (!ALIGN_EPI) { if (wr == 0) PG8_BAR; }
    PG8_BAR;
    if constexpr (Epi::AFTER_DRAIN) { E.fused(acc, cur, wr, wc, fr, fq, lds, wid, lane); }
#undef PG8_SA
#undef PG8_SB
#undef PG8_STAGE
#undef PG8_LDA
#undef PG8_LDB
#undef PG8_MMA
#undef PG8_WAIT_V
#undef PG8_WAIT_L
#undef PG8_BAR
#undef PG8_SCHED
}
}
using pg8::Unit; using pg8::Gemm;

constexpr int LDS_BYTES = 147456;
struct Args { const float* in[29]; float* out; unsigned char* ws; };

struct Ctx {
    LAS unsigned char* lds; int tid, lane, wave, G, bid, gw, NGW;
    const float* const* in; float* out; unsigned char* ws;
};

__device__ __forceinline__ void p0_transpose_item(const float* W, int ldw, bf16_t* WT, int ldt, const float* kscale, LAS float* scr, int kb, int nb, int lane) {
    const int k0 = 64 * kb, n0 = 32 * nb;
#pragma unroll 8
    for (int i = 0; i < 32; ++i) { const int kk = 2 * i + (lane >> 5); float v = W[(size_t)(k0 + kk) * ldw + n0 + (lane & 31)]; if (kscale) v *= kscale[k0 + kk]; scr[kk * 33 + (lane & 31)] = v; }
    LDS_WAIT(); asm volatile("" ::: "memory");
    const int c = lane & 7;
#pragma unroll
    for (int j = 0; j < 4; ++j) { const int n = (lane >> 3) + 8 * j; const LAS float* s = scr + (8 * c) * 33 + n;
        u32x4 o; o.x = cvt_pk_bf16(s[0 * 33], s[1 * 33]); o.y = cvt_pk_bf16(s[2 * 33], s[3 * 33]); o.z = cvt_pk_bf16(s[4 * 33], s[5 * 33]); o.w = cvt_pk_bf16(s[6 * 33], s[7 * 33]);
        *(u32x4*)(WT + (size_t)(n0 + n) * ldt + k0 + 8 * c) = o; }
    LDS_WAIT(); asm volatile("" ::: "memory");
}

__device__ __forceinline__ void p0_prologue(const Ctx& F) {
    LAS float* scr = (LAS float*)(F.lds + F.wave * 16384);
    unsigned char* ws = F.ws;
    constexpr int I_WIN = 16 * 192, I_QKV = 12 * 4 * 8, I_WOUT = 32 * 32, I_WPG = 16 * 32, I_WPP = 4 * 32;
    constexpr int I_T = I_WIN + I_QKV + I_WOUT + I_WPG + I_WPP;
    constexpr int I_X = MA, I_P = MA, I_SP = 1024, I_WG = 1024, I_YPAD = 128;
    constexpr int NITEMS = I_T + I_X + I_P + I_SP + I_WG + I_YPAD;
    for (int it = F.gw; it < NITEMS; it += F.NGW) {
        int r = it;
        if (r < I_T) {
            if (r < I_WIN) { p0_transpose_item(F.in[9], NIN, (bf16_t*)(ws + WS_WIN), DM, F.in[8], scr, r / 192, r % 192, F.lane); continue; } r -= I_WIN;
            if (r < I_QKV) { const int mat = r / 32, rr = r % 32, which = mat / 4, h = mat % 4;
                const float* W = F.in[16 + which] + (size_t)h * 65536; bf16_t* WT = (bf16_t*)(ws + (which == 0 ? WS_WQ : which == 1 ? WS_WK : WS_WV)) + (size_t)h * 65536;
                p0_transpose_item(W, 256, WT, 256, nullptr, scr, rr / 8, rr % 8, F.lane); continue; } r -= I_QKV;
            if (r < I_WOUT) { p0_transpose_item(F.in[23], DM, (bf16_t*)(ws + WS_WOUT), DMIX, nullptr, scr, r / 32, r % 32, F.lane); continue; } r -= I_WOUT;
            if (r < I_WPG) { p0_transpose_item(F.in[24], DM, (bf16_t*)(ws + WS_WPG), DM, nullptr, scr, r / 32, r % 32, F.lane); continue; } r -= I_WPG;
            p0_transpose_item(F.in[26], DM, (bf16_t*)(ws + WS_WPP), DPLE, nullptr, scr, r / 32, r % 32, F.lane); continue;
        }
        r -= I_T;
        if (r < I_X) {
            bf16_t* orow = (bf16_t*)(ws + WS_XB) + (size_t)r * DM; float* rs = (float*)(ws + WS_RS);
            unsigned long long* o8 = (unsigned long long*)orow + F.lane;
            if (r >= MP + MS) {
#pragma unroll
                for (int j = 0; j < 4; ++j) o8[64 * j] = 0ull;
                if (F.lane == 0) rs[r] = 0.f; continue; }
            const float* xrow = r < MP ? F.in[0] + (size_t)r * DM : F.in[1] + (size_t)(r - MP) * DM;
            const f32x4* xr = (const f32x4*)xrow + F.lane; f32x4 v[4]; float s = 0.f;
#pragma unroll
            for (int j = 0; j < 4; ++j) { v[j] = xr[64 * j]; s += (v[j].x * v[j].x + v[j].y * v[j].y) + (v[j].z * v[j].z + v[j].w * v[j].w); }
            s = wave_sum(s);
#pragma unroll
            for (int j = 0; j < 4; ++j) o8[64 * j] = (unsigned long long)cvt_pk_bf16(v[j].x, v[j].y) | ((unsigned long long)cvt_pk_bf16(v[j].z, v[j].w) << 32);
            if (F.lane == 0) rs[r] = 1.0f / sqrtf(s * (1.0f / DM) + EPS);
            continue;
        }
        r -= I_X;
        if (r < I_P) {
            unsigned long long* o8 = (unsigned long long*)((bf16_t*)(ws + WS_PB) + (size_t)r * DPLE) + F.lane;
            if (r >= MP + MS) { o8[0] = 0ull; continue; }
            const float* prow = r < MP ? F.in[6] + (size_t)r * DPLE : F.in[7] + (size_t)(r - MP) * DPLE;
            const f32x4 v = ((const f32x4*)prow)[F.lane];
            o8[0] = (unsigned long long)cvt_pk_bf16(v.x, v.y) | ((unsigned long long)cvt_pk_bf16(v.z, v.w) << 32);
            continue;
        }
        r -= I_P;
        if (r < I_SP) {
            const int t = r & 127; const float* wrow = F.in[12] + (size_t)r * 128; const f32x2 v = ((const f32x2*)wrow)[F.lane];
            const int s0 = 2 * F.lane; ((unsigned*)((bf16_t*)(ws + WS_WSP) + (size_t)r * 128))[F.lane] = cvt_pk_bf16(s0 <= t ? v.x : 0.f, s0 + 1 <= t ? v.y : 0.f);
            continue;
        }
        r -= I_SP;
        if (r < I_WG) {
            const int i = r, h = i >> 8, d = i & 255, j = F.lane & 7, isx = (F.lane >> 3) & 1, part = F.lane >> 4;
            const float* wif = F.in[19]; float s = 0.f;
            if (!isx) { const float* wq = F.in[16] + ((size_t)h * 256 + d) * 256; const float* wk = F.in[17] + ((size_t)h * 256 + d) * 256;
                for (int e = part * 64; e < part * 64 + 64; ++e) s += wq[e] * wif[(size_t)(h * 256 + e) * 8 + j] + wk[e] * wif[(size_t)(1024 + h * 256 + e) * 8 + j]; }
            else { const float* wv = F.in[18] + ((size_t)h * 256 + d) * 256;
                for (int e = part * 64; e < part * 64 + 64; ++e) s += wv[e] * wif[(size_t)(2048 + h * 256 + e) * 8 + j]; }
            s += __shfl_xor(s, 16); s += __shfl_xor(s, 32);
            if (F.lane < 16) ((float*)(ws + WS_WG))[(size_t)i * 16 + F.lane] = s;
            continue;
        }
        r -= I_WG;
        {
            u32x4* yrow = (u32x4*)((bf16_t*)(ws + WS_Y) + (size_t)(MP + MS + r) * DMIX) + F.lane;
#pragma unroll
            for (int j = 0; j < 4; ++j) yrow[64 * j] = (u32x4){0u, 0u, 0u, 0u};
        }
    }
}

struct OrderRowMajor {
    int nM, nN, n, G, c; const char* A; const char* B; size_t astep, bstep;
    __device__ __forceinline__ bool next(int i, Unit& u) const {
        const int L = i * G + c; if (L >= n) return false;
        u.pm = L / nN; u.pn = L % nN; u.aux = 0; u.a = A + (size_t)u.pm * astep; u.b = B + (size_t)u.pn * bstep; return true;
    }
};
struct EpiInProj {
    static constexpr bool PERM = true, AFTER_DRAIN = false;
    bf16_t* PA; bf16_t* PB; const float* rs;
    template <int KIND> __device__ __forceinline__ void run(const f32x4 (&acc)[2][2][4][2], bf16_t* base, int row0, int col0) const {
#pragma unroll
        for (int ai = 0; ai < 2; ++ai)
#pragma unroll
            for (int m = 0; m < 4; ++m) { const int row = row0 + ai * 128 + m * 16; const float s = rs[row]; bf16_t* rowp = base + (size_t)row * 3072 + col0;
#pragma unroll
                for (int bj = 0; bj < 2; ++bj) { f32x4 v0 = acc[ai][bj][m][0] * s, v1 = acc[ai][bj][m][1] * s;
                    if (KIND == 0) { f32x2 a = gelu_pk((f32x2){v0[0], v0[1]}), b = gelu_pk((f32x2){v0[2], v0[3]}), c = gelu_pk((f32x2){v1[0], v1[1]}), d = gelu_pk((f32x2){v1[2], v1[3]});
                        v0 = (f32x4){a.x, a.y, b.x, b.y}; v1 = (f32x4){c.x, c.y, d.x, d.y}; }
                    if (KIND == 1) {
#pragma unroll
                        for (int j = 0; j < 4; ++j) { v0[j] = siluf_(v0[j]); v1[j] = siluf_(v1[j]); } }
                    if (KIND == 3) {
#pragma unroll
                        for (int j = 0; j < 4; ++j) { v0[j] = sigmoidf_(v0[j]); v1[j] = sigmoidf_(v1[j]); } }
                    u32x4 w; w.x = cvt_pk_bf16(v0[0], v0[1]); w.y = cvt_pk_bf16(v0[2], v0[3]); w.z = cvt_pk_bf16(v1[0], v1[1]); w.w = cvt_pk_bf16(v1[2], v1[3]);
                    *(u32x4*)(rowp + bj * 128) = w; } }
    }
    __device__ __forceinline__ void operator()(const f32x4 (&acc)[2][2][4][2], const Unit& u, int wr, int wc, int fr, int fq) const {
        const int row0 = u.pm * 256 + wr * 64 + fr, pn = u.pn;
        bf16_t* base = pn < 12 ? PA + pn * 256 : PB + (pn - 12) * 256; const int col0 = wc * 32 + 8 * fq;
        if (pn < 8) run<0>(acc, base, row0, col0);
        else if (pn < 12 || pn >= 20) run<1>(acc, base, row0, col0);
        else if (pn < 16) run<2>(acc, base, row0, col0);
        else run<3>(acc, base, row0, col0);
    }
};

__device__ __forceinline__ float logsigmoidf_(float x) { return fminf(x, 0.f) - log1pf(__expf(-fabsf(x))); }
__device__ __forceinline__ void unpack8(const u32x4 w, float (&f)[8]) { f[0] = bf_lo(w.x); f[1] = bf_hi(w.x); f[2] = bf_lo(w.y); f[3] = bf_hi(w.y); f[4] = bf_lo(w.z); f[5] = bf_hi(w.z); f[6] = bf_lo(w.w); f[7] = bf_hi(w.w); }
__device__ __forceinline__ u32x4 pack8(const float (&f)[8]) { u32x4 w; w.x = cvt_pk_bf16(f[0], f[1]); w.y = cvt_pk_bf16(f[2], f[3]); w.z = cvt_pk_bf16(f[4], f[5]); w.w = cvt_pk_bf16(f[6], f[7]); return w; }

__device__ __forceinline__ void p2a_conv_gates(const Ctx& F) {
    unsigned char* ws = F.ws;
    const bf16_t* PBX = (const bf16_t*)(ws + WS_PROJB);
    bf16_t* XC = (bf16_t*)(ws + WS_XB);
    const float* Wg = (const float*)(ws + WS_WG);
    float* GLI = (float*)(ws + WS_GLI); float* GLF = (float*)(ws + WS_GLF);
    const float* convw = F.in[14]; const float* convb = F.in[15]; const float* bif = F.in[20];
    LAS float* red = (LAS float*)F.lds;
    const int cgp = F.tid & 127, rg = F.tid >> 7, ch0 = cgp * 8;
    for (int tile = F.bid; tile < MP / 32; tile += F.G) {
        float cw[4][8], cb[8];
#pragma unroll
        for (int j = 0; j < 4; ++j) { const f32x4 a = *(const f32x4*)(convw + j * 1024 + ch0), b = *(const f32x4*)(convw + j * 1024 + ch0 + 4);
            cw[j][0] = a.x; cw[j][1] = a.y; cw[j][2] = a.z; cw[j][3] = a.w; cw[j][4] = b.x; cw[j][5] = b.y; cw[j][6] = b.z; cw[j][7] = b.w; }
        { const f32x4 a = *(const f32x4*)(convb + ch0), b = *(const f32x4*)(convb + ch0 + 4); cb[0] = a.x; cb[1] = a.y; cb[2] = a.z; cb[3] = a.w; cb[4] = b.x; cb[5] = b.y; cb[6] = b.z; cb[7] = b.w; }
        const int r0 = tile * 32 + rg * 8, seq0 = r0 & ~(SEQ - 1);
        float w0[8], w1[8], w2[8], cur[8];
#pragma unroll
        for (int c = 0; c < 8; ++c) { w0[c] = 0.f; w1[c] = 0.f; w2[c] = 0.f; }
        if (r0 - 3 >= seq0) unpack8(*(const u32x4*)(PBX + (size_t)(r0 - 3) * 3072 + ch0), w0);
        if (r0 - 2 >= seq0) unpack8(*(const u32x4*)(PBX + (size_t)(r0 - 2) * 3072 + ch0), w1);
        if (r0 - 1 >= seq0) unpack8(*(const u32x4*)(PBX + (size_t)(r0 - 1) * 3072 + ch0), w2);
#pragma unroll 1
        for (int i = 0; i < 8; ++i) {
            const int r = r0 + i;
            unpack8(*(const u32x4*)(PBX + (size_t)r * 3072 + ch0), cur);
            float xc[8], gp[8];
#pragma unroll
            for (int c = 0; c < 8; ++c) xc[c] = siluf_(cw[0][c] * w0[c] + cw[1][c] * w1[c] + cw[2][c] * w2[c] + cw[3][c] * cur[c] + cb[c]);
            *(u32x4*)(XC + (size_t)r * DM + ch0) = pack8(xc);
#pragma unroll
            for (int j = 0; j < 8; ++j) gp[j] = 0.f;
#pragma unroll
            for (int c = 0; c < 8; ++c) { const float* wrow = Wg + (size_t)(ch0 + c) * 16;
                const f32x4 a = *(const f32x4*)(wrow), b = *(const f32x4*)(wrow + 4), cc = *(const f32x4*)(wrow + 8), d = *(const f32x4*)(wrow + 12);
                gp[0] += xc[c] * a.x + cur[c] * cc.x; gp[1] += xc[c] * a.y + cur[c] * cc.y; gp[2] += xc[c] * a.z + cur[c] * cc.z; gp[3] += xc[c] * a.w + cur[c] * cc.w;
                gp[4] += xc[c] * b.x + cur[c] * d.x; gp[5] += xc[c] * b.y + cur[c] * d.y; gp[6] += xc[c] * b.z + cur[c] * d.z; gp[7] += xc[c] * b.w + cur[c] * d.w; }
#pragma unroll
            for (int j = 0; j < 8; ++j) gp[j] = wave_sum(gp[j]);
            if (F.lane == 0) {
#pragma unroll
                for (int j = 0; j < 8; ++j) red[((rg * 8 + i) * 2 + (F.wave & 1)) * 8 + j] = gp[j]; }
#pragma unroll
            for (int c = 0; c < 8; ++c) { w0[c] = w1[c]; w1[c] = w2[c]; w2[c] = cur[c]; }
        }
        __syncthreads();
        if (F.tid < 256) { const int rl = F.tid >> 3, j = F.tid & 7, r = tile * 32 + rl;
            const float g = red[(rl * 2 + 0) * 8 + j] + red[(rl * 2 + 1) * 8 + j] + bif[j];
            if (j < 4) GLI[(size_t)j * MA + r] = g; else GLF[(size_t)(j - 4) * MA + r] = logsigmoidf_(g); }
        __syncthreads();
    }
    for (int i = F.bid * 512 + F.tid; i < NB * 3 * 1024; i += F.G * 512) { const int b = i / 3072, j = (i / 1024) % 3, ch = i & 1023;
        F.out[O_CVP + i] = bf2f(PBX[(size_t)(b * SEQ + SEQ - 3 + j) * 3072 + ch]); }
    for (int i = F.gw; i < MS; i += F.NGW) {
        const int r = MP + i, ch0s = F.lane * 16; const float* st = F.in[5] + (size_t)i * 3 * 1024;
        const bf16_t* PA = (const bf16_t*)(ws + WS_PROJA) + (size_t)r * 3072;
        float gp[8];
#pragma unroll
        for (int j = 0; j < 8; ++j) gp[j] = 0.f;
#pragma unroll
        for (int half = 0; half < 2; ++half) { const int c0 = ch0s + half * 8; float xb[8], xc[8];
            unpack8(*(const u32x4*)(PBX + (size_t)r * 3072 + c0), xb);
#pragma unroll
            for (int c = 0; c < 8; ++c) { const int ch = c0 + c; const float s0 = st[ch], s1 = st[1024 + ch], s2 = st[2048 + ch];
                xc[c] = siluf_(convw[ch] * s0 + convw[1024 + ch] * s1 + convw[2048 + ch] * s2 + convw[3072 + ch] * xb[c] + convb[ch]);
                F.out[O_CVS + (size_t)i * 3072 + ch] = s1; F.out[O_CVS + (size_t)i * 3072 + 1024 + ch] = s2; F.out[O_CVS + (size_t)i * 3072 + 2048 + ch] = xb[c];
                const float* wrow = Wg + (size_t)ch * 16;
#pragma unroll
                for (int j = 0; j < 8; ++j) gp[j] += xc[c] * wrow[j] + xb[c] * wrow[8 + j]; }
            *(u32x4*)(XC + (size_t)r * DM + c0) = pack8(xc); }
#pragma unroll
        for (int j = 0; j < 8; ++j) gp[j] = wave_sum(gp[j]);
        if (F.lane < 8) { float g = 0.f;
#pragma unroll
            for (int j = 0; j < 8; ++j) g = (F.lane == j) ? gp[j] : g;
            g += bif[F.lane];
            if (F.lane < 4) GLI[(size_t)F.lane * MA + r] = g; else GLF[(size_t)(F.lane - 4) * MA + r] = logsigmoidf_(g); }
        float gv[16], s = 0.f;
        { float t8[8]; unpack8(*(const u32x4*)(PA + 1024 + ch0s), t8);
#pragma unroll
          for (int c = 0; c < 8; ++c) gv[c] = t8[c];
          unpack8(*(const u32x4*)(PA + 1024 + ch0s + 8), t8);
#pragma unroll
          for (int c = 0; c < 8; ++c) gv[8 + c] = t8[c]; }
#pragma unroll
        for (int c = 0; c < 16; ++c) s += gv[c];
        s += __shfl_xor(s, 1); s += __shfl_xor(s, 2); s += __shfl_xor(s, 4);
        const float mu = s * (1.f / 128.f); float q = 0.f;
#pragma unroll
        for (int c = 0; c < 16; ++c) { const float d = gv[c] - mu; q += d * d; }
        q += __shfl_xor(q, 1); q += __shfl_xor(q, 2); q += __shfl_xor(q, 4);
        const float rstd = 1.0f / sqrtf(q * (1.f / 128.f) + EPS);
        const int h = F.lane >> 3; const float wsp = F.in[12][(size_t)h * 16384], bsp = F.in[13][h * 128];
        float uu[16], zz[16];
        { float t8[8]; unpack8(*(const u32x4*)(PA + ch0s), t8);
#pragma unroll
          for (int c = 0; c < 8; ++c) uu[c] = t8[c];
          unpack8(*(const u32x4*)(PA + ch0s + 8), t8);
#pragma unroll
          for (int c = 0; c < 8; ++c) uu[8 + c] = t8[c];
          unpack8(*(const u32x4*)(PA + 2048 + ch0s), t8);
#pragma unroll
          for (int c = 0; c < 8; ++c) zz[c] = t8[c];
          unpack8(*(const u32x4*)(PA + 2048 + ch0s + 8), t8);
#pragma unroll
          for (int c = 0; c < 8; ++c) zz[8 + c] = t8[c]; }
        float ya[16];
#pragma unroll
        for (int c = 0; c < 16; ++c) { const int ch = ch0s + c; const float vn = (gv[c] - mu) * rstd * F.in[10][ch] + F.in[11][ch];
            F.out[O_VS + (size_t)i * 1024 + ch] = vn; ya[c] = uu[c] * (wsp * vn + bsp) * zz[c]; }
        bf16_t* yrow = (bf16_t*)(ws + WS_Y) + (size_t)r * DMIX + ch0s;
        { float t8[8];
#pragma unroll
          for (int c = 0; c < 8; ++c) t8[c] = ya[c];
          *(u32x4*)(yrow) = pack8(t8);
#pragma unroll
          for (int c = 0; c < 8; ++c) t8[c] = ya[8 + c];
          *(u32x4*)(yrow + 8) = pack8(t8); }
    }
}

__device__ __forceinline__ void mscan_wave(const Ctx& F, int bh) {
    unsigned char* ws = F.ws; const int b = bh >> 2, h = bh & 3, lane = F.lane;
    const float* li = (const float*)(ws + WS_GLI) + (size_t)h * MA + (size_t)b * SEQ + lane * 32;
    const float* lf = (const float*)(ws + WS_GLF) + (size_t)h * MA + (size_t)b * SEQ + lane * 32;
    float A = 0.f, Bv = -INFINITY;
    for (int i = 0; i < 32; ++i) { const float f = lf[i], l = li[i]; Bv = fmaxf(Bv + f, l); A += f; }
    float sA = A, sB = Bv;
#pragma unroll
    for (int o = 1; o < 64; o <<= 1) { const float pA = __shfl_up(sA, o), pB = __shfl_up(sB, o); if (lane >= o) { sB = fmaxf(pB + sA, sB); sA = pA + sA; } }
    float eA = __shfl_up(sA, 1), eB = __shfl_up(sB, 1); if (lane == 0) { eA = 0.f; eB = -INFINITY; }
    const float m_in = fmaxf(0.f + eA, eB);
    float cA = A;
#pragma unroll
    for (int o = 1; o < 8; o <<= 1) { const float p = __shfl_up(cA, o); if ((lane & 7) >= o) cA += p; }
    const float b_in = cA - A;
    const float m_prev = __shfl(m_in, lane & ~7);
    float* DA = (float*)(ws + WS_DA) + (size_t)h * MA + (size_t)b * SEQ + lane * 32; float* DR = (float*)(ws + WS_DR) + (size_t)h * MA + (size_t)b * SEQ + lane * 32;
    float* DG = (float*)(ws + WS_DG) + (size_t)h * MA + (size_t)b * SEQ + lane * 32; float* DEM = (float*)(ws + WS_DEM) + (size_t)h * MA + (size_t)b * SEQ + lane * 32;
    float* DW = (float*)(ws + WS_DW) + (size_t)h * MA + (size_t)b * SEQ + lane * 32;
    float m = m_in, bb = b_in, a_last = 0.f;
    for (int i = 0; i < 32; ++i) { const float f = lf[i], l = li[i]; m = fmaxf(m + f, l); bb += f;
        a_last = bb - m; DA[i] = a_last; DR[i] = l - bb; DG[i] = __expf(bb + m_prev - m); DEM[i] = __expf(-m); }
    const float a_end = __shfl(a_last, lane | 7);
    for (int i = 0; i < 32; ++i) { const float f = lf[i]; (void)f; }
    { float bb2 = b_in; for (int i = 0; i < 32; ++i) { bb2 += lf[i]; DW[i] = __expf(a_end + (li[i] - bb2)); } }
    if (lane == 63) F.out[O_MP + bh] = m;
}

__device__ __forceinline__ void p9_final(const Ctx& F) {
    unsigned char* ws = F.ws; const bf16_t* GB = (const bf16_t*)(ws + WS_GB); const bf16_t* EB = (const bf16_t*)(ws + WS_EB);
    const float* pleg = F.in[27]; const float* fing = F.in[28];
    for (int r = F.gw; r < MP + MS; r += F.NGW) {
        float* xrow = r < MP ? F.out + O_Y + (size_t)r * DM : F.out + O_YS + (size_t)(r - MP) * DM;
        float x1[16], gg[16], ee[16]; const int c0 = F.lane * 16;
#pragma unroll
        for (int j = 0; j < 4; ++j) { const f32x4 v = *(const f32x4*)(xrow + c0 + 4 * j); x1[4 * j] = v.x; x1[4 * j + 1] = v.y; x1[4 * j + 2] = v.z; x1[4 * j + 3] = v.w; }
        { float t8[8]; unpack8(*(const u32x4*)(GB + (size_t)r * DM + c0), t8);
#pragma unroll
          for (int c = 0; c < 8; ++c) gg[c] = t8[c];
          unpack8(*(const u32x4*)(GB + (size_t)r * DM + c0 + 8), t8);
#pragma unroll
          for (int c = 0; c < 8; ++c) gg[8 + c] = t8[c];
          unpack8(*(const u32x4*)(EB + (size_t)r * DM + c0), t8);
#pragma unroll
          for (int c = 0; c < 8; ++c) ee[c] = t8[c];
          unpack8(*(const u32x4*)(EB + (size_t)r * DM + c0 + 8), t8);
#pragma unroll
          for (int c = 0; c < 8; ++c) ee[8 + c] = t8[c]; }
        float s = 0.f;
#pragma unroll
        for (int c = 0; c < 16; ++c) s += ee[c] * ee[c];
        s = wave_sum(s); const float rse = 1.0f / sqrtf(s * (1.f / DM) + EPS);
        float s2 = 0.f;
#pragma unroll
        for (int c = 0; c < 16; ++c) { x1[c] = x1[c] + gg[c] * (ee[c] * rse * pleg[c0 + c]); s2 += x1[c] * x1[c]; }
        s2 = wave_sum(s2); const float rs2 = 1.0f / sqrtf(s2 * (1.f / DM) + EPS);
#pragma unroll
        for (int j = 0; j < 4; ++j) { f32x4 v; v.x = x1[4 * j] * rs2 * fing[c0 + 4 * j]; v.y = x1[4 * j + 1] * rs2 * fing[c0 + 4 * j + 1]; v.z = x1[4 * j + 2] * rs2 * fing[c0 + 4 * j + 2]; v.w = x1[4 * j + 3] * rs2 * fing[c0 + 4 * j + 3];
            *(f32x4*)(xrow + c0 + 4 * j) = v; }
    }
}
template <class Epi>
__global__ void __launch_bounds__(256) ngemm(const bf16_t* A, int lda, size_t azs, const bf16_t* Bt, int ldb, size_t bzs, int K, Epi E) {
    __shared__ float As[64][33], Bs[64][33];
    const int tid = threadIdx.x, tx = tid & 15, ty = tid >> 4, z = blockIdx.z, row0 = blockIdx.y * 64, col0 = blockIdx.x * 64;
    const bf16_t* Ab = A + (size_t)z * azs + (size_t)(row0 + (tid >> 2)) * lda + (tid & 3) * 8;
    const bf16_t* Bb = Bt + (size_t)z * bzs + (size_t)(col0 + (tid >> 2)) * ldb + (tid & 3) * 8;
    float acc[4][4];
#pragma unroll
    for (int i = 0; i < 4; ++i)
#pragma unroll
        for (int j = 0; j < 4; ++j) acc[i][j] = 0.f;
    for (int k0 = 0; k0 < K; k0 += 32) {
        float a8[8], b8[8]; unpack8(*(const u32x4*)(Ab + k0), a8); unpack8(*(const u32x4*)(Bb + k0), b8);
        __syncthreads();
#pragma unroll
        for (int c = 0; c < 8; ++c) { As[tid >> 2][(tid & 3) * 8 + c] = a8[c]; Bs[tid >> 2][(tid & 3) * 8 + c] = b8[c]; }
        __syncthreads();
#pragma unroll 8
        for (int k = 0; k < 32; ++k) { float av[4], bv[4];
#pragma unroll
            for (int i = 0; i < 4; ++i) { av[i] = As[ty * 4 + i][k]; bv[i] = Bs[tx * 4 + i][k]; }
#pragma unroll
            for (int i = 0; i < 4; ++i)
#pragma unroll
                for (int j = 0; j < 4; ++j) acc[i][j] += av[i] * bv[j]; }
    }
#pragma unroll
    for (int i = 0; i < 4; ++i)
#pragma unroll
        for (int j = 0; j < 4; ++j) E(z, row0 + ty * 4 + i, col0 + tx * 4 + j, acc[i][j]);
}
struct NEpiInProj { bf16_t* PA; bf16_t* PB; const float* rs;
    __device__ void operator()(int, int row, int col, float acc) const { float v = acc * rs[row]; const int grp = col >> 10;
        if (grp < 2) v = 0.5f * v * (1.0f + erff(v * 0.70710678118f)); else if (grp == 2 || grp == 5) v = v / (1.0f + expf(-v)); else if (grp == 4) v = 1.0f / (1.0f + expf(-v));
        bf16_t* dst = col < 3072 ? PA + (size_t)row * 3072 + col : PB + (size_t)row * 3072 + (col - 3072); *dst = f2bf(v); } };
struct NEpiHead { bf16_t* O; float scale;
    __device__ void operator()(int z, int row, int col, float acc) const { O[(size_t)row * 1024 + z * 256 + col] = f2bf(acc * scale); } };
struct NEpiOut { const float* xp; const float* xs; float* out; bf16_t* X1B;
    __device__ void operator()(int, int row, int col, float acc) const { if (row >= MP + MS) { X1B[(size_t)row * DM + col] = 0; return; }
        const float x = row < MP ? xp[(size_t)row * DM + col] : xs[(size_t)(row - MP) * DM + col]; const float v = x + acc;
        if (row < MP) out[O_Y + (size_t)row * DM + col] = v; else out[O_YS + (size_t)(row - MP) * DM + col] = v; X1B[(size_t)row * DM + col] = f2bf(v); } };
struct NEpiGate { bf16_t* GB; const float* bias;
    __device__ void operator()(int, int row, int col, float acc) const { GB[(size_t)row * DM + col] = f2bf(1.0f / (1.0f + expf(-(acc + bias[col])))); } };
struct NEpiPlain { bf16_t* O; int ldo;
    __device__ void operator()(int, int row, int col, float acc) const { O[(size_t)row * ldo + col] = f2bf(acc); } };

__global__ void __launch_bounds__(512, 2) k_p0(Args args) { extern __shared__ __attribute__((aligned(16))) unsigned char lds_raw[];
    Ctx F; F.lds = (LAS unsigned char*)lds_raw; F.tid = threadIdx.x; F.lane = F.tid & 63; F.wave = __builtin_amdgcn_readfirstlane(F.tid >> 6);
    F.G = gridDim.x; F.bid = blockIdx.x; F.gw = F.bid * 8 + F.wave; F.NGW = F.G * 8; F.in = args.in; F.out = args.out; F.ws = args.ws; p0_prologue(F); }
__global__ void __launch_bounds__(512, 2) k_p2a(Args args) { extern __shared__ __attribute__((aligned(16))) unsigned char lds_raw[];
    Ctx F; F.lds = (LAS unsigned char*)lds_raw; F.tid = threadIdx.x; F.lane = F.tid & 63; F.wave = __builtin_amdgcn_readfirstlane(F.tid >> 6);
    F.G = gridDim.x; F.bid = blockIdx.x; F.gw = F.bid * 8 + F.wave; F.NGW = F.G * 8; F.in = args.in; F.out = args.out; F.ws = args.ws; p2a_conv_gates(F); }
__global__ void __launch_bounds__(512, 2) k_mscan(Args args) { extern __shared__ __attribute__((aligned(16))) unsigned char lds_raw[];
    Ctx F; F.lds = (LAS unsigned char*)lds_raw; F.tid = threadIdx.x; F.lane = F.tid & 63; F.wave = __builtin_amdgcn_readfirstlane(F.tid >> 6);
    F.G = gridDim.x; F.bid = blockIdx.x; F.gw = F.bid * 8 + F.wave; F.NGW = F.G * 8; F.in = args.in; F.out = args.out; F.ws = args.ws; if (F.bid < 32 && F.wave == 0) mscan_wave(F, F.bid); }
__global__ void __launch_bounds__(512, 2) k_p9(Args args) { extern __shared__ __attribute__((aligned(16))) unsigned char lds_raw[];
    Ctx F; F.lds = (LAS unsigned char*)lds_raw; F.tid = threadIdx.x; F.lane = F.tid & 63; F.wave = __builtin_amdgcn_readfirstlane(F.tid >> 6);
    F.G = gridDim.x; F.bid = blockIdx.x; F.gw = F.bid * 8 + F.wave; F.NGW = F.G * 8; F.in = args.in; F.out = args.out; F.ws = args.ws; p9_final(F); }

__global__ void n_vn(Args a, float* VN) {
    const int gw = (blockIdx.x * blockDim.x + threadIdx.x) >> 6, lane = threadIdx.x & 63; if (gw >= MP * HA) return; const int row = gw >> 3, h = gw & 7;
    const bf16_t* gv = (const bf16_t*)(a.ws + WS_PROJA) + (size_t)row * 3072 + 1024 + h * 128; const float x0 = bf2f(gv[lane]), x1 = bf2f(gv[64 + lane]);
    const float mu = wave_sum(x0 + x1) * (1.f / 128.f); const float d0 = x0 - mu, d1 = x1 - mu; const float rstd = 1.0f / sqrtf(wave_sum(d0 * d0 + d1 * d1) * (1.f / 128.f) + EPS);
    VN[(size_t)row * 1024 + h * 128 + lane] = d0 * rstd * a.in[10][h * 128 + lane] + a.in[11][h * 128 + lane];
    VN[(size_t)row * 1024 + h * 128 + 64 + lane] = d1 * rstd * a.in[10][h * 128 + 64 + lane] + a.in[11][h * 128 + 64 + lane]; }
__global__ void n_spatial(Args a, const float* VN) {
    const size_t i = (size_t)blockIdx.x * blockDim.x + threadIdx.x; if (i >= (size_t)MP * 1024) return; const int row = (int)(i >> 10), ch = (int)(i & 1023), h = ch >> 7, t = row & 127, r0 = row - t;
    const float* w = a.in[12] + ((size_t)h * 128 + t) * 128; float s = 0.f; for (int ss = 0; ss <= t; ++ss) s += w[ss] * VN[(size_t)(r0 + ss) * 1024 + ch];
    s += a.in[13][h * 128 + t]; const bf16_t* PA = (const bf16_t*)(a.ws + WS_PROJA) + (size_t)row * 3072;
    ((bf16_t*)(a.ws + WS_Y))[(size_t)row * DMIX + ch] = f2bf(bf2f(PA[ch]) * s * bf2f(PA[2048 + ch])); }

__global__ void __launch_bounds__(256) n_mlstm_prompt(Args a, const bf16_t* Q, const bf16_t* Kk, const bf16_t* V, float* H) {
    __shared__ float red[4][34]; __shared__ float vsh[32];
    const int bh = blockIdx.x >> 3, es = blockIdx.x & 7, b = bh >> 2, h = bh & 3, d = threadIdx.x, lane = d & 63, wv = d >> 6;
    const float* li = (const float*)(a.ws + WS_GLI) + (size_t)h * MA + (size_t)b * SEQ; const float* lf = (const float*)(a.ws + WS_GLF) + (size_t)h * MA + (size_t)b * SEQ;
    float C[32], n = 0.f, m = 0.f;
#pragma unroll
    for (int e = 0; e < 32; ++e) C[e] = 0.f;
    for (int t = 0; t < SEQ; ++t) { const size_t row = (size_t)b * SEQ + t;
        const float mn = fmaxf(lf[t] + m, li[t]), f = expf(lf[t] + m - mn), ig = expf(li[t] - mn); m = mn;
        const float q = bf2f(Q[row * 1024 + h * 256 + d]), k = bf2f(Kk[row * 1024 + h * 256 + d]);
        __syncthreads();
        if (d < 32) vsh[d] = bf2f(V[row * 1024 + h * 256 + es * 32 + d]);
        __syncthreads();
        n = f * n + ig * k; float p[33];
#pragma unroll
        for (int e = 0; e < 32; ++e) { C[e] = f * C[e] + ig * vsh[e] * k; p[e] = C[e] * q; }
        p[32] = n * q;
#pragma unroll
        for (int e = 0; e < 33; ++e) { p[e] = wave_sum(p[e]); }
        if (lane == 0) {
#pragma unroll
            for (int e = 0; e < 33; ++e) red[wv][e] = p[e]; }
        __syncthreads();
        if (d < 32) { const float num = red[0][d] + red[1][d] + red[2][d] + red[3][d], den = red[0][32] + red[1][32] + red[2][32] + red[3][32];
            H[row * 1024 + h * 256 + es * 32 + d] = num / fmaxf(fabsf(den), expf(-mn)); }
    }
#pragma unroll
    for (int e = 0; e < 32; ++e) a.out[O_CP + (((size_t)bh * 256) + es * 32 + e) * 256 + d] = C[e];
    if (es == 0) { a.out[O_NP + (size_t)bh * 256 + d] = n; if (d == 0) a.out[O_MP + bh] = m; }
}
__global__ void n_yb(Args a, const float* H) {
    const int gw = (blockIdx.x * blockDim.x + threadIdx.x) >> 6, lane = threadIdx.x & 63; if (gw >= MP * HB) return; const int row = gw >> 2, h = gw & 3;
    const bf16_t* PB = (const bf16_t*)(a.ws + WS_PROJB) + (size_t)row * 3072; const bf16_t* XC = (const bf16_t*)(a.ws + WS_XB) + (size_t)row * DM;
    float x[4]; float s = 0.f;
#pragma unroll
    for (int j = 0; j < 4; ++j) { const int e = j * 64 + lane; x[j] = H[(size_t)row * 1024 + h * 256 + e] * bf2f(PB[1024 + h * 256 + e]); s += x[j]; }
    const float mu = wave_sum(s) * (1.f / 256.f); float q = 0.f;
#pragma unroll
    for (int j = 0; j < 4; ++j) { x[j] -= mu; q += x[j] * x[j]; }
    const float rstd = 1.0f / sqrtf(wave_sum(q) * (1.f / 256.f) + EPS);
#pragma unroll
    for (int j = 0; j < 4; ++j) { const int e = j * 64 + lane, ch = h * 256 + e; const float hb = x[j] * rstd * a.in[21][ch];
        ((bf16_t*)(a.ws + WS_Y))[(size_t)row * DMIX + 1024 + ch] = f2bf((hb + a.in[22][ch] * bf2f(XC[ch])) * bf2f(PB[2048 + ch])); }
}
__global__ void __launch_bounds__(256) n_mlstm_sample(Args a, const bf16_t* Q, const bf16_t* Kk, const bf16_t* V) {
    __shared__ float qs[256], ks[256], red[8];
    const int i = blockIdx.x >> 2, h = blockIdx.x & 3, e = threadIdx.x, lane = e & 63, wv = e >> 6; const size_t row = MP + i;
    qs[e] = bf2f(Q[row * 1024 + h * 256 + e]); ks[e] = bf2f(Kk[row * 1024 + h * 256 + e]); const float v = bf2f(V[row * 1024 + h * 256 + e]);
    const float li = ((const float*)(a.ws + WS_GLI))[(size_t)h * MA + row], lf = ((const float*)(a.ws + WS_GLF))[(size_t)h * MA + row], m0 = a.in[4][i * 4 + h];
    const float mn = fmaxf(lf + m0, li), g = expf(lf + m0 - mn), wi = expf(li - mn);
    const float n0 = a.in[3][((size_t)i * 4 + h) * 256 + e];
    __syncthreads();
    float p0 = wave_sum(qs[e] * ks[e]), p1 = wave_sum(n0 * qs[e]); if (lane == 0) { red[wv] = p0; red[4 + wv] = p1; }
    __syncthreads();
    const float qk = red[0] + red[1] + red[2] + red[3], nq = red[4] + red[5] + red[6] + red[7];
    const float* C0 = a.in[2] + (((size_t)i * 4 + h) * 256 + e) * 256; float* C1 = a.out + O_CS + (((size_t)i * 4 + h) * 256 + e) * 256; float cq = 0.f;
    for (int d = 0; d < 256; ++d) { const float c = C0[d]; cq += c * qs[d]; C1[d] = g * c + wi * v * ks[d]; }
    const float sc = wi * qk, num = sc * v + g * cq, den = sc + g * nq, hv = num / fmaxf(fabsf(den), expf(-mn));
    a.out[O_NS + ((size_t)i * 4 + h) * 256 + e] = g * n0 + wi * ks[e]; if (e == 0) a.out[O_MS + i * 4 + h] = mn;
    const bf16_t* PB = (const bf16_t*)(a.ws + WS_PROJB) + row * 3072; const bf16_t* XC = (const bf16_t*)(a.ws + WS_XB) + row * DM; const int ch = h * 256 + e;
    const float x = hv * bf2f(PB[1024 + ch]);
    __syncthreads();
    p0 = wave_sum(x); if (lane == 0) red[wv] = p0;
    __syncthreads();
    const float mu = (red[0] + red[1] + red[2] + red[3]) * (1.f / 256.f), dx = x - mu;
    __syncthreads();
    p0 = wave_sum(dx * dx); if (lane == 0) red[wv] = p0;
    __syncthreads();
    const float rstd = 1.0f / sqrtf((red[0] + red[1] + red[2] + red[3]) * (1.f / 256.f) + EPS);
    ((bf16_t*)(a.ws + WS_Y))[row * DMIX + 1024 + ch] = f2bf((dx * rstd * a.in[21][ch] + a.in[22][ch] * bf2f(XC[ch])) * bf2f(PB[2048 + ch]));
}

extern "C" void kernel_launch(void* const* d_in, const int* in_sizes, int n_in, void* d_out, int out_size, void* d_ws, size_t ws_size, hipStream_t stream) {
    static int ok = 0;
    if (ok == 0) {
        if (n_in != 29 || (size_t)out_size != O_END || ws_size < WS_END) { fprintf(stderr, "kernel_launch: unexpected shapes (n_in %d out %d ws %zu)\n", n_in, out_size, ws_size); ok = -1; return; }
        (void)hipFuncSetAttribute((const void*)k_p0, hipFuncAttributeMaxDynamicSharedMemorySize, LDS_BYTES);
        (void)hipFuncSetAttribute((const void*)k_p2a, hipFuncAttributeMaxDynamicSharedMemorySize, LDS_BYTES);
        (void)hipFuncSetAttribute((const void*)k_mscan, hipFuncAttributeMaxDynamicSharedMemorySize, LDS_BYTES);
        (void)hipFuncSetAttribute((const void*)k_p9, hipFuncAttributeMaxDynamicSharedMemorySize, LDS_BYTES);
        ok = 1;
    }
    if (ok < 0) return;
    Args a{};
    for (int i = 0; i < 29; ++i) a.in[i] = (const float*)d_in[i];
    a.out = (float*)d_out; a.ws = (unsigned char*)d_ws;
    unsigned char* ws = (unsigned char*)d_ws;
    bf16_t* Q = (bf16_t*)(ws + WS_Q); bf16_t* Kk = (bf16_t*)(ws + WS_K); bf16_t* Vf = (bf16_t*)(ws + WS_PQ); float* H = (float*)(ws + WS_VC); float* VN = (float*)(ws + WS_PQ);
    k_p0<<<256, 512, LDS_BYTES, stream>>>(a);
    ngemm<<<dim3(NIN / 64, MA / 64, 1), 256, 0, stream>>>((const bf16_t*)(ws + WS_XB), DM, 0, (const bf16_t*)(ws + WS_WIN), DM, 0, DM, NEpiInProj{(bf16_t*)(ws + WS_PROJA), (bf16_t*)(ws + WS_PROJB), (const float*)(ws + WS_RS)});
    k_p2a<<<256, 512, LDS_BYTES, stream>>>(a);
    n_vn<<<MP * HA / 4, 256, 0, stream>>>(a, VN);
    n_spatial<<<MP * 1024 / 256, 256, 0, stream>>>(a, VN);
    ngemm<<<dim3(4, MA / 64, 4), 256, 0, stream>>>((const bf16_t*)(ws + WS_XB), DM, 256, (const bf16_t*)(ws + WS_WQ), 256, 65536, 256, NEpiHead{Q, 1.0f});
    ngemm<<<dim3(4, MA / 64, 4), 256, 0, stream>>>((const bf16_t*)(ws + WS_XB), DM, 256, (const bf16_t*)(ws + WS_WK), 256, 65536, 256, NEpiHead{Kk, 0.0625f});
    ngemm<<<dim3(4, MA / 64, 4), 256, 0, stream>>>((const bf16_t*)(ws + WS_PROJB), 3072, 256, (const bf16_t*)(ws + WS_WV), 256, 65536, 256, NEpiHead{Vf, 1.0f});
    n_mlstm_prompt<<<256, 256, 0, stream>>>(a, Q, Kk, Vf, H);
    n_yb<<<MP * HB / 4, 256, 0, stream>>>(a, H);
    n_mlstm_sample<<<MS * HB, 256, 0, stream>>>(a, Q, Kk, Vf);
    ngemm<<<dim3(DM / 64, MA / 64, 1), 256, 0, stream>>>((const bf16_t*)(ws + WS_Y), DMIX, 0, (const bf16_t*)(ws + WS_WOUT), DMIX, 0, DMIX, NEpiOut{a.in[0], a.in[1], a.out, (bf16_t*)(ws + WS_X1B)});
    ngemm<<<dim3(DM / 64, MA / 64, 1), 256, 0, stream>>>((const bf16_t*)(ws + WS_X1B), DM, 0, (const bf16_t*)(ws + WS_WPG), DM, 0, DM, NEpiGate{(bf16_t*)(ws + WS_GB), a.in[25]});
    ngemm<<<dim3(DM / 64, MA / 64, 1), 256, 0, stream>>>((const bf16_t*)(ws + WS_PB), DPLE, 0, (const bf16_t*)(ws + WS_WPP), DPLE, 0, DPLE, NEpiPlain{(bf16_t*)(ws + WS_EB), DM});
    k_p9<<<256, 512, LDS_BYTES, stream>>>(a);
}
```

```cpp
#include <hip/hip_runtime.h>
#include <hip/hip_cooperative_groups.h>
#include <cstdio>
#include <cstdint>
namespace cg = cooperative_groups;

#define LAS __attribute__((address_space(3)))
typedef unsigned short bf16_t;
typedef short bf16x8 __attribute__((ext_vector_type(8)));
typedef float f32x4 __attribute__((ext_vector_type(4)));
typedef float f32x2 __attribute__((ext_vector_type(2)));
typedef unsigned u32x4 __attribute__((ext_vector_type(4)));
typedef unsigned u32x2 __attribute__((ext_vector_type(2)));

constexpr int DM = 1024, SEQ = 2048, NB = 8, MP = NB * SEQ, MS = 128, MA = MP + 256, NTILE = MA / 256;
constexpr int NIN = 6144, WA = 1024, WB = 1024, HA = 8, DHA = 128, HB = 4, DHB = 256, DPLE = 256, DMIX = 2048;
constexpr int LC = 256, NCH = SEQ / LC;
constexpr int NUNIT = NB * HB * NCH;
constexpr float EPS = 1e-6f;

constexpr size_t O_Y = 0, O_YS = 16777216, O_CP = 16908288, O_NP = 19005440, O_MP = 19013632, O_CVP = 19013664, O_CS = 19038240, O_NS = 52592672, O_MS = 52723744, O_CVS = 52724256, O_VS = 53117472, O_END = 53248544;

constexpr size_t MiB = 1u << 20;
constexpr size_t WS_CTL = 0, WS_WIN = 1 * MiB, WS_WQ = 13 * MiB, WS_WK = WS_WQ + MiB / 2, WS_WV = 14 * MiB, WS_WOUT = WS_WV + MiB / 2, WS_WPG = WS_WOUT + 4 * MiB, WS_WPP = WS_WPG + 2 * MiB,
    WS_WSP = 21 * MiB, WS_WG = WS_WSP + MiB / 4, WS_RS = WS_WG + MiB / 4, WS_GLI = 22 * MiB, WS_GLF = WS_GLI + MiB / 2, WS_DA = 23 * MiB, WS_DR = WS_DA + MiB / 2, WS_DG = 24 * MiB, WS_DEM = WS_DG + MiB / 2,
    WS_DW = 25 * MiB, WS_QN = WS_DW + MiB / 2, WS_DENP = 26 * MiB, WS_DN = 27 * MiB, WS_VS = WS_DN + MiB / 2, WS_PB = 28 * MiB, WS_XB = 37 * MiB, WS_PROJA = 70 * MiB, WS_PROJB = 168 * MiB,
    WS_PQ = 266 * MiB, WS_VC = 330 * MiB, WS_Y = 394 * MiB, WS_END = 460 * MiB;
constexpr size_t WS_Q = WS_PROJA, WS_K = WS_Q + 33 * MiB, WS_WKT = WS_K + 33 * MiB;
constexpr size_t WS_X1B = WS_PROJA, WS_GB = WS_X1B + 33 * MiB, WS_EB = WS_GB + 33 * MiB;
static_assert(WS_WKT + 32 * MiB <= WS_PROJB && WS_EB + 33 * MiB <= WS_PQ, "ws map");

__device__ __forceinline__ unsigned cvt_pk_bf16(float lo, float hi) { unsigned r; asm volatile("v_cvt_pk_bf16_f32 %0, %1, %2" : "=v"(r) : "v"(lo), "v"(hi)); return r; }
__device__ __forceinline__ float bf_lo(unsigned w) { return __uint_as_float(w << 16); }
__device__ __forceinline__ float bf_hi(unsigned w) { return __uint_as_float(w & 0xffff0000u); }
__device__ __forceinline__ float bf2f(bf16_t b) { return __uint_as_float(((unsigned)b) << 16); }
__device__ __forceinline__ bf16_t f2bf(float f) { return (bf16_t)(cvt_pk_bf16(f, 0.f) & 0xffffu); }
__device__ __forceinline__ float fast_exp(float x) { return __builtin_amdgcn_exp2f(x * 1.4426950408889634f); }
__device__ __forceinline__ float sigmoidf_(float x) { return __builtin_amdgcn_rcpf(1.0f + fast_exp(-x)); }
__device__ __forceinline__ float siluf_(float x) { return x * sigmoidf_(x); }
__device__ __forceinline__ f32x2 gelu_pk(f32x2 v) {
    const f32x2 av = __builtin_elementwise_abs(v), d = av * 0.2316418882f + 1.0f;
    f32x2 t; t.x = __builtin_amdgcn_rcpf(d.x); t.y = __builtin_amdgcn_rcpf(d.y);
    f32x2 q = t * 0.5307027145f + (-0.7265760135f); q = q * t + 0.7107068705f; q = q * t + (-0.142248368f); q = q * t + 0.127414796f; q = q * t;
    const f32x2 s = (v * v) * (-0.72134752044f);
    f32x2 e; e.x = __builtin_amdgcn_exp2f(s.x); e.y = __builtin_amdgcn_exp2f(s.y);
    const f32x2 m = v * (q * e), r = v - m;
    f32x2 o; o.x = v.x < 0.f ? m.x : r.x; o.y = v.y < 0.f ? m.y : r.y; return o;
}
__device__ __forceinline__ float wave_sum(float v) {
#pragma unroll
    for (int o = 1; o < 64; o <<= 1) v += __shfl_xor(v, o);
    return v;
}
#define LDS_WAIT() asm volatile("s_waitcnt lgkmcnt(0)" ::: "memory")

namespace pg8 {
constexpr int BM = 256, BK = 64, HALF = 128, HTB = HALF * BK * 2, STAGE_BYTES = 8 * HTB;
__host__ __device__ __forceinline__ int lds_byte(int r, int c) { const int st = (r >> 4) * 2 + (c >> 5), rr = r & 15, cc = c & 31, ob = rr * 64 + cc * 2; return st * 1024 + (ob ^ (((ob >> 9) & 1) << 5)); }
__host__ __device__ __forceinline__ void stage_rc(int b, int& R, int& C) { const int st = b / 1024, sb = b % 1024, swz = sb ^ (((sb >> 9) & 1) << 5); R = (st >> 1) * 16 + swz / 64; C = (st & 1) * 32 + (swz % 64) / 2; }
__host__ __device__ __forceinline__ int perm32(int rho) { const int n = rho >> 4, i = rho & 15; return 8 * (i >> 2) + 4 * n + (i & 3); }

struct Unit { const char* a; const char* b; int pm, pn, aux; };
struct Gemm { int lda, ldb, K; };

template <class Epi, class Sched, bool ALIGN_EPI = true, bool SP2 = true>
__device__ __forceinline__ void gemm_phase(LAS unsigned char* lds, const Gemm g, const Sched& S, const Epi& E) {
    int tid_ = threadIdx.x; asm volatile("" : "+v"(tid_));
    const int tid = tid_, wid = __builtin_amdgcn_readfirstlane(tid >> 6), lane = tid & 63, wr = wid >> 2, wc = wid & 3, fr = lane & 15, fq = lane >> 4;
    int K_ = g.K; asm volatile("" : "+s"(K_)); const int K = K_, nt = K / BK; (void)K;
    unsigned voffA[2], voffB[2];
#pragma unroll
    for (int i = 0; i < 2; ++i) { int R, C; stage_rc(tid * 16 + i * 8192, R, C); const int Rb = Epi::PERM ? ((R & ~31) + perm32(R & 31)) : R;
        voffA[i] = (unsigned)(R * g.lda + C) * 2u; voffB[i] = (unsigned)(Rb * g.ldb + C) * 2u; }
    const size_t kstep = (size_t)(BK * 2);
    const size_t hstepA = (size_t)HALF * g.lda * 2, hstepB = (size_t)HALF * g.ldb * 2;
    const unsigned ldsw = (unsigned)wid * 1024u;
    const int aoff = lds_byte(wr * 64 + fr, fq * 8), boff = lds_byte(wc * 32 + fr, fq * 8);
#define PG8_SA(b, h) (((b) * 2 + (h)) * HTB)
#define PG8_SB(b, h) ((4 + (b) * 2 + (h)) * HTB)
#define PG8_STAGE(bufoff, gbase, voff) do { _Pragma("unroll") for (int _i = 0; _i < 2; ++_i) \
        __builtin_amdgcn_global_load_lds((const unsigned*)((const char*)(gbase) + (voff)[_i]), (LAS unsigned*)(lds + (bufoff) + ldsw + _i * 8192), 16, 0, 0); } while (0)
#define PG8_LDA(dst, b, h) do { _Pragma("unroll") for (int m = 0; m < 4; ++m) _Pragma("unroll") for (int k = 0; k < 2; ++k) dst[m][k] = *(const LAS bf16x8*)(lds + PG8_SA(b, h) + aoff + m * 2048 + k * 1024); } while (0)
#define PG8_LDB(dst, b, h) do { _Pragma("unroll") for (int n = 0; n < 2; ++n) _Pragma("unroll") for (int k = 0; k < 2; ++k) dst[n][k] = *(const LAS bf16x8*)(lds + PG8_SB(b, h) + boff + n * 2048 + k * 1024); } while (0)
#define PG8_MMA(ai, bj, At, Bt) do { __builtin_amdgcn_s_setprio(1); _Pragma("unroll") for (int m = 0; m < 4; ++m) _Pragma("unroll") for (int n = 0; n < 2; ++n) _Pragma("unroll") for (int k = 0; k < 2; ++k) \
        acc[ai][bj][m][n] = __builtin_amdgcn_mfma_f32_16x16x32_bf16(Bt[n][k], At[m][k], acc[ai][bj][m][n], 0, 0, 0); __builtin_amdgcn_s_setprio(0); } while (0)
#define PG8_WAIT_V(n) asm volatile("s_waitcnt vmcnt(" #n ")" ::: "memory")
#define PG8_WAIT_L(n) asm volatile("s_waitcnt lgkmcnt(" #n ")" ::: "memory")
#define PG8_BAR __builtin_amdgcn_s_barrier()
#define PG8_SCHED __builtin_amdgcn_sched_barrier(0)
    Unit cur, nxt; int ui = 0;
    if (!S.next(0, cur)) return;
    f32x4 acc[2][2][4][2];
#pragma unroll
    for (int a = 0; a < 2; ++a)
#pragma unroll
        for (int b = 0; b < 2; ++b)
#pragma unroll
            for (int m = 0; m < 4; ++m)
#pragma unroll
                for (int n = 0; n < 2; ++n) acc[a][b][m][n] = (f32x4){0.f, 0.f, 0.f, 0.f};
    bf16x8 At[4][2], B0[2][2], B1[2][2];
    const char* cA = cur.a; const char* cB = cur.b;
    if constexpr (SP2) {
        PG8_STAGE(PG8_SB(0, 0), cB, voffB); PG8_STAGE(PG8_SB(0, 1), cB + hstepB, voffB); PG8_STAGE(PG8_SA(0, 0), cA, voffA); PG8_STAGE(PG8_SA(0, 1), cA + hstepA, voffA);
        if (wr == 1) PG8_BAR;
        PG8_WAIT_V(2); PG8_BAR;
        PG8_STAGE(PG8_SB(1, 0), cB + kstep, voffB); PG8_STAGE(PG8_SA(1, 0), cA + kstep, voffA); PG8_STAGE(PG8_SB(1, 1), cB + hstepB + kstep, voffB);
        PG8_WAIT_V(6); PG8_BAR;
    } else {
        PG8_STAGE(PG8_SB(0, 0), cB, voffB); PG8_STAGE(PG8_SA(0, 0), cA, voffA); PG8_STAGE(PG8_SB(0, 1), cB + hstepB, voffB); PG8_STAGE(PG8_SA(0, 1), cA + hstepA, voffA);
        if (wr == 1) PG8_BAR;
        PG8_WAIT_V(4); PG8_BAR;
        PG8_STAGE(PG8_SB(1, 0), cB + kstep, voffB); PG8_STAGE(PG8_SA(1, 0), cA + kstep, voffA); PG8_STAGE(PG8_SB(1, 1), cB + hstepB + kstep, voffB);
        PG8_WAIT_V(6); PG8_BAR;
    }
    for (;;) {
        const bool has_next = S.next(ui + 1, nxt);
        const char* nA = has_next ? nxt.a : cA; const char* nB = has_next ? nxt.b : cB;
#pragma unroll 1
        for (int t = 0; t < nt; t += 2) {
            const bool last = (t == nt - 2);
            const char* a1 = cA + (size_t)(t + 1) * kstep;
            const char* a2 = last ? nA : cA + (size_t)(t + 2) * kstep; const char* b2 = last ? nB : cB + (size_t)(t + 2) * kstep;
            const char* a3 = a2 + kstep; const char* b3 = b2 + kstep;
            if constexpr (SP2) {
            PG8_LDB(B0, 0, 0); PG8_LDB(B1, 0, 1); PG8_SCHED; PG8_LDA(At, 0, 0); PG8_STAGE(PG8_SA(1, 1), a1 + hstepA, voffA);
            PG8_WAIT_V(8); PG8_WAIT_L(0); PG8_BAR; PG8_MMA(0, 0, At, B0); PG8_MMA(0, 1, At, B1); PG8_BAR; PG8_SCHED;
            PG8_LDA(At, 0, 1); PG8_STAGE(PG8_SB(0, 0), b2, voffB); PG8_STAGE(PG8_SB(0, 1), b2 + hstepB, voffB); PG8_STAGE(PG8_SA(0, 0), a2, voffA);
            PG8_WAIT_V(8); PG8_WAIT_L(0); PG8_BAR; PG8_MMA(1, 0, At, B0); PG8_MMA(1, 1, At, B1); PG8_BAR; PG8_SCHED;
            PG8_LDB(B0, 1, 0); PG8_LDB(B1, 1, 1); PG8_SCHED; PG8_LDA(At, 1, 0); PG8_STAGE(PG8_SA(0, 1), a2 + hstepA, voffA);
            PG8_WAIT_V(8); PG8_WAIT_L(0); PG8_BAR; PG8_MMA(0, 0, At, B0); PG8_MMA(0, 1, At, B1); PG8_BAR; PG8_SCHED;
            PG8_LDA(At, 1, 1); PG8_STAGE(PG8_SB(1, 0), b3, voffB); PG8_STAGE(PG8_SB(1, 1), b3 + hstepB, voffB); PG8_STAGE(PG8_SA(1, 0), a3, voffA);
            PG8_WAIT_V(8); PG8_WAIT_L(0); PG8_BAR; PG8_MMA(1, 0, At, B0); PG8_MMA(1, 1, At, B1); PG8_BAR; PG8_SCHED;
            } else {
            PG8_LDB(B0, 0, 0); PG8_SCHED; PG8_LDA(At, 0, 0); PG8_STAGE(PG8_SA(1, 1), a1 + hstepA, voffA);
            PG8_WAIT_L(8); PG8_BAR; PG8_WAIT_L(0); PG8_MMA(0, 0, At, B0); PG8_BAR; PG8_SCHED;
            PG8_LDB(B1, 0, 1); PG8_STAGE(PG8_SB(0, 0), b2, voffB);
            PG8_BAR; PG8_WAIT_L(0); PG8_MMA(0, 1, At, B1); PG8_BAR;
            PG8_LDA(At, 0, 1); PG8_STAGE(PG8_SA(0, 0), a2, voffA);
            PG8_BAR; PG8_WAIT_L(0); PG8_MMA(1, 0, At, B0); PG8_BAR; PG8_SCHED;
            PG8_STAGE(PG8_SB(0, 1), b2 + hstepB, voffB);
            PG8_WAIT_V(6); PG8_BAR; PG8_MMA(1, 1, At, B1); PG8_BAR;
            PG8_LDB(B0, 1, 0); PG8_SCHED; PG8_LDA(At, 1, 0); PG8_STAGE(PG8_SA(0, 1), a2 + hstepA, voffA);
            PG8_WAIT_L(8); PG8_BAR; PG8_WAIT_L(0); PG8_MMA(0, 0, At, B0); PG8_BAR; PG8_SCHED;
            PG8_LDB(B1, 1, 1); PG8_STAGE(PG8_SB(1, 0), b3, voffB);
            PG8_BAR; PG8_WAIT_L(0); PG8_MMA(0, 1, At, B1); PG8_BAR;
            PG8_LDA(At, 1, 1); PG8_STAGE(PG8_SA(1, 0), a3, voffA);
            PG8_BAR; PG8_WAIT_L(0); PG8_MMA(1, 0, At, B0); PG8_BAR; PG8_SCHED;
            PG8_STAGE(PG8_SB(1, 1), b3 + hstepB, voffB);
            PG8_WAIT_V(6); PG8_BAR; PG8_MMA(1, 1, At, B1); PG8_BAR;
            }
        }
        if constexpr (ALIGN_EPI) { if (wr == 0) PG8_BAR; }
        if constexpr (!Epi::AFTER_DRAIN) { E(acc, cur, wr, wc, fr, fq); }
        if (!has_next) break;
#pragma unroll
        for (int a = 0; a < 2; ++a)
#pragma unroll
            for (int b = 0; b < 2; ++b)
#pragma unroll
                for (int m = 0; m < 4; ++m)
#pragma unroll
                    for (int n = 0; n < 2; ++n) acc[a][b][m][n] = (f32x4){0.f, 0.f, 0.f, 0.f};
        cur = nxt; cA = nA; cB = nB; ++ui;
        if constexpr (ALIGN_EPI) { if (wr == 1) PG8_BAR; }
    }
    PG8_WAIT_V(0);
    if constexpr (!ALIGN_EPI) { if (wr == 0) PG8_BAR; }
    PG8_BAR;
    if constexpr (Epi::AFTER_DRAIN) { E.fused(acc, cur, wr, wc, fr, fq, lds, wid, lane); }
#undef PG8_SA
#undef PG8_SB
#undef PG8_STAGE
#undef PG8_LDA
#undef PG8_LDB
#undef PG8_MMA
#undef PG8_WAIT_V
#undef PG8_WAIT_L
#undef PG8_BAR
#undef PG8_SCHED
}
}
using pg8::Unit; using pg8::Gemm;

constexpr int LDS_BYTES = 147456;
struct Args { const float* in[29]; float* out; unsigned char* ws; };

struct Ctx {
    LAS unsigned char* lds; int tid, lane, wave, G, bid, gw, NGW;
    const float* const* in; float* out; unsigned char* ws;
};

__device__ __forceinline__ void p0_transpose_item(const float* W, int ldw, bf16_t* WT, int ldt, const float* kscale, LAS float* scr, int kb, int nb, int lane) {
    const int k0 = 64 * kb, n0 = 32 * nb;
#pragma unroll 8
    for (int i = 0; i < 32; ++i) { const int kk = 2 * i + (lane >> 5); float v = W[(size_t)(k0 + kk) * ldw + n0 + (lane & 31)]; if (kscale) v *= kscale[k0 + kk]; scr[kk * 33 + (lane & 31)] = v; }
    LDS_WAIT(); asm volatile("" ::: "memory");
    const int c = lane & 7;
#pragma unroll
    for (int j = 0; j < 4; ++j) { const int n = (lane >> 3) + 8 * j; const LAS float* s = scr + (8 * c) * 33 + n;
        u32x4 o; o.x = cvt_pk_bf16(s[0 * 33], s[1 * 33]); o.y = cvt_pk_bf16(s[2 * 33], s[3 * 33]); o.z = cvt_pk_bf16(s[4 * 33], s[5 * 33]); o.w = cvt_pk_bf16(s[6 * 33], s[7 * 33]);
        *(u32x4*)(WT + (size_t)(n0 + n) * ldt + k0 + 8 * c) = o; }
    LDS_WAIT(); asm volatile("" ::: "memory");
}

__device__ __forceinline__ void p0_prologue(const Ctx& F0) { Ctx F = F0; asm volatile("" : "+v"(F.tid), "+v"(F.lane));
    LAS float* scr = (LAS float*)(F.lds + F.wave * 16384);
    unsigned char* ws = F.ws;
    constexpr int I_WIN = 16 * 192, I_QKV = 12 * 4 * 8, I_WOUT = 32 * 32, I_WPG = 16 * 32, I_WPP = 4 * 32;
    constexpr int I_T = I_WIN + I_QKV + I_WOUT + I_WPG + I_WPP;
    constexpr int I_X = MA, I_P = MA, I_SP = 1024, I_WG = 1024, I_YPAD = 128;
    constexpr int NITEMS = I_T + I_X + I_P + I_SP + I_WG + I_YPAD;
    for (int it = F.gw; it < NITEMS; it += F.NGW) {
        int r = it;
        if (r < I_T) {
            if (r < I_WIN) { p0_transpose_item(F.in[9], NIN, (bf16_t*)(ws + WS_WIN), DM, F.in[8], scr, r / 192, r % 192, F.lane); continue; } r -= I_WIN;
            if (r < I_QKV) { const int mat = r / 32, rr = r % 32, which = mat / 4, h = mat % 4;
                const float* W = F.in[16 + which] + (size_t)h * 65536; bf16_t* WT = (bf16_t*)(ws + (which == 0 ? WS_WQ : which == 1 ? WS_WK : WS_WV)) + (size_t)h * 65536;
                p0_transpose_item(W, 256, WT, 256, nullptr, scr, rr / 8, rr % 8, F.lane); continue; } r -= I_QKV;
            if (r < I_WOUT) { p0_transpose_item(F.in[23], DM, (bf16_t*)(ws + WS_WOUT), DMIX, nullptr, scr, r / 32, r % 32, F.lane); continue; } r -= I_WOUT;
            if (r < I_WPG) { p0_transpose_item(F.in[24], DM, (bf16_t*)(ws + WS_WPG), DM, nullptr, scr, r / 32, r % 32, F.lane); continue; } r -= I_WPG;
            p0_transpose_item(F.in[26], DM, (bf16_t*)(ws + WS_WPP), DPLE, nullptr, scr, r / 32, r % 32, F.lane); continue;
        }
        r -= I_T;
        if (r < I_X) {
            bf16_t* orow = (bf16_t*)(ws + WS_XB) + (size_t)r * DM; float* rs = (float*)(ws + WS_RS);
            unsigned long long* o8 = (unsigned long long*)orow + F.lane;
            if (r >= MP + MS) {
#pragma unroll
                for (int j = 0; j < 4; ++j) o8[64 * j] = 0ull;
                if (F.lane == 0) rs[r] = 0.f; continue; }
            const float* xrow = r < MP ? F.in[0] + (size_t)r * DM : F.in[1] + (size_t)(r - MP) * DM;
            const f32x4* xr = (const f32x4*)xrow + F.lane; f32x4 v[4]; float s = 0.f;
#pragma unroll
            for (int j = 0; j < 4; ++j) { v[j] = xr[64 * j]; s += (v[j].x * v[j].x + v[j].y * v[j].y) + (v[j].z * v[j].z + v[j].w * v[j].w); }
            s = wave_sum(s);
#pragma unroll
            for (int j = 0; j < 4; ++j) o8[64 * j] = (unsigned long long)cvt_pk_bf16(v[j].x, v[j].y) | ((unsigned long long)cvt_pk_bf16(v[j].z, v[j].w) << 32);
            if (F.lane == 0) rs[r] = 1.0f / sqrtf(s * (1.0f / DM) + EPS);
            continue;
        }
        r -= I_X;
        if (r < I_P) {
            unsigned long long* o8 = (unsigned long long*)((bf16_t*)(ws + WS_PB) + (size_t)r * DPLE) + F.lane;
            if (r >= MP + MS) { o8[0] = 0ull; continue; }
            const float* prow = r < MP ? F.in[6] + (size_t)r * DPLE : F.in[7] + (size_t)(r - MP) * DPLE;
            const f32x4 v = ((const f32x4*)prow)[F.lane];
            o8[0] = (unsigned long long)cvt_pk_bf16(v.x, v.y) | ((unsigned long long)cvt_pk_bf16(v.z, v.w) << 32);
            continue;
        }
        r -= I_P;
        if (r < I_SP) {
            const int t = r & 127; const float* wrow = F.in[12] + (size_t)r * 128; const f32x2 v = ((const f32x2*)wrow)[F.lane];
            const int s0 = 2 * F.lane; ((unsigned*)((bf16_t*)(ws + WS_WSP) + (size_t)r * 128))[F.lane] = cvt_pk_bf16(s0 <= t ? v.x : 0.f, s0 + 1 <= t ? v.y : 0.f);
            continue;
        }
        r -= I_SP;
        if (r < I_WG) {
            const int i = r, h = i >> 8, d = i & 255, j = F.lane & 7, isx = (F.lane >> 3) & 1, part = F.lane >> 4;
            const float* wif = F.in[19]; float s = 0.f;
            if (!isx) { const float* wq = F.in[16] + ((size_t)h * 256 + d) * 256; const float* wk = F.in[17] + ((size_t)h * 256 + d) * 256;
                for (int e = part * 64; e < part * 64 + 64; ++e) s += wq[e] * wif[(size_t)(h * 256 + e) * 8 + j] + wk[e] * wif[(size_t)(1024 + h * 256 + e) * 8 + j]; }
            else { const float* wv = F.in[18] + ((size_t)h * 256 + d) * 256;
                for (int e = part * 64; e < part * 64 + 64; ++e) s += wv[e] * wif[(size_t)(2048 + h * 256 + e) * 8 + j]; }
            s += __shfl_xor(s, 16); s += __shfl_xor(s, 32);
            if (F.lane < 16) ((float*)(ws + WS_WG))[(size_t)i * 16 + F.lane] = s;
            continue;
        }
        r -= I_WG;
        {
            u32x4* yrow = (u32x4*)((bf16_t*)(ws + WS_Y) + (size_t)(MP + MS + r) * DMIX) + F.lane;
#pragma unroll
            for (int j = 0; j < 4; ++j) yrow[64 * j] = (u32x4){0u, 0u, 0u, 0u};
        }
    }
}

struct OrderRowMajor {
    int nM, nN, n, G, c; const char* A; const char* B; size_t astep, bstep;
    __device__ __forceinline__ bool next(int i, Unit& u) const {
        const int L = i * G + c; if (L >= n) return false;
        u.pm = L / nN; u.pn = L % nN; u.aux = 0; u.a = A + (size_t)u.pm * astep; u.b = B + (size_t)u.pn * bstep; return true;
    }
};
struct EpiInProj {
    static constexpr bool PERM = true, AFTER_DRAIN = false;
    bf16_t* PA; bf16_t* PB; const float* rs;
    template <int KIND> __device__ __forceinline__ void run(const f32x4 (&acc)[2][2][4][2], bf16_t* base, int row0, int col0) const {
#pragma unroll
        for (int ai = 0; ai < 2; ++ai)
#pragma unroll
            for (int m = 0; m < 4; ++m) { const int row = row0 + ai * 128 + m * 16; const float s = rs[row]; bf16_t* rowp = base + (size_t)row * 3072 + col0;
#pragma unroll
                for (int bj = 0; bj < 2; ++bj) { f32x4 v0 = acc[ai][bj][m][0] * s, v1 = acc[ai][bj][m][1] * s;
                    if (KIND == 0) { f32x2 a = gelu_pk((f32x2){v0[0], v0[1]}), b = gelu_pk((f32x2){v0[2], v0[3]}), c = gelu_pk((f32x2){v1[0], v1[1]}), d = gelu_pk((f32x2){v1[2], v1[3]});
                        v0 = (f32x4){a.x, a.y, b.x, b.y}; v1 = (f32x4){c.x, c.y, d.x, d.y}; }
                    if (KIND == 1) {
#pragma unroll
                        for (int j = 0; j < 4; ++j) { v0[j] = siluf_(v0[j]); v1[j] = siluf_(v1[j]); } }
                    if (KIND == 3) {
#pragma unroll
                        for (int j = 0; j < 4; ++j) { v0[j] = sigmoidf_(v0[j]); v1[j] = sigmoidf_(v1[j]); } }
                    u32x4 w; w.x = cvt_pk_bf16(v0[0], v0[1]); w.y = cvt_pk_bf16(v0[2], v0[3]); w.z = cvt_pk_bf16(v1[0], v1[1]); w.w = cvt_pk_bf16(v1[2], v1[3]);
                    *(u32x4*)(rowp + bj * 128) = w; } }
    }
    __device__ __forceinline__ void operator()(const f32x4 (&acc)[2][2][4][2], const Unit& u, int wr, int wc, int fr, int fq) const {
        const int row0 = u.pm * 256 + wr * 64 + fr, pn = u.pn;
        bf16_t* base = pn < 12 ? PA + pn * 256 : PB + (pn - 12) * 256; const int col0 = wc * 32 + 8 * fq;
        if (pn < 8) run<0>(acc, base, row0, col0);
        else if (pn < 12 || pn >= 20) run<1>(acc, base, row0, col0);
        else if (pn < 16) run<2>(acc, base, row0, col0);
        else run<3>(acc, base, row0, col0);
    }
};

__device__ __forceinline__ float logsigmoidf_(float x) { return fminf(x, 0.f) - log1pf(__expf(-fabsf(x))); }
__device__ __forceinline__ void unpack8(const u32x4 w, float (&f)[8]) { f[0] = bf_lo(w.x); f[1] = bf_hi(w.x); f[2] = bf_lo(w.y); f[3] = bf_hi(w.y); f[4] = bf_lo(w.z); f[5] = bf_hi(w.z); f[6] = bf_lo(w.w); f[7] = bf_hi(w.w); }
__device__ __forceinline__ u32x4 pack8(const float (&f)[8]) { u32x4 w; w.x = cvt_pk_bf16(f[0], f[1]); w.y = cvt_pk_bf16(f[2], f[3]); w.z = cvt_pk_bf16(f[4], f[5]); w.w = cvt_pk_bf16(f[6], f[7]); return w; }

__device__ __forceinline__ void p2a_conv_gates(const Ctx& F0) { Ctx F = F0; asm volatile("" : "+v"(F.tid), "+v"(F.lane));
    unsigned char* ws = F.ws;
    const bf16_t* PBX = (const bf16_t*)(ws + WS_PROJB);
    bf16_t* XC = (bf16_t*)(ws + WS_XB);
    const float* Wg = (const float*)(ws + WS_WG);
    float* GLI = (float*)(ws + WS_GLI); float* GLF = (float*)(ws + WS_GLF);
    const float* convw = F.in[14]; const float* convb = F.in[15]; const float* bif = F.in[20];
    LAS float* red = (LAS float*)F.lds;
    const int cgp = F.tid & 127, rg = F.tid >> 7, ch0 = cgp * 8;
    for (int tile = F.bid; tile < MP / 32; tile += F.G) {
        float cw[4][8], cb[8];
#pragma unroll
        for (int j = 0; j < 4; ++j) { const f32x4 a = *(const f32x4*)(convw + j * 1024 + ch0), b = *(const f32x4*)(convw + j * 1024 + ch0 + 4);
            cw[j][0] = a.x; cw[j][1] = a.y; cw[j][2] = a.z; cw[j][3] = a.w; cw[j][4] = b.x; cw[j][5] = b.y; cw[j][6] = b.z; cw[j][7] = b.w; }
        { const f32x4 a = *(const f32x4*)(convb + ch0), b = *(const f32x4*)(convb + ch0 + 4); cb[0] = a.x; cb[1] = a.y; cb[2] = a.z; cb[3] = a.w; cb[4] = b.x; cb[5] = b.y; cb[6] = b.z; cb[7] = b.w; }
        const int r0 = tile * 32 + rg * 8, seq0 = r0 & ~(SEQ - 1);
        float w0[8], w1[8], w2[8], cur[8];
#pragma unroll
        for (int c = 0; c < 8; ++c) { w0[c] = 0.f; w1[c] = 0.f; w2[c] = 0.f; }
        if (r0 - 3 >= seq0) unpack8(*(const u32x4*)(PBX + (size_t)(r0 - 3) * 3072 + ch0), w0);
        if (r0 - 2 >= seq0) unpack8(*(const u32x4*)(PBX + (size_t)(r0 - 2) * 3072 + ch0), w1);
        if (r0 - 1 >= seq0) unpack8(*(const u32x4*)(PBX + (size_t)(r0 - 1) * 3072 + ch0), w2);
#pragma unroll 1
        for (int i = 0; i < 8; ++i) {
            const int r = r0 + i;
            unpack8(*(const u32x4*)(PBX + (size_t)r * 3072 + ch0), cur);
            float xc[8], gp[8];
#pragma unroll
            for (int c = 0; c < 8; ++c) xc[c] = siluf_(cw[0][c] * w0[c] + cw[1][c] * w1[c] + cw[2][c] * w2[c] + cw[3][c] * cur[c] + cb[c]);
            *(u32x4*)(XC + (size_t)r * DM + ch0) = pack8(xc);
#pragma unroll
            for (int j = 0; j < 8; ++j) gp[j] = 0.f;
#pragma unroll
            for (int c = 0; c < 8; ++c) { const float* wrow = Wg + (size_t)(ch0 + c) * 16;
                const f32x4 a = *(const f32x4*)(wrow), b = *(const f32x4*)(wrow + 4), cc = *(const f32x4*)(wrow + 8), d = *(const f32x4*)(wrow + 12);
                gp[0] += xc[c] * a.x + cur[c] * cc.x; gp[1] += xc[c] * a.y + cur[c] * cc.y; gp[2] += xc[c] * a.z + cur[c] * cc.z; gp[3] += xc[c] * a.w + cur[c] * cc.w;
                gp[4] += xc[c] * b.x + cur[c] * d.x; gp[5] += xc[c] * b.y + cur[c] * d.y; gp[6] += xc[c] * b.z + cur[c] * d.z; gp[7] += xc[c] * b.w + cur[c] * d.w; }
#pragma unroll
            for (int j = 0; j < 8; ++j) gp[j] = wave_sum(gp[j]);
            if (F.lane == 0) {
#pragma unroll
                for (int j = 0; j < 8; ++j) red[((rg * 8 + i) * 2 + (F.wave & 1)) * 8 + j] = gp[j]; }
#pragma unroll
            for (int c = 0; c < 8; ++c) { w0[c] = w1[c]; w1[c] = w2[c]; w2[c] = cur[c]; }
        }
        __syncthreads();
        if (F.tid < 256) { const int rl = F.tid >> 3, j = F.tid & 7, r = tile * 32 + rl;
            const float g = red[(rl * 2 + 0) * 8 + j] + red[(rl * 2 + 1) * 8 + j] + bif[j];
            if (j < 4) GLI[(size_t)j * MA + r] = g; else GLF[(size_t)(j - 4) * MA + r] = logsigmoidf_(g); }
        __syncthreads();
    }
    for (int i = F.bid * 512 + F.tid; i < NB * 3 * 1024; i += F.G * 512) { const int b = i / 3072, j = (i / 1024) % 3, ch = i & 1023;
        F.out[O_CVP + i] = bf2f(PBX[(size_t)(b * SEQ + SEQ - 3 + j) * 3072 + ch]); }
    for (int i = F.gw; i < MS; i += F.NGW) {
        const int r = MP + i, ch0s = F.lane * 16; const float* st = F.in[5] + (size_t)i * 3 * 1024;
        const bf16_t* PA = (const bf16_t*)(ws + WS_PROJA) + (size_t)r * 3072;
        float gp[8];
#pragma unroll
        for (int j = 0; j < 8; ++j) gp[j] = 0.f;
#pragma unroll
        for (int half = 0; half < 2; ++half) { const int c0 = ch0s + half * 8; float xb[8], xc[8];
            unpack8(*(const u32x4*)(PBX + (size_t)r * 3072 + c0), xb);
#pragma unroll
            for (int c = 0; c < 8; ++c) { const int ch = c0 + c; const float s0 = st[ch], s1 = st[1024 + ch], s2 = st[2048 + ch];
                xc[c] = siluf_(convw[ch] * s0 + convw[1024 + ch] * s1 + convw[2048 + ch] * s2 + convw[3072 + ch] * xb[c] + convb[ch]);
                F.out[O_CVS + (size_t)i * 3072 + ch] = s1; F.out[O_CVS + (size_t)i * 3072 + 1024 + ch] = s2; F.out[O_CVS + (size_t)i * 3072 + 2048 + ch] = xb[c];
                const float* wrow = Wg + (size_t)ch * 16;
#pragma unroll
                for (int j = 0; j < 8; ++j) gp[j] += xc[c] * wrow[j] + xb[c] * wrow[8 + j]; }
            *(u32x4*)(XC + (size_t)r * DM + c0) = pack8(xc); }
#pragma unroll
        for (int j = 0; j < 8; ++j) gp[j] = wave_sum(gp[j]);
        if (F.lane < 8) { float g = 0.f;
#pragma unroll
            for (int j = 0; j < 8; ++j) g = (F.lane == j) ? gp[j] : g;
            g += bif[F.lane];
            if (F.lane < 4) GLI[(size_t)F.lane * MA + r] = g; else GLF[(size_t)(F.lane - 4) * MA + r] = logsigmoidf_(g); }
        float gv[16], s = 0.f;
        { float t8[8]; unpack8(*(const u32x4*)(PA + 1024 + ch0s), t8);
#pragma unroll
          for (int c = 0; c < 8; ++c) gv[c] = t8[c];
          unpack8(*(const u32x4*)(PA + 1024 + ch0s + 8), t8);
#pragma unroll
          for (int c = 0; c < 8; ++c) gv[8 + c] = t8[c]; }
#pragma unroll
        for (int c = 0; c < 16; ++c) s += gv[c];
        s += __shfl_xor(s, 1); s += __shfl_xor(s, 2); s += __shfl_xor(s, 4);
        const float mu = s * (1.f / 128.f); float q = 0.f;
#pragma unroll
        for (int c = 0; c < 16; ++c) { const float d = gv[c] - mu; q += d * d; }
        q += __shfl_xor(q, 1); q += __shfl_xor(q, 2); q += __shfl_xor(q, 4);
        const float rstd = 1.0f / sqrtf(q * (1.f / 128.f) + EPS);
        const int h = F.lane >> 3; const float wsp = F.in[12][(size_t)h * 16384], bsp = F.in[13][h * 128];
        float uu[16], zz[16];
        { float t8[8]; unpack8(*(const u32x4*)(PA + ch0s), t8);
#pragma unroll
          for (int c = 0; c < 8; ++c) uu[c] = t8[c];
          unpack8(*(const u32x4*)(PA + ch0s + 8), t8);
#pragma unroll
          for (int c = 0; c < 8; ++c) uu[8 + c] = t8[c];
          unpack8(*(const u32x4*)(PA + 2048 + ch0s), t8);
#pragma unroll
          for (int c = 0; c < 8; ++c) zz[c] = t8[c];
          unpack8(*(const u32x4*)(PA + 2048 + ch0s + 8), t8);
#pragma unroll
          for (int c = 0; c < 8; ++c) zz[8 + c] = t8[c]; }
        float ya[16];
#pragma unroll
        for (int c = 0; c < 16; ++c) { const int ch = ch0s + c; const float vn = (gv[c] - mu) * rstd * F.in[10][ch] + F.in[11][ch];
            F.out[O_VS + (size_t)i * 1024 + ch] = vn; ya[c] = uu[c] * (wsp * vn + bsp) * zz[c]; }
        bf16_t* yrow = (bf16_t*)(ws + WS_Y) + (size_t)r * DMIX + ch0s;
        { float t8[8];
#pragma unroll
          for (int c = 0; c < 8; ++c) t8[c] = ya[c];
          *(u32x4*)(yrow) = pack8(t8);
#pragma unroll
          for (int c = 0; c < 8; ++c) t8[c] = ya[8 + c];
          *(u32x4*)(yrow + 8) = pack8(t8); }
    }
}

__device__ __forceinline__ void mscan_wave(const Ctx& F, int bh) {
    unsigned char* ws = F.ws; const int b = bh >> 2, h = bh & 3, lane = F.lane;
    const float* li = (const float*)(ws + WS_GLI) + (size_t)h * MA + (size_t)b * SEQ + lane * 32;
    const float* lf = (const float*)(ws + WS_GLF) + (size_t)h * MA + (size_t)b * SEQ + lane * 32;
    float A = 0.f, Bv = -INFINITY;
    for (int i = 0; i < 32; ++i) { const float f = lf[i], l = li[i]; Bv = fmaxf(Bv + f, l); A += f; }
    float sA = A, sB = Bv;
#pragma unroll
    for (int o = 1; o < 64; o <<= 1) { const float pA = __shfl_up(sA, o), pB = __shfl_up(sB, o); if (lane >= o) { sB = fmaxf(pB + sA, sB); sA = pA + sA; } }
    float eA = __shfl_up(sA, 1), eB = __shfl_up(sB, 1); if (lane == 0) { eA = 0.f; eB = -INFINITY; }
    const float m_in = fmaxf(0.f + eA, eB);
    float cA = A;
#pragma unroll
    for (int o = 1; o < 8; o <<= 1) { const float p = __shfl_up(cA, o); if ((lane & 7) >= o) cA += p; }
    const float b_in = cA - A;
    const float m_prev = __shfl(m_in, lane & ~7);
    float* DA = (float*)(ws + WS_DA) + (size_t)h * MA + (size_t)b * SEQ + lane * 32; float* DR = (float*)(ws + WS_DR) + (size_t)h * MA + (size_t)b * SEQ + lane * 32;
    float* DG = (float*)(ws + WS_DG) + (size_t)h * MA + (size_t)b * SEQ + lane * 32; float* DEM = (float*)(ws + WS_DEM) + (size_t)h * MA + (size_t)b * SEQ + lane * 32;
    float* DW = (float*)(ws + WS_DW) + (size_t)h * MA + (size_t)b * SEQ + lane * 32;
    float m = m_in, bb = b_in, a_last = 0.f;
    for (int i = 0; i < 32; ++i) { const float f = lf[i], l = li[i]; m = fmaxf(m + f, l); bb += f;
        a_last = bb - m; DA[i] = a_last; DR[i] = l - bb; DG[i] = __expf(bb + m_prev - m); DEM[i] = __expf(-m); }
    const float a_end = __shfl(a_last, lane | 7);
    for (int i = 0; i < 32; ++i) { const float f = lf[i]; (void)f; }
    { float bb2 = b_in; for (int i = 0; i < 32; ++i) { bb2 += lf[i]; DW[i] = __expf(a_end + (li[i] - bb2)); } }
    if (lane == 63) F.out[O_MP + bh] = m;
}

__device__ __forceinline__ void p9_final(const Ctx& F0) { Ctx F = F0; asm volatile("" : "+v"(F.tid), "+v"(F.lane));
    unsigned char* ws = F.ws; const bf16_t* GB = (const bf16_t*)(ws + WS_GB); const bf16_t* EB = (const bf16_t*)(ws + WS_EB);
    const float* pleg = F.in[27]; const float* fing = F.in[28];
    for (int r = F.gw; r < MP + MS; r += F.NGW) {
        float* xrow = r < MP ? F.out + O_Y + (size_t)r * DM : F.out + O_YS + (size_t)(r - MP) * DM;
        float x1[16], gg[16], ee[16]; const int c0 = F.lane * 16;
#pragma unroll
        for (int j = 0; j < 4; ++j) { const f32x4 v = *(const f32x4*)(xrow + c0 + 4 * j); x1[4 * j] = v.x; x1[4 * j + 1] = v.y; x1[4 * j + 2] = v.z; x1[4 * j + 3] = v.w; }
        { float t8[8]; unpack8(*(const u32x4*)(GB + (size_t)r * DM + c0), t8);
#pragma unroll
          for (int c = 0; c < 8; ++c) gg[c] = t8[c];
          unpack8(*(const u32x4*)(GB + (size_t)r * DM + c0 + 8), t8);
#pragma unroll
          for (int c = 0; c < 8; ++c) gg[8 + c] = t8[c];
          unpack8(*(const u32x4*)(EB + (size_t)r * DM + c0), t8);
#pragma unroll
          for (int c = 0; c < 8; ++c) ee[c] = t8[c];
          unpack8(*(const u32x4*)(EB + (size_t)r * DM + c0 + 8), t8);
#pragma unroll
          for (int c = 0; c < 8; ++c) ee[8 + c] = t8[c]; }
        float s = 0.f;
#pragma unroll
        for (int c = 0; c < 16; ++c) s += ee[c] * ee[c];
        s = wave_sum(s); const float rse = 1.0f / sqrtf(s * (1.f / DM) + EPS);
        float s2 = 0.f;
#pragma unroll
        for (int c = 0; c < 16; ++c) { x1[c] = x1[c] + gg[c] * (ee[c] * rse * pleg[c0 + c]); s2 += x1[c] * x1[c]; }
        s2 = wave_sum(s2); const float rs2 = 1.0f / sqrtf(s2 * (1.f / DM) + EPS);
#pragma unroll
        for (int j = 0; j < 4; ++j) { f32x4 v; v.x = x1[4 * j] * rs2 * fing[c0 + 4 * j]; v.y = x1[4 * j + 1] * rs2 * fing[c0 + 4 * j + 1]; v.z = x1[4 * j + 2] * rs2 * fing[c0 + 4 * j + 2]; v.w = x1[4 * j + 3] * rs2 * fing[c0 + 4 * j + 3];
            *(f32x4*)(xrow + c0 + 4 * j) = v; }
    }
}
#define MAKE_CTX() extern __shared__ __attribute__((aligned(16))) unsigned char lds_raw[]; \
    Ctx F; F.lds = (LAS unsigned char*)lds_raw; F.tid = threadIdx.x; F.lane = F.tid & 63; F.wave = __builtin_amdgcn_readfirstlane(F.tid >> 6); \
    F.G = gridDim.x; F.bid = blockIdx.x; F.gw = F.bid * 8 + F.wave; F.NGW = F.G * 8; F.in = args.in; F.out = args.out; F.ws = args.ws; unsigned char* ws = args.ws; (void)ws

template <int KIND> struct EpiBf16Act {
    static constexpr bool PERM = false, AFTER_DRAIN = false;
    bf16_t* O; int ldo; const float* bias; float scale;
    __device__ __forceinline__ void operator()(const f32x4 (&acc)[2][2][4][2], const Unit& u, int wr, int wc, int fr, int fq) const {
        const int row0 = u.pm * 256 + wr * 64 + fr, col0 = u.pn * 256 + wc * 32 + 4 * fq;
        f32x4 bv[2][2];
#pragma unroll
        for (int bj = 0; bj < 2; ++bj)
#pragma unroll
            for (int n = 0; n < 2; ++n) bv[bj][n] = bias ? *(const f32x4*)(bias + col0 + bj * 128 + 16 * n) : (f32x4){0.f, 0.f, 0.f, 0.f};
#pragma unroll
        for (int ai = 0; ai < 2; ++ai)
#pragma unroll
            for (int m = 0; m < 4; ++m) { bf16_t* rowp = O + (size_t)(row0 + ai * 128 + m * 16) * ldo + col0;
#pragma unroll
                for (int bj = 0; bj < 2; ++bj)
#pragma unroll
                    for (int n = 0; n < 2; ++n) { f32x4 v = acc[ai][bj][m][n] * scale + bv[bj][n];
                        if (KIND == 3) {
#pragma unroll
                            for (int j = 0; j < 4; ++j) v[j] = sigmoidf_(v[j]); }
                        u32x2 w; w.x = cvt_pk_bf16(v[0], v[1]); w.y = cvt_pk_bf16(v[2], v[3]); *(u32x2*)(rowp + bj * 128 + n * 16) = w; } }
    }
};
struct EpiOutProj {
    static constexpr bool PERM = false, AFTER_DRAIN = false;
    const float* xp; const float* xs; float* out; bf16_t* X1B;
    __device__ __forceinline__ void operator()(const f32x4 (&acc)[2][2][4][2], const Unit& u, int wr, int wc, int fr, int fq) const {
        const int row0 = u.pm * 256 + wr * 64 + fr, col0 = u.pn * 256 + wc * 32 + 4 * fq;
#pragma unroll
        for (int ai = 0; ai < 2; ++ai)
#pragma unroll
            for (int m = 0; m < 4; ++m) { const int row = row0 + ai * 128 + m * 16;
                const bool real = row < MP + MS;
                const float* xr = row < MP ? xp + (size_t)row * DM : xs + (size_t)(real ? row - MP : 0) * DM;
                float* orow = row < MP ? out + O_Y + (size_t)row * DM : out + O_YS + (size_t)(real ? row - MP : 0) * DM;
#pragma unroll
                for (int bj = 0; bj < 2; ++bj)
#pragma unroll
                    for (int n = 0; n < 2; ++n) { const int c = col0 + bj * 128 + n * 16; f32x4 v = acc[ai][bj][m][n];
                        if (real) { v = v + *(const f32x4*)(xr + c); *(f32x4*)(orow + c) = v; } else v = (f32x4){0.f, 0.f, 0.f, 0.f};
                        u32x2 w; w.x = cvt_pk_bf16(v[0], v[1]); w.y = cvt_pk_bf16(v[2], v[3]); *(u32x2*)(X1B + (size_t)row * DM + c) = w; } }
    }
};


struct EpiInProjNP {
    static constexpr bool PERM = false, AFTER_DRAIN = false;
    bf16_t* PA; bf16_t* PB; const float* rs;
    __device__ __forceinline__ void operator()(const f32x4 (&acc)[2][2][4][2], const Unit& u, int wr, int wc, int fr, int fq) const {
        const int row0 = u.pm * 256 + wr * 64 + fr, pn = u.pn; bf16_t* base = pn < 12 ? PA + pn * 256 : PB + (pn - 12) * 256; const int col0 = wc * 32 + 4 * fq;
        const int kind = pn < 8 ? 0 : ((pn < 12 || pn >= 20) ? 1 : (pn < 16 ? 2 : 3));
#pragma unroll
        for (int ai = 0; ai < 2; ++ai)
#pragma unroll
            for (int m = 0; m < 4; ++m) { const int row = row0 + ai * 128 + m * 16; const float s = rs[row];
#pragma unroll
                for (int bj = 0; bj < 2; ++bj)
#pragma unroll
                    for (int n = 0; n < 2; ++n) { f32x4 v = acc[ai][bj][m][n] * s;
#pragma unroll
                        for (int j = 0; j < 4; ++j) { float x = v[j]; if (kind == 0) { f32x2 g2 = gelu_pk((f32x2){x, x}); x = g2.x; } else if (kind == 1) x = siluf_(x); else if (kind == 3) x = sigmoidf_(x); v[j] = x; }
                        u32x2 w; w.x = cvt_pk_bf16(v[0], v[1]); w.y = cvt_pk_bf16(v[2], v[3]); *(u32x2*)(base + (size_t)row * 3072 + col0 + bj * 128 + n * 16) = w; } }
    }
};
__device__ __forceinline__ void p1_inproj(const Ctx& F) {
    unsigned char* ws = F.ws; Gemm g{DM, DM, DM};
    OrderRowMajor S{NTILE, 24, NTILE * 24, F.G, F.bid, (const char*)(ws + WS_XB), (const char*)(ws + WS_WIN), (size_t)256 * DM * 2, (size_t)256 * DM * 2};
    EpiInProjNP E{(bf16_t*)(ws + WS_PROJA), (bf16_t*)(ws + WS_PROJB), (const float*)(ws + WS_RS)};
    pg8::gemm_phase<EpiInProjNP, OrderRowMajor, false, false>(F.lds, g, S, E);
}
__device__ __forceinline__ void p7_outproj(const Ctx& F) {
    unsigned char* ws = F.ws; Gemm g{DMIX, DMIX, DMIX};
    OrderRowMajor S{NTILE, 4, NTILE * 4, F.G, F.bid, (const char*)(ws + WS_Y), (const char*)(ws + WS_WOUT), (size_t)256 * DMIX * 2, (size_t)256 * DMIX * 2};
    EpiOutProj E{F.in[0], F.in[1], F.out, (bf16_t*)(ws + WS_X1B)};
    pg8::gemm_phase<EpiOutProj, OrderRowMajor>(F.lds, g, S, E);
}
__device__ __forceinline__ void p8_ple(const Ctx& F) {
    unsigned char* ws = F.ws;
    { Gemm g{DM, DM, DM}; OrderRowMajor S{NTILE, 4, NTILE * 4, F.G, F.bid, (const char*)(ws + WS_X1B), (const char*)(ws + WS_WPG), (size_t)256 * DM * 2, (size_t)256 * DM * 2};
      EpiBf16Act<3> E{(bf16_t*)(ws + WS_GB), DM, F.in[25], 1.0f}; pg8::gemm_phase<EpiBf16Act<3>, OrderRowMajor>(F.lds, g, S, E); }
    { Gemm g{DPLE, DPLE, DPLE}; OrderRowMajor S{NTILE, 4, NTILE * 4, F.G, (F.bid + 128) & 255, (const char*)(ws + WS_PB), (const char*)(ws + WS_WPP), (size_t)256 * DPLE * 2, (size_t)256 * DPLE * 2};
      EpiBf16Act<0> E{(bf16_t*)(ws + WS_EB), DM, nullptr, 1.0f}; pg8::gemm_phase<EpiBf16Act<0>, OrderRowMajor>(F.lds, g, S, E); }
}
typedef float f32x4_t __attribute__((ext_vector_type(4)));
__device__ __forceinline__ void p2b_spatial(const Ctx& F0) { Ctx F = F0; asm volatile("" : "+v"(F.tid), "+v"(F.lane));
    unsigned char* ws = F.ws;
    const bf16_t* PA = (const bf16_t*)(ws + WS_PROJA); const bf16_t* WSP = (const bf16_t*)(ws + WS_WSP); bf16_t* Y = (bf16_t*)(ws + WS_Y);
    const float* lng = F.in[10]; const float* lnb = F.in[11]; const float* bsp = F.in[13];
    LAS bf16_t* vnT = (LAS bf16_t*)F.lds;
    const int lane = F.lane, w = F.wave, l15 = lane & 15, lq = lane >> 4;
    for (int unit = F.bid; unit < NB * 16 * HA; unit += F.G) {
        const int b = unit >> 7, c = (unit >> 3) & 15, h = unit & 7, r0 = b * SEQ + c * 128;
        const float g0 = lng[h * 128 + 2 * lane], g1 = lng[h * 128 + 2 * lane + 1], b0 = lnb[h * 128 + 2 * lane], b1 = lnb[h * 128 + 2 * lane + 1];
#pragma unroll 2
        for (int p = 0; p < 8; ++p) { const int s0 = w * 16 + 2 * p;
            const unsigned wa = *(const unsigned*)(PA + (size_t)(r0 + s0) * 3072 + 1024 + h * 128 + 2 * lane), wb = *(const unsigned*)(PA + (size_t)(r0 + s0 + 1) * 3072 + 1024 + h * 128 + 2 * lane);
            float a0 = bf_lo(wa), a1 = bf_hi(wa), c0 = bf_lo(wb), c1 = bf_hi(wb);
            const float mua = wave_sum(a0 + a1) * (1.f / 128.f), mub = wave_sum(c0 + c1) * (1.f / 128.f);
            a0 -= mua; a1 -= mua; c0 -= mub; c1 -= mub;
            const float ra = 1.0f / sqrtf(wave_sum(a0 * a0 + a1 * a1) * (1.f / 128.f) + EPS), rb = 1.0f / sqrtf(wave_sum(c0 * c0 + c1 * c1) * (1.f / 128.f) + EPS);
            *(LAS unsigned*)(vnT + (2 * lane) * 136 + s0) = cvt_pk_bf16(a0 * ra * g0 + b0, c0 * rb * g0 + b0);
            *(LAS unsigned*)(vnT + (2 * lane + 1) * 136 + s0) = cvt_pk_bf16(a1 * ra * g1 + b1, c1 * rb * g1 + b1); }
        __syncthreads();
        const int t0 = 16 * w, nks = (t0 + 15) / 32 + 1;
        f32x4 acc[8];
#pragma unroll
        for (int nb = 0; nb < 8; ++nb) acc[nb] = (f32x4){0.f, 0.f, 0.f, 0.f};
        for (int ks = 0; ks < nks; ++ks) { const int k0 = ks * 32;
            const bf16x8 wf = *(const bf16x8*)(WSP + ((size_t)h * 128 + t0 + l15) * 128 + k0 + 8 * lq);
#pragma unroll
            for (int nb = 0; nb < 8; ++nb) { const bf16x8 vf = *(const LAS bf16x8*)(vnT + (nb * 16 + l15) * 136 + k0 + 8 * lq);
                acc[nb] = __builtin_amdgcn_mfma_f32_16x16x32_bf16(vf, wf, acc[nb], 0, 0, 0); } }
        const int t = t0 + l15; const float bt = bsp[h * 128 + t]; const size_t row = (size_t)(r0 + t);
#pragma unroll
        for (int nb = 0; nb < 8; ++nb) { const int d = nb * 16 + 4 * lq;
            const u32x2 uu = *(const u32x2*)(PA + row * 3072 + h * 128 + d), zz = *(const u32x2*)(PA + row * 3072 + 2048 + h * 128 + d);
            u32x2 o; o.x = cvt_pk_bf16(bf_lo(uu.x) * (acc[nb][0] + bt) * bf_lo(zz.x), bf_hi(uu.x) * (acc[nb][1] + bt) * bf_hi(zz.x));
            o.y = cvt_pk_bf16(bf_lo(uu.y) * (acc[nb][2] + bt) * bf_lo(zz.y), bf_hi(uu.y) * (acc[nb][3] + bt) * bf_hi(zz.y));
            *(u32x2*)(Y + row * DMIX + h * 128 + d) = o; }
        __syncthreads();
    }
    if (F.bid < 32 && F.wave == 0) mscan_wave(F, F.bid);
}

struct OrderHeadRows {
    int n, G, c; const char* A; size_t astep; const char* B; int pm0;
    __device__ __forceinline__ bool next(int i, Unit& u) const { const int L = i * G + c; if (L >= n) return false;
        u.pm = pm0 + (L >> 2); u.pn = 0; u.aux = L & 3; u.a = A + (size_t)u.pm * astep + (size_t)u.aux * 512; u.b = B + (size_t)u.aux * 131072; return true; }
};
struct OrderHeadT {
    int n, G, c; const char* W; const char* X; size_t xstep;
    __device__ __forceinline__ bool next(int i, Unit& u) const { const int L = i * G + c; if (L >= n) return false;
        const int b = L >> 5, h = (L >> 3) & 3, cc = L & 7; u.pm = b * 8 + cc; u.pn = L; u.aux = h; u.a = W + (size_t)h * 131072; u.b = X + (size_t)u.pm * xstep + (size_t)h * 512; return true; }
};
struct EpiQ {
    static constexpr bool PERM = false, AFTER_DRAIN = false;
    bf16_t* Q; bf16_t* PQ; const float* DG;
    __device__ __forceinline__ void operator()(const f32x4 (&acc)[2][2][4][2], const Unit& u, int wr, int wc, int fr, int fq) const {
        const int h = u.aux, rl0 = wr * 64 + fr, col0 = wc * 32 + 4 * fq; const bool prompt = u.pm < 64;
        const int unit = ((u.pm >> 3) * 4 + h) * 8 + (u.pm & 7);
#pragma unroll
        for (int ai = 0; ai < 2; ++ai)
#pragma unroll
            for (int m = 0; m < 4; ++m) { const int rl = rl0 + ai * 128 + m * 16, row = u.pm * 256 + rl;
#pragma unroll
                for (int bj = 0; bj < 2; ++bj)
#pragma unroll
                    for (int n = 0; n < 2; ++n) { const int c = col0 + bj * 128 + n * 16; const f32x4 v = acc[ai][bj][m][n];
                        u32x2 w; w.x = cvt_pk_bf16(v[0], v[1]); w.y = cvt_pk_bf16(v[2], v[3]); *(u32x2*)(Q + (size_t)row * 1024 + h * 256 + c) = w; }
                asm volatile("" ::: "memory"); }
        if (prompt) {
#pragma unroll
        for (int ai = 0; ai < 2; ++ai)
#pragma unroll
            for (int m = 0; m < 4; ++m) { const int rl = rl0 + ai * 128 + m * 16, row = u.pm * 256 + rl; const float g = DG[(size_t)h * MA + row];
#pragma unroll
                for (int bj = 0; bj < 2; ++bj)
#pragma unroll
                    for (int n = 0; n < 2; ++n) { const int c = col0 + bj * 128 + n * 16; const f32x4 v = acc[ai][bj][m][n] * g;
                        u32x2 w2; w2.x = cvt_pk_bf16(v[0], v[1]); w2.y = cvt_pk_bf16(v[2], v[3]); *(u32x2*)(PQ + ((size_t)unit * 256 + rl) * 512 + 256 + c) = w2; }
                asm volatile("" ::: "memory"); } }
    }
};
struct EpiHeadPlain {
    static constexpr bool PERM = false, AFTER_DRAIN = false;
    bf16_t* O; float scale; int row_off;
    __device__ __forceinline__ void operator()(const f32x4 (&acc)[2][2][4][2], const Unit& u, int wr, int wc, int fr, int fq) const {
        const int h = u.aux, row0 = u.pm * 256 - row_off + wr * 64 + fr, col0 = h * 256 + wc * 32 + 4 * fq;
#pragma unroll
        for (int ai = 0; ai < 2; ++ai)
#pragma unroll
            for (int m = 0; m < 4; ++m) { bf16_t* rowp = O + (size_t)(row0 + ai * 128 + m * 16) * 1024 + col0;
#pragma unroll
                for (int bj = 0; bj < 2; ++bj)
#pragma unroll
                    for (int n = 0; n < 2; ++n) { const f32x4 v = acc[ai][bj][m][n] * scale; u32x2 w; w.x = cvt_pk_bf16(v[0], v[1]); w.y = cvt_pk_bf16(v[2], v[3]); *(u32x2*)(rowp + bj * 128 + n * 16) = w; } }
    }
};
struct EpiUnitT {
    static constexpr bool PERM = false, AFTER_DRAIN = false;
    bf16_t* O; int ldo; const float* cs; float scale;
    __device__ __forceinline__ void operator()(const f32x4 (&acc)[2][2][4][2], const Unit& u, int wr, int wc, int fr, int fq) const {
        const int h = u.aux, rl0 = wr * 64 + fr, col0 = wc * 32 + 4 * fq; bf16_t* base = O + (size_t)u.pn * 256 * ldo;
#pragma unroll
        for (int ai = 0; ai < 2; ++ai)
#pragma unroll
            for (int m = 0; m < 4; ++m) { bf16_t* rowp = base + (size_t)(rl0 + ai * 128 + m * 16) * ldo + col0;
#pragma unroll
                for (int bj = 0; bj < 2; ++bj)
#pragma unroll
                    for (int n = 0; n < 2; ++n) { const f32x4 scv = cs ? *(const f32x4*)(cs + (size_t)h * MA + u.pm * 256 + col0 + bj * 128 + n * 16) * scale : (f32x4){scale, scale, scale, scale}; const f32x4 v = acc[ai][bj][m][n] * scv; u32x2 w; w.x = cvt_pk_bf16(v[0], v[1]); w.y = cvt_pk_bf16(v[2], v[3]); *(u32x2*)(rowp + bj * 128 + n * 16) = w; } }
    }
};
__device__ __forceinline__ void p3_qkv(const Ctx& F) {
    unsigned char* ws = F.ws; const char* XC = (const char*)(ws + WS_XB); const char* PBX = (const char*)(ws + WS_PROJB);
    { Gemm g{DM, 256, 256}; OrderHeadRows S{NTILE * 4, F.G, F.bid, XC, (size_t)256 * DM * 2, (const char*)(ws + WS_WQ), 0};
      EpiQ E{(bf16_t*)(ws + WS_Q), (bf16_t*)(ws + WS_PQ), (const float*)(ws + WS_DG)}; pg8::gemm_phase<EpiQ, OrderHeadRows>(F.lds, g, S, E); }
    { Gemm g{DM, 256, 256}; OrderHeadRows S{NTILE * 4, F.G, (F.bid + 4) & 255, XC, (size_t)256 * DM * 2, (const char*)(ws + WS_WK), 0};
      EpiHeadPlain E{(bf16_t*)(ws + WS_K), 0.0625f, 0}; pg8::gemm_phase<EpiHeadPlain, OrderHeadRows>(F.lds, g, S, E); }
    { Gemm g{3072, 256, 256}; OrderHeadRows S{4, F.G, (F.bid + 248) & 255, PBX, (size_t)256 * 3072 * 2, (const char*)(ws + WS_WV), 64};
      EpiHeadPlain E{(bf16_t*)(ws + WS_VS), 1.0f, MP}; pg8::gemm_phase<EpiHeadPlain, OrderHeadRows>(F.lds, g, S, E); }
    { Gemm g{256, 3072, 256}; OrderHeadT S{NUNIT, F.G, F.bid, (const char*)(ws + WS_WV), PBX, (size_t)256 * 3072 * 2};
      EpiUnitT E{(bf16_t*)(ws + WS_VC), 512, nullptr, 1.0f}; pg8::gemm_phase<EpiUnitT, OrderHeadT>(F.lds, g, S, E); }
    { Gemm g{256, DM, 256}; OrderHeadT S{NUNIT, F.G, F.bid, (const char*)(ws + WS_WK), XC, (size_t)256 * DM * 2};
      EpiUnitT E{(bf16_t*)(ws + WS_WKT), 256, (const float*)(ws + WS_DW), 0.0625f}; pg8::gemm_phase<EpiUnitT, OrderHeadT>(F.lds, g, S, E); }
}

struct OrderUnitNT {
    int n, G, c; const char* A; size_t astep_pm, astep_h, astep_u; const char* B; size_t bstep_pm, bstep_h, bstep_u;
    __device__ __forceinline__ bool next(int i, Unit& u) const { const int L = i * G + c; if (L >= n) return false;
        const int b = L >> 5, h = (L >> 3) & 3, cc = L & 7; u.pm = b * 8 + cc; u.pn = L; u.aux = h;
        u.a = A + (size_t)u.pm * astep_pm + (size_t)h * astep_h + (size_t)L * astep_u; u.b = B + (size_t)u.pm * bstep_pm + (size_t)h * bstep_h + (size_t)L * bstep_u; return true; }
};
struct EpiScore {
    static constexpr bool PERM = false, AFTER_DRAIN = false;
    bf16_t* PQ; const float* DA; const float* DR; float* DENP;
    __device__ __forceinline__ void operator()(const f32x4 (&acc)[2][2][4][2], const Unit& u, int wr, int wc, int fr, int fq) const {
        const int h = u.aux, rl0 = wr * 64 + fr, col0 = wc * 32 + 4 * fq; const size_t vb = (size_t)h * MA + (size_t)u.pm * 256;
#pragma unroll
        for (int ai = 0; ai < 2; ++ai)
#pragma unroll
            for (int m = 0; m < 4; ++m) { int t_ = rl0 + ai * 128 + m * 16; asm volatile("" : "+v"(t_)); const int t = t_; const float at = DA[vb + t]; float rs_ = 0.f; bf16_t* rowp = PQ + ((size_t)u.pn * 256 + t) * 512 + col0;
#pragma unroll
                for (int bj = 0; bj < 2; ++bj)
#pragma unroll
                    for (int n = 0; n < 2; ++n) { const int c = col0 + bj * 128 + n * 16; f32x4 v; const f32x4 rr = *(const f32x4*)(DR + vb + c);
#pragma unroll
                        for (int j = 0; j < 4; ++j) { const float e = fast_exp(fminf(at + rr[j], 0.f)); v[j] = (c + j <= t) ? acc[ai][bj][m][n][j] * e : 0.f; rs_ += v[j]; }
                        u32x2 w; w.x = cvt_pk_bf16(v[0], v[1]); w.y = cvt_pk_bf16(v[2], v[3]); *(u32x2*)(rowp + bj * 128 + n * 16) = w; }
                rs_ += __shfl_xor(rs_, 16); rs_ += __shfl_xor(rs_, 32);
                if (fq == 0) DENP[(vb + t) * 4 + wc] = rs_; asm volatile("" ::: "memory"); }
    }
};
struct EpiF32Unit {
    static constexpr bool PERM = false, AFTER_DRAIN = false;
    float* O;
    __device__ __forceinline__ void operator()(const f32x4 (&acc)[2][2][4][2], const Unit& u, int wr, int wc, int fr, int fq) const {
        float* base = O + (size_t)u.pn * 65536 + (size_t)(wr * 64 + fr) * 256 + wc * 32 + 4 * fq;
#pragma unroll
        for (int ai = 0; ai < 2; ++ai)
#pragma unroll
            for (int m = 0; m < 4; ++m)
#pragma unroll
                for (int bj = 0; bj < 2; ++bj)
#pragma unroll
                    for (int n = 0; n < 2; ++n) *(f32x4*)(base + (size_t)(ai * 128 + m * 16) * 256 + bj * 128 + n * 16) = acc[ai][bj][m][n];
    }
};
__device__ __forceinline__ void p4_scores_dc(const Ctx& F) {
    unsigned char* ws = F.ws;
    { Gemm g{DM, DM, 256}; OrderUnitNT S{NUNIT, F.G, F.bid, (const char*)(ws + WS_Q), (size_t)256 * DM * 2, 512, 0, (const char*)(ws + WS_K), (size_t)256 * DM * 2, 512, 0};
      EpiScore E{(bf16_t*)(ws + WS_PQ), (const float*)(ws + WS_DA), (const float*)(ws + WS_DR), (float*)(ws + WS_DENP)}; pg8::gemm_phase<EpiScore, OrderUnitNT>(F.lds, g, S, E); }
    { Gemm g{512, 256, 256}; OrderUnitNT S{NUNIT, F.G, F.bid, (const char*)(ws + WS_VC), 0, 0, (size_t)256 * 512 * 2, (const char*)(ws + WS_WKT), 0, 0, (size_t)256 * 256 * 2};
      EpiF32Unit E{F.out + O_Y}; pg8::gemm_phase<EpiF32Unit, OrderUnitNT>(F.lds, g, S, E); }
    for (int u = F.bid; u < NUNIT; u += F.G) { const int d = F.tid >> 1, hf = F.tid & 1; const bf16_t* src = (const bf16_t*)(ws + WS_WKT) + ((size_t)u * 256 + d) * 256 + hf * 128; float s = 0.f;
#pragma unroll
        for (int j = 0; j < 16; ++j) { float t8[8]; unpack8(*(const u32x4*)(src + j * 8), t8);
#pragma unroll
            for (int e = 0; e < 8; ++e) s += t8[e]; }
        s += __shfl_xor(s, 1); if (hf == 0) ((float*)(ws + WS_DN))[(size_t)u * 256 + d] = s; }
}

__device__ __forceinline__ void p5_scan_sample(const Ctx& F0) { Ctx F = F0; asm volatile("" : "+v"(F.tid), "+v"(F.lane));
    unsigned char* ws = F.ws; const float* DG = (const float*)(ws + WS_DG); const float* DC = F.out + O_Y; bf16_t* VC = (bf16_t*)(ws + WS_VC);
    for (int idx = F.bid * 512 + F.tid; idx < 32 * 16384; idx += F.G * 512) { const int bh = idx >> 14, q4 = idx & 16383, e = q4 >> 6, d4 = (q4 & 63) * 4, b = bh >> 2, h = bh & 3;
        f32x4 dc[8]; float ge[8];
#pragma unroll
        for (int c = 0; c < 8; ++c) { dc[c] = *(const f32x4*)(DC + ((size_t)(bh * 8 + c) * 256 + e) * 256 + d4); ge[c] = DG[(size_t)h * MA + b * SEQ + c * 256 + 255]; }
        f32x4 C = (f32x4){0.f, 0.f, 0.f, 0.f};
#pragma unroll
        for (int c = 0; c < 8; ++c) { u32x2 w; w.x = cvt_pk_bf16(C[0], C[1]); w.y = cvt_pk_bf16(C[2], C[3]); *(u32x2*)(VC + ((size_t)(bh * 8 + c) * 256 + e) * 512 + 256 + d4) = w; C = C * ge[c] + dc[c]; }
        *(f32x4*)(F.out + O_CP + ((size_t)bh * 256 + e) * 256 + d4) = C; }
    LAS float* npv = (LAS float*)F.lds;
    for (int u = F.bid; u < NUNIT; u += F.G) { const int bh = u >> 3, cc = u & 7, b = bh >> 2, h = bh & 3;
        __syncthreads();
        if (F.tid < 256) { float n = 0.f; const float* DN = (const float*)(ws + WS_DN);
            for (int j = 0; j < cc; ++j) n = DG[(size_t)h * MA + b * SEQ + j * 256 + 255] * n + DN[(size_t)(bh * 8 + j) * 256 + F.tid];
            npv[F.tid] = n; if (cc == 7) F.out[O_NP + (size_t)bh * 256 + F.tid] = DG[(size_t)h * MA + b * SEQ + 7 * 256 + 255] * n + DN[(size_t)u * 256 + F.tid]; }
        __syncthreads();
        const f32x4 nv = *(const LAS f32x4*)(npv + 4 * F.lane); const bf16_t* Q = (const bf16_t*)(ws + WS_Q);
        for (int r = 0; r < 32; ++r) { const size_t row = (size_t)b * SEQ + cc * 256 + F.wave * 32 + r; const u32x2 qq = *(const u32x2*)(Q + row * 1024 + h * 256 + 4 * F.lane);
            const float s = wave_sum(bf_lo(qq.x) * nv[0] + bf_hi(qq.x) * nv[1] + bf_lo(qq.y) * nv[2] + bf_hi(qq.y) * nv[3]); if (F.lane == 0) ((float*)(ws + WS_QN))[(size_t)h * MA + row] = s; } }
    LAS float* hs = (LAS float*)F.lds + 512; LAS float* red = (LAS float*)F.lds + 1024;
    for (int job = F.bid; job < MS * HB; job += F.G) { const int i = job >> 2, h = job & 3; const size_t row = MP + i;
        const bf16_t* Q = (const bf16_t*)(ws + WS_Q) + row * 1024 + h * 256; const bf16_t* K = (const bf16_t*)(ws + WS_K) + row * 1024 + h * 256; const bf16_t* V = (const bf16_t*)(ws + WS_VS) + (size_t)i * 1024 + h * 256;
        const u32x2 qw = *(const u32x2*)(Q + 4 * F.lane), kw = *(const u32x2*)(K + 4 * F.lane);
        const f32x4 q4 = (f32x4){bf_lo(qw.x), bf_hi(qw.x), bf_lo(qw.y), bf_hi(qw.y)}, k4 = (f32x4){bf_lo(kw.x), bf_hi(kw.x), bf_lo(kw.y), bf_hi(kw.y)};
        const f32x4 n0 = *(const f32x4*)(F.in[3] + ((size_t)i * 4 + h) * 256 + 4 * F.lane);
        const float li = ((const float*)(ws + WS_GLI))[(size_t)h * MA + row], lf = ((const float*)(ws + WS_GLF))[(size_t)h * MA + row], m0 = F.in[4][i * 4 + h];
        const float mn = fmaxf(lf + m0, li), g = __expf(lf + m0 - mn), wi = __expf(li - mn);
        const float qk = wave_sum(q4[0] * k4[0] + q4[1] * k4[1] + q4[2] * k4[2] + q4[3] * k4[3]), nq = wave_sum(n0[0] * q4[0] + n0[1] * q4[1] + n0[2] * q4[2] + n0[3] * q4[3]);
        const float sc = wi * qk, den = sc + g * nq, dinv = 1.0f / fmaxf(fabsf(den), __expf(-mn));
        const float* C0 = F.in[2] + (((size_t)i * 4 + h) * 256 + F.wave * 32) * 256 + 4 * F.lane; float* C1 = F.out + O_CS + (((size_t)i * 4 + h) * 256 + F.wave * 32) * 256 + 4 * F.lane;
        __syncthreads();
#pragma unroll 1
        for (int r8 = 0; r8 < 32; r8 += 8) { f32x4 c[8]; float ve[8], cq[8];
#pragma unroll
            for (int r = 0; r < 8; ++r) { c[r] = *(const f32x4*)(C0 + (size_t)(r8 + r) * 256); ve[r] = bf2f(V[F.wave * 32 + r8 + r]); }
#pragma unroll
            for (int r = 0; r < 8; ++r) { cq[r] = c[r][0] * q4[0] + c[r][1] * q4[1] + c[r][2] * q4[2] + c[r][3] * q4[3]; const float wv = wi * ve[r]; *(f32x4*)(C1 + (size_t)(r8 + r) * 256) = c[r] * g + k4 * wv; }
#pragma unroll
            for (int r = 0; r < 8; ++r) { cq[r] = wave_sum(cq[r]); if (F.lane == 0) hs[F.wave * 32 + r8 + r] = (sc * ve[r] + g * cq[r]) * dinv; } }
        if (F.wave == 0) { *(f32x4*)(F.out + O_NS + ((size_t)i * 4 + h) * 256 + 4 * F.lane) = n0 * g + k4 * wi; if (F.lane == 0) F.out[O_MS + i * 4 + h] = mn; }
        __syncthreads();
        const bf16_t* PB = (const bf16_t*)(ws + WS_PROJB) + row * 3072; const bf16_t* XC = (const bf16_t*)(ws + WS_XB) + row * DM;
        float x = 0.f; const int ch = h * 256 + (F.tid & 255);
        if (F.tid < 256) x = hs[F.tid] * bf2f(PB[1024 + ch]);
        float p = wave_sum(x); if (F.lane == 0) red[F.wave] = p;
        __syncthreads();
        const float mu = (red[0] + red[1] + red[2] + red[3]) * (1.f / 256.f), dx = x - mu;
        __syncthreads();
        p = wave_sum(F.tid < 256 ? dx * dx : 0.f); if (F.lane == 0) red[F.wave] = p;
        __syncthreads();
        const float rstd = 1.0f / sqrtf((red[0] + red[1] + red[2] + red[3]) * (1.f / 256.f) + EPS);
        if (F.tid < 256) ((bf16_t*)(ws + WS_Y))[row * DMIX + 1024 + ch] = f2bf((dx * rstd * F.in[21][ch] + F.in[22][ch] * bf2f(XC[ch])) * bf2f(PB[2048 + ch]));
        __syncthreads();
    }
}

struct EpiHOut {
    static constexpr bool PERM = false, AFTER_DRAIN = true;
    const float* DENP; const float* DG; const float* QN; const float* DEM; const bf16_t* PB; const bf16_t* XC; bf16_t* Y; const float* gng; const float* skip;
    __device__ __forceinline__ void fused(f32x4 (&acc)[2][2][4][2], const Unit& u, int wr, int wc, int fr, int fq, LAS unsigned char* lds, int wid, int lane) const {
        const int h = u.aux, rl0 = wr * 64 + fr, col0 = wc * 32 + 4 * fq; const size_t vb = (size_t)h * MA + (size_t)u.pm * 256;
        LAS float* P1 = (LAS float*)lds; LAS float* P2 = (LAS float*)lds + 1024;
#pragma unroll
        for (int ai = 0; ai < 2; ++ai)
#pragma unroll
            for (int m = 0; m < 4; ++m) { const int t = rl0 + ai * 128 + m * 16; const size_t row = (size_t)u.pm * 256 + t;
                const f32x4 dp = *(const f32x4*)(DENP + (vb + t) * 4); const float den = (dp[0] + dp[1]) + (dp[2] + dp[3]) + DG[vb + t] * QN[vb + t];
                const float dinv = 1.0f / fmaxf(fabsf(den), DEM[vb + t]); float s = 0.f;
#pragma unroll
                for (int bj = 0; bj < 2; ++bj)
#pragma unroll
                    for (int n = 0; n < 2; ++n) { const int c = col0 + bj * 128 + n * 16; const u32x2 ow = *(const u32x2*)(PB + row * 3072 + 1024 + h * 256 + c);
                        f32x4 v = acc[ai][bj][m][n] * dinv; v[0] *= bf_lo(ow.x); v[1] *= bf_hi(ow.x); v[2] *= bf_lo(ow.y); v[3] *= bf_hi(ow.y); acc[ai][bj][m][n] = v; s += (v[0] + v[1]) + (v[2] + v[3]); }
                s += __shfl_xor(s, 16); s += __shfl_xor(s, 32); if (fq == 0) P1[t * 4 + wc] = s; }
        asm volatile("s_waitcnt lgkmcnt(0)" ::: "memory"); __builtin_amdgcn_s_barrier(); asm volatile("" ::: "memory");
#pragma unroll
        for (int ai = 0; ai < 2; ++ai)
#pragma unroll
            for (int m = 0; m < 4; ++m) { const int t = rl0 + ai * 128 + m * 16; const f32x4 ps = *(const LAS f32x4*)(P1 + t * 4); const float mu = ((ps[0] + ps[1]) + (ps[2] + ps[3])) * (1.f / 256.f); float q = 0.f;
#pragma unroll
                for (int bj = 0; bj < 2; ++bj)
#pragma unroll
                    for (int n = 0; n < 2; ++n) { f32x4 v = acc[ai][bj][m][n] - mu; acc[ai][bj][m][n] = v; q += (v[0] * v[0] + v[1] * v[1]) + (v[2] * v[2] + v[3] * v[3]); }
                q += __shfl_xor(q, 16); q += __shfl_xor(q, 32); if (fq == 0) P2[t * 4 + wc] = q; }
        asm volatile("s_waitcnt lgkmcnt(0)" ::: "memory"); __builtin_amdgcn_s_barrier(); asm volatile("" ::: "memory");
#pragma unroll
        for (int ai = 0; ai < 2; ++ai)
#pragma unroll
            for (int m = 0; m < 4; ++m) { const int t = rl0 + ai * 128 + m * 16; const size_t row = (size_t)u.pm * 256 + t; const f32x4 ps = *(const LAS f32x4*)(P2 + t * 4);
                const float rstd = 1.0f / sqrtf(((ps[0] + ps[1]) + (ps[2] + ps[3])) * (1.f / 256.f) + EPS);
#pragma unroll
                for (int bj = 0; bj < 2; ++bj)
#pragma unroll
                    for (int n = 0; n < 2; ++n) { const int c = h * 256 + col0 + bj * 128 + n * 16; const u32x2 xw = *(const u32x2*)(XC + row * DM + c), zw = *(const u32x2*)(PB + row * 3072 + 2048 + c);
                        const f32x4 ggv = *(const f32x4*)(gng + c), skv = *(const f32x4*)(skip + c); const f32x4 v = acc[ai][bj][m][n] * rstd * ggv; u32x2 w;
                        w.x = cvt_pk_bf16((v[0] + skv[0] * bf_lo(xw.x)) * bf_lo(zw.x), (v[1] + skv[1] * bf_hi(xw.x)) * bf_hi(zw.x));
                        w.y = cvt_pk_bf16((v[2] + skv[2] * bf_lo(xw.y)) * bf_lo(zw.y), (v[3] + skv[3] * bf_hi(xw.y)) * bf_hi(zw.y));
                        *(u32x2*)(Y + row * DMIX + 1024 + c) = w; }
                asm volatile("" ::: "memory"); }
    }
};
__device__ __forceinline__ void p6_hout(const Ctx& F) {
    unsigned char* ws = F.ws; Gemm g{512, 512, 512};
    OrderUnitNT S{NUNIT, F.G, F.bid, (const char*)(ws + WS_PQ), 0, 0, (size_t)256 * 512 * 2, (const char*)(ws + WS_VC), 0, 0, (size_t)256 * 512 * 2};
    EpiHOut E{(const float*)(ws + WS_DENP), (const float*)(ws + WS_DG), (const float*)(ws + WS_QN), (const float*)(ws + WS_DEM), (const bf16_t*)(ws + WS_PROJB), (const bf16_t*)(ws + WS_XB), (bf16_t*)(ws + WS_Y), F.in[21], F.in[22]};
    pg8::gemm_phase<EpiHOut, OrderUnitNT, false, true>(F.lds, g, S, E);
}
__global__ void __launch_bounds__(512, 2) mega(Args args) {
    MAKE_CTX();
    cg::grid_group grid = cg::this_grid();
#define GRID_SYNC() grid.sync()
    p0_prologue(F);      GRID_SYNC();
    p1_inproj(F);        GRID_SYNC();
    p2a_conv_gates(F);   GRID_SYNC();
    p2b_spatial(F);      GRID_SYNC();
    p3_qkv(F);           GRID_SYNC();
    p4_scores_dc(F);     GRID_SYNC();
    p5_scan_sample(F);   GRID_SYNC();
    p6_hout(F);          GRID_SYNC();
    p7_outproj(F);       GRID_SYNC();
    p8_ple(F);           GRID_SYNC();
    p9_final(F);
}

extern "C" void kernel_launch(void* const* d_in, const int* in_sizes, int n_in, void* d_out, int out_size, void* d_ws, size_t ws_size, hipStream_t stream) {
    static int grid = 0;
    if (grid == 0) {
        if (n_in != 29 || (size_t)out_size != O_END || ws_size < WS_END) { fprintf(stderr, "kernel_launch: unexpected shapes (n_in %d out %d ws %zu)\n", n_in, out_size, ws_size); grid = -1; return; }
        int dev = 0, cus = 0, per_cu = 0;
        if (hipGetDevice(&dev) != hipSuccess || hipDeviceGetAttribute(&cus, hipDeviceAttributeMultiprocessorCount, dev) != hipSuccess) { grid = -1; return; }
        if (hipFuncSetAttribute((const void*)mega, hipFuncAttributeMaxDynamicSharedMemorySize, LDS_BYTES) != hipSuccess) { fprintf(stderr, "kernel_launch: hipFuncSetAttribute failed\n"); grid = -1; return; }
        if (hipOccupancyMaxActiveBlocksPerMultiprocessor(&per_cu, (const void*)mega, 512, LDS_BYTES) != hipSuccess || per_cu < 1) { fprintf(stderr, "kernel_launch: occupancy query says %d\n", per_cu); grid = -1; return; }
        (void)hipGetLastError();
        grid = cus;
        if (grid != 256) { fprintf(stderr, "kernel_launch: this kernel is laid out for 256 CUs, got %d\n", grid); grid = -1; return; }
    }
    if (grid < 0) return;
    Args a{};
    for (int i = 0; i < 29; ++i) a.in[i] = (const float*)d_in[i];
    a.out = (float*)d_out; a.ws = (unsigned char*)d_ws;
    void* kargs[] = {&a};
    hipError_t e = hipLaunchCooperativeKernel((const void*)mega, dim3(grid), dim3(512), kargs, LDS_BYTES, stream);
    if (e != hipSuccess) fprintf(stderr, "kernel_launch: cooperative launch failed: %s (grid %d)\n", hipGetErrorString(e), grid);
}
```

```cpp
#include <hip/hip_runtime.h>
#include <hip/hip_cooperative_groups.h>
#include <cstdio>
#include <cstdint>
namespace cg = cooperative_groups;

#define LAS __attribute__((address_space(3)))
typedef unsigned short bf16_t;
typedef short bf16x8 __attribute__((ext_vector_type(8)));
typedef float f32x4 __attribute__((ext_vector_type(4)));
typedef float f32x2 __attribute__((ext_vector_type(2)));
typedef unsigned u32x4 __attribute__((ext_vector_type(4)));
typedef unsigned u32x2 __attribute__((ext_vector_type(2)));

constexpr int DM = 1024, SEQ = 2048, NB = 8, MP = NB * SEQ, MS = 128, MA = MP + 256, NTILE = MA / 256;
constexpr int NIN = 6144, WA = 1024, WB = 1024, HA = 8, DHA = 128, HB = 4, DHB = 256, DPLE = 256, DMIX = 2048;
constexpr int LC = 256, NCH = SEQ / LC;
constexpr int NUNIT = NB * HB * NCH;
constexpr float EPS = 1e-6f;

constexpr size_t O_Y = 0, O_YS = 16777216, O_CP = 16908288, O_NP = 19005440, O_MP = 19013632, O_CVP = 19013664, O_CS = 19038240, O_NS = 52592672, O_MS = 52723744, O_CVS = 52724256, O_VS = 53117472, O_END = 53248544;

constexpr size_t MiB = 1u << 20;
constexpr size_t WS_CTL = 0, WS_WIN = 1 * MiB, WS_WQ = 13 * MiB, WS_WK = WS_WQ + MiB / 2, WS_WV = 14 * MiB, WS_WOUT = WS_WV + MiB / 2, WS_WPG = WS_WOUT + 4 * MiB, WS_WPP = WS_WPG + 2 * MiB,
    WS_WSP = 21 * MiB, WS_WG = WS_WSP + MiB / 4, WS_RS = WS_WG + MiB / 4, WS_GLI = 22 * MiB, WS_GLF = WS_GLI + MiB / 2, WS_DA = 23 * MiB, WS_DR = WS_DA + MiB / 2, WS_DG = 24 * MiB, WS_DEM = WS_DG + MiB / 2,
    WS_DW = 25 * MiB, WS_QN = WS_DW + MiB / 2, WS_DENP = 26 * MiB, WS_DN = 27 * MiB, WS_VS = WS_DN + MiB / 2, WS_PB = 28 * MiB, WS_XB = 37 * MiB, WS_PROJA = 70 * MiB, WS_PROJB = 168 * MiB,
    WS_PQ = 266 * MiB, WS_VC = 330 * MiB, WS_Y = 394 * MiB, WS_END = 460 * MiB;
constexpr size_t WS_Q = WS_PROJA, WS_K = WS_Q + 33 * MiB, WS_WKT = WS_K + 33 * MiB;
constexpr size_t WS_X1B = WS_PROJA, WS_GB = WS_X1B + 33 * MiB, WS_EB = WS_GB + 33 * MiB;
static_assert(WS_WKT + 32 * MiB <= WS_PROJB && WS_EB + 33 * MiB <= WS_PQ, "ws map");

__device__ __forceinline__ unsigned cvt_pk_bf16(float lo, float hi) { unsigned r; asm volatile("v_cvt_pk_bf16_f32 %0, %1, %2" : "=v"(r) : "v"(lo), "v"(hi)); return r; }
__device__ __forceinline__ float bf_lo(unsigned w) { return __uint_as_float(w << 16); }
__device__ __forceinline__ float bf_hi(unsigned w) { return __uint_as_float(w & 0xffff0000u); }
__device__ __forceinline__ float bf2f(bf16_t b) { return __uint_as_float(((unsigned)b) << 16); }
__device__ __forceinline__ bf16_t f2bf(float f) { return (bf16_t)(cvt_pk_bf16(f, 0.f) & 0xffffu); }
__device__ __forceinline__ float fast_exp(float x) { return __builtin_amdgcn_exp2f(x * 1.4426950408889634f); }
__device__ __forceinline__ float sigmoidf_(float x) { return __builtin_amdgcn_rcpf(1.0f + fast_exp(-x)); }
__device__ __forceinline__ float siluf_(float x) { return x * sigmoidf_(x); }
__device__ __forceinline__ f32x2 gelu_pk(f32x2 v) {
    const f32x2 av = __builtin_elementwise_abs(v), d = av * 0.2316418882f + 1.0f;
    f32x2 t; t.x = __builtin_amdgcn_rcpf(d.x); t.y = __builtin_amdgcn_rcpf(d.y);
    f32x2 q = t * 0.5307027145f + (-0.7265760135f); q = q * t + 0.7107068705f; q = q * t + (-0.142248368f); q = q * t + 0.127414796f; q = q * t;
    const f32x2 s = (v * v) * (-0.72134752044f);
    f32x2 e; e.x = __builtin_amdgcn_exp2f(s.x); e.y = __builtin_amdgcn_exp2f(s.y);
    const f32x2 m = v * (q * e), r = v - m;
    f32x2 o; o.x = v.x < 0.f ? m.x : r.x; o.y = v.y < 0.f ? m.y : r.y; return o;
}
__device__ __forceinline__ float wave_sum(float v) {
#pragma unroll
    for (int o = 1; o < 64; o <<= 1) v += __shfl_xor(v, o);
    return v;
}
#define LDS_WAIT() asm volatile("s_waitcnt lgkmcnt(0)" ::: "memory")

namespace pg8 {
constexpr int BM = 256, BK = 64, HALF = 128, HTB = HALF * BK * 2, STAGE_BYTES = 8 * HTB;
__host__ __device__ __forceinline__ int lds_byte(int r, int c) { const int st = (r >> 4) * 2 + (c >> 5), rr = r & 15, cc = c & 31, ob = rr * 64 + cc * 2; return st * 1024 + (ob ^ (((ob >> 9) & 1) << 5)); }
__host__ __device__ __forceinline__ void stage_rc(int b, int& R, int& C) { const int st = b / 1024, sb = b % 1024, swz = sb ^ (((sb >> 9) & 1) << 5); R = (st >> 1) * 16 + swz / 64; C = (st & 1) * 32 + (swz % 64) / 2; }
__host__ __device__ __forceinline__ int perm32(int rho) { const int n = rho >> 4, i = rho & 15; return 8 * (i >> 2) + 4 * n + (i & 3); }

struct Unit { const char* a; const char* b; int pm, pn, aux; };
struct Gemm { int lda, ldb, K; };

template <class Epi, class Sched, bool ALIGN_EPI = true, bool SP2 = true>
__device__ __forceinline__ void gemm_phase(LAS unsigned char* lds, const Gemm g, const Sched& S, const Epi& E) {
    int tid_ = threadIdx.x; asm volatile("" : "+v"(tid_));
    const int tid = tid_, wid = __builtin_amdgcn_readfirstlane(tid >> 6), lane = tid & 63, wr = wid >> 2, wc = wid & 3, fr = lane & 15, fq = lane >> 4;
    int K_ = g.K; asm volatile("" : "+s"(K_)); const int K = K_, nt = K / BK; (void)K;
    unsigned voffA[2], voffB[2];
#pragma unroll
    for (int i = 0; i < 2; ++i) { int R, C; stage_rc(tid * 16 + i * 8192, R, C); const int Rb = Epi::PERM ? ((R & ~31) + perm32(R & 31)) : R;
        voffA[i] = (unsigned)(R * g.lda + C) * 2u; voffB[i] = (unsigned)(Rb * g.ldb + C) * 2u; }
    const size_t kstep = (size_t)(BK * 2);
    const size_t hstepA = (size_t)HALF * g.lda * 2, hstepB = (size_t)HALF * g.ldb * 2;
    const unsigned ldsw = (unsigned)wid * 1024u;
    const int aoff = lds_byte(wr * 64 + fr, fq * 8), boff = lds_byte(wc * 32 + fr, fq * 8);
#define PG8_SA(b, h) (((b) * 2 + (h)) * HTB)
#define PG8_SB(b, h) ((4 + (b) * 2 + (h)) * HTB)
#define PG8_STAGE(bufoff, gbase, voff) do { _Pragma("unroll") for (int _i = 0; _i < 2; ++_i) \
        __builtin_amdgcn_global_load_lds((const unsigned*)((const char*)(gbase) + (voff)[_i]), (LAS unsigned*)(lds + (bufoff) + ldsw + _i * 8192), 16, 0, 0); } while (0)
#define PG8_LDA(dst, b, h) do { _Pragma("unroll") for (int m = 0; m < 4; ++m) _Pragma("unroll") for (int k = 0; k < 2; ++k) dst[m][k] = *(const LAS bf16x8*)(lds + PG8_SA(b, h) + aoff + m * 2048 + k * 1024); } while (0)
#define PG8_LDB(dst, b, h) do { _Pragma("unroll") for (int n = 0; n < 2; ++n) _Pragma("unroll") for (int k = 0; k < 2; ++k) dst[n][k] = *(const LAS bf16x8*)(lds + PG8_SB(b, h) + boff + n * 2048 + k * 1024); } while (0)
#define PG8_MMA(ai, bj, At, Bt) do { __builtin_amdgcn_s_setprio(1); _Pragma("unroll") for (int m = 0; m < 4; ++m) _Pragma("unroll") for (int n = 0; n < 2; ++n) _Pragma("unroll") for (int k = 0; k < 2; ++k) \
        acc[ai][bj][m][n] = __builtin_amdgcn_mfma_f32_16x16x32_bf16(Bt[n][k], At[m][k], acc[ai][bj][m][n], 0, 0, 0); __builtin_amdgcn_s_setprio(0); } while (0)
#define PG8_WAIT_V(n) asm volatile("s_waitcnt vmcnt(" #n ")" ::: "memory")
#define PG8_WAIT_L(n) asm volatile("s_waitcnt lgkmcnt(" #n ")" ::: "memory")
#define PG8_BAR __builtin_amdgcn_s_barrier()
#define PG8_SCHED __builtin_amdgcn_sched_barrier(0)
    Unit cur, nxt; int ui = 0;
    if (!S.next(0, cur)) return;
    f32x4 acc[2][2][4][2];
#pragma unroll
    for (int a = 0; a < 2; ++a)
#pragma unroll
        for (int b = 0; b < 2; ++b)
#pragma unroll
            for (int m = 0; m < 4; ++m)
#pragma unroll
                for (int n = 0; n < 2; ++n) acc[a][b][m][n] = (f32x4){0.f, 0.f, 0.f, 0.f};
    bf16x8 At[4][2], B0[2][2], B1[2][2];
    const char* cA = cur.a; const char* cB = cur.b;
    if constexpr (SP2) {
        PG8_STAGE(PG8_SB(0, 0), cB, voffB); PG8_STAGE(PG8_SB(0, 1), cB + hstepB, voffB); PG8_STAGE(PG8_SA(0, 0), cA, voffA); PG8_STAGE(PG8_SA(0, 1), cA + hstepA, voffA);
        if (wr == 1) PG8_BAR;
        PG8_WAIT_V(2); PG8_BAR;
        PG8_STAGE(PG8_SB(1, 0), cB + kstep, voffB); PG8_STAGE(PG8_SA(1, 0), cA + kstep, voffA); PG8_STAGE(PG8_SB(1, 1), cB + hstepB + kstep, voffB);
        PG8_WAIT_V(6); PG8_BAR;
    } else {
        PG8_STAGE(PG8_SB(0, 0), cB, voffB); PG8_STAGE(PG8_SA(0, 0), cA, voffA); PG8_STAGE(PG8_SB(0, 1), cB + hstepB, voffB); PG8_STAGE(PG8_SA(0, 1), cA + hstepA, voffA);
        if (wr == 1) PG8_BAR;
        PG8_WAIT_V(4); PG8_BAR;
        PG8_STAGE(PG8_SB(1, 0), cB + kstep, voffB); PG8_STAGE(PG8_SA(1, 0), cA + kstep, voffA); PG8_STAGE(PG8_SB(1, 1), cB + hstepB + kstep, voffB);
        PG8_WAIT_V(6); PG8_BAR;
    }
    for (;;) {
        const bool has_next = S.next(ui + 1, nxt);
        const char* nA = has_next ? nxt.a : cA; const char* nB = has_next ? nxt.b : cB;
#pragma unroll 1
        for (int t = 0; t < nt; t += 2) {
            const bool last = (t == nt - 2);
            const char* a1 = cA + (size_t)(t + 1) * kstep;
            const char* a2 = last ? nA : cA + (size_t)(t + 2) * kstep; const char* b2 = last ? nB : cB + (size_t)(t + 2) * kstep;
            const char* a3 = a2 + kstep; const char* b3 = b2 + kstep;
            if constexpr (SP2) {
            PG8_LDB(B0, 0, 0); PG8_LDB(B1, 0, 1); PG8_SCHED; PG8_LDA(At, 0, 0); PG8_STAGE(PG8_SA(1, 1), a1 + hstepA, voffA);
            PG8_WAIT_V(8); PG8_WAIT_L(0); PG8_BAR; PG8_MMA(0, 0, At, B0); PG8_MMA(0, 1, At, B1); PG8_BAR; PG8_SCHED;
            PG8_LDA(At, 0, 1); PG8_STAGE(PG8_SB(0, 0), b2, voffB); PG8_STAGE(PG8_SB(0, 1), b2 + hstepB, voffB); PG8_STAGE(PG8_SA(0, 0), a2, voffA);
            PG8_WAIT_V(8); PG8_WAIT_L(0); PG8_BAR; PG8_MMA(1, 0, At, B0); PG8_MMA(1, 1, At, B1); PG8_BAR; PG8_SCHED;
            PG8_LDB(B0, 1, 0); PG8_LDB(B1, 1, 1); PG8_SCHED; PG8_LDA(At, 1, 0); PG8_STAGE(PG8_SA(0, 1), a2 + hstepA, voffA);
            PG8_WAIT_V(8); PG8_WAIT_L(0); PG8_BAR; PG8_MMA(0, 0, At, B0); PG8_MMA(0, 1, At, B1); PG8_BAR; PG8_SCHED;
            PG8_LDA(At, 1, 1); PG8_STAGE(PG8_SB(1, 0), b3, voffB); PG8_STAGE(PG8_SB(1, 1), b3 + hstepB, voffB); PG8_STAGE(PG8_SA(1, 0), a3, voffA);
            PG8_WAIT_V(8); PG8_WAIT_L(0); PG8_BAR; PG8_MMA(1, 0, At, B0); PG8_MMA(1, 1, At, B1); PG8_BAR; PG8_SCHED;
            } else {
            PG8_LDB(B0, 0, 0); PG8_SCHED; PG8_LDA(At, 0, 0); PG8_STAGE(PG8_SA(1, 1), a1 + hstepA, voffA);
            PG8_WAIT_L(8); PG8_BAR; PG8_WAIT_L(0); PG8_MMA(0, 0, At, B0); PG8_BAR; PG8_SCHED;
            PG8_LDB(B1, 0, 1); PG8_STAGE(PG8_SB(0, 0), b2, voffB);
            PG8_BAR; PG8_WAIT_L(0); PG8_MMA(0, 1, At, B1); PG8_BAR;
            PG8_LDA(At, 0, 1); PG8_STAGE(PG8_SA(0, 0), a2, voffA);
            PG8_BAR; PG8_WAIT_L(0); PG8_MMA(1, 0, At, B0); PG8_BAR; PG8_SCHED;
            PG8_STAGE(PG8_SB(0, 1), b2 + hstepB, voffB);
            PG8_WAIT_V(6); PG8_BAR; PG8_MMA(1, 1, At, B1); PG8_BAR;
            PG8_LDB(B0, 1, 0); PG8_SCHED; PG8_LDA(At, 1, 0); PG8_STAGE(PG8_SA(0, 1), a2 + hstepA, voffA);
            PG8_WAIT_L(8); PG8_BAR; PG8_WAIT_L(0); PG8_MMA(0, 0, At, B0); PG8_BAR; PG8_SCHED;
            PG8_LDB(B1, 1, 1); PG8_STAGE(PG8_SB(1, 0), b3, voffB);
            PG8_BAR; PG8_WAIT_L(0); PG8_MMA(0, 1, At, B1); PG8_BAR;
            PG8_LDA(At, 1, 1); PG8_STAGE(PG8_SA(1, 0), a3, voffA);
            PG8_BAR; PG8_WAIT_L(0); PG8_MMA(1, 0, At, B0); PG8_BAR; PG8_SCHED;
            PG8_STAGE(PG8_SB(1, 1), b3 + hstepB, voffB);
            PG8_WAIT_V(6); PG8_BAR; PG8_MMA(1, 1, At, B1); PG8_BAR;
            }
        }
        if constexpr (ALIGN_EPI) { if (wr == 0) PG8_BAR; }
        if constexpr (!Epi::AFTER_DRAIN) { E(acc, cur, wr, wc, fr, fq); }
        if (!has_next) break;
#pragma unroll
        for (int a = 0; a < 2; ++a)
#pragma unroll
            for (int b = 0; b < 2; ++b)
#pragma unroll
                for (int m = 0; m < 4; ++m)
#pragma unroll
                    for (int n = 0; n < 2; ++n) acc[a][b][m][n] = (f32x4){0.f, 0.f, 0.f, 0.f};
        cur = nxt; cA = nA; cB = nB; ++ui;
        if constexpr (ALIGN_EPI) { if (wr == 1) PG8_BAR; }
    }
    PG8_WAIT_V(0);
    if constexpr (!ALIGN_EPI) { if (wr == 0) PG8_BAR; }
    PG8_BAR;
    if constexpr (Epi::AFTER_DRAIN) { E.fused(acc, cur, wr, wc, fr, fq, lds, wid, lane); }
#undef PG8_SA
#undef PG8_SB
#undef PG8_STAGE
#undef PG8_LDA
#undef PG8_LDB
#undef PG8_MMA
#undef PG8_WAIT_V
#undef PG8_WAIT_L
#undef PG8_BAR
#undef PG8_SCHED
}
}
using pg8::Unit; using pg8::Gemm;

constexpr int LDS_BYTES = 147456;
struct Args { const float* in[29]; float* out; unsigned char* ws; };

struct Ctx {
    LAS unsigned char* lds; int tid, lane, wave, G, bid, gw, NGW;
    const float* const* in; float* out; unsigned char* ws;
};

__device__ __forceinline__ void p0_transpose_item(const float* W, int ldw, bf16_t* WT, int ldt, const float* kscale, LAS float* scr, int kb, int nb, int lane) {
    const int k0 = 64 * kb, n0 = 32 * nb;
#pragma unroll 8
    for (int i = 0; i < 32; ++i) { const int kk = 2 * i + (lane >> 5); float v = W[(size_t)(k0 + kk) * ldw + n0 + (lane & 31)]; if (kscale) v *= kscale[k0 + kk]; scr[kk * 33 + (lane & 31)] = v; }
    LDS_WAIT(); asm volatile("" ::: "memory");
    const int c = lane & 7;
#pragma unroll
    for (int j = 0; j < 4; ++j) { const int n = (lane >> 3) + 8 * j; const LAS float* s = scr + (8 * c) * 33 + n;
        u32x4 o; o.x = cvt_pk_bf16(s[0 * 33], s[1 * 33]); o.y = cvt_pk_bf16(s[2 * 33], s[3 * 33]); o.z = cvt_pk_bf16(s[4 * 33], s[5 * 33]); o.w = cvt_pk_bf16(s[6 * 33], s[7 * 33]);
        *(u32x4*)(WT + (size_t)(n0 + n) * ldt + k0 + 8 * c) = o; }
    LDS_WAIT(); asm volatile("" ::: "memory");
}

__device__ __forceinline__ void p0_prologue(const Ctx& F0) { Ctx F = F0; asm volatile("" : "+v"(F.tid), "+v"(F.lane));
    LAS float* scr = (LAS float*)(F.lds + F.wave * 16384);
    unsigned char* ws = F.ws;
    constexpr int I_WIN = 16 * 192, I_QKV = 12 * 4 * 8, I_WOUT = 32 * 32, I_WPG = 16 * 32, I_WPP = 4 * 32;
    constexpr int I_T = I_WIN + I_QKV + I_WOUT + I_WPG + I_WPP;
    constexpr int I_X = MA, I_P = MA, I_SP = 1024, I_WG = 1024, I_YPAD = 128;
    constexpr int NITEMS = I_T + I_X + I_P + I_SP + I_WG + I_YPAD;
    for (int it = F.gw; it < NITEMS; it += F.NGW) {
        int r = it;
        if (r < I_T) {
            if (r < I_WIN) { p0_transpose_item(F.in[9], NIN, (bf16_t*)(ws + WS_WIN), DM, F.in[8], scr, r / 192, r % 192, F.lane); continue; } r -= I_WIN;
            if (r < I_QKV) { const int mat = r / 32, rr = r % 32, which = mat / 4, h = mat % 4;
                const float* W = F.in[16 + which] + (size_t)h * 65536; bf16_t* WT = (bf16_t*)(ws + (which == 0 ? WS_WQ : which == 1 ? WS_WK : WS_WV)) + (size_t)h * 65536;
                p0_transpose_item(W, 256, WT, 256, nullptr, scr, rr / 8, rr % 8, F.lane); continue; } r -= I_QKV;
            if (r < I_WOUT) { p0_transpose_item(F.in[23], DM, (bf16_t*)(ws + WS_WOUT), DMIX, nullptr, scr, r / 32, r % 32, F.lane); continue; } r -= I_WOUT;
            if (r < I_WPG) { p0_transpose_item(F.in[24], DM, (bf16_t*)(ws + WS_WPG), DM, nullptr, scr, r / 32, r % 32, F.lane); continue; } r -= I_WPG;
            p0_transpose_item(F.in[26], DM, (bf16_t*)(ws + WS_WPP), DPLE, nullptr, scr, r / 32, r % 32, F.lane); continue;
        }
        r -= I_T;
        if (r < I_X) {
            bf16_t* orow = (bf16_t*)(ws + WS_XB) + (size_t)r * DM; float* rs = (float*)(ws + WS_RS);
            unsigned long long* o8 = (unsigned long long*)orow + F.lane;
            if (r >= MP + MS) {
#pragma unroll
                for (int j = 0; j < 4; ++j) o8[64 * j] = 0ull;
                if (F.lane == 0) rs[r] = 0.f; continue; }
            const float* xrow = r < MP ? F.in[0] + (size_t)r * DM : F.in[1] + (size_t)(r - MP) * DM;
            const f32x4* xr = (const f32x4*)xrow + F.lane; f32x4 v[4]; float s = 0.f;
#pragma unroll
            for (int j = 0; j < 4; ++j) { v[j] = xr[64 * j]; s += (v[j].x * v[j].x + v[j].y * v[j].y) + (v[j].z * v[j].z + v[j].w * v[j].w); }
            s = wave_sum(s);
#pragma unroll
            for (int j = 0; j < 4; ++j) o8[64 * j] = (unsigned long long)cvt_pk_bf16(v[j].x, v[j].y) | ((unsigned long long)cvt_pk_bf16(v[j].z, v[j].w) << 32);
            if (F.lane == 0) rs[r] = 1.0f / sqrtf(s * (1.0f / DM) + EPS);
            continue;
        }
        r -= I_X;
        if (r < I_P) {
            unsigned long long* o8 = (unsigned long long*)((bf16_t*)(ws + WS_PB) + (size_t)r * DPLE) + F.lane;
            if (r >= MP + MS) { o8[0] = 0ull; continue; }
            const float* prow = r < MP ? F.in[6] + (size_t)r * DPLE : F.in[7] + (size_t)(r - MP) * DPLE;
            const f32x4 v = ((const f32x4*)prow)[F.lane];
            o8[0] = (unsigned long long)cvt_pk_bf16(v.x, v.y) | ((unsigned long long)cvt_pk_bf16(v.z, v.w) << 32);
            continue;
        }
        r -= I_P;
        if (r < I_SP) {
            const int t = r & 127; const float* wrow = F.in[12] + (size_t)r * 128; const f32x2 v = ((const f32x2*)wrow)[F.lane];
            const int s0 = 2 * F.lane; ((unsigned*)((bf16_t*)(ws + WS_WSP) + (size_t)r * 128))[F.lane] = cvt_pk_bf16(s0 <= t ? v.x : 0.f, s0 + 1 <= t ? v.y : 0.f);
            continue;
        }
        r -= I_SP;
        if (r < I_WG) {
            const int i = r, h = i >> 8, d = i & 255, j = F.lane & 7, isx = (F.lane >> 3) & 1, part = F.lane >> 4;
            const float* wif = F.in[19]; float s = 0.f;
            if (!isx) { const float* wq = F.in[16] + ((size_t)h * 256 + d) * 256; const float* wk = F.in[17] + ((size_t)h * 256 + d) * 256;
                for (int e = part * 64; e < part * 64 + 64; ++e) s += wq[e] * wif[(size_t)(h * 256 + e) * 8 + j] + wk[e] * wif[(size_t)(1024 + h * 256 + e) * 8 + j]; }
            else { const float* wv = F.in[18] + ((size_t)h * 256 + d) * 256;
                for (int e = part * 64; e < part * 64 + 64; ++e) s += wv[e] * wif[(size_t)(2048 + h * 256 + e) * 8 + j]; }
            s += __shfl_xor(s, 16); s += __shfl_xor(s, 32);
            if (F.lane < 16) ((float*)(ws + WS_WG))[(size_t)i * 16 + F.lane] = s;
            continue;
        }
        r -= I_WG;
        {
            u32x4* yrow = (u32x4*)((bf16_t*)(ws + WS_Y) + (size_t)(MP + MS + r) * DMIX) + F.lane;
#pragma unroll
            for (int j = 0; j < 4; ++j) yrow[64 * j] = (u32x4){0u, 0u, 0u, 0u};
        }
    }
}

struct OrderRowMajor {
    int nM, nN, n, G, c; const char* A; const char* B; size_t astep, bstep;
    __device__ __forceinline__ bool next(int i, Unit& u) const {
        const int L = i * G + c; if (L >= n) return false;
        u.pm = L / nN; u.pn = L % nN; u.aux = 0; u.a = A + (size_t)u.pm * astep; u.b = B + (size_t)u.pn * bstep; return true;
    }
};
struct EpiInProj {
    static constexpr bool PERM = true, AFTER_DRAIN = false;
    bf16_t* PA; bf16_t* PB; const float* rs;
    template <int KIND> __device__ __forceinline__ void run(const f32x4 (&acc)[2][2][4][2], bf16_t* base, int row0, int col0) const {
#pragma unroll
        for (int ai = 0; ai < 2; ++ai)
#pragma unroll
            for (int m = 0; m < 4; ++m) { const int row = row0 + ai * 128 + m * 16; const float s = rs[row]; bf16_t* rowp = base + (size_t)row * 3072 + col0;
#pragma unroll
                for (int bj = 0; bj < 2; ++bj) { f32x4 v0 = acc[ai][bj][m][0] * s, v1 = acc[ai][bj][m][1] * s;
                    if (KIND == 0) { f32x2 a = gelu_pk((f32x2){v0[0], v0[1]}), b = gelu_pk((f32x2){v0[2], v0[3]}), c = gelu_pk((f32x2){v1[0], v1[1]}), d = gelu_pk((f32x2){v1[2], v1[3]});
                        v0 = (f32x4){a.x, a.y, b.x, b.y}; v1 = (f32x4){c.x, c.y, d.x, d.y}; }
                    if (KIND == 1) {
#pragma unroll
                        for (int j = 0; j < 4; ++j) { v0[j] = siluf_(v0[j]); v1[j] = siluf_(v1[j]); } }
                    if (KIND == 3) {
#pragma unroll
                        for (int j = 0; j < 4; ++j) { v0[j] = sigmoidf_(v0[j]); v1[j] = sigmoidf_(v1[j]); } }
                    u32x4 w; w.x = cvt_pk_bf16(v0[0], v0[1]); w.y = cvt_pk_bf16(v0[2], v0[3]); w.z = cvt_pk_bf16(v1[0], v1[1]); w.w = cvt_pk_bf16(v1[2], v1[3]);
                    *(u32x4*)(rowp + bj * 128) = w; } }
    }
    __device__ __forceinline__ void operator()(const f32x4 (&acc)[2][2][4][2], const Unit& u, int wr, int wc, int fr, int fq) const {
        const int row0 = u.pm * 256 + wr * 64 + fr, pn = u.pn;
        bf16_t* base = pn < 12 ? PA + pn * 256 : PB + (pn - 12) * 256; const int col0 = wc * 32 + 8 * fq;
        if (pn < 8) run<0>(acc, base, row0, col0);
        else if (pn < 12 || pn >= 20) run<1>(acc, base, row0, col0);
        else if (pn < 16) run<2>(acc, base, row0, col0);
        else run<3>(acc, base, row0, col0);
    }
};

__device__ __forceinline__ float logsigmoidf_(float x) { return fminf(x, 0.f) - log1pf(__expf(-fabsf(x))); }
__device__ __forceinline__ void unpack8(const u32x4 w, float (&f)[8]) { f[0] = bf_lo(w.x); f[1] = bf_hi(w.x); f[2] = bf_lo(w.y); f[3] = bf_hi(w.y); f[4] = bf_lo(w.z); f[5] = bf_hi(w.z); f[6] = bf_lo(w.w); f[7] = bf_hi(w.w); }
__device__ __forceinline__ u32x4 pack8(const float (&f)[8]) { u32x4 w; w.x = cvt_pk_bf16(f[0], f[1]); w.y = cvt_pk_bf16(f[2], f[3]); w.z = cvt_pk_bf16(f[4], f[5]); w.w = cvt_pk_bf16(f[6], f[7]); return w; }

__device__ __forceinline__ void p2a_conv_gates(const Ctx& F0) { Ctx F = F0; asm volatile("" : "+v"(F.tid), "+v"(F.lane));
    unsigned char* ws = F.ws;
    const bf16_t* PBX = (const bf16_t*)(ws + WS_PROJB);
    bf16_t* XC = (bf16_t*)(ws + WS_XB);
    const float* Wg = (const float*)(ws + WS_WG);
    float* GLI = (float*)(ws + WS_GLI); float* GLF = (float*)(ws + WS_GLF);
    const float* convw = F.in[14]; const float* convb = F.in[15]; const float* bif = F.in[20];
    LAS float* red = (LAS float*)F.lds;
    const int cgp = F.tid & 127, rg = F.tid >> 7, ch0 = cgp * 8;
    for (int tile = F.bid; tile < MP / 32; tile += F.G) {
        float cw[4][8], cb[8];
#pragma unroll
        for (int j = 0; j < 4; ++j) { const f32x4 a = *(const f32x4*)(convw + j * 1024 + ch0), b = *(const f32x4*)(convw + j * 1024 + ch0 + 4);
            cw[j][0] = a.x; cw[j][1] = a.y; cw[j][2] = a.z; cw[j][3] = a.w; cw[j][4] = b.x; cw[j][5] = b.y; cw[j][6] = b.z; cw[j][7] = b.w; }
        { const f32x4 a = *(const f32x4*)(convb + ch0), b = *(const f32x4*)(convb + ch0 + 4); cb[0] = a.x; cb[1] = a.y; cb[2] = a.z; cb[3] = a.w; cb[4] = b.x; cb[5] = b.y; cb[6] = b.z; cb[7] = b.w; }
        const int r0 = tile * 32 + rg * 8, seq0 = r0 & ~(SEQ - 1);
        float w0[8], w1[8], w2[8], cur[8];
#pragma unroll
        for (int c = 0; c < 8; ++c) { w0[c] = 0.f; w1[c] = 0.f; w2[c] = 0.f; }
        if (r0 - 3 >= seq0) unpack8(*(const u32x4*)(PBX + (size_t)(r0 - 3) * 3072 + ch0), w0);
        if (r0 - 2 >= seq0) unpack8(*(const u32x4*)(PBX + (size_t)(r0 - 2) * 3072 + ch0), w1);
        if (r0 - 1 >= seq0) unpack8(*(const u32x4*)(PBX + (size_t)(r0 - 1) * 3072 + ch0), w2);
#pragma unroll 1
        for (int i = 0; i < 8; ++i) {
            const int r = r0 + i;
            unpack8(*(const u32x4*)(PBX + (size_t)r * 3072 + ch0), cur);
            float xc[8], gp[8];
#pragma unroll
            for (int c = 0; c < 8; ++c) xc[c] = siluf_(cw[0][c] * w0[c] + cw[1][c] * w1[c] + cw[2][c] * w2[c] + cw[3][c] * cur[c] + cb[c]);
            *(u32x4*)(XC + (size_t)r * DM + ch0) = pack8(xc);
#pragma unroll
            for (int j = 0; j < 8; ++j) gp[j] = 0.f;
#pragma unroll
            for (int c = 0; c < 8; ++c) { const float* wrow = Wg + (size_t)(ch0 + c) * 16;
                const f32x4 a = *(const f32x4*)(wrow), b = *(const f32x4*)(wrow + 4), cc = *(const f32x4*)(wrow + 8), d = *(const f32x4*)(wrow + 12);
                gp[0] += xc[c] * a.x + cur[c] * cc.x; gp[1] += xc[c] * a.y + cur[c] * cc.y; gp[2] += xc[c] * a.z + cur[c] * cc.z; gp[3] += xc[c] * a.w + cur[c] * cc.w;
                gp[4] += xc[c] * b.x + cur[c] * d.x; gp[5] += xc[c] * b.y + cur[c] * d.y; gp[6] += xc[c] * b.z + cur[c] * d.z; gp[7] += xc[c] * b.w + cur[c] * d.w; }
#pragma unroll
            for (int j = 0; j < 8; ++j) gp[j] = wave_sum(gp[j]);
            if (F.lane == 0) {
#pragma unroll
                for (int j = 0; j < 8; ++j) red[((rg * 8 + i) * 2 + (F.wave & 1)) * 8 + j] = gp[j]; }
#pragma unroll
            for (int c = 0; c < 8; ++c) { w0[c] = w1[c]; w1[c] = w2[c]; w2[c] = cur[c]; }
        }
        __syncthreads();
        if (F.tid < 256) { const int rl = F.tid >> 3, j = F.tid & 7, r = tile * 32 + rl;
            const float g = red[(rl * 2 + 0) * 8 + j] + red[(rl * 2 + 1) * 8 + j] + bif[j];
            if (j < 4) GLI[(size_t)j * MA + r] = g; else GLF[(size_t)(j - 4) * MA + r] = logsigmoidf_(g); }
        __syncthreads();
    }
    for (int i = F.bid * 512 + F.tid; i < NB * 3 * 1024; i += F.G * 512) { const int b = i / 3072, j = (i / 1024) % 3, ch = i & 1023;
        F.out[O_CVP + i] = bf2f(PBX[(size_t)(b * SEQ + SEQ - 3 + j) * 3072 + ch]); }
    for (int i = F.gw; i < MS; i += F.NGW) {
        const int r = MP + i, ch0s = F.lane * 16; const float* st = F.in[5] + (size_t)i * 3 * 1024;
        const bf16_t* PA = (const bf16_t*)(ws + WS_PROJA) + (size_t)r * 3072;
        float gp[8];
#pragma unroll
        for (int j = 0; j < 8; ++j) gp[j] = 0.f;
#pragma unroll
        for (int half = 0; half < 2; ++half) { const int c0 = ch0s + half * 8; float xb[8], xc[8];
            unpack8(*(const u32x4*)(PBX + (size_t)r * 3072 + c0), xb);
#pragma unroll
            for (int c = 0; c < 8; ++c) { const int ch = c0 + c; const float s0 = st[ch], s1 = st[1024 + ch], s2 = st[2048 + ch];
                xc[c] = siluf_(convw[ch] * s0 + convw[1024 + ch] * s1 + convw[2048 + ch] * s2 + convw[3072 + ch] * xb[c] + convb[ch]);
                F.out[O_CVS + (size_t)i * 3072 + ch] = s1; F.out[O_CVS + (size_t)i * 3072 + 1024 + ch] = s2; F.out[O_CVS + (size_t)i * 3072 + 2048 + ch] = xb[c];
                const float* wrow = Wg + (size_t)ch * 16;
#pragma unroll
                for (int j = 0; j < 8; ++j) gp[j] += xc[c] * wrow[j] + xb[c] * wrow[8 + j]; }
            *(u32x4*)(XC + (size_t)r * DM + c0) = pack8(xc); }
#pragma unroll
        for (int j = 0; j < 8; ++j) gp[j] = wave_sum(gp[j]);
        if (F.lane < 8) { float g = 0.f;
#pragma unroll
            for (int j = 0; j < 8; ++j) g = (F.lane == j) ? gp[j] : g;
            g += bif[F.lane];
            if (F.lane < 4) GLI[(size_t)F.lane * MA + r] = g; else GLF[(size_t)(F.lane - 4) * MA + r] = logsigmoidf_(g); }
        float gv[16], s = 0.f;
        { float t8[8]; unpack8(*(const u32x4*)(PA + 1024 + ch0s), t8);
#pragma unroll
          for (int c = 0; c < 8; ++c) gv[c] = t8[c];
          unpack8(*(const u32x4*)(PA + 1024 + ch0s + 8), t8);
#pragma unroll
          for (int c = 0; c < 8; ++c) gv[8 + c] = t8[c]; }
#pragma unroll
        for (int c = 0; c < 16; ++c) s += gv[c];
        s += __shfl_xor(s, 1); s += __shfl_xor(s, 2); s += __shfl_xor(s, 4);
        const float mu = s * (1.f / 128.f); float q = 0.f;
#pragma unroll
        for (int c = 0; c < 16; ++c) { const float d = gv[c] - mu; q += d * d; }
        q += __shfl_xor(q, 1); q += __shfl_xor(q, 2); q += __shfl_xor(q, 4);
        const float rstd = 1.0f / sqrtf(q * (1.f / 128.f) + EPS);
        const int h = F.lane >> 3; const float wsp = F.in[12][(size_t)h * 16384], bsp = F.in[13][h * 128];
        float uu[16], zz[16];
        { float t8[8]; unpack8(*(const u32x4*)(PA + ch0s), t8);
#pragma unroll
          for (int c = 0; c < 8; ++c) uu[c] = t8[c];
          unpack8(*(const u32x4*)(PA + ch0s + 8), t8);
#pragma unroll
          for (int c = 0; c < 8; ++c) uu[8 + c] = t8[c];
          unpack8(*(const u32x4*)(PA + 2048 + ch0s), t8);
#pragma unroll
          for (int c = 0; c < 8; ++c) zz[c] = t8[c];
          unpack8(*(const u32x4*)(PA + 2048 + ch0s + 8), t8);
#pragma unroll
          for (int c = 0; c < 8; ++c) zz[8 + c] = t8[c]; }
        float ya[16];
#pragma unroll
        for (int c = 0; c < 16; ++c) { const int ch = ch0s + c; const float vn = (gv[c] - mu) * rstd * F.in[10][ch] + F.in[11][ch];
            F.out[O_VS + (size_t)i * 1024 + ch] = vn; ya[c] = uu[c] * (wsp * vn + bsp) * zz[c]; }
        bf16_t* yrow = (bf16_t*)(ws + WS_Y) + (size_t)r * DMIX + ch0s;
        { float t8[8];
#pragma unroll
          for (int c = 0; c < 8; ++c) t8[c] = ya[c];
          *(u32x4*)(yrow) = pack8(t8);
#pragma unroll
          for (int c = 0; c < 8; ++c) t8[c] = ya[8 + c];
          *(u32x4*)(yrow + 8) = pack8(t8); }
    }
}

__device__ __forceinline__ void mscan_wave(const Ctx& F, int bh) {
    unsigned char* ws = F.ws; const int b = bh >> 2, h = bh & 3, lane = F.lane;
    const float* li = (const float*)(ws + WS_GLI) + (size_t)h * MA + (size_t)b * SEQ + lane * 32;
    const float* lf = (const float*)(ws + WS_GLF) + (size_t)h * MA + (size_t)b * SEQ + lane * 32;
    float A = 0.f, Bv = -INFINITY;
    for (int i = 0; i < 32; ++i) { const float f = lf[i], l = li[i]; Bv = fmaxf(Bv + f, l); A += f; }
    float sA = A, sB = Bv;
#pragma unroll
    for (int o = 1; o < 64; o <<= 1) { const float pA = __shfl_up(sA, o), pB = __shfl_up(sB, o); if (lane >= o) { sB = fmaxf(pB + sA, sB); sA = pA + sA; } }
    float eA = __shfl_up(sA, 1), eB = __shfl_up(sB, 1); if (lane == 0) { eA = 0.f; eB = -INFINITY; }
    const float m_in = fmaxf(0.f + eA, eB);
    float cA = A;
#pragma unroll
    for (int o = 1; o < 8; o <<= 1) { const float p = __shfl_up(cA, o); if ((lane & 7) >= o) cA += p; }
    const float b_in = cA - A;
    const float m_prev = __shfl(m_in, lane & ~7);
    float* DA = (float*)(ws + WS_DA) + (size_t)h * MA + (size_t)b * SEQ + lane * 32; float* DR = (float*)(ws + WS_DR) + (size_t)h * MA + (size_t)b * SEQ + lane * 32;
    float* DG = (float*)(ws + WS_DG) + (size_t)h * MA + (size_t)b * SEQ + lane * 32; float* DEM = (float*)(ws + WS_DEM) + (size_t)h * MA + (size_t)b * SEQ + lane * 32;
    float* DW = (float*)(ws + WS_DW) + (size_t)h * MA + (size_t)b * SEQ + lane * 32;
    float m = m_in, bb = b_in, a_last = 0.f;
    for (int i = 0; i < 32; ++i) { const float f = lf[i], l = li[i]; m = fmaxf(m + f, l); bb += f;
        a_last = bb - m; DA[i] = a_last; DR[i] = l - bb; DG[i] = __expf(bb + m_prev - m); DEM[i] = __expf(-m); }
    const float a_end = __shfl(a_last, lane | 7);
    for (int i = 0; i < 32; ++i) { const float f = lf[i]; (void)f; }
    { float bb2 = b_in; for (int i = 0; i < 32; ++i) { bb2 += lf[i]; DW[i] = __expf(a_end + (li[i] - bb2)); } }
    if (lane == 63) F.out[O_MP + bh] = m;
}

__device__ __forceinline__ void p9_final(const Ctx& F0) { Ctx F = F0; asm volatile("" : "+v"(F.tid), "+v"(F.lane));
    unsigned char* ws = F.ws; const bf16_t* GB = (const bf16_t*)(ws + WS_GB); const bf16_t* EB = (const bf16_t*)(ws + WS_EB);
    const float* pleg = F.in[27]; const float* fing = F.in[28];
    for (int r = F.gw; r < MP + MS; r += F.NGW) {
        float* xrow = r < MP ? F.out + O_Y + (size_t)r * DM : F.out + O_YS + (size_t)(r - MP) * DM;
        float x1[16], gg[16], ee[16]; const int c0 = F.lane * 16;
#pragma unroll
        for (int j = 0; j < 4; ++j) { const f32x4 v = *(const f32x4*)(xrow + c0 + 4 * j); x1[4 * j] = v.x; x1[4 * j + 1] = v.y; x1[4 * j + 2] = v.z; x1[4 * j + 3] = v.w; }
        { float t8[8]; unpack8(*(const u32x4*)(GB + (size_t)r * DM + c0), t8);
#pragma unroll
          for (int c = 0; c < 8; ++c) gg[c] = t8[c];
          unpack8(*(const u32x4*)(GB + (size_t)r * DM + c0 + 8), t8);
#pragma unroll
          for (int c = 0; c < 8; ++c) gg[8 + c] = t8[c];
          unpack8(*(const u32x4*)(EB + (size_t)r * DM + c0), t8);
#pragma unroll
          for (int c = 0; c < 8; ++c) ee[c] = t8[c];
          unpack8(*(const u32x4*)(EB + (size_t)r * DM + c0 + 8), t8);
#pragma unroll
          for (int c = 0; c < 8; ++c) ee[8 + c] = t8[c]; }
        float s = 0.f;
#pragma unroll
        for (int c = 0; c < 16; ++c) s += ee[c] * ee[c];
        s = wave_sum(s); const float rse = 1.0f / sqrtf(s * (1.f / DM) + EPS);
        float s2 = 0.f;
#pragma unroll
        for (int c = 0; c < 16; ++c) { x1[c] = x1[c] + gg[c] * (ee[c] * rse * pleg[c0 + c]); s2 += x1[c] * x1[c]; }
        s2 = wave_sum(s2); const float rs2 = 1.0f / sqrtf(s2 * (1.f / DM) + EPS);
#pragma unroll
        for (int j = 0; j < 4; ++j) { f32x4 v; v.x = x1[4 * j] * rs2 * fing[c0 + 4 * j]; v.y = x1[4 * j + 1] * rs2 * fing[c0 + 4 * j + 1]; v.z = x1[4 * j + 2] * rs2 * fing[c0 + 4 * j + 2]; v.w = x1[4 * j + 3] * rs2 * fing[c0 + 4 * j + 3];
            *(f32x4*)(xrow + c0 + 4 * j) = v; }
    }
}
#define MAKE_CTX() extern __shared__ __attribute__((aligned(16))) unsigned char lds_raw[]; \
    Ctx F; F.lds = (LAS unsigned char*)lds_raw; F.tid = threadIdx.x; F.lane = F.tid & 63; F.wave = __builtin_amdgcn_readfirstlane(F.tid >> 6); \
    F.G = gridDim.x; F.bid = blockIdx.x; F.gw = F.bid * 8 + F.wave; F.NGW = F.G * 8; F.in = args.in; F.out = args.out; F.ws = args.ws; unsigned char* ws = args.ws; (void)ws

template <int KIND> struct EpiBf16Act {
    static constexpr bool PERM = false, AFTER_DRAIN = false;
    bf16_t* O; int ldo; const float* bias; float scale;
    __device__ __forceinline__ void operator()(const f32x4 (&acc)[2][2][4][2], const Unit& u, int wr, int wc, int fr, int fq) const {
        const int row0 = u.pm * 256 + wr * 64 + fr, col0 = u.pn * 256 + wc * 32 + 4 * fq;
        f32x4 bv[2][2];
#pragma unroll
        for (int bj = 0; bj < 2; ++bj)
#pragma unroll
            for (int n = 0; n < 2; ++n) bv[bj][n] = bias ? *(const f32x4*)(bias + col0 + bj * 128 + 16 * n) : (f32x4){0.f, 0.f, 0.f, 0.f};
#pragma unroll
        for (int ai = 0; ai < 2; ++ai)
#pragma unroll
            for (int m = 0; m < 4; ++m) { bf16_t* rowp = O + (size_t)(row0 + ai * 128 + m * 16) * ldo + col0;
#pragma unroll
                for (int bj = 0; bj < 2; ++bj)
#pragma unroll
                    for (int n = 0; n < 2; ++n) { f32x4 v = acc[ai][bj][m][n] * scale + bv[bj][n];
                        if (KIND == 3) {
#pragma unroll
                            for (int j = 0; j < 4; ++j) v[j] = sigmoidf_(v[j]); }
                        u32x2 w; w.x = cvt_pk_bf16(v[0], v[1]); w.y = cvt_pk_bf16(v[2], v[3]); *(u32x2*)(rowp + bj * 128 + n * 16) = w; } }
    }
};
struct EpiOutProj {
    static constexpr bool PERM = false, AFTER_DRAIN = false;
    const float* xp; const float* xs; float* out; bf16_t* X1B;
    __device__ __forceinline__ void operator()(const f32x4 (&acc)[2][2][4][2], const Unit& u, int wr, int wc, int fr, int fq) const {
        const int row0 = u.pm * 256 + wr * 64 + fr, col0 = u.pn * 256 + wc * 32 + 4 * fq;
#pragma unroll
        for (int ai = 0; ai < 2; ++ai)
#pragma unroll
            for (int m = 0; m < 4; ++m) { const int row = row0 + ai * 128 + m * 16;
                const bool real = row < MP + MS;
                const float* xr = row < MP ? xp + (size_t)row * DM : xs + (size_t)(real ? row - MP : 0) * DM;
                float* orow = row < MP ? out + O_Y + (size_t)row * DM : out + O_YS + (size_t)(real ? row - MP : 0) * DM;
#pragma unroll
                for (int bj = 0; bj < 2; ++bj)
#pragma unroll
                    for (int n = 0; n < 2; ++n) { const int c = col0 + bj * 128 + n * 16; f32x4 v = acc[ai][bj][m][n];
                        if (real) { v = v + *(const f32x4*)(xr + c); *(f32x4*)(orow + c) = v; } else v = (f32x4){0.f, 0.f, 0.f, 0.f};
                        u32x2 w; w.x = cvt_pk_bf16(v[0], v[1]); w.y = cvt_pk_bf16(v[2], v[3]); *(u32x2*)(X1B + (size_t)row * DM + c) = w; } }
    }
};


struct EpiInProjNP {
    static constexpr bool PERM = false, AFTER_DRAIN = false;
    bf16_t* PA; bf16_t* PB; const float* rs;
    __device__ __forceinline__ void operator()(const f32x4 (&acc)[2][2][4][2], const Unit& u, int wr, int wc, int fr, int fq) const {
        const int row0 = u.pm * 256 + wr * 64 + fr, pn = u.pn; bf16_t* base = pn < 12 ? PA + pn * 256 : PB + (pn - 12) * 256; const int col0 = wc * 32 + 4 * fq;
        const int kind = pn < 8 ? 0 : ((pn < 12 || pn >= 20) ? 1 : (pn < 16 ? 2 : 3));
#pragma unroll
        for (int ai = 0; ai < 2; ++ai)
#pragma unroll
            for (int m = 0; m < 4; ++m) { const int row = row0 + ai * 128 + m * 16; const float s = rs[row];
#pragma unroll
                for (int bj = 0; bj < 2; ++bj)
#pragma unroll
                    for (int n = 0; n < 2; ++n) { f32x4 v = acc[ai][bj][m][n] * s;
#pragma unroll
                        for (int j = 0; j < 4; ++j) { float x = v[j]; if (kind == 0) { f32x2 g2 = gelu_pk((f32x2){x, x}); x = g2.x; } else if (kind == 1) x = siluf_(x); else if (kind == 3) x = sigmoidf_(x); v[j] = x; }
                        u32x2 w; w.x = cvt_pk_bf16(v[0], v[1]); w.y = cvt_pk_bf16(v[2], v[3]); *(u32x2*)(base + (size_t)row * 3072 + col0 + bj * 128 + n * 16) = w; } }
    }
};
__device__ __forceinline__ void p1_inproj(const Ctx& F) {
    unsigned char* ws = F.ws; Gemm g{DM, DM, DM};
    OrderRowMajor S{NTILE, 24, NTILE * 24, F.G, F.bid, (const char*)(ws + WS_XB), (const char*)(ws + WS_WIN), (size_t)256 * DM * 2, (size_t)256 * DM * 2};
    EpiInProjNP E{(bf16_t*)(ws + WS_PROJA), (bf16_t*)(ws + WS_PROJB), (const float*)(ws + WS_RS)};
    pg8::gemm_phase<EpiInProjNP, OrderRowMajor, false, false>(F.lds, g, S, E);
}
__device__ __forceinline__ void p7_outproj(const Ctx& F) {
    unsigned char* ws = F.ws; Gemm g{DMIX, DMIX, DMIX};
    OrderRowMajor S{NTILE, 4, NTILE * 4, F.G, F.bid, (const char*)(ws + WS_Y), (const char*)(ws + WS_WOUT), (size_t)256 * DMIX * 2, (size_t)256 * DMIX * 2};
    EpiOutProj E{F.in[0], F.in[1], F.out, (bf16_t*)(ws + WS_X1B)};
    pg8::gemm_phase<EpiOutProj, OrderRowMajor>(F.lds, g, S, E);
}
__device__ __forceinline__ void p8_ple(const Ctx& F) {
    unsigned char* ws = F.ws;
    { Gemm g{DM, DM, DM}; OrderRowMajor S{NTILE, 4, NTILE * 4, F.G, F.bid, (const char*)(ws + WS_X1B), (const char*)(ws + WS_WPG), (size_t)256 * DM * 2, (size_t)256 * DM * 2};
      EpiBf16Act<3> E{(bf16_t*)(ws + WS_GB), DM, F.in[25], 1.0f}; pg8::gemm_phase<EpiBf16Act<3>, OrderRowMajor>(F.lds, g, S, E); }
    { Gemm g{DPLE, DPLE, DPLE}; OrderRowMajor S{NTILE, 4, NTILE * 4, F.G, (F.bid + 128) & 255, (const char*)(ws + WS_PB), (const char*)(ws + WS_WPP), (size_t)256 * DPLE * 2, (size_t)256 * DPLE * 2};
      EpiBf16Act<0> E{(bf16_t*)(ws + WS_EB), DM, nullptr, 1.0f}; pg8::gemm_phase<EpiBf16Act<0>, OrderRowMajor>(F.lds, g, S, E); }
}
typedef float f32x4_t __attribute__((ext_vector_type(4)));
__device__ __forceinline__ void p2b_spatial(const Ctx& F0) { Ctx F = F0; asm volatile("" : "+v"(F.tid), "+v"(F.lane));
    unsigned char* ws = F.ws;
    const bf16_t* PA = (const bf16_t*)(ws + WS_PROJA); const bf16_t* WSP = (const bf16_t*)(ws + WS_WSP); bf16_t* Y = (bf16_t*)(ws + WS_Y);
    const float* lng = F.in[10]; const float* lnb = F.in[11]; const float* bsp = F.in[13];
    LAS bf16_t* vnT = (LAS bf16_t*)F.lds;
    const int lane = F.lane, w = F.wave, l15 = lane & 15, lq = lane >> 4;
    for (int unit = F.bid; unit < NB * 16 * HA; unit += F.G) {
        const int b = unit >> 7, c = (unit >> 3) & 15, h = unit & 7, r0 = b * SEQ + c * 128;
        const float g0 = lng[h * 128 + 2 * lane], g1 = lng[h * 128 + 2 * lane + 1], b0 = lnb[h * 128 + 2 * lane], b1 = lnb[h * 128 + 2 * lane + 1];
#pragma unroll 2
        for (int p = 0; p < 8; ++p) { const int s0 = w * 16 + 2 * p;
            const unsigned wa = *(const unsigned*)(PA + (size_t)(r0 + s0) * 3072 + 1024 + h * 128 + 2 * lane), wb = *(const unsigned*)(PA + (size_t)(r0 + s0 + 1) * 3072 + 1024 + h * 128 + 2 * lane);
            float a0 = bf_lo(wa), a1 = bf_hi(wa), c0 = bf_lo(wb), c1 = bf_hi(wb);
            const float mua = wave_sum(a0 + a1) * (1.f / 128.f), mub = wave_sum(c0 + c1) * (1.f / 128.f);
            a0 -= mua; a1 -= mua; c0 -= mub; c1 -= mub;
            const float ra = 1.0f / sqrtf(wave_sum(a0 * a0 + a1 * a1) * (1.f / 128.f) + EPS), rb = 1.0f / sqrtf(wave_sum(c0 * c0 + c1 * c1) * (1.f / 128.f) + EPS);
            *(LAS unsigned*)(vnT + (2 * lane) * 136 + s0) = cvt_pk_bf16(a0 * ra * g0 + b0, c0 * rb * g0 + b0);
            *(LAS unsigned*)(vnT + (2 * lane + 1) * 136 + s0) = cvt_pk_bf16(a1 * ra * g1 + b1, c1 * rb * g1 + b1); }
        __syncthreads();
        const int t0 = 16 * w, nks = (t0 + 15) / 32 + 1;
        f32x4 acc[8];
#pragma unroll
        for (int nb = 0; nb < 8; ++nb) acc[nb] = (f32x4){0.f, 0.f, 0.f, 0.f};
        for (int ks = 0; ks < nks; ++ks) { const int k0 = ks * 32;
            const bf16x8 wf = *(const bf16x8*)(WSP + ((size_t)h * 128 + t0 + l15) * 128 + k0 + 8 * lq);
#pragma unroll
            for (int nb = 0; nb < 8; ++nb) { const bf16x8 vf = *(const LAS bf16x8*)(vnT + (nb * 16 + l15) * 136 + k0 + 8 * lq);
                acc[nb] = __builtin_amdgcn_mfma_f32_16x16x32_bf16(vf, wf, acc[nb], 0, 0, 0); } }
        const int t = t0 + l15; const float bt = bsp[h * 128 + t]; const size_t row = (size_t)(r0 + t);
#pragma unroll
        for (int nb = 0; nb < 8; ++nb) { const int d = nb * 16 + 4 * lq;
            const u32x2 uu = *(const u32x2*)(PA + row * 3072 + h * 128 + d), zz = *(const u32x2*)(PA + row * 3072 + 2048 + h * 128 + d);
            u32x2 o; o.x = cvt_pk_bf16(bf_lo(uu.x) * (acc[nb][0] + bt) * bf_lo(zz.x), bf_hi(uu.x) * (acc[nb][1] + bt) * bf_hi(zz.x));
            o.y = cvt_pk_bf16(bf_lo(uu.y) * (acc[nb][2] + bt) * bf_lo(zz.y), bf_hi(uu.y) * (acc[nb][3] + bt) * bf_hi(zz.y));
            *(u32x2*)(Y + row * DMIX + h * 128 + d) = o; }
        __syncthreads();
    }
    if (F.bid < 32 && F.wave == 0) mscan_wave(F, F.bid);
}

struct OrderHeadRows {
    int n, G, c; const char* A; size_t astep; const char* B; int pm0;
    __device__ __forceinline__ bool next(int i, Unit& u) const { const int L = i * G + c; if (L >= n) return false;
        u.pm = pm0 + (L >> 2); u.pn = 0; u.aux = L & 3; u.a = A + (size_t)u.pm * astep + (size_t)u.aux * 512; u.b = B + (size_t)u.aux * 131072; return true; }
};
struct OrderHeadT {
    int n, G, c; const char* W; const char* X; size_t xstep;
    __device__ __forceinline__ bool next(int i, Unit& u) const { const int L = i * G + c; if (L >= n) return false;
        const int b = L >> 5, h = (L >> 3) & 3, cc = L & 7; u.pm = b * 8 + cc; u.pn = L; u.aux = h; u.a = W + (size_t)h * 131072; u.b = X + (size_t)u.pm * xstep + (size_t)h * 512; return true; }
};
struct EpiQ {
    static constexpr bool PERM = false, AFTER_DRAIN = false;
    bf16_t* Q; bf16_t* PQ; const float* DG;
    __device__ __forceinline__ void operator()(const f32x4 (&acc)[2][2][4][2], const Unit& u, int wr, int wc, int fr, int fq) const {
        const int h = u.aux, rl0 = wr * 64 + fr, col0 = wc * 32 + 4 * fq; const bool prompt = u.pm < 64;
        const int unit = ((u.pm >> 3) * 4 + h) * 8 + (u.pm & 7);
#pragma unroll
        for (int ai = 0; ai < 2; ++ai)
#pragma unroll
            for (int m = 0; m < 4; ++m) { const int rl = rl0 + ai * 128 + m * 16, row = u.pm * 256 + rl;
#pragma unroll
                for (int bj = 0; bj < 2; ++bj)
#pragma unroll
                    for (int n = 0; n < 2; ++n) { const int c = col0 + bj * 128 + n * 16; const f32x4 v = acc[ai][bj][m][n];
                        u32x2 w; w.x = cvt_pk_bf16(v[0], v[1]); w.y = cvt_pk_bf16(v[2], v[3]); *(u32x2*)(Q + (size_t)row * 1024 + h * 256 + c) = w; }
                asm volatile("" ::: "memory"); }
        if (prompt) {
#pragma unroll
        for (int ai = 0; ai < 2; ++ai)
#pragma unroll
            for (int m = 0; m < 4; ++m) { const int rl = rl0 + ai * 128 + m * 16, row = u.pm * 256 + rl; const float g = DG[(size_t)h * MA + row];
#pragma unroll
                for (int bj = 0; bj < 2; ++bj)
#pragma unroll
                    for (int n = 0; n < 2; ++n) { const int c = col0 + bj * 128 + n * 16; const f32x4 v = acc[ai][bj][m][n] * g;
                        u32x2 w2; w2.x = cvt_pk_bf16(v[0], v[1]); w2.y = cvt_pk_bf16(v[2], v[3]); *(u32x2*)(PQ + ((size_t)unit * 256 + rl) * 512 + 256 + c) = w2; }
                asm volatile("" ::: "memory"); } }
    }
};
struct EpiHeadPlain {
    static constexpr bool PERM = false, AFTER_DRAIN = false;
    bf16_t* O; float scale; int row_off;
    __device__ __forceinline__ void operator()(const f32x4 (&acc)[2][2][4][2], const Unit& u, int wr, int wc, int fr, int fq) const {
        const int h = u.aux, row0 = u.pm * 256 - row_off + wr * 64 + fr, col0 = h * 256 + wc * 32 + 4 * fq;
#pragma unroll
        for (int ai = 0; ai < 2; ++ai)
#pragma unroll
            for (int m = 0; m < 4; ++m) { bf16_t* rowp = O + (size_t)(row0 + ai * 128 + m * 16) * 1024 + col0;
#pragma unroll
                for (int bj = 0; bj < 2; ++bj)
#pragma unroll
                    for (int n = 0; n < 2; ++n) { const f32x4 v = acc[ai][bj][m][n] * scale; u32x2 w; w.x = cvt_pk_bf16(v[0], v[1]); w.y = cvt_pk_bf16(v[2], v[3]); *(u32x2*)(rowp + bj * 128 + n * 16) = w; } }
    }
};
struct EpiUnitT {
    static constexpr bool PERM = false, AFTER_DRAIN = false;
    bf16_t* O; int ldo; const float* cs; float scale;
    __device__ __forceinline__ void operator()(const f32x4 (&acc)[2][2][4][2], const Unit& u, int wr, int wc, int fr, int fq) const {
        const int h = u.aux, rl0 = wr * 64 + fr, col0 = wc * 32 + 4 * fq; bf16_t* base = O + (size_t)u.pn * 256 * ldo;
#pragma unroll
        for (int ai = 0; ai < 2; ++ai)
#pragma unroll
            for (int m = 0; m < 4; ++m) { bf16_t* rowp = base + (size_t)(rl0 + ai * 128 + m * 16) * ldo + col0;
#pragma unroll
                for (int bj = 0; bj < 2; ++bj)
#pragma unroll
                    for (int n = 0; n < 2; ++n) { const f32x4 scv = cs ? *(const f32x4*)(cs + (size_t)h * MA + u.pm * 256 + col0 + bj * 128 + n * 16) * scale : (f32x4){scale, scale, scale, scale}; const f32x4 v = acc[ai][bj][m][n] * scv; u32x2 w; w.x = cvt_pk_bf16(v[0], v[1]); w.y = cvt_pk_bf16(v[2], v[3]); *(u32x2*)(rowp + bj * 128 + n * 16) = w; } }
    }
};
__device__ __forceinline__ void p3_qkv(const Ctx& F) {
    unsigned char* ws = F.ws; const char* XC = (const char*)(ws + WS_XB); const char* PBX = (const char*)(ws + WS_PROJB);
    { Gemm g{DM, 256, 256}; OrderHeadRows S{NTILE * 4, F.G, F.bid, XC, (size_t)256 * DM * 2, (const char*)(ws + WS_WQ), 0};
      EpiQ E{(bf16_t*)(ws + WS_Q), (bf16_t*)(ws + WS_PQ), (const float*)(ws + WS_DG)}; pg8::gemm_phase<EpiQ, OrderHeadRows>(F.lds, g, S, E); }
    { Gemm g{DM, 256, 256}; OrderHeadRows S{NTILE * 4, F.G, (F.bid + 4) & 255, XC, (size_t)256 * DM * 2, (const char*)(ws + WS_WK), 0};
      EpiHeadPlain E{(bf16_t*)(ws + WS_K), 0.0625f, 0}; pg8::gemm_phase<EpiHeadPlain, OrderHeadRows>(F.lds, g, S, E); }
    { Gemm g{3072, 256, 256}; OrderHeadRows S{4, F.G, (F.bid + 248) & 255, PBX, (size_t)256 * 3072 * 2, (const char*)(ws + WS_WV), 64};
      EpiHeadPlain E{(bf16_t*)(ws + WS_VS), 1.0f, MP}; pg8::gemm_phase<EpiHeadPlain, OrderHeadRows>(F.lds, g, S, E); }
    { Gemm g{256, 3072, 256}; OrderHeadT S{NUNIT, F.G, F.bid, (const char*)(ws + WS_WV), PBX, (size_t)256 * 3072 * 2};
      EpiUnitT E{(bf16_t*)(ws + WS_VC), 512, nullptr, 1.0f}; pg8::gemm_phase<EpiUnitT, OrderHeadT>(F.lds, g, S, E); }
    { Gemm g{256, DM, 256}; OrderHeadT S{NUNIT, F.G, F.bid, (const char*)(ws + WS_WK), XC, (size_t)256 * DM * 2};
      EpiUnitT E{(bf16_t*)(ws + WS_WKT), 256, (const float*)(ws + WS_DW), 0.0625f}; pg8::gemm_phase<EpiUnitT, OrderHeadT>(F.lds, g, S, E); }
}

struct OrderUnitNT {
    int n, G, c; const char* A; size_t astep_pm, astep_h, astep_u; const char* B; size_t bstep_pm, bstep_h, bstep_u;
    __device__ __forceinline__ bool next(int i, Unit& u) const { const int L = i * G + c; if (L >= n) return false;
        const int b = L >> 5, h = (L >> 3) & 3, cc = L & 7; u.pm = b * 8 + cc; u.pn = L; u.aux = h;
        u.a = A + (size_t)u.pm * astep_pm + (size_t)h * astep_h + (size_t)L * astep_u; u.b = B + (size_t)u.pm * bstep_pm + (size_t)h * bstep_h + (size_t)L * bstep_u; return true; }
};
struct EpiScore {
    static constexpr bool PERM = false, AFTER_DRAIN = false;
    bf16_t* PQ; const float* DA; const float* DR; float* DENP;
    __device__ __forceinline__ void operator()(const f32x4 (&acc)[2][2][4][2], const Unit& u, int wr, int wc, int fr, int fq) const {
        const int h = u.aux, rl0 = wr * 64 + fr, col0 = wc * 32 + 4 * fq; const size_t vb = (size_t)h * MA + (size_t)u.pm * 256;
#pragma unroll
        for (int ai = 0; ai < 2; ++ai)
#pragma unroll
            for (int m = 0; m < 4; ++m) { int t_ = rl0 + ai * 128 + m * 16; asm volatile("" : "+v"(t_)); const int t = t_; const float at = DA[vb + t]; float rs_ = 0.f; bf16_t* rowp = PQ + ((size_t)u.pn * 256 + t) * 512 + col0;
#pragma unroll
                for (int bj = 0; bj < 2; ++bj)
#pragma unroll
                    for (int n = 0; n < 2; ++n) { const int c = col0 + bj * 128 + n * 16; f32x4 v; const f32x4 rr = *(const f32x4*)(DR + vb + c);
#pragma unroll
                        for (int j = 0; j < 4; ++j) { const float e = fast_exp(fminf(at + rr[j], 0.f)); v[j] = (c + j <= t) ? acc[ai][bj][m][n][j] * e : 0.f; rs_ += v[j]; }
                        u32x2 w; w.x = cvt_pk_bf16(v[0], v[1]); w.y = cvt_pk_bf16(v[2], v[3]); *(u32x2*)(rowp + bj * 128 + n * 16) = w; }
                rs_ += __shfl_xor(rs_, 16); rs_ += __shfl_xor(rs_, 32);
                if (fq == 0) DENP[(vb + t) * 4 + wc] = rs_; asm volatile("" ::: "memory"); }
    }
};
struct EpiF32Unit {
    static constexpr bool PERM = false, AFTER_DRAIN = false;
    float* O;
    __device__ __forceinline__ void operator()(const f32x4 (&acc)[2][2][4][2], const Unit& u, int wr, int wc, int fr, int fq) const {
        float* base = O + (size_t)u.pn * 65536 + (size_t)(wr * 64 + fr) * 256 + wc * 32 + 4 * fq;
#pragma unroll
        for (int ai = 0; ai < 2; ++ai)
#pragma unroll
            for (int m = 0; m < 4; ++m)
#pragma unroll
                for (int bj = 0; bj < 2; ++bj)
#pragma unroll
                    for (int n = 0; n < 2; ++n) *(f32x4*)(base + (size_t)(ai * 128 + m * 16) * 256 + bj * 128 + n * 16) = acc[ai][bj][m][n];
    }
};
__device__ __forceinline__ void p4_scores_dc(const Ctx& F) {
    unsigned char* ws = F.ws;
    { Gemm g{DM, DM, 256}; OrderUnitNT S{NUNIT, F.G, F.bid, (const char*)(ws + WS_Q), (size_t)256 * DM * 2, 512, 0, (const char*)(ws + WS_K), (size_t)256 * DM * 2, 512, 0};
      EpiScore E{(bf16_t*)(ws + WS_PQ), (const float*)(ws + WS_DA), (const float*)(ws + WS_DR), (float*)(ws + WS_DENP)}; pg8::gemm_phase<EpiScore, OrderUnitNT>(F.lds, g, S, E); }
    { Gemm g{512, 256, 256}; OrderUnitNT S{NUNIT, F.G, F.bid, (const char*)(ws + WS_VC), 0, 0, (size_t)256 * 512 * 2, (const char*)(ws + WS_WKT), 0, 0, (size_t)256 * 256 * 2};
      EpiF32Unit E{F.out + O_Y}; pg8::gemm_phase<EpiF32Unit, OrderUnitNT>(F.lds, g, S, E); }
    for (int u = F.bid; u < NUNIT; u += F.G) { const int d = F.tid >> 1, hf = F.tid & 1; const bf16_t* src = (const bf16_t*)(ws + WS_WKT) + ((size_t)u * 256 + d) * 256 + hf * 128; float s = 0.f;
#pragma unroll
        for (int j = 0; j < 16; ++j) { float t8[8]; unpack8(*(const u32x4*)(src + j * 8), t8);
#pragma unroll
            for (int e = 0; e < 8; ++e) s += t8[e]; }
        s += __shfl_xor(s, 1); if (hf == 0) ((float*)(ws + WS_DN))[(size_t)u * 256 + d] = s; }
}

__device__ __forceinline__ void p5_scan_sample(const Ctx& F0) { Ctx F = F0; asm volatile("" : "+v"(F.tid), "+v"(F.lane));
    unsigned char* ws = F.ws; const float* DG = (const float*)(ws + WS_DG); const float* DC = F.out + O_Y; bf16_t* VC = (bf16_t*)(ws + WS_VC);
    for (int idx = F.bid * 512 + F.tid; idx < 32 * 16384; idx += F.G * 512) { const int bh = idx >> 14, q4 = idx & 16383, e = q4 >> 6, d4 = (q4 & 63) * 4, b = bh >> 2, h = bh & 3;
        f32x4 dc[8]; float ge[8];
#pragma unroll
        for (int c = 0; c < 8; ++c) { dc[c] = *(const f32x4*)(DC + ((size_t)(bh * 8 + c) * 256 + e) * 256 + d4); ge[c] = DG[(size_t)h * MA + b * SEQ + c * 256 + 255]; }
        f32x4 C = (f32x4){0.f, 0.f, 0.f, 0.f};
#pragma unroll
        for (int c = 0; c < 8; ++c) { u32x2 w; w.x = cvt_pk_bf16(C[0], C[1]); w.y = cvt_pk_bf16(C[2], C[3]); *(u32x2*)(VC + ((size_t)(bh * 8 + c) * 256 + e) * 512 + 256 + d4) = w; C = C * ge[c] + dc[c]; }
        *(f32x4*)(F.out + O_CP + ((size_t)bh * 256 + e) * 256 + d4) = C; }
    LAS float* npv = (LAS float*)F.lds;
    for (int u = F.bid; u < NUNIT; u += F.G) { const int bh = u >> 3, cc = u & 7, b = bh >> 2, h = bh & 3;
        __syncthreads();
        if (F.tid < 256) { float n = 0.f; const float* DN = (const float*)(ws + WS_DN);
            for (int j = 0; j < cc; ++j) n = DG[(size_t)h * MA + b * SEQ + j * 256 + 255] * n + DN[(size_t)(bh * 8 + j) * 256 + F.tid];
            npv[F.tid] = n; if (cc == 7) F.out[O_NP + (size_t)bh * 256 + F.tid] = DG[(size_t)h * MA + b * SEQ + 7 * 256 + 255] * n + DN[(size_t)u * 256 + F.tid]; }
        __syncthreads();
        const f32x4 nv = *(const LAS f32x4*)(npv + 4 * F.lane); const bf16_t* Q = (const bf16_t*)(ws + WS_Q);
        for (int r = 0; r < 32; ++r) { const size_t row = (size_t)b * SEQ + cc * 256 + F.wave * 32 + r; const u32x2 qq = *(const u32x2*)(Q + row * 1024 + h * 256 + 4 * F.lane);
            const float s = wave_sum(bf_lo(qq.x) * nv[0] + bf_hi(qq.x) * nv[1] + bf_lo(qq.y) * nv[2] + bf_hi(qq.y) * nv[3]); if (F.lane == 0) ((float*)(ws + WS_QN))[(size_t)h * MA + row] = s; } }
    LAS float* hs = (LAS float*)F.lds + 512; LAS float* red = (LAS float*)F.lds + 1024;
    for (int job = F.bid; job < MS * HB; job += F.G) { const int i = job >> 2, h = job & 3; const size_t row = MP + i;
        const bf16_t* Q = (const bf16_t*)(ws + WS_Q) + row * 1024 + h * 256; const bf16_t* K = (const bf16_t*)(ws + WS_K) + row * 1024 + h * 256; const bf16_t* V = (const bf16_t*)(ws + WS_VS) + (size_t)i * 1024 + h * 256;
        const u32x2 qw = *(const u32x2*)(Q + 4 * F.lane), kw = *(const u32x2*)(K + 4 * F.lane);
        const f32x4 q4 = (f32x4){bf_lo(qw.x), bf_hi(qw.x), bf_lo(qw.y), bf_hi(qw.y)}, k4 = (f32x4){bf_lo(kw.x), bf_hi(kw.x), bf_lo(kw.y), bf_hi(kw.y)};
        const f32x4 n0 = *(const f32x4*)(F.in[3] + ((size_t)i * 4 + h) * 256 + 4 * F.lane);
        const float li = ((const float*)(ws + WS_GLI))[(size_t)h * MA + row], lf = ((const float*)(ws + WS_GLF))[(size_t)h * MA + row], m0 = F.in[4][i * 4 + h];
        const float mn = fmaxf(lf + m0, li), g = __expf(lf + m0 - mn), wi = __expf(li - mn);
        const float qk = wave_sum(q4[0] * k4[0] + q4[1] * k4[1] + q4[2] * k4[2] + q4[3] * k4[3]), nq = wave_sum(n0[0] * q4[0] + n0[1] * q4[1] + n0[2] * q4[2] + n0[3] * q4[3]);
        const float sc = wi * qk, den = sc + g * nq, dinv = 1.0f / fmaxf(fabsf(den), __expf(-mn));
        const float* C0 = F.in[2] + (((size_t)i * 4 + h) * 256 + F.wave * 32) * 256 + 4 * F.lane; float* C1 = F.out + O_CS + (((size_t)i * 4 + h) * 256 + F.wave * 32) * 256 + 4 * F.lane;
        __syncthreads();
#pragma unroll 1
        for (int r8 = 0; r8 < 32; r8 += 8) { f32x4 c[8]; float ve[8], cq[8];
#pragma unroll
            for (int r = 0; r < 8; ++r) { c[r] = *(const f32x4*)(C0 + (size_t)(r8 + r) * 256); ve[r] = bf2f(V[F.wave * 32 + r8 + r]); }
#pragma unroll
            for (int r = 0; r < 8; ++r) { cq[r] = c[r][0] * q4[0] + c[r][1] * q4[1] + c[r][2] * q4[2] + c[r][3] * q4[3]; const float wv = wi * ve[r]; *(f32x4*)(C1 + (size_t)(r8 + r) * 256) = c[r] * g + k4 * wv; }
#pragma unroll
            for (int r = 0; r < 8; ++r) { cq[r] = wave_sum(cq[r]); if (F.lane == 0) hs[F.wave * 32 + r8 + r] = (sc * ve[r] + g * cq[r]) * dinv; } }
        if (F.wave == 0) { *(f32x4*)(F.out + O_NS + ((size_t)i * 4 + h) * 256 + 4 * F.lane) = n0 * g + k4 * wi; if (F.lane == 0) F.out[O_MS + i * 4 + h] = mn; }
        __syncthreads();
        const bf16_t* PB = (const bf16_t*)(ws + WS_PROJB) + row * 3072; const bf16_t* XC = (const bf16_t*)(ws + WS_XB) + row * DM;
        float x = 0.f; const int ch = h * 256 + (F.tid & 255);
        if (F.tid < 256) x = hs[F.tid] * bf2f(PB[1024 + ch]);
        float p = wave_sum(x); if (F.lane == 0) red[F.wave] = p;
        __syncthreads();
        const float mu = (red[0] + red[1] + red[2] + red[3]) * (1.f / 256.f), dx = x - mu;
        __syncthreads();
        p = wave_sum(F.tid < 256 ? dx * dx : 0.f); if (F.lane == 0) red[F.wave] = p;
        __syncthreads();
        const float rstd = 1.0f / sqrtf((red[0] + red[1] + red[2] + red[3]) * (1.f / 256.f) + EPS);
        if (F.tid < 256) ((bf16_t*)(ws + WS_Y))[row * DMIX + 1024 + ch] = f2bf((dx * rstd * F.in[21][ch] + F.in[22][ch] * bf2f(XC[ch])) * bf2f(PB[2048 + ch]));
        __syncthreads();
    }
}

struct EpiHOut {
    static constexpr bool PERM = false, AFTER_DRAIN = true;
    const float* DENP; const float* DG; const float* QN; const float* DEM; const bf16_t* PB; const bf16_t* XC; bf16_t* Y; const float* gng; const float* skip;
    __device__ __forceinline__ void fused(f32x4 (&acc)[2][2][4][2], const Unit& u, int wr, int wc, int fr, int fq, LAS unsigned char* lds, int wid, int lane) const {
        const int h = u.aux, rl0 = wr * 64 + fr, col0 = wc * 32 + 4 * fq; const size_t vb = (size_t)h * MA + (size_t)u.pm * 256;
        LAS float* P1 = (LAS float*)lds; LAS float* P2 = (LAS float*)lds + 1024;
#pragma unroll
        for (int ai = 0; ai < 2; ++ai)
#pragma unroll
            for (int m = 0; m < 4; ++m) { const int t = rl0 + ai * 128 + m * 16; const size_t row = (size_t)u.pm * 256 + t;
                const f32x4 dp = *(const f32x4*)(DENP + (vb + t) * 4); const float den = (dp[0] + dp[1]) + (dp[2] + dp[3]) + DG[vb + t] * QN[vb + t];
                const float dinv = 1.0f / fmaxf(fabsf(den), DEM[vb + t]); float s = 0.f;
#pragma unroll
                for (int bj = 0; bj < 2; ++bj)
#pragma unroll
                    for (int n = 0; n < 2; ++n) { const int c = col0 + bj * 128 + n * 16; const u32x2 ow = *(const u32x2*)(PB + row * 3072 + 1024 + h * 256 + c);
                        f32x4 v = acc[ai][bj][m][n] * dinv; v[0] *= bf_lo(ow.x); v[1] *= bf_hi(ow.x); v[2] *= bf_lo(ow.y); v[3] *= bf_hi(ow.y); acc[ai][bj][m][n] = v; s += (v[0] + v[1]) + (v[2] + v[3]); }
                s += __shfl_xor(s, 16); s += __shfl_xor(s, 32); if (fq == 0) P1[t * 4 + wc] = s; }
        asm volatile("s_waitcnt lgkmcnt(0)" ::: "memory"); __builtin_amdgcn_s_barrier(); asm volatile("" ::: "memory");
#pragma unroll
        for (int ai = 0; ai < 2; ++ai)
#pragma unroll
            for (int m = 0; m < 4; ++m) { const int t = rl0 + ai * 128 + m * 16; const f32x4 ps = *(const LAS f32x4*)(P1 + t * 4); const float mu = ((ps[0] + ps[1]) + (ps[2] + ps[3])) * (1.f / 256.f); float q = 0.f;
#pragma unroll
                for (int bj = 0; bj < 2; ++bj)
#pragma unroll
                    for (int n = 0; n < 2; ++n) { f32x4 v = acc[ai][bj][m][n] - mu; acc[ai][bj][m][n] = v; q += (v[0] * v[0] + v[1] * v[1]) + (v[2] * v[2] + v[3] * v[3]); }
                q += __shfl_xor(q, 16); q += __shfl_xor(q, 32); if (fq == 0) P2[t * 4 + wc] = q; }
        asm volatile("s_waitcnt lgkmcnt(0)" ::: "memory"); __builtin_amdgcn_s_barrier(); asm volatile("" ::: "memory");
#pragma unroll
        for (int ai = 0; ai < 2; ++ai)
#pragma unroll
            for (int m = 0; m < 4; ++m) { const int t = rl0 + ai * 128 + m * 16; const size_t row = (size_t)u.pm * 256 + t; const f32x4 ps = *(const LAS f32x4*)(P2 + t * 4);
                const float rstd = 1.0f / sqrtf(((ps[0] + ps[1]) + (ps[2] + ps[3])) * (1.f / 256.f) + EPS);
#pragma unroll
                for (int bj = 0; bj < 2; ++bj)
#pragma unroll
                    for (int n = 0; n < 2; ++n) { const int c = h * 256 + col0 + bj * 128 + n * 16; const u32x2 xw = *(const u32x2*)(XC + row * DM + c), zw = *(const u32x2*)(PB + row * 3072 + 2048 + c);
                        const f32x4 ggv = *(const f32x4*)(gng + c), skv = *(const f32x4*)(skip + c); const f32x4 v = acc[ai][bj][m][n] * rstd * ggv; u32x2 w;
                        w.x = cvt_pk_bf16((v[0] + skv[0] * bf_lo(xw.x)) * bf_lo(zw.x), (v[1] + skv[1] * bf_hi(xw.x)) * bf_hi(zw.x));
                        w.y = cvt_pk_bf16((v[2] + skv[2] * bf_lo(xw.y)) * bf_lo(zw.y), (v[3] + skv[3] * bf_hi(xw.y)) * bf_hi(zw.y));
                        *(u32x2*)(Y + row * DMIX + 1024 + c) = w; }
                asm volatile("" ::: "memory"); }
    }
};
__device__ __forceinline__ void p6_hout(const Ctx& F) {
    unsigned char* ws = F.ws; Gemm g{512, 512, 512};
    OrderUnitNT S{NUNIT, F.G, F.bid, (const char*)(ws + WS_PQ), 0, 0, (size_t)256 * 512 * 2, (const char*)(ws + WS_VC), 0, 0, (size_t)256 * 512 * 2};
    EpiHOut E{(const float*)(ws + WS_DENP), (const float*)(ws + WS_DG), (const float*)(ws + WS_QN), (const float*)(ws + WS_DEM), (const bf16_t*)(ws + WS_PROJB), (const bf16_t*)(ws + WS_XB), (bf16_t*)(ws + WS_Y), F.in[21], F.in[22]};
    pg8::gemm_phase<EpiHOut, OrderUnitNT, false, true>(F.lds, g, S, E);
}
#define XB_TMO      128
#define XB_XCNT(j)  (256  + 64 * (j))
#define XB_XSUB(j)  (1280 + 64 * (j))
#define XB_XGEN(j)  (2304 + 64 * (j))
#define XB_TOP      3328
#define XB_TOPGEN   3392
#define XCD_BAR_WORDS 3456
#define XB_SPIN_CAP (1u << 18)
__device__ __forceinline__ unsigned xb_ld(unsigned* p)              { return __hip_atomic_load(p, __ATOMIC_RELAXED, __HIP_MEMORY_SCOPE_AGENT); }
__device__ __forceinline__ unsigned xb_add(unsigned* p, unsigned v) { return __hip_atomic_fetch_add(p, v, __ATOMIC_RELAXED, __HIP_MEMORY_SCOPE_AGENT); }
__device__ __forceinline__ unsigned xb_xcc_id() { return (unsigned)__builtin_amdgcn_s_getreg((3 << 11) | 20) & 0xFu; }
#define XB_SPIN(cond, bar) do { unsigned _sp = 0; while (cond) { __builtin_amdgcn_s_sleep(1); \
    if ((++_sp & 255u) == 0u) { if (xb_ld(&(bar)[XB_TMO])) break; if (_sp > XB_SPIN_CAP) { atomicAdd(&(bar)[XB_TMO], 1u); break; } } } } while (0)
struct XcdBarrier { unsigned* bar; unsigned x; volatile LAS unsigned* st; };
__device__ __forceinline__ XcdBarrier xcd_barrier_post(unsigned* bar, volatile LAS unsigned* st) {
    XcdBarrier b; b.bar = bar; b.x = xb_xcc_id(); b.st = st;
    if (threadIdx.x == 0) (void)xb_add(&bar[XB_XCNT(b.x)], 1u);
    return b;
}
__device__ __forceinline__ void xcd_barrier_complete(unsigned* bar, unsigned x, unsigned& nloc, unsigned& nx) {
    const unsigned G = gridDim.x * gridDim.y * gridDim.z;
    unsigned sum, cnt, mine, sp = 0u;
    for (;;) {
        sum = 0u; cnt = 0u; mine = 0u;
#pragma unroll
        for (unsigned j = 0; j < 16; ++j) { const unsigned c = xb_ld(&bar[XB_XCNT(j)]); sum += c; cnt += (c > 0u) ? 1u : 0u; mine = (j == x) ? c : mine; }
        if (sum == G) break;
        __builtin_amdgcn_s_sleep(1);
        if ((++sp & 255u) == 0u) { if (xb_ld(&bar[XB_TMO])) break; if (sp > XB_SPIN_CAP) { atomicAdd(&bar[XB_TMO], 1u); break; } }
    }
    nloc = mine > 0u ? mine : 1u; nx = cnt > 0u ? cnt : 1u;
}
__device__ __forceinline__ void xcd_barrier(const XcdBarrier& b) {
    asm volatile("s_waitcnt vmcnt(0)" ::: "memory");
    __syncthreads();
    if (threadIdx.x == 0) {
        unsigned* bar = b.bar;
        __builtin_amdgcn_s_waitcnt(0);
        unsigned nloc = b.st[0], nx = b.st[1];
        if (nloc == 0u) { xcd_barrier_complete(bar, b.x, nloc, nx); b.st[0] = nloc; b.st[1] = nx; }
        const unsigned old = xb_add(&bar[XB_XSUB(b.x)], 1u);
        const unsigned gen = old / nloc;
        if (old + 1u == (gen + 1u) * nloc) {
            __builtin_amdgcn_fence(__ATOMIC_RELEASE, "agent");
            asm volatile("s_waitcnt vmcnt(0)" ::: "memory");
            const unsigned og = xb_add(&bar[XB_TOP], 1u);
            const unsigned tg = og / nx;
            if (og + 1u == (tg + 1u) * nx) xb_add(&bar[XB_TOPGEN], 1u);
            else XB_SPIN(xb_ld(&bar[XB_TOPGEN]) == tg, bar);
            __builtin_amdgcn_fence(__ATOMIC_ACQUIRE, "agent");
            xb_add(&bar[XB_XGEN(b.x)], 1u);
            asm volatile("s_waitcnt vmcnt(0)" ::: "memory");
        } else {
            XB_SPIN(xb_ld(&bar[XB_XGEN(b.x)]) == gen, bar);
            __builtin_amdgcn_fence(__ATOMIC_ACQUIRE, "agent");
            asm volatile("s_waitcnt vmcnt(0)" ::: "memory");
        }
    }
    __syncthreads();
}
__global__ void __launch_bounds__(512, 2) mega(Args args) {
    MAKE_CTX();
    volatile LAS unsigned* MISC = (volatile LAS unsigned*)(F.lds + 131072 + 320);
    if (F.tid < 32) MISC[F.tid] = 0u;
    __syncthreads();
    const XcdBarrier bar = xcd_barrier_post((unsigned*)(ws + WS_CTL), MISC + 8);
#define GRID_SYNC() xcd_barrier(bar)
    p0_prologue(F);      GRID_SYNC();
    p1_inproj(F);        GRID_SYNC();
    p2a_conv_gates(F);   GRID_SYNC();
    p2b_spatial(F);      GRID_SYNC();
    p3_qkv(F);           GRID_SYNC();
    p4_scores_dc(F);     GRID_SYNC();
    p5_scan_sample(F);   GRID_SYNC();
    p6_hout(F);          GRID_SYNC();
    p7_outproj(F);       GRID_SYNC();
    p8_ple(F);           GRID_SYNC();
    p9_final(F);
}

extern "C" void kernel_launch(void* const* d_in, const int* in_sizes, int n_in, void* d_out, int out_size, void* d_ws, size_t ws_size, hipStream_t stream) {
    static int grid = 0;
    if (grid == 0) {
        if (n_in != 29 || (size_t)out_size != O_END || ws_size < WS_END) { fprintf(stderr, "kernel_launch: unexpected shapes (n_in %d out %d ws %zu)\n", n_in, out_size, ws_size); grid = -1; return; }
        int dev = 0, cus = 0, per_cu = 0;
        if (hipGetDevice(&dev) != hipSuccess || hipDeviceGetAttribute(&cus, hipDeviceAttributeMultiprocessorCount, dev) != hipSuccess) { grid = -1; return; }
        if (hipFuncSetAttribute((const void*)mega, hipFuncAttributeMaxDynamicSharedMemorySize, LDS_BYTES) != hipSuccess) { fprintf(stderr, "kernel_launch: hipFuncSetAttribute failed\n"); grid = -1; return; }
        if (hipOccupancyMaxActiveBlocksPerMultiprocessor(&per_cu, (const void*)mega, 512, LDS_BYTES) != hipSuccess || per_cu < 1) { fprintf(stderr, "kernel_launch: occupancy query says %d\n", per_cu); grid = -1; return; }
        (void)hipGetLastError();
        grid = cus;
        if (grid != 256) { fprintf(stderr, "kernel_launch: this kernel is laid out for 256 CUs, got %d\n", grid); grid = -1; return; }
    }
    if (grid < 0) return;
    if (hipMemsetAsync((unsigned char*)d_ws + WS_CTL, 0, 16384, stream) != hipSuccess) { fprintf(stderr, "kernel_launch: memset failed\n"); return; }
    Args a{};
    for (int i = 0; i < 29; ++i) a.in[i] = (const float*)d_in[i];
    a.out = (float*)d_out; a.ws = (unsigned char*)d_ws;
    void* kargs[] = {&a};
    hipError_t e = hipLaunchCooperativeKernel((const void*)mega, dim3(grid), dim3(512), kargs, LDS_BYTES, stream);
    if (e != hipSuccess) fprintf(stderr, "kernel_launch: cooperative launch failed: %s (grid %d)\n", hipGetErrorString(e), grid);
}
```

```cpp
#include <hip/hip_runtime.h>
#include <hip/hip_cooperative_groups.h>
#include <cstdio>
#include <cstdint>
namespace cg = cooperative_groups;

#define LAS __attribute__((address_space(3)))
typedef unsigned short bf16_t;
typedef short bf16x8 __attribute__((ext_vector_type(8)));
typedef float f32x4 __attribute__((ext_vector_type(4)));
typedef float f32x2 __attribute__((ext_vector_type(2)));
typedef unsigned u32x4 __attribute__((ext_vector_type(4)));
typedef unsigned u32x2 __attribute__((ext_vector_type(2)));

constexpr int DM = 1024, SEQ = 2048, NB = 8, MP = NB * SEQ, MS = 128, MA = MP + 256, NTILE = MA / 256;
constexpr int NIN = 6144, WA = 1024, WB = 1024, HA = 8, DHA = 128, HB = 4, DHB = 256, DPLE = 256, DMIX = 2048;
constexpr int LC = 256, NCH = SEQ / LC;
constexpr int NUNIT = NB * HB * NCH;
constexpr float EPS = 1e-6f;

constexpr size_t O_Y = 0, O_YS = 16777216, O_CP = 16908288, O_NP = 19005440, O_MP = 19013632, O_CVP = 19013664, O_CS = 19038240, O_NS = 52592672, O_MS = 52723744, O_CVS = 52724256, O_VS = 53117472, O_END = 53248544;

constexpr size_t MiB = 1u << 20;
constexpr size_t WS_CTL = 0, WS_WIN = 1 * MiB, WS_WQ = 13 * MiB, WS_WK = WS_WQ + MiB / 2, WS_WV = 14 * MiB, WS_WOUT = WS_WV + MiB / 2, WS_WPG = WS_WOUT + 4 * MiB, WS_WPP = WS_WPG + 2 * MiB,
    WS_WSP = 21 * MiB, WS_WG = WS_WSP + MiB / 4, WS_RS = WS_WG + MiB / 4, WS_GLI = 22 * MiB, WS_GLF = WS_GLI + MiB / 2, WS_DA = 23 * MiB, WS_DR = WS_DA + MiB / 2, WS_DG = 24 * MiB, WS_DEM = WS_DG + MiB / 2,
    WS_DW = 25 * MiB, WS_QN = WS_DW + MiB / 2, WS_DENP = 26 * MiB, WS_DN = 27 * MiB, WS_VS = WS_DN + MiB / 2, WS_PB = 28 * MiB, WS_XB = 37 * MiB, WS_PROJA = 70 * MiB, WS_PROJB = 168 * MiB,
    WS_PQ = 266 * MiB, WS_VC = 330 * MiB, WS_Y = 394 * MiB, WS_XB2 = 460 * MiB, WS_END = 493 * MiB;
constexpr size_t WS_WGB = WS_RS + MiB / 8;
constexpr size_t WS_Q = WS_PROJA, WS_K = WS_Q + 33 * MiB, WS_WKT = WS_K + 33 * MiB;
constexpr size_t WS_X1B = WS_PROJA, WS_GB = WS_X1B + 33 * MiB, WS_EB = WS_GB + 33 * MiB;
static_assert(WS_WKT + 32 * MiB <= WS_PROJB && WS_EB + 33 * MiB <= WS_PQ, "ws map");

__device__ __forceinline__ unsigned cvt_pk_bf16(float lo, float hi) { unsigned r; asm volatile("v_cvt_pk_bf16_f32 %0, %1, %2" : "=v"(r) : "v"(lo), "v"(hi)); return r; }
__device__ __forceinline__ float bf_lo(unsigned w) { return __uint_as_float(w << 16); }
__device__ __forceinline__ float bf_hi(unsigned w) { return __uint_as_float(w & 0xffff0000u); }
__device__ __forceinline__ float bf2f(bf16_t b) { return __uint_as_float(((unsigned)b) << 16); }
__device__ __forceinline__ bf16_t f2bf(float f) { return (bf16_t)(cvt_pk_bf16(f, 0.f) & 0xffffu); }
__device__ __forceinline__ float fast_exp(float x) { return __builtin_amdgcn_exp2f(x * 1.4426950408889634f); }
__device__ __forceinline__ float sigmoidf_(float x) { return __builtin_amdgcn_rcpf(1.0f + fast_exp(-x)); }
__device__ __forceinline__ float siluf_(float x) { return x * sigmoidf_(x); }
__device__ __forceinline__ f32x2 gelu_pk(f32x2 v) {
    const f32x2 av = __builtin_elementwise_abs(v), d = av * 0.2316418882f + 1.0f;
    f32x2 t; t.x = __builtin_amdgcn_rcpf(d.x); t.y = __builtin_amdgcn_rcpf(d.y);
    f32x2 q = t * 0.5307027145f + (-0.7265760135f); q = q * t + 0.7107068705f; q = q * t + (-0.142248368f); q = q * t + 0.127414796f; q = q * t;
    const f32x2 s = (v * v) * (-0.72134752044f);
    f32x2 e; e.x = __builtin_amdgcn_exp2f(s.x); e.y = __builtin_amdgcn_exp2f(s.y);
    const f32x2 m = v * (q * e), r = v - m;
    f32x2 o; o.x = v.x < 0.f ? m.x : r.x; o.y = v.y < 0.f ? m.y : r.y; return o;
}
__device__ __forceinline__ float wave_sum(float v) {
#pragma unroll
    for (int o = 1; o < 64; o <<= 1) v += __shfl_xor(v, o);
    return v;
}
#define LDS_WAIT() asm volatile("s_waitcnt lgkmcnt(0)" ::: "memory")

namespace pg8 {
constexpr int BM = 256, BK = 64, HALF = 128, HTB = HALF * BK * 2, STAGE_BYTES = 8 * HTB;
__host__ __device__ __forceinline__ int lds_byte(int r, int c) { const int st = (r >> 4) * 2 + (c >> 5), rr = r & 15, cc = c & 31, ob = rr * 64 + cc * 2; return st * 1024 + (ob ^ (((ob >> 9) & 1) << 5)); }
__host__ __device__ __forceinline__ void stage_rc(int b, int& R, int& C) { const int st = b / 1024, sb = b % 1024, swz = sb ^ (((sb >> 9) & 1) << 5); R = (st >> 1) * 16 + swz / 64; C = (st & 1) * 32 + (swz % 64) / 2; }
__host__ __device__ __forceinline__ int perm32(int rho) { const int n = rho >> 4, i = rho & 15; return 8 * (i >> 2) + 4 * n + (i & 3); }

struct Unit { const char* a; const char* b; int pm, pn, aux; };
struct Gemm { int lda, ldb, K; };

template <class Epi, class Sched, bool ALIGN_EPI = true, bool SP2 = true>
__device__ __forceinline__ void gemm_phase(LAS unsigned char* lds, const Gemm g, const Sched& S, const Epi& E) {
    int tid_ = threadIdx.x; asm volatile("" : "+v"(tid_));
    const int tid = tid_, wid = __builtin_amdgcn_readfirstlane(tid >> 6), lane = tid & 63, wr = wid >> 2, wc = wid & 3, fr = lane & 15, fq = lane >> 4;
    int K_ = g.K; asm volatile("" : "+s"(K_)); const int K = K_, nt = K / BK; (void)K;
    unsigned voffA[2], voffB[2];
#pragma unroll
    for (int i = 0; i < 2; ++i) { int R, C; stage_rc(tid * 16 + i * 8192, R, C); const int Rb = Epi::PERM ? ((R & ~31) + perm32(R & 31)) : R;
        voffA[i] = (unsigned)(R * g.lda + C) * 2u; voffB[i] = (unsigned)(Rb * g.ldb + C) * 2u; }
    const size_t kstep = (size_t)(BK * 2);
    const size_t hstepA = (size_t)HALF * g.lda * 2, hstepB = (size_t)HALF * g.ldb * 2;
    const unsigned ldsw = (unsigned)wid * 1024u;
    const int aoff = lds_byte(wr * 64 + fr, fq * 8), boff = lds_byte(wc * 32 + fr, fq * 8);
#define PG8_SA(b, h) (((b) * 2 + (h)) * HTB)
#define PG8_SB(b, h) ((4 + (b) * 2 + (h)) * HTB)
#define PG8_STAGE(bufoff, gbase, voff) do { _Pragma("unroll") for (int _i = 0; _i < 2; ++_i) \
        __builtin_amdgcn_global_load_lds((const unsigned*)((const char*)(gbase) + (voff)[_i]), (LAS unsigned*)(lds + (bufoff) + ldsw + _i * 8192), 16, 0, 0); } while (0)
#define PG8_LDA(dst, b, h) do { _Pragma("unroll") for (int m = 0; m < 4; ++m) _Pragma("unroll") for (int k = 0; k < 2; ++k) dst[m][k] = *(const LAS bf16x8*)(lds + PG8_SA(b, h) + aoff + m * 2048 + k * 1024); } while (0)
#define PG8_LDB(dst, b, h) do { _Pragma("unroll") for (int n = 0; n < 2; ++n) _Pragma("unroll") for (int k = 0; k < 2; ++k) dst[n][k] = *(const LAS bf16x8*)(lds + PG8_SB(b, h) + boff + n * 2048 + k * 1024); } while (0)
#define PG8_MMA(ai, bj, At, Bt) do { __builtin_amdgcn_s_setprio(1); _Pragma("unroll") for (int m = 0; m < 4; ++m) _Pragma("unroll") for (int n = 0; n < 2; ++n) _Pragma("unroll") for (int k = 0; k < 2; ++k) \
        acc[ai][bj][m][n] = __builtin_amdgcn_mfma_f32_16x16x32_bf16(Bt[n][k], At[m][k], acc[ai][bj][m][n], 0, 0, 0); __builtin_amdgcn_s_setprio(0); } while (0)
#define PG8_WAIT_V(n) asm volatile("s_waitcnt vmcnt(" #n ")" ::: "memory")
#define PG8_WAIT_L(n) asm volatile("s_waitcnt lgkmcnt(" #n ")" ::: "memory")
#define PG8_BAR __builtin_amdgcn_s_barrier()
#define PG8_SCHED __builtin_amdgcn_sched_barrier(0)
    Unit cur, nxt; int ui = 0;
    if (!S.next(0, cur)) return;
    f32x4 acc[2][2][4][2];
#pragma unroll
    for (int a = 0; a < 2; ++a)
#pragma unroll
        for (int b = 0; b < 2; ++b)
#pragma unroll
            for (int m = 0; m < 4; ++m)
#pragma unroll
                for (int n = 0; n < 2; ++n) acc[a][b][m][n] = (f32x4){0.f, 0.f, 0.f, 0.f};
    bf16x8 At[4][2], B0[2][2], B1[2][2];
    const char* cA = cur.a; const char* cB = cur.b;
    if constexpr (SP2) {
        PG8_STAGE(PG8_SB(0, 0), cB, voffB); PG8_STAGE(PG8_SB(0, 1), cB + hstepB, voffB); PG8_STAGE(PG8_SA(0, 0), cA, voffA); PG8_STAGE(PG8_SA(0, 1), cA + hstepA, voffA);
        if (wr == 1) PG8_BAR;
        PG8_WAIT_V(2); PG8_BAR;
        PG8_STAGE(PG8_SB(1, 0), cB + kstep, voffB); PG8_STAGE(PG8_SA(1, 0), cA + kstep, voffA); PG8_STAGE(PG8_SB(1, 1), cB + hstepB + kstep, voffB);
        PG8_WAIT_V(6); PG8_BAR;
    } else {
        PG8_STAGE(PG8_SB(0, 0), cB, voffB); PG8_STAGE(PG8_SA(0, 0), cA, voffA); PG8_STAGE(PG8_SB(0, 1), cB + hstepB, voffB); PG8_STAGE(PG8_SA(0, 1), cA + hstepA, voffA);
        if (wr == 1) PG8_BAR;
        PG8_WAIT_V(4); PG8_BAR;
        PG8_STAGE(PG8_SB(1, 0), cB + kstep, voffB); PG8_STAGE(PG8_SA(1, 0), cA + kstep, voffA); PG8_STAGE(PG8_SB(1, 1), cB + hstepB + kstep, voffB);
        PG8_WAIT_V(6); PG8_BAR;
    }
    for (;;) {
        const bool has_next = S.next(ui + 1, nxt);
        const char* nA = has_next ? nxt.a : cA; const char* nB = has_next ? nxt.b : cB;
#pragma unroll 1
        for (int t = 0; t < nt; t += 2) {
            const bool last = (t == nt - 2);
            const char* a1 = cA + (size_t)(t + 1) * kstep;
            const char* a2 = last ? nA : cA + (size_t)(t + 2) * kstep; const char* b2 = last ? nB : cB + (size_t)(t + 2) * kstep;
            const char* a3 = a2 + kstep; const char* b3 = b2 + kstep;
            if constexpr (SP2) {
            PG8_LDB(B0, 0, 0); PG8_LDB(B1, 0, 1); PG8_SCHED; PG8_LDA(At, 0, 0); PG8_STAGE(PG8_SA(1, 1), a1 + hstepA, voffA);
            PG8_WAIT_V(8); PG8_WAIT_L(0); PG8_BAR; PG8_MMA(0, 0, At, B0); PG8_MMA(0, 1, At, B1); PG8_BAR; PG8_SCHED;
            PG8_LDA(At, 0, 1); PG8_STAGE(PG8_SB(0, 0), b2, voffB); PG8_STAGE(PG8_SB(0, 1), b2 + hstepB, voffB); PG8_STAGE(PG8_SA(0, 0), a2, voffA);
            PG8_WAIT_V(8); PG8_WAIT_L(0); PG8_BAR; PG8_MMA(1, 0, At, B0); PG8_MMA(1, 1, At, B1); PG8_BAR; PG8_SCHED;
            PG8_LDB(B0, 1, 0); PG8_LDB(B1, 1, 1); PG8_SCHED; PG8_LDA(At, 1, 0); PG8_STAGE(PG8_SA(0, 1), a2 + hstepA, voffA);
            PG8_WAIT_V(8); PG8_WAIT_L(0); PG8_BAR; PG8_MMA(0, 0, At, B0); PG8_MMA(0, 1, At, B1); PG8_BAR; PG8_SCHED;
            PG8_LDA(At, 1, 1); PG8_STAGE(PG8_SB(1, 0), b3, voffB); PG8_STAGE(PG8_SB(1, 1), b3 + hstepB, voffB); PG8_STAGE(PG8_SA(1, 0), a3, voffA);
            PG8_WAIT_V(8); PG8_WAIT_L(0); PG8_BAR; PG8_MMA(1, 0, At, B0); PG8_MMA(1, 1, At, B1); PG8_BAR; PG8_SCHED;
            } else {
            PG8_LDB(B0, 0, 0); PG8_SCHED; PG8_LDA(At, 0, 0); PG8_STAGE(PG8_SA(1, 1), a1 + hstepA, voffA);
            PG8_WAIT_L(8); PG8_BAR; PG8_WAIT_L(0); PG8_MMA(0, 0, At, B0); PG8_BAR; PG8_SCHED;
            PG8_LDB(B1, 0, 1); PG8_STAGE(PG8_SB(0, 0), b2, voffB);
            PG8_BAR; PG8_WAIT_L(0); PG8_MMA(0, 1, At, B1); PG8_BAR;
            PG8_LDA(At, 0, 1); PG8_STAGE(PG8_SA(0, 0), a2, voffA);
            PG8_BAR; PG8_WAIT_L(0); PG8_MMA(1, 0, At, B0); PG8_BAR; PG8_SCHED;
            PG8_STAGE(PG8_SB(0, 1), b2 + hstepB, voffB);
            PG8_WAIT_V(6); PG8_BAR; PG8_MMA(1, 1, At, B1); PG8_BAR;
            PG8_LDB(B0, 1, 0); PG8_SCHED; PG8_LDA(At, 1, 0); PG8_STAGE(PG8_SA(0, 1), a2 + hstepA, voffA);
            PG8_WAIT_L(8); PG8_BAR; PG8_WAIT_L(0); PG8_MMA(0, 0, At, B0); PG8_BAR; PG8_SCHED;
            PG8_LDB(B1, 1, 1); PG8_STAGE(PG8_SB(1, 0), b3, voffB);
            PG8_BAR; PG8_WAIT_L(0); PG8_MMA(0, 1, At, B1); PG8_BAR;
            PG8_LDA(At, 1, 1); PG8_STAGE(PG8_SA(1, 0), a3, voffA);
            PG8_BAR; PG8_WAIT_L(0); PG8_MMA(1, 0, At, B0); PG8_BAR; PG8_SCHED;
            PG8_STAGE(PG8_SB(1, 1), b3 + hstepB, voffB);
            PG8_WAIT_V(6); PG8_BAR; PG8_MMA(1, 1, At, B1); PG8_BAR;
            }
        }
        if constexpr (ALIGN_EPI) { if (wr == 0) PG8_BAR; }
        if constexpr (!Epi::AFTER_DRAIN) { E(acc, cur, wr, wc, fr, fq); }
        if (!has_next) break;
#pragma unroll
        for (int a = 0; a < 2; ++a)
#pragma unroll
            for (int b = 0; b < 2; ++b)
#pragma unroll
                for (int m = 0; m < 4; ++m)
#pragma unroll
                    for (int n = 0; n < 2; ++n) acc[a][b][m][n] = (f32x4){0.f, 0.f, 0.f, 0.f};
        cur = nxt; cA = nA; cB = nB; ++ui;
        if constexpr (ALIGN_EPI) { if (wr == 1) PG8_BAR; }
    }
    PG8_WAIT_V(0);
    if constexpr (!ALIGN_EPI) { if (wr == 0) PG8_BAR; }
    PG8_BAR;
    if constexpr (Epi::AFTER_DRAIN) { E.fused(acc, cur, wr, wc, fr, fq, lds, wid, lane); }
#undef PG8_SA
#undef PG8_SB
#undef PG8_STAGE
#undef PG8_LDA
#undef PG8_LDB
#undef PG8_MMA
#undef PG8_WAIT_V
#undef PG8_WAIT_L
#undef PG8_BAR
#undef PG8_SCHED
}
}
using pg8::Unit; using pg8::Gemm;

constexpr int LDS_BYTES = 147456;
struct Args { const float* in[29]; float* out; unsigned char* ws; };

struct Ctx {
    LAS unsigned char* lds; int tid, lane, wave, G, bid, gw, NGW;
    const float* const* in; float* out; unsigned char* ws;
};

__device__ __forceinline__ void p0_transpose_item(const float* W, int ldw, bf16_t* WT, int ldt, const float* kscale, LAS float* scr, int kb, int nb, int lane) {
    const int k0 = 64 * kb, n0 = 32 * nb;
#pragma unroll 8
    for (int i = 0; i < 32; ++i) { const int kk = 2 * i + (lane >> 5); float v = W[(size_t)(k0 + kk) * ldw + n0 + (lane & 31)]; if (kscale) v *= kscale[k0 + kk]; scr[kk * 33 + (lane & 31)] = v; }
    LDS_WAIT(); asm volatile("" ::: "memory");
    const int c = lane & 7;
#pragma unroll
    for (int j = 0; j < 4; ++j) { const int n = (lane >> 3) + 8 * j; const LAS float* s = scr + (8 * c) * 33 + n;
        u32x4 o; o.x = cvt_pk_bf16(s[0 * 33], s[1 * 33]); o.y = cvt_pk_bf16(s[2 * 33], s[3 * 33]); o.z = cvt_pk_bf16(s[4 * 33], s[5 * 33]); o.w = cvt_pk_bf16(s[6 * 33], s[7 * 33]);
        *(u32x4*)(WT + (size_t)(n0 + n) * ldt + k0 + 8 * c) = o; }
    LDS_WAIT(); asm volatile("" ::: "memory");
}

__device__ __forceinline__ void p0_prologue(const Ctx& F0) { Ctx F = F0; asm volatile("" : "+v"(F.tid), "+v"(F.lane));
    LAS float* scr = (LAS float*)(F.lds + F.wave * 16384);
    unsigned char* ws = F.ws;
    constexpr int I_WIN = 16 * 192, I_QKV = 12 * 4 * 8, I_WOUT = 32 * 32, I_WPG = 16 * 32, I_WPP = 4 * 32;
    constexpr int I_T = I_WIN + I_QKV + I_WOUT + I_WPG + I_WPP;
    constexpr int I_X = MA, I_P = MA, I_SP = 1024, I_WG = 1024, I_YPAD = 128;
    constexpr int NITEMS = I_T + I_X + I_P + I_SP + I_WG + I_YPAD;
    for (int it = F.gw; it < NITEMS; it += F.NGW) {
        int r = it;
        if (r < I_T) {
            if (r < I_WIN) { p0_transpose_item(F.in[9], NIN, (bf16_t*)(ws + WS_WIN), DM, F.in[8], scr, r / 192, r % 192, F.lane); continue; } r -= I_WIN;
            if (r < I_QKV) { const int mat = r / 32, rr = r % 32, which = mat / 4, h = mat % 4;
                const float* W = F.in[16 + which] + (size_t)h * 65536; bf16_t* WT = (bf16_t*)(ws + (which == 0 ? WS_WQ : which == 1 ? WS_WK : WS_WV)) + (size_t)h * 65536;
                p0_transpose_item(W, 256, WT, 256, nullptr, scr, rr / 8, rr % 8, F.lane); continue; } r -= I_QKV;
            if (r < I_WOUT) { p0_transpose_item(F.in[23], DM, (bf16_t*)(ws + WS_WOUT), DMIX, nullptr, scr, r / 32, r % 32, F.lane); continue; } r -= I_WOUT;
            if (r < I_WPG) { p0_transpose_item(F.in[24], DM, (bf16_t*)(ws + WS_WPG), DM, nullptr, scr, r / 32, r % 32, F.lane); continue; } r -= I_WPG;
            p0_transpose_item(F.in[26], DM, (bf16_t*)(ws + WS_WPP), DPLE, nullptr, scr, r / 32, r % 32, F.lane); continue;
        }
        r -= I_T;
        if (r < I_X) {
            bf16_t* orow = (bf16_t*)(ws + WS_XB) + (size_t)r * DM; float* rs = (float*)(ws + WS_RS);
            unsigned long long* o8 = (unsigned long long*)orow + F.lane;
            if (r >= MP + MS) {
#pragma unroll
                for (int j = 0; j < 4; ++j) o8[64 * j] = 0ull;
                if (F.lane == 0) rs[r] = 0.f; continue; }
            const float* xrow = r < MP ? F.in[0] + (size_t)r * DM : F.in[1] + (size_t)(r - MP) * DM;
            const f32x4* xr = (const f32x4*)xrow + F.lane; f32x4 v[4]; float s = 0.f;
#pragma unroll
            for (int j = 0; j < 4; ++j) { v[j] = xr[64 * j]; s += (v[j].x * v[j].x + v[j].y * v[j].y) + (v[j].z * v[j].z + v[j].w * v[j].w); }
            s = wave_sum(s);
#pragma unroll
            for (int j = 0; j < 4; ++j) o8[64 * j] = (unsigned long long)cvt_pk_bf16(v[j].x, v[j].y) | ((unsigned long long)cvt_pk_bf16(v[j].z, v[j].w) << 32);
            if (F.lane == 0) rs[r] = 1.0f / sqrtf(s * (1.0f / DM) + EPS);
            continue;
        }
        r -= I_X;
        if (r < I_P) {
            unsigned long long* o8 = (unsigned long long*)((bf16_t*)(ws + WS_PB) + (size_t)r * DPLE) + F.lane;
            if (r >= MP + MS) { o8[0] = 0ull; continue; }
            const float* prow = r < MP ? F.in[6] + (size_t)r * DPLE : F.in[7] + (size_t)(r - MP) * DPLE;
            const f32x4 v = ((const f32x4*)prow)[F.lane];
            o8[0] = (unsigned long long)cvt_pk_bf16(v.x, v.y) | ((unsigned long long)cvt_pk_bf16(v.z, v.w) << 32);
            continue;
        }
        r -= I_P;
        if (r < I_SP) {
            const int t = r & 127; const float* wrow = F.in[12] + (size_t)r * 128; const f32x2 v = ((const f32x2*)wrow)[F.lane];
            const int s0 = 2 * F.lane; ((unsigned*)((bf16_t*)(ws + WS_WSP) + (size_t)r * 128))[F.lane] = cvt_pk_bf16(s0 <= t ? v.x : 0.f, s0 + 1 <= t ? v.y : 0.f);
            continue;
        }
        r -= I_SP;
        if (r < I_WG) {
            const int i = r, h = i >> 8, d = i & 255, j = F.lane & 7, isx = (F.lane >> 3) & 1, part = F.lane >> 4;
            const float* wif = F.in[19]; float s = 0.f;
            if (!isx) { const float* wq = F.in[16] + ((size_t)h * 256 + d) * 256; const float* wk = F.in[17] + ((size_t)h * 256 + d) * 256;
                for (int e = part * 64; e < part * 64 + 64; ++e) s += wq[e] * wif[(size_t)(h * 256 + e) * 8 + j] + wk[e] * wif[(size_t)(1024 + h * 256 + e) * 8 + j]; }
            else { const float* wv = F.in[18] + ((size_t)h * 256 + d) * 256;
                for (int e = part * 64; e < part * 64 + 64; ++e) s += wv[e] * wif[(size_t)(2048 + h * 256 + e) * 8 + j]; }
            s += __shfl_xor(s, 16); s += __shfl_xor(s, 32);
            if (F.lane < 16) ((float*)(ws + WS_WG))[(size_t)i * 16 + F.lane] = s;
            if (F.lane < 16) { bf16_t* wgb = (bf16_t*)(ws + WS_WGB) + (size_t)(F.lane >> 3) * 16384 + (size_t)(F.lane & 7) * 1024 + i; wgb[0] = f2bf(s); wgb[8 * 1024] = 0; }
            continue;
        }
        r -= I_WG;
        {
            u32x4* yrow = (u32x4*)((bf16_t*)(ws + WS_Y) + (size_t)(MP + MS + r) * DMIX) + F.lane;
#pragma unroll
            for (int j = 0; j < 4; ++j) yrow[64 * j] = (u32x4){0u, 0u, 0u, 0u};
        }
    }
}

struct OrderRowMajor {
    int nM, nN, n, G, c; const char* A; const char* B; size_t astep, bstep;
    __device__ __forceinline__ bool next(int i, Unit& u) const {
        const int L = i * G + c; if (L >= n) return false;
        u.pm = L / nN; u.pn = L % nN; u.aux = 0; u.a = A + (size_t)u.pm * astep; u.b = B + (size_t)u.pn * bstep; return true;
    }
};
struct EpiInProj {
    static constexpr bool PERM = true, AFTER_DRAIN = false;
    bf16_t* PA; bf16_t* PB; const float* rs;
    template <int KIND> __device__ __forceinline__ void run(const f32x4 (&acc)[2][2][4][2], bf16_t* base, int row0, int col0) const {
#pragma unroll
        for (int ai = 0; ai < 2; ++ai)
#pragma unroll
            for (int m = 0; m < 4; ++m) { const int row = row0 + ai * 128 + m * 16; const float s = rs[row]; bf16_t* rowp = base + (size_t)row * 3072 + col0;
#pragma unroll
                for (int bj = 0; bj < 2; ++bj) { f32x4 v0 = acc[ai][bj][m][0] * s, v1 = acc[ai][bj][m][1] * s;
                    if (KIND == 0) { f32x2 a = gelu_pk((f32x2){v0[0], v0[1]}), b = gelu_pk((f32x2){v0[2], v0[3]}), c = gelu_pk((f32x2){v1[0], v1[1]}), d = gelu_pk((f32x2){v1[2], v1[3]});
                        v0 = (f32x4){a.x, a.y, b.x, b.y}; v1 = (f32x4){c.x, c.y, d.x, d.y}; }
                    if (KIND == 1) {
#pragma unroll
                        for (int j = 0; j < 4; ++j) { v0[j] = siluf_(v0[j]); v1[j] = siluf_(v1[j]); } }
                    if (KIND == 3) {
#pragma unroll
                        for (int j = 0; j < 4; ++j) { v0[j] = sigmoidf_(v0[j]); v1[j] = sigmoidf_(v1[j]); } }
                    u32x4 w; w.x = cvt_pk_bf16(v0[0], v0[1]); w.y = cvt_pk_bf16(v0[2], v0[3]); w.z = cvt_pk_bf16(v1[0], v1[1]); w.w = cvt_pk_bf16(v1[2], v1[3]);
                    *(u32x4*)(rowp + bj * 128) = w; } }
    }
    __device__ __forceinline__ void operator()(const f32x4 (&acc)[2][2][4][2], const Unit& u, int wr, int wc, int fr, int fq) const {
        const int row0 = u.pm * 256 + wr * 64 + fr, pn = u.pn;
        bf16_t* base = pn < 12 ? PA + pn * 256 : PB + (pn - 12) * 256; const int col0 = wc * 32 + 8 * fq;
        if (pn < 8) run<0>(acc, base, row0, col0);
        else if (pn < 12 || pn >= 20) run<1>(acc, base, row0, col0);
        else if (pn < 16) run<2>(acc, base, row0, col0);
        else run<3>(acc, base, row0, col0);
    }
};

__device__ __forceinline__ float logsigmoidf_(float x) { return fminf(x, 0.f) - log1pf(__expf(-fabsf(x))); }
__device__ __forceinline__ void unpack8(const u32x4 w, float (&f)[8]) { f[0] = bf_lo(w.x); f[1] = bf_hi(w.x); f[2] = bf_lo(w.y); f[3] = bf_hi(w.y); f[4] = bf_lo(w.z); f[5] = bf_hi(w.z); f[6] = bf_lo(w.w); f[7] = bf_hi(w.w); }
__device__ __forceinline__ u32x4 pack8(const float (&f)[8]) { u32x4 w; w.x = cvt_pk_bf16(f[0], f[1]); w.y = cvt_pk_bf16(f[2], f[3]); w.z = cvt_pk_bf16(f[4], f[5]); w.w = cvt_pk_bf16(f[6], f[7]); return w; }

__device__ __forceinline__ void p2a_conv_gates(const Ctx& F0) { Ctx F = F0; asm volatile("" : "+v"(F.tid), "+v"(F.lane));
    unsigned char* ws = F.ws;
    const bf16_t* PBX = (const bf16_t*)(ws + WS_PROJB);
    bf16_t* XC = (bf16_t*)(ws + WS_XB); bf16_t* XB2 = (bf16_t*)(ws + WS_XB2);
    const float* Wg = (const float*)(ws + WS_WG);
    float* GLI = (float*)(ws + WS_GLI); float* GLF = (float*)(ws + WS_GLF);
    const float* convw = F.in[14]; const float* convb = F.in[15]; const float* bif = F.in[20];
    LAS float* cwl = (LAS float*)F.lds; LAS bf16_t* wgl = (LAS bf16_t*)(F.lds + 20480); LAS f32x4* comb = (LAS f32x4*)(F.lds + 20480 + 65536);
    for (int i = F.tid; i < 5 * 1024 / 4; i += 512) ((LAS f32x4*)cwl)[i] = i < 1024 ? ((const f32x4*)convw)[i] : ((const f32x4*)convb)[i - 1024];
    for (int i = F.tid; i < 65536 / 16; i += 512) ((LAS u32x4*)wgl)[i] = ((const u32x4*)(ws + WS_WGB))[i];
    __syncthreads();
    const int l15 = F.lane & 15, lq = F.lane >> 4, rgp = F.wave >> 1, hh = F.wave & 1;
    for (int tile = F.bid; tile < MP / 64 + 2; tile += F.G) {
        const bool smp = tile >= MP / 64; const int row = tile * 64 + rgp * 16 + l15, seq0 = row & ~(SEQ - 1); const float* st = F.in[5] + (size_t)(row - MP) * 3072;
        f32x4 acc = (f32x4){0.f, 0.f, 0.f, 0.f};
#pragma unroll 2
        for (int cbk = 0; cbk < 16; ++cbk) { const int ch0 = (hh * 16 + cbk) * 32 + 8 * lq;
            u32x4 x3 = (u32x4){0u, 0u, 0u, 0u}, x2 = x3, x1 = x3; const u32x4 x0 = *(const u32x4*)(PBX + (size_t)row * 3072 + ch0);
            float w0[8], w1[8], w2[8], cur[8], xc[8];
            if (!smp) {
                if (row - 3 >= seq0) x3 = *(const u32x4*)(PBX + (size_t)(row - 3) * 3072 + ch0);
                if (row - 2 >= seq0) x2 = *(const u32x4*)(PBX + (size_t)(row - 2) * 3072 + ch0);
                if (row - 1 >= seq0) x1 = *(const u32x4*)(PBX + (size_t)(row - 1) * 3072 + ch0);
                unpack8(x3, w0); unpack8(x2, w1); unpack8(x1, w2);
            } else {
#pragma unroll
                for (int q = 0; q < 2; ++q) { const f32x4 a0 = *(const f32x4*)(st + ch0 + 4 * q), a1 = *(const f32x4*)(st + 1024 + ch0 + 4 * q), a2 = *(const f32x4*)(st + 2048 + ch0 + 4 * q);
#pragma unroll
                    for (int e = 0; e < 4; ++e) { w0[4 * q + e] = a0[e]; w1[4 * q + e] = a1[e]; w2[4 * q + e] = a2[e]; } }
            }
            unpack8(x0, cur);
#pragma unroll
            for (int q = 0; q < 2; ++q) { const f32x4 c0 = *(const LAS f32x4*)(cwl + ch0 + 4 * q), c1 = *(const LAS f32x4*)(cwl + 1024 + ch0 + 4 * q), c2 = *(const LAS f32x4*)(cwl + 2048 + ch0 + 4 * q), c3 = *(const LAS f32x4*)(cwl + 3072 + ch0 + 4 * q), cb = *(const LAS f32x4*)(cwl + 4096 + ch0 + 4 * q);
#pragma unroll
                for (int e = 0; e < 4; ++e) xc[4 * q + e] = siluf_(c0[e] * w0[4 * q + e] + c1[e] * w1[4 * q + e] + c2[e] * w2[4 * q + e] + c3[e] * cur[4 * q + e] + cb[e]); }
            const u32x4 xcp = pack8(xc);
            *(u32x4*)(XC + (size_t)row * DM + ch0) = xcp; *(u32x4*)(XB2 + (size_t)row * DM + ch0) = x0;
            const bf16x8 bc = *(const LAS bf16x8*)(wgl + l15 * 1024 + ch0), bx = *(const LAS bf16x8*)(wgl + 16384 + l15 * 1024 + ch0);
            acc = __builtin_amdgcn_mfma_f32_16x16x32_bf16(__builtin_bit_cast(bf16x8, xcp), bc, acc, 0, 0, 0);
            acc = __builtin_amdgcn_mfma_f32_16x16x32_bf16(__builtin_bit_cast(bf16x8, x0), bx, acc, 0, 0, 0); }
        __syncthreads();
        if (hh == 1) comb[rgp * 64 + F.lane] = acc;
        __syncthreads();
        if (hh == 0 && l15 < 8) { const f32x4 o = comb[rgp * 64 + F.lane]; const float bj = bif[l15];
#pragma unroll
            for (int r = 0; r < 4; ++r) { const float g = acc[r] + o[r] + bj; const size_t rr = (size_t)(tile * 64 + rgp * 16 + 4 * lq + r);
                if (l15 < 4) GLI[(size_t)l15 * MA + rr] = g; else GLF[(size_t)(l15 - 4) * MA + rr] = logsigmoidf_(g); } }
    }
    __syncthreads();
    for (int i = F.bid * 512 + F.tid; i < NB * 3 * 1024; i += F.G * 512) { const int b = i / 3072, j = (i / 1024) % 3, ch = i & 1023;
        F.out[O_CVP + i] = bf2f(PBX[(size_t)(b * SEQ + SEQ - 3 + j) * 3072 + ch]); }
    for (int i = F.gw; i < MS; i += F.NGW) {
        const int r = MP + i, ch0s = F.lane * 16; const float* st = F.in[5] + (size_t)i * 3 * 1024;
        const bf16_t* PA = (const bf16_t*)(ws + WS_PROJA) + (size_t)r * 3072;
#pragma unroll
        for (int half = 0; half < 2; ++half) { const int c0 = ch0s + half * 8; float xb[8]; unpack8(*(const u32x4*)(PBX + (size_t)r * 3072 + c0), xb);
#pragma unroll
            for (int q = 0; q < 2; ++q) { *(f32x4*)(F.out + O_CVS + (size_t)i * 3072 + c0 + 4 * q) = *(const f32x4*)(st + 1024 + c0 + 4 * q); *(f32x4*)(F.out + O_CVS + (size_t)i * 3072 + 1024 + c0 + 4 * q) = *(const f32x4*)(st + 2048 + c0 + 4 * q);
                *(f32x4*)(F.out + O_CVS + (size_t)i * 3072 + 2048 + c0 + 4 * q) = (f32x4){xb[4 * q], xb[4 * q + 1], xb[4 * q + 2], xb[4 * q + 3]}; } }
        float gv[16], s = 0.f;
        { float t8[8]; unpack8(*(const u32x4*)(PA + 1024 + ch0s), t8);
#pragma unroll
          for (int c = 0; c < 8; ++c) gv[c] = t8[c];
          unpack8(*(const u32x4*)(PA + 1024 + ch0s + 8), t8);
#pragma unroll
          for (int c = 0; c < 8; ++c) gv[8 + c] = t8[c]; }
#pragma unroll
        for (int c = 0; c < 16; ++c) s += gv[c];
        s += __shfl_xor(s, 1); s += __shfl_xor(s, 2); s += __shfl_xor(s, 4);
        const float mu = s * (1.f / 128.f); float q = 0.f;
#pragma unroll
        for (int c = 0; c < 16; ++c) { const float d = gv[c] - mu; q += d * d; }
        q += __shfl_xor(q, 1); q += __shfl_xor(q, 2); q += __shfl_xor(q, 4);
        const float rstd = 1.0f / sqrtf(q * (1.f / 128.f) + EPS);
        const int h = F.lane >> 3; const float wsp = F.in[12][(size_t)h * 16384], bsp = F.in[13][h * 128];
        float uu[16], zz[16];
        { float t8[8]; unpack8(*(const u32x4*)(PA + ch0s), t8);
#pragma unroll
          for (int c = 0; c < 8; ++c) uu[c] = t8[c];
          unpack8(*(const u32x4*)(PA + ch0s + 8), t8);
#pragma unroll
          for (int c = 0; c < 8; ++c) uu[8 + c] = t8[c];
          unpack8(*(const u32x4*)(PA + 2048 + ch0s), t8);
#pragma unroll
          for (int c = 0; c < 8; ++c) zz[c] = t8[c];
          unpack8(*(const u32x4*)(PA + 2048 + ch0s + 8), t8);
#pragma unroll
          for (int c = 0; c < 8; ++c) zz[8 + c] = t8[c]; }
        float ya[16];
#pragma unroll
        for (int c = 0; c < 16; ++c) { const int ch = ch0s + c; const float vn = (gv[c] - mu) * rstd * F.in[10][ch] + F.in[11][ch];
            F.out[O_VS + (size_t)i * 1024 + ch] = vn; ya[c] = uu[c] * (wsp * vn + bsp) * zz[c]; }
        bf16_t* yrow = (bf16_t*)(ws + WS_Y) + (size_t)r * DMIX + ch0s;
        { float t8[8];
#pragma unroll
          for (int c = 0; c < 8; ++c) t8[c] = ya[c];
          *(u32x4*)(yrow) = pack8(t8);
#pragma unroll
          for (int c = 0; c < 8; ++c) t8[c] = ya[8 + c];
          *(u32x4*)(yrow + 8) = pack8(t8); }
    }
}

__device__ __forceinline__ void mscan_wave(const Ctx& F, int bh) {
    unsigned char* ws = F.ws; const int b = bh >> 2, h = bh & 3, lane = F.lane;
    const float* li = (const float*)(ws + WS_GLI) + (size_t)h * MA + (size_t)b * SEQ + lane * 32;
    const float* lf = (const float*)(ws + WS_GLF) + (size_t)h * MA + (size_t)b * SEQ + lane * 32;
    float A = 0.f, Bv = -INFINITY;
    for (int i = 0; i < 32; ++i) { const float f = lf[i], l = li[i]; Bv = fmaxf(Bv + f, l); A += f; }
    float sA = A, sB = Bv;
#pragma unroll
    for (int o = 1; o < 64; o <<= 1) { const float pA = __shfl_up(sA, o), pB = __shfl_up(sB, o); if (lane >= o) { sB = fmaxf(pB + sA, sB); sA = pA + sA; } }
    float eA = __shfl_up(sA, 1), eB = __shfl_up(sB, 1); if (lane == 0) { eA = 0.f; eB = -INFINITY; }
    const float m_in = fmaxf(0.f + eA, eB);
    float cA = A;
#pragma unroll
    for (int o = 1; o < 8; o <<= 1) { const float p = __shfl_up(cA, o); if ((lane & 7) >= o) cA += p; }
    const float b_in = cA - A;
    const float m_prev = __shfl(m_in, lane & ~7);
    float* DA = (float*)(ws + WS_DA) + (size_t)h * MA + (size_t)b * SEQ + lane * 32; float* DR = (float*)(ws + WS_DR) + (size_t)h * MA + (size_t)b * SEQ + lane * 32;
    float* DG = (float*)(ws + WS_DG) + (size_t)h * MA + (size_t)b * SEQ + lane * 32; float* DEM = (float*)(ws + WS_DEM) + (size_t)h * MA + (size_t)b * SEQ + lane * 32;
    float* DW = (float*)(ws + WS_DW) + (size_t)h * MA + (size_t)b * SEQ + lane * 32;
    float m = m_in, bb = b_in, a_last = 0.f;
    for (int i = 0; i < 32; ++i) { const float f = lf[i], l = li[i]; m = fmaxf(m + f, l); bb += f;
        a_last = bb - m; DA[i] = a_last; DR[i] = l - bb; DG[i] = __expf(bb + m_prev - m); DEM[i] = __expf(-m); }
    const float a_end = __shfl(a_last, lane | 7);
    for (int i = 0; i < 32; ++i) { const float f = lf[i]; (void)f; }
    { float bb2 = b_in; for (int i = 0; i < 32; ++i) { bb2 += lf[i]; DW[i] = __expf(a_end + (li[i] - bb2)); } }
    if (lane == 63) F.out[O_MP + bh] = m;
}

__device__ __forceinline__ void p9_final(const Ctx& F0) { Ctx F = F0; asm volatile("" : "+v"(F.tid), "+v"(F.lane));
    unsigned char* ws = F.ws; const bf16_t* GB = (const bf16_t*)(ws + WS_GB); const bf16_t* EB = (const bf16_t*)(ws + WS_EB);
    const float* pleg = F.in[27]; const float* fing = F.in[28];
    f32x4 pg[4], fg[4];
#pragma unroll
    for (int j = 0; j < 4; ++j) { pg[j] = ((const f32x4*)pleg)[F.lane + 64 * j]; fg[j] = ((const f32x4*)fing)[F.lane + 64 * j]; }
    for (int r0 = F.gw * 2; r0 < MP + MS; r0 += F.NGW * 2) {
        f32x4 x[2][4]; u32x2 g[2][4], e[2][4]; float* xrow[2];
#pragma unroll
        for (int q = 0; q < 2; ++q) { const int r = r0 + q; xrow[q] = r < MP ? F.out + O_Y + (size_t)r * DM : F.out + O_YS + (size_t)(r - MP) * DM;
#pragma unroll
            for (int j = 0; j < 4; ++j) { x[q][j] = ((const f32x4*)xrow[q])[F.lane + 64 * j]; g[q][j] = ((const u32x2*)(GB + (size_t)r * DM))[F.lane + 64 * j]; e[q][j] = ((const u32x2*)(EB + (size_t)r * DM))[F.lane + 64 * j]; } }
#pragma unroll
        for (int q = 0; q < 2; ++q) { float s = 0.f; f32x4 ev[4];
#pragma unroll
            for (int j = 0; j < 4; ++j) { ev[j] = (f32x4){bf_lo(e[q][j].x), bf_hi(e[q][j].x), bf_lo(e[q][j].y), bf_hi(e[q][j].y)}; s += (ev[j][0] * ev[j][0] + ev[j][1] * ev[j][1]) + (ev[j][2] * ev[j][2] + ev[j][3] * ev[j][3]); }
            s = wave_sum(s); const float rse = 1.0f / sqrtf(s * (1.f / DM) + EPS); float s2 = 0.f;
#pragma unroll
            for (int j = 0; j < 4; ++j) { const f32x4 gv = (f32x4){bf_lo(g[q][j].x), bf_hi(g[q][j].x), bf_lo(g[q][j].y), bf_hi(g[q][j].y)};
                x[q][j] = x[q][j] + gv * (ev[j] * rse * pg[j]); s2 += (x[q][j][0] * x[q][j][0] + x[q][j][1] * x[q][j][1]) + (x[q][j][2] * x[q][j][2] + x[q][j][3] * x[q][j][3]); }
            s2 = wave_sum(s2); const float rs2 = 1.0f / sqrtf(s2 * (1.f / DM) + EPS);
#pragma unroll
            for (int j = 0; j < 4; ++j) ((f32x4*)xrow[q])[F.lane + 64 * j] = x[q][j] * rs2 * fg[j]; }
    }
}
#define MAKE_CTX() extern __shared__ __attribute__((aligned(16))) unsigned char lds_raw[]; \
    Ctx F; F.lds = (LAS unsigned char*)lds_raw; F.tid = threadIdx.x; F.lane = F.tid & 63; F.wave = __builtin_amdgcn_readfirstlane(F.tid >> 6); \
    F.G = gridDim.x; F.bid = blockIdx.x; F.gw = F.bid * 8 + F.wave; F.NGW = F.G * 8; F.in = args.in; F.out = args.out; F.ws = args.ws; unsigned char* ws = args.ws; (void)ws

template <int KIND> struct EpiBf16Act {
    static constexpr bool PERM = false, AFTER_DRAIN = false;
    bf16_t* O; int ldo; const float* bias; float scale;
    __device__ __forceinline__ void operator()(const f32x4 (&acc)[2][2][4][2], const Unit& u, int wr, int wc, int fr, int fq) const {
        const int row0 = u.pm * 256 + wr * 64 + fr, col0 = u.pn * 256 + wc * 32 + 4 * fq;
        f32x4 bv[2][2];
#pragma unroll
        for (int bj = 0; bj < 2; ++bj)
#pragma unroll
            for (int n = 0; n < 2; ++n) bv[bj][n] = bias ? *(const f32x4*)(bias + col0 + bj * 128 + 16 * n) : (f32x4){0.f, 0.f, 0.f, 0.f};
#pragma unroll
        for (int ai = 0; ai < 2; ++ai)
#pragma unroll
            for (int m = 0; m < 4; ++m) { bf16_t* rowp = O + (size_t)(row0 + ai * 128 + m * 16) * ldo + col0;
#pragma unroll
                for (int bj = 0; bj < 2; ++bj)
#pragma unroll
                    for (int n = 0; n < 2; ++n) { f32x4 v = acc[ai][bj][m][n] * scale + bv[bj][n];
                        if (KIND == 3) {
#pragma unroll
                            for (int j = 0; j < 4; ++j) v[j] = sigmoidf_(v[j]); }
                        u32x2 w; w.x = cvt_pk_bf16(v[0], v[1]); w.y = cvt_pk_bf16(v[2], v[3]); *(u32x2*)(rowp + bj * 128 + n * 16) = w; } }
    }
};
struct EpiOutProj {
    static constexpr bool PERM = false, AFTER_DRAIN = false;
    const float* xp; const float* xs; float* out; bf16_t* X1B;
    __device__ __forceinline__ void operator()(const f32x4 (&acc)[2][2][4][2], const Unit& u, int wr, int wc, int fr, int fq) const {
        const int row0 = u.pm * 256 + wr * 64 + fr, col0 = u.pn * 256 + wc * 32 + 4 * fq;
#pragma unroll
        for (int ai = 0; ai < 2; ++ai)
#pragma unroll
            for (int m = 0; m < 4; ++m) { const int row = row0 + ai * 128 + m * 16;
                const bool real = row < MP + MS;
                const float* xr = row < MP ? xp + (size_t)row * DM : xs + (size_t)(real ? row - MP : 0) * DM;
                float* orow = row < MP ? out + O_Y + (size_t)row * DM : out + O_YS + (size_t)(real ? row - MP : 0) * DM;
#pragma unroll
                for (int bj = 0; bj < 2; ++bj)
#pragma unroll
                    for (int n = 0; n < 2; ++n) { const int c = col0 + bj * 128 + n * 16; f32x4 v = acc[ai][bj][m][n];
                        if (real) { v = v + *(const f32x4*)(xr + c); *(f32x4*)(orow + c) = v; } else v = (f32x4){0.f, 0.f, 0.f, 0.f};
                        u32x2 w; w.x = cvt_pk_bf16(v[0], v[1]); w.y = cvt_pk_bf16(v[2], v[3]); *(u32x2*)(X1B + (size_t)row * DM + c) = w; } }
    }
};


struct EpiInProjNP {
    static constexpr bool PERM = false, AFTER_DRAIN = false;
    bf16_t* PA; bf16_t* PB; const float* rs;
    __device__ __forceinline__ void operator()(const f32x4 (&acc)[2][2][4][2], const Unit& u, int wr, int wc, int fr, int fq) const {
        const int row0 = u.pm * 256 + wr * 64 + fr, pn = u.pn; bf16_t* base = pn < 12 ? PA + pn * 256 : PB + (pn - 12) * 256; const int col0 = wc * 32 + 4 * fq;
        const int kind = pn < 8 ? 0 : ((pn < 12 || pn >= 20) ? 1 : (pn < 16 ? 2 : 3));
#pragma unroll
        for (int ai = 0; ai < 2; ++ai)
#pragma unroll
            for (int m = 0; m < 4; ++m) { const int row = row0 + ai * 128 + m * 16; const float s = rs[row];
#pragma unroll
                for (int bj = 0; bj < 2; ++bj)
#pragma unroll
                    for (int n = 0; n < 2; ++n) { f32x4 v = acc[ai][bj][m][n] * s;
#pragma unroll
                        for (int j = 0; j < 4; ++j) { float x = v[j]; if (kind == 0) { f32x2 g2 = gelu_pk((f32x2){x, x}); x = g2.x; } else if (kind == 1) x = siluf_(x); else if (kind == 3) x = sigmoidf_(x); v[j] = x; }
                        u32x2 w; w.x = cvt_pk_bf16(v[0], v[1]); w.y = cvt_pk_bf16(v[2], v[3]); *(u32x2*)(base + (size_t)row * 3072 + col0 + bj * 128 + n * 16) = w; } }
    }
};
__device__ __forceinline__ void p1_inproj(const Ctx& F) {
    unsigned char* ws = F.ws; Gemm g{DM, DM, DM};
    OrderRowMajor S{64, 24, 64 * 24, F.G, F.bid, (const char*)(ws + WS_XB), (const char*)(ws + WS_WIN), (size_t)256 * DM * 2, (size_t)256 * DM * 2};
    EpiInProjNP E{(bf16_t*)(ws + WS_PROJA), (bf16_t*)(ws + WS_PROJB), (const float*)(ws + WS_RS)};
    pg8::gemm_phase<EpiInProjNP, OrderRowMajor>(F.lds, g, S, E);
}
__device__ __forceinline__ void p7_outproj(const Ctx& F) {
    unsigned char* ws = F.ws; Gemm g{DMIX, DMIX, DMIX};
    OrderRowMajor S{64, 4, 64 * 4, F.G, F.bid, (const char*)(ws + WS_Y), (const char*)(ws + WS_WOUT), (size_t)256 * DMIX * 2, (size_t)256 * DMIX * 2};
    EpiOutProj E{F.in[0], F.in[1], F.out, (bf16_t*)(ws + WS_X1B)};
    pg8::gemm_phase<EpiOutProj, OrderRowMajor>(F.lds, g, S, E);
}
__device__ __forceinline__ void p8_ple(const Ctx& F) {
    unsigned char* ws = F.ws;
    { Gemm g{DM, DM, DM}; OrderRowMajor S{NTILE, 4, NTILE * 4, F.G, F.bid, (const char*)(ws + WS_X1B), (const char*)(ws + WS_WPG), (size_t)256 * DM * 2, (size_t)256 * DM * 2};
      EpiBf16Act<3> E{(bf16_t*)(ws + WS_GB), DM, F.in[25], 1.0f}; pg8::gemm_phase<EpiBf16Act<3>, OrderRowMajor>(F.lds, g, S, E); }
    { Gemm g{DPLE, DPLE, DPLE}; OrderRowMajor S{NTILE, 4, NTILE * 4, F.G, (F.bid + 128) & 255, (const char*)(ws + WS_PB), (const char*)(ws + WS_WPP), (size_t)256 * DPLE * 2, (size_t)256 * DPLE * 2};
      EpiBf16Act<0> E{(bf16_t*)(ws + WS_EB), DM, nullptr, 1.0f}; pg8::gemm_phase<EpiBf16Act<0>, OrderRowMajor>(F.lds, g, S, E); }
}
typedef float f32x4_t __attribute__((ext_vector_type(4)));
__device__ __forceinline__ void p2b_spatial(const Ctx& F0) { Ctx F = F0; asm volatile("" : "+v"(F.tid), "+v"(F.lane));
    unsigned char* ws = F.ws;
    const bf16_t* PA = (const bf16_t*)(ws + WS_PROJA); const bf16_t* WSP = (const bf16_t*)(ws + WS_WSP); bf16_t* Y = (bf16_t*)(ws + WS_Y);
    const float* lng = F.in[10]; const float* lnb = F.in[11]; const float* bsp = F.in[13];
    LAS bf16_t* vnT = (LAS bf16_t*)F.lds;
    const int lane = F.lane, w = F.wave, l15 = lane & 15, lq = lane >> 4;
    for (int unit = F.bid; unit < NB * 16 * HA; unit += F.G) {
        const int b = unit >> 7, c = (unit >> 3) & 15, h = unit & 7, r0 = b * SEQ + c * 128;
        const float g0 = lng[h * 128 + 2 * lane], g1 = lng[h * 128 + 2 * lane + 1], b0 = lnb[h * 128 + 2 * lane], b1 = lnb[h * 128 + 2 * lane + 1];
#pragma unroll 2
        for (int p = 0; p < 8; ++p) { const int s0 = w * 16 + 2 * p;
            const unsigned wa = *(const unsigned*)(PA + (size_t)(r0 + s0) * 3072 + 1024 + h * 128 + 2 * lane), wb = *(const unsigned*)(PA + (size_t)(r0 + s0 + 1) * 3072 + 1024 + h * 128 + 2 * lane);
            float a0 = bf_lo(wa), a1 = bf_hi(wa), c0 = bf_lo(wb), c1 = bf_hi(wb);
            const float mua = wave_sum(a0 + a1) * (1.f / 128.f), mub = wave_sum(c0 + c1) * (1.f / 128.f);
            a0 -= mua; a1 -= mua; c0 -= mub; c1 -= mub;
            const float ra = 1.0f / sqrtf(wave_sum(a0 * a0 + a1 * a1) * (1.f / 128.f) + EPS), rb = 1.0f / sqrtf(wave_sum(c0 * c0 + c1 * c1) * (1.f / 128.f) + EPS);
            *(LAS unsigned*)(vnT + (2 * lane) * 136 + s0) = cvt_pk_bf16(a0 * ra * g0 + b0, c0 * rb * g0 + b0);
            *(LAS unsigned*)(vnT + (2 * lane + 1) * 136 + s0) = cvt_pk_bf16(a1 * ra * g1 + b1, c1 * rb * g1 + b1); }
        __syncthreads();
        const int t0 = 16 * w, nks = (t0 + 15) / 32 + 1;
        f32x4 acc[8];
#pragma unroll
        for (int nb = 0; nb < 8; ++nb) acc[nb] = (f32x4){0.f, 0.f, 0.f, 0.f};
        for (int ks = 0; ks < nks; ++ks) { const int k0 = ks * 32;
            const bf16x8 wf = *(const bf16x8*)(WSP + ((size_t)h * 128 + t0 + l15) * 128 + k0 + 8 * lq);
#pragma unroll
            for (int nb = 0; nb < 8; ++nb) { const bf16x8 vf = *(const LAS bf16x8*)(vnT + (nb * 16 + l15) * 136 + k0 + 8 * lq);
                acc[nb] = __builtin_amdgcn_mfma_f32_16x16x32_bf16(vf, wf, acc[nb], 0, 0, 0); } }
        const int t = t0 + l15; const float bt = bsp[h * 128 + t]; const size_t row = (size_t)(r0 + t);
#pragma unroll
        for (int nb = 0; nb < 8; ++nb) { const int d = nb * 16 + 4 * lq;
            const u32x2 uu = *(const u32x2*)(PA + row * 3072 + h * 128 + d), zz = *(const u32x2*)(PA + row * 3072 + 2048 + h * 128 + d);
            u32x2 o; o.x = cvt_pk_bf16(bf_lo(uu.x) * (acc[nb][0] + bt) * bf_lo(zz.x), bf_hi(uu.x) * (acc[nb][1] + bt) * bf_hi(zz.x));
            o.y = cvt_pk_bf16(bf_lo(uu.y) * (acc[nb][2] + bt) * bf_lo(zz.y), bf_hi(uu.y) * (acc[nb][3] + bt) * bf_hi(zz.y));
            *(u32x2*)(Y + row * DMIX + h * 128 + d) = o; }
        __syncthreads();
    }
    if (F.bid < 32 && F.wave == 0) mscan_wave(F, F.bid);
}

struct OrderHeadRows {
    int n, G, c; const char* A; size_t astep; const char* B; int pm0;
    __device__ __forceinline__ bool next(int i, Unit& u) const { const int L = i * G + c; if (L >= n) return false;
        u.pm = pm0 + (L >> 2); u.pn = 0; u.aux = L & 3; u.a = A + (size_t)u.pm * astep + (size_t)u.aux * 512; u.b = B + (size_t)u.aux * 131072; return true; }
};
struct OrderHeadT {
    int n, G, c; const char* W; const char* X; size_t xstep;
    __device__ __forceinline__ bool next(int i, Unit& u) const { const int L = i * G + c; if (L >= n) return false;
        const int b = L >> 5, h = (L >> 3) & 3, cc = L & 7; u.pm = b * 8 + cc; u.pn = L; u.aux = h; u.a = W + (size_t)h * 131072; u.b = X + (size_t)u.pm * xstep + (size_t)h * 512; return true; }
};
struct EpiQ {
    static constexpr bool PERM = false, AFTER_DRAIN = false;
    bf16_t* Q; bf16_t* PQ; const float* DG;
    __device__ __forceinline__ void operator()(const f32x4 (&acc)[2][2][4][2], const Unit& u, int wr, int wc, int fr, int fq) const {
        const int h = u.aux, rl0 = wr * 64 + fr, col0 = wc * 32 + 4 * fq; const bool prompt = u.pm < 64;
        const int unit = ((u.pm >> 3) * 4 + h) * 8 + (u.pm & 7);
#pragma unroll
        for (int ai = 0; ai < 2; ++ai)
#pragma unroll
            for (int m = 0; m < 4; ++m) { const int rl = rl0 + ai * 128 + m * 16, row = u.pm * 256 + rl;
#pragma unroll
                for (int bj = 0; bj < 2; ++bj)
#pragma unroll
                    for (int n = 0; n < 2; ++n) { const int c = col0 + bj * 128 + n * 16; const f32x4 v = acc[ai][bj][m][n];
                        u32x2 w; w.x = cvt_pk_bf16(v[0], v[1]); w.y = cvt_pk_bf16(v[2], v[3]); *(u32x2*)(Q + (size_t)row * 1024 + h * 256 + c) = w; }
                asm volatile("" ::: "memory"); }
        if (prompt) {
#pragma unroll
        for (int ai = 0; ai < 2; ++ai)
#pragma unroll
            for (int m = 0; m < 4; ++m) { const int rl = rl0 + ai * 128 + m * 16, row = u.pm * 256 + rl; const float g = DG[(size_t)h * MA + row];
#pragma unroll
                for (int bj = 0; bj < 2; ++bj)
#pragma unroll
                    for (int n = 0; n < 2; ++n) { const int c = col0 + bj * 128 + n * 16; const f32x4 v = acc[ai][bj][m][n] * g;
                        u32x2 w2; w2.x = cvt_pk_bf16(v[0], v[1]); w2.y = cvt_pk_bf16(v[2], v[3]); *(u32x2*)(PQ + ((size_t)unit * 256 + rl) * 512 + 256 + c) = w2; }
                asm volatile("" ::: "memory"); } }
    }
};
struct EpiHeadPlain {
    static constexpr bool PERM = false, AFTER_DRAIN = false;
    bf16_t* O; float scale; int row_off;
    __device__ __forceinline__ void operator()(const f32x4 (&acc)[2][2][4][2], const Unit& u, int wr, int wc, int fr, int fq) const {
        const int h = u.aux, row0 = u.pm * 256 - row_off + wr * 64 + fr, col0 = h * 256 + wc * 32 + 4 * fq;
#pragma unroll
        for (int ai = 0; ai < 2; ++ai)
#pragma unroll
            for (int m = 0; m < 4; ++m) { bf16_t* rowp = O + (size_t)(row0 + ai * 128 + m * 16) * 1024 + col0;
#pragma unroll
                for (int bj = 0; bj < 2; ++bj)
#pragma unroll
                    for (int n = 0; n < 2; ++n) { const f32x4 v = acc[ai][bj][m][n] * scale; u32x2 w; w.x = cvt_pk_bf16(v[0], v[1]); w.y = cvt_pk_bf16(v[2], v[3]); *(u32x2*)(rowp + bj * 128 + n * 16) = w; } }
    }
};
struct EpiUnitT {
    static constexpr bool PERM = false, AFTER_DRAIN = false;
    bf16_t* O; int ldo; const float* cs; float scale;
    __device__ __forceinline__ void operator()(const f32x4 (&acc)[2][2][4][2], const Unit& u, int wr, int wc, int fr, int fq) const {
        const int h = u.aux, rl0 = wr * 64 + fr, col0 = wc * 32 + 4 * fq; bf16_t* base = O + (size_t)u.pn * 256 * ldo;
#pragma unroll
        for (int ai = 0; ai < 2; ++ai)
#pragma unroll
            for (int m = 0; m < 4; ++m) { bf16_t* rowp = base + (size_t)(rl0 + ai * 128 + m * 16) * ldo + col0;
#pragma unroll
                for (int bj = 0; bj < 2; ++bj)
#pragma unroll
                    for (int n = 0; n < 2; ++n) { const f32x4 scv = cs ? *(const f32x4*)(cs + (size_t)h * MA + u.pm * 256 + col0 + bj * 128 + n * 16) * scale : (f32x4){scale, scale, scale, scale}; const f32x4 v = acc[ai][bj][m][n] * scv; u32x2 w; w.x = cvt_pk_bf16(v[0], v[1]); w.y = cvt_pk_bf16(v[2], v[3]); *(u32x2*)(rowp + bj * 128 + n * 16) = w; } }
    }
};
__device__ __forceinline__ void p3_qkv(const Ctx& F) {
    unsigned char* ws = F.ws; const char* XC = (const char*)(ws + WS_XB); const char* PBX = (const char*)(ws + WS_PROJB);
    { Gemm g{DM, 256, 256}; OrderHeadRows S{NTILE * 4, F.G, F.bid, XC, (size_t)256 * DM * 2, (const char*)(ws + WS_WQ), 0};
      EpiQ E{(bf16_t*)(ws + WS_Q), (bf16_t*)(ws + WS_PQ), (const float*)(ws + WS_DG)}; pg8::gemm_phase<EpiQ, OrderHeadRows>(F.lds, g, S, E); }
    { Gemm g{DM, 256, 256}; OrderHeadRows S{NTILE * 4, F.G, (F.bid + 4) & 255, XC, (size_t)256 * DM * 2, (const char*)(ws + WS_WK), 0};
      EpiHeadPlain E{(bf16_t*)(ws + WS_K), 0.0625f, 0}; pg8::gemm_phase<EpiHeadPlain, OrderHeadRows>(F.lds, g, S, E); }
    { Gemm g{3072, 256, 256}; OrderHeadRows S{4, F.G, (F.bid + 248) & 255, PBX, (size_t)256 * 3072 * 2, (const char*)(ws + WS_WV), 64};
      EpiHeadPlain E{(bf16_t*)(ws + WS_VS), 1.0f, MP}; pg8::gemm_phase<EpiHeadPlain, OrderHeadRows>(F.lds, g, S, E); }
    { Gemm g{256, 3072, 256}; OrderHeadT S{NUNIT, F.G, F.bid, (const char*)(ws + WS_WV), PBX, (size_t)256 * 3072 * 2};
      EpiUnitT E{(bf16_t*)(ws + WS_VC), 512, nullptr, 1.0f}; pg8::gemm_phase<EpiUnitT, OrderHeadT>(F.lds, g, S, E); }
    { Gemm g{256, DM, 256}; OrderHeadT S{NUNIT, F.G, F.bid, (const char*)(ws + WS_WK), XC, (size_t)256 * DM * 2};
      EpiUnitT E{(bf16_t*)(ws + WS_WKT), 256, (const float*)(ws + WS_DW), 0.0625f}; pg8::gemm_phase<EpiUnitT, OrderHeadT>(F.lds, g, S, E); }
}

struct OrderUnitNT {
    int n, G, c; const char* A; size_t astep_pm, astep_h, astep_u; const char* B; size_t bstep_pm, bstep_h, bstep_u;
    __device__ __forceinline__ bool next(int i, Unit& u) const { const int L = i * G + c; if (L >= n) return false;
        const int b = L >> 5, h = (L >> 3) & 3, cc = L & 7; u.pm = b * 8 + cc; u.pn = L; u.aux = h;
        u.a = A + (size_t)u.pm * astep_pm + (size_t)h * astep_h + (size_t)L * astep_u; u.b = B + (size_t)u.pm * bstep_pm + (size_t)h * bstep_h + (size_t)L * bstep_u; return true; }
};
struct EpiScore {
    static constexpr bool PERM = false, AFTER_DRAIN = false;
    bf16_t* PQ; const float* DA; const float* DR; float* DENP;
    __device__ __forceinline__ void operator()(const f32x4 (&acc)[2][2][4][2], const Unit& u, int wr, int wc, int fr, int fq) const {
        const int h = u.aux, rl0 = wr * 64 + fr, col0 = wc * 32 + 4 * fq; const size_t vb = (size_t)h * MA + (size_t)u.pm * 256;
#pragma unroll
        for (int ai = 0; ai < 2; ++ai)
#pragma unroll
            for (int m = 0; m < 4; ++m) { int t_ = rl0 + ai * 128 + m * 16; asm volatile("" : "+v"(t_)); const int t = t_; const float at = DA[vb + t]; float rs_ = 0.f; bf16_t* rowp = PQ + ((size_t)u.pn * 256 + t) * 512 + col0;
#pragma unroll
                for (int bj = 0; bj < 2; ++bj)
#pragma unroll
                    for (int n = 0; n < 2; ++n) { const int c = col0 + bj * 128 + n * 16; f32x4 v; const f32x4 rr = *(const f32x4*)(DR + vb + c);
#pragma unroll
                        for (int j = 0; j < 4; ++j) { const float e = fast_exp(fminf(at + rr[j], 0.f)); v[j] = (c + j <= t) ? acc[ai][bj][m][n][j] * e : 0.f; rs_ += v[j]; }
                        u32x2 w; w.x = cvt_pk_bf16(v[0], v[1]); w.y = cvt_pk_bf16(v[2], v[3]); *(u32x2*)(rowp + bj * 128 + n * 16) = w; }
                rs_ += __shfl_xor(rs_, 16); rs_ += __shfl_xor(rs_, 32);
                if (fq == 0) DENP[(vb + t) * 4 + wc] = rs_; asm volatile("" ::: "memory"); }
    }
};
struct EpiF32Unit {
    static constexpr bool PERM = false, AFTER_DRAIN = false;
    float* O;
    __device__ __forceinline__ void operator()(const f32x4 (&acc)[2][2][4][2], const Unit& u, int wr, int wc, int fr, int fq) const {
        float* base = O + (size_t)u.pn * 65536 + (size_t)(wr * 64 + fr) * 256 + wc * 32 + 4 * fq;
#pragma unroll
        for (int ai = 0; ai < 2; ++ai)
#pragma unroll
            for (int m = 0; m < 4; ++m)
#pragma unroll
                for (int bj = 0; bj < 2; ++bj)
#pragma unroll
                    for (int n = 0; n < 2; ++n) *(f32x4*)(base + (size_t)(ai * 128 + m * 16) * 256 + bj * 128 + n * 16) = acc[ai][bj][m][n];
    }
};
__device__ __forceinline__ void p4_scores_dc(const Ctx& F) {
    unsigned char* ws = F.ws;
    { Gemm g{DM, DM, 256}; OrderUnitNT S{NUNIT, F.G, F.bid, (const char*)(ws + WS_Q), (size_t)256 * DM * 2, 512, 0, (const char*)(ws + WS_K), (size_t)256 * DM * 2, 512, 0};
      EpiScore E{(bf16_t*)(ws + WS_PQ), (const float*)(ws + WS_DA), (const float*)(ws + WS_DR), (float*)(ws + WS_DENP)}; pg8::gemm_phase<EpiScore, OrderUnitNT>(F.lds, g, S, E); }
    { Gemm g{512, 256, 256}; OrderUnitNT S{NUNIT, F.G, F.bid, (const char*)(ws + WS_VC), 0, 0, (size_t)256 * 512 * 2, (const char*)(ws + WS_WKT), 0, 0, (size_t)256 * 256 * 2};
      EpiF32Unit E{F.out + O_Y}; pg8::gemm_phase<EpiF32Unit, OrderUnitNT>(F.lds, g, S, E); }
    for (int u = F.bid; u < NUNIT; u += F.G) { const int d = F.tid >> 1, hf = F.tid & 1; const bf16_t* src = (const bf16_t*)(ws + WS_WKT) + ((size_t)u * 256 + d) * 256 + hf * 128; float s = 0.f;
#pragma unroll
        for (int j = 0; j < 16; ++j) { float t8[8]; unpack8(*(const u32x4*)(src + j * 8), t8);
#pragma unroll
            for (int e = 0; e < 8; ++e) s += t8[e]; }
        s += __shfl_xor(s, 1); if (hf == 0) ((float*)(ws + WS_DN))[(size_t)u * 256 + d] = s; }
}

__device__ __forceinline__ void p5_scan_sample(const Ctx& F0) { Ctx F = F0; asm volatile("" : "+v"(F.tid), "+v"(F.lane));
    unsigned char* ws = F.ws; const float* DG = (const float*)(ws + WS_DG); const float* DC = F.out + O_Y; bf16_t* VC = (bf16_t*)(ws + WS_VC);
    for (int idx = F.bid * 512 + F.tid; idx < 32 * 16384; idx += F.G * 512) { const int bh = idx >> 14, q4 = idx & 16383, e = q4 >> 6, d4 = (q4 & 63) * 4, b = bh >> 2, h = bh & 3;
        f32x4 dc[8]; float ge[8];
#pragma unroll
        for (int c = 0; c < 8; ++c) { dc[c] = *(const f32x4*)(DC + ((size_t)(bh * 8 + c) * 256 + e) * 256 + d4); ge[c] = DG[(size_t)h * MA + b * SEQ + c * 256 + 255]; }
        f32x4 C = (f32x4){0.f, 0.f, 0.f, 0.f};
#pragma unroll
        for (int c = 0; c < 8; ++c) { u32x2 w; w.x = cvt_pk_bf16(C[0], C[1]); w.y = cvt_pk_bf16(C[2], C[3]); *(u32x2*)(VC + ((size_t)(bh * 8 + c) * 256 + e) * 512 + 256 + d4) = w; C = C * ge[c] + dc[c]; }
        *(f32x4*)(F.out + O_CP + ((size_t)bh * 256 + e) * 256 + d4) = C; }
    LAS float* npv = (LAS float*)F.lds;
    for (int u = F.bid; u < NUNIT; u += F.G) { const int bh = u >> 3, cc = u & 7, b = bh >> 2, h = bh & 3;
        __syncthreads();
        if (F.tid < 256) { float n = 0.f; const float* DN = (const float*)(ws + WS_DN);
            for (int j = 0; j < cc; ++j) n = DG[(size_t)h * MA + b * SEQ + j * 256 + 255] * n + DN[(size_t)(bh * 8 + j) * 256 + F.tid];
            npv[F.tid] = n; if (cc == 7) F.out[O_NP + (size_t)bh * 256 + F.tid] = DG[(size_t)h * MA + b * SEQ + 7 * 256 + 255] * n + DN[(size_t)u * 256 + F.tid]; }
        __syncthreads();
        const f32x4 nv = *(const LAS f32x4*)(npv + 4 * F.lane); const bf16_t* Q = (const bf16_t*)(ws + WS_Q);
        for (int r = 0; r < 32; ++r) { const size_t row = (size_t)b * SEQ + cc * 256 + F.wave * 32 + r; const u32x2 qq = *(const u32x2*)(Q + row * 1024 + h * 256 + 4 * F.lane);
            const float s = wave_sum(bf_lo(qq.x) * nv[0] + bf_hi(qq.x) * nv[1] + bf_lo(qq.y) * nv[2] + bf_hi(qq.y) * nv[3]); if (F.lane == 0) ((float*)(ws + WS_QN))[(size_t)h * MA + row] = s; } }
    LAS float* hs = (LAS float*)F.lds + 512; LAS float* red = (LAS float*)F.lds + 1024;
    for (int job = F.bid; job < MS * HB; job += F.G) { const int i = job >> 2, h = job & 3; const size_t row = MP + i;
        const bf16_t* Q = (const bf16_t*)(ws + WS_Q) + row * 1024 + h * 256; const bf16_t* K = (const bf16_t*)(ws + WS_K) + row * 1024 + h * 256; const bf16_t* V = (const bf16_t*)(ws + WS_VS) + (size_t)i * 1024 + h * 256;
        const u32x2 qw = *(const u32x2*)(Q + 4 * F.lane), kw = *(const u32x2*)(K + 4 * F.lane);
        const f32x4 q4 = (f32x4){bf_lo(qw.x), bf_hi(qw.x), bf_lo(qw.y), bf_hi(qw.y)}, k4 = (f32x4){bf_lo(kw.x), bf_hi(kw.x), bf_lo(kw.y), bf_hi(kw.y)};
        const f32x4 n0 = *(const f32x4*)(F.in[3] + ((size_t)i * 4 + h) * 256 + 4 * F.lane);
        const float li = ((const float*)(ws + WS_GLI))[(size_t)h * MA + row], lf = ((const float*)(ws + WS_GLF))[(size_t)h * MA + row], m0 = F.in[4][i * 4 + h];
        const float mn = fmaxf(lf + m0, li), g = __expf(lf + m0 - mn), wi = __expf(li - mn);
        const float qk = wave_sum(q4[0] * k4[0] + q4[1] * k4[1] + q4[2] * k4[2] + q4[3] * k4[3]), nq = wave_sum(n0[0] * q4[0] + n0[1] * q4[1] + n0[2] * q4[2] + n0[3] * q4[3]);
        const float sc = wi * qk, den = sc + g * nq, dinv = 1.0f / fmaxf(fabsf(den), __expf(-mn));
        const float* C0 = F.in[2] + (((size_t)i * 4 + h) * 256 + F.wave * 32) * 256 + 4 * F.lane; float* C1 = F.out + O_CS + (((size_t)i * 4 + h) * 256 + F.wave * 32) * 256 + 4 * F.lane;
        __syncthreads();
#pragma unroll 1
        for (int r8 = 0; r8 < 32; r8 += 8) { f32x4 c[8]; float ve[8], cq[8];
#pragma unroll
            for (int r = 0; r < 8; ++r) { c[r] = *(const f32x4*)(C0 + (size_t)(r8 + r) * 256); ve[r] = bf2f(V[F.wave * 32 + r8 + r]); }
#pragma unroll
            for (int r = 0; r < 8; ++r) { cq[r] = c[r][0] * q4[0] + c[r][1] * q4[1] + c[r][2] * q4[2] + c[r][3] * q4[3]; const float wv = wi * ve[r]; *(f32x4*)(C1 + (size_t)(r8 + r) * 256) = c[r] * g + k4 * wv; }
#pragma unroll
            for (int r = 0; r < 8; ++r) { cq[r] = wave_sum(cq[r]); if (F.lane == 0) hs[F.wave * 32 + r8 + r] = (sc * ve[r] + g * cq[r]) * dinv; } }
        if (F.wave == 0) { *(f32x4*)(F.out + O_NS + ((size_t)i * 4 + h) * 256 + 4 * F.lane) = n0 * g + k4 * wi; if (F.lane == 0) F.out[O_MS + i * 4 + h] = mn; }
        __syncthreads();
        const bf16_t* PB = (const bf16_t*)(ws + WS_PROJB) + row * 3072; const bf16_t* XC = (const bf16_t*)(ws + WS_XB) + row * DM;
        float x = 0.f; const int ch = h * 256 + (F.tid & 255);
        if (F.tid < 256) x = hs[F.tid] * bf2f(PB[1024 + ch]);
        float p = wave_sum(x); if (F.lane == 0) red[F.wave] = p;
        __syncthreads();
        const float mu = (red[0] + red[1] + red[2] + red[3]) * (1.f / 256.f), dx = x - mu;
        __syncthreads();
        p = wave_sum(F.tid < 256 ? dx * dx : 0.f); if (F.lane == 0) red[F.wave] = p;
        __syncthreads();
        const float rstd = 1.0f / sqrtf((red[0] + red[1] + red[2] + red[3]) * (1.f / 256.f) + EPS);
        if (F.tid < 256) ((bf16_t*)(ws + WS_Y))[row * DMIX + 1024 + ch] = f2bf((dx * rstd * F.in[21][ch] + F.in[22][ch] * bf2f(XC[ch])) * bf2f(PB[2048 + ch]));
        __syncthreads();
    }
}

struct EpiHOut {
    static constexpr bool PERM = false, AFTER_DRAIN = true;
    const float* DENP; const float* DG; const float* QN; const float* DEM; const bf16_t* PB; const bf16_t* XC; bf16_t* Y; const float* gng; const float* skip;
    __device__ __forceinline__ void fused(f32x4 (&acc)[2][2][4][2], const Unit& u, int wr, int wc, int fr, int fq, LAS unsigned char* lds, int wid, int lane) const {
        const int h = u.aux, rl0 = wr * 64 + fr, col0 = wc * 32 + 4 * fq; const size_t vb = (size_t)h * MA + (size_t)u.pm * 256;
        LAS float* P1 = (LAS float*)lds; LAS float* P2 = (LAS float*)lds + 1024;
#pragma unroll
        for (int ai = 0; ai < 2; ++ai)
#pragma unroll
            for (int m = 0; m < 4; ++m) { const int t = rl0 + ai * 128 + m * 16; const size_t row = (size_t)u.pm * 256 + t;
                const f32x4 dp = *(const f32x4*)(DENP + (vb + t) * 4); const float den = (dp[0] + dp[1]) + (dp[2] + dp[3]) + DG[vb + t] * QN[vb + t];
                const float dinv = 1.0f / fmaxf(fabsf(den), DEM[vb + t]); float s = 0.f;
#pragma unroll
                for (int bj = 0; bj < 2; ++bj)
#pragma unroll
                    for (int n = 0; n < 2; ++n) { const int c = col0 + bj * 128 + n * 16; const u32x2 ow = *(const u32x2*)(PB + row * 3072 + 1024 + h * 256 + c);
                        f32x4 v = acc[ai][bj][m][n] * dinv; v[0] *= bf_lo(ow.x); v[1] *= bf_hi(ow.x); v[2] *= bf_lo(ow.y); v[3] *= bf_hi(ow.y); acc[ai][bj][m][n] = v; s += (v[0] + v[1]) + (v[2] + v[3]); }
                s += __shfl_xor(s, 16); s += __shfl_xor(s, 32); if (fq == 0) P1[t * 4 + wc] = s; }
        asm volatile("s_waitcnt lgkmcnt(0)" ::: "memory"); __builtin_amdgcn_s_barrier(); asm volatile("" ::: "memory");
#pragma unroll
        for (int ai = 0; ai < 2; ++ai)
#pragma unroll
            for (int m = 0; m < 4; ++m) { const int t = rl0 + ai * 128 + m * 16; const f32x4 ps = *(const LAS f32x4*)(P1 + t * 4); const float mu = ((ps[0] + ps[1]) + (ps[2] + ps[3])) * (1.f / 256.f); float q = 0.f;
#pragma unroll
                for (int bj = 0; bj < 2; ++bj)
#pragma unroll
                    for (int n = 0; n < 2; ++n) { f32x4 v = acc[ai][bj][m][n] - mu; acc[ai][bj][m][n] = v; q += (v[0] * v[0] + v[1] * v[1]) + (v[2] * v[2] + v[3] * v[3]); }
                q += __shfl_xor(q, 16); q += __shfl_xor(q, 32); if (fq == 0) P2[t * 4 + wc] = q; }
        asm volatile("s_waitcnt lgkmcnt(0)" ::: "memory"); __builtin_amdgcn_s_barrier(); asm volatile("" ::: "memory");
#pragma unroll
        for (int ai = 0; ai < 2; ++ai)
#pragma unroll
            for (int m = 0; m < 4; ++m) { const int t = rl0 + ai * 128 + m * 16; const size_t row = (size_t)u.pm * 256 + t; const f32x4 ps = *(const LAS f32x4*)(P2 + t * 4);
                const float rstd = 1.0f / sqrtf(((ps[0] + ps[1]) + (ps[2] + ps[3])) * (1.f / 256.f) + EPS);
#pragma unroll
                for (int bj = 0; bj < 2; ++bj)
#pragma unroll
                    for (int n = 0; n < 2; ++n) { const int c = h * 256 + col0 + bj * 128 + n * 16; const u32x2 xw = *(const u32x2*)(XC + row * DM + c), zw = *(const u32x2*)(PB + row * 3072 + 2048 + c);
                        const f32x4 ggv = *(const f32x4*)(gng + c), skv = *(const f32x4*)(skip + c); const f32x4 v = acc[ai][bj][m][n] * rstd * ggv; u32x2 w;
                        w.x = cvt_pk_bf16((v[0] + skv[0] * bf_lo(xw.x)) * bf_lo(zw.x), (v[1] + skv[1] * bf_hi(xw.x)) * bf_hi(zw.x));
                        w.y = cvt_pk_bf16((v[2] + skv[2] * bf_lo(xw.y)) * bf_lo(zw.y), (v[3] + skv[3] * bf_hi(xw.y)) * bf_hi(zw.y));
                        *(u32x2*)(Y + row * DMIX + 1024 + c) = w; }
                asm volatile("" ::: "memory"); }
    }
};
__device__ __forceinline__ void p6_hout(const Ctx& F) {
    unsigned char* ws = F.ws; Gemm g{512, 512, 512};
    OrderUnitNT S{NUNIT, F.G, F.bid, (const char*)(ws + WS_PQ), 0, 0, (size_t)256 * 512 * 2, (const char*)(ws + WS_VC), 0, 0, (size_t)256 * 512 * 2};
    EpiHOut E{(const float*)(ws + WS_DENP), (const float*)(ws + WS_DG), (const float*)(ws + WS_QN), (const float*)(ws + WS_DEM), (const bf16_t*)(ws + WS_PROJB), (const bf16_t*)(ws + WS_XB), (bf16_t*)(ws + WS_Y), F.in[21], F.in[22]};
    pg8::gemm_phase<EpiHOut, OrderUnitNT, false, true>(F.lds, g, S, E);
}
template <class PtrF, class Ef>
__device__ __forceinline__ void sample_gemm(const Ctx& F, int nitems, int K, int lda, int ldb, const PtrF& P, const Ef& E) {
    const int l15 = F.lane & 15, lq = F.lane >> 4, w = F.wave;
    for (int item = F.bid; item < nitems; item += F.G) {
        const bf16_t* A; const bf16_t* B; P(item, A, B);
        const bf16_t* ap = A + (size_t)(16 * w + l15) * lda + 8 * lq; const bf16_t* bp = B + (size_t)l15 * ldb + 8 * lq;
        f32x4 acc = (f32x4){0.f, 0.f, 0.f, 0.f};
        for (int k0 = 0; k0 < K; k0 += 256) { bf16x8 a[8], b[8];
#pragma unroll
            for (int j = 0; j < 8; ++j) { a[j] = *(const bf16x8*)(ap + k0 + 32 * j); b[j] = *(const bf16x8*)(bp + k0 + 32 * j); }
#pragma unroll
            for (int j = 0; j < 8; ++j) acc = __builtin_amdgcn_mfma_f32_16x16x32_bf16(a[j], b[j], acc, 0, 0, 0); }
#pragma unroll
        for (int r = 0; r < 4; ++r) E(item, 16 * w + 4 * lq + r, l15, acc[r]);
    }
}
__device__ __forceinline__ void sample_inproj(const Ctx& F) {
    unsigned char* ws = F.ws; const bf16_t* XB = (const bf16_t*)(ws + WS_XB) + (size_t)MP * DM; const bf16_t* W = (const bf16_t*)(ws + WS_WIN);
    bf16_t* PA = (bf16_t*)(ws + WS_PROJA) + (size_t)MP * 3072; bf16_t* PB = (bf16_t*)(ws + WS_PROJB) + (size_t)MP * 3072; const float* rs = (const float*)(ws + WS_RS) + MP;
    sample_gemm(F, NIN / 16, DM, DM, DM,
        [=](int item, const bf16_t*& A, const bf16_t*& B) { A = XB; B = W + (size_t)item * 16 * DM; },
        [=](int item, int r, int c, float acc) { const int col = item * 16 + c, grp = col >> 10; float v = acc * rs[r];
            if (grp < 2) { const f32x2 g2 = gelu_pk((f32x2){v, v}); v = g2.x; } else if (grp == 2 || grp == 5) v = siluf_(v); else if (grp == 4) v = sigmoidf_(v);
            bf16_t* dst = col < 3072 ? PA + (size_t)r * 3072 + col : PB + (size_t)r * 3072 + (col - 3072); *dst = f2bf(v); });
}
__device__ __forceinline__ void sample_qkv(const Ctx& F) {
    unsigned char* ws = F.ws; const bf16_t* XC = (const bf16_t*)(ws + WS_XB) + (size_t)MP * DM; const bf16_t* XBr = (const bf16_t*)(ws + WS_PROJB) + (size_t)MP * 3072;
    const bf16_t* WQ = (const bf16_t*)(ws + WS_WQ); const bf16_t* WK = (const bf16_t*)(ws + WS_WK); const bf16_t* WV = (const bf16_t*)(ws + WS_WV);
    bf16_t* Q = (bf16_t*)(ws + WS_Q) + (size_t)MP * 1024; bf16_t* Kk = (bf16_t*)(ws + WS_K) + (size_t)MP * 1024; bf16_t* Vs = (bf16_t*)(ws + WS_VS);
    sample_gemm(F, 128, 256, DM, 256,
        [=](int item, const bf16_t*& A, const bf16_t*& B) { const int which = item >> 6, it = item & 63, h = it >> 4; A = XC + h * 256; B = (which ? WK : WQ) + (size_t)h * 65536 + (size_t)(it & 15) * 16 * 256; },
        [=](int item, int r, int c, float acc) { const int which = item >> 6, it = item & 63; bf16_t* O = which ? Kk : Q; O[(size_t)r * 1024 + it * 16 + c] = f2bf(which ? acc * 0.0625f : acc); });
    sample_gemm(F, 64, 256, 3072, 256,
        [=](int item, const bf16_t*& A, const bf16_t*& B) { const int h = item >> 4; A = XBr + h * 256; B = WV + (size_t)h * 65536 + (size_t)(item & 15) * 16 * 256; },
        [=](int item, int r, int c, float acc) { Vs[(size_t)r * 1024 + item * 16 + c] = f2bf(acc); });
}
__device__ __forceinline__ void sample_outproj(const Ctx& F) {
    unsigned char* ws = F.ws; const bf16_t* Y = (const bf16_t*)(ws + WS_Y) + (size_t)MP * DMIX; const bf16_t* W = (const bf16_t*)(ws + WS_WOUT);
    const float* xs = F.in[1]; float* out = F.out + O_YS; bf16_t* X1B = (bf16_t*)(ws + WS_X1B) + (size_t)MP * DM;
    sample_gemm(F, DM / 16, DMIX, DMIX, DMIX,
        [=](int item, const bf16_t*& A, const bf16_t*& B) { A = Y; B = W + (size_t)item * 16 * DMIX; },
        [=](int item, int r, int c, float acc) { const int col = item * 16 + c; const float v = xs[(size_t)r * DM + col] + acc; out[(size_t)r * DM + col] = v; X1B[(size_t)r * DM + col] = f2bf(v); });
}
__device__ __forceinline__ void sample_ple(const Ctx& F) {
    unsigned char* ws = F.ws; const bf16_t* X1B = (const bf16_t*)(ws + WS_X1B) + (size_t)MP * DM; const bf16_t* PBs = (const bf16_t*)(ws + WS_PB) + (size_t)MP * DPLE;
    const bf16_t* WG = (const bf16_t*)(ws + WS_WPG); const bf16_t* WP = (const bf16_t*)(ws + WS_WPP); const float* bias = F.in[25];
    bf16_t* GB = (bf16_t*)(ws + WS_GB) + (size_t)MP * DM; bf16_t* EB = (bf16_t*)(ws + WS_EB) + (size_t)MP * DM;
    sample_gemm(F, DM / 16, DM, DM, DM,
        [=](int item, const bf16_t*& A, const bf16_t*& B) { A = X1B; B = WG + (size_t)item * 16 * DM; },
        [=](int item, int r, int c, float acc) { const int col = item * 16 + c; GB[(size_t)r * DM + col] = f2bf(sigmoidf_(acc + bias[col])); });
    sample_gemm(F, DM / 16, DPLE, DPLE, DPLE,
        [=](int item, const bf16_t*& A, const bf16_t*& B) { A = PBs; B = WP + (size_t)item * 16 * DPLE; },
        [=](int item, int r, int c, float acc) { EB[(size_t)r * DM + item * 16 + c] = f2bf(acc); });
}
template <class PtrF, class Ef>
__device__ __forceinline__ void sample_gemm_ks(const Ctx& F, int nitems, int K, int lda, int ldb, const PtrF& P, const Ef& E) {
    const int l15 = F.lane & 15, lq = F.lane >> 4, w = F.wave; LAS f32x4* red = (LAS f32x4*)F.lds;
    const int ks = K >> 3;
    for (int item = F.bid; item < nitems; item += F.G) {
        const bf16_t* A; const bf16_t* B; P(item, A, B);
        const bf16_t* ap = A + (size_t)l15 * lda + w * ks + 8 * lq; const bf16_t* bp = B + (size_t)l15 * ldb + w * ks + 8 * lq;
        f32x4 acc[2][4];
#pragma unroll
        for (int m = 0; m < 2; ++m)
#pragma unroll
            for (int n = 0; n < 4; ++n) acc[m][n] = (f32x4){0.f, 0.f, 0.f, 0.f};
        for (int k0 = 0; k0 < ks; k0 += 128) { bf16x8 a[4][2], b[4][4];
#pragma unroll
            for (int j = 0; j < 4; ++j) {
#pragma unroll
                for (int m = 0; m < 2; ++m) a[j][m] = (k0 + 32 * j < ks) ? *(const bf16x8*)(ap + (size_t)(16 * m) * lda + k0 + 32 * j) : (bf16x8){0, 0, 0, 0, 0, 0, 0, 0};
#pragma unroll
                for (int n = 0; n < 4; ++n) b[j][n] = (k0 + 32 * j < ks) ? *(const bf16x8*)(bp + (size_t)(16 * n) * ldb + k0 + 32 * j) : (bf16x8){0, 0, 0, 0, 0, 0, 0, 0}; }
#pragma unroll
            for (int j = 0; j < 4; ++j)
#pragma unroll
                for (int m = 0; m < 2; ++m)
#pragma unroll
                    for (int n = 0; n < 4; ++n) acc[m][n] = __builtin_amdgcn_mfma_f32_16x16x32_bf16(a[j][m], b[j][n], acc[m][n], 0, 0, 0); }
        __syncthreads();
#pragma unroll
        for (int m = 0; m < 2; ++m)
#pragma unroll
            for (int n = 0; n < 4; ++n) red[(w * 8 + m * 4 + n) * 64 + F.lane] = acc[m][n];
        __syncthreads();
        f32x4 s = red[(0 * 8 + w) * 64 + F.lane];
#pragma unroll
        for (int ww = 1; ww < 8; ++ww) s = s + red[(ww * 8 + w) * 64 + F.lane];
        const int mt = w >> 2, nt = w & 3;
#pragma unroll
        for (int r = 0; r < 4; ++r) E(item, 16 * mt + 4 * lq + r, 16 * nt + l15, s[r]);
    }
    __syncthreads();
}
__device__ __forceinline__ void sample_outproj_ks(const Ctx& F) {
    unsigned char* ws = F.ws; const bf16_t* Y = (const bf16_t*)(ws + WS_Y) + (size_t)MP * DMIX; const bf16_t* W = (const bf16_t*)(ws + WS_WOUT);
    const float* xs = F.in[1]; float* out = F.out + O_YS; bf16_t* X1B = (bf16_t*)(ws + WS_X1B) + (size_t)MP * DM;
    sample_gemm_ks(F, 64, DMIX, DMIX, DMIX,
        [=](int item, const bf16_t*& A, const bf16_t*& B) { A = Y + (size_t)(item & 3) * 32 * DMIX; B = W + (size_t)(item >> 2) * 64 * DMIX; },
        [=](int item, int r, int c, float acc) { const int row = (item & 3) * 32 + r, col = (item >> 2) * 64 + c; const float v = xs[(size_t)row * DM + col] + acc; out[(size_t)row * DM + col] = v; X1B[(size_t)row * DM + col] = f2bf(v); });
}
#define XB_TMO      128
#define XB_XCNT(j)  (256  + 64 * (j))
#define XB_XSUB(j)  (1280 + 64 * (j))
#define XB_XGEN(j)  (2304 + 64 * (j))
#define XB_TOP      3328
#define XB_TOPGEN   3392
#define XCD_BAR_WORDS 3456
#define XB_SPIN_CAP (1u << 18)
__device__ __forceinline__ unsigned xb_ld(unsigned* p)              { return __hip_atomic_load(p, __ATOMIC_RELAXED, __HIP_MEMORY_SCOPE_AGENT); }
__device__ __forceinline__ unsigned xb_add(unsigned* p, unsigned v) { return __hip_atomic_fetch_add(p, v, __ATOMIC_RELAXED, __HIP_MEMORY_SCOPE_AGENT); }
__device__ __forceinline__ unsigned xb_xcc_id() { return (unsigned)__builtin_amdgcn_s_getreg((3 << 11) | 20) & 0xFu; }
#define XB_SPIN(cond, bar) do { unsigned _sp = 0; while (cond) { __builtin_amdgcn_s_sleep(1); \
    if ((++_sp & 255u) == 0u) { if (xb_ld(&(bar)[XB_TMO])) break; if (_sp > XB_SPIN_CAP) { atomicAdd(&(bar)[XB_TMO], 1u); break; } } } } while (0)
struct XcdBarrier { unsigned* bar; unsigned x; volatile LAS unsigned* st; };
__device__ __forceinline__ XcdBarrier xcd_barrier_post(unsigned* bar, volatile LAS unsigned* st) {
    XcdBarrier b; b.bar = bar; b.x = xb_xcc_id(); b.st = st;
    if (threadIdx.x == 0) (void)xb_add(&bar[XB_XCNT(b.x)], 1u);
    return b;
}
__device__ __forceinline__ void xcd_barrier_complete(unsigned* bar, unsigned x, unsigned& nloc, unsigned& nx) {
    const unsigned G = gridDim.x * gridDim.y * gridDim.z;
    unsigned sum, cnt, mine, sp = 0u;
    for (;;) {
        sum = 0u; cnt = 0u; mine = 0u;
#pragma unroll
        for (unsigned j = 0; j < 16; ++j) { const unsigned c = xb_ld(&bar[XB_XCNT(j)]); sum += c; cnt += (c > 0u) ? 1u : 0u; mine = (j == x) ? c : mine; }
        if (sum == G) break;
        __builtin_amdgcn_s_sleep(1);
        if ((++sp & 255u) == 0u) { if (xb_ld(&bar[XB_TMO])) break; if (sp > XB_SPIN_CAP) { atomicAdd(&bar[XB_TMO], 1u); break; } }
    }
    nloc = mine > 0u ? mine : 1u; nx = cnt > 0u ? cnt : 1u;
}
__device__ __forceinline__ void xcd_barrier(const XcdBarrier& b) {
    asm volatile("s_waitcnt vmcnt(0)" ::: "memory");
    __syncthreads();
    if (threadIdx.x == 0) {
        unsigned* bar = b.bar;
        __builtin_amdgcn_s_waitcnt(0);
        unsigned nloc = b.st[0], nx = b.st[1];
        if (nloc == 0u) { xcd_barrier_complete(bar, b.x, nloc, nx); b.st[0] = nloc; b.st[1] = nx; }
        const unsigned old = xb_add(&bar[XB_XSUB(b.x)], 1u);
        const unsigned gen = old / nloc;
        if (old + 1u == (gen + 1u) * nloc) {
            __builtin_amdgcn_fence(__ATOMIC_RELEASE, "agent");
            asm volatile("s_waitcnt vmcnt(0)" ::: "memory");
            const unsigned og = xb_add(&bar[XB_TOP], 1u);
            const unsigned tg = og / nx;
            if (og + 1u == (tg + 1u) * nx) xb_add(&bar[XB_TOPGEN], 1u);
            else XB_SPIN(xb_ld(&bar[XB_TOPGEN]) == tg, bar);
            __builtin_amdgcn_fence(__ATOMIC_ACQUIRE, "agent");
            xb_add(&bar[XB_XGEN(b.x)], 1u);
            asm volatile("s_waitcnt vmcnt(0)" ::: "memory");
        } else {
            XB_SPIN(xb_ld(&bar[XB_XGEN(b.x)]) == gen, bar);
            __builtin_amdgcn_fence(__ATOMIC_ACQUIRE, "agent");
            asm volatile("s_waitcnt vmcnt(0)" ::: "memory");
        }
    }
    __syncthreads();
}
__global__ void __launch_bounds__(512, 2) mega(Args args) {
    MAKE_CTX();
    volatile LAS unsigned* MISC = (volatile LAS unsigned*)(F.lds + 131072 + 320);
    if (F.tid < 32) MISC[F.tid] = 0u;
    __syncthreads();
    const XcdBarrier bar = xcd_barrier_post((unsigned*)(ws + WS_CTL), MISC + 8);
#define GRID_SYNC() xcd_barrier(bar)
    p0_prologue(F);      GRID_SYNC();
    sample_inproj(F); p1_inproj(F); GRID_SYNC();
    p2a_conv_gates(F);   GRID_SYNC();
    p2b_spatial(F);      GRID_SYNC();
    p3_qkv(F);           GRID_SYNC();
    p4_scores_dc(F);     GRID_SYNC();
    p5_scan_sample(F);   GRID_SYNC();
    p6_hout(F);          GRID_SYNC();
    sample_outproj_ks(F); p7_outproj(F); GRID_SYNC();
    p8_ple(F);           GRID_SYNC();
    p9_final(F);
}

extern "C" void kernel_launch(void* const* d_in, const int* in_sizes, int n_in, void* d_out, int out_size, void* d_ws, size_t ws_size, hipStream_t stream) {
    static int grid = 0;
    if (grid == 0) {
        if (n_in != 29 || (size_t)out_size != O_END || ws_size < WS_END) { fprintf(stderr, "kernel_launch: unexpected shapes (n_in %d out %d ws %zu)\n", n_in, out_size, ws_size); grid = -1; return; }
        int dev = 0, cus = 0, per_cu = 0;
        if (hipGetDevice(&dev) != hipSuccess || hipDeviceGetAttribute(&cus, hipDeviceAttributeMultiprocessorCount, dev) != hipSuccess) { grid = -1; return; }
        if (hipFuncSetAttribute((const void*)mega, hipFuncAttributeMaxDynamicSharedMemorySize, LDS_BYTES) != hipSuccess) { fprintf(stderr, "kernel_launch: hipFuncSetAttribute failed\n"); grid = -1; return; }
        if (hipOccupancyMaxActiveBlocksPerMultiprocessor(&per_cu, (const void*)mega, 512, LDS_BYTES) != hipSuccess || per_cu < 1) { fprintf(stderr, "kernel_launch: occupancy query says %d\n", per_cu); grid = -1; return; }
        (void)hipGetLastError();
        grid = cus;
        if (grid != 256) { fprintf(stderr, "kernel_launch: this kernel is laid out for 256 CUs, got %d\n", grid); grid = -1; return; }
    }
    if (grid < 0) return;
    if (hipMemsetAsync((unsigned char*)d_ws + WS_CTL, 0, 16384, stream) != hipSuccess) { fprintf(stderr, "kernel_launch: memset failed\n"); return; }
    Args a{};
    for (int i = 0; i < 29; ++i) a.in[i] = (const float*)d_in[i];
    a.out = (float*)d_out; a.ws = (unsigned char*)d_ws;
    void* kargs[] = {&a};
    hipError_t e = hipLaunchCooperativeKernel((const void*)mega, dim3(grid), dim3(512), kargs, LDS_BYTES, stream);
    if (e != hipSuccess) fprintf(stderr, "kernel_launch: cooperative launch failed: %s (grid %d)\n", hipGetErrorString(e), grid);
}
```

```cpp
#include <hip/hip_runtime.h>
#include <hip/hip_cooperative_groups.h>
#include <cstdio>
#include <cstdint>
namespace cg = cooperative_groups;

#define LAS __attribute__((address_space(3)))
typedef unsigned short bf16_t;
typedef short bf16x8 __attribute__((ext_vector_type(8)));
typedef float f32x4 __attribute__((ext_vector_type(4)));
typedef float f32x2 __attribute__((ext_vector_type(2)));
typedef unsigned u32x4 __attribute__((ext_vector_type(4)));
typedef unsigned u32x2 __attribute__((ext_vector_type(2)));

constexpr int DM = 1024, SEQ = 2048, NB = 8, MP = NB * SEQ, MS = 128, MA = MP + 256, NTILE = MA / 256;
constexpr int NIN = 6144, WA = 1024, WB = 1024, HA = 8, DHA = 128, HB = 4, DHB = 256, DPLE = 256, DMIX = 2048;
constexpr int LC = 256, NCH = SEQ / LC;
constexpr int NUNIT = NB * HB * NCH;
constexpr float EPS = 1e-6f;

constexpr size_t O_Y = 0, O_YS = 16777216, O_CP = 16908288, O_NP = 19005440, O_MP = 19013632, O_CVP = 19013664, O_CS = 19038240, O_NS = 52592672, O_MS = 52723744, O_CVS = 52724256, O_VS = 53117472, O_END = 53248544;

constexpr size_t MiB = 1u << 20;
constexpr size_t WS_CTL = 0, WS_WIN = 1 * MiB, WS_WQ = 13 * MiB, WS_WK = WS_WQ + MiB / 2, WS_WV = 14 * MiB, WS_WOUT = WS_WV + MiB / 2, WS_WPG = WS_WOUT + 4 * MiB, WS_WPP = WS_WPG + 2 * MiB,
    WS_WSP = 21 * MiB, WS_WG = WS_WSP + MiB / 4, WS_RS = WS_WG + MiB / 4, WS_GLI = 22 * MiB, WS_GLF = WS_GLI + MiB / 2, WS_DA = 23 * MiB, WS_DR = WS_DA + MiB / 2, WS_DG = 24 * MiB, WS_DEM = WS_DG + MiB / 2,
    WS_DW = 25 * MiB, WS_QN = WS_DW + MiB / 2, WS_DENP = 26 * MiB, WS_DN = 27 * MiB, WS_VS = WS_DN + MiB / 2, WS_PB = 28 * MiB, WS_XB = 37 * MiB, WS_PROJA = 70 * MiB, WS_PROJB = 168 * MiB,
    WS_PQ = 266 * MiB, WS_VC = 330 * MiB, WS_Y = 394 * MiB, WS_XB2 = 460 * MiB, WS_END = 493 * MiB;
constexpr size_t WS_WGB = WS_RS + MiB / 8;
constexpr size_t WS_Q = WS_PROJA, WS_K = WS_Q + 33 * MiB, WS_WKT = WS_K + 33 * MiB;
constexpr size_t WS_X1B = WS_PROJA, WS_GB = WS_X1B + 33 * MiB, WS_EB = WS_GB + 33 * MiB;
static_assert(WS_WKT + 32 * MiB <= WS_PROJB && WS_EB + 33 * MiB <= WS_PQ, "ws map");

__device__ __forceinline__ unsigned cvt_pk_bf16(float lo, float hi) { unsigned r; asm volatile("v_cvt_pk_bf16_f32 %0, %1, %2" : "=v"(r) : "v"(lo), "v"(hi)); return r; }
__device__ __forceinline__ float bf_lo(unsigned w) { return __uint_as_float(w << 16); }
__device__ __forceinline__ float bf_hi(unsigned w) { return __uint_as_float(w & 0xffff0000u); }
__device__ __forceinline__ float bf2f(bf16_t b) { return __uint_as_float(((unsigned)b) << 16); }
__device__ __forceinline__ bf16_t f2bf(float f) { return (bf16_t)(cvt_pk_bf16(f, 0.f) & 0xffffu); }
__device__ __forceinline__ float fast_exp(float x) { return __builtin_amdgcn_exp2f(x * 1.4426950408889634f); }
__device__ __forceinline__ float sigmoidf_(float x) { return __builtin_amdgcn_rcpf(1.0f + fast_exp(-x)); }
__device__ __forceinline__ float siluf_(float x) { return x * sigmoidf_(x); }
__device__ __forceinline__ f32x2 gelu_pk(f32x2 v) {
    const f32x2 av = __builtin_elementwise_abs(v), d = av * 0.2316418882f + 1.0f;
    f32x2 t; t.x = __builtin_amdgcn_rcpf(d.x); t.y = __builtin_amdgcn_rcpf(d.y);
    f32x2 q = t * 0.5307027145f + (-0.7265760135f); q = q * t + 0.7107068705f; q = q * t + (-0.142248368f); q = q * t + 0.127414796f; q = q * t;
    const f32x2 s = (v * v) * (-0.72134752044f);
    f32x2 e; e.x = __builtin_amdgcn_exp2f(s.x); e.y = __builtin_amdgcn_exp2f(s.y);
    const f32x2 m = v * (q * e), r = v - m;
    f32x2 o; o.x = v.x < 0.f ? m.x : r.x; o.y = v.y < 0.f ? m.y : r.y; return o;
}
__device__ __forceinline__ float wave_sum(float v) {
#pragma unroll
    for (int o = 1; o < 64; o <<= 1) v += __shfl_xor(v, o);
    return v;
}
#define LDS_WAIT() asm volatile("s_waitcnt lgkmcnt(0)" ::: "memory")

namespace pg8 {
constexpr int BM = 256, BK = 64, HALF = 128, HTB = HALF * BK * 2, STAGE_BYTES = 8 * HTB;
__host__ __device__ __forceinline__ int lds_byte(int r, int c) { const int st = (r >> 4) * 2 + (c >> 5), rr = r & 15, cc = c & 31, ob = rr * 64 + cc * 2; return st * 1024 + (ob ^ (((ob >> 9) & 1) << 5)); }
__host__ __device__ __forceinline__ void stage_rc(int b, int& R, int& C) { const int st = b / 1024, sb = b % 1024, swz = sb ^ (((sb >> 9) & 1) << 5); R = (st >> 1) * 16 + swz / 64; C = (st & 1) * 32 + (swz % 64) / 2; }
__host__ __device__ __forceinline__ int perm32(int rho) { const int n = rho >> 4, i = rho & 15; return 8 * (i >> 2) + 4 * n + (i & 3); }

struct Unit { const char* a; const char* b; int pm, pn, aux; };
struct Gemm { int lda, ldb, K; };

template <class Epi, class Sched, bool ALIGN_EPI = true, bool SP2 = true>
__device__ __forceinline__ void gemm_phase(LAS unsigned char* lds, const Gemm g, const Sched& S, const Epi& E) {
    int tid_ = threadIdx.x; asm volatile("" : "+v"(tid_));
    const int tid = tid_, wid = __builtin_amdgcn_readfirstlane(tid >> 6), lane = tid & 63, wr = wid >> 2, wc = wid & 3, fr = lane & 15, fq = lane >> 4;
    int K_ = g.K; asm volatile("" : "+s"(K_)); const int K = K_, nt = K / BK; (void)K;
    unsigned voffA[2], voffB[2];
#pragma unroll
    for (int i = 0; i < 2; ++i) { int R, C; stage_rc(tid * 16 + i * 8192, R, C); const int Rb = Epi::PERM ? ((R & ~31) + perm32(R & 31)) : R;
        voffA[i] = (unsigned)(R * g.lda + C) * 2u; voffB[i] = (unsigned)(Rb * g.ldb + C) * 2u; }
    const size_t kstep = (size_t)(BK * 2);
    const size_t hstepA = (size_t)HALF * g.lda * 2, hstepB = (size_t)HALF * g.ldb * 2;
    const unsigned ldsw = (unsigned)wid * 1024u;
    const int aoff = lds_byte(wr * 64 + fr, fq * 8), boff = lds_byte(wc * 32 + fr, fq * 8);
#define PG8_SA(b, h) (((b) * 2 + (h)) * HTB)
#define PG8_SB(b, h) ((4 + (b) * 2 + (h)) * HTB)
#define PG8_STAGE(bufoff, gbase, voff) do { _Pragma("unroll") for (int _i = 0; _i < 2; ++_i) \
        __builtin_amdgcn_global_load_lds((const unsigned*)((const char*)(gbase) + (voff)[_i]), (LAS unsigned*)(lds + (bufoff) + ldsw + _i * 8192), 16, 0, 0); } while (0)
#define PG8_LDA(dst, b, h) do { _Pragma("unroll") for (int m = 0; m < 4; ++m) _Pragma("unroll") for (int k = 0; k < 2; ++k) dst[m][k] = *(const LAS bf16x8*)(lds + PG8_SA(b, h) + aoff + m * 2048 + k * 1024); } while (0)
#define PG8_LDB(dst, b, h) do { _Pragma("unroll") for (int n = 0; n < 2; ++n) _Pragma("unroll") for (int k = 0; k < 2; ++k) dst[n][k] = *(const LAS bf16x8*)(lds + PG8_SB(b, h) + boff + n * 2048 + k * 1024); } while (0)
#define PG8_MMA(ai, bj, At, Bt) do { __builtin_amdgcn_s_setprio(1); _Pragma("unroll") for (int m = 0; m < 4; ++m) _Pragma("unroll") for (int n = 0; n < 2; ++n) _Pragma("unroll") for (int k = 0; k < 2; ++k) \
        acc[ai][bj][m][n] = __builtin_amdgcn_mfma_f32_16x16x32_bf16(Bt[n][k], At[m][k], acc[ai][bj][m][n], 0, 0, 0); __builtin_amdgcn_s_setprio(0); } while (0)
#define PG8_WAIT_V(n) asm volatile("s_waitcnt vmcnt(" #n ")" ::: "memory")
#define PG8_WAIT_L(n) asm volatile("s_waitcnt lgkmcnt(" #n ")" ::: "memory")
#define PG8_BAR __builtin_amdgcn_s_barrier()
#define PG8_SCHED __builtin_amdgcn_sched_barrier(0)
    Unit cur, nxt; int ui = 0;
    if (!S.next(0, cur)) return;
    f32x4 acc[2][2][4][2];
#pragma unroll
    for (int a = 0; a < 2; ++a)
#pragma unroll
        for (int b = 0; b < 2; ++b)
#pragma unroll
            for (int m = 0; m < 4; ++m)
#pragma unroll
                for (int n = 0; n < 2; ++n) acc[a][b][m][n] = (f32x4){0.f, 0.f, 0.f, 0.f};
    bf16x8 At[4][2], B0[2][2], B1[2][2];
    const char* cA = cur.a; const char* cB = cur.b;
    if constexpr (SP2) {
        PG8_STAGE(PG8_SB(0, 0), cB, voffB); PG8_STAGE(PG8_SB(0, 1), cB + hstepB, voffB); PG8_STAGE(PG8_SA(0, 0), cA, voffA); PG8_STAGE(PG8_SA(0, 1), cA + hstepA, voffA);
        if (wr == 1) PG8_BAR;
        PG8_WAIT_V(2); PG8_BAR;
        PG8_STAGE(PG8_SB(1, 0), cB + kstep, voffB); PG8_STAGE(PG8_SA(1, 0), cA + kstep, voffA); PG8_STAGE(PG8_SB(1, 1), cB + hstepB + kstep, voffB);
        PG8_WAIT_V(6); PG8_BAR;
    } else {
        PG8_STAGE(PG8_SB(0, 0), cB, voffB); PG8_STAGE(PG8_SA(0, 0), cA, voffA); PG8_STAGE(PG8_SB(0, 1), cB + hstepB, voffB); PG8_STAGE(PG8_SA(0, 1), cA + hstepA, voffA);
        if (wr == 1) PG8_BAR;
        PG8_WAIT_V(4); PG8_BAR;
        PG8_STAGE(PG8_SB(1, 0), cB + kstep, voffB); PG8_STAGE(PG8_SA(1, 0), cA + kstep, voffA); PG8_STAGE(PG8_SB(1, 1), cB + hstepB + kstep, voffB);
        PG8_WAIT_V(6); PG8_BAR;
    }
    for (;;) {
        const bool has_next = S.next(ui + 1, nxt);
        const char* nA = has_next ? nxt.a : cA; const char* nB = has_next ? nxt.b : cB;
#pragma unroll 1
        for (int t = 0; t < nt; t += 2) {
            const bool last = (t == nt - 2);
            const char* a1 = cA + (size_t)(t + 1) * kstep;
            const char* a2 = last ? nA : cA + (size_t)(t + 2) * kstep; const char* b2 = last ? nB : cB + (size_t)(t + 2) * kstep;
            const char* a3 = a2 + kstep; const char* b3 = b2 + kstep;
            if constexpr (SP2) {
            PG8_LDB(B0, 0, 0); PG8_LDB(B1, 0, 1); PG8_SCHED; PG8_LDA(At, 0, 0); PG8_STAGE(PG8_SA(1, 1), a1 + hstepA, voffA);
            PG8_WAIT_V(8); PG8_WAIT_L(0); PG8_BAR; PG8_MMA(0, 0, At, B0); PG8_MMA(0, 1, At, B1); PG8_BAR; PG8_SCHED;
            PG8_LDA(At, 0, 1); PG8_STAGE(PG8_SB(0, 0), b2, voffB); PG8_STAGE(PG8_SB(0, 1), b2 + hstepB, voffB); PG8_STAGE(PG8_SA(0, 0), a2, voffA);
            PG8_WAIT_V(8); PG8_WAIT_L(0); PG8_BAR; PG8_MMA(1, 0, At, B0); PG8_MMA(1, 1, At, B1); PG8_BAR; PG8_SCHED;
            PG8_LDB(B0, 1, 0); PG8_LDB(B1, 1, 1); PG8_SCHED; PG8_LDA(At, 1, 0); PG8_STAGE(PG8_SA(0, 1), a2 + hstepA, voffA);
            PG8_WAIT_V(8); PG8_WAIT_L(0); PG8_BAR; PG8_MMA(0, 0, At, B0); PG8_MMA(0, 1, At, B1); PG8_BAR; PG8_SCHED;
            PG8_LDA(At, 1, 1); PG8_STAGE(PG8_SB(1, 0), b3, voffB); PG8_STAGE(PG8_SB(1, 1), b3 + hstepB, voffB); PG8_STAGE(PG8_SA(1, 0), a3, voffA);
            PG8_WAIT_V(8); PG8_WAIT_L(0); PG8_BAR; PG8_MMA(1, 0, At, B0); PG8_MMA(1, 1, At, B1); PG8_BAR; PG8_SCHED;
            } else {
            PG8_LDB(B0, 0, 0); PG8_SCHED; PG8_LDA(At, 0, 0); PG8_STAGE(PG8_SA(1, 1), a1 + hstepA, voffA);
            PG8_WAIT_L(8); PG8_BAR; PG8_WAIT_L(0); PG8_MMA(0, 0, At, B0); PG8_BAR; PG8_SCHED;
            PG8_LDB(B1, 0, 1); PG8_STAGE(PG8_SB(0, 0), b2, voffB);
            PG8_BAR; PG8_WAIT_L(0); PG8_MMA(0, 1, At, B1); PG8_BAR;
            PG8_LDA(At, 0, 1); PG8_STAGE(PG8_SA(0, 0), a2, voffA);
            PG8_BAR; PG8_WAIT_L(0); PG8_MMA(1, 0, At, B0); PG8_BAR; PG8_SCHED;
            PG8_STAGE(PG8_SB(0, 1), b2 + hstepB, voffB);
            PG8_WAIT_V(6); PG8_BAR; PG8_MMA(1, 1, At, B1); PG8_BAR;
            PG8_LDB(B0, 1, 0); PG8_SCHED; PG8_LDA(At, 1, 0); PG8_STAGE(PG8_SA(0, 1), a2 + hstepA, voffA);
            PG8_WAIT_L(8); PG8_BAR; PG8_WAIT_L(0); PG8_MMA(0, 0, At, B0); PG8_BAR; PG8_SCHED;
            PG8_LDB(B1, 1, 1); PG8_STAGE(PG8_SB(1, 0), b3, voffB);
            PG8_BAR; PG8_WAIT_L(0); PG8_MMA(0, 1, At, B1); PG8_BAR;
            PG8_LDA(At, 1, 1); PG8_STAGE(PG8_SA(1, 0), a3, voffA);
            PG8_BAR; PG8_WAIT_L(0); PG8_MMA(1, 0, At, B0); PG8_BAR; PG8_SCHED;
            PG8_STAGE(PG8_SB(1, 1), b3 + hstepB, voffB);
            PG8_WAIT_V(6); PG8_BAR; PG8_MMA(1, 1, At, B1); PG8_BAR;
            }
        }
        if constexpr (ALIGN_EPI) { if (wr == 0) PG8_BAR; }
        if constexpr (!Epi::AFTER_DRAIN) { E(acc, cur, wr, wc, fr, fq); }
        if (!has_next) break;
#pragma unroll
        for (int a = 0; a < 2; ++a)
#pragma unroll
            for (int b = 0; b < 2; ++b)
#pragma unroll
                for (int m = 0; m < 4; ++m)
#pragma unroll
                    for (int n = 0; n < 2; ++n) acc[a][b][m][n] = (f32x4){0.f, 0.f, 0.f, 0.f};
        cur = nxt; cA = nA; cB = nB; ++ui;
        if constexpr (ALIGN_EPI) { if (wr == 1) PG8_BAR; }
    }
    PG8_WAIT_V(0);
    if constexpr (!ALIGN_EPI) { if (wr == 0) PG8_BAR; }
    PG8_BAR;
    if constexpr (Epi::AFTER_DRAIN) { E.fused(acc, cur, wr, wc, fr, fq, lds, wid, lane); }
#undef PG8_SA
#undef PG8_SB
#undef PG8_STAGE
#undef PG8_LDA
#undef PG8_LDB
#undef PG8_MMA
#undef PG8_WAIT_V
#undef PG8_WAIT_L
#undef PG8_BAR
#undef PG8_SCHED
}
}
using pg8::Unit; using pg8::Gemm;

constexpr int LDS_BYTES = 147456;
struct Args { const float* in[29]; float* out; unsigned char* ws; };

struct Ctx {
    LAS unsigned char* lds; int tid, lane, wave, G, bid, gw, NGW;
    const float* const* in; float* out; unsigned char* ws;
};

__device__ __forceinline__ void p0_transpose_item(const float* W, int ldw, bf16_t* WT, int ldt, const float* kscale, LAS float* scr, int kb, int nb, int lane) {
    const int k0 = 64 * kb, n0 = 32 * nb;
#pragma unroll 8
    for (int i = 0; i < 32; ++i) { const int kk = 2 * i + (lane >> 5); float v = W[(size_t)(k0 + kk) * ldw + n0 + (lane & 31)]; if (kscale) v *= kscale[k0 + kk]; scr[kk * 33 + (lane & 31)] = v; }
    LDS_WAIT(); asm volatile("" ::: "memory");
    const int c = lane & 7;
#pragma unroll
    for (int j = 0; j < 4; ++j) { const int n = (lane >> 3) + 8 * j; const LAS float* s = scr + (8 * c) * 33 + n;
        u32x4 o; o.x = cvt_pk_bf16(s[0 * 33], s[1 * 33]); o.y = cvt_pk_bf16(s[2 * 33], s[3 * 33]); o.z = cvt_pk_bf16(s[4 * 33], s[5 * 33]); o.w = cvt_pk_bf16(s[6 * 33], s[7 * 33]);
        *(u32x4*)(WT + (size_t)(n0 + n) * ldt + k0 + 8 * c) = o; }
    LDS_WAIT(); asm volatile("" ::: "memory");
}

__device__ __forceinline__ void p0_prologue(const Ctx& F0) { Ctx F = F0; asm volatile("" : "+v"(F.tid), "+v"(F.lane));
    LAS float* scr = (LAS float*)(F.lds + F.wave * 16384);
    unsigned char* ws = F.ws;
    constexpr int I_WIN = 16 * 192, I_QKV = 12 * 4 * 8, I_WOUT = 32 * 32, I_WPG = 16 * 32, I_WPP = 4 * 32;
    constexpr int I_T = I_WIN + I_QKV + I_WOUT + I_WPG + I_WPP;
    constexpr int I_X = MA, I_P = MA, I_SP = 1024, I_WG = 1024, I_YPAD = 128;
    constexpr int NITEMS = I_T + I_X + I_P + I_SP + I_WG + I_YPAD;
    for (int it = F.gw; it < NITEMS; it += F.NGW) {
        int r = it;
        if (r < I_T) {
            if (r < I_WIN) { p0_transpose_item(F.in[9], NIN, (bf16_t*)(ws + WS_WIN), DM, F.in[8], scr, r / 192, r % 192, F.lane); continue; } r -= I_WIN;
            if (r < I_QKV) { const int mat = r / 32, rr = r % 32, which = mat / 4, h = mat % 4;
                const float* W = F.in[16 + which] + (size_t)h * 65536; bf16_t* WT = (bf16_t*)(ws + (which == 0 ? WS_WQ : which == 1 ? WS_WK : WS_WV)) + (size_t)h * 65536;
                p0_transpose_item(W, 256, WT, 256, nullptr, scr, rr / 8, rr % 8, F.lane); continue; } r -= I_QKV;
            if (r < I_WOUT) { p0_transpose_item(F.in[23], DM, (bf16_t*)(ws + WS_WOUT), DMIX, nullptr, scr, r / 32, r % 32, F.lane); continue; } r -= I_WOUT;
            if (r < I_WPG) { p0_transpose_item(F.in[24], DM, (bf16_t*)(ws + WS_WPG), DM, nullptr, scr, r / 32, r % 32, F.lane); continue; } r -= I_WPG;
            p0_transpose_item(F.in[26], DM, (bf16_t*)(ws + WS_WPP), DPLE, nullptr, scr, r / 32, r % 32, F.lane); continue;
        }
        r -= I_T;
        if (r < I_X) {
            bf16_t* orow = (bf16_t*)(ws + WS_XB) + (size_t)r * DM; float* rs = (float*)(ws + WS_RS);
            unsigned long long* o8 = (unsigned long long*)orow + F.lane;
            if (r >= MP + MS) {
#pragma unroll
                for (int j = 0; j < 4; ++j) o8[64 * j] = 0ull;
                if (F.lane == 0) rs[r] = 0.f; continue; }
            const float* xrow = r < MP ? F.in[0] + (size_t)r * DM : F.in[1] + (size_t)(r - MP) * DM;
            const f32x4* xr = (const f32x4*)xrow + F.lane; f32x4 v[4]; float s = 0.f;
#pragma unroll
            for (int j = 0; j < 4; ++j) { v[j] = xr[64 * j]; s += (v[j].x * v[j].x + v[j].y * v[j].y) + (v[j].z * v[j].z + v[j].w * v[j].w); }
            s = wave_sum(s);
#pragma unroll
            for (int j = 0; j < 4; ++j) o8[64 * j] = (unsigned long long)cvt_pk_bf16(v[j].x, v[j].y) | ((unsigned long long)cvt_pk_bf16(v[j].z, v[j].w) << 32);
            if (F.lane == 0) rs[r] = 1.0f / sqrtf(s * (1.0f / DM) + EPS);
            continue;
        }
        r -= I_X;
        if (r < I_P) {
            unsigned long long* o8 = (unsigned long long*)((bf16_t*)(ws + WS_PB) + (size_t)r * DPLE) + F.lane;
            if (r >= MP + MS) { o8[0] = 0ull; continue; }
            const float* prow = r < MP ? F.in[6] + (size_t)r * DPLE : F.in[7] + (size_t)(r - MP) * DPLE;
            const f32x4 v = ((const f32x4*)prow)[F.lane];
            o8[0] = (unsigned long long)cvt_pk_bf16(v.x, v.y) | ((unsigned long long)cvt_pk_bf16(v.z, v.w) << 32);
            continue;
        }
        r -= I_P;
        if (r < I_SP) {
            const int t = r & 127; const float* wrow = F.in[12] + (size_t)r * 128; const f32x2 v = ((const f32x2*)wrow)[F.lane];
            const int s0 = 2 * F.lane; ((unsigned*)((bf16_t*)(ws + WS_WSP) + (size_t)r * 128))[F.lane] = cvt_pk_bf16(s0 <= t ? v.x : 0.f, s0 + 1 <= t ? v.y : 0.f);
            continue;
        }
        r -= I_SP;
        if (r < I_WG) {
            const int i = r, h = i >> 8, d = i & 255; const float* wif = F.in[19];
            const f32x4 wq4 = *(const f32x4*)(F.in[16] + ((size_t)h * 256 + d) * 256 + 4 * F.lane), wk4 = *(const f32x4*)(F.in[17] + ((size_t)h * 256 + d) * 256 + 4 * F.lane), wv4 = *(const f32x4*)(F.in[18] + ((size_t)h * 256 + d) * 256 + 4 * F.lane);
            float sx[8], sb[8];
#pragma unroll
            for (int j = 0; j < 8; ++j) { sx[j] = 0.f; sb[j] = 0.f; }
#pragma unroll
            for (int e = 0; e < 4; ++e) { const size_t rq = (size_t)(h * 256 + 4 * F.lane + e) * 8;
                const f32x4 q0 = *(const f32x4*)(wif + rq), q1 = *(const f32x4*)(wif + rq + 4), k0 = *(const f32x4*)(wif + 8192 + rq), k1 = *(const f32x4*)(wif + 8192 + rq + 4), v0 = *(const f32x4*)(wif + 16384 + rq), v1 = *(const f32x4*)(wif + 16384 + rq + 4);
#pragma unroll
                for (int j = 0; j < 4; ++j) { sx[j] += wq4[e] * q0[j] + wk4[e] * k0[j]; sx[4 + j] += wq4[e] * q1[j] + wk4[e] * k1[j]; sb[j] += wv4[e] * v0[j]; sb[4 + j] += wv4[e] * v1[j]; } }
#pragma unroll
            for (int j = 0; j < 8; ++j) { sx[j] = wave_sum(sx[j]); sb[j] = wave_sum(sb[j]); }
            float s = 0.f;
#pragma unroll
            for (int j = 0; j < 8; ++j) { s = (F.lane == j) ? sx[j] : s; s = (F.lane == 8 + j) ? sb[j] : s; }
            if (F.lane < 16) ((float*)(ws + WS_WG))[(size_t)i * 16 + F.lane] = s;
            if (F.lane < 16) { bf16_t* wgb = (bf16_t*)(ws + WS_WGB) + (size_t)(F.lane >> 3) * 16384 + (size_t)(F.lane & 7) * 1024 + i; wgb[0] = f2bf(s); wgb[8 * 1024] = 0; }
            continue;
        }
        r -= I_WG;
        {
            u32x4* yrow = (u32x4*)((bf16_t*)(ws + WS_Y) + (size_t)(MP + MS + r) * DMIX) + F.lane;
#pragma unroll
            for (int j = 0; j < 4; ++j) yrow[64 * j] = (u32x4){0u, 0u, 0u, 0u};
        }
    }
}

struct OrderRowMajor {
    int nM, nN, n, G, c; const char* A; const char* B; size_t astep, bstep;
    __device__ __forceinline__ bool next(int i, Unit& u) const {
        const int L = i * G + c; if (L >= n) return false;
        u.pm = L / nN; u.pn = L % nN; u.aux = 0; u.a = A + (size_t)u.pm * astep; u.b = B + (size_t)u.pn * bstep; return true;
    }
};
struct OrderPanel4 {
    int n, G, c; const char* A; const char* B; size_t astep, bstep;
    __device__ __forceinline__ bool next(int i, Unit& u) const {
        const int L = i * G + c; if (L >= n) return false;
        if (L < 256) { const int x = L & 7, j = L >> 3; u.pm = x * 8 + (j >> 2); u.pn = j & 3; } else { u.pm = 64; u.pn = L - 256; }
        u.aux = 0; u.a = A + (size_t)u.pm * astep; u.b = B + (size_t)u.pn * bstep; return true;
    }
};
struct OrderXcd {
    int nM, nN, n, G, c; const char* A; const char* B; size_t astep, bstep;
    __device__ __forceinline__ bool next(int i, Unit& u) const {
        const int L = i * G + c; if (L >= n) return false;
        int wgid = L; { const int q = n / 8, r = n % 8, xcd = wgid % 8, off = wgid / 8; wgid = (xcd < r ? xcd * (q + 1) : r * (q + 1) + (xcd - r) * q) + off; }
        const int nig = 8 * nN, gid = wgid / nig, fm = gid * 8, gsz = (nM - fm) < 8 ? (nM - fm) : 8;
        u.pm = fm + ((wgid % nig) % gsz); u.pn = (wgid % nig) / gsz; u.aux = 0; u.a = A + (size_t)u.pm * astep; u.b = B + (size_t)u.pn * bstep; return true;
    }
};
struct EpiInProj {
    static constexpr bool PERM = true, AFTER_DRAIN = false;
    bf16_t* PA; bf16_t* PB; const float* rs;
    template <int KIND> __device__ __forceinline__ void run(const f32x4 (&acc)[2][2][4][2], bf16_t* base, int row0, int col0) const {
#pragma unroll
        for (int ai = 0; ai < 2; ++ai)
#pragma unroll
            for (int m = 0; m < 4; ++m) { const int row = row0 + ai * 128 + m * 16; const float s = rs[row]; bf16_t* rowp = base + (size_t)row * 3072 + col0;
#pragma unroll
                for (int bj = 0; bj < 2; ++bj) { f32x4 v0 = acc[ai][bj][m][0] * s, v1 = acc[ai][bj][m][1] * s;
                    if (KIND == 0) { f32x2 a = gelu_pk((f32x2){v0[0], v0[1]}), b = gelu_pk((f32x2){v0[2], v0[3]}), c = gelu_pk((f32x2){v1[0], v1[1]}), d = gelu_pk((f32x2){v1[2], v1[3]});
                        v0 = (f32x4){a.x, a.y, b.x, b.y}; v1 = (f32x4){c.x, c.y, d.x, d.y}; }
                    if (KIND == 1) {
#pragma unroll
                        for (int j = 0; j < 4; ++j) { v0[j] = siluf_(v0[j]); v1[j] = siluf_(v1[j]); } }
                    if (KIND == 3) {
#pragma unroll
                        for (int j = 0; j < 4; ++j) { v0[j] = sigmoidf_(v0[j]); v1[j] = sigmoidf_(v1[j]); } }
                    u32x4 w; w.x = cvt_pk_bf16(v0[0], v0[1]); w.y = cvt_pk_bf16(v0[2], v0[3]); w.z = cvt_pk_bf16(v1[0], v1[1]); w.w = cvt_pk_bf16(v1[2], v1[3]);
                    *(u32x4*)(rowp + bj * 128) = w; } }
    }
    __device__ __forceinline__ void operator()(const f32x4 (&acc)[2][2][4][2], const Unit& u, int wr, int wc, int fr, int fq) const {
        const int row0 = u.pm * 256 + wr * 64 + fr, pn = u.pn;
        bf16_t* base = pn < 12 ? PA + pn * 256 : PB + (pn - 12) * 256; const int col0 = wc * 32 + 8 * fq;
        if (pn < 8) run<0>(acc, base, row0, col0);
        else if (pn < 12 || pn >= 20) run<1>(acc, base, row0, col0);
        else if (pn < 16) run<2>(acc, base, row0, col0);
        else run<3>(acc, base, row0, col0);
    }
};

__device__ __forceinline__ float logsigmoidf_(float x) { return fminf(x, 0.f) - log1pf(__expf(-fabsf(x))); }
__device__ __forceinline__ void unpack8(const u32x4 w, float (&f)[8]) { f[0] = bf_lo(w.x); f[1] = bf_hi(w.x); f[2] = bf_lo(w.y); f[3] = bf_hi(w.y); f[4] = bf_lo(w.z); f[5] = bf_hi(w.z); f[6] = bf_lo(w.w); f[7] = bf_hi(w.w); }
__device__ __forceinline__ u32x4 pack8(const float (&f)[8]) { u32x4 w; w.x = cvt_pk_bf16(f[0], f[1]); w.y = cvt_pk_bf16(f[2], f[3]); w.z = cvt_pk_bf16(f[4], f[5]); w.w = cvt_pk_bf16(f[6], f[7]); return w; }

__device__ __forceinline__ void p2a_conv_gates(const Ctx& F0) { Ctx F = F0; asm volatile("" : "+v"(F.tid), "+v"(F.lane));
    unsigned char* ws = F.ws;
    const bf16_t* PBX = (const bf16_t*)(ws + WS_PROJB);
    bf16_t* XC = (bf16_t*)(ws + WS_XB); bf16_t* XB2 = (bf16_t*)(ws + WS_XB2);
    const float* Wg = (const float*)(ws + WS_WG);
    float* GLI = (float*)(ws + WS_GLI); float* GLF = (float*)(ws + WS_GLF);
    const float* convw = F.in[14]; const float* convb = F.in[15]; const float* bif = F.in[20];
    LAS float* cwl = (LAS float*)F.lds; LAS bf16_t* wgl = (LAS bf16_t*)(F.lds + 20480); LAS f32x4* comb = (LAS f32x4*)(F.lds + 20480 + 65536);
    for (int i = F.tid; i < 5 * 1024 / 4; i += 512) ((LAS f32x4*)cwl)[i] = i < 1024 ? ((const f32x4*)convw)[i] : ((const f32x4*)convb)[i - 1024];
    for (int i = F.tid; i < 65536 / 16; i += 512) ((LAS u32x4*)wgl)[i] = ((const u32x4*)(ws + WS_WGB))[i];
    __syncthreads();
    const int l15 = F.lane & 15, lq = F.lane >> 4, rgp = F.wave >> 1, hh = F.wave & 1;
    for (int tile = F.bid; tile < MP / 64 + 2; tile += F.G) {
        const bool smp = tile >= MP / 64; const int row = tile * 64 + rgp * 16 + l15, seq0 = row & ~(SEQ - 1); const float* st = F.in[5] + (size_t)(row - MP) * 3072;
        f32x4 acc = (f32x4){0.f, 0.f, 0.f, 0.f};
#pragma unroll 4
        for (int cbk = 0; cbk < 16; ++cbk) { const int ch0 = (hh * 16 + cbk) * 32 + 8 * lq;
            u32x4 x3 = (u32x4){0u, 0u, 0u, 0u}, x2 = x3, x1 = x3; const u32x4 x0 = *(const u32x4*)(PBX + (size_t)row * 3072 + ch0);
            float w0[8], w1[8], w2[8], cur[8], xc[8];
            if (!smp) {
                if (row - 3 >= seq0) x3 = *(const u32x4*)(PBX + (size_t)(row - 3) * 3072 + ch0);
                if (row - 2 >= seq0) x2 = *(const u32x4*)(PBX + (size_t)(row - 2) * 3072 + ch0);
                if (row - 1 >= seq0) x1 = *(const u32x4*)(PBX + (size_t)(row - 1) * 3072 + ch0);
                unpack8(x3, w0); unpack8(x2, w1); unpack8(x1, w2);
            } else {
#pragma unroll
                for (int q = 0; q < 2; ++q) { const f32x4 a0 = *(const f32x4*)(st + ch0 + 4 * q), a1 = *(const f32x4*)(st + 1024 + ch0 + 4 * q), a2 = *(const f32x4*)(st + 2048 + ch0 + 4 * q);
#pragma unroll
                    for (int e = 0; e < 4; ++e) { w0[4 * q + e] = a0[e]; w1[4 * q + e] = a1[e]; w2[4 * q + e] = a2[e]; } }
            }
            unpack8(x0, cur);
#pragma unroll
            for (int q = 0; q < 2; ++q) { const f32x4 c0 = *(const LAS f32x4*)(cwl + ch0 + 4 * q), c1 = *(const LAS f32x4*)(cwl + 1024 + ch0 + 4 * q), c2 = *(const LAS f32x4*)(cwl + 2048 + ch0 + 4 * q), c3 = *(const LAS f32x4*)(cwl + 3072 + ch0 + 4 * q), cb = *(const LAS f32x4*)(cwl + 4096 + ch0 + 4 * q);
#pragma unroll
                for (int e = 0; e < 4; ++e) xc[4 * q + e] = siluf_(c0[e] * w0[4 * q + e] + c1[e] * w1[4 * q + e] + c2[e] * w2[4 * q + e] + c3[e] * cur[4 * q + e] + cb[e]); }
            const u32x4 xcp = pack8(xc);
            *(u32x4*)(XC + (size_t)row * DM + ch0) = xcp; *(u32x4*)(XB2 + (size_t)row * DM + ch0) = x0;
            const bf16x8 bc = *(const LAS bf16x8*)(wgl + l15 * 1024 + ch0), bx = *(const LAS bf16x8*)(wgl + 16384 + l15 * 1024 + ch0);
            acc = __builtin_amdgcn_mfma_f32_16x16x32_bf16(__builtin_bit_cast(bf16x8, xcp), bc, acc, 0, 0, 0);
            acc = __builtin_amdgcn_mfma_f32_16x16x32_bf16(__builtin_bit_cast(bf16x8, x0), bx, acc, 0, 0, 0); }
        __syncthreads();
        if (hh == 1) comb[rgp * 64 + F.lane] = acc;
        __syncthreads();
        if (hh == 0 && l15 < 8) { const f32x4 o = comb[rgp * 64 + F.lane]; const float bj = bif[l15];
#pragma unroll
            for (int r = 0; r < 4; ++r) { const float g = acc[r] + o[r] + bj; const size_t rr = (size_t)(tile * 64 + rgp * 16 + 4 * lq + r);
                if (l15 < 4) GLI[(size_t)l15 * MA + rr] = g; else GLF[(size_t)(l15 - 4) * MA + rr] = logsigmoidf_(g); } }
    }
    __syncthreads();
    for (int i = F.bid * 512 + F.tid; i < NB * 3 * 1024; i += F.G * 512) { const int b = i / 3072, j = (i / 1024) % 3, ch = i & 1023;
        F.out[O_CVP + i] = bf2f(PBX[(size_t)(b * SEQ + SEQ - 3 + j) * 3072 + ch]); }
    for (int i = F.gw; i < MS; i += F.NGW) {
        const int r = MP + i, ch0s = F.lane * 16; const float* st = F.in[5] + (size_t)i * 3 * 1024;
        const bf16_t* PA = (const bf16_t*)(ws + WS_PROJA) + (size_t)r * 3072;
#pragma unroll
        for (int half = 0; half < 2; ++half) { const int c0 = ch0s + half * 8; float xb[8]; unpack8(*(const u32x4*)(PBX + (size_t)r * 3072 + c0), xb);
#pragma unroll
            for (int q = 0; q < 2; ++q) { *(f32x4*)(F.out + O_CVS + (size_t)i * 3072 + c0 + 4 * q) = *(const f32x4*)(st + 1024 + c0 + 4 * q); *(f32x4*)(F.out + O_CVS + (size_t)i * 3072 + 1024 + c0 + 4 * q) = *(const f32x4*)(st + 2048 + c0 + 4 * q);
                *(f32x4*)(F.out + O_CVS + (size_t)i * 3072 + 2048 + c0 + 4 * q) = (f32x4){xb[4 * q], xb[4 * q + 1], xb[4 * q + 2], xb[4 * q + 3]}; } }
        float gv[16], s = 0.f;
        { float t8[8]; unpack8(*(const u32x4*)(PA + 1024 + ch0s), t8);
#pragma unroll
          for (int c = 0; c < 8; ++c) gv[c] = t8[c];
          unpack8(*(const u32x4*)(PA + 1024 + ch0s + 8), t8);
#pragma unroll
          for (int c = 0; c < 8; ++c) gv[8 + c] = t8[c]; }
#pragma unroll
        for (int c = 0; c < 16; ++c) s += gv[c];
        s += __shfl_xor(s, 1); s += __shfl_xor(s, 2); s += __shfl_xor(s, 4);
        const float mu = s * (1.f / 128.f); float q = 0.f;
#pragma unroll
        for (int c = 0; c < 16; ++c) { const float d = gv[c] - mu; q += d * d; }
        q += __shfl_xor(q, 1); q += __shfl_xor(q, 2); q += __shfl_xor(q, 4);
        const float rstd = 1.0f / sqrtf(q * (1.f / 128.f) + EPS);
        const int h = F.lane >> 3; const float wsp = F.in[12][(size_t)h * 16384], bsp = F.in[13][h * 128];
        float uu[16], zz[16];
        { float t8[8]; unpack8(*(const u32x4*)(PA + ch0s), t8);
#pragma unroll
          for (int c = 0; c < 8; ++c) uu[c] = t8[c];
          unpack8(*(const u32x4*)(PA + ch0s + 8), t8);
#pragma unroll
          for (int c = 0; c < 8; ++c) uu[8 + c] = t8[c];
          unpack8(*(const u32x4*)(PA + 2048 + ch0s), t8);
#pragma unroll
          for (int c = 0; c < 8; ++c) zz[c] = t8[c];
          unpack8(*(const u32x4*)(PA + 2048 + ch0s + 8), t8);
#pragma unroll
          for (int c = 0; c < 8; ++c) zz[8 + c] = t8[c]; }
        float ya[16];
#pragma unroll
        for (int c = 0; c < 16; ++c) { const int ch = ch0s + c; const float vn = (gv[c] - mu) * rstd * F.in[10][ch] + F.in[11][ch];
            F.out[O_VS + (size_t)i * 1024 + ch] = vn; ya[c] = uu[c] * (wsp * vn + bsp) * zz[c]; }
        bf16_t* yrow = (bf16_t*)(ws + WS_Y) + (size_t)r * DMIX + ch0s;
        { float t8[8];
#pragma unroll
          for (int c = 0; c < 8; ++c) t8[c] = ya[c];
          *(u32x4*)(yrow) = pack8(t8);
#pragma unroll
          for (int c = 0; c < 8; ++c) t8[c] = ya[8 + c];
          *(u32x4*)(yrow + 8) = pack8(t8); }
    }
}

__device__ __forceinline__ void mscan_wave(const Ctx& F, int bh) {
    unsigned char* ws = F.ws; const int b = bh >> 2, h = bh & 3, lane = F.lane;
    const float* li = (const float*)(ws + WS_GLI) + (size_t)h * MA + (size_t)b * SEQ + lane * 32;
    const float* lf = (const float*)(ws + WS_GLF) + (size_t)h * MA + (size_t)b * SEQ + lane * 32;
    float A = 0.f, Bv = -INFINITY;
    for (int i = 0; i < 32; ++i) { const float f = lf[i], l = li[i]; Bv = fmaxf(Bv + f, l); A += f; }
    float sA = A, sB = Bv;
#pragma unroll
    for (int o = 1; o < 64; o <<= 1) { const float pA = __shfl_up(sA, o), pB = __shfl_up(sB, o); if (lane >= o) { sB = fmaxf(pB + sA, sB); sA = pA + sA; } }
    float eA = __shfl_up(sA, 1), eB = __shfl_up(sB, 1); if (lane == 0) { eA = 0.f; eB = -INFINITY; }
    const float m_in = fmaxf(0.f + eA, eB);
    float cA = A;
#pragma unroll
    for (int o = 1; o < 8; o <<= 1) { const float p = __shfl_up(cA, o); if ((lane & 7) >= o) cA += p; }
    const float b_in = cA - A;
    const float m_prev = __shfl(m_in, lane & ~7);
    float* DA = (float*)(ws + WS_DA) + (size_t)h * MA + (size_t)b * SEQ + lane * 32; float* DR = (float*)(ws + WS_DR) + (size_t)h * MA + (size_t)b * SEQ + lane * 32;
    float* DG = (float*)(ws + WS_DG) + (size_t)h * MA + (size_t)b * SEQ + lane * 32; float* DEM = (float*)(ws + WS_DEM) + (size_t)h * MA + (size_t)b * SEQ + lane * 32;
    float* DW = (float*)(ws + WS_DW) + (size_t)h * MA + (size_t)b * SEQ + lane * 32;
    float m = m_in, bb = b_in, a_last = 0.f;
    for (int i = 0; i < 32; ++i) { const float f = lf[i], l = li[i]; m = fmaxf(m + f, l); bb += f;
        a_last = bb - m; DA[i] = a_last; DR[i] = l - bb; DG[i] = __expf(bb + m_prev - m); DEM[i] = __expf(-m); }
    const float a_end = __shfl(a_last, lane | 7);
    for (int i = 0; i < 32; ++i) { const float f = lf[i]; (void)f; }
    { float bb2 = b_in; for (int i = 0; i < 32; ++i) { bb2 += lf[i]; DW[i] = __expf(a_end + (li[i] - bb2)); } }
    if (lane == 63) F.out[O_MP + bh] = m;
}

__device__ __forceinline__ void p9_final(const Ctx& F0) { Ctx F = F0; asm volatile("" : "+v"(F.tid), "+v"(F.lane));
    unsigned char* ws = F.ws; const bf16_t* GB = (const bf16_t*)(ws + WS_GB); const bf16_t* EB = (const bf16_t*)(ws + WS_EB);
    const float* pleg = F.in[27]; const float* fing = F.in[28];
    f32x4 pg[4], fg[4];
#pragma unroll
    for (int j = 0; j < 4; ++j) { pg[j] = ((const f32x4*)pleg)[F.lane + 64 * j]; fg[j] = ((const f32x4*)fing)[F.lane + 64 * j]; }
    for (int r0 = F.gw * 2; r0 < MP + MS; r0 += F.NGW * 2) {
        f32x4 x[2][4]; u32x2 g[2][4], e[2][4]; float* xrow[2];
#pragma unroll
        for (int q = 0; q < 2; ++q) { const int r = r0 + q; xrow[q] = r < MP ? F.out + O_Y + (size_t)r * DM : F.out + O_YS + (size_t)(r - MP) * DM;
#pragma unroll
            for (int j = 0; j < 4; ++j) { x[q][j] = ((const f32x4*)xrow[q])[F.lane + 64 * j]; g[q][j] = ((const u32x2*)(GB + (size_t)r * DM))[F.lane + 64 * j]; e[q][j] = ((const u32x2*)(EB + (size_t)r * DM))[F.lane + 64 * j]; } }
#pragma unroll
        for (int q = 0; q < 2; ++q) { float s = 0.f; f32x4 ev[4];
#pragma unroll
            for (int j = 0; j < 4; ++j) { ev[j] = (f32x4){bf_lo(e[q][j].x), bf_hi(e[q][j].x), bf_lo(e[q][j].y), bf_hi(e[q][j].y)}; s += (ev[j][0] * ev[j][0] + ev[j][1] * ev[j][1]) + (ev[j][2] * ev[j][2] + ev[j][3] * ev[j][3]); }
            s = wave_sum(s); const float rse = 1.0f / sqrtf(s * (1.f / DM) + EPS); float s2 = 0.f;
#pragma unroll
            for (int j = 0; j < 4; ++j) { const f32x4 gv = (f32x4){bf_lo(g[q][j].x), bf_hi(g[q][j].x), bf_lo(g[q][j].y), bf_hi(g[q][j].y)};
                x[q][j] = x[q][j] + gv * (ev[j] * rse * pg[j]); s2 += (x[q][j][0] * x[q][j][0] + x[q][j][1] * x[q][j][1]) + (x[q][j][2] * x[q][j][2] + x[q][j][3] * x[q][j][3]); }
            s2 = wave_sum(s2); const float rs2 = 1.0f / sqrtf(s2 * (1.f / DM) + EPS);
#pragma unroll
            for (int j = 0; j < 4; ++j) ((f32x4*)xrow[q])[F.lane + 64 * j] = x[q][j] * rs2 * fg[j]; }
    }
}
#define MAKE_CTX() extern __shared__ __attribute__((aligned(16))) unsigned char lds_raw[]; \
    Ctx F; F.lds = (LAS unsigned char*)lds_raw; F.tid = threadIdx.x; F.lane = F.tid & 63; F.wave = __builtin_amdgcn_readfirstlane(F.tid >> 6); \
    F.G = gridDim.x; F.bid = blockIdx.x; F.gw = F.bid * 8 + F.wave; F.NGW = F.G * 8; F.in = args.in; F.out = args.out; F.ws = args.ws; unsigned char* ws = args.ws; (void)ws

template <int KIND> struct EpiBf16Act {
    static constexpr bool PERM = false, AFTER_DRAIN = false;
    bf16_t* O; int ldo; const float* bias; float scale;
    __device__ __forceinline__ void operator()(const f32x4 (&acc)[2][2][4][2], const Unit& u, int wr, int wc, int fr, int fq) const {
        const int row0 = u.pm * 256 + wr * 64 + fr, col0 = u.pn * 256 + wc * 32 + 4 * fq;
        f32x4 bv[2][2];
#pragma unroll
        for (int bj = 0; bj < 2; ++bj)
#pragma unroll
            for (int n = 0; n < 2; ++n) bv[bj][n] = bias ? *(const f32x4*)(bias + col0 + bj * 128 + 16 * n) : (f32x4){0.f, 0.f, 0.f, 0.f};
#pragma unroll
        for (int ai = 0; ai < 2; ++ai)
#pragma unroll
            for (int m = 0; m < 4; ++m) { bf16_t* rowp = O + (size_t)(row0 + ai * 128 + m * 16) * ldo + col0;
#pragma unroll
                for (int bj = 0; bj < 2; ++bj)
#pragma unroll
                    for (int n = 0; n < 2; ++n) { f32x4 v = acc[ai][bj][m][n] * scale + bv[bj][n];
                        if (KIND == 3) {
#pragma unroll
                            for (int j = 0; j < 4; ++j) v[j] = sigmoidf_(v[j]); }
                        u32x2 w; w.x = cvt_pk_bf16(v[0], v[1]); w.y = cvt_pk_bf16(v[2], v[3]); *(u32x2*)(rowp + bj * 128 + n * 16) = w; } }
    }
};
struct EpiOutProj {
    static constexpr bool PERM = false, AFTER_DRAIN = false;
    const float* xp; const float* xs; float* out; bf16_t* X1B;
    __device__ __forceinline__ void operator()(const f32x4 (&acc)[2][2][4][2], const Unit& u, int wr, int wc, int fr, int fq) const {
        const int row0 = u.pm * 256 + wr * 64 + fr, col0 = u.pn * 256 + wc * 32 + 4 * fq;
#pragma unroll
        for (int ai = 0; ai < 2; ++ai)
#pragma unroll
            for (int m = 0; m < 4; ++m) { const int row = row0 + ai * 128 + m * 16;
                const bool real = row < MP + MS;
                const float* xr = row < MP ? xp + (size_t)row * DM : xs + (size_t)(real ? row - MP : 0) * DM;
                float* orow = row < MP ? out + O_Y + (size_t)row * DM : out + O_YS + (size_t)(real ? row - MP : 0) * DM;
#pragma unroll
                for (int bj = 0; bj < 2; ++bj)
#pragma unroll
                    for (int n = 0; n < 2; ++n) { const int c = col0 + bj * 128 + n * 16; f32x4 v = acc[ai][bj][m][n];
                        if (real) { v = v + *(const f32x4*)(xr + c); *(f32x4*)(orow + c) = v; } else v = (f32x4){0.f, 0.f, 0.f, 0.f};
                        u32x2 w; w.x = cvt_pk_bf16(v[0], v[1]); w.y = cvt_pk_bf16(v[2], v[3]); *(u32x2*)(X1B + (size_t)row * DM + c) = w; } }
    }
};


struct EpiInProjNP {
    static constexpr bool PERM = false, AFTER_DRAIN = false;
    bf16_t* PA; bf16_t* PB; const float* rs;
    __device__ __forceinline__ void operator()(const f32x4 (&acc)[2][2][4][2], const Unit& u, int wr, int wc, int fr, int fq) const {
        const int row0 = u.pm * 256 + wr * 64 + fr, pn = u.pn; bf16_t* base = pn < 12 ? PA + pn * 256 : PB + (pn - 12) * 256; const int col0 = wc * 32 + 4 * fq;
        const int kind = pn < 8 ? 0 : ((pn < 12 || pn >= 20) ? 1 : (pn < 16 ? 2 : 3));
#pragma unroll
        for (int ai = 0; ai < 2; ++ai)
#pragma unroll
            for (int m = 0; m < 4; ++m) { const int row = row0 + ai * 128 + m * 16; const float s = rs[row];
#pragma unroll
                for (int bj = 0; bj < 2; ++bj)
#pragma unroll
                    for (int n = 0; n < 2; ++n) { f32x4 v = acc[ai][bj][m][n] * s;
#pragma unroll
                        for (int j = 0; j < 4; ++j) { float x = v[j]; if (kind == 0) { f32x2 g2 = gelu_pk((f32x2){x, x}); x = g2.x; } else if (kind == 1) x = siluf_(x); else if (kind == 3) x = sigmoidf_(x); v[j] = x; }
                        u32x2 w; w.x = cvt_pk_bf16(v[0], v[1]); w.y = cvt_pk_bf16(v[2], v[3]); *(u32x2*)(base + (size_t)row * 3072 + col0 + bj * 128 + n * 16) = w; } }
    }
};
__device__ __forceinline__ void p1_inproj(const Ctx& F) {
    unsigned char* ws = F.ws; Gemm g{DM, DM, DM};
    OrderXcd S{64, 24, 64 * 24, F.G, F.bid, (const char*)(ws + WS_XB), (const char*)(ws + WS_WIN), (size_t)256 * DM * 2, (size_t)256 * DM * 2};
    EpiInProjNP E{(bf16_t*)(ws + WS_PROJA), (bf16_t*)(ws + WS_PROJB), (const float*)(ws + WS_RS)};
    pg8::gemm_phase<EpiInProjNP, OrderXcd>(F.lds, g, S, E);
}
__device__ __forceinline__ void p7_outproj(const Ctx& F) {
    unsigned char* ws = F.ws; Gemm g{DMIX, DMIX, DMIX};
    OrderPanel4 S{64 * 4, F.G, F.bid, (const char*)(ws + WS_Y), (const char*)(ws + WS_WOUT), (size_t)256 * DMIX * 2, (size_t)256 * DMIX * 2};
    EpiOutProj E{F.in[0], F.in[1], F.out, (bf16_t*)(ws + WS_X1B)};
    pg8::gemm_phase<EpiOutProj, OrderPanel4>(F.lds, g, S, E);
}
__device__ __forceinline__ void p8_ple(const Ctx& F) {
    unsigned char* ws = F.ws;
    { Gemm g{DM, DM, DM}; OrderPanel4 S{NTILE * 4, F.G, F.bid, (const char*)(ws + WS_X1B), (const char*)(ws + WS_WPG), (size_t)256 * DM * 2, (size_t)256 * DM * 2};
      EpiBf16Act<3> E{(bf16_t*)(ws + WS_GB), DM, F.in[25], 1.0f}; pg8::gemm_phase<EpiBf16Act<3>, OrderPanel4>(F.lds, g, S, E); }
    { Gemm g{DPLE, DPLE, DPLE}; OrderPanel4 S{NTILE * 4, F.G, (F.bid + 128) & 255, (const char*)(ws + WS_PB), (const char*)(ws + WS_WPP), (size_t)256 * DPLE * 2, (size_t)256 * DPLE * 2};
      EpiBf16Act<0> E{(bf16_t*)(ws + WS_EB), DM, nullptr, 1.0f}; pg8::gemm_phase<EpiBf16Act<0>, OrderPanel4>(F.lds, g, S, E); }
}
typedef float f32x4_t __attribute__((ext_vector_type(4)));
__device__ __forceinline__ void p2b_spatial_units(const Ctx& F0) { Ctx F = F0; asm volatile("" : "+v"(F.tid), "+v"(F.lane));
    unsigned char* ws = F.ws;
    const bf16_t* PA = (const bf16_t*)(ws + WS_PROJA); const bf16_t* WSP = (const bf16_t*)(ws + WS_WSP); bf16_t* Y = (bf16_t*)(ws + WS_Y);
    const float* lng = F.in[10]; const float* lnb = F.in[11]; const float* bsp = F.in[13];
    LAS bf16_t* vnT = (LAS bf16_t*)F.lds;
    const int lane = F.lane, w = F.wave, l15 = lane & 15, lq = lane >> 4;
    for (int unit = F.bid; unit < NB * 16 * HA; unit += F.G) {
        const int b = unit >> 7, c = (unit >> 3) & 15, h = unit & 7, r0 = b * SEQ + c * 128;
        const float g0 = lng[h * 128 + 2 * lane], g1 = lng[h * 128 + 2 * lane + 1], b0 = lnb[h * 128 + 2 * lane], b1 = lnb[h * 128 + 2 * lane + 1];
        unsigned wav[8], wbv[8];
#pragma unroll
        for (int p = 0; p < 8; ++p) { const int s0 = w * 16 + 2 * p; wav[p] = *(const unsigned*)(PA + (size_t)(r0 + s0) * 3072 + 1024 + h * 128 + 2 * lane); wbv[p] = *(const unsigned*)(PA + (size_t)(r0 + s0 + 1) * 3072 + 1024 + h * 128 + 2 * lane); }
#pragma unroll
        for (int p = 0; p < 8; ++p) { const int s0 = w * 16 + 2 * p; const unsigned wa = wav[p], wb = wbv[p];
            float a0 = bf_lo(wa), a1 = bf_hi(wa), c0 = bf_lo(wb), c1 = bf_hi(wb);
            const float mua = wave_sum(a0 + a1) * (1.f / 128.f), mub = wave_sum(c0 + c1) * (1.f / 128.f);
            a0 -= mua; a1 -= mua; c0 -= mub; c1 -= mub;
            const float ra = 1.0f / sqrtf(wave_sum(a0 * a0 + a1 * a1) * (1.f / 128.f) + EPS), rb = 1.0f / sqrtf(wave_sum(c0 * c0 + c1 * c1) * (1.f / 128.f) + EPS);
            *(LAS unsigned*)(vnT + (2 * lane) * 136 + s0) = cvt_pk_bf16(a0 * ra * g0 + b0, c0 * rb * g0 + b0);
            *(LAS unsigned*)(vnT + (2 * lane + 1) * 136 + s0) = cvt_pk_bf16(a1 * ra * g1 + b1, c1 * rb * g1 + b1); }
        __syncthreads();
        const int t0 = 16 * w, nks = (t0 + 15) / 32 + 1;
        f32x4 acc[8];
#pragma unroll
        for (int nb = 0; nb < 8; ++nb) acc[nb] = (f32x4){0.f, 0.f, 0.f, 0.f};
        bf16x8 wfr[4];
#pragma unroll
        for (int ks = 0; ks < 4; ++ks) wfr[ks] = *(const bf16x8*)(WSP + ((size_t)h * 128 + t0 + l15) * 128 + ks * 32 + 8 * lq);
        const int t = t0 + l15; const float bt = bsp[h * 128 + t]; const size_t row = (size_t)(r0 + t);
        u32x2 uuv[8], zzv[8];
#pragma unroll
        for (int nb = 0; nb < 8; ++nb) { const int d = nb * 16 + 4 * lq; uuv[nb] = *(const u32x2*)(PA + row * 3072 + h * 128 + d); zzv[nb] = *(const u32x2*)(PA + row * 3072 + 2048 + h * 128 + d); }
#pragma unroll
        for (int ks = 0; ks < 4; ++ks) { if (ks < nks) { const int k0 = ks * 32;
#pragma unroll
            for (int nb = 0; nb < 8; ++nb) { const bf16x8 vf = *(const LAS bf16x8*)(vnT + (nb * 16 + l15) * 136 + k0 + 8 * lq);
                acc[nb] = __builtin_amdgcn_mfma_f32_16x16x32_bf16(vf, wfr[ks], acc[nb], 0, 0, 0); } } }
#pragma unroll
        for (int nb = 0; nb < 8; ++nb) { const int d = nb * 16 + 4 * lq; const u32x2 uu = uuv[nb], zz = zzv[nb];
            u32x2 o; o.x = cvt_pk_bf16(bf_lo(uu.x) * (acc[nb][0] + bt) * bf_lo(zz.x), bf_hi(uu.x) * (acc[nb][1] + bt) * bf_hi(zz.x));
            o.y = cvt_pk_bf16(bf_lo(uu.y) * (acc[nb][2] + bt) * bf_lo(zz.y), bf_hi(uu.y) * (acc[nb][3] + bt) * bf_hi(zz.y));
            *(u32x2*)(Y + row * DMIX + h * 128 + d) = o; }
        __syncthreads();
    }
}
__device__ __forceinline__ void p2b_mscan(const Ctx& F) { if (F.bid < 32 && F.wave == 0) mscan_wave(F, F.bid); }

struct OrderHeadRows {
    int n, G, c; const char* A; size_t astep; const char* B; int pm0;
    __device__ __forceinline__ bool next(int i, Unit& u) const { const int L = i * G + c; if (L >= n) return false;
        u.pm = pm0 + (L >> 2); u.pn = 0; u.aux = L & 3; u.a = A + (size_t)u.pm * astep + (size_t)u.aux * 512; u.b = B + (size_t)u.aux * 131072; return true; }
};
struct OrderHeadT {
    int n, G, c; const char* W; const char* X; size_t xstep;
    __device__ __forceinline__ bool next(int i, Unit& u) const { const int L = i * G + c; if (L >= n) return false;
        const int b = L >> 5, h = (L >> 3) & 3, cc = L & 7; u.pm = b * 8 + cc; u.pn = L; u.aux = h; u.a = W + (size_t)h * 131072; u.b = X + (size_t)u.pm * xstep + (size_t)h * 512; return true; }
};
struct EpiQ {
    static constexpr bool PERM = false, AFTER_DRAIN = false;
    bf16_t* Q; bf16_t* PQ; const float* DG;
    __device__ __forceinline__ void operator()(const f32x4 (&acc)[2][2][4][2], const Unit& u, int wr, int wc, int fr, int fq) const {
        const int h = u.aux, rl0 = wr * 64 + fr, col0 = wc * 32 + 4 * fq; const bool prompt = u.pm < 64;
        const int unit = ((u.pm >> 3) * 4 + h) * 8 + (u.pm & 7);
#pragma unroll
        for (int ai = 0; ai < 2; ++ai)
#pragma unroll
            for (int m = 0; m < 4; ++m) { const int rl = rl0 + ai * 128 + m * 16, row = u.pm * 256 + rl;
#pragma unroll
                for (int bj = 0; bj < 2; ++bj)
#pragma unroll
                    for (int n = 0; n < 2; ++n) { const int c = col0 + bj * 128 + n * 16; const f32x4 v = acc[ai][bj][m][n];
                        u32x2 w; w.x = cvt_pk_bf16(v[0], v[1]); w.y = cvt_pk_bf16(v[2], v[3]); *(u32x2*)(Q + (size_t)row * 1024 + h * 256 + c) = w; }
                asm volatile("" ::: "memory"); }
        if (prompt) {
#pragma unroll
        for (int ai = 0; ai < 2; ++ai)
#pragma unroll
            for (int m = 0; m < 4; ++m) { const int rl = rl0 + ai * 128 + m * 16, row = u.pm * 256 + rl; const float g = DG[(size_t)h * MA + row];
#pragma unroll
                for (int bj = 0; bj < 2; ++bj)
#pragma unroll
                    for (int n = 0; n < 2; ++n) { const int c = col0 + bj * 128 + n * 16; const f32x4 v = acc[ai][bj][m][n] * g;
                        u32x2 w2; w2.x = cvt_pk_bf16(v[0], v[1]); w2.y = cvt_pk_bf16(v[2], v[3]); *(u32x2*)(PQ + ((size_t)unit * 256 + rl) * 512 + 256 + c) = w2; }
                asm volatile("" ::: "memory"); } }
    }
};
struct EpiHeadPlain {
    static constexpr bool PERM = false, AFTER_DRAIN = false;
    bf16_t* O; float scale; int row_off;
    __device__ __forceinline__ void operator()(const f32x4 (&acc)[2][2][4][2], const Unit& u, int wr, int wc, int fr, int fq) const {
        const int h = u.aux, row0 = u.pm * 256 - row_off + wr * 64 + fr, col0 = h * 256 + wc * 32 + 4 * fq;
#pragma unroll
        for (int ai = 0; ai < 2; ++ai)
#pragma unroll
            for (int m = 0; m < 4; ++m) { bf16_t* rowp = O + (size_t)(row0 + ai * 128 + m * 16) * 1024 + col0;
#pragma unroll
                for (int bj = 0; bj < 2; ++bj)
#pragma unroll
                    for (int n = 0; n < 2; ++n) { const f32x4 v = acc[ai][bj][m][n] * scale; u32x2 w; w.x = cvt_pk_bf16(v[0], v[1]); w.y = cvt_pk_bf16(v[2], v[3]); *(u32x2*)(rowp + bj * 128 + n * 16) = w; } }
    }
};
struct EpiUnitT {
    static constexpr bool PERM = false, AFTER_DRAIN = false;
    bf16_t* O; int ldo; const float* cs; float scale;
    __device__ __forceinline__ void operator()(const f32x4 (&acc)[2][2][4][2], const Unit& u, int wr, int wc, int fr, int fq) const {
        const int h = u.aux, rl0 = wr * 64 + fr, col0 = wc * 32 + 4 * fq; bf16_t* base = O + (size_t)u.pn * 256 * ldo;
#pragma unroll
        for (int ai = 0; ai < 2; ++ai)
#pragma unroll
            for (int m = 0; m < 4; ++m) { bf16_t* rowp = base + (size_t)(rl0 + ai * 128 + m * 16) * ldo + col0;
#pragma unroll
                for (int bj = 0; bj < 2; ++bj)
#pragma unroll
                    for (int n = 0; n < 2; ++n) { const f32x4 scv = cs ? *(const f32x4*)(cs + (size_t)h * MA + u.pm * 256 + col0 + bj * 128 + n * 16) * scale : (f32x4){scale, scale, scale, scale}; const f32x4 v = acc[ai][bj][m][n] * scv; u32x2 w; w.x = cvt_pk_bf16(v[0], v[1]); w.y = cvt_pk_bf16(v[2], v[3]); *(u32x2*)(rowp + bj * 128 + n * 16) = w; } }
    }
};
struct OrderQK {
    int G, c; const char* ws;
    __device__ __forceinline__ bool next(int i, Unit& u) const { const int L = i * G + c; if (L >= 512) return false; const char* XC = ws + WS_XB; const char* WQ = ws + WS_WQ; const char* WK = ws + WS_WK;
        const int kind = L >> 8, l = L & 255; u.pm = l >> 2; u.pn = kind; u.aux = l & 3; u.a = XC + (size_t)u.pm * (256 * DM * 2) + (size_t)u.aux * 512; u.b = (kind ? WK : WQ) + (size_t)u.aux * 131072; return true; }
};
struct EpiQK {
    static constexpr bool PERM = false, AFTER_DRAIN = false;
    bf16_t* Q; bf16_t* K; bf16_t* PQ; const float* DG;
    __device__ __forceinline__ void operator()(const f32x4 (&acc)[2][2][4][2], const Unit& u, int wr, int wc, int fr, int fq) const {
        const int h = u.aux, rl0 = wr * 64 + fr, col0 = wc * 32 + 4 * fq; const bool isk = u.pn != 0; bf16_t* O = isk ? K : Q; const float sc = isk ? 0.0625f : 1.0f;
        const int unit = ((u.pm >> 3) * 4 + h) * 8 + (u.pm & 7);
#pragma unroll
        for (int ai = 0; ai < 2; ++ai)
#pragma unroll
            for (int m = 0; m < 4; ++m) { const int rl = rl0 + ai * 128 + m * 16, row = u.pm * 256 + rl;
#pragma unroll
                for (int bj = 0; bj < 2; ++bj)
#pragma unroll
                    for (int n = 0; n < 2; ++n) { const int c = col0 + bj * 128 + n * 16; const f32x4 v = acc[ai][bj][m][n] * sc;
                        u32x2 w; w.x = cvt_pk_bf16(v[0], v[1]); w.y = cvt_pk_bf16(v[2], v[3]); *(u32x2*)(O + (size_t)row * 1024 + h * 256 + c) = w; }
                asm volatile("" ::: "memory"); }
        if (!isk) {
#pragma unroll
        for (int ai = 0; ai < 2; ++ai)
#pragma unroll
            for (int m = 0; m < 4; ++m) { const int rl = rl0 + ai * 128 + m * 16, row = u.pm * 256 + rl; const float g = DG[(size_t)h * MA + row];
#pragma unroll
                for (int bj = 0; bj < 2; ++bj)
#pragma unroll
                    for (int n = 0; n < 2; ++n) { const int c = col0 + bj * 128 + n * 16; const f32x4 v = acc[ai][bj][m][n] * g;
                        u32x2 w2; w2.x = cvt_pk_bf16(v[0], v[1]); w2.y = cvt_pk_bf16(v[2], v[3]); *(u32x2*)(PQ + ((size_t)unit * 256 + rl) * 512 + 256 + c) = w2; }
                asm volatile("" ::: "memory"); } }
    }
};
struct OrderS12 {
    int G, c; const char* ws;
    __device__ __forceinline__ bool next(int i, Unit& u) const { const int L = i * G + c; if (L >= 12) return false; const char* XC = ws + WS_XB; const char* XB2 = ws + WS_XB2; const char* WQ = ws + WS_WQ; const char* WK = ws + WS_WK; const char* WV = ws + WS_WV;
        const int kind = L >> 2; u.pm = 64; u.pn = kind; u.aux = L & 3; u.a = (kind == 2 ? XB2 : XC) + (size_t)64 * (256 * DM * 2) + (size_t)u.aux * 512; u.b = (kind == 0 ? WQ : kind == 1 ? WK : WV) + (size_t)u.aux * 131072; return true; }
};
struct EpiS12 {
    static constexpr bool PERM = false, AFTER_DRAIN = false;
    bf16_t* Q; bf16_t* K; bf16_t* Vs;
    __device__ __forceinline__ void operator()(const f32x4 (&acc)[2][2][4][2], const Unit& u, int wr, int wc, int fr, int fq) const {
        const int h = u.aux, kind = u.pn; bf16_t* O = kind == 0 ? Q + (size_t)MP * 1024 : kind == 1 ? K + (size_t)MP * 1024 : Vs; const float sc = kind == 1 ? 0.0625f : 1.0f;
        const int row0 = wr * 64 + fr, col0 = h * 256 + wc * 32 + 4 * fq;
#pragma unroll
        for (int m = 0; m < 4; ++m) { bf16_t* rowp = O + (size_t)(row0 + m * 16) * 1024 + col0;
#pragma unroll
            for (int bj = 0; bj < 2; ++bj)
#pragma unroll
                for (int n = 0; n < 2; ++n) { const f32x4 v = acc[0][bj][m][n] * sc; u32x2 w; w.x = cvt_pk_bf16(v[0], v[1]); w.y = cvt_pk_bf16(v[2], v[3]); *(u32x2*)(rowp + bj * 128 + n * 16) = w; } }
    }
};
struct OrderVW {
    int G, c; const char* ws;
    __device__ __forceinline__ bool next(int i, Unit& u) const { const int L = i * G + c; if (L >= 512) return false; const char* XC = ws + WS_XB; const char* XB2 = ws + WS_XB2; const char* WK = ws + WS_WK; const char* WV = ws + WS_WV;
        const int kind = L >> 8, l = L & 255, b = l >> 5, h = (l >> 3) & 3, cc = l & 7; u.pm = b * 8 + cc; u.pn = l | (kind << 8); u.aux = h;
        u.a = (kind ? WK : WV) + (size_t)h * 131072; u.b = (kind ? XC : XB2) + (size_t)u.pm * (256 * DM * 2) + (size_t)h * 512; return true; }
};
struct EpiVW {
    static constexpr bool PERM = false, AFTER_DRAIN = false;
    bf16_t* VC; bf16_t* WKT; const float* DW;
    __device__ __forceinline__ void operator()(const f32x4 (&acc)[2][2][4][2], const Unit& u, int wr, int wc, int fr, int fq) const {
        const int h = u.aux, kind = u.pn >> 8, l = u.pn & 255, rl0 = wr * 64 + fr, col0 = wc * 32 + 4 * fq; const int ldo = kind ? 256 : 512; bf16_t* base = (kind ? WKT : VC) + (size_t)l * 256 * ldo;
#pragma unroll
        for (int ai = 0; ai < 2; ++ai)
#pragma unroll
            for (int m = 0; m < 4; ++m) { bf16_t* rowp = base + (size_t)(rl0 + ai * 128 + m * 16) * ldo + col0;
#pragma unroll
                for (int bj = 0; bj < 2; ++bj)
#pragma unroll
                    for (int n = 0; n < 2; ++n) { const f32x4 scv = kind ? *(const f32x4*)(DW + (size_t)h * MA + u.pm * 256 + col0 + bj * 128 + n * 16) * 0.0625f : (f32x4){1.f, 1.f, 1.f, 1.f};
                        const f32x4 v = acc[ai][bj][m][n] * scv; u32x2 w; w.x = cvt_pk_bf16(v[0], v[1]); w.y = cvt_pk_bf16(v[2], v[3]); *(u32x2*)(rowp + bj * 128 + n * 16) = w; }
                asm volatile("" ::: "memory"); }
    }
};
__device__ __forceinline__ void p3_qkv(const Ctx& F) {
    unsigned char* ws = F.ws;
    { Gemm g{DM, 256, 256}; OrderQK S{F.G, F.bid, (const char*)ws}; EpiQK E{(bf16_t*)(ws + WS_Q), (bf16_t*)(ws + WS_K), (bf16_t*)(ws + WS_PQ), (const float*)(ws + WS_DG)};
      pg8::gemm_phase<EpiQK, OrderQK>(F.lds, g, S, E); }
    { Gemm g{DM, 256, 256}; OrderS12 S{F.G, (F.bid + 244) & 255, (const char*)ws}; EpiS12 E{(bf16_t*)(ws + WS_Q), (bf16_t*)(ws + WS_K), (bf16_t*)(ws + WS_VS)};
      pg8::gemm_phase<EpiS12, OrderS12>(F.lds, g, S, E); }
    { Gemm g{256, DM, 256}; OrderVW S{F.G, F.bid, (const char*)ws}; EpiVW E{(bf16_t*)(ws + WS_VC), (bf16_t*)(ws + WS_WKT), (const float*)(ws + WS_DW)};
      pg8::gemm_phase<EpiVW, OrderVW>(F.lds, g, S, E); }
}

struct OrderUnitNT {
    int n, G, c; const char* A; size_t astep_pm, astep_h, astep_u; const char* B; size_t bstep_pm, bstep_h, bstep_u;
    __device__ __forceinline__ bool next(int i, Unit& u) const { const int L = i * G + c; if (L >= n) return false;
        const int b = L >> 5, h = (L >> 3) & 3, cc = L & 7; u.pm = b * 8 + cc; u.pn = L; u.aux = h;
        u.a = A + (size_t)u.pm * astep_pm + (size_t)h * astep_h + (size_t)L * astep_u; u.b = B + (size_t)u.pm * bstep_pm + (size_t)h * bstep_h + (size_t)L * bstep_u; return true; }
};
struct EpiScore {
    static constexpr bool PERM = false, AFTER_DRAIN = false;
    bf16_t* PQ; const float* DA; const float* DR; float* DENP;
    __device__ __forceinline__ void operator()(const f32x4 (&acc)[2][2][4][2], const Unit& u, int wr, int wc, int fr, int fq) const {
        const int h = u.aux, rl0 = wr * 64 + fr, col0 = wc * 32 + 4 * fq; const size_t vb = (size_t)h * MA + (size_t)u.pm * 256;
#pragma unroll
        for (int ai = 0; ai < 2; ++ai)
#pragma unroll
            for (int m = 0; m < 4; ++m) { int t_ = rl0 + ai * 128 + m * 16; asm volatile("" : "+v"(t_)); const int t = t_; const float at = DA[vb + t]; float rs_ = 0.f; bf16_t* rowp = PQ + ((size_t)u.pn * 256 + t) * 512 + col0;
#pragma unroll
                for (int bj = 0; bj < 2; ++bj)
#pragma unroll
                    for (int n = 0; n < 2; ++n) { const int c = col0 + bj * 128 + n * 16; f32x4 v; const f32x4 rr = *(const f32x4*)(DR + vb + c);
#pragma unroll
                        for (int j = 0; j < 4; ++j) { const float e = fast_exp(fminf(at + rr[j], 0.f)); v[j] = (c + j <= t) ? acc[ai][bj][m][n][j] * e : 0.f; rs_ += v[j]; }
                        u32x2 w; w.x = cvt_pk_bf16(v[0], v[1]); w.y = cvt_pk_bf16(v[2], v[3]); *(u32x2*)(rowp + bj * 128 + n * 16) = w; }
                rs_ += __shfl_xor(rs_, 16); rs_ += __shfl_xor(rs_, 32);
                if (fq == 0) DENP[(vb + t) * 4 + wc] = rs_; asm volatile("" ::: "memory"); }
    }
};
struct EpiF32Unit {
    static constexpr bool PERM = false, AFTER_DRAIN = false;
    bf16_t* O;
    __device__ __forceinline__ void operator()(const f32x4 (&acc)[2][2][4][2], const Unit& u, int wr, int wc, int fr, int fq) const {
        bf16_t* base = O + (size_t)u.pn * 65536 + (size_t)(wr * 64 + fr) * 256 + wc * 32 + 4 * fq;
#pragma unroll
        for (int ai = 0; ai < 2; ++ai)
#pragma unroll
            for (int m = 0; m < 4; ++m)
#pragma unroll
                for (int bj = 0; bj < 2; ++bj)
#pragma unroll
                    for (int n = 0; n < 2; ++n) { const f32x4 v = acc[ai][bj][m][n]; u32x2 w; w.x = cvt_pk_bf16(v[0], v[1]); w.y = cvt_pk_bf16(v[2], v[3]); *(u32x2*)(base + (size_t)(ai * 128 + m * 16) * 256 + bj * 128 + n * 16) = w; }
    }
};
__device__ __forceinline__ void p4_scores_dc(const Ctx& F) {
    unsigned char* ws = F.ws;
    { Gemm g{DM, DM, 256}; OrderUnitNT S{NUNIT, F.G, F.bid, (const char*)(ws + WS_Q), (size_t)256 * DM * 2, 512, 0, (const char*)(ws + WS_K), (size_t)256 * DM * 2, 512, 0};
      EpiScore E{(bf16_t*)(ws + WS_PQ), (const float*)(ws + WS_DA), (const float*)(ws + WS_DR), (float*)(ws + WS_DENP)}; pg8::gemm_phase<EpiScore, OrderUnitNT>(F.lds, g, S, E); }
    { Gemm g{512, 256, 256}; OrderUnitNT S{NUNIT, F.G, F.bid, (const char*)(ws + WS_VC), 0, 0, (size_t)256 * 512 * 2, (const char*)(ws + WS_WKT), 0, 0, (size_t)256 * 256 * 2};
      EpiF32Unit E{(bf16_t*)(F.out + O_Y)}; pg8::gemm_phase<EpiF32Unit, OrderUnitNT>(F.lds, g, S, E); }
    for (int u = F.bid; u < NUNIT; u += F.G) { const int d = F.tid >> 1, hf = F.tid & 1; const bf16_t* src = (const bf16_t*)(ws + WS_WKT) + ((size_t)u * 256 + d) * 256 + hf * 128; float s = 0.f;
#pragma unroll
        for (int j = 0; j < 16; ++j) { float t8[8]; unpack8(*(const u32x4*)(src + j * 8), t8);
#pragma unroll
            for (int e = 0; e < 8; ++e) s += t8[e]; }
        s += __shfl_xor(s, 1); if (hf == 0) ((float*)(ws + WS_DN))[(size_t)u * 256 + d] = s; }
}

__device__ __forceinline__ void p5_scan_sample(const Ctx& F0) { Ctx F = F0; asm volatile("" : "+v"(F.tid), "+v"(F.lane));
    unsigned char* ws = F.ws; const float* DG = (const float*)(ws + WS_DG); const bf16_t* DCb = (const bf16_t*)(F.out + O_Y); bf16_t* VC = (bf16_t*)(ws + WS_VC);
    for (int idx = F.bid * 512 + F.tid; idx < 32 * 16384; idx += F.G * 512) { const int bh = idx >> 14, q4 = idx & 16383, e = q4 >> 6, d4 = (q4 & 63) * 4, b = bh >> 2, h = bh & 3;
        f32x4 dc[8]; float ge[8];
#pragma unroll
        for (int c = 0; c < 8; ++c) { const u32x2 dw = *(const u32x2*)(DCb + ((size_t)(bh * 8 + c) * 256 + e) * 256 + d4); dc[c] = (f32x4){bf_lo(dw.x), bf_hi(dw.x), bf_lo(dw.y), bf_hi(dw.y)}; ge[c] = DG[(size_t)h * MA + b * SEQ + c * 256 + 255]; }
        f32x4 C = (f32x4){0.f, 0.f, 0.f, 0.f};
#pragma unroll
        for (int c = 0; c < 8; ++c) { u32x2 w; w.x = cvt_pk_bf16(C[0], C[1]); w.y = cvt_pk_bf16(C[2], C[3]); *(u32x2*)(VC + ((size_t)(bh * 8 + c) * 256 + e) * 512 + 256 + d4) = w; C = C * ge[c] + dc[c]; }
        *(f32x4*)(F.out + O_CP + ((size_t)bh * 256 + e) * 256 + d4) = C; }
    LAS float* npv = (LAS float*)F.lds;
    for (int u = F.bid; u < NUNIT; u += F.G) { const int bh = u >> 3, cc = u & 7, b = bh >> 2, h = bh & 3;
        __syncthreads();
        if (F.tid < 256) { float n = 0.f; const float* DN = (const float*)(ws + WS_DN);
            for (int j = 0; j < cc; ++j) n = DG[(size_t)h * MA + b * SEQ + j * 256 + 255] * n + DN[(size_t)(bh * 8 + j) * 256 + F.tid];
            npv[F.tid] = n; if (cc == 7) F.out[O_NP + (size_t)bh * 256 + F.tid] = DG[(size_t)h * MA + b * SEQ + 7 * 256 + 255] * n + DN[(size_t)u * 256 + F.tid]; }
        __syncthreads();
        const f32x4 nv = *(const LAS f32x4*)(npv + 4 * F.lane); const bf16_t* Q = (const bf16_t*)(ws + WS_Q);
        for (int r = 0; r < 32; ++r) { const size_t row = (size_t)b * SEQ + cc * 256 + F.wave * 32 + r; const u32x2 qq = *(const u32x2*)(Q + row * 1024 + h * 256 + 4 * F.lane);
            const float s = wave_sum(bf_lo(qq.x) * nv[0] + bf_hi(qq.x) * nv[1] + bf_lo(qq.y) * nv[2] + bf_hi(qq.y) * nv[3]); if (F.lane == 0) ((float*)(ws + WS_QN))[(size_t)h * MA + row] = s; } }

}


__device__ __forceinline__ void p5s_sample(const Ctx& F0) { Ctx F = F0; asm volatile("" : "+v"(F.tid), "+v"(F.lane));
    unsigned char* ws = F.ws;
    LAS float* hs = (LAS float*)F.lds + 512; LAS float* red = (LAS float*)F.lds + 1024;
    for (int job = F.bid; job < MS * HB; job += F.G) { const int i = job >> 2, h = job & 3; const size_t row = MP + i;
        const bf16_t* Q = (const bf16_t*)(ws + WS_Q) + row * 1024 + h * 256; const bf16_t* K = (const bf16_t*)(ws + WS_K) + row * 1024 + h * 256; const bf16_t* V = (const bf16_t*)(ws + WS_VS) + (size_t)i * 1024 + h * 256;
        const u32x2 qw = *(const u32x2*)(Q + 4 * F.lane), kw = *(const u32x2*)(K + 4 * F.lane);
        const f32x4 q4 = (f32x4){bf_lo(qw.x), bf_hi(qw.x), bf_lo(qw.y), bf_hi(qw.y)}, k4 = (f32x4){bf_lo(kw.x), bf_hi(kw.x), bf_lo(kw.y), bf_hi(kw.y)};
        const f32x4 n0 = *(const f32x4*)(F.in[3] + ((size_t)i * 4 + h) * 256 + 4 * F.lane);
        const float li = ((const float*)(ws + WS_GLI))[(size_t)h * MA + row], lf = ((const float*)(ws + WS_GLF))[(size_t)h * MA + row], m0 = F.in[4][i * 4 + h];
        const float mn = fmaxf(lf + m0, li), g = __expf(lf + m0 - mn), wi = __expf(li - mn);
        const float qk = wave_sum(q4[0] * k4[0] + q4[1] * k4[1] + q4[2] * k4[2] + q4[3] * k4[3]), nq = wave_sum(n0[0] * q4[0] + n0[1] * q4[1] + n0[2] * q4[2] + n0[3] * q4[3]);
        const float sc = wi * qk, den = sc + g * nq, dinv = 1.0f / fmaxf(fabsf(den), __expf(-mn));
        const float* C0 = F.in[2] + (((size_t)i * 4 + h) * 256 + F.wave * 32) * 256 + 4 * F.lane; float* C1 = F.out + O_CS + (((size_t)i * 4 + h) * 256 + F.wave * 32) * 256 + 4 * F.lane;
        __syncthreads();
#pragma unroll 1
        for (int r8 = 0; r8 < 32; r8 += 8) { f32x4 c[8]; float ve[8], cq[8];
#pragma unroll
            for (int r = 0; r < 8; ++r) { c[r] = *(const f32x4*)(C0 + (size_t)(r8 + r) * 256); ve[r] = bf2f(V[F.wave * 32 + r8 + r]); }
#pragma unroll
            for (int r = 0; r < 8; ++r) { cq[r] = c[r][0] * q4[0] + c[r][1] * q4[1] + c[r][2] * q4[2] + c[r][3] * q4[3]; const float wv = wi * ve[r]; *(f32x4*)(C1 + (size_t)(r8 + r) * 256) = c[r] * g + k4 * wv; }
#pragma unroll
            for (int r = 0; r < 8; ++r) { cq[r] = wave_sum(cq[r]); if (F.lane == 0) hs[F.wave * 32 + r8 + r] = (sc * ve[r] + g * cq[r]) * dinv; } }
        if (F.wave == 0) { *(f32x4*)(F.out + O_NS + ((size_t)i * 4 + h) * 256 + 4 * F.lane) = n0 * g + k4 * wi; if (F.lane == 0) F.out[O_MS + i * 4 + h] = mn; }
        __syncthreads();
        const bf16_t* PB = (const bf16_t*)(ws + WS_PROJB) + row * 3072; const bf16_t* XC = (const bf16_t*)(ws + WS_XB) + row * DM;
        float x = 0.f; const int ch = h * 256 + (F.tid & 255);
        if (F.tid < 256) x = hs[F.tid] * bf2f(PB[1024 + ch]);
        float p = wave_sum(x); if (F.lane == 0) red[F.wave] = p;
        __syncthreads();
        const float mu = (red[0] + red[1] + red[2] + red[3]) * (1.f / 256.f), dx = x - mu;
        __syncthreads();
        p = wave_sum(F.tid < 256 ? dx * dx : 0.f); if (F.lane == 0) red[F.wave] = p;
        __syncthreads();
        const float rstd = 1.0f / sqrtf((red[0] + red[1] + red[2] + red[3]) * (1.f / 256.f) + EPS);
        if (F.tid < 256) ((bf16_t*)(ws + WS_Y))[row * DMIX + 1024 + ch] = f2bf((dx * rstd * F.in[21][ch] + F.in[22][ch] * bf2f(XC[ch])) * bf2f(PB[2048 + ch]));
        __syncthreads();
    }
}
struct EpiHOut {
    static constexpr bool PERM = false, AFTER_DRAIN = true;
    const float* DENP; const float* DG; const float* QN; const float* DEM; const bf16_t* PB; const bf16_t* XC; bf16_t* Y; const float* gng; const float* skip;
    __device__ __forceinline__ void fused(f32x4 (&acc)[2][2][4][2], const Unit& u, int wr, int wc, int fr, int fq, LAS unsigned char* lds, int wid, int lane) const {
        const int h = u.aux, rl0 = wr * 64 + fr, col0 = wc * 32 + 4 * fq; const size_t vb = (size_t)h * MA + (size_t)u.pm * 256;
        LAS float* P1 = (LAS float*)lds; LAS float* P2 = (LAS float*)lds + 1024;
#pragma unroll
        for (int ai = 0; ai < 2; ++ai) { u32x2 ow[4][2][2]; f32x4 dp[4]; float dgq[4], dem[4];
#pragma unroll
            for (int m = 0; m < 4; ++m) { const int t = rl0 + ai * 128 + m * 16; const size_t row = (size_t)u.pm * 256 + t; dp[m] = *(const f32x4*)(DENP + (vb + t) * 4); dgq[m] = DG[vb + t] * QN[vb + t]; dem[m] = DEM[vb + t];
#pragma unroll
                for (int bj = 0; bj < 2; ++bj)
#pragma unroll
                    for (int n = 0; n < 2; ++n) ow[m][bj][n] = *(const u32x2*)(PB + row * 3072 + 1024 + h * 256 + col0 + bj * 128 + n * 16); }
#pragma unroll
            for (int m = 0; m < 4; ++m) { const int t = rl0 + ai * 128 + m * 16; const float den = (dp[m][0] + dp[m][1]) + (dp[m][2] + dp[m][3]) + dgq[m];
                const float dinv = 1.0f / fmaxf(fabsf(den), dem[m]); float s = 0.f;
#pragma unroll
                for (int bj = 0; bj < 2; ++bj)
#pragma unroll
                    for (int n = 0; n < 2; ++n) { const u32x2 o2 = ow[m][bj][n];
                        f32x4 v = acc[ai][bj][m][n] * dinv; v[0] *= bf_lo(o2.x); v[1] *= bf_hi(o2.x); v[2] *= bf_lo(o2.y); v[3] *= bf_hi(o2.y); acc[ai][bj][m][n] = v; s += (v[0] + v[1]) + (v[2] + v[3]); }
                s += __shfl_xor(s, 16); s += __shfl_xor(s, 32); if (fq == 0) P1[t * 4 + wc] = s; } }
        asm volatile("s_waitcnt lgkmcnt(0)" ::: "memory"); __builtin_amdgcn_s_barrier(); asm volatile("" ::: "memory");
#pragma unroll
        for (int ai = 0; ai < 2; ++ai)
#pragma unroll
            for (int m = 0; m < 4; ++m) { const int t = rl0 + ai * 128 + m * 16; const f32x4 ps = *(const LAS f32x4*)(P1 + t * 4); const float mu = ((ps[0] + ps[1]) + (ps[2] + ps[3])) * (1.f / 256.f); float q = 0.f;
#pragma unroll
                for (int bj = 0; bj < 2; ++bj)
#pragma unroll
                    for (int n = 0; n < 2; ++n) { f32x4 v = acc[ai][bj][m][n] - mu; acc[ai][bj][m][n] = v; q += (v[0] * v[0] + v[1] * v[1]) + (v[2] * v[2] + v[3] * v[3]); }
                q += __shfl_xor(q, 16); q += __shfl_xor(q, 32); if (fq == 0) P2[t * 4 + wc] = q; }
        asm volatile("s_waitcnt lgkmcnt(0)" ::: "memory"); __builtin_amdgcn_s_barrier(); asm volatile("" ::: "memory");
#pragma unroll
        for (int ai = 0; ai < 2; ++ai) { u32x2 xw[4][2][2], zw[4][2][2];
#pragma unroll
            for (int m = 0; m < 4; ++m) { const int t = rl0 + ai * 128 + m * 16; const size_t row = (size_t)u.pm * 256 + t;
#pragma unroll
                for (int bj = 0; bj < 2; ++bj)
#pragma unroll
                    for (int n = 0; n < 2; ++n) { const int c = h * 256 + col0 + bj * 128 + n * 16; xw[m][bj][n] = *(const u32x2*)(XC + row * DM + c); zw[m][bj][n] = *(const u32x2*)(PB + row * 3072 + 2048 + c); } }
#pragma unroll
            for (int m = 0; m < 4; ++m) { const int t = rl0 + ai * 128 + m * 16; const size_t row = (size_t)u.pm * 256 + t; const f32x4 ps = *(const LAS f32x4*)(P2 + t * 4);
                const float rstd = 1.0f / sqrtf(((ps[0] + ps[1]) + (ps[2] + ps[3])) * (1.f / 256.f) + EPS);
#pragma unroll
                for (int bj = 0; bj < 2; ++bj)
#pragma unroll
                    for (int n = 0; n < 2; ++n) { const int c = h * 256 + col0 + bj * 128 + n * 16; const u32x2 x2 = xw[m][bj][n], z2 = zw[m][bj][n];
                        const f32x4 ggv = *(const f32x4*)(gng + c), skv = *(const f32x4*)(skip + c); const f32x4 v = acc[ai][bj][m][n] * rstd * ggv; u32x2 w;
                        w.x = cvt_pk_bf16((v[0] + skv[0] * bf_lo(x2.x)) * bf_lo(z2.x), (v[1] + skv[1] * bf_hi(x2.x)) * bf_hi(z2.x));
                        w.y = cvt_pk_bf16((v[2] + skv[2] * bf_lo(x2.y)) * bf_lo(z2.y), (v[3] + skv[3] * bf_hi(x2.y)) * bf_hi(z2.y));
                        *(u32x2*)(Y + row * DMIX + 1024 + c) = w; } } }
    }
};
__device__ __forceinline__ void p6_hout(const Ctx& F) {
    unsigned char* ws = F.ws; Gemm g{512, 512, 512};
    OrderUnitNT S{NUNIT, F.G, F.bid, (const char*)(ws + WS_PQ), 0, 0, (size_t)256 * 512 * 2, (const char*)(ws + WS_VC), 0, 0, (size_t)256 * 512 * 2};
    EpiHOut E{(const float*)(ws + WS_DENP), (const float*)(ws + WS_DG), (const float*)(ws + WS_QN), (const float*)(ws + WS_DEM), (const bf16_t*)(ws + WS_PROJB), (const bf16_t*)(ws + WS_XB), (bf16_t*)(ws + WS_Y), F.in[21], F.in[22]};
    pg8::gemm_phase<EpiHOut, OrderUnitNT, false, true>(F.lds, g, S, E);
}
template <class PtrF, class Ef>
__device__ __forceinline__ void sample_gemm(const Ctx& F, int nitems, int K, int lda, int ldb, const PtrF& P, const Ef& E) {
    const int l15 = F.lane & 15, lq = F.lane >> 4, w = F.wave;
    for (int item = F.bid; item < nitems; item += F.G) {
        const bf16_t* A; const bf16_t* B; P(item, A, B);
        const bf16_t* ap = A + (size_t)(16 * w + l15) * lda + 8 * lq; const bf16_t* bp = B + (size_t)l15 * ldb + 8 * lq;
        f32x4 acc = (f32x4){0.f, 0.f, 0.f, 0.f};
        for (int k0 = 0; k0 < K; k0 += 256) { bf16x8 a[8], b[8];
#pragma unroll
            for (int j = 0; j < 8; ++j) { a[j] = *(const bf16x8*)(ap + k0 + 32 * j); b[j] = *(const bf16x8*)(bp + k0 + 32 * j); }
#pragma unroll
            for (int j = 0; j < 8; ++j) acc = __builtin_amdgcn_mfma_f32_16x16x32_bf16(a[j], b[j], acc, 0, 0, 0); }
#pragma unroll
        for (int r = 0; r < 4; ++r) E(item, 16 * w + 4 * lq + r, l15, acc[r]);
    }
}
__device__ __forceinline__ void sample_inproj(const Ctx& F) {
    unsigned char* ws = F.ws; const bf16_t* XB = (const bf16_t*)(ws + WS_XB) + (size_t)MP * DM; const bf16_t* W = (const bf16_t*)(ws + WS_WIN);
    bf16_t* PA = (bf16_t*)(ws + WS_PROJA) + (size_t)MP * 3072; bf16_t* PB = (bf16_t*)(ws + WS_PROJB) + (size_t)MP * 3072; const float* rs = (const float*)(ws + WS_RS) + MP;
    sample_gemm(F, NIN / 16, DM, DM, DM,
        [=](int item, const bf16_t*& A, const bf16_t*& B) { A = XB; B = W + (size_t)item * 16 * DM; },
        [=](int item, int r, int c, float acc) { const int col = item * 16 + c, grp = col >> 10; float v = acc * rs[r];
            if (grp < 2) { const f32x2 g2 = gelu_pk((f32x2){v, v}); v = g2.x; } else if (grp == 2 || grp == 5) v = siluf_(v); else if (grp == 4) v = sigmoidf_(v);
            bf16_t* dst = col < 3072 ? PA + (size_t)r * 3072 + col : PB + (size_t)r * 3072 + (col - 3072); *dst = f2bf(v); });
}
__device__ __forceinline__ void sample_qkv(const Ctx& F) {
    unsigned char* ws = F.ws; const bf16_t* XC = (const bf16_t*)(ws + WS_XB) + (size_t)MP * DM; const bf16_t* XBr = (const bf16_t*)(ws + WS_PROJB) + (size_t)MP * 3072;
    const bf16_t* WQ = (const bf16_t*)(ws + WS_WQ); const bf16_t* WK = (const bf16_t*)(ws + WS_WK); const bf16_t* WV = (const bf16_t*)(ws + WS_WV);
    bf16_t* Q = (bf16_t*)(ws + WS_Q) + (size_t)MP * 1024; bf16_t* Kk = (bf16_t*)(ws + WS_K) + (size_t)MP * 1024; bf16_t* Vs = (bf16_t*)(ws + WS_VS);
    sample_gemm(F, 128, 256, DM, 256,
        [=](int item, const bf16_t*& A, const bf16_t*& B) { const int which = item >> 6, it = item & 63, h = it >> 4; A = XC + h * 256; B = (which ? WK : WQ) + (size_t)h * 65536 + (size_t)(it & 15) * 16 * 256; },
        [=](int item, int r, int c, float acc) { const int which = item >> 6, it = item & 63; bf16_t* O = which ? Kk : Q; O[(size_t)r * 1024 + it * 16 + c] = f2bf(which ? acc * 0.0625f : acc); });
    sample_gemm(F, 64, 256, 3072, 256,
        [=](int item, const bf16_t*& A, const bf16_t*& B) { const int h = item >> 4; A = XBr + h * 256; B = WV + (size_t)h * 65536 + (size_t)(item & 15) * 16 * 256; },
        [=](int item, int r, int c, float acc) { Vs[(size_t)r * 1024 + item * 16 + c] = f2bf(acc); });
}
__device__ __forceinline__ void sample_outproj(const Ctx& F) {
    unsigned char* ws = F.ws; const bf16_t* Y = (const bf16_t*)(ws + WS_Y) + (size_t)MP * DMIX; const bf16_t* W = (const bf16_t*)(ws + WS_WOUT);
    const float* xs = F.in[1]; float* out = F.out + O_YS; bf16_t* X1B = (bf16_t*)(ws + WS_X1B) + (size_t)MP * DM;
    sample_gemm(F, DM / 16, DMIX, DMIX, DMIX,
        [=](int item, const bf16_t*& A, const bf16_t*& B) { A = Y; B = W + (size_t)item * 16 * DMIX; },
        [=](int item, int r, int c, float acc) { const int col = item * 16 + c; const float v = xs[(size_t)r * DM + col] + acc; out[(size_t)r * DM + col] = v; X1B[(size_t)r * DM + col] = f2bf(v); });
}
__device__ __forceinline__ void sample_ple(const Ctx& F) {
    unsigned char* ws = F.ws; const bf16_t* X1B = (const bf16_t*)(ws + WS_X1B) + (size_t)MP * DM; const bf16_t* PBs = (const bf16_t*)(ws + WS_PB) + (size_t)MP * DPLE;
    const bf16_t* WG = (const bf16_t*)(ws + WS_WPG); const bf16_t* WP = (const bf16_t*)(ws + WS_WPP); const float* bias = F.in[25];
    bf16_t* GB = (bf16_t*)(ws + WS_GB) + (size_t)MP * DM; bf16_t* EB = (bf16_t*)(ws + WS_EB) + (size_t)MP * DM;
    sample_gemm(F, DM / 16, DM, DM, DM,
        [=](int item, const bf16_t*& A, const bf16_t*& B) { A = X1B; B = WG + (size_t)item * 16 * DM; },
        [=](int item, int r, int c, float acc) { const int col = item * 16 + c; GB[(size_t)r * DM + col] = f2bf(sigmoidf_(acc + bias[col])); });
    sample_gemm(F, DM / 16, DPLE, DPLE, DPLE,
        [=](int item, const bf16_t*& A, const bf16_t*& B) { A = PBs; B = WP + (size_t)item * 16 * DPLE; },
        [=](int item, int r, int c, float acc) { EB[(size_t)r * DM + item * 16 + c] = f2bf(acc); });
}
template <class PtrF, class Ef>
__device__ __forceinline__ void sample_gemm_ks(const Ctx& F, int nitems, int K, int lda, int ldb, const PtrF& P, const Ef& E) {
    const int l15 = F.lane & 15, lq = F.lane >> 4, w = F.wave; LAS f32x4* red = (LAS f32x4*)F.lds;
    const int ks = K >> 3;
    for (int item = F.bid; item < nitems; item += F.G) {
        const bf16_t* A; const bf16_t* B; P(item, A, B);
        const bf16_t* ap = A + (size_t)l15 * lda + w * ks + 8 * lq; const bf16_t* bp = B + (size_t)l15 * ldb + w * ks + 8 * lq;
        f32x4 acc[2][4];
#pragma unroll
        for (int m = 0; m < 2; ++m)
#pragma unroll
            for (int n = 0; n < 4; ++n) acc[m][n] = (f32x4){0.f, 0.f, 0.f, 0.f};
        for (int k0 = 0; k0 < ks; k0 += 128) { bf16x8 a[4][2], b[4][4];
#pragma unroll
            for (int j = 0; j < 4; ++j) {
#pragma unroll
                for (int m = 0; m < 2; ++m) a[j][m] = (k0 + 32 * j < ks) ? *(const bf16x8*)(ap + (size_t)(16 * m) * lda + k0 + 32 * j) : (bf16x8){0, 0, 0, 0, 0, 0, 0, 0};
#pragma unroll
                for (int n = 0; n < 4; ++n) b[j][n] = (k0 + 32 * j < ks) ? *(const bf16x8*)(bp + (size_t)(16 * n) * ldb + k0 + 32 * j) : (bf16x8){0, 0, 0, 0, 0, 0, 0, 0}; }
#pragma unroll
            for (int j = 0; j < 4; ++j)
#pragma unroll
                for (int m = 0; m < 2; ++m)
#pragma unroll
                    for (int n = 0; n < 4; ++n) acc[m][n] = __builtin_amdgcn_mfma_f32_16x16x32_bf16(a[j][m], b[j][n], acc[m][n], 0, 0, 0); }
        __syncthreads();
#pragma unroll
        for (int m = 0; m < 2; ++m)
#pragma unroll
            for (int n = 0; n < 4; ++n) red[(w * 8 + m * 4 + n) * 64 + F.lane] = acc[m][n];
        __syncthreads();
        f32x4 s = red[(0 * 8 + w) * 64 + F.lane];
#pragma unroll
        for (int ww = 1; ww < 8; ++ww) s = s + red[(ww * 8 + w) * 64 + F.lane];
        const int mt = w >> 2, nt = w & 3;
#pragma unroll
        for (int r = 0; r < 4; ++r) E(item, 16 * mt + 4 * lq + r, 16 * nt + l15, s[r]);
    }
    __syncthreads();
}
__device__ __forceinline__ void sample_outproj_ks(const Ctx& F) {
    unsigned char* ws = F.ws; const bf16_t* Y = (const bf16_t*)(ws + WS_Y) + (size_t)MP * DMIX; const bf16_t* W = (const bf16_t*)(ws + WS_WOUT);
    const float* xs = F.in[1]; float* out = F.out + O_YS; bf16_t* X1B = (bf16_t*)(ws + WS_X1B) + (size_t)MP * DM;
    sample_gemm_ks(F, 64, DMIX, DMIX, DMIX,
        [=](int item, const bf16_t*& A, const bf16_t*& B) { A = Y + (size_t)(item & 3) * 32 * DMIX; B = W + (size_t)(item >> 2) * 64 * DMIX; },
        [=](int item, int r, int c, float acc) { const int row = (item & 3) * 32 + r, col = (item >> 2) * 64 + c; const float v = xs[(size_t)row * DM + col] + acc; out[(size_t)row * DM + col] = v; X1B[(size_t)row * DM + col] = f2bf(v); });
}
__device__ __forceinline__ void sample_ple_ks(const Ctx& F) {
    unsigned char* ws = F.ws; const bf16_t* X1B = (const bf16_t*)(ws + WS_X1B) + (size_t)MP * DM; const bf16_t* PBs = (const bf16_t*)(ws + WS_PB) + (size_t)MP * DPLE;
    const bf16_t* WG = (const bf16_t*)(ws + WS_WPG); const bf16_t* WP = (const bf16_t*)(ws + WS_WPP); const float* bias = F.in[25];
    bf16_t* GB = (bf16_t*)(ws + WS_GB) + (size_t)MP * DM; bf16_t* EB = (bf16_t*)(ws + WS_EB) + (size_t)MP * DM;
    sample_gemm_ks(F, 64, DM, DM, DM,
        [=](int item, const bf16_t*& A, const bf16_t*& B) { A = X1B + (size_t)(item & 3) * 32 * DM; B = WG + (size_t)(item >> 2) * 64 * DM; },
        [=](int item, int r, int c, float acc) { const int row = (item & 3) * 32 + r, col = (item >> 2) * 64 + c; GB[(size_t)row * DM + col] = f2bf(sigmoidf_(acc + bias[col])); });
    sample_gemm_ks(F, 64, DPLE, DPLE, DPLE,
        [=](int item, const bf16_t*& A, const bf16_t*& B) { A = PBs + (size_t)(item & 3) * 32 * DPLE; B = WP + (size_t)(item >> 2) * 64 * DPLE; },
        [=](int item, int r, int c, float acc) { const int row = (item & 3) * 32 + r, col = (item >> 2) * 64 + c; EB[(size_t)row * DM + col] = f2bf(acc); });
}
#define XB_TMO      128
#define XB_XCNT(j)  (256  + 64 * (j))
#define XB_XSUB(j)  (1280 + 64 * (j))
#define XB_XGEN(j)  (2304 + 64 * (j))
#define XB_TOP      3328
#define XB_TOPGEN   3392
#define XCD_BAR_WORDS 3456
#define XB_SPIN_CAP (1u << 18)
__device__ __forceinline__ unsigned xb_ld(unsigned* p)              { return __hip_atomic_load(p, __ATOMIC_RELAXED, __HIP_MEMORY_SCOPE_AGENT); }
__device__ __forceinline__ unsigned xb_add(unsigned* p, unsigned v) { return __hip_atomic_fetch_add(p, v, __ATOMIC_RELAXED, __HIP_MEMORY_SCOPE_AGENT); }
__device__ __forceinline__ unsigned xb_xcc_id() { return (unsigned)__builtin_amdgcn_s_getreg((3 << 11) | 20) & 0xFu; }
#define XB_SPIN(cond, bar) do { unsigned _sp = 0; while (cond) { __builtin_amdgcn_s_sleep(1); \
    if ((++_sp & 255u) == 0u) { if (xb_ld(&(bar)[XB_TMO])) break; if (_sp > XB_SPIN_CAP) { atomicAdd(&(bar)[XB_TMO], 1u); break; } } } } while (0)
struct XcdBarrier { unsigned* bar; unsigned x; volatile LAS unsigned* st; };
__device__ __forceinline__ XcdBarrier xcd_barrier_post(unsigned* bar, volatile LAS unsigned* st) {
    XcdBarrier b; b.bar = bar; b.x = xb_xcc_id(); b.st = st;
    if (threadIdx.x == 0) (void)xb_add(&bar[XB_XCNT(b.x)], 1u);
    return b;
}
__device__ __forceinline__ void xcd_barrier_complete(unsigned* bar, unsigned x, unsigned& nloc, unsigned& nx) {
    const unsigned G = gridDim.x * gridDim.y * gridDim.z;
    unsigned sum, cnt, mine, sp = 0u;
    for (;;) {
        sum = 0u; cnt = 0u; mine = 0u;
#pragma unroll
        for (unsigned j = 0; j < 16; ++j) { const unsigned c = xb_ld(&bar[XB_XCNT(j)]); sum += c; cnt += (c > 0u) ? 1u : 0u; mine = (j == x) ? c : mine; }
        if (sum == G) break;
        __builtin_amdgcn_s_sleep(1);
        if ((++sp & 255u) == 0u) { if (xb_ld(&bar[XB_TMO])) break; if (sp > XB_SPIN_CAP) { atomicAdd(&bar[XB_TMO], 1u); break; } }
    }
    nloc = mine > 0u ? mine : 1u; nx = cnt > 0u ? cnt : 1u;
}
__device__ __forceinline__ void xcd_barrier(const XcdBarrier& b) {
    asm volatile("s_waitcnt vmcnt(0)" ::: "memory");
    __syncthreads();
    if (threadIdx.x == 0) {
        unsigned* bar = b.bar;
        __builtin_amdgcn_s_waitcnt(0);
        unsigned nloc = b.st[0], nx = b.st[1];
        if (nloc == 0u) { xcd_barrier_complete(bar, b.x, nloc, nx); b.st[0] = nloc; b.st[1] = nx; }
        const unsigned old = xb_add(&bar[XB_XSUB(b.x)], 1u);
        const unsigned gen = old / nloc;
        if (old + 1u == (gen + 1u) * nloc) {
            __builtin_amdgcn_fence(__ATOMIC_RELEASE, "agent");
            asm volatile("s_waitcnt vmcnt(0)" ::: "memory");
            const unsigned og = xb_add(&bar[XB_TOP], 1u);
            const unsigned tg = og / nx;
            if (og + 1u == (tg + 1u) * nx) xb_add(&bar[XB_TOPGEN], 1u);
            else XB_SPIN(xb_ld(&bar[XB_TOPGEN]) == tg, bar);
            __builtin_amdgcn_fence(__ATOMIC_ACQUIRE, "agent");
            xb_add(&bar[XB_XGEN(b.x)], 1u);
            asm volatile("s_waitcnt vmcnt(0)" ::: "memory");
        } else {
            XB_SPIN(xb_ld(&bar[XB_XGEN(b.x)]) == gen, bar);
            __builtin_amdgcn_fence(__ATOMIC_ACQUIRE, "agent");
            asm volatile("s_waitcnt vmcnt(0)" ::: "memory");
        }
    }
    __syncthreads();
}
__global__ void __launch_bounds__(512, 2) mega(Args args) {
    MAKE_CTX();
    volatile LAS unsigned* MISC = (volatile LAS unsigned*)(F.lds + 131072 + 320);
    if (F.tid < 32) MISC[F.tid] = 0u;
    __syncthreads();
    const XcdBarrier bar = xcd_barrier_post((unsigned*)(ws + WS_CTL), MISC + 8);
#define GRID_SYNC() xcd_barrier(bar)
    p0_prologue(F);      GRID_SYNC();
    sample_inproj(F); p1_inproj(F); GRID_SYNC();
    p2a_conv_gates(F); p2b_spatial_units(F); GRID_SYNC();
    p2b_mscan(F);        GRID_SYNC();
    p3_qkv(F);           GRID_SYNC();
    if (F.bid & 1) { p5s_sample(F); p4_scores_dc(F); } else { p4_scores_dc(F); p5s_sample(F); } GRID_SYNC();
    p5_scan_sample(F);   GRID_SYNC();
    p6_hout(F);          GRID_SYNC();
    sample_outproj_ks(F); p7_outproj(F); GRID_SYNC();
    p8_ple(F);           GRID_SYNC();
    p9_final(F);
}

extern "C" void kernel_launch(void* const* d_in, const int* in_sizes, int n_in, void* d_out, int out_size, void* d_ws, size_t ws_size, hipStream_t stream) {
    static int grid = 0;
    if (grid == 0) {
        if (n_in != 29 || (size_t)out_size != O_END || ws_size < WS_END) { fprintf(stderr, "kernel_launch: unexpected shapes (n_in %d out %d ws %zu)\n", n_in, out_size, ws_size); grid = -1; return; }
        int dev = 0, cus = 0, per_cu = 0;
        if (hipGetDevice(&dev) != hipSuccess || hipDeviceGetAttribute(&cus, hipDeviceAttributeMultiprocessorCount, dev) != hipSuccess) { grid = -1; return; }
        if (hipFuncSetAttribute((const void*)mega, hipFuncAttributeMaxDynamicSharedMemorySize, LDS_BYTES) != hipSuccess) { fprintf(stderr, "kernel_launch: hipFuncSetAttribute failed\n"); grid = -1; return; }
        if (hipOccupancyMaxActiveBlocksPerMultiprocessor(&per_cu, (const void*)mega, 512, LDS_BYTES) != hipSuccess || per_cu < 1) { fprintf(stderr, "kernel_launch: occupancy query says %d\n", per_cu); grid = -1; return; }
        (void)hipGetLastError();
        grid = cus;
        if (grid != 256) { fprintf(stderr, "kernel_launch: this kernel is laid out for 256 CUs, got %d\n", grid); grid = -1; return; }
    }
    if (grid < 0) return;
    if (hipMemsetAsync((unsigned char*)d_ws + WS_CTL, 0, 16384, stream) != hipSuccess) { fprintf(stderr, "kernel_launch: memset failed\n"); return; }
    Args a{};
    for (int i = 0; i < 29; ++i) a.in[i] = (const float*)d_in[i];
    a.out = (float*)d_out; a.ws = (unsigned char*)d_ws;
    void* kargs[] = {&a};
    hipError_t e = hipLaunchCooperativeKernel((const void*)mega, dim3(grid), dim3(512), kargs, LDS_BYTES, stream);
    if (e != hipSuccess) fprintf(stderr, "kernel_launch: cooperative launch failed: %s (grid %d)\n", hipGetErrorString(e), grid);
}
```

```cpp
#include <hip/hip_runtime.h>
#include <hip/hip_cooperative_groups.h>
#include <cstdio>
#include <cstdint>
namespace cg = cooperative_groups;

#define LAS __attribute__((address_space(3)))
typedef unsigned short bf16_t;
typedef short bf16x8 __attribute__((ext_vector_type(8)));
typedef float f32x4 __attribute__((ext_vector_type(4)));
typedef float f32x2 __attribute__((ext_vector_type(2)));
typedef unsigned u32x4 __attribute__((ext_vector_type(4)));
typedef unsigned u32x2 __attribute__((ext_vector_type(2)));

constexpr int DM = 1024, SEQ = 2048, NB = 8, MP = NB * SEQ, MS = 128, MA = MP + 256, NTILE = MA / 256;
constexpr int NIN = 6144, WA = 1024, WB = 1024, HA = 8, DHA = 128, HB = 4, DHB = 256, DPLE = 256, DMIX = 2048;
constexpr int LC = 256, NCH = SEQ / LC;
constexpr int NUNIT = NB * HB * NCH;
constexpr float EPS = 1e-6f;

constexpr size_t O_Y = 0, O_YS = 16777216, O_CP = 16908288, O_NP = 19005440, O_MP = 19013632, O_CVP = 19013664, O_CS = 19038240, O_NS = 52592672, O_MS = 52723744, O_CVS = 52724256, O_VS = 53117472, O_END = 53248544;

constexpr size_t MiB = 1u << 20;
constexpr size_t WS_CTL = 0, WS_WIN = 1 * MiB, WS_WQ = 13 * MiB, WS_WK = WS_WQ + MiB / 2, WS_WV = 14 * MiB, WS_WOUT = WS_WV + MiB / 2, WS_WPG = WS_WOUT + 4 * MiB, WS_WPP = WS_WPG + 2 * MiB,
    WS_WSP = 21 * MiB, WS_WG = WS_WSP + MiB / 4, WS_RS = WS_WG + MiB / 4, WS_GLI = 22 * MiB, WS_GLF = WS_GLI + MiB / 2, WS_DA = 23 * MiB, WS_DR = WS_DA + MiB / 2, WS_DG = 24 * MiB, WS_DEM = WS_DG + MiB / 2,
    WS_DW = 25 * MiB, WS_QN = WS_DW + MiB / 2, WS_DENP = 26 * MiB, WS_DN = 27 * MiB, WS_VS = WS_DN + MiB / 2, WS_PB = 28 * MiB, WS_XB = 37 * MiB, WS_PROJA = 70 * MiB, WS_PROJB = 168 * MiB,
    WS_PQ = 266 * MiB, WS_VC = 330 * MiB, WS_Y = 394 * MiB, WS_XB2 = 460 * MiB, WS_END = 493 * MiB;
constexpr size_t WS_WGB = WS_RS + MiB / 8;
constexpr size_t WS_Q = WS_PROJA, WS_K = WS_Q + 33 * MiB, WS_WKT = WS_K + 33 * MiB;
constexpr size_t WS_X1B = WS_PROJA, WS_GB = WS_X1B + 33 * MiB, WS_EB = WS_GB + 33 * MiB;
static_assert(WS_WKT + 32 * MiB <= WS_PROJB && WS_EB + 33 * MiB <= WS_PQ, "ws map");

__device__ __forceinline__ unsigned cvt_pk_bf16(float lo, float hi) { unsigned r; asm volatile("v_cvt_pk_bf16_f32 %0, %1, %2" : "=v"(r) : "v"(lo), "v"(hi)); return r; }
__device__ __forceinline__ float bf_lo(unsigned w) { return __uint_as_float(w << 16); }
__device__ __forceinline__ float bf_hi(unsigned w) { return __uint_as_float(w & 0xffff0000u); }
__device__ __forceinline__ float bf2f(bf16_t b) { return __uint_as_float(((unsigned)b) << 16); }
__device__ __forceinline__ bf16_t f2bf(float f) { return (bf16_t)(cvt_pk_bf16(f, 0.f) & 0xffffu); }
__device__ __forceinline__ float fast_exp(float x) { return __builtin_amdgcn_exp2f(x * 1.4426950408889634f); }
__device__ __forceinline__ float sigmoidf_(float x) { return __builtin_amdgcn_rcpf(1.0f + fast_exp(-x)); }
__device__ __forceinline__ float siluf_(float x) { return x * sigmoidf_(x); }
__device__ __forceinline__ f32x2 gelu_pk(f32x2 v) {
    const f32x2 av = __builtin_elementwise_abs(v), d = av * 0.2316418882f + 1.0f;
    f32x2 t; t.x = __builtin_amdgcn_rcpf(d.x); t.y = __builtin_amdgcn_rcpf(d.y);
    f32x2 q = t * 0.5307027145f + (-0.7265760135f); q = q * t + 0.7107068705f; q = q * t + (-0.142248368f); q = q * t + 0.127414796f; q = q * t;
    const f32x2 s = (v * v) * (-0.72134752044f);
    f32x2 e; e.x = __builtin_amdgcn_exp2f(s.x); e.y = __builtin_amdgcn_exp2f(s.y);
    const f32x2 m = v * (q * e), r = v - m;
    f32x2 o; o.x = v.x < 0.f ? m.x : r.x; o.y = v.y < 0.f ? m.y : r.y; return o;
}
__device__ __forceinline__ float wave_sum(float v) {
#pragma unroll
    for (int o = 1; o < 64; o <<= 1) v += __shfl_xor(v, o);
    return v;
}
#define LDS_WAIT() asm volatile("s_waitcnt lgkmcnt(0)" ::: "memory")

namespace pg8 {
constexpr int BM = 256, BK = 64, HALF = 128, HTB = HALF * BK * 2, STAGE_BYTES = 8 * HTB;
__host__ __device__ __forceinline__ int lds_byte(int r, int c) { const int st = (r >> 4) * 2 + (c >> 5), rr = r & 15, cc = c & 31, ob = rr * 64 + cc * 2; return st * 1024 + (ob ^ (((ob >> 9) & 1) << 5)); }
__host__ __device__ __forceinline__ void stage_rc(int b, int& R, int& C) { const int st = b / 1024, sb = b % 1024, swz = sb ^ (((sb >> 9) & 1) << 5); R = (st >> 1) * 16 + swz / 64; C = (st & 1) * 32 + (swz % 64) / 2; }
__host__ __device__ __forceinline__ int perm32(int rho) { const int n = rho >> 4, i = rho & 15; return 8 * (i >> 2) + 4 * n + (i & 3); }

struct Unit { const char* a; const char* b; int pm, pn, aux; };
struct Gemm { int lda, ldb, K; };

template <class Epi, class Sched, bool ALIGN_EPI = true, bool SP2 = true>
__device__ __forceinline__ void gemm_phase(LAS unsigned char* lds, const Gemm g, const Sched& S, const Epi& E) {
    int tid_ = threadIdx.x; asm volatile("" : "+v"(tid_));
    const int tid = tid_, wid = __builtin_amdgcn_readfirstlane(tid >> 6), lane = tid & 63, wr = wid >> 2, wc = wid & 3, fr = lane & 15, fq = lane >> 4;
    int K_ = g.K; asm volatile("" : "+s"(K_)); const int K = K_, nt = K / BK; (void)K;
    unsigned voffA[2], voffB[2];
#pragma unroll
    for (int i = 0; i < 2; ++i) { int R, C; stage_rc(tid * 16 + i * 8192, R, C); const int Rb = Epi::PERM ? ((R & ~31) + perm32(R & 31)) : R;
        voffA[i] = (unsigned)(R * g.lda + C) * 2u; voffB[i] = (unsigned)(Rb * g.ldb + C) * 2u; }
    const size_t kstep = (size_t)(BK * 2);
    const size_t hstepA = (size_t)HALF * g.lda * 2, hstepB = (size_t)HALF * g.ldb * 2;
    const unsigned ldsw = (unsigned)wid * 1024u;
    const int aoff = lds_byte(wr * 64 + fr, fq * 8), boff = lds_byte(wc * 32 + fr, fq * 8);
#define PG8_SA(b, h) (((b) * 2 + (h)) * HTB)
#define PG8_SB(b, h) ((4 + (b) * 2 + (h)) * HTB)
#define PG8_STAGE(bufoff, gbase, voff) do { _Pragma("unroll") for (int _i = 0; _i < 2; ++_i) \
        __builtin_amdgcn_global_load_lds((const unsigned*)((const char*)(gbase) + (voff)[_i]), (LAS unsigned*)(lds + (bufoff) + ldsw + _i * 8192), 16, 0, 0); } while (0)
#define PG8_LDA(dst, b, h) do { _Pragma("unroll") for (int m = 0; m < 4; ++m) _Pragma("unroll") for (int k = 0; k < 2; ++k) dst[m][k] = *(const LAS bf16x8*)(lds + PG8_SA(b, h) + aoff + m * 2048 + k * 1024); } while (0)
#define PG8_LDB(dst, b, h) do { _Pragma("unroll") for (int n = 0; n < 2; ++n) _Pragma("unroll") for (int k = 0; k < 2; ++k) dst[n][k] = *(const LAS bf16x8*)(lds + PG8_SB(b, h) + boff + n * 2048 + k * 1024); } while (0)
#define PG8_MMA(ai, bj, At, Bt) do { __builtin_amdgcn_s_setprio(1); _Pragma("unroll") for (int m = 0; m < 4; ++m) _Pragma("unroll") for (int n = 0; n < 2; ++n) _Pragma("unroll") for (int k = 0; k < 2; ++k) \
        acc[ai][bj][m][n] = __builtin_amdgcn_mfma_f32_16x16x32_bf16(Bt[n][k], At[m][k], acc[ai][bj][m][n], 0, 0, 0); __builtin_amdgcn_s_setprio(0); } while (0)
#define PG8_WAIT_V(n) asm volatile("s_waitcnt vmcnt(" #n ")" ::: "memory")
#define PG8_WAIT_L(n) asm volatile("s_waitcnt lgkmcnt(" #n ")" ::: "memory")
#define PG8_BAR __builtin_amdgcn_s_barrier()
#define PG8_SCHED __builtin_amdgcn_sched_barrier(0)
    Unit cur, nxt; int ui = 0;
    if (!S.next(0, cur)) return;
    f32x4 acc[2][2][4][2];
#pragma unroll
    for (int a = 0; a < 2; ++a)
#pragma unroll
        for (int b = 0; b < 2; ++b)
#pragma unroll
            for (int m = 0; m < 4; ++m)
#pragma unroll
                for (int n = 0; n < 2; ++n) acc[a][b][m][n] = (f32x4){0.f, 0.f, 0.f, 0.f};
    bf16x8 At[4][2], B0[2][2], B1[2][2];
    const char* cA = cur.a; const char* cB = cur.b;
    if constexpr (SP2) {
        PG8_STAGE(PG8_SB(0, 0), cB, voffB); PG8_STAGE(PG8_SB(0, 1), cB + hstepB, voffB); PG8_STAGE(PG8_SA(0, 0), cA, voffA); PG8_STAGE(PG8_SA(0, 1), cA + hstepA, voffA);
        if (wr == 1) PG8_BAR;
        PG8_WAIT_V(2); PG8_BAR;
        PG8_STAGE(PG8_SB(1, 0), cB + kstep, voffB); PG8_STAGE(PG8_SA(1, 0), cA + kstep, voffA); PG8_STAGE(PG8_SB(1, 1), cB + hstepB + kstep, voffB);
        PG8_WAIT_V(6); PG8_BAR;
    } else {
        PG8_STAGE(PG8_SB(0, 0), cB, voffB); PG8_STAGE(PG8_SA(0, 0), cA, voffA); PG8_STAGE(PG8_SB(0, 1), cB + hstepB, voffB); PG8_STAGE(PG8_SA(0, 1), cA + hstepA, voffA);
        if (wr == 1) PG8_BAR;
        PG8_WAIT_V(4); PG8_BAR;
        PG8_STAGE(PG8_SB(1, 0), cB + kstep, voffB); PG8_STAGE(PG8_SA(1, 0), cA + kstep, voffA); PG8_STAGE(PG8_SB(1, 1), cB + hstepB + kstep, voffB);
        PG8_WAIT_V(6); PG8_BAR;
    }
    for (;;) {
        const bool has_next = S.next(ui + 1, nxt);
        const char* nA = has_next ? nxt.a : cA; const char* nB = has_next ? nxt.b : cB;
#pragma unroll 1
        for (int t = 0; t < nt; t += 2) {
            const bool last = (t == nt - 2);
            const char* a1 = cA + (size_t)(t + 1) * kstep;
            const char* a2 = last ? nA : cA + (size_t)(t + 2) * kstep; const char* b2 = last ? nB : cB + (size_t)(t + 2) * kstep;
            const char* a3 = a2 + kstep; const char* b3 = b2 + kstep;
            if constexpr (SP2) {
            PG8_LDB(B0, 0, 0); PG8_LDB(B1, 0, 1); PG8_SCHED; PG8_LDA(At, 0, 0); PG8_STAGE(PG8_SA(1, 1), a1 + hstepA, voffA);
            PG8_WAIT_V(8); PG8_WAIT_L(0); PG8_BAR; PG8_MMA(0, 0, At, B0); PG8_MMA(0, 1, At, B1); PG8_BAR; PG8_SCHED;
            PG8_LDA(At, 0, 1); PG8_STAGE(PG8_SB(0, 0), b2, voffB); PG8_STAGE(PG8_SB(0, 1), b2 + hstepB, voffB); PG8_STAGE(PG8_SA(0, 0), a2, voffA);
            PG8_WAIT_V(8); PG8_WAIT_L(0); PG8_BAR; PG8_MMA(1, 0, At, B0); PG8_MMA(1, 1, At, B1); PG8_BAR; PG8_SCHED;
            PG8_LDB(B0, 1, 0); PG8_LDB(B1, 1, 1); PG8_SCHED; PG8_LDA(At, 1, 0); PG8_STAGE(PG8_SA(0, 1), a2 + hstepA, voffA);
            PG8_WAIT_V(8); PG8_WAIT_L(0); PG8_BAR; PG8_MMA(0, 0, At, B0); PG8_MMA(0, 1, At, B1); PG8_BAR; PG8_SCHED;
            PG8_LDA(At, 1, 1); PG8_STAGE(PG8_SB(1, 0), b3, voffB); PG8_STAGE(PG8_SB(1, 1), b3 + hstepB, voffB); PG8_STAGE(PG8_SA(1, 0), a3, voffA);
            PG8_WAIT_V(8); PG8_WAIT_L(0); PG8_BAR; PG8_MMA(1, 0, At, B0); PG8_MMA(1, 1, At, B1); PG8_BAR; PG8_SCHED;
            } else {
            PG8_LDB(B0, 0, 0); PG8_SCHED; PG8_LDA(At, 0, 0); PG8_STAGE(PG8_SA(1, 1), a1 + hstepA, voffA);
            PG8_WAIT_L(8); PG8_BAR; PG8_WAIT_L(0); PG8_MMA(0, 0, At, B0); PG8_BAR; PG8_SCHED;
            PG8_LDB(B1, 0, 1); PG8_STAGE(PG8_SB(0, 0), b2, voffB);
            PG8_BAR; PG8_WAIT_L(0); PG8_MMA(0, 1, At, B1); PG8_BAR;
            PG8_LDA(At, 0, 1); PG8_STAGE(PG8_SA(0, 0), a2, voffA);
            PG8_BAR; PG8_WAIT_L(0); PG8_MMA(1, 0, At, B0); PG8_BAR; PG8_SCHED;
            PG8_STAGE(PG8_SB(0, 1), b2 + hstepB, voffB);
            PG8_WAIT_V(6); PG8_BAR; PG8_MMA(1, 1, At, B1); PG8_BAR;
            PG8_LDB(B0, 1, 0); PG8_SCHED; PG8_LDA(At, 1, 0); PG8_STAGE(PG8_SA(0, 1), a2 + hstepA, voffA);
            PG8_WAIT_L(8); PG8_BAR; PG8_WAIT_L(0); PG8_MMA(0, 0, At, B0); PG8_BAR; PG8_SCHED;
            PG8_LDB(B1, 1, 1); PG8_STAGE(PG8_SB(1, 0), b3, voffB);
            PG8_BAR; PG8_WAIT_L(0); PG8_MMA(0, 1, At, B1); PG8_BAR;
            PG8_LDA(At, 1, 1); PG8_STAGE(PG8_SA(1, 0), a3, voffA);
            PG8_BAR; PG8_WAIT_L(0); PG8_MMA(1, 0, At, B0); PG8_BAR; PG8_SCHED;
            PG8_STAGE(PG8_SB(1, 1), b3 + hstepB, voffB);
            PG8_WAIT_V(6); PG8_BAR; PG8_MMA(1, 1, At, B1); PG8_BAR;
            }
        }
        if constexpr (ALIGN_EPI) { if (wr == 0) PG8_BAR; }
        if constexpr (!Epi::AFTER_DRAIN) { E(acc, cur, wr, wc, fr, fq); }
        if (!has_next) break;
#pragma unroll
        for (int a = 0; a < 2; ++a)
#pragma unroll
            for (int b = 0; b < 2; ++b)
#pragma unroll
                for (int m = 0; m < 4; ++m)
#pragma unroll
                    for (int n = 0; n < 2; ++n) acc[a][b][m][n] = (f32x4){0.f, 0.f, 0.f, 0.f};
        cur = nxt; cA = nA; cB = nB; ++ui;
        if constexpr (ALIGN_EPI) { if (wr == 1) PG8_BAR; }
    }
    PG8_WAIT_V(0);
    if constexpr (!ALIGN_EPI) { if (wr == 0) PG8_BAR; }
    PG8_BAR;
    if constexpr (Epi::AFTER_DRAIN) { E.fused(acc, cur, wr, wc, fr, fq, lds, wid, lane); }
#undef PG8_SA
#undef PG8_SB
#undef PG8_STAGE
#undef PG8_LDA
#undef PG8_LDB
#undef PG8_MMA
#undef PG8_WAIT_V
#undef PG8_WAIT_L
#undef PG8_BAR
#undef PG8_SCHED
}
}
using pg8::Unit; using pg8::Gemm;

constexpr int LDS_BYTES = 147456;
struct Args { const float* in[29]; float* out; unsigned char* ws; };

struct Ctx {
    LAS unsigned char* lds; int tid, lane, wave, G, bid, gw, NGW;
    const float* const* in; float* out; unsigned char* ws;
};

__device__ __forceinline__ void p0_transpose_item(const float* W, int ldw, bf16_t* WT, int ldt, const float* kscale, LAS float* scr, int kb, int nb, int lane) {
    const int k0 = 64 * kb, n0 = 32 * nb;
#pragma unroll 8
    for (int i = 0; i < 32; ++i) { const int kk = 2 * i + (lane >> 5); float v = W[(size_t)(k0 + kk) * ldw + n0 + (lane & 31)]; if (kscale) v *= kscale[k0 + kk]; scr[kk * 33 + (lane & 31)] = v; }
    LDS_WAIT(); asm volatile("" ::: "memory");
    const int c = lane & 7;
#pragma unroll
    for (int j = 0; j < 4; ++j) { const int n = (lane >> 3) + 8 * j; const LAS float* s = scr + (8 * c) * 33 + n;
        u32x4 o; o.x = cvt_pk_bf16(s[0 * 33], s[1 * 33]); o.y = cvt_pk_bf16(s[2 * 33], s[3 * 33]); o.z = cvt_pk_bf16(s[4 * 33], s[5 * 33]); o.w = cvt_pk_bf16(s[6 * 33], s[7 * 33]);
        *(u32x4*)(WT + (size_t)(n0 + n) * ldt + k0 + 8 * c) = o; }
    LDS_WAIT(); asm volatile("" ::: "memory");
}

__device__ __forceinline__ void p0_prologue(const Ctx& F0) { Ctx F = F0; asm volatile("" : "+v"(F.tid), "+v"(F.lane));
    LAS float* scr = (LAS float*)(F.lds + F.wave * 16384);
    unsigned char* ws = F.ws;
    constexpr int I_WIN = 16 * 192, I_QKV = 12 * 4 * 8, I_WOUT = 32 * 32, I_WPG = 16 * 32, I_WPP = 4 * 32;
    constexpr int I_T = I_WIN + I_QKV + I_WOUT + I_WPG + I_WPP;
    constexpr int I_X = MA, I_P = MA, I_SP = 1024, I_WG = 1024, I_YPAD = 128;
    constexpr int NITEMS = I_T + I_X + I_P + I_SP + I_WG + I_YPAD;
    for (int it = F.gw; it < NITEMS; it += F.NGW) {
        int r = it;
        if (r < I_T) {
            if (r < I_WIN) { p0_transpose_item(F.in[9], NIN, (bf16_t*)(ws + WS_WIN), DM, F.in[8], scr, r / 192, r % 192, F.lane); continue; } r -= I_WIN;
            if (r < I_QKV) { const int mat = r / 32, rr = r % 32, which = mat / 4, h = mat % 4;
                const float* W = F.in[16 + which] + (size_t)h * 65536; bf16_t* WT = (bf16_t*)(ws + (which == 0 ? WS_WQ : which == 1 ? WS_WK : WS_WV)) + (size_t)h * 65536;
                p0_transpose_item(W, 256, WT, 256, nullptr, scr, rr / 8, rr % 8, F.lane); continue; } r -= I_QKV;
            if (r < I_WOUT) { p0_transpose_item(F.in[23], DM, (bf16_t*)(ws + WS_WOUT), DMIX, nullptr, scr, r / 32, r % 32, F.lane); continue; } r -= I_WOUT;
            if (r < I_WPG) { p0_transpose_item(F.in[24], DM, (bf16_t*)(ws + WS_WPG), DM, nullptr, scr, r / 32, r % 32, F.lane); continue; } r -= I_WPG;
            p0_transpose_item(F.in[26], DM, (bf16_t*)(ws + WS_WPP), DPLE, nullptr, scr, r / 32, r % 32, F.lane); continue;
        }
        r -= I_T;
        if (r < I_X) {
            bf16_t* orow = (bf16_t*)(ws + WS_XB) + (size_t)r * DM; float* rs = (float*)(ws + WS_RS);
            unsigned long long* o8 = (unsigned long long*)orow + F.lane;
            if (r >= MP + MS) {
#pragma unroll
                for (int j = 0; j < 4; ++j) o8[64 * j] = 0ull;
                if (F.lane == 0) rs[r] = 0.f; continue; }
            const float* xrow = r < MP ? F.in[0] + (size_t)r * DM : F.in[1] + (size_t)(r - MP) * DM;
            const f32x4* xr = (const f32x4*)xrow + F.lane; f32x4 v[4]; float s = 0.f;
#pragma unroll
            for (int j = 0; j < 4; ++j) { v[j] = xr[64 * j]; s += (v[j].x * v[j].x + v[j].y * v[j].y) + (v[j].z * v[j].z + v[j].w * v[j].w); }
            s = wave_sum(s);
#pragma unroll
            for (int j = 0; j < 4; ++j) o8[64 * j] = (unsigned long long)cvt_pk_bf16(v[j].x, v[j].y) | ((unsigned long long)cvt_pk_bf16(v[j].z, v[j].w) << 32);
            if (F.lane == 0) rs[r] = 1.0f / sqrtf(s * (1.0f / DM) + EPS);
            continue;
        }
        r -= I_X;
        if (r < I_P) {
            unsigned long long* o8 = (unsigned long long*)((bf16_t*)(ws + WS_PB) + (size_t)r * DPLE) + F.lane;
            if (r >= MP + MS) { o8[0] = 0ull; continue; }
            const float* prow = r < MP ? F.in[6] + (size_t)r * DPLE : F.in[7] + (size_t)(r - MP) * DPLE;
            const f32x4 v = ((const f32x4*)prow)[F.lane];
            o8[0] = (unsigned long long)cvt_pk_bf16(v.x, v.y) | ((unsigned long long)cvt_pk_bf16(v.z, v.w) << 32);
            continue;
        }
        r -= I_P;
        if (r < I_SP) {
            const int t = r & 127; const float* wrow = F.in[12] + (size_t)r * 128; const f32x2 v = ((const f32x2*)wrow)[F.lane];
            const int s0 = 2 * F.lane; ((unsigned*)((bf16_t*)(ws + WS_WSP) + (size_t)r * 128))[F.lane] = cvt_pk_bf16(s0 <= t ? v.x : 0.f, s0 + 1 <= t ? v.y : 0.f);
            continue;
        }
        r -= I_SP;
        if (r < I_WG) {
            const int i = r, h = i >> 8, d = i & 255; const float* wif = F.in[19];
            const f32x4 wq4 = *(const f32x4*)(F.in[16] + ((size_t)h * 256 + d) * 256 + 4 * F.lane), wk4 = *(const f32x4*)(F.in[17] + ((size_t)h * 256 + d) * 256 + 4 * F.lane), wv4 = *(const f32x4*)(F.in[18] + ((size_t)h * 256 + d) * 256 + 4 * F.lane);
            float sx[8], sb[8];
#pragma unroll
            for (int j = 0; j < 8; ++j) { sx[j] = 0.f; sb[j] = 0.f; }
#pragma unroll
            for (int e = 0; e < 4; ++e) { const size_t rq = (size_t)(h * 256 + 4 * F.lane + e) * 8;
                const f32x4 q0 = *(const f32x4*)(wif + rq), q1 = *(const f32x4*)(wif + rq + 4), k0 = *(const f32x4*)(wif + 8192 + rq), k1 = *(const f32x4*)(wif + 8192 + rq + 4), v0 = *(const f32x4*)(wif + 16384 + rq), v1 = *(const f32x4*)(wif + 16384 + rq + 4);
#pragma unroll
                for (int j = 0; j < 4; ++j) { sx[j] += wq4[e] * q0[j] + wk4[e] * k0[j]; sx[4 + j] += wq4[e] * q1[j] + wk4[e] * k1[j]; sb[j] += wv4[e] * v0[j]; sb[4 + j] += wv4[e] * v1[j]; } }
#pragma unroll
            for (int j = 0; j < 8; ++j) { sx[j] = wave_sum(sx[j]); sb[j] = wave_sum(sb[j]); }
            float s = 0.f;
#pragma unroll
            for (int j = 0; j < 8; ++j) { s = (F.lane == j) ? sx[j] : s; s = (F.lane == 8 + j) ? sb[j] : s; }
            if (F.lane < 16) ((float*)(ws + WS_WG))[(size_t)i * 16 + F.lane] = s;
            if (F.lane < 16) { bf16_t* wgb = (bf16_t*)(ws + WS_WGB) + (size_t)(F.lane >> 3) * 16384 + (size_t)(F.lane & 7) * 1024 + i; wgb[0] = f2bf(s); wgb[8 * 1024] = 0; }
            continue;
        }
        r -= I_WG;
        {
            u32x4* yrow = (u32x4*)((bf16_t*)(ws + WS_Y) + (size_t)(MP + MS + r) * DMIX) + F.lane;
#pragma unroll
            for (int j = 0; j < 4; ++j) yrow[64 * j] = (u32x4){0u, 0u, 0u, 0u};
        }
    }
}

struct OrderRowMajor {
    int nM, nN, n, G, c; const char* A; const char* B; size_t astep, bstep;
    __device__ __forceinline__ bool next(int i, Unit& u) const {
        const int L = i * G + c; if (L >= n) return false;
        u.pm = L / nN; u.pn = L % nN; u.aux = 0; u.a = A + (size_t)u.pm * astep; u.b = B + (size_t)u.pn * bstep; return true;
    }
};
struct OrderPanel4 {
    int n, G, c; const char* A; const char* B; size_t astep, bstep;
    __device__ __forceinline__ bool next(int i, Unit& u) const {
        const int L = i * G + c; if (L >= n) return false;
        if (L < 256) { const int x = L & 7, j = L >> 3; u.pm = x * 8 + (j >> 2); u.pn = j & 3; } else { u.pm = 64; u.pn = L - 256; }
        u.aux = 0; u.a = A + (size_t)u.pm * astep; u.b = B + (size_t)u.pn * bstep; return true;
    }
};
struct OrderProjSkip {
    int G, c; const char* A; const char* B; size_t astep, bstep;
    __device__ __forceinline__ bool next(int i, Unit& u) const {
        if (c < 4) return false; const int cp = c - 4; const int L = i == 0 ? cp : (i == 1 && cp < 8 ? 252 + cp : -1); if (L < 0) return false;
        if (L < 256) { const int x = L & 7, j = L >> 3; u.pm = x * 8 + (j >> 2); u.pn = j & 3; } else { u.pm = 64; u.pn = L - 256; }
        u.aux = 0; u.a = A + (size_t)u.pm * astep; u.b = B + (size_t)u.pn * bstep; return true;
    }
};
struct OrderXcd {
    int nM, nN, n, G, c; const char* A; const char* B; size_t astep, bstep;
    __device__ __forceinline__ bool next(int i, Unit& u) const {
        const int L = i * G + c; if (L >= n) return false;
        int wgid = L; { const int q = n / 8, r = n % 8, xcd = wgid % 8, off = wgid / 8; wgid = (xcd < r ? xcd * (q + 1) : r * (q + 1) + (xcd - r) * q) + off; }
        const int nig = 8 * nN, gid = wgid / nig, fm = gid * 8, gsz = (nM - fm) < 8 ? (nM - fm) : 8;
        u.pm = fm + ((wgid % nig) % gsz); u.pn = (wgid % nig) / gsz; u.aux = 0; u.a = A + (size_t)u.pm * astep; u.b = B + (size_t)u.pn * bstep; return true;
    }
};
struct EpiInProj {
    static constexpr bool PERM = true, AFTER_DRAIN = false;
    bf16_t* PA; bf16_t* PB; const float* rs;
    template <int KIND> __device__ __forceinline__ void run(const f32x4 (&acc)[2][2][4][2], bf16_t* base, int row0, int col0) const {
#pragma unroll
        for (int ai = 0; ai < 2; ++ai)
#pragma unroll
            for (int m = 0; m < 4; ++m) { const int row = row0 + ai * 128 + m * 16; const float s = rs[row]; bf16_t* rowp = base + (size_t)row * 3072 + col0;
#pragma unroll
                for (int bj = 0; bj < 2; ++bj) { f32x4 v0 = acc[ai][bj][m][0] * s, v1 = acc[ai][bj][m][1] * s;
                    if (KIND == 0) { f32x2 a = gelu_pk((f32x2){v0[0], v0[1]}), b = gelu_pk((f32x2){v0[2], v0[3]}), c = gelu_pk((f32x2){v1[0], v1[1]}), d = gelu_pk((f32x2){v1[2], v1[3]});
                        v0 = (f32x4){a.x, a.y, b.x, b.y}; v1 = (f32x4){c.x, c.y, d.x, d.y}; }
                    if (KIND == 1) {
#pragma unroll
                        for (int j = 0; j < 4; ++j) { v0[j] = siluf_(v0[j]); v1[j] = siluf_(v1[j]); } }
                    if (KIND == 3) {
#pragma unroll
                        for (int j = 0; j < 4; ++j) { v0[j] = sigmoidf_(v0[j]); v1[j] = sigmoidf_(v1[j]); } }
                    u32x4 w; w.x = cvt_pk_bf16(v0[0], v0[1]); w.y = cvt_pk_bf16(v0[2], v0[3]); w.z = cvt_pk_bf16(v1[0], v1[1]); w.w = cvt_pk_bf16(v1[2], v1[3]);
                    *(u32x4*)(rowp + bj * 128) = w; } }
    }
    __device__ __forceinline__ void operator()(const f32x4 (&acc)[2][2][4][2], const Unit& u, int wr, int wc, int fr, int fq) const {
        const int row0 = u.pm * 256 + wr * 64 + fr, pn = u.pn;
        bf16_t* base = pn < 12 ? PA + pn * 256 : PB + (pn - 12) * 256; const int col0 = wc * 32 + 8 * fq;
        if (pn < 8) run<0>(acc, base, row0, col0);
        else if (pn < 12 || pn >= 20) run<1>(acc, base, row0, col0);
        else if (pn < 16) run<2>(acc, base, row0, col0);
        else run<3>(acc, base, row0, col0);
    }
};

__device__ __forceinline__ float logsigmoidf_(float x) { return fminf(x, 0.f) - log1pf(__expf(-fabsf(x))); }
__device__ __forceinline__ void unpack8(const u32x4 w, float (&f)[8]) { f[0] = bf_lo(w.x); f[1] = bf_hi(w.x); f[2] = bf_lo(w.y); f[3] = bf_hi(w.y); f[4] = bf_lo(w.z); f[5] = bf_hi(w.z); f[6] = bf_lo(w.w); f[7] = bf_hi(w.w); }
__device__ __forceinline__ u32x4 pack8(const float (&f)[8]) { u32x4 w; w.x = cvt_pk_bf16(f[0], f[1]); w.y = cvt_pk_bf16(f[2], f[3]); w.z = cvt_pk_bf16(f[4], f[5]); w.w = cvt_pk_bf16(f[6], f[7]); return w; }

__device__ __forceinline__ void p2a_conv_gates(const Ctx& F0) { Ctx F = F0; asm volatile("" : "+v"(F.tid), "+v"(F.lane));
    unsigned char* ws = F.ws;
    const bf16_t* PBX = (const bf16_t*)(ws + WS_PROJB);
    bf16_t* XC = (bf16_t*)(ws + WS_XB); bf16_t* XB2 = (bf16_t*)(ws + WS_XB2);
    const float* Wg = (const float*)(ws + WS_WG);
    float* GLI = (float*)(ws + WS_GLI); float* GLF = (float*)(ws + WS_GLF);
    const float* convw = F.in[14]; const float* convb = F.in[15]; const float* bif = F.in[20];
    LAS float* cwl = (LAS float*)F.lds; LAS bf16_t* wgl = (LAS bf16_t*)(F.lds + 20480); LAS f32x4* comb = (LAS f32x4*)(F.lds + 20480 + 65536);
    for (int i = F.tid; i < 5 * 1024 / 4; i += 512) ((LAS f32x4*)cwl)[i] = i < 1024 ? ((const f32x4*)convw)[i] : ((const f32x4*)convb)[i - 1024];
    for (int i = F.tid; i < 65536 / 16; i += 512) ((LAS u32x4*)wgl)[i] = ((const u32x4*)(ws + WS_WGB))[i];
    __syncthreads();
    const int l15 = F.lane & 15, lq = F.lane >> 4, rgp = F.wave >> 1, hh = F.wave & 1;
    for (int tile = F.bid; tile < MP / 64 + 2; tile += F.G) {
        const bool smp = tile >= MP / 64; const int row = tile * 64 + rgp * 16 + l15, seq0 = row & ~(SEQ - 1); const float* st = F.in[5] + (size_t)(row - MP) * 3072;
        f32x4 acc = (f32x4){0.f, 0.f, 0.f, 0.f};
#pragma unroll 4
        for (int cbk = 0; cbk < 16; ++cbk) { const int ch0 = (hh * 16 + cbk) * 32 + 8 * lq;
            u32x4 x3 = (u32x4){0u, 0u, 0u, 0u}, x2 = x3, x1 = x3; const u32x4 x0 = *(const u32x4*)(PBX + (size_t)row * 3072 + ch0);
            float w0[8], w1[8], w2[8], cur[8], xc[8];
            if (!smp) {
                if (row - 3 >= seq0) x3 = *(const u32x4*)(PBX + (size_t)(row - 3) * 3072 + ch0);
                if (row - 2 >= seq0) x2 = *(const u32x4*)(PBX + (size_t)(row - 2) * 3072 + ch0);
                if (row - 1 >= seq0) x1 = *(const u32x4*)(PBX + (size_t)(row - 1) * 3072 + ch0);
                unpack8(x3, w0); unpack8(x2, w1); unpack8(x1, w2);
            } else {
#pragma unroll
                for (int q = 0; q < 2; ++q) { const f32x4 a0 = *(const f32x4*)(st + ch0 + 4 * q), a1 = *(const f32x4*)(st + 1024 + ch0 + 4 * q), a2 = *(const f32x4*)(st + 2048 + ch0 + 4 * q);
#pragma unroll
                    for (int e = 0; e < 4; ++e) { w0[4 * q + e] = a0[e]; w1[4 * q + e] = a1[e]; w2[4 * q + e] = a2[e]; } }
            }
            unpack8(x0, cur);
#pragma unroll
            for (int q = 0; q < 2; ++q) { const f32x4 c0 = *(const LAS f32x4*)(cwl + ch0 + 4 * q), c1 = *(const LAS f32x4*)(cwl + 1024 + ch0 + 4 * q), c2 = *(const LAS f32x4*)(cwl + 2048 + ch0 + 4 * q), c3 = *(const LAS f32x4*)(cwl + 3072 + ch0 + 4 * q), cb = *(const LAS f32x4*)(cwl + 4096 + ch0 + 4 * q);
#pragma unroll
                for (int e = 0; e < 4; ++e) xc[4 * q + e] = siluf_(c0[e] * w0[4 * q + e] + c1[e] * w1[4 * q + e] + c2[e] * w2[4 * q + e] + c3[e] * cur[4 * q + e] + cb[e]); }
            const u32x4 xcp = pack8(xc);
            *(u32x4*)(XC + (size_t)row * DM + ch0) = xcp; *(u32x4*)(XB2 + (size_t)row * DM + ch0) = x0;
            const bf16x8 bc = *(const LAS bf16x8*)(wgl + l15 * 1024 + ch0), bx = *(const LAS bf16x8*)(wgl + 16384 + l15 * 1024 + ch0);
            acc = __builtin_amdgcn_mfma_f32_16x16x32_bf16(__builtin_bit_cast(bf16x8, xcp), bc, acc, 0, 0, 0);
            acc = __builtin_amdgcn_mfma_f32_16x16x32_bf16(__builtin_bit_cast(bf16x8, x0), bx, acc, 0, 0, 0); }
        __syncthreads();
        if (hh == 1) comb[rgp * 64 + F.lane] = acc;
        __syncthreads();
        if (hh == 0 && l15 < 8) { const f32x4 o = comb[rgp * 64 + F.lane]; const float bj = bif[l15];
#pragma unroll
            for (int r = 0; r < 4; ++r) { const float g = acc[r] + o[r] + bj; const size_t rr = (size_t)(tile * 64 + rgp * 16 + 4 * lq + r);
                if (l15 < 4) GLI[(size_t)l15 * MA + rr] = g; else GLF[(size_t)(l15 - 4) * MA + rr] = logsigmoidf_(g); } }
    }
    __syncthreads();
    for (int i = F.bid * 512 + F.tid; i < NB * 3 * 1024; i += F.G * 512) { const int b = i / 3072, j = (i / 1024) % 3, ch = i & 1023;
        F.out[O_CVP + i] = bf2f(PBX[(size_t)(b * SEQ + SEQ - 3 + j) * 3072 + ch]); }
    for (int i = F.gw; i < MS; i += F.NGW) {
        const int r = MP + i, ch0s = F.lane * 16; const float* st = F.in[5] + (size_t)i * 3 * 1024;
        const bf16_t* PA = (const bf16_t*)(ws + WS_PROJA) + (size_t)r * 3072;
#pragma unroll
        for (int half = 0; half < 2; ++half) { const int c0 = ch0s + half * 8; float xb[8]; unpack8(*(const u32x4*)(PBX + (size_t)r * 3072 + c0), xb);
#pragma unroll
            for (int q = 0; q < 2; ++q) { *(f32x4*)(F.out + O_CVS + (size_t)i * 3072 + c0 + 4 * q) = *(const f32x4*)(st + 1024 + c0 + 4 * q); *(f32x4*)(F.out + O_CVS + (size_t)i * 3072 + 1024 + c0 + 4 * q) = *(const f32x4*)(st + 2048 + c0 + 4 * q);
                *(f32x4*)(F.out + O_CVS + (size_t)i * 3072 + 2048 + c0 + 4 * q) = (f32x4){xb[4 * q], xb[4 * q + 1], xb[4 * q + 2], xb[4 * q + 3]}; } }
        float gv[16], s = 0.f;
        { float t8[8]; unpack8(*(const u32x4*)(PA + 1024 + ch0s), t8);
#pragma unroll
          for (int c = 0; c < 8; ++c) gv[c] = t8[c];
          unpack8(*(const u32x4*)(PA + 1024 + ch0s + 8), t8);
#pragma unroll
          for (int c = 0; c < 8; ++c) gv[8 + c] = t8[c]; }
#pragma unroll
        for (int c = 0; c < 16; ++c) s += gv[c];
        s += __shfl_xor(s, 1); s += __shfl_xor(s, 2); s += __shfl_xor(s, 4);
        const float mu = s * (1.f / 128.f); float q = 0.f;
#pragma unroll
        for (int c = 0; c < 16; ++c) { const float d = gv[c] - mu; q += d * d; }
        q += __shfl_xor(q, 1); q += __shfl_xor(q, 2); q += __shfl_xor(q, 4);
        const float rstd = 1.0f / sqrtf(q * (1.f / 128.f) + EPS);
        const int h = F.lane >> 3; const float wsp = F.in[12][(size_t)h * 16384], bsp = F.in[13][h * 128];
        float uu[16], zz[16];
        { float t8[8]; unpack8(*(const u32x4*)(PA + ch0s), t8);
#pragma unroll
          for (int c = 0; c < 8; ++c) uu[c] = t8[c];
          unpack8(*(const u32x4*)(PA + ch0s + 8), t8);
#pragma unroll
          for (int c = 0; c < 8; ++c) uu[8 + c] = t8[c];
          unpack8(*(const u32x4*)(PA + 2048 + ch0s), t8);
#pragma unroll
          for (int c = 0; c < 8; ++c) zz[c] = t8[c];
          unpack8(*(const u32x4*)(PA + 2048 + ch0s + 8), t8);
#pragma unroll
          for (int c = 0; c < 8; ++c) zz[8 + c] = t8[c]; }
        float ya[16];
#pragma unroll
        for (int c = 0; c < 16; ++c) { const int ch = ch0s + c; const float vn = (gv[c] - mu) * rstd * F.in[10][ch] + F.in[11][ch];
            F.out[O_VS + (size_t)i * 1024 + ch] = vn; ya[c] = uu[c] * (wsp * vn + bsp) * zz[c]; }
        bf16_t* yrow = (bf16_t*)(ws + WS_Y) + (size_t)r * DMIX + ch0s;
        { float t8[8];
#pragma unroll
          for (int c = 0; c < 8; ++c) t8[c] = ya[c];
          *(u32x4*)(yrow) = pack8(t8);
#pragma unroll
          for (int c = 0; c < 8; ++c) t8[c] = ya[8 + c];
          *(u32x4*)(yrow + 8) = pack8(t8); }
    }
}

__device__ __forceinline__ void mscan_wave(const Ctx& F, int bh) {
    unsigned char* ws = F.ws; const int b = bh >> 2, h = bh & 3, lane = F.lane;
    const float* li = (const float*)(ws + WS_GLI) + (size_t)h * MA + (size_t)b * SEQ + lane * 32;
    const float* lf = (const float*)(ws + WS_GLF) + (size_t)h * MA + (size_t)b * SEQ + lane * 32;
    float A = 0.f, Bv = -INFINITY;
    for (int i = 0; i < 32; ++i) { const float f = lf[i], l = li[i]; Bv = fmaxf(Bv + f, l); A += f; }
    float sA = A, sB = Bv;
#pragma unroll
    for (int o = 1; o < 64; o <<= 1) { const float pA = __shfl_up(sA, o), pB = __shfl_up(sB, o); if (lane >= o) { sB = fmaxf(pB + sA, sB); sA = pA + sA; } }
    float eA = __shfl_up(sA, 1), eB = __shfl_up(sB, 1); if (lane == 0) { eA = 0.f; eB = -INFINITY; }
    const float m_in = fmaxf(0.f + eA, eB);
    float cA = A;
#pragma unroll
    for (int o = 1; o < 8; o <<= 1) { const float p = __shfl_up(cA, o); if ((lane & 7) >= o) cA += p; }
    const float b_in = cA - A;
    const float m_prev = __shfl(m_in, lane & ~7);
    float* DA = (float*)(ws + WS_DA) + (size_t)h * MA + (size_t)b * SEQ + lane * 32; float* DR = (float*)(ws + WS_DR) + (size_t)h * MA + (size_t)b * SEQ + lane * 32;
    float* DG = (float*)(ws + WS_DG) + (size_t)h * MA + (size_t)b * SEQ + lane * 32; float* DEM = (float*)(ws + WS_DEM) + (size_t)h * MA + (size_t)b * SEQ + lane * 32;
    float* DW = (float*)(ws + WS_DW) + (size_t)h * MA + (size_t)b * SEQ + lane * 32;
    float m = m_in, bb = b_in, a_last = 0.f;
    for (int i = 0; i < 32; ++i) { const float f = lf[i], l = li[i]; m = fmaxf(m + f, l); bb += f;
        a_last = bb - m; DA[i] = a_last; DR[i] = l - bb; DG[i] = __expf(bb + m_prev - m); DEM[i] = __expf(-m); }
    const float a_end = __shfl(a_last, lane | 7);
    for (int i = 0; i < 32; ++i) { const float f = lf[i]; (void)f; }
    { float bb2 = b_in; for (int i = 0; i < 32; ++i) { bb2 += lf[i]; DW[i] = __expf(a_end + (li[i] - bb2)); } }
    if (lane == 63) F.out[O_MP + bh] = m;
}

__device__ __forceinline__ void p9_final(const Ctx& F0) { Ctx F = F0; asm volatile("" : "+v"(F.tid), "+v"(F.lane));
    unsigned char* ws = F.ws; const bf16_t* GB = (const bf16_t*)(ws + WS_GB); const bf16_t* EB = (const bf16_t*)(ws + WS_EB);
    const float* pleg = F.in[27]; const float* fing = F.in[28];
    f32x4 pg[4], fg[4];
#pragma unroll
    for (int j = 0; j < 4; ++j) { pg[j] = ((const f32x4*)pleg)[F.lane + 64 * j]; fg[j] = ((const f32x4*)fing)[F.lane + 64 * j]; }
    for (int r0 = F.gw * 2; r0 < MP + MS; r0 += F.NGW * 2) {
        f32x4 x[2][4]; u32x2 g[2][4], e[2][4]; float* xrow[2];
#pragma unroll
        for (int q = 0; q < 2; ++q) { const int r = r0 + q; xrow[q] = r < MP ? F.out + O_Y + (size_t)r * DM : F.out + O_YS + (size_t)(r - MP) * DM;
#pragma unroll
            for (int j = 0; j < 4; ++j) { x[q][j] = ((const f32x4*)xrow[q])[F.lane + 64 * j]; g[q][j] = ((const u32x2*)(GB + (size_t)r * DM))[F.lane + 64 * j]; e[q][j] = ((const u32x2*)(EB + (size_t)r * DM))[F.lane + 64 * j]; } }
#pragma unroll
        for (int q = 0; q < 2; ++q) { float s = 0.f; f32x4 ev[4];
#pragma unroll
            for (int j = 0; j < 4; ++j) { ev[j] = (f32x4){bf_lo(e[q][j].x), bf_hi(e[q][j].x), bf_lo(e[q][j].y), bf_hi(e[q][j].y)}; s += (ev[j][0] * ev[j][0] + ev[j][1] * ev[j][1]) + (ev[j][2] * ev[j][2] + ev[j][3] * ev[j][3]); }
            s = wave_sum(s); const float rse = 1.0f / sqrtf(s * (1.f / DM) + EPS); float s2 = 0.f;
#pragma unroll
            for (int j = 0; j < 4; ++j) { const f32x4 gv = (f32x4){bf_lo(g[q][j].x), bf_hi(g[q][j].x), bf_lo(g[q][j].y), bf_hi(g[q][j].y)};
                x[q][j] = x[q][j] + gv * (ev[j] * rse * pg[j]); s2 += (x[q][j][0] * x[q][j][0] + x[q][j][1] * x[q][j][1]) + (x[q][j][2] * x[q][j][2] + x[q][j][3] * x[q][j][3]); }
            s2 = wave_sum(s2); const float rs2 = 1.0f / sqrtf(s2 * (1.f / DM) + EPS);
#pragma unroll
            for (int j = 0; j < 4; ++j) ((f32x4*)xrow[q])[F.lane + 64 * j] = x[q][j] * rs2 * fg[j]; }
    }
}
#define MAKE_CTX() extern __shared__ __attribute__((aligned(16))) unsigned char lds_raw[]; \
    Ctx F; F.lds = (LAS unsigned char*)lds_raw; F.tid = threadIdx.x; F.lane = F.tid & 63; F.wave = __builtin_amdgcn_readfirstlane(F.tid >> 6); \
    F.G = gridDim.x; F.bid = blockIdx.x; F.gw = F.bid * 8 + F.wave; F.NGW = F.G * 8; F.in = args.in; F.out = args.out; F.ws = args.ws; unsigned char* ws = args.ws; (void)ws

template <int KIND> struct EpiBf16Act {
    static constexpr bool PERM = false, AFTER_DRAIN = false;
    bf16_t* O; int ldo; const float* bias; float scale;
    __device__ __forceinline__ void operator()(const f32x4 (&acc)[2][2][4][2], const Unit& u, int wr, int wc, int fr, int fq) const {
        const int row0 = u.pm * 256 + wr * 64 + fr, col0 = u.pn * 256 + wc * 32 + 4 * fq;
        f32x4 bv[2][2];
#pragma unroll
        for (int bj = 0; bj < 2; ++bj)
#pragma unroll
            for (int n = 0; n < 2; ++n) bv[bj][n] = bias ? *(const f32x4*)(bias + col0 + bj * 128 + 16 * n) : (f32x4){0.f, 0.f, 0.f, 0.f};
#pragma unroll
        for (int ai = 0; ai < 2; ++ai)
#pragma unroll
            for (int m = 0; m < 4; ++m) { bf16_t* rowp = O + (size_t)(row0 + ai * 128 + m * 16) * ldo + col0;
#pragma unroll
                for (int bj = 0; bj < 2; ++bj)
#pragma unroll
                    for (int n = 0; n < 2; ++n) { f32x4 v = acc[ai][bj][m][n] * scale + bv[bj][n];
                        if (KIND == 3) {
#pragma unroll
                            for (int j = 0; j < 4; ++j) v[j] = sigmoidf_(v[j]); }
                        u32x2 w; w.x = cvt_pk_bf16(v[0], v[1]); w.y = cvt_pk_bf16(v[2], v[3]); *(u32x2*)(rowp + bj * 128 + n * 16) = w; } }
    }
};
struct EpiOutProj {
    static constexpr bool PERM = false, AFTER_DRAIN = false;
    const float* xp; const float* xs; float* out; bf16_t* X1B;
    __device__ __forceinline__ void operator()(const f32x4 (&acc)[2][2][4][2], const Unit& u, int wr, int wc, int fr, int fq) const {
        const int row0 = u.pm * 256 + wr * 64 + fr, col0 = u.pn * 256 + wc * 32 + 4 * fq;
#pragma unroll
        for (int ai = 0; ai < 2; ++ai)
#pragma unroll
            for (int m = 0; m < 4; ++m) { const int row = row0 + ai * 128 + m * 16;
                const bool real = row < MP + MS;
                const float* xr = row < MP ? xp + (size_t)row * DM : xs + (size_t)(real ? row - MP : 0) * DM;
                float* orow = row < MP ? out + O_Y + (size_t)row * DM : out + O_YS + (size_t)(real ? row - MP : 0) * DM;
#pragma unroll
                for (int bj = 0; bj < 2; ++bj)
#pragma unroll
                    for (int n = 0; n < 2; ++n) { const int c = col0 + bj * 128 + n * 16; f32x4 v = acc[ai][bj][m][n];
                        if (real) { v = v + *(const f32x4*)(xr + c); *(f32x4*)(orow + c) = v; } else v = (f32x4){0.f, 0.f, 0.f, 0.f};
                        u32x2 w; w.x = cvt_pk_bf16(v[0], v[1]); w.y = cvt_pk_bf16(v[2], v[3]); *(u32x2*)(X1B + (size_t)row * DM + c) = w; } }
    }
};


struct EpiInProjNP {
    static constexpr bool PERM = false, AFTER_DRAIN = false;
    bf16_t* PA; bf16_t* PB; const float* rs;
    __device__ __forceinline__ void operator()(const f32x4 (&acc)[2][2][4][2], const Unit& u, int wr, int wc, int fr, int fq) const {
        const int row0 = u.pm * 256 + wr * 64 + fr, pn = u.pn; bf16_t* base = pn < 12 ? PA + pn * 256 : PB + (pn - 12) * 256; const int col0 = wc * 32 + 4 * fq;
        const int kind = pn < 8 ? 0 : ((pn < 12 || pn >= 20) ? 1 : (pn < 16 ? 2 : 3));
#pragma unroll
        for (int ai = 0; ai < 2; ++ai)
#pragma unroll
            for (int m = 0; m < 4; ++m) { const int row = row0 + ai * 128 + m * 16; const float s = rs[row];
#pragma unroll
                for (int bj = 0; bj < 2; ++bj)
#pragma unroll
                    for (int n = 0; n < 2; ++n) { f32x4 v = acc[ai][bj][m][n] * s;
                        if (kind == 0) { const f32x2 ga = gelu_pk((f32x2){v[0], v[1]}), gb = gelu_pk((f32x2){v[2], v[3]}); v = (f32x4){ga.x, ga.y, gb.x, gb.y}; }
                        else {
#pragma unroll
                        for (int j = 0; j < 4; ++j) { float x = v[j]; if (kind == 1) x = siluf_(x); else if (kind == 3) x = sigmoidf_(x); v[j] = x; } }
                        u32x2 w; w.x = cvt_pk_bf16(v[0], v[1]); w.y = cvt_pk_bf16(v[2], v[3]); *(u32x2*)(base + (size_t)row * 3072 + col0 + bj * 128 + n * 16) = w; } }
    }
};
__device__ __forceinline__ void p1_inproj(const Ctx& F) {
    unsigned char* ws = F.ws; Gemm g{DM, DM, DM};
    OrderXcd S{64, 24, 64 * 24, F.G, F.bid, (const char*)(ws + WS_XB), (const char*)(ws + WS_WIN), (size_t)256 * DM * 2, (size_t)256 * DM * 2};
    EpiInProjNP E{(bf16_t*)(ws + WS_PROJA), (bf16_t*)(ws + WS_PROJB), (const float*)(ws + WS_RS)};
    pg8::gemm_phase<EpiInProjNP, OrderXcd>(F.lds, g, S, E);
}
__device__ __forceinline__ void p7_outproj(const Ctx& F) {
    unsigned char* ws = F.ws; Gemm g{DMIX, DMIX, DMIX};
    OrderPanel4 S{64 * 4, F.G, F.bid, (const char*)(ws + WS_Y), (const char*)(ws + WS_WOUT), (size_t)256 * DMIX * 2, (size_t)256 * DMIX * 2};
    EpiOutProj E{F.in[0], F.in[1], F.out, (bf16_t*)(ws + WS_X1B)};
    pg8::gemm_phase<EpiOutProj, OrderPanel4>(F.lds, g, S, E);
}
__device__ __forceinline__ void p8_ple(const Ctx& F) {
    unsigned char* ws = F.ws;
    { Gemm g{DM, DM, DM}; OrderPanel4 S{NTILE * 4, F.G, F.bid, (const char*)(ws + WS_X1B), (const char*)(ws + WS_WPG), (size_t)256 * DM * 2, (size_t)256 * DM * 2};
      EpiBf16Act<3> E{(bf16_t*)(ws + WS_GB), DM, F.in[25], 1.0f}; pg8::gemm_phase<EpiBf16Act<3>, OrderPanel4>(F.lds, g, S, E); }
    { Gemm g{DPLE, DPLE, DPLE}; OrderProjSkip S{F.G, F.bid, (const char*)(ws + WS_PB), (const char*)(ws + WS_WPP), (size_t)256 * DPLE * 2, (size_t)256 * DPLE * 2};
      EpiBf16Act<0> E{(bf16_t*)(ws + WS_EB), DM, nullptr, 1.0f}; pg8::gemm_phase<EpiBf16Act<0>, OrderProjSkip>(F.lds, g, S, E); }
}
typedef float f32x4_t __attribute__((ext_vector_type(4)));
__device__ __forceinline__ void p2b_spatial_units(const Ctx& F0) { Ctx F = F0; asm volatile("" : "+v"(F.tid), "+v"(F.lane));
    unsigned char* ws = F.ws;
    const bf16_t* PA = (const bf16_t*)(ws + WS_PROJA); const bf16_t* WSP = (const bf16_t*)(ws + WS_WSP); bf16_t* Y = (bf16_t*)(ws + WS_Y);
    const float* lng = F.in[10]; const float* lnb = F.in[11]; const float* bsp = F.in[13];
    LAS bf16_t* vnT = (LAS bf16_t*)F.lds;
    const int lane = F.lane, w = F.wave, l15 = lane & 15, lq = lane >> 4;
    for (int it = 0; it < 5; ++it) { int unit = F.bid + it * F.G; if (it == 3 && F.bid < 2) continue; if (it == 4) { if (F.bid != 2 && F.bid != 3) break; unit = 768 + (F.bid - 2); } if (unit >= NB * 16 * HA) break;
        const int b = unit >> 7, c = (unit >> 3) & 15, h = unit & 7, r0 = b * SEQ + c * 128;
        const float g0 = lng[h * 128 + 2 * lane], g1 = lng[h * 128 + 2 * lane + 1], b0 = lnb[h * 128 + 2 * lane], b1 = lnb[h * 128 + 2 * lane + 1];
        unsigned wav[8], wbv[8];
#pragma unroll
        for (int p = 0; p < 8; ++p) { const int s0 = w * 16 + 2 * p; wav[p] = *(const unsigned*)(PA + (size_t)(r0 + s0) * 3072 + 1024 + h * 128 + 2 * lane); wbv[p] = *(const unsigned*)(PA + (size_t)(r0 + s0 + 1) * 3072 + 1024 + h * 128 + 2 * lane); }
#pragma unroll
        for (int p = 0; p < 8; ++p) { const int s0 = w * 16 + 2 * p; const unsigned wa = wav[p], wb = wbv[p];
            float a0 = bf_lo(wa), a1 = bf_hi(wa), c0 = bf_lo(wb), c1 = bf_hi(wb);
            const float mua = wave_sum(a0 + a1) * (1.f / 128.f), mub = wave_sum(c0 + c1) * (1.f / 128.f);
            a0 -= mua; a1 -= mua; c0 -= mub; c1 -= mub;
            const float ra = 1.0f / sqrtf(wave_sum(a0 * a0 + a1 * a1) * (1.f / 128.f) + EPS), rb = 1.0f / sqrtf(wave_sum(c0 * c0 + c1 * c1) * (1.f / 128.f) + EPS);
            *(LAS unsigned*)(vnT + (2 * lane) * 136 + s0) = cvt_pk_bf16(a0 * ra * g0 + b0, c0 * rb * g0 + b0);
            *(LAS unsigned*)(vnT + (2 * lane + 1) * 136 + s0) = cvt_pk_bf16(a1 * ra * g1 + b1, c1 * rb * g1 + b1); }
        __syncthreads();
        const int t0 = 16 * w, nks = (t0 + 15) / 32 + 1;
        f32x4 acc[8];
#pragma unroll
        for (int nb = 0; nb < 8; ++nb) acc[nb] = (f32x4){0.f, 0.f, 0.f, 0.f};
        bf16x8 wfr[4];
#pragma unroll
        for (int ks = 0; ks < 4; ++ks) wfr[ks] = *(const bf16x8*)(WSP + ((size_t)h * 128 + t0 + l15) * 128 + ks * 32 + 8 * lq);
        const int t = t0 + l15; const float bt = bsp[h * 128 + t]; const size_t row = (size_t)(r0 + t);
        u32x2 uuv[8], zzv[8];
#pragma unroll
        for (int nb = 0; nb < 8; ++nb) { const int d = nb * 16 + 4 * lq; uuv[nb] = *(const u32x2*)(PA + row * 3072 + h * 128 + d); zzv[nb] = *(const u32x2*)(PA + row * 3072 + 2048 + h * 128 + d); }
#pragma unroll
        for (int ks = 0; ks < 4; ++ks) { if (ks < nks) { const int k0 = ks * 32;
#pragma unroll
            for (int nb = 0; nb < 8; ++nb) { const bf16x8 vf = *(const LAS bf16x8*)(vnT + (nb * 16 + l15) * 136 + k0 + 8 * lq);
                acc[nb] = __builtin_amdgcn_mfma_f32_16x16x32_bf16(vf, wfr[ks], acc[nb], 0, 0, 0); } } }
#pragma unroll
        for (int nb = 0; nb < 8; ++nb) { const int d = nb * 16 + 4 * lq; const u32x2 uu = uuv[nb], zz = zzv[nb];
            u32x2 o; o.x = cvt_pk_bf16(bf_lo(uu.x) * (acc[nb][0] + bt) * bf_lo(zz.x), bf_hi(uu.x) * (acc[nb][1] + bt) * bf_hi(zz.x));
            o.y = cvt_pk_bf16(bf_lo(uu.y) * (acc[nb][2] + bt) * bf_lo(zz.y), bf_hi(uu.y) * (acc[nb][3] + bt) * bf_hi(zz.y));
            *(u32x2*)(Y + row * DMIX + h * 128 + d) = o; }
        __syncthreads();
    }
}
__device__ __forceinline__ void p2b_mscan(const Ctx& F) { if (F.bid < 32 && F.wave == 0) mscan_wave(F, F.bid); }

struct OrderHeadRows {
    int n, G, c; const char* A; size_t astep; const char* B; int pm0;
    __device__ __forceinline__ bool next(int i, Unit& u) const { const int L = i * G + c; if (L >= n) return false;
        u.pm = pm0 + (L >> 2); u.pn = 0; u.aux = L & 3; u.a = A + (size_t)u.pm * astep + (size_t)u.aux * 512; u.b = B + (size_t)u.aux * 131072; return true; }
};
struct OrderHeadT {
    int n, G, c; const char* W; const char* X; size_t xstep;
    __device__ __forceinline__ bool next(int i, Unit& u) const { const int L = i * G + c; if (L >= n) return false;
        const int b = L >> 5, h = (L >> 3) & 3, cc = L & 7; u.pm = b * 8 + cc; u.pn = L; u.aux = h; u.a = W + (size_t)h * 131072; u.b = X + (size_t)u.pm * xstep + (size_t)h * 512; return true; }
};
struct EpiQ {
    static constexpr bool PERM = false, AFTER_DRAIN = false;
    bf16_t* Q; bf16_t* PQ; const float* DG;
    __device__ __forceinline__ void operator()(const f32x4 (&acc)[2][2][4][2], const Unit& u, int wr, int wc, int fr, int fq) const {
        const int h = u.aux, rl0 = wr * 64 + fr, col0 = wc * 32 + 4 * fq; const bool prompt = u.pm < 64;
        const int unit = ((u.pm >> 3) * 4 + h) * 8 + (u.pm & 7);
#pragma unroll
        for (int ai = 0; ai < 2; ++ai)
#pragma unroll
            for (int m = 0; m < 4; ++m) { const int rl = rl0 + ai * 128 + m * 16, row = u.pm * 256 + rl;
#pragma unroll
                for (int bj = 0; bj < 2; ++bj)
#pragma unroll
                    for (int n = 0; n < 2; ++n) { const int c = col0 + bj * 128 + n * 16; const f32x4 v = acc[ai][bj][m][n];
                        u32x2 w; w.x = cvt_pk_bf16(v[0], v[1]); w.y = cvt_pk_bf16(v[2], v[3]); *(u32x2*)(Q + (size_t)row * 1024 + h * 256 + c) = w; }
                asm volatile("" ::: "memory"); }
        if (prompt) {
#pragma unroll
        for (int ai = 0; ai < 2; ++ai)
#pragma unroll
            for (int m = 0; m < 4; ++m) { const int rl = rl0 + ai * 128 + m * 16, row = u.pm * 256 + rl; const float g = DG[(size_t)h * MA + row];
#pragma unroll
                for (int bj = 0; bj < 2; ++bj)
#pragma unroll
                    for (int n = 0; n < 2; ++n) { const int c = col0 + bj * 128 + n * 16; const f32x4 v = acc[ai][bj][m][n] * g;
                        u32x2 w2; w2.x = cvt_pk_bf16(v[0], v[1]); w2.y = cvt_pk_bf16(v[2], v[3]); *(u32x2*)(PQ + ((size_t)unit * 256 + rl) * 512 + 256 + c) = w2; }
                asm volatile("" ::: "memory"); } }
    }
};
struct EpiHeadPlain {
    static constexpr bool PERM = false, AFTER_DRAIN = false;
    bf16_t* O; float scale; int row_off;
    __device__ __forceinline__ void operator()(const f32x4 (&acc)[2][2][4][2], const Unit& u, int wr, int wc, int fr, int fq) const {
        const int h = u.aux, row0 = u.pm * 256 - row_off + wr * 64 + fr, col0 = h * 256 + wc * 32 + 4 * fq;
#pragma unroll
        for (int ai = 0; ai < 2; ++ai)
#pragma unroll
            for (int m = 0; m < 4; ++m) { bf16_t* rowp = O + (size_t)(row0 + ai * 128 + m * 16) * 1024 + col0;
#pragma unroll
                for (int bj = 0; bj < 2; ++bj)
#pragma unroll
                    for (int n = 0; n < 2; ++n) { const f32x4 v = acc[ai][bj][m][n] * scale; u32x2 w; w.x = cvt_pk_bf16(v[0], v[1]); w.y = cvt_pk_bf16(v[2], v[3]); *(u32x2*)(rowp + bj * 128 + n * 16) = w; } }
    }
};
struct EpiUnitT {
    static constexpr bool PERM = false, AFTER_DRAIN = false;
    bf16_t* O; int ldo; const float* cs; float scale;
    __device__ __forceinline__ void operator()(const f32x4 (&acc)[2][2][4][2], const Unit& u, int wr, int wc, int fr, int fq) const {
        const int h = u.aux, rl0 = wr * 64 + fr, col0 = wc * 32 + 4 * fq; bf16_t* base = O + (size_t)u.pn * 256 * ldo;
#pragma unroll
        for (int ai = 0; ai < 2; ++ai)
#pragma unroll
            for (int m = 0; m < 4; ++m) { bf16_t* rowp = base + (size_t)(rl0 + ai * 128 + m * 16) * ldo + col0;
#pragma unroll
                for (int bj = 0; bj < 2; ++bj)
#pragma unroll
                    for (int n = 0; n < 2; ++n) { const f32x4 scv = cs ? *(const f32x4*)(cs + (size_t)h * MA + u.pm * 256 + col0 + bj * 128 + n * 16) * scale : (f32x4){scale, scale, scale, scale}; const f32x4 v = acc[ai][bj][m][n] * scv; u32x2 w; w.x = cvt_pk_bf16(v[0], v[1]); w.y = cvt_pk_bf16(v[2], v[3]); *(u32x2*)(rowp + bj * 128 + n * 16) = w; } }
    }
};
struct OrderQK {
    int G, c; const char* ws;
    __device__ __forceinline__ bool next(int i, Unit& u) const { const int L = i * G + c; if (L >= 512) return false; const char* XC = ws + WS_XB; const char* WQ = ws + WS_WQ; const char* WK = ws + WS_WK;
        const int kind = L >> 8, l = L & 255; u.pm = l >> 2; u.pn = kind; u.aux = l & 3; u.a = XC + (size_t)u.pm * (256 * DM * 2) + (size_t)u.aux * 512; u.b = (kind ? WK : WQ) + (size_t)u.aux * 131072; return true; }
};
struct EpiQK {
    static constexpr bool PERM = false, AFTER_DRAIN = false;
    bf16_t* Q; bf16_t* K; bf16_t* PQ; const float* DG;
    __device__ __forceinline__ void operator()(const f32x4 (&acc)[2][2][4][2], const Unit& u, int wr, int wc, int fr, int fq) const {
        const int h = u.aux, rl0 = wr * 64 + fr, col0 = wc * 32 + 4 * fq; const bool isk = u.pn != 0; bf16_t* O = isk ? K : Q; const float sc = isk ? 0.0625f : 1.0f;
        const int unit = ((u.pm >> 3) * 4 + h) * 8 + (u.pm & 7);
#pragma unroll
        for (int ai = 0; ai < 2; ++ai)
#pragma unroll
            for (int m = 0; m < 4; ++m) { const int rl = rl0 + ai * 128 + m * 16, row = u.pm * 256 + rl;
#pragma unroll
                for (int bj = 0; bj < 2; ++bj)
#pragma unroll
                    for (int n = 0; n < 2; ++n) { const int c = col0 + bj * 128 + n * 16; const f32x4 v = acc[ai][bj][m][n] * sc;
                        u32x2 w; w.x = cvt_pk_bf16(v[0], v[1]); w.y = cvt_pk_bf16(v[2], v[3]); *(u32x2*)(O + (size_t)row * 1024 + h * 256 + c) = w; }
                asm volatile("" ::: "memory"); }
        if (!isk) {
#pragma unroll
        for (int ai = 0; ai < 2; ++ai)
#pragma unroll
            for (int m = 0; m < 4; ++m) { const int rl = rl0 + ai * 128 + m * 16, row = u.pm * 256 + rl; const float g = DG[(size_t)h * MA + row];
#pragma unroll
                for (int bj = 0; bj < 2; ++bj)
#pragma unroll
                    for (int n = 0; n < 2; ++n) { const int c = col0 + bj * 128 + n * 16; const f32x4 v = acc[ai][bj][m][n] * g;
                        u32x2 w2; w2.x = cvt_pk_bf16(v[0], v[1]); w2.y = cvt_pk_bf16(v[2], v[3]); *(u32x2*)(PQ + ((size_t)unit * 256 + rl) * 512 + 256 + c) = w2; }
                asm volatile("" ::: "memory"); } }
    }
};
struct OrderS12 {
    int G, c; const char* ws;
    __device__ __forceinline__ bool next(int i, Unit& u) const { const int L = i * G + c; if (L >= 12) return false; const char* XC = ws + WS_XB; const char* XB2 = ws + WS_XB2; const char* WQ = ws + WS_WQ; const char* WK = ws + WS_WK; const char* WV = ws + WS_WV;
        const int kind = L >> 2; u.pm = 64; u.pn = kind; u.aux = L & 3; u.a = (kind == 2 ? XB2 : XC) + (size_t)64 * (256 * DM * 2) + (size_t)u.aux * 512; u.b = (kind == 0 ? WQ : kind == 1 ? WK : WV) + (size_t)u.aux * 131072; return true; }
};
struct EpiS12 {
    static constexpr bool PERM = false, AFTER_DRAIN = false;
    bf16_t* Q; bf16_t* K; bf16_t* Vs;
    __device__ __forceinline__ void operator()(const f32x4 (&acc)[2][2][4][2], const Unit& u, int wr, int wc, int fr, int fq) const {
        const int h = u.aux, kind = u.pn; bf16_t* O = kind == 0 ? Q + (size_t)MP * 1024 : kind == 1 ? K + (size_t)MP * 1024 : Vs; const float sc = kind == 1 ? 0.0625f : 1.0f;
        const int row0 = wr * 64 + fr, col0 = h * 256 + wc * 32 + 4 * fq;
#pragma unroll
        for (int m = 0; m < 4; ++m) { bf16_t* rowp = O + (size_t)(row0 + m * 16) * 1024 + col0;
#pragma unroll
            for (int bj = 0; bj < 2; ++bj)
#pragma unroll
                for (int n = 0; n < 2; ++n) { const f32x4 v = acc[0][bj][m][n] * sc; u32x2 w; w.x = cvt_pk_bf16(v[0], v[1]); w.y = cvt_pk_bf16(v[2], v[3]); *(u32x2*)(rowp + bj * 128 + n * 16) = w; } }
    }
};
struct OrderVW {
    int G, c; const char* ws;
    __device__ __forceinline__ bool next(int i, Unit& u) const { const int L = i * G + c; if (L >= 512) return false; const char* XC = ws + WS_XB; const char* XB2 = ws + WS_XB2; const char* WK = ws + WS_WK; const char* WV = ws + WS_WV;
        const int kind = L >> 8, l = L & 255, b = l >> 5, h = (l >> 3) & 3, cc = l & 7; u.pm = b * 8 + cc; u.pn = l | (kind << 8); u.aux = h;
        u.a = (kind ? WK : WV) + (size_t)h * 131072; u.b = (kind ? XC : XB2) + (size_t)u.pm * (256 * DM * 2) + (size_t)h * 512; return true; }
};
struct EpiVW {
    static constexpr bool PERM = false, AFTER_DRAIN = false;
    bf16_t* VC; bf16_t* WKT; const float* DW;
    __device__ __forceinline__ void operator()(const f32x4 (&acc)[2][2][4][2], const Unit& u, int wr, int wc, int fr, int fq) const {
        const int h = u.aux, kind = u.pn >> 8, l = u.pn & 255, rl0 = wr * 64 + fr, col0 = wc * 32 + 4 * fq; const int ldo = kind ? 256 : 512; bf16_t* base = (kind ? WKT : VC) + (size_t)l * 256 * ldo;
#pragma unroll
        for (int ai = 0; ai < 2; ++ai)
#pragma unroll
            for (int m = 0; m < 4; ++m) { bf16_t* rowp = base + (size_t)(rl0 + ai * 128 + m * 16) * ldo + col0;
#pragma unroll
                for (int bj = 0; bj < 2; ++bj)
#pragma unroll
                    for (int n = 0; n < 2; ++n) { const f32x4 scv = kind ? *(const f32x4*)(DW + (size_t)h * MA + u.pm * 256 + col0 + bj * 128 + n * 16) * 0.0625f : (f32x4){1.f, 1.f, 1.f, 1.f};
                        const f32x4 v = acc[ai][bj][m][n] * scv; u32x2 w; w.x = cvt_pk_bf16(v[0], v[1]); w.y = cvt_pk_bf16(v[2], v[3]); *(u32x2*)(rowp + bj * 128 + n * 16) = w; }
                asm volatile("" ::: "memory"); }
    }
};
__device__ __forceinline__ void p3_qkv(const Ctx& F) {
    unsigned char* ws = F.ws;
    { Gemm g{DM, 256, 256}; OrderQK S{F.G, F.bid, (const char*)ws}; EpiQK E{(bf16_t*)(ws + WS_Q), (bf16_t*)(ws + WS_K), (bf16_t*)(ws + WS_PQ), (const float*)(ws + WS_DG)};
      pg8::gemm_phase<EpiQK, OrderQK>(F.lds, g, S, E); }
    { Gemm g{256, DM, 256}; OrderVW S{F.G, F.bid, (const char*)ws}; EpiVW E{(bf16_t*)(ws + WS_VC), (bf16_t*)(ws + WS_WKT), (const float*)(ws + WS_DW)};
      pg8::gemm_phase<EpiVW, OrderVW>(F.lds, g, S, E); }
}

__device__ __forceinline__ void p3_s12(const Ctx& F) {
    unsigned char* ws = F.ws;
    { Gemm g{DM, 256, 256}; OrderS12 S{F.G, (F.bid - 32) & 255, (const char*)ws}; EpiS12 E{(bf16_t*)(ws + WS_Q), (bf16_t*)(ws + WS_K), (bf16_t*)(ws + WS_VS)};
      pg8::gemm_phase<EpiS12, OrderS12>(F.lds, g, S, E); }
}
struct OrderUnitNT {
    int n, G, c; const char* A; size_t astep_pm, astep_h, astep_u; const char* B; size_t bstep_pm, bstep_h, bstep_u;
    __device__ __forceinline__ bool next(int i, Unit& u) const { const int L = i * G + c; if (L >= n) return false;
        const int b = L >> 5, h = (L >> 3) & 3, cc = L & 7; u.pm = b * 8 + cc; u.pn = L; u.aux = h;
        u.a = A + (size_t)u.pm * astep_pm + (size_t)h * astep_h + (size_t)L * astep_u; u.b = B + (size_t)u.pm * bstep_pm + (size_t)h * bstep_h + (size_t)L * bstep_u; return true; }
};
struct EpiScore {
    static constexpr bool PERM = false, AFTER_DRAIN = false;
    bf16_t* PQ; const float* DA; const float* DR; float* DENP;
    __device__ __forceinline__ void operator()(const f32x4 (&acc)[2][2][4][2], const Unit& u, int wr, int wc, int fr, int fq) const {
        const int h = u.aux, rl0 = wr * 64 + fr, col0 = wc * 32 + 4 * fq; const size_t vb = (size_t)h * MA + (size_t)u.pm * 256;
#pragma unroll
        for (int ai = 0; ai < 2; ++ai)
#pragma unroll
            for (int m = 0; m < 4; ++m) { int t_ = rl0 + ai * 128 + m * 16; asm volatile("" : "+v"(t_)); const int t = t_; const float at = DA[vb + t]; float rs_ = 0.f; bf16_t* rowp = PQ + ((size_t)u.pn * 256 + t) * 512 + col0;
#pragma unroll
                for (int bj = 0; bj < 2; ++bj)
#pragma unroll
                    for (int n = 0; n < 2; ++n) { const int c = col0 + bj * 128 + n * 16; f32x4 v; const f32x4 rr = *(const f32x4*)(DR + vb + c);
#pragma unroll
                        for (int j = 0; j < 4; ++j) { const float e = fast_exp(fminf(at + rr[j], 0.f)); v[j] = (c + j <= t) ? acc[ai][bj][m][n][j] * e : 0.f; rs_ += v[j]; }
                        u32x2 w; w.x = cvt_pk_bf16(v[0], v[1]); w.y = cvt_pk_bf16(v[2], v[3]); *(u32x2*)(rowp + bj * 128 + n * 16) = w; }
                rs_ += __shfl_xor(rs_, 16); rs_ += __shfl_xor(rs_, 32);
                if (fq == 0) DENP[(vb + t) * 4 + wc] = rs_; asm volatile("" ::: "memory"); }
    }
};
struct EpiF32Unit {
    static constexpr bool PERM = false, AFTER_DRAIN = false;
    bf16_t* O;
    __device__ __forceinline__ void operator()(const f32x4 (&acc)[2][2][4][2], const Unit& u, int wr, int wc, int fr, int fq) const {
        bf16_t* base = O + (size_t)u.pn * 65536 + (size_t)(wr * 64 + fr) * 256 + wc * 32 + 4 * fq;
#pragma unroll
        for (int ai = 0; ai < 2; ++ai)
#pragma unroll
            for (int m = 0; m < 4; ++m)
#pragma unroll
                for (int bj = 0; bj < 2; ++bj)
#pragma unroll
                    for (int n = 0; n < 2; ++n) { const f32x4 v = acc[ai][bj][m][n]; u32x2 w; w.x = cvt_pk_bf16(v[0], v[1]); w.y = cvt_pk_bf16(v[2], v[3]); *(u32x2*)(base + (size_t)(ai * 128 + m * 16) * 256 + bj * 128 + n * 16) = w; }
    }
};
__device__ __forceinline__ void p4_scores_dc(const Ctx& F) {
    unsigned char* ws = F.ws;
    { Gemm g{DM, DM, 256}; OrderUnitNT S{NUNIT, F.G, F.bid, (const char*)(ws + WS_Q), (size_t)256 * DM * 2, 512, 0, (const char*)(ws + WS_K), (size_t)256 * DM * 2, 512, 0};
      EpiScore E{(bf16_t*)(ws + WS_PQ), (const float*)(ws + WS_DA), (const float*)(ws + WS_DR), (float*)(ws + WS_DENP)}; pg8::gemm_phase<EpiScore, OrderUnitNT>(F.lds, g, S, E); }
    { Gemm g{512, 256, 256}; OrderUnitNT S{NUNIT, F.G, F.bid, (const char*)(ws + WS_VC), 0, 0, (size_t)256 * 512 * 2, (const char*)(ws + WS_WKT), 0, 0, (size_t)256 * 256 * 2};
      EpiF32Unit E{(bf16_t*)(F.out + O_Y)}; pg8::gemm_phase<EpiF32Unit, OrderUnitNT>(F.lds, g, S, E); }
    for (int u = F.bid; u < NUNIT; u += F.G) { const int d = F.tid >> 1, hf = F.tid & 1; const bf16_t* src = (const bf16_t*)(ws + WS_WKT) + ((size_t)u * 256 + d) * 256 + hf * 128; float s = 0.f;
#pragma unroll
        for (int j = 0; j < 16; ++j) { float t8[8]; unpack8(*(const u32x4*)(src + j * 8), t8);
#pragma unroll
            for (int e = 0; e < 8; ++e) s += t8[e]; }
        s += __shfl_xor(s, 1); if (hf == 0) ((float*)(ws + WS_DN))[(size_t)u * 256 + d] = s; }
}

__device__ __forceinline__ void p5_scan_sample(const Ctx& F0) { Ctx F = F0; asm volatile("" : "+v"(F.tid), "+v"(F.lane));
    unsigned char* ws = F.ws; const float* DG = (const float*)(ws + WS_DG); const bf16_t* DCb = (const bf16_t*)(F.out + O_Y); bf16_t* VC = (bf16_t*)(ws + WS_VC);
    for (int idx = F.bid * 512 + F.tid; idx < 32 * 16384; idx += F.G * 512) { const int bh = idx >> 14, q4 = idx & 16383, e = q4 >> 6, d4 = (q4 & 63) * 4, b = bh >> 2, h = bh & 3;
        f32x4 dc[8]; float ge[8];
#pragma unroll
        for (int c = 0; c < 8; ++c) { const u32x2 dw = *(const u32x2*)(DCb + ((size_t)(bh * 8 + c) * 256 + e) * 256 + d4); dc[c] = (f32x4){bf_lo(dw.x), bf_hi(dw.x), bf_lo(dw.y), bf_hi(dw.y)}; ge[c] = DG[(size_t)h * MA + b * SEQ + c * 256 + 255]; }
        f32x4 C = (f32x4){0.f, 0.f, 0.f, 0.f};
#pragma unroll
        for (int c = 0; c < 8; ++c) { u32x2 w; w.x = cvt_pk_bf16(C[0], C[1]); w.y = cvt_pk_bf16(C[2], C[3]); *(u32x2*)(VC + ((size_t)(bh * 8 + c) * 256 + e) * 512 + 256 + d4) = w; C = C * ge[c] + dc[c]; }
        *(f32x4*)(F.out + O_CP + ((size_t)bh * 256 + e) * 256 + d4) = C; }
    LAS float* npv = (LAS float*)F.lds;
    for (int u = F.bid; u < NUNIT; u += F.G) { const int bh = u >> 3, cc = u & 7, b = bh >> 2, h = bh & 3;
        __syncthreads();
        if (F.tid < 256) { float n = 0.f; const float* DN = (const float*)(ws + WS_DN);
            for (int j = 0; j < cc; ++j) n = DG[(size_t)h * MA + b * SEQ + j * 256 + 255] * n + DN[(size_t)(bh * 8 + j) * 256 + F.tid];
            npv[F.tid] = n; if (cc == 7) F.out[O_NP + (size_t)bh * 256 + F.tid] = DG[(size_t)h * MA + b * SEQ + 7 * 256 + 255] * n + DN[(size_t)u * 256 + F.tid]; }
        __syncthreads();
        const f32x4 nv = *(const LAS f32x4*)(npv + 4 * F.lane); const bf16_t* Q = (const bf16_t*)(ws + WS_Q);
        for (int r = 0; r < 32; ++r) { const size_t row = (size_t)b * SEQ + cc * 256 + F.wave * 32 + r; const u32x2 qq = *(const u32x2*)(Q + row * 1024 + h * 256 + 4 * F.lane);
            const float s = wave_sum(bf_lo(qq.x) * nv[0] + bf_hi(qq.x) * nv[1] + bf_lo(qq.y) * nv[2] + bf_hi(qq.y) * nv[3]); if (F.lane == 0) ((float*)(ws + WS_QN))[(size_t)h * MA + row] = s; } }

}


__device__ __forceinline__ void p5s_sample(const Ctx& F0) { Ctx F = F0; asm volatile("" : "+v"(F.tid), "+v"(F.lane));
    unsigned char* ws = F.ws;
    LAS float* hs = (LAS float*)F.lds + 512; LAS float* red = (LAS float*)F.lds + 1024;
    for (int job = F.bid; job < MS * HB; job += F.G) { const int i = job >> 2, h = job & 3; const size_t row = MP + i;
        const bf16_t* Q = (const bf16_t*)(ws + WS_Q) + row * 1024 + h * 256; const bf16_t* K = (const bf16_t*)(ws + WS_K) + row * 1024 + h * 256; const bf16_t* V = (const bf16_t*)(ws + WS_VS) + (size_t)i * 1024 + h * 256;
        const u32x2 qw = *(const u32x2*)(Q + 4 * F.lane), kw = *(const u32x2*)(K + 4 * F.lane);
        const f32x4 q4 = (f32x4){bf_lo(qw.x), bf_hi(qw.x), bf_lo(qw.y), bf_hi(qw.y)}, k4 = (f32x4){bf_lo(kw.x), bf_hi(kw.x), bf_lo(kw.y), bf_hi(kw.y)};
        const f32x4 n0 = *(const f32x4*)(F.in[3] + ((size_t)i * 4 + h) * 256 + 4 * F.lane);
        const float li = ((const float*)(ws + WS_GLI))[(size_t)h * MA + row], lf = ((const float*)(ws + WS_GLF))[(size_t)h * MA + row], m0 = F.in[4][i * 4 + h];
        const float mn = fmaxf(lf + m0, li), g = __expf(lf + m0 - mn), wi = __expf(li - mn);
        const float qk = wave_sum(q4[0] * k4[0] + q4[1] * k4[1] + q4[2] * k4[2] + q4[3] * k4[3]), nq = wave_sum(n0[0] * q4[0] + n0[1] * q4[1] + n0[2] * q4[2] + n0[3] * q4[3]);
        const float sc = wi * qk, den = sc + g * nq, dinv = 1.0f / fmaxf(fabsf(den), __expf(-mn));
        const float* C0 = F.in[2] + (((size_t)i * 4 + h) * 256 + F.wave * 32) * 256 + 4 * F.lane; float* C1 = F.out + O_CS + (((size_t)i * 4 + h) * 256 + F.wave * 32) * 256 + 4 * F.lane;
        __syncthreads();
#pragma unroll 1
        for (int r8 = 0; r8 < 32; r8 += 8) { f32x4 c[8]; float ve[8], cq[8];
#pragma unroll
            for (int r = 0; r < 8; ++r) { c[r] = *(const f32x4*)(C0 + (size_t)(r8 + r) * 256); ve[r] = bf2f(V[F.wave * 32 + r8 + r]); }
#pragma unroll
            for (int r = 0; r < 8; ++r) { cq[r] = c[r][0] * q4[0] + c[r][1] * q4[1] + c[r][2] * q4[2] + c[r][3] * q4[3]; const float wv = wi * ve[r]; *(f32x4*)(C1 + (size_t)(r8 + r) * 256) = c[r] * g + k4 * wv; }
#pragma unroll
            for (int r = 0; r < 8; ++r) { cq[r] = wave_sum(cq[r]); if (F.lane == 0) hs[F.wave * 32 + r8 + r] = (sc * ve[r] + g * cq[r]) * dinv; } }
        if (F.wave == 0) { *(f32x4*)(F.out + O_NS + ((size_t)i * 4 + h) * 256 + 4 * F.lane) = n0 * g + k4 * wi; if (F.lane == 0) F.out[O_MS + i * 4 + h] = mn; }
        __syncthreads();
        const bf16_t* PB = (const bf16_t*)(ws + WS_PROJB) + row * 3072; const bf16_t* XC = (const bf16_t*)(ws + WS_XB) + row * DM;
        float x = 0.f; const int ch = h * 256 + (F.tid & 255);
        if (F.tid < 256) x = hs[F.tid] * bf2f(PB[1024 + ch]);
        float p = wave_sum(x); if (F.lane == 0) red[F.wave] = p;
        __syncthreads();
        const float mu = (red[0] + red[1] + red[2] + red[3]) * (1.f / 256.f), dx = x - mu;
        __syncthreads();
        p = wave_sum(F.tid < 256 ? dx * dx : 0.f); if (F.lane == 0) red[F.wave] = p;
        __syncthreads();
        const float rstd = 1.0f / sqrtf((red[0] + red[1] + red[2] + red[3]) * (1.f / 256.f) + EPS);
        if (F.tid < 256) ((bf16_t*)(ws + WS_Y))[row * DMIX + 1024 + ch] = f2bf((dx * rstd * F.in[21][ch] + F.in[22][ch] * bf2f(XC[ch])) * bf2f(PB[2048 + ch]));
        __syncthreads();
    }
}
struct EpiHOut {
    static constexpr bool PERM = false, AFTER_DRAIN = true;
    const float* DENP; const float* DG; const float* QN; const float* DEM; const bf16_t* PB; const bf16_t* XC; bf16_t* Y; const float* gng; const float* skip;
    __device__ __forceinline__ void fused(f32x4 (&acc)[2][2][4][2], const Unit& u, int wr, int wc, int fr, int fq, LAS unsigned char* lds, int wid, int lane) const {
        const int h = u.aux, rl0 = wr * 64 + fr, col0 = wc * 32 + 4 * fq; const size_t vb = (size_t)h * MA + (size_t)u.pm * 256;
        LAS float* P1 = (LAS float*)lds; LAS float* P2 = (LAS float*)lds + 1024;
#pragma unroll
        for (int ai = 0; ai < 2; ++ai) { u32x2 ow[4][2][2]; f32x4 dp[4]; float dgq[4], dem[4];
#pragma unroll
            for (int m = 0; m < 4; ++m) { const int t = rl0 + ai * 128 + m * 16; const size_t row = (size_t)u.pm * 256 + t; dp[m] = *(const f32x4*)(DENP + (vb + t) * 4); dgq[m] = DG[vb + t] * QN[vb + t]; dem[m] = DEM[vb + t];
#pragma unroll
                for (int bj = 0; bj < 2; ++bj)
#pragma unroll
                    for (int n = 0; n < 2; ++n) ow[m][bj][n] = *(const u32x2*)(PB + row * 3072 + 1024 + h * 256 + col0 + bj * 128 + n * 16); }
#pragma unroll
            for (int m = 0; m < 4; ++m) { const int t = rl0 + ai * 128 + m * 16; const float den = (dp[m][0] + dp[m][1]) + (dp[m][2] + dp[m][3]) + dgq[m];
                const float dinv = 1.0f / fmaxf(fabsf(den), dem[m]); float s = 0.f;
#pragma unroll
                for (int bj = 0; bj < 2; ++bj)
#pragma unroll
                    for (int n = 0; n < 2; ++n) { const u32x2 o2 = ow[m][bj][n];
                        f32x4 v = acc[ai][bj][m][n] * dinv; v[0] *= bf_lo(o2.x); v[1] *= bf_hi(o2.x); v[2] *= bf_lo(o2.y); v[3] *= bf_hi(o2.y); acc[ai][bj][m][n] = v; s += (v[0] + v[1]) + (v[2] + v[3]); }
                s += __shfl_xor(s, 16); s += __shfl_xor(s, 32); if (fq == 0) P1[t * 4 + wc] = s; } }
        asm volatile("s_waitcnt lgkmcnt(0)" ::: "memory"); __builtin_amdgcn_s_barrier(); asm volatile("" ::: "memory");
#pragma unroll
        for (int ai = 0; ai < 2; ++ai)
#pragma unroll
            for (int m = 0; m < 4; ++m) { const int t = rl0 + ai * 128 + m * 16; const f32x4 ps = *(const LAS f32x4*)(P1 + t * 4); const float mu = ((ps[0] + ps[1]) + (ps[2] + ps[3])) * (1.f / 256.f); float q = 0.f;
#pragma unroll
                for (int bj = 0; bj < 2; ++bj)
#pragma unroll
                    for (int n = 0; n < 2; ++n) { f32x4 v = acc[ai][bj][m][n] - mu; acc[ai][bj][m][n] = v; q += (v[0] * v[0] + v[1] * v[1]) + (v[2] * v[2] + v[3] * v[3]); }
                q += __shfl_xor(q, 16); q += __shfl_xor(q, 32); if (fq == 0) P2[t * 4 + wc] = q; }
        asm volatile("s_waitcnt lgkmcnt(0)" ::: "memory"); __builtin_amdgcn_s_barrier(); asm volatile("" ::: "memory");
#pragma unroll
        for (int ai = 0; ai < 2; ++ai) { u32x2 xw[4][2][2], zw[4][2][2];
#pragma unroll
            for (int m = 0; m < 4; ++m) { const int t = rl0 + ai * 128 + m * 16; const size_t row = (size_t)u.pm * 256 + t;
#pragma unroll
                for (int bj = 0; bj < 2; ++bj)
#pragma unroll
                    for (int n = 0; n < 2; ++n) { const int c = h * 256 + col0 + bj * 128 + n * 16; xw[m][bj][n] = *(const u32x2*)(XC + row * DM + c); zw[m][bj][n] = *(const u32x2*)(PB + row * 3072 + 2048 + c); } }
#pragma unroll
            for (int m = 0; m < 4; ++m) { const int t = rl0 + ai * 128 + m * 16; const size_t row = (size_t)u.pm * 256 + t; const f32x4 ps = *(const LAS f32x4*)(P2 + t * 4);
                const float rstd = 1.0f / sqrtf(((ps[0] + ps[1]) + (ps[2] + ps[3])) * (1.f / 256.f) + EPS);
#pragma unroll
                for (int bj = 0; bj < 2; ++bj)
#pragma unroll
                    for (int n = 0; n < 2; ++n) { const int c = h * 256 + col0 + bj * 128 + n * 16; const u32x2 x2 = xw[m][bj][n], z2 = zw[m][bj][n];
                        const f32x4 ggv = *(const f32x4*)(gng + c), skv = *(const f32x4*)(skip + c); const f32x4 v = acc[ai][bj][m][n] * rstd * ggv; u32x2 w;
                        w.x = cvt_pk_bf16((v[0] + skv[0] * bf_lo(x2.x)) * bf_lo(z2.x), (v[1] + skv[1] * bf_hi(x2.x)) * bf_hi(z2.x));
                        w.y = cvt_pk_bf16((v[2] + skv[2] * bf_lo(x2.y)) * bf_lo(z2.y), (v[3] + skv[3] * bf_hi(x2.y)) * bf_hi(z2.y));
                        *(u32x2*)(Y + row * DMIX + 1024 + c) = w; } } }
    }
};
__device__ __forceinline__ void p6_hout(const Ctx& F) {
    unsigned char* ws = F.ws; Gemm g{512, 512, 512};
    OrderUnitNT S{NUNIT, F.G, F.bid, (const char*)(ws + WS_PQ), 0, 0, (size_t)256 * 512 * 2, (const char*)(ws + WS_VC), 0, 0, (size_t)256 * 512 * 2};
    EpiHOut E{(const float*)(ws + WS_DENP), (const float*)(ws + WS_DG), (const float*)(ws + WS_QN), (const float*)(ws + WS_DEM), (const bf16_t*)(ws + WS_PROJB), (const bf16_t*)(ws + WS_XB), (bf16_t*)(ws + WS_Y), F.in[21], F.in[22]};
    pg8::gemm_phase<EpiHOut, OrderUnitNT, false, true>(F.lds, g, S, E);
}
template <class PtrF, class Ef>
__device__ __forceinline__ void sample_gemm(const Ctx& F, int nitems, int K, int lda, int ldb, const PtrF& P, const Ef& E) {
    const int l15 = F.lane & 15, lq = F.lane >> 4, w = F.wave;
    for (int item = F.bid; item < nitems; item += F.G) {
        const bf16_t* A; const bf16_t* B; P(item, A, B);
        const bf16_t* ap = A + (size_t)(16 * w + l15) * lda + 8 * lq; const bf16_t* bp = B + (size_t)l15 * ldb + 8 * lq;
        f32x4 acc = (f32x4){0.f, 0.f, 0.f, 0.f};
        for (int k0 = 0; k0 < K; k0 += 256) { bf16x8 a[8], b[8];
#pragma unroll
            for (int j = 0; j < 8; ++j) { a[j] = *(const bf16x8*)(ap + k0 + 32 * j); b[j] = *(const bf16x8*)(bp + k0 + 32 * j); }
#pragma unroll
            for (int j = 0; j < 8; ++j) acc = __builtin_amdgcn_mfma_f32_16x16x32_bf16(a[j], b[j], acc, 0, 0, 0); }
#pragma unroll
        for (int r = 0; r < 4; ++r) E(item, 16 * w + 4 * lq + r, l15, acc[r]);
    }
}
__device__ __forceinline__ void sample_inproj(const Ctx& F) {
    unsigned char* ws = F.ws; const bf16_t* XB = (const bf16_t*)(ws + WS_XB) + (size_t)MP * DM; const bf16_t* W = (const bf16_t*)(ws + WS_WIN);
    bf16_t* PA = (bf16_t*)(ws + WS_PROJA) + (size_t)MP * 3072; bf16_t* PB = (bf16_t*)(ws + WS_PROJB) + (size_t)MP * 3072; const float* rs = (const float*)(ws + WS_RS) + MP;
    sample_gemm(F, NIN / 16, DM, DM, DM,
        [=](int item, const bf16_t*& A, const bf16_t*& B) { A = XB; B = W + (size_t)item * 16 * DM; },
        [=](int item, int r, int c, float acc) { const int col = item * 16 + c, grp = col >> 10; float v = acc * rs[r];
            if (grp < 2) { const f32x2 g2 = gelu_pk((f32x2){v, v}); v = g2.x; } else if (grp == 2 || grp == 5) v = siluf_(v); else if (grp == 4) v = sigmoidf_(v);
            bf16_t* dst = col < 3072 ? PA + (size_t)r * 3072 + col : PB + (size_t)r * 3072 + (col - 3072); *dst = f2bf(v); });
}
__device__ __forceinline__ void sample_qkv(const Ctx& F) {
    unsigned char* ws = F.ws; const bf16_t* XC = (const bf16_t*)(ws + WS_XB) + (size_t)MP * DM; const bf16_t* XBr = (const bf16_t*)(ws + WS_PROJB) + (size_t)MP * 3072;
    const bf16_t* WQ = (const bf16_t*)(ws + WS_WQ); const bf16_t* WK = (const bf16_t*)(ws + WS_WK); const bf16_t* WV = (const bf16_t*)(ws + WS_WV);
    bf16_t* Q = (bf16_t*)(ws + WS_Q) + (size_t)MP * 1024; bf16_t* Kk = (bf16_t*)(ws + WS_K) + (size_t)MP * 1024; bf16_t* Vs = (bf16_t*)(ws + WS_VS);
    sample_gemm(F, 128, 256, DM, 256,
        [=](int item, const bf16_t*& A, const bf16_t*& B) { const int which = item >> 6, it = item & 63, h = it >> 4; A = XC + h * 256; B = (which ? WK : WQ) + (size_t)h * 65536 + (size_t)(it & 15) * 16 * 256; },
        [=](int item, int r, int c, float acc) { const int which = item >> 6, it = item & 63; bf16_t* O = which ? Kk : Q; O[(size_t)r * 1024 + it * 16 + c] = f2bf(which ? acc * 0.0625f : acc); });
    sample_gemm(F, 64, 256, 3072, 256,
        [=](int item, const bf16_t*& A, const bf16_t*& B) { const int h = item >> 4; A = XBr + h * 256; B = WV + (size_t)h * 65536 + (size_t)(item & 15) * 16 * 256; },
        [=](int item, int r, int c, float acc) { Vs[(size_t)r * 1024 + item * 16 + c] = f2bf(acc); });
}
__device__ __forceinline__ void sample_outproj(const Ctx& F) {
    unsigned char* ws = F.ws; const bf16_t* Y = (const bf16_t*)(ws + WS_Y) + (size_t)MP * DMIX; const bf16_t* W = (const bf16_t*)(ws + WS_WOUT);
    const float* xs = F.in[1]; float* out = F.out + O_YS; bf16_t* X1B = (bf16_t*)(ws + WS_X1B) + (size_t)MP * DM;
    sample_gemm(F, DM / 16, DMIX, DMIX, DMIX,
        [=](int item, const bf16_t*& A, const bf16_t*& B) { A = Y; B = W + (size_t)item * 16 * DMIX; },
        [=](int item, int r, int c, float acc) { const int col = item * 16 + c; const float v = xs[(size_t)r * DM + col] + acc; out[(size_t)r * DM + col] = v; X1B[(size_t)r * DM + col] = f2bf(v); });
}
__device__ __forceinline__ void sample_ple(const Ctx& F) {
    unsigned char* ws = F.ws; const bf16_t* X1B = (const bf16_t*)(ws + WS_X1B) + (size_t)MP * DM; const bf16_t* PBs = (const bf16_t*)(ws + WS_PB) + (size_t)MP * DPLE;
    const bf16_t* WG = (const bf16_t*)(ws + WS_WPG); const bf16_t* WP = (const bf16_t*)(ws + WS_WPP); const float* bias = F.in[25];
    bf16_t* GB = (bf16_t*)(ws + WS_GB) + (size_t)MP * DM; bf16_t* EB = (bf16_t*)(ws + WS_EB) + (size_t)MP * DM;
    sample_gemm(F, DM / 16, DM, DM, DM,
        [=](int item, const bf16_t*& A, const bf16_t*& B) { A = X1B; B = WG + (size_t)item * 16 * DM; },
        [=](int item, int r, int c, float acc) { const int col = item * 16 + c; GB[(size_t)r * DM + col] = f2bf(sigmoidf_(acc + bias[col])); });
    sample_gemm(F, DM / 16, DPLE, DPLE, DPLE,
        [=](int item, const bf16_t*& A, const bf16_t*& B) { A = PBs; B = WP + (size_t)item * 16 * DPLE; },
        [=](int item, int r, int c, float acc) { EB[(size_t)r * DM + item * 16 + c] = f2bf(acc); });
}
template <class PtrF, class Ef>
__device__ __forceinline__ void sample_gemm_ks(const Ctx& F, int nitems, int K, int lda, int ldb, const PtrF& P, const Ef& E) {
    const int l15 = F.lane & 15, lq = F.lane >> 4, w = F.wave; LAS f32x4* red = (LAS f32x4*)F.lds;
    const int ks = K >> 3;
    for (int item = F.bid; item < nitems; item += F.G) {
        const bf16_t* A; const bf16_t* B; P(item, A, B);
        const bf16_t* ap = A + (size_t)l15 * lda + w * ks + 8 * lq; const bf16_t* bp = B + (size_t)l15 * ldb + w * ks + 8 * lq;
        f32x4 acc[2][4];
#pragma unroll
        for (int m = 0; m < 2; ++m)
#pragma unroll
            for (int n = 0; n < 4; ++n) acc[m][n] = (f32x4){0.f, 0.f, 0.f, 0.f};
        for (int k0 = 0; k0 < ks; k0 += 128) { bf16x8 a[4][2], b[4][4];
#pragma unroll
            for (int j = 0; j < 4; ++j) {
#pragma unroll
                for (int m = 0; m < 2; ++m) a[j][m] = (k0 + 32 * j < ks) ? *(const bf16x8*)(ap + (size_t)(16 * m) * lda + k0 + 32 * j) : (bf16x8){0, 0, 0, 0, 0, 0, 0, 0};
#pragma unroll
                for (int n = 0; n < 4; ++n) b[j][n] = (k0 + 32 * j < ks) ? *(const bf16x8*)(bp + (size_t)(16 * n) * ldb + k0 + 32 * j) : (bf16x8){0, 0, 0, 0, 0, 0, 0, 0}; }
#pragma unroll
            for (int j = 0; j < 4; ++j)
#pragma unroll
                for (int m = 0; m < 2; ++m)
#pragma unroll
                    for (int n = 0; n < 4; ++n) acc[m][n] = __builtin_amdgcn_mfma_f32_16x16x32_bf16(a[j][m], b[j][n], acc[m][n], 0, 0, 0); }
        __syncthreads();
#pragma unroll
        for (int m = 0; m < 2; ++m)
#pragma unroll
            for (int n = 0; n < 4; ++n) red[(w * 8 + m * 4 + n) * 64 + F.lane] = acc[m][n];
        __syncthreads();
        f32x4 s = red[(0 * 8 + w) * 64 + F.lane];
#pragma unroll
        for (int ww = 1; ww < 8; ++ww) s = s + red[(ww * 8 + w) * 64 + F.lane];
        const int mt = w >> 2, nt = w & 3;
#pragma unroll
        for (int r = 0; r < 4; ++r) E(item, 16 * mt + 4 * lq + r, 16 * nt + l15, s[r]);
    }
    __syncthreads();
}
__device__ __forceinline__ void sample_outproj_ks(const Ctx& F) {
    unsigned char* ws = F.ws; const bf16_t* Y = (const bf16_t*)(ws + WS_Y) + (size_t)MP * DMIX; const bf16_t* W = (const bf16_t*)(ws + WS_WOUT);
    const float* xs = F.in[1]; float* out = F.out + O_YS; bf16_t* X1B = (bf16_t*)(ws + WS_X1B) + (size_t)MP * DM;
    sample_gemm_ks(F, 64, DMIX, DMIX, DMIX,
        [=](int item, const bf16_t*& A, const bf16_t*& B) { A = Y + (size_t)(item & 3) * 32 * DMIX; B = W + (size_t)(item >> 2) * 64 * DMIX; },
        [=](int item, int r, int c, float acc) { const int row = (item & 3) * 32 + r, col = (item >> 2) * 64 + c; const float v = xs[(size_t)row * DM + col] + acc; out[(size_t)row * DM + col] = v; X1B[(size_t)row * DM + col] = f2bf(v); });
}
__device__ __forceinline__ void sample_ple_ks(const Ctx& F) {
    unsigned char* ws = F.ws; const bf16_t* X1B = (const bf16_t*)(ws + WS_X1B) + (size_t)MP * DM; const bf16_t* PBs = (const bf16_t*)(ws + WS_PB) + (size_t)MP * DPLE;
    const bf16_t* WG = (const bf16_t*)(ws + WS_WPG); const bf16_t* WP = (const bf16_t*)(ws + WS_WPP); const float* bias = F.in[25];
    bf16_t* GB = (bf16_t*)(ws + WS_GB) + (size_t)MP * DM; bf16_t* EB = (bf16_t*)(ws + WS_EB) + (size_t)MP * DM;
    sample_gemm_ks(F, 64, DM, DM, DM,
        [=](int item, const bf16_t*& A, const bf16_t*& B) { A = X1B + (size_t)(item & 3) * 32 * DM; B = WG + (size_t)(item >> 2) * 64 * DM; },
        [=](int item, int r, int c, float acc) { const int row = (item & 3) * 32 + r, col = (item >> 2) * 64 + c; GB[(size_t)row * DM + col] = f2bf(sigmoidf_(acc + bias[col])); });
    sample_gemm_ks(F, 64, DPLE, DPLE, DPLE,
        [=](int item, const bf16_t*& A, const bf16_t*& B) { A = PBs + (size_t)(item & 3) * 32 * DPLE; B = WP + (size_t)(item >> 2) * 64 * DPLE; },
        [=](int item, int r, int c, float acc) { const int row = (item & 3) * 32 + r, col = (item >> 2) * 64 + c; EB[(size_t)row * DM + col] = f2bf(acc); });
}
#define XB_TMO      128
#define XB_XCNT(j)  (256  + 64 * (j))
#define XB_XSUB(j)  (1280 + 64 * (j))
#define XB_XGEN(j)  (2304 + 64 * (j))
#define XB_TOP      3328
#define XB_TOPGEN   3392
#define XCD_BAR_WORDS 3456
#define XB_SPIN_CAP (1u << 18)
__device__ __forceinline__ unsigned xb_ld(unsigned* p)              { return __hip_atomic_load(p, __ATOMIC_RELAXED, __HIP_MEMORY_SCOPE_AGENT); }
__device__ __forceinline__ unsigned xb_add(unsigned* p, unsigned v) { return __hip_atomic_fetch_add(p, v, __ATOMIC_RELAXED, __HIP_MEMORY_SCOPE_AGENT); }
__device__ __forceinline__ unsigned xb_xcc_id() { return (unsigned)__builtin_amdgcn_s_getreg((3 << 11) | 20) & 0xFu; }
#define XB_SPIN(cond, bar) do { unsigned _sp = 0; while (cond) { __builtin_amdgcn_s_sleep(1); \
    if ((++_sp & 255u) == 0u) { if (xb_ld(&(bar)[XB_TMO])) break; if (_sp > XB_SPIN_CAP) { atomicAdd(&(bar)[XB_TMO], 1u); break; } } } } while (0)
struct XcdBarrier { unsigned* bar; unsigned x; volatile LAS unsigned* st; };
__device__ __forceinline__ XcdBarrier xcd_barrier_post(unsigned* bar, volatile LAS unsigned* st) {
    XcdBarrier b; b.bar = bar; b.x = xb_xcc_id(); b.st = st;
    if (threadIdx.x == 0) (void)xb_add(&bar[XB_XCNT(b.x)], 1u);
    return b;
}
__device__ __forceinline__ void xcd_barrier_complete(unsigned* bar, unsigned x, unsigned& nloc, unsigned& nx) {
    const unsigned G = gridDim.x * gridDim.y * gridDim.z;
    unsigned sum, cnt, mine, sp = 0u;
    for (;;) {
        sum = 0u; cnt = 0u; mine = 0u;
#pragma unroll
        for (unsigned j = 0; j < 16; ++j) { const unsigned c = xb_ld(&bar[XB_XCNT(j)]); sum += c; cnt += (c > 0u) ? 1u : 0u; mine = (j == x) ? c : mine; }
        if (sum == G) break;
        __builtin_amdgcn_s_sleep(1);
        if ((++sp & 255u) == 0u) { if (xb_ld(&bar[XB_TMO])) break; if (sp > XB_SPIN_CAP) { atomicAdd(&bar[XB_TMO], 1u); break; } }
    }
    nloc = mine > 0u ? mine : 1u; nx = cnt > 0u ? cnt : 1u;
}
__device__ __forceinline__ void xcd_barrier(const XcdBarrier& b) {
    asm volatile("s_waitcnt vmcnt(0)" ::: "memory");
    __syncthreads();
    if (threadIdx.x == 0) {
        unsigned* bar = b.bar;
        __builtin_amdgcn_s_waitcnt(0);
        unsigned nloc = b.st[0], nx = b.st[1];
        if (nloc == 0u) { xcd_barrier_complete(bar, b.x, nloc, nx); b.st[0] = nloc; b.st[1] = nx; }
        const unsigned old = xb_add(&bar[XB_XSUB(b.x)], 1u);
        const unsigned gen = old / nloc;
        if (old + 1u == (gen + 1u) * nloc) {
            __builtin_amdgcn_fence(__ATOMIC_RELEASE, "agent");
            asm volatile("s_waitcnt vmcnt(0)" ::: "memory");
            const unsigned og = xb_add(&bar[XB_TOP], 1u);
            const unsigned tg = og / nx;
            if (og + 1u == (tg + 1u) * nx) xb_add(&bar[XB_TOPGEN], 1u);
            else XB_SPIN(xb_ld(&bar[XB_TOPGEN]) == tg, bar);
            __builtin_amdgcn_fence(__ATOMIC_ACQUIRE, "agent");
            xb_add(&bar[XB_XGEN(b.x)], 1u);
            asm volatile("s_waitcnt vmcnt(0)" ::: "memory");
        } else {
            XB_SPIN(xb_ld(&bar[XB_XGEN(b.x)]) == gen, bar);
            __builtin_amdgcn_fence(__ATOMIC_ACQUIRE, "agent");
            asm volatile("s_waitcnt vmcnt(0)" ::: "memory");
        }
    }
    __syncthreads();
}
__global__ void __launch_bounds__(512, 2) mega(Args args) {
    MAKE_CTX();
    volatile LAS unsigned* MISC = (volatile LAS unsigned*)(F.lds + 131072 + 320);
    if (F.tid < 32) MISC[F.tid] = 0u;
    __syncthreads();
    const XcdBarrier bar = xcd_barrier_post((unsigned*)(ws + WS_CTL), MISC + 8);
#define GRID_SYNC() xcd_barrier(bar)
    p0_prologue(F);      GRID_SYNC();
    sample_inproj(F); p1_inproj(F); GRID_SYNC();
    p2a_conv_gates(F); p2b_spatial_units(F); GRID_SYNC();
    p2b_mscan(F); p3_s12(F); GRID_SYNC();
    p3_qkv(F);           GRID_SYNC();
    if (F.bid & 1) { p5s_sample(F); p4_scores_dc(F); } else { p4_scores_dc(F); p5s_sample(F); } GRID_SYNC();
    p5_scan_sample(F);   GRID_SYNC();
    p6_hout(F);          GRID_SYNC();
    sample_outproj_ks(F); p7_outproj(F); GRID_SYNC();
    p8_ple(F);           GRID_SYNC();
    p9_final(F);
}

extern "C" void kernel_launch(void* const* d_in, const int* in_sizes, int n_in, void* d_out, int out_size, void* d_ws, size_t ws_size, hipStream_t stream) {
    static int grid = 0;
    if (grid == 0) {
        if (n_in != 29 || (size_t)out_size != O_END || ws_size < WS_END) { fprintf(stderr, "kernel_launch: unexpected shapes (n_in %d out %d ws %zu)\n", n_in, out_size, ws_size); grid = -1; return; }
        int dev = 0, cus = 0, per_cu = 0;
        if (hipGetDevice(&dev) != hipSuccess || hipDeviceGetAttribute(&cus, hipDeviceAttributeMultiprocessorCount, dev) != hipSuccess) { grid = -1; return; }
        if (hipFuncSetAttribute((const void*)mega, hipFuncAttributeMaxDynamicSharedMemorySize, LDS_BYTES) != hipSuccess) { fprintf(stderr, "kernel_launch: hipFuncSetAttribute failed\n"); grid = -1; return; }
        if (hipOccupancyMaxActiveBlocksPerMultiprocessor(&per_cu, (const void*)mega, 512, LDS_BYTES) != hipSuccess || per_cu < 1) { fprintf(stderr, "kernel_launch: occupancy query says %d\n", per_cu); grid = -1; return; }
        (void)hipGetLastError();
        grid = cus;
        if (grid != 256) { fprintf(stderr, "kernel_launch: this kernel is laid out for 256 CUs, got %d\n", grid); grid = -1; return; }
    }
    if (grid < 0) return;
    if (hipMemsetAsync((unsigned char*)d_ws + WS_CTL, 0, 16384, stream) != hipSuccess) { fprintf(stderr, "kernel_launch: memset failed\n"); return; }
    Args a{};
    for (int i = 0; i < 29; ++i) a.in[i] = (const float*)d_in[i];
    a.out = (float*)d_out; a.ws = (unsigned char*)d_ws;
    void* kargs[] = {&a};
    hipError_t e = hipLaunchCooperativeKernel((const void*)mega, dim3(grid), dim3(512), kargs, LDS_BYTES, stream);
    if (e != hipSuccess) fprintf(stderr, "kernel_launch: cooperative launch failed: %s (grid %d)\n", hipGetErrorString(e), grid);
}
```

```cpp
#include <hip/hip_runtime.h>
#include <hip/hip_cooperative_groups.h>
#include <cstdio>
#include <cstdint>
namespace cg = cooperative_groups;

#define LAS __attribute__((address_space(3)))
typedef unsigned short bf16_t;
typedef short bf16x8 __attribute__((ext_vector_type(8)));
typedef float f32x4 __attribute__((ext_vector_type(4)));
typedef float f32x2 __attribute__((ext_vector_type(2)));
typedef unsigned u32x4 __attribute__((ext_vector_type(4)));
typedef unsigned u32x2 __attribute__((ext_vector_type(2)));

constexpr int DM = 1024, SEQ = 2048, NB = 8, MP = NB * SEQ, MS = 128, MA = MP + 256, NTILE = MA / 256;
constexpr int NIN = 6144, WA = 1024, WB = 1024, HA = 8, DHA = 128, HB = 4, DHB = 256, DPLE = 256, DMIX = 2048;
constexpr int LC = 256, NCH = SEQ / LC;
constexpr int NUNIT = NB * HB * NCH;
constexpr float EPS = 1e-6f;

constexpr size_t O_Y = 0, O_YS = 16777216, O_CP = 16908288, O_NP = 19005440, O_MP = 19013632, O_CVP = 19013664, O_CS = 19038240, O_NS = 52592672, O_MS = 52723744, O_CVS = 52724256, O_VS = 53117472, O_END = 53248544;

constexpr size_t MiB = 1u << 20;
constexpr size_t WS_CTL = 0, WS_WIN = 1 * MiB, WS_WQ = 13 * MiB, WS_WK = WS_WQ + MiB / 2, WS_WV = 14 * MiB, WS_WOUT = WS_WV + MiB / 2, WS_WPG = WS_WOUT + 4 * MiB, WS_WPP = WS_WPG + 2 * MiB,
    WS_WSP = 21 * MiB, WS_WG = WS_WSP + MiB / 4, WS_RS = WS_WG + MiB / 4, WS_GLI = 22 * MiB, WS_GLF = WS_GLI + MiB / 2, WS_DA = 23 * MiB, WS_DR = WS_DA + MiB / 2, WS_DG = 24 * MiB, WS_DEM = WS_DG + MiB / 2,
    WS_DW = 25 * MiB, WS_QN = WS_DW + MiB / 2, WS_DENP = 26 * MiB, WS_DN = 27 * MiB, WS_VS = WS_DN + MiB / 2, WS_PB = 28 * MiB, WS_XB = 37 * MiB, WS_PROJA = 70 * MiB, WS_PROJB = 168 * MiB,
    WS_PQ = 266 * MiB, WS_VC = 330 * MiB, WS_Y = 394 * MiB, WS_XB2 = 460 * MiB, WS_END = 493 * MiB;
constexpr size_t WS_WGB = WS_RS + MiB / 8;
constexpr size_t WS_Q = WS_PROJA, WS_K = WS_Q + 33 * MiB, WS_WKT = WS_K + 33 * MiB;
constexpr size_t WS_X1B = WS_PROJA, WS_GB = WS_X1B + 33 * MiB, WS_EB = WS_GB + 33 * MiB;
static_assert(WS_WKT + 32 * MiB <= WS_PROJB && WS_EB + 33 * MiB <= WS_PQ, "ws map");

__device__ __forceinline__ unsigned cvt_pk_bf16(float lo, float hi) { unsigned r; asm volatile("v_cvt_pk_bf16_f32 %0, %1, %2" : "=v"(r) : "v"(lo), "v"(hi)); return r; }
__device__ __forceinline__ float bf_lo(unsigned w) { return __uint_as_float(w << 16); }
__device__ __forceinline__ float bf_hi(unsigned w) { return __uint_as_float(w & 0xffff0000u); }
__device__ __forceinline__ float bf2f(bf16_t b) { return __uint_as_float(((unsigned)b) << 16); }
__device__ __forceinline__ bf16_t f2bf(float f) { return (bf16_t)(cvt_pk_bf16(f, 0.f) & 0xffffu); }
__device__ __forceinline__ float fast_exp(float x) { return __builtin_amdgcn_exp2f(x * 1.4426950408889634f); }
__device__ __forceinline__ float sigmoidf_(float x) { return __builtin_amdgcn_rcpf(1.0f + fast_exp(-x)); }
__device__ __forceinline__ float siluf_(float x) { return x * sigmoidf_(x); }
__device__ __forceinline__ f32x2 gelu_pk(f32x2 v) {
    const f32x2 av = __builtin_elementwise_abs(v), d = av * 0.2316418882f + 1.0f;
    f32x2 t; t.x = __builtin_amdgcn_rcpf(d.x); t.y = __builtin_amdgcn_rcpf(d.y);
    f32x2 q = t * 0.5307027145f + (-0.7265760135f); q = q * t + 0.7107068705f; q = q * t + (-0.142248368f); q = q * t + 0.127414796f; q = q * t;
    const f32x2 s = (v * v) * (-0.72134752044f);
    f32x2 e; e.x = __builtin_amdgcn_exp2f(s.x); e.y = __builtin_amdgcn_exp2f(s.y);
    const f32x2 m = v * (q * e), r = v - m;
    f32x2 o; o.x = v.x < 0.f ? m.x : r.x; o.y = v.y < 0.f ? m.y : r.y; return o;
}
__device__ __forceinline__ float wave_sum(float v) {
#pragma unroll
    for (int o = 1; o < 64; o <<= 1) v += __shfl_xor(v, o);
    return v;
}
#define LDS_WAIT() asm volatile("s_waitcnt lgkmcnt(0)" ::: "memory")

namespace pg8 {
constexpr int BM = 256, BK = 64, HALF = 128, HTB = HALF * BK * 2, STAGE_BYTES = 8 * HTB;
__host__ __device__ __forceinline__ int lds_byte(int r, int c) { const int st = (r >> 4) * 2 + (c >> 5), rr = r & 15, cc = c & 31, ob = rr * 64 + cc * 2; return st * 1024 + (ob ^ (((ob >> 9) & 1) << 5)); }
__host__ __device__ __forceinline__ void stage_rc(int b, int& R, int& C) { const int st = b / 1024, sb = b % 1024, swz = sb ^ (((sb >> 9) & 1) << 5); R = (st >> 1) * 16 + swz / 64; C = (st & 1) * 32 + (swz % 64) / 2; }
__host__ __device__ __forceinline__ int perm32(int rho) { const int n = rho >> 4, i = rho & 15; return 8 * (i >> 2) + 4 * n + (i & 3); }

struct Unit { const char* a; const char* b; int pm, pn, aux; };
struct Gemm { int lda, ldb, K; };

template <class Epi, class Sched, bool ALIGN_EPI = true, bool SP2 = true>
__device__ __forceinline__ void gemm_phase(LAS unsigned char* lds, const Gemm g, const Sched& S, const Epi& E) {
    int tid_ = threadIdx.x; asm volatile("" : "+v"(tid_));
    const int tid = tid_, wid = __builtin_amdgcn_readfirstlane(tid >> 6), lane = tid & 63, wr = wid >> 2, wc = wid & 3, fr = lane & 15, fq = lane >> 4;
    int K_ = g.K; asm volatile("" : "+s"(K_)); const int K = K_, nt = K / BK; (void)K;
    unsigned voffA[2], voffB[2];
#pragma unroll
    for (int i = 0; i < 2; ++i) { int R, C; stage_rc(tid * 16 + i * 8192, R, C); const int Rb = Epi::PERM ? ((R & ~31) + perm32(R & 31)) : R;
        voffA[i] = (unsigned)(R * g.lda + C) * 2u; voffB[i] = (unsigned)(Rb * g.ldb + C) * 2u; }
    const size_t kstep = (size_t)(BK * 2);
    const size_t hstepA = (size_t)HALF * g.lda * 2, hstepB = (size_t)HALF * g.ldb * 2;
    const unsigned ldsw = (unsigned)wid * 1024u;
    const int aoff = lds_byte(wr * 64 + fr, fq * 8), boff = lds_byte(wc * 32 + fr, fq * 8);
#define PG8_SA(b, h) (((b) * 2 + (h)) * HTB)
#define PG8_SB(b, h) ((4 + (b) * 2 + (h)) * HTB)
#define PG8_STAGE(bufoff, gbase, voff) do { _Pragma("unroll") for (int _i = 0; _i < 2; ++_i) \
        __builtin_amdgcn_global_load_lds((const unsigned*)((const char*)(gbase) + (voff)[_i]), (LAS unsigned*)(lds + (bufoff) + ldsw + _i * 8192), 16, 0, 0); } while (0)
#define PG8_LDA(dst, b, h) do { _Pragma("unroll") for (int m = 0; m < 4; ++m) _Pragma("unroll") for (int k = 0; k < 2; ++k) dst[m][k] = *(const LAS bf16x8*)(lds + PG8_SA(b, h) + aoff + m * 2048 + k * 1024); } while (0)
#define PG8_LDB(dst, b, h) do { _Pragma("unroll") for (int n = 0; n < 2; ++n) _Pragma("unroll") for (int k = 0; k < 2; ++k) dst[n][k] = *(const LAS bf16x8*)(lds + PG8_SB(b, h) + boff + n * 2048 + k * 1024); } while (0)
#define PG8_MMA(ai, bj, At, Bt) do { __builtin_amdgcn_s_setprio(1); _Pragma("unroll") for (int m = 0; m < 4; ++m) _Pragma("unroll") for (int n = 0; n < 2; ++n) _Pragma("unroll") for (int k = 0; k < 2; ++k) \
        acc[ai][bj][m][n] = __builtin_amdgcn_mfma_f32_16x16x32_bf16(Bt[n][k], At[m][k], acc[ai][bj][m][n], 0, 0, 0); __builtin_amdgcn_s_setprio(0); } while (0)
#define PG8_WAIT_V(n) asm volatile("s_waitcnt vmcnt(" #n ")" ::: "memory")
#define PG8_WAIT_L(n) asm volatile("s_waitcnt lgkmcnt(" #n ")" ::: "memory")
#define PG8_BAR __builtin_amdgcn_s_barrier()
#define PG8_SCHED __builtin_amdgcn_sched_barrier(0)
    Unit cur, nxt; int ui = 0;
    if (!S.next(0, cur)) return;
    f32x4 acc[2][2][4][2];
#pragma unroll
    for (int a = 0; a < 2; ++a)
#pragma unroll
        for (int b = 0; b < 2; ++b)
#pragma unroll
            for (int m = 0; m < 4; ++m)
#pragma unroll
                for (int n = 0; n < 2; ++n) acc[a][b][m][n] = (f32x4){0.f, 0.f, 0.f, 0.f};
    bf16x8 At[4][2], B0[2][2], B1[2][2];
    const char* cA = cur.a; const char* cB = cur.b;
    if constexpr (SP2) {
        PG8_STAGE(PG8_SB(0, 0), cB, voffB); PG8_STAGE(PG8_SB(0, 1), cB + hstepB, voffB); PG8_STAGE(PG8_SA(0, 0), cA, voffA); PG8_STAGE(PG8_SA(0, 1), cA + hstepA, voffA);
        if (wr == 1) PG8_BAR;
        PG8_WAIT_V(2); PG8_BAR;
        PG8_STAGE(PG8_SB(1, 0), cB + kstep, voffB); PG8_STAGE(PG8_SA(1, 0), cA + kstep, voffA); PG8_STAGE(PG8_SB(1, 1), cB + hstepB + kstep, voffB);
        PG8_WAIT_V(6); PG8_BAR;
    } else {
        PG8_STAGE(PG8_SB(0, 0), cB, voffB); PG8_STAGE(PG8_SA(0, 0), cA, voffA); PG8_STAGE(PG8_SB(0, 1), cB + hstepB, voffB); PG8_STAGE(PG8_SA(0, 1), cA + hstepA, voffA);
        if (wr == 1) PG8_BAR;
        PG8_WAIT_V(4); PG8_BAR;
        PG8_STAGE(PG8_SB(1, 0), cB + kstep, voffB); PG8_STAGE(PG8_SA(1, 0), cA + kstep, voffA); PG8_STAGE(PG8_SB(1, 1), cB + hstepB + kstep, voffB);
        PG8_WAIT_V(6); PG8_BAR;
    }
    for (;;) {
        const bool has_next = S.next(ui + 1, nxt);
        const char* nA = has_next ? nxt.a : cA; const char* nB = has_next ? nxt.b : cB;
#pragma unroll 1
        for (int t = 0; t < nt; t += 2) {
            const bool last = (t == nt - 2);
            const char* a1 = cA + (size_t)(t + 1) * kstep;
            const char* a2 = last ? nA : cA + (size_t)(t + 2) * kstep; const char* b2 = last ? nB : cB + (size_t)(t + 2) * kstep;
            const char* a3 = a2 + kstep; const char* b3 = b2 + kstep;
            if constexpr (SP2) {
            PG8_LDB(B0, 0, 0); PG8_LDB(B1, 0, 1); PG8_SCHED; PG8_LDA(At, 0, 0); PG8_STAGE(PG8_SA(1, 1), a1 + hstepA, voffA);
            PG8_WAIT_V(8); PG8_WAIT_L(0); PG8_BAR; PG8_MMA(0, 0, At, B0); PG8_MMA(0, 1, At, B1); PG8_BAR; PG8_SCHED;
            PG8_LDA(At, 0, 1); PG8_STAGE(PG8_SB(0, 0), b2, voffB); PG8_STAGE(PG8_SB(0, 1), b2 + hstepB, voffB); PG8_STAGE(PG8_SA(0, 0), a2, voffA);
            PG8_WAIT_V(8); PG8_WAIT_L(0); PG8_BAR; PG8_MMA(1, 0, At, B0); PG8_MMA(1, 1, At, B1); PG8_BAR; PG8_SCHED;
            PG8_LDB(B0, 1, 0); PG8_LDB(B1, 1, 1); PG8_SCHED; PG8_LDA(At, 1, 0); PG8_STAGE(PG8_SA(0, 1), a2 + hstepA, voffA);
            PG8_WAIT_V(8); PG8_WAIT_L(0); PG8_BAR; PG8_MMA(0, 0, At, B0); PG8_MMA(0, 1, At, B1); PG8_BAR; PG8_SCHED;
            PG8_LDA(At, 1, 1); PG8_STAGE(PG8_SB(1, 0), b3, voffB); PG8_STAGE(PG8_SB(1, 1), b3 + hstepB, voffB); PG8_STAGE(PG8_SA(1, 0), a3, voffA);
            PG8_WAIT_V(8); PG8_WAIT_L(0); PG8_BAR; PG8_MMA(1, 0, At, B0); PG8_MMA(1, 1, At, B1); PG8_BAR; PG8_SCHED;
            } else {
            PG8_LDB(B0, 0, 0); PG8_SCHED; PG8_LDA(At, 0, 0); PG8_STAGE(PG8_SA(1, 1), a1 + hstepA, voffA);
            PG8_WAIT_L(8); PG8_BAR; PG8_WAIT_L(0); PG8_MMA(0, 0, At, B0); PG8_BAR; PG8_SCHED;
            PG8_LDB(B1, 0, 1); PG8_STAGE(PG8_SB(0, 0), b2, voffB);
            PG8_BAR; PG8_WAIT_L(0); PG8_MMA(0, 1, At, B1); PG8_BAR;
            PG8_LDA(At, 0, 1); PG8_STAGE(PG8_SA(0, 0), a2, voffA);
            PG8_BAR; PG8_WAIT_L(0); PG8_MMA(1, 0, At, B0); PG8_BAR; PG8_SCHED;
            PG8_STAGE(PG8_SB(0, 1), b2 + hstepB, voffB);
            PG8_WAIT_V(6); PG8_BAR; PG8_MMA(1, 1, At, B1); PG8_BAR;
            PG8_LDB(B0, 1, 0); PG8_SCHED; PG8_LDA(At, 1, 0); PG8_STAGE(PG8_SA(0, 1), a2 + hstepA, voffA);
            PG8_WAIT_L(8); PG8_BAR; PG8_WAIT_L(0); PG8_MMA(0, 0, At, B0); PG8_BAR; PG8_SCHED;
            PG8_LDB(B1, 1, 1); PG8_STAGE(PG8_SB(1, 0), b3, voffB);
            PG8_BAR; PG8_WAIT_L(0); PG8_MMA(0, 1, At, B1); PG8_BAR;
            PG8_LDA(At, 1, 1); PG8_STAGE(PG8_SA(1, 0), a3, voffA);
            PG8_BAR; PG8_WAIT_L(0); PG8_MMA(1, 0, At, B0); PG8_BAR; PG8_SCHED;
            PG8_STAGE(PG8_SB(1, 1), b3 + hstepB, voffB);
            PG8_WAIT_V(6); PG8_BAR; PG8_MMA(1, 1, At, B1); PG8_BAR;
            }
        }
        if constexpr (ALIGN_EPI) { if (wr == 0) PG8_BAR; }
        if constexpr (!Epi::AFTER_DRAIN) { E(acc, cur, wr, wc, fr, fq); }
        if (!has_next) break;
#pragma unroll
        for (int a = 0; a < 2; ++a)
#pragma unroll
            for (int b = 0; b < 2; ++b)
#pragma unroll
                for (int m = 0; m < 4; ++m)
#pragma unroll
                    for (int n = 0; n < 2; ++n) acc[a][b][m][n] = (f32x4){0.f, 0.f, 0.f, 0.f};
        cur = nxt; cA = nA; cB = nB; ++ui;
        if constexpr (ALIGN_EPI) { if (wr == 1) PG8_BAR; }
    }
    PG8_WAIT_V(0);
    if constexpr (!ALIGN_EPI) { if (wr == 0) PG8_BAR; }
    PG8_BAR;
    if constexpr (Epi::AFTER_DRAIN) { E.fused(acc, cur, wr, wc, fr, fq, lds, wid, lane); }
#undef PG8_SA
#undef PG8_SB
#undef PG8_STAGE
#undef PG8_LDA
#undef PG8_LDB
#undef PG8_MMA
#undef PG8_WAIT_V
#undef PG8_WAIT_L
#undef PG8_BAR
#undef PG8_SCHED
}
}
using pg8::Unit; using pg8::Gemm;

constexpr int LDS_BYTES = 147456;
struct Args { const float* in[29]; float* out; unsigned char* ws; };

struct Ctx {
    LAS unsigned char* lds; int tid, lane, wave, G, bid, gw, NGW;
    const float* const* in; float* out; unsigned char* ws;
};

__device__ __forceinline__ void p0_transpose_item(const float* W, int ldw, bf16_t* WT, int ldt, const float* kscale, LAS float* scr, int kb, int nb, int lane) {
    const int k0 = 64 * kb, n0 = 32 * nb;
#pragma unroll 8
    for (int i = 0; i < 32; ++i) { const int kk = 2 * i + (lane >> 5); float v = __builtin_nontemporal_load(W + (size_t)(k0 + kk) * ldw + n0 + (lane & 31)); if (kscale) v *= kscale[k0 + kk]; scr[kk * 33 + (lane & 31)] = v; }
    LDS_WAIT(); asm volatile("" ::: "memory");
    const int c = lane & 7;
#pragma unroll
    for (int j = 0; j < 4; ++j) { const int n = (lane >> 3) + 8 * j; const LAS float* s = scr + (8 * c) * 33 + n;
        u32x4 o; o.x = cvt_pk_bf16(s[0 * 33], s[1 * 33]); o.y = cvt_pk_bf16(s[2 * 33], s[3 * 33]); o.z = cvt_pk_bf16(s[4 * 33], s[5 * 33]); o.w = cvt_pk_bf16(s[6 * 33], s[7 * 33]);
        *(u32x4*)(WT + (size_t)(n0 + n) * ldt + k0 + 8 * c) = o; }
    LDS_WAIT(); asm volatile("" ::: "memory");
}

__device__ __forceinline__ void p0_prologue(const Ctx& F0) { Ctx F = F0; asm volatile("" : "+v"(F.tid), "+v"(F.lane));
    LAS float* scr = (LAS float*)(F.lds + F.wave * 16384);
    unsigned char* ws = F.ws;
    constexpr int I_WIN = 16 * 192, I_QKV = 12 * 4 * 8, I_WOUT = 32 * 32, I_WPG = 16 * 32, I_WPP = 4 * 32;
    constexpr int I_T = I_WIN + I_QKV + I_WOUT + I_WPG + I_WPP;
    constexpr int I_X = MA, I_P = MA, I_SP = 1024, I_WG = 1024, I_YPAD = 128;
    constexpr int NITEMS = I_T + I_X + I_P + I_SP + I_WG + I_YPAD;
    for (int it = F.gw; it < NITEMS; it += F.NGW) {
        int r = it;
        if (r < I_T) {
            if (r < I_WIN) { p0_transpose_item(F.in[9], NIN, (bf16_t*)(ws + WS_WIN), DM, F.in[8], scr, r / 192, r % 192, F.lane); continue; } r -= I_WIN;
            if (r < I_QKV) { const int mat = r / 32, rr = r % 32, which = mat / 4, h = mat % 4;
                const float* W = F.in[16 + which] + (size_t)h * 65536; bf16_t* WT = (bf16_t*)(ws + (which == 0 ? WS_WQ : which == 1 ? WS_WK : WS_WV)) + (size_t)h * 65536;
                p0_transpose_item(W, 256, WT, 256, nullptr, scr, rr / 8, rr % 8, F.lane); continue; } r -= I_QKV;
            if (r < I_WOUT) { p0_transpose_item(F.in[23], DM, (bf16_t*)(ws + WS_WOUT), DMIX, nullptr, scr, r / 32, r % 32, F.lane); continue; } r -= I_WOUT;
            if (r < I_WPG) { p0_transpose_item(F.in[24], DM, (bf16_t*)(ws + WS_WPG), DM, nullptr, scr, r / 32, r % 32, F.lane); continue; } r -= I_WPG;
            p0_transpose_item(F.in[26], DM, (bf16_t*)(ws + WS_WPP), DPLE, nullptr, scr, r / 32, r % 32, F.lane); continue;
        }
        r -= I_T;
        if (r < I_X) {
            bf16_t* orow = (bf16_t*)(ws + WS_XB) + (size_t)r * DM; float* rs = (float*)(ws + WS_RS);
            unsigned long long* o8 = (unsigned long long*)orow + F.lane;
            if (r >= MP + MS) {
#pragma unroll
                for (int j = 0; j < 4; ++j) o8[64 * j] = 0ull;
                if (F.lane == 0) rs[r] = 0.f; continue; }
            const float* xrow = r < MP ? F.in[0] + (size_t)r * DM : F.in[1] + (size_t)(r - MP) * DM;
            const f32x4* xr = (const f32x4*)xrow + F.lane; f32x4 v[4]; float s = 0.f;
#pragma unroll
            for (int j = 0; j < 4; ++j) { v[j] = xr[64 * j]; s += (v[j].x * v[j].x + v[j].y * v[j].y) + (v[j].z * v[j].z + v[j].w * v[j].w); }
            s = wave_sum(s);
#pragma unroll
            for (int j = 0; j < 4; ++j) o8[64 * j] = (unsigned long long)cvt_pk_bf16(v[j].x, v[j].y) | ((unsigned long long)cvt_pk_bf16(v[j].z, v[j].w) << 32);
            if (F.lane == 0) rs[r] = 1.0f / sqrtf(s * (1.0f / DM) + EPS);
            continue;
        }
        r -= I_X;
        if (r < I_P) {
            unsigned long long* o8 = (unsigned long long*)((bf16_t*)(ws + WS_PB) + (size_t)r * DPLE) + F.lane;
            if (r >= MP + MS) { o8[0] = 0ull; continue; }
            const float* prow = r < MP ? F.in[6] + (size_t)r * DPLE : F.in[7] + (size_t)(r - MP) * DPLE;
            const f32x4 v = __builtin_nontemporal_load((const f32x4*)prow + F.lane);
            o8[0] = (unsigned long long)cvt_pk_bf16(v.x, v.y) | ((unsigned long long)cvt_pk_bf16(v.z, v.w) << 32);
            continue;
        }
        r -= I_P;
        if (r < I_SP) {
            const int t = r & 127; const float* wrow = F.in[12] + (size_t)r * 128; const f32x2 v = ((const f32x2*)wrow)[F.lane];
            const int s0 = 2 * F.lane; ((unsigned*)((bf16_t*)(ws + WS_WSP) + (size_t)r * 128))[F.lane] = cvt_pk_bf16(s0 <= t ? v.x : 0.f, s0 + 1 <= t ? v.y : 0.f);
            continue;
        }
        r -= I_SP;
        if (r < I_WG) {
            const int i = r, h = i >> 8, d = i & 255; const float* wif = F.in[19];
            const f32x4 wq4 = *(const f32x4*)(F.in[16] + ((size_t)h * 256 + d) * 256 + 4 * F.lane), wk4 = *(const f32x4*)(F.in[17] + ((size_t)h * 256 + d) * 256 + 4 * F.lane), wv4 = *(const f32x4*)(F.in[18] + ((size_t)h * 256 + d) * 256 + 4 * F.lane);
            float sx[8], sb[8];
#pragma unroll
            for (int j = 0; j < 8; ++j) { sx[j] = 0.f; sb[j] = 0.f; }
#pragma unroll
            for (int e = 0; e < 4; ++e) { const size_t rq = (size_t)(h * 256 + 4 * F.lane + e) * 8;
                const f32x4 q0 = *(const f32x4*)(wif + rq), q1 = *(const f32x4*)(wif + rq + 4), k0 = *(const f32x4*)(wif + 8192 + rq), k1 = *(const f32x4*)(wif + 8192 + rq + 4), v0 = *(const f32x4*)(wif + 16384 + rq), v1 = *(const f32x4*)(wif + 16384 + rq + 4);
#pragma unroll
                for (int j = 0; j < 4; ++j) { sx[j] += wq4[e] * q0[j] + wk4[e] * k0[j]; sx[4 + j] += wq4[e] * q1[j] + wk4[e] * k1[j]; sb[j] += wv4[e] * v0[j]; sb[4 + j] += wv4[e] * v1[j]; } }
#pragma unroll
            for (int j = 0; j < 8; ++j) { sx[j] = wave_sum(sx[j]); sb[j] = wave_sum(sb[j]); }
            float s = 0.f;
#pragma unroll
            for (int j = 0; j < 8; ++j) { s = (F.lane == j) ? sx[j] : s; s = (F.lane == 8 + j) ? sb[j] : s; }
            if (F.lane < 16) ((float*)(ws + WS_WG))[(size_t)i * 16 + F.lane] = s;
            if (F.lane < 16) { bf16_t* wgb = (bf16_t*)(ws + WS_WGB) + (size_t)(F.lane >> 3) * 16384 + (size_t)(F.lane & 7) * 1024 + i; wgb[0] = f2bf(s); wgb[8 * 1024] = 0; }
            continue;
        }
        r -= I_WG;
        {
            u32x4* yrow = (u32x4*)((bf16_t*)(ws + WS_Y) + (size_t)(MP + MS + r) * DMIX) + F.lane;
#pragma unroll
            for (int j = 0; j < 4; ++j) yrow[64 * j] = (u32x4){0u, 0u, 0u, 0u};
        }
    }
}

struct OrderRowMajor {
    int nM, nN, n, G, c; const char* A; const char* B; size_t astep, bstep;
    __device__ __forceinline__ bool next(int i, Unit& u) const {
        const int L = i * G + c; if (L >= n) return false;
        u.pm = L / nN; u.pn = L % nN; u.aux = 0; u.a = A + (size_t)u.pm * astep; u.b = B + (size_t)u.pn * bstep; return true;
    }
};
struct OrderPanel4 {
    int n, G, c; const char* A; const char* B; size_t astep, bstep;
    __device__ __forceinline__ bool next(int i, Unit& u) const {
        const int L = i * G + c; if (L >= n) return false;
        if (L < 256) { const int x = L & 7, j = L >> 3; u.pm = x * 8 + (j >> 2); u.pn = j & 3; } else { u.pm = 64; u.pn = L - 256; }
        u.aux = 0; u.a = A + (size_t)u.pm * astep; u.b = B + (size_t)u.pn * bstep; return true;
    }
};
struct OrderProjSkip {
    int G, c; const char* A; const char* B; size_t astep, bstep;
    __device__ __forceinline__ bool next(int i, Unit& u) const {
        if (c < 4) return false; const int cp = c - 4; const int L = i == 0 ? cp : (i == 1 && cp < 8 ? 252 + cp : -1); if (L < 0) return false;
        if (L < 256) { const int x = L & 7, j = L >> 3; u.pm = x * 8 + (j >> 2); u.pn = j & 3; } else { u.pm = 64; u.pn = L - 256; }
        u.aux = 0; u.a = A + (size_t)u.pm * astep; u.b = B + (size_t)u.pn * bstep; return true;
    }
};
struct OrderXcd {
    int nM, nN, n, G, c; const char* A; const char* B; size_t astep, bstep;
    __device__ __forceinline__ bool next(int i, Unit& u) const {
        const int L = i * G + c; if (L >= n) return false;
        int wgid = L; { const int q = n / 8, r = n % 8, xcd = wgid % 8, off = wgid / 8; wgid = (xcd < r ? xcd * (q + 1) : r * (q + 1) + (xcd - r) * q) + off; }
        const int nig = 8 * nN, gid = wgid / nig, fm = gid * 8, gsz = (nM - fm) < 8 ? (nM - fm) : 8;
        u.pm = fm + ((wgid % nig) % gsz); u.pn = (wgid % nig) / gsz; u.aux = 0; u.a = A + (size_t)u.pm * astep; u.b = B + (size_t)u.pn * bstep; return true;
    }
};
struct EpiInProj {
    static constexpr bool PERM = true, AFTER_DRAIN = false;
    bf16_t* PA; bf16_t* PB; const float* rs;
    template <int KIND> __device__ __forceinline__ void run(const f32x4 (&acc)[2][2][4][2], bf16_t* base, int row0, int col0) const {
#pragma unroll
        for (int ai = 0; ai < 2; ++ai)
#pragma unroll
            for (int m = 0; m < 4; ++m) { const int row = row0 + ai * 128 + m * 16; const float s = rs[row]; bf16_t* rowp = base + (size_t)row * 3072 + col0;
#pragma unroll
                for (int bj = 0; bj < 2; ++bj) { f32x4 v0 = acc[ai][bj][m][0] * s, v1 = acc[ai][bj][m][1] * s;
                    if (KIND == 0) { f32x2 a = gelu_pk((f32x2){v0[0], v0[1]}), b = gelu_pk((f32x2){v0[2], v0[3]}), c = gelu_pk((f32x2){v1[0], v1[1]}), d = gelu_pk((f32x2){v1[2], v1[3]});
                        v0 = (f32x4){a.x, a.y, b.x, b.y}; v1 = (f32x4){c.x, c.y, d.x, d.y}; }
                    if (KIND == 1) {
#pragma unroll
                        for (int j = 0; j < 4; ++j) { v0[j] = siluf_(v0[j]); v1[j] = siluf_(v1[j]); } }
                    if (KIND == 3) {
#pragma unroll
                        for (int j = 0; j < 4; ++j) { v0[j] = sigmoidf_(v0[j]); v1[j] = sigmoidf_(v1[j]); } }
                    u32x4 w; w.x = cvt_pk_bf16(v0[0], v0[1]); w.y = cvt_pk_bf16(v0[2], v0[3]); w.z = cvt_pk_bf16(v1[0], v1[1]); w.w = cvt_pk_bf16(v1[2], v1[3]);
                    *(u32x4*)(rowp + bj * 128) = w; } }
    }
    __device__ __forceinline__ void operator()(const f32x4 (&acc)[2][2][4][2], const Unit& u, int wr, int wc, int fr, int fq) const {
        const int row0 = u.pm * 256 + wr * 64 + fr, pn = u.pn;
        bf16_t* base = pn < 12 ? PA + pn * 256 : PB + (pn - 12) * 256; const int col0 = wc * 32 + 8 * fq;
        if (pn < 8) run<0>(acc, base, row0, col0);
        else if (pn < 12 || pn >= 20) run<1>(acc, base, row0, col0);
        else if (pn < 16) run<2>(acc, base, row0, col0);
        else run<3>(acc, base, row0, col0);
    }
};

__device__ __forceinline__ float logsigmoidf_(float x) { return fminf(x, 0.f) - log1pf(__expf(-fabsf(x))); }
__device__ __forceinline__ void unpack8(const u32x4 w, float (&f)[8]) { f[0] = bf_lo(w.x); f[1] = bf_hi(w.x); f[2] = bf_lo(w.y); f[3] = bf_hi(w.y); f[4] = bf_lo(w.z); f[5] = bf_hi(w.z); f[6] = bf_lo(w.w); f[7] = bf_hi(w.w); }
__device__ __forceinline__ u32x4 pack8(const float (&f)[8]) { u32x4 w; w.x = cvt_pk_bf16(f[0], f[1]); w.y = cvt_pk_bf16(f[2], f[3]); w.z = cvt_pk_bf16(f[4], f[5]); w.w = cvt_pk_bf16(f[6], f[7]); return w; }

__device__ __forceinline__ void p2a_conv_gates(const Ctx& F0) { Ctx F = F0; asm volatile("" : "+v"(F.tid), "+v"(F.lane));
    unsigned char* ws = F.ws;
    const bf16_t* PBX = (const bf16_t*)(ws + WS_PROJB);
    bf16_t* XC = (bf16_t*)(ws + WS_XB); bf16_t* XB2 = (bf16_t*)(ws + WS_XB2);
    const float* Wg = (const float*)(ws + WS_WG);
    float* GLI = (float*)(ws + WS_GLI); float* GLF = (float*)(ws + WS_GLF);
    const float* convw = F.in[14]; const float* convb = F.in[15]; const float* bif = F.in[20];
    LAS float* cwl = (LAS float*)F.lds; LAS bf16_t* wgl = (LAS bf16_t*)(F.lds + 20480); LAS f32x4* comb = (LAS f32x4*)(F.lds + 20480 + 65536);
    {
        u32x4 t[11];
#pragma unroll
        for (int j = 0; j < 11; ++j) { const int i = F.tid + 512 * j; t[j] = (u32x4){0u, 0u, 0u, 0u};
            if (i < 1024) t[j] = ((const u32x4*)convw)[i]; else if (i < 1280) t[j] = ((const u32x4*)convb)[i - 1024]; else if (i < 5376) t[j] = ((const u32x4*)(ws + WS_WGB))[i - 1280]; }
#pragma unroll
        for (int j = 0; j < 11; ++j) { const int i = F.tid + 512 * j; if (i < 5376) ((LAS u32x4*)F.lds)[i] = t[j]; }
    }
    __syncthreads();
    const int l15 = F.lane & 15, lq = F.lane >> 4, rgp = F.wave >> 1, hh = F.wave & 1;
    auto conv_block = [&](int row, bool smp, int seq0, const float* st, int ch0, f32x4& acc) {
        u32x4 x3 = (u32x4){0u, 0u, 0u, 0u}, x2 = x3, x1 = x3; const u32x4 x0 = *(const u32x4*)(PBX + (size_t)row * 3072 + ch0);
        float w0[8], w1[8], w2[8], cur[8], xc[8];
        if (!smp) {
            if (row - 3 >= seq0) x3 = *(const u32x4*)(PBX + (size_t)(row - 3) * 3072 + ch0);
            if (row - 2 >= seq0) x2 = *(const u32x4*)(PBX + (size_t)(row - 2) * 3072 + ch0);
            if (row - 1 >= seq0) x1 = *(const u32x4*)(PBX + (size_t)(row - 1) * 3072 + ch0);
            unpack8(x3, w0); unpack8(x2, w1); unpack8(x1, w2);
        } else {
#pragma unroll
            for (int q = 0; q < 2; ++q) { const f32x4 a0 = *(const f32x4*)(st + ch0 + 4 * q), a1 = *(const f32x4*)(st + 1024 + ch0 + 4 * q), a2 = *(const f32x4*)(st + 2048 + ch0 + 4 * q);
#pragma unroll
                for (int e = 0; e < 4; ++e) { w0[4 * q + e] = a0[e]; w1[4 * q + e] = a1[e]; w2[4 * q + e] = a2[e]; } }
        }
        unpack8(x0, cur);
#pragma unroll
        for (int q = 0; q < 2; ++q) { const f32x4 c0 = *(const LAS f32x4*)(cwl + ch0 + 4 * q), c1 = *(const LAS f32x4*)(cwl + 1024 + ch0 + 4 * q), c2 = *(const LAS f32x4*)(cwl + 2048 + ch0 + 4 * q), c3 = *(const LAS f32x4*)(cwl + 3072 + ch0 + 4 * q), cb = *(const LAS f32x4*)(cwl + 4096 + ch0 + 4 * q);
#pragma unroll
            for (int e = 0; e < 4; ++e) xc[4 * q + e] = siluf_(c0[e] * w0[4 * q + e] + c1[e] * w1[4 * q + e] + c2[e] * w2[4 * q + e] + c3[e] * cur[4 * q + e] + cb[e]); }
        const u32x4 xcp = pack8(xc);
        *(u32x4*)(XC + (size_t)row * DM + ch0) = xcp; *(u32x4*)(XB2 + (size_t)row * DM + ch0) = x0;
        const bf16x8 bc = *(const LAS bf16x8*)(wgl + l15 * 1024 + ch0), bx = *(const LAS bf16x8*)(wgl + 16384 + l15 * 1024 + ch0);
        acc = __builtin_amdgcn_mfma_f32_16x16x32_bf16(__builtin_bit_cast(bf16x8, xcp), bc, acc, 0, 0, 0);
        acc = __builtin_amdgcn_mfma_f32_16x16x32_bf16(__builtin_bit_cast(bf16x8, x0), bx, acc, 0, 0, 0);
    };
    for (int tile = F.bid; tile < MP / 64; tile += F.G) {
        const int row = tile * 64 + rgp * 16 + l15, seq0 = row & ~(SEQ - 1);
        f32x4 acc = (f32x4){0.f, 0.f, 0.f, 0.f};
#pragma unroll 8
        for (int cbk = 0; cbk < 16; ++cbk) conv_block(row, false, seq0, nullptr, (hh * 16 + cbk) * 32 + 8 * lq, acc);
        __syncthreads();
        if (hh == 1) comb[rgp * 64 + F.lane] = acc;
        __syncthreads();
        if (hh == 0 && l15 < 8) { const f32x4 o = comb[rgp * 64 + F.lane]; const float bj = bif[l15];
#pragma unroll
            for (int r = 0; r < 4; ++r) { const float g = acc[r] + o[r] + bj; const size_t rr = (size_t)(tile * 64 + rgp * 16 + 4 * lq + r);
                if (l15 < 4) GLI[(size_t)l15 * MA + rr] = g; else GLF[(size_t)(l15 - 4) * MA + rr] = logsigmoidf_(g); } }
    }
    for (int si = F.bid; si < MS / 16; si += F.G) {
        const int row = MP + si * 16 + l15; const float* st = F.in[5] + (size_t)(row - MP) * 3072;
        f32x4 acc = (f32x4){0.f, 0.f, 0.f, 0.f};
#pragma unroll
        for (int cbk = 0; cbk < 4; ++cbk) conv_block(row, true, 0, st, (F.wave * 4 + cbk) * 32 + 8 * lq, acc);
        __syncthreads();
        comb[F.wave * 64 + F.lane] = acc;
        __syncthreads();
        if (F.wave == 0 && l15 < 8) { f32x4 o = comb[F.lane];
#pragma unroll
            for (int ww = 1; ww < 8; ++ww) o = o + comb[ww * 64 + F.lane];
            const float bj = bif[l15];
#pragma unroll
            for (int r = 0; r < 4; ++r) { const float g = o[r] + bj; const size_t rr = (size_t)(MP + si * 16 + 4 * lq + r);
                if (l15 < 4) GLI[(size_t)l15 * MA + rr] = g; else GLF[(size_t)(l15 - 4) * MA + rr] = logsigmoidf_(g); } }
    }
    __syncthreads();
    for (int i = F.bid * 512 + F.tid; i < NB * 3 * 1024; i += F.G * 512) { const int b = i / 3072, j = (i / 1024) % 3, ch = i & 1023;
        F.out[O_CVP + i] = bf2f(PBX[(size_t)(b * SEQ + SEQ - 3 + j) * 3072 + ch]); }
    for (int i = F.gw; i < MS; i += F.NGW) {
        const int r = MP + i, ch0s = F.lane * 16; const float* st = F.in[5] + (size_t)i * 3 * 1024;
        const bf16_t* PA = (const bf16_t*)(ws + WS_PROJA) + (size_t)r * 3072;
#pragma unroll
        for (int half = 0; half < 2; ++half) { const int c0 = ch0s + half * 8; float xb[8]; unpack8(*(const u32x4*)(PBX + (size_t)r * 3072 + c0), xb);
#pragma unroll
            for (int q = 0; q < 2; ++q) { *(f32x4*)(F.out + O_CVS + (size_t)i * 3072 + c0 + 4 * q) = *(const f32x4*)(st + 1024 + c0 + 4 * q); *(f32x4*)(F.out + O_CVS + (size_t)i * 3072 + 1024 + c0 + 4 * q) = *(const f32x4*)(st + 2048 + c0 + 4 * q);
                *(f32x4*)(F.out + O_CVS + (size_t)i * 3072 + 2048 + c0 + 4 * q) = (f32x4){xb[4 * q], xb[4 * q + 1], xb[4 * q + 2], xb[4 * q + 3]}; } }
        float gv[16], s = 0.f;
        { float t8[8]; unpack8(*(const u32x4*)(PA + 1024 + ch0s), t8);
#pragma unroll
          for (int c = 0; c < 8; ++c) gv[c] = t8[c];
          unpack8(*(const u32x4*)(PA + 1024 + ch0s + 8), t8);
#pragma unroll
          for (int c = 0; c < 8; ++c) gv[8 + c] = t8[c]; }
#pragma unroll
        for (int c = 0; c < 16; ++c) s += gv[c];
        s += __shfl_xor(s, 1); s += __shfl_xor(s, 2); s += __shfl_xor(s, 4);
        const float mu = s * (1.f / 128.f); float q = 0.f;
#pragma unroll
        for (int c = 0; c < 16; ++c) { const float d = gv[c] - mu; q += d * d; }
        q += __shfl_xor(q, 1); q += __shfl_xor(q, 2); q += __shfl_xor(q, 4);
        const float rstd = 1.0f / sqrtf(q * (1.f / 128.f) + EPS);
        const int h = F.lane >> 3; const float wsp = F.in[12][(size_t)h * 16384], bsp = F.in[13][h * 128];
        float uu[16], zz[16];
        { float t8[8]; unpack8(*(const u32x4*)(PA + ch0s), t8);
#pragma unroll
          for (int c = 0; c < 8; ++c) uu[c] = t8[c];
          unpack8(*(const u32x4*)(PA + ch0s + 8), t8);
#pragma unroll
          for (int c = 0; c < 8; ++c) uu[8 + c] = t8[c];
          unpack8(*(const u32x4*)(PA + 2048 + ch0s), t8);
#pragma unroll
          for (int c = 0; c < 8; ++c) zz[c] = t8[c];
          unpack8(*(const u32x4*)(PA + 2048 + ch0s + 8), t8);
#pragma unroll
          for (int c = 0; c < 8; ++c) zz[8 + c] = t8[c]; }
        float ya[16];
#pragma unroll
        for (int c = 0; c < 16; ++c) { const int ch = ch0s + c; const float vn = (gv[c] - mu) * rstd * F.in[10][ch] + F.in[11][ch];
            F.out[O_VS + (size_t)i * 1024 + ch] = vn; ya[c] = uu[c] * (wsp * vn + bsp) * zz[c]; }
        bf16_t* yrow = (bf16_t*)(ws + WS_Y) + (size_t)r * DMIX + ch0s;
        { float t8[8];
#pragma unroll
          for (int c = 0; c < 8; ++c) t8[c] = ya[c];
          *(u32x4*)(yrow) = pack8(t8);
#pragma unroll
          for (int c = 0; c < 8; ++c) t8[c] = ya[8 + c];
          *(u32x4*)(yrow + 8) = pack8(t8); }
    }
}

__device__ __forceinline__ void mscan_wave(const Ctx& F, int bh) {
    unsigned char* ws = F.ws; const int b = bh >> 2, h = bh & 3, lane = F.lane;
    const float* li = (const float*)(ws + WS_GLI) + (size_t)h * MA + (size_t)b * SEQ + lane * 32;
    const float* lf = (const float*)(ws + WS_GLF) + (size_t)h * MA + (size_t)b * SEQ + lane * 32;
    float A = 0.f, Bv = -INFINITY;
    for (int i = 0; i < 32; ++i) { const float f = lf[i], l = li[i]; Bv = fmaxf(Bv + f, l); A += f; }
    float sA = A, sB = Bv;
#pragma unroll
    for (int o = 1; o < 64; o <<= 1) { const float pA = __shfl_up(sA, o), pB = __shfl_up(sB, o); if (lane >= o) { sB = fmaxf(pB + sA, sB); sA = pA + sA; } }
    float eA = __shfl_up(sA, 1), eB = __shfl_up(sB, 1); if (lane == 0) { eA = 0.f; eB = -INFINITY; }
    const float m_in = fmaxf(0.f + eA, eB);
    float cA = A;
#pragma unroll
    for (int o = 1; o < 8; o <<= 1) { const float p = __shfl_up(cA, o); if ((lane & 7) >= o) cA += p; }
    const float b_in = cA - A;
    const float m_prev = __shfl(m_in, lane & ~7);
    float* DA = (float*)(ws + WS_DA) + (size_t)h * MA + (size_t)b * SEQ + lane * 32; float* DR = (float*)(ws + WS_DR) + (size_t)h * MA + (size_t)b * SEQ + lane * 32;
    float* DG = (float*)(ws + WS_DG) + (size_t)h * MA + (size_t)b * SEQ + lane * 32; float* DEM = (float*)(ws + WS_DEM) + (size_t)h * MA + (size_t)b * SEQ + lane * 32;
    float* DW = (float*)(ws + WS_DW) + (size_t)h * MA + (size_t)b * SEQ + lane * 32;
    float m = m_in, bb = b_in, a_last = 0.f;
    for (int i = 0; i < 32; ++i) { const float f = lf[i], l = li[i]; m = fmaxf(m + f, l); bb += f;
        a_last = bb - m; DA[i] = -m_prev; DR[i] = l - bb; DG[i] = __expf(bb + m_prev - m); DEM[i] = __expf(-m); }
    const float a_end = __shfl(a_last, lane | 7);
    for (int i = 0; i < 32; ++i) { const float f = lf[i]; (void)f; }
    { float bb2 = b_in; for (int i = 0; i < 32; ++i) { bb2 += lf[i]; DW[i] = __expf(a_end + (li[i] - bb2)); } }
    if (lane == 63) F.out[O_MP + bh] = m;
}

__device__ __forceinline__ void p9_final(const Ctx& F0) { Ctx F = F0; asm volatile("" : "+v"(F.tid), "+v"(F.lane));
    unsigned char* ws = F.ws; const bf16_t* GB = (const bf16_t*)(ws + WS_GB); const bf16_t* EB = (const bf16_t*)(ws + WS_EB);
    const float* pleg = F.in[27]; const float* fing = F.in[28];
    f32x4 pg[4], fg[4];
#pragma unroll
    for (int j = 0; j < 4; ++j) { pg[j] = ((const f32x4*)pleg)[F.lane + 64 * j]; fg[j] = ((const f32x4*)fing)[F.lane + 64 * j]; }
    for (int r0 = F.gw * 2; r0 < MP + MS; r0 += F.NGW * 2) {
        f32x4 x[2][4]; u32x2 g[2][4], e[2][4], xb[2][4]; float* xrow[2]; const bf16_t* X1B = (const bf16_t*)(ws + WS_X1B);
#pragma unroll
        for (int q = 0; q < 2; ++q) { const int r = r0 + q; xrow[q] = r < MP ? F.out + O_Y + (size_t)r * DM : F.out + O_YS + (size_t)(r - MP) * DM;
#pragma unroll
            for (int j = 0; j < 4; ++j) { xb[q][j] = __builtin_nontemporal_load((const u32x2*)(X1B + (size_t)r * DM) + F.lane + 64 * j); g[q][j] = __builtin_nontemporal_load((const u32x2*)(GB + (size_t)r * DM) + F.lane + 64 * j); e[q][j] = __builtin_nontemporal_load((const u32x2*)(EB + (size_t)r * DM) + F.lane + 64 * j); } }
#pragma unroll
        for (int q = 0; q < 2; ++q) { float s = 0.f; f32x4 ev[4];
#pragma unroll
            for (int j = 0; j < 4; ++j) { x[q][j] = (f32x4){bf_lo(xb[q][j].x), bf_hi(xb[q][j].x), bf_lo(xb[q][j].y), bf_hi(xb[q][j].y)}; ev[j] = (f32x4){bf_lo(e[q][j].x), bf_hi(e[q][j].x), bf_lo(e[q][j].y), bf_hi(e[q][j].y)}; s += (ev[j][0] * ev[j][0] + ev[j][1] * ev[j][1]) + (ev[j][2] * ev[j][2] + ev[j][3] * ev[j][3]); }
            s = wave_sum(s); const float rse = 1.0f / sqrtf(s * (1.f / DM) + EPS); float s2 = 0.f;
#pragma unroll
            for (int j = 0; j < 4; ++j) { const f32x4 gv = (f32x4){bf_lo(g[q][j].x), bf_hi(g[q][j].x), bf_lo(g[q][j].y), bf_hi(g[q][j].y)};
                x[q][j] = x[q][j] + gv * (ev[j] * rse * pg[j]); s2 += (x[q][j][0] * x[q][j][0] + x[q][j][1] * x[q][j][1]) + (x[q][j][2] * x[q][j][2] + x[q][j][3] * x[q][j][3]); }
            s2 = wave_sum(s2); const float rs2 = 1.0f / sqrtf(s2 * (1.f / DM) + EPS);
#pragma unroll
            for (int j = 0; j < 4; ++j) __builtin_nontemporal_store(x[q][j] * rs2 * fg[j], (f32x4*)xrow[q] + F.lane + 64 * j); }
    }
}
#define MAKE_CTX() extern __shared__ __attribute__((aligned(16))) unsigned char lds_raw[]; \
    Ctx F; F.lds = (LAS unsigned char*)lds_raw; F.tid = threadIdx.x; F.lane = F.tid & 63; F.wave = __builtin_amdgcn_readfirstlane(F.tid >> 6); \
    F.G = gridDim.x; F.bid = blockIdx.x; F.gw = F.bid * 8 + F.wave; F.NGW = F.G * 8; F.in = args.in; F.out = args.out; F.ws = args.ws; unsigned char* ws = args.ws; (void)ws

template <int KIND> struct EpiBf16Act {
    static constexpr bool PERM = false, AFTER_DRAIN = false;
    bf16_t* O; int ldo; const float* bias; float scale;
    __device__ __forceinline__ void operator()(const f32x4 (&acc)[2][2][4][2], const Unit& u, int wr, int wc, int fr, int fq) const {
        const int row0 = u.pm * 256 + wr * 64 + fr, col0 = u.pn * 256 + wc * 32 + 4 * fq;
        f32x4 bv[2][2];
#pragma unroll
        for (int bj = 0; bj < 2; ++bj)
#pragma unroll
            for (int n = 0; n < 2; ++n) bv[bj][n] = bias ? *(const f32x4*)(bias + col0 + bj * 128 + 16 * n) : (f32x4){0.f, 0.f, 0.f, 0.f};
#pragma unroll
        for (int ai = 0; ai < 2; ++ai)
#pragma unroll
            for (int m = 0; m < 4; ++m) { bf16_t* rowp = O + (size_t)(row0 + ai * 128 + m * 16) * ldo + col0;
#pragma unroll
                for (int bj = 0; bj < 2; ++bj)
#pragma unroll
                    for (int n = 0; n < 2; ++n) { f32x4 v = acc[ai][bj][m][n] * scale + bv[bj][n];
                        if (KIND == 3) {
#pragma unroll
                            for (int j = 0; j < 4; ++j) v[j] = sigmoidf_(v[j]); }
                        u32x2 w; w.x = cvt_pk_bf16(v[0], v[1]); w.y = cvt_pk_bf16(v[2], v[3]); *(u32x2*)(rowp + bj * 128 + n * 16) = w; } }
    }
};
struct EpiOutProj {
    static constexpr bool PERM = false, AFTER_DRAIN = false;
    const float* xp; const float* xs; float* out; bf16_t* X1B;
    __device__ __forceinline__ void operator()(const f32x4 (&acc)[2][2][4][2], const Unit& u, int wr, int wc, int fr, int fq) const {
        const int row0 = u.pm * 256 + wr * 64 + fr, col0 = u.pn * 256 + wc * 32 + 4 * fq;
#pragma unroll
        for (int ai = 0; ai < 2; ++ai) { f32x4 xv[4][2][2];
#pragma unroll
            for (int m = 0; m < 4; ++m) { const int row = row0 + ai * 128 + m * 16; const bool real = row < MP + MS; const float* xr = row < MP ? xp + (size_t)row * DM : xs + (size_t)(real ? row - MP : 0) * DM;
#pragma unroll
                for (int bj = 0; bj < 2; ++bj)
#pragma unroll
                    for (int n = 0; n < 2; ++n) xv[m][bj][n] = __builtin_nontemporal_load((const f32x4*)(xr + col0 + bj * 128 + n * 16)); }
#pragma unroll
            for (int m = 0; m < 4; ++m) { const int row = row0 + ai * 128 + m * 16; const bool real = row < MP + MS;
#pragma unroll
                for (int bj = 0; bj < 2; ++bj)
#pragma unroll
                    for (int n = 0; n < 2; ++n) { const int c = col0 + bj * 128 + n * 16; f32x4 v = acc[ai][bj][m][n];
                        if (real) v = v + xv[m][bj][n]; else v = (f32x4){0.f, 0.f, 0.f, 0.f};
                        u32x2 w; w.x = cvt_pk_bf16(v[0], v[1]); w.y = cvt_pk_bf16(v[2], v[3]); *(u32x2*)(X1B + (size_t)row * DM + c) = w; } } }
    }
};

struct EpiInProjNP {
    static constexpr bool PERM = false, AFTER_DRAIN = false;
    bf16_t* PA; bf16_t* PB; const float* rs;
    __device__ __forceinline__ void operator()(const f32x4 (&acc)[2][2][4][2], const Unit& u, int wr, int wc, int fr, int fq) const {
        const int row0 = u.pm * 256 + wr * 64 + fr, pn = u.pn; bf16_t* base = pn < 12 ? PA + pn * 256 : PB + (pn - 12) * 256; const int col0 = wc * 32 + 4 * fq;
        const int kind = pn < 8 ? 0 : ((pn < 12 || pn >= 20) ? 1 : (pn < 16 ? 2 : 3));
        float rsv[2][4];
#pragma unroll
        for (int ai = 0; ai < 2; ++ai)
#pragma unroll
            for (int m = 0; m < 4; ++m) rsv[ai][m] = rs[row0 + ai * 128 + m * 16];
#pragma unroll
        for (int ai = 0; ai < 2; ++ai)
#pragma unroll
            for (int m = 0; m < 4; ++m) { const int row = row0 + ai * 128 + m * 16; const float s = rsv[ai][m];
#pragma unroll
                for (int bj = 0; bj < 2; ++bj)
#pragma unroll
                    for (int n = 0; n < 2; ++n) { f32x4 v = acc[ai][bj][m][n] * s;
                        if (kind == 0) { const f32x2 ga = gelu_pk((f32x2){v[0], v[1]}), gb = gelu_pk((f32x2){v[2], v[3]}); v = (f32x4){ga.x, ga.y, gb.x, gb.y}; }
                        else {
#pragma unroll
                        for (int j = 0; j < 4; ++j) { float x = v[j]; if (kind == 1) x = siluf_(x); else if (kind == 3) x = sigmoidf_(x); v[j] = x; } }
                        u32x2 w; w.x = cvt_pk_bf16(v[0], v[1]); w.y = cvt_pk_bf16(v[2], v[3]); *(u32x2*)(base + (size_t)row * 3072 + col0 + bj * 128 + n * 16) = w; } }
    }
};
__device__ __forceinline__ void p1_inproj(const Ctx& F) {
    unsigned char* ws = F.ws; Gemm g{DM, DM, DM};
    OrderXcd S{64, 24, 64 * 24, F.G, F.bid, (const char*)(ws + WS_XB), (const char*)(ws + WS_WIN), (size_t)256 * DM * 2, (size_t)256 * DM * 2};
    EpiInProjNP E{(bf16_t*)(ws + WS_PROJA), (bf16_t*)(ws + WS_PROJB), (const float*)(ws + WS_RS)};
    pg8::gemm_phase<EpiInProjNP, OrderXcd>(F.lds, g, S, E);
}
__device__ __forceinline__ void p7_outproj(const Ctx& F) {
    unsigned char* ws = F.ws; Gemm g{DMIX, DMIX, DMIX};
    OrderPanel4 S{64 * 4, F.G, F.bid, (const char*)(ws + WS_Y), (const char*)(ws + WS_WOUT), (size_t)256 * DMIX * 2, (size_t)256 * DMIX * 2};
    EpiOutProj E{F.in[0], F.in[1], F.out, (bf16_t*)(ws + WS_X1B)};
    pg8::gemm_phase<EpiOutProj, OrderPanel4>(F.lds, g, S, E);
}
__device__ __forceinline__ void p8_ple(const Ctx& F) {
    unsigned char* ws = F.ws;
    { Gemm g{DM, DM, DM}; OrderPanel4 S{NTILE * 4, F.G, F.bid, (const char*)(ws + WS_X1B), (const char*)(ws + WS_WPG), (size_t)256 * DM * 2, (size_t)256 * DM * 2};
      EpiBf16Act<3> E{(bf16_t*)(ws + WS_GB), DM, F.in[25], 1.0f}; pg8::gemm_phase<EpiBf16Act<3>, OrderPanel4>(F.lds, g, S, E); }
    { Gemm g{DPLE, DPLE, DPLE}; OrderProjSkip S{F.G, F.bid, (const char*)(ws + WS_PB), (const char*)(ws + WS_WPP), (size_t)256 * DPLE * 2, (size_t)256 * DPLE * 2};
      EpiBf16Act<0> E{(bf16_t*)(ws + WS_EB), DM, nullptr, 1.0f}; pg8::gemm_phase<EpiBf16Act<0>, OrderProjSkip>(F.lds, g, S, E); }
}
typedef float f32x4_t __attribute__((ext_vector_type(4)));
__device__ __forceinline__ void p2b_spatial_units(const Ctx& F0) { Ctx F = F0; asm volatile("" : "+v"(F.tid), "+v"(F.lane));
    unsigned char* ws = F.ws;
    const bf16_t* PA = (const bf16_t*)(ws + WS_PROJA); const bf16_t* WSP = (const bf16_t*)(ws + WS_WSP); bf16_t* Y = (bf16_t*)(ws + WS_Y);
    const float* lng = F.in[10]; const float* lnb = F.in[11]; const float* bsp = F.in[13];
    LAS bf16_t* vnT = (LAS bf16_t*)F.lds;
    const int lane = F.lane, w = F.wave, l15 = lane & 15, lq = lane >> 4;
    for (int unit = F.bid; unit < NB * 16 * HA; unit += F.G) {
        const int b = unit >> 7, c = (unit >> 3) & 15, h = unit & 7, r0 = b * SEQ + c * 128;
        const float g0 = lng[h * 128 + 2 * lane], g1 = lng[h * 128 + 2 * lane + 1], b0 = lnb[h * 128 + 2 * lane], b1 = lnb[h * 128 + 2 * lane + 1];
        unsigned wav[8], wbv[8];
#pragma unroll
        for (int p = 0; p < 8; ++p) { const int s0 = w * 16 + 2 * p; wav[p] = *(const unsigned*)(PA + (size_t)(r0 + s0) * 3072 + 1024 + h * 128 + 2 * lane); wbv[p] = *(const unsigned*)(PA + (size_t)(r0 + s0 + 1) * 3072 + 1024 + h * 128 + 2 * lane); }
#pragma unroll
        for (int p = 0; p < 8; ++p) { const int s0 = w * 16 + 2 * p; const unsigned wa = wav[p], wb = wbv[p];
            float a0 = bf_lo(wa), a1 = bf_hi(wa), c0 = bf_lo(wb), c1 = bf_hi(wb);
            const float mua = wave_sum(a0 + a1) * (1.f / 128.f), mub = wave_sum(c0 + c1) * (1.f / 128.f);
            a0 -= mua; a1 -= mua; c0 -= mub; c1 -= mub;
            const float ra = 1.0f / sqrtf(wave_sum(a0 * a0 + a1 * a1) * (1.f / 128.f) + EPS), rb = 1.0f / sqrtf(wave_sum(c0 * c0 + c1 * c1) * (1.f / 128.f) + EPS);
            *(LAS unsigned*)(vnT + (2 * lane) * 136 + s0) = cvt_pk_bf16(a0 * ra * g0 + b0, c0 * rb * g0 + b0);
            *(LAS unsigned*)(vnT + (2 * lane + 1) * 136 + s0) = cvt_pk_bf16(a1 * ra * g1 + b1, c1 * rb * g1 + b1); }
        __syncthreads();
        const int t0 = 16 * w, nks = (t0 + 15) / 32 + 1;
        f32x4 acc[8];
#pragma unroll
        for (int nb = 0; nb < 8; ++nb) acc[nb] = (f32x4){0.f, 0.f, 0.f, 0.f};
        bf16x8 wfr[4];
#pragma unroll
        for (int ks = 0; ks < 4; ++ks) wfr[ks] = *(const bf16x8*)(WSP + ((size_t)h * 128 + t0 + l15) * 128 + ks * 32 + 8 * lq);
        const int t = t0 + l15; const float bt = bsp[h * 128 + t]; const size_t row = (size_t)(r0 + t);
        u32x2 uuv[8], zzv[8];
#pragma unroll
        for (int nb = 0; nb < 8; ++nb) { const int d = nb * 16 + 4 * lq; uuv[nb] = *(const u32x2*)(PA + row * 3072 + h * 128 + d); zzv[nb] = *(const u32x2*)(PA + row * 3072 + 2048 + h * 128 + d); }
#pragma unroll
        for (int ks = 0; ks < 4; ++ks) { if (ks < nks) { const int k0 = ks * 32;
#pragma unroll
            for (int nb = 0; nb < 8; ++nb) { const bf16x8 vf = *(const LAS bf16x8*)(vnT + (nb * 16 + l15) * 136 + k0 + 8 * lq);
                acc[nb] = __builtin_amdgcn_mfma_f32_16x16x32_bf16(vf, wfr[ks], acc[nb], 0, 0, 0); } } }
#pragma unroll
        for (int nb = 0; nb < 8; ++nb) { const int d = nb * 16 + 4 * lq; const u32x2 uu = uuv[nb], zz = zzv[nb];
            u32x2 o; o.x = cvt_pk_bf16(bf_lo(uu.x) * (acc[nb][0] + bt) * bf_lo(zz.x), bf_hi(uu.x) * (acc[nb][1] + bt) * bf_hi(zz.x));
            o.y = cvt_pk_bf16(bf_lo(uu.y) * (acc[nb][2] + bt) * bf_lo(zz.y), bf_hi(uu.y) * (acc[nb][3] + bt) * bf_hi(zz.y));
            *(u32x2*)(Y + row * DMIX + h * 128 + d) = o; }
        __syncthreads();
    }
}
__device__ __forceinline__ void p2b_mscan(const Ctx& F) { if (F.bid < 32 && F.wave == 0) mscan_wave(F, F.bid); }

struct OrderQK {
    int G, c; const char* ws;
    __device__ __forceinline__ bool next(int i, Unit& u) const { const int L = i * G + c; if (L >= 512) return false; const char* XC = ws + WS_XB; const char* WQ = ws + WS_WQ; const char* WK = ws + WS_WK;
        const int kind = L >> 8, l = L & 255; u.pm = l >> 2; u.pn = kind; u.aux = l & 3; u.a = XC + (size_t)u.pm * (256 * DM * 2) + (size_t)u.aux * 512; u.b = (kind ? WK : WQ) + (size_t)u.aux * 131072; return true; }
};
struct EpiQK {
    static constexpr bool PERM = false, AFTER_DRAIN = false;
    bf16_t* K; bf16_t* PQ; const float* DG;
    __device__ __forceinline__ void operator()(const f32x4 (&acc)[2][2][4][2], const Unit& u, int wr, int wc, int fr, int fq) const {
        const int h = u.aux, rl0 = wr * 64 + fr, col0 = wc * 32 + 4 * fq; const bool isk = u.pn != 0;
        const int unit = ((u.pm >> 3) * 4 + h) * 8 + (u.pm & 7);
        float gv[2][4];
#pragma unroll
        for (int ai = 0; ai < 2; ++ai)
#pragma unroll
            for (int m = 0; m < 4; ++m) gv[ai][m] = isk ? 0.0625f : DG[(size_t)h * MA + u.pm * 256 + rl0 + ai * 128 + m * 16];
        bf16_t* base = isk ? K + (size_t)u.pm * 256 * 1024 + h * 256 : PQ + (size_t)unit * 256 * 512 + 256; const int ldo = isk ? 1024 : 512;
#pragma unroll
        for (int ai = 0; ai < 2; ++ai)
#pragma unroll
            for (int m = 0; m < 4; ++m) { const int rl = rl0 + ai * 128 + m * 16; const float g = gv[ai][m];
#pragma unroll
                for (int bj = 0; bj < 2; ++bj)
#pragma unroll
                    for (int n = 0; n < 2; ++n) { const int c = col0 + bj * 128 + n * 16; const f32x4 v = acc[ai][bj][m][n] * g;
                        u32x2 w; w.x = cvt_pk_bf16(v[0], v[1]); w.y = cvt_pk_bf16(v[2], v[3]); *(u32x2*)(base + (size_t)rl * ldo + c) = w; }
                asm volatile("" ::: "memory"); }
    }
};
struct OrderS12 {
    int G, c; const char* ws;
    __device__ __forceinline__ bool next(int i, Unit& u) const { const int L = i * G + c; if (L >= 12) return false; const char* XC = ws + WS_XB; const char* XB2 = ws + WS_XB2; const char* WQ = ws + WS_WQ; const char* WK = ws + WS_WK; const char* WV = ws + WS_WV;
        const int kind = L >> 2; u.pm = 64; u.pn = kind; u.aux = L & 3; u.a = (kind == 2 ? XB2 : XC) + (size_t)64 * (256 * DM * 2) + (size_t)u.aux * 512; u.b = (kind == 0 ? WQ : kind == 1 ? WK : WV) + (size_t)u.aux * 131072; return true; }
};
struct EpiS12 {
    static constexpr bool PERM = false, AFTER_DRAIN = false;
    bf16_t* Q; bf16_t* K; bf16_t* Vs;
    __device__ __forceinline__ void operator()(const f32x4 (&acc)[2][2][4][2], const Unit& u, int wr, int wc, int fr, int fq) const {
        const int h = u.aux, kind = u.pn; bf16_t* O = kind == 0 ? Q + (size_t)MP * 1024 : kind == 1 ? K + (size_t)MP * 1024 : Vs; const float sc = kind == 1 ? 0.0625f : 1.0f;
        const int row0 = wr * 64 + fr, col0 = h * 256 + wc * 32 + 4 * fq;
#pragma unroll
        for (int m = 0; m < 4; ++m) { bf16_t* rowp = O + (size_t)(row0 + m * 16) * 1024 + col0;
#pragma unroll
            for (int bj = 0; bj < 2; ++bj)
#pragma unroll
                for (int n = 0; n < 2; ++n) { const f32x4 v = acc[0][bj][m][n] * sc; u32x2 w; w.x = cvt_pk_bf16(v[0], v[1]); w.y = cvt_pk_bf16(v[2], v[3]); *(u32x2*)(rowp + bj * 128 + n * 16) = w; } }
    }
};
struct OrderVW {
    int G, c; const char* ws;
    __device__ __forceinline__ bool next(int i, Unit& u) const { const int L = i * G + c; if (L >= 512) return false; const char* XC = ws + WS_XB; const char* XB2 = ws + WS_XB2; const char* WK = ws + WS_WK; const char* WV = ws + WS_WV;
        const int kind = L >> 8, l = L & 255, b = l >> 5, h = (l >> 3) & 3, cc = l & 7; u.pm = b * 8 + cc; u.pn = l | (kind << 8); u.aux = h;
        u.a = (kind ? WK : WV) + (size_t)h * 131072; u.b = (kind ? XC : XB2) + (size_t)u.pm * (256 * DM * 2) + (size_t)h * 512; return true; }
};
struct EpiVW {
    static constexpr bool PERM = false, AFTER_DRAIN = false;
    bf16_t* VC; bf16_t* WKT; const float* DW;
    __device__ __forceinline__ void operator()(const f32x4 (&acc)[2][2][4][2], const Unit& u, int wr, int wc, int fr, int fq) const {
        const int h = u.aux, kind = u.pn >> 8, l = u.pn & 255, rl0 = wr * 64 + fr, col0 = wc * 32 + 4 * fq; const int ldo = kind ? 256 : 512; bf16_t* base = (kind ? WKT : VC) + (size_t)l * 256 * ldo;
        f32x4 scq[2][2];
#pragma unroll
        for (int bj = 0; bj < 2; ++bj)
#pragma unroll
            for (int n = 0; n < 2; ++n) scq[bj][n] = kind ? *(const f32x4*)(DW + (size_t)h * MA + u.pm * 256 + col0 + bj * 128 + n * 16) * 0.0625f : (f32x4){1.f, 1.f, 1.f, 1.f};
#pragma unroll
        for (int ai = 0; ai < 2; ++ai)
#pragma unroll
            for (int m = 0; m < 4; ++m) { bf16_t* rowp = base + (size_t)(rl0 + ai * 128 + m * 16) * ldo + col0;
#pragma unroll
                for (int bj = 0; bj < 2; ++bj)
#pragma unroll
                    for (int n = 0; n < 2; ++n) { const f32x4 v = acc[ai][bj][m][n] * scq[bj][n]; u32x2 w; w.x = cvt_pk_bf16(v[0], v[1]); w.y = cvt_pk_bf16(v[2], v[3]); *(u32x2*)(rowp + bj * 128 + n * 16) = w; }
                asm volatile("" ::: "memory"); }
    }
};
__device__ __forceinline__ void p3_qkv(const Ctx& F) {
    unsigned char* ws = F.ws;
    { Gemm g{DM, 256, 256}; OrderQK S{F.G, F.bid, (const char*)ws}; EpiQK E{(bf16_t*)(ws + WS_K), (bf16_t*)(ws + WS_PQ), (const float*)(ws + WS_DG)};
      pg8::gemm_phase<EpiQK, OrderQK>(F.lds, g, S, E); }
    { Gemm g{256, DM, 256}; OrderVW S{F.G, F.bid, (const char*)ws}; EpiVW E{(bf16_t*)(ws + WS_VC), (bf16_t*)(ws + WS_WKT), (const float*)(ws + WS_DW)};
      pg8::gemm_phase<EpiVW, OrderVW>(F.lds, g, S, E); }
}

__device__ __forceinline__ void p3_s12(const Ctx& F) {
    unsigned char* ws = F.ws;
    { Gemm g{DM, 256, 256}; OrderS12 S{F.G, (F.bid - 32) & 255, (const char*)ws}; EpiS12 E{(bf16_t*)(ws + WS_Q), (bf16_t*)(ws + WS_K), (bf16_t*)(ws + WS_VS)};
      pg8::gemm_phase<EpiS12, OrderS12>(F.lds, g, S, E); }
}
struct OrderUnitNT {
    int n, G, c; const char* A; size_t astep_pm, astep_h, astep_u; const char* B; size_t bstep_pm, bstep_h, bstep_u;
    __device__ __forceinline__ bool next(int i, Unit& u) const { const int L = i * G + c; if (L >= n) return false;
        const int b = L >> 5, h = (L >> 3) & 3, cc = L & 7; u.pm = b * 8 + cc; u.pn = L; u.aux = h;
        u.a = A + (size_t)u.pm * astep_pm + (size_t)h * astep_h + (size_t)L * astep_u; u.b = B + (size_t)u.pm * bstep_pm + (size_t)h * bstep_h + (size_t)L * bstep_u; return true; }
};
struct EpiScore {
    static constexpr bool PERM = false, AFTER_DRAIN = false;
    bf16_t* PQ; const float* DA; const float* DR; float* DENP;
    __device__ __forceinline__ void operator()(const f32x4 (&acc)[2][2][4][2], const Unit& u, int wr, int wc, int fr, int fq) const {
        const int h = u.aux, rl0 = wr * 64 + fr, col0 = wc * 32 + 4 * fq; const size_t vb = (size_t)h * MA + (size_t)u.pm * 256;
        float atv[2][4]; f32x4 rrv[2][2];
#pragma unroll
        for (int ai = 0; ai < 2; ++ai)
#pragma unroll
            for (int m = 0; m < 4; ++m) atv[ai][m] = DA[vb + rl0 + ai * 128 + m * 16];
#pragma unroll
        for (int bj = 0; bj < 2; ++bj)
#pragma unroll
            for (int n = 0; n < 2; ++n) rrv[bj][n] = *(const f32x4*)(DR + vb + col0 + bj * 128 + n * 16);
#pragma unroll
        for (int ai = 0; ai < 2; ++ai)
#pragma unroll
            for (int m = 0; m < 4; ++m) { int t_ = rl0 + ai * 128 + m * 16; asm volatile("" : "+v"(t_)); const int t = t_; const float at = atv[ai][m]; float rs_ = 0.f; bf16_t* rowp = PQ + ((size_t)u.pn * 256 + t) * 512 + col0;
#pragma unroll
                for (int bj = 0; bj < 2; ++bj)
#pragma unroll
                    for (int n = 0; n < 2; ++n) { const int c = col0 + bj * 128 + n * 16; f32x4 v; const f32x4 rr = rrv[bj][n];
#pragma unroll
                        for (int j = 0; j < 4; ++j) { const float e = fast_exp(at + rr[j]); v[j] = (c + j <= t) ? acc[ai][bj][m][n][j] * e : 0.f; rs_ += v[j]; }
                        u32x2 w; w.x = cvt_pk_bf16(v[0], v[1]); w.y = cvt_pk_bf16(v[2], v[3]); *(u32x2*)(rowp + bj * 128 + n * 16) = w; }
                rs_ += __shfl_xor(rs_, 16); rs_ += __shfl_xor(rs_, 32);
                if (fq == 0) DENP[(vb + t) * 4 + wc] = rs_; asm volatile("" ::: "memory"); }
    }
};
struct EpiF32Unit {
    static constexpr bool PERM = false, AFTER_DRAIN = false;
    bf16_t* O;
    __device__ __forceinline__ void operator()(const f32x4 (&acc)[2][2][4][2], const Unit& u, int wr, int wc, int fr, int fq) const {
        bf16_t* base = O + (size_t)u.pn * 65536 + (size_t)(wr * 64 + fr) * 256 + wc * 32 + 4 * fq;
#pragma unroll
        for (int ai = 0; ai < 2; ++ai)
#pragma unroll
            for (int m = 0; m < 4; ++m)
#pragma unroll
                for (int bj = 0; bj < 2; ++bj)
#pragma unroll
                    for (int n = 0; n < 2; ++n) { const f32x4 v = acc[ai][bj][m][n]; u32x2 w; w.x = cvt_pk_bf16(v[0], v[1]); w.y = cvt_pk_bf16(v[2], v[3]); *(u32x2*)(base + (size_t)(ai * 128 + m * 16) * 256 + bj * 128 + n * 16) = w; }
    }
};
__device__ __forceinline__ void p4_scores_dc(const Ctx& F) {
    unsigned char* ws = F.ws;
    { Gemm g{512, DM, 256}; OrderUnitNT S{NUNIT, F.G, F.bid, (const char*)(ws + WS_PQ) + 512, 0, 0, (size_t)256 * 512 * 2, (const char*)(ws + WS_K), (size_t)256 * DM * 2, 512, 0};
      EpiScore E{(bf16_t*)(ws + WS_PQ), (const float*)(ws + WS_DA), (const float*)(ws + WS_DR), (float*)(ws + WS_DENP)}; pg8::gemm_phase<EpiScore, OrderUnitNT>(F.lds, g, S, E); }
    { Gemm g{512, 256, 256}; OrderUnitNT S{NUNIT, F.G, F.bid, (const char*)(ws + WS_VC), 0, 0, (size_t)256 * 512 * 2, (const char*)(ws + WS_WKT), 0, 0, (size_t)256 * 256 * 2};
      EpiF32Unit E{(bf16_t*)(F.out + O_Y)}; pg8::gemm_phase<EpiF32Unit, OrderUnitNT>(F.lds, g, S, E); }
    for (int u = F.bid; u < NUNIT; u += F.G) { const int d = F.tid >> 1, hf = F.tid & 1; const bf16_t* src = (const bf16_t*)(ws + WS_WKT) + ((size_t)u * 256 + d) * 256 + hf * 128; float s = 0.f;
#pragma unroll
        for (int j = 0; j < 16; ++j) { float t8[8]; unpack8(*(const u32x4*)(src + j * 8), t8);
#pragma unroll
            for (int e = 0; e < 8; ++e) s += t8[e]; }
        s += __shfl_xor(s, 1); if (hf == 0) ((float*)(ws + WS_DN))[(size_t)u * 256 + d] = s; }
}

__device__ __forceinline__ void p5_scan_sample(const Ctx& F0) { Ctx F = F0; asm volatile("" : "+v"(F.tid), "+v"(F.lane));
    unsigned char* ws = F.ws; const float* DG = (const float*)(ws + WS_DG); const bf16_t* DCb = (const bf16_t*)(F.out + O_Y); bf16_t* VC = (bf16_t*)(ws + WS_VC);
    for (int idx = F.bid * 512 + F.tid; idx < 32 * 16384; idx += F.G * 512) { const int bh = idx >> 14, q4 = idx & 16383, e = q4 >> 6, d4 = (q4 & 63) * 4, b = bh >> 2, h = bh & 3;
        f32x4 dc[8]; float ge[8];
#pragma unroll
        for (int c = 0; c < 8; ++c) { const u32x2 dw = __builtin_nontemporal_load((const u32x2*)(DCb + ((size_t)(bh * 8 + c) * 256 + e) * 256 + d4)); dc[c] = (f32x4){bf_lo(dw.x), bf_hi(dw.x), bf_lo(dw.y), bf_hi(dw.y)}; ge[c] = DG[(size_t)h * MA + b * SEQ + c * 256 + 255]; }
        f32x4 C = (f32x4){0.f, 0.f, 0.f, 0.f};
#pragma unroll
        for (int c = 0; c < 8; ++c) { u32x2 w; w.x = cvt_pk_bf16(C[0], C[1]); w.y = cvt_pk_bf16(C[2], C[3]); *(u32x2*)(VC + ((size_t)(bh * 8 + c) * 256 + e) * 512 + 256 + d4) = w; C = C * ge[c] + dc[c]; }
        __builtin_nontemporal_store(C, (f32x4*)(F.out + O_CP + ((size_t)bh * 256 + e) * 256 + d4)); }
    LAS float* npv = (LAS float*)F.lds;
    for (int u = F.bid; u < NUNIT; u += F.G) { const int bh = u >> 3, cc = u & 7, b = bh >> 2, h = bh & 3;
        __syncthreads();
        if (F.tid < 256) { float n = 0.f; const float* DN = (const float*)(ws + WS_DN);
            for (int j = 0; j < cc; ++j) n = DG[(size_t)h * MA + b * SEQ + j * 256 + 255] * n + DN[(size_t)(bh * 8 + j) * 256 + F.tid];
            npv[F.tid] = n; if (cc == 7) F.out[O_NP + (size_t)bh * 256 + F.tid] = DG[(size_t)h * MA + b * SEQ + 7 * 256 + 255] * n + DN[(size_t)u * 256 + F.tid]; }
        __syncthreads();
        const f32x4 nv = *(const LAS f32x4*)(npv + 4 * F.lane); const bf16_t* PQg = (const bf16_t*)(ws + WS_PQ);
        for (int r = 0; r < 32; ++r) { const size_t row = (size_t)b * SEQ + cc * 256 + F.wave * 32 + r; const u32x2 qq = *(const u32x2*)(PQg + ((size_t)u * 256 + F.wave * 32 + r) * 512 + 256 + 4 * F.lane);
            const float s = wave_sum(bf_lo(qq.x) * nv[0] + bf_hi(qq.x) * nv[1] + bf_lo(qq.y) * nv[2] + bf_hi(qq.y) * nv[3]); if (F.lane == 0) ((float*)(ws + WS_QN))[(size_t)h * MA + row] = s; } }

}


__device__ __forceinline__ void p5s_sample(const Ctx& F0) { Ctx F = F0; asm volatile("" : "+v"(F.tid), "+v"(F.lane));
    unsigned char* ws = F.ws;
    LAS float* hs = (LAS float*)F.lds + 512; LAS float* red = (LAS float*)F.lds + 1024;
    for (int job = F.bid; job < MS * HB; job += F.G) { const int i = job >> 2, h = job & 3; const size_t row = MP + i;
        const bf16_t* Q = (const bf16_t*)(ws + WS_Q) + row * 1024 + h * 256; const bf16_t* K = (const bf16_t*)(ws + WS_K) + row * 1024 + h * 256; const bf16_t* V = (const bf16_t*)(ws + WS_VS) + (size_t)i * 1024 + h * 256;
        const u32x2 qw = *(const u32x2*)(Q + 4 * F.lane), kw = *(const u32x2*)(K + 4 * F.lane);
        const f32x4 q4 = (f32x4){bf_lo(qw.x), bf_hi(qw.x), bf_lo(qw.y), bf_hi(qw.y)}, k4 = (f32x4){bf_lo(kw.x), bf_hi(kw.x), bf_lo(kw.y), bf_hi(kw.y)};
        const f32x4 n0 = *(const f32x4*)(F.in[3] + ((size_t)i * 4 + h) * 256 + 4 * F.lane);
        const float li = ((const float*)(ws + WS_GLI))[(size_t)h * MA + row], lf = ((const float*)(ws + WS_GLF))[(size_t)h * MA + row], m0 = F.in[4][i * 4 + h];
        const float mn = fmaxf(lf + m0, li), g = __expf(lf + m0 - mn), wi = __expf(li - mn);
        const float qk = wave_sum(q4[0] * k4[0] + q4[1] * k4[1] + q4[2] * k4[2] + q4[3] * k4[3]), nq = wave_sum(n0[0] * q4[0] + n0[1] * q4[1] + n0[2] * q4[2] + n0[3] * q4[3]);
        const float sc = wi * qk, den = sc + g * nq, dinv = 1.0f / fmaxf(fabsf(den), __expf(-mn));
        const float* C0 = F.in[2] + (((size_t)i * 4 + h) * 256 + F.wave * 32) * 256 + 4 * F.lane; float* C1 = F.out + O_CS + (((size_t)i * 4 + h) * 256 + F.wave * 32) * 256 + 4 * F.lane;
        __syncthreads();
#pragma unroll 1
        for (int r8 = 0; r8 < 32; r8 += 8) { f32x4 c[8]; float ve[8], cq[8];
#pragma unroll
            for (int r = 0; r < 8; ++r) { c[r] = __builtin_nontemporal_load((const f32x4*)(C0 + (size_t)(r8 + r) * 256)); ve[r] = bf2f(V[F.wave * 32 + r8 + r]); }
#pragma unroll
            for (int r = 0; r < 8; ++r) { cq[r] = c[r][0] * q4[0] + c[r][1] * q4[1] + c[r][2] * q4[2] + c[r][3] * q4[3]; const float wv = wi * ve[r]; __builtin_nontemporal_store(c[r] * g + k4 * wv, (f32x4*)(C1 + (size_t)(r8 + r) * 256)); }
#pragma unroll
            for (int r = 0; r < 8; ++r) { cq[r] = wave_sum(cq[r]); if (F.lane == 0) hs[F.wave * 32 + r8 + r] = (sc * ve[r] + g * cq[r]) * dinv; } }
        if (F.wave == 0) { *(f32x4*)(F.out + O_NS + ((size_t)i * 4 + h) * 256 + 4 * F.lane) = n0 * g + k4 * wi; if (F.lane == 0) F.out[O_MS + i * 4 + h] = mn; }
        __syncthreads();
        const bf16_t* PB = (const bf16_t*)(ws + WS_PROJB) + row * 3072; const bf16_t* XC = (const bf16_t*)(ws + WS_XB) + row * DM;
        float x = 0.f; const int ch = h * 256 + (F.tid & 255);
        if (F.tid < 256) x = hs[F.tid] * bf2f(PB[1024 + ch]);
        float p = wave_sum(x); if (F.lane == 0) red[F.wave] = p;
        __syncthreads();
        const float mu = (red[0] + red[1] + red[2] + red[3]) * (1.f / 256.f), dx = x - mu;
        __syncthreads();
        p = wave_sum(F.tid < 256 ? dx * dx : 0.f); if (F.lane == 0) red[F.wave] = p;
        __syncthreads();
        const float rstd = 1.0f / sqrtf((red[0] + red[1] + red[2] + red[3]) * (1.f / 256.f) + EPS);
        if (F.tid < 256) ((bf16_t*)(ws + WS_Y))[row * DMIX + 1024 + ch] = f2bf((dx * rstd * F.in[21][ch] + F.in[22][ch] * bf2f(XC[ch])) * bf2f(PB[2048 + ch]));
        __syncthreads();
    }
}
struct EpiHOut {
    static constexpr bool PERM = false, AFTER_DRAIN = true;
    const float* DENP; const float* DG; const float* QN; const float* DEM; const bf16_t* PB; const bf16_t* XC; bf16_t* Y; const float* gng; const float* skip;
    __device__ __forceinline__ void fused(f32x4 (&acc)[2][2][4][2], const Unit& u, int wr, int wc, int fr, int fq, LAS unsigned char* lds, int wid, int lane) const {
        const int h = u.aux, rl0 = wr * 64 + fr, col0 = wc * 32 + 4 * fq; const size_t vb = (size_t)h * MA + (size_t)u.pm * 256;
        LAS float* P1 = (LAS float*)lds; LAS float* P2 = (LAS float*)lds + 1024;
#pragma unroll
        for (int ai = 0; ai < 2; ++ai) { u32x2 ow[4][2][2]; f32x4 dp[4]; float dgq[4], dem[4];
#pragma unroll
            for (int m = 0; m < 4; ++m) { const int t = rl0 + ai * 128 + m * 16; const size_t row = (size_t)u.pm * 256 + t; dp[m] = *(const f32x4*)(DENP + (vb + t) * 4); dgq[m] = QN[vb + t]; dem[m] = DEM[vb + t];
#pragma unroll
                for (int bj = 0; bj < 2; ++bj)
#pragma unroll
                    for (int n = 0; n < 2; ++n) ow[m][bj][n] = *(const u32x2*)(PB + row * 3072 + 1024 + h * 256 + col0 + bj * 128 + n * 16); }
#pragma unroll
            for (int m = 0; m < 4; ++m) { const int t = rl0 + ai * 128 + m * 16; const float den = (dp[m][0] + dp[m][1]) + (dp[m][2] + dp[m][3]) + dgq[m];
                const float dinv = 1.0f / fmaxf(fabsf(den), dem[m]); float s = 0.f;
#pragma unroll
                for (int bj = 0; bj < 2; ++bj)
#pragma unroll
                    for (int n = 0; n < 2; ++n) { const u32x2 o2 = ow[m][bj][n];
                        f32x4 v = acc[ai][bj][m][n] * dinv; v[0] *= bf_lo(o2.x); v[1] *= bf_hi(o2.x); v[2] *= bf_lo(o2.y); v[3] *= bf_hi(o2.y); acc[ai][bj][m][n] = v; s += (v[0] + v[1]) + (v[2] + v[3]); }
                s += __shfl_xor(s, 16); s += __shfl_xor(s, 32); if (fq == 0) P1[t * 4 + wc] = s; } }
        asm volatile("s_waitcnt lgkmcnt(0)" ::: "memory"); __builtin_amdgcn_s_barrier(); asm volatile("" ::: "memory");
#pragma unroll
        for (int ai = 0; ai < 2; ++ai)
#pragma unroll
            for (int m = 0; m < 4; ++m) { const int t = rl0 + ai * 128 + m * 16; const f32x4 ps = *(const LAS f32x4*)(P1 + t * 4); const float mu = ((ps[0] + ps[1]) + (ps[2] + ps[3])) * (1.f / 256.f); float q = 0.f;
#pragma unroll
                for (int bj = 0; bj < 2; ++bj)
#pragma unroll
                    for (int n = 0; n < 2; ++n) { f32x4 v = acc[ai][bj][m][n] - mu; acc[ai][bj][m][n] = v; q += (v[0] * v[0] + v[1] * v[1]) + (v[2] * v[2] + v[3] * v[3]); }
                q += __shfl_xor(q, 16); q += __shfl_xor(q, 32); if (fq == 0) P2[t * 4 + wc] = q; }
        asm volatile("s_waitcnt lgkmcnt(0)" ::: "memory"); __builtin_amdgcn_s_barrier(); asm volatile("" ::: "memory");
#pragma unroll
        for (int ai = 0; ai < 2; ++ai) { u32x2 xw[4][2][2], zw[4][2][2];
#pragma unroll
            for (int m = 0; m < 4; ++m) { const int t = rl0 + ai * 128 + m * 16; const size_t row = (size_t)u.pm * 256 + t;
#pragma unroll
                for (int bj = 0; bj < 2; ++bj)
#pragma unroll
                    for (int n = 0; n < 2; ++n) { const int c = h * 256 + col0 + bj * 128 + n * 16; xw[m][bj][n] = *(const u32x2*)(XC + row * DM + c); zw[m][bj][n] = *(const u32x2*)(PB + row * 3072 + 2048 + c); } }
#pragma unroll
            for (int m = 0; m < 4; ++m) { const int t = rl0 + ai * 128 + m * 16; const size_t row = (size_t)u.pm * 256 + t; const f32x4 ps = *(const LAS f32x4*)(P2 + t * 4);
                const float rstd = 1.0f / sqrtf(((ps[0] + ps[1]) + (ps[2] + ps[3])) * (1.f / 256.f) + EPS);
#pragma unroll
                for (int bj = 0; bj < 2; ++bj)
#pragma unroll
                    for (int n = 0; n < 2; ++n) { const int c = h * 256 + col0 + bj * 128 + n * 16; const u32x2 x2 = xw[m][bj][n], z2 = zw[m][bj][n];
                        const f32x4 ggv = *(const f32x4*)(gng + c), skv = *(const f32x4*)(skip + c); const f32x4 v = acc[ai][bj][m][n] * rstd * ggv; u32x2 w;
                        w.x = cvt_pk_bf16((v[0] + skv[0] * bf_lo(x2.x)) * bf_lo(z2.x), (v[1] + skv[1] * bf_hi(x2.x)) * bf_hi(z2.x));
                        w.y = cvt_pk_bf16((v[2] + skv[2] * bf_lo(x2.y)) * bf_lo(z2.y), (v[3] + skv[3] * bf_hi(x2.y)) * bf_hi(z2.y));
                        *(u32x2*)(Y + row * DMIX + 1024 + c) = w; } } }
    }
};
__device__ __forceinline__ void p6_hout(const Ctx& F) {
    unsigned char* ws = F.ws; Gemm g{512, 512, 512};
    OrderUnitNT S{NUNIT, F.G, F.bid, (const char*)(ws + WS_PQ), 0, 0, (size_t)256 * 512 * 2, (const char*)(ws + WS_VC), 0, 0, (size_t)256 * 512 * 2};
    EpiHOut E{(const float*)(ws + WS_DENP), (const float*)(ws + WS_DG), (const float*)(ws + WS_QN), (const float*)(ws + WS_DEM), (const bf16_t*)(ws + WS_PROJB), (const bf16_t*)(ws + WS_XB), (bf16_t*)(ws + WS_Y), F.in[21], F.in[22]};
    pg8::gemm_phase<EpiHOut, OrderUnitNT, false, true>(F.lds, g, S, E);
}
template <class PtrF, class Ef>
__device__ __forceinline__ void sample_gemm(const Ctx& F, int nitems, int K, int lda, int ldb, const PtrF& P, const Ef& E) {
    const int l15 = F.lane & 15, lq = F.lane >> 4, w = F.wave;
    for (int item = F.bid; item < nitems; item += F.G) {
        const bf16_t* A; const bf16_t* B; P(item, A, B);
        const bf16_t* ap = A + (size_t)(16 * w + l15) * lda + 8 * lq; const bf16_t* bp = B + (size_t)l15 * ldb + 8 * lq;
        f32x4 acc = (f32x4){0.f, 0.f, 0.f, 0.f};
        for (int k0 = 0; k0 < K; k0 += 256) { bf16x8 a[8], b[8];
#pragma unroll
            for (int j = 0; j < 8; ++j) { a[j] = *(const bf16x8*)(ap + k0 + 32 * j); b[j] = *(const bf16x8*)(bp + k0 + 32 * j); }
#pragma unroll
            for (int j = 0; j < 8; ++j) acc = __builtin_amdgcn_mfma_f32_16x16x32_bf16(a[j], b[j], acc, 0, 0, 0); }
#pragma unroll
        for (int r = 0; r < 4; ++r) E(item, 16 * w + 4 * lq + r, l15, acc[r]);
    }
}
__device__ __forceinline__ void sample_inproj(const Ctx& F) {
    unsigned char* ws = F.ws; const bf16_t* XB = (const bf16_t*)(ws + WS_XB) + (size_t)MP * DM; const bf16_t* W = (const bf16_t*)(ws + WS_WIN);
    bf16_t* PA = (bf16_t*)(ws + WS_PROJA) + (size_t)MP * 3072; bf16_t* PB = (bf16_t*)(ws + WS_PROJB) + (size_t)MP * 3072; const float* rs = (const float*)(ws + WS_RS) + MP;
    sample_gemm(F, NIN / 16, DM, DM, DM,
        [=](int item, const bf16_t*& A, const bf16_t*& B) { A = XB; B = W + (size_t)item * 16 * DM; },
        [=](int item, int r, int c, float acc) { const int col = item * 16 + c, grp = col >> 10; float v = acc * rs[r];
            if (grp < 2) { const f32x2 g2 = gelu_pk((f32x2){v, v}); v = g2.x; } else if (grp == 2 || grp == 5) v = siluf_(v); else if (grp == 4) v = sigmoidf_(v);
            bf16_t* dst = col < 3072 ? PA + (size_t)r * 3072 + col : PB + (size_t)r * 3072 + (col - 3072); *dst = f2bf(v); });
}
__device__ __forceinline__ void sample_qkv(const Ctx& F) {
    unsigned char* ws = F.ws; const bf16_t* XC = (const bf16_t*)(ws + WS_XB) + (size_t)MP * DM; const bf16_t* XBr = (const bf16_t*)(ws + WS_PROJB) + (size_t)MP * 3072;
    const bf16_t* WQ = (const bf16_t*)(ws + WS_WQ); const bf16_t* WK = (const bf16_t*)(ws + WS_WK); const bf16_t* WV = (const bf16_t*)(ws + WS_WV);
    bf16_t* Q = (bf16_t*)(ws + WS_Q) + (size_t)MP * 1024; bf16_t* Kk = (bf16_t*)(ws + WS_K) + (size_t)MP * 1024; bf16_t* Vs = (bf16_t*)(ws + WS_VS);
    sample_gemm(F, 128, 256, DM, 256,
        [=](int item, const bf16_t*& A, const bf16_t*& B) { const int which = item >> 6, it = item & 63, h = it >> 4; A = XC + h * 256; B = (which ? WK : WQ) + (size_t)h * 65536 + (size_t)(it & 15) * 16 * 256; },
        [=](int item, int r, int c, float acc) { const int which = item >> 6, it = item & 63; bf16_t* O = which ? Kk : Q; O[(size_t)r * 1024 + it * 16 + c] = f2bf(which ? acc * 0.0625f : acc); });
    sample_gemm(F, 64, 256, 3072, 256,
        [=](int item, const bf16_t*& A, const bf16_t*& B) { const int h = item >> 4; A = XBr + h * 256; B = WV + (size_t)h * 65536 + (size_t)(item & 15) * 16 * 256; },
        [=](int item, int r, int c, float acc) { Vs[(size_t)r * 1024 + item * 16 + c] = f2bf(acc); });
}
__device__ __forceinline__ void sample_outproj(const Ctx& F) {
    unsigned char* ws = F.ws; const bf16_t* Y = (const bf16_t*)(ws + WS_Y) + (size_t)MP * DMIX; const bf16_t* W = (const bf16_t*)(ws + WS_WOUT);
    const float* xs = F.in[1]; float* out = F.out + O_YS; bf16_t* X1B = (bf16_t*)(ws + WS_X1B) + (size_t)MP * DM;
    sample_gemm(F, DM / 16, DMIX, DMIX, DMIX,
        [=](int item, const bf16_t*& A, const bf16_t*& B) { A = Y; B = W + (size_t)item * 16 * DMIX; },
        [=](int item, int r, int c, float acc) { const int col = item * 16 + c; const float v = xs[(size_t)r * DM + col] + acc; out[(size_t)r * DM + col] = v; X1B[(size_t)r * DM + col] = f2bf(v); });
}
__device__ __forceinline__ void sample_ple(const Ctx& F) {
    unsigned char* ws = F.ws; const bf16_t* X1B = (const bf16_t*)(ws + WS_X1B) + (size_t)MP * DM; const bf16_t* PBs = (const bf16_t*)(ws + WS_PB) + (size_t)MP * DPLE;
    const bf16_t* WG = (const bf16_t*)(ws + WS_WPG); const bf16_t* WP = (const bf16_t*)(ws + WS_WPP); const float* bias = F.in[25];
    bf16_t* GB = (bf16_t*)(ws + WS_GB) + (size_t)MP * DM; bf16_t* EB = (bf16_t*)(ws + WS_EB) + (size_t)MP * DM;
    sample_gemm(F, DM / 16, DM, DM, DM,
        [=](int item, const bf16_t*& A, const bf16_t*& B) { A = X1B; B = WG + (size_t)item * 16 * DM; },
        [=](int item, int r, int c, float acc) { const int col = item * 16 + c; GB[(size_t)r * DM + col] = f2bf(sigmoidf_(acc + bias[col])); });
    sample_gemm(F, DM / 16, DPLE, DPLE, DPLE,
        [=](int item, const bf16_t*& A, const bf16_t*& B) { A = PBs; B = WP + (size_t)item * 16 * DPLE; },
        [=](int item, int r, int c, float acc) { EB[(size_t)r * DM + item * 16 + c] = f2bf(acc); });
}
template <class PtrF, class Ef>
__device__ __forceinline__ void sample_gemm_ks(const Ctx& F, int nitems, int K, int lda, int ldb, const PtrF& P, const Ef& E) {
    const int l15 = F.lane & 15, lq = F.lane >> 4, w = F.wave; LAS f32x4* red = (LAS f32x4*)F.lds;
    const int ks = K >> 3;
    for (int item = F.bid; item < nitems; item += F.G) {
        const bf16_t* A; const bf16_t* B; P(item, A, B);
        const bf16_t* ap = A + (size_t)l15 * lda + w * ks + 8 * lq; const bf16_t* bp = B + (size_t)l15 * ldb + w * ks + 8 * lq;
        f32x4 acc[2][4];
#pragma unroll
        for (int m = 0; m < 2; ++m)
#pragma unroll
            for (int n = 0; n < 4; ++n) acc[m][n] = (f32x4){0.f, 0.f, 0.f, 0.f};
        for (int k0 = 0; k0 < ks; k0 += 128) { bf16x8 a[4][2], b[4][4];
#pragma unroll
            for (int j = 0; j < 4; ++j) {
#pragma unroll
                for (int m = 0; m < 2; ++m) a[j][m] = (k0 + 32 * j < ks) ? *(const bf16x8*)(ap + (size_t)(16 * m) * lda + k0 + 32 * j) : (bf16x8){0, 0, 0, 0, 0, 0, 0, 0};
#pragma unroll
                for (int n = 0; n < 4; ++n) b[j][n] = (k0 + 32 * j < ks) ? *(const bf16x8*)(bp + (size_t)(16 * n) * ldb + k0 + 32 * j) : (bf16x8){0, 0, 0, 0, 0, 0, 0, 0}; }
#pragma unroll
            for (int j = 0; j < 4; ++j)
#pragma unroll
                for (int m = 0; m < 2; ++m)
#pragma unroll
                    for (int n = 0; n < 4; ++n) acc[m][n] = __builtin_amdgcn_mfma_f32_16x16x32_bf16(a[j][m], b[j][n], acc[m][n], 0, 0, 0); }
        __syncthreads();
#pragma unroll
        for (int m = 0; m < 2; ++m)
#pragma unroll
            for (int n = 0; n < 4; ++n) red[(w * 8 + m * 4 + n) * 64 + F.lane] = acc[m][n];
        __syncthreads();
        f32x4 s = red[(0 * 8 + w) * 64 + F.lane];
#pragma unroll
        for (int ww = 1; ww < 8; ++ww) s = s + red[(ww * 8 + w) * 64 + F.lane];
        const int mt = w >> 2, nt = w & 3;
#pragma unroll
        for (int r = 0; r < 4; ++r) E(item, 16 * mt + 4 * lq + r, 16 * nt + l15, s[r]);
    }
    __syncthreads();
}
__device__ __forceinline__ void sample_outproj_ks(const Ctx& F) {
    unsigned char* ws = F.ws; const bf16_t* Y = (const bf16_t*)(ws + WS_Y) + (size_t)MP * DMIX; const bf16_t* W = (const bf16_t*)(ws + WS_WOUT);
    const float* xs = F.in[1]; float* out = F.out + O_YS; bf16_t* X1B = (bf16_t*)(ws + WS_X1B) + (size_t)MP * DM;
    sample_gemm_ks(F, 64, DMIX, DMIX, DMIX,
        [=](int item, const bf16_t*& A, const bf16_t*& B) { A = Y + (size_t)(item & 3) * 32 * DMIX; B = W + (size_t)(item >> 2) * 64 * DMIX; },
        [=](int item, int r, int c, float acc) { const int row = (item & 3) * 32 + r, col = (item >> 2) * 64 + c; const float v = xs[(size_t)row * DM + col] + acc; X1B[(size_t)row * DM + col] = f2bf(v); });
}
__device__ __forceinline__ void sample_ple_ks(const Ctx& F) {
    unsigned char* ws = F.ws; const bf16_t* X1B = (const bf16_t*)(ws + WS_X1B) + (size_t)MP * DM; const bf16_t* PBs = (const bf16_t*)(ws + WS_PB) + (size_t)MP * DPLE;
    const bf16_t* WG = (const bf16_t*)(ws + WS_WPG); const bf16_t* WP = (const bf16_t*)(ws + WS_WPP); const float* bias = F.in[25];
    bf16_t* GB = (bf16_t*)(ws + WS_GB) + (size_t)MP * DM; bf16_t* EB = (bf16_t*)(ws + WS_EB) + (size_t)MP * DM;
    sample_gemm_ks(F, 64, DM, DM, DM,
        [=](int item, const bf16_t*& A, const bf16_t*& B) { A = X1B + (size_t)(item & 3) * 32 * DM; B = WG + (size_t)(item >> 2) * 64 * DM; },
        [=](int item, int r, int c, float acc) { const int row = (item & 3) * 32 + r, col = (item >> 2) * 64 + c; GB[(size_t)row * DM + col] = f2bf(sigmoidf_(acc + bias[col])); });
    sample_gemm_ks(F, 64, DPLE, DPLE, DPLE,
        [=](int item, const bf16_t*& A, const bf16_t*& B) { A = PBs + (size_t)(item & 3) * 32 * DPLE; B = WP + (size_t)(item >> 2) * 64 * DPLE; },
        [=](int item, int r, int c, float acc) { const int row = (item & 3) * 32 + r, col = (item >> 2) * 64 + c; EB[(size_t)row * DM + col] = f2bf(acc); });
}
#define XB_TMO      128
#define XB_XCNT(j)  (256  + 64 * (j))
#define XB_XSUB(j)  (1280 + 64 * (j))
#define XB_XGEN(j)  (2304 + 64 * (j))
#define XB_TOP      3328
#define XB_TOPGEN   3392
#define XCD_BAR_WORDS 3456
#define XB_SPIN_CAP (1u << 18)
__device__ __forceinline__ unsigned xb_ld(unsigned* p)              { return __hip_atomic_load(p, __ATOMIC_RELAXED, __HIP_MEMORY_SCOPE_AGENT); }
__device__ __forceinline__ unsigned xb_add(unsigned* p, unsigned v) { return __hip_atomic_fetch_add(p, v, __ATOMIC_RELAXED, __HIP_MEMORY_SCOPE_AGENT); }
__device__ __forceinline__ unsigned xb_xcc_id() { return (unsigned)__builtin_amdgcn_s_getreg((3 << 11) | 20) & 0xFu; }
#define XB_SPIN(cond, bar) do { unsigned _sp = 0; while (cond) { __builtin_amdgcn_s_sleep(1); \
    if ((++_sp & 255u) == 0u) { if (xb_ld(&(bar)[XB_TMO])) break; if (_sp > XB_SPIN_CAP) { atomicAdd(&(bar)[XB_TMO], 1u); break; } } } } while (0)
struct XcdBarrier { unsigned* bar; unsigned x; volatile LAS unsigned* st; };
__device__ __forceinline__ XcdBarrier xcd_barrier_post(unsigned* bar, volatile LAS unsigned* st) {
    XcdBarrier b; b.bar = bar; b.x = xb_xcc_id(); b.st = st;
    if (threadIdx.x == 0) (void)xb_add(&bar[XB_XCNT(b.x)], 1u);
    return b;
}
__device__ __forceinline__ void xcd_barrier_complete(unsigned* bar, unsigned x, unsigned& nloc, unsigned& nx) {
    const unsigned G = gridDim.x * gridDim.y * gridDim.z;
    unsigned sum, cnt, mine, sp = 0u;
    for (;;) {
        sum = 0u; cnt = 0u; mine = 0u;
#pragma unroll
        for (unsigned j = 0; j < 16; ++j) { const unsigned c = xb_ld(&bar[XB_XCNT(j)]); sum += c; cnt += (c > 0u) ? 1u : 0u; mine = (j == x) ? c : mine; }
        if (sum == G) break;
        __builtin_amdgcn_s_sleep(1);
        if ((++sp & 255u) == 0u) { if (xb_ld(&bar[XB_TMO])) break; if (sp > XB_SPIN_CAP) { atomicAdd(&bar[XB_TMO], 1u); break; } }
    }
    nloc = mine > 0u ? mine : 1u; nx = cnt > 0u ? cnt : 1u;
}
__device__ __forceinline__ void xcd_barrier(const XcdBarrier& b) {
    asm volatile("s_waitcnt vmcnt(0)" ::: "memory");
    __syncthreads();
    if (threadIdx.x == 0) {
        unsigned* bar = b.bar;
        __builtin_amdgcn_s_waitcnt(0);
        unsigned nloc = b.st[0], nx = b.st[1];
        if (nloc == 0u) { xcd_barrier_complete(bar, b.x, nloc, nx); b.st[0] = nloc; b.st[1] = nx; }
        const unsigned old = xb_add(&bar[XB_XSUB(b.x)], 1u);
        const unsigned gen = old / nloc;
        if (old + 1u == (gen + 1u) * nloc) {
            __builtin_amdgcn_fence(__ATOMIC_RELEASE, "agent");
            asm volatile("s_waitcnt vmcnt(0)" ::: "memory");
            const unsigned og = xb_add(&bar[XB_TOP], 1u);
            const unsigned tg = og / nx;
            if (og + 1u == (tg + 1u) * nx) xb_add(&bar[XB_TOPGEN], 1u);
            else XB_SPIN(xb_ld(&bar[XB_TOPGEN]) == tg, bar);
            __builtin_amdgcn_fence(__ATOMIC_ACQUIRE, "agent");
            xb_add(&bar[XB_XGEN(b.x)], 1u);
            asm volatile("s_waitcnt vmcnt(0)" ::: "memory");
        } else {
            XB_SPIN(xb_ld(&bar[XB_XGEN(b.x)]) == gen, bar);
            __builtin_amdgcn_fence(__ATOMIC_ACQUIRE, "agent");
            asm volatile("s_waitcnt vmcnt(0)" ::: "memory");
        }
    }
    __syncthreads();
}
__global__ void __launch_bounds__(512, 2) mega(Args args) {
    MAKE_CTX();
    volatile LAS unsigned* MISC = (volatile LAS unsigned*)(F.lds + 131072 + 320);
    if (F.tid < 32) MISC[F.tid] = 0u;
    __syncthreads();
    const XcdBarrier bar = xcd_barrier_post((unsigned*)(ws + WS_CTL), MISC + 8);
#define GRID_SYNC() xcd_barrier(bar)
    p0_prologue(F);      GRID_SYNC();
    sample_inproj(F); p1_inproj(F); GRID_SYNC();
    p2a_conv_gates(F); p2b_spatial_units(F); GRID_SYNC();
    p2b_mscan(F); p3_s12(F); GRID_SYNC();
    p3_qkv(F);           GRID_SYNC();
    if (F.bid & 1) { p5s_sample(F); p4_scores_dc(F); } else { p4_scores_dc(F); p5s_sample(F); } GRID_SYNC();
    p5_scan_sample(F);   GRID_SYNC();
    p6_hout(F);          GRID_SYNC();
    sample_outproj_ks(F); p7_outproj(F); GRID_SYNC();
    p8_ple(F);           GRID_SYNC();
    p9_final(F);
}

extern "C" void kernel_launch(void* const* d_in, const int* in_sizes, int n_in, void* d_out, int out_size, void* d_ws, size_t ws_size, hipStream_t stream) {
    static int grid = 0;
    if (grid == 0) {
        if (n_in != 29 || (size_t)out_size != O_END || ws_size < WS_END) { fprintf(stderr, "kernel_launch: unexpected shapes (n_in %d out %d ws %zu)\n", n_in, out_size, ws_size); grid = -1; return; }
        int dev = 0, cus = 0, per_cu = 0;
        if (hipGetDevice(&dev) != hipSuccess || hipDeviceGetAttribute(&cus, hipDeviceAttributeMultiprocessorCount, dev) != hipSuccess) { grid = -1; return; }
        if (hipFuncSetAttribute((const void*)mega, hipFuncAttributeMaxDynamicSharedMemorySize, LDS_BYTES) != hipSuccess) { fprintf(stderr, "kernel_launch: hipFuncSetAttribute failed\n"); grid = -1; return; }
        if (hipOccupancyMaxActiveBlocksPerMultiprocessor(&per_cu, (const void*)mega, 512, LDS_BYTES) != hipSuccess || per_cu < 1) { fprintf(stderr, "kernel_launch: occupancy query says %d\n", per_cu); grid = -1; return; }
        (void)hipGetLastError();
        grid = cus;
        if (grid != 256) { fprintf(stderr, "kernel_launch: this kernel is laid out for 256 CUs, got %d\n", grid); grid = -1; return; }
    }
    if (grid < 0) return;
    if (hipMemsetAsync((unsigned char*)d_ws + WS_CTL, 0, 16384, stream) != hipSuccess) { fprintf(stderr, "kernel_launch: memset failed\n"); return; }
    Args a{};
    for (int i = 0; i < 29; ++i) a.in[i] = (const float*)d_in[i];
    a.out = (float*)d_out; a.ws = (unsigned char*)d_ws;
    void* kargs[] = {&a};
    hipError_t e = hipLaunchCooperativeKernel((const void*)mega, dim3(grid), dim3(512), kargs, LDS_BYTES, stream);
    if (e != hipSuccess) fprintf(stderr, "kernel_launch: cooperative launch failed: %s (grid %d)\n", hipGetErrorString(e), grid);
}
```

```cpp
#include <hip/hip_runtime.h>
#include <hip/hip_cooperative_groups.h>
#include <cstdio>
#include <cstdint>
namespace cg = cooperative_groups;

#define LAS __attribute__((address_space(3)))
typedef unsigned short bf16_t;
typedef short bf16x8 __attribute__((ext_vector_type(8)));
typedef float f32x4 __attribute__((ext_vector_type(4)));
typedef float f32x2 __attribute__((ext_vector_type(2)));
typedef unsigned u32x4 __attribute__((ext_vector_type(4)));
typedef unsigned u32x2 __attribute__((ext_vector_type(2)));

constexpr int DM = 1024, SEQ = 2048, NB = 8, MP = NB * SEQ, MS = 128, MA = MP + 256, NTILE = MA / 256;
constexpr int NIN = 6144, WA = 1024, WB = 1024, HA = 8, DHA = 128, HB = 4, DHB = 256, DPLE = 256, DMIX = 2048;
constexpr int LC = 256, NCH = SEQ / LC;
constexpr int NUNIT = NB * HB * NCH;
constexpr float EPS = 1e-6f;

constexpr size_t O_Y = 0, O_YS = 16777216, O_CP = 16908288, O_NP = 19005440, O_MP = 19013632, O_CVP = 19013664, O_CS = 19038240, O_NS = 52592672, O_MS = 52723744, O_CVS = 52724256, O_VS = 53117472, O_END = 53248544;

constexpr size_t MiB = 1u << 20;
constexpr size_t WS_CTL = 0, WS_WIN = 1 * MiB, WS_WQ = 13 * MiB, WS_WK = WS_WQ + MiB / 2, WS_WV = 14 * MiB, WS_WOUT = WS_WV + MiB / 2, WS_WPG = WS_WOUT + 4 * MiB, WS_WPP = WS_WPG + 2 * MiB,
    WS_WSP = 21 * MiB, WS_WG = WS_WSP + MiB / 4, WS_RS = WS_WG + MiB / 4, WS_GLI = 22 * MiB, WS_GLF = WS_GLI + MiB / 2, WS_DA = 23 * MiB, WS_DR = WS_DA + MiB / 2, WS_DG = 24 * MiB, WS_DEM = WS_DG + MiB / 2,
    WS_DW = 25 * MiB, WS_QN = WS_DW + MiB / 2, WS_DENP = 26 * MiB, WS_DN = 27 * MiB, WS_VS = WS_DN + MiB / 2, WS_PB = 28 * MiB, WS_XB = 37 * MiB, WS_PROJA = 70 * MiB, WS_PROJB = 168 * MiB,
    WS_PQ = 266 * MiB, WS_VC = 330 * MiB, WS_Y = 394 * MiB, WS_XB2 = 460 * MiB, WS_DN4 = 493 * MiB, WS_END = 495 * MiB;
constexpr size_t WS_WGB = WS_RS + MiB / 8;
constexpr size_t WS_Q = WS_PROJA, WS_K = WS_Q + 33 * MiB, WS_WKT = WS_K + 33 * MiB;
constexpr size_t WS_X1B = WS_PROJA, WS_GB = WS_X1B + 33 * MiB, WS_EB = WS_GB + 33 * MiB;
static_assert(WS_WKT + 32 * MiB <= WS_PROJB && WS_EB + 33 * MiB <= WS_PQ, "ws map");

__device__ __forceinline__ unsigned cvt_pk_bf16(float lo, float hi) { unsigned r; asm volatile("v_cvt_pk_bf16_f32 %0, %1, %2" : "=v"(r) : "v"(lo), "v"(hi)); return r; }
__device__ __forceinline__ float bf_lo(unsigned w) { return __uint_as_float(w << 16); }
__device__ __forceinline__ float bf_hi(unsigned w) { return __uint_as_float(w & 0xffff0000u); }
__device__ __forceinline__ float bf2f(bf16_t b) { return __uint_as_float(((unsigned)b) << 16); }
__device__ __forceinline__ bf16_t f2bf(float f) { return (bf16_t)(cvt_pk_bf16(f, 0.f) & 0xffffu); }
__device__ __forceinline__ float fast_exp(float x) { return __builtin_amdgcn_exp2f(x * 1.4426950408889634f); }
__device__ __forceinline__ float sigmoidf_(float x) { return __builtin_amdgcn_rcpf(1.0f + fast_exp(-x)); }
__device__ __forceinline__ float siluf_(float x) { return x * sigmoidf_(x); }
__device__ __forceinline__ f32x2 gelu_pk(f32x2 v) {
    const f32x2 av = __builtin_elementwise_abs(v), d = av * 0.2316418882f + 1.0f;
    f32x2 t; t.x = __builtin_amdgcn_rcpf(d.x); t.y = __builtin_amdgcn_rcpf(d.y);
    f32x2 q = t * 0.5307027145f + (-0.7265760135f); q = q * t + 0.7107068705f; q = q * t + (-0.142248368f); q = q * t + 0.127414796f; q = q * t;
    const f32x2 s = (v * v) * (-0.72134752044f);
    f32x2 e; e.x = __builtin_amdgcn_exp2f(s.x); e.y = __builtin_amdgcn_exp2f(s.y);
    const f32x2 m = v * (q * e), r = v - m;
    f32x2 o; o.x = v.x < 0.f ? m.x : r.x; o.y = v.y < 0.f ? m.y : r.y; return o;
}
__device__ __forceinline__ float dpp_add(float v, const int ctrl_sel) {
    const int iv = __builtin_bit_cast(int, v); int r;
    if (ctrl_sel == 0) r = __builtin_amdgcn_update_dpp(0, iv, 0xB1, 0xF, 0xF, true);
    else if (ctrl_sel == 1) r = __builtin_amdgcn_update_dpp(0, iv, 0x4E, 0xF, 0xF, true);
    else if (ctrl_sel == 2) r = __builtin_amdgcn_update_dpp(0, iv, 0x141, 0xF, 0xF, true);
    else r = __builtin_amdgcn_update_dpp(0, iv, 0x140, 0xF, 0xF, true);
    return v + __builtin_bit_cast(float, r);
}
__device__ __forceinline__ float wave_sum(float v) {
    v = dpp_add(v, 0); v = dpp_add(v, 1); v = dpp_add(v, 2); v = dpp_add(v, 3);
    const int iv = __builtin_bit_cast(int, v);
    const float r0 = __builtin_bit_cast(float, __builtin_amdgcn_readlane(iv, 0)), r1 = __builtin_bit_cast(float, __builtin_amdgcn_readlane(iv, 16)),
                r2 = __builtin_bit_cast(float, __builtin_amdgcn_readlane(iv, 32)), r3 = __builtin_bit_cast(float, __builtin_amdgcn_readlane(iv, 48));
    return (r0 + r1) + (r2 + r3);
}
#define LDS_WAIT() asm volatile("s_waitcnt lgkmcnt(0)" ::: "memory")

namespace pg8 {
constexpr int BM = 256, BK = 64, HALF = 128, HTB = HALF * BK * 2, STAGE_BYTES = 8 * HTB;
__host__ __device__ __forceinline__ int lds_byte(int r, int c) { const int st = (r >> 4) * 2 + (c >> 5), rr = r & 15, cc = c & 31, ob = rr * 64 + cc * 2; return st * 1024 + (ob ^ (((ob >> 9) & 1) << 5)); }
__host__ __device__ __forceinline__ void stage_rc(int b, int& R, int& C) { const int st = b / 1024, sb = b % 1024, swz = sb ^ (((sb >> 9) & 1) << 5); R = (st >> 1) * 16 + swz / 64; C = (st & 1) * 32 + (swz % 64) / 2; }
__host__ __device__ __forceinline__ int perm32(int rho) { const int n = rho >> 4, i = rho & 15; return 8 * (i >> 2) + 4 * n + (i & 3); }

struct Unit { const char* a; const char* b; int pm, pn, aux; };
struct Gemm { int lda, ldb, K; };

template <class Epi, class Sched, bool ALIGN_EPI = true, bool SP2 = true>
__device__ __forceinline__ void gemm_phase(LAS unsigned char* lds, const Gemm g, const Sched& S, const Epi& E) {
    int tid_ = threadIdx.x; asm volatile("" : "+v"(tid_));
    const int tid = tid_, wid = __builtin_amdgcn_readfirstlane(tid >> 6), lane = tid & 63, wr = wid >> 2, wc = wid & 3, fr = lane & 15, fq = lane >> 4;
    int K_ = g.K; asm volatile("" : "+s"(K_)); const int K = K_, nt = K / BK; (void)K;
    unsigned voffA[2], voffB[2];
#pragma unroll
    for (int i = 0; i < 2; ++i) { int R, C; stage_rc(tid * 16 + i * 8192, R, C); const int Rb = Epi::PERM ? ((R & ~31) + perm32(R & 31)) : R;
        voffA[i] = (unsigned)(R * g.lda + C) * 2u; voffB[i] = (unsigned)(Rb * g.ldb + C) * 2u; }
    const size_t kstep = (size_t)(BK * 2);
    const size_t hstepA = (size_t)HALF * g.lda * 2, hstepB = (size_t)HALF * g.ldb * 2;
    const unsigned ldsw = (unsigned)wid * 1024u;
    const int aoff = lds_byte(wr * 64 + fr, fq * 8), boff = lds_byte(wc * 32 + fr, fq * 8);
#define PG8_SA(b, h) (((b) * 2 + (h)) * HTB)
#define PG8_SB(b, h) ((4 + (b) * 2 + (h)) * HTB)
#define PG8_STAGE(bufoff, gbase, voff) do { _Pragma("unroll") for (int _i = 0; _i < 2; ++_i) \
        __builtin_amdgcn_global_load_lds((const unsigned*)((const char*)(gbase) + (voff)[_i]), (LAS unsigned*)(lds + (bufoff) + ldsw + _i * 8192), 16, 0, 0); } while (0)
#define PG8_LDA(dst, b, h) do { _Pragma("unroll") for (int m = 0; m < 4; ++m) _Pragma("unroll") for (int k = 0; k < 2; ++k) dst[m][k] = *(const LAS bf16x8*)(lds + PG8_SA(b, h) + aoff + m * 2048 + k * 1024); } while (0)
#define PG8_LDB(dst, b, h) do { _Pragma("unroll") for (int n = 0; n < 2; ++n) _Pragma("unroll") for (int k = 0; k < 2; ++k) dst[n][k] = *(const LAS bf16x8*)(lds + PG8_SB(b, h) + boff + n * 2048 + k * 1024); } while (0)
#define PG8_MMA(ai, bj, At, Bt) do { __builtin_amdgcn_s_setprio(1); _Pragma("unroll") for (int m = 0; m < 4; ++m) _Pragma("unroll") for (int n = 0; n < 2; ++n) _Pragma("unroll") for (int k = 0; k < 2; ++k) \
        acc[ai][bj][m][n] = __builtin_amdgcn_mfma_f32_16x16x32_bf16(Bt[n][k], At[m][k], acc[ai][bj][m][n], 0, 0, 0); __builtin_amdgcn_s_setprio(0); } while (0)
#define PG8_WAIT_V(n) asm volatile("s_waitcnt vmcnt(" #n ")" ::: "memory")
#define PG8_WAIT_L(n) asm volatile("s_waitcnt lgkmcnt(" #n ")" ::: "memory")
#define PG8_BAR __builtin_amdgcn_s_barrier()
#define PG8_SCHED __builtin_amdgcn_sched_barrier(0)
    Unit cur, nxt; int ui = 0;
    if (!S.next(0, cur)) return;
    f32x4 acc[2][2][4][2];
#pragma unroll
    for (int a = 0; a < 2; ++a)
#pragma unroll
        for (int b = 0; b < 2; ++b)
#pragma unroll
            for (int m = 0; m < 4; ++m)
#pragma unroll
                for (int n = 0; n < 2; ++n) acc[a][b][m][n] = (f32x4){0.f, 0.f, 0.f, 0.f};
    bf16x8 At[4][2], B0[2][2], B1[2][2];
    const char* cA = cur.a; const char* cB = cur.b;
    if constexpr (SP2) {
        PG8_STAGE(PG8_SB(0, 0), cB, voffB); PG8_STAGE(PG8_SB(0, 1), cB + hstepB, voffB); PG8_STAGE(PG8_SA(0, 0), cA, voffA); PG8_STAGE(PG8_SA(0, 1), cA + hstepA, voffA);
        if (wr == 1) PG8_BAR;
        PG8_WAIT_V(2); PG8_BAR;
        PG8_STAGE(PG8_SB(1, 0), cB + kstep, voffB); PG8_STAGE(PG8_SA(1, 0), cA + kstep, voffA); PG8_STAGE(PG8_SB(1, 1), cB + hstepB + kstep, voffB);
        PG8_WAIT_V(6); PG8_BAR;
    } else {
        PG8_STAGE(PG8_SB(0, 0), cB, voffB); PG8_STAGE(PG8_SA(0, 0), cA, voffA); PG8_STAGE(PG8_SB(0, 1), cB + hstepB, voffB); PG8_STAGE(PG8_SA(0, 1), cA + hstepA, voffA);
        if (wr == 1) PG8_BAR;
        PG8_WAIT_V(4); PG8_BAR;
        PG8_STAGE(PG8_SB(1, 0), cB + kstep, voffB); PG8_STAGE(PG8_SA(1, 0), cA + kstep, voffA); PG8_STAGE(PG8_SB(1, 1), cB + hstepB + kstep, voffB);
        PG8_WAIT_V(6); PG8_BAR;
    }
    for (;;) {
        const bool has_next = S.next(ui + 1, nxt);
        const char* nA = has_next ? nxt.a : cA; const char* nB = has_next ? nxt.b : cB;
#pragma unroll 1
        for (int t = 0; t < nt; t += 2) {
            const bool last = (t == nt - 2);
            const char* a1 = cA + (size_t)(t + 1) * kstep;
            const char* a2 = last ? nA : cA + (size_t)(t + 2) * kstep; const char* b2 = last ? nB : cB + (size_t)(t + 2) * kstep;
            const char* a3 = a2 + kstep; const char* b3 = b2 + kstep;
            if constexpr (SP2) {
            PG8_LDB(B0, 0, 0); PG8_LDB(B1, 0, 1); PG8_SCHED; PG8_LDA(At, 0, 0); PG8_STAGE(PG8_SA(1, 1), a1 + hstepA, voffA);
            PG8_WAIT_V(8); PG8_WAIT_L(0); PG8_BAR; PG8_MMA(0, 0, At, B0); PG8_MMA(0, 1, At, B1); PG8_BAR; PG8_SCHED;
            PG8_LDA(At, 0, 1); PG8_STAGE(PG8_SB(0, 0), b2, voffB); PG8_STAGE(PG8_SB(0, 1), b2 + hstepB, voffB); PG8_STAGE(PG8_SA(0, 0), a2, voffA);
            PG8_WAIT_V(8); PG8_WAIT_L(0); PG8_BAR; PG8_MMA(1, 0, At, B0); PG8_MMA(1, 1, At, B1); PG8_BAR; PG8_SCHED;
            PG8_LDB(B0, 1, 0); PG8_LDB(B1, 1, 1); PG8_SCHED; PG8_LDA(At, 1, 0); PG8_STAGE(PG8_SA(0, 1), a2 + hstepA, voffA);
            PG8_WAIT_V(8); PG8_WAIT_L(0); PG8_BAR; PG8_MMA(0, 0, At, B0); PG8_MMA(0, 1, At, B1); PG8_BAR; PG8_SCHED;
            PG8_LDA(At, 1, 1); PG8_STAGE(PG8_SB(1, 0), b3, voffB); PG8_STAGE(PG8_SB(1, 1), b3 + hstepB, voffB); PG8_STAGE(PG8_SA(1, 0), a3, voffA);
            PG8_WAIT_V(8); PG8_WAIT_L(0); PG8_BAR; PG8_MMA(1, 0, At, B0); PG8_MMA(1, 1, At, B1); PG8_BAR; PG8_SCHED;
            } else {
            PG8_LDB(B0, 0, 0); PG8_SCHED; PG8_LDA(At, 0, 0); PG8_STAGE(PG8_SA(1, 1), a1 + hstepA, voffA);
            PG8_WAIT_L(8); PG8_BAR; PG8_WAIT_L(0); PG8_MMA(0, 0, At, B0); PG8_BAR; PG8_SCHED;
            PG8_LDB(B1, 0, 1); PG8_STAGE(PG8_SB(0, 0), b2, voffB);
            PG8_BAR; PG8_WAIT_L(0); PG8_MMA(0, 1, At, B1); PG8_BAR;
            PG8_LDA(At, 0, 1); PG8_STAGE(PG8_SA(0, 0), a2, voffA);
            PG8_BAR; PG8_WAIT_L(0); PG8_MMA(1, 0, At, B0); PG8_BAR; PG8_SCHED;
            PG8_STAGE(PG8_SB(0, 1), b2 + hstepB, voffB);
            PG8_WAIT_V(6); PG8_BAR; PG8_MMA(1, 1, At, B1); PG8_BAR;
            PG8_LDB(B0, 1, 0); PG8_SCHED; PG8_LDA(At, 1, 0); PG8_STAGE(PG8_SA(0, 1), a2 + hstepA, voffA);
            PG8_WAIT_L(8); PG8_BAR; PG8_WAIT_L(0); PG8_MMA(0, 0, At, B0); PG8_BAR; PG8_SCHED;
            PG8_LDB(B1, 1, 1); PG8_STAGE(PG8_SB(1, 0), b3, voffB);
            PG8_BAR; PG8_WAIT_L(0); PG8_MMA(0, 1, At, B1); PG8_BAR;
            PG8_LDA(At, 1, 1); PG8_STAGE(PG8_SA(1, 0), a3, voffA);
            PG8_BAR; PG8_WAIT_L(0); PG8_MMA(1, 0, At, B0); PG8_BAR; PG8_SCHED;
            PG8_STAGE(PG8_SB(1, 1), b3 + hstepB, voffB);
            PG8_WAIT_V(6); PG8_BAR; PG8_MMA(1, 1, At, B1); PG8_BAR;
            }
        }
        if constexpr (ALIGN_EPI) { if (wr == 0) PG8_BAR; }
        if constexpr (!Epi::AFTER_DRAIN) { E(acc, cur, wr, wc, fr, fq); }
        if (!has_next) break;
#pragma unroll
        for (int a = 0; a < 2; ++a)
#pragma unroll
            for (int b = 0; b < 2; ++b)
#pragma unroll
                for (int m = 0; m < 4; ++m)
#pragma unroll
                    for (int n = 0; n < 2; ++n) acc[a][b][m][n] = (f32x4){0.f, 0.f, 0.f, 0.f};
        cur = nxt; cA = nA; cB = nB; ++ui;
        if constexpr (ALIGN_EPI) { if (wr == 1) PG8_BAR; }
    }
    PG8_WAIT_V(0);
    if constexpr (!ALIGN_EPI) { if (wr == 0) PG8_BAR; }
    PG8_BAR;
    if constexpr (Epi::AFTER_DRAIN) { E.fused(acc, cur, wr, wc, fr, fq, lds, wid, lane); }
#undef PG8_SA
#undef PG8_SB
#undef PG8_STAGE
#undef PG8_LDA
#undef PG8_LDB
#undef PG8_MMA
#undef PG8_WAIT_V
#undef PG8_WAIT_L
#undef PG8_BAR
#undef PG8_SCHED
}
}
using pg8::Unit; using pg8::Gemm;

constexpr int LDS_BYTES = 147456;
struct Args { const float* in[29]; float* out; unsigned char* ws; };

struct Ctx {
    LAS unsigned char* lds; int tid, lane, wave, G, bid, gw, NGW;
    const float* const* in; float* out; unsigned char* ws;
};

__device__ __forceinline__ void p0_transpose_item(const float* W, int ldw, bf16_t* WT, int ldt, const float* kscale, LAS float* scr, int kb, int nb, int lane) {
    const int k0 = 64 * kb, n0 = 32 * nb;
    float wv_[32];
#pragma unroll
    for (int i = 0; i < 32; ++i) { const int kk = 2 * i + (lane >> 5); wv_[i] = __builtin_nontemporal_load(W + (size_t)(k0 + kk) * ldw + n0 + (lane & 31)); }
#pragma unroll
    for (int i = 0; i < 32; ++i) { const int kk = 2 * i + (lane >> 5); float v = wv_[i]; if (kscale) v *= kscale[k0 + kk]; scr[kk * 33 + (lane & 31)] = v; }
    LDS_WAIT(); asm volatile("" ::: "memory");
    const int c = lane & 7;
#pragma unroll
    for (int j = 0; j < 4; ++j) { const int n = (lane >> 3) + 8 * j; const LAS float* s = scr + (8 * c) * 33 + n;
        u32x4 o; o.x = cvt_pk_bf16(s[0 * 33], s[1 * 33]); o.y = cvt_pk_bf16(s[2 * 33], s[3 * 33]); o.z = cvt_pk_bf16(s[4 * 33], s[5 * 33]); o.w = cvt_pk_bf16(s[6 * 33], s[7 * 33]);
        *(u32x4*)(WT + (size_t)(n0 + n) * ldt + k0 + 8 * c) = o; }
    LDS_WAIT(); asm volatile("" ::: "memory");
}

__device__ __forceinline__ void p0_prologue(const Ctx& F0) { Ctx F = F0; asm volatile("" : "+v"(F.tid), "+v"(F.lane), "+s"(F.gw));
    LAS float* scr = (LAS float*)(F.lds + F.wave * 16384);
    unsigned char* ws = F.ws;
    constexpr int I_WIN = 16 * 192, I_QKV = 12 * 4 * 8, I_WOUT = 32 * 32, I_WPG = 16 * 32, I_WPP = 4 * 32;
    constexpr int I_T = I_WIN + I_QKV + I_WOUT + I_WPG + I_WPP;
    constexpr int I_X = 0, I_P = 0, I_SP = 1024, I_WG = 1024, I_YPAD = 128;
    constexpr int NITEMS = I_T + I_X + I_P + I_SP + I_WG + I_YPAD;
    for (int it = F.gw; it < NITEMS; it += F.NGW) {
        int r = it;
        if (r < I_T) {
            if (r < I_WIN) { p0_transpose_item(F.in[9], NIN, (bf16_t*)(ws + WS_WIN), DM, F.in[8], scr, r / 192, r % 192, F.lane); continue; } r -= I_WIN;
            if (r < I_QKV) { const int mat = r / 32, rr = r % 32, which = mat / 4, h = mat % 4;
                const float* W = F.in[16 + which] + (size_t)h * 65536; bf16_t* WT = (bf16_t*)(ws + (which == 0 ? WS_WQ : which == 1 ? WS_WK : WS_WV)) + (size_t)h * 65536;
                p0_transpose_item(W, 256, WT, 256, nullptr, scr, rr / 8, rr % 8, F.lane); continue; } r -= I_QKV;
            if (r < I_WOUT) { p0_transpose_item(F.in[23], DM, (bf16_t*)(ws + WS_WOUT), DMIX, nullptr, scr, r / 32, r % 32, F.lane); continue; } r -= I_WOUT;
            if (r < I_WPG) { p0_transpose_item(F.in[24], DM, (bf16_t*)(ws + WS_WPG), DM, nullptr, scr, r / 32, r % 32, F.lane); continue; } r -= I_WPG;
            p0_transpose_item(F.in[26], DM, (bf16_t*)(ws + WS_WPP), DPLE, nullptr, scr, r / 32, r % 32, F.lane); continue;
        }
        r -= I_T;
        if (r < I_X) {
            bf16_t* orow = (bf16_t*)(ws + WS_XB) + (size_t)r * DM; float* rs = (float*)(ws + WS_RS);
            unsigned long long* o8 = (unsigned long long*)orow + F.lane;
            if (r >= MP + MS) {
#pragma unroll
                for (int j = 0; j < 4; ++j) o8[64 * j] = 0ull;
                if (F.lane == 0) rs[r] = 0.f; continue; }
            const float* xrow = r < MP ? F.in[0] + (size_t)r * DM : F.in[1] + (size_t)(r - MP) * DM;
            const f32x4* xr = (const f32x4*)xrow + F.lane; f32x4 v[4]; float s = 0.f;
#pragma unroll
            for (int j = 0; j < 4; ++j) { v[j] = xr[64 * j]; s += (v[j].x * v[j].x + v[j].y * v[j].y) + (v[j].z * v[j].z + v[j].w * v[j].w); }
            s = wave_sum(s);
#pragma unroll
            for (int j = 0; j < 4; ++j) o8[64 * j] = (unsigned long long)cvt_pk_bf16(v[j].x, v[j].y) | ((unsigned long long)cvt_pk_bf16(v[j].z, v[j].w) << 32);
            if (F.lane == 0) rs[r] = 1.0f / sqrtf(s * (1.0f / DM) + EPS);
            continue;
        }
        r -= I_X;
        if (r < I_P) {
            unsigned long long* o8 = (unsigned long long*)((bf16_t*)(ws + WS_PB) + (size_t)r * DPLE) + F.lane;
            if (r >= MP + MS) { o8[0] = 0ull; continue; }
            const float* prow = r < MP ? F.in[6] + (size_t)r * DPLE : F.in[7] + (size_t)(r - MP) * DPLE;
            const f32x4 v = __builtin_nontemporal_load((const f32x4*)prow + F.lane);
            o8[0] = (unsigned long long)cvt_pk_bf16(v.x, v.y) | ((unsigned long long)cvt_pk_bf16(v.z, v.w) << 32);
            continue;
        }
        r -= I_P;
        if (r < I_SP) {
            const int t = r & 127; const float* wrow = F.in[12] + (size_t)r * 128; const f32x2 v = ((const f32x2*)wrow)[F.lane];
            const int s0 = 2 * F.lane; ((unsigned*)((bf16_t*)(ws + WS_WSP) + (size_t)r * 128))[F.lane] = cvt_pk_bf16(s0 <= t ? v.x : 0.f, s0 + 1 <= t ? v.y : 0.f);
            continue;
        }
        r -= I_SP;
        if (r < I_WG) {
            const int i = r, h = i >> 8, d = i & 255; const float* wif = F.in[19];
            const f32x4 wq4 = *(const f32x4*)(F.in[16] + ((size_t)h * 256 + d) * 256 + 4 * F.lane), wk4 = *(const f32x4*)(F.in[17] + ((size_t)h * 256 + d) * 256 + 4 * F.lane), wv4 = *(const f32x4*)(F.in[18] + ((size_t)h * 256 + d) * 256 + 4 * F.lane);
            float sx[8], sb[8];
#pragma unroll
            for (int j = 0; j < 8; ++j) { sx[j] = 0.f; sb[j] = 0.f; }
#pragma unroll
            for (int e = 0; e < 4; ++e) { const size_t rq = (size_t)(h * 256 + 4 * F.lane + e) * 8;
                const f32x4 q0 = *(const f32x4*)(wif + rq), q1 = *(const f32x4*)(wif + rq + 4), k0 = *(const f32x4*)(wif + 8192 + rq), k1 = *(const f32x4*)(wif + 8192 + rq + 4), v0 = *(const f32x4*)(wif + 16384 + rq), v1 = *(const f32x4*)(wif + 16384 + rq + 4);
#pragma unroll
                for (int j = 0; j < 4; ++j) { sx[j] += wq4[e] * q0[j] + wk4[e] * k0[j]; sx[4 + j] += wq4[e] * q1[j] + wk4[e] * k1[j]; sb[j] += wv4[e] * v0[j]; sb[4 + j] += wv4[e] * v1[j]; } }
#pragma unroll
            for (int j = 0; j < 8; ++j) { sx[j] = wave_sum(sx[j]); sb[j] = wave_sum(sb[j]); }
            float s = 0.f;
#pragma unroll
            for (int j = 0; j < 8; ++j) { s = (F.lane == j) ? sx[j] : s; s = (F.lane == 8 + j) ? sb[j] : s; }
            if (F.lane < 16) ((float*)(ws + WS_WG))[(size_t)i * 16 + F.lane] = s;
            if (F.lane < 16) { bf16_t* wgb = (bf16_t*)(ws + WS_WGB) + (size_t)(F.lane >> 3) * 16384 + (size_t)(F.lane & 7) * 1024 + i; wgb[0] = f2bf(s); wgb[8 * 1024] = 0; }
            continue;
        }
        r -= I_WG;
        {
            u32x4* yrow = (u32x4*)((bf16_t*)(ws + WS_Y) + (size_t)(MP + MS + r) * DMIX) + F.lane;
#pragma unroll
            for (int j = 0; j < 4; ++j) yrow[64 * j] = (u32x4){0u, 0u, 0u, 0u};
        }
    }
    {
        float* rs = (float*)(ws + WS_RS);
        for (int r0 = F.gw * 4; r0 < MP + MS; r0 += F.NGW * 4) { f32x4 v[4][4];
#pragma unroll
            for (int q = 0; q < 4; ++q) { const int r = r0 + q; const float* xrow = r < MP ? F.in[0] + (size_t)r * DM : F.in[1] + (size_t)(r - MP) * DM;
#pragma unroll
                for (int j = 0; j < 4; ++j) v[q][j] = __builtin_nontemporal_load((const f32x4*)xrow + F.lane + 64 * j); }
#pragma unroll
            for (int q = 0; q < 4; ++q) { const int r = r0 + q; float sq = 0.f;
#pragma unroll
                for (int j = 0; j < 4; ++j) sq += (v[q][j].x * v[q][j].x + v[q][j].y * v[q][j].y) + (v[q][j].z * v[q][j].z + v[q][j].w * v[q][j].w);
                sq = wave_sum(sq); unsigned long long* o8 = (unsigned long long*)((bf16_t*)(ws + WS_XB) + (size_t)r * DM) + F.lane;
#pragma unroll
                for (int j = 0; j < 4; ++j) o8[64 * j] = (unsigned long long)cvt_pk_bf16(v[q][j].x, v[q][j].y) | ((unsigned long long)cvt_pk_bf16(v[q][j].z, v[q][j].w) << 32);
                if (F.lane == 0) rs[r] = 1.0f / sqrtf(sq * (1.0f / DM) + EPS); } }
        for (int r = MP + MS + F.gw; r < MA; r += F.NGW) { unsigned long long* o8 = (unsigned long long*)((bf16_t*)(ws + WS_XB) + (size_t)r * DM) + F.lane;
#pragma unroll
            for (int j = 0; j < 4; ++j) o8[64 * j] = 0ull;
            if (F.lane == 0) rs[r] = 0.f; ((unsigned long long*)((bf16_t*)(ws + WS_PB) + (size_t)r * DPLE))[F.lane] = 0ull; }
        for (int r0 = F.gw * 8; r0 < MP + MS; r0 += F.NGW * 8) { f32x4 pv[8];
#pragma unroll
            for (int q = 0; q < 8; ++q) { const int r = r0 + q; const float* prow = r < MP ? F.in[6] + (size_t)r * DPLE : F.in[7] + (size_t)(r - MP) * DPLE; pv[q] = __builtin_nontemporal_load((const f32x4*)prow + F.lane); }
#pragma unroll
            for (int q = 0; q < 8; ++q) ((unsigned long long*)((bf16_t*)(ws + WS_PB) + (size_t)(r0 + q) * DPLE))[F.lane] = (unsigned long long)cvt_pk_bf16(pv[q].x, pv[q].y) | ((unsigned long long)cvt_pk_bf16(pv[q].z, pv[q].w) << 32); }
    }
}

struct OrderRowMajor {
    int nM, nN, n, G, c; const char* A; const char* B; size_t astep, bstep;
    __device__ __forceinline__ bool next(int i, Unit& u) const {
        const int L = i * G + c; if (L >= n) return false;
        u.pm = L / nN; u.pn = L % nN; u.aux = 0; u.a = A + (size_t)u.pm * astep; u.b = B + (size_t)u.pn * bstep; return true;
    }
};
struct OrderPanel4 {
    int n, G, c; const char* A; const char* B; size_t astep, bstep;
    __device__ __forceinline__ bool next(int i, Unit& u) const {
        const int L = i * G + c; if (L >= n) return false;
        if (L < 256) { const int x = L & 7, j = L >> 3; u.pm = x * 8 + (j >> 2); u.pn = j & 3; } else { u.pm = 64; u.pn = L - 256; }
        u.aux = 0; u.a = A + (size_t)u.pm * astep; u.b = B + (size_t)u.pn * bstep; return true;
    }
};
struct OrderProjSkip {
    int G, c; const char* A; const char* B; size_t astep, bstep;
    __device__ __forceinline__ bool next(int i, Unit& u) const {
        if (c < 4) return false; const int cp = c - 4; const int L = i == 0 ? cp : (i == 1 && cp < 8 ? 252 + cp : -1); if (L < 0) return false;
        if (L < 256) { const int x = L & 7, j = L >> 3; u.pm = x * 8 + (j >> 2); u.pn = j & 3; } else { u.pm = 64; u.pn = L - 256; }
        u.aux = 0; u.a = A + (size_t)u.pm * astep; u.b = B + (size_t)u.pn * bstep; return true;
    }
};
struct OrderXcd {
    int nM, nN, n, G, c; const char* A; const char* B; size_t astep, bstep;
    __device__ __forceinline__ bool next(int i, Unit& u) const {
        const int L = i * G + c; if (L >= n) return false;
        int wgid = L; { const int q = n / 8, r = n % 8, xcd = wgid % 8, off = wgid / 8; wgid = (xcd < r ? xcd * (q + 1) : r * (q + 1) + (xcd - r) * q) + off; }
        const int nig = 8 * nN, gid = wgid / nig, fm = gid * 8, gsz = (nM - fm) < 8 ? (nM - fm) : 8;
        u.pm = fm + ((wgid % nig) % gsz); u.pn = (wgid % nig) / gsz; u.aux = 0; u.a = A + (size_t)u.pm * astep; u.b = B + (size_t)u.pn * bstep; return true;
    }
};
struct EpiInProj {
    static constexpr bool PERM = true, AFTER_DRAIN = false;
    bf16_t* PA; bf16_t* PB; const float* rs;
    template <int KIND> __device__ __forceinline__ void run(const f32x4 (&acc)[2][2][4][2], bf16_t* base, int row0, int col0) const {
#pragma unroll
        for (int ai = 0; ai < 2; ++ai)
#pragma unroll
            for (int m = 0; m < 4; ++m) { const int row = row0 + ai * 128 + m * 16; const float s = rs[row]; bf16_t* rowp = base + (size_t)row * 3072 + col0;
#pragma unroll
                for (int bj = 0; bj < 2; ++bj) { f32x4 v0 = acc[ai][bj][m][0] * s, v1 = acc[ai][bj][m][1] * s;
                    if (KIND == 0) { f32x2 a = gelu_pk((f32x2){v0[0], v0[1]}), b = gelu_pk((f32x2){v0[2], v0[3]}), c = gelu_pk((f32x2){v1[0], v1[1]}), d = gelu_pk((f32x2){v1[2], v1[3]});
                        v0 = (f32x4){a.x, a.y, b.x, b.y}; v1 = (f32x4){c.x, c.y, d.x, d.y}; }
                    if (KIND == 1) {
#pragma unroll
                        for (int j = 0; j < 4; ++j) { v0[j] = siluf_(v0[j]); v1[j] = siluf_(v1[j]); } }
                    if (KIND == 3) {
#pragma unroll
                        for (int j = 0; j < 4; ++j) { v0[j] = sigmoidf_(v0[j]); v1[j] = sigmoidf_(v1[j]); } }
                    u32x4 w; w.x = cvt_pk_bf16(v0[0], v0[1]); w.y = cvt_pk_bf16(v0[2], v0[3]); w.z = cvt_pk_bf16(v1[0], v1[1]); w.w = cvt_pk_bf16(v1[2], v1[3]);
                    *(u32x4*)(rowp + bj * 128) = w; } }
    }
    __device__ __forceinline__ void operator()(const f32x4 (&acc)[2][2][4][2], const Unit& u, int wr, int wc, int fr, int fq) const {
        const int row0 = u.pm * 256 + wr * 64 + fr, pn = u.pn;
        bf16_t* base = pn < 12 ? PA + pn * 256 : PB + (pn - 12) * 256; const int col0 = wc * 32 + 8 * fq;
        if (pn < 8) run<0>(acc, base, row0, col0);
        else if (pn < 12 || pn >= 20) run<1>(acc, base, row0, col0);
        else if (pn < 16) run<2>(acc, base, row0, col0);
        else run<3>(acc, base, row0, col0);
    }
};

__device__ __forceinline__ float logsigmoidf_(float x) { return fminf(x, 0.f) - log1pf(__expf(-fabsf(x))); }
__device__ __forceinline__ void unpack8(const u32x4 w, float (&f)[8]) { f[0] = bf_lo(w.x); f[1] = bf_hi(w.x); f[2] = bf_lo(w.y); f[3] = bf_hi(w.y); f[4] = bf_lo(w.z); f[5] = bf_hi(w.z); f[6] = bf_lo(w.w); f[7] = bf_hi(w.w); }
__device__ __forceinline__ u32x4 pack8(const float (&f)[8]) { u32x4 w; w.x = cvt_pk_bf16(f[0], f[1]); w.y = cvt_pk_bf16(f[2], f[3]); w.z = cvt_pk_bf16(f[4], f[5]); w.w = cvt_pk_bf16(f[6], f[7]); return w; }

__device__ __forceinline__ void p2a_conv_gates(const Ctx& F0) { Ctx F = F0; asm volatile("" : "+v"(F.tid), "+v"(F.lane), "+s"(F.gw));
    unsigned char* ws = F.ws;
    const bf16_t* PBX = (const bf16_t*)(ws + WS_PROJB);
    bf16_t* XC = (bf16_t*)(ws + WS_XB); bf16_t* XB2 = (bf16_t*)(ws + WS_XB2);
    const float* Wg = (const float*)(ws + WS_WG);
    float* GLI = (float*)(ws + WS_GLI); float* GLF = (float*)(ws + WS_GLF);
    const float* convw = F.in[14]; const float* convb = F.in[15]; const float* bif = F.in[20];
    LAS float* cwl = (LAS float*)F.lds; LAS bf16_t* wgl = (LAS bf16_t*)(F.lds + 20480); LAS f32x4* comb = (LAS f32x4*)(F.lds + 20480 + 65536);
    {
        u32x4 t[11];
#pragma unroll
        for (int j = 0; j < 11; ++j) { const int i = F.tid + 512 * j; t[j] = (u32x4){0u, 0u, 0u, 0u};
            if (i < 1024) t[j] = ((const u32x4*)convw)[i]; else if (i < 1280) t[j] = ((const u32x4*)convb)[i - 1024]; else if (i < 5376) t[j] = ((const u32x4*)(ws + WS_WGB))[i - 1280]; }
#pragma unroll
        for (int j = 0; j < 11; ++j) { const int i = F.tid + 512 * j; if (i < 5376) ((LAS u32x4*)F.lds)[i] = t[j]; }
    }
    __syncthreads();
    const int l15 = F.lane & 15, lq = F.lane >> 4, rgp = F.wave >> 1, hh = F.wave & 1;
    auto conv_block = [&](int row, bool smp, int seq0, const float* st, int ch0, f32x4& acc) {
        u32x4 x3 = (u32x4){0u, 0u, 0u, 0u}, x2 = x3, x1 = x3; const u32x4 x0 = *(const u32x4*)(PBX + (size_t)row * 3072 + ch0);
        float w0[8], w1[8], w2[8], cur[8], xc[8];
        if (!smp) {
            if (row - 3 >= seq0) x3 = *(const u32x4*)(PBX + (size_t)(row - 3) * 3072 + ch0);
            if (row - 2 >= seq0) x2 = *(const u32x4*)(PBX + (size_t)(row - 2) * 3072 + ch0);
            if (row - 1 >= seq0) x1 = *(const u32x4*)(PBX + (size_t)(row - 1) * 3072 + ch0);
            unpack8(x3, w0); unpack8(x2, w1); unpack8(x1, w2);
        } else {
#pragma unroll
            for (int q = 0; q < 2; ++q) { const f32x4 a0 = *(const f32x4*)(st + ch0 + 4 * q), a1 = *(const f32x4*)(st + 1024 + ch0 + 4 * q), a2 = *(const f32x4*)(st + 2048 + ch0 + 4 * q);
#pragma unroll
                for (int e = 0; e < 4; ++e) { w0[4 * q + e] = a0[e]; w1[4 * q + e] = a1[e]; w2[4 * q + e] = a2[e]; } }
        }
        unpack8(x0, cur);
#pragma unroll
        for (int q = 0; q < 2; ++q) { const f32x4 c0 = *(const LAS f32x4*)(cwl + ch0 + 4 * q), c1 = *(const LAS f32x4*)(cwl + 1024 + ch0 + 4 * q), c2 = *(const LAS f32x4*)(cwl + 2048 + ch0 + 4 * q), c3 = *(const LAS f32x4*)(cwl + 3072 + ch0 + 4 * q), cb = *(const LAS f32x4*)(cwl + 4096 + ch0 + 4 * q);
#pragma unroll
            for (int e = 0; e < 4; ++e) xc[4 * q + e] = siluf_(c0[e] * w0[4 * q + e] + c1[e] * w1[4 * q + e] + c2[e] * w2[4 * q + e] + c3[e] * cur[4 * q + e] + cb[e]); }
        const u32x4 xcp = pack8(xc);
        *(u32x4*)(XC + (size_t)row * DM + ch0) = xcp; *(u32x4*)(XB2 + (size_t)row * DM + ch0) = x0;
        const bf16x8 bc = *(const LAS bf16x8*)(wgl + l15 * 1024 + ch0), bx = *(const LAS bf16x8*)(wgl + 16384 + l15 * 1024 + ch0);
        acc = __builtin_amdgcn_mfma_f32_16x16x32_bf16(__builtin_bit_cast(bf16x8, xcp), bc, acc, 0, 0, 0);
        acc = __builtin_amdgcn_mfma_f32_16x16x32_bf16(__builtin_bit_cast(bf16x8, x0), bx, acc, 0, 0, 0);
    };
    for (int tile = F.bid; tile < MP / 64; tile += F.G) {
        const int row = tile * 64 + rgp * 16 + l15, seq0 = row & ~(SEQ - 1);
        f32x4 acc = (f32x4){0.f, 0.f, 0.f, 0.f};
#pragma unroll 8
        for (int cbk = 0; cbk < 16; ++cbk) conv_block(row, false, seq0, nullptr, (hh * 16 + cbk) * 32 + 8 * lq, acc);
        __syncthreads();
        if (hh == 1) comb[rgp * 64 + F.lane] = acc;
        __syncthreads();
        if (hh == 0 && l15 < 8) { const f32x4 o = comb[rgp * 64 + F.lane]; const float bj = bif[l15];
#pragma unroll
            for (int r = 0; r < 4; ++r) { const float g = acc[r] + o[r] + bj; const size_t rr = (size_t)(tile * 64 + rgp * 16 + 4 * lq + r);
                if (l15 < 4) GLI[(size_t)l15 * MA + rr] = g; else GLF[(size_t)(l15 - 4) * MA + rr] = logsigmoidf_(g); } }
    }
    for (int si = F.bid; si < MS / 16; si += F.G) {
        const int row = MP + si * 16 + l15; const float* st = F.in[5] + (size_t)(row - MP) * 3072;
        f32x4 acc = (f32x4){0.f, 0.f, 0.f, 0.f};
#pragma unroll
        for (int cbk = 0; cbk < 4; ++cbk) conv_block(row, true, 0, st, (F.wave * 4 + cbk) * 32 + 8 * lq, acc);
        __syncthreads();
        comb[F.wave * 64 + F.lane] = acc;
        __syncthreads();
        if (F.wave == 0 && l15 < 8) { f32x4 o = comb[F.lane];
#pragma unroll
            for (int ww = 1; ww < 8; ++ww) o = o + comb[ww * 64 + F.lane];
            const float bj = bif[l15];
#pragma unroll
            for (int r = 0; r < 4; ++r) { const float g = o[r] + bj; const size_t rr = (size_t)(MP + si * 16 + 4 * lq + r);
                if (l15 < 4) GLI[(size_t)l15 * MA + rr] = g; else GLF[(size_t)(l15 - 4) * MA + rr] = logsigmoidf_(g); } }
    }
    __syncthreads();
    for (int i = F.bid * 512 + F.tid; i < NB * 3 * 1024; i += F.G * 512) { const int b = i / 3072, j = (i / 1024) % 3, ch = i & 1023;
        F.out[O_CVP + i] = bf2f(PBX[(size_t)(b * SEQ + SEQ - 3 + j) * 3072 + ch]); }
    for (int i = F.gw; i < MS; i += F.NGW) {
        const int r = MP + i, ch0s = F.lane * 16; const float* st = F.in[5] + (size_t)i * 3 * 1024;
        const bf16_t* PA = (const bf16_t*)(ws + WS_PROJA) + (size_t)r * 3072;
#pragma unroll
        for (int half = 0; half < 2; ++half) { const int c0 = ch0s + half * 8; float xb[8]; unpack8(*(const u32x4*)(PBX + (size_t)r * 3072 + c0), xb);
#pragma unroll
            for (int q = 0; q < 2; ++q) { *(f32x4*)(F.out + O_CVS + (size_t)i * 3072 + c0 + 4 * q) = *(const f32x4*)(st + 1024 + c0 + 4 * q); *(f32x4*)(F.out + O_CVS + (size_t)i * 3072 + 1024 + c0 + 4 * q) = *(const f32x4*)(st + 2048 + c0 + 4 * q);
                *(f32x4*)(F.out + O_CVS + (size_t)i * 3072 + 2048 + c0 + 4 * q) = (f32x4){xb[4 * q], xb[4 * q + 1], xb[4 * q + 2], xb[4 * q + 3]}; } }
        float gv[16], s = 0.f;
        { float t8[8]; unpack8(*(const u32x4*)(PA + 1024 + ch0s), t8);
#pragma unroll
          for (int c = 0; c < 8; ++c) gv[c] = t8[c];
          unpack8(*(const u32x4*)(PA + 1024 + ch0s + 8), t8);
#pragma unroll
          for (int c = 0; c < 8; ++c) gv[8 + c] = t8[c]; }
#pragma unroll
        for (int c = 0; c < 16; ++c) s += gv[c];
        s += __shfl_xor(s, 1); s += __shfl_xor(s, 2); s += __shfl_xor(s, 4);
        const float mu = s * (1.f / 128.f); float q = 0.f;
#pragma unroll
        for (int c = 0; c < 16; ++c) { const float d = gv[c] - mu; q += d * d; }
        q += __shfl_xor(q, 1); q += __shfl_xor(q, 2); q += __shfl_xor(q, 4);
        const float rstd = 1.0f / sqrtf(q * (1.f / 128.f) + EPS);
        const int h = F.lane >> 3; const float wsp = F.in[12][(size_t)h * 16384], bsp = F.in[13][h * 128];
        float uu[16], zz[16];
        { float t8[8]; unpack8(*(const u32x4*)(PA + ch0s), t8);
#pragma unroll
          for (int c = 0; c < 8; ++c) uu[c] = t8[c];
          unpack8(*(const u32x4*)(PA + ch0s + 8), t8);
#pragma unroll
          for (int c = 0; c < 8; ++c) uu[8 + c] = t8[c];
          unpack8(*(const u32x4*)(PA + 2048 + ch0s), t8);
#pragma unroll
          for (int c = 0; c < 8; ++c) zz[c] = t8[c];
          unpack8(*(const u32x4*)(PA + 2048 + ch0s + 8), t8);
#pragma unroll
          for (int c = 0; c < 8; ++c) zz[8 + c] = t8[c]; }
        float ya[16];
#pragma unroll
        for (int c = 0; c < 16; ++c) { const int ch = ch0s + c; const float vn = (gv[c] - mu) * rstd * F.in[10][ch] + F.in[11][ch];
            F.out[O_VS + (size_t)i * 1024 + ch] = vn; ya[c] = uu[c] * (wsp * vn + bsp) * zz[c]; }
        bf16_t* yrow = (bf16_t*)(ws + WS_Y) + (size_t)r * DMIX + ch0s;
        { float t8[8];
#pragma unroll
          for (int c = 0; c < 8; ++c) t8[c] = ya[c];
          *(u32x4*)(yrow) = pack8(t8);
#pragma unroll
          for (int c = 0; c < 8; ++c) t8[c] = ya[8 + c];
          *(u32x4*)(yrow + 8) = pack8(t8); }
    }
}

__device__ __forceinline__ void mscan_wave(const Ctx& F, int bh) {
    unsigned char* ws = F.ws; const int b = bh >> 2, h = bh & 3, lane = F.lane;
    const float* li = (const float*)(ws + WS_GLI) + (size_t)h * MA + (size_t)b * SEQ + lane * 32;
    const float* lf = (const float*)(ws + WS_GLF) + (size_t)h * MA + (size_t)b * SEQ + lane * 32;
    float A = 0.f, Bv = -INFINITY;
    for (int i = 0; i < 32; ++i) { const float f = lf[i], l = li[i]; Bv = fmaxf(Bv + f, l); A += f; }
    float sA = A, sB = Bv;
#pragma unroll
    for (int o = 1; o < 64; o <<= 1) { const float pA = __shfl_up(sA, o), pB = __shfl_up(sB, o); if (lane >= o) { sB = fmaxf(pB + sA, sB); sA = pA + sA; } }
    float eA = __shfl_up(sA, 1), eB = __shfl_up(sB, 1); if (lane == 0) { eA = 0.f; eB = -INFINITY; }
    const float m_in = fmaxf(0.f + eA, eB);
    float cA = A;
#pragma unroll
    for (int o = 1; o < 8; o <<= 1) { const float p = __shfl_up(cA, o); if ((lane & 7) >= o) cA += p; }
    const float b_in = cA - A;
    const float m_prev = __shfl(m_in, lane & ~7);
    float* DA = (float*)(ws + WS_DA) + (size_t)h * MA + (size_t)b * SEQ + lane * 32; float* DR = (float*)(ws + WS_DR) + (size_t)h * MA + (size_t)b * SEQ + lane * 32;
    float* DG = (float*)(ws + WS_DG) + (size_t)h * MA + (size_t)b * SEQ + lane * 32; float* DEM = (float*)(ws + WS_DEM) + (size_t)h * MA + (size_t)b * SEQ + lane * 32;
    float* DW = (float*)(ws + WS_DW) + (size_t)h * MA + (size_t)b * SEQ + lane * 32;
    float m = m_in, bb = b_in, a_last = 0.f;
    for (int i = 0; i < 32; ++i) { const float f = lf[i], l = li[i]; m = fmaxf(m + f, l); bb += f;
        a_last = bb - m; DA[i] = -m_prev; DR[i] = l - bb; DG[i] = __expf(bb + m_prev - m); DEM[i] = __expf(-m); }
    const float a_end = __shfl(a_last, lane | 7);
    for (int i = 0; i < 32; ++i) { const float f = lf[i]; (void)f; }
    { float bb2 = b_in; for (int i = 0; i < 32; ++i) { bb2 += lf[i]; DW[i] = __expf(a_end + (li[i] - bb2)); } }
    if (lane == 63) F.out[O_MP + bh] = m;
}

__device__ __forceinline__ void p9_final(const Ctx& F0) { Ctx F = F0; asm volatile("" : "+v"(F.tid), "+v"(F.lane), "+s"(F.gw));
    unsigned char* ws = F.ws; const bf16_t* GB = (const bf16_t*)(ws + WS_GB); const bf16_t* EB = (const bf16_t*)(ws + WS_EB);
    const float* pleg = F.in[27]; const float* fing = F.in[28];
    f32x4 pg[4], fg[4];
#pragma unroll
    for (int j = 0; j < 4; ++j) { pg[j] = ((const f32x4*)pleg)[F.lane + 64 * j]; fg[j] = ((const f32x4*)fing)[F.lane + 64 * j]; }
    for (int r0 = F.gw * 2; r0 < MP + MS; r0 += F.NGW * 2) {
        f32x4 x[2][4]; u32x2 g[2][4], e[2][4], xb[2][4]; float* xrow[2]; const bf16_t* X1B = (const bf16_t*)(ws + WS_X1B);
#pragma unroll
        for (int q = 0; q < 2; ++q) { const int r = r0 + q; xrow[q] = r < MP ? F.out + O_Y + (size_t)r * DM : F.out + O_YS + (size_t)(r - MP) * DM;
#pragma unroll
            for (int j = 0; j < 4; ++j) { xb[q][j] = __builtin_nontemporal_load((const u32x2*)(X1B + (size_t)r * DM) + F.lane + 64 * j); g[q][j] = __builtin_nontemporal_load((const u32x2*)(GB + (size_t)r * DM) + F.lane + 64 * j); e[q][j] = __builtin_nontemporal_load((const u32x2*)(EB + (size_t)r * DM) + F.lane + 64 * j); } }
#pragma unroll
        for (int q = 0; q < 2; ++q) { float s = 0.f; f32x4 ev[4];
#pragma unroll
            for (int j = 0; j < 4; ++j) { x[q][j] = (f32x4){bf_lo(xb[q][j].x), bf_hi(xb[q][j].x), bf_lo(xb[q][j].y), bf_hi(xb[q][j].y)}; ev[j] = (f32x4){bf_lo(e[q][j].x), bf_hi(e[q][j].x), bf_lo(e[q][j].y), bf_hi(e[q][j].y)}; s += (ev[j][0] * ev[j][0] + ev[j][1] * ev[j][1]) + (ev[j][2] * ev[j][2] + ev[j][3] * ev[j][3]); }
            s = wave_sum(s); const float rse = 1.0f / sqrtf(s * (1.f / DM) + EPS); float s2 = 0.f;
#pragma unroll
            for (int j = 0; j < 4; ++j) { const f32x4 gv = (f32x4){bf_lo(g[q][j].x), bf_hi(g[q][j].x), bf_lo(g[q][j].y), bf_hi(g[q][j].y)};
                x[q][j] = x[q][j] + gv * (ev[j] * rse * pg[j]); s2 += (x[q][j][0] * x[q][j][0] + x[q][j][1] * x[q][j][1]) + (x[q][j][2] * x[q][j][2] + x[q][j][3] * x[q][j][3]); }
            s2 = wave_sum(s2); const float rs2 = 1.0f / sqrtf(s2 * (1.f / DM) + EPS);
#pragma unroll
            for (int j = 0; j < 4; ++j) __builtin_nontemporal_store(x[q][j] * rs2 * fg[j], (f32x4*)xrow[q] + F.lane + 64 * j); }
    }
}
#define MAKE_CTX() extern __shared__ __attribute__((aligned(16))) unsigned char lds_raw[]; \
    Ctx F; F.lds = (LAS unsigned char*)lds_raw; F.tid = threadIdx.x; F.lane = F.tid & 63; F.wave = __builtin_amdgcn_readfirstlane(F.tid >> 6); \
    F.G = gridDim.x; F.bid = blockIdx.x; F.gw = F.bid * 8 + F.wave; F.NGW = F.G * 8; F.in = args.in; F.out = args.out; F.ws = args.ws; unsigned char* ws = args.ws; (void)ws

template <int KIND> struct EpiBf16Act {
    static constexpr bool PERM = false, AFTER_DRAIN = false;
    bf16_t* O; int ldo; const float* bias; float scale;
    __device__ __forceinline__ void operator()(const f32x4 (&acc)[2][2][4][2], const Unit& u, int wr, int wc, int fr, int fq) const {
        const int row0 = u.pm * 256 + wr * 64 + fr, col0 = u.pn * 256 + wc * 32 + 4 * fq;
        f32x4 bv[2][2];
#pragma unroll
        for (int bj = 0; bj < 2; ++bj)
#pragma unroll
            for (int n = 0; n < 2; ++n) bv[bj][n] = bias ? *(const f32x4*)(bias + col0 + bj * 128 + 16 * n) : (f32x4){0.f, 0.f, 0.f, 0.f};
#pragma unroll
        for (int ai = 0; ai < 2; ++ai)
#pragma unroll
            for (int m = 0; m < 4; ++m) { bf16_t* rowp = O + (size_t)(row0 + ai * 128 + m * 16) * ldo + col0;
#pragma unroll
                for (int bj = 0; bj < 2; ++bj)
#pragma unroll
                    for (int n = 0; n < 2; ++n) { f32x4 v = acc[ai][bj][m][n] * scale + bv[bj][n];
                        if (KIND == 3) {
#pragma unroll
                            for (int j = 0; j < 4; ++j) v[j] = sigmoidf_(v[j]); }
                        u32x2 w; w.x = cvt_pk_bf16(v[0], v[1]); w.y = cvt_pk_bf16(v[2], v[3]); *(u32x2*)(rowp + bj * 128 + n * 16) = w; } }
    }
};
struct EpiOutProj {
    static constexpr bool PERM = false, AFTER_DRAIN = false;
    const float* xp; const float* xs; float* out; bf16_t* X1B;
    __device__ __forceinline__ void operator()(const f32x4 (&acc)[2][2][4][2], const Unit& u, int wr, int wc, int fr, int fq) const {
        const int row0 = u.pm * 256 + wr * 64 + fr, col0 = u.pn * 256 + wc * 32 + 4 * fq;
#pragma unroll
        for (int ai = 0; ai < 2; ++ai) { f32x4 xv[4][2][2];
#pragma unroll
            for (int m = 0; m < 4; ++m) { const int row = row0 + ai * 128 + m * 16; const bool real = row < MP + MS; const float* xr = row < MP ? xp + (size_t)row * DM : xs + (size_t)(real ? row - MP : 0) * DM;
#pragma unroll
                for (int bj = 0; bj < 2; ++bj)
#pragma unroll
                    for (int n = 0; n < 2; ++n) xv[m][bj][n] = __builtin_nontemporal_load((const f32x4*)(xr + col0 + bj * 128 + n * 16)); }
#pragma unroll
            for (int m = 0; m < 4; ++m) { const int row = row0 + ai * 128 + m * 16; const bool real = row < MP + MS;
#pragma unroll
                for (int bj = 0; bj < 2; ++bj)
#pragma unroll
                    for (int n = 0; n < 2; ++n) { const int c = col0 + bj * 128 + n * 16; f32x4 v = acc[ai][bj][m][n];
                        if (real) v = v + xv[m][bj][n]; else v = (f32x4){0.f, 0.f, 0.f, 0.f};
                        u32x2 w; w.x = cvt_pk_bf16(v[0], v[1]); w.y = cvt_pk_bf16(v[2], v[3]); *(u32x2*)(X1B + (size_t)row * DM + c) = w; } } }
    }
};

struct EpiInProjNP {
    static constexpr bool PERM = false, AFTER_DRAIN = false;
    bf16_t* PA; bf16_t* PB; const float* rs;
    __device__ __forceinline__ void operator()(const f32x4 (&acc)[2][2][4][2], const Unit& u, int wr, int wc, int fr, int fq) const {
        const int row0 = u.pm * 256 + wr * 64 + fr, pn = u.pn; bf16_t* base = pn < 12 ? PA + pn * 256 : PB + (pn - 12) * 256; const int col0 = wc * 32 + 4 * fq;
        const int kind = pn < 8 ? 0 : ((pn < 12 || pn >= 20) ? 1 : (pn < 16 ? 2 : 3));
        float rsv[2][4];
#pragma unroll
        for (int ai = 0; ai < 2; ++ai)
#pragma unroll
            for (int m = 0; m < 4; ++m) rsv[ai][m] = rs[row0 + ai * 128 + m * 16];
#pragma unroll
        for (int ai = 0; ai < 2; ++ai)
#pragma unroll
            for (int m = 0; m < 4; ++m) { const int row = row0 + ai * 128 + m * 16; const float s = rsv[ai][m];
#pragma unroll
                for (int bj = 0; bj < 2; ++bj)
#pragma unroll
                    for (int n = 0; n < 2; ++n) { f32x4 v = acc[ai][bj][m][n] * s;
                        if (kind == 0) { const f32x2 ga = gelu_pk((f32x2){v[0], v[1]}), gb = gelu_pk((f32x2){v[2], v[3]}); v = (f32x4){ga.x, ga.y, gb.x, gb.y}; }
                        else {
#pragma unroll
                        for (int j = 0; j < 4; ++j) { float x = v[j]; if (kind == 1) x = siluf_(x); else if (kind == 3) x = sigmoidf_(x); v[j] = x; } }
                        u32x2 w; w.x = cvt_pk_bf16(v[0], v[1]); w.y = cvt_pk_bf16(v[2], v[3]); *(u32x2*)(base + (size_t)row * 3072 + col0 + bj * 128 + n * 16) = w; } }
    }
};
__device__ __forceinline__ void p1_inproj(const Ctx& F) {
    unsigned char* ws = F.ws; Gemm g{DM, DM, DM};
    OrderXcd S{64, 24, 64 * 24, F.G, F.bid, (const char*)(ws + WS_XB), (const char*)(ws + WS_WIN), (size_t)256 * DM * 2, (size_t)256 * DM * 2};
    EpiInProjNP E{(bf16_t*)(ws + WS_PROJA), (bf16_t*)(ws + WS_PROJB), (const float*)(ws + WS_RS)};
    pg8::gemm_phase<EpiInProjNP, OrderXcd>(F.lds, g, S, E);
}
__device__ __forceinline__ void p7_outproj(const Ctx& F) {
    unsigned char* ws = F.ws; Gemm g{DMIX, DMIX, DMIX};
    OrderPanel4 S{64 * 4, F.G, F.bid, (const char*)(ws + WS_Y), (const char*)(ws + WS_WOUT), (size_t)256 * DMIX * 2, (size_t)256 * DMIX * 2};
    EpiOutProj E{F.in[0], F.in[1], F.out, (bf16_t*)(ws + WS_X1B)};
    pg8::gemm_phase<EpiOutProj, OrderPanel4>(F.lds, g, S, E);
}
__device__ __forceinline__ void p8_ple(const Ctx& F) {
    unsigned char* ws = F.ws;
    { Gemm g{DM, DM, DM}; OrderPanel4 S{NTILE * 4, F.G, F.bid, (const char*)(ws + WS_X1B), (const char*)(ws + WS_WPG), (size_t)256 * DM * 2, (size_t)256 * DM * 2};
      EpiBf16Act<3> E{(bf16_t*)(ws + WS_GB), DM, F.in[25], 1.0f}; pg8::gemm_phase<EpiBf16Act<3>, OrderPanel4>(F.lds, g, S, E); }
    { Gemm g{DPLE, DPLE, DPLE}; OrderProjSkip S{F.G, F.bid, (const char*)(ws + WS_PB), (const char*)(ws + WS_WPP), (size_t)256 * DPLE * 2, (size_t)256 * DPLE * 2};
      EpiBf16Act<0> E{(bf16_t*)(ws + WS_EB), DM, nullptr, 1.0f}; pg8::gemm_phase<EpiBf16Act<0>, OrderProjSkip>(F.lds, g, S, E); }
}
typedef float f32x4_t __attribute__((ext_vector_type(4)));
__device__ __forceinline__ void p2b_spatial_units(const Ctx& F0) { Ctx F = F0; asm volatile("" : "+v"(F.tid), "+v"(F.lane), "+s"(F.gw));
    unsigned char* ws = F.ws;
    const bf16_t* PA = (const bf16_t*)(ws + WS_PROJA); const bf16_t* WSP = (const bf16_t*)(ws + WS_WSP); bf16_t* Y = (bf16_t*)(ws + WS_Y);
    const float* lng = F.in[10]; const float* lnb = F.in[11]; const float* bsp = F.in[13];
    LAS bf16_t* vnT = (LAS bf16_t*)F.lds;
    const int lane = F.lane, w = F.wave, l15 = lane & 15, lq = lane >> 4;
    for (int unit = F.bid; unit < NB * 16 * HA; unit += F.G) {
        const int b = unit >> 7, c = (unit >> 3) & 15, h = unit & 7, r0 = b * SEQ + c * 128;
        const float g0 = lng[h * 128 + 2 * lane], g1 = lng[h * 128 + 2 * lane + 1], b0 = lnb[h * 128 + 2 * lane], b1 = lnb[h * 128 + 2 * lane + 1];
        unsigned wav[8], wbv[8];
#pragma unroll
        for (int p = 0; p < 8; ++p) { const int s0 = w * 16 + 2 * p; wav[p] = *(const unsigned*)(PA + (size_t)(r0 + s0) * 3072 + 1024 + h * 128 + 2 * lane); wbv[p] = *(const unsigned*)(PA + (size_t)(r0 + s0 + 1) * 3072 + 1024 + h * 128 + 2 * lane); }
#pragma unroll
        for (int p = 0; p < 8; ++p) { const int s0 = w * 16 + 2 * p; const unsigned wa = wav[p], wb = wbv[p];
            float a0 = bf_lo(wa), a1 = bf_hi(wa), c0 = bf_lo(wb), c1 = bf_hi(wb);
            const float mua = wave_sum(a0 + a1) * (1.f / 128.f), mub = wave_sum(c0 + c1) * (1.f / 128.f);
            a0 -= mua; a1 -= mua; c0 -= mub; c1 -= mub;
            const float ra = 1.0f / sqrtf(wave_sum(a0 * a0 + a1 * a1) * (1.f / 128.f) + EPS), rb = 1.0f / sqrtf(wave_sum(c0 * c0 + c1 * c1) * (1.f / 128.f) + EPS);
            *(LAS unsigned*)(vnT + (2 * lane) * 136 + s0) = cvt_pk_bf16(a0 * ra * g0 + b0, c0 * rb * g0 + b0);
            *(LAS unsigned*)(vnT + (2 * lane + 1) * 136 + s0) = cvt_pk_bf16(a1 * ra * g1 + b1, c1 * rb * g1 + b1); }
        __syncthreads();
        const int t0 = 16 * w, nks = (t0 + 15) / 32 + 1;
        f32x4 acc[8];
#pragma unroll
        for (int nb = 0; nb < 8; ++nb) acc[nb] = (f32x4){0.f, 0.f, 0.f, 0.f};
        bf16x8 wfr[4];
#pragma unroll
        for (int ks = 0; ks < 4; ++ks) wfr[ks] = *(const bf16x8*)(WSP + ((size_t)h * 128 + t0 + l15) * 128 + ks * 32 + 8 * lq);
        const int t = t0 + l15; const float bt = bsp[h * 128 + t]; const size_t row = (size_t)(r0 + t);
        u32x2 uuv[8], zzv[8];
#pragma unroll
        for (int nb = 0; nb < 8; ++nb) { const int d = nb * 16 + 4 * lq; uuv[nb] = *(const u32x2*)(PA + row * 3072 + h * 128 + d); zzv[nb] = *(const u32x2*)(PA + row * 3072 + 2048 + h * 128 + d); }
#pragma unroll
        for (int ks = 0; ks < 4; ++ks) { if (ks < nks) { const int k0 = ks * 32;
#pragma unroll
            for (int nb = 0; nb < 8; ++nb) { const bf16x8 vf = *(const LAS bf16x8*)(vnT + (nb * 16 + l15) * 136 + k0 + 8 * lq);
                acc[nb] = __builtin_amdgcn_mfma_f32_16x16x32_bf16(vf, wfr[ks], acc[nb], 0, 0, 0); } } }
#pragma unroll
        for (int nb = 0; nb < 8; ++nb) { const int d = nb * 16 + 4 * lq; const u32x2 uu = uuv[nb], zz = zzv[nb];
            u32x2 o; o.x = cvt_pk_bf16(bf_lo(uu.x) * (acc[nb][0] + bt) * bf_lo(zz.x), bf_hi(uu.x) * (acc[nb][1] + bt) * bf_hi(zz.x));
            o.y = cvt_pk_bf16(bf_lo(uu.y) * (acc[nb][2] + bt) * bf_lo(zz.y), bf_hi(uu.y) * (acc[nb][3] + bt) * bf_hi(zz.y));
            *(u32x2*)(Y + row * DMIX + h * 128 + d) = o; }
        __syncthreads();
    }
}
__device__ __forceinline__ void p2b_mscan(const Ctx& F) { if (F.bid < 32 && F.wave == 0) mscan_wave(F, F.bid); }

struct OrderQK {
    int G, c; const char* ws;
    __device__ __forceinline__ bool next(int i, Unit& u) const { const int L = i * G + c; if (L >= 512) return false; const char* XC = ws + WS_XB; const char* WQ = ws + WS_WQ; const char* WK = ws + WS_WK;
        const int kind = L >> 8, l = L & 255; u.pm = l >> 2; u.pn = kind; u.aux = l & 3; u.a = XC + (size_t)u.pm * (256 * DM * 2) + (size_t)u.aux * 512; u.b = (kind ? WK : WQ) + (size_t)u.aux * 131072; return true; }
};
struct EpiQK {
    static constexpr bool PERM = false, AFTER_DRAIN = false;
    bf16_t* K; bf16_t* PQ; const float* DG;
    __device__ __forceinline__ void operator()(const f32x4 (&acc)[2][2][4][2], const Unit& u, int wr, int wc, int fr, int fq) const {
        const int h = u.aux, rl0 = wr * 64 + fr, col0 = wc * 32 + 4 * fq; const bool isk = u.pn != 0;
        const int unit = ((u.pm >> 3) * 4 + h) * 8 + (u.pm & 7);
        float gv[2][4];
#pragma unroll
        for (int ai = 0; ai < 2; ++ai)
#pragma unroll
            for (int m = 0; m < 4; ++m) gv[ai][m] = isk ? 0.0625f : DG[(size_t)h * MA + u.pm * 256 + rl0 + ai * 128 + m * 16];
        bf16_t* base = isk ? K + (size_t)u.pm * 256 * 1024 + h * 256 : PQ + (size_t)unit * 256 * 512 + 256; const int ldo = isk ? 1024 : 512;
#pragma unroll
        for (int ai = 0; ai < 2; ++ai)
#pragma unroll
            for (int m = 0; m < 4; ++m) { const int rl = rl0 + ai * 128 + m * 16; const float g = gv[ai][m];
#pragma unroll
                for (int bj = 0; bj < 2; ++bj)
#pragma unroll
                    for (int n = 0; n < 2; ++n) { const int c = col0 + bj * 128 + n * 16; const f32x4 v = acc[ai][bj][m][n] * g;
                        u32x2 w; w.x = cvt_pk_bf16(v[0], v[1]); w.y = cvt_pk_bf16(v[2], v[3]); *(u32x2*)(base + (size_t)rl * ldo + c) = w; }
                asm volatile("" ::: "memory"); }
    }
};
struct OrderS12 {
    int G, c; const char* ws;
    __device__ __forceinline__ bool next(int i, Unit& u) const { const int L = i * G + c; if (L >= 12) return false; const char* XC = ws + WS_XB; const char* XB2 = ws + WS_XB2; const char* WQ = ws + WS_WQ; const char* WK = ws + WS_WK; const char* WV = ws + WS_WV;
        const int kind = L >> 2; u.pm = 64; u.pn = kind; u.aux = L & 3; u.a = (kind == 2 ? XB2 : XC) + (size_t)64 * (256 * DM * 2) + (size_t)u.aux * 512; u.b = (kind == 0 ? WQ : kind == 1 ? WK : WV) + (size_t)u.aux * 131072; return true; }
};
struct EpiS12 {
    static constexpr bool PERM = false, AFTER_DRAIN = false;
    bf16_t* Q; bf16_t* K; bf16_t* Vs;
    __device__ __forceinline__ void operator()(const f32x4 (&acc)[2][2][4][2], const Unit& u, int wr, int wc, int fr, int fq) const {
        const int h = u.aux, kind = u.pn; bf16_t* O = kind == 0 ? Q + (size_t)MP * 1024 : kind == 1 ? K + (size_t)MP * 1024 : Vs; const float sc = kind == 1 ? 0.0625f : 1.0f;
        const int row0 = wr * 64 + fr, col0 = h * 256 + wc * 32 + 4 * fq;
#pragma unroll
        for (int m = 0; m < 4; ++m) { bf16_t* rowp = O + (size_t)(row0 + m * 16) * 1024 + col0;
#pragma unroll
            for (int bj = 0; bj < 2; ++bj)
#pragma unroll
                for (int n = 0; n < 2; ++n) { const f32x4 v = acc[0][bj][m][n] * sc; u32x2 w; w.x = cvt_pk_bf16(v[0], v[1]); w.y = cvt_pk_bf16(v[2], v[3]); *(u32x2*)(rowp + bj * 128 + n * 16) = w; } }
    }
};
struct OrderVW {
    int G, c; const char* ws;
    __device__ __forceinline__ bool next(int i, Unit& u) const { const int L = i * G + c; if (L >= 512) return false; const char* XC = ws + WS_XB; const char* XB2 = ws + WS_XB2; const char* WK = ws + WS_WK; const char* WV = ws + WS_WV;
        const int kind = L >> 8, l = L & 255, b = l >> 5, h = (l >> 3) & 3, cc = l & 7; u.pm = b * 8 + cc; u.pn = l | (kind << 8); u.aux = h;
        u.a = (kind ? WK : WV) + (size_t)h * 131072; u.b = (kind ? XC : XB2) + (size_t)u.pm * (256 * DM * 2) + (size_t)h * 512; return true; }
};
struct EpiVW {
    static constexpr bool PERM = false, AFTER_DRAIN = false;
    bf16_t* VC; bf16_t* WKT; const float* DW; float* DNP;
    __device__ __forceinline__ void operator()(const f32x4 (&acc)[2][2][4][2], const Unit& u, int wr, int wc, int fr, int fq) const {
        const int h = u.aux, kind = u.pn >> 8, l = u.pn & 255, rl0 = wr * 64 + fr, col0 = wc * 32 + 4 * fq; const int ldo = kind ? 256 : 512; bf16_t* base = (kind ? WKT : VC) + (size_t)l * 256 * ldo;
        f32x4 scq[2][2];
#pragma unroll
        for (int bj = 0; bj < 2; ++bj)
#pragma unroll
            for (int n = 0; n < 2; ++n) scq[bj][n] = kind ? *(const f32x4*)(DW + (size_t)h * MA + u.pm * 256 + col0 + bj * 128 + n * 16) * 0.0625f : (f32x4){1.f, 1.f, 1.f, 1.f};
#pragma unroll
        for (int ai = 0; ai < 2; ++ai)
#pragma unroll
            for (int m = 0; m < 4; ++m) { bf16_t* rowp = base + (size_t)(rl0 + ai * 128 + m * 16) * ldo + col0; float rsum = 0.f;
#pragma unroll
                for (int bj = 0; bj < 2; ++bj)
#pragma unroll
                    for (int n = 0; n < 2; ++n) { const f32x4 v = acc[ai][bj][m][n] * scq[bj][n]; u32x2 w; w.x = cvt_pk_bf16(v[0], v[1]); w.y = cvt_pk_bf16(v[2], v[3]); *(u32x2*)(rowp + bj * 128 + n * 16) = w;
                        rsum += (bf_lo(w.x) + bf_hi(w.x)) + (bf_lo(w.y) + bf_hi(w.y)); }
                if (kind) { rsum += __shfl_xor(rsum, 16); rsum += __shfl_xor(rsum, 32); if (fq == 0) DNP[((size_t)l * 256 + rl0 + ai * 128 + m * 16) * 4 + wc] = rsum; }
                asm volatile("" ::: "memory"); }
    }
};
__device__ __forceinline__ void p3_qkv(const Ctx& F) {
    unsigned char* ws = F.ws;
    { Gemm g{DM, 256, 256}; OrderQK S{F.G, F.bid, (const char*)ws}; EpiQK E{(bf16_t*)(ws + WS_K), (bf16_t*)(ws + WS_PQ), (const float*)(ws + WS_DG)};
      pg8::gemm_phase<EpiQK, OrderQK>(F.lds, g, S, E); }
    { Gemm g{256, DM, 256}; OrderVW S{F.G, F.bid, (const char*)ws}; EpiVW E{(bf16_t*)(ws + WS_VC), (bf16_t*)(ws + WS_WKT), (const float*)(ws + WS_DW), (float*)(ws + WS_DN4)};
      pg8::gemm_phase<EpiVW, OrderVW>(F.lds, g, S, E); }
}

__device__ __forceinline__ void p3_s12(const Ctx& F) {
    unsigned char* ws = F.ws;
    { Gemm g{DM, 256, 256}; OrderS12 S{F.G, (F.bid - 32) & 255, (const char*)ws}; EpiS12 E{(bf16_t*)(ws + WS_Q), (bf16_t*)(ws + WS_K), (bf16_t*)(ws + WS_VS)};
      pg8::gemm_phase<EpiS12, OrderS12>(F.lds, g, S, E); }
}
struct OrderUnitNT {
    int n, G, c; const char* A; size_t astep_pm, astep_h, astep_u; const char* B; size_t bstep_pm, bstep_h, bstep_u;
    __device__ __forceinline__ bool next(int i, Unit& u) const { const int L = i * G + c; if (L >= n) return false;
        const int b = L >> 5, h = (L >> 3) & 3, cc = L & 7; u.pm = b * 8 + cc; u.pn = L; u.aux = h;
        u.a = A + (size_t)u.pm * astep_pm + (size_t)h * astep_h + (size_t)L * astep_u; u.b = B + (size_t)u.pm * bstep_pm + (size_t)h * bstep_h + (size_t)L * bstep_u; return true; }
};
struct EpiScore {
    static constexpr bool PERM = false, AFTER_DRAIN = false;
    bf16_t* PQ; const float* DA; const float* DR; float* DENP;
    __device__ __forceinline__ void operator()(const f32x4 (&acc)[2][2][4][2], const Unit& u, int wr, int wc, int fr, int fq) const {
        const int h = u.aux, rl0 = wr * 64 + fr, col0 = wc * 32 + 4 * fq; const size_t vb = (size_t)h * MA + (size_t)u.pm * 256;
        float atv[2][4]; f32x4 rrv[2][2];
#pragma unroll
        for (int ai = 0; ai < 2; ++ai)
#pragma unroll
            for (int m = 0; m < 4; ++m) atv[ai][m] = DA[vb + rl0 + ai * 128 + m * 16];
#pragma unroll
        for (int bj = 0; bj < 2; ++bj)
#pragma unroll
            for (int n = 0; n < 2; ++n) rrv[bj][n] = *(const f32x4*)(DR + vb + col0 + bj * 128 + n * 16);
#pragma unroll
        for (int ai = 0; ai < 2; ++ai)
#pragma unroll
            for (int m = 0; m < 4; ++m) { int t_ = rl0 + ai * 128 + m * 16; asm volatile("" : "+v"(t_)); const int t = t_; const float at = atv[ai][m]; float rs_ = 0.f; bf16_t* rowp = PQ + ((size_t)u.pn * 256 + t) * 512 + col0;
#pragma unroll
                for (int bj = 0; bj < 2; ++bj)
#pragma unroll
                    for (int n = 0; n < 2; ++n) { const int c = col0 + bj * 128 + n * 16; f32x4 v; const f32x4 rr = rrv[bj][n];
#pragma unroll
                        for (int j = 0; j < 4; ++j) { const float e = fast_exp(fminf(at + rr[j], 60.f)); v[j] = (c + j <= t) ? acc[ai][bj][m][n][j] * e : 0.f; rs_ += v[j]; }
                        u32x2 w; w.x = cvt_pk_bf16(v[0], v[1]); w.y = cvt_pk_bf16(v[2], v[3]); *(u32x2*)(rowp + bj * 128 + n * 16) = w; }
                rs_ += __shfl_xor(rs_, 16); rs_ += __shfl_xor(rs_, 32);
                if (fq == 0) DENP[(vb + t) * 4 + wc] = rs_; asm volatile("" ::: "memory"); }
    }
};
struct EpiF32Unit {
    static constexpr bool PERM = false, AFTER_DRAIN = false;
    bf16_t* O;
    __device__ __forceinline__ void operator()(const f32x4 (&acc)[2][2][4][2], const Unit& u, int wr, int wc, int fr, int fq) const {
        bf16_t* base = O + (size_t)u.pn * 65536 + (size_t)(wr * 64 + fr) * 256 + wc * 32 + 4 * fq;
#pragma unroll
        for (int ai = 0; ai < 2; ++ai)
#pragma unroll
            for (int m = 0; m < 4; ++m)
#pragma unroll
                for (int bj = 0; bj < 2; ++bj)
#pragma unroll
                    for (int n = 0; n < 2; ++n) { const f32x4 v = acc[ai][bj][m][n]; u32x2 w; w.x = cvt_pk_bf16(v[0], v[1]); w.y = cvt_pk_bf16(v[2], v[3]); *(u32x2*)(base + (size_t)(ai * 128 + m * 16) * 256 + bj * 128 + n * 16) = w; }
    }
};
__device__ __forceinline__ void p4_scores_dc(const Ctx& F) {
    unsigned char* ws = F.ws;
    { Gemm g{512, DM, 256}; OrderUnitNT S{NUNIT, F.G, F.bid, (const char*)(ws + WS_PQ) + 512, 0, 0, (size_t)256 * 512 * 2, (const char*)(ws + WS_K), (size_t)256 * DM * 2, 512, 0};
      EpiScore E{(bf16_t*)(ws + WS_PQ), (const float*)(ws + WS_DA), (const float*)(ws + WS_DR), (float*)(ws + WS_DENP)}; pg8::gemm_phase<EpiScore, OrderUnitNT>(F.lds, g, S, E); }
    { Gemm g{512, 256, 256}; OrderUnitNT S{NUNIT, F.G, F.bid, (const char*)(ws + WS_VC), 0, 0, (size_t)256 * 512 * 2, (const char*)(ws + WS_WKT), 0, 0, (size_t)256 * 256 * 2};
      EpiF32Unit E{(bf16_t*)(F.out + O_Y)}; pg8::gemm_phase<EpiF32Unit, OrderUnitNT>(F.lds, g, S, E); }
}

__device__ __forceinline__ void p5_scan_sample(const Ctx& F0) { Ctx F = F0; asm volatile("" : "+v"(F.tid), "+v"(F.lane), "+s"(F.gw));
    unsigned char* ws = F.ws; const float* DG = (const float*)(ws + WS_DG); const bf16_t* DCb = (const bf16_t*)(F.out + O_Y); bf16_t* VC = (bf16_t*)(ws + WS_VC);
    for (int idx = F.bid * 512 + F.tid; idx < 32 * 16384; idx += F.G * 512) { const int bh = idx >> 14, q4 = idx & 16383, e = q4 >> 6, d4 = (q4 & 63) * 4, b = bh >> 2, h = bh & 3;
        f32x4 dc[8]; float ge[8];
#pragma unroll
        for (int c = 0; c < 8; ++c) { const u32x2 dw = __builtin_nontemporal_load((const u32x2*)(DCb + ((size_t)(bh * 8 + c) * 256 + e) * 256 + d4)); dc[c] = (f32x4){bf_lo(dw.x), bf_hi(dw.x), bf_lo(dw.y), bf_hi(dw.y)}; ge[c] = DG[(size_t)h * MA + b * SEQ + c * 256 + 255]; }
        f32x4 C = (f32x4){0.f, 0.f, 0.f, 0.f};
#pragma unroll
        for (int c = 0; c < 8; ++c) { u32x2 w; w.x = cvt_pk_bf16(C[0], C[1]); w.y = cvt_pk_bf16(C[2], C[3]); *(u32x2*)(VC + ((size_t)(bh * 8 + c) * 256 + e) * 512 + 256 + d4) = w; C = C * ge[c] + dc[c]; }
        __builtin_nontemporal_store(C, (f32x4*)(F.out + O_CP + ((size_t)bh * 256 + e) * 256 + d4)); }
    LAS float* npv = (LAS float*)F.lds;
    for (int u = F.bid; u < NUNIT; u += F.G) { const int bh = u >> 3, cc = u & 7, b = bh >> 2, h = bh & 3;
        __syncthreads();
        if (F.tid < 256) { float n = 0.f; const float* DN = (const float*)(ws + WS_DN4);
            for (int j = 0; j < cc; ++j) { const f32x4 dp = *(const f32x4*)(DN + ((size_t)(bh * 8 + j) * 256 + F.tid) * 4); n = DG[(size_t)h * MA + b * SEQ + j * 256 + 255] * n + ((dp[0] + dp[1]) + (dp[2] + dp[3])); }
            npv[F.tid] = n; const f32x4 dl = *(const f32x4*)(DN + ((size_t)u * 256 + F.tid) * 4); if (cc == 7) F.out[O_NP + (size_t)bh * 256 + F.tid] = DG[(size_t)h * MA + b * SEQ + 7 * 256 + 255] * n + ((dl[0] + dl[1]) + (dl[2] + dl[3])); }
        __syncthreads();
        const f32x4 nv = *(const LAS f32x4*)(npv + 4 * F.lane); const bf16_t* PQg = (const bf16_t*)(ws + WS_PQ);
        for (int r = 0; r < 32; ++r) { const size_t row = (size_t)b * SEQ + cc * 256 + F.wave * 32 + r; const u32x2 qq = *(const u32x2*)(PQg + ((size_t)u * 256 + F.wave * 32 + r) * 512 + 256 + 4 * F.lane);
            const float s = wave_sum(bf_lo(qq.x) * nv[0] + bf_hi(qq.x) * nv[1] + bf_lo(qq.y) * nv[2] + bf_hi(qq.y) * nv[3]); if (F.lane == 0) ((float*)(ws + WS_QN))[(size_t)h * MA + row] = s; } }

}


__device__ __forceinline__ void p5s_sample(const Ctx& F0) { Ctx F = F0; asm volatile("" : "+v"(F.tid), "+v"(F.lane), "+s"(F.gw));
    unsigned char* ws = F.ws;
    LAS float* hs = (LAS float*)F.lds + 512; LAS float* red = (LAS float*)F.lds + 1024;
    for (int job = F.bid; job < MS * HB; job += F.G) { const int i = job >> 2, h = job & 3; const size_t row = MP + i;
        const bf16_t* Q = (const bf16_t*)(ws + WS_Q) + row * 1024 + h * 256; const bf16_t* K = (const bf16_t*)(ws + WS_K) + row * 1024 + h * 256; const bf16_t* V = (const bf16_t*)(ws + WS_VS) + (size_t)i * 1024 + h * 256;
        const u32x2 qw = *(const u32x2*)(Q + 4 * F.lane), kw = *(const u32x2*)(K + 4 * F.lane);
        const f32x4 q4 = (f32x4){bf_lo(qw.x), bf_hi(qw.x), bf_lo(qw.y), bf_hi(qw.y)}, k4 = (f32x4){bf_lo(kw.x), bf_hi(kw.x), bf_lo(kw.y), bf_hi(kw.y)};
        const f32x4 n0 = *(const f32x4*)(F.in[3] + ((size_t)i * 4 + h) * 256 + 4 * F.lane);
        const float li = ((const float*)(ws + WS_GLI))[(size_t)h * MA + row], lf = ((const float*)(ws + WS_GLF))[(size_t)h * MA + row], m0 = F.in[4][i * 4 + h];
        const float mn = fmaxf(lf + m0, li), g = __expf(lf + m0 - mn), wi = __expf(li - mn);
        const float qk = wave_sum(q4[0] * k4[0] + q4[1] * k4[1] + q4[2] * k4[2] + q4[3] * k4[3]), nq = wave_sum(n0[0] * q4[0] + n0[1] * q4[1] + n0[2] * q4[2] + n0[3] * q4[3]);
        const float sc = wi * qk, den = sc + g * nq, dinv = 1.0f / fmaxf(fabsf(den), __expf(-mn));
        const float* C0 = F.in[2] + (((size_t)i * 4 + h) * 256 + F.wave * 32) * 256 + 4 * F.lane; float* C1 = F.out + O_CS + (((size_t)i * 4 + h) * 256 + F.wave * 32) * 256 + 4 * F.lane;
        __syncthreads();
#pragma unroll 1
        for (int r8 = 0; r8 < 32; r8 += 8) { f32x4 c[8]; float ve[8], cq[8];
#pragma unroll
            for (int r = 0; r < 8; ++r) { c[r] = __builtin_nontemporal_load((const f32x4*)(C0 + (size_t)(r8 + r) * 256)); ve[r] = bf2f(V[F.wave * 32 + r8 + r]); }
#pragma unroll
            for (int r = 0; r < 8; ++r) { cq[r] = c[r][0] * q4[0] + c[r][1] * q4[1] + c[r][2] * q4[2] + c[r][3] * q4[3]; const float wv = wi * ve[r]; __builtin_nontemporal_store(c[r] * g + k4 * wv, (f32x4*)(C1 + (size_t)(r8 + r) * 256)); }
#pragma unroll
            for (int r = 0; r < 8; ++r) { cq[r] = wave_sum(cq[r]); if (F.lane == 0) hs[F.wave * 32 + r8 + r] = (sc * ve[r] + g * cq[r]) * dinv; } }
        if (F.wave == 0) { *(f32x4*)(F.out + O_NS + ((size_t)i * 4 + h) * 256 + 4 * F.lane) = n0 * g + k4 * wi; if (F.lane == 0) F.out[O_MS + i * 4 + h] = mn; }
        __syncthreads();
        const bf16_t* PB = (const bf16_t*)(ws + WS_PROJB) + row * 3072; const bf16_t* XC = (const bf16_t*)(ws + WS_XB) + row * DM;
        float x = 0.f; const int ch = h * 256 + (F.tid & 255);
        if (F.tid < 256) x = hs[F.tid] * bf2f(PB[1024 + ch]);
        float p = wave_sum(x); if (F.lane == 0) red[F.wave] = p;
        __syncthreads();
        const float mu = (red[0] + red[1] + red[2] + red[3]) * (1.f / 256.f), dx = x - mu;
        __syncthreads();
        p = wave_sum(F.tid < 256 ? dx * dx : 0.f); if (F.lane == 0) red[F.wave] = p;
        __syncthreads();
        const float rstd = 1.0f / sqrtf((red[0] + red[1] + red[2] + red[3]) * (1.f / 256.f) + EPS);
        if (F.tid < 256) ((bf16_t*)(ws + WS_Y))[row * DMIX + 1024 + ch] = f2bf((dx * rstd * F.in[21][ch] + F.in[22][ch] * bf2f(XC[ch])) * bf2f(PB[2048 + ch]));
        __syncthreads();
    }
}
struct EpiHOut {
    static constexpr bool PERM = false, AFTER_DRAIN = true;
    const float* DENP; const float* DG; const float* QN; const float* DEM; const bf16_t* PB; const bf16_t* XC; bf16_t* Y; const float* gng; const float* skip;
    __device__ __forceinline__ void fused(f32x4 (&acc)[2][2][4][2], const Unit& u, int wr, int wc, int fr, int fq, LAS unsigned char* lds, int wid, int lane) const {
        const int h = u.aux, rl0 = wr * 64 + fr, col0 = wc * 32 + 4 * fq; const size_t vb = (size_t)h * MA + (size_t)u.pm * 256;
        LAS float* P1 = (LAS float*)lds; LAS float* P2 = (LAS float*)lds + 1024;
#pragma unroll
        for (int ai = 0; ai < 2; ++ai) { u32x2 ow[4][2][2]; f32x4 dp[4]; float dgq[4], dem[4];
#pragma unroll
            for (int m = 0; m < 4; ++m) { const int t = rl0 + ai * 128 + m * 16; const size_t row = (size_t)u.pm * 256 + t; dp[m] = *(const f32x4*)(DENP + (vb + t) * 4); dgq[m] = QN[vb + t]; dem[m] = DEM[vb + t];
#pragma unroll
                for (int bj = 0; bj < 2; ++bj)
#pragma unroll
                    for (int n = 0; n < 2; ++n) ow[m][bj][n] = *(const u32x2*)(PB + row * 3072 + 1024 + h * 256 + col0 + bj * 128 + n * 16); }
#pragma unroll
            for (int m = 0; m < 4; ++m) { const int t = rl0 + ai * 128 + m * 16; const float den = (dp[m][0] + dp[m][1]) + (dp[m][2] + dp[m][3]) + dgq[m];
                const float dinv = 1.0f / fmaxf(fabsf(den), dem[m]); float s = 0.f;
#pragma unroll
                for (int bj = 0; bj < 2; ++bj)
#pragma unroll
                    for (int n = 0; n < 2; ++n) { const u32x2 o2 = ow[m][bj][n];
                        f32x4 v = acc[ai][bj][m][n] * dinv; v[0] *= bf_lo(o2.x); v[1] *= bf_hi(o2.x); v[2] *= bf_lo(o2.y); v[3] *= bf_hi(o2.y); acc[ai][bj][m][n] = v; s += (v[0] + v[1]) + (v[2] + v[3]); }
                s += __shfl_xor(s, 16); s += __shfl_xor(s, 32); if (fq == 0) P1[t * 4 + wc] = s; } }
        asm volatile("s_waitcnt lgkmcnt(0)" ::: "memory"); __builtin_amdgcn_s_barrier(); asm volatile("" ::: "memory");
#pragma unroll
        for (int ai = 0; ai < 2; ++ai)
#pragma unroll
            for (int m = 0; m < 4; ++m) { const int t = rl0 + ai * 128 + m * 16; const f32x4 ps = *(const LAS f32x4*)(P1 + t * 4); const float mu = ((ps[0] + ps[1]) + (ps[2] + ps[3])) * (1.f / 256.f); float q = 0.f;
#pragma unroll
                for (int bj = 0; bj < 2; ++bj)
#pragma unroll
                    for (int n = 0; n < 2; ++n) { f32x4 v = acc[ai][bj][m][n] - mu; acc[ai][bj][m][n] = v; q += (v[0] * v[0] + v[1] * v[1]) + (v[2] * v[2] + v[3] * v[3]); }
                q += __shfl_xor(q, 16); q += __shfl_xor(q, 32); if (fq == 0) P2[t * 4 + wc] = q; }
        asm volatile("s_waitcnt lgkmcnt(0)" ::: "memory"); __builtin_amdgcn_s_barrier(); asm volatile("" ::: "memory");
#pragma unroll
        for (int ai = 0; ai < 2; ++ai) { u32x2 xw[4][2][2], zw[4][2][2];
#pragma unroll
            for (int m = 0; m < 4; ++m) { const int t = rl0 + ai * 128 + m * 16; const size_t row = (size_t)u.pm * 256 + t;
#pragma unroll
                for (int bj = 0; bj < 2; ++bj)
#pragma unroll
                    for (int n = 0; n < 2; ++n) { const int c = h * 256 + col0 + bj * 128 + n * 16; xw[m][bj][n] = *(const u32x2*)(XC + row * DM + c); zw[m][bj][n] = *(const u32x2*)(PB + row * 3072 + 2048 + c); } }
#pragma unroll
            for (int m = 0; m < 4; ++m) { const int t = rl0 + ai * 128 + m * 16; const size_t row = (size_t)u.pm * 256 + t; const f32x4 ps = *(const LAS f32x4*)(P2 + t * 4);
                const float rstd = 1.0f / sqrtf(((ps[0] + ps[1]) + (ps[2] + ps[3])) * (1.f / 256.f) + EPS);
#pragma unroll
                for (int bj = 0; bj < 2; ++bj)
#pragma unroll
                    for (int n = 0; n < 2; ++n) { const int c = h * 256 + col0 + bj * 128 + n * 16; const u32x2 x2 = xw[m][bj][n], z2 = zw[m][bj][n];
                        const f32x4 ggv = *(const f32x4*)(gng + c), skv = *(const f32x4*)(skip + c); const f32x4 v = acc[ai][bj][m][n] * rstd * ggv; u32x2 w;
                        w.x = cvt_pk_bf16((v[0] + skv[0] * bf_lo(x2.x)) * bf_lo(z2.x), (v[1] + skv[1] * bf_hi(x2.x)) * bf_hi(z2.x));
                        w.y = cvt_pk_bf16((v[2] + skv[2] * bf_lo(x2.y)) * bf_lo(z2.y), (v[3] + skv[3] * bf_hi(x2.y)) * bf_hi(z2.y));
                        *(u32x2*)(Y + row * DMIX + 1024 + c) = w; } } }
    }
};
__device__ __forceinline__ void p6_hout(const Ctx& F) {
    unsigned char* ws = F.ws; Gemm g{512, 512, 512};
    OrderUnitNT S{NUNIT, F.G, F.bid, (const char*)(ws + WS_PQ), 0, 0, (size_t)256 * 512 * 2, (const char*)(ws + WS_VC), 0, 0, (size_t)256 * 512 * 2};
    EpiHOut E{(const float*)(ws + WS_DENP), (const float*)(ws + WS_DG), (const float*)(ws + WS_QN), (const float*)(ws + WS_DEM), (const bf16_t*)(ws + WS_PROJB), (const bf16_t*)(ws + WS_XB), (bf16_t*)(ws + WS_Y), F.in[21], F.in[22]};
    pg8::gemm_phase<EpiHOut, OrderUnitNT, false, true>(F.lds, g, S, E);
}
template <class PtrF, class Ef>
__device__ __forceinline__ void sample_gemm(const Ctx& F, int nitems, int K, int lda, int ldb, const PtrF& P, const Ef& E) {
    int lane_ = F.lane; asm volatile("" : "+v"(lane_));
    const int l15 = lane_ & 15, lq = lane_ >> 4, w = F.wave;
    for (int item = F.bid; item < nitems; item += F.G) {
        const bf16_t* A; const bf16_t* B; P(item, A, B);
        const bf16_t* ap = A + (size_t)(16 * w + l15) * lda + 8 * lq; const bf16_t* bp = B + (size_t)l15 * ldb + 8 * lq;
        f32x4 acc = (f32x4){0.f, 0.f, 0.f, 0.f};
        for (int k0 = 0; k0 < K; k0 += 256) { bf16x8 a[8], b[8];
#pragma unroll
            for (int j = 0; j < 8; ++j) { a[j] = *(const bf16x8*)(ap + k0 + 32 * j); b[j] = *(const bf16x8*)(bp + k0 + 32 * j); }
#pragma unroll
            for (int j = 0; j < 8; ++j) acc = __builtin_amdgcn_mfma_f32_16x16x32_bf16(a[j], b[j], acc, 0, 0, 0); }
#pragma unroll
        for (int r = 0; r < 4; ++r) E(item, 16 * w + 4 * lq + r, l15, acc[r]);
    }
}
__device__ __forceinline__ void sample_inproj(const Ctx& F) {
    unsigned char* ws = F.ws; const bf16_t* XB = (const bf16_t*)(ws + WS_XB) + (size_t)MP * DM; const bf16_t* W = (const bf16_t*)(ws + WS_WIN);
    bf16_t* PA = (bf16_t*)(ws + WS_PROJA) + (size_t)MP * 3072; bf16_t* PB = (bf16_t*)(ws + WS_PROJB) + (size_t)MP * 3072; const float* rs = (const float*)(ws + WS_RS) + MP;
    sample_gemm(F, NIN / 16, DM, DM, DM,
        [=](int item, const bf16_t*& A, const bf16_t*& B) { A = XB; B = W + (size_t)item * 16 * DM; },
        [=](int item, int r, int c, float acc) { const int col = item * 16 + c, grp = col >> 10; float v = acc * rs[r];
            if (grp < 2) { const f32x2 g2 = gelu_pk((f32x2){v, v}); v = g2.x; } else if (grp == 2 || grp == 5) v = siluf_(v); else if (grp == 4) v = sigmoidf_(v);
            bf16_t* dst = col < 3072 ? PA + (size_t)r * 3072 + col : PB + (size_t)r * 3072 + (col - 3072); *dst = f2bf(v); });
}
__device__ __forceinline__ void sample_qkv(const Ctx& F) {
    unsigned char* ws = F.ws; const bf16_t* XC = (const bf16_t*)(ws + WS_XB) + (size_t)MP * DM; const bf16_t* XBr = (const bf16_t*)(ws + WS_PROJB) + (size_t)MP * 3072;
    const bf16_t* WQ = (const bf16_t*)(ws + WS_WQ); const bf16_t* WK = (const bf16_t*)(ws + WS_WK); const bf16_t* WV = (const bf16_t*)(ws + WS_WV);
    bf16_t* Q = (bf16_t*)(ws + WS_Q) + (size_t)MP * 1024; bf16_t* Kk = (bf16_t*)(ws + WS_K) + (size_t)MP * 1024; bf16_t* Vs = (bf16_t*)(ws + WS_VS);
    sample_gemm(F, 128, 256, DM, 256,
        [=](int item, const bf16_t*& A, const bf16_t*& B) { const int which = item >> 6, it = item & 63, h = it >> 4; A = XC + h * 256; B = (which ? WK : WQ) + (size_t)h * 65536 + (size_t)(it & 15) * 16 * 256; },
        [=](int item, int r, int c, float acc) { const int which = item >> 6, it = item & 63; bf16_t* O = which ? Kk : Q; O[(size_t)r * 1024 + it * 16 + c] = f2bf(which ? acc * 0.0625f : acc); });
    sample_gemm(F, 64, 256, 3072, 256,
        [=](int item, const bf16_t*& A, const bf16_t*& B) { const int h = item >> 4; A = XBr + h * 256; B = WV + (size_t)h * 65536 + (size_t)(item & 15) * 16 * 256; },
        [=](int item, int r, int c, float acc) { Vs[(size_t)r * 1024 + item * 16 + c] = f2bf(acc); });
}
__device__ __forceinline__ void sample_outproj(const Ctx& F) {
    unsigned char* ws = F.ws; const bf16_t* Y = (const bf16_t*)(ws + WS_Y) + (size_t)MP * DMIX; const bf16_t* W = (const bf16_t*)(ws + WS_WOUT);
    const float* xs = F.in[1]; float* out = F.out + O_YS; bf16_t* X1B = (bf16_t*)(ws + WS_X1B) + (size_t)MP * DM;
    sample_gemm(F, DM / 16, DMIX, DMIX, DMIX,
        [=](int item, const bf16_t*& A, const bf16_t*& B) { A = Y; B = W + (size_t)item * 16 * DMIX; },
        [=](int item, int r, int c, float acc) { const int col = item * 16 + c; const float v = xs[(size_t)r * DM + col] + acc; out[(size_t)r * DM + col] = v; X1B[(size_t)r * DM + col] = f2bf(v); });
}
__device__ __forceinline__ void sample_ple(const Ctx& F) {
    unsigned char* ws = F.ws; const bf16_t* X1B = (const bf16_t*)(ws + WS_X1B) + (size_t)MP * DM; const bf16_t* PBs = (const bf16_t*)(ws + WS_PB) + (size_t)MP * DPLE;
    const bf16_t* WG = (const bf16_t*)(ws + WS_WPG); const bf16_t* WP = (const bf16_t*)(ws + WS_WPP); const float* bias = F.in[25];
    bf16_t* GB = (bf16_t*)(ws + WS_GB) + (size_t)MP * DM; bf16_t* EB = (bf16_t*)(ws + WS_EB) + (size_t)MP * DM;
    sample_gemm(F, DM / 16, DM, DM, DM,
        [=](int item, const bf16_t*& A, const bf16_t*& B) { A = X1B; B = WG + (size_t)item * 16 * DM; },
        [=](int item, int r, int c, float acc) { const int col = item * 16 + c; GB[(size_t)r * DM + col] = f2bf(sigmoidf_(acc + bias[col])); });
    sample_gemm(F, DM / 16, DPLE, DPLE, DPLE,
        [=](int item, const bf16_t*& A, const bf16_t*& B) { A = PBs; B = WP + (size_t)item * 16 * DPLE; },
        [=](int item, int r, int c, float acc) { EB[(size_t)r * DM + item * 16 + c] = f2bf(acc); });
}
template <class PtrF, class Ef>
__device__ __forceinline__ void sample_gemm_ks(const Ctx& F, int nitems, int K, int lda, int ldb, const PtrF& P, const Ef& E) {
    int lane_ = F.lane; asm volatile("" : "+v"(lane_)); const int l15 = lane_ & 15, lq = lane_ >> 4, w = F.wave; LAS f32x4* red = (LAS f32x4*)F.lds;
    const int ks = K >> 3;
    for (int item = F.bid; item < nitems; item += F.G) {
        const bf16_t* A; const bf16_t* B; P(item, A, B);
        const bf16_t* ap = A + (size_t)l15 * lda + w * ks + 8 * lq; const bf16_t* bp = B + (size_t)l15 * ldb + w * ks + 8 * lq;
        f32x4 acc[2][4];
#pragma unroll
        for (int m = 0; m < 2; ++m)
#pragma unroll
            for (int n = 0; n < 4; ++n) acc[m][n] = (f32x4){0.f, 0.f, 0.f, 0.f};
        for (int k0 = 0; k0 < ks; k0 += 128) { bf16x8 a[4][2], b[4][4];
#pragma unroll
            for (int j = 0; j < 4; ++j) {
#pragma unroll
                for (int m = 0; m < 2; ++m) a[j][m] = (k0 + 32 * j < ks) ? *(const bf16x8*)(ap + (size_t)(16 * m) * lda + k0 + 32 * j) : (bf16x8){0, 0, 0, 0, 0, 0, 0, 0};
#pragma unroll
                for (int n = 0; n < 4; ++n) b[j][n] = (k0 + 32 * j < ks) ? *(const bf16x8*)(bp + (size_t)(16 * n) * ldb + k0 + 32 * j) : (bf16x8){0, 0, 0, 0, 0, 0, 0, 0}; }
#pragma unroll
            for (int j = 0; j < 4; ++j)
#pragma unroll
                for (int m = 0; m < 2; ++m)
#pragma unroll
                    for (int n = 0; n < 4; ++n) acc[m][n] = __builtin_amdgcn_mfma_f32_16x16x32_bf16(a[j][m], b[j][n], acc[m][n], 0, 0, 0); }
        __syncthreads();
#pragma unroll
        for (int m = 0; m < 2; ++m)
#pragma unroll
            for (int n = 0; n < 4; ++n) red[(w * 8 + m * 4 + n) * 64 + F.lane] = acc[m][n];
        __syncthreads();
        f32x4 s = red[(0 * 8 + w) * 64 + F.lane];
#pragma unroll
        for (int ww = 1; ww < 8; ++ww) s = s + red[(ww * 8 + w) * 64 + F.lane];
        const int mt = w >> 2, nt = w & 3;
#pragma unroll
        for (int r = 0; r < 4; ++r) E(item, 16 * mt + 4 * lq + r, 16 * nt + l15, s[r]);
    }
    __syncthreads();
}
__device__ __forceinline__ void sample_outproj_ks(const Ctx& F) {
    unsigned char* ws = F.ws; const bf16_t* Y = (const bf16_t*)(ws + WS_Y) + (size_t)MP * DMIX; const bf16_t* W = (const bf16_t*)(ws + WS_WOUT);
    const float* xs = F.in[1]; float* out = F.out + O_YS; bf16_t* X1B = (bf16_t*)(ws + WS_X1B) + (size_t)MP * DM;
    sample_gemm_ks(F, 64, DMIX, DMIX, DMIX,
        [=](int item, const bf16_t*& A, const bf16_t*& B) { A = Y + (size_t)(item & 3) * 32 * DMIX; B = W + (size_t)(item >> 2) * 64 * DMIX; },
        [=](int item, int r, int c, float acc) { const int row = (item & 3) * 32 + r, col = (item >> 2) * 64 + c; const float v = xs[(size_t)row * DM + col] + acc; X1B[(size_t)row * DM + col] = f2bf(v); });
}
__device__ __forceinline__ void sample_ple_ks(const Ctx& F) {
    unsigned char* ws = F.ws; const bf16_t* X1B = (const bf16_t*)(ws + WS_X1B) + (size_t)MP * DM; const bf16_t* PBs = (const bf16_t*)(ws + WS_PB) + (size_t)MP * DPLE;
    const bf16_t* WG = (const bf16_t*)(ws + WS_WPG); const bf16_t* WP = (const bf16_t*)(ws + WS_WPP); const float* bias = F.in[25];
    bf16_t* GB = (bf16_t*)(ws + WS_GB) + (size_t)MP * DM; bf16_t* EB = (bf16_t*)(ws + WS_EB) + (size_t)MP * DM;
    sample_gemm_ks(F, 64, DM, DM, DM,
        [=](int item, const bf16_t*& A, const bf16_t*& B) { A = X1B + (size_t)(item & 3) * 32 * DM; B = WG + (size_t)(item >> 2) * 64 * DM; },
        [=](int item, int r, int c, float acc) { const int row = (item & 3) * 32 + r, col = (item >> 2) * 64 + c; GB[(size_t)row * DM + col] = f2bf(sigmoidf_(acc + bias[col])); });
    sample_gemm_ks(F, 64, DPLE, DPLE, DPLE,
        [=](int item, const bf16_t*& A, const bf16_t*& B) { A = PBs + (size_t)(item & 3) * 32 * DPLE; B = WP + (size_t)(item >> 2) * 64 * DPLE; },
        [=](int item, int r, int c, float acc) { const int row = (item & 3) * 32 + r, col = (item >> 2) * 64 + c; EB[(size_t)row * DM + col] = f2bf(acc); });
}
#define XB_TMO      128
#define XB_XCNT(j)  (256  + 64 * (j))
#define XB_XSUB(j)  (1280 + 64 * (j))
#define XB_XGEN(j)  (2304 + 64 * (j))
#define XB_TOP      3328
#define XB_TOPGEN   3392
#define XCD_BAR_WORDS 3456
#define XB_SPIN_CAP (1u << 18)
__device__ __forceinline__ unsigned xb_ld(unsigned* p)              { return __hip_atomic_load(p, __ATOMIC_RELAXED, __HIP_MEMORY_SCOPE_AGENT); }
__device__ __forceinline__ unsigned xb_add(unsigned* p, unsigned v) { return __hip_atomic_fetch_add(p, v, __ATOMIC_RELAXED, __HIP_MEMORY_SCOPE_AGENT); }
__device__ __forceinline__ unsigned xb_xcc_id() { return (unsigned)__builtin_amdgcn_s_getreg((3 << 11) | 20) & 0xFu; }
#define XB_SPIN(cond, bar) do { unsigned _sp = 0; while (cond) { __builtin_amdgcn_s_sleep(1); \
    if ((++_sp & 255u) == 0u) { if (xb_ld(&(bar)[XB_TMO])) break; if (_sp > XB_SPIN_CAP) { atomicAdd(&(bar)[XB_TMO], 1u); break; } } } } while (0)
struct XcdBarrier { unsigned* bar; unsigned x; volatile LAS unsigned* st; };
__device__ __forceinline__ XcdBarrier xcd_barrier_post(unsigned* bar, volatile LAS unsigned* st) {
    XcdBarrier b; b.bar = bar; b.x = xb_xcc_id(); b.st = st;
    if (threadIdx.x == 0) (void)xb_add(&bar[XB_XCNT(b.x)], 1u);
    return b;
}
__device__ __forceinline__ void xcd_barrier_complete(unsigned* bar, unsigned x, unsigned& nloc, unsigned& nx) {
    const unsigned G = gridDim.x * gridDim.y * gridDim.z;
    unsigned sum, cnt, mine, sp = 0u;
    for (;;) {
        sum = 0u; cnt = 0u; mine = 0u;
#pragma unroll
        for (unsigned j = 0; j < 16; ++j) { const unsigned c = xb_ld(&bar[XB_XCNT(j)]); sum += c; cnt += (c > 0u) ? 1u : 0u; mine = (j == x) ? c : mine; }
        if (sum == G) break;
        __builtin_amdgcn_s_sleep(1);
        if ((++sp & 255u) == 0u) { if (xb_ld(&bar[XB_TMO])) break; if (sp > XB_SPIN_CAP) { atomicAdd(&bar[XB_TMO], 1u); break; } }
    }
    nloc = mine > 0u ? mine : 1u; nx = cnt > 0u ? cnt : 1u;
}
__device__ __forceinline__ void xcd_barrier(const XcdBarrier& b) {
    asm volatile("s_waitcnt vmcnt(0)" ::: "memory");
    __syncthreads();
    if (threadIdx.x == 0) {
        unsigned* bar = b.bar;
        __builtin_amdgcn_s_waitcnt(0);
        unsigned nloc = b.st[0], nx = b.st[1];
        if (nloc == 0u) { xcd_barrier_complete(bar, b.x, nloc, nx); b.st[0] = nloc; b.st[1] = nx; }
        const unsigned old = xb_add(&bar[XB_XSUB(b.x)], 1u);
        const unsigned gen = old / nloc;
        if (old + 1u == (gen + 1u) * nloc) {
            __builtin_amdgcn_fence(__ATOMIC_RELEASE, "agent");
            asm volatile("s_waitcnt vmcnt(0)" ::: "memory");
            const unsigned og = xb_add(&bar[XB_TOP], 1u);
            const unsigned tg = og / nx;
            if (og + 1u == (tg + 1u) * nx) xb_add(&bar[XB_TOPGEN], 1u);
            else XB_SPIN(xb_ld(&bar[XB_TOPGEN]) == tg, bar);
            __builtin_amdgcn_fence(__ATOMIC_ACQUIRE, "agent");
            xb_add(&bar[XB_XGEN(b.x)], 1u);
            asm volatile("s_waitcnt vmcnt(0)" ::: "memory");
        } else {
            XB_SPIN(xb_ld(&bar[XB_XGEN(b.x)]) == gen, bar);
            __builtin_amdgcn_fence(__ATOMIC_ACQUIRE, "agent");
            asm volatile("s_waitcnt vmcnt(0)" ::: "memory");
        }
    }
    __syncthreads();
}
__global__ void __launch_bounds__(512, 2) mega(Args args) {
    MAKE_CTX();
    volatile LAS unsigned* MISC = (volatile LAS unsigned*)(F.lds + 131072 + 320);
    if (F.tid < 32) MISC[F.tid] = 0u;
    __syncthreads();
    const XcdBarrier bar = xcd_barrier_post((unsigned*)(ws + WS_CTL), MISC + 8);
#define GRID_SYNC() xcd_barrier(bar)
    p0_prologue(F);      GRID_SYNC();
    sample_inproj(F); p1_inproj(F); GRID_SYNC();
    p2a_conv_gates(F); p2b_spatial_units(F); GRID_SYNC();
    p2b_mscan(F); p3_s12(F); GRID_SYNC();
    p3_qkv(F);           GRID_SYNC();
    if (F.bid & 1) { p5s_sample(F); p4_scores_dc(F); } else { p4_scores_dc(F); p5s_sample(F); } GRID_SYNC();
    p5_scan_sample(F);   GRID_SYNC();
    p6_hout(F);          GRID_SYNC();
    sample_outproj_ks(F); p7_outproj(F); GRID_SYNC();
    p8_ple(F);           GRID_SYNC();
    p9_final(F);
}

extern "C" void kernel_launch(void* const* d_in, const int* in_sizes, int n_in, void* d_out, int out_size, void* d_ws, size_t ws_size, hipStream_t stream) {
    static int grid = 0;
    if (grid == 0) {
        if (n_in != 29 || (size_t)out_size != O_END || ws_size < WS_END) { fprintf(stderr, "kernel_launch: unexpected shapes (n_in %d out %d ws %zu)\n", n_in, out_size, ws_size); grid = -1; return; }
        int dev = 0, cus = 0, per_cu = 0;
        if (hipGetDevice(&dev) != hipSuccess || hipDeviceGetAttribute(&cus, hipDeviceAttributeMultiprocessorCount, dev) != hipSuccess) { grid = -1; return; }
        if (hipFuncSetAttribute((const void*)mega, hipFuncAttributeMaxDynamicSharedMemorySize, LDS_BYTES) != hipSuccess) { fprintf(stderr, "kernel_launch: hipFuncSetAttribute failed\n"); grid = -1; return; }
        if (hipOccupancyMaxActiveBlocksPerMultiprocessor(&per_cu, (const void*)mega, 512, LDS_BYTES) != hipSuccess || per_cu < 1) { fprintf(stderr, "kernel_launch: occupancy query says %d\n", per_cu); grid = -1; return; }
        (void)hipGetLastError();
        grid = cus;
        if (grid != 256) { fprintf(stderr, "kernel_launch: this kernel is laid out for 256 CUs, got %d\n", grid); grid = -1; return; }
    }
    if (grid < 0) return;
    if (hipMemsetAsync((unsigned char*)d_ws + WS_CTL, 0, 16384, stream) != hipSuccess) { fprintf(stderr, "kernel_launch: memset failed\n"); return; }
    Args a{};
    for (int i = 0; i < 29; ++i) a.in[i] = (const float*)d_in[i];
    a.out = (float*)d_out; a.ws = (unsigned char*)d_ws;
    void* kargs[] = {&a};
    hipError_t e = hipLaunchCooperativeKernel((const void*)mega, dim3(grid), dim3(512), kargs, LDS_BYTES, stream);
    if (e != hipSuccess) fprintf(stderr, "kernel_launch: cooperative launch failed: %s (grid %d)\n", hipGetErrorString(e), grid);
}
```

```cpp
#include <hip/hip_runtime.h>
#include <hip/hip_cooperative_groups.h>
#include <cstdio>
#include <cstdint>
namespace cg = cooperative_groups;

#define LAS __attribute__((address_space(3)))
typedef unsigned short bf16_t;
typedef short bf16x8 __attribute__((ext_vector_type(8)));
typedef float f32x4 __attribute__((ext_vector_type(4)));
typedef float f32x2 __attribute__((ext_vector_type(2)));
typedef unsigned u32x4 __attribute__((ext_vector_type(4)));
typedef unsigned u32x2 __attribute__((ext_vector_type(2)));

constexpr int DM = 1024, SEQ = 2048, NB = 8, MP = NB * SEQ, MS = 128, MA = MP + 256, NTILE = MA / 256;
constexpr int NIN = 6144, WA = 1024, WB = 1024, HA = 8, DHA = 128, HB = 4, DHB = 256, DPLE = 256, DMIX = 2048;
constexpr int LC = 256, NCH = SEQ / LC;
constexpr int NUNIT = NB * HB * NCH;
constexpr float EPS = 1e-6f;

constexpr size_t O_Y = 0, O_YS = 16777216, O_CP = 16908288, O_NP = 19005440, O_MP = 19013632, O_CVP = 19013664, O_CS = 19038240, O_NS = 52592672, O_MS = 52723744, O_CVS = 52724256, O_VS = 53117472, O_END = 53248544;

constexpr size_t MiB = 1u << 20;
constexpr size_t WS_CTL = 0, WS_WIN = 1 * MiB, WS_WQ = 13 * MiB, WS_WK = WS_WQ + MiB / 2, WS_WV = 14 * MiB, WS_WOUT = WS_WV + MiB / 2, WS_WPG = WS_WOUT + 4 * MiB, WS_WPP = WS_WPG + 2 * MiB,
    WS_WSP = 21 * MiB, WS_WG = WS_WSP + MiB / 4, WS_RS = WS_WG + MiB / 4, WS_GLI = 22 * MiB, WS_GLF = WS_GLI + MiB / 2, WS_DA = 23 * MiB, WS_DR = WS_DA + MiB / 2, WS_DG = 24 * MiB, WS_DEM = WS_DG + MiB / 2,
    WS_DW = 25 * MiB, WS_QN = WS_DW + MiB / 2, WS_DENP = 26 * MiB, WS_DN = 27 * MiB, WS_VS = WS_DN + MiB / 2, WS_PB = 28 * MiB, WS_XB = 37 * MiB, WS_PROJA = 70 * MiB, WS_PROJB = 168 * MiB,
    WS_PQ = 266 * MiB, WS_VC = 330 * MiB, WS_Y = 394 * MiB, WS_XB2 = 460 * MiB, WS_DN4 = 493 * MiB, WS_END = 495 * MiB;
constexpr size_t WS_WGB = WS_RS + MiB / 8;
constexpr size_t WS_Q = WS_PROJA, WS_K = WS_Q + 33 * MiB, WS_WKT = WS_K + 33 * MiB;
constexpr size_t WS_X1B = WS_PROJA, WS_GB = WS_X1B + 33 * MiB, WS_EB = WS_GB + 33 * MiB;
static_assert(WS_WKT + 32 * MiB <= WS_PROJB && WS_EB + 33 * MiB <= WS_PQ, "ws map");

__device__ __forceinline__ unsigned cvt_pk_bf16(float lo, float hi) { unsigned r; asm volatile("v_cvt_pk_bf16_f32 %0, %1, %2" : "=v"(r) : "v"(lo), "v"(hi)); return r; }
__device__ __forceinline__ float bf_lo(unsigned w) { return __uint_as_float(w << 16); }
__device__ __forceinline__ float bf_hi(unsigned w) { return __uint_as_float(w & 0xffff0000u); }
__device__ __forceinline__ float bf2f(bf16_t b) { return __uint_as_float(((unsigned)b) << 16); }
__device__ __forceinline__ bf16_t f2bf(float f) { return (bf16_t)(cvt_pk_bf16(f, 0.f) & 0xffffu); }
__device__ __forceinline__ float fast_exp(float x) { return __builtin_amdgcn_exp2f(x * 1.4426950408889634f); }
__device__ __forceinline__ float sigmoidf_(float x) { return __builtin_amdgcn_rcpf(1.0f + fast_exp(-x)); }
__device__ __forceinline__ float siluf_(float x) { return x * sigmoidf_(x); }
__device__ __forceinline__ f32x2 gelu_pk(f32x2 v) {
    const f32x2 av = __builtin_elementwise_abs(v), d = av * 0.2316418882f + 1.0f;
    f32x2 t; t.x = __builtin_amdgcn_rcpf(d.x); t.y = __builtin_amdgcn_rcpf(d.y);
    f32x2 q = t * 0.5307027145f + (-0.7265760135f); q = q * t + 0.7107068705f; q = q * t + (-0.142248368f); q = q * t + 0.127414796f; q = q * t;
    const f32x2 s = (v * v) * (-0.72134752044f);
    f32x2 e; e.x = __builtin_amdgcn_exp2f(s.x); e.y = __builtin_amdgcn_exp2f(s.y);
    const f32x2 m = v * (q * e), r = v - m;
    f32x2 o; o.x = v.x < 0.f ? m.x : r.x; o.y = v.y < 0.f ? m.y : r.y; return o;
}
__device__ __forceinline__ float dpp_add(float v, const int ctrl_sel) {
    const int iv = __builtin_bit_cast(int, v); int r;
    if (ctrl_sel == 0) r = __builtin_amdgcn_update_dpp(0, iv, 0xB1, 0xF, 0xF, true);
    else if (ctrl_sel == 1) r = __builtin_amdgcn_update_dpp(0, iv, 0x4E, 0xF, 0xF, true);
    else if (ctrl_sel == 2) r = __builtin_amdgcn_update_dpp(0, iv, 0x141, 0xF, 0xF, true);
    else r = __builtin_amdgcn_update_dpp(0, iv, 0x140, 0xF, 0xF, true);
    return v + __builtin_bit_cast(float, r);
}
__device__ __forceinline__ float wave_sum(float v) {
    v = dpp_add(v, 0); v = dpp_add(v, 1); v = dpp_add(v, 2); v = dpp_add(v, 3);
    const int iv = __builtin_bit_cast(int, v);
    const float r0 = __builtin_bit_cast(float, __builtin_amdgcn_readlane(iv, 0)), r1 = __builtin_bit_cast(float, __builtin_amdgcn_readlane(iv, 16)),
                r2 = __builtin_bit_cast(float, __builtin_amdgcn_readlane(iv, 32)), r3 = __builtin_bit_cast(float, __builtin_amdgcn_readlane(iv, 48));
    return (r0 + r1) + (r2 + r3);
}
#define LDS_WAIT() asm volatile("s_waitcnt lgkmcnt(0)" ::: "memory")

namespace pg8 {
constexpr int BM = 256, BK = 64, HALF = 128, HTB = HALF * BK * 2, STAGE_BYTES = 8 * HTB;
__host__ __device__ __forceinline__ int lds_byte(int r, int c) { const int st = (r >> 4) * 2 + (c >> 5), rr = r & 15, cc = c & 31, ob = rr * 64 + cc * 2; return st * 1024 + (ob ^ (((ob >> 9) & 1) << 5)); }
__host__ __device__ __forceinline__ void stage_rc(int b, int& R, int& C) { const int st = b / 1024, sb = b % 1024, swz = sb ^ (((sb >> 9) & 1) << 5); R = (st >> 1) * 16 + swz / 64; C = (st & 1) * 32 + (swz % 64) / 2; }
__host__ __device__ __forceinline__ int perm32(int rho) { const int n = rho >> 4, i = rho & 15; return 8 * (i >> 2) + 4 * n + (i & 3); }

struct Unit { const char* a; const char* b; int pm, pn, aux; };
struct Gemm { int lda, ldb, K; };

template <class Epi, class Sched, bool ALIGN_EPI = true, bool SP2 = true>
__device__ __forceinline__ void gemm_phase(LAS unsigned char* lds, const Gemm g, const Sched& S, const Epi& E) {
    int tid_ = threadIdx.x; asm volatile("" : "+v"(tid_));
    const int tid = tid_, wid = __builtin_amdgcn_readfirstlane(tid >> 6), lane = tid & 63, wr = wid >> 2, wc = wid & 3, fr = lane & 15, fq = lane >> 4;
    int K_ = g.K; asm volatile("" : "+s"(K_)); const int K = K_, nt = K / BK; (void)K;
    unsigned voffA[2], voffB[2];
#pragma unroll
    for (int i = 0; i < 2; ++i) { int R, C; stage_rc(tid * 16 + i * 8192, R, C); const int Rb = Epi::PERM ? ((R & ~31) + perm32(R & 31)) : R;
        voffA[i] = (unsigned)(R * g.lda + C) * 2u; voffB[i] = (unsigned)(Rb * g.ldb + C) * 2u; }
    const size_t kstep = (size_t)(BK * 2);
    const size_t hstepA = (size_t)HALF * g.lda * 2, hstepB = (size_t)HALF * g.ldb * 2;
    const unsigned ldsw = (unsigned)wid * 1024u;
    const int aoff = lds_byte(wr * 64 + fr, fq * 8), boff = lds_byte(wc * 32 + fr, fq * 8);
#define PG8_SA(b, h) (((b) * 2 + (h)) * HTB)
#define PG8_SB(b, h) ((4 + (b) * 2 + (h)) * HTB)
#define PG8_STAGE(bufoff, gbase, voff) do { _Pragma("unroll") for (int _i = 0; _i < 2; ++_i) \
        __builtin_amdgcn_global_load_lds((const unsigned*)((const char*)(gbase) + (voff)[_i]), (LAS unsigned*)(lds + (bufoff) + ldsw + _i * 8192), 16, 0, 0); } while (0)
#define PG8_LDA(dst, b, h) do { _Pragma("unroll") for (int m = 0; m < 4; ++m) _Pragma("unroll") for (int k = 0; k < 2; ++k) dst[m][k] = *(const LAS bf16x8*)(lds + PG8_SA(b, h) + aoff + m * 2048 + k * 1024); } while (0)
#define PG8_LDB(dst, b, h) do { _Pragma("unroll") for (int n = 0; n < 2; ++n) _Pragma("unroll") for (int k = 0; k < 2; ++k) dst[n][k] = *(const LAS bf16x8*)(lds + PG8_SB(b, h) + boff + n * 2048 + k * 1024); } while (0)
#define PG8_MMA(ai, bj, At, Bt) do { __builtin_amdgcn_s_setprio(1); _Pragma("unroll") for (int m = 0; m < 4; ++m) _Pragma("unroll") for (int n = 0; n < 2; ++n) _Pragma("unroll") for (int k = 0; k < 2; ++k) \
        acc[ai][bj][m][n] = __builtin_amdgcn_mfma_f32_16x16x32_bf16(Bt[n][k], At[m][k], acc[ai][bj][m][n], 0, 0, 0); __builtin_amdgcn_s_setprio(0); } while (0)
#define PG8_WAIT_V(n) asm volatile("s_waitcnt vmcnt(" #n ")" ::: "memory")
#define PG8_WAIT_L(n) asm volatile("s_waitcnt lgkmcnt(" #n ")" ::: "memory")
#define PG8_BAR __builtin_amdgcn_s_barrier()
#define PG8_SCHED __builtin_amdgcn_sched_barrier(0)
    Unit cur, nxt; int ui = 0;
    if (!S.next(0, cur)) return;
    f32x4 acc[2][2][4][2];
#pragma unroll
    for (int a = 0; a < 2; ++a)
#pragma unroll
        for (int b = 0; b < 2; ++b)
#pragma unroll
            for (int m = 0; m < 4; ++m)
#pragma unroll
                for (int n = 0; n < 2; ++n) acc[a][b][m][n] = (f32x4){0.f, 0.f, 0.f, 0.f};
    bf16x8 At[4][2], B0[2][2], B1[2][2];
    const char* cA = cur.a; const char* cB = cur.b;
    if constexpr (SP2) {
        PG8_STAGE(PG8_SB(0, 0), cB, voffB); PG8_STAGE(PG8_SB(0, 1), cB + hstepB, voffB); PG8_STAGE(PG8_SA(0, 0), cA, voffA); PG8_STAGE(PG8_SA(0, 1), cA + hstepA, voffA);
        if (wr == 1) PG8_BAR;
        PG8_WAIT_V(2); PG8_BAR;
        PG8_STAGE(PG8_SB(1, 0), cB + kstep, voffB); PG8_STAGE(PG8_SA(1, 0), cA + kstep, voffA); PG8_STAGE(PG8_SB(1, 1), cB + hstepB + kstep, voffB);
        PG8_WAIT_V(6); PG8_BAR;
    } else {
        PG8_STAGE(PG8_SB(0, 0), cB, voffB); PG8_STAGE(PG8_SA(0, 0), cA, voffA); PG8_STAGE(PG8_SB(0, 1), cB + hstepB, voffB); PG8_STAGE(PG8_SA(0, 1), cA + hstepA, voffA);
        if (wr == 1) PG8_BAR;
        PG8_WAIT_V(4); PG8_BAR;
        PG8_STAGE(PG8_SB(1, 0), cB + kstep, voffB); PG8_STAGE(PG8_SA(1, 0), cA + kstep, voffA); PG8_STAGE(PG8_SB(1, 1), cB + hstepB + kstep, voffB);
        PG8_WAIT_V(6); PG8_BAR;
    }
    for (;;) {
        const bool has_next = S.next(ui + 1, nxt);
        const char* nA = has_next ? nxt.a : cA; const char* nB = has_next ? nxt.b : cB;
#pragma unroll 1
        for (int t = 0; t < nt; t += 2) {
            const bool last = (t == nt - 2);
            const char* a1 = cA + (size_t)(t + 1) * kstep;
            const char* a2 = last ? nA : cA + (size_t)(t + 2) * kstep; const char* b2 = last ? nB : cB + (size_t)(t + 2) * kstep;
            const char* a3 = a2 + kstep; const char* b3 = b2 + kstep;
            if constexpr (SP2) {
            PG8_LDB(B0, 0, 0); PG8_LDB(B1, 0, 1); PG8_SCHED; PG8_LDA(At, 0, 0); PG8_STAGE(PG8_SA(1, 1), a1 + hstepA, voffA);
            PG8_WAIT_V(8); PG8_WAIT_L(0); PG8_BAR; PG8_MMA(0, 0, At, B0); PG8_MMA(0, 1, At, B1); PG8_BAR; PG8_SCHED;
            PG8_LDA(At, 0, 1); PG8_STAGE(PG8_SB(0, 0), b2, voffB); PG8_STAGE(PG8_SB(0, 1), b2 + hstepB, voffB); PG8_STAGE(PG8_SA(0, 0), a2, voffA);
            PG8_WAIT_V(8); PG8_WAIT_L(0); PG8_BAR; PG8_MMA(1, 0, At, B0); PG8_MMA(1, 1, At, B1); PG8_BAR; PG8_SCHED;
            PG8_LDB(B0, 1, 0); PG8_LDB(B1, 1, 1); PG8_SCHED; PG8_LDA(At, 1, 0); PG8_STAGE(PG8_SA(0, 1), a2 + hstepA, voffA);
            PG8_WAIT_V(8); PG8_WAIT_L(0); PG8_BAR; PG8_MMA(0, 0, At, B0); PG8_MMA(0, 1, At, B1); PG8_BAR; PG8_SCHED;
            PG8_LDA(At, 1, 1); PG8_STAGE(PG8_SB(1, 0), b3, voffB); PG8_STAGE(PG8_SB(1, 1), b3 + hstepB, voffB); PG8_STAGE(PG8_SA(1, 0), a3, voffA);
            PG8_WAIT_V(8); PG8_WAIT_L(0); PG8_BAR; PG8_MMA(1, 0, At, B0); PG8_MMA(1, 1, At, B1); PG8_BAR; PG8_SCHED;
            } else {
            PG8_LDB(B0, 0, 0); PG8_SCHED; PG8_LDA(At, 0, 0); PG8_STAGE(PG8_SA(1, 1), a1 + hstepA, voffA);
            PG8_WAIT_L(8); PG8_BAR; PG8_WAIT_L(0); PG8_MMA(0, 0, At, B0); PG8_BAR; PG8_SCHED;
            PG8_LDB(B1, 0, 1); PG8_STAGE(PG8_SB(0, 0), b2, voffB);
            PG8_BAR; PG8_WAIT_L(0); PG8_MMA(0, 1, At, B1); PG8_BAR;
            PG8_LDA(At, 0, 1); PG8_STAGE(PG8_SA(0, 0), a2, voffA);
            PG8_BAR; PG8_WAIT_L(0); PG8_MMA(1, 0, At, B0); PG8_BAR; PG8_SCHED;
            PG8_STAGE(PG8_SB(0, 1), b2 + hstepB, voffB);
            PG8_WAIT_V(6); PG8_BAR; PG8_MMA(1, 1, At, B1); PG8_BAR;
            PG8_LDB(B0, 1, 0); PG8_SCHED; PG8_LDA(At, 1, 0); PG8_STAGE(PG8_SA(0, 1), a2 + hstepA, voffA);
            PG8_WAIT_L(8); PG8_BAR; PG8_WAIT_L(0); PG8_MMA(0, 0, At, B0); PG8_BAR; PG8_SCHED;
            PG8_LDB(B1, 1, 1); PG8_STAGE(PG8_SB(1, 0), b3, voffB);
            PG8_BAR; PG8_WAIT_L(0); PG8_MMA(0, 1, At, B1); PG8_BAR;
            PG8_LDA(At, 1, 1); PG8_STAGE(PG8_SA(1, 0), a3, voffA);
            PG8_BAR; PG8_WAIT_L(0); PG8_MMA(1, 0, At, B0); PG8_BAR; PG8_SCHED;
            PG8_STAGE(PG8_SB(1, 1), b3 + hstepB, voffB);
            PG8_WAIT_V(6); PG8_BAR; PG8_MMA(1, 1, At, B1); PG8_BAR;
            }
        }
        if constexpr (ALIGN_EPI) { if (wr == 0) PG8_BAR; }
        if constexpr (!Epi::AFTER_DRAIN) { E(acc, cur, wr, wc, fr, fq); }
        if (!has_next) break;
#pragma unroll
        for (int a = 0; a < 2; ++a)
#pragma unroll
            for (int b = 0; b < 2; ++b)
#pragma unroll
                for (int m = 0; m < 4; ++m)
#pragma unroll
                    for (int n = 0; n < 2; ++n) acc[a][b][m][n] = (f32x4){0.f, 0.f, 0.f, 0.f};
        cur = nxt; cA = nA; cB = nB; ++ui;
        if constexpr (ALIGN_EPI) { if (wr == 1) PG8_BAR; }
    }
    PG8_WAIT_V(0);
    if constexpr (!ALIGN_EPI) { if (wr == 0) PG8_BAR; }
    PG8_BAR;
    if constexpr (Epi::AFTER_DRAIN) { E.fused(acc, cur, wr, wc, fr, fq, lds, wid, lane); }
#undef PG8_SA
#undef PG8_SB
#undef PG8_STAGE
#undef PG8_LDA
#undef PG8_LDB
#undef PG8_MMA
#undef PG8_WAIT_V
#undef PG8_WAIT_L
#undef PG8_BAR
#undef PG8_SCHED
}
}
using pg8::Unit; using pg8::Gemm;

constexpr int LDS_BYTES = 147456;
struct Args { const float* in[29]; float* out; unsigned char* ws; };

struct Ctx {
    LAS unsigned char* lds; int tid, lane, wave, G, bid, gw, NGW;
    const float* const* in; float* out; unsigned char* ws;
};

__device__ __forceinline__ void p0_transpose_item(const float* W, int ldw, bf16_t* WT, int ldt, const float* kscale, LAS float* scr, int kb, int nb, int lane) {
    const int k0 = 64 * kb, n0 = 32 * nb;
    float wv_[32];
#pragma unroll
    for (int i = 0; i < 32; ++i) { const int kk = 2 * i + (lane >> 5); wv_[i] = __builtin_nontemporal_load(W + (size_t)(k0 + kk) * ldw + n0 + (lane & 31)); }
#pragma unroll
    for (int i = 0; i < 32; ++i) { const int kk = 2 * i + (lane >> 5); float v = wv_[i]; if (kscale) v *= kscale[k0 + kk]; scr[kk * 33 + (lane & 31)] = v; }
    LDS_WAIT(); asm volatile("" ::: "memory");
    const int c = lane & 7;
#pragma unroll
    for (int j = 0; j < 4; ++j) { const int n = (lane >> 3) + 8 * j; const LAS float* s = scr + (8 * c) * 33 + n;
        u32x4 o; o.x = cvt_pk_bf16(s[0 * 33], s[1 * 33]); o.y = cvt_pk_bf16(s[2 * 33], s[3 * 33]); o.z = cvt_pk_bf16(s[4 * 33], s[5 * 33]); o.w = cvt_pk_bf16(s[6 * 33], s[7 * 33]);
        *(u32x4*)(WT + (size_t)(n0 + n) * ldt + k0 + 8 * c) = o; }
    LDS_WAIT(); asm volatile("" ::: "memory");
}

__device__ __forceinline__ void p0_prologue(const Ctx& F0) { Ctx F = F0; asm volatile("" : "+v"(F.tid), "+v"(F.lane), "+s"(F.gw));
    LAS float* scr = (LAS float*)(F.lds + F.wave * 16384);
    unsigned char* ws = F.ws;
    constexpr int I_WIN = 16 * 192, I_QKV = 12 * 4 * 8, I_WOUT = 32 * 32, I_WPG = 16 * 32, I_WPP = 4 * 32;
    constexpr int I_T = I_WIN + I_QKV + I_WOUT + I_WPG + I_WPP;
    constexpr int I_X = 0, I_P = 0, I_SP = 1024, I_WG = 1024, I_YPAD = 128;
    constexpr int NITEMS = I_T + I_X + I_P + I_SP + I_WG + I_YPAD;
    for (int it = F.gw; it < NITEMS; it += F.NGW) {
        int r = it;
        if (r < I_T) {
            if (r < I_WIN) { p0_transpose_item(F.in[9], NIN, (bf16_t*)(ws + WS_WIN), DM, F.in[8], scr, r / 192, r % 192, F.lane); continue; } r -= I_WIN;
            if (r < I_QKV) { const int mat = r / 32, rr = r % 32, which = mat / 4, h = mat % 4;
                const float* W = F.in[16 + which] + (size_t)h * 65536; bf16_t* WT = (bf16_t*)(ws + (which == 0 ? WS_WQ : which == 1 ? WS_WK : WS_WV)) + (size_t)h * 65536;
                p0_transpose_item(W, 256, WT, 256, nullptr, scr, rr / 8, rr % 8, F.lane); continue; } r -= I_QKV;
            if (r < I_WOUT) { p0_transpose_item(F.in[23], DM, (bf16_t*)(ws + WS_WOUT), DMIX, nullptr, scr, r / 32, r % 32, F.lane); continue; } r -= I_WOUT;
            if (r < I_WPG) { p0_transpose_item(F.in[24], DM, (bf16_t*)(ws + WS_WPG), DM, nullptr, scr, r / 32, r % 32, F.lane); continue; } r -= I_WPG;
            p0_transpose_item(F.in[26], DM, (bf16_t*)(ws + WS_WPP), DPLE, nullptr, scr, r / 32, r % 32, F.lane); continue;
        }
        r -= I_T;
        if (r < I_X) {
            bf16_t* orow = (bf16_t*)(ws + WS_XB) + (size_t)r * DM; float* rs = (float*)(ws + WS_RS);
            unsigned long long* o8 = (unsigned long long*)orow + F.lane;
            if (r >= MP + MS) {
#pragma unroll
                for (int j = 0; j < 4; ++j) o8[64 * j] = 0ull;
                if (F.lane == 0) rs[r] = 0.f; continue; }
            const float* xrow = r < MP ? F.in[0] + (size_t)r * DM : F.in[1] + (size_t)(r - MP) * DM;
            const f32x4* xr = (const f32x4*)xrow + F.lane; f32x4 v[4]; float s = 0.f;
#pragma unroll
            for (int j = 0; j < 4; ++j) { v[j] = xr[64 * j]; s += (v[j].x * v[j].x + v[j].y * v[j].y) + (v[j].z * v[j].z + v[j].w * v[j].w); }
            s = wave_sum(s);
#pragma unroll
            for (int j = 0; j < 4; ++j) o8[64 * j] = (unsigned long long)cvt_pk_bf16(v[j].x, v[j].y) | ((unsigned long long)cvt_pk_bf16(v[j].z, v[j].w) << 32);
            if (F.lane == 0) rs[r] = 1.0f / sqrtf(s * (1.0f / DM) + EPS);
            continue;
        }
        r -= I_X;
        if (r < I_P) {
            unsigned long long* o8 = (unsigned long long*)((bf16_t*)(ws + WS_PB) + (size_t)r * DPLE) + F.lane;
            if (r >= MP + MS) { o8[0] = 0ull; continue; }
            const float* prow = r < MP ? F.in[6] + (size_t)r * DPLE : F.in[7] + (size_t)(r - MP) * DPLE;
            const f32x4 v = __builtin_nontemporal_load((const f32x4*)prow + F.lane);
            o8[0] = (unsigned long long)cvt_pk_bf16(v.x, v.y) | ((unsigned long long)cvt_pk_bf16(v.z, v.w) << 32);
            continue;
        }
        r -= I_P;
        if (r < I_SP) {
            const int t = r & 127; const float* wrow = F.in[12] + (size_t)r * 128; const f32x2 v = ((const f32x2*)wrow)[F.lane];
            const int s0 = 2 * F.lane; ((unsigned*)((bf16_t*)(ws + WS_WSP) + (size_t)r * 128))[F.lane] = cvt_pk_bf16(s0 <= t ? v.x : 0.f, s0 + 1 <= t ? v.y : 0.f);
            continue;
        }
        r -= I_SP;
        if (r < I_WG) {
            const int i = r, h = i >> 8, d = i & 255; const float* wif = F.in[19];
            const f32x4 wq4 = *(const f32x4*)(F.in[16] + ((size_t)h * 256 + d) * 256 + 4 * F.lane), wk4 = *(const f32x4*)(F.in[17] + ((size_t)h * 256 + d) * 256 + 4 * F.lane), wv4 = *(const f32x4*)(F.in[18] + ((size_t)h * 256 + d) * 256 + 4 * F.lane);
            float sx[8], sb[8];
#pragma unroll
            for (int j = 0; j < 8; ++j) { sx[j] = 0.f; sb[j] = 0.f; }
#pragma unroll
            for (int e = 0; e < 4; ++e) { const size_t rq = (size_t)(h * 256 + 4 * F.lane + e) * 8;
                const f32x4 q0 = *(const f32x4*)(wif + rq), q1 = *(const f32x4*)(wif + rq + 4), k0 = *(const f32x4*)(wif + 8192 + rq), k1 = *(const f32x4*)(wif + 8192 + rq + 4), v0 = *(const f32x4*)(wif + 16384 + rq), v1 = *(const f32x4*)(wif + 16384 + rq + 4);
#pragma unroll
                for (int j = 0; j < 4; ++j) { sx[j] += wq4[e] * q0[j] + wk4[e] * k0[j]; sx[4 + j] += wq4[e] * q1[j] + wk4[e] * k1[j]; sb[j] += wv4[e] * v0[j]; sb[4 + j] += wv4[e] * v1[j]; } }
#pragma unroll
            for (int j = 0; j < 8; ++j) { sx[j] = wave_sum(sx[j]); sb[j] = wave_sum(sb[j]); }
            float s = 0.f;
#pragma unroll
            for (int j = 0; j < 8; ++j) { s = (F.lane == j) ? sx[j] : s; s = (F.lane == 8 + j) ? sb[j] : s; }
            if (F.lane < 16) ((float*)(ws + WS_WG))[(size_t)i * 16 + F.lane] = s;
            if (F.lane < 16) { bf16_t* wgb = (bf16_t*)(ws + WS_WGB) + (size_t)(F.lane >> 3) * 16384 + (size_t)(F.lane & 7) * 1024 + i; wgb[0] = f2bf(s); wgb[8 * 1024] = 0; }
            continue;
        }
        r -= I_WG;
        {
            u32x4* yrow = (u32x4*)((bf16_t*)(ws + WS_Y) + (size_t)(MP + MS + r) * DMIX) + F.lane;
#pragma unroll
            for (int j = 0; j < 4; ++j) yrow[64 * j] = (u32x4){0u, 0u, 0u, 0u};
        }
    }
    {
        float* rs = (float*)(ws + WS_RS);
        for (int r0 = F.gw * 4; r0 < MP + MS; r0 += F.NGW * 4) { f32x4 v[4][4];
#pragma unroll
            for (int q = 0; q < 4; ++q) { const int r = r0 + q; const float* xrow = r < MP ? F.in[0] + (size_t)r * DM : F.in[1] + (size_t)(r - MP) * DM;
#pragma unroll
                for (int j = 0; j < 4; ++j) v[q][j] = __builtin_nontemporal_load((const f32x4*)xrow + F.lane + 64 * j); }
#pragma unroll
            for (int q = 0; q < 4; ++q) { const int r = r0 + q; float sq = 0.f;
#pragma unroll
                for (int j = 0; j < 4; ++j) sq += (v[q][j].x * v[q][j].x + v[q][j].y * v[q][j].y) + (v[q][j].z * v[q][j].z + v[q][j].w * v[q][j].w);
                sq = wave_sum(sq); unsigned long long* o8 = (unsigned long long*)((bf16_t*)(ws + WS_XB) + (size_t)r * DM) + F.lane;
#pragma unroll
                for (int j = 0; j < 4; ++j) o8[64 * j] = (unsigned long long)cvt_pk_bf16(v[q][j].x, v[q][j].y) | ((unsigned long long)cvt_pk_bf16(v[q][j].z, v[q][j].w) << 32);
                if (F.lane == 0) rs[r] = 1.0f / sqrtf(sq * (1.0f / DM) + EPS); } }
        for (int r = MP + MS + F.gw; r < MA; r += F.NGW) { unsigned long long* o8 = (unsigned long long*)((bf16_t*)(ws + WS_XB) + (size_t)r * DM) + F.lane;
#pragma unroll
            for (int j = 0; j < 4; ++j) o8[64 * j] = 0ull;
            if (F.lane == 0) rs[r] = 0.f; ((unsigned long long*)((bf16_t*)(ws + WS_PB) + (size_t)r * DPLE))[F.lane] = 0ull; }
        for (int r0 = F.gw * 8; r0 < MP + MS; r0 += F.NGW * 8) { f32x4 pv[8];
#pragma unroll
            for (int q = 0; q < 8; ++q) { const int r = r0 + q; const float* prow = r < MP ? F.in[6] + (size_t)r * DPLE : F.in[7] + (size_t)(r - MP) * DPLE; pv[q] = __builtin_nontemporal_load((const f32x4*)prow + F.lane); }
#pragma unroll
            for (int q = 0; q < 8; ++q) ((unsigned long long*)((bf16_t*)(ws + WS_PB) + (size_t)(r0 + q) * DPLE))[F.lane] = (unsigned long long)cvt_pk_bf16(pv[q].x, pv[q].y) | ((unsigned long long)cvt_pk_bf16(pv[q].z, pv[q].w) << 32); }
    }
}

struct OrderRowMajor {
    int nM, nN, n, G, c; const char* A; const char* B; size_t astep, bstep;
    __device__ __forceinline__ bool next(int i, Unit& u) const {
        const int L = i * G + c; if (L >= n) return false;
        u.pm = L / nN; u.pn = L % nN; u.aux = 0; u.a = A + (size_t)u.pm * astep; u.b = B + (size_t)u.pn * bstep; return true;
    }
};
struct OrderPanel4 {
    int n, G, c; const char* A; const char* B; size_t astep, bstep;
    __device__ __forceinline__ bool next(int i, Unit& u) const {
        const int L = i * G + c; if (L >= n) return false;
        if (L < 256) { const int x = L & 7, j = L >> 3; u.pm = x * 8 + (j >> 2); u.pn = j & 3; } else { u.pm = 64; u.pn = L - 256; }
        u.aux = 0; u.a = A + (size_t)u.pm * astep; u.b = B + (size_t)u.pn * bstep; return true;
    }
};
struct OrderProjSkip {
    int G, c; const char* A; const char* B; size_t astep, bstep;
    __device__ __forceinline__ bool next(int i, Unit& u) const {
        if (c < 4) return false; const int cp = c - 4; const int L = i == 0 ? cp : (i == 1 && cp < 8 ? 252 + cp : -1); if (L < 0) return false;
        if (L < 256) { const int x = L & 7, j = L >> 3; u.pm = x * 8 + (j >> 2); u.pn = j & 3; } else { u.pm = 64; u.pn = L - 256; }
        u.aux = 0; u.a = A + (size_t)u.pm * astep; u.b = B + (size_t)u.pn * bstep; return true;
    }
};
struct OrderXcd {
    int nM, nN, n, G, c; const char* A; const char* B; size_t astep, bstep;
    __device__ __forceinline__ bool next(int i, Unit& u) const {
        const int L = i * G + c; if (L >= n) return false;
        int wgid = L; { const int q = n / 8, r = n % 8, xcd = wgid % 8, off = wgid / 8; wgid = (xcd < r ? xcd * (q + 1) : r * (q + 1) + (xcd - r) * q) + off; }
        const int nig = 8 * nN, gid = wgid / nig, fm = gid * 8, gsz = (nM - fm) < 8 ? (nM - fm) : 8;
        u.pm = fm + ((wgid % nig) % gsz); u.pn = (wgid % nig) / gsz; u.aux = 0; u.a = A + (size_t)u.pm * astep; u.b = B + (size_t)u.pn * bstep; return true;
    }
};
struct EpiInProj {
    static constexpr bool PERM = true, AFTER_DRAIN = false;
    bf16_t* PA; bf16_t* PB; const float* rs;
    template <int KIND> __device__ __forceinline__ void run(const f32x4 (&acc)[2][2][4][2], bf16_t* base, int row0, int col0) const {
#pragma unroll
        for (int ai = 0; ai < 2; ++ai)
#pragma unroll
            for (int m = 0; m < 4; ++m) { const int row = row0 + ai * 128 + m * 16; const float s = rs[row]; bf16_t* rowp = base + (size_t)row * 3072 + col0;
#pragma unroll
                for (int bj = 0; bj < 2; ++bj) { f32x4 v0 = acc[ai][bj][m][0] * s, v1 = acc[ai][bj][m][1] * s;
                    if (KIND == 0) { f32x2 a = gelu_pk((f32x2){v0[0], v0[1]}), b = gelu_pk((f32x2){v0[2], v0[3]}), c = gelu_pk((f32x2){v1[0], v1[1]}), d = gelu_pk((f32x2){v1[2], v1[3]});
                        v0 = (f32x4){a.x, a.y, b.x, b.y}; v1 = (f32x4){c.x, c.y, d.x, d.y}; }
                    if (KIND == 1) {
#pragma unroll
                        for (int j = 0; j < 4; ++j) { v0[j] = siluf_(v0[j]); v1[j] = siluf_(v1[j]); } }
                    if (KIND == 3) {
#pragma unroll
                        for (int j = 0; j < 4; ++j) { v0[j] = sigmoidf_(v0[j]); v1[j] = sigmoidf_(v1[j]); } }
                    u32x4 w; w.x = cvt_pk_bf16(v0[0], v0[1]); w.y = cvt_pk_bf16(v0[2], v0[3]); w.z = cvt_pk_bf16(v1[0], v1[1]); w.w = cvt_pk_bf16(v1[2], v1[3]);
                    *(u32x4*)(rowp + bj * 128) = w; } }
    }
    __device__ __forceinline__ void operator()(const f32x4 (&acc)[2][2][4][2], const Unit& u, int wr, int wc, int fr, int fq) const {
        const int row0 = u.pm * 256 + wr * 64 + fr, pn = u.pn;
        bf16_t* base = pn < 12 ? PA + pn * 256 : PB + (pn - 12) * 256; const int col0 = wc * 32 + 8 * fq;
        if (pn < 8) run<0>(acc, base, row0, col0);
        else if (pn < 12 || pn >= 20) run<1>(acc, base, row0, col0);
        else if (pn < 16) run<2>(acc, base, row0, col0);
        else run<3>(acc, base, row0, col0);
    }
};

__device__ __forceinline__ float logsigmoidf_(float x) { return fminf(x, 0.f) - log1pf(__expf(-fabsf(x))); }
__device__ __forceinline__ void unpack8(const u32x4 w, float (&f)[8]) { f[0] = bf_lo(w.x); f[1] = bf_hi(w.x); f[2] = bf_lo(w.y); f[3] = bf_hi(w.y); f[4] = bf_lo(w.z); f[5] = bf_hi(w.z); f[6] = bf_lo(w.w); f[7] = bf_hi(w.w); }
__device__ __forceinline__ u32x4 pack8(const float (&f)[8]) { u32x4 w; w.x = cvt_pk_bf16(f[0], f[1]); w.y = cvt_pk_bf16(f[2], f[3]); w.z = cvt_pk_bf16(f[4], f[5]); w.w = cvt_pk_bf16(f[6], f[7]); return w; }

__device__ __forceinline__ void p2a_conv_gates(const Ctx& F0) { Ctx F = F0; asm volatile("" : "+v"(F.tid), "+v"(F.lane), "+s"(F.gw));
    unsigned char* ws = F.ws;
    const bf16_t* PBX = (const bf16_t*)(ws + WS_PROJB);
    bf16_t* XC = (bf16_t*)(ws + WS_XB); bf16_t* XB2 = (bf16_t*)(ws + WS_XB2);
    const float* Wg = (const float*)(ws + WS_WG);
    float* GLI = (float*)(ws + WS_GLI); float* GLF = (float*)(ws + WS_GLF);
    const float* convw = F.in[14]; const float* convb = F.in[15]; const float* bif = F.in[20];
    LAS float* cwl = (LAS float*)F.lds; LAS bf16_t* wgl = (LAS bf16_t*)(F.lds + 20480); LAS f32x4* comb = (LAS f32x4*)(F.lds + 20480 + 65536);
    {
        u32x4 t[11];
#pragma unroll
        for (int j = 0; j < 11; ++j) { const int i = F.tid + 512 * j; t[j] = (u32x4){0u, 0u, 0u, 0u};
            if (i < 1024) t[j] = ((const u32x4*)convw)[i]; else if (i < 1280) t[j] = ((const u32x4*)convb)[i - 1024]; else if (i < 5376) t[j] = ((const u32x4*)(ws + WS_WGB))[i - 1280]; }
#pragma unroll
        for (int j = 0; j < 11; ++j) { const int i = F.tid + 512 * j; if (i < 5376) ((LAS u32x4*)F.lds)[i] = t[j]; }
    }
    __syncthreads();
    const int l15 = F.lane & 15, lq = F.lane >> 4, rgp = F.wave >> 1, hh = F.wave & 1;
    auto conv_block = [&](int row, bool smp, int seq0, const float* st, int ch0, f32x4& acc) {
        u32x4 x3 = (u32x4){0u, 0u, 0u, 0u}, x2 = x3, x1 = x3; const u32x4 x0 = *(const u32x4*)(PBX + (size_t)row * 3072 + ch0);
        float w0[8], w1[8], w2[8], cur[8], xc[8];
        if (!smp) {
            if (row - 3 >= seq0) x3 = *(const u32x4*)(PBX + (size_t)(row - 3) * 3072 + ch0);
            if (row - 2 >= seq0) x2 = *(const u32x4*)(PBX + (size_t)(row - 2) * 3072 + ch0);
            if (row - 1 >= seq0) x1 = *(const u32x4*)(PBX + (size_t)(row - 1) * 3072 + ch0);
            unpack8(x3, w0); unpack8(x2, w1); unpack8(x1, w2);
        } else {
#pragma unroll
            for (int q = 0; q < 2; ++q) { const f32x4 a0 = *(const f32x4*)(st + ch0 + 4 * q), a1 = *(const f32x4*)(st + 1024 + ch0 + 4 * q), a2 = *(const f32x4*)(st + 2048 + ch0 + 4 * q);
#pragma unroll
                for (int e = 0; e < 4; ++e) { w0[4 * q + e] = a0[e]; w1[4 * q + e] = a1[e]; w2[4 * q + e] = a2[e]; } }
        }
        unpack8(x0, cur);
#pragma unroll
        for (int q = 0; q < 2; ++q) { const f32x4 c0 = *(const LAS f32x4*)(cwl + ch0 + 4 * q), c1 = *(const LAS f32x4*)(cwl + 1024 + ch0 + 4 * q), c2 = *(const LAS f32x4*)(cwl + 2048 + ch0 + 4 * q), c3 = *(const LAS f32x4*)(cwl + 3072 + ch0 + 4 * q), cb = *(const LAS f32x4*)(cwl + 4096 + ch0 + 4 * q);
#pragma unroll
            for (int e = 0; e < 4; ++e) xc[4 * q + e] = siluf_(c0[e] * w0[4 * q + e] + c1[e] * w1[4 * q + e] + c2[e] * w2[4 * q + e] + c3[e] * cur[4 * q + e] + cb[e]); }
        const u32x4 xcp = pack8(xc);
        *(u32x4*)(XC + (size_t)row * DM + ch0) = xcp; *(u32x4*)(XB2 + (size_t)row * DM + ch0) = x0;
        const bf16x8 bc = *(const LAS bf16x8*)(wgl + l15 * 1024 + ch0), bx = *(const LAS bf16x8*)(wgl + 16384 + l15 * 1024 + ch0);
        acc = __builtin_amdgcn_mfma_f32_16x16x32_bf16(__builtin_bit_cast(bf16x8, xcp), bc, acc, 0, 0, 0);
        acc = __builtin_amdgcn_mfma_f32_16x16x32_bf16(__builtin_bit_cast(bf16x8, x0), bx, acc, 0, 0, 0);
    };
    for (int tile = F.bid; tile < MP / 64; tile += F.G) {
        const int row = tile * 64 + rgp * 16 + l15, seq0 = row & ~(SEQ - 1);
        f32x4 acc = (f32x4){0.f, 0.f, 0.f, 0.f};
#pragma unroll 8
        for (int cbk = 0; cbk < 16; ++cbk) conv_block(row, false, seq0, nullptr, (hh * 16 + cbk) * 32 + 8 * lq, acc);
        __syncthreads();
        if (hh == 1) comb[rgp * 64 + F.lane] = acc;
        __syncthreads();
        if (hh == 0 && l15 < 8) { const f32x4 o = comb[rgp * 64 + F.lane]; const float bj = bif[l15];
#pragma unroll
            for (int r = 0; r < 4; ++r) { const float g = acc[r] + o[r] + bj; const size_t rr = (size_t)(tile * 64 + rgp * 16 + 4 * lq + r);
                if (l15 < 4) GLI[(size_t)l15 * MA + rr] = g; else GLF[(size_t)(l15 - 4) * MA + rr] = logsigmoidf_(g); } }
    }
    for (int si = F.G - 1 - F.bid; si < MS / 16; si += F.G) {
        const int row = MP + si * 16 + l15; const float* st = F.in[5] + (size_t)(row - MP) * 3072;
        f32x4 acc = (f32x4){0.f, 0.f, 0.f, 0.f};
#pragma unroll
        for (int cbk = 0; cbk < 4; ++cbk) conv_block(row, true, 0, st, (F.wave * 4 + cbk) * 32 + 8 * lq, acc);
        __syncthreads();
        comb[F.wave * 64 + F.lane] = acc;
        __syncthreads();
        if (F.wave == 0 && l15 < 8) { f32x4 o = comb[F.lane];
#pragma unroll
            for (int ww = 1; ww < 8; ++ww) o = o + comb[ww * 64 + F.lane];
            const float bj = bif[l15];
#pragma unroll
            for (int r = 0; r < 4; ++r) { const float g = o[r] + bj; const size_t rr = (size_t)(MP + si * 16 + 4 * lq + r);
                if (l15 < 4) GLI[(size_t)l15 * MA + rr] = g; else GLF[(size_t)(l15 - 4) * MA + rr] = logsigmoidf_(g); } }
    }
}
__device__ __forceinline__ void p2c_sample_rows(const Ctx& F0) { Ctx F = F0; asm volatile("" : "+v"(F.tid), "+v"(F.lane), "+s"(F.gw));
    unsigned char* ws = F.ws;
    const bf16_t* PBX = (const bf16_t*)(ws + WS_PROJB);
    if (F.bid >= 64 && F.bid < 112) { const int i = (F.bid - 64) * 512 + F.tid; const int b = i / 3072, j = (i / 1024) % 3, ch = i & 1023;
        F.out[O_CVP + i] = bf2f(PBX[(size_t)(b * SEQ + SEQ - 3 + j) * 3072 + ch]); }
    if (F.bid >= 112 && F.bid < 128) { const int i = (F.bid - 112) * 8 + F.wave;
        const int r = MP + i, ch0s = F.lane * 16; const float* st = F.in[5] + (size_t)i * 3 * 1024;
        const bf16_t* PA = (const bf16_t*)(ws + WS_PROJA) + (size_t)r * 3072;
#pragma unroll
        for (int half = 0; half < 2; ++half) { const int c0 = ch0s + half * 8; float xb[8]; unpack8(*(const u32x4*)(PBX + (size_t)r * 3072 + c0), xb);
#pragma unroll
            for (int q = 0; q < 2; ++q) { *(f32x4*)(F.out + O_CVS + (size_t)i * 3072 + c0 + 4 * q) = *(const f32x4*)(st + 1024 + c0 + 4 * q); *(f32x4*)(F.out + O_CVS + (size_t)i * 3072 + 1024 + c0 + 4 * q) = *(const f32x4*)(st + 2048 + c0 + 4 * q);
                *(f32x4*)(F.out + O_CVS + (size_t)i * 3072 + 2048 + c0 + 4 * q) = (f32x4){xb[4 * q], xb[4 * q + 1], xb[4 * q + 2], xb[4 * q + 3]}; } }
        float gv[16], s = 0.f;
        { float t8[8]; unpack8(*(const u32x4*)(PA + 1024 + ch0s), t8);
#pragma unroll
          for (int c = 0; c < 8; ++c) gv[c] = t8[c];
          unpack8(*(const u32x4*)(PA + 1024 + ch0s + 8), t8);
#pragma unroll
          for (int c = 0; c < 8; ++c) gv[8 + c] = t8[c]; }
#pragma unroll
        for (int c = 0; c < 16; ++c) s += gv[c];
        s += __shfl_xor(s, 1); s += __shfl_xor(s, 2); s += __shfl_xor(s, 4);
        const float mu = s * (1.f / 128.f); float q = 0.f;
#pragma unroll
        for (int c = 0; c < 16; ++c) { const float d = gv[c] - mu; q += d * d; }
        q += __shfl_xor(q, 1); q += __shfl_xor(q, 2); q += __shfl_xor(q, 4);
        const float rstd = 1.0f / sqrtf(q * (1.f / 128.f) + EPS);
        const int h = F.lane >> 3; const float wsp = F.in[12][(size_t)h * 16384], bsp = F.in[13][h * 128];
        float uu[16], zz[16];
        { float t8[8]; unpack8(*(const u32x4*)(PA + ch0s), t8);
#pragma unroll
          for (int c = 0; c < 8; ++c) uu[c] = t8[c];
          unpack8(*(const u32x4*)(PA + ch0s + 8), t8);
#pragma unroll
          for (int c = 0; c < 8; ++c) uu[8 + c] = t8[c];
          unpack8(*(const u32x4*)(PA + 2048 + ch0s), t8);
#pragma unroll
          for (int c = 0; c < 8; ++c) zz[c] = t8[c];
          unpack8(*(const u32x4*)(PA + 2048 + ch0s + 8), t8);
#pragma unroll
          for (int c = 0; c < 8; ++c) zz[8 + c] = t8[c]; }
        float ya[16];
#pragma unroll
        for (int c = 0; c < 16; ++c) { const int ch = ch0s + c; const float vn = (gv[c] - mu) * rstd * F.in[10][ch] + F.in[11][ch];
            F.out[O_VS + (size_t)i * 1024 + ch] = vn; ya[c] = uu[c] * (wsp * vn + bsp) * zz[c]; }
        bf16_t* yrow = (bf16_t*)(ws + WS_Y) + (size_t)r * DMIX + ch0s;
        { float t8[8];
#pragma unroll
          for (int c = 0; c < 8; ++c) t8[c] = ya[c];
          *(u32x4*)(yrow) = pack8(t8);
#pragma unroll
          for (int c = 0; c < 8; ++c) t8[c] = ya[8 + c];
          *(u32x4*)(yrow + 8) = pack8(t8); }
    }
}

__device__ __forceinline__ void mscan_wave(const Ctx& F, int bh) {
    unsigned char* ws = F.ws; const int b = bh >> 2, h = bh & 3, lane = F.lane;
    const float* li = (const float*)(ws + WS_GLI) + (size_t)h * MA + (size_t)b * SEQ + lane * 32;
    const float* lf = (const float*)(ws + WS_GLF) + (size_t)h * MA + (size_t)b * SEQ + lane * 32;
    float A = 0.f, Bv = -INFINITY;
    for (int i = 0; i < 32; ++i) { const float f = lf[i], l = li[i]; Bv = fmaxf(Bv + f, l); A += f; }
    float sA = A, sB = Bv;
#pragma unroll
    for (int o = 1; o < 64; o <<= 1) { const float pA = __shfl_up(sA, o), pB = __shfl_up(sB, o); if (lane >= o) { sB = fmaxf(pB + sA, sB); sA = pA + sA; } }
    float eA = __shfl_up(sA, 1), eB = __shfl_up(sB, 1); if (lane == 0) { eA = 0.f; eB = -INFINITY; }
    const float m_in = fmaxf(0.f + eA, eB);
    float cA = A;
#pragma unroll
    for (int o = 1; o < 8; o <<= 1) { const float p = __shfl_up(cA, o); if ((lane & 7) >= o) cA += p; }
    const float b_in = cA - A;
    const float m_prev = __shfl(m_in, lane & ~7);
    float* DA = (float*)(ws + WS_DA) + (size_t)h * MA + (size_t)b * SEQ + lane * 32; float* DR = (float*)(ws + WS_DR) + (size_t)h * MA + (size_t)b * SEQ + lane * 32;
    float* DG = (float*)(ws + WS_DG) + (size_t)h * MA + (size_t)b * SEQ + lane * 32; float* DEM = (float*)(ws + WS_DEM) + (size_t)h * MA + (size_t)b * SEQ + lane * 32;
    float* DW = (float*)(ws + WS_DW) + (size_t)h * MA + (size_t)b * SEQ + lane * 32;
    float m = m_in, bb = b_in, a_last = 0.f;
    for (int i = 0; i < 32; ++i) { const float f = lf[i], l = li[i]; m = fmaxf(m + f, l); bb += f;
        a_last = bb - m; DA[i] = -m_prev; DR[i] = l - bb; DG[i] = __expf(bb + m_prev - m); DEM[i] = __expf(-m); }
    const float a_end = __shfl(a_last, lane | 7);
    for (int i = 0; i < 32; ++i) { const float f = lf[i]; (void)f; }
    { float bb2 = b_in; for (int i = 0; i < 32; ++i) { bb2 += lf[i]; DW[i] = __expf(a_end + (li[i] - bb2)); } }
    if (lane == 63) F.out[O_MP + bh] = m;
}

__device__ __forceinline__ void p9_final(const Ctx& F0) { Ctx F = F0; asm volatile("" : "+v"(F.tid), "+v"(F.lane), "+s"(F.gw));
    unsigned char* ws = F.ws; const bf16_t* GB = (const bf16_t*)(ws + WS_GB); const bf16_t* EB = (const bf16_t*)(ws + WS_EB);
    const float* pleg = F.in[27]; const float* fing = F.in[28];
    f32x4 pg[4], fg[4];
#pragma unroll
    for (int j = 0; j < 4; ++j) { pg[j] = ((const f32x4*)pleg)[F.lane + 64 * j]; fg[j] = ((const f32x4*)fing)[F.lane + 64 * j]; }
    for (int r0 = F.gw * 2; r0 < MP + MS; r0 += F.NGW * 2) {
        f32x4 x[2][4]; u32x2 g[2][4], e[2][4], xb[2][4]; float* xrow[2]; const bf16_t* X1B = (const bf16_t*)(ws + WS_X1B);
#pragma unroll
        for (int q = 0; q < 2; ++q) { const int r = r0 + q; xrow[q] = r < MP ? F.out + O_Y + (size_t)r * DM : F.out + O_YS + (size_t)(r - MP) * DM;
#pragma unroll
            for (int j = 0; j < 4; ++j) { xb[q][j] = __builtin_nontemporal_load((const u32x2*)(X1B + (size_t)r * DM) + F.lane + 64 * j); g[q][j] = __builtin_nontemporal_load((const u32x2*)(GB + (size_t)r * DM) + F.lane + 64 * j); e[q][j] = __builtin_nontemporal_load((const u32x2*)(EB + (size_t)r * DM) + F.lane + 64 * j); } }
#pragma unroll
        for (int q = 0; q < 2; ++q) { float s = 0.f; f32x4 ev[4];
#pragma unroll
            for (int j = 0; j < 4; ++j) { x[q][j] = (f32x4){bf_lo(xb[q][j].x), bf_hi(xb[q][j].x), bf_lo(xb[q][j].y), bf_hi(xb[q][j].y)}; ev[j] = (f32x4){bf_lo(e[q][j].x), bf_hi(e[q][j].x), bf_lo(e[q][j].y), bf_hi(e[q][j].y)}; s += (ev[j][0] * ev[j][0] + ev[j][1] * ev[j][1]) + (ev[j][2] * ev[j][2] + ev[j][3] * ev[j][3]); }
            s = wave_sum(s); const float rse = 1.0f / sqrtf(s * (1.f / DM) + EPS); float s2 = 0.f;
#pragma unroll
            for (int j = 0; j < 4; ++j) { const f32x4 gv = (f32x4){bf_lo(g[q][j].x), bf_hi(g[q][j].x), bf_lo(g[q][j].y), bf_hi(g[q][j].y)};
                x[q][j] = x[q][j] + gv * (ev[j] * rse * pg[j]); s2 += (x[q][j][0] * x[q][j][0] + x[q][j][1] * x[q][j][1]) + (x[q][j][2] * x[q][j][2] + x[q][j][3] * x[q][j][3]); }
            s2 = wave_sum(s2); const float rs2 = 1.0f / sqrtf(s2 * (1.f / DM) + EPS);
#pragma unroll
            for (int j = 0; j < 4; ++j) __builtin_nontemporal_store(x[q][j] * rs2 * fg[j], (f32x4*)xrow[q] + F.lane + 64 * j); }
    }
}
#define MAKE_CTX() extern __shared__ __attribute__((aligned(16))) unsigned char lds_raw[]; \
    Ctx F; F.lds = (LAS unsigned char*)lds_raw; F.tid = threadIdx.x; F.lane = F.tid & 63; F.wave = __builtin_amdgcn_readfirstlane(F.tid >> 6); \
    F.G = gridDim.x; F.bid = blockIdx.x; F.gw = F.bid * 8 + F.wave; F.NGW = F.G * 8; F.in = args.in; F.out = args.out; F.ws = args.ws; unsigned char* ws = args.ws; (void)ws

template <int KIND> struct EpiBf16Act {
    static constexpr bool PERM = false, AFTER_DRAIN = false;
    bf16_t* O; int ldo; const float* bias; float scale;
    __device__ __forceinline__ void operator()(const f32x4 (&acc)[2][2][4][2], const Unit& u, int wr, int wc, int fr, int fq) const {
        const int row0 = u.pm * 256 + wr * 64 + fr, col0 = u.pn * 256 + wc * 32 + 4 * fq;
        f32x4 bv[2][2];
#pragma unroll
        for (int bj = 0; bj < 2; ++bj)
#pragma unroll
            for (int n = 0; n < 2; ++n) bv[bj][n] = bias ? *(const f32x4*)(bias + col0 + bj * 128 + 16 * n) : (f32x4){0.f, 0.f, 0.f, 0.f};
#pragma unroll
        for (int ai = 0; ai < 2; ++ai)
#pragma unroll
            for (int m = 0; m < 4; ++m) { bf16_t* rowp = O + (size_t)(row0 + ai * 128 + m * 16) * ldo + col0;
#pragma unroll
                for (int bj = 0; bj < 2; ++bj)
#pragma unroll
                    for (int n = 0; n < 2; ++n) { f32x4 v = acc[ai][bj][m][n] * scale + bv[bj][n];
                        if (KIND == 3) {
#pragma unroll
                            for (int j = 0; j < 4; ++j) v[j] = sigmoidf_(v[j]); }
                        u32x2 w; w.x = cvt_pk_bf16(v[0], v[1]); w.y = cvt_pk_bf16(v[2], v[3]); *(u32x2*)(rowp + bj * 128 + n * 16) = w; } }
    }
};
struct EpiOutProj {
    static constexpr bool PERM = false, AFTER_DRAIN = false;
    const float* xp; const float* xs; float* out; bf16_t* X1B;
    __device__ __forceinline__ void operator()(const f32x4 (&acc)[2][2][4][2], const Unit& u, int wr, int wc, int fr, int fq) const {
        const int row0 = u.pm * 256 + wr * 64 + fr, col0 = u.pn * 256 + wc * 32 + 4 * fq;
#pragma unroll
        for (int ai = 0; ai < 2; ++ai) { f32x4 xv[4][2][2];
#pragma unroll
            for (int m = 0; m < 4; ++m) { const int row = row0 + ai * 128 + m * 16; const bool real = row < MP + MS; const float* xr = row < MP ? xp + (size_t)row * DM : xs + (size_t)(real ? row - MP : 0) * DM;
#pragma unroll
                for (int bj = 0; bj < 2; ++bj)
#pragma unroll
                    for (int n = 0; n < 2; ++n) xv[m][bj][n] = __builtin_nontemporal_load((const f32x4*)(xr + col0 + bj * 128 + n * 16)); }
#pragma unroll
            for (int m = 0; m < 4; ++m) { const int row = row0 + ai * 128 + m * 16; const bool real = row < MP + MS;
#pragma unroll
                for (int bj = 0; bj < 2; ++bj)
#pragma unroll
                    for (int n = 0; n < 2; ++n) { const int c = col0 + bj * 128 + n * 16; f32x4 v = acc[ai][bj][m][n];
                        if (real) v = v + xv[m][bj][n]; else v = (f32x4){0.f, 0.f, 0.f, 0.f};
                        u32x2 w; w.x = cvt_pk_bf16(v[0], v[1]); w.y = cvt_pk_bf16(v[2], v[3]); *(u32x2*)(X1B + (size_t)row * DM + c) = w; } } }
    }
};

struct EpiInProjNP {
    static constexpr bool PERM = false, AFTER_DRAIN = false;
    bf16_t* PA; bf16_t* PB; const float* rs;
    __device__ __forceinline__ void operator()(const f32x4 (&acc)[2][2][4][2], const Unit& u, int wr, int wc, int fr, int fq) const {
        const int row0 = u.pm * 256 + wr * 64 + fr, pn = u.pn; bf16_t* base = pn < 12 ? PA + pn * 256 : PB + (pn - 12) * 256; const int col0 = wc * 32 + 4 * fq;
        const int kind = pn < 8 ? 0 : ((pn < 12 || pn >= 20) ? 1 : (pn < 16 ? 2 : 3));
        float rsv[2][4];
#pragma unroll
        for (int ai = 0; ai < 2; ++ai)
#pragma unroll
            for (int m = 0; m < 4; ++m) rsv[ai][m] = rs[row0 + ai * 128 + m * 16];
#pragma unroll
        for (int ai = 0; ai < 2; ++ai)
#pragma unroll
            for (int m = 0; m < 4; ++m) { const int row = row0 + ai * 128 + m * 16; const float s = rsv[ai][m];
#pragma unroll
                for (int bj = 0; bj < 2; ++bj)
#pragma unroll
                    for (int n = 0; n < 2; ++n) { f32x4 v = acc[ai][bj][m][n] * s;
                        if (kind == 0) { const f32x2 ga = gelu_pk((f32x2){v[0], v[1]}), gb = gelu_pk((f32x2){v[2], v[3]}); v = (f32x4){ga.x, ga.y, gb.x, gb.y}; }
                        else {
#pragma unroll
                        for (int j = 0; j < 4; ++j) { float x = v[j]; if (kind == 1) x = siluf_(x); else if (kind == 3) x = sigmoidf_(x); v[j] = x; } }
                        u32x2 w; w.x = cvt_pk_bf16(v[0], v[1]); w.y = cvt_pk_bf16(v[2], v[3]); *(u32x2*)(base + (size_t)row * 3072 + col0 + bj * 128 + n * 16) = w; } }
    }
};
__device__ __forceinline__ void p1_inproj(const Ctx& F) {
    unsigned char* ws = F.ws; Gemm g{DM, DM, DM};
    OrderXcd S{64, 24, 64 * 24, F.G, F.bid, (const char*)(ws + WS_XB), (const char*)(ws + WS_WIN), (size_t)256 * DM * 2, (size_t)256 * DM * 2};
    EpiInProjNP E{(bf16_t*)(ws + WS_PROJA), (bf16_t*)(ws + WS_PROJB), (const float*)(ws + WS_RS)};
    pg8::gemm_phase<EpiInProjNP, OrderXcd>(F.lds, g, S, E);
}
__device__ __forceinline__ void p7_outproj(const Ctx& F) {
    unsigned char* ws = F.ws; Gemm g{DMIX, DMIX, DMIX};
    OrderPanel4 S{64 * 4, F.G, F.bid, (const char*)(ws + WS_Y), (const char*)(ws + WS_WOUT), (size_t)256 * DMIX * 2, (size_t)256 * DMIX * 2};
    EpiOutProj E{F.in[0], F.in[1], F.out, (bf16_t*)(ws + WS_X1B)};
    pg8::gemm_phase<EpiOutProj, OrderPanel4>(F.lds, g, S, E);
}
__device__ __forceinline__ void p8_ple(const Ctx& F) {
    unsigned char* ws = F.ws;
    { Gemm g{DM, DM, DM}; OrderPanel4 S{NTILE * 4, F.G, F.bid, (const char*)(ws + WS_X1B), (const char*)(ws + WS_WPG), (size_t)256 * DM * 2, (size_t)256 * DM * 2};
      EpiBf16Act<3> E{(bf16_t*)(ws + WS_GB), DM, F.in[25], 1.0f}; pg8::gemm_phase<EpiBf16Act<3>, OrderPanel4>(F.lds, g, S, E); }
    { Gemm g{DPLE, DPLE, DPLE}; OrderProjSkip S{F.G, F.bid, (const char*)(ws + WS_PB), (const char*)(ws + WS_WPP), (size_t)256 * DPLE * 2, (size_t)256 * DPLE * 2};
      EpiBf16Act<0> E{(bf16_t*)(ws + WS_EB), DM, nullptr, 1.0f}; pg8::gemm_phase<EpiBf16Act<0>, OrderProjSkip>(F.lds, g, S, E); }
}
typedef float f32x4_t __attribute__((ext_vector_type(4)));
__device__ __forceinline__ void p2b_spatial_units(const Ctx& F0) { Ctx F = F0; asm volatile("" : "+v"(F.tid), "+v"(F.lane), "+s"(F.gw));
    unsigned char* ws = F.ws;
    const bf16_t* PA = (const bf16_t*)(ws + WS_PROJA); const bf16_t* WSP = (const bf16_t*)(ws + WS_WSP); bf16_t* Y = (bf16_t*)(ws + WS_Y);
    const float* lng = F.in[10]; const float* lnb = F.in[11]; const float* bsp = F.in[13];
    LAS bf16_t* vnT = (LAS bf16_t*)F.lds;
    const int lane = F.lane, w = F.wave, l15 = lane & 15, lq = lane >> 4;
    for (int unit = F.bid; unit < NB * 16 * HA; unit += F.G) {
        const int b = unit >> 7, c = (unit >> 3) & 15, h = unit & 7, r0 = b * SEQ + c * 128;
        const float g0 = lng[h * 128 + 2 * lane], g1 = lng[h * 128 + 2 * lane + 1], b0 = lnb[h * 128 + 2 * lane], b1 = lnb[h * 128 + 2 * lane + 1];
        unsigned wav[8], wbv[8];
#pragma unroll
        for (int p = 0; p < 8; ++p) { const int s0 = w * 16 + 2 * p; wav[p] = *(const unsigned*)(PA + (size_t)(r0 + s0) * 3072 + 1024 + h * 128 + 2 * lane); wbv[p] = *(const unsigned*)(PA + (size_t)(r0 + s0 + 1) * 3072 + 1024 + h * 128 + 2 * lane); }
#pragma unroll
        for (int p = 0; p < 8; ++p) { const int s0 = w * 16 + 2 * p; const unsigned wa = wav[p], wb = wbv[p];
            float a0 = bf_lo(wa), a1 = bf_hi(wa), c0 = bf_lo(wb), c1 = bf_hi(wb);
            const float mua = wave_sum(a0 + a1) * (1.f / 128.f), mub = wave_sum(c0 + c1) * (1.f / 128.f);
            a0 -= mua; a1 -= mua; c0 -= mub; c1 -= mub;
            const float ra = 1.0f / sqrtf(wave_sum(a0 * a0 + a1 * a1) * (1.f / 128.f) + EPS), rb = 1.0f / sqrtf(wave_sum(c0 * c0 + c1 * c1) * (1.f / 128.f) + EPS);
            *(LAS unsigned*)(vnT + (2 * lane) * 136 + s0) = cvt_pk_bf16(a0 * ra * g0 + b0, c0 * rb * g0 + b0);
            *(LAS unsigned*)(vnT + (2 * lane + 1) * 136 + s0) = cvt_pk_bf16(a1 * ra * g1 + b1, c1 * rb * g1 + b1); }
        __syncthreads();
        const int t0 = 16 * w, nks = (t0 + 15) / 32 + 1;
        f32x4 acc[8];
#pragma unroll
        for (int nb = 0; nb < 8; ++nb) acc[nb] = (f32x4){0.f, 0.f, 0.f, 0.f};
        bf16x8 wfr[4];
#pragma unroll
        for (int ks = 0; ks < 4; ++ks) wfr[ks] = *(const bf16x8*)(WSP + ((size_t)h * 128 + t0 + l15) * 128 + ks * 32 + 8 * lq);
        const int t = t0 + l15; const float bt = bsp[h * 128 + t]; const size_t row = (size_t)(r0 + t);
        u32x2 uuv[8], zzv[8];
#pragma unroll
        for (int nb = 0; nb < 8; ++nb) { const int d = nb * 16 + 4 * lq; uuv[nb] = *(const u32x2*)(PA + row * 3072 + h * 128 + d); zzv[nb] = *(const u32x2*)(PA + row * 3072 + 2048 + h * 128 + d); }
#pragma unroll
        for (int ks = 0; ks < 4; ++ks) { if (ks < nks) { const int k0 = ks * 32;
#pragma unroll
            for (int nb = 0; nb < 8; ++nb) { const bf16x8 vf = *(const LAS bf16x8*)(vnT + (nb * 16 + l15) * 136 + k0 + 8 * lq);
                acc[nb] = __builtin_amdgcn_mfma_f32_16x16x32_bf16(vf, wfr[ks], acc[nb], 0, 0, 0); } } }
#pragma unroll
        for (int nb = 0; nb < 8; ++nb) { const int d = nb * 16 + 4 * lq; const u32x2 uu = uuv[nb], zz = zzv[nb];
            u32x2 o; o.x = cvt_pk_bf16(bf_lo(uu.x) * (acc[nb][0] + bt) * bf_lo(zz.x), bf_hi(uu.x) * (acc[nb][1] + bt) * bf_hi(zz.x));
            o.y = cvt_pk_bf16(bf_lo(uu.y) * (acc[nb][2] + bt) * bf_lo(zz.y), bf_hi(uu.y) * (acc[nb][3] + bt) * bf_hi(zz.y));
            *(u32x2*)(Y + row * DMIX + h * 128 + d) = o; }
        __syncthreads();
    }
}
__device__ __forceinline__ void p2b_mscan(const Ctx& F) { if (F.bid < 32 && F.wave == 0) mscan_wave(F, F.bid); }

struct OrderQK {
    int G, c; const char* ws;
    __device__ __forceinline__ bool next(int i, Unit& u) const { const int L = i * G + c; if (L >= 512) return false; const char* XC = ws + WS_XB; const char* WQ = ws + WS_WQ; const char* WK = ws + WS_WK;
        const int kind = L >> 8, l = L & 255; u.pm = l >> 2; u.pn = kind; u.aux = l & 3; u.a = XC + (size_t)u.pm * (256 * DM * 2) + (size_t)u.aux * 512; u.b = (kind ? WK : WQ) + (size_t)u.aux * 131072; return true; }
};
struct EpiQK {
    static constexpr bool PERM = false, AFTER_DRAIN = false;
    bf16_t* K; bf16_t* PQ; const float* DG;
    __device__ __forceinline__ void operator()(const f32x4 (&acc)[2][2][4][2], const Unit& u, int wr, int wc, int fr, int fq) const {
        const int h = u.aux, rl0 = wr * 64 + fr, col0 = wc * 32 + 4 * fq; const bool isk = u.pn != 0;
        const int unit = ((u.pm >> 3) * 4 + h) * 8 + (u.pm & 7);
        float gv[2][4];
#pragma unroll
        for (int ai = 0; ai < 2; ++ai)
#pragma unroll
            for (int m = 0; m < 4; ++m) gv[ai][m] = isk ? 0.0625f : DG[(size_t)h * MA + u.pm * 256 + rl0 + ai * 128 + m * 16];
        bf16_t* base = isk ? K + (size_t)u.pm * 256 * 1024 + h * 256 : PQ + (size_t)unit * 256 * 512 + 256; const int ldo = isk ? 1024 : 512;
#pragma unroll
        for (int ai = 0; ai < 2; ++ai)
#pragma unroll
            for (int m = 0; m < 4; ++m) { const int rl = rl0 + ai * 128 + m * 16; const float g = gv[ai][m];
#pragma unroll
                for (int bj = 0; bj < 2; ++bj)
#pragma unroll
                    for (int n = 0; n < 2; ++n) { const int c = col0 + bj * 128 + n * 16; const f32x4 v = acc[ai][bj][m][n] * g;
                        u32x2 w; w.x = cvt_pk_bf16(v[0], v[1]); w.y = cvt_pk_bf16(v[2], v[3]); *(u32x2*)(base + (size_t)rl * ldo + c) = w; }
                asm volatile("" ::: "memory"); }
    }
};
struct OrderS12 {
    int G, c; const char* ws;
    __device__ __forceinline__ bool next(int i, Unit& u) const { const int L = i * G + c; if (L >= 12) return false; const char* XC = ws + WS_XB; const char* XB2 = ws + WS_XB2; const char* WQ = ws + WS_WQ; const char* WK = ws + WS_WK; const char* WV = ws + WS_WV;
        const int kind = L >> 2; u.pm = 64; u.pn = kind; u.aux = L & 3; u.a = (kind == 2 ? XB2 : XC) + (size_t)64 * (256 * DM * 2) + (size_t)u.aux * 512; u.b = (kind == 0 ? WQ : kind == 1 ? WK : WV) + (size_t)u.aux * 131072; return true; }
};
struct EpiS12 {
    static constexpr bool PERM = false, AFTER_DRAIN = false;
    bf16_t* Q; bf16_t* K; bf16_t* Vs;
    __device__ __forceinline__ void operator()(const f32x4 (&acc)[2][2][4][2], const Unit& u, int wr, int wc, int fr, int fq) const {
        const int h = u.aux, kind = u.pn; bf16_t* O = kind == 0 ? Q + (size_t)MP * 1024 : kind == 1 ? K + (size_t)MP * 1024 : Vs; const float sc = kind == 1 ? 0.0625f : 1.0f;
        const int row0 = wr * 64 + fr, col0 = h * 256 + wc * 32 + 4 * fq;
#pragma unroll
        for (int m = 0; m < 4; ++m) { bf16_t* rowp = O + (size_t)(row0 + m * 16) * 1024 + col0;
#pragma unroll
            for (int bj = 0; bj < 2; ++bj)
#pragma unroll
                for (int n = 0; n < 2; ++n) { const f32x4 v = acc[0][bj][m][n] * sc; u32x2 w; w.x = cvt_pk_bf16(v[0], v[1]); w.y = cvt_pk_bf16(v[2], v[3]); *(u32x2*)(rowp + bj * 128 + n * 16) = w; } }
    }
};
struct OrderVW {
    int G, c; const char* ws;
    __device__ __forceinline__ bool next(int i, Unit& u) const { const int L = i * G + c; if (L >= 512) return false; const char* XC = ws + WS_XB; const char* XB2 = ws + WS_XB2; const char* WK = ws + WS_WK; const char* WV = ws + WS_WV;
        const int kind = L >> 8, l = L & 255, b = l >> 5, h = (l >> 3) & 3, cc = l & 7; u.pm = b * 8 + cc; u.pn = l | (kind << 8); u.aux = h;
        u.a = (kind ? WK : WV) + (size_t)h * 131072; u.b = (kind ? XC : XB2) + (size_t)u.pm * (256 * DM * 2) + (size_t)h * 512; return true; }
};
struct EpiVW {
    static constexpr bool PERM = false, AFTER_DRAIN = false;
    bf16_t* VC; bf16_t* WKT; const float* DW; float* DNP;
    __device__ __forceinline__ void operator()(const f32x4 (&acc)[2][2][4][2], const Unit& u, int wr, int wc, int fr, int fq) const {
        const int h = u.aux, kind = u.pn >> 8, l = u.pn & 255, rl0 = wr * 64 + fr, col0 = wc * 32 + 4 * fq; const int ldo = kind ? 256 : 512; bf16_t* base = (kind ? WKT : VC) + (size_t)l * 256 * ldo;
        f32x4 scq[2][2];
#pragma unroll
        for (int bj = 0; bj < 2; ++bj)
#pragma unroll
            for (int n = 0; n < 2; ++n) scq[bj][n] = kind ? *(const f32x4*)(DW + (size_t)h * MA + u.pm * 256 + col0 + bj * 128 + n * 16) * 0.0625f : (f32x4){1.f, 1.f, 1.f, 1.f};
#pragma unroll
        for (int ai = 0; ai < 2; ++ai)
#pragma unroll
            for (int m = 0; m < 4; ++m) { bf16_t* rowp = base + (size_t)(rl0 + ai * 128 + m * 16) * ldo + col0; float rsum = 0.f;
#pragma unroll
                for (int bj = 0; bj < 2; ++bj)
#pragma unroll
                    for (int n = 0; n < 2; ++n) { const f32x4 v = acc[ai][bj][m][n] * scq[bj][n]; u32x2 w; w.x = cvt_pk_bf16(v[0], v[1]); w.y = cvt_pk_bf16(v[2], v[3]); *(u32x2*)(rowp + bj * 128 + n * 16) = w;
                        rsum += (bf_lo(w.x) + bf_hi(w.x)) + (bf_lo(w.y) + bf_hi(w.y)); }
                if (kind) { rsum += __shfl_xor(rsum, 16); rsum += __shfl_xor(rsum, 32); if (fq == 0) DNP[((size_t)l * 256 + rl0 + ai * 128 + m * 16) * 4 + wc] = rsum; }
                asm volatile("" ::: "memory"); }
    }
};
__device__ __forceinline__ void p3_qkv(const Ctx& F) {
    unsigned char* ws = F.ws;
    { Gemm g{DM, 256, 256}; OrderQK S{F.G, F.bid, (const char*)ws}; EpiQK E{(bf16_t*)(ws + WS_K), (bf16_t*)(ws + WS_PQ), (const float*)(ws + WS_DG)};
      pg8::gemm_phase<EpiQK, OrderQK>(F.lds, g, S, E); }
    { Gemm g{256, DM, 256}; OrderVW S{F.G, F.bid, (const char*)ws}; EpiVW E{(bf16_t*)(ws + WS_VC), (bf16_t*)(ws + WS_WKT), (const float*)(ws + WS_DW), (float*)(ws + WS_DN4)};
      pg8::gemm_phase<EpiVW, OrderVW>(F.lds, g, S, E); }
}

__device__ __forceinline__ void p3_s12(const Ctx& F) {
    unsigned char* ws = F.ws;
    { Gemm g{DM, 256, 256}; OrderS12 S{F.G, (F.bid - 32) & 255, (const char*)ws}; EpiS12 E{(bf16_t*)(ws + WS_Q), (bf16_t*)(ws + WS_K), (bf16_t*)(ws + WS_VS)};
      pg8::gemm_phase<EpiS12, OrderS12>(F.lds, g, S, E); }
}
struct OrderUnitNT {
    int n, G, c; const char* A; size_t astep_pm, astep_h, astep_u; const char* B; size_t bstep_pm, bstep_h, bstep_u;
    __device__ __forceinline__ bool next(int i, Unit& u) const { const int L = i * G + c; if (L >= n) return false;
        const int b = L >> 5, h = (L >> 3) & 3, cc = L & 7; u.pm = b * 8 + cc; u.pn = L; u.aux = h;
        u.a = A + (size_t)u.pm * astep_pm + (size_t)h * astep_h + (size_t)L * astep_u; u.b = B + (size_t)u.pm * bstep_pm + (size_t)h * bstep_h + (size_t)L * bstep_u; return true; }
};
struct EpiScore {
    static constexpr bool PERM = false, AFTER_DRAIN = false;
    bf16_t* PQ; const float* DA; const float* DR; float* DENP;
    __device__ __forceinline__ void operator()(const f32x4 (&acc)[2][2][4][2], const Unit& u, int wr, int wc, int fr, int fq) const {
        const int h = u.aux, rl0 = wr * 64 + fr, col0 = wc * 32 + 4 * fq; const size_t vb = (size_t)h * MA + (size_t)u.pm * 256;
        float atv[2][4]; f32x4 rrv[2][2];
#pragma unroll
        for (int ai = 0; ai < 2; ++ai)
#pragma unroll
            for (int m = 0; m < 4; ++m) atv[ai][m] = DA[vb + rl0 + ai * 128 + m * 16];
#pragma unroll
        for (int bj = 0; bj < 2; ++bj)
#pragma unroll
            for (int n = 0; n < 2; ++n) rrv[bj][n] = *(const f32x4*)(DR + vb + col0 + bj * 128 + n * 16);
#pragma unroll
        for (int ai = 0; ai < 2; ++ai)
#pragma unroll
            for (int m = 0; m < 4; ++m) { int t_ = rl0 + ai * 128 + m * 16; asm volatile("" : "+v"(t_)); const int t = t_; const float at = atv[ai][m]; float rs_ = 0.f; bf16_t* rowp = PQ + ((size_t)u.pn * 256 + t) * 512 + col0;
#pragma unroll
                for (int bj = 0; bj < 2; ++bj)
#pragma unroll
                    for (int n = 0; n < 2; ++n) { const int c = col0 + bj * 128 + n * 16; f32x4 v; const f32x4 rr = rrv[bj][n];
#pragma unroll
                        for (int j = 0; j < 4; ++j) { const float e = fast_exp(fminf(at + rr[j], 60.f)); v[j] = (c + j <= t) ? acc[ai][bj][m][n][j] * e : 0.f; rs_ += v[j]; }
                        u32x2 w; w.x = cvt_pk_bf16(v[0], v[1]); w.y = cvt_pk_bf16(v[2], v[3]); *(u32x2*)(rowp + bj * 128 + n * 16) = w; }
                rs_ += __shfl_xor(rs_, 16); rs_ += __shfl_xor(rs_, 32);
                if (fq == 0) DENP[(vb + t) * 4 + wc] = rs_; asm volatile("" ::: "memory"); }
    }
};
struct EpiF32Unit {
    static constexpr bool PERM = false, AFTER_DRAIN = false;
    bf16_t* O;
    __device__ __forceinline__ void operator()(const f32x4 (&acc)[2][2][4][2], const Unit& u, int wr, int wc, int fr, int fq) const {
        bf16_t* base = O + (size_t)u.pn * 65536 + (size_t)(wr * 64 + fr) * 256 + wc * 32 + 4 * fq;
#pragma unroll
        for (int ai = 0; ai < 2; ++ai)
#pragma unroll
            for (int m = 0; m < 4; ++m)
#pragma unroll
                for (int bj = 0; bj < 2; ++bj)
#pragma unroll
                    for (int n = 0; n < 2; ++n) { const f32x4 v = acc[ai][bj][m][n]; u32x2 w; w.x = cvt_pk_bf16(v[0], v[1]); w.y = cvt_pk_bf16(v[2], v[3]); *(u32x2*)(base + (size_t)(ai * 128 + m * 16) * 256 + bj * 128 + n * 16) = w; }
    }
};
__device__ __forceinline__ void p4_scores_dc(const Ctx& F) {
    unsigned char* ws = F.ws;
    { Gemm g{512, DM, 256}; OrderUnitNT S{NUNIT, F.G, F.bid, (const char*)(ws + WS_PQ) + 512, 0, 0, (size_t)256 * 512 * 2, (const char*)(ws + WS_K), (size_t)256 * DM * 2, 512, 0};
      EpiScore E{(bf16_t*)(ws + WS_PQ), (const float*)(ws + WS_DA), (const float*)(ws + WS_DR), (float*)(ws + WS_DENP)}; pg8::gemm_phase<EpiScore, OrderUnitNT>(F.lds, g, S, E); }
    { Gemm g{512, 256, 256}; OrderUnitNT S{NUNIT, F.G, F.bid, (const char*)(ws + WS_VC), 0, 0, (size_t)256 * 512 * 2, (const char*)(ws + WS_WKT), 0, 0, (size_t)256 * 256 * 2};
      EpiF32Unit E{(bf16_t*)(F.out + O_Y)}; pg8::gemm_phase<EpiF32Unit, OrderUnitNT>(F.lds, g, S, E); }
}

__device__ __forceinline__ void p5_scan_sample(const Ctx& F0) { Ctx F = F0; asm volatile("" : "+v"(F.tid), "+v"(F.lane), "+s"(F.gw));
    unsigned char* ws = F.ws; const float* DG = (const float*)(ws + WS_DG); const bf16_t* DCb = (const bf16_t*)(F.out + O_Y); bf16_t* VC = (bf16_t*)(ws + WS_VC);
    for (int idx = F.bid * 512 + F.tid; idx < 32 * 16384; idx += F.G * 512) { const int bh = idx >> 14, q4 = idx & 16383, e = q4 >> 6, d4 = (q4 & 63) * 4, b = bh >> 2, h = bh & 3;
        f32x4 dc[8]; float ge[8];
#pragma unroll
        for (int c = 0; c < 8; ++c) { const u32x2 dw = __builtin_nontemporal_load((const u32x2*)(DCb + ((size_t)(bh * 8 + c) * 256 + e) * 256 + d4)); dc[c] = (f32x4){bf_lo(dw.x), bf_hi(dw.x), bf_lo(dw.y), bf_hi(dw.y)}; ge[c] = DG[(size_t)h * MA + b * SEQ + c * 256 + 255]; }
        f32x4 C = (f32x4){0.f, 0.f, 0.f, 0.f};
#pragma unroll
        for (int c = 0; c < 8; ++c) { u32x2 w; w.x = cvt_pk_bf16(C[0], C[1]); w.y = cvt_pk_bf16(C[2], C[3]); *(u32x2*)(VC + ((size_t)(bh * 8 + c) * 256 + e) * 512 + 256 + d4) = w; C = C * ge[c] + dc[c]; }
        __builtin_nontemporal_store(C, (f32x4*)(F.out + O_CP + ((size_t)bh * 256 + e) * 256 + d4)); }
    LAS float* npv = (LAS float*)F.lds;
    for (int u = F.bid; u < NUNIT; u += F.G) { const int bh = u >> 3, cc = u & 7, b = bh >> 2, h = bh & 3;
        __syncthreads();
        if (F.tid < 256) { float n = 0.f; const float* DN = (const float*)(ws + WS_DN4);
            for (int j = 0; j < cc; ++j) { const f32x4 dp = *(const f32x4*)(DN + ((size_t)(bh * 8 + j) * 256 + F.tid) * 4); n = DG[(size_t)h * MA + b * SEQ + j * 256 + 255] * n + ((dp[0] + dp[1]) + (dp[2] + dp[3])); }
            npv[F.tid] = n; const f32x4 dl = *(const f32x4*)(DN + ((size_t)u * 256 + F.tid) * 4); if (cc == 7) F.out[O_NP + (size_t)bh * 256 + F.tid] = DG[(size_t)h * MA + b * SEQ + 7 * 256 + 255] * n + ((dl[0] + dl[1]) + (dl[2] + dl[3])); }
        __syncthreads();
        const f32x4 nv = *(const LAS f32x4*)(npv + 4 * F.lane); const bf16_t* PQg = (const bf16_t*)(ws + WS_PQ);
        for (int r = 0; r < 32; ++r) { const size_t row = (size_t)b * SEQ + cc * 256 + F.wave * 32 + r; const u32x2 qq = *(const u32x2*)(PQg + ((size_t)u * 256 + F.wave * 32 + r) * 512 + 256 + 4 * F.lane);
            const float s = wave_sum(bf_lo(qq.x) * nv[0] + bf_hi(qq.x) * nv[1] + bf_lo(qq.y) * nv[2] + bf_hi(qq.y) * nv[3]); if (F.lane == 0) ((float*)(ws + WS_QN))[(size_t)h * MA + row] = s; } }

}


__device__ __forceinline__ void p5s_sample(const Ctx& F0) { Ctx F = F0; asm volatile("" : "+v"(F.tid), "+v"(F.lane), "+s"(F.gw));
    unsigned char* ws = F.ws;
    LAS float* hs = (LAS float*)F.lds + 512; LAS float* red = (LAS float*)F.lds + 1024;
    for (int job = F.bid; job < MS * HB; job += F.G) { const int i = job >> 2, h = job & 3; const size_t row = MP + i;
        const bf16_t* Q = (const bf16_t*)(ws + WS_Q) + row * 1024 + h * 256; const bf16_t* K = (const bf16_t*)(ws + WS_K) + row * 1024 + h * 256; const bf16_t* V = (const bf16_t*)(ws + WS_VS) + (size_t)i * 1024 + h * 256;
        const u32x2 qw = *(const u32x2*)(Q + 4 * F.lane), kw = *(const u32x2*)(K + 4 * F.lane);
        const f32x4 q4 = (f32x4){bf_lo(qw.x), bf_hi(qw.x), bf_lo(qw.y), bf_hi(qw.y)}, k4 = (f32x4){bf_lo(kw.x), bf_hi(kw.x), bf_lo(kw.y), bf_hi(kw.y)};
        const f32x4 n0 = *(const f32x4*)(F.in[3] + ((size_t)i * 4 + h) * 256 + 4 * F.lane);
        const float li = ((const float*)(ws + WS_GLI))[(size_t)h * MA + row], lf = ((const float*)(ws + WS_GLF))[(size_t)h * MA + row], m0 = F.in[4][i * 4 + h];
        const float mn = fmaxf(lf + m0, li), g = __expf(lf + m0 - mn), wi = __expf(li - mn);
        const float qk = wave_sum(q4[0] * k4[0] + q4[1] * k4[1] + q4[2] * k4[2] + q4[3] * k4[3]), nq = wave_sum(n0[0] * q4[0] + n0[1] * q4[1] + n0[2] * q4[2] + n0[3] * q4[3]);
        const float sc = wi * qk, den = sc + g * nq, dinv = 1.0f / fmaxf(fabsf(den), __expf(-mn));
        const float* C0 = F.in[2] + (((size_t)i * 4 + h) * 256 + F.wave * 32) * 256 + 4 * F.lane; float* C1 = F.out + O_CS + (((size_t)i * 4 + h) * 256 + F.wave * 32) * 256 + 4 * F.lane;
        __syncthreads();
#pragma unroll 1
        for (int r8 = 0; r8 < 32; r8 += 8) { f32x4 c[8]; float ve[8], cq[8];
#pragma unroll
            for (int r = 0; r < 8; ++r) { c[r] = __builtin_nontemporal_load((const f32x4*)(C0 + (size_t)(r8 + r) * 256)); ve[r] = bf2f(V[F.wave * 32 + r8 + r]); }
#pragma unroll
            for (int r = 0; r < 8; ++r) { cq[r] = c[r][0] * q4[0] + c[r][1] * q4[1] + c[r][2] * q4[2] + c[r][3] * q4[3]; const float wv = wi * ve[r]; __builtin_nontemporal_store(c[r] * g + k4 * wv, (f32x4*)(C1 + (size_t)(r8 + r) * 256)); }
#pragma unroll
            for (int r = 0; r < 8; ++r) { cq[r] = wave_sum(cq[r]); if (F.lane == 0) hs[F.wave * 32 + r8 + r] = (sc * ve[r] + g * cq[r]) * dinv; } }
        if (F.wave == 0) { *(f32x4*)(F.out + O_NS + ((size_t)i * 4 + h) * 256 + 4 * F.lane) = n0 * g + k4 * wi; if (F.lane == 0) F.out[O_MS + i * 4 + h] = mn; }
        __syncthreads();
        const bf16_t* PB = (const bf16_t*)(ws + WS_PROJB) + row * 3072; const bf16_t* XC = (const bf16_t*)(ws + WS_XB) + row * DM;
        float x = 0.f; const int ch = h * 256 + (F.tid & 255);
        if (F.tid < 256) x = hs[F.tid] * bf2f(PB[1024 + ch]);
        float p = wave_sum(x); if (F.lane == 0) red[F.wave] = p;
        __syncthreads();
        const float mu = (red[0] + red[1] + red[2] + red[3]) * (1.f / 256.f), dx = x - mu;
        __syncthreads();
        p = wave_sum(F.tid < 256 ? dx * dx : 0.f); if (F.lane == 0) red[F.wave] = p;
        __syncthreads();
        const float rstd = 1.0f / sqrtf((red[0] + red[1] + red[2] + red[3]) * (1.f / 256.f) + EPS);
        if (F.tid < 256) ((bf16_t*)(ws + WS_Y))[row * DMIX + 1024 + ch] = f2bf((dx * rstd * F.in[21][ch] + F.in[22][ch] * bf2f(XC[ch])) * bf2f(PB[2048 + ch]));
        __syncthreads();
    }
}
struct EpiHOut {
    static constexpr bool PERM = false, AFTER_DRAIN = true;
    const float* DENP; const float* DG; const float* QN; const float* DEM; const bf16_t* PB; const bf16_t* XC; bf16_t* Y; const float* gng; const float* skip;
    __device__ __forceinline__ void fused(f32x4 (&acc)[2][2][4][2], const Unit& u, int wr, int wc, int fr, int fq, LAS unsigned char* lds, int wid, int lane) const {
        const int h = u.aux, rl0 = wr * 64 + fr, col0 = wc * 32 + 4 * fq; const size_t vb = (size_t)h * MA + (size_t)u.pm * 256;
        LAS float* P1 = (LAS float*)lds; LAS float* P2 = (LAS float*)lds + 1024;
#pragma unroll
        for (int ai = 0; ai < 2; ++ai) { u32x2 ow[4][2][2]; f32x4 dp[4]; float dgq[4], dem[4];
#pragma unroll
            for (int m = 0; m < 4; ++m) { const int t = rl0 + ai * 128 + m * 16; const size_t row = (size_t)u.pm * 256 + t; dp[m] = *(const f32x4*)(DENP + (vb + t) * 4); dgq[m] = QN[vb + t]; dem[m] = DEM[vb + t];
#pragma unroll
                for (int bj = 0; bj < 2; ++bj)
#pragma unroll
                    for (int n = 0; n < 2; ++n) ow[m][bj][n] = *(const u32x2*)(PB + row * 3072 + 1024 + h * 256 + col0 + bj * 128 + n * 16); }
#pragma unroll
            for (int m = 0; m < 4; ++m) { const int t = rl0 + ai * 128 + m * 16; const float den = (dp[m][0] + dp[m][1]) + (dp[m][2] + dp[m][3]) + dgq[m];
                const float dinv = 1.0f / fmaxf(fabsf(den), dem[m]); float s = 0.f;
#pragma unroll
                for (int bj = 0; bj < 2; ++bj)
#pragma unroll
                    for (int n = 0; n < 2; ++n) { const u32x2 o2 = ow[m][bj][n];
                        f32x4 v = acc[ai][bj][m][n] * dinv; v[0] *= bf_lo(o2.x); v[1] *= bf_hi(o2.x); v[2] *= bf_lo(o2.y); v[3] *= bf_hi(o2.y); acc[ai][bj][m][n] = v; s += (v[0] + v[1]) + (v[2] + v[3]); }
                s += __shfl_xor(s, 16); s += __shfl_xor(s, 32); if (fq == 0) P1[t * 4 + wc] = s; } }
        asm volatile("s_waitcnt lgkmcnt(0)" ::: "memory"); __builtin_amdgcn_s_barrier(); asm volatile("" ::: "memory");
#pragma unroll
        for (int ai = 0; ai < 2; ++ai)
#pragma unroll
            for (int m = 0; m < 4; ++m) { const int t = rl0 + ai * 128 + m * 16; const f32x4 ps = *(const LAS f32x4*)(P1 + t * 4); const float mu = ((ps[0] + ps[1]) + (ps[2] + ps[3])) * (1.f / 256.f); float q = 0.f;
#pragma unroll
                for (int bj = 0; bj < 2; ++bj)
#pragma unroll
                    for (int n = 0; n < 2; ++n) { f32x4 v = acc[ai][bj][m][n] - mu; acc[ai][bj][m][n] = v; q += (v[0] * v[0] + v[1] * v[1]) + (v[2] * v[2] + v[3] * v[3]); }
                q += __shfl_xor(q, 16); q += __shfl_xor(q, 32); if (fq == 0) P2[t * 4 + wc] = q; }
        asm volatile("s_waitcnt lgkmcnt(0)" ::: "memory"); __builtin_amdgcn_s_barrier(); asm volatile("" ::: "memory");
#pragma unroll
        for (int ai = 0; ai < 2; ++ai) { u32x2 xw[4][2][2], zw[4][2][2];
#pragma unroll
            for (int m = 0; m < 4; ++m) { const int t = rl0 + ai * 128 + m * 16; const size_t row = (size_t)u.pm * 256 + t;
#pragma unroll
                for (int bj = 0; bj < 2; ++bj)
#pragma unroll
                    for (int n = 0; n < 2; ++n) { const int c = h * 256 + col0 + bj * 128 + n * 16; xw[m][bj][n] = *(const u32x2*)(XC + row * DM + c); zw[m][bj][n] = *(const u32x2*)(PB + row * 3072 + 2048 + c); } }
#pragma unroll
            for (int m = 0; m < 4; ++m) { const int t = rl0 + ai * 128 + m * 16; const size_t row = (size_t)u.pm * 256 + t; const f32x4 ps = *(const LAS f32x4*)(P2 + t * 4);
                const float rstd = 1.0f / sqrtf(((ps[0] + ps[1]) + (ps[2] + ps[3])) * (1.f / 256.f) + EPS);
#pragma unroll
                for (int bj = 0; bj < 2; ++bj)
#pragma unroll
                    for (int n = 0; n < 2; ++n) { const int c = h * 256 + col0 + bj * 128 + n * 16; const u32x2 x2 = xw[m][bj][n], z2 = zw[m][bj][n];
                        const f32x4 ggv = *(const f32x4*)(gng + c), skv = *(const f32x4*)(skip + c); const f32x4 v = acc[ai][bj][m][n] * rstd * ggv; u32x2 w;
                        w.x = cvt_pk_bf16((v[0] + skv[0] * bf_lo(x2.x)) * bf_lo(z2.x), (v[1] + skv[1] * bf_hi(x2.x)) * bf_hi(z2.x));
                        w.y = cvt_pk_bf16((v[2] + skv[2] * bf_lo(x2.y)) * bf_lo(z2.y), (v[3] + skv[3] * bf_hi(x2.y)) * bf_hi(z2.y));
                        *(u32x2*)(Y + row * DMIX + 1024 + c) = w; } } }
    }
};
__device__ __forceinline__ void p6_hout(const Ctx& F) {
    unsigned char* ws = F.ws; Gemm g{512, 512, 512};
    OrderUnitNT S{NUNIT, F.G, F.bid, (const char*)(ws + WS_PQ), 0, 0, (size_t)256 * 512 * 2, (const char*)(ws + WS_VC), 0, 0, (size_t)256 * 512 * 2};
    EpiHOut E{(const float*)(ws + WS_DENP), (const float*)(ws + WS_DG), (const float*)(ws + WS_QN), (const float*)(ws + WS_DEM), (const bf16_t*)(ws + WS_PROJB), (const bf16_t*)(ws + WS_XB), (bf16_t*)(ws + WS_Y), F.in[21], F.in[22]};
    pg8::gemm_phase<EpiHOut, OrderUnitNT, false, true>(F.lds, g, S, E);
}
template <class PtrF, class Ef>
__device__ __forceinline__ void sample_gemm(const Ctx& F, int nitems, int K, int lda, int ldb, const PtrF& P, const Ef& E) {
    int lane_ = F.lane; asm volatile("" : "+v"(lane_));
    const int l15 = lane_ & 15, lq = lane_ >> 4, w = F.wave;
    for (int item = F.bid; item < nitems; item += F.G) {
        const bf16_t* A; const bf16_t* B; P(item, A, B);
        const bf16_t* ap = A + (size_t)(16 * w + l15) * lda + 8 * lq; const bf16_t* bp = B + (size_t)l15 * ldb + 8 * lq;
        f32x4 acc = (f32x4){0.f, 0.f, 0.f, 0.f};
        for (int k0 = 0; k0 < K; k0 += 256) { bf16x8 a[8], b[8];
#pragma unroll
            for (int j = 0; j < 8; ++j) { a[j] = *(const bf16x8*)(ap + k0 + 32 * j); b[j] = *(const bf16x8*)(bp + k0 + 32 * j); }
#pragma unroll
            for (int j = 0; j < 8; ++j) acc = __builtin_amdgcn_mfma_f32_16x16x32_bf16(a[j], b[j], acc, 0, 0, 0); }
#pragma unroll
        for (int r = 0; r < 4; ++r) E(item, 16 * w + 4 * lq + r, l15, acc[r]);
    }
}
__device__ __forceinline__ void sample_inproj(const Ctx& F) {
    unsigned char* ws = F.ws; const bf16_t* XB = (const bf16_t*)(ws + WS_XB) + (size_t)MP * DM; const bf16_t* W = (const bf16_t*)(ws + WS_WIN);
    bf16_t* PA = (bf16_t*)(ws + WS_PROJA) + (size_t)MP * 3072; bf16_t* PB = (bf16_t*)(ws + WS_PROJB) + (size_t)MP * 3072; const float* rs = (const float*)(ws + WS_RS) + MP;
    sample_gemm(F, NIN / 16, DM, DM, DM,
        [=](int item, const bf16_t*& A, const bf16_t*& B) { A = XB; B = W + (size_t)item * 16 * DM; },
        [=](int item, int r, int c, float acc) { const int col = item * 16 + c, grp = col >> 10; float v = acc * rs[r];
            if (grp < 2) { const f32x2 g2 = gelu_pk((f32x2){v, v}); v = g2.x; } else if (grp == 2 || grp == 5) v = siluf_(v); else if (grp == 4) v = sigmoidf_(v);
            bf16_t* dst = col < 3072 ? PA + (size_t)r * 3072 + col : PB + (size_t)r * 3072 + (col - 3072); *dst = f2bf(v); });
}
__device__ __forceinline__ void sample_qkv(const Ctx& F) {
    unsigned char* ws = F.ws; const bf16_t* XC = (const bf16_t*)(ws + WS_XB) + (size_t)MP * DM; const bf16_t* XBr = (const bf16_t*)(ws + WS_PROJB) + (size_t)MP * 3072;
    const bf16_t* WQ = (const bf16_t*)(ws + WS_WQ); const bf16_t* WK = (const bf16_t*)(ws + WS_WK); const bf16_t* WV = (const bf16_t*)(ws + WS_WV);
    bf16_t* Q = (bf16_t*)(ws + WS_Q) + (size_t)MP * 1024; bf16_t* Kk = (bf16_t*)(ws + WS_K) + (size_t)MP * 1024; bf16_t* Vs = (bf16_t*)(ws + WS_VS);
    sample_gemm(F, 128, 256, DM, 256,
        [=](int item, const bf16_t*& A, const bf16_t*& B) { const int which = item >> 6, it = item & 63, h = it >> 4; A = XC + h * 256; B = (which ? WK : WQ) + (size_t)h * 65536 + (size_t)(it & 15) * 16 * 256; },
        [=](int item, int r, int c, float acc) { const int which = item >> 6, it = item & 63; bf16_t* O = which ? Kk : Q; O[(size_t)r * 1024 + it * 16 + c] = f2bf(which ? acc * 0.0625f : acc); });
    sample_gemm(F, 64, 256, 3072, 256,
        [=](int item, const bf16_t*& A, const bf16_t*& B) { const int h = item >> 4; A = XBr + h * 256; B = WV + (size_t)h * 65536 + (size_t)(item & 15) * 16 * 256; },
        [=](int item, int r, int c, float acc) { Vs[(size_t)r * 1024 + item * 16 + c] = f2bf(acc); });
}
__device__ __forceinline__ void sample_outproj(const Ctx& F) {
    unsigned char* ws = F.ws; const bf16_t* Y = (const bf16_t*)(ws + WS_Y) + (size_t)MP * DMIX; const bf16_t* W = (const bf16_t*)(ws + WS_WOUT);
    const float* xs = F.in[1]; float* out = F.out + O_YS; bf16_t* X1B = (bf16_t*)(ws + WS_X1B) + (size_t)MP * DM;
    sample_gemm(F, DM / 16, DMIX, DMIX, DMIX,
        [=](int item, const bf16_t*& A, const bf16_t*& B) { A = Y; B = W + (size_t)item * 16 * DMIX; },
        [=](int item, int r, int c, float acc) { const int col = item * 16 + c; const float v = xs[(size_t)r * DM + col] + acc; out[(size_t)r * DM + col] = v; X1B[(size_t)r * DM + col] = f2bf(v); });
}
__device__ __forceinline__ void sample_ple(const Ctx& F) {
    unsigned char* ws = F.ws; const bf16_t* X1B = (const bf16_t*)(ws + WS_X1B) + (size_t)MP * DM; const bf16_t* PBs = (const bf16_t*)(ws + WS_PB) + (size_t)MP * DPLE;
    const bf16_t* WG = (const bf16_t*)(ws + WS_WPG); const bf16_t* WP = (const bf16_t*)(ws + WS_WPP); const float* bias = F.in[25];
    bf16_t* GB = (bf16_t*)(ws + WS_GB) + (size_t)MP * DM; bf16_t* EB = (bf16_t*)(ws + WS_EB) + (size_t)MP * DM;
    sample_gemm(F, DM / 16, DM, DM, DM,
        [=](int item, const bf16_t*& A, const bf16_t*& B) { A = X1B; B = WG + (size_t)item * 16 * DM; },
        [=](int item, int r, int c, float acc) { const int col = item * 16 + c; GB[(size_t)r * DM + col] = f2bf(sigmoidf_(acc + bias[col])); });
    sample_gemm(F, DM / 16, DPLE, DPLE, DPLE,
        [=](int item, const bf16_t*& A, const bf16_t*& B) { A = PBs; B = WP + (size_t)item * 16 * DPLE; },
        [=](int item, int r, int c, float acc) { EB[(size_t)r * DM + item * 16 + c] = f2bf(acc); });
}
template <class PtrF, class Ef>
__device__ __forceinline__ void sample_gemm_ks(const Ctx& F, int nitems, int K, int lda, int ldb, const PtrF& P, const Ef& E) {
    int lane_ = F.lane; asm volatile("" : "+v"(lane_)); const int l15 = lane_ & 15, lq = lane_ >> 4, w = F.wave; LAS f32x4* red = (LAS f32x4*)F.lds;
    const int ks = K >> 3;
    for (int item = F.bid; item < nitems; item += F.G) {
        const bf16_t* A; const bf16_t* B; P(item, A, B);
        const bf16_t* ap = A + (size_t)l15 * lda + w * ks + 8 * lq; const bf16_t* bp = B + (size_t)l15 * ldb + w * ks + 8 * lq;
        f32x4 acc[2][4];
#pragma unroll
        for (int m = 0; m < 2; ++m)
#pragma unroll
            for (int n = 0; n < 4; ++n) acc[m][n] = (f32x4){0.f, 0.f, 0.f, 0.f};
        for (int k0 = 0; k0 < ks; k0 += 128) { bf16x8 a[4][2], b[4][4];
#pragma unroll
            for (int j = 0; j < 4; ++j) {
#pragma unroll
                for (int m = 0; m < 2; ++m) a[j][m] = (k0 + 32 * j < ks) ? *(const bf16x8*)(ap + (size_t)(16 * m) * lda + k0 + 32 * j) : (bf16x8){0, 0, 0, 0, 0, 0, 0, 0};
#pragma unroll
                for (int n = 0; n < 4; ++n) b[j][n] = (k0 + 32 * j < ks) ? *(const bf16x8*)(bp + (size_t)(16 * n) * ldb + k0 + 32 * j) : (bf16x8){0, 0, 0, 0, 0, 0, 0, 0}; }
#pragma unroll
            for (int j = 0; j < 4; ++j)
#pragma unroll
                for (int m = 0; m < 2; ++m)
#pragma unroll
                    for (int n = 0; n < 4; ++n) acc[m][n] = __builtin_amdgcn_mfma_f32_16x16x32_bf16(a[j][m], b[j][n], acc[m][n], 0, 0, 0); }
        __syncthreads();
#pragma unroll
        for (int m = 0; m < 2; ++m)
#pragma unroll
            for (int n = 0; n < 4; ++n) red[(w * 8 + m * 4 + n) * 64 + F.lane] = acc[m][n];
        __syncthreads();
        f32x4 s = red[(0 * 8 + w) * 64 + F.lane];
#pragma unroll
        for (int ww = 1; ww < 8; ++ww) s = s + red[(ww * 8 + w) * 64 + F.lane];
        const int mt = w >> 2, nt = w & 3;
#pragma unroll
        for (int r = 0; r < 4; ++r) E(item, 16 * mt + 4 * lq + r, 16 * nt + l15, s[r]);
    }
    __syncthreads();
}
__device__ __forceinline__ void sample_outproj_ks(const Ctx& F) {
    unsigned char* ws = F.ws; const bf16_t* Y = (const bf16_t*)(ws + WS_Y) + (size_t)MP * DMIX; const bf16_t* W = (const bf16_t*)(ws + WS_WOUT);
    const float* xs = F.in[1]; float* out = F.out + O_YS; bf16_t* X1B = (bf16_t*)(ws + WS_X1B) + (size_t)MP * DM;
    sample_gemm_ks(F, 64, DMIX, DMIX, DMIX,
        [=](int item, const bf16_t*& A, const bf16_t*& B) { A = Y + (size_t)(item & 3) * 32 * DMIX; B = W + (size_t)(item >> 2) * 64 * DMIX; },
        [=](int item, int r, int c, float acc) { const int row = (item & 3) * 32 + r, col = (item >> 2) * 64 + c; const float v = xs[(size_t)row * DM + col] + acc; X1B[(size_t)row * DM + col] = f2bf(v); });
}
__device__ __forceinline__ void sample_ple_ks(const Ctx& F) {
    unsigned char* ws = F.ws; const bf16_t* X1B = (const bf16_t*)(ws + WS_X1B) + (size_t)MP * DM; const bf16_t* PBs = (const bf16_t*)(ws + WS_PB) + (size_t)MP * DPLE;
    const bf16_t* WG = (const bf16_t*)(ws + WS_WPG); const bf16_t* WP = (const bf16_t*)(ws + WS_WPP); const float* bias = F.in[25];
    bf16_t* GB = (bf16_t*)(ws + WS_GB) + (size_t)MP * DM; bf16_t* EB = (bf16_t*)(ws + WS_EB) + (size_t)MP * DM;
    sample_gemm_ks(F, 64, DM, DM, DM,
        [=](int item, const bf16_t*& A, const bf16_t*& B) { A = X1B + (size_t)(item & 3) * 32 * DM; B = WG + (size_t)(item >> 2) * 64 * DM; },
        [=](int item, int r, int c, float acc) { const int row = (item & 3) * 32 + r, col = (item >> 2) * 64 + c; GB[(size_t)row * DM + col] = f2bf(sigmoidf_(acc + bias[col])); });
    sample_gemm_ks(F, 64, DPLE, DPLE, DPLE,
        [=](int item, const bf16_t*& A, const bf16_t*& B) { A = PBs + (size_t)(item & 3) * 32 * DPLE; B = WP + (size_t)(item >> 2) * 64 * DPLE; },
        [=](int item, int r, int c, float acc) { const int row = (item & 3) * 32 + r, col = (item >> 2) * 64 + c; EB[(size_t)row * DM + col] = f2bf(acc); });
}
#define XB_TMO      128
#define XB_XCNT(j)  (256  + 64 * (j))
#define XB_XSUB(j)  (1280 + 64 * (j))
#define XB_XGEN(j)  (2304 + 64 * (j))
#define XB_TOP      3328
#define XB_TOPGEN   3392
#define XCD_BAR_WORDS 3456
#define XB_SPIN_CAP (1u << 18)
__device__ __forceinline__ unsigned xb_ld(unsigned* p)              { return __hip_atomic_load(p, __ATOMIC_RELAXED, __HIP_MEMORY_SCOPE_AGENT); }
__device__ __forceinline__ unsigned xb_add(unsigned* p, unsigned v) { return __hip_atomic_fetch_add(p, v, __ATOMIC_RELAXED, __HIP_MEMORY_SCOPE_AGENT); }
__device__ __forceinline__ unsigned xb_xcc_id() { return (unsigned)__builtin_amdgcn_s_getreg((3 << 11) | 20) & 0xFu; }
#define XB_SPIN(cond, bar) do { unsigned _sp = 0; while (cond) { __builtin_amdgcn_s_sleep(1); \
    if ((++_sp & 255u) == 0u) { if (xb_ld(&(bar)[XB_TMO])) break; if (_sp > XB_SPIN_CAP) { atomicAdd(&(bar)[XB_TMO], 1u); break; } } } } while (0)
struct XcdBarrier { unsigned* bar; unsigned x; volatile LAS unsigned* st; };
__device__ __forceinline__ XcdBarrier xcd_barrier_post(unsigned* bar, volatile LAS unsigned* st) {
    XcdBarrier b; b.bar = bar; b.x = xb_xcc_id(); b.st = st;
    if (threadIdx.x == 0) (void)xb_add(&bar[XB_XCNT(b.x)], 1u);
    return b;
}
__device__ __forceinline__ void xcd_barrier_complete(unsigned* bar, unsigned x, unsigned& nloc, unsigned& nx) {
    const unsigned G = gridDim.x * gridDim.y * gridDim.z;
    unsigned sum, cnt, mine, sp = 0u;
    for (;;) {
        sum = 0u; cnt = 0u; mine = 0u;
#pragma unroll
        for (unsigned j = 0; j < 16; ++j) { const unsigned c = xb_ld(&bar[XB_XCNT(j)]); sum += c; cnt += (c > 0u) ? 1u : 0u; mine = (j == x) ? c : mine; }
        if (sum == G) break;
        __builtin_amdgcn_s_sleep(1);
        if ((++sp & 255u) == 0u) { if (xb_ld(&bar[XB_TMO])) break; if (sp > XB_SPIN_CAP) { atomicAdd(&bar[XB_TMO], 1u); break; } }
    }
    nloc = mine > 0u ? mine : 1u; nx = cnt > 0u ? cnt : 1u;
}
__device__ __forceinline__ void xcd_barrier(const XcdBarrier& b) {
    asm volatile("s_waitcnt vmcnt(0)" ::: "memory");
    __syncthreads();
    if (threadIdx.x == 0) {
        unsigned* bar = b.bar;
        __builtin_amdgcn_s_waitcnt(0);
        unsigned nloc = b.st[0], nx = b.st[1];
        if (nloc == 0u) { xcd_barrier_complete(bar, b.x, nloc, nx); b.st[0] = nloc; b.st[1] = nx; }
        const unsigned old = xb_add(&bar[XB_XSUB(b.x)], 1u);
        const unsigned gen = old / nloc;
        if (old + 1u == (gen + 1u) * nloc) {
            __builtin_amdgcn_fence(__ATOMIC_RELEASE, "agent");
            asm volatile("s_waitcnt vmcnt(0)" ::: "memory");
            const unsigned og = xb_add(&bar[XB_TOP], 1u);
            const unsigned tg = og / nx;
            if (og + 1u == (tg + 1u) * nx) xb_add(&bar[XB_TOPGEN], 1u);
            else XB_SPIN(xb_ld(&bar[XB_TOPGEN]) == tg, bar);
            __builtin_amdgcn_fence(__ATOMIC_ACQUIRE, "agent");
            xb_add(&bar[XB_XGEN(b.x)], 1u);
            asm volatile("s_waitcnt vmcnt(0)" ::: "memory");
        } else {
            XB_SPIN(xb_ld(&bar[XB_XGEN(b.x)]) == gen, bar);
            __builtin_amdgcn_fence(__ATOMIC_ACQUIRE, "agent");
            asm volatile("s_waitcnt vmcnt(0)" ::: "memory");
        }
    }
    __syncthreads();
}
__global__ void __launch_bounds__(512, 2) mega(Args args) {
    MAKE_CTX();
    volatile LAS unsigned* MISC = (volatile LAS unsigned*)(F.lds + 131072 + 320);
    if (F.tid < 32) MISC[F.tid] = 0u;
    __syncthreads();
    const XcdBarrier bar = xcd_barrier_post((unsigned*)(ws + WS_CTL), MISC + 8);
#define GRID_SYNC() xcd_barrier(bar)
    p0_prologue(F);      GRID_SYNC();
    sample_inproj(F); p1_inproj(F); GRID_SYNC();
    p2a_conv_gates(F); p2b_spatial_units(F); GRID_SYNC();
    p2b_mscan(F); p3_s12(F); p2c_sample_rows(F); GRID_SYNC();
    p3_qkv(F);           GRID_SYNC();
    if (F.bid & 1) { p5s_sample(F); p4_scores_dc(F); } else { p4_scores_dc(F); p5s_sample(F); } GRID_SYNC();
    p5_scan_sample(F);   GRID_SYNC();
    p6_hout(F);          GRID_SYNC();
    sample_outproj_ks(F); p7_outproj(F); GRID_SYNC();
    p8_ple(F);           GRID_SYNC();
    p9_final(F);
}

extern "C" void kernel_launch(void* const* d_in, const int* in_sizes, int n_in, void* d_out, int out_size, void* d_ws, size_t ws_size, hipStream_t stream) {
    static int grid = 0;
    if (grid == 0) {
        if (n_in != 29 || (size_t)out_size != O_END || ws_size < WS_END) { fprintf(stderr, "kernel_launch: unexpected shapes (n_in %d out %d ws %zu)\n", n_in, out_size, ws_size); grid = -1; return; }
        int dev = 0, cus = 0, per_cu = 0;
        if (hipGetDevice(&dev) != hipSuccess || hipDeviceGetAttribute(&cus, hipDeviceAttributeMultiprocessorCount, dev) != hipSuccess) { grid = -1; return; }
        if (hipFuncSetAttribute((const void*)mega, hipFuncAttributeMaxDynamicSharedMemorySize, LDS_BYTES) != hipSuccess) { fprintf(stderr, "kernel_launch: hipFuncSetAttribute failed\n"); grid = -1; return; }
        if (hipOccupancyMaxActiveBlocksPerMultiprocessor(&per_cu, (const void*)mega, 512, LDS_BYTES) != hipSuccess || per_cu < 1) { fprintf(stderr, "kernel_launch: occupancy query says %d\n", per_cu); grid = -1; return; }
        (void)hipGetLastError();
        grid = cus;
        if (grid != 256) { fprintf(stderr, "kernel_launch: this kernel is laid out for 256 CUs, got %d\n", grid); grid = -1; return; }
    }
    if (grid < 0) return;
    if (hipMemsetAsync((unsigned char*)d_ws + WS_CTL, 0, 16384, stream) != hipSuccess) { fprintf(stderr, "kernel_launch: memset failed\n"); return; }
    Args a{};
    for (int i = 0; i < 29; ++i) a.in[i] = (const float*)d_in[i];
    a.out = (float*)d_out; a.ws = (unsigned char*)d_ws;
    void* kargs[] = {&a};
    hipError_t e = hipLaunchCooperativeKernel((const void*)mega, dim3(grid), dim3(512), kargs, LDS_BYTES, stream);
    if (e != hipSuccess) fprintf(stderr, "kernel_launch: cooperative launch failed: %s (grid %d)\n", hipGetErrorString(e), grid);
}
```

```cpp
#include <hip/hip_runtime.h>
#include <hip/hip_cooperative_groups.h>
#include <cstdio>
#include <cstdint>
namespace cg = cooperative_groups;

#define LAS __attribute__((address_space(3)))
typedef unsigned short bf16_t;
typedef short bf16x8 __attribute__((ext_vector_type(8)));
typedef float f32x4 __attribute__((ext_vector_type(4)));
typedef float f32x2 __attribute__((ext_vector_type(2)));
typedef unsigned u32x4 __attribute__((ext_vector_type(4)));
typedef unsigned u32x2 __attribute__((ext_vector_type(2)));

constexpr int DM = 1024, SEQ = 2048, NB = 8, MP = NB * SEQ, MS = 128, MA = MP + 256, NTILE = MA / 256;
constexpr int NIN = 6144, WA = 1024, WB = 1024, HA = 8, DHA = 128, HB = 4, DHB = 256, DPLE = 256, DMIX = 2048;
constexpr int LC = 256, NCH = SEQ / LC;
constexpr int NUNIT = NB * HB * NCH;
constexpr float EPS = 1e-6f;

constexpr size_t O_Y = 0, O_YS = 16777216, O_CP = 16908288, O_NP = 19005440, O_MP = 19013632, O_CVP = 19013664, O_CS = 19038240, O_NS = 52592672, O_MS = 52723744, O_CVS = 52724256, O_VS = 53117472, O_END = 53248544;

constexpr size_t MiB = 1u << 20;
constexpr size_t WS_CTL = 0, WS_WIN = 1 * MiB, WS_WQ = 13 * MiB, WS_WK = WS_WQ + MiB / 2, WS_WV = 14 * MiB, WS_WOUT = WS_WV + MiB / 2, WS_WPG = WS_WOUT + 4 * MiB, WS_WPP = WS_WPG + 2 * MiB,
    WS_WSP = 21 * MiB, WS_WG = WS_WSP + MiB / 4, WS_RS = WS_WG + MiB / 4, WS_GLI = 22 * MiB, WS_GLF = WS_GLI + MiB / 2, WS_DA = 23 * MiB, WS_DR = WS_DA + MiB / 2, WS_DG = 24 * MiB, WS_DEM = WS_DG + MiB / 2,
    WS_DW = 25 * MiB, WS_QN = WS_DW + MiB / 2, WS_DENP = 26 * MiB, WS_DN = 27 * MiB, WS_VS = WS_DN + MiB / 2, WS_PB = 28 * MiB, WS_XB = 37 * MiB, WS_PROJA = 70 * MiB, WS_PROJB = 168 * MiB,
    WS_PQ = 266 * MiB, WS_VC = 330 * MiB, WS_Y = 394 * MiB, WS_XB2 = 460 * MiB, WS_DN4 = 493 * MiB, WS_END = 495 * MiB;
constexpr size_t WS_WGB = WS_RS + MiB / 8;
constexpr size_t WS_Q = WS_PROJA, WS_K = WS_Q + 33 * MiB, WS_WKT = WS_K + 33 * MiB;
constexpr size_t WS_X1B = WS_PROJA, WS_GB = WS_X1B + 33 * MiB, WS_EB = WS_GB + 33 * MiB;
static_assert(WS_WKT + 32 * MiB <= WS_PROJB && WS_EB + 33 * MiB <= WS_PQ, "ws map");

__device__ __forceinline__ unsigned cvt_pk_bf16(float lo, float hi) { unsigned r; asm volatile("v_cvt_pk_bf16_f32 %0, %1, %2" : "=v"(r) : "v"(lo), "v"(hi)); return r; }
__device__ __forceinline__ float bf_lo(unsigned w) { return __uint_as_float(w << 16); }
__device__ __forceinline__ float bf_hi(unsigned w) { return __uint_as_float(w & 0xffff0000u); }
__device__ __forceinline__ float bf2f(bf16_t b) { return __uint_as_float(((unsigned)b) << 16); }
__device__ __forceinline__ bf16_t f2bf(float f) { return (bf16_t)(cvt_pk_bf16(f, 0.f) & 0xffffu); }
__device__ __forceinline__ float fast_exp(float x) { return __builtin_amdgcn_exp2f(x * 1.4426950408889634f); }
__device__ __forceinline__ float sigmoidf_(float x) { return __builtin_amdgcn_rcpf(1.0f + fast_exp(-x)); }
__device__ __forceinline__ float siluf_(float x) { return x * sigmoidf_(x); }
__device__ __forceinline__ f32x2 gelu_pk(f32x2 v) {
    const f32x2 av = __builtin_elementwise_abs(v), d = av * 0.2316418882f + 1.0f;
    f32x2 t; t.x = __builtin_amdgcn_rcpf(d.x); t.y = __builtin_amdgcn_rcpf(d.y);
    f32x2 q = t * 0.5307027145f + (-0.7265760135f); q = q * t + 0.7107068705f; q = q * t + (-0.142248368f); q = q * t + 0.127414796f; q = q * t;
    const f32x2 s = (v * v) * (-0.72134752044f);
    f32x2 e; e.x = __builtin_amdgcn_exp2f(s.x); e.y = __builtin_amdgcn_exp2f(s.y);
    const f32x2 m = v * (q * e), r = v - m;
    f32x2 o; o.x = v.x < 0.f ? m.x : r.x; o.y = v.y < 0.f ? m.y : r.y; return o;
}
__device__ __forceinline__ float dpp_add(float v, const int ctrl_sel) {
    const int iv = __builtin_bit_cast(int, v); int r;
    if (ctrl_sel == 0) r = __builtin_amdgcn_update_dpp(0, iv, 0xB1, 0xF, 0xF, true);
    else if (ctrl_sel == 1) r = __builtin_amdgcn_update_dpp(0, iv, 0x4E, 0xF, 0xF, true);
    else if (ctrl_sel == 2) r = __builtin_amdgcn_update_dpp(0, iv, 0x141, 0xF, 0xF, true);
    else r = __builtin_amdgcn_update_dpp(0, iv, 0x140, 0xF, 0xF, true);
    return v + __builtin_bit_cast(float, r);
}
__device__ __forceinline__ float wave_sum(float v) {
    v = dpp_add(v, 0); v = dpp_add(v, 1); v = dpp_add(v, 2); v = dpp_add(v, 3);
    const int iv = __builtin_bit_cast(int, v);
    const float r0 = __builtin_bit_cast(float, __builtin_amdgcn_readlane(iv, 0)), r1 = __builtin_bit_cast(float, __builtin_amdgcn_readlane(iv, 16)),
                r2 = __builtin_bit_cast(float, __builtin_amdgcn_readlane(iv, 32)), r3 = __builtin_bit_cast(float, __builtin_amdgcn_readlane(iv, 48));
    return (r0 + r1) + (r2 + r3);
}
#define LDS_WAIT() asm volatile("s_waitcnt lgkmcnt(0)" ::: "memory")

namespace pg8 {
constexpr int BM = 256, BK = 64, HALF = 128, HTB = HALF * BK * 2, STAGE_BYTES = 8 * HTB;
__host__ __device__ __forceinline__ int lds_byte(int r, int c) { const int st = (r >> 4) * 2 + (c >> 5), rr = r & 15, cc = c & 31, ob = rr * 64 + cc * 2; return st * 1024 + (ob ^ (((ob >> 9) & 1) << 5)); }
__host__ __device__ __forceinline__ void stage_rc(int b, int& R, int& C) { const int st = b / 1024, sb = b % 1024, swz = sb ^ (((sb >> 9) & 1) << 5); R = (st >> 1) * 16 + swz / 64; C = (st & 1) * 32 + (swz % 64) / 2; }
__host__ __device__ __forceinline__ int perm32(int rho) { const int n = rho >> 4, i = rho & 15; return 8 * (i >> 2) + 4 * n + (i & 3); }

struct Unit { const char* a; const char* b; int pm, pn, aux; };
struct Gemm { int lda, ldb, K; };

template <class Epi, class Sched, bool ALIGN_EPI = true, bool SP2 = true>
__device__ __forceinline__ void gemm_phase(LAS unsigned char* lds, const Gemm g, const Sched& S, const Epi& E) {
    int tid_ = threadIdx.x; asm volatile("" : "+v"(tid_));
    const int tid = tid_, wid = __builtin_amdgcn_readfirstlane(tid >> 6), lane = tid & 63, wr = wid >> 2, wc = wid & 3, fr = lane & 15, fq = lane >> 4;
    int K_ = g.K; asm volatile("" : "+s"(K_)); const int K = K_, nt = K / BK; (void)K;
    unsigned voffA[2], voffB[2];
#pragma unroll
    for (int i = 0; i < 2; ++i) { int R, C; stage_rc(tid * 16 + i * 8192, R, C); const int Rb = Epi::PERM ? ((R & ~31) + perm32(R & 31)) : R;
        voffA[i] = (unsigned)(R * g.lda + C) * 2u; voffB[i] = (unsigned)(Rb * g.ldb + C) * 2u; }
    const size_t kstep = (size_t)(BK * 2);
    const size_t hstepA = (size_t)HALF * g.lda * 2, hstepB = (size_t)HALF * g.ldb * 2;
    const unsigned ldsw = (unsigned)wid * 1024u;
    const int aoff = lds_byte(wr * 64 + fr, fq * 8), boff = lds_byte(wc * 32 + fr, fq * 8);
#define PG8_SA(b, h) (((b) * 2 + (h)) * HTB)
#define PG8_SB(b, h) ((4 + (b) * 2 + (h)) * HTB)
#define PG8_STAGE(bufoff, gbase, voff) do { _Pragma("unroll") for (int _i = 0; _i < 2; ++_i) \
        __builtin_amdgcn_global_load_lds((const unsigned*)((const char*)(gbase) + (voff)[_i]), (LAS unsigned*)(lds + (bufoff) + ldsw + _i * 8192), 16, 0, 0); } while (0)
#define PG8_LDA(dst, b, h) do { _Pragma("unroll") for (int m = 0; m < 4; ++m) _Pragma("unroll") for (int k = 0; k < 2; ++k) dst[m][k] = *(const LAS bf16x8*)(lds + PG8_SA(b, h) + aoff + m * 2048 + k * 1024); } while (0)
#define PG8_LDB(dst, b, h) do { _Pragma("unroll") for (int n = 0; n < 2; ++n) _Pragma("unroll") for (int k = 0; k < 2; ++k) dst[n][k] = *(const LAS bf16x8*)(lds + PG8_SB(b, h) + boff + n * 2048 + k * 1024); } while (0)
#define PG8_MMA(ai, bj, At, Bt) do { __builtin_amdgcn_s_setprio(1); _Pragma("unroll") for (int m = 0; m < 4; ++m) _Pragma("unroll") for (int n = 0; n < 2; ++n) _Pragma("unroll") for (int k = 0; k < 2; ++k) \
        acc[ai][bj][m][n] = __builtin_amdgcn_mfma_f32_16x16x32_bf16(Bt[n][k], At[m][k], acc[ai][bj][m][n], 0, 0, 0); __builtin_amdgcn_s_setprio(0); } while (0)
#define PG8_WAIT_V(n) asm volatile("s_waitcnt vmcnt(" #n ")" ::: "memory")
#define PG8_WAIT_L(n) asm volatile("s_waitcnt lgkmcnt(" #n ")" ::: "memory")
#define PG8_BAR __builtin_amdgcn_s_barrier()
#define PG8_SCHED __builtin_amdgcn_sched_barrier(0)
    Unit cur, nxt; int ui = 0;
    if (!S.next(0, cur)) return;
    f32x4 acc[2][2][4][2];
#pragma unroll
    for (int a = 0; a < 2; ++a)
#pragma unroll
        for (int b = 0; b < 2; ++b)
#pragma unroll
            for (int m = 0; m < 4; ++m)
#pragma unroll
                for (int n = 0; n < 2; ++n) acc[a][b][m][n] = (f32x4){0.f, 0.f, 0.f, 0.f};
    bf16x8 At[4][2], B0[2][2], B1[2][2];
    const char* cA = cur.a; const char* cB = cur.b;
    if constexpr (SP2) {
        PG8_STAGE(PG8_SB(0, 0), cB, voffB); PG8_STAGE(PG8_SB(0, 1), cB + hstepB, voffB); PG8_STAGE(PG8_SA(0, 0), cA, voffA); PG8_STAGE(PG8_SA(0, 1), cA + hstepA, voffA);
        if (wr == 1) PG8_BAR;
        PG8_WAIT_V(2); PG8_BAR;
        PG8_STAGE(PG8_SB(1, 0), cB + kstep, voffB); PG8_STAGE(PG8_SA(1, 0), cA + kstep, voffA); PG8_STAGE(PG8_SB(1, 1), cB + hstepB + kstep, voffB);
        PG8_WAIT_V(6); PG8_BAR;
    } else {
        PG8_STAGE(PG8_SB(0, 0), cB, voffB); PG8_STAGE(PG8_SA(0, 0), cA, voffA); PG8_STAGE(PG8_SB(0, 1), cB + hstepB, voffB); PG8_STAGE(PG8_SA(0, 1), cA + hstepA, voffA);
        if (wr == 1) PG8_BAR;
        PG8_WAIT_V(4); PG8_BAR;
        PG8_STAGE(PG8_SB(1, 0), cB + kstep, voffB); PG8_STAGE(PG8_SA(1, 0), cA + kstep, voffA); PG8_STAGE(PG8_SB(1, 1), cB + hstepB + kstep, voffB);
        PG8_WAIT_V(6); PG8_BAR;
    }
    for (;;) {
        const bool has_next = S.next(ui + 1, nxt);
        const char* nA = has_next ? nxt.a : cA; const char* nB = has_next ? nxt.b : cB;
#pragma unroll 1
        for (int t = 0; t < nt; t += 2) {
            const bool last = (t == nt - 2);
            const char* a1 = cA + (size_t)(t + 1) * kstep;
            const char* a2 = last ? nA : cA + (size_t)(t + 2) * kstep; const char* b2 = last ? nB : cB + (size_t)(t + 2) * kstep;
            const char* a3 = a2 + kstep; const char* b3 = b2 + kstep;
            if constexpr (SP2) {
            PG8_LDB(B0, 0, 0); PG8_LDB(B1, 0, 1); PG8_SCHED; PG8_LDA(At, 0, 0); PG8_STAGE(PG8_SA(1, 1), a1 + hstepA, voffA);
            PG8_WAIT_V(8); PG8_WAIT_L(0); PG8_BAR; PG8_MMA(0, 0, At, B0); PG8_MMA(0, 1, At, B1); PG8_BAR; PG8_SCHED;
            PG8_LDA(At, 0, 1); PG8_STAGE(PG8_SB(0, 0), b2, voffB); PG8_STAGE(PG8_SB(0, 1), b2 + hstepB, voffB); PG8_STAGE(PG8_SA(0, 0), a2, voffA);
            PG8_WAIT_V(8); PG8_WAIT_L(0); PG8_BAR; PG8_MMA(1, 0, At, B0); PG8_MMA(1, 1, At, B1); PG8_BAR; PG8_SCHED;
            PG8_LDB(B0, 1, 0); PG8_LDB(B1, 1, 1); PG8_SCHED; PG8_LDA(At, 1, 0); PG8_STAGE(PG8_SA(0, 1), a2 + hstepA, voffA);
            PG8_WAIT_V(8); PG8_WAIT_L(0); PG8_BAR; PG8_MMA(0, 0, At, B0); PG8_MMA(0, 1, At, B1); PG8_BAR; PG8_SCHED;
            PG8_LDA(At, 1, 1); PG8_STAGE(PG8_SB(1, 0), b3, voffB); PG8_STAGE(PG8_SB(1, 1), b3 + hstepB, voffB); PG8_STAGE(PG8_SA(1, 0), a3, voffA);
            PG8_WAIT_V(8); PG8_WAIT_L(0); PG8_BAR; PG8_MMA(1, 0, At, B0); PG8_MMA(1, 1, At, B1); PG8_BAR; PG8_SCHED;
            } else {
            PG8_LDB(B0, 0, 0); PG8_SCHED; PG8_LDA(At, 0, 0); PG8_STAGE(PG8_SA(1, 1), a1 + hstepA, voffA);
            PG8_WAIT_L(8); PG8_BAR; PG8_WAIT_L(0); PG8_MMA(0, 0, At, B0); PG8_BAR; PG8_SCHED;
            PG8_LDB(B1, 0, 1); PG8_STAGE(PG8_SB(0, 0), b2, voffB);
            PG8_BAR; PG8_WAIT_L(0); PG8_MMA(0, 1, At, B1); PG8_BAR;
            PG8_LDA(At, 0, 1); PG8_STAGE(PG8_SA(0, 0), a2, voffA);
            PG8_BAR; PG8_WAIT_L(0); PG8_MMA(1, 0, At, B0); PG8_BAR; PG8_SCHED;
            PG8_STAGE(PG8_SB(0, 1), b2 + hstepB, voffB);
            PG8_WAIT_V(6); PG8_BAR; PG8_MMA(1, 1, At, B1); PG8_BAR;
            PG8_LDB(B0, 1, 0); PG8_SCHED; PG8_LDA(At, 1, 0); PG8_STAGE(PG8_SA(0, 1), a2 + hstepA, voffA);
            PG8_WAIT_L(8); PG8_BAR; PG8_WAIT_L(0); PG8_MMA(0, 0, At, B0); PG8_BAR; PG8_SCHED;
            PG8_LDB(B1, 1, 1); PG8_STAGE(PG8_SB(1, 0), b3, voffB);
            PG8_BAR; PG8_WAIT_L(0); PG8_MMA(0, 1, At, B1); PG8_BAR;
            PG8_LDA(At, 1, 1); PG8_STAGE(PG8_SA(1, 0), a3, voffA);
            PG8_BAR; PG8_WAIT_L(0); PG8_MMA(1, 0, At, B0); PG8_BAR; PG8_SCHED;
            PG8_STAGE(PG8_SB(1, 1), b3 + hstepB, voffB);
            PG8_WAIT_V(6); PG8_BAR; PG8_MMA(1, 1, At, B1); PG8_BAR;
            }
        }
        if constexpr (ALIGN_EPI) { if (wr == 0) PG8_BAR; }
        if constexpr (!Epi::AFTER_DRAIN) { E(acc, cur, wr, wc, fr, fq); }
        if (!has_next) break;
#pragma unroll
        for (int a = 0; a < 2; ++a)
#pragma unroll
            for (int b = 0; b < 2; ++b)
#pragma unroll
                for (int m = 0; m < 4; ++m)
#pragma unroll
                    for (int n = 0; n < 2; ++n) acc[a][b][m][n] = (f32x4){0.f, 0.f, 0.f, 0.f};
        cur = nxt; cA = nA; cB = nB; ++ui;
        if constexpr (ALIGN_EPI) { if (wr == 1) PG8_BAR; }
    }
    PG8_WAIT_V(0);
    if constexpr (!ALIGN_EPI) { if (wr == 0) PG8_BAR; }
    PG8_BAR;
    if constexpr (Epi::AFTER_DRAIN) { E.fused(acc, cur, wr, wc, fr, fq, lds, wid, lane); }
#undef PG8_SA
#undef PG8_SB
#undef PG8_STAGE
#undef PG8_LDA
#undef PG8_LDB
#undef PG8_MMA
#undef PG8_WAIT_V
#undef PG8_WAIT_L
#undef PG8_BAR
#undef PG8_SCHED
}
}
using pg8::Unit; using pg8::Gemm;

constexpr int LDS_BYTES = 147456;
struct Args { const float* in[29]; float* out; unsigned char* ws; };

struct Ctx {
    LAS unsigned char* lds; int tid, lane, wave, G, bid, gw, NGW;
    const float* const* in; float* out; unsigned char* ws;
};

__device__ __forceinline__ void p0_transpose_item(const float* W, int ldw, bf16_t* WT, int ldt, const float* kscale, LAS float* scr, int kb, int nb, int lane) {
    const int k0 = 64 * kb, n0 = 32 * nb;
    float wv_[32];
#pragma unroll
    for (int i = 0; i < 32; ++i) { const int kk = 2 * i + (lane >> 5); wv_[i] = __builtin_nontemporal_load(W + (size_t)(k0 + kk) * ldw + n0 + (lane & 31)); }
#pragma unroll
    for (int i = 0; i < 32; ++i) { const int kk = 2 * i + (lane >> 5); float v = wv_[i]; if (kscale) v *= kscale[k0 + kk]; scr[kk * 33 + (lane & 31)] = v; }
    LDS_WAIT(); asm volatile("" ::: "memory");
    const int c = lane & 7;
#pragma unroll
    for (int j = 0; j < 4; ++j) { const int n = (lane >> 3) + 8 * j; const LAS float* s = scr + (8 * c) * 33 + n;
        u32x4 o; o.x = cvt_pk_bf16(s[0 * 33], s[1 * 33]); o.y = cvt_pk_bf16(s[2 * 33], s[3 * 33]); o.z = cvt_pk_bf16(s[4 * 33], s[5 * 33]); o.w = cvt_pk_bf16(s[6 * 33], s[7 * 33]);
        *(u32x4*)(WT + (size_t)(n0 + n) * ldt + k0 + 8 * c) = o; }
    LDS_WAIT(); asm volatile("" ::: "memory");
}

__device__ __forceinline__ void p0_prologue(const Ctx& F0) { Ctx F = F0; asm volatile("" : "+v"(F.tid), "+v"(F.lane), "+s"(F.gw));
    LAS float* scr = (LAS float*)(F.lds + F.wave * 16384);
    unsigned char* ws = F.ws;
    constexpr int I_WIN = 16 * 192, I_QKV = 12 * 4 * 8, I_WOUT = 32 * 32, I_WPG = 16 * 32, I_WPP = 4 * 32;
    constexpr int I_T = I_WIN + I_QKV + I_WOUT + I_WPG + I_WPP;
    constexpr int I_X = 0, I_P = 0, I_SP = 1024, I_WG = 1024, I_YPAD = 128;
    constexpr int NITEMS = I_T + I_X + I_P + I_SP + I_WG + I_YPAD;
    for (int it = F.gw; it < NITEMS; it += F.NGW) {
        int r = it;
        if (r < I_T) {
            if (r < I_WIN) { p0_transpose_item(F.in[9], NIN, (bf16_t*)(ws + WS_WIN), DM, F.in[8], scr, r / 192, r % 192, F.lane); continue; } r -= I_WIN;
            if (r < I_QKV) { const int mat = r / 32, rr = r % 32, which = mat / 4, h = mat % 4;
                const float* W = F.in[16 + which] + (size_t)h * 65536; bf16_t* WT = (bf16_t*)(ws + (which == 0 ? WS_WQ : which == 1 ? WS_WK : WS_WV)) + (size_t)h * 65536;
                p0_transpose_item(W, 256, WT, 256, nullptr, scr, rr / 8, rr % 8, F.lane); continue; } r -= I_QKV;
            if (r < I_WOUT) { p0_transpose_item(F.in[23], DM, (bf16_t*)(ws + WS_WOUT), DMIX, nullptr, scr, r / 32, r % 32, F.lane); continue; } r -= I_WOUT;
            if (r < I_WPG) { p0_transpose_item(F.in[24], DM, (bf16_t*)(ws + WS_WPG), DM, nullptr, scr, r / 32, r % 32, F.lane); continue; } r -= I_WPG;
            p0_transpose_item(F.in[26], DM, (bf16_t*)(ws + WS_WPP), DPLE, nullptr, scr, r / 32, r % 32, F.lane); continue;
        }
        r -= I_T;
        if (r < I_X) {
            bf16_t* orow = (bf16_t*)(ws + WS_XB) + (size_t)r * DM; float* rs = (float*)(ws + WS_RS);
            unsigned long long* o8 = (unsigned long long*)orow + F.lane;
            if (r >= MP + MS) {
#pragma unroll
                for (int j = 0; j < 4; ++j) o8[64 * j] = 0ull;
                if (F.lane == 0) rs[r] = 0.f; continue; }
            const float* xrow = r < MP ? F.in[0] + (size_t)r * DM : F.in[1] + (size_t)(r - MP) * DM;
            const f32x4* xr = (const f32x4*)xrow + F.lane; f32x4 v[4]; float s = 0.f;
#pragma unroll
            for (int j = 0; j < 4; ++j) { v[j] = xr[64 * j]; s += (v[j].x * v[j].x + v[j].y * v[j].y) + (v[j].z * v[j].z + v[j].w * v[j].w); }
            s = wave_sum(s);
#pragma unroll
            for (int j = 0; j < 4; ++j) o8[64 * j] = (unsigned long long)cvt_pk_bf16(v[j].x, v[j].y) | ((unsigned long long)cvt_pk_bf16(v[j].z, v[j].w) << 32);
            if (F.lane == 0) rs[r] = 1.0f / sqrtf(s * (1.0f / DM) + EPS);
            continue;
        }
        r -= I_X;
        if (r < I_P) {
            unsigned long long* o8 = (unsigned long long*)((bf16_t*)(ws + WS_PB) + (size_t)r * DPLE) + F.lane;
            if (r >= MP + MS) { o8[0] = 0ull; continue; }
            const float* prow = r < MP ? F.in[6] + (size_t)r * DPLE : F.in[7] + (size_t)(r - MP) * DPLE;
            const f32x4 v = __builtin_nontemporal_load((const f32x4*)prow + F.lane);
            o8[0] = (unsigned long long)cvt_pk_bf16(v.x, v.y) | ((unsigned long long)cvt_pk_bf16(v.z, v.w) << 32);
            continue;
        }
        r -= I_P;
        if (r < I_SP) {
            const int t = r & 127; const float* wrow = F.in[12] + (size_t)r * 128; const f32x2 v = ((const f32x2*)wrow)[F.lane];
            const int s0 = 2 * F.lane; ((unsigned*)((bf16_t*)(ws + WS_WSP) + (size_t)r * 128))[F.lane] = cvt_pk_bf16(s0 <= t ? v.x : 0.f, s0 + 1 <= t ? v.y : 0.f);
            continue;
        }
        r -= I_SP;
        if (r < I_WG) {
            const int i = r, h = i >> 8, d = i & 255; const float* wif = F.in[19];
            const f32x4 wq4 = *(const f32x4*)(F.in[16] + ((size_t)h * 256 + d) * 256 + 4 * F.lane), wk4 = *(const f32x4*)(F.in[17] + ((size_t)h * 256 + d) * 256 + 4 * F.lane), wv4 = *(const f32x4*)(F.in[18] + ((size_t)h * 256 + d) * 256 + 4 * F.lane);
            float sx[8], sb[8];
#pragma unroll
            for (int j = 0; j < 8; ++j) { sx[j] = 0.f; sb[j] = 0.f; }
#pragma unroll
            for (int e = 0; e < 4; ++e) { const size_t rq = (size_t)(h * 256 + 4 * F.lane + e) * 8;
                const f32x4 q0 = *(const f32x4*)(wif + rq), q1 = *(const f32x4*)(wif + rq + 4), k0 = *(const f32x4*)(wif + 8192 + rq), k1 = *(const f32x4*)(wif + 8192 + rq + 4), v0 = *(const f32x4*)(wif + 16384 + rq), v1 = *(const f32x4*)(wif + 16384 + rq + 4);
#pragma unroll
                for (int j = 0; j < 4; ++j) { sx[j] += wq4[e] * q0[j] + wk4[e] * k0[j]; sx[4 + j] += wq4[e] * q1[j] + wk4[e] * k1[j]; sb[j] += wv4[e] * v0[j]; sb[4 + j] += wv4[e] * v1[j]; } }
#pragma unroll
            for (int j = 0; j < 8; ++j) { sx[j] = wave_sum(sx[j]); sb[j] = wave_sum(sb[j]); }
            float s = 0.f;
#pragma unroll
            for (int j = 0; j < 8; ++j) { s = (F.lane == j) ? sx[j] : s; s = (F.lane == 8 + j) ? sb[j] : s; }
            if (F.lane < 16) ((float*)(ws + WS_WG))[(size_t)i * 16 + F.lane] = s;
            if (F.lane < 16) { bf16_t* wgb = (bf16_t*)(ws + WS_WGB) + (size_t)(F.lane >> 3) * 16384 + (size_t)(F.lane & 7) * 1024 + i; wgb[0] = f2bf(s); wgb[8 * 1024] = 0; }
            continue;
        }
        r -= I_WG;
        {
            u32x4* yrow = (u32x4*)((bf16_t*)(ws + WS_Y) + (size_t)(MP + MS + r) * DMIX) + F.lane;
#pragma unroll
            for (int j = 0; j < 4; ++j) yrow[64 * j] = (u32x4){0u, 0u, 0u, 0u};
        }
    }
    {
        float* rs = (float*)(ws + WS_RS);
        for (int r0 = F.gw * 4; r0 < MP + MS; r0 += F.NGW * 4) { f32x4 v[4][4];
#pragma unroll
            for (int q = 0; q < 4; ++q) { const int r = r0 + q; const float* xrow = r < MP ? F.in[0] + (size_t)r * DM : F.in[1] + (size_t)(r - MP) * DM;
#pragma unroll
                for (int j = 0; j < 4; ++j) v[q][j] = __builtin_nontemporal_load((const f32x4*)xrow + F.lane + 64 * j); }
#pragma unroll
            for (int q = 0; q < 4; ++q) { const int r = r0 + q; float sq = 0.f;
#pragma unroll
                for (int j = 0; j < 4; ++j) sq += (v[q][j].x * v[q][j].x + v[q][j].y * v[q][j].y) + (v[q][j].z * v[q][j].z + v[q][j].w * v[q][j].w);
                sq = wave_sum(sq); unsigned long long* o8 = (unsigned long long*)((bf16_t*)(ws + WS_XB) + (size_t)r * DM) + F.lane;
#pragma unroll
                for (int j = 0; j < 4; ++j) o8[64 * j] = (unsigned long long)cvt_pk_bf16(v[q][j].x, v[q][j].y) | ((unsigned long long)cvt_pk_bf16(v[q][j].z, v[q][j].w) << 32);
                if (F.lane == 0) rs[r] = 1.0f / sqrtf(sq * (1.0f / DM) + EPS); } }
        for (int r = MP + MS + F.gw; r < MA; r += F.NGW) { unsigned long long* o8 = (unsigned long long*)((bf16_t*)(ws + WS_XB) + (size_t)r * DM) + F.lane;
#pragma unroll
            for (int j = 0; j < 4; ++j) o8[64 * j] = 0ull;
            if (F.lane == 0) rs[r] = 0.f; ((unsigned long long*)((bf16_t*)(ws + WS_PB) + (size_t)r * DPLE))[F.lane] = 0ull; }
        for (int r0 = F.gw * 8; r0 < MP + MS; r0 += F.NGW * 8) { f32x4 pv[8];
#pragma unroll
            for (int q = 0; q < 8; ++q) { const int r = r0 + q; const float* prow = r < MP ? F.in[6] + (size_t)r * DPLE : F.in[7] + (size_t)(r - MP) * DPLE; pv[q] = __builtin_nontemporal_load((const f32x4*)prow + F.lane); }
#pragma unroll
            for (int q = 0; q < 8; ++q) ((unsigned long long*)((bf16_t*)(ws + WS_PB) + (size_t)(r0 + q) * DPLE))[F.lane] = (unsigned long long)cvt_pk_bf16(pv[q].x, pv[q].y) | ((unsigned long long)cvt_pk_bf16(pv[q].z, pv[q].w) << 32); }
    }
}

struct OrderRowMajor {
    int nM, nN, n, G, c; const char* A; const char* B; size_t astep, bstep;
    __device__ __forceinline__ bool next(int i, Unit& u) const {
        const int L = i * G + c; if (L >= n) return false;
        u.pm = L / nN; u.pn = L % nN; u.aux = 0; u.a = A + (size_t)u.pm * astep; u.b = B + (size_t)u.pn * bstep; return true;
    }
};
struct OrderPanel4 {
    int n, G, c; const char* A; const char* B; size_t astep, bstep;
    __device__ __forceinline__ bool next(int i, Unit& u) const {
        const int L = i * G + c; if (L >= n) return false;
        if (L < 256) { const int x = L & 7, j = L >> 3; u.pm = x * 8 + (j >> 2); u.pn = j & 3; } else { u.pm = 64; u.pn = L - 256; }
        u.aux = 0; u.a = A + (size_t)u.pm * astep; u.b = B + (size_t)u.pn * bstep; return true;
    }
};
struct OrderProjSkip {
    int G, c; const char* A; const char* B; size_t astep, bstep;
    __device__ __forceinline__ bool next(int i, Unit& u) const {
        if (c < 4) return false; const int cp = c - 4; const int L = i == 0 ? cp : (i == 1 && cp < 8 ? 252 + cp : -1); if (L < 0) return false;
        if (L < 256) { const int x = L & 7, j = L >> 3; u.pm = x * 8 + (j >> 2); u.pn = j & 3; } else { u.pm = 64; u.pn = L - 256; }
        u.aux = 0; u.a = A + (size_t)u.pm * astep; u.b = B + (size_t)u.pn * bstep; return true;
    }
};
struct OrderXcd {
    int nM, nN, n, G, c; const char* A; const char* B; size_t astep, bstep;
    __device__ __forceinline__ bool next(int i, Unit& u) const {
        const int L = i * G + c; if (L >= n) return false;
        int wgid = L; { const int q = n / 8, r = n % 8, xcd = wgid % 8, off = wgid / 8; wgid = (xcd < r ? xcd * (q + 1) : r * (q + 1) + (xcd - r) * q) + off; }
        const int nig = 8 * nN, gid = wgid / nig, fm = gid * 8, gsz = (nM - fm) < 8 ? (nM - fm) : 8;
        u.pm = fm + ((wgid % nig) % gsz); u.pn = (wgid % nig) / gsz; u.aux = 0; u.a = A + (size_t)u.pm * astep; u.b = B + (size_t)u.pn * bstep; return true;
    }
};
struct EpiInProj {
    static constexpr bool PERM = true, AFTER_DRAIN = false;
    bf16_t* PA; bf16_t* PB; const float* rs;
    template <int KIND> __device__ __forceinline__ void run(const f32x4 (&acc)[2][2][4][2], bf16_t* base, int row0, int col0) const {
#pragma unroll
        for (int ai = 0; ai < 2; ++ai)
#pragma unroll
            for (int m = 0; m < 4; ++m) { const int row = row0 + ai * 128 + m * 16; const float s = rs[row]; bf16_t* rowp = base + (size_t)row * 3072 + col0;
#pragma unroll
                for (int bj = 0; bj < 2; ++bj) { f32x4 v0 = acc[ai][bj][m][0] * s, v1 = acc[ai][bj][m][1] * s;
                    if (KIND == 0) { f32x2 a = gelu_pk((f32x2){v0[0], v0[1]}), b = gelu_pk((f32x2){v0[2], v0[3]}), c = gelu_pk((f32x2){v1[0], v1[1]}), d = gelu_pk((f32x2){v1[2], v1[3]});
                        v0 = (f32x4){a.x, a.y, b.x, b.y}; v1 = (f32x4){c.x, c.y, d.x, d.y}; }
                    if (KIND == 1) {
#pragma unroll
                        for (int j = 0; j < 4; ++j) { v0[j] = siluf_(v0[j]); v1[j] = siluf_(v1[j]); } }
                    if (KIND == 3) {
#pragma unroll
                        for (int j = 0; j < 4; ++j) { v0[j] = sigmoidf_(v0[j]); v1[j] = sigmoidf_(v1[j]); } }
                    u32x4 w; w.x = cvt_pk_bf16(v0[0], v0[1]); w.y = cvt_pk_bf16(v0[2], v0[3]); w.z = cvt_pk_bf16(v1[0], v1[1]); w.w = cvt_pk_bf16(v1[2], v1[3]);
                    *(u32x4*)(rowp + bj * 128) = w; } }
    }
    __device__ __forceinline__ void operator()(const f32x4 (&acc)[2][2][4][2], const Unit& u, int wr, int wc, int fr, int fq) const {
        const int row0 = u.pm * 256 + wr * 64 + fr, pn = u.pn;
        bf16_t* base = pn < 12 ? PA + pn * 256 : PB + (pn - 12) * 256; const int col0 = wc * 32 + 8 * fq;
        if (pn < 8) run<0>(acc, base, row0, col0);
        else if (pn < 12 || pn >= 20) run<1>(acc, base, row0, col0);
        else if (pn < 16) run<2>(acc, base, row0, col0);
        else run<3>(acc, base, row0, col0);
    }
};

__device__ __forceinline__ float logsigmoidf_(float x) { return fminf(x, 0.f) - log1pf(__expf(-fabsf(x))); }
__device__ __forceinline__ void unpack8(const u32x4 w, float (&f)[8]) { f[0] = bf_lo(w.x); f[1] = bf_hi(w.x); f[2] = bf_lo(w.y); f[3] = bf_hi(w.y); f[4] = bf_lo(w.z); f[5] = bf_hi(w.z); f[6] = bf_lo(w.w); f[7] = bf_hi(w.w); }
__device__ __forceinline__ u32x4 pack8(const float (&f)[8]) { u32x4 w; w.x = cvt_pk_bf16(f[0], f[1]); w.y = cvt_pk_bf16(f[2], f[3]); w.z = cvt_pk_bf16(f[4], f[5]); w.w = cvt_pk_bf16(f[6], f[7]); return w; }

__device__ __forceinline__ void p2a_conv_gates(const Ctx& F0) { Ctx F = F0; asm volatile("" : "+v"(F.tid), "+v"(F.lane), "+s"(F.gw));
    unsigned char* ws = F.ws;
    const bf16_t* PBX = (const bf16_t*)(ws + WS_XB2);
    bf16_t* XC = (bf16_t*)(ws + WS_XB);
    const float* Wg = (const float*)(ws + WS_WG);
    float* GLI = (float*)(ws + WS_GLI); float* GLF = (float*)(ws + WS_GLF);
    const float* convw = F.in[14]; const float* convb = F.in[15]; const float* bif = F.in[20];
    LAS float* cwl = (LAS float*)F.lds; LAS bf16_t* wgl = (LAS bf16_t*)(F.lds + 20480); LAS f32x4* comb = (LAS f32x4*)(F.lds + 20480 + 32 * 2064);
    {
        u32x4 t[11];
#pragma unroll
        for (int j = 0; j < 11; ++j) { const int i = min(F.tid + 512 * j, 5375);
            const u32x4* srcp = i < 1024 ? (const u32x4*)convw + i : (i < 1280 ? (const u32x4*)convb + (i - 1024) : (const u32x4*)(ws + WS_WGB) + (i - 1280));
            t[j] = *srcp; }
#pragma unroll
        for (int j = 0; j < 11; ++j) { const int i = F.tid + 512 * j; if (i < 1280) ((LAS u32x4*)F.lds)[i] = t[j]; else if (i < 5376) { const int p = i - 1280; *(LAS u32x4*)(F.lds + 20480 + (p >> 7) * 2064 + (p & 127) * 16) = t[j]; } }
    }
    __syncthreads();
    const int l15 = F.lane & 15, lq = F.lane >> 4, rgp = F.wave >> 1, hh = F.wave & 1;
    auto conv_core = [&](int row, const float (&w0)[8], const float (&w1)[8], const float (&w2)[8], const u32x4 x0, int ch0, f32x4& acc) {
        float cur[8], xc[8];
        unpack8(x0, cur);
#pragma unroll
        for (int q = 0; q < 2; ++q) { const f32x4 c0 = *(const LAS f32x4*)(cwl + ch0 + 4 * q), c1 = *(const LAS f32x4*)(cwl + 1024 + ch0 + 4 * q), c2 = *(const LAS f32x4*)(cwl + 2048 + ch0 + 4 * q), c3 = *(const LAS f32x4*)(cwl + 3072 + ch0 + 4 * q), cb = *(const LAS f32x4*)(cwl + 4096 + ch0 + 4 * q);
#pragma unroll
            for (int e = 0; e < 4; ++e) xc[4 * q + e] = siluf_(c0[e] * w0[4 * q + e] + c1[e] * w1[4 * q + e] + c2[e] * w2[4 * q + e] + c3[e] * cur[4 * q + e] + cb[e]); }
        const u32x4 xcp = pack8(xc);
        *(u32x4*)(XC + (size_t)row * DM + ch0) = xcp;
        const bf16x8 bc = *(const LAS bf16x8*)(wgl + l15 * 1032 + ch0), bx = *(const LAS bf16x8*)(wgl + 16 * 1032 + l15 * 1032 + ch0);
        acc = __builtin_amdgcn_mfma_f32_16x16x32_bf16(__builtin_bit_cast(bf16x8, xcp), bc, acc, 0, 0, 0);
        acc = __builtin_amdgcn_mfma_f32_16x16x32_bf16(__builtin_bit_cast(bf16x8, x0), bx, acc, 0, 0, 0);
    };
    for (int tile = F.bid; tile < MP / 64; tile += F.G) {
        const int row = tile * 64 + rgp * 16 + l15, seq0 = row & ~(SEQ - 1);
        const bool v1 = row - 1 >= seq0, v2 = row - 2 >= seq0, v3 = row - 3 >= seq0;
        const bf16_t* p0 = PBX + (size_t)row * DM + hh * 512 + 8 * lq;
        const bf16_t* p1 = p0 - (v1 ? DM : 0); const bf16_t* p2 = p0 - (v2 ? 2 * DM : 0); const bf16_t* p3 = p0 - (v3 ? 3 * DM : 0);
        f32x4 acc = (f32x4){0.f, 0.f, 0.f, 0.f};
        u32x4 X0[2][4], X1[2][4], X2[2][4], X3[2][4];
#pragma unroll
        for (int j = 0; j < 4; ++j) { const int off = j * 32; X0[0][j] = *(const u32x4*)(p0 + off); X1[0][j] = *(const u32x4*)(p1 + off); X2[0][j] = *(const u32x4*)(p2 + off); X3[0][j] = *(const u32x4*)(p3 + off); }
#pragma unroll
        for (int bt = 0; bt < 4; ++bt) {
            if (bt < 3) {
#pragma unroll
                for (int j = 0; j < 4; ++j) { const int off = ((bt + 1) * 4 + j) * 32; X0[(bt + 1) & 1][j] = *(const u32x4*)(p0 + off); X1[(bt + 1) & 1][j] = *(const u32x4*)(p1 + off); X2[(bt + 1) & 1][j] = *(const u32x4*)(p2 + off); X3[(bt + 1) & 1][j] = *(const u32x4*)(p3 + off); } }
#pragma unroll
            for (int j = 0; j < 4; ++j) { const u32x4 z = (u32x4){0u, 0u, 0u, 0u}; float w0[8], w1[8], w2[8];
                unpack8(v3 ? X3[bt & 1][j] : z, w0); unpack8(v2 ? X2[bt & 1][j] : z, w1); unpack8(v1 ? X1[bt & 1][j] : z, w2);
                conv_core(row, w0, w1, w2, X0[bt & 1][j], (hh * 16 + bt * 4 + j) * 32 + 8 * lq, acc); }
        }
        __syncthreads();
        if (hh == 1) comb[rgp * 64 + F.lane] = acc;
        __syncthreads();
        if (hh == 0 && l15 < 8) { const f32x4 o = comb[rgp * 64 + F.lane]; const float bj = bif[l15];
#pragma unroll
            for (int r = 0; r < 4; ++r) { const float g = acc[r] + o[r] + bj; const size_t rr = (size_t)(tile * 64 + rgp * 16 + 4 * lq + r);
                if (l15 < 4) GLI[(size_t)l15 * MA + rr] = g; else GLF[(size_t)(l15 - 4) * MA + rr] = logsigmoidf_(g); } }
    }
    for (int si = F.G - 1 - F.bid; si < MS / 16; si += F.G) {
        const int row = MP + si * 16 + l15; const float* st = F.in[5] + (size_t)(row - MP) * 3072;
        f32x4 acc = (f32x4){0.f, 0.f, 0.f, 0.f};
        u32x4 X0[4]; f32x4 S[4][3][2];
#pragma unroll
        for (int cbk = 0; cbk < 4; ++cbk) { const int ch0 = (F.wave * 4 + cbk) * 32 + 8 * lq; X0[cbk] = *(const u32x4*)(PBX + (size_t)row * DM + ch0);
#pragma unroll
            for (int q = 0; q < 2; ++q) { S[cbk][0][q] = *(const f32x4*)(st + ch0 + 4 * q); S[cbk][1][q] = *(const f32x4*)(st + 1024 + ch0 + 4 * q); S[cbk][2][q] = *(const f32x4*)(st + 2048 + ch0 + 4 * q); } }
#pragma unroll
        for (int cbk = 0; cbk < 4; ++cbk) { float w0[8], w1[8], w2[8];
#pragma unroll
            for (int q = 0; q < 2; ++q)
#pragma unroll
                for (int e = 0; e < 4; ++e) { w0[4 * q + e] = S[cbk][0][q][e]; w1[4 * q + e] = S[cbk][1][q][e]; w2[4 * q + e] = S[cbk][2][q][e]; }
            conv_core(row, w0, w1, w2, X0[cbk], (F.wave * 4 + cbk) * 32 + 8 * lq, acc); }
        __syncthreads();
        comb[F.wave * 64 + F.lane] = acc;
        __syncthreads();
        if (F.wave == 0 && l15 < 8) { f32x4 o = comb[F.lane];
#pragma unroll
            for (int ww = 1; ww < 8; ++ww) o = o + comb[ww * 64 + F.lane];
            const float bj = bif[l15];
#pragma unroll
            for (int r = 0; r < 4; ++r) { const float g = o[r] + bj; const size_t rr = (size_t)(MP + si * 16 + 4 * lq + r);
                if (l15 < 4) GLI[(size_t)l15 * MA + rr] = g; else GLF[(size_t)(l15 - 4) * MA + rr] = logsigmoidf_(g); } }
    }
}
__device__ __forceinline__ void p2c_sample_rows(const Ctx& F0) { Ctx F = F0; asm volatile("" : "+v"(F.tid), "+v"(F.lane), "+s"(F.gw));
    unsigned char* ws = F.ws;
    const bf16_t* PBX = (const bf16_t*)(ws + WS_XB2);
    if (F.bid >= 64 && F.bid < 112) { const int i = (F.bid - 64) * 512 + F.tid; const int b = i / 3072, j = (i / 1024) % 3, ch = i & 1023;
        F.out[O_CVP + i] = bf2f(PBX[(size_t)(b * SEQ + SEQ - 3 + j) * DM + ch]); }
    if (F.bid >= 112 && F.bid < 128) { const int i = (F.bid - 112) * 8 + F.wave;
        const int r = MP + i, ch0s = F.lane * 16; const float* st = F.in[5] + (size_t)i * 3 * 1024;
        const bf16_t* PA = (const bf16_t*)(ws + WS_PROJA) + (size_t)r * 3072;
#pragma unroll
        for (int half = 0; half < 2; ++half) { const int c0 = ch0s + half * 8; float xb[8]; unpack8(*(const u32x4*)(PBX + (size_t)r * DM + c0), xb);
#pragma unroll
            for (int q = 0; q < 2; ++q) { *(f32x4*)(F.out + O_CVS + (size_t)i * 3072 + c0 + 4 * q) = *(const f32x4*)(st + 1024 + c0 + 4 * q); *(f32x4*)(F.out + O_CVS + (size_t)i * 3072 + 1024 + c0 + 4 * q) = *(const f32x4*)(st + 2048 + c0 + 4 * q);
                *(f32x4*)(F.out + O_CVS + (size_t)i * 3072 + 2048 + c0 + 4 * q) = (f32x4){xb[4 * q], xb[4 * q + 1], xb[4 * q + 2], xb[4 * q + 3]}; } }
        float gv[16], s = 0.f;
        { float t8[8]; unpack8(*(const u32x4*)(PA + 1024 + ch0s), t8);
#pragma unroll
          for (int c = 0; c < 8; ++c) gv[c] = t8[c];
          unpack8(*(const u32x4*)(PA + 1024 + ch0s + 8), t8);
#pragma unroll
          for (int c = 0; c < 8; ++c) gv[8 + c] = t8[c]; }
#pragma unroll
        for (int c = 0; c < 16; ++c) s += gv[c];
        s += __shfl_xor(s, 1); s += __shfl_xor(s, 2); s += __shfl_xor(s, 4);
        const float mu = s * (1.f / 128.f); float q = 0.f;
#pragma unroll
        for (int c = 0; c < 16; ++c) { const float d = gv[c] - mu; q += d * d; }
        q += __shfl_xor(q, 1); q += __shfl_xor(q, 2); q += __shfl_xor(q, 4);
        const float rstd = 1.0f / sqrtf(q * (1.f / 128.f) + EPS);
        const int h = F.lane >> 3; const float wsp = F.in[12][(size_t)h * 16384], bsp = F.in[13][h * 128];
        float uu[16], zz[16];
        { float t8[8]; unpack8(*(const u32x4*)(PA + ch0s), t8);
#pragma unroll
          for (int c = 0; c < 8; ++c) uu[c] = t8[c];
          unpack8(*(const u32x4*)(PA + ch0s + 8), t8);
#pragma unroll
          for (int c = 0; c < 8; ++c) uu[8 + c] = t8[c];
          unpack8(*(const u32x4*)(PA + 2048 + ch0s), t8);
#pragma unroll
          for (int c = 0; c < 8; ++c) zz[c] = t8[c];
          unpack8(*(const u32x4*)(PA + 2048 + ch0s + 8), t8);
#pragma unroll
          for (int c = 0; c < 8; ++c) zz[8 + c] = t8[c]; }
        float ya[16];
#pragma unroll
        for (int c = 0; c < 16; ++c) { const int ch = ch0s + c; const float vn = (gv[c] - mu) * rstd * F.in[10][ch] + F.in[11][ch];
            F.out[O_VS + (size_t)i * 1024 + ch] = vn; ya[c] = uu[c] * (wsp * vn + bsp) * zz[c]; }
        bf16_t* yrow = (bf16_t*)(ws + WS_Y) + (size_t)r * DMIX + ch0s;
        { float t8[8];
#pragma unroll
          for (int c = 0; c < 8; ++c) t8[c] = ya[c];
          *(u32x4*)(yrow) = pack8(t8);
#pragma unroll
          for (int c = 0; c < 8; ++c) t8[c] = ya[8 + c];
          *(u32x4*)(yrow + 8) = pack8(t8); }
    }
}

__device__ __forceinline__ void mscan_wave(const Ctx& F, int bh) {
    unsigned char* ws = F.ws; const int b = bh >> 2, h = bh & 3, lane = F.lane;
    const float* li = (const float*)(ws + WS_GLI) + (size_t)h * MA + (size_t)b * SEQ + lane * 32;
    const float* lf = (const float*)(ws + WS_GLF) + (size_t)h * MA + (size_t)b * SEQ + lane * 32;
    float A = 0.f, Bv = -INFINITY;
    for (int i = 0; i < 32; ++i) { const float f = lf[i], l = li[i]; Bv = fmaxf(Bv + f, l); A += f; }
    float sA = A, sB = Bv;
#pragma unroll
    for (int o = 1; o < 64; o <<= 1) { const float pA = __shfl_up(sA, o), pB = __shfl_up(sB, o); if (lane >= o) { sB = fmaxf(pB + sA, sB); sA = pA + sA; } }
    float eA = __shfl_up(sA, 1), eB = __shfl_up(sB, 1); if (lane == 0) { eA = 0.f; eB = -INFINITY; }
    const float m_in = fmaxf(0.f + eA, eB);
    float cA = A;
#pragma unroll
    for (int o = 1; o < 8; o <<= 1) { const float p = __shfl_up(cA, o); if ((lane & 7) >= o) cA += p; }
    const float b_in = cA - A;
    const float m_prev = __shfl(m_in, lane & ~7);
    float* DA = (float*)(ws + WS_DA) + (size_t)h * MA + (size_t)b * SEQ + lane * 32; float* DR = (float*)(ws + WS_DR) + (size_t)h * MA + (size_t)b * SEQ + lane * 32;
    float* DG = (float*)(ws + WS_DG) + (size_t)h * MA + (size_t)b * SEQ + lane * 32; float* DEM = (float*)(ws + WS_DEM) + (size_t)h * MA + (size_t)b * SEQ + lane * 32;
    float* DW = (float*)(ws + WS_DW) + (size_t)h * MA + (size_t)b * SEQ + lane * 32;
    float m = m_in, bb = b_in, a_last = 0.f;
    for (int i = 0; i < 32; ++i) { const float f = lf[i], l = li[i]; m = fmaxf(m + f, l); bb += f;
        a_last = bb - m; DA[i] = -m_prev; DR[i] = l - bb; DG[i] = __expf(bb + m_prev - m); DEM[i] = __expf(-m); }
    const float a_end = __shfl(a_last, lane | 7);
    for (int i = 0; i < 32; ++i) { const float f = lf[i]; (void)f; }
    { float bb2 = b_in; for (int i = 0; i < 32; ++i) { bb2 += lf[i]; DW[i] = __expf(a_end + (li[i] - bb2)); } }
    if (lane == 63) F.out[O_MP + bh] = m;
}

__device__ __forceinline__ void p9_final(const Ctx& F0) { Ctx F = F0; asm volatile("" : "+v"(F.tid), "+v"(F.lane), "+s"(F.gw));
    unsigned char* ws = F.ws; const bf16_t* GB = (const bf16_t*)(ws + WS_GB); const bf16_t* EB = (const bf16_t*)(ws + WS_EB);
    const float* pleg = F.in[27]; const float* fing = F.in[28];
    f32x4 pg[4], fg[4];
#pragma unroll
    for (int j = 0; j < 4; ++j) { pg[j] = ((const f32x4*)pleg)[F.lane + 64 * j]; fg[j] = ((const f32x4*)fing)[F.lane + 64 * j]; }
    for (int r0 = F.gw * 2; r0 < MP + MS; r0 += F.NGW * 2) {
        f32x4 x[2][4]; u32x2 g[2][4], e[2][4], xb[2][4]; float* xrow[2]; const bf16_t* X1B = (const bf16_t*)(ws + WS_X1B);
#pragma unroll
        for (int q = 0; q < 2; ++q) { const int r = r0 + q; xrow[q] = r < MP ? F.out + O_Y + (size_t)r * DM : F.out + O_YS + (size_t)(r - MP) * DM;
#pragma unroll
            for (int j = 0; j < 4; ++j) { xb[q][j] = __builtin_nontemporal_load((const u32x2*)(X1B + (size_t)r * DM) + F.lane + 64 * j); g[q][j] = __builtin_nontemporal_load((const u32x2*)(GB + (size_t)r * DM) + F.lane + 64 * j); e[q][j] = __builtin_nontemporal_load((const u32x2*)(EB + (size_t)r * DM) + F.lane + 64 * j); } }
#pragma unroll
        for (int q = 0; q < 2; ++q) { float s = 0.f; f32x4 ev[4];
#pragma unroll
            for (int j = 0; j < 4; ++j) { x[q][j] = (f32x4){bf_lo(xb[q][j].x), bf_hi(xb[q][j].x), bf_lo(xb[q][j].y), bf_hi(xb[q][j].y)}; ev[j] = (f32x4){bf_lo(e[q][j].x), bf_hi(e[q][j].x), bf_lo(e[q][j].y), bf_hi(e[q][j].y)}; s += (ev[j][0] * ev[j][0] + ev[j][1] * ev[j][1]) + (ev[j][2] * ev[j][2] + ev[j][3] * ev[j][3]); }
            s = wave_sum(s); const float rse = 1.0f / sqrtf(s * (1.f / DM) + EPS); float s2 = 0.f;
#pragma unroll
            for (int j = 0; j < 4; ++j) { const f32x4 gv = (f32x4){bf_lo(g[q][j].x), bf_hi(g[q][j].x), bf_lo(g[q][j].y), bf_hi(g[q][j].y)};
                x[q][j] = x[q][j] + gv * (ev[j] * rse * pg[j]); s2 += (x[q][j][0] * x[q][j][0] + x[q][j][1] * x[q][j][1]) + (x[q][j][2] * x[q][j][2] + x[q][j][3] * x[q][j][3]); }
            s2 = wave_sum(s2); const float rs2 = 1.0f / sqrtf(s2 * (1.f / DM) + EPS);
#pragma unroll
            for (int j = 0; j < 4; ++j) __builtin_nontemporal_store(x[q][j] * rs2 * fg[j], (f32x4*)xrow[q] + F.lane + 64 * j); }
    }
}
#define MAKE_CTX() extern __shared__ __attribute__((aligned(16))) unsigned char lds_raw[]; \
    Ctx F; F.lds = (LAS unsigned char*)lds_raw; F.tid = threadIdx.x; F.lane = F.tid & 63; F.wave = __builtin_amdgcn_readfirstlane(F.tid >> 6); \
    F.G = gridDim.x; F.bid = blockIdx.x; F.gw = F.bid * 8 + F.wave; F.NGW = F.G * 8; F.in = args.in; F.out = args.out; F.ws = args.ws; unsigned char* ws = args.ws; (void)ws

template <int KIND> struct EpiBf16Act {
    static constexpr bool PERM = false, AFTER_DRAIN = false;
    bf16_t* O; int ldo; const float* bias; float scale;
    __device__ __forceinline__ void operator()(const f32x4 (&acc)[2][2][4][2], const Unit& u, int wr, int wc, int fr, int fq) const {
        const int row0 = u.pm * 256 + wr * 64 + fr, col0 = u.pn * 256 + wc * 32 + 4 * fq;
        f32x4 bv[2][2];
#pragma unroll
        for (int bj = 0; bj < 2; ++bj)
#pragma unroll
            for (int n = 0; n < 2; ++n) bv[bj][n] = bias ? *(const f32x4*)(bias + col0 + bj * 128 + 16 * n) : (f32x4){0.f, 0.f, 0.f, 0.f};
#pragma unroll
        for (int ai = 0; ai < 2; ++ai)
#pragma unroll
            for (int m = 0; m < 4; ++m) { bf16_t* rowp = O + (size_t)(row0 + ai * 128 + m * 16) * ldo + col0;
#pragma unroll
                for (int bj = 0; bj < 2; ++bj)
#pragma unroll
                    for (int n = 0; n < 2; ++n) { f32x4 v = acc[ai][bj][m][n] * scale + bv[bj][n];
                        if (KIND == 3) {
#pragma unroll
                            for (int j = 0; j < 4; ++j) v[j] = sigmoidf_(v[j]); }
                        u32x2 w; w.x = cvt_pk_bf16(v[0], v[1]); w.y = cvt_pk_bf16(v[2], v[3]); *(u32x2*)(rowp + bj * 128 + n * 16) = w; } }
    }
};
struct EpiOutProj {
    static constexpr bool PERM = false, AFTER_DRAIN = false;
    const float* xp; const float* xs; float* out; bf16_t* X1B;
    __device__ __forceinline__ void operator()(const f32x4 (&acc)[2][2][4][2], const Unit& u, int wr, int wc, int fr, int fq) const {
        const int row0 = u.pm * 256 + wr * 64 + fr, col0 = u.pn * 256 + wc * 32 + 4 * fq;
#pragma unroll
        for (int ai = 0; ai < 2; ++ai) { f32x4 xv[4][2][2];
#pragma unroll
            for (int m = 0; m < 4; ++m) { const int row = row0 + ai * 128 + m * 16; const bool real = row < MP + MS; const float* xr = row < MP ? xp + (size_t)row * DM : xs + (size_t)(real ? row - MP : 0) * DM;
#pragma unroll
                for (int bj = 0; bj < 2; ++bj)
#pragma unroll
                    for (int n = 0; n < 2; ++n) xv[m][bj][n] = __builtin_nontemporal_load((const f32x4*)(xr + col0 + bj * 128 + n * 16)); }
#pragma unroll
            for (int m = 0; m < 4; ++m) { const int row = row0 + ai * 128 + m * 16; const bool real = row < MP + MS;
#pragma unroll
                for (int bj = 0; bj < 2; ++bj)
#pragma unroll
                    for (int n = 0; n < 2; ++n) { const int c = col0 + bj * 128 + n * 16; f32x4 v = acc[ai][bj][m][n];
                        if (real) v = v + xv[m][bj][n]; else v = (f32x4){0.f, 0.f, 0.f, 0.f};
                        u32x2 w; w.x = cvt_pk_bf16(v[0], v[1]); w.y = cvt_pk_bf16(v[2], v[3]); *(u32x2*)(X1B + (size_t)row * DM + c) = w; } } }
    }
};

struct EpiInProjNP {
    static constexpr bool PERM = false, AFTER_DRAIN = false;
    bf16_t* PA; bf16_t* PB; const float* rs; bf16_t* XB2;
    __device__ __forceinline__ void operator()(const f32x4 (&acc)[2][2][4][2], const Unit& u, int wr, int wc, int fr, int fq) const {
        const int row0 = u.pm * 256 + wr * 64 + fr, pn = u.pn; const int col0 = wc * 32 + 4 * fq;
        const int kind = pn < 8 ? 0 : ((pn < 12 || pn >= 20) ? 1 : (pn < 16 ? 2 : 3));
        bf16_t* base = pn < 12 ? PA + pn * 256 : (kind == 2 ? XB2 + (pn - 12) * 256 : PB + (pn - 12) * 256); const int pitch = kind == 2 ? DM : 3072;
        float rsv[2][4];
#pragma unroll
        for (int ai = 0; ai < 2; ++ai)
#pragma unroll
            for (int m = 0; m < 4; ++m) rsv[ai][m] = rs[row0 + ai * 128 + m * 16];
#pragma unroll
        for (int ai = 0; ai < 2; ++ai)
#pragma unroll
            for (int m = 0; m < 4; ++m) { const int row = row0 + ai * 128 + m * 16; const float s = rsv[ai][m];
#pragma unroll
                for (int bj = 0; bj < 2; ++bj)
#pragma unroll
                    for (int n = 0; n < 2; ++n) { f32x4 v = acc[ai][bj][m][n] * s;
                        if (kind == 0) { const f32x2 ga = gelu_pk((f32x2){v[0], v[1]}), gb = gelu_pk((f32x2){v[2], v[3]}); v = (f32x4){ga.x, ga.y, gb.x, gb.y}; }
                        else {
#pragma unroll
                        for (int j = 0; j < 4; ++j) { float x = v[j]; if (kind == 1) x = siluf_(x); else if (kind == 3) x = sigmoidf_(x); v[j] = x; } }
                        u32x2 w; w.x = cvt_pk_bf16(v[0], v[1]); w.y = cvt_pk_bf16(v[2], v[3]); *(u32x2*)(base + (size_t)row * pitch + col0 + bj * 128 + n * 16) = w; } }
    }
};
__device__ __forceinline__ void p1_inproj(const Ctx& F) {
    unsigned char* ws = F.ws; Gemm g{DM, DM, DM};
    OrderXcd S{64, 24, 64 * 24, F.G, F.bid, (const char*)(ws + WS_XB), (const char*)(ws + WS_WIN), (size_t)256 * DM * 2, (size_t)256 * DM * 2};
    EpiInProjNP E{(bf16_t*)(ws + WS_PROJA), (bf16_t*)(ws + WS_PROJB), (const float*)(ws + WS_RS), (bf16_t*)(ws + WS_XB2)};
    pg8::gemm_phase<EpiInProjNP, OrderXcd>(F.lds, g, S, E);
}
__device__ __forceinline__ void p7_outproj(const Ctx& F) {
    unsigned char* ws = F.ws; Gemm g{DMIX, DMIX, DMIX};
    OrderPanel4 S{64 * 4, F.G, F.bid, (const char*)(ws + WS_Y), (const char*)(ws + WS_WOUT), (size_t)256 * DMIX * 2, (size_t)256 * DMIX * 2};
    EpiOutProj E{F.in[0], F.in[1], F.out, (bf16_t*)(ws + WS_X1B)};
    pg8::gemm_phase<EpiOutProj, OrderPanel4>(F.lds, g, S, E);
}
__device__ __forceinline__ void p8_ple(const Ctx& F) {
    unsigned char* ws = F.ws;
    { Gemm g{DM, DM, DM}; OrderPanel4 S{NTILE * 4, F.G, F.bid, (const char*)(ws + WS_X1B), (const char*)(ws + WS_WPG), (size_t)256 * DM * 2, (size_t)256 * DM * 2};
      EpiBf16Act<3> E{(bf16_t*)(ws + WS_GB), DM, F.in[25], 1.0f}; pg8::gemm_phase<EpiBf16Act<3>, OrderPanel4>(F.lds, g, S, E); }
    { Gemm g{DPLE, DPLE, DPLE}; OrderProjSkip S{F.G, F.bid, (const char*)(ws + WS_PB), (const char*)(ws + WS_WPP), (size_t)256 * DPLE * 2, (size_t)256 * DPLE * 2};
      EpiBf16Act<0> E{(bf16_t*)(ws + WS_EB), DM, nullptr, 1.0f}; pg8::gemm_phase<EpiBf16Act<0>, OrderProjSkip>(F.lds, g, S, E); }
}
typedef float f32x4_t __attribute__((ext_vector_type(4)));
__device__ __forceinline__ void p2b_spatial_units(const Ctx& F0) { Ctx F = F0; asm volatile("" : "+v"(F.tid), "+v"(F.lane), "+s"(F.gw));
    unsigned char* ws = F.ws;
    const bf16_t* PA = (const bf16_t*)(ws + WS_PROJA); const bf16_t* WSP = (const bf16_t*)(ws + WS_WSP); bf16_t* Y = (bf16_t*)(ws + WS_Y);
    const float* lng = F.in[10]; const float* lnb = F.in[11]; const float* bsp = F.in[13];
    LAS bf16_t* vnT = (LAS bf16_t*)F.lds;
    const int lane = F.lane, w = F.wave, l15 = lane & 15, lq = lane >> 4;
    unsigned wav[8], wbv[8];
    auto load_v = [&](int unit) { const int b = unit >> 7, c = (unit >> 3) & 15, h = unit & 7, r0 = b * SEQ + c * 128;
#pragma unroll
        for (int p = 0; p < 8; ++p) { const int s0 = w * 16 + 2 * p; wav[p] = *(const unsigned*)(PA + (size_t)(r0 + s0) * 3072 + 1024 + h * 128 + 2 * lane); wbv[p] = *(const unsigned*)(PA + (size_t)(r0 + s0 + 1) * 3072 + 1024 + h * 128 + 2 * lane); } };
    if (F.bid < NB * 16 * HA) load_v(F.bid);
    for (int unit = F.bid; unit < NB * 16 * HA; unit += F.G) {
        const int b = unit >> 7, c = (unit >> 3) & 15, h = unit & 7, r0 = b * SEQ + c * 128;
        const float g0 = lng[h * 128 + 2 * lane], g1 = lng[h * 128 + 2 * lane + 1], b0 = lnb[h * 128 + 2 * lane], b1 = lnb[h * 128 + 2 * lane + 1];
        const int t0 = 16 * w, nks = (t0 + 15) / 32 + 1;
        bf16x8 wfr[4];
#pragma unroll
        for (int ks = 0; ks < 4; ++ks) wfr[ks] = *(const bf16x8*)(WSP + ((size_t)h * 128 + t0 + l15) * 128 + ks * 32 + 8 * lq);
        const int t = t0 + l15; const float bt = bsp[h * 128 + t]; const size_t row = (size_t)(r0 + t);
        u32x2 uuv[8], zzv[8];
#pragma unroll
        for (int nb = 0; nb < 8; ++nb) { const int d = nb * 16 + 4 * lq; uuv[nb] = *(const u32x2*)(PA + row * 3072 + h * 128 + d); zzv[nb] = *(const u32x2*)(PA + row * 3072 + 2048 + h * 128 + d); }
#pragma unroll
        for (int p = 0; p < 8; ++p) { const int s0 = w * 16 + 2 * p; const unsigned wa = wav[p], wb = wbv[p];
            float a0 = bf_lo(wa), a1 = bf_hi(wa), c0 = bf_lo(wb), c1 = bf_hi(wb);
            const float mua = wave_sum(a0 + a1) * (1.f / 128.f), mub = wave_sum(c0 + c1) * (1.f / 128.f);
            a0 -= mua; a1 -= mua; c0 -= mub; c1 -= mub;
            const float ra = 1.0f / sqrtf(wave_sum(a0 * a0 + a1 * a1) * (1.f / 128.f) + EPS), rb = 1.0f / sqrtf(wave_sum(c0 * c0 + c1 * c1) * (1.f / 128.f) + EPS);
            *(LAS unsigned*)(vnT + (2 * lane) * 136 + s0) = cvt_pk_bf16(a0 * ra * g0 + b0, c0 * rb * g0 + b0);
            *(LAS unsigned*)(vnT + (2 * lane + 1) * 136 + s0) = cvt_pk_bf16(a1 * ra * g1 + b1, c1 * rb * g1 + b1); }
        __syncthreads();
        if (unit + F.G < NB * 16 * HA) load_v(unit + F.G);
        f32x4 acc[8];
#pragma unroll
        for (int nb = 0; nb < 8; ++nb) acc[nb] = (f32x4){0.f, 0.f, 0.f, 0.f};
#pragma unroll
        for (int ks = 0; ks < 4; ++ks) { if (ks < nks) { const int k0 = ks * 32;
#pragma unroll
            for (int nb = 0; nb < 8; ++nb) { const bf16x8 vf = *(const LAS bf16x8*)(vnT + (nb * 16 + l15) * 136 + k0 + 8 * lq);
                acc[nb] = __builtin_amdgcn_mfma_f32_16x16x32_bf16(vf, wfr[ks], acc[nb], 0, 0, 0); } } }
#pragma unroll
        for (int nb = 0; nb < 8; ++nb) { const int d = nb * 16 + 4 * lq; const u32x2 uu = uuv[nb], zz = zzv[nb];
            u32x2 o; o.x = cvt_pk_bf16(bf_lo(uu.x) * (acc[nb][0] + bt) * bf_lo(zz.x), bf_hi(uu.x) * (acc[nb][1] + bt) * bf_hi(zz.x));
            o.y = cvt_pk_bf16(bf_lo(uu.y) * (acc[nb][2] + bt) * bf_lo(zz.y), bf_hi(uu.y) * (acc[nb][3] + bt) * bf_hi(zz.y));
            *(u32x2*)(Y + row * DMIX + h * 128 + d) = o; }
        __syncthreads();
    }
}
__device__ __forceinline__ void p2b_mscan(const Ctx& F) { if (F.bid < 32 && F.wave == 0) mscan_wave(F, F.bid); }

struct OrderQK {
    int G, c; const char* ws;
    __device__ __forceinline__ bool next(int i, Unit& u) const { const int L = i * G + c; if (L >= 512) return false; const char* XC = ws + WS_XB; const char* WQ = ws + WS_WQ; const char* WK = ws + WS_WK;
        const int kind = L >> 8, l = L & 255; u.pm = l >> 2; u.pn = kind; u.aux = l & 3; u.a = XC + (size_t)u.pm * (256 * DM * 2) + (size_t)u.aux * 512; u.b = (kind ? WK : WQ) + (size_t)u.aux * 131072; return true; }
};
struct EpiQK {
    static constexpr bool PERM = false, AFTER_DRAIN = false;
    bf16_t* K; bf16_t* PQ; const float* DG;
    __device__ __forceinline__ void operator()(const f32x4 (&acc)[2][2][4][2], const Unit& u, int wr, int wc, int fr, int fq) const {
        const int h = u.aux, rl0 = wr * 64 + fr, col0 = wc * 32 + 4 * fq; const bool isk = u.pn != 0;
        const int unit = ((u.pm >> 3) * 4 + h) * 8 + (u.pm & 7);
        float gv[2][4];
#pragma unroll
        for (int ai = 0; ai < 2; ++ai)
#pragma unroll
            for (int m = 0; m < 4; ++m) gv[ai][m] = isk ? 0.0625f : DG[(size_t)h * MA + u.pm * 256 + rl0 + ai * 128 + m * 16];
        bf16_t* base = isk ? K + (size_t)u.pm * 256 * 1024 + h * 256 : PQ + (size_t)unit * 256 * 512 + 256; const int ldo = isk ? 1024 : 512;
#pragma unroll
        for (int ai = 0; ai < 2; ++ai)
#pragma unroll
            for (int m = 0; m < 4; ++m) { const int rl = rl0 + ai * 128 + m * 16; const float g = gv[ai][m];
#pragma unroll
                for (int bj = 0; bj < 2; ++bj)
#pragma unroll
                    for (int n = 0; n < 2; ++n) { const int c = col0 + bj * 128 + n * 16; const f32x4 v = acc[ai][bj][m][n] * g;
                        u32x2 w; w.x = cvt_pk_bf16(v[0], v[1]); w.y = cvt_pk_bf16(v[2], v[3]); *(u32x2*)(base + (size_t)rl * ldo + c) = w; }
                asm volatile("" ::: "memory"); }
    }
};
struct OrderS12 {
    int G, c; const char* ws;
    __device__ __forceinline__ bool next(int i, Unit& u) const { const int L = i * G + c; if (L >= 12) return false; const char* XC = ws + WS_XB; const char* XB2 = ws + WS_XB2; const char* WQ = ws + WS_WQ; const char* WK = ws + WS_WK; const char* WV = ws + WS_WV;
        const int kind = L >> 2; u.pm = 64; u.pn = kind; u.aux = L & 3; u.a = (kind == 2 ? XB2 : XC) + (size_t)64 * (256 * DM * 2) + (size_t)u.aux * 512; u.b = (kind == 0 ? WQ : kind == 1 ? WK : WV) + (size_t)u.aux * 131072; return true; }
};
struct EpiS12 {
    static constexpr bool PERM = false, AFTER_DRAIN = false;
    bf16_t* Q; bf16_t* K; bf16_t* Vs;
    __device__ __forceinline__ void operator()(const f32x4 (&acc)[2][2][4][2], const Unit& u, int wr, int wc, int fr, int fq) const {
        const int h = u.aux, kind = u.pn; bf16_t* O = kind == 0 ? Q + (size_t)MP * 1024 : kind == 1 ? K + (size_t)MP * 1024 : Vs; const float sc = kind == 1 ? 0.0625f : 1.0f;
        const int row0 = wr * 64 + fr, col0 = h * 256 + wc * 32 + 4 * fq;
#pragma unroll
        for (int m = 0; m < 4; ++m) { bf16_t* rowp = O + (size_t)(row0 + m * 16) * 1024 + col0;
#pragma unroll
            for (int bj = 0; bj < 2; ++bj)
#pragma unroll
                for (int n = 0; n < 2; ++n) { const f32x4 v = acc[0][bj][m][n] * sc; u32x2 w; w.x = cvt_pk_bf16(v[0], v[1]); w.y = cvt_pk_bf16(v[2], v[3]); *(u32x2*)(rowp + bj * 128 + n * 16) = w; } }
    }
};
struct OrderVW {
    int G, c; const char* ws;
    __device__ __forceinline__ bool next(int i, Unit& u) const { const int L = i * G + c; if (L >= 512) return false; const char* XC = ws + WS_XB; const char* XB2 = ws + WS_XB2; const char* WK = ws + WS_WK; const char* WV = ws + WS_WV;
        const int kind = L >> 8, l = L & 255, b = l >> 5, h = (l >> 3) & 3, cc = l & 7; u.pm = b * 8 + cc; u.pn = l | (kind << 8); u.aux = h;
        u.a = (kind ? WK : WV) + (size_t)h * 131072; u.b = (kind ? XC : XB2) + (size_t)u.pm * (256 * DM * 2) + (size_t)h * 512; return true; }
};
struct EpiVW {
    static constexpr bool PERM = false, AFTER_DRAIN = false;
    bf16_t* VC; bf16_t* WKT; const float* DW; float* DNP;
    __device__ __forceinline__ void operator()(const f32x4 (&acc)[2][2][4][2], const Unit& u, int wr, int wc, int fr, int fq) const {
        const int h = u.aux, kind = u.pn >> 8, l = u.pn & 255, rl0 = wr * 64 + fr, col0 = wc * 32 + 4 * fq; const int ldo = kind ? 256 : 512; bf16_t* base = (kind ? WKT : VC) + (size_t)l * 256 * ldo;
        f32x4 scq[2][2];
#pragma unroll
        for (int bj = 0; bj < 2; ++bj)
#pragma unroll
            for (int n = 0; n < 2; ++n) scq[bj][n] = kind ? *(const f32x4*)(DW + (size_t)h * MA + u.pm * 256 + col0 + bj * 128 + n * 16) * 0.0625f : (f32x4){1.f, 1.f, 1.f, 1.f};
#pragma unroll
        for (int ai = 0; ai < 2; ++ai)
#pragma unroll
            for (int m = 0; m < 4; ++m) { bf16_t* rowp = base + (size_t)(rl0 + ai * 128 + m * 16) * ldo + col0; float rsum = 0.f;
#pragma unroll
                for (int bj = 0; bj < 2; ++bj)
#pragma unroll
                    for (int n = 0; n < 2; ++n) { const f32x4 v = acc[ai][bj][m][n] * scq[bj][n]; u32x2 w; w.x = cvt_pk_bf16(v[0], v[1]); w.y = cvt_pk_bf16(v[2], v[3]); *(u32x2*)(rowp + bj * 128 + n * 16) = w;
                        rsum += (bf_lo(w.x) + bf_hi(w.x)) + (bf_lo(w.y) + bf_hi(w.y)); }
                if (kind) { rsum += __shfl_xor(rsum, 16); rsum += __shfl_xor(rsum, 32); if (fq == 0) DNP[((size_t)l * 256 + rl0 + ai * 128 + m * 16) * 4 + wc] = rsum; }
                asm volatile("" ::: "memory"); }
    }
};
__device__ __forceinline__ void p3_qkv(const Ctx& F) {
    unsigned char* ws = F.ws;
    { Gemm g{DM, 256, 256}; OrderQK S{F.G, F.bid, (const char*)ws}; EpiQK E{(bf16_t*)(ws + WS_K), (bf16_t*)(ws + WS_PQ), (const float*)(ws + WS_DG)};
      pg8::gemm_phase<EpiQK, OrderQK>(F.lds, g, S, E); }
    { Gemm g{256, DM, 256}; OrderVW S{F.G, F.bid, (const char*)ws}; EpiVW E{(bf16_t*)(ws + WS_VC), (bf16_t*)(ws + WS_WKT), (const float*)(ws + WS_DW), (float*)(ws + WS_DN4)};
      pg8::gemm_phase<EpiVW, OrderVW>(F.lds, g, S, E); }
}

__device__ __forceinline__ void p3_s12(const Ctx& F) {
    unsigned char* ws = F.ws;
    { Gemm g{DM, 256, 256}; OrderS12 S{F.G, (F.bid - 32) & 255, (const char*)ws}; EpiS12 E{(bf16_t*)(ws + WS_Q), (bf16_t*)(ws + WS_K), (bf16_t*)(ws + WS_VS)};
      pg8::gemm_phase<EpiS12, OrderS12>(F.lds, g, S, E); }
}
struct OrderUnitNT {
    int n, G, c; const char* A; size_t astep_pm, astep_h, astep_u; const char* B; size_t bstep_pm, bstep_h, bstep_u;
    __device__ __forceinline__ bool next(int i, Unit& u) const { const int L = i * G + c; if (L >= n) return false;
        const int b = L >> 5, h = (L >> 3) & 3, cc = L & 7; u.pm = b * 8 + cc; u.pn = L; u.aux = h;
        u.a = A + (size_t)u.pm * astep_pm + (size_t)h * astep_h + (size_t)L * astep_u; u.b = B + (size_t)u.pm * bstep_pm + (size_t)h * bstep_h + (size_t)L * bstep_u; return true; }
};
struct EpiScore {
    static constexpr bool PERM = false, AFTER_DRAIN = false;
    bf16_t* PQ; const float* DA; const float* DR; float* DENP;
    __device__ __forceinline__ void operator()(const f32x4 (&acc)[2][2][4][2], const Unit& u, int wr, int wc, int fr, int fq) const {
        const int h = u.aux, rl0 = wr * 64 + fr, col0 = wc * 32 + 4 * fq; const size_t vb = (size_t)h * MA + (size_t)u.pm * 256;
        float atv[2][4]; f32x4 rrv[2][2];
#pragma unroll
        for (int ai = 0; ai < 2; ++ai)
#pragma unroll
            for (int m = 0; m < 4; ++m) atv[ai][m] = DA[vb + rl0 + ai * 128 + m * 16];
#pragma unroll
        for (int bj = 0; bj < 2; ++bj)
#pragma unroll
            for (int n = 0; n < 2; ++n) rrv[bj][n] = *(const f32x4*)(DR + vb + col0 + bj * 128 + n * 16);
#pragma unroll
        for (int ai = 0; ai < 2; ++ai)
#pragma unroll
            for (int m = 0; m < 4; ++m) { int t_ = rl0 + ai * 128 + m * 16; asm volatile("" : "+v"(t_)); const int t = t_; const float at = atv[ai][m]; float rs_ = 0.f; bf16_t* rowp = PQ + ((size_t)u.pn * 256 + t) * 512 + col0;
#pragma unroll
                for (int bj = 0; bj < 2; ++bj)
#pragma unroll
                    for (int n = 0; n < 2; ++n) { const int c = col0 + bj * 128 + n * 16; f32x4 v; const f32x4 rr = rrv[bj][n];
#pragma unroll
                        for (int j = 0; j < 4; ++j) { const float e = fast_exp(fminf(at + rr[j], 60.f)); v[j] = (c + j <= t) ? acc[ai][bj][m][n][j] * e : 0.f; rs_ += v[j]; }
                        u32x2 w; w.x = cvt_pk_bf16(v[0], v[1]); w.y = cvt_pk_bf16(v[2], v[3]); *(u32x2*)(rowp + bj * 128 + n * 16) = w; }
                rs_ += __shfl_xor(rs_, 16); rs_ += __shfl_xor(rs_, 32);
                if (fq == 0) DENP[(vb + t) * 4 + wc] = rs_; asm volatile("" ::: "memory"); }
    }
};
struct EpiF32Unit {
    static constexpr bool PERM = false, AFTER_DRAIN = false;
    bf16_t* O;
    __device__ __forceinline__ void operator()(const f32x4 (&acc)[2][2][4][2], const Unit& u, int wr, int wc, int fr, int fq) const {
        bf16_t* base = O + (size_t)u.pn * 65536 + (size_t)(wr * 64 + fr) * 256 + wc * 32 + 4 * fq;
#pragma unroll
        for (int ai = 0; ai < 2; ++ai)
#pragma unroll
            for (int m = 0; m < 4; ++m)
#pragma unroll
                for (int bj = 0; bj < 2; ++bj)
#pragma unroll
                    for (int n = 0; n < 2; ++n) { const f32x4 v = acc[ai][bj][m][n]; u32x2 w; w.x = cvt_pk_bf16(v[0], v[1]); w.y = cvt_pk_bf16(v[2], v[3]); *(u32x2*)(base + (size_t)(ai * 128 + m * 16) * 256 + bj * 128 + n * 16) = w; }
    }
};
__device__ __forceinline__ void p4_scores_dc(const Ctx& F) {
    unsigned char* ws = F.ws;
    { Gemm g{512, DM, 256}; OrderUnitNT S{NUNIT, F.G, F.bid, (const char*)(ws + WS_PQ) + 512, 0, 0, (size_t)256 * 512 * 2, (const char*)(ws + WS_K), (size_t)256 * DM * 2, 512, 0};
      EpiScore E{(bf16_t*)(ws + WS_PQ), (const float*)(ws + WS_DA), (const float*)(ws + WS_DR), (float*)(ws + WS_DENP)}; pg8::gemm_phase<EpiScore, OrderUnitNT>(F.lds, g, S, E); }
    { Gemm g{512, 256, 256}; OrderUnitNT S{NUNIT, F.G, F.bid, (const char*)(ws + WS_VC), 0, 0, (size_t)256 * 512 * 2, (const char*)(ws + WS_WKT), 0, 0, (size_t)256 * 256 * 2};
      EpiF32Unit E{(bf16_t*)(F.out + O_Y)}; pg8::gemm_phase<EpiF32Unit, OrderUnitNT>(F.lds, g, S, E); }
}

__device__ __forceinline__ void p5_scan_sample(const Ctx& F0) { Ctx F = F0; asm volatile("" : "+v"(F.tid), "+v"(F.lane), "+s"(F.gw));
    unsigned char* ws = F.ws; const float* DG = (const float*)(ws + WS_DG); const bf16_t* DCb = (const bf16_t*)(F.out + O_Y); bf16_t* VC = (bf16_t*)(ws + WS_VC);
    for (int idx = F.bid * 512 + F.tid; idx < 32 * 16384; idx += F.G * 512) { const int bh = idx >> 14, q4 = idx & 16383, e = q4 >> 6, d4 = (q4 & 63) * 4, b = bh >> 2, h = bh & 3;
        f32x4 dc[8]; float ge[8];
#pragma unroll
        for (int c = 0; c < 8; ++c) { const u32x2 dw = __builtin_nontemporal_load((const u32x2*)(DCb + ((size_t)(bh * 8 + c) * 256 + e) * 256 + d4)); dc[c] = (f32x4){bf_lo(dw.x), bf_hi(dw.x), bf_lo(dw.y), bf_hi(dw.y)}; ge[c] = DG[(size_t)h * MA + b * SEQ + c * 256 + 255]; }
        f32x4 C = (f32x4){0.f, 0.f, 0.f, 0.f};
#pragma unroll
        for (int c = 0; c < 8; ++c) { u32x2 w; w.x = cvt_pk_bf16(C[0], C[1]); w.y = cvt_pk_bf16(C[2], C[3]); *(u32x2*)(VC + ((size_t)(bh * 8 + c) * 256 + e) * 512 + 256 + d4) = w; C = C * ge[c] + dc[c]; }
        __builtin_nontemporal_store(C, (f32x4*)(F.out + O_CP + ((size_t)bh * 256 + e) * 256 + d4)); }
    LAS float* npv = (LAS float*)F.lds;
    for (int u = F.bid; u < NUNIT; u += F.G) { const int bh = u >> 3, cc = u & 7, b = bh >> 2, h = bh & 3;
        __syncthreads();
        if (F.tid < 256) { float n = 0.f; const float* DN = (const float*)(ws + WS_DN4);
            for (int j = 0; j < cc; ++j) { const f32x4 dp = *(const f32x4*)(DN + ((size_t)(bh * 8 + j) * 256 + F.tid) * 4); n = DG[(size_t)h * MA + b * SEQ + j * 256 + 255] * n + ((dp[0] + dp[1]) + (dp[2] + dp[3])); }
            npv[F.tid] = n; const f32x4 dl = *(const f32x4*)(DN + ((size_t)u * 256 + F.tid) * 4); if (cc == 7) F.out[O_NP + (size_t)bh * 256 + F.tid] = DG[(size_t)h * MA + b * SEQ + 7 * 256 + 255] * n + ((dl[0] + dl[1]) + (dl[2] + dl[3])); }
        __syncthreads();
        const f32x4 nv = *(const LAS f32x4*)(npv + 4 * F.lane); const bf16_t* PQg = (const bf16_t*)(ws + WS_PQ);
        for (int r = 0; r < 32; ++r) { const size_t row = (size_t)b * SEQ + cc * 256 + F.wave * 32 + r; const u32x2 qq = *(const u32x2*)(PQg + ((size_t)u * 256 + F.wave * 32 + r) * 512 + 256 + 4 * F.lane);
            const float s = wave_sum(bf_lo(qq.x) * nv[0] + bf_hi(qq.x) * nv[1] + bf_lo(qq.y) * nv[2] + bf_hi(qq.y) * nv[3]); if (F.lane == 0) ((float*)(ws + WS_QN))[(size_t)h * MA + row] = s; } }

}


__device__ __forceinline__ void p5s_sample(const Ctx& F0) { Ctx F = F0; asm volatile("" : "+v"(F.tid), "+v"(F.lane), "+s"(F.gw));
    unsigned char* ws = F.ws;
    LAS float* hs = (LAS float*)F.lds + 512; LAS float* red = (LAS float*)F.lds + 1024;
    for (int job = F.bid; job < MS * HB; job += F.G) { const int i = job >> 2, h = job & 3; const size_t row = MP + i;
        const bf16_t* Q = (const bf16_t*)(ws + WS_Q) + row * 1024 + h * 256; const bf16_t* K = (const bf16_t*)(ws + WS_K) + row * 1024 + h * 256; const bf16_t* V = (const bf16_t*)(ws + WS_VS) + (size_t)i * 1024 + h * 256;
        const u32x2 qw = *(const u32x2*)(Q + 4 * F.lane), kw = *(const u32x2*)(K + 4 * F.lane);
        const f32x4 q4 = (f32x4){bf_lo(qw.x), bf_hi(qw.x), bf_lo(qw.y), bf_hi(qw.y)}, k4 = (f32x4){bf_lo(kw.x), bf_hi(kw.x), bf_lo(kw.y), bf_hi(kw.y)};
        const f32x4 n0 = *(const f32x4*)(F.in[3] + ((size_t)i * 4 + h) * 256 + 4 * F.lane);
        const float li = ((const float*)(ws + WS_GLI))[(size_t)h * MA + row], lf = ((const float*)(ws + WS_GLF))[(size_t)h * MA + row], m0 = F.in[4][i * 4 + h];
        const float mn = fmaxf(lf + m0, li), g = __expf(lf + m0 - mn), wi = __expf(li - mn);
        const float qk = wave_sum(q4[0] * k4[0] + q4[1] * k4[1] + q4[2] * k4[2] + q4[3] * k4[3]), nq = wave_sum(n0[0] * q4[0] + n0[1] * q4[1] + n0[2] * q4[2] + n0[3] * q4[3]);
        const float sc = wi * qk, den = sc + g * nq, dinv = 1.0f / fmaxf(fabsf(den), __expf(-mn));
        const float* C0 = F.in[2] + (((size_t)i * 4 + h) * 256 + F.wave * 32) * 256 + 4 * F.lane; float* C1 = F.out + O_CS + (((size_t)i * 4 + h) * 256 + F.wave * 32) * 256 + 4 * F.lane;
        __syncthreads();
#pragma unroll 1
        for (int r8 = 0; r8 < 32; r8 += 8) { f32x4 c[8]; float ve[8], cq[8];
#pragma unroll
            for (int r = 0; r < 8; ++r) { c[r] = __builtin_nontemporal_load((const f32x4*)(C0 + (size_t)(r8 + r) * 256)); ve[r] = bf2f(V[F.wave * 32 + r8 + r]); }
#pragma unroll
            for (int r = 0; r < 8; ++r) { cq[r] = c[r][0] * q4[0] + c[r][1] * q4[1] + c[r][2] * q4[2] + c[r][3] * q4[3]; const float wv = wi * ve[r]; __builtin_nontemporal_store(c[r] * g + k4 * wv, (f32x4*)(C1 + (size_t)(r8 + r) * 256)); }
#pragma unroll
            for (int r = 0; r < 8; ++r) { cq[r] = wave_sum(cq[r]); if (F.lane == 0) hs[F.wave * 32 + r8 + r] = (sc * ve[r] + g * cq[r]) * dinv; } }
        if (F.wave == 0) { *(f32x4*)(F.out + O_NS + ((size_t)i * 4 + h) * 256 + 4 * F.lane) = n0 * g + k4 * wi; if (F.lane == 0) F.out[O_MS + i * 4 + h] = mn; }
        __syncthreads();
        const bf16_t* PB = (const bf16_t*)(ws + WS_PROJB) + row * 3072; const bf16_t* XC = (const bf16_t*)(ws + WS_XB) + row * DM;
        float x = 0.f; const int ch = h * 256 + (F.tid & 255);
        if (F.tid < 256) x = hs[F.tid] * bf2f(PB[1024 + ch]);
        float p = wave_sum(x); if (F.lane == 0) red[F.wave] = p;
        __syncthreads();
        const float mu = (red[0] + red[1] + red[2] + red[3]) * (1.f / 256.f), dx = x - mu;
        __syncthreads();
        p = wave_sum(F.tid < 256 ? dx * dx : 0.f); if (F.lane == 0) red[F.wave] = p;
        __syncthreads();
        const float rstd = 1.0f / sqrtf((red[0] + red[1] + red[2] + red[3]) * (1.f / 256.f) + EPS);
        if (F.tid < 256) ((bf16_t*)(ws + WS_Y))[row * DMIX + 1024 + ch] = f2bf((dx * rstd * F.in[21][ch] + F.in[22][ch] * bf2f(XC[ch])) * bf2f(PB[2048 + ch]));
        __syncthreads();
    }
}
struct EpiHOut {
    static constexpr bool PERM = false, AFTER_DRAIN = true;
    const float* DENP; const float* DG; const float* QN; const float* DEM; const bf16_t* PB; const bf16_t* XC; bf16_t* Y; const float* gng; const float* skip;
    __device__ __forceinline__ void fused(f32x4 (&acc)[2][2][4][2], const Unit& u, int wr, int wc, int fr, int fq, LAS unsigned char* lds, int wid, int lane) const {
        const int h = u.aux, rl0 = wr * 64 + fr, col0 = wc * 32 + 4 * fq; const size_t vb = (size_t)h * MA + (size_t)u.pm * 256;
        LAS float* P1 = (LAS float*)lds; LAS float* P2 = (LAS float*)lds + 1024;
#pragma unroll
        for (int ai = 0; ai < 2; ++ai) { u32x2 ow[4][2][2]; f32x4 dp[4]; float dgq[4], dem[4];
#pragma unroll
            for (int m = 0; m < 4; ++m) { const int t = rl0 + ai * 128 + m * 16; const size_t row = (size_t)u.pm * 256 + t; dp[m] = *(const f32x4*)(DENP + (vb + t) * 4); dgq[m] = QN[vb + t]; dem[m] = DEM[vb + t];
#pragma unroll
                for (int bj = 0; bj < 2; ++bj)
#pragma unroll
                    for (int n = 0; n < 2; ++n) ow[m][bj][n] = *(const u32x2*)(PB + row * 3072 + 1024 + h * 256 + col0 + bj * 128 + n * 16); }
#pragma unroll
            for (int m = 0; m < 4; ++m) { const int t = rl0 + ai * 128 + m * 16; const float den = (dp[m][0] + dp[m][1]) + (dp[m][2] + dp[m][3]) + dgq[m];
                const float dinv = 1.0f / fmaxf(fabsf(den), dem[m]); float s = 0.f;
#pragma unroll
                for (int bj = 0; bj < 2; ++bj)
#pragma unroll
                    for (int n = 0; n < 2; ++n) { const u32x2 o2 = ow[m][bj][n];
                        f32x4 v = acc[ai][bj][m][n] * dinv; v[0] *= bf_lo(o2.x); v[1] *= bf_hi(o2.x); v[2] *= bf_lo(o2.y); v[3] *= bf_hi(o2.y); acc[ai][bj][m][n] = v; s += (v[0] + v[1]) + (v[2] + v[3]); }
                s += __shfl_xor(s, 16); s += __shfl_xor(s, 32); if (fq == 0) P1[t * 4 + wc] = s; } }
        asm volatile("s_waitcnt lgkmcnt(0)" ::: "memory"); __builtin_amdgcn_s_barrier(); asm volatile("" ::: "memory");
#pragma unroll
        for (int ai = 0; ai < 2; ++ai)
#pragma unroll
            for (int m = 0; m < 4; ++m) { const int t = rl0 + ai * 128 + m * 16; const f32x4 ps = *(const LAS f32x4*)(P1 + t * 4); const float mu = ((ps[0] + ps[1]) + (ps[2] + ps[3])) * (1.f / 256.f); float q = 0.f;
#pragma unroll
                for (int bj = 0; bj < 2; ++bj)
#pragma unroll
                    for (int n = 0; n < 2; ++n) { f32x4 v = acc[ai][bj][m][n] - mu; acc[ai][bj][m][n] = v; q += (v[0] * v[0] + v[1] * v[1]) + (v[2] * v[2] + v[3] * v[3]); }
                q += __shfl_xor(q, 16); q += __shfl_xor(q, 32); if (fq == 0) P2[t * 4 + wc] = q; }
        asm volatile("s_waitcnt lgkmcnt(0)" ::: "memory"); __builtin_amdgcn_s_barrier(); asm volatile("" ::: "memory");
#pragma unroll
        for (int ai = 0; ai < 2; ++ai) { u32x2 xw[4][2][2], zw[4][2][2];
#pragma unroll
            for (int m = 0; m < 4; ++m) { const int t = rl0 + ai * 128 + m * 16; const size_t row = (size_t)u.pm * 256 + t;
#pragma unroll
                for (int bj = 0; bj < 2; ++bj)
#pragma unroll
                    for (int n = 0; n < 2; ++n) { const int c = h * 256 + col0 + bj * 128 + n * 16; xw[m][bj][n] = *(const u32x2*)(XC + row * DM + c); zw[m][bj][n] = *(const u32x2*)(PB + row * 3072 + 2048 + c); } }
#pragma unroll
            for (int m = 0; m < 4; ++m) { const int t = rl0 + ai * 128 + m * 16; const size_t row = (size_t)u.pm * 256 + t; const f32x4 ps = *(const LAS f32x4*)(P2 + t * 4);
                const float rstd = 1.0f / sqrtf(((ps[0] + ps[1]) + (ps[2] + ps[3])) * (1.f / 256.f) + EPS);
#pragma unroll
                for (int bj = 0; bj < 2; ++bj)
#pragma unroll
                    for (int n = 0; n < 2; ++n) { const int c = h * 256 + col0 + bj * 128 + n * 16; const u32x2 x2 = xw[m][bj][n], z2 = zw[m][bj][n];
                        const f32x4 ggv = *(const f32x4*)(gng + c), skv = *(const f32x4*)(skip + c); const f32x4 v = acc[ai][bj][m][n] * rstd * ggv; u32x2 w;
                        w.x = cvt_pk_bf16((v[0] + skv[0] * bf_lo(x2.x)) * bf_lo(z2.x), (v[1] + skv[1] * bf_hi(x2.x)) * bf_hi(z2.x));
                        w.y = cvt_pk_bf16((v[2] + skv[2] * bf_lo(x2.y)) * bf_lo(z2.y), (v[3] + skv[3] * bf_hi(x2.y)) * bf_hi(z2.y));
                        *(u32x2*)(Y + row * DMIX + 1024 + c) = w; } } }
    }
};
__device__ __forceinline__ void p6_hout(const Ctx& F) {
    unsigned char* ws = F.ws; Gemm g{512, 512, 512};
    OrderUnitNT S{NUNIT, F.G, F.bid, (const char*)(ws + WS_PQ), 0, 0, (size_t)256 * 512 * 2, (const char*)(ws + WS_VC), 0, 0, (size_t)256 * 512 * 2};
    EpiHOut E{(const float*)(ws + WS_DENP), (const float*)(ws + WS_DG), (const float*)(ws + WS_QN), (const float*)(ws + WS_DEM), (const bf16_t*)(ws + WS_PROJB), (const bf16_t*)(ws + WS_XB), (bf16_t*)(ws + WS_Y), F.in[21], F.in[22]};
    pg8::gemm_phase<EpiHOut, OrderUnitNT, false, true>(F.lds, g, S, E);
}
template <class PtrF, class Ef>
__device__ __forceinline__ void sample_gemm(const Ctx& F, int nitems, int K, int lda, int ldb, const PtrF& P, const Ef& E) {
    int lane_ = F.lane; asm volatile("" : "+v"(lane_));
    const int l15 = lane_ & 15, lq = lane_ >> 4, w = F.wave;
    for (int item = F.bid; item < nitems; item += F.G) {
        const bf16_t* A; const bf16_t* B; P(item, A, B);
        const bf16_t* ap = A + (size_t)(16 * w + l15) * lda + 8 * lq; const bf16_t* bp = B + (size_t)l15 * ldb + 8 * lq;
        f32x4 acc = (f32x4){0.f, 0.f, 0.f, 0.f};
        for (int k0 = 0; k0 < K; k0 += 256) { bf16x8 a[8], b[8];
#pragma unroll
            for (int j = 0; j < 8; ++j) { a[j] = *(const bf16x8*)(ap + k0 + 32 * j); b[j] = *(const bf16x8*)(bp + k0 + 32 * j); }
#pragma unroll
            for (int j = 0; j < 8; ++j) acc = __builtin_amdgcn_mfma_f32_16x16x32_bf16(a[j], b[j], acc, 0, 0, 0); }
#pragma unroll
        for (int r = 0; r < 4; ++r) E(item, 16 * w + 4 * lq + r, l15, acc[r]);
    }
}
__device__ __forceinline__ void sample_inproj(const Ctx& F) {
    unsigned char* ws = F.ws; const bf16_t* XB = (const bf16_t*)(ws + WS_XB) + (size_t)MP * DM; const bf16_t* W = (const bf16_t*)(ws + WS_WIN);
    bf16_t* PA = (bf16_t*)(ws + WS_PROJA) + (size_t)MP * 3072; bf16_t* PB = (bf16_t*)(ws + WS_PROJB) + (size_t)MP * 3072; bf16_t* XB2 = (bf16_t*)(ws + WS_XB2) + (size_t)MP * DM; const float* rs = (const float*)(ws + WS_RS) + MP;
    sample_gemm(F, NIN / 16, DM, DM, DM,
        [=](int item, const bf16_t*& A, const bf16_t*& B) { A = XB; B = W + (size_t)item * 16 * DM; },
        [=](int item, int r, int c, float acc) { const int col = item * 16 + c, grp = col >> 10; float v = acc * rs[r];
            if (grp < 2) { const f32x2 g2 = gelu_pk((f32x2){v, v}); v = g2.x; } else if (grp == 2 || grp == 5) v = siluf_(v); else if (grp == 4) v = sigmoidf_(v);
            bf16_t* dst = col < 3072 ? PA + (size_t)r * 3072 + col : (col < 4096 ? XB2 + (size_t)r * DM + (col - 3072) : PB + (size_t)r * 3072 + (col - 3072)); *dst = f2bf(v); });
}
__device__ __forceinline__ void sample_qkv(const Ctx& F) {
    unsigned char* ws = F.ws; const bf16_t* XC = (const bf16_t*)(ws + WS_XB) + (size_t)MP * DM; const bf16_t* XBr = (const bf16_t*)(ws + WS_PROJB) + (size_t)MP * 3072;
    const bf16_t* WQ = (const bf16_t*)(ws + WS_WQ); const bf16_t* WK = (const bf16_t*)(ws + WS_WK); const bf16_t* WV = (const bf16_t*)(ws + WS_WV);
    bf16_t* Q = (bf16_t*)(ws + WS_Q) + (size_t)MP * 1024; bf16_t* Kk = (bf16_t*)(ws + WS_K) + (size_t)MP * 1024; bf16_t* Vs = (bf16_t*)(ws + WS_VS);
    sample_gemm(F, 128, 256, DM, 256,
        [=](int item, const bf16_t*& A, const bf16_t*& B) { const int which = item >> 6, it = item & 63, h = it >> 4; A = XC + h * 256; B = (which ? WK : WQ) + (size_t)h * 65536 + (size_t)(it & 15) * 16 * 256; },
        [=](int item, int r, int c, float acc) { const int which = item >> 6, it = item & 63; bf16_t* O = which ? Kk : Q; O[(size_t)r * 1024 + it * 16 + c] = f2bf(which ? acc * 0.0625f : acc); });
    sample_gemm(F, 64, 256, 3072, 256,
        [=](int item, const bf16_t*& A, const bf16_t*& B) { const int h = item >> 4; A = XBr + h * 256; B = WV + (size_t)h * 65536 + (size_t)(item & 15) * 16 * 256; },
        [=](int item, int r, int c, float acc) { Vs[(size_t)r * 1024 + item * 16 + c] = f2bf(acc); });
}
__device__ __forceinline__ void sample_outproj(const Ctx& F) {
    unsigned char* ws = F.ws; const bf16_t* Y = (const bf16_t*)(ws + WS_Y) + (size_t)MP * DMIX; const bf16_t* W = (const bf16_t*)(ws + WS_WOUT);
    const float* xs = F.in[1]; float* out = F.out + O_YS; bf16_t* X1B = (bf16_t*)(ws + WS_X1B) + (size_t)MP * DM;
    sample_gemm(F, DM / 16, DMIX, DMIX, DMIX,
        [=](int item, const bf16_t*& A, const bf16_t*& B) { A = Y; B = W + (size_t)item * 16 * DMIX; },
        [=](int item, int r, int c, float acc) { const int col = item * 16 + c; const float v = xs[(size_t)r * DM + col] + acc; out[(size_t)r * DM + col] = v; X1B[(size_t)r * DM + col] = f2bf(v); });
}
__device__ __forceinline__ void sample_ple(const Ctx& F) {
    unsigned char* ws = F.ws; const bf16_t* X1B = (const bf16_t*)(ws + WS_X1B) + (size_t)MP * DM; const bf16_t* PBs = (const bf16_t*)(ws + WS_PB) + (size_t)MP * DPLE;
    const bf16_t* WG = (const bf16_t*)(ws + WS_WPG); const bf16_t* WP = (const bf16_t*)(ws + WS_WPP); const float* bias = F.in[25];
    bf16_t* GB = (bf16_t*)(ws + WS_GB) + (size_t)MP * DM; bf16_t* EB = (bf16_t*)(ws + WS_EB) + (size_t)MP * DM;
    sample_gemm(F, DM / 16, DM, DM, DM,
        [=](int item, const bf16_t*& A, const bf16_t*& B) { A = X1B; B = WG + (size_t)item * 16 * DM; },
        [=](int item, int r, int c, float acc) { const int col = item * 16 + c; GB[(size_t)r * DM + col] = f2bf(sigmoidf_(acc + bias[col])); });
    sample_gemm(F, DM / 16, DPLE, DPLE, DPLE,
        [=](int item, const bf16_t*& A, const bf16_t*& B) { A = PBs; B = WP + (size_t)item * 16 * DPLE; },
        [=](int item, int r, int c, float acc) { EB[(size_t)r * DM + item * 16 + c] = f2bf(acc); });
}
template <class PtrF, class Ef>
__device__ __forceinline__ void sample_gemm_ks(const Ctx& F, int nitems, int K, int lda, int ldb, const PtrF& P, const Ef& E) {
    int lane_ = F.lane; asm volatile("" : "+v"(lane_)); const int l15 = lane_ & 15, lq = lane_ >> 4, w = F.wave; LAS f32x4* red = (LAS f32x4*)F.lds;
    const int ks = K >> 3;
    for (int item = F.bid; item < nitems; item += F.G) {
        const bf16_t* A; const bf16_t* B; P(item, A, B);
        const bf16_t* ap = A + (size_t)l15 * lda + w * ks + 8 * lq; const bf16_t* bp = B + (size_t)l15 * ldb + w * ks + 8 * lq;
        f32x4 acc[2][4];
#pragma unroll
        for (int m = 0; m < 2; ++m)
#pragma unroll
            for (int n = 0; n < 4; ++n) acc[m][n] = (f32x4){0.f, 0.f, 0.f, 0.f};
        for (int k0 = 0; k0 < ks; k0 += 128) { bf16x8 a[4][2], b[4][4];
#pragma unroll
            for (int j = 0; j < 4; ++j) {
#pragma unroll
                for (int m = 0; m < 2; ++m) a[j][m] = (k0 + 32 * j < ks) ? *(const bf16x8*)(ap + (size_t)(16 * m) * lda + k0 + 32 * j) : (bf16x8){0, 0, 0, 0, 0, 0, 0, 0};
#pragma unroll
                for (int n = 0; n < 4; ++n) b[j][n] = (k0 + 32 * j < ks) ? *(const bf16x8*)(bp + (size_t)(16 * n) * ldb + k0 + 32 * j) : (bf16x8){0, 0, 0, 0, 0, 0, 0, 0}; }
#pragma unroll
            for (int j = 0; j < 4; ++j)
#pragma unroll
                for (int m = 0; m < 2; ++m)
#pragma unroll
                    for (int n = 0; n < 4; ++n) acc[m][n] = __builtin_amdgcn_mfma_f32_16x16x32_bf16(a[j][m], b[j][n], acc[m][n], 0, 0, 0); }
        __syncthreads();
#pragma unroll
        for (int m = 0; m < 2; ++m)
#pragma unroll
            for (int n = 0; n < 4; ++n) red[(w * 8 + m * 4 + n) * 64 + F.lane] = acc[m][n];
        __syncthreads();
        f32x4 s = red[(0 * 8 + w) * 64 + F.lane];
#pragma unroll
        for (int ww = 1; ww < 8; ++ww) s = s + red[(ww * 8 + w) * 64 + F.lane];
        const int mt = w >> 2, nt = w & 3;
#pragma unroll
        for (int r = 0; r < 4; ++r) E(item, 16 * mt + 4 * lq + r, 16 * nt + l15, s[r]);
    }
    __syncthreads();
}
__device__ __forceinline__ void sample_outproj_ks(const Ctx& F) {
    unsigned char* ws = F.ws; const bf16_t* Y = (const bf16_t*)(ws + WS_Y) + (size_t)MP * DMIX; const bf16_t* W = (const bf16_t*)(ws + WS_WOUT);
    const float* xs = F.in[1]; float* out = F.out + O_YS; bf16_t* X1B = (bf16_t*)(ws + WS_X1B) + (size_t)MP * DM;
    sample_gemm_ks(F, 64, DMIX, DMIX, DMIX,
        [=](int item, const bf16_t*& A, const bf16_t*& B) { A = Y + (size_t)(item & 3) * 32 * DMIX; B = W + (size_t)(item >> 2) * 64 * DMIX; },
        [=](int item, int r, int c, float acc) { const int row = (item & 3) * 32 + r, col = (item >> 2) * 64 + c; const float v = xs[(size_t)row * DM + col] + acc; X1B[(size_t)row * DM + col] = f2bf(v); });
}
__device__ __forceinline__ void sample_ple_ks(const Ctx& F) {
    unsigned char* ws = F.ws; const bf16_t* X1B = (const bf16_t*)(ws + WS_X1B) + (size_t)MP * DM; const bf16_t* PBs = (const bf16_t*)(ws + WS_PB) + (size_t)MP * DPLE;
    const bf16_t* WG = (const bf16_t*)(ws + WS_WPG); const bf16_t* WP = (const bf16_t*)(ws + WS_WPP); const float* bias = F.in[25];
    bf16_t* GB = (bf16_t*)(ws + WS_GB) + (size_t)MP * DM; bf16_t* EB = (bf16_t*)(ws + WS_EB) + (size_t)MP * DM;
    sample_gemm_ks(F, 64, DM, DM, DM,
        [=](int item, const bf16_t*& A, const bf16_t*& B) { A = X1B + (size_t)(item & 3) * 32 * DM; B = WG + (size_t)(item >> 2) * 64 * DM; },
        [=](int item, int r, int c, float acc) { const int row = (item & 3) * 32 + r, col = (item >> 2) * 64 + c; GB[(size_t)row * DM + col] = f2bf(sigmoidf_(acc + bias[col])); });
    sample_gemm_ks(F, 64, DPLE, DPLE, DPLE,
        [=](int item, const bf16_t*& A, const bf16_t*& B) { A = PBs + (size_t)(item & 3) * 32 * DPLE; B = WP + (size_t)(item >> 2) * 64 * DPLE; },
        [=](int item, int r, int c, float acc) { const int row = (item & 3) * 32 + r, col = (item >> 2) * 64 + c; EB[(size_t)row * DM + col] = f2bf(acc); });
}
#define XB_TMO      128
#define XB_XCNT(j)  (256  + 64 * (j))
#define XB_XSUB(j)  (1280 + 64 * (j))
#define XB_XGEN(j)  (2304 + 64 * (j))
#define XB_TOP      3328
#define XB_TOPGEN   3392
#define XCD_BAR_WORDS 3456
#define XB_SPIN_CAP (1u << 18)
__device__ __forceinline__ unsigned xb_ld(unsigned* p)              { return __hip_atomic_load(p, __ATOMIC_RELAXED, __HIP_MEMORY_SCOPE_AGENT); }
__device__ __forceinline__ unsigned xb_add(unsigned* p, unsigned v) { return __hip_atomic_fetch_add(p, v, __ATOMIC_RELAXED, __HIP_MEMORY_SCOPE_AGENT); }
__device__ __forceinline__ unsigned xb_xcc_id() { return (unsigned)__builtin_amdgcn_s_getreg((3 << 11) | 20) & 0xFu; }
#define XB_SPIN(cond, bar) do { unsigned _sp = 0; while (cond) { __builtin_amdgcn_s_sleep(1); \
    if ((++_sp & 255u) == 0u) { if (xb_ld(&(bar)[XB_TMO])) break; if (_sp > XB_SPIN_CAP) { atomicAdd(&(bar)[XB_TMO], 1u); break; } } } } while (0)
struct XcdBarrier { unsigned* bar; unsigned x; volatile LAS unsigned* st; };
__device__ __forceinline__ XcdBarrier xcd_barrier_post(unsigned* bar, volatile LAS unsigned* st) {
    XcdBarrier b; b.bar = bar; b.x = xb_xcc_id(); b.st = st;
    if (threadIdx.x == 0) (void)xb_add(&bar[XB_XCNT(b.x)], 1u);
    return b;
}
__device__ __forceinline__ void xcd_barrier_complete(unsigned* bar, unsigned x, unsigned& nloc, unsigned& nx) {
    const unsigned G = gridDim.x * gridDim.y * gridDim.z;
    unsigned sum, cnt, mine, sp = 0u;
    for (;;) {
        sum = 0u; cnt = 0u; mine = 0u;
#pragma unroll
        for (unsigned j = 0; j < 16; ++j) { const unsigned c = xb_ld(&bar[XB_XCNT(j)]); sum += c; cnt += (c > 0u) ? 1u : 0u; mine = (j == x) ? c : mine; }
        if (sum == G) break;
        __builtin_amdgcn_s_sleep(1);
        if ((++sp & 255u) == 0u) { if (xb_ld(&bar[XB_TMO])) break; if (sp > XB_SPIN_CAP) { atomicAdd(&bar[XB_TMO], 1u); break; } }
    }
    nloc = mine > 0u ? mine : 1u; nx = cnt > 0u ? cnt : 1u;
}
__device__ __forceinline__ void xcd_barrier(const XcdBarrier& b) {
    asm volatile("s_waitcnt vmcnt(0)" ::: "memory");
    __syncthreads();
    if (threadIdx.x == 0) {
        unsigned* bar = b.bar;
        __builtin_amdgcn_s_waitcnt(0);
        unsigned nloc = b.st[0], nx = b.st[1];
        if (nloc == 0u) { xcd_barrier_complete(bar, b.x, nloc, nx); b.st[0] = nloc; b.st[1] = nx; }
        const unsigned old = xb_add(&bar[XB_XSUB(b.x)], 1u);
        const unsigned gen = old / nloc;
        if (old + 1u == (gen + 1u) * nloc) {
            __builtin_amdgcn_fence(__ATOMIC_RELEASE, "agent");
            asm volatile("s_waitcnt vmcnt(0)" ::: "memory");
            const unsigned og = xb_add(&bar[XB_TOP], 1u);
            const unsigned tg = og / nx;
            if (og + 1u == (tg + 1u) * nx) xb_add(&bar[XB_TOPGEN], 1u);
            else XB_SPIN(xb_ld(&bar[XB_TOPGEN]) == tg, bar);
            __builtin_amdgcn_fence(__ATOMIC_ACQUIRE, "agent");
            xb_add(&bar[XB_XGEN(b.x)], 1u);
            asm volatile("s_waitcnt vmcnt(0)" ::: "memory");
        } else {
            XB_SPIN(xb_ld(&bar[XB_XGEN(b.x)]) == gen, bar);
            __builtin_amdgcn_fence(__ATOMIC_ACQUIRE, "agent");
            asm volatile("s_waitcnt vmcnt(0)" ::: "memory");
        }
    }
    __syncthreads();
}
__global__ void __launch_bounds__(512, 2) mega(Args args) {
    MAKE_CTX();
    volatile LAS unsigned* MISC = (volatile LAS unsigned*)(F.lds + 131072 + 320);
    if (F.tid < 32) MISC[F.tid] = 0u;
    __syncthreads();
    const XcdBarrier bar = xcd_barrier_post((unsigned*)(ws + WS_CTL), MISC + 8);
#define GRID_SYNC() xcd_barrier(bar)
    p0_prologue(F);      GRID_SYNC();
    sample_inproj(F); p1_inproj(F); GRID_SYNC();
    p2a_conv_gates(F); p2b_spatial_units(F); GRID_SYNC();
    p2b_mscan(F); p3_s12(F); p2c_sample_rows(F); GRID_SYNC();
    p3_qkv(F);           GRID_SYNC();
    if (F.bid & 1) { p5s_sample(F); p4_scores_dc(F); } else { p4_scores_dc(F); p5s_sample(F); } GRID_SYNC();
    p5_scan_sample(F);   GRID_SYNC();
    p6_hout(F);          GRID_SYNC();
    sample_outproj_ks(F); p7_outproj(F); GRID_SYNC();
    p8_ple(F);           GRID_SYNC();
    p9_final(F);
}

extern "C" void kernel_launch(void* const* d_in, const int* in_sizes, int n_in, void* d_out, int out_size, void* d_ws, size_t ws_size, hipStream_t stream) {
    static int grid = 0;
    if (grid == 0) {
        if (n_in != 29 || (size_t)out_size != O_END || ws_size < WS_END) { fprintf(stderr, "kernel_launch: unexpected shapes (n_in %d out %d ws %zu)\n", n_in, out_size, ws_size); grid = -1; return; }
        int dev = 0, cus = 0, per_cu = 0;
        if (hipGetDevice(&dev) != hipSuccess || hipDeviceGetAttribute(&cus, hipDeviceAttributeMultiprocessorCount, dev) != hipSuccess) { grid = -1; return; }
        if (hipFuncSetAttribute((const void*)mega, hipFuncAttributeMaxDynamicSharedMemorySize, LDS_BYTES) != hipSuccess) { fprintf(stderr, "kernel_launch: hipFuncSetAttribute failed\n"); grid = -1; return; }
        if (hipOccupancyMaxActiveBlocksPerMultiprocessor(&per_cu, (const void*)mega, 512, LDS_BYTES) != hipSuccess || per_cu < 1) { fprintf(stderr, "kernel_launch: occupancy query says %d\n", per_cu); grid = -1; return; }
        (void)hipGetLastError();
        grid = cus;
        if (grid != 256) { fprintf(stderr, "kernel_launch: this kernel is laid out for 256 CUs, got %d\n", grid); grid = -1; return; }
    }
    if (grid < 0) return;
    if (hipMemsetAsync((unsigned char*)d_ws + WS_CTL, 0, 16384, stream) != hipSuccess) { fprintf(stderr, "kernel_launch: memset failed\n"); return; }
    Args a{};
    for (int i = 0; i < 29; ++i) a.in[i] = (const float*)d_in[i];
    a.out = (float*)d_out; a.ws = (unsigned char*)d_ws;
    void* kargs[] = {&a};
    hipError_t e = hipLaunchCooperativeKernel((const void*)mega, dim3(grid), dim3(512), kargs, LDS_BYTES, stream);
    if (e != hipSuccess) fprintf(stderr, "kernel_launch: cooperative launch failed: %s (grid %d)\n", hipGetErrorString(e), grid);
}
```

```cpp
#include <hip/hip_runtime.h>
#include <hip/hip_cooperative_groups.h>
#include <cstdio>
#include <cstdint>
namespace cg = cooperative_groups;

#define LAS __attribute__((address_space(3)))
typedef unsigned short bf16_t;
typedef short bf16x8 __attribute__((ext_vector_type(8)));
typedef float f32x4 __attribute__((ext_vector_type(4)));
typedef float f32x2 __attribute__((ext_vector_type(2)));
typedef unsigned u32x4 __attribute__((ext_vector_type(4)));
typedef unsigned u32x2 __attribute__((ext_vector_type(2)));

constexpr int DM = 1024, SEQ = 2048, NB = 8, MP = NB * SEQ, MS = 128, MA = MP + 256, NTILE = MA / 256;
constexpr int NIN = 6144, WA = 1024, WB = 1024, HA = 8, DHA = 128, HB = 4, DHB = 256, DPLE = 256, DMIX = 2048;
constexpr int LC = 256, NCH = SEQ / LC;
constexpr int NUNIT = NB * HB * NCH;
constexpr float EPS = 1e-6f;

constexpr size_t O_Y = 0, O_YS = 16777216, O_CP = 16908288, O_NP = 19005440, O_MP = 19013632, O_CVP = 19013664, O_CS = 19038240, O_NS = 52592672, O_MS = 52723744, O_CVS = 52724256, O_VS = 53117472, O_END = 53248544;

constexpr size_t MiB = 1u << 20;
constexpr size_t WS_CTL = 0, WS_WIN = 1 * MiB, WS_WQ = 13 * MiB, WS_WK = WS_WQ + MiB / 2, WS_WV = 14 * MiB, WS_WOUT = WS_WV + MiB / 2, WS_WPG = WS_WOUT + 4 * MiB, WS_WPP = WS_WPG + 2 * MiB,
    WS_WSP = 21 * MiB, WS_WG = WS_WSP + MiB / 4, WS_RS = WS_WG + MiB / 4, WS_GLI = 22 * MiB, WS_GLF = WS_GLI + MiB / 2, WS_DA = 23 * MiB, WS_DR = WS_DA + MiB / 2, WS_DG = 24 * MiB, WS_DEM = WS_DG + MiB / 2,
    WS_DW = 25 * MiB, WS_QN = WS_DW + MiB / 2, WS_DENP = 26 * MiB, WS_DN = 27 * MiB, WS_VS = WS_DN + MiB / 2, WS_PB = 28 * MiB, WS_XB = 37 * MiB, WS_PROJA = 70 * MiB, WS_PROJB = 168 * MiB,
    WS_PQ = 266 * MiB, WS_VC = 330 * MiB, WS_Y = 394 * MiB, WS_XB2 = 460 * MiB, WS_DN4 = 493 * MiB, WS_END = 495 * MiB;
constexpr size_t WS_WGB = WS_RS + MiB / 8;
constexpr size_t WS_Q = WS_PROJA, WS_K = WS_Q + 33 * MiB, WS_WKT = WS_K + 33 * MiB;
constexpr size_t WS_X1B = WS_PROJA, WS_GB = WS_X1B + 33 * MiB, WS_EB = WS_GB + 33 * MiB;
static_assert(WS_WKT + 32 * MiB <= WS_PROJB && WS_EB + 33 * MiB <= WS_PQ, "ws map");

__device__ __forceinline__ unsigned cvt_pk_bf16(float lo, float hi) { unsigned r; asm volatile("v_cvt_pk_bf16_f32 %0, %1, %2" : "=v"(r) : "v"(lo), "v"(hi)); return r; }
__device__ __forceinline__ float bf_lo(unsigned w) { return __uint_as_float(w << 16); }
__device__ __forceinline__ float bf_hi(unsigned w) { return __uint_as_float(w & 0xffff0000u); }
__device__ __forceinline__ float bf2f(bf16_t b) { return __uint_as_float(((unsigned)b) << 16); }
__device__ __forceinline__ bf16_t f2bf(float f) { return (bf16_t)(cvt_pk_bf16(f, 0.f) & 0xffffu); }
__device__ __forceinline__ float fast_exp(float x) { return __builtin_amdgcn_exp2f(x * 1.4426950408889634f); }
__device__ __forceinline__ float sigmoidf_(float x) { return __builtin_amdgcn_rcpf(1.0f + fast_exp(-x)); }
__device__ __forceinline__ float siluf_(float x) { return x * sigmoidf_(x); }
__device__ __forceinline__ f32x2 gelu_pk(f32x2 v) {
    const f32x2 av = __builtin_elementwise_abs(v), d = av * 0.2316418882f + 1.0f;
    f32x2 t; t.x = __builtin_amdgcn_rcpf(d.x); t.y = __builtin_amdgcn_rcpf(d.y);
    f32x2 q = t * 0.5307027145f + (-0.7265760135f); q = q * t + 0.7107068705f; q = q * t + (-0.142248368f); q = q * t + 0.127414796f; q = q * t;
    const f32x2 s = (v * v) * (-0.72134752044f);
    f32x2 e; e.x = __builtin_amdgcn_exp2f(s.x); e.y = __builtin_amdgcn_exp2f(s.y);
    const f32x2 m = v * (q * e), r = v - m;
    f32x2 o; o.x = v.x < 0.f ? m.x : r.x; o.y = v.y < 0.f ? m.y : r.y; return o;
}
__device__ __forceinline__ float dpp_add(float v, const int ctrl_sel) {
    const int iv = __builtin_bit_cast(int, v); int r;
    if (ctrl_sel == 0) r = __builtin_amdgcn_update_dpp(0, iv, 0xB1, 0xF, 0xF, true);
    else if (ctrl_sel == 1) r = __builtin_amdgcn_update_dpp(0, iv, 0x4E, 0xF, 0xF, true);
    else if (ctrl_sel == 2) r = __builtin_amdgcn_update_dpp(0, iv, 0x141, 0xF, 0xF, true);
    else r = __builtin_amdgcn_update_dpp(0, iv, 0x140, 0xF, 0xF, true);
    return v + __builtin_bit_cast(float, r);
}
__device__ __forceinline__ float wave_sum(float v) {
    v = dpp_add(v, 0); v = dpp_add(v, 1); v = dpp_add(v, 2); v = dpp_add(v, 3);
    const int iv = __builtin_bit_cast(int, v);
    const float r0 = __builtin_bit_cast(float, __builtin_amdgcn_readlane(iv, 0)), r1 = __builtin_bit_cast(float, __builtin_amdgcn_readlane(iv, 16)),
                r2 = __builtin_bit_cast(float, __builtin_amdgcn_readlane(iv, 32)), r3 = __builtin_bit_cast(float, __builtin_amdgcn_readlane(iv, 48));
    return (r0 + r1) + (r2 + r3);
}
#define LDS_WAIT() asm volatile("s_waitcnt lgkmcnt(0)" ::: "memory")

namespace pg8 {
constexpr int BM = 256, BK = 64, HALF = 128, HTB = HALF * BK * 2, STAGE_BYTES = 8 * HTB;
__host__ __device__ __forceinline__ int lds_byte(int r, int c) { const int st = (r >> 4) * 2 + (c >> 5), rr = r & 15, cc = c & 31, ob = rr * 64 + cc * 2; return st * 1024 + (ob ^ (((ob >> 9) & 1) << 5)); }
__host__ __device__ __forceinline__ void stage_rc(int b, int& R, int& C) { const int st = b / 1024, sb = b % 1024, swz = sb ^ (((sb >> 9) & 1) << 5); R = (st >> 1) * 16 + swz / 64; C = (st & 1) * 32 + (swz % 64) / 2; }
__host__ __device__ __forceinline__ int perm32(int rho) { const int n = rho >> 4, i = rho & 15; return 8 * (i >> 2) + 4 * n + (i & 3); }

struct Unit { const char* a; const char* b; int pm, pn, aux; };
struct Gemm { int lda, ldb, K; };

template <class Epi, class Sched, bool ALIGN_EPI = true, bool SP2 = true>
__device__ __forceinline__ void gemm_phase(LAS unsigned char* lds, const Gemm g, const Sched& S, const Epi& E) {
    int tid_ = threadIdx.x; asm volatile("" : "+v"(tid_));
    const int tid = tid_, wid = __builtin_amdgcn_readfirstlane(tid >> 6), lane = tid & 63, wr = wid >> 2, wc = wid & 3, fr = lane & 15, fq = lane >> 4;
    int K_ = g.K; asm volatile("" : "+s"(K_)); const int K = K_, nt = K / BK; (void)K;
    unsigned voffA[2], voffB[2];
#pragma unroll
    for (int i = 0; i < 2; ++i) { int R, C; stage_rc(tid * 16 + i * 8192, R, C); const int Rb = Epi::PERM ? ((R & ~31) + perm32(R & 31)) : R;
        voffA[i] = (unsigned)(R * g.lda + C) * 2u; voffB[i] = (unsigned)(Rb * g.ldb + C) * 2u; }
    const size_t kstep = (size_t)(BK * 2);
    const size_t hstepA = (size_t)HALF * g.lda * 2, hstepB = (size_t)HALF * g.ldb * 2;
    const unsigned ldsw = (unsigned)wid * 1024u;
    const int aoff = lds_byte(wr * 64 + fr, fq * 8), boff = lds_byte(wc * 32 + fr, fq * 8);
#define PG8_SA(b, h) (((b) * 2 + (h)) * HTB)
#define PG8_SB(b, h) ((4 + (b) * 2 + (h)) * HTB)
#define PG8_STAGE(bufoff, gbase, voff) do { _Pragma("unroll") for (int _i = 0; _i < 2; ++_i) \
        __builtin_amdgcn_global_load_lds((const unsigned*)((const char*)(gbase) + (voff)[_i]), (LAS unsigned*)(lds + (bufoff) + ldsw + _i * 8192), 16, 0, 0); } while (0)
#define PG8_LDA(dst, b, h) do { _Pragma("unroll") for (int m = 0; m < 4; ++m) _Pragma("unroll") for (int k = 0; k < 2; ++k) dst[m][k] = *(const LAS bf16x8*)(lds + PG8_SA(b, h) + aoff + m * 2048 + k * 1024); } while (0)
#define PG8_LDB(dst, b, h) do { _Pragma("unroll") for (int n = 0; n < 2; ++n) _Pragma("unroll") for (int k = 0; k < 2; ++k) dst[n][k] = *(const LAS bf16x8*)(lds + PG8_SB(b, h) + boff + n * 2048 + k * 1024); } while (0)
#define PG8_MMA(ai, bj, At, Bt) do { __builtin_amdgcn_s_setprio(1); _Pragma("unroll") for (int m = 0; m < 4; ++m) _Pragma("unroll") for (int n = 0; n < 2; ++n) _Pragma("unroll") for (int k = 0; k < 2; ++k) \
        acc[ai][bj][m][n] = __builtin_amdgcn_mfma_f32_16x16x32_bf16(Bt[n][k], At[m][k], acc[ai][bj][m][n], 0, 0, 0); __builtin_amdgcn_s_setprio(0); } while (0)
#define PG8_WAIT_V(n) asm volatile("s_waitcnt vmcnt(" #n ")" ::: "memory")
#define PG8_WAIT_L(n) asm volatile("s_waitcnt lgkmcnt(" #n ")" ::: "memory")
#define PG8_BAR __builtin_amdgcn_s_barrier()
#define PG8_SCHED __builtin_amdgcn_sched_barrier(0)
    Unit cur, nxt; int ui = 0;
    if (!S.next(0, cur)) return;
    f32x4 acc[2][2][4][2];
#pragma unroll
    for (int a = 0; a < 2; ++a)
#pragma unroll
        for (int b = 0; b < 2; ++b)
#pragma unroll
            for (int m = 0; m < 4; ++m)
#pragma unroll
                for (int n = 0; n < 2; ++n) acc[a][b][m][n] = (f32x4){0.f, 0.f, 0.f, 0.f};
    bf16x8 At[4][2], B0[2][2], B1[2][2];
    const char* cA = cur.a; const char* cB = cur.b;
    if constexpr (SP2) {
        PG8_STAGE(PG8_SB(0, 0), cB, voffB); PG8_STAGE(PG8_SB(0, 1), cB + hstepB, voffB); PG8_STAGE(PG8_SA(0, 0), cA, voffA); PG8_STAGE(PG8_SA(0, 1), cA + hstepA, voffA);
        if (wr == 1) PG8_BAR;
        PG8_WAIT_V(2); PG8_BAR;
        PG8_STAGE(PG8_SB(1, 0), cB + kstep, voffB); PG8_STAGE(PG8_SA(1, 0), cA + kstep, voffA); PG8_STAGE(PG8_SB(1, 1), cB + hstepB + kstep, voffB);
        PG8_WAIT_V(6); PG8_BAR;
    } else {
        PG8_STAGE(PG8_SB(0, 0), cB, voffB); PG8_STAGE(PG8_SA(0, 0), cA, voffA); PG8_STAGE(PG8_SB(0, 1), cB + hstepB, voffB); PG8_STAGE(PG8_SA(0, 1), cA + hstepA, voffA);
        if (wr == 1) PG8_BAR;
        PG8_WAIT_V(4); PG8_BAR;
        PG8_STAGE(PG8_SB(1, 0), cB + kstep, voffB); PG8_STAGE(PG8_SA(1, 0), cA + kstep, voffA); PG8_STAGE(PG8_SB(1, 1), cB + hstepB + kstep, voffB);
        PG8_WAIT_V(6); PG8_BAR;
    }
    for (;;) {
        const bool has_next = S.next(ui + 1, nxt);
        const char* nA = has_next ? nxt.a : cA; const char* nB = has_next ? nxt.b : cB;
#pragma unroll 1
        for (int t = 0; t < nt; t += 2) {
            const bool last = (t == nt - 2);
            const char* a1 = cA + (size_t)(t + 1) * kstep;
            const char* a2 = last ? nA : cA + (size_t)(t + 2) * kstep; const char* b2 = last ? nB : cB + (size_t)(t + 2) * kstep;
            const char* a3 = a2 + kstep; const char* b3 = b2 + kstep;
            if constexpr (SP2) {
            PG8_LDB(B0, 0, 0); PG8_LDB(B1, 0, 1); PG8_SCHED; PG8_LDA(At, 0, 0); PG8_STAGE(PG8_SA(1, 1), a1 + hstepA, voffA);
            PG8_WAIT_V(8); PG8_WAIT_L(0); PG8_BAR; PG8_MMA(0, 0, At, B0); PG8_MMA(0, 1, At, B1); PG8_BAR; PG8_SCHED;
            PG8_LDA(At, 0, 1); PG8_STAGE(PG8_SB(0, 0), b2, voffB); PG8_STAGE(PG8_SB(0, 1), b2 + hstepB, voffB); PG8_STAGE(PG8_SA(0, 0), a2, voffA);
            PG8_WAIT_V(8); PG8_WAIT_L(0); PG8_BAR; PG8_MMA(1, 0, At, B0); PG8_MMA(1, 1, At, B1); PG8_BAR; PG8_SCHED;
            PG8_LDB(B0, 1, 0); PG8_LDB(B1, 1, 1); PG8_SCHED; PG8_LDA(At, 1, 0); PG8_STAGE(PG8_SA(0, 1), a2 + hstepA, voffA);
            PG8_WAIT_V(8); PG8_WAIT_L(0); PG8_BAR; PG8_MMA(0, 0, At, B0); PG8_MMA(0, 1, At, B1); PG8_BAR; PG8_SCHED;
            PG8_LDA(At, 1, 1); PG8_STAGE(PG8_SB(1, 0), b3, voffB); PG8_STAGE(PG8_SB(1, 1), b3 + hstepB, voffB); PG8_STAGE(PG8_SA(1, 0), a3, voffA);
            PG8_WAIT_V(8); PG8_WAIT_L(0); PG8_BAR; PG8_MMA(1, 0, At, B0); PG8_MMA(1, 1, At, B1); PG8_BAR; PG8_SCHED;
            } else {
            PG8_LDB(B0, 0, 0); PG8_SCHED; PG8_LDA(At, 0, 0); PG8_STAGE(PG8_SA(1, 1), a1 + hstepA, voffA);
            PG8_WAIT_L(8); PG8_BAR; PG8_WAIT_L(0); PG8_MMA(0, 0, At, B0); PG8_BAR; PG8_SCHED;
            PG8_LDB(B1, 0, 1); PG8_STAGE(PG8_SB(0, 0), b2, voffB);
            PG8_BAR; PG8_WAIT_L(0); PG8_MMA(0, 1, At, B1); PG8_BAR;
            PG8_LDA(At, 0, 1); PG8_STAGE(PG8_SA(0, 0), a2, voffA);
            PG8_BAR; PG8_WAIT_L(0); PG8_MMA(1, 0, At, B0); PG8_BAR; PG8_SCHED;
            PG8_STAGE(PG8_SB(0, 1), b2 + hstepB, voffB);
            PG8_WAIT_V(6); PG8_BAR; PG8_MMA(1, 1, At, B1); PG8_BAR;
            PG8_LDB(B0, 1, 0); PG8_SCHED; PG8_LDA(At, 1, 0); PG8_STAGE(PG8_SA(0, 1), a2 + hstepA, voffA);
            PG8_WAIT_L(8); PG8_BAR; PG8_WAIT_L(0); PG8_MMA(0, 0, At, B0); PG8_BAR; PG8_SCHED;
            PG8_LDB(B1, 1, 1); PG8_STAGE(PG8_SB(1, 0), b3, voffB);
            PG8_BAR; PG8_WAIT_L(0); PG8_MMA(0, 1, At, B1); PG8_BAR;
            PG8_LDA(At, 1, 1); PG8_STAGE(PG8_SA(1, 0), a3, voffA);
            PG8_BAR; PG8_WAIT_L(0); PG8_MMA(1, 0, At, B0); PG8_BAR; PG8_SCHED;
            PG8_STAGE(PG8_SB(1, 1), b3 + hstepB, voffB);
            PG8_WAIT_V(6); PG8_BAR; PG8_MMA(1, 1, At, B1); PG8_BAR;
            }
        }
        if constexpr (ALIGN_EPI) { if (wr == 0) PG8_BAR; }
        if constexpr (!Epi::AFTER_DRAIN) { E(acc, cur, wr, wc, fr, fq); }
        if (!has_next) break;
#pragma unroll
        for (int a = 0; a < 2; ++a)
#pragma unroll
            for (int b = 0; b < 2; ++b)
#pragma unroll
                for (int m = 0; m < 4; ++m)
#pragma unroll
                    for (int n = 0; n < 2; ++n) acc[a][b][m][n] = (f32x4){0.f, 0.f, 0.f, 0.f};
        cur = nxt; cA = nA; cB = nB; ++ui;
        if constexpr (ALIGN_EPI) { if (wr == 1) PG8_BAR; }
    }
    PG8_WAIT_V(0);
    if constexpr (!ALIGN_EPI) { if (wr == 0) PG8_BAR; }
    PG8_BAR;
    if constexpr (Epi::AFTER_DRAIN) { E.fused(acc, cur, wr, wc, fr, fq, lds, wid, lane); }
#undef PG8_SA
#undef PG8_SB
#undef PG8_STAGE
#undef PG8_LDA
#undef PG8_LDB
#undef PG8_MMA
#undef PG8_WAIT_V
#undef PG8_WAIT_L
#undef PG8_BAR
#undef PG8_SCHED
}
}
using pg8::Unit; using pg8::Gemm;

constexpr int LDS_BYTES = 147456;
struct Args { const float* in[29]; float* out; unsigned char* ws; };

struct Ctx {
    LAS unsigned char* lds; int tid, lane, wave, G, bid, gw, NGW;
    const float* const* in; float* out; unsigned char* ws;
};

struct TDesc { const float* W; bf16_t* WT; const float* ksc; int ldw, ldt, k0, n0; };
constexpr int I_WIN = 16 * 192, I_QKV = 12 * 4 * 8, I_WOUT = 32 * 32, I_WPG = 16 * 32, I_WPP = 4 * 32, I_T = I_WIN + I_QKV + I_WOUT + I_WPG + I_WPP;
__device__ __forceinline__ TDesc p0_decode(const Ctx& F, int r) {
    unsigned char* ws = F.ws; TDesc d; d.ksc = nullptr;
    if (r < I_WIN) { d.W = F.in[9]; d.ldw = NIN; d.WT = (bf16_t*)(ws + WS_WIN); d.ldt = DM; d.ksc = F.in[8]; d.k0 = 64 * (r / 192); d.n0 = 32 * (r % 192); return d; } r -= I_WIN;
    if (r < I_QKV) { const int mat = r / 32, rr = r % 32, which = mat / 4, h = mat % 4;
        d.W = F.in[16 + which] + (size_t)h * 65536; d.WT = (bf16_t*)(ws + (which == 0 ? WS_WQ : which == 1 ? WS_WK : WS_WV)) + (size_t)h * 65536; d.ldw = 256; d.ldt = 256; d.k0 = 64 * (rr / 8); d.n0 = 32 * (rr % 8); return d; } r -= I_QKV;
    if (r < I_WOUT) { d.W = F.in[23]; d.ldw = DM; d.WT = (bf16_t*)(ws + WS_WOUT); d.ldt = DMIX; d.k0 = 64 * (r / 32); d.n0 = 32 * (r % 32); return d; } r -= I_WOUT;
    if (r < I_WPG) { d.W = F.in[24]; d.ldw = DM; d.WT = (bf16_t*)(ws + WS_WPG); d.ldt = DM; d.k0 = 64 * (r / 32); d.n0 = 32 * (r % 32); return d; } r -= I_WPG;
    d.W = F.in[26]; d.ldw = DM; d.WT = (bf16_t*)(ws + WS_WPP); d.ldt = DPLE; d.k0 = 64 * (r / 32); d.n0 = 32 * (r % 32); return d;
}

__device__ __forceinline__ void p0_prologue(const Ctx& F0) { Ctx F = F0; asm volatile("" : "+v"(F.tid), "+v"(F.lane), "+s"(F.gw));
    LAS float* scr = (LAS float*)(F.lds + F.wave * 16384);
    unsigned char* ws = F.ws; const int lane = F.lane;
    {
        float wv[3][32]; f32x4 ks[3][2]; TDesc td[3];
#pragma unroll
        for (int k = 0; k < 3; ++k) { const int it = F.gw + k * F.NGW;
            if (it < I_T) { td[k] = p0_decode(F, it); const int c = lane & 7;
#pragma unroll
                for (int i = 0; i < 32; ++i) { const int kk = 2 * i + (lane >> 5); wv[k][i] = __builtin_nontemporal_load(td[k].W + (size_t)(td[k].k0 + kk) * td[k].ldw + td[k].n0 + (lane & 31)); }
                if (td[k].ksc) { ks[k][0] = *(const f32x4*)(td[k].ksc + td[k].k0 + 8 * c); ks[k][1] = *(const f32x4*)(td[k].ksc + td[k].k0 + 8 * c + 4); }
                else { ks[k][0] = (f32x4){1.f, 1.f, 1.f, 1.f}; ks[k][1] = ks[k][0]; } } }
#pragma unroll
        for (int k = 0; k < 3; ++k) { const int it = F.gw + k * F.NGW;
            if (it < I_T) { const int c = lane & 7;
#pragma unroll
                for (int i = 0; i < 32; ++i) { const int kk = 2 * i + (lane >> 5); scr[kk * 33 + (lane & 31)] = wv[k][i]; }
                LDS_WAIT(); asm volatile("" ::: "memory");
#pragma unroll
                for (int j = 0; j < 4; ++j) { const int n = (lane >> 3) + 8 * j; const LAS float* s = scr + (8 * c) * 33 + n;
                    u32x4 o; o.x = cvt_pk_bf16(s[0 * 33] * ks[k][0][0], s[1 * 33] * ks[k][0][1]); o.y = cvt_pk_bf16(s[2 * 33] * ks[k][0][2], s[3 * 33] * ks[k][0][3]);
                    o.z = cvt_pk_bf16(s[4 * 33] * ks[k][1][0], s[5 * 33] * ks[k][1][1]); o.w = cvt_pk_bf16(s[6 * 33] * ks[k][1][2], s[7 * 33] * ks[k][1][3]);
                    *(u32x4*)(td[k].WT + (size_t)(td[k].n0 + n) * td[k].ldt + td[k].k0 + 8 * c) = o; }
                LDS_WAIT(); asm volatile("" ::: "memory"); } }
    }
    constexpr int I_SP = 1024, I_WG = 1024, I_YPAD = 128;
    for (int r = F.gw; r < I_SP + I_WG + I_YPAD; r += F.NGW) {
        if (r < I_SP) {
            const int t = r & 127; const float* wrow = F.in[12] + (size_t)r * 128; const f32x2 v = ((const f32x2*)wrow)[lane];
            const int s0 = 2 * lane; ((unsigned*)((bf16_t*)(ws + WS_WSP) + (size_t)r * 128))[lane] = cvt_pk_bf16(s0 <= t ? v.x : 0.f, s0 + 1 <= t ? v.y : 0.f);
            continue;
        }
        if (r < I_SP + I_WG) {
            const int i = r - I_SP, h = i >> 8, d = i & 255; const float* wif = F.in[19];
            const f32x4 wq4 = *(const f32x4*)(F.in[16] + ((size_t)h * 256 + d) * 256 + 4 * lane), wk4 = *(const f32x4*)(F.in[17] + ((size_t)h * 256 + d) * 256 + 4 * lane), wv4 = *(const f32x4*)(F.in[18] + ((size_t)h * 256 + d) * 256 + 4 * lane);
            float sx[8], sb[8];
#pragma unroll
            for (int j = 0; j < 8; ++j) { sx[j] = 0.f; sb[j] = 0.f; }
#pragma unroll
            for (int e = 0; e < 4; ++e) { const size_t rq = (size_t)(h * 256 + 4 * lane + e) * 8;
                const f32x4 q0 = *(const f32x4*)(wif + rq), q1 = *(const f32x4*)(wif + rq + 4), k0 = *(const f32x4*)(wif + 8192 + rq), k1 = *(const f32x4*)(wif + 8192 + rq + 4), v0 = *(const f32x4*)(wif + 16384 + rq), v1 = *(const f32x4*)(wif + 16384 + rq + 4);
#pragma unroll
                for (int j = 0; j < 4; ++j) { sx[j] += wq4[e] * q0[j] + wk4[e] * k0[j]; sx[4 + j] += wq4[e] * q1[j] + wk4[e] * k1[j]; sb[j] += wv4[e] * v0[j]; sb[4 + j] += wv4[e] * v1[j]; } }
#pragma unroll
            for (int j = 0; j < 8; ++j) { sx[j] = wave_sum(sx[j]); sb[j] = wave_sum(sb[j]); }
            float s = 0.f;
#pragma unroll
            for (int j = 0; j < 8; ++j) { s = (lane == j) ? sx[j] : s; s = (lane == 8 + j) ? sb[j] : s; }
            if (lane < 16) ((float*)(ws + WS_WG))[(size_t)i * 16 + lane] = s;
            if (lane < 16) { bf16_t* wgb = (bf16_t*)(ws + WS_WGB) + (size_t)(lane >> 3) * 16384 + (size_t)(lane & 7) * 1024 + i; wgb[0] = f2bf(s); wgb[8 * 1024] = 0; }
            continue;
        }
        {
            u32x4* yrow = (u32x4*)((bf16_t*)(ws + WS_Y) + (size_t)(MP + MS + (r - I_SP - I_WG)) * DMIX) + lane;
#pragma unroll
            for (int j = 0; j < 4; ++j) yrow[64 * j] = (u32x4){0u, 0u, 0u, 0u};
        }
    }
    {
        float* rs = (float*)(ws + WS_RS);
        const int r0 = F.gw * 8; const bool smp = F.gw < MS;
        f32x4 v[8][4], vs[4], pv[8], ps;
#pragma unroll
        for (int q = 0; q < 8; ++q) { const float* xrow = F.in[0] + (size_t)(r0 + q) * DM;
#pragma unroll
            for (int j = 0; j < 4; ++j) v[q][j] = __builtin_nontemporal_load((const f32x4*)xrow + lane + 64 * j); }
#pragma unroll
        for (int q = 0; q < 8; ++q) pv[q] = __builtin_nontemporal_load((const f32x4*)(F.in[6] + (size_t)(r0 + q) * DPLE) + lane);
        if (smp) {
#pragma unroll
            for (int j = 0; j < 4; ++j) vs[j] = __builtin_nontemporal_load((const f32x4*)(F.in[1] + (size_t)F.gw * DM) + lane + 64 * j);
            ps = __builtin_nontemporal_load((const f32x4*)(F.in[7] + (size_t)F.gw * DPLE) + lane); }
        auto xrow_out = [&](int r, const f32x4 (&vv)[4]) { float sq = 0.f;
#pragma unroll
            for (int j = 0; j < 4; ++j) sq += (vv[j].x * vv[j].x + vv[j].y * vv[j].y) + (vv[j].z * vv[j].z + vv[j].w * vv[j].w);
            sq = wave_sum(sq); unsigned long long* o8 = (unsigned long long*)((bf16_t*)(ws + WS_XB) + (size_t)r * DM) + lane;
#pragma unroll
            for (int j = 0; j < 4; ++j) o8[64 * j] = (unsigned long long)cvt_pk_bf16(vv[j].x, vv[j].y) | ((unsigned long long)cvt_pk_bf16(vv[j].z, vv[j].w) << 32);
            if (lane == 0) rs[r] = 1.0f / sqrtf(sq * (1.0f / DM) + EPS); };
#pragma unroll
        for (int q = 0; q < 8; ++q) xrow_out(r0 + q, v[q]);
#pragma unroll
        for (int q = 0; q < 8; ++q) ((unsigned long long*)((bf16_t*)(ws + WS_PB) + (size_t)(r0 + q) * DPLE))[lane] = (unsigned long long)cvt_pk_bf16(pv[q].x, pv[q].y) | ((unsigned long long)cvt_pk_bf16(pv[q].z, pv[q].w) << 32);
        if (smp) { xrow_out(MP + F.gw, vs);
            ((unsigned long long*)((bf16_t*)(ws + WS_PB) + (size_t)(MP + F.gw) * DPLE))[lane] = (unsigned long long)cvt_pk_bf16(ps.x, ps.y) | ((unsigned long long)cvt_pk_bf16(ps.z, ps.w) << 32); }
        for (int r = MP + MS + (F.NGW - 1 - F.gw); r < MA; r += F.NGW) { unsigned long long* o8 = (unsigned long long*)((bf16_t*)(ws + WS_XB) + (size_t)r * DM) + lane;
#pragma unroll
            for (int j = 0; j < 4; ++j) o8[64 * j] = 0ull;
            if (lane == 0) rs[r] = 0.f; ((unsigned long long*)((bf16_t*)(ws + WS_PB) + (size_t)r * DPLE))[lane] = 0ull; }
    }
}

struct OrderRowMajor {
    int nM, nN, n, G, c; const char* A; const char* B; size_t astep, bstep;
    __device__ __forceinline__ bool next(int i, Unit& u) const {
        const int L = i * G + c; if (L >= n) return false;
        u.pm = L / nN; u.pn = L % nN; u.aux = 0; u.a = A + (size_t)u.pm * astep; u.b = B + (size_t)u.pn * bstep; return true;
    }
};
struct OrderPanel4 {
    int n, G, c; const char* A; const char* B; size_t astep, bstep;
    __device__ __forceinline__ bool next(int i, Unit& u) const {
        const int L = i * G + c; if (L >= n) return false;
        if (L < 256) { const int x = L & 7, j = L >> 3; u.pm = x * 8 + (j >> 2); u.pn = j & 3; } else { u.pm = 64; u.pn = L - 256; }
        u.aux = 0; u.a = A + (size_t)u.pm * astep; u.b = B + (size_t)u.pn * bstep; return true;
    }
};
struct OrderProjSkip {
    int G, c; const char* A; const char* B; size_t astep, bstep;
    __device__ __forceinline__ bool next(int i, Unit& u) const {
        if (c < 4) return false; const int cp = c - 4; const int L = i == 0 ? cp : (i == 1 && cp < 8 ? 252 + cp : -1); if (L < 0) return false;
        if (L < 256) { const int x = L & 7, j = L >> 3; u.pm = x * 8 + (j >> 2); u.pn = j & 3; } else { u.pm = 64; u.pn = L - 256; }
        u.aux = 0; u.a = A + (size_t)u.pm * astep; u.b = B + (size_t)u.pn * bstep; return true;
    }
};
struct OrderXcd {
    int nM, nN, n, G, c; const char* A; const char* B; size_t astep, bstep;
    __device__ __forceinline__ bool next(int i, Unit& u) const {
        const int L = i * G + c; if (L >= n) return false;
        int wgid = L; { const int q = n / 8, r = n % 8, xcd = wgid % 8, off = wgid / 8; wgid = (xcd < r ? xcd * (q + 1) : r * (q + 1) + (xcd - r) * q) + off; }
        const int nig = 8 * nN, gid = wgid / nig, fm = gid * 8, gsz = (nM - fm) < 8 ? (nM - fm) : 8;
        u.pm = fm + ((wgid % nig) % gsz); u.pn = (wgid % nig) / gsz; u.aux = 0; u.a = A + (size_t)u.pm * astep; u.b = B + (size_t)u.pn * bstep; return true;
    }
};
struct EpiInProj {
    static constexpr bool PERM = true, AFTER_DRAIN = false;
    bf16_t* PA; bf16_t* PB; const float* rs;
    template <int KIND> __device__ __forceinline__ void run(const f32x4 (&acc)[2][2][4][2], bf16_t* base, int row0, int col0) const {
#pragma unroll
        for (int ai = 0; ai < 2; ++ai)
#pragma unroll
            for (int m = 0; m < 4; ++m) { const int row = row0 + ai * 128 + m * 16; const float s = rs[row]; bf16_t* rowp = base + (size_t)row * 3072 + col0;
#pragma unroll
                for (int bj = 0; bj < 2; ++bj) { f32x4 v0 = acc[ai][bj][m][0] * s, v1 = acc[ai][bj][m][1] * s;
                    if (KIND == 0) { f32x2 a = gelu_pk((f32x2){v0[0], v0[1]}), b = gelu_pk((f32x2){v0[2], v0[3]}), c = gelu_pk((f32x2){v1[0], v1[1]}), d = gelu_pk((f32x2){v1[2], v1[3]});
                        v0 = (f32x4){a.x, a.y, b.x, b.y}; v1 = (f32x4){c.x, c.y, d.x, d.y}; }
                    if (KIND == 1) {
#pragma unroll
                        for (int j = 0; j < 4; ++j) { v0[j] = siluf_(v0[j]); v1[j] = siluf_(v1[j]); } }
                    if (KIND == 3) {
#pragma unroll
                        for (int j = 0; j < 4; ++j) { v0[j] = sigmoidf_(v0[j]); v1[j] = sigmoidf_(v1[j]); } }
                    u32x4 w; w.x = cvt_pk_bf16(v0[0], v0[1]); w.y = cvt_pk_bf16(v0[2], v0[3]); w.z = cvt_pk_bf16(v1[0], v1[1]); w.w = cvt_pk_bf16(v1[2], v1[3]);
                    *(u32x4*)(rowp + bj * 128) = w; } }
    }
    __device__ __forceinline__ void operator()(const f32x4 (&acc)[2][2][4][2], const Unit& u, int wr, int wc, int fr, int fq) const {
        const int row0 = u.pm * 256 + wr * 64 + fr, pn = u.pn;
        bf16_t* base = pn < 12 ? PA + pn * 256 : PB + (pn - 12) * 256; const int col0 = wc * 32 + 8 * fq;
        if (pn < 8) run<0>(acc, base, row0, col0);
        else if (pn < 12 || pn >= 20) run<1>(acc, base, row0, col0);
        else if (pn < 16) run<2>(acc, base, row0, col0);
        else run<3>(acc, base, row0, col0);
    }
};

__device__ __forceinline__ float logsigmoidf_(float x) { return fminf(x, 0.f) - log1pf(__expf(-fabsf(x))); }
__device__ __forceinline__ void unpack8(const u32x4 w, float (&f)[8]) { f[0] = bf_lo(w.x); f[1] = bf_hi(w.x); f[2] = bf_lo(w.y); f[3] = bf_hi(w.y); f[4] = bf_lo(w.z); f[5] = bf_hi(w.z); f[6] = bf_lo(w.w); f[7] = bf_hi(w.w); }
__device__ __forceinline__ u32x4 pack8(const float (&f)[8]) { u32x4 w; w.x = cvt_pk_bf16(f[0], f[1]); w.y = cvt_pk_bf16(f[2], f[3]); w.z = cvt_pk_bf16(f[4], f[5]); w.w = cvt_pk_bf16(f[6], f[7]); return w; }

__device__ __forceinline__ void p2a_conv_gates(const Ctx& F0) { Ctx F = F0; asm volatile("" : "+v"(F.tid), "+v"(F.lane), "+s"(F.gw));
    unsigned char* ws = F.ws;
    const bf16_t* PBX = (const bf16_t*)(ws + WS_XB2);
    bf16_t* XC = (bf16_t*)(ws + WS_XB);
    const float* Wg = (const float*)(ws + WS_WG);
    float* GLI = (float*)(ws + WS_GLI); float* GLF = (float*)(ws + WS_GLF);
    const float* convw = F.in[14]; const float* convb = F.in[15]; const float* bif = F.in[20];
    LAS float* cwl = (LAS float*)F.lds; LAS bf16_t* wgl = (LAS bf16_t*)(F.lds + 20480); LAS f32x4* comb = (LAS f32x4*)(F.lds + 20480 + 32 * 2064);
    {
        u32x4 t[11];
#pragma unroll
        for (int j = 0; j < 11; ++j) { const int i = min(F.tid + 512 * j, 5375);
            const u32x4* srcp = i < 1024 ? (const u32x4*)convw + i : (i < 1280 ? (const u32x4*)convb + (i - 1024) : (const u32x4*)(ws + WS_WGB) + (i - 1280));
            t[j] = *srcp; }
#pragma unroll
        for (int j = 0; j < 11; ++j) { const int i = F.tid + 512 * j; if (i < 1280) ((LAS u32x4*)F.lds)[i] = t[j]; else if (i < 5376) { const int p = i - 1280; *(LAS u32x4*)(F.lds + 20480 + (p >> 7) * 2064 + (p & 127) * 16) = t[j]; } }
    }
    __syncthreads();
    const int l15 = F.lane & 15, lq = F.lane >> 4, rgp = F.wave >> 1, hh = F.wave & 1;
    auto conv_core = [&](int row, const float (&w0)[8], const float (&w1)[8], const float (&w2)[8], const u32x4 x0, int ch0, f32x4& acc) {
        float cur[8], xc[8];
        unpack8(x0, cur);
#pragma unroll
        for (int q = 0; q < 2; ++q) { const f32x4 c0 = *(const LAS f32x4*)(cwl + ch0 + 4 * q), c1 = *(const LAS f32x4*)(cwl + 1024 + ch0 + 4 * q), c2 = *(const LAS f32x4*)(cwl + 2048 + ch0 + 4 * q), c3 = *(const LAS f32x4*)(cwl + 3072 + ch0 + 4 * q), cb = *(const LAS f32x4*)(cwl + 4096 + ch0 + 4 * q);
#pragma unroll
            for (int e = 0; e < 4; ++e) xc[4 * q + e] = siluf_(c0[e] * w0[4 * q + e] + c1[e] * w1[4 * q + e] + c2[e] * w2[4 * q + e] + c3[e] * cur[4 * q + e] + cb[e]); }
        const u32x4 xcp = pack8(xc);
        *(u32x4*)(XC + (size_t)row * DM + ch0) = xcp;
        const bf16x8 bc = *(const LAS bf16x8*)(wgl + l15 * 1032 + ch0), bx = *(const LAS bf16x8*)(wgl + 16 * 1032 + l15 * 1032 + ch0);
        acc = __builtin_amdgcn_mfma_f32_16x16x32_bf16(__builtin_bit_cast(bf16x8, xcp), bc, acc, 0, 0, 0);
        acc = __builtin_amdgcn_mfma_f32_16x16x32_bf16(__builtin_bit_cast(bf16x8, x0), bx, acc, 0, 0, 0);
    };
    for (int tile = F.bid; tile < MP / 64; tile += F.G) {
        const int row = tile * 64 + rgp * 16 + l15, seq0 = row & ~(SEQ - 1);
        const bool v1 = row - 1 >= seq0, v2 = row - 2 >= seq0, v3 = row - 3 >= seq0;
        const bf16_t* p0 = PBX + (size_t)row * DM + hh * 512 + 8 * lq;
        const bf16_t* p1 = p0 - (v1 ? DM : 0); const bf16_t* p2 = p0 - (v2 ? 2 * DM : 0); const bf16_t* p3 = p0 - (v3 ? 3 * DM : 0);
        f32x4 acc = (f32x4){0.f, 0.f, 0.f, 0.f};
        u32x4 X0[2][4], X1[2][4], X2[2][4], X3[2][4];
#pragma unroll
        for (int j = 0; j < 4; ++j) { const int off = j * 32; X0[0][j] = *(const u32x4*)(p0 + off); X1[0][j] = *(const u32x4*)(p1 + off); X2[0][j] = *(const u32x4*)(p2 + off); X3[0][j] = *(const u32x4*)(p3 + off); }
#pragma unroll
        for (int bt = 0; bt < 4; ++bt) {
            if (bt < 3) {
#pragma unroll
                for (int j = 0; j < 4; ++j) { const int off = ((bt + 1) * 4 + j) * 32; X0[(bt + 1) & 1][j] = *(const u32x4*)(p0 + off); X1[(bt + 1) & 1][j] = *(const u32x4*)(p1 + off); X2[(bt + 1) & 1][j] = *(const u32x4*)(p2 + off); X3[(bt + 1) & 1][j] = *(const u32x4*)(p3 + off); } }
#pragma unroll
            for (int j = 0; j < 4; ++j) { const u32x4 z = (u32x4){0u, 0u, 0u, 0u}; float w0[8], w1[8], w2[8];
                unpack8(v3 ? X3[bt & 1][j] : z, w0); unpack8(v2 ? X2[bt & 1][j] : z, w1); unpack8(v1 ? X1[bt & 1][j] : z, w2);
                conv_core(row, w0, w1, w2, X0[bt & 1][j], (hh * 16 + bt * 4 + j) * 32 + 8 * lq, acc); }
        }
        __syncthreads();
        if (hh == 1) comb[rgp * 64 + F.lane] = acc;
        __syncthreads();
        if (hh == 0 && l15 < 8) { const f32x4 o = comb[rgp * 64 + F.lane]; const float bj = bif[l15];
#pragma unroll
            for (int r = 0; r < 4; ++r) { const float g = acc[r] + o[r] + bj; const size_t rr = (size_t)(tile * 64 + rgp * 16 + 4 * lq + r);
                if (l15 < 4) GLI[(size_t)l15 * MA + rr] = g; else GLF[(size_t)(l15 - 4) * MA + rr] = logsigmoidf_(g); } }
    }
    for (int si = F.G - 1 - F.bid; si < MS / 16; si += F.G) {
        const int row = MP + si * 16 + l15; const float* st = F.in[5] + (size_t)(row - MP) * 3072;
        f32x4 acc = (f32x4){0.f, 0.f, 0.f, 0.f};
        u32x4 X0[4]; f32x4 S[4][3][2];
#pragma unroll
        for (int cbk = 0; cbk < 4; ++cbk) { const int ch0 = (F.wave * 4 + cbk) * 32 + 8 * lq; X0[cbk] = *(const u32x4*)(PBX + (size_t)row * DM + ch0);
#pragma unroll
            for (int q = 0; q < 2; ++q) { S[cbk][0][q] = *(const f32x4*)(st + ch0 + 4 * q); S[cbk][1][q] = *(const f32x4*)(st + 1024 + ch0 + 4 * q); S[cbk][2][q] = *(const f32x4*)(st + 2048 + ch0 + 4 * q); } }
#pragma unroll
        for (int cbk = 0; cbk < 4; ++cbk) { float w0[8], w1[8], w2[8];
#pragma unroll
            for (int q = 0; q < 2; ++q)
#pragma unroll
                for (int e = 0; e < 4; ++e) { w0[4 * q + e] = S[cbk][0][q][e]; w1[4 * q + e] = S[cbk][1][q][e]; w2[4 * q + e] = S[cbk][2][q][e]; }
            conv_core(row, w0, w1, w2, X0[cbk], (F.wave * 4 + cbk) * 32 + 8 * lq, acc); }
        __syncthreads();
        comb[F.wave * 64 + F.lane] = acc;
        __syncthreads();
        if (F.wave == 0 && l15 < 8) { f32x4 o = comb[F.lane];
#pragma unroll
            for (int ww = 1; ww < 8; ++ww) o = o + comb[ww * 64 + F.lane];
            const float bj = bif[l15];
#pragma unroll
            for (int r = 0; r < 4; ++r) { const float g = o[r] + bj; const size_t rr = (size_t)(MP + si * 16 + 4 * lq + r);
                if (l15 < 4) GLI[(size_t)l15 * MA + rr] = g; else GLF[(size_t)(l15 - 4) * MA + rr] = logsigmoidf_(g); } }
    }
}
__device__ __forceinline__ void p2c_sample_rows(const Ctx& F0) { Ctx F = F0; asm volatile("" : "+v"(F.tid), "+v"(F.lane), "+s"(F.gw));
    unsigned char* ws = F.ws;
    const bf16_t* PBX = (const bf16_t*)(ws + WS_XB2);
    if (F.bid >= 64 && F.bid < 112) { const int i = (F.bid - 64) * 512 + F.tid; const int b = i / 3072, j = (i / 1024) % 3, ch = i & 1023;
        F.out[O_CVP + i] = bf2f(PBX[(size_t)(b * SEQ + SEQ - 3 + j) * DM + ch]); }
    if (F.bid >= 112 && F.bid < 128) { const int i = (F.bid - 112) * 8 + F.wave;
        const int r = MP + i, ch0s = F.lane * 16; const float* st = F.in[5] + (size_t)i * 3 * 1024;
        const bf16_t* PA = (const bf16_t*)(ws + WS_PROJA) + (size_t)r * 3072;
        u32x4 xbw[2], gvw[2], uuw[2], zzw[2]; f32x4 s1[4], s2[4], lg[4], lb[4];
#pragma unroll
        for (int half = 0; half < 2; ++half) { xbw[half] = *(const u32x4*)(PBX + (size_t)r * DM + ch0s + 8 * half); gvw[half] = *(const u32x4*)(PA + 1024 + ch0s + 8 * half);
            uuw[half] = *(const u32x4*)(PA + ch0s + 8 * half); zzw[half] = *(const u32x4*)(PA + 2048 + ch0s + 8 * half); }
#pragma unroll
        for (int q4 = 0; q4 < 4; ++q4) { s1[q4] = *(const f32x4*)(st + 1024 + ch0s + 4 * q4); s2[q4] = *(const f32x4*)(st + 2048 + ch0s + 4 * q4);
            lg[q4] = *(const f32x4*)(F.in[10] + ch0s + 4 * q4); lb[q4] = *(const f32x4*)(F.in[11] + ch0s + 4 * q4); }
        const int h = F.lane >> 3; const float wsp = F.in[12][(size_t)h * 16384], bsp = F.in[13][h * 128];
#pragma unroll
        for (int half = 0; half < 2; ++half) { float xb[8]; unpack8(xbw[half], xb);
#pragma unroll
            for (int q = 0; q < 2; ++q) { const int q4 = half * 2 + q; *(f32x4*)(F.out + O_CVS + (size_t)i * 3072 + ch0s + 4 * q4) = s1[q4]; *(f32x4*)(F.out + O_CVS + (size_t)i * 3072 + 1024 + ch0s + 4 * q4) = s2[q4];
                *(f32x4*)(F.out + O_CVS + (size_t)i * 3072 + 2048 + ch0s + 4 * q4) = (f32x4){xb[4 * q], xb[4 * q + 1], xb[4 * q + 2], xb[4 * q + 3]}; } }
        float gv[16], s = 0.f;
        { float t8[8]; unpack8(gvw[0], t8);
#pragma unroll
          for (int c = 0; c < 8; ++c) gv[c] = t8[c];
          unpack8(gvw[1], t8);
#pragma unroll
          for (int c = 0; c < 8; ++c) gv[8 + c] = t8[c]; }
#pragma unroll
        for (int c = 0; c < 16; ++c) s += gv[c];
        s += __shfl_xor(s, 1); s += __shfl_xor(s, 2); s += __shfl_xor(s, 4);
        const float mu = s * (1.f / 128.f); float q = 0.f;
#pragma unroll
        for (int c = 0; c < 16; ++c) { const float d = gv[c] - mu; q += d * d; }
        q += __shfl_xor(q, 1); q += __shfl_xor(q, 2); q += __shfl_xor(q, 4);
        const float rstd = 1.0f / sqrtf(q * (1.f / 128.f) + EPS);
        float uu[16], zz[16];
        { float t8[8]; unpack8(uuw[0], t8);
#pragma unroll
          for (int c = 0; c < 8; ++c) uu[c] = t8[c];
          unpack8(uuw[1], t8);
#pragma unroll
          for (int c = 0; c < 8; ++c) uu[8 + c] = t8[c];
          unpack8(zzw[0], t8);
#pragma unroll
          for (int c = 0; c < 8; ++c) zz[c] = t8[c];
          unpack8(zzw[1], t8);
#pragma unroll
          for (int c = 0; c < 8; ++c) zz[8 + c] = t8[c]; }
        float ya[16];
#pragma unroll
        for (int q4 = 0; q4 < 4; ++q4) { f32x4 vv;
#pragma unroll
            for (int e = 0; e < 4; ++e) { const int c = 4 * q4 + e; const float vn = (gv[c] - mu) * rstd * lg[q4][e] + lb[q4][e]; vv[e] = vn; ya[c] = uu[c] * (wsp * vn + bsp) * zz[c]; }
            *(f32x4*)(F.out + O_VS + (size_t)i * 1024 + ch0s + 4 * q4) = vv; }
        bf16_t* yrow = (bf16_t*)(ws + WS_Y) + (size_t)r * DMIX + ch0s;
        { float t8[8];
#pragma unroll
          for (int c = 0; c < 8; ++c) t8[c] = ya[c];
          *(u32x4*)(yrow) = pack8(t8);
#pragma unroll
          for (int c = 0; c < 8; ++c) t8[c] = ya[8 + c];
          *(u32x4*)(yrow + 8) = pack8(t8); }
    }
}

__device__ __forceinline__ void mscan_wave(const Ctx& F, int bh) {
    unsigned char* ws = F.ws; const int b = bh >> 2, h = bh & 3, lane = F.lane;
    const float* li = (const float*)(ws + WS_GLI) + (size_t)h * MA + (size_t)b * SEQ + lane * 32;
    const float* lf = (const float*)(ws + WS_GLF) + (size_t)h * MA + (size_t)b * SEQ + lane * 32;
    float lfv[32], liv[32];
#pragma unroll
    for (int j = 0; j < 8; ++j) { const f32x4 a = *(const f32x4*)(lf + 4 * j), c = *(const f32x4*)(li + 4 * j);
#pragma unroll
        for (int e = 0; e < 4; ++e) { lfv[4 * j + e] = a[e]; liv[4 * j + e] = c[e]; } }
    float A = 0.f, Bv = -INFINITY;
#pragma unroll
    for (int i = 0; i < 32; ++i) { const float f = lfv[i], l = liv[i]; Bv = fmaxf(Bv + f, l); A += f; }
    float sA = A, sB = Bv;
#pragma unroll
    for (int o = 1; o < 64; o <<= 1) { const float pA = __shfl_up(sA, o), pB = __shfl_up(sB, o); if (lane >= o) { sB = fmaxf(pB + sA, sB); sA = pA + sA; } }
    float eA = __shfl_up(sA, 1), eB = __shfl_up(sB, 1); if (lane == 0) { eA = 0.f; eB = -INFINITY; }
    const float m_in = fmaxf(0.f + eA, eB);
    float cA = A;
#pragma unroll
    for (int o = 1; o < 8; o <<= 1) { const float p = __shfl_up(cA, o); if ((lane & 7) >= o) cA += p; }
    const float b_in = cA - A;
    const float m_prev = __shfl(m_in, lane & ~7);
    float* DA = (float*)(ws + WS_DA) + (size_t)h * MA + (size_t)b * SEQ + lane * 32; float* DR = (float*)(ws + WS_DR) + (size_t)h * MA + (size_t)b * SEQ + lane * 32;
    float* DG = (float*)(ws + WS_DG) + (size_t)h * MA + (size_t)b * SEQ + lane * 32; float* DEM = (float*)(ws + WS_DEM) + (size_t)h * MA + (size_t)b * SEQ + lane * 32;
    float* DW = (float*)(ws + WS_DW) + (size_t)h * MA + (size_t)b * SEQ + lane * 32;
    float m = m_in, bb = b_in, a_last = 0.f;
#pragma unroll
    for (int j = 0; j < 8; ++j) { f32x4 vA, vR, vG, vE;
#pragma unroll
        for (int e = 0; e < 4; ++e) { const float f = lfv[4 * j + e], l = liv[4 * j + e]; m = fmaxf(m + f, l); bb += f;
            a_last = bb - m; vA[e] = -m_prev; vR[e] = l - bb; vG[e] = __expf(bb + m_prev - m); vE[e] = __expf(-m); }
        *(f32x4*)(DA + 4 * j) = vA; *(f32x4*)(DR + 4 * j) = vR; *(f32x4*)(DG + 4 * j) = vG; *(f32x4*)(DEM + 4 * j) = vE; }
    const float a_end = __shfl(a_last, lane | 7);
    { float bb2 = b_in;
#pragma unroll
      for (int j = 0; j < 8; ++j) { f32x4 vW;
#pragma unroll
          for (int e = 0; e < 4; ++e) { bb2 += lfv[4 * j + e]; vW[e] = __expf(a_end + (liv[4 * j + e] - bb2)); }
          *(f32x4*)(DW + 4 * j) = vW; } }
    if (lane == 63) F.out[O_MP + bh] = m;
}

__device__ __forceinline__ void p9_final(const Ctx& F0) { Ctx F = F0; asm volatile("" : "+v"(F.tid), "+v"(F.lane), "+s"(F.gw));
    unsigned char* ws = F.ws; const bf16_t* GB = (const bf16_t*)(ws + WS_GB); const bf16_t* EB = (const bf16_t*)(ws + WS_EB);
    const float* pleg = F.in[27]; const float* fing = F.in[28];
    f32x4 pg[4], fg[4];
#pragma unroll
    for (int j = 0; j < 4; ++j) { pg[j] = ((const f32x4*)pleg)[F.lane + 64 * j]; fg[j] = ((const f32x4*)fing)[F.lane + 64 * j]; }
    for (int r0 = F.gw * 2; r0 < MP + MS; r0 += F.NGW * 2) {
        f32x4 x[2][4]; u32x2 g[2][4], e[2][4], xb[2][4]; float* xrow[2]; const bf16_t* X1B = (const bf16_t*)(ws + WS_X1B);
#pragma unroll
        for (int q = 0; q < 2; ++q) { const int r = r0 + q; xrow[q] = r < MP ? F.out + O_Y + (size_t)r * DM : F.out + O_YS + (size_t)(r - MP) * DM;
#pragma unroll
            for (int j = 0; j < 4; ++j) { xb[q][j] = __builtin_nontemporal_load((const u32x2*)(X1B + (size_t)r * DM) + F.lane + 64 * j); g[q][j] = __builtin_nontemporal_load((const u32x2*)(GB + (size_t)r * DM) + F.lane + 64 * j); e[q][j] = __builtin_nontemporal_load((const u32x2*)(EB + (size_t)r * DM) + F.lane + 64 * j); } }
#pragma unroll
        for (int q = 0; q < 2; ++q) { float s = 0.f; f32x4 ev[4];
#pragma unroll
            for (int j = 0; j < 4; ++j) { x[q][j] = (f32x4){bf_lo(xb[q][j].x), bf_hi(xb[q][j].x), bf_lo(xb[q][j].y), bf_hi(xb[q][j].y)}; ev[j] = (f32x4){bf_lo(e[q][j].x), bf_hi(e[q][j].x), bf_lo(e[q][j].y), bf_hi(e[q][j].y)}; s += (ev[j][0] * ev[j][0] + ev[j][1] * ev[j][1]) + (ev[j][2] * ev[j][2] + ev[j][3] * ev[j][3]); }
            s = wave_sum(s); const float rse = 1.0f / sqrtf(s * (1.f / DM) + EPS); float s2 = 0.f;
#pragma unroll
            for (int j = 0; j < 4; ++j) { const f32x4 gv = (f32x4){bf_lo(g[q][j].x), bf_hi(g[q][j].x), bf_lo(g[q][j].y), bf_hi(g[q][j].y)};
                x[q][j] = x[q][j] + gv * (ev[j] * rse * pg[j]); s2 += (x[q][j][0] * x[q][j][0] + x[q][j][1] * x[q][j][1]) + (x[q][j][2] * x[q][j][2] + x[q][j][3] * x[q][j][3]); }
            s2 = wave_sum(s2); const float rs2 = 1.0f / sqrtf(s2 * (1.f / DM) + EPS);
#pragma unroll
            for (int j = 0; j < 4; ++j) __builtin_nontemporal_store(x[q][j] * rs2 * fg[j], (f32x4*)xrow[q] + F.lane + 64 * j); }
    }
}
#define MAKE_CTX() extern __shared__ __attribute__((aligned(16))) unsigned char lds_raw[]; \
    Ctx F; F.lds = (LAS unsigned char*)lds_raw; F.tid = threadIdx.x; F.lane = F.tid & 63; F.wave = __builtin_amdgcn_readfirstlane(F.tid >> 6); \
    F.G = gridDim.x; F.bid = blockIdx.x; F.gw = F.bid * 8 + F.wave; F.NGW = F.G * 8; F.in = args.in; F.out = args.out; F.ws = args.ws; unsigned char* ws = args.ws; (void)ws

template <int KIND> struct EpiBf16Act {
    static constexpr bool PERM = false, AFTER_DRAIN = false;
    bf16_t* O; int ldo; const float* bias; float scale;
    __device__ __forceinline__ void operator()(const f32x4 (&acc)[2][2][4][2], const Unit& u, int wr, int wc, int fr, int fq) const {
        const int row0 = u.pm * 256 + wr * 64 + fr, col0 = u.pn * 256 + wc * 32 + 4 * fq;
        f32x4 bv[2][2];
#pragma unroll
        for (int bj = 0; bj < 2; ++bj)
#pragma unroll
            for (int n = 0; n < 2; ++n) bv[bj][n] = bias ? *(const f32x4*)(bias + col0 + bj * 128 + 16 * n) : (f32x4){0.f, 0.f, 0.f, 0.f};
#pragma unroll
        for (int ai = 0; ai < 2; ++ai)
#pragma unroll
            for (int m = 0; m < 4; ++m) { bf16_t* rowp = O + (size_t)(row0 + ai * 128 + m * 16) * ldo + col0;
#pragma unroll
                for (int bj = 0; bj < 2; ++bj)
#pragma unroll
                    for (int n = 0; n < 2; ++n) { f32x4 v = acc[ai][bj][m][n] * scale + bv[bj][n];
                        if (KIND == 3) {
#pragma unroll
                            for (int j = 0; j < 4; ++j) v[j] = sigmoidf_(v[j]); }
                        u32x2 w; w.x = cvt_pk_bf16(v[0], v[1]); w.y = cvt_pk_bf16(v[2], v[3]); *(u32x2*)(rowp + bj * 128 + n * 16) = w; } }
    }
};
struct EpiOutProj {
    static constexpr bool PERM = false, AFTER_DRAIN = false;
    const float* xp; const float* xs; float* out; bf16_t* X1B;
    __device__ __forceinline__ void operator()(const f32x4 (&acc)[2][2][4][2], const Unit& u, int wr, int wc, int fr, int fq) const {
        const int row0 = u.pm * 256 + wr * 64 + fr, col0 = u.pn * 256 + wc * 32 + 4 * fq;
#pragma unroll
        for (int ai = 0; ai < 2; ++ai) { f32x4 xv[4][2][2];
#pragma unroll
            for (int m = 0; m < 4; ++m) { const int row = row0 + ai * 128 + m * 16; const bool real = row < MP + MS; const float* xr = row < MP ? xp + (size_t)row * DM : xs + (size_t)(real ? row - MP : 0) * DM;
#pragma unroll
                for (int bj = 0; bj < 2; ++bj)
#pragma unroll
                    for (int n = 0; n < 2; ++n) xv[m][bj][n] = __builtin_nontemporal_load((const f32x4*)(xr + col0 + bj * 128 + n * 16)); }
#pragma unroll
            for (int m = 0; m < 4; ++m) { const int row = row0 + ai * 128 + m * 16; const bool real = row < MP + MS;
#pragma unroll
                for (int bj = 0; bj < 2; ++bj)
#pragma unroll
                    for (int n = 0; n < 2; ++n) { const int c = col0 + bj * 128 + n * 16; f32x4 v = acc[ai][bj][m][n];
                        if (real) v = v + xv[m][bj][n]; else v = (f32x4){0.f, 0.f, 0.f, 0.f};
                        u32x2 w; w.x = cvt_pk_bf16(v[0], v[1]); w.y = cvt_pk_bf16(v[2], v[3]); *(u32x2*)(X1B + (size_t)row * DM + c) = w; } } }
    }
};

struct EpiInProjNP {
    static constexpr bool PERM = false, AFTER_DRAIN = false;
    bf16_t* PA; bf16_t* PB; const float* rs; bf16_t* XB2;
    __device__ __forceinline__ void operator()(const f32x4 (&acc)[2][2][4][2], const Unit& u, int wr, int wc, int fr, int fq) const {
        const int row0 = u.pm * 256 + wr * 64 + fr, pn = u.pn; const int col0 = wc * 32 + 4 * fq;
        const int kind = pn < 8 ? 0 : ((pn < 12 || pn >= 20) ? 1 : (pn < 16 ? 2 : 3));
        bf16_t* base = pn < 12 ? PA + pn * 256 : (kind == 2 ? XB2 + (pn - 12) * 256 : PB + (pn - 12) * 256); const int pitch = kind == 2 ? DM : 3072;
        float rsv[2][4];
#pragma unroll
        for (int ai = 0; ai < 2; ++ai)
#pragma unroll
            for (int m = 0; m < 4; ++m) rsv[ai][m] = rs[row0 + ai * 128 + m * 16];
#pragma unroll
        for (int ai = 0; ai < 2; ++ai)
#pragma unroll
            for (int m = 0; m < 4; ++m) { const int row = row0 + ai * 128 + m * 16; const float s = rsv[ai][m];
#pragma unroll
                for (int bj = 0; bj < 2; ++bj)
#pragma unroll
                    for (int n = 0; n < 2; ++n) { f32x4 v = acc[ai][bj][m][n] * s;
                        if (kind == 0) { const f32x2 ga = gelu_pk((f32x2){v[0], v[1]}), gb = gelu_pk((f32x2){v[2], v[3]}); v = (f32x4){ga.x, ga.y, gb.x, gb.y}; }
                        else {
#pragma unroll
                        for (int j = 0; j < 4; ++j) { float x = v[j]; if (kind == 1) x = siluf_(x); else if (kind == 3) x = sigmoidf_(x); v[j] = x; } }
                        u32x2 w; w.x = cvt_pk_bf16(v[0], v[1]); w.y = cvt_pk_bf16(v[2], v[3]); *(u32x2*)(base + (size_t)row * pitch + col0 + bj * 128 + n * 16) = w; } }
    }
};
__device__ __forceinline__ void p1_inproj(const Ctx& F) {
    unsigned char* ws = F.ws; Gemm g{DM, DM, DM};
    OrderXcd S{64, 24, 64 * 24, F.G, F.bid, (const char*)(ws + WS_XB), (const char*)(ws + WS_WIN), (size_t)256 * DM * 2, (size_t)256 * DM * 2};
    EpiInProjNP E{(bf16_t*)(ws + WS_PROJA), (bf16_t*)(ws + WS_PROJB), (const float*)(ws + WS_RS), (bf16_t*)(ws + WS_XB2)};
    pg8::gemm_phase<EpiInProjNP, OrderXcd>(F.lds, g, S, E);
}
__device__ __forceinline__ void p7_outproj(const Ctx& F) {
    unsigned char* ws = F.ws; Gemm g{DMIX, DMIX, DMIX};
    OrderPanel4 S{64 * 4, F.G, F.bid, (const char*)(ws + WS_Y), (const char*)(ws + WS_WOUT), (size_t)256 * DMIX * 2, (size_t)256 * DMIX * 2};
    EpiOutProj E{F.in[0], F.in[1], F.out, (bf16_t*)(ws + WS_X1B)};
    pg8::gemm_phase<EpiOutProj, OrderPanel4>(F.lds, g, S, E);
}
__device__ __forceinline__ void p8_ple(const Ctx& F) {
    unsigned char* ws = F.ws;
    { Gemm g{DM, DM, DM}; OrderPanel4 S{NTILE * 4, F.G, F.bid, (const char*)(ws + WS_X1B), (const char*)(ws + WS_WPG), (size_t)256 * DM * 2, (size_t)256 * DM * 2};
      EpiBf16Act<3> E{(bf16_t*)(ws + WS_GB), DM, F.in[25], 1.0f}; pg8::gemm_phase<EpiBf16Act<3>, OrderPanel4>(F.lds, g, S, E); }
    { Gemm g{DPLE, DPLE, DPLE}; OrderProjSkip S{F.G, F.bid, (const char*)(ws + WS_PB), (const char*)(ws + WS_WPP), (size_t)256 * DPLE * 2, (size_t)256 * DPLE * 2};
      EpiBf16Act<0> E{(bf16_t*)(ws + WS_EB), DM, nullptr, 1.0f}; pg8::gemm_phase<EpiBf16Act<0>, OrderProjSkip>(F.lds, g, S, E); }
}
typedef float f32x4_t __attribute__((ext_vector_type(4)));
__device__ __forceinline__ void p2b_spatial_units(const Ctx& F0) { Ctx F = F0; asm volatile("" : "+v"(F.tid), "+v"(F.lane), "+s"(F.gw));
    unsigned char* ws = F.ws;
    const bf16_t* PA = (const bf16_t*)(ws + WS_PROJA); const bf16_t* WSP = (const bf16_t*)(ws + WS_WSP); bf16_t* Y = (bf16_t*)(ws + WS_Y);
    const float* lng = F.in[10]; const float* lnb = F.in[11]; const float* bsp = F.in[13];
    LAS bf16_t* vnT = (LAS bf16_t*)F.lds;
    const int lane = F.lane, w = F.wave, l15 = lane & 15, lq = lane >> 4;
    unsigned wav[8], wbv[8];
    auto load_v = [&](int unit) { const int b = unit >> 7, c = (unit >> 3) & 15, h = unit & 7, r0 = b * SEQ + c * 128;
#pragma unroll
        for (int p = 0; p < 8; ++p) { const int s0 = w * 16 + 2 * p; wav[p] = *(const unsigned*)(PA + (size_t)(r0 + s0) * 3072 + 1024 + h * 128 + 2 * lane); wbv[p] = *(const unsigned*)(PA + (size_t)(r0 + s0 + 1) * 3072 + 1024 + h * 128 + 2 * lane); } };
    if (F.bid < NB * 16 * HA) load_v(F.bid);
    for (int unit = F.bid; unit < NB * 16 * HA; unit += F.G) {
        const int b = unit >> 7, c = (unit >> 3) & 15, h = unit & 7, r0 = b * SEQ + c * 128;
        const float g0 = lng[h * 128 + 2 * lane], g1 = lng[h * 128 + 2 * lane + 1], b0 = lnb[h * 128 + 2 * lane], b1 = lnb[h * 128 + 2 * lane + 1];
        const int t0 = 16 * w, nks = (t0 + 15) / 32 + 1;
        bf16x8 wfr[4];
#pragma unroll
        for (int ks = 0; ks < 4; ++ks) wfr[ks] = *(const bf16x8*)(WSP + ((size_t)h * 128 + t0 + l15) * 128 + ks * 32 + 8 * lq);
        const int t = t0 + l15; const float bt = bsp[h * 128 + t]; const size_t row = (size_t)(r0 + t);
        u32x2 uuv[8], zzv[8];
#pragma unroll
        for (int nb = 0; nb < 8; ++nb) { const int d = nb * 16 + 4 * lq; uuv[nb] = *(const u32x2*)(PA + row * 3072 + h * 128 + d); zzv[nb] = *(const u32x2*)(PA + row * 3072 + 2048 + h * 128 + d); }
#pragma unroll
        for (int p = 0; p < 8; ++p) { const int s0 = w * 16 + 2 * p; const unsigned wa = wav[p], wb = wbv[p];
            float a0 = bf_lo(wa), a1 = bf_hi(wa), c0 = bf_lo(wb), c1 = bf_hi(wb);
            const float mua = wave_sum(a0 + a1) * (1.f / 128.f), mub = wave_sum(c0 + c1) * (1.f / 128.f);
            a0 -= mua; a1 -= mua; c0 -= mub; c1 -= mub;
            const float ra = 1.0f / sqrtf(wave_sum(a0 * a0 + a1 * a1) * (1.f / 128.f) + EPS), rb = 1.0f / sqrtf(wave_sum(c0 * c0 + c1 * c1) * (1.f / 128.f) + EPS);
            *(LAS unsigned*)(vnT + (2 * lane) * 136 + s0) = cvt_pk_bf16(a0 * ra * g0 + b0, c0 * rb * g0 + b0);
            *(LAS unsigned*)(vnT + (2 * lane + 1) * 136 + s0) = cvt_pk_bf16(a1 * ra * g1 + b1, c1 * rb * g1 + b1); }
        __syncthreads();
        if (unit + F.G < NB * 16 * HA) load_v(unit + F.G);
        f32x4 acc[8];
#pragma unroll
        for (int nb = 0; nb < 8; ++nb) acc[nb] = (f32x4){0.f, 0.f, 0.f, 0.f};
#pragma unroll
        for (int ks = 0; ks < 4; ++ks) { if (ks < nks) { const int k0 = ks * 32;
#pragma unroll
            for (int nb = 0; nb < 8; ++nb) { const bf16x8 vf = *(const LAS bf16x8*)(vnT + (nb * 16 + l15) * 136 + k0 + 8 * lq);
                acc[nb] = __builtin_amdgcn_mfma_f32_16x16x32_bf16(vf, wfr[ks], acc[nb], 0, 0, 0); } } }
#pragma unroll
        for (int nb = 0; nb < 8; ++nb) { const int d = nb * 16 + 4 * lq; const u32x2 uu = uuv[nb], zz = zzv[nb];
            u32x2 o; o.x = cvt_pk_bf16(bf_lo(uu.x) * (acc[nb][0] + bt) * bf_lo(zz.x), bf_hi(uu.x) * (acc[nb][1] + bt) * bf_hi(zz.x));
            o.y = cvt_pk_bf16(bf_lo(uu.y) * (acc[nb][2] + bt) * bf_lo(zz.y), bf_hi(uu.y) * (acc[nb][3] + bt) * bf_hi(zz.y));
            *(u32x2*)(Y + row * DMIX + h * 128 + d) = o; }
        __syncthreads();
    }
}
__device__ __forceinline__ void p2b_mscan(const Ctx& F) { if (F.bid < 32 && F.wave == 0) mscan_wave(F, F.bid); }

struct OrderQK {
    int G, c; const char* ws;
    __device__ __forceinline__ bool next(int i, Unit& u) const { const int L = i * G + c; if (L >= 512) return false; const char* XC = ws + WS_XB; const char* WQ = ws + WS_WQ; const char* WK = ws + WS_WK;
        const int kind = L >> 8, l = L & 255; u.pm = l >> 2; u.pn = kind; u.aux = l & 3; u.a = XC + (size_t)u.pm * (256 * DM * 2) + (size_t)u.aux * 512; u.b = (kind ? WK : WQ) + (size_t)u.aux * 131072; return true; }
};
struct EpiQK {
    static constexpr bool PERM = false, AFTER_DRAIN = false;
    bf16_t* K; bf16_t* PQ; const float* DG;
    __device__ __forceinline__ void operator()(const f32x4 (&acc)[2][2][4][2], const Unit& u, int wr, int wc, int fr, int fq) const {
        const int h = u.aux, rl0 = wr * 64 + fr, col0 = wc * 32 + 4 * fq; const bool isk = u.pn != 0;
        const int unit = ((u.pm >> 3) * 4 + h) * 8 + (u.pm & 7);
        float gv[2][4];
#pragma unroll
        for (int ai = 0; ai < 2; ++ai)
#pragma unroll
            for (int m = 0; m < 4; ++m) gv[ai][m] = isk ? 0.0625f : DG[(size_t)h * MA + u.pm * 256 + rl0 + ai * 128 + m * 16];
        bf16_t* base = isk ? K + (size_t)u.pm * 256 * 1024 + h * 256 : PQ + (size_t)unit * 256 * 512 + 256; const int ldo = isk ? 1024 : 512;
#pragma unroll
        for (int ai = 0; ai < 2; ++ai)
#pragma unroll
            for (int m = 0; m < 4; ++m) { const int rl = rl0 + ai * 128 + m * 16; const float g = gv[ai][m];
#pragma unroll
                for (int bj = 0; bj < 2; ++bj)
#pragma unroll
                    for (int n = 0; n < 2; ++n) { const int c = col0 + bj * 128 + n * 16; const f32x4 v = acc[ai][bj][m][n] * g;
                        u32x2 w; w.x = cvt_pk_bf16(v[0], v[1]); w.y = cvt_pk_bf16(v[2], v[3]); *(u32x2*)(base + (size_t)rl * ldo + c) = w; }
                asm volatile("" ::: "memory"); }
    }
};
struct OrderS12 {
    int G, c; const char* ws;
    __device__ __forceinline__ bool next(int i, Unit& u) const { const int L = i * G + c; if (L >= 12) return false; const char* XC = ws + WS_XB; const char* XB2 = ws + WS_XB2; const char* WQ = ws + WS_WQ; const char* WK = ws + WS_WK; const char* WV = ws + WS_WV;
        const int kind = L >> 2; u.pm = 64; u.pn = kind; u.aux = L & 3; u.a = (kind == 2 ? XB2 : XC) + (size_t)64 * (256 * DM * 2) + (size_t)u.aux * 512; u.b = (kind == 0 ? WQ : kind == 1 ? WK : WV) + (size_t)u.aux * 131072; return true; }
};
struct EpiS12 {
    static constexpr bool PERM = false, AFTER_DRAIN = false;
    bf16_t* Q; bf16_t* K; bf16_t* Vs;
    __device__ __forceinline__ void operator()(const f32x4 (&acc)[2][2][4][2], const Unit& u, int wr, int wc, int fr, int fq) const {
        const int h = u.aux, kind = u.pn; bf16_t* O = kind == 0 ? Q + (size_t)MP * 1024 : kind == 1 ? K + (size_t)MP * 1024 : Vs; const float sc = kind == 1 ? 0.0625f : 1.0f;
        const int row0 = wr * 64 + fr, col0 = h * 256 + wc * 32 + 4 * fq;
#pragma unroll
        for (int m = 0; m < 4; ++m) { bf16_t* rowp = O + (size_t)(row0 + m * 16) * 1024 + col0;
#pragma unroll
            for (int bj = 0; bj < 2; ++bj)
#pragma unroll
                for (int n = 0; n < 2; ++n) { const f32x4 v = acc[0][bj][m][n] * sc; u32x2 w; w.x = cvt_pk_bf16(v[0], v[1]); w.y = cvt_pk_bf16(v[2], v[3]); *(u32x2*)(rowp + bj * 128 + n * 16) = w; } }
    }
};
struct OrderVW {
    int G, c; const char* ws;
    __device__ __forceinline__ bool next(int i, Unit& u) const { const int L = i * G + c; if (L >= 512) return false; const char* XC = ws + WS_XB; const char* XB2 = ws + WS_XB2; const char* WK = ws + WS_WK; const char* WV = ws + WS_WV;
        const int kind = L >> 8, l = L & 255, b = l >> 5, h = (l >> 3) & 3, cc = l & 7; u.pm = b * 8 + cc; u.pn = l | (kind << 8); u.aux = h;
        u.a = (kind ? WK : WV) + (size_t)h * 131072; u.b = (kind ? XC : XB2) + (size_t)u.pm * (256 * DM * 2) + (size_t)h * 512; return true; }
};
struct EpiVW {
    static constexpr bool PERM = false, AFTER_DRAIN = false;
    bf16_t* VC; bf16_t* WKT; const float* DW; float* DNP;
    __device__ __forceinline__ void operator()(const f32x4 (&acc)[2][2][4][2], const Unit& u, int wr, int wc, int fr, int fq) const {
        const int h = u.aux, kind = u.pn >> 8, l = u.pn & 255, rl0 = wr * 64 + fr, col0 = wc * 32 + 4 * fq; const int ldo = kind ? 256 : 512; bf16_t* base = (kind ? WKT : VC) + (size_t)l * 256 * ldo;
        f32x4 scq[2][2];
#pragma unroll
        for (int bj = 0; bj < 2; ++bj)
#pragma unroll
            for (int n = 0; n < 2; ++n) scq[bj][n] = kind ? *(const f32x4*)(DW + (size_t)h * MA + u.pm * 256 + col0 + bj * 128 + n * 16) * 0.0625f : (f32x4){1.f, 1.f, 1.f, 1.f};
#pragma unroll
        for (int ai = 0; ai < 2; ++ai)
#pragma unroll
            for (int m = 0; m < 4; ++m) { bf16_t* rowp = base + (size_t)(rl0 + ai * 128 + m * 16) * ldo + col0; float rsum = 0.f;
#pragma unroll
                for (int bj = 0; bj < 2; ++bj)
#pragma unroll
                    for (int n = 0; n < 2; ++n) { const f32x4 v = acc[ai][bj][m][n] * scq[bj][n]; u32x2 w; w.x = cvt_pk_bf16(v[0], v[1]); w.y = cvt_pk_bf16(v[2], v[3]); *(u32x2*)(rowp + bj * 128 + n * 16) = w;
                        rsum += (bf_lo(w.x) + bf_hi(w.x)) + (bf_lo(w.y) + bf_hi(w.y)); }
                if (kind) { rsum += __shfl_xor(rsum, 16); rsum += __shfl_xor(rsum, 32); if (fq == 0) DNP[((size_t)l * 256 + rl0 + ai * 128 + m * 16) * 4 + wc] = rsum; }
                asm volatile("" ::: "memory"); }
    }
};
__device__ __forceinline__ void p3_qkv(const Ctx& F) {
    unsigned char* ws = F.ws;
    { Gemm g{DM, 256, 256}; OrderQK S{F.G, F.bid, (const char*)ws}; EpiQK E{(bf16_t*)(ws + WS_K), (bf16_t*)(ws + WS_PQ), (const float*)(ws + WS_DG)};
      pg8::gemm_phase<EpiQK, OrderQK>(F.lds, g, S, E); }
    { Gemm g{256, DM, 256}; OrderVW S{F.G, F.bid, (const char*)ws}; EpiVW E{(bf16_t*)(ws + WS_VC), (bf16_t*)(ws + WS_WKT), (const float*)(ws + WS_DW), (float*)(ws + WS_DN4)};
      pg8::gemm_phase<EpiVW, OrderVW>(F.lds, g, S, E); }
}

__device__ __forceinline__ void p3_s12(const Ctx& F) {
    unsigned char* ws = F.ws;
    { Gemm g{DM, 256, 256}; OrderS12 S{F.G, (F.bid - 32) & 255, (const char*)ws}; EpiS12 E{(bf16_t*)(ws + WS_Q), (bf16_t*)(ws + WS_K), (bf16_t*)(ws + WS_VS)};
      pg8::gemm_phase<EpiS12, OrderS12>(F.lds, g, S, E); }
}
struct OrderUnitNT {
    int n, G, c; const char* A; size_t astep_pm, astep_h, astep_u; const char* B; size_t bstep_pm, bstep_h, bstep_u;
    __device__ __forceinline__ bool next(int i, Unit& u) const { const int L = i * G + c; if (L >= n) return false;
        const int b = L >> 5, h = (L >> 3) & 3, cc = L & 7; u.pm = b * 8 + cc; u.pn = L; u.aux = h;
        u.a = A + (size_t)u.pm * astep_pm + (size_t)h * astep_h + (size_t)L * astep_u; u.b = B + (size_t)u.pm * bstep_pm + (size_t)h * bstep_h + (size_t)L * bstep_u; return true; }
};
struct EpiScore {
    static constexpr bool PERM = false, AFTER_DRAIN = false;
    bf16_t* PQ; const float* DA; const float* DR; float* DENP;
    __device__ __forceinline__ void operator()(const f32x4 (&acc)[2][2][4][2], const Unit& u, int wr, int wc, int fr, int fq) const {
        const int h = u.aux, rl0 = wr * 64 + fr, col0 = wc * 32 + 4 * fq; const size_t vb = (size_t)h * MA + (size_t)u.pm * 256;
        float atv[2][4]; f32x4 rrv[2][2];
#pragma unroll
        for (int ai = 0; ai < 2; ++ai)
#pragma unroll
            for (int m = 0; m < 4; ++m) atv[ai][m] = DA[vb + rl0 + ai * 128 + m * 16];
#pragma unroll
        for (int bj = 0; bj < 2; ++bj)
#pragma unroll
            for (int n = 0; n < 2; ++n) rrv[bj][n] = *(const f32x4*)(DR + vb + col0 + bj * 128 + n * 16);
#pragma unroll
        for (int ai = 0; ai < 2; ++ai)
#pragma unroll
            for (int m = 0; m < 4; ++m) { int t_ = rl0 + ai * 128 + m * 16; asm volatile("" : "+v"(t_)); const int t = t_; const float at = atv[ai][m]; float rs_ = 0.f; bf16_t* rowp = PQ + ((size_t)u.pn * 256 + t) * 512 + col0;
#pragma unroll
                for (int bj = 0; bj < 2; ++bj)
#pragma unroll
                    for (int n = 0; n < 2; ++n) { const int c = col0 + bj * 128 + n * 16; f32x4 v; const f32x4 rr = rrv[bj][n];
#pragma unroll
                        for (int j = 0; j < 4; ++j) { const float e = fast_exp(fminf(at + rr[j], 60.f)); v[j] = (c + j <= t) ? acc[ai][bj][m][n][j] * e : 0.f; rs_ += v[j]; }
                        u32x2 w; w.x = cvt_pk_bf16(v[0], v[1]); w.y = cvt_pk_bf16(v[2], v[3]); *(u32x2*)(rowp + bj * 128 + n * 16) = w; }
                rs_ += __shfl_xor(rs_, 16); rs_ += __shfl_xor(rs_, 32);
                if (fq == 0) DENP[(vb + t) * 4 + wc] = rs_; asm volatile("" ::: "memory"); }
    }
};
struct EpiF32Unit {
    static constexpr bool PERM = false, AFTER_DRAIN = false;
    bf16_t* O;
    __device__ __forceinline__ void operator()(const f32x4 (&acc)[2][2][4][2], const Unit& u, int wr, int wc, int fr, int fq) const {
        bf16_t* base = O + (size_t)u.pn * 65536 + (size_t)(wr * 64 + fr) * 256 + wc * 32 + 4 * fq;
#pragma unroll
        for (int ai = 0; ai < 2; ++ai)
#pragma unroll
            for (int m = 0; m < 4; ++m)
#pragma unroll
                for (int bj = 0; bj < 2; ++bj)
#pragma unroll
                    for (int n = 0; n < 2; ++n) { const f32x4 v = acc[ai][bj][m][n]; u32x2 w; w.x = cvt_pk_bf16(v[0], v[1]); w.y = cvt_pk_bf16(v[2], v[3]); *(u32x2*)(base + (size_t)(ai * 128 + m * 16) * 256 + bj * 128 + n * 16) = w; }
    }
};
__device__ __forceinline__ void p4_scores_dc(const Ctx& F) {
    unsigned char* ws = F.ws;
    { Gemm g{512, DM, 256}; OrderUnitNT S{NUNIT, F.G, F.bid, (const char*)(ws + WS_PQ) + 512, 0, 0, (size_t)256 * 512 * 2, (const char*)(ws + WS_K), (size_t)256 * DM * 2, 512, 0};
      EpiScore E{(bf16_t*)(ws + WS_PQ), (const float*)(ws + WS_DA), (const float*)(ws + WS_DR), (float*)(ws + WS_DENP)}; pg8::gemm_phase<EpiScore, OrderUnitNT>(F.lds, g, S, E); }
    { Gemm g{512, 256, 256}; OrderUnitNT S{NUNIT, F.G, F.bid, (const char*)(ws + WS_VC), 0, 0, (size_t)256 * 512 * 2, (const char*)(ws + WS_WKT), 0, 0, (size_t)256 * 256 * 2};
      EpiF32Unit E{(bf16_t*)(F.out + O_Y)}; pg8::gemm_phase<EpiF32Unit, OrderUnitNT>(F.lds, g, S, E); }
}

__device__ __forceinline__ void p5_scan_sample(const Ctx& F0) { Ctx F = F0; asm volatile("" : "+v"(F.tid), "+v"(F.lane), "+s"(F.gw));
    unsigned char* ws = F.ws; const float* DG = (const float*)(ws + WS_DG); const bf16_t* DCb = (const bf16_t*)(F.out + O_Y); bf16_t* VC = (bf16_t*)(ws + WS_VC);
    for (int idx = F.bid * 512 + F.tid; idx < 32 * 16384; idx += F.G * 512) { const int bh = idx >> 14, q4 = idx & 16383, e = q4 >> 6, d4 = (q4 & 63) * 4, b = bh >> 2, h = bh & 3;
        f32x4 dc[8]; float ge[8];
#pragma unroll
        for (int c = 0; c < 8; ++c) { const u32x2 dw = __builtin_nontemporal_load((const u32x2*)(DCb + ((size_t)(bh * 8 + c) * 256 + e) * 256 + d4)); dc[c] = (f32x4){bf_lo(dw.x), bf_hi(dw.x), bf_lo(dw.y), bf_hi(dw.y)}; ge[c] = DG[(size_t)h * MA + b * SEQ + c * 256 + 255]; }
        f32x4 C = (f32x4){0.f, 0.f, 0.f, 0.f};
#pragma unroll
        for (int c = 0; c < 8; ++c) { u32x2 w; w.x = cvt_pk_bf16(C[0], C[1]); w.y = cvt_pk_bf16(C[2], C[3]); *(u32x2*)(VC + ((size_t)(bh * 8 + c) * 256 + e) * 512 + 256 + d4) = w; C = C * ge[c] + dc[c]; }
        __builtin_nontemporal_store(C, (f32x4*)(F.out + O_CP + ((size_t)bh * 256 + e) * 256 + d4)); }
    LAS float* npv = (LAS float*)F.lds;
    for (int u = F.bid; u < NUNIT; u += F.G) { const int bh = u >> 3, cc = u & 7, b = bh >> 2, h = bh & 3;
        __syncthreads();
        if (F.tid < 256) { float n = 0.f; const float* DN = (const float*)(ws + WS_DN4);
            for (int j = 0; j < cc; ++j) { const f32x4 dp = *(const f32x4*)(DN + ((size_t)(bh * 8 + j) * 256 + F.tid) * 4); n = DG[(size_t)h * MA + b * SEQ + j * 256 + 255] * n + ((dp[0] + dp[1]) + (dp[2] + dp[3])); }
            npv[F.tid] = n; const f32x4 dl = *(const f32x4*)(DN + ((size_t)u * 256 + F.tid) * 4); if (cc == 7) F.out[O_NP + (size_t)bh * 256 + F.tid] = DG[(size_t)h * MA + b * SEQ + 7 * 256 + 255] * n + ((dl[0] + dl[1]) + (dl[2] + dl[3])); }
        __syncthreads();
        const f32x4 nv = *(const LAS f32x4*)(npv + 4 * F.lane); const bf16_t* PQg = (const bf16_t*)(ws + WS_PQ);
        for (int r = 0; r < 32; ++r) { const size_t row = (size_t)b * SEQ + cc * 256 + F.wave * 32 + r; const u32x2 qq = *(const u32x2*)(PQg + ((size_t)u * 256 + F.wave * 32 + r) * 512 + 256 + 4 * F.lane);
            const float s = wave_sum(bf_lo(qq.x) * nv[0] + bf_hi(qq.x) * nv[1] + bf_lo(qq.y) * nv[2] + bf_hi(qq.y) * nv[3]); if (F.lane == 0) ((float*)(ws + WS_QN))[(size_t)h * MA + row] = s; } }

}


__device__ __forceinline__ void p5s_sample(const Ctx& F0) { Ctx F = F0; asm volatile("" : "+v"(F.tid), "+v"(F.lane), "+s"(F.gw));
    unsigned char* ws = F.ws;
    LAS float* hs = (LAS float*)F.lds + 512; LAS float* red = (LAS float*)F.lds + 1024;
    for (int job = F.bid; job < MS * HB; job += F.G) { const int i = job >> 2, h = job & 3; const size_t row = MP + i;
        const bf16_t* Q = (const bf16_t*)(ws + WS_Q) + row * 1024 + h * 256; const bf16_t* K = (const bf16_t*)(ws + WS_K) + row * 1024 + h * 256; const bf16_t* V = (const bf16_t*)(ws + WS_VS) + (size_t)i * 1024 + h * 256;
        const u32x2 qw = *(const u32x2*)(Q + 4 * F.lane), kw = *(const u32x2*)(K + 4 * F.lane);
        const f32x4 q4 = (f32x4){bf_lo(qw.x), bf_hi(qw.x), bf_lo(qw.y), bf_hi(qw.y)}, k4 = (f32x4){bf_lo(kw.x), bf_hi(kw.x), bf_lo(kw.y), bf_hi(kw.y)};
        const f32x4 n0 = *(const f32x4*)(F.in[3] + ((size_t)i * 4 + h) * 256 + 4 * F.lane);
        const float li = ((const float*)(ws + WS_GLI))[(size_t)h * MA + row], lf = ((const float*)(ws + WS_GLF))[(size_t)h * MA + row], m0 = F.in[4][i * 4 + h];
        const float mn = fmaxf(lf + m0, li), g = __expf(lf + m0 - mn), wi = __expf(li - mn);
        const float qk = wave_sum(q4[0] * k4[0] + q4[1] * k4[1] + q4[2] * k4[2] + q4[3] * k4[3]), nq = wave_sum(n0[0] * q4[0] + n0[1] * q4[1] + n0[2] * q4[2] + n0[3] * q4[3]);
        const float sc = wi * qk, den = sc + g * nq, dinv = 1.0f / fmaxf(fabsf(den), __expf(-mn));
        const float* C0 = F.in[2] + (((size_t)i * 4 + h) * 256 + F.wave * 32) * 256 + 4 * F.lane; float* C1 = F.out + O_CS + (((size_t)i * 4 + h) * 256 + F.wave * 32) * 256 + 4 * F.lane;
        __syncthreads();
#pragma unroll 1
        for (int r8 = 0; r8 < 32; r8 += 8) { f32x4 c[8]; float ve[8], cq[8];
#pragma unroll
            for (int r = 0; r < 8; ++r) { c[r] = __builtin_nontemporal_load((const f32x4*)(C0 + (size_t)(r8 + r) * 256)); ve[r] = bf2f(V[F.wave * 32 + r8 + r]); }
#pragma unroll
            for (int r = 0; r < 8; ++r) { cq[r] = c[r][0] * q4[0] + c[r][1] * q4[1] + c[r][2] * q4[2] + c[r][3] * q4[3]; const float wv = wi * ve[r]; __builtin_nontemporal_store(c[r] * g + k4 * wv, (f32x4*)(C1 + (size_t)(r8 + r) * 256)); }
#pragma unroll
            for (int r = 0; r < 8; ++r) { cq[r] = wave_sum(cq[r]); if (F.lane == 0) hs[F.wave * 32 + r8 + r] = (sc * ve[r] + g * cq[r]) * dinv; } }
        if (F.wave == 0) { *(f32x4*)(F.out + O_NS + ((size_t)i * 4 + h) * 256 + 4 * F.lane) = n0 * g + k4 * wi; if (F.lane == 0) F.out[O_MS + i * 4 + h] = mn; }
        __syncthreads();
        const bf16_t* PB = (const bf16_t*)(ws + WS_PROJB) + row * 3072; const bf16_t* XC = (const bf16_t*)(ws + WS_XB) + row * DM;
        float x = 0.f; const int ch = h * 256 + (F.tid & 255);
        if (F.tid < 256) x = hs[F.tid] * bf2f(PB[1024 + ch]);
        float p = wave_sum(x); if (F.lane == 0) red[F.wave] = p;
        __syncthreads();
        const float mu = (red[0] + red[1] + red[2] + red[3]) * (1.f / 256.f), dx = x - mu;
        __syncthreads();
        p = wave_sum(F.tid < 256 ? dx * dx : 0.f); if (F.lane == 0) red[F.wave] = p;
        __syncthreads();
        const float rstd = 1.0f / sqrtf((red[0] + red[1] + red[2] + red[3]) * (1.f / 256.f) + EPS);
        if (F.tid < 256) ((bf16_t*)(ws + WS_Y))[row * DMIX + 1024 + ch] = f2bf((dx * rstd * F.in[21][ch] + F.in[22][ch] * bf2f(XC[ch])) * bf2f(PB[2048 + ch]));
        __syncthreads();
    }
}
struct EpiHOut {
    static constexpr bool PERM = false, AFTER_DRAIN = true;
    const float* DENP; const float* DG; const float* QN; const float* DEM; const bf16_t* PB; const bf16_t* XC; bf16_t* Y; const float* gng; const float* skip;
    __device__ __forceinline__ void fused(f32x4 (&acc)[2][2][4][2], const Unit& u, int wr, int wc, int fr, int fq, LAS unsigned char* lds, int wid, int lane) const {
        const int h = u.aux, rl0 = wr * 64 + fr, col0 = wc * 32 + 4 * fq; const size_t vb = (size_t)h * MA + (size_t)u.pm * 256;
        LAS float* P1 = (LAS float*)lds; LAS float* P2 = (LAS float*)lds + 1024;
#pragma unroll
        for (int ai = 0; ai < 2; ++ai) { u32x2 ow[4][2][2]; f32x4 dp[4]; float dgq[4], dem[4];
#pragma unroll
            for (int m = 0; m < 4; ++m) { const int t = rl0 + ai * 128 + m * 16; const size_t row = (size_t)u.pm * 256 + t; dp[m] = *(const f32x4*)(DENP + (vb + t) * 4); dgq[m] = QN[vb + t]; dem[m] = DEM[vb + t];
#pragma unroll
                for (int bj = 0; bj < 2; ++bj)
#pragma unroll
                    for (int n = 0; n < 2; ++n) ow[m][bj][n] = *(const u32x2*)(PB + row * 3072 + 1024 + h * 256 + col0 + bj * 128 + n * 16); }
#pragma unroll
            for (int m = 0; m < 4; ++m) { const int t = rl0 + ai * 128 + m * 16; const float den = (dp[m][0] + dp[m][1]) + (dp[m][2] + dp[m][3]) + dgq[m];
                const float dinv = 1.0f / fmaxf(fabsf(den), dem[m]); float s = 0.f;
#pragma unroll
                for (int bj = 0; bj < 2; ++bj)
#pragma unroll
                    for (int n = 0; n < 2; ++n) { const u32x2 o2 = ow[m][bj][n];
                        f32x4 v = acc[ai][bj][m][n] * dinv; v[0] *= bf_lo(o2.x); v[1] *= bf_hi(o2.x); v[2] *= bf_lo(o2.y); v[3] *= bf_hi(o2.y); acc[ai][bj][m][n] = v; s += (v[0] + v[1]) + (v[2] + v[3]); }
                s += __shfl_xor(s, 16); s += __shfl_xor(s, 32); if (fq == 0) P1[t * 4 + wc] = s; } }
        asm volatile("s_waitcnt lgkmcnt(0)" ::: "memory"); __builtin_amdgcn_s_barrier(); asm volatile("" ::: "memory");
#pragma unroll
        for (int ai = 0; ai < 2; ++ai)
#pragma unroll
            for (int m = 0; m < 4; ++m) { const int t = rl0 + ai * 128 + m * 16; const f32x4 ps = *(const LAS f32x4*)(P1 + t * 4); const float mu = ((ps[0] + ps[1]) + (ps[2] + ps[3])) * (1.f / 256.f); float q = 0.f;
#pragma unroll
                for (int bj = 0; bj < 2; ++bj)
#pragma unroll
                    for (int n = 0; n < 2; ++n) { f32x4 v = acc[ai][bj][m][n] - mu; acc[ai][bj][m][n] = v; q += (v[0] * v[0] + v[1] * v[1]) + (v[2] * v[2] + v[3] * v[3]); }
                q += __shfl_xor(q, 16); q += __shfl_xor(q, 32); if (fq == 0) P2[t * 4 + wc] = q; }
        asm volatile("s_waitcnt lgkmcnt(0)" ::: "memory"); __builtin_amdgcn_s_barrier(); asm volatile("" ::: "memory");
#pragma unroll
        for (int ai = 0; ai < 2; ++ai) { u32x2 xw[4][2][2], zw[4][2][2];
#pragma unroll
            for (int m = 0; m < 4; ++m) { const int t = rl0 + ai * 128 + m * 16; const size_t row = (size_t)u.pm * 256 + t;
#pragma unroll
                for (int bj = 0; bj < 2; ++bj)
#pragma unroll
                    for (int n = 0; n < 2; ++n) { const int c = h * 256 + col0 + bj * 128 + n * 16; xw[m][bj][n] = *(const u32x2*)(XC + row * DM + c); zw[m][bj][n] = *(const u32x2*)(PB + row * 3072 + 2048 + c); } }
#pragma unroll
            for (int m = 0; m < 4; ++m) { const int t = rl0 + ai * 128 + m * 16; const size_t row = (size_t)u.pm * 256 + t; const f32x4 ps = *(const LAS f32x4*)(P2 + t * 4);
                const float rstd = 1.0f / sqrtf(((ps[0] + ps[1]) + (ps[2] + ps[3])) * (1.f / 256.f) + EPS);
#pragma unroll
                for (int bj = 0; bj < 2; ++bj)
#pragma unroll
                    for (int n = 0; n < 2; ++n) { const int c = h * 256 + col0 + bj * 128 + n * 16; const u32x2 x2 = xw[m][bj][n], z2 = zw[m][bj][n];
                        const f32x4 ggv = *(const f32x4*)(gng + c), skv = *(const f32x4*)(skip + c); const f32x4 v = acc[ai][bj][m][n] * rstd * ggv; u32x2 w;
                        w.x = cvt_pk_bf16((v[0] + skv[0] * bf_lo(x2.x)) * bf_lo(z2.x), (v[1] + skv[1] * bf_hi(x2.x)) * bf_hi(z2.x));
                        w.y = cvt_pk_bf16((v[2] + skv[2] * bf_lo(x2.y)) * bf_lo(z2.y), (v[3] + skv[3] * bf_hi(x2.y)) * bf_hi(z2.y));
                        *(u32x2*)(Y + row * DMIX + 1024 + c) = w; } } }
    }
};
__device__ __forceinline__ void p6_hout(const Ctx& F) {
    unsigned char* ws = F.ws; Gemm g{512, 512, 512};
    OrderUnitNT S{NUNIT, F.G, F.bid, (const char*)(ws + WS_PQ), 0, 0, (size_t)256 * 512 * 2, (const char*)(ws + WS_VC), 0, 0, (size_t)256 * 512 * 2};
    EpiHOut E{(const float*)(ws + WS_DENP), (const float*)(ws + WS_DG), (const float*)(ws + WS_QN), (const float*)(ws + WS_DEM), (const bf16_t*)(ws + WS_PROJB), (const bf16_t*)(ws + WS_XB), (bf16_t*)(ws + WS_Y), F.in[21], F.in[22]};
    pg8::gemm_phase<EpiHOut, OrderUnitNT, false, true>(F.lds, g, S, E);
}
template <class PtrF, class Ef>
__device__ __forceinline__ void sample_gemm(const Ctx& F, int nitems, int K, int lda, int ldb, const PtrF& P, const Ef& E) {
    int lane_ = F.lane; asm volatile("" : "+v"(lane_));
    const int l15 = lane_ & 15, lq = lane_ >> 4, w = F.wave;
    for (int item = F.bid; item < nitems; item += F.G) {
        const bf16_t* A; const bf16_t* B; P(item, A, B);
        const bf16_t* ap = A + (size_t)(16 * w + l15) * lda + 8 * lq; const bf16_t* bp = B + (size_t)l15 * ldb + 8 * lq;
        f32x4 acc = (f32x4){0.f, 0.f, 0.f, 0.f};
        for (int k0 = 0; k0 < K; k0 += 256) { bf16x8 a[8], b[8];
#pragma unroll
            for (int j = 0; j < 8; ++j) { a[j] = *(const bf16x8*)(ap + k0 + 32 * j); b[j] = *(const bf16x8*)(bp + k0 + 32 * j); }
#pragma unroll
            for (int j = 0; j < 8; ++j) acc = __builtin_amdgcn_mfma_f32_16x16x32_bf16(a[j], b[j], acc, 0, 0, 0); }
#pragma unroll
        for (int r = 0; r < 4; ++r) E(item, 16 * w + 4 * lq + r, l15, acc[r]);
    }
}
__device__ __forceinline__ void sample_inproj(const Ctx& F) {
    unsigned char* ws = F.ws; const bf16_t* XB = (const bf16_t*)(ws + WS_XB) + (size_t)MP * DM; const bf16_t* W = (const bf16_t*)(ws + WS_WIN);
    bf16_t* PA = (bf16_t*)(ws + WS_PROJA) + (size_t)MP * 3072; bf16_t* PB = (bf16_t*)(ws + WS_PROJB) + (size_t)MP * 3072; bf16_t* XB2 = (bf16_t*)(ws + WS_XB2) + (size_t)MP * DM; const float* rs = (const float*)(ws + WS_RS) + MP;
    sample_gemm(F, NIN / 16, DM, DM, DM,
        [=](int item, const bf16_t*& A, const bf16_t*& B) { A = XB; B = W + (size_t)item * 16 * DM; },
        [=](int item, int r, int c, float acc) { const int col = item * 16 + c, grp = col >> 10; float v = acc * rs[r];
            if (grp < 2) { const f32x2 g2 = gelu_pk((f32x2){v, v}); v = g2.x; } else if (grp == 2 || grp == 5) v = siluf_(v); else if (grp == 4) v = sigmoidf_(v);
            bf16_t* dst = col < 3072 ? PA + (size_t)r * 3072 + col : (col < 4096 ? XB2 + (size_t)r * DM + (col - 3072) : PB + (size_t)r * 3072 + (col - 3072)); *dst = f2bf(v); });
}
__device__ __forceinline__ void sample_qkv(const Ctx& F) {
    unsigned char* ws = F.ws; const bf16_t* XC = (const bf16_t*)(ws + WS_XB) + (size_t)MP * DM; const bf16_t* XBr = (const bf16_t*)(ws + WS_PROJB) + (size_t)MP * 3072;
    const bf16_t* WQ = (const bf16_t*)(ws + WS_WQ); const bf16_t* WK = (const bf16_t*)(ws + WS_WK); const bf16_t* WV = (const bf16_t*)(ws + WS_WV);
    bf16_t* Q = (bf16_t*)(ws + WS_Q) + (size_t)MP * 1024; bf16_t* Kk = (bf16_t*)(ws + WS_K) + (size_t)MP * 1024; bf16_t* Vs = (bf16_t*)(ws + WS_VS);
    sample_gemm(F, 128, 256, DM, 256,
        [=](int item, const bf16_t*& A, const bf16_t*& B) { const int which = item >> 6, it = item & 63, h = it >> 4; A = XC + h * 256; B = (which ? WK : WQ) + (size_t)h * 65536 + (size_t)(it & 15) * 16 * 256; },
        [=](int item, int r, int c, float acc) { const int which = item >> 6, it = item & 63; bf16_t* O = which ? Kk : Q; O[(size_t)r * 1024 + it * 16 + c] = f2bf(which ? acc * 0.0625f : acc); });
    sample_gemm(F, 64, 256, 3072, 256,
        [=](int item, const bf16_t*& A, const bf16_t*& B) { const int h = item >> 4; A = XBr + h * 256; B = WV + (size_t)h * 65536 + (size_t)(item & 15) * 16 * 256; },
        [=](int item, int r, int c, float acc) { Vs[(size_t)r * 1024 + item * 16 + c] = f2bf(acc); });
}
__device__ __forceinline__ void sample_outproj(const Ctx& F) {
    unsigned char* ws = F.ws; const bf16_t* Y = (const bf16_t*)(ws + WS_Y) + (size_t)MP * DMIX; const bf16_t* W = (const bf16_t*)(ws + WS_WOUT);
    const float* xs = F.in[1]; float* out = F.out + O_YS; bf16_t* X1B = (bf16_t*)(ws + WS_X1B) + (size_t)MP * DM;
    sample_gemm(F, DM / 16, DMIX, DMIX, DMIX,
        [=](int item, const bf16_t*& A, const bf16_t*& B) { A = Y; B = W + (size_t)item * 16 * DMIX; },
        [=](int item, int r, int c, float acc) { const int col = item * 16 + c; const float v = xs[(size_t)r * DM + col] + acc; out[(size_t)r * DM + col] = v; X1B[(size_t)r * DM + col] = f2bf(v); });
}
__device__ __forceinline__ void sample_ple(const Ctx& F) {
    unsigned char* ws = F.ws; const bf16_t* X1B = (const bf16_t*)(ws + WS_X1B) + (size_t)MP * DM; const bf16_t* PBs = (const bf16_t*)(ws + WS_PB) + (size_t)MP * DPLE;
    const bf16_t* WG = (const bf16_t*)(ws + WS_WPG); const bf16_t* WP = (const bf16_t*)(ws + WS_WPP); const float* bias = F.in[25];
    bf16_t* GB = (bf16_t*)(ws + WS_GB) + (size_t)MP * DM; bf16_t* EB = (bf16_t*)(ws + WS_EB) + (size_t)MP * DM;
    sample_gemm(F, DM / 16, DM, DM, DM,
        [=](int item, const bf16_t*& A, const bf16_t*& B) { A = X1B; B = WG + (size_t)item * 16 * DM; },
        [=](int item, int r, int c, float acc) { const int col = item * 16 + c; GB[(size_t)r * DM + col] = f2bf(sigmoidf_(acc + bias[col])); });
    sample_gemm(F, DM / 16, DPLE, DPLE, DPLE,
        [=](int item, const bf16_t*& A, const bf16_t*& B) { A = PBs; B = WP + (size_t)item * 16 * DPLE; },
        [=](int item, int r, int c, float acc) { EB[(size_t)r * DM + item * 16 + c] = f2bf(acc); });
}
template <class PtrF, class Ef>
__device__ __forceinline__ void sample_gemm_ks(const Ctx& F, int nitems, int K, int lda, int ldb, const PtrF& P, const Ef& E) {
    int lane_ = F.lane; asm volatile("" : "+v"(lane_)); const int l15 = lane_ & 15, lq = lane_ >> 4, w = F.wave; LAS f32x4* red = (LAS f32x4*)F.lds;
    const int ks = K >> 3;
    for (int item = F.bid; item < nitems; item += F.G) {
        const bf16_t* A; const bf16_t* B; P(item, A, B);
        const bf16_t* ap = A + (size_t)l15 * lda + w * ks + 8 * lq; const bf16_t* bp = B + (size_t)l15 * ldb + w * ks + 8 * lq;
        f32x4 acc[2][4];
#pragma unroll
        for (int m = 0; m < 2; ++m)
#pragma unroll
            for (int n = 0; n < 4; ++n) acc[m][n] = (f32x4){0.f, 0.f, 0.f, 0.f};
        for (int k0 = 0; k0 < ks; k0 += 128) { bf16x8 a[4][2], b[4][4];
#pragma unroll
            for (int j = 0; j < 4; ++j) {
#pragma unroll
                for (int m = 0; m < 2; ++m) a[j][m] = (k0 + 32 * j < ks) ? *(const bf16x8*)(ap + (size_t)(16 * m) * lda + k0 + 32 * j) : (bf16x8){0, 0, 0, 0, 0, 0, 0, 0};
#pragma unroll
                for (int n = 0; n < 4; ++n) b[j][n] = (k0 + 32 * j < ks) ? *(const bf16x8*)(bp + (size_t)(16 * n) * ldb + k0 + 32 * j) : (bf16x8){0, 0, 0, 0, 0, 0, 0, 0}; }
#pragma unroll
            for (int j = 0; j < 4; ++j)
#pragma unroll
                for (int m = 0; m < 2; ++m)
#pragma unroll
                    for (int n = 0; n < 4; ++n) acc[m][n] = __builtin_amdgcn_mfma_f32_16x16x32_bf16(a[j][m], b[j][n], acc[m][n], 0, 0, 0); }
        __syncthreads();
#pragma unroll
        for (int m = 0; m < 2; ++m)
#pragma unroll
            for (int n = 0; n < 4; ++n) red[(w * 8 + m * 4 + n) * 64 + F.lane] = acc[m][n];
        __syncthreads();
        f32x4 s = red[(0 * 8 + w) * 64 + F.lane];
#pragma unroll
        for (int ww = 1; ww < 8; ++ww) s = s + red[(ww * 8 + w) * 64 + F.lane];
        const int mt = w >> 2, nt = w & 3;
#pragma unroll
        for (int r = 0; r < 4; ++r) E(item, 16 * mt + 4 * lq + r, 16 * nt + l15, s[r]);
    }
    __syncthreads();
}
__device__ __forceinline__ void sample_outproj_ks(const Ctx& F) {
    unsigned char* ws = F.ws; const bf16_t* Y = (const bf16_t*)(ws + WS_Y) + (size_t)MP * DMIX; const bf16_t* W = (const bf16_t*)(ws + WS_WOUT);
    const float* xs = F.in[1]; float* out = F.out + O_YS; bf16_t* X1B = (bf16_t*)(ws + WS_X1B) + (size_t)MP * DM;
    sample_gemm_ks(F, 64, DMIX, DMIX, DMIX,
        [=](int item, const bf16_t*& A, const bf16_t*& B) { A = Y + (size_t)(item & 3) * 32 * DMIX; B = W + (size_t)(item >> 2) * 64 * DMIX; },
        [=](int item, int r, int c, float acc) { const int row = (item & 3) * 32 + r, col = (item >> 2) * 64 + c; const float v = xs[(size_t)row * DM + col] + acc; X1B[(size_t)row * DM + col] = f2bf(v); });
}
__device__ __forceinline__ void sample_ple_ks(const Ctx& F) {
    unsigned char* ws = F.ws; const bf16_t* X1B = (const bf16_t*)(ws + WS_X1B) + (size_t)MP * DM; const bf16_t* PBs = (const bf16_t*)(ws + WS_PB) + (size_t)MP * DPLE;
    const bf16_t* WG = (const bf16_t*)(ws + WS_WPG); const bf16_t* WP = (const bf16_t*)(ws + WS_WPP); const float* bias = F.in[25];
    bf16_t* GB = (bf16_t*)(ws + WS_GB) + (size_t)MP * DM; bf16_t* EB = (bf16_t*)(ws + WS_EB) + (size_t)MP * DM;
    sample_gemm_ks(F, 64, DM, DM, DM,
        [=](int item, const bf16_t*& A, const bf16_t*& B) { A = X1B + (size_t)(item & 3) * 32 * DM; B = WG + (size_t)(item >> 2) * 64 * DM; },
        [=](int item, int r, int c, float acc) { const int row = (item & 3) * 32 + r, col = (item >> 2) * 64 + c; GB[(size_t)row * DM + col] = f2bf(sigmoidf_(acc + bias[col])); });
    sample_gemm_ks(F, 64, DPLE, DPLE, DPLE,
        [=](int item, const bf16_t*& A, const bf16_t*& B) { A = PBs + (size_t)(item & 3) * 32 * DPLE; B = WP + (size_t)(item >> 2) * 64 * DPLE; },
        [=](int item, int r, int c, float acc) { const int row = (item & 3) * 32 + r, col = (item >> 2) * 64 + c; EB[(size_t)row * DM + col] = f2bf(acc); });
}
#define XB_TMO      128
#define XB_XCNT(j)  (256  + 64 * (j))
#define XB_XSUB(j)  (1280 + 64 * (j))
#define XB_XGEN(j)  (2304 + 64 * (j))
#define XB_TOP      3328
#define XB_TOPGEN   3392
#define XCD_BAR_WORDS 3456
#define XB_SPIN_CAP (1u << 18)
__device__ __forceinline__ unsigned xb_ld(unsigned* p)              { return __hip_atomic_load(p, __ATOMIC_RELAXED, __HIP_MEMORY_SCOPE_AGENT); }
__device__ __forceinline__ unsigned xb_add(unsigned* p, unsigned v) { return __hip_atomic_fetch_add(p, v, __ATOMIC_RELAXED, __HIP_MEMORY_SCOPE_AGENT); }
__device__ __forceinline__ unsigned xb_xcc_id() { return (unsigned)__builtin_amdgcn_s_getreg((3 << 11) | 20) & 0xFu; }
#define XB_SPIN(cond, bar) do { unsigned _sp = 0; while (cond) { __builtin_amdgcn_s_sleep(1); \
    if ((++_sp & 255u) == 0u) { if (xb_ld(&(bar)[XB_TMO])) break; if (_sp > XB_SPIN_CAP) { atomicAdd(&(bar)[XB_TMO], 1u); break; } } } } while (0)
struct XcdBarrier { unsigned* bar; unsigned x; volatile LAS unsigned* st; };
__device__ __forceinline__ XcdBarrier xcd_barrier_post(unsigned* bar, volatile LAS unsigned* st) {
    XcdBarrier b; b.bar = bar; b.x = xb_xcc_id(); b.st = st;
    if (threadIdx.x == 0) (void)xb_add(&bar[XB_XCNT(b.x)], 1u);
    return b;
}
__device__ __forceinline__ void xcd_barrier_complete(unsigned* bar, unsigned x, unsigned& nloc, unsigned& nx) {
    const unsigned G = gridDim.x * gridDim.y * gridDim.z;
    unsigned sum, cnt, mine, sp = 0u;
    for (;;) {
        sum = 0u; cnt = 0u; mine = 0u;
#pragma unroll
        for (unsigned j = 0; j < 16; ++j) { const unsigned c = xb_ld(&bar[XB_XCNT(j)]); sum += c; cnt += (c > 0u) ? 1u : 0u; mine = (j == x) ? c : mine; }
        if (sum == G) break;
        __builtin_amdgcn_s_sleep(1);
        if ((++sp & 255u) == 0u) { if (xb_ld(&bar[XB_TMO])) break; if (sp > XB_SPIN_CAP) { atomicAdd(&bar[XB_TMO], 1u); break; } }
    }
    nloc = mine > 0u ? mine : 1u; nx = cnt > 0u ? cnt : 1u;
}
__device__ __forceinline__ void xcd_barrier(const XcdBarrier& b) {
    asm volatile("s_waitcnt vmcnt(0)" ::: "memory");
    __syncthreads();
    if (threadIdx.x == 0) {
        unsigned* bar = b.bar;
        __builtin_amdgcn_s_waitcnt(0);
        unsigned nloc = b.st[0], nx = b.st[1];
        if (nloc == 0u) { xcd_barrier_complete(bar, b.x, nloc, nx); b.st[0] = nloc; b.st[1] = nx; }
        const unsigned old = xb_add(&bar[XB_XSUB(b.x)], 1u);
        const unsigned gen = old / nloc;
        if (old + 1u == (gen + 1u) * nloc) {
            __builtin_amdgcn_fence(__ATOMIC_RELEASE, "agent");
            asm volatile("s_waitcnt vmcnt(0)" ::: "memory");
            const unsigned og = xb_add(&bar[XB_TOP], 1u);
            const unsigned tg = og / nx;
            if (og + 1u == (tg + 1u) * nx) xb_add(&bar[XB_TOPGEN], 1u);
            else XB_SPIN(xb_ld(&bar[XB_TOPGEN]) == tg, bar);
            __builtin_amdgcn_fence(__ATOMIC_ACQUIRE, "agent");
            xb_add(&bar[XB_XGEN(b.x)], 1u);
            asm volatile("s_waitcnt vmcnt(0)" ::: "memory");
        } else {
            XB_SPIN(xb_ld(&bar[XB_XGEN(b.x)]) == gen, bar);
            __builtin_amdgcn_fence(__ATOMIC_ACQUIRE, "agent");
            asm volatile("s_waitcnt vmcnt(0)" ::: "memory");
        }
    }
    __syncthreads();
}
__global__ void __launch_bounds__(512, 2) mega(Args args) {
    MAKE_CTX();
    volatile LAS unsigned* MISC = (volatile LAS unsigned*)(F.lds + 131072 + 320);
    if (F.tid < 32) MISC[F.tid] = 0u;
    __syncthreads();
    const XcdBarrier bar = xcd_barrier_post((unsigned*)(ws + WS_CTL), MISC + 8);
#define GRID_SYNC() xcd_barrier(bar)
    p0_prologue(F);      GRID_SYNC();
    sample_inproj(F); p1_inproj(F); GRID_SYNC();
    p2a_conv_gates(F); p2b_spatial_units(F); GRID_SYNC();
    p2b_mscan(F); p3_s12(F); p2c_sample_rows(F); GRID_SYNC();
    p3_qkv(F);           GRID_SYNC();
    if (F.bid & 1) { p5s_sample(F); p4_scores_dc(F); } else { p4_scores_dc(F); p5s_sample(F); } GRID_SYNC();
    p5_scan_sample(F);   GRID_SYNC();
    p6_hout(F);          GRID_SYNC();
    sample_outproj_ks(F); p7_outproj(F); GRID_SYNC();
    p8_ple(F);           GRID_SYNC();
    p9_final(F);
}

extern "C" void kernel_launch(void* const* d_in, const int* in_sizes, int n_in, void* d_out, int out_size, void* d_ws, size_t ws_size, hipStream_t stream) {
    static int grid = 0;
    if (grid == 0) {
        if (n_in != 29 || (size_t)out_size != O_END || ws_size < WS_END) { fprintf(stderr, "kernel_launch: unexpected shapes (n_in %d out %d ws %zu)\n", n_in, out_size, ws_size); grid = -1; return; }
        int dev = 0, cus = 0, per_cu = 0;
        if (hipGetDevice(&dev) != hipSuccess || hipDeviceGetAttribute(&cus, hipDeviceAttributeMultiprocessorCount, dev) != hipSuccess) { grid = -1; return; }
        if (hipFuncSetAttribute((const void*)mega, hipFuncAttributeMaxDynamicSharedMemorySize, LDS_BYTES) != hipSuccess) { fprintf(stderr, "kernel_launch: hipFuncSetAttribute failed\n"); grid = -1; return; }
        if (hipOccupancyMaxActiveBlocksPerMultiprocessor(&per_cu, (const void*)mega, 512, LDS_BYTES) != hipSuccess || per_cu < 1) { fprintf(stderr, "kernel_launch: occupancy query says %d\n", per_cu); grid = -1; return; }
        (void)hipGetLastError();
        grid = cus;
        if (grid != 256) { fprintf(stderr, "kernel_launch: this kernel is laid out for 256 CUs, got %d\n", grid); grid = -1; return; }
    }
    if (grid < 0) return;
    if (hipMemsetAsync((unsigned char*)d_ws + WS_CTL, 0, 16384, stream) != hipSuccess) { fprintf(stderr, "kernel_launch: memset failed\n"); return; }
    Args a{};
    for (int i = 0; i < 29; ++i) a.in[i] = (const float*)d_in[i];
    a.out = (float*)d_out; a.ws = (unsigned char*)d_ws;
    void* kargs[] = {&a};
    hipError_t e = hipLaunchCooperativeKernel((const void*)mega, dim3(grid), dim3(512), kargs, LDS_BYTES, stream);
    if (e != hipSuccess) fprintf(stderr, "kernel_launch: cooperative launch failed: %s (grid %d)\n", hipGetErrorString(e), grid);
}
```

```cpp
#include <hip/hip_runtime.h>
#include <hip/hip_cooperative_groups.h>
#include <cstdio>
#include <cstdint>
namespace cg = cooperative_groups;

#define LAS __attribute__((address_space(3)))
typedef unsigned short bf16_t;
typedef short bf16x8 __attribute__((ext_vector_type(8)));
typedef float f32x4 __attribute__((ext_vector_type(4)));
typedef float f32x2 __attribute__((ext_vector_type(2)));
typedef unsigned u32x4 __attribute__((ext_vector_type(4)));
typedef unsigned u32x2 __attribute__((ext_vector_type(2)));

constexpr int DM = 1024, SEQ = 2048, NB = 8, MP = NB * SEQ, MS = 128, MA = MP + 256, NTILE = MA / 256;
constexpr int NIN = 6144, WA = 1024, WB = 1024, HA = 8, DHA = 128, HB = 4, DHB = 256, DPLE = 256, DMIX = 2048;
constexpr int LC = 256, NCH = SEQ / LC;
constexpr int NUNIT = NB * HB * NCH;
constexpr float EPS = 1e-6f;

constexpr size_t O_Y = 0, O_YS = 16777216, O_CP = 16908288, O_NP = 19005440, O_MP = 19013632, O_CVP = 19013664, O_CS = 19038240, O_NS = 52592672, O_MS = 52723744, O_CVS = 52724256, O_VS = 53117472, O_END = 53248544;

constexpr size_t MiB = 1u << 20;
constexpr size_t WS_CTL = 0, WS_WIN = 1 * MiB, WS_WQ = 13 * MiB, WS_WK = WS_WQ + MiB / 2, WS_WV = 14 * MiB, WS_WOUT = WS_WV + MiB / 2, WS_WPG = WS_WOUT + 4 * MiB, WS_WPP = WS_WPG + 2 * MiB,
    WS_WSP = 21 * MiB, WS_WG = WS_WSP + MiB / 4, WS_RS = WS_WG + MiB / 4, WS_GLI = 22 * MiB, WS_GLF = WS_GLI + MiB / 2, WS_DA = 23 * MiB, WS_DR = WS_DA + MiB / 2, WS_DG = 24 * MiB, WS_DEM = WS_DG + MiB / 2,
    WS_DW = 25 * MiB, WS_QN = WS_DW + MiB / 2, WS_DENP = 26 * MiB, WS_DN = 27 * MiB, WS_VS = WS_DN + MiB / 2, WS_PB = 28 * MiB, WS_XB = 37 * MiB, WS_PROJA = 70 * MiB, WS_PROJB = 168 * MiB,
    WS_PQ = 266 * MiB, WS_VC = 330 * MiB, WS_Y = 394 * MiB, WS_XB2 = 460 * MiB, WS_DN4 = 493 * MiB, WS_END = 495 * MiB;
constexpr size_t WS_WGB = WS_RS + MiB / 8;
constexpr size_t WS_Q = WS_PROJA, WS_K = WS_Q + 33 * MiB, WS_WKT = WS_K + 33 * MiB;
constexpr size_t WS_X1B = WS_PROJA, WS_GB = WS_X1B + 33 * MiB, WS_EB = WS_GB + 33 * MiB;
static_assert(WS_WKT + 32 * MiB <= WS_PROJB && WS_EB + 33 * MiB <= WS_PQ, "ws map");

__device__ __forceinline__ unsigned cvt_pk_bf16(float lo, float hi) { unsigned r; asm volatile("v_cvt_pk_bf16_f32 %0, %1, %2" : "=v"(r) : "v"(lo), "v"(hi)); return r; }
__device__ __forceinline__ float bf_lo(unsigned w) { return __uint_as_float(w << 16); }
__device__ __forceinline__ float bf_hi(unsigned w) { return __uint_as_float(w & 0xffff0000u); }
__device__ __forceinline__ float bf2f(bf16_t b) { return __uint_as_float(((unsigned)b) << 16); }
__device__ __forceinline__ bf16_t f2bf(float f) { return (bf16_t)(cvt_pk_bf16(f, 0.f) & 0xffffu); }
__device__ __forceinline__ float fast_exp(float x) { return __builtin_amdgcn_exp2f(x * 1.4426950408889634f); }
__device__ __forceinline__ float sigmoidf_(float x) { return __builtin_amdgcn_rcpf(1.0f + fast_exp(-x)); }
__device__ __forceinline__ float siluf_(float x) { return x * sigmoidf_(x); }
__device__ __forceinline__ f32x2 gelu_pk(f32x2 v) {
    const f32x2 av = __builtin_elementwise_abs(v), d = av * 0.2316418882f + 1.0f;
    f32x2 t; t.x = __builtin_amdgcn_rcpf(d.x); t.y = __builtin_amdgcn_rcpf(d.y);
    f32x2 q = t * 0.5307027145f + (-0.7265760135f); q = q * t + 0.7107068705f; q = q * t + (-0.142248368f); q = q * t + 0.127414796f; q = q * t;
    const f32x2 s = (v * v) * (-0.72134752044f);
    f32x2 e; e.x = __builtin_amdgcn_exp2f(s.x); e.y = __builtin_amdgcn_exp2f(s.y);
    const f32x2 m = v * (q * e), r = v - m;
    f32x2 o; o.x = v.x < 0.f ? m.x : r.x; o.y = v.y < 0.f ? m.y : r.y; return o;
}
__device__ __forceinline__ float dpp_add(float v, const int ctrl_sel) {
    const int iv = __builtin_bit_cast(int, v); int r;
    if (ctrl_sel == 0) r = __builtin_amdgcn_update_dpp(0, iv, 0xB1, 0xF, 0xF, true);
    else if (ctrl_sel == 1) r = __builtin_amdgcn_update_dpp(0, iv, 0x4E, 0xF, 0xF, true);
    else if (ctrl_sel == 2) r = __builtin_amdgcn_update_dpp(0, iv, 0x141, 0xF, 0xF, true);
    else r = __builtin_amdgcn_update_dpp(0, iv, 0x140, 0xF, 0xF, true);
    return v + __builtin_bit_cast(float, r);
}
__device__ __forceinline__ float wave_sum(float v) {
    v = dpp_add(v, 0); v = dpp_add(v, 1); v = dpp_add(v, 2); v = dpp_add(v, 3);
    const int iv = __builtin_bit_cast(int, v);
    const float r0 = __builtin_bit_cast(float, __builtin_amdgcn_readlane(iv, 0)), r1 = __builtin_bit_cast(float, __builtin_amdgcn_readlane(iv, 16)),
                r2 = __builtin_bit_cast(float, __builtin_amdgcn_readlane(iv, 32)), r3 = __builtin_bit_cast(float, __builtin_amdgcn_readlane(iv, 48));
    return (r0 + r1) + (r2 + r3);
}
#define LDS_WAIT() asm volatile("s_waitcnt lgkmcnt(0)" ::: "memory")

namespace pg8 {
constexpr int BM = 256, BK = 64, HALF = 128, HTB = HALF * BK * 2, STAGE_BYTES = 8 * HTB;
__host__ __device__ __forceinline__ int lds_byte(int r, int c) { const int st = (r >> 4) * 2 + (c >> 5), rr = r & 15, cc = c & 31, ob = rr * 64 + cc * 2; return st * 1024 + (ob ^ (((ob >> 9) & 1) << 5)); }
__host__ __device__ __forceinline__ void stage_rc(int b, int& R, int& C) { const int st = b / 1024, sb = b % 1024, swz = sb ^ (((sb >> 9) & 1) << 5); R = (st >> 1) * 16 + swz / 64; C = (st & 1) * 32 + (swz % 64) / 2; }
__host__ __device__ __forceinline__ int perm32(int rho) { const int n = rho >> 4, i = rho & 15; return 8 * (i >> 2) + 4 * n + (i & 3); }

struct Unit { const char* a; const char* b; int pm, pn, aux; };
struct Gemm { int lda, ldb, K; };

template <class Epi, class Sched, bool ALIGN_EPI = true, bool SP2 = true>
__device__ __forceinline__ void gemm_phase(LAS unsigned char* lds, const Gemm g, const Sched& S, const Epi& E) {
    int tid_ = threadIdx.x; asm volatile("" : "+v"(tid_));
    const int tid = tid_, wid = __builtin_amdgcn_readfirstlane(tid >> 6), lane = tid & 63, wr = wid >> 2, wc = wid & 3, fr = lane & 15, fq = lane >> 4;
    int K_ = g.K; asm volatile("" : "+s"(K_)); const int K = K_, nt = K / BK; (void)K;
    unsigned voffA[2], voffB[2];
#pragma unroll
    for (int i = 0; i < 2; ++i) { int R, C; stage_rc(tid * 16 + i * 8192, R, C); const int Rb = Epi::PERM ? ((R & ~31) + perm32(R & 31)) : R;
        voffA[i] = (unsigned)(R * g.lda + C) * 2u; voffB[i] = (unsigned)(Rb * g.ldb + C) * 2u; }
    const size_t kstep = (size_t)(BK * 2);
    const size_t hstepA = (size_t)HALF * g.lda * 2, hstepB = (size_t)HALF * g.ldb * 2;
    const unsigned ldsw = (unsigned)wid * 1024u;
    const int aoff = lds_byte(wr * 64 + fr, fq * 8), boff = lds_byte(wc * 32 + fr, fq * 8);
#define PG8_SA(b, h) (((b) * 2 + (h)) * HTB)
#define PG8_SB(b, h) ((4 + (b) * 2 + (h)) * HTB)
#define PG8_STAGE(bufoff, gbase, voff) do { _Pragma("unroll") for (int _i = 0; _i < 2; ++_i) \
        __builtin_amdgcn_global_load_lds((const unsigned*)((const char*)(gbase) + (voff)[_i]), (LAS unsigned*)(lds + (bufoff) + ldsw + _i * 8192), 16, 0, 0); } while (0)
#define PG8_LDA(dst, b, h) do { _Pragma("unroll") for (int m = 0; m < 4; ++m) _Pragma("unroll") for (int k = 0; k < 2; ++k) dst[m][k] = *(const LAS bf16x8*)(lds + PG8_SA(b, h) + aoff + m * 2048 + k * 1024); } while (0)
#define PG8_LDB(dst, b, h) do { _Pragma("unroll") for (int n = 0; n < 2; ++n) _Pragma("unroll") for (int k = 0; k < 2; ++k) dst[n][k] = *(const LAS bf16x8*)(lds + PG8_SB(b, h) + boff + n * 2048 + k * 1024); } while (0)
#define PG8_MMA(ai, bj, At, Bt) do { __builtin_amdgcn_s_setprio(1); _Pragma("unroll") for (int m = 0; m < 4; ++m) _Pragma("unroll") for (int n = 0; n < 2; ++n) _Pragma("unroll") for (int k = 0; k < 2; ++k) \
        acc[ai][bj][m][n] = __builtin_amdgcn_mfma_f32_16x16x32_bf16(Bt[n][k], At[m][k], acc[ai][bj][m][n], 0, 0, 0); __builtin_amdgcn_s_setprio(0); } while (0)
#define PG8_WAIT_V(n) asm volatile("s_waitcnt vmcnt(" #n ")" ::: "memory")
#define PG8_WAIT_L(n) asm volatile("s_waitcnt lgkmcnt(" #n ")" ::: "memory")
#define PG8_BAR __builtin_amdgcn_s_barrier()
#define PG8_SCHED __builtin_amdgcn_sched_barrier(0)
    Unit cur, nxt; int ui = 0;
    if (!S.next(0, cur)) return;
    f32x4 acc[2][2][4][2];
#pragma unroll
    for (int a = 0; a < 2; ++a)
#pragma unroll
        for (int b = 0; b < 2; ++b)
#pragma unroll
            for (int m = 0; m < 4; ++m)
#pragma unroll
                for (int n = 0; n < 2; ++n) acc[a][b][m][n] = (f32x4){0.f, 0.f, 0.f, 0.f};
    bf16x8 At[4][2], B0[2][2], B1[2][2];
    const char* cA = cur.a; const char* cB = cur.b;
    if constexpr (SP2) {
        PG8_STAGE(PG8_SB(0, 0), cB, voffB); PG8_STAGE(PG8_SB(0, 1), cB + hstepB, voffB); PG8_STAGE(PG8_SA(0, 0), cA, voffA); PG8_STAGE(PG8_SA(0, 1), cA + hstepA, voffA);
        if (wr == 1) PG8_BAR;
        PG8_WAIT_V(2); PG8_BAR;
        PG8_STAGE(PG8_SB(1, 0), cB + kstep, voffB); PG8_STAGE(PG8_SA(1, 0), cA + kstep, voffA); PG8_STAGE(PG8_SB(1, 1), cB + hstepB + kstep, voffB);
        PG8_WAIT_V(6); PG8_BAR;
    } else {
        PG8_STAGE(PG8_SB(0, 0), cB, voffB); PG8_STAGE(PG8_SA(0, 0), cA, voffA); PG8_STAGE(PG8_SB(0, 1), cB + hstepB, voffB); PG8_STAGE(PG8_SA(0, 1), cA + hstepA, voffA);
        if (wr == 1) PG8_BAR;
        PG8_WAIT_V(4); PG8_BAR;
        PG8_STAGE(PG8_SB(1, 0), cB + kstep, voffB); PG8_STAGE(PG8_SA(1, 0), cA + kstep, voffA); PG8_STAGE(PG8_SB(1, 1), cB + hstepB + kstep, voffB);
        PG8_WAIT_V(6); PG8_BAR;
    }
    for (;;) {
        const bool has_next = S.next(ui + 1, nxt);
        const char* nA = has_next ? nxt.a : cA; const char* nB = has_next ? nxt.b : cB;
#pragma unroll 1
        for (int t = 0; t < nt; t += 2) {
            const bool last = (t == nt - 2);
            const char* a1 = cA + (size_t)(t + 1) * kstep;
            const char* a2 = last ? nA : cA + (size_t)(t + 2) * kstep; const char* b2 = last ? nB : cB + (size_t)(t + 2) * kstep;
            const char* a3 = a2 + kstep; const char* b3 = b2 + kstep;
            if constexpr (SP2) {
            PG8_LDB(B0, 0, 0); PG8_LDB(B1, 0, 1); PG8_SCHED; PG8_LDA(At, 0, 0); PG8_STAGE(PG8_SA(1, 1), a1 + hstepA, voffA);
            PG8_WAIT_V(8); PG8_WAIT_L(0); PG8_BAR; PG8_MMA(0, 0, At, B0); PG8_MMA(0, 1, At, B1); PG8_BAR; PG8_SCHED;
            PG8_LDA(At, 0, 1); PG8_STAGE(PG8_SB(0, 0), b2, voffB); PG8_STAGE(PG8_SB(0, 1), b2 + hstepB, voffB); PG8_STAGE(PG8_SA(0, 0), a2, voffA);
            PG8_WAIT_V(8); PG8_WAIT_L(0); PG8_BAR; PG8_MMA(1, 0, At, B0); PG8_MMA(1, 1, At, B1); PG8_BAR; PG8_SCHED;
            PG8_LDB(B0, 1, 0); PG8_LDB(B1, 1, 1); PG8_SCHED; PG8_LDA(At, 1, 0); PG8_STAGE(PG8_SA(0, 1), a2 + hstepA, voffA);
            PG8_WAIT_V(8); PG8_WAIT_L(0); PG8_BAR; PG8_MMA(0, 0, At, B0); PG8_MMA(0, 1, At, B1); PG8_BAR; PG8_SCHED;
            PG8_LDA(At, 1, 1); PG8_STAGE(PG8_SB(1, 0), b3, voffB); PG8_STAGE(PG8_SB(1, 1), b3 + hstepB, voffB); PG8_STAGE(PG8_SA(1, 0), a3, voffA);
            PG8_WAIT_V(8); PG8_WAIT_L(0); PG8_BAR; PG8_MMA(1, 0, At, B0); PG8_MMA(1, 1, At, B1); PG8_BAR; PG8_SCHED;
            } else {
            PG8_LDB(B0, 0, 0); PG8_SCHED; PG8_LDA(At, 0, 0); PG8_STAGE(PG8_SA(1, 1), a1 + hstepA, voffA);
            PG8_WAIT_L(8); PG8_BAR; PG8_WAIT_L(0); PG8_MMA(0, 0, At, B0); PG8_BAR; PG8_SCHED;
            PG8_LDB(B1, 0, 1); PG8_STAGE(PG8_SB(0, 0), b2, voffB);
            PG8_BAR; PG8_WAIT_L(0); PG8_MMA(0, 1, At, B1); PG8_BAR;
            PG8_LDA(At, 0, 1); PG8_STAGE(PG8_SA(0, 0), a2, voffA);
            PG8_BAR; PG8_WAIT_L(0); PG8_MMA(1, 0, At, B0); PG8_BAR; PG8_SCHED;
            PG8_STAGE(PG8_SB(0, 1), b2 + hstepB, voffB);
            PG8_WAIT_V(6); PG8_BAR; PG8_MMA(1, 1, At, B1); PG8_BAR;
            PG8_LDB(B0, 1, 0); PG8_SCHED; PG8_LDA(At, 1, 0); PG8_STAGE(PG8_SA(0, 1), a2 + hstepA, voffA);
            PG8_WAIT_L(8); PG8_BAR; PG8_WAIT_L(0); PG8_MMA(0, 0, At, B0); PG8_BAR; PG8_SCHED;
            PG8_LDB(B1, 1, 1); PG8_STAGE(PG8_SB(1, 0), b3, voffB);
            PG8_BAR; PG8_WAIT_L(0); PG8_MMA(0, 1, At, B1); PG8_BAR;
            PG8_LDA(At, 1, 1); PG8_STAGE(PG8_SA(1, 0), a3, voffA);
            PG8_BAR; PG8_WAIT_L(0); PG8_MMA(1, 0, At, B0); PG8_BAR; PG8_SCHED;
            PG8_STAGE(PG8_SB(1, 1), b3 + hstepB, voffB);
            PG8_WAIT_V(6); PG8_BAR; PG8_MMA(1, 1, At, B1); PG8_BAR;
            }
        }
        if constexpr (ALIGN_EPI) { if (wr == 0) PG8_BAR; }
        if constexpr (!Epi::AFTER_DRAIN) { E(acc, cur, wr, wc, fr, fq); }
        if (!has_next) break;
#pragma unroll
        for (int a = 0; a < 2; ++a)
#pragma unroll
            for (int b = 0; b < 2; ++b)
#pragma unroll
                for (int m = 0; m < 4; ++m)
#pragma unroll
                    for (int n = 0; n < 2; ++n) acc[a][b][m][n] = (f32x4){0.f, 0.f, 0.f, 0.f};
        cur = nxt; cA = nA; cB = nB; ++ui;
        if constexpr (ALIGN_EPI) { if (wr == 1) PG8_BAR; }
    }
    PG8_WAIT_V(0);
    if constexpr (!ALIGN_EPI) { if (wr == 0) PG8_BAR; }
    PG8_BAR;
    if constexpr (Epi::AFTER_DRAIN) { E.fused(acc, cur, wr, wc, fr, fq, lds, wid, lane); }
#undef PG8_SA
#undef PG8_SB
#undef PG8_STAGE
#undef PG8_LDA
#undef PG8_LDB
#undef PG8_MMA
#undef PG8_WAIT_V
#undef PG8_WAIT_L
#undef PG8_BAR
#undef PG8_SCHED
}
}
using pg8::Unit; using pg8::Gemm;

constexpr int LDS_BYTES = 147456;
struct Args { const float* in[29]; float* out; unsigned char* ws; };

struct Ctx {
    LAS unsigned char* lds; int tid, lane, wave, G, bid, gw, NGW;
    const float* const* in; float* out; unsigned char* ws;
};

struct TDesc { const float* W; bf16_t* WT; const float* ksc; int ldw, ldt, k0, n0; };
constexpr int I_WIN = 16 * 192, I_QKV = 12 * 4 * 8, I_WOUT = 32 * 32, I_WPG = 16 * 32, I_WPP = 4 * 32, I_T = I_WIN + I_QKV + I_WOUT + I_WPG + I_WPP;
__device__ __forceinline__ TDesc p0_decode(const Ctx& F, int r) {
    unsigned char* ws = F.ws; TDesc d; d.ksc = nullptr;
    if (r < I_WIN) { d.W = F.in[9]; d.ldw = NIN; d.WT = (bf16_t*)(ws + WS_WIN); d.ldt = DM; d.ksc = F.in[8]; d.k0 = 64 * (r / 192); d.n0 = 32 * (r % 192); return d; } r -= I_WIN;
    if (r < I_QKV) { const int mat = r / 32, rr = r % 32, which = mat / 4, h = mat % 4;
        d.W = F.in[16 + which] + (size_t)h * 65536; d.WT = (bf16_t*)(ws + (which == 0 ? WS_WQ : which == 1 ? WS_WK : WS_WV)) + (size_t)h * 65536; d.ldw = 256; d.ldt = 256; d.k0 = 64 * (rr / 8); d.n0 = 32 * (rr % 8); return d; } r -= I_QKV;
    if (r < I_WOUT) { d.W = F.in[23]; d.ldw = DM; d.WT = (bf16_t*)(ws + WS_WOUT); d.ldt = DMIX; d.k0 = 64 * (r / 32); d.n0 = 32 * (r % 32); return d; } r -= I_WOUT;
    if (r < I_WPG) { d.W = F.in[24]; d.ldw = DM; d.WT = (bf16_t*)(ws + WS_WPG); d.ldt = DM; d.k0 = 64 * (r / 32); d.n0 = 32 * (r % 32); return d; } r -= I_WPG;
    d.W = F.in[26]; d.ldw = DM; d.WT = (bf16_t*)(ws + WS_WPP); d.ldt = DPLE; d.k0 = 64 * (r / 32); d.n0 = 32 * (r % 32); return d;
}

__device__ __forceinline__ void p0_prologue(const Ctx& F0) { Ctx F = F0; asm volatile("" : "+v"(F.tid), "+v"(F.lane), "+s"(F.gw));
    LAS float* scr = (LAS float*)(F.lds + F.wave * 16384);
    unsigned char* ws = F.ws; const int lane = F.lane;
    {
        float wv[3][32]; f32x4 ks[3][2]; TDesc td[3];
#pragma unroll
        for (int k = 0; k < 3; ++k) { const int it = F.gw + k * F.NGW;
            if (it < I_T) { td[k] = p0_decode(F, it); const int c = lane & 7;
#pragma unroll
                for (int i = 0; i < 32; ++i) { const int kk = 2 * i + (lane >> 5); wv[k][i] = __builtin_nontemporal_load(td[k].W + (size_t)(td[k].k0 + kk) * td[k].ldw + td[k].n0 + (lane & 31)); }
                if (td[k].ksc) { ks[k][0] = *(const f32x4*)(td[k].ksc + td[k].k0 + 8 * c); ks[k][1] = *(const f32x4*)(td[k].ksc + td[k].k0 + 8 * c + 4); }
                else { ks[k][0] = (f32x4){1.f, 1.f, 1.f, 1.f}; ks[k][1] = ks[k][0]; } } }
#pragma unroll
        for (int k = 0; k < 3; ++k) { const int it = F.gw + k * F.NGW;
            if (it < I_T) { const int c = lane & 7;
#pragma unroll
                for (int i = 0; i < 32; ++i) { const int kk = 2 * i + (lane >> 5); scr[kk * 33 + (lane & 31)] = wv[k][i]; }
                LDS_WAIT(); asm volatile("" ::: "memory");
#pragma unroll
                for (int j = 0; j < 4; ++j) { const int n = (lane >> 3) + 8 * j; const LAS float* s = scr + (8 * c) * 33 + n;
                    u32x4 o; o.x = cvt_pk_bf16(s[0 * 33] * ks[k][0][0], s[1 * 33] * ks[k][0][1]); o.y = cvt_pk_bf16(s[2 * 33] * ks[k][0][2], s[3 * 33] * ks[k][0][3]);
                    o.z = cvt_pk_bf16(s[4 * 33] * ks[k][1][0], s[5 * 33] * ks[k][1][1]); o.w = cvt_pk_bf16(s[6 * 33] * ks[k][1][2], s[7 * 33] * ks[k][1][3]);
                    *(u32x4*)(td[k].WT + (size_t)(td[k].n0 + n) * td[k].ldt + td[k].k0 + 8 * c) = o; }
                LDS_WAIT(); asm volatile("" ::: "memory"); } }
    }
    constexpr int I_SP = 1024, I_WG = 1024, I_YPAD = 128;
    for (int r = F.gw; r < I_SP + I_WG + I_YPAD; r += F.NGW) {
        if (r < I_SP) {
            const int t = r & 127; const float* wrow = F.in[12] + (size_t)r * 128; const f32x2 v = ((const f32x2*)wrow)[lane];
            const int s0 = 2 * lane; ((unsigned*)((bf16_t*)(ws + WS_WSP) + (size_t)r * 128))[lane] = cvt_pk_bf16(s0 <= t ? v.x : 0.f, s0 + 1 <= t ? v.y : 0.f);
            continue;
        }
        if (r < I_SP + I_WG) {
            const int i = r - I_SP, h = i >> 8, d = i & 255; const float* wif = F.in[19];
            const f32x4 wq4 = *(const f32x4*)(F.in[16] + ((size_t)h * 256 + d) * 256 + 4 * lane), wk4 = *(const f32x4*)(F.in[17] + ((size_t)h * 256 + d) * 256 + 4 * lane), wv4 = *(const f32x4*)(F.in[18] + ((size_t)h * 256 + d) * 256 + 4 * lane);
            float sx[8], sb[8];
#pragma unroll
            for (int j = 0; j < 8; ++j) { sx[j] = 0.f; sb[j] = 0.f; }
#pragma unroll
            for (int e = 0; e < 4; ++e) { const size_t rq = (size_t)(h * 256 + 4 * lane + e) * 8;
                const f32x4 q0 = *(const f32x4*)(wif + rq), q1 = *(const f32x4*)(wif + rq + 4), k0 = *(const f32x4*)(wif + 8192 + rq), k1 = *(const f32x4*)(wif + 8192 + rq + 4), v0 = *(const f32x4*)(wif + 16384 + rq), v1 = *(const f32x4*)(wif + 16384 + rq + 4);
#pragma unroll
                for (int j = 0; j < 4; ++j) { sx[j] += wq4[e] * q0[j] + wk4[e] * k0[j]; sx[4 + j] += wq4[e] * q1[j] + wk4[e] * k1[j]; sb[j] += wv4[e] * v0[j]; sb[4 + j] += wv4[e] * v1[j]; } }
#pragma unroll
            for (int j = 0; j < 8; ++j) { sx[j] = wave_sum(sx[j]); sb[j] = wave_sum(sb[j]); }
            float s = 0.f;
#pragma unroll
            for (int j = 0; j < 8; ++j) { s = (lane == j) ? sx[j] : s; s = (lane == 8 + j) ? sb[j] : s; }
            if (lane < 16) ((float*)(ws + WS_WG))[(size_t)i * 16 + lane] = s;
            if (lane < 16) { bf16_t* wgb = (bf16_t*)(ws + WS_WGB) + (size_t)(lane >> 3) * 16384 + (size_t)(lane & 7) * 1024 + i; wgb[0] = f2bf(s); wgb[8 * 1024] = 0; }
            continue;
        }
        {
            u32x4* yrow = (u32x4*)((bf16_t*)(ws + WS_Y) + (size_t)(MP + MS + (r - I_SP - I_WG)) * DMIX) + lane;
#pragma unroll
            for (int j = 0; j < 4; ++j) yrow[64 * j] = (u32x4){0u, 0u, 0u, 0u};
        }
    }
    {
        float* rs = (float*)(ws + WS_RS);
        const int r0 = F.gw * 8; const bool smp = F.gw < MS;
        f32x4 v[8][4], vs[4], pv[8], ps;
#pragma unroll
        for (int q = 0; q < 8; ++q) { const float* xrow = F.in[0] + (size_t)(r0 + q) * DM;
#pragma unroll
            for (int j = 0; j < 4; ++j) v[q][j] = __builtin_nontemporal_load((const f32x4*)xrow + lane + 64 * j); }
#pragma unroll
        for (int q = 0; q < 8; ++q) pv[q] = __builtin_nontemporal_load((const f32x4*)(F.in[6] + (size_t)(r0 + q) * DPLE) + lane);
        if (smp) {
#pragma unroll
            for (int j = 0; j < 4; ++j) vs[j] = __builtin_nontemporal_load((const f32x4*)(F.in[1] + (size_t)F.gw * DM) + lane + 64 * j);
            ps = __builtin_nontemporal_load((const f32x4*)(F.in[7] + (size_t)F.gw * DPLE) + lane); }
        auto xrow_out = [&](int r, const f32x4 (&vv)[4]) { float sq = 0.f;
#pragma unroll
            for (int j = 0; j < 4; ++j) sq += (vv[j].x * vv[j].x + vv[j].y * vv[j].y) + (vv[j].z * vv[j].z + vv[j].w * vv[j].w);
            sq = wave_sum(sq); unsigned long long* o8 = (unsigned long long*)((bf16_t*)(ws + WS_XB) + (size_t)r * DM) + lane;
#pragma unroll
            for (int j = 0; j < 4; ++j) o8[64 * j] = (unsigned long long)cvt_pk_bf16(vv[j].x, vv[j].y) | ((unsigned long long)cvt_pk_bf16(vv[j].z, vv[j].w) << 32);
            if (lane == 0) rs[r] = 1.0f / sqrtf(sq * (1.0f / DM) + EPS); };
#pragma unroll
        for (int q = 0; q < 8; ++q) xrow_out(r0 + q, v[q]);
#pragma unroll
        for (int q = 0; q < 8; ++q) ((unsigned long long*)((bf16_t*)(ws + WS_PB) + (size_t)(r0 + q) * DPLE))[lane] = (unsigned long long)cvt_pk_bf16(pv[q].x, pv[q].y) | ((unsigned long long)cvt_pk_bf16(pv[q].z, pv[q].w) << 32);
        if (smp) { xrow_out(MP + F.gw, vs);
            ((unsigned long long*)((bf16_t*)(ws + WS_PB) + (size_t)(MP + F.gw) * DPLE))[lane] = (unsigned long long)cvt_pk_bf16(ps.x, ps.y) | ((unsigned long long)cvt_pk_bf16(ps.z, ps.w) << 32); }
        for (int r = MP + MS + (F.NGW - 1 - F.gw); r < MA; r += F.NGW) { unsigned long long* o8 = (unsigned long long*)((bf16_t*)(ws + WS_XB) + (size_t)r * DM) + lane;
#pragma unroll
            for (int j = 0; j < 4; ++j) o8[64 * j] = 0ull;
            if (lane == 0) rs[r] = 0.f; ((unsigned long long*)((bf16_t*)(ws + WS_PB) + (size_t)r * DPLE))[lane] = 0ull; }
    }
}

struct OrderRowMajor {
    int nM, nN, n, G, c; const char* A; const char* B; size_t astep, bstep;
    __device__ __forceinline__ bool next(int i, Unit& u) const {
        const int L = i * G + c; if (L >= n) return false;
        u.pm = L / nN; u.pn = L % nN; u.aux = 0; u.a = A + (size_t)u.pm * astep; u.b = B + (size_t)u.pn * bstep; return true;
    }
};
struct OrderPanel4 {
    int n, G, c; const char* A; const char* B; size_t astep, bstep;
    __device__ __forceinline__ bool next(int i, Unit& u) const {
        const int L = i * G + c; if (L >= n) return false;
        if (L < 256) { const int x = L & 7, j = L >> 3; u.pm = x * 8 + (j >> 2); u.pn = j & 3; } else { u.pm = 64; u.pn = L - 256; }
        u.aux = 0; u.a = A + (size_t)u.pm * astep; u.b = B + (size_t)u.pn * bstep; return true;
    }
};
struct OrderProjSkip {
    int G, c; const char* A; const char* B; size_t astep, bstep;
    __device__ __forceinline__ bool next(int i, Unit& u) const {
        if (c < 4) return false; const int cp = c - 4; const int L = i == 0 ? cp : (i == 1 && cp < 8 ? 252 + cp : -1); if (L < 0) return false;
        if (L < 256) { const int x = L & 7, j = L >> 3; u.pm = x * 8 + (j >> 2); u.pn = j & 3; } else { u.pm = 64; u.pn = L - 256; }
        u.aux = 0; u.a = A + (size_t)u.pm * astep; u.b = B + (size_t)u.pn * bstep; return true;
    }
};
struct OrderXcd {
    int nM, nN, n, G, c; const char* A; const char* B; size_t astep, bstep;
    __device__ __forceinline__ bool next(int i, Unit& u) const {
        const int L = i * G + c; if (L >= n) return false;
        int wgid = L; { const int q = n / 8, r = n % 8, xcd = wgid % 8, off = wgid / 8; wgid = (xcd < r ? xcd * (q + 1) : r * (q + 1) + (xcd - r) * q) + off; }
        const int nig = 8 * nN, gid = wgid / nig, fm = gid * 8, gsz = (nM - fm) < 8 ? (nM - fm) : 8;
        u.pm = fm + ((wgid % nig) % gsz); u.pn = (wgid % nig) / gsz; u.aux = 0; u.a = A + (size_t)u.pm * astep; u.b = B + (size_t)u.pn * bstep; return true;
    }
};
struct EpiInProj {
    static constexpr bool PERM = true, AFTER_DRAIN = false;
    bf16_t* PA; bf16_t* PB; const float* rs;
    template <int KIND> __device__ __forceinline__ void run(const f32x4 (&acc)[2][2][4][2], bf16_t* base, int row0, int col0) const {
#pragma unroll
        for (int ai = 0; ai < 2; ++ai)
#pragma unroll
            for (int m = 0; m < 4; ++m) { const int row = row0 + ai * 128 + m * 16; const float s = rs[row]; bf16_t* rowp = base + (size_t)row * 3072 + col0;
#pragma unroll
                for (int bj = 0; bj < 2; ++bj) { f32x4 v0 = acc[ai][bj][m][0] * s, v1 = acc[ai][bj][m][1] * s;
                    if (KIND == 0) { f32x2 a = gelu_pk((f32x2){v0[0], v0[1]}), b = gelu_pk((f32x2){v0[2], v0[3]}), c = gelu_pk((f32x2){v1[0], v1[1]}), d = gelu_pk((f32x2){v1[2], v1[3]});
                        v0 = (f32x4){a.x, a.y, b.x, b.y}; v1 = (f32x4){c.x, c.y, d.x, d.y}; }
                    if (KIND == 1) {
#pragma unroll
                        for (int j = 0; j < 4; ++j) { v0[j] = siluf_(v0[j]); v1[j] = siluf_(v1[j]); } }
                    if (KIND == 3) {
#pragma unroll
                        for (int j = 0; j < 4; ++j) { v0[j] = sigmoidf_(v0[j]); v1[j] = sigmoidf_(v1[j]); } }
                    u32x4 w; w.x = cvt_pk_bf16(v0[0], v0[1]); w.y = cvt_pk_bf16(v0[2], v0[3]); w.z = cvt_pk_bf16(v1[0], v1[1]); w.w = cvt_pk_bf16(v1[2], v1[3]);
                    *(u32x4*)(rowp + bj * 128) = w; } }
    }
    __device__ __forceinline__ void operator()(const f32x4 (&acc)[2][2][4][2], const Unit& u, int wr, int wc, int fr, int fq) const {
        const int row0 = u.pm * 256 + wr * 64 + fr, pn = u.pn;
        bf16_t* base = pn < 12 ? PA + pn * 256 : PB + (pn - 12) * 256; const int col0 = wc * 32 + 8 * fq;
        if (pn < 8) run<0>(acc, base, row0, col0);
        else if (pn < 12 || pn >= 20) run<1>(acc, base, row0, col0);
        else if (pn < 16) run<2>(acc, base, row0, col0);
        else run<3>(acc, base, row0, col0);
    }
};

__device__ __forceinline__ float logsigmoidf_(float x) { return fminf(x, 0.f) - log1pf(__expf(-fabsf(x))); }
__device__ __forceinline__ void unpack8(const u32x4 w, float (&f)[8]) { f[0] = bf_lo(w.x); f[1] = bf_hi(w.x); f[2] = bf_lo(w.y); f[3] = bf_hi(w.y); f[4] = bf_lo(w.z); f[5] = bf_hi(w.z); f[6] = bf_lo(w.w); f[7] = bf_hi(w.w); }
__device__ __forceinline__ u32x4 pack8(const float (&f)[8]) { u32x4 w; w.x = cvt_pk_bf16(f[0], f[1]); w.y = cvt_pk_bf16(f[2], f[3]); w.z = cvt_pk_bf16(f[4], f[5]); w.w = cvt_pk_bf16(f[6], f[7]); return w; }

__device__ __forceinline__ void p2a_conv_gates(const Ctx& F0) { Ctx F = F0; asm volatile("" : "+v"(F.tid), "+v"(F.lane), "+s"(F.gw));
    unsigned char* ws = F.ws;
    const bf16_t* PBX = (const bf16_t*)(ws + WS_XB2);
    bf16_t* XC = (bf16_t*)(ws + WS_XB);
    const float* Wg = (const float*)(ws + WS_WG);
    float* GLI = (float*)(ws + WS_GLI); float* GLF = (float*)(ws + WS_GLF);
    const float* convw = F.in[14]; const float* convb = F.in[15]; const float* bif = F.in[20];
    LAS float* cwl = (LAS float*)F.lds; LAS bf16_t* wgl = (LAS bf16_t*)(F.lds + 20480); LAS f32x4* comb = (LAS f32x4*)(F.lds + 20480 + 32 * 2064);
    {
        u32x4 t[11];
#pragma unroll
        for (int j = 0; j < 11; ++j) { const int i = min(F.tid + 512 * j, 5375);
            const u32x4* srcp = i < 1024 ? (const u32x4*)convw + i : (i < 1280 ? (const u32x4*)convb + (i - 1024) : (const u32x4*)(ws + WS_WGB) + (i - 1280));
            t[j] = *srcp; }
#pragma unroll
        for (int j = 0; j < 11; ++j) { const int i = F.tid + 512 * j; if (i < 1280) ((LAS u32x4*)F.lds)[i] = t[j]; else if (i < 5376) { const int p = i - 1280; *(LAS u32x4*)(F.lds + 20480 + (p >> 7) * 2064 + (p & 127) * 16) = t[j]; } }
    }
    __syncthreads();
    const int l15 = F.lane & 15, lq = F.lane >> 4, rgp = F.wave >> 1, hh = F.wave & 1;
    auto conv_core = [&](int row, const float (&w0)[8], const float (&w1)[8], const float (&w2)[8], const u32x4 x0, int ch0, f32x4& acc) {
        float cur[8], xc[8];
        unpack8(x0, cur);
#pragma unroll
        for (int q = 0; q < 2; ++q) { const f32x4 c0 = *(const LAS f32x4*)(cwl + ch0 + 4 * q), c1 = *(const LAS f32x4*)(cwl + 1024 + ch0 + 4 * q), c2 = *(const LAS f32x4*)(cwl + 2048 + ch0 + 4 * q), c3 = *(const LAS f32x4*)(cwl + 3072 + ch0 + 4 * q), cb = *(const LAS f32x4*)(cwl + 4096 + ch0 + 4 * q);
#pragma unroll
            for (int e = 0; e < 4; ++e) xc[4 * q + e] = siluf_(c0[e] * w0[4 * q + e] + c1[e] * w1[4 * q + e] + c2[e] * w2[4 * q + e] + c3[e] * cur[4 * q + e] + cb[e]); }
        const u32x4 xcp = pack8(xc);
        *(u32x4*)(XC + (size_t)row * DM + ch0) = xcp;
        const bf16x8 bc = *(const LAS bf16x8*)(wgl + l15 * 1032 + ch0), bx = *(const LAS bf16x8*)(wgl + 16 * 1032 + l15 * 1032 + ch0);
        acc = __builtin_amdgcn_mfma_f32_16x16x32_bf16(__builtin_bit_cast(bf16x8, xcp), bc, acc, 0, 0, 0);
        acc = __builtin_amdgcn_mfma_f32_16x16x32_bf16(__builtin_bit_cast(bf16x8, x0), bx, acc, 0, 0, 0);
    };
    for (int tile = F.bid; tile < MP / 64; tile += F.G) {
        const int row = tile * 64 + rgp * 16 + l15, seq0 = row & ~(SEQ - 1);
        const bool v1 = row - 1 >= seq0, v2 = row - 2 >= seq0, v3 = row - 3 >= seq0;
        const bf16_t* p0 = PBX + (size_t)row * DM + hh * 512 + 8 * lq;
        const bf16_t* p1 = p0 - (v1 ? DM : 0); const bf16_t* p2 = p0 - (v2 ? 2 * DM : 0); const bf16_t* p3 = p0 - (v3 ? 3 * DM : 0);
        f32x4 acc = (f32x4){0.f, 0.f, 0.f, 0.f};
        u32x4 X0[2][4], X1[2][4], X2[2][4], X3[2][4];
#pragma unroll
        for (int j = 0; j < 4; ++j) { const int off = j * 32; X0[0][j] = *(const u32x4*)(p0 + off); X1[0][j] = *(const u32x4*)(p1 + off); X2[0][j] = *(const u32x4*)(p2 + off); X3[0][j] = *(const u32x4*)(p3 + off); }
#pragma unroll
        for (int bt = 0; bt < 4; ++bt) {
            if (bt < 3) {
#pragma unroll
                for (int j = 0; j < 4; ++j) { const int off = ((bt + 1) * 4 + j) * 32; X0[(bt + 1) & 1][j] = *(const u32x4*)(p0 + off); X1[(bt + 1) & 1][j] = *(const u32x4*)(p1 + off); X2[(bt + 1) & 1][j] = *(const u32x4*)(p2 + off); X3[(bt + 1) & 1][j] = *(const u32x4*)(p3 + off); } }
#pragma unroll
            for (int j = 0; j < 4; ++j) { const u32x4 z = (u32x4){0u, 0u, 0u, 0u}; float w0[8], w1[8], w2[8];
                unpack8(v3 ? X3[bt & 1][j] : z, w0); unpack8(v2 ? X2[bt & 1][j] : z, w1); unpack8(v1 ? X1[bt & 1][j] : z, w2);
                conv_core(row, w0, w1, w2, X0[bt & 1][j], (hh * 16 + bt * 4 + j) * 32 + 8 * lq, acc); }
        }
        __syncthreads();
        if (hh == 1) comb[rgp * 64 + F.lane] = acc;
        __syncthreads();
        if (hh == 0 && l15 < 8) { const f32x4 o = comb[rgp * 64 + F.lane]; const float bj = bif[l15];
#pragma unroll
            for (int r = 0; r < 4; ++r) { const float g = acc[r] + o[r] + bj; const size_t rr = (size_t)(tile * 64 + rgp * 16 + 4 * lq + r);
                if (l15 < 4) GLI[(size_t)l15 * MA + rr] = g; else GLF[(size_t)(l15 - 4) * MA + rr] = logsigmoidf_(g); } }
    }
    for (int si = F.G - 1 - F.bid; si < MS / 16; si += F.G) {
        const int row = MP + si * 16 + l15; const float* st = F.in[5] + (size_t)(row - MP) * 3072;
        f32x4 acc = (f32x4){0.f, 0.f, 0.f, 0.f};
        u32x4 X0[4]; f32x4 S[4][3][2];
#pragma unroll
        for (int cbk = 0; cbk < 4; ++cbk) { const int ch0 = (F.wave * 4 + cbk) * 32 + 8 * lq; X0[cbk] = *(const u32x4*)(PBX + (size_t)row * DM + ch0);
#pragma unroll
            for (int q = 0; q < 2; ++q) { S[cbk][0][q] = *(const f32x4*)(st + ch0 + 4 * q); S[cbk][1][q] = *(const f32x4*)(st + 1024 + ch0 + 4 * q); S[cbk][2][q] = *(const f32x4*)(st + 2048 + ch0 + 4 * q); } }
#pragma unroll
        for (int cbk = 0; cbk < 4; ++cbk) { float w0[8], w1[8], w2[8];
#pragma unroll
            for (int q = 0; q < 2; ++q)
#pragma unroll
                for (int e = 0; e < 4; ++e) { w0[4 * q + e] = S[cbk][0][q][e]; w1[4 * q + e] = S[cbk][1][q][e]; w2[4 * q + e] = S[cbk][2][q][e]; }
            conv_core(row, w0, w1, w2, X0[cbk], (F.wave * 4 + cbk) * 32 + 8 * lq, acc); }
        __syncthreads();
        comb[F.wave * 64 + F.lane] = acc;
        __syncthreads();
        if (F.wave == 0 && l15 < 8) { f32x4 o = comb[F.lane];
#pragma unroll
            for (int ww = 1; ww < 8; ++ww) o = o + comb[ww * 64 + F.lane];
            const float bj = bif[l15];
#pragma unroll
            for (int r = 0; r < 4; ++r) { const float g = o[r] + bj; const size_t rr = (size_t)(MP + si * 16 + 4 * lq + r);
                if (l15 < 4) GLI[(size_t)l15 * MA + rr] = g; else GLF[(size_t)(l15 - 4) * MA + rr] = logsigmoidf_(g); } }
    }
}
__device__ __forceinline__ void p2c_sample_rows(const Ctx& F0) { Ctx F = F0; asm volatile("" : "+v"(F.tid), "+v"(F.lane), "+s"(F.gw));
    unsigned char* ws = F.ws;
    const bf16_t* PBX = (const bf16_t*)(ws + WS_XB2);
    if (F.bid >= 64 && F.bid < 112) { const int i = (F.bid - 64) * 512 + F.tid; const int b = i / 3072, j = (i / 1024) % 3, ch = i & 1023;
        F.out[O_CVP + i] = bf2f(PBX[(size_t)(b * SEQ + SEQ - 3 + j) * DM + ch]); }
    if (F.bid >= 112 && F.bid < 128) { const int i = (F.bid - 112) * 8 + F.wave;
        const int r = MP + i, ch0s = F.lane * 16; const float* st = F.in[5] + (size_t)i * 3 * 1024;
        const bf16_t* PA = (const bf16_t*)(ws + WS_PROJA) + (size_t)r * 3072;
        u32x4 xbw[2], gvw[2], uuw[2], zzw[2]; f32x4 s1[4], s2[4], lg[4], lb[4];
#pragma unroll
        for (int half = 0; half < 2; ++half) { xbw[half] = *(const u32x4*)(PBX + (size_t)r * DM + ch0s + 8 * half); gvw[half] = *(const u32x4*)(PA + 1024 + ch0s + 8 * half);
            uuw[half] = *(const u32x4*)(PA + ch0s + 8 * half); zzw[half] = *(const u32x4*)(PA + 2048 + ch0s + 8 * half); }
#pragma unroll
        for (int q4 = 0; q4 < 4; ++q4) { s1[q4] = *(const f32x4*)(st + 1024 + ch0s + 4 * q4); s2[q4] = *(const f32x4*)(st + 2048 + ch0s + 4 * q4);
            lg[q4] = *(const f32x4*)(F.in[10] + ch0s + 4 * q4); lb[q4] = *(const f32x4*)(F.in[11] + ch0s + 4 * q4); }
        const int h = F.lane >> 3; const float wsp = F.in[12][(size_t)h * 16384], bsp = F.in[13][h * 128];
#pragma unroll
        for (int half = 0; half < 2; ++half) { float xb[8]; unpack8(xbw[half], xb);
#pragma unroll
            for (int q = 0; q < 2; ++q) { const int q4 = half * 2 + q; *(f32x4*)(F.out + O_CVS + (size_t)i * 3072 + ch0s + 4 * q4) = s1[q4]; *(f32x4*)(F.out + O_CVS + (size_t)i * 3072 + 1024 + ch0s + 4 * q4) = s2[q4];
                *(f32x4*)(F.out + O_CVS + (size_t)i * 3072 + 2048 + ch0s + 4 * q4) = (f32x4){xb[4 * q], xb[4 * q + 1], xb[4 * q + 2], xb[4 * q + 3]}; } }
        float gv[16], s = 0.f;
        { float t8[8]; unpack8(gvw[0], t8);
#pragma unroll
          for (int c = 0; c < 8; ++c) gv[c] = t8[c];
          unpack8(gvw[1], t8);
#pragma unroll
          for (int c = 0; c < 8; ++c) gv[8 + c] = t8[c]; }
#pragma unroll
        for (int c = 0; c < 16; ++c) s += gv[c];
        s += __shfl_xor(s, 1); s += __shfl_xor(s, 2); s += __shfl_xor(s, 4);
        const float mu = s * (1.f / 128.f); float q = 0.f;
#pragma unroll
        for (int c = 0; c < 16; ++c) { const float d = gv[c] - mu; q += d * d; }
        q += __shfl_xor(q, 1); q += __shfl_xor(q, 2); q += __shfl_xor(q, 4);
        const float rstd = 1.0f / sqrtf(q * (1.f / 128.f) + EPS);
        float uu[16], zz[16];
        { float t8[8]; unpack8(uuw[0], t8);
#pragma unroll
          for (int c = 0; c < 8; ++c) uu[c] = t8[c];
          unpack8(uuw[1], t8);
#pragma unroll
          for (int c = 0; c < 8; ++c) uu[8 + c] = t8[c];
          unpack8(zzw[0], t8);
#pragma unroll
          for (int c = 0; c < 8; ++c) zz[c] = t8[c];
          unpack8(zzw[1], t8);
#pragma unroll
          for (int c = 0; c < 8; ++c) zz[8 + c] = t8[c]; }
        float ya[16];
#pragma unroll
        for (int q4 = 0; q4 < 4; ++q4) { f32x4 vv;
#pragma unroll
            for (int e = 0; e < 4; ++e) { const int c = 4 * q4 + e; const float vn = (gv[c] - mu) * rstd * lg[q4][e] + lb[q4][e]; vv[e] = vn; ya[c] = uu[c] * (wsp * vn + bsp) * zz[c]; }
            *(f32x4*)(F.out + O_VS + (size_t)i * 1024 + ch0s + 4 * q4) = vv; }
        bf16_t* yrow = (bf16_t*)(ws + WS_Y) + (size_t)r * DMIX + ch0s;
        { float t8[8];
#pragma unroll
          for (int c = 0; c < 8; ++c) t8[c] = ya[c];
          *(u32x4*)(yrow) = pack8(t8);
#pragma unroll
          for (int c = 0; c < 8; ++c) t8[c] = ya[8 + c];
          *(u32x4*)(yrow + 8) = pack8(t8); }
    }
}

__device__ __forceinline__ void mscan_wave(const Ctx& F, int bh) {
    unsigned char* ws = F.ws; const int b = bh >> 2, h = bh & 3, lane = F.lane;
    const float* li = (const float*)(ws + WS_GLI) + (size_t)h * MA + (size_t)b * SEQ + lane * 32;
    const float* lf = (const float*)(ws + WS_GLF) + (size_t)h * MA + (size_t)b * SEQ + lane * 32;
    float lfv[32], liv[32];
#pragma unroll
    for (int j = 0; j < 8; ++j) { const f32x4 a = *(const f32x4*)(lf + 4 * j), c = *(const f32x4*)(li + 4 * j);
#pragma unroll
        for (int e = 0; e < 4; ++e) { lfv[4 * j + e] = a[e]; liv[4 * j + e] = c[e]; } }
    float A = 0.f, Bv = -INFINITY;
#pragma unroll
    for (int i = 0; i < 32; ++i) { const float f = lfv[i], l = liv[i]; Bv = fmaxf(Bv + f, l); A += f; }
    float sA = A, sB = Bv;
#pragma unroll
    for (int o = 1; o < 64; o <<= 1) { const float pA = __shfl_up(sA, o), pB = __shfl_up(sB, o); if (lane >= o) { sB = fmaxf(pB + sA, sB); sA = pA + sA; } }
    float eA = __shfl_up(sA, 1), eB = __shfl_up(sB, 1); if (lane == 0) { eA = 0.f; eB = -INFINITY; }
    const float m_in = fmaxf(0.f + eA, eB);
    float cA = A;
#pragma unroll
    for (int o = 1; o < 8; o <<= 1) { const float p = __shfl_up(cA, o); if ((lane & 7) >= o) cA += p; }
    const float b_in = cA - A;
    const float m_prev = __shfl(m_in, lane & ~7);
    float* DA = (float*)(ws + WS_DA) + (size_t)h * MA + (size_t)b * SEQ + lane * 32; float* DR = (float*)(ws + WS_DR) + (size_t)h * MA + (size_t)b * SEQ + lane * 32;
    float* DG = (float*)(ws + WS_DG) + (size_t)h * MA + (size_t)b * SEQ + lane * 32; float* DEM = (float*)(ws + WS_DEM) + (size_t)h * MA + (size_t)b * SEQ + lane * 32;
    float* DW = (float*)(ws + WS_DW) + (size_t)h * MA + (size_t)b * SEQ + lane * 32;
    float m = m_in, bb = b_in, a_last = 0.f;
#pragma unroll
    for (int j = 0; j < 8; ++j) { f32x4 vA, vR, vG, vE;
#pragma unroll
        for (int e = 0; e < 4; ++e) { const float f = lfv[4 * j + e], l = liv[4 * j + e]; m = fmaxf(m + f, l); bb += f;
            a_last = bb - m; vA[e] = -m_prev; vR[e] = l - bb; vG[e] = __expf(bb + m_prev - m); vE[e] = __expf(-m); }
        *(f32x4*)(DA + 4 * j) = vA; *(f32x4*)(DR + 4 * j) = vR; *(f32x4*)(DG + 4 * j) = vG; *(f32x4*)(DEM + 4 * j) = vE; }
    const float a_end = __shfl(a_last, lane | 7);
    { float bb2 = b_in;
#pragma unroll
      for (int j = 0; j < 8; ++j) { f32x4 vW;
#pragma unroll
          for (int e = 0; e < 4; ++e) { bb2 += lfv[4 * j + e]; vW[e] = __expf(a_end + (liv[4 * j + e] - bb2)); }
          *(f32x4*)(DW + 4 * j) = vW; } }
    if (lane == 63) F.out[O_MP + bh] = m;
}

__device__ __forceinline__ void p9_final(const Ctx& F0) { Ctx F = F0; asm volatile("" : "+v"(F.tid), "+v"(F.lane), "+s"(F.gw));
    unsigned char* ws = F.ws; const bf16_t* GB = (const bf16_t*)(ws + WS_GB); const bf16_t* EB = (const bf16_t*)(ws + WS_EB);
    const float* pleg = F.in[27]; const float* fing = F.in[28];
    f32x4 pg[4], fg[4];
#pragma unroll
    for (int j = 0; j < 4; ++j) { pg[j] = ((const f32x4*)pleg)[F.lane + 64 * j]; fg[j] = ((const f32x4*)fing)[F.lane + 64 * j]; }
    for (int r0 = F.gw * 2; r0 < MP + MS; r0 += F.NGW * 2) {
        f32x4 x[2][4]; u32x2 g[2][4], e[2][4], xb[2][4]; float* xrow[2]; const bf16_t* X1B = (const bf16_t*)(ws + WS_X1B);
#pragma unroll
        for (int q = 0; q < 2; ++q) { const int r = r0 + q; xrow[q] = r < MP ? F.out + O_Y + (size_t)r * DM : F.out + O_YS + (size_t)(r - MP) * DM;
#pragma unroll
            for (int j = 0; j < 4; ++j) { xb[q][j] = __builtin_nontemporal_load((const u32x2*)(X1B + (size_t)r * DM) + F.lane + 64 * j); g[q][j] = __builtin_nontemporal_load((const u32x2*)(GB + (size_t)r * DM) + F.lane + 64 * j); e[q][j] = __builtin_nontemporal_load((const u32x2*)(EB + (size_t)r * DM) + F.lane + 64 * j); } }
#pragma unroll
        for (int q = 0; q < 2; ++q) { float s = 0.f; f32x4 ev[4];
#pragma unroll
            for (int j = 0; j < 4; ++j) { x[q][j] = (f32x4){bf_lo(xb[q][j].x), bf_hi(xb[q][j].x), bf_lo(xb[q][j].y), bf_hi(xb[q][j].y)}; ev[j] = (f32x4){bf_lo(e[q][j].x), bf_hi(e[q][j].x), bf_lo(e[q][j].y), bf_hi(e[q][j].y)}; s += (ev[j][0] * ev[j][0] + ev[j][1] * ev[j][1]) + (ev[j][2] * ev[j][2] + ev[j][3] * ev[j][3]); }
            s = wave_sum(s); const float rse = 1.0f / sqrtf(s * (1.f / DM) + EPS); float s2 = 0.f;
#pragma unroll
            for (int j = 0; j < 4; ++j) { const f32x4 gv = (f32x4){bf_lo(g[q][j].x), bf_hi(g[q][j].x), bf_lo(g[q][j].y), bf_hi(g[q][j].y)};
                x[q][j] = x[q][j] + gv * (ev[j] * rse * pg[j]); s2 += (x[q][j][0] * x[q][j][0] + x[q][j][1] * x[q][j][1]) + (x[q][j][2] * x[q][j][2] + x[q][j][3] * x[q][j][3]); }
            s2 = wave_sum(s2); const float rs2 = 1.0f / sqrtf(s2 * (1.f / DM) + EPS);
#pragma unroll
            for (int j = 0; j < 4; ++j) __builtin_nontemporal_store(x[q][j] * rs2 * fg[j], (f32x4*)xrow[q] + F.lane + 64 * j); }
    }
}
#define MAKE_CTX() extern __shared__ __attribute__((aligned(16))) unsigned char lds_raw[]; \
    Ctx F; F.lds = (LAS unsigned char*)lds_raw; F.tid = threadIdx.x; F.lane = F.tid & 63; F.wave = __builtin_amdgcn_readfirstlane(F.tid >> 6); \
    F.G = gridDim.x; F.bid = blockIdx.x; F.gw = F.bid * 8 + F.wave; F.NGW = F.G * 8; F.in = args.in; F.out = args.out; F.ws = args.ws; unsigned char* ws = args.ws; (void)ws

template <int KIND> struct EpiBf16Act {
    static constexpr bool PERM = false, AFTER_DRAIN = false;
    bf16_t* O; int ldo; const float* bias; float scale;
    __device__ __forceinline__ void operator()(const f32x4 (&acc)[2][2][4][2], const Unit& u, int wr, int wc, int fr, int fq) const {
        const int row0 = u.pm * 256 + wr * 64 + fr, col0 = u.pn * 256 + wc * 32 + 4 * fq;
        f32x4 bv[2][2];
#pragma unroll
        for (int bj = 0; bj < 2; ++bj)
#pragma unroll
            for (int n = 0; n < 2; ++n) bv[bj][n] = bias ? *(const f32x4*)(bias + col0 + bj * 128 + 16 * n) : (f32x4){0.f, 0.f, 0.f, 0.f};
#pragma unroll
        for (int ai = 0; ai < 2; ++ai)
#pragma unroll
            for (int m = 0; m < 4; ++m) { bf16_t* rowp = O + (size_t)(row0 + ai * 128 + m * 16) * ldo + col0;
#pragma unroll
                for (int bj = 0; bj < 2; ++bj)
#pragma unroll
                    for (int n = 0; n < 2; ++n) { f32x4 v = acc[ai][bj][m][n] * scale + bv[bj][n];
                        if (KIND == 3) {
#pragma unroll
                            for (int j = 0; j < 4; ++j) v[j] = sigmoidf_(v[j]); }
                        u32x2 w; w.x = cvt_pk_bf16(v[0], v[1]); w.y = cvt_pk_bf16(v[2], v[3]); *(u32x2*)(rowp + bj * 128 + n * 16) = w; } }
    }
};
struct EpiOutProj {
    static constexpr bool PERM = false, AFTER_DRAIN = false;
    const float* xp; const float* xs; float* out; bf16_t* X1B;
    __device__ __forceinline__ void operator()(const f32x4 (&acc)[2][2][4][2], const Unit& u, int wr, int wc, int fr, int fq) const {
        const int row0 = u.pm * 256 + wr * 64 + fr, col0 = u.pn * 256 + wc * 32 + 4 * fq;
#pragma unroll
        for (int ai = 0; ai < 2; ++ai) { f32x4 xv[4][2][2];
#pragma unroll
            for (int m = 0; m < 4; ++m) { const int row = row0 + ai * 128 + m * 16; const bool real = row < MP + MS; const float* xr = row < MP ? xp + (size_t)row * DM : xs + (size_t)(real ? row - MP : 0) * DM;
#pragma unroll
                for (int bj = 0; bj < 2; ++bj)
#pragma unroll
                    for (int n = 0; n < 2; ++n) xv[m][bj][n] = __builtin_nontemporal_load((const f32x4*)(xr + col0 + bj * 128 + n * 16)); }
#pragma unroll
            for (int m = 0; m < 4; ++m) { const int row = row0 + ai * 128 + m * 16; const bool real = row < MP + MS;
#pragma unroll
                for (int bj = 0; bj < 2; ++bj)
#pragma unroll
                    for (int n = 0; n < 2; ++n) { const int c = col0 + bj * 128 + n * 16; f32x4 v = acc[ai][bj][m][n];
                        if (real) v = v + xv[m][bj][n]; else v = (f32x4){0.f, 0.f, 0.f, 0.f};
                        u32x2 w; w.x = cvt_pk_bf16(v[0], v[1]); w.y = cvt_pk_bf16(v[2], v[3]); *(u32x2*)(X1B + (size_t)row * DM + c) = w; } } }
    }
};

struct EpiInProjNP {
    static constexpr bool PERM = false, AFTER_DRAIN = false;
    bf16_t* PA; bf16_t* PB; const float* rs; bf16_t* XB2;
    __device__ __forceinline__ void operator()(const f32x4 (&acc)[2][2][4][2], const Unit& u, int wr, int wc, int fr, int fq) const {
        const int row0 = u.pm * 256 + wr * 64 + fr, pn = u.pn; const int col0 = wc * 32 + 4 * fq;
        const int kind = pn < 8 ? 0 : ((pn < 12 || pn >= 20) ? 1 : (pn < 16 ? 2 : 3));
        bf16_t* base = pn < 12 ? PA + pn * 256 : (kind == 2 ? XB2 + (pn - 12) * 256 : PB + (pn - 12) * 256); const int pitch = kind == 2 ? DM : 3072;
        float rsv[2][4];
#pragma unroll
        for (int ai = 0; ai < 2; ++ai)
#pragma unroll
            for (int m = 0; m < 4; ++m) rsv[ai][m] = rs[row0 + ai * 128 + m * 16];
#pragma unroll
        for (int ai = 0; ai < 2; ++ai)
#pragma unroll
            for (int m = 0; m < 4; ++m) { const int row = row0 + ai * 128 + m * 16; const float s = rsv[ai][m];
#pragma unroll
                for (int bj = 0; bj < 2; ++bj)
#pragma unroll
                    for (int n = 0; n < 2; ++n) { f32x4 v = acc[ai][bj][m][n] * s;
                        if (kind == 0) { const f32x2 ga = gelu_pk((f32x2){v[0], v[1]}), gb = gelu_pk((f32x2){v[2], v[3]}); v = (f32x4){ga.x, ga.y, gb.x, gb.y}; }
                        else {
#pragma unroll
                        for (int j = 0; j < 4; ++j) { float x = v[j]; if (kind == 1) x = siluf_(x); else if (kind == 3) x = sigmoidf_(x); v[j] = x; } }
                        u32x2 w; w.x = cvt_pk_bf16(v[0], v[1]); w.y = cvt_pk_bf16(v[2], v[3]); *(u32x2*)(base + (size_t)row * pitch + col0 + bj * 128 + n * 16) = w; } }
    }
};
__device__ __forceinline__ void p1_inproj(const Ctx& F) {
    unsigned char* ws = F.ws; Gemm g{DM, DM, DM};
    OrderXcd S{64, 24, 64 * 24, F.G, F.bid, (const char*)(ws + WS_XB), (const char*)(ws + WS_WIN), (size_t)256 * DM * 2, (size_t)256 * DM * 2};
    EpiInProjNP E{(bf16_t*)(ws + WS_PROJA), (bf16_t*)(ws + WS_PROJB), (const float*)(ws + WS_RS), (bf16_t*)(ws + WS_XB2)};
    pg8::gemm_phase<EpiInProjNP, OrderXcd>(F.lds, g, S, E);
}
__device__ __forceinline__ void p7_outproj(const Ctx& F) {
    unsigned char* ws = F.ws; Gemm g{DMIX, DMIX, DMIX};
    OrderPanel4 S{64 * 4, F.G, F.bid, (const char*)(ws + WS_Y), (const char*)(ws + WS_WOUT), (size_t)256 * DMIX * 2, (size_t)256 * DMIX * 2};
    EpiOutProj E{F.in[0], F.in[1], F.out, (bf16_t*)(ws + WS_X1B)};
    pg8::gemm_phase<EpiOutProj, OrderPanel4>(F.lds, g, S, E);
}
__device__ __forceinline__ void p8_ple(const Ctx& F) {
    unsigned char* ws = F.ws;
    { Gemm g{DM, DM, DM}; OrderPanel4 S{NTILE * 4, F.G, F.bid, (const char*)(ws + WS_X1B), (const char*)(ws + WS_WPG), (size_t)256 * DM * 2, (size_t)256 * DM * 2};
      EpiBf16Act<3> E{(bf16_t*)(ws + WS_GB), DM, F.in[25], 1.0f}; pg8::gemm_phase<EpiBf16Act<3>, OrderPanel4>(F.lds, g, S, E); }
    { Gemm g{DPLE, DPLE, DPLE}; OrderProjSkip S{F.G, F.bid, (const char*)(ws + WS_PB), (const char*)(ws + WS_WPP), (size_t)256 * DPLE * 2, (size_t)256 * DPLE * 2};
      EpiBf16Act<0> E{(bf16_t*)(ws + WS_EB), DM, nullptr, 1.0f}; pg8::gemm_phase<EpiBf16Act<0>, OrderProjSkip>(F.lds, g, S, E); }
}
typedef float f32x4_t __attribute__((ext_vector_type(4)));
__device__ __forceinline__ void p2b_spatial_units(const Ctx& F0) { Ctx F = F0; asm volatile("" : "+v"(F.tid), "+v"(F.lane), "+s"(F.gw));
    unsigned char* ws = F.ws;
    const bf16_t* PA = (const bf16_t*)(ws + WS_PROJA); const bf16_t* WSP = (const bf16_t*)(ws + WS_WSP); bf16_t* Y = (bf16_t*)(ws + WS_Y);
    const float* lng = F.in[10]; const float* lnb = F.in[11]; const float* bsp = F.in[13];
    LAS bf16_t* vnT = (LAS bf16_t*)F.lds;
    const int lane = F.lane, w = F.wave, l15 = lane & 15, lq = lane >> 4;
    unsigned wav[8], wbv[8];
    auto load_v = [&](int unit) { const int b = unit >> 7, c = (unit >> 3) & 15, h = unit & 7, r0 = b * SEQ + c * 128;
#pragma unroll
        for (int p = 0; p < 8; ++p) { const int s0 = w * 16 + 2 * p; wav[p] = *(const unsigned*)(PA + (size_t)(r0 + s0) * 3072 + 1024 + h * 128 + 2 * lane); wbv[p] = *(const unsigned*)(PA + (size_t)(r0 + s0 + 1) * 3072 + 1024 + h * 128 + 2 * lane); } };
    if (F.bid < NB * 16 * HA) load_v(F.bid);
    for (int unit = F.bid; unit < NB * 16 * HA; unit += F.G) {
        const int b = unit >> 7, c = (unit >> 3) & 15, h = unit & 7, r0 = b * SEQ + c * 128;
        const float g0 = lng[h * 128 + 2 * lane], g1 = lng[h * 128 + 2 * lane + 1], b0 = lnb[h * 128 + 2 * lane], b1 = lnb[h * 128 + 2 * lane + 1];
        const int t0 = 16 * w, nks = (t0 + 15) / 32 + 1;
        bf16x8 wfr[4];
#pragma unroll
        for (int ks = 0; ks < 4; ++ks) wfr[ks] = *(const bf16x8*)(WSP + ((size_t)h * 128 + t0 + l15) * 128 + ks * 32 + 8 * lq);
        const int t = t0 + l15; const float bt = bsp[h * 128 + t]; const size_t row = (size_t)(r0 + t);
        u32x2 uuv[8], zzv[8];
#pragma unroll
        for (int nb = 0; nb < 8; ++nb) { const int d = nb * 16 + 4 * lq; uuv[nb] = *(const u32x2*)(PA + row * 3072 + h * 128 + d); zzv[nb] = *(const u32x2*)(PA + row * 3072 + 2048 + h * 128 + d); }
#pragma unroll
        for (int p = 0; p < 8; ++p) { const int s0 = w * 16 + 2 * p; const unsigned wa = wav[p], wb = wbv[p];
            float a0 = bf_lo(wa), a1 = bf_hi(wa), c0 = bf_lo(wb), c1 = bf_hi(wb);
            const float mua = wave_sum(a0 + a1) * (1.f / 128.f), mub = wave_sum(c0 + c1) * (1.f / 128.f);
            a0 -= mua; a1 -= mua; c0 -= mub; c1 -= mub;
            const float ra = 1.0f / sqrtf(wave_sum(a0 * a0 + a1 * a1) * (1.f / 128.f) + EPS), rb = 1.0f / sqrtf(wave_sum(c0 * c0 + c1 * c1) * (1.f / 128.f) + EPS);
            *(LAS unsigned*)(vnT + (2 * lane) * 136 + s0) = cvt_pk_bf16(a0 * ra * g0 + b0, c0 * rb * g0 + b0);
            *(LAS unsigned*)(vnT + (2 * lane + 1) * 136 + s0) = cvt_pk_bf16(a1 * ra * g1 + b1, c1 * rb * g1 + b1); }
        __syncthreads();
        if (unit + F.G < NB * 16 * HA) load_v(unit + F.G);
        f32x4 acc[8];
#pragma unroll
        for (int nb = 0; nb < 8; ++nb) acc[nb] = (f32x4){0.f, 0.f, 0.f, 0.f};
#pragma unroll
        for (int ks = 0; ks < 4; ++ks) { if (ks < nks) { const int k0 = ks * 32;
#pragma unroll
            for (int nb = 0; nb < 8; ++nb) { const bf16x8 vf = *(const LAS bf16x8*)(vnT + (nb * 16 + l15) * 136 + k0 + 8 * lq);
                acc[nb] = __builtin_amdgcn_mfma_f32_16x16x32_bf16(vf, wfr[ks], acc[nb], 0, 0, 0); } } }
#pragma unroll
        for (int nb = 0; nb < 8; ++nb) { const int d = nb * 16 + 4 * lq; const u32x2 uu = uuv[nb], zz = zzv[nb];
            u32x2 o; o.x = cvt_pk_bf16(bf_lo(uu.x) * (acc[nb][0] + bt) * bf_lo(zz.x), bf_hi(uu.x) * (acc[nb][1] + bt) * bf_hi(zz.x));
            o.y = cvt_pk_bf16(bf_lo(uu.y) * (acc[nb][2] + bt) * bf_lo(zz.y), bf_hi(uu.y) * (acc[nb][3] + bt) * bf_hi(zz.y));
            *(u32x2*)(Y + row * DMIX + h * 128 + d) = o; }
        __syncthreads();
    }
}
__device__ __forceinline__ void p2b_mscan(const Ctx& F) { if (F.bid < 32 && F.wave == 0) mscan_wave(F, F.bid); }

struct OrderQK {
    int G, c; const char* ws;
    __device__ __forceinline__ bool next(int i, Unit& u) const { const int L = i * G + c; if (L >= 512) return false; const char* XC = ws + WS_XB; const char* WQ = ws + WS_WQ; const char* WK = ws + WS_WK;
        const int kind = L >> 8, l = L & 255; u.pm = l >> 2; u.pn = kind; u.aux = l & 3; u.a = XC + (size_t)u.pm * (256 * DM * 2) + (size_t)u.aux * 512; u.b = (kind ? WK : WQ) + (size_t)u.aux * 131072; return true; }
};
struct EpiQK {
    static constexpr bool PERM = false, AFTER_DRAIN = false;
    bf16_t* K; bf16_t* PQ; const float* DG;
    __device__ __forceinline__ void operator()(const f32x4 (&acc)[2][2][4][2], const Unit& u, int wr, int wc, int fr, int fq) const {
        const int h = u.aux, rl0 = wr * 64 + fr, col0 = wc * 32 + 4 * fq; const bool isk = u.pn != 0;
        const int unit = ((u.pm >> 3) * 4 + h) * 8 + (u.pm & 7);
        float gv[2][4];
#pragma unroll
        for (int ai = 0; ai < 2; ++ai)
#pragma unroll
            for (int m = 0; m < 4; ++m) gv[ai][m] = isk ? 0.0625f : DG[(size_t)h * MA + u.pm * 256 + rl0 + ai * 128 + m * 16];
        bf16_t* base = isk ? K + (size_t)u.pm * 256 * 1024 + h * 256 : PQ + (size_t)unit * 256 * 512 + 256; const int ldo = isk ? 1024 : 512;
#pragma unroll
        for (int ai = 0; ai < 2; ++ai)
#pragma unroll
            for (int m = 0; m < 4; ++m) { const int rl = rl0 + ai * 128 + m * 16; const float g = gv[ai][m];
#pragma unroll
                for (int bj = 0; bj < 2; ++bj)
#pragma unroll
                    for (int n = 0; n < 2; ++n) { const int c = col0 + bj * 128 + n * 16; const f32x4 v = acc[ai][bj][m][n] * g;
                        u32x2 w; w.x = cvt_pk_bf16(v[0], v[1]); w.y = cvt_pk_bf16(v[2], v[3]); *(u32x2*)(base + (size_t)rl * ldo + c) = w; }
                asm volatile("" ::: "memory"); }
    }
};
struct OrderS12 {
    int G, c; const char* ws;
    __device__ __forceinline__ bool next(int i, Unit& u) const { const int L = i * G + c; if (L >= 12) return false; const char* XC = ws + WS_XB; const char* XB2 = ws + WS_XB2; const char* WQ = ws + WS_WQ; const char* WK = ws + WS_WK; const char* WV = ws + WS_WV;
        const int kind = L >> 2; u.pm = 64; u.pn = kind; u.aux = L & 3; u.a = (kind == 2 ? XB2 : XC) + (size_t)64 * (256 * DM * 2) + (size_t)u.aux * 512; u.b = (kind == 0 ? WQ : kind == 1 ? WK : WV) + (size_t)u.aux * 131072; return true; }
};
struct EpiS12 {
    static constexpr bool PERM = false, AFTER_DRAIN = false;
    bf16_t* Q; bf16_t* K; bf16_t* Vs;
    __device__ __forceinline__ void operator()(const f32x4 (&acc)[2][2][4][2], const Unit& u, int wr, int wc, int fr, int fq) const {
        const int h = u.aux, kind = u.pn; bf16_t* O = kind == 0 ? Q + (size_t)MP * 1024 : kind == 1 ? K + (size_t)MP * 1024 : Vs; const float sc = kind == 1 ? 0.0625f : 1.0f;
        const int row0 = wr * 64 + fr, col0 = h * 256 + wc * 32 + 4 * fq;
#pragma unroll
        for (int m = 0; m < 4; ++m) { bf16_t* rowp = O + (size_t)(row0 + m * 16) * 1024 + col0;
#pragma unroll
            for (int bj = 0; bj < 2; ++bj)
#pragma unroll
                for (int n = 0; n < 2; ++n) { const f32x4 v = acc[0][bj][m][n] * sc; u32x2 w; w.x = cvt_pk_bf16(v[0], v[1]); w.y = cvt_pk_bf16(v[2], v[3]); *(u32x2*)(rowp + bj * 128 + n * 16) = w; } }
    }
};
struct OrderVW {
    int G, c; const char* ws;
    __device__ __forceinline__ bool next(int i, Unit& u) const { const int L = i * G + c; if (L >= 512) return false; const char* XC = ws + WS_XB; const char* XB2 = ws + WS_XB2; const char* WK = ws + WS_WK; const char* WV = ws + WS_WV;
        const int kind = L >> 8, l = L & 255, b = l >> 5, h = (l >> 3) & 3, cc = l & 7; u.pm = b * 8 + cc; u.pn = l | (kind << 8); u.aux = h;
        u.a = (kind ? WK : WV) + (size_t)h * 131072; u.b = (kind ? XC : XB2) + (size_t)u.pm * (256 * DM * 2) + (size_t)h * 512; return true; }
};
struct EpiVW {
    static constexpr bool PERM = false, AFTER_DRAIN = false;
    bf16_t* VC; bf16_t* WKT; const float* DW; float* DNP;
    __device__ __forceinline__ void operator()(const f32x4 (&acc)[2][2][4][2], const Unit& u, int wr, int wc, int fr, int fq) const {
        const int h = u.aux, kind = u.pn >> 8, l = u.pn & 255, rl0 = wr * 64 + fr, col0 = wc * 32 + 4 * fq; const int ldo = kind ? 256 : 512; bf16_t* base = (kind ? WKT : VC) + (size_t)l * 256 * ldo;
        f32x4 scq[2][2];
#pragma unroll
        for (int bj = 0; bj < 2; ++bj)
#pragma unroll
            for (int n = 0; n < 2; ++n) scq[bj][n] = kind ? *(const f32x4*)(DW + (size_t)h * MA + u.pm * 256 + col0 + bj * 128 + n * 16) * 0.0625f : (f32x4){1.f, 1.f, 1.f, 1.f};
#pragma unroll
        for (int ai = 0; ai < 2; ++ai)
#pragma unroll
            for (int m = 0; m < 4; ++m) { bf16_t* rowp = base + (size_t)(rl0 + ai * 128 + m * 16) * ldo + col0; float rsum = 0.f;
#pragma unroll
                for (int bj = 0; bj < 2; ++bj)
#pragma unroll
                    for (int n = 0; n < 2; ++n) { const f32x4 v = acc[ai][bj][m][n] * scq[bj][n]; u32x2 w; w.x = cvt_pk_bf16(v[0], v[1]); w.y = cvt_pk_bf16(v[2], v[3]); *(u32x2*)(rowp + bj * 128 + n * 16) = w;
                        rsum += (bf_lo(w.x) + bf_hi(w.x)) + (bf_lo(w.y) + bf_hi(w.y)); }
                if (kind) { rsum += __shfl_xor(rsum, 16); rsum += __shfl_xor(rsum, 32); if (fq == 0) DNP[((size_t)l * 256 + rl0 + ai * 128 + m * 16) * 4 + wc] = rsum; }
                asm volatile("" ::: "memory"); }
    }
};
__device__ __forceinline__ void p3_qkv(const Ctx& F) {
    unsigned char* ws = F.ws;
    { Gemm g{DM, 256, 256}; OrderQK S{F.G, F.bid, (const char*)ws}; EpiQK E{(bf16_t*)(ws + WS_K), (bf16_t*)(ws + WS_PQ), (const float*)(ws + WS_DG)};
      pg8::gemm_phase<EpiQK, OrderQK>(F.lds, g, S, E); }
    { Gemm g{256, DM, 256}; OrderVW S{F.G, F.bid, (const char*)ws}; EpiVW E{(bf16_t*)(ws + WS_VC), (bf16_t*)(ws + WS_WKT), (const float*)(ws + WS_DW), (float*)(ws + WS_DN4)};
      pg8::gemm_phase<EpiVW, OrderVW>(F.lds, g, S, E); }
}

__device__ __forceinline__ void p3_s12(const Ctx& F) {
    unsigned char* ws = F.ws;
    { Gemm g{DM, 256, 256}; OrderS12 S{F.G, (F.bid - 32) & 255, (const char*)ws}; EpiS12 E{(bf16_t*)(ws + WS_Q), (bf16_t*)(ws + WS_K), (bf16_t*)(ws + WS_VS)};
      pg8::gemm_phase<EpiS12, OrderS12>(F.lds, g, S, E); }
}
struct OrderUnitNT {
    int n, G, c; const char* A; size_t astep_pm, astep_h, astep_u; const char* B; size_t bstep_pm, bstep_h, bstep_u;
    __device__ __forceinline__ bool next(int i, Unit& u) const { const int L = i * G + c; if (L >= n) return false;
        const int b = L >> 5, h = (L >> 3) & 3, cc = L & 7; u.pm = b * 8 + cc; u.pn = L; u.aux = h;
        u.a = A + (size_t)u.pm * astep_pm + (size_t)h * astep_h + (size_t)L * astep_u; u.b = B + (size_t)u.pm * bstep_pm + (size_t)h * bstep_h + (size_t)L * bstep_u; return true; }
};
struct EpiScore {
    static constexpr bool PERM = false, AFTER_DRAIN = false;
    bf16_t* PQ; const float* DA; const float* DR; float* DENP;
    __device__ __forceinline__ void operator()(const f32x4 (&acc)[2][2][4][2], const Unit& u, int wr, int wc, int fr, int fq) const {
        const int h = u.aux, rl0 = wr * 64 + fr, col0 = wc * 32 + 4 * fq; const size_t vb = (size_t)h * MA + (size_t)u.pm * 256;
        float atv[2][4]; f32x4 rrv[2][2];
#pragma unroll
        for (int ai = 0; ai < 2; ++ai)
#pragma unroll
            for (int m = 0; m < 4; ++m) atv[ai][m] = DA[vb + rl0 + ai * 128 + m * 16];
#pragma unroll
        for (int bj = 0; bj < 2; ++bj)
#pragma unroll
            for (int n = 0; n < 2; ++n) rrv[bj][n] = *(const f32x4*)(DR + vb + col0 + bj * 128 + n * 16);
#pragma unroll
        for (int ai = 0; ai < 2; ++ai)
#pragma unroll
            for (int m = 0; m < 4; ++m) { int t_ = rl0 + ai * 128 + m * 16; asm volatile("" : "+v"(t_)); const int t = t_; const float at = atv[ai][m]; float rs_ = 0.f; bf16_t* rowp = PQ + ((size_t)u.pn * 256 + t) * 512 + col0;
#pragma unroll
                for (int bj = 0; bj < 2; ++bj)
#pragma unroll
                    for (int n = 0; n < 2; ++n) { const int c = col0 + bj * 128 + n * 16; f32x4 v; const f32x4 rr = rrv[bj][n];
#pragma unroll
                        for (int j = 0; j < 4; ++j) { const float e = fast_exp(fminf(at + rr[j], 60.f)); v[j] = (c + j <= t) ? acc[ai][bj][m][n][j] * e : 0.f; rs_ += v[j]; }
                        u32x2 w; w.x = cvt_pk_bf16(v[0], v[1]); w.y = cvt_pk_bf16(v[2], v[3]); *(u32x2*)(rowp + bj * 128 + n * 16) = w; }
                rs_ += __shfl_xor(rs_, 16); rs_ += __shfl_xor(rs_, 32);
                if (fq == 0) DENP[(vb + t) * 4 + wc] = rs_; asm volatile("" ::: "memory"); }
    }
};
struct EpiF32Unit {
    static constexpr bool PERM = false, AFTER_DRAIN = false;
    bf16_t* O;
    __device__ __forceinline__ void operator()(const f32x4 (&acc)[2][2][4][2], const Unit& u, int wr, int wc, int fr, int fq) const {
        bf16_t* base = O + (size_t)u.pn * 65536 + (size_t)(wr * 64 + fr) * 256 + wc * 32 + 4 * fq;
#pragma unroll
        for (int ai = 0; ai < 2; ++ai)
#pragma unroll
            for (int m = 0; m < 4; ++m)
#pragma unroll
                for (int bj = 0; bj < 2; ++bj)
#pragma unroll
                    for (int n = 0; n < 2; ++n) { const f32x4 v = acc[ai][bj][m][n]; u32x2 w; w.x = cvt_pk_bf16(v[0], v[1]); w.y = cvt_pk_bf16(v[2], v[3]); *(u32x2*)(base + (size_t)(ai * 128 + m * 16) * 256 + bj * 128 + n * 16) = w; }
    }
};
__device__ __forceinline__ void p4_scores_dc(const Ctx& F) {
    unsigned char* ws = F.ws;
    { Gemm g{512, DM, 256}; OrderUnitNT S{NUNIT, F.G, F.bid, (const char*)(ws + WS_PQ) + 512, 0, 0, (size_t)256 * 512 * 2, (const char*)(ws + WS_K), (size_t)256 * DM * 2, 512, 0};
      EpiScore E{(bf16_t*)(ws + WS_PQ), (const float*)(ws + WS_DA), (const float*)(ws + WS_DR), (float*)(ws + WS_DENP)}; pg8::gemm_phase<EpiScore, OrderUnitNT>(F.lds, g, S, E); }
    { Gemm g{512, 256, 256}; OrderUnitNT S{NUNIT, F.G, F.bid, (const char*)(ws + WS_VC), 0, 0, (size_t)256 * 512 * 2, (const char*)(ws + WS_WKT), 0, 0, (size_t)256 * 256 * 2};
      EpiF32Unit E{(bf16_t*)(F.out + O_Y)}; pg8::gemm_phase<EpiF32Unit, OrderUnitNT>(F.lds, g, S, E); }
}

template <int R> __device__ __forceinline__ void qn_rows(const u32x2 (&qq)[32], const f32x4 nv, int& sres) {
    if constexpr (R < 32) { const float s = wave_sum(bf_lo(qq[R].x) * nv[0] + bf_hi(qq[R].x) * nv[1] + bf_lo(qq[R].y) * nv[2] + bf_hi(qq[R].y) * nv[3]);
        const int sv = __builtin_amdgcn_readfirstlane(__builtin_bit_cast(int, s)); asm volatile("s_nop 3\n\tv_writelane_b32 %0, %1, %2" : "+v"(sres) : "s"(sv), "n"(R));
        qn_rows<R + 1>(qq, nv, sres); }
}
__device__ __forceinline__ void p5_scan_sample(const Ctx& F0) { Ctx F = F0; asm volatile("" : "+v"(F.tid), "+v"(F.lane), "+s"(F.gw));
    unsigned char* ws = F.ws; const float* DG = (const float*)(ws + WS_DG); const bf16_t* DCb = (const bf16_t*)(F.out + O_Y); bf16_t* VC = (bf16_t*)(ws + WS_VC);
    {   u32x4 dw[2][8]; float ge[2][8];
#pragma unroll
        for (int k = 0; k < 2; ++k) { const int idx = F.bid * 512 + F.tid + k * F.G * 512, bh = idx >> 13, q8 = idx & 8191, e = q8 >> 5, d8 = (q8 & 31) * 8, b = bh >> 2, h = bh & 3;
#pragma unroll
            for (int c = 0; c < 8; ++c) { dw[k][c] = __builtin_nontemporal_load((const u32x4*)(DCb + ((size_t)(bh * 8 + c) * 256 + e) * 256 + d8)); ge[k][c] = DG[(size_t)h * MA + b * SEQ + c * 256 + 255]; } }
#pragma unroll
        for (int k = 0; k < 2; ++k) { const int idx = F.bid * 512 + F.tid + k * F.G * 512, bh = idx >> 13, q8 = idx & 8191, e = q8 >> 5, d8 = (q8 & 31) * 8;
            float C[8];
#pragma unroll
            for (int j = 0; j < 8; ++j) C[j] = 0.f;
#pragma unroll
            for (int c = 0; c < 8; ++c) { float dc[8]; unpack8(dw[k][c], dc); *(u32x4*)(VC + ((size_t)(bh * 8 + c) * 256 + e) * 512 + 256 + d8) = pack8(C);
#pragma unroll
                for (int j = 0; j < 8; ++j) C[j] = C[j] * ge[k][c] + dc[j]; }
            __builtin_nontemporal_store((f32x4){C[0], C[1], C[2], C[3]}, (f32x4*)(F.out + O_CP + ((size_t)bh * 256 + e) * 256 + d8));
            __builtin_nontemporal_store((f32x4){C[4], C[5], C[6], C[7]}, (f32x4*)(F.out + O_CP + ((size_t)bh * 256 + e) * 256 + d8 + 4)); }
    }
    LAS float* npv = (LAS float*)F.lds;
    for (int u = F.bid; u < NUNIT; u += F.G) { const int bh = u >> 3, cc = u & 7, b = bh >> 2, h = bh & 3;
        const bf16_t* PQg = (const bf16_t*)(ws + WS_PQ);
        u32x2 qq[32];
        const bf16_t* qbase = PQg + ((size_t)u * 256 + F.wave * 32) * 512 + 256 + 4 * F.lane; asm volatile("" : "+v"(qbase));
#pragma unroll
        for (int r = 0; r < 32; ++r) qq[r] = *(const u32x2*)(qbase + r * 512);
        __syncthreads();
        if (F.tid < 256) { float n = 0.f; const float* DN = (const float*)(ws + WS_DN4);
            for (int j = 0; j < cc; ++j) { const f32x4 dp = *(const f32x4*)(DN + ((size_t)(bh * 8 + j) * 256 + F.tid) * 4); n = DG[(size_t)h * MA + b * SEQ + j * 256 + 255] * n + ((dp[0] + dp[1]) + (dp[2] + dp[3])); }
            npv[F.tid] = n; const f32x4 dl = *(const f32x4*)(DN + ((size_t)u * 256 + F.tid) * 4); if (cc == 7) F.out[O_NP + (size_t)bh * 256 + F.tid] = DG[(size_t)h * MA + b * SEQ + 7 * 256 + 255] * n + ((dl[0] + dl[1]) + (dl[2] + dl[3])); }
        __syncthreads();
        const f32x4 nv = *(const LAS f32x4*)(npv + 4 * F.lane); int sres = 0;
        qn_rows<0>(qq, nv, sres);
        if (F.lane < 32) ((float*)(ws + WS_QN))[(size_t)h * MA + (size_t)b * SEQ + cc * 256 + F.wave * 32 + F.lane] = __builtin_bit_cast(float, sres); }
}
__device__ __forceinline__ void p5s_sample(const Ctx& F0) { Ctx F = F0; asm volatile("" : "+v"(F.tid), "+v"(F.lane), "+s"(F.gw));
    unsigned char* ws = F.ws;
    LAS float* hs = (LAS float*)F.lds + 512; LAS float* red = (LAS float*)F.lds + 1024;
    for (int job = F.bid; job < MS * HB; job += F.G) { const int i = job >> 2, h = job & 3; const size_t row = MP + i;
        const bf16_t* Q = (const bf16_t*)(ws + WS_Q) + row * 1024 + h * 256; const bf16_t* K = (const bf16_t*)(ws + WS_K) + row * 1024 + h * 256; const bf16_t* V = (const bf16_t*)(ws + WS_VS) + (size_t)i * 1024 + h * 256;
        const u32x2 qw = *(const u32x2*)(Q + 4 * F.lane), kw = *(const u32x2*)(K + 4 * F.lane);
        const f32x4 q4 = (f32x4){bf_lo(qw.x), bf_hi(qw.x), bf_lo(qw.y), bf_hi(qw.y)}, k4 = (f32x4){bf_lo(kw.x), bf_hi(kw.x), bf_lo(kw.y), bf_hi(kw.y)};
        const f32x4 n0 = *(const f32x4*)(F.in[3] + ((size_t)i * 4 + h) * 256 + 4 * F.lane);
        const float li = ((const float*)(ws + WS_GLI))[(size_t)h * MA + row], lf = ((const float*)(ws + WS_GLF))[(size_t)h * MA + row], m0 = F.in[4][i * 4 + h];
        const float mn = fmaxf(lf + m0, li), g = __expf(lf + m0 - mn), wi = __expf(li - mn);
        const float qk = wave_sum(q4[0] * k4[0] + q4[1] * k4[1] + q4[2] * k4[2] + q4[3] * k4[3]), nq = wave_sum(n0[0] * q4[0] + n0[1] * q4[1] + n0[2] * q4[2] + n0[3] * q4[3]);
        const float sc = wi * qk, den = sc + g * nq, dinv = 1.0f / fmaxf(fabsf(den), __expf(-mn));
        const float* C0 = F.in[2] + (((size_t)i * 4 + h) * 256 + F.wave * 32) * 256 + 4 * F.lane; float* C1 = F.out + O_CS + (((size_t)i * 4 + h) * 256 + F.wave * 32) * 256 + 4 * F.lane;
        __syncthreads();
#pragma unroll 1
        for (int r8 = 0; r8 < 32; r8 += 8) { f32x4 c[8]; float ve[8], cq[8];
#pragma unroll
            for (int r = 0; r < 8; ++r) { c[r] = __builtin_nontemporal_load((const f32x4*)(C0 + (size_t)(r8 + r) * 256)); ve[r] = bf2f(V[F.wave * 32 + r8 + r]); }
#pragma unroll
            for (int r = 0; r < 8; ++r) { cq[r] = c[r][0] * q4[0] + c[r][1] * q4[1] + c[r][2] * q4[2] + c[r][3] * q4[3]; const float wv = wi * ve[r]; __builtin_nontemporal_store(c[r] * g + k4 * wv, (f32x4*)(C1 + (size_t)(r8 + r) * 256)); }
#pragma unroll
            for (int r = 0; r < 8; ++r) { cq[r] = wave_sum(cq[r]); if (F.lane == 0) hs[F.wave * 32 + r8 + r] = (sc * ve[r] + g * cq[r]) * dinv; } }
        if (F.wave == 0) { *(f32x4*)(F.out + O_NS + ((size_t)i * 4 + h) * 256 + 4 * F.lane) = n0 * g + k4 * wi; if (F.lane == 0) F.out[O_MS + i * 4 + h] = mn; }
        __syncthreads();
        const bf16_t* PB = (const bf16_t*)(ws + WS_PROJB) + row * 3072; const bf16_t* XC = (const bf16_t*)(ws + WS_XB) + row * DM;
        float x = 0.f; const int ch = h * 256 + (F.tid & 255);
        if (F.tid < 256) x = hs[F.tid] * bf2f(PB[1024 + ch]);
        float p = wave_sum(x); if (F.lane == 0) red[F.wave] = p;
        __syncthreads();
        const float mu = (red[0] + red[1] + red[2] + red[3]) * (1.f / 256.f), dx = x - mu;
        __syncthreads();
        p = wave_sum(F.tid < 256 ? dx * dx : 0.f); if (F.lane == 0) red[F.wave] = p;
        __syncthreads();
        const float rstd = 1.0f / sqrtf((red[0] + red[1] + red[2] + red[3]) * (1.f / 256.f) + EPS);
        if (F.tid < 256) ((bf16_t*)(ws + WS_Y))[row * DMIX + 1024 + ch] = f2bf((dx * rstd * F.in[21][ch] + F.in[22][ch] * bf2f(XC[ch])) * bf2f(PB[2048 + ch]));
        __syncthreads();
    }
}
struct EpiHOut {
    static constexpr bool PERM = false, AFTER_DRAIN = true;
    const float* DENP; const float* DG; const float* QN; const float* DEM; const bf16_t* PB; const bf16_t* XC; bf16_t* Y; const float* gng; const float* skip;
    __device__ __forceinline__ void fused(f32x4 (&acc)[2][2][4][2], const Unit& u, int wr, int wc, int fr, int fq, LAS unsigned char* lds, int wid, int lane) const {
        const int h = u.aux, rl0 = wr * 64 + fr, col0 = wc * 32 + 4 * fq; const size_t vb = (size_t)h * MA + (size_t)u.pm * 256;
        LAS float* P1 = (LAS float*)lds; LAS float* P2 = (LAS float*)lds + 1024;
#pragma unroll
        for (int ai = 0; ai < 2; ++ai) { u32x2 ow[4][2][2]; f32x4 dp[4]; float dgq[4], dem[4];
#pragma unroll
            for (int m = 0; m < 4; ++m) { const int t = rl0 + ai * 128 + m * 16; const size_t row = (size_t)u.pm * 256 + t; dp[m] = *(const f32x4*)(DENP + (vb + t) * 4); dgq[m] = QN[vb + t]; dem[m] = DEM[vb + t];
#pragma unroll
                for (int bj = 0; bj < 2; ++bj)
#pragma unroll
                    for (int n = 0; n < 2; ++n) ow[m][bj][n] = *(const u32x2*)(PB + row * 3072 + 1024 + h * 256 + col0 + bj * 128 + n * 16); }
#pragma unroll
            for (int m = 0; m < 4; ++m) { const int t = rl0 + ai * 128 + m * 16; const float den = (dp[m][0] + dp[m][1]) + (dp[m][2] + dp[m][3]) + dgq[m];
                const float dinv = 1.0f / fmaxf(fabsf(den), dem[m]); float s = 0.f;
#pragma unroll
                for (int bj = 0; bj < 2; ++bj)
#pragma unroll
                    for (int n = 0; n < 2; ++n) { const u32x2 o2 = ow[m][bj][n];
                        f32x4 v = acc[ai][bj][m][n] * dinv; v[0] *= bf_lo(o2.x); v[1] *= bf_hi(o2.x); v[2] *= bf_lo(o2.y); v[3] *= bf_hi(o2.y); acc[ai][bj][m][n] = v; s += (v[0] + v[1]) + (v[2] + v[3]); }
                s += __shfl_xor(s, 16); s += __shfl_xor(s, 32); if (fq == 0) P1[t * 4 + wc] = s; } }
        asm volatile("s_waitcnt lgkmcnt(0)" ::: "memory"); __builtin_amdgcn_s_barrier(); asm volatile("" ::: "memory");
#pragma unroll
        for (int ai = 0; ai < 2; ++ai)
#pragma unroll
            for (int m = 0; m < 4; ++m) { const int t = rl0 + ai * 128 + m * 16; const f32x4 ps = *(const LAS f32x4*)(P1 + t * 4); const float mu = ((ps[0] + ps[1]) + (ps[2] + ps[3])) * (1.f / 256.f); float q = 0.f;
#pragma unroll
                for (int bj = 0; bj < 2; ++bj)
#pragma unroll
                    for (int n = 0; n < 2; ++n) { f32x4 v = acc[ai][bj][m][n] - mu; acc[ai][bj][m][n] = v; q += (v[0] * v[0] + v[1] * v[1]) + (v[2] * v[2] + v[3] * v[3]); }
                q += __shfl_xor(q, 16); q += __shfl_xor(q, 32); if (fq == 0) P2[t * 4 + wc] = q; }
        asm volatile("s_waitcnt lgkmcnt(0)" ::: "memory"); __builtin_amdgcn_s_barrier(); asm volatile("" ::: "memory");
#pragma unroll
        for (int ai = 0; ai < 2; ++ai) { u32x2 xw[4][2][2], zw[4][2][2];
#pragma unroll
            for (int m = 0; m < 4; ++m) { const int t = rl0 + ai * 128 + m * 16; const size_t row = (size_t)u.pm * 256 + t;
#pragma unroll
                for (int bj = 0; bj < 2; ++bj)
#pragma unroll
                    for (int n = 0; n < 2; ++n) { const int c = h * 256 + col0 + bj * 128 + n * 16; xw[m][bj][n] = *(const u32x2*)(XC + row * DM + c); zw[m][bj][n] = *(const u32x2*)(PB + row * 3072 + 2048 + c); } }
#pragma unroll
            for (int m = 0; m < 4; ++m) { const int t = rl0 + ai * 128 + m * 16; const size_t row = (size_t)u.pm * 256 + t; const f32x4 ps = *(const LAS f32x4*)(P2 + t * 4);
                const float rstd = 1.0f / sqrtf(((ps[0] + ps[1]) + (ps[2] + ps[3])) * (1.f / 256.f) + EPS);
#pragma unroll
                for (int bj = 0; bj < 2; ++bj)
#pragma unroll
                    for (int n = 0; n < 2; ++n) { const int c = h * 256 + col0 + bj * 128 + n * 16; const u32x2 x2 = xw[m][bj][n], z2 = zw[m][bj][n];
                        const f32x4 ggv = *(const f32x4*)(gng + c), skv = *(const f32x4*)(skip + c); const f32x4 v = acc[ai][bj][m][n] * rstd * ggv; u32x2 w;
                        w.x = cvt_pk_bf16((v[0] + skv[0] * bf_lo(x2.x)) * bf_lo(z2.x), (v[1] + skv[1] * bf_hi(x2.x)) * bf_hi(z2.x));
                        w.y = cvt_pk_bf16((v[2] + skv[2] * bf_lo(x2.y)) * bf_lo(z2.y), (v[3] + skv[3] * bf_hi(x2.y)) * bf_hi(z2.y));
                        *(u32x2*)(Y + row * DMIX + 1024 + c) = w; } } }
    }
};
__device__ __forceinline__ void p6_hout(const Ctx& F) {
    unsigned char* ws = F.ws; Gemm g{512, 512, 512};
    OrderUnitNT S{NUNIT, F.G, F.bid, (const char*)(ws + WS_PQ), 0, 0, (size_t)256 * 512 * 2, (const char*)(ws + WS_VC), 0, 0, (size_t)256 * 512 * 2};
    EpiHOut E{(const float*)(ws + WS_DENP), (const float*)(ws + WS_DG), (const float*)(ws + WS_QN), (const float*)(ws + WS_DEM), (const bf16_t*)(ws + WS_PROJB), (const bf16_t*)(ws + WS_XB), (bf16_t*)(ws + WS_Y), F.in[21], F.in[22]};
    pg8::gemm_phase<EpiHOut, OrderUnitNT, false, true>(F.lds, g, S, E);
}
template <class PtrF, class Ef>
__device__ __forceinline__ void sample_gemm(const Ctx& F, int nitems, int K, int lda, int ldb, const PtrF& P, const Ef& E) {
    int lane_ = F.lane; asm volatile("" : "+v"(lane_));
    const int l15 = lane_ & 15, lq = lane_ >> 4, w = F.wave;
    for (int item = F.bid; item < nitems; item += F.G) {
        const bf16_t* A; const bf16_t* B; P(item, A, B);
        const bf16_t* ap = A + (size_t)(16 * w + l15) * lda + 8 * lq; const bf16_t* bp = B + (size_t)l15 * ldb + 8 * lq;
        f32x4 acc = (f32x4){0.f, 0.f, 0.f, 0.f};
        for (int k0 = 0; k0 < K; k0 += 256) { bf16x8 a[8], b[8];
#pragma unroll
            for (int j = 0; j < 8; ++j) { a[j] = *(const bf16x8*)(ap + k0 + 32 * j); b[j] = *(const bf16x8*)(bp + k0 + 32 * j); }
#pragma unroll
            for (int j = 0; j < 8; ++j) acc = __builtin_amdgcn_mfma_f32_16x16x32_bf16(a[j], b[j], acc, 0, 0, 0); }
#pragma unroll
        for (int r = 0; r < 4; ++r) E(item, 16 * w + 4 * lq + r, l15, acc[r]);
    }
}
__device__ __forceinline__ void sample_inproj(const Ctx& F) {
    unsigned char* ws = F.ws; const bf16_t* XB = (const bf16_t*)(ws + WS_XB) + (size_t)MP * DM; const bf16_t* W = (const bf16_t*)(ws + WS_WIN);
    bf16_t* PA = (bf16_t*)(ws + WS_PROJA) + (size_t)MP * 3072; bf16_t* PB = (bf16_t*)(ws + WS_PROJB) + (size_t)MP * 3072; bf16_t* XB2 = (bf16_t*)(ws + WS_XB2) + (size_t)MP * DM; const float* rs = (const float*)(ws + WS_RS) + MP;
    sample_gemm(F, NIN / 16, DM, DM, DM,
        [=](int item, const bf16_t*& A, const bf16_t*& B) { A = XB; B = W + (size_t)item * 16 * DM; },
        [=](int item, int r, int c, float acc) { const int col = item * 16 + c, grp = col >> 10; float v = acc * rs[r];
            if (grp < 2) { const f32x2 g2 = gelu_pk((f32x2){v, v}); v = g2.x; } else if (grp == 2 || grp == 5) v = siluf_(v); else if (grp == 4) v = sigmoidf_(v);
            bf16_t* dst = col < 3072 ? PA + (size_t)r * 3072 + col : (col < 4096 ? XB2 + (size_t)r * DM + (col - 3072) : PB + (size_t)r * 3072 + (col - 3072)); *dst = f2bf(v); });
}
__device__ __forceinline__ void sample_qkv(const Ctx& F) {
    unsigned char* ws = F.ws; const bf16_t* XC = (const bf16_t*)(ws + WS_XB) + (size_t)MP * DM; const bf16_t* XBr = (const bf16_t*)(ws + WS_PROJB) + (size_t)MP * 3072;
    const bf16_t* WQ = (const bf16_t*)(ws + WS_WQ); const bf16_t* WK = (const bf16_t*)(ws + WS_WK); const bf16_t* WV = (const bf16_t*)(ws + WS_WV);
    bf16_t* Q = (bf16_t*)(ws + WS_Q) + (size_t)MP * 1024; bf16_t* Kk = (bf16_t*)(ws + WS_K) + (size_t)MP * 1024; bf16_t* Vs = (bf16_t*)(ws + WS_VS);
    sample_gemm(F, 128, 256, DM, 256,
        [=](int item, const bf16_t*& A, const bf16_t*& B) { const int which = item >> 6, it = item & 63, h = it >> 4; A = XC + h * 256; B = (which ? WK : WQ) + (size_t)h * 65536 + (size_t)(it & 15) * 16 * 256; },
        [=](int item, int r, int c, float acc) { const int which = item >> 6, it = item & 63; bf16_t* O = which ? Kk : Q; O[(size_t)r * 1024 + it * 16 + c] = f2bf(which ? acc * 0.0625f : acc); });
    sample_gemm(F, 64, 256, 3072, 256,
        [=](int item, const bf16_t*& A, const bf16_t*& B) { const int h = item >> 4; A = XBr + h * 256; B = WV + (size_t)h * 65536 + (size_t)(item & 15) * 16 * 256; },
        [=](int item, int r, int c, float acc) { Vs[(size_t)r * 1024 + item * 16 + c] = f2bf(acc); });
}
__device__ __forceinline__ void sample_outproj(const Ctx& F) {
    unsigned char* ws = F.ws; const bf16_t* Y = (const bf16_t*)(ws + WS_Y) + (size_t)MP * DMIX; const bf16_t* W = (const bf16_t*)(ws + WS_WOUT);
    const float* xs = F.in[1]; float* out = F.out + O_YS; bf16_t* X1B = (bf16_t*)(ws + WS_X1B) + (size_t)MP * DM;
    sample_gemm(F, DM / 16, DMIX, DMIX, DMIX,
        [=](int item, const bf16_t*& A, const bf16_t*& B) { A = Y; B = W + (size_t)item * 16 * DMIX; },
        [=](int item, int r, int c, float acc) { const int col = item * 16 + c; const float v = xs[(size_t)r * DM + col] + acc; out[(size_t)r * DM + col] = v; X1B[(size_t)r * DM + col] = f2bf(v); });
}
__device__ __forceinline__ void sample_ple(const Ctx& F) {
    unsigned char* ws = F.ws; const bf16_t* X1B = (const bf16_t*)(ws + WS_X1B) + (size_t)MP * DM; const bf16_t* PBs = (const bf16_t*)(ws + WS_PB) + (size_t)MP * DPLE;
    const bf16_t* WG = (const bf16_t*)(ws + WS_WPG); const bf16_t* WP = (const bf16_t*)(ws + WS_WPP); const float* bias = F.in[25];
    bf16_t* GB = (bf16_t*)(ws + WS_GB) + (size_t)MP * DM; bf16_t* EB = (bf16_t*)(ws + WS_EB) + (size_t)MP * DM;
    sample_gemm(F, DM / 16, DM, DM, DM,
        [=](int item, const bf16_t*& A, const bf16_t*& B) { A = X1B; B = WG + (size_t)item * 16 * DM; },
        [=](int item, int r, int c, float acc) { const int col = item * 16 + c; GB[(size_t)r * DM + col] = f2bf(sigmoidf_(acc + bias[col])); });
    sample_gemm(F, DM / 16, DPLE, DPLE, DPLE,
        [=](int item, const bf16_t*& A, const bf16_t*& B) { A = PBs; B = WP + (size_t)item * 16 * DPLE; },
        [=](int item, int r, int c, float acc) { EB[(size_t)r * DM + item * 16 + c] = f2bf(acc); });
}
template <class PtrF, class Ef>
__device__ __forceinline__ void sample_gemm_ks(const Ctx& F, int nitems, int K, int lda, int ldb, const PtrF& P, const Ef& E) {
    int lane_ = F.lane; asm volatile("" : "+v"(lane_)); const int l15 = lane_ & 15, lq = lane_ >> 4, w = F.wave; LAS f32x4* red = (LAS f32x4*)F.lds;
    const int ks = K >> 3;
    for (int item = F.bid; item < nitems; item += F.G) {
        const bf16_t* A; const bf16_t* B; P(item, A, B);
        const bf16_t* ap = A + (size_t)l15 * lda + w * ks + 8 * lq; const bf16_t* bp = B + (size_t)l15 * ldb + w * ks + 8 * lq;
        f32x4 acc[2][4];
#pragma unroll
        for (int m = 0; m < 2; ++m)
#pragma unroll
            for (int n = 0; n < 4; ++n) acc[m][n] = (f32x4){0.f, 0.f, 0.f, 0.f};
        for (int k0 = 0; k0 < ks; k0 += 128) { bf16x8 a[4][2], b[4][4];
#pragma unroll
            for (int j = 0; j < 4; ++j) {
#pragma unroll
                for (int m = 0; m < 2; ++m) a[j][m] = (k0 + 32 * j < ks) ? *(const bf16x8*)(ap + (size_t)(16 * m) * lda + k0 + 32 * j) : (bf16x8){0, 0, 0, 0, 0, 0, 0, 0};
#pragma unroll
                for (int n = 0; n < 4; ++n) b[j][n] = (k0 + 32 * j < ks) ? *(const bf16x8*)(bp + (size_t)(16 * n) * ldb + k0 + 32 * j) : (bf16x8){0, 0, 0, 0, 0, 0, 0, 0}; }
#pragma unroll
            for (int j = 0; j < 4; ++j)
#pragma unroll
                for (int m = 0; m < 2; ++m)
#pragma unroll
                    for (int n = 0; n < 4; ++n) acc[m][n] = __builtin_amdgcn_mfma_f32_16x16x32_bf16(a[j][m], b[j][n], acc[m][n], 0, 0, 0); }
        __syncthreads();
#pragma unroll
        for (int m = 0; m < 2; ++m)
#pragma unroll
            for (int n = 0; n < 4; ++n) red[(w * 8 + m * 4 + n) * 64 + F.lane] = acc[m][n];
        __syncthreads();
        f32x4 s = red[(0 * 8 + w) * 64 + F.lane];
#pragma unroll
        for (int ww = 1; ww < 8; ++ww) s = s + red[(ww * 8 + w) * 64 + F.lane];
        const int mt = w >> 2, nt = w & 3;
#pragma unroll
        for (int r = 0; r < 4; ++r) E(item, 16 * mt + 4 * lq + r, 16 * nt + l15, s[r]);
    }
    __syncthreads();
}
__device__ __forceinline__ void sample_outproj_ks(const Ctx& F) {
    unsigned char* ws = F.ws; const bf16_t* Y = (const bf16_t*)(ws + WS_Y) + (size_t)MP * DMIX; const bf16_t* W = (const bf16_t*)(ws + WS_WOUT);
    const float* xs = F.in[1]; bf16_t* X1B = (bf16_t*)(ws + WS_X1B) + (size_t)MP * DM;
    int lane_ = F.lane; asm volatile("" : "+v"(lane_)); const int l15 = lane_ & 15, lq = lane_ >> 4, w = F.wave; LAS f32x4* red = (LAS f32x4*)F.lds;
    for (int item = F.bid; item < 256; item += F.G) { const int rb = item & 3, cb = item >> 2;
        const bf16_t* ap = Y + (size_t)(rb * 32 + l15) * DMIX + w * 256 + 8 * lq; const bf16_t* bp = W + (size_t)(cb * 16 + l15) * DMIX + w * 256 + 8 * lq;
        bf16x8 a[8][2], b[8]; float xr[4] = {0.f, 0.f, 0.f, 0.f};
#pragma unroll
        for (int j = 0; j < 8; ++j) { a[j][0] = *(const bf16x8*)(ap + 32 * j); a[j][1] = *(const bf16x8*)(ap + (size_t)16 * DMIX + 32 * j); b[j] = *(const bf16x8*)(bp + 32 * j); }
        if (w < 2) {
#pragma unroll
            for (int r = 0; r < 4; ++r) xr[r] = xs[(size_t)(rb * 32 + 16 * w + 4 * lq + r) * DM + cb * 16 + l15]; }
        f32x4 acc[2] = {(f32x4){0.f, 0.f, 0.f, 0.f}, (f32x4){0.f, 0.f, 0.f, 0.f}};
#pragma unroll
        for (int j = 0; j < 8; ++j)
#pragma unroll
            for (int m = 0; m < 2; ++m) acc[m] = __builtin_amdgcn_mfma_f32_16x16x32_bf16(a[j][m], b[j], acc[m], 0, 0, 0);
        __syncthreads();
        red[(w * 2 + 0) * 64 + F.lane] = acc[0]; red[(w * 2 + 1) * 64 + F.lane] = acc[1];
        __syncthreads();
        if (w < 2) { f32x4 s = red[(0 * 2 + w) * 64 + F.lane];
#pragma unroll
            for (int ww = 1; ww < 8; ++ww) s = s + red[(ww * 2 + w) * 64 + F.lane];
#pragma unroll
            for (int r = 0; r < 4; ++r) X1B[(size_t)(rb * 32 + 16 * w + 4 * lq + r) * DM + cb * 16 + l15] = f2bf(xr[r] + s[r]); }
    }
    __syncthreads();
}
__device__ __forceinline__ void sample_ple_ks(const Ctx& F) {
    unsigned char* ws = F.ws; const bf16_t* X1B = (const bf16_t*)(ws + WS_X1B) + (size_t)MP * DM; const bf16_t* PBs = (const bf16_t*)(ws + WS_PB) + (size_t)MP * DPLE;
    const bf16_t* WG = (const bf16_t*)(ws + WS_WPG); const bf16_t* WP = (const bf16_t*)(ws + WS_WPP); const float* bias = F.in[25];
    bf16_t* GB = (bf16_t*)(ws + WS_GB) + (size_t)MP * DM; bf16_t* EB = (bf16_t*)(ws + WS_EB) + (size_t)MP * DM;
    sample_gemm_ks(F, 64, DM, DM, DM,
        [=](int item, const bf16_t*& A, const bf16_t*& B) { A = X1B + (size_t)(item & 3) * 32 * DM; B = WG + (size_t)(item >> 2) * 64 * DM; },
        [=](int item, int r, int c, float acc) { const int row = (item & 3) * 32 + r, col = (item >> 2) * 64 + c; GB[(size_t)row * DM + col] = f2bf(sigmoidf_(acc + bias[col])); });
    sample_gemm_ks(F, 64, DPLE, DPLE, DPLE,
        [=](int item, const bf16_t*& A, const bf16_t*& B) { A = PBs + (size_t)(item & 3) * 32 * DPLE; B = WP + (size_t)(item >> 2) * 64 * DPLE; },
        [=](int item, int r, int c, float acc) { const int row = (item & 3) * 32 + r, col = (item >> 2) * 64 + c; EB[(size_t)row * DM + col] = f2bf(acc); });
}
#define XB_TMO      128
#define XB_XCNT(j)  (256  + 64 * (j))
#define XB_XSUB(j)  (1280 + 64 * (j))
#define XB_XGEN(j)  (2304 + 64 * (j))
#define XB_TOP      3328
#define XB_TOPGEN   3392
#define XCD_BAR_WORDS 3456
#define XB_SPIN_CAP (1u << 18)
__device__ __forceinline__ unsigned xb_ld(unsigned* p)              { return __hip_atomic_load(p, __ATOMIC_RELAXED, __HIP_MEMORY_SCOPE_AGENT); }
__device__ __forceinline__ unsigned xb_add(unsigned* p, unsigned v) { return __hip_atomic_fetch_add(p, v, __ATOMIC_RELAXED, __HIP_MEMORY_SCOPE_AGENT); }
__device__ __forceinline__ unsigned xb_xcc_id() { return (unsigned)__builtin_amdgcn_s_getreg((3 << 11) | 20) & 0xFu; }
#define XB_SPIN(cond, bar) do { unsigned _sp = 0; while (cond) { __builtin_amdgcn_s_sleep(1); \
    if ((++_sp & 255u) == 0u) { if (xb_ld(&(bar)[XB_TMO])) break; if (_sp > XB_SPIN_CAP) { atomicAdd(&(bar)[XB_TMO], 1u); break; } } } } while (0)
struct XcdBarrier { unsigned* bar; unsigned x; volatile LAS unsigned* st; };
__device__ __forceinline__ XcdBarrier xcd_barrier_post(unsigned* bar, volatile LAS unsigned* st) {
    XcdBarrier b; b.bar = bar; b.x = xb_xcc_id(); b.st = st;
    if (threadIdx.x == 0) (void)xb_add(&bar[XB_XCNT(b.x)], 1u);
    return b;
}
__device__ __forceinline__ void xcd_barrier_complete(unsigned* bar, unsigned x, unsigned& nloc, unsigned& nx) {
    const unsigned G = gridDim.x * gridDim.y * gridDim.z;
    unsigned sum, cnt, mine, sp = 0u;
    for (;;) {
        sum = 0u; cnt = 0u; mine = 0u;
#pragma unroll
        for (unsigned j = 0; j < 16; ++j) { const unsigned c = xb_ld(&bar[XB_XCNT(j)]); sum += c; cnt += (c > 0u) ? 1u : 0u; mine = (j == x) ? c : mine; }
        if (sum == G) break;
        __builtin_amdgcn_s_sleep(1);
        if ((++sp & 255u) == 0u) { if (xb_ld(&bar[XB_TMO])) break; if (sp > XB_SPIN_CAP) { atomicAdd(&bar[XB_TMO], 1u); break; } }
    }
    nloc = mine > 0u ? mine : 1u; nx = cnt > 0u ? cnt : 1u;
}
__device__ __forceinline__ void xcd_barrier(const XcdBarrier& b) {
    asm volatile("s_waitcnt vmcnt(0)" ::: "memory");
    __syncthreads();
    if (threadIdx.x == 0) {
        unsigned* bar = b.bar;
        __builtin_amdgcn_s_waitcnt(0);
        unsigned nloc = b.st[0], nx = b.st[1];
        if (nloc == 0u) { xcd_barrier_complete(bar, b.x, nloc, nx); b.st[0] = nloc; b.st[1] = nx; }
        const unsigned old = xb_add(&bar[XB_XSUB(b.x)], 1u);
        const unsigned gen = old / nloc;
        if (old + 1u == (gen + 1u) * nloc) {
            __builtin_amdgcn_fence(__ATOMIC_RELEASE, "agent");
            asm volatile("s_waitcnt vmcnt(0)" ::: "memory");
            const unsigned og = xb_add(&bar[XB_TOP], 1u);
            const unsigned tg = og / nx;
            if (og + 1u == (tg + 1u) * nx) xb_add(&bar[XB_TOPGEN], 1u);
            else XB_SPIN(xb_ld(&bar[XB_TOPGEN]) == tg, bar);
            __builtin_amdgcn_fence(__ATOMIC_ACQUIRE, "agent");
            xb_add(&bar[XB_XGEN(b.x)], 1u);
            asm volatile("s_waitcnt vmcnt(0)" ::: "memory");
        } else {
            XB_SPIN(xb_ld(&bar[XB_XGEN(b.x)]) == gen, bar);
            __builtin_amdgcn_fence(__ATOMIC_ACQUIRE, "agent");
            asm volatile("s_waitcnt vmcnt(0)" ::: "memory");
        }
    }
    __syncthreads();
}
__global__ void __launch_bounds__(512, 2) mega(Args args) {
    MAKE_CTX();
    volatile LAS unsigned* MISC = (volatile LAS unsigned*)(F.lds + 131072 + 320);
    if (F.tid < 32) MISC[F.tid] = 0u;
    __syncthreads();
    const XcdBarrier bar = xcd_barrier_post((unsigned*)(ws + WS_CTL), MISC + 8);
#define GRID_SYNC() xcd_barrier(bar)
    p0_prologue(F);      GRID_SYNC();
    sample_inproj(F); p1_inproj(F); GRID_SYNC();
    p2a_conv_gates(F); p2b_spatial_units(F); GRID_SYNC();
    p2b_mscan(F); p3_s12(F); p2c_sample_rows(F); GRID_SYNC();
    p3_qkv(F);           GRID_SYNC();
    if (F.bid & 1) { p5s_sample(F); p4_scores_dc(F); } else { p4_scores_dc(F); p5s_sample(F); } GRID_SYNC();
    p5_scan_sample(F);   GRID_SYNC();
    p6_hout(F);          GRID_SYNC();
    sample_outproj_ks(F); p7_outproj(F); GRID_SYNC();
    p8_ple(F);           GRID_SYNC();
    p9_final(F);
}

extern "C" void kernel_launch(void* const* d_in, const int* in_sizes, int n_in, void* d_out, int out_size, void* d_ws, size_t ws_size, hipStream_t stream) {
    static int grid = 0;
    if (grid == 0) {
        if (n_in != 29 || (size_t)out_size != O_END || ws_size < WS_END) { fprintf(stderr, "kernel_launch: unexpected shapes (n_in %d out %d ws %zu)\n", n_in, out_size, ws_size); grid = -1; return; }
        int dev = 0, cus = 0, per_cu = 0;
        if (hipGetDevice(&dev) != hipSuccess || hipDeviceGetAttribute(&cus, hipDeviceAttributeMultiprocessorCount, dev) != hipSuccess) { grid = -1; return; }
        if (hipFuncSetAttribute((const void*)mega, hipFuncAttributeMaxDynamicSharedMemorySize, LDS_BYTES) != hipSuccess) { fprintf(stderr, "kernel_launch: hipFuncSetAttribute failed\n"); grid = -1; return; }
        if (hipOccupancyMaxActiveBlocksPerMultiprocessor(&per_cu, (const void*)mega, 512, LDS_BYTES) != hipSuccess || per_cu < 1) { fprintf(stderr, "kernel_launch: occupancy query says %d\n", per_cu); grid = -1; return; }
        (void)hipGetLastError();
        grid = cus;
        if (grid != 256) { fprintf(stderr, "kernel_launch: this kernel is laid out for 256 CUs, got %d\n", grid); grid = -1; return; }
    }
    if (grid < 0) return;
    if (hipMemsetAsync((unsigned char*)d_ws + WS_CTL, 0, 16384, stream) != hipSuccess) { fprintf(stderr, "kernel_launch: memset failed\n"); return; }
    Args a{};
    for (int i = 0; i < 29; ++i) a.in[i] = (const float*)d_in[i];
    a.out = (float*)d_out; a.ws = (unsigned char*)d_ws;
    void* kargs[] = {&a};
    hipError_t e = hipLaunchCooperativeKernel((const void*)mega, dim3(grid), dim3(512), kargs, LDS_BYTES, stream);
    if (e != hipSuccess) fprintf(stderr, "kernel_launch: cooperative launch failed: %s (grid %d)\n", hipGetErrorString(e), grid);
}
```

```cpp
#include <hip/hip_runtime.h>
#include <hip/hip_cooperative_groups.h>
#include <cstdio>
#include <cstdint>
namespace cg = cooperative_groups;

#define LAS __attribute__((address_space(3)))
typedef unsigned short bf16_t;
typedef short bf16x8 __attribute__((ext_vector_type(8)));
typedef float f32x4 __attribute__((ext_vector_type(4)));
typedef float f32x2 __attribute__((ext_vector_type(2)));
typedef unsigned u32x4 __attribute__((ext_vector_type(4)));
typedef unsigned u32x2 __attribute__((ext_vector_type(2)));

constexpr int DM = 1024, SEQ = 2048, NB = 8, MP = NB * SEQ, MS = 128, MA = MP + 256, NTILE = MA / 256;
constexpr int NIN = 6144, WA = 1024, WB = 1024, HA = 8, DHA = 128, HB = 4, DHB = 256, DPLE = 256, DMIX = 2048;
constexpr int LC = 256, NCH = SEQ / LC;
constexpr int NUNIT = NB * HB * NCH;
constexpr float EPS = 1e-6f;

constexpr size_t O_Y = 0, O_YS = 16777216, O_CP = 16908288, O_NP = 19005440, O_MP = 19013632, O_CVP = 19013664, O_CS = 19038240, O_NS = 52592672, O_MS = 52723744, O_CVS = 52724256, O_VS = 53117472, O_END = 53248544;

constexpr size_t MiB = 1u << 20;
constexpr size_t WS_CTL = 0, WS_WIN = 1 * MiB, WS_WQ = 13 * MiB, WS_WK = WS_WQ + MiB / 2, WS_WV = 14 * MiB, WS_WOUT = WS_WV + MiB / 2, WS_WPG = WS_WOUT + 4 * MiB, WS_WPP = WS_WPG + 2 * MiB,
    WS_WSP = 21 * MiB, WS_WG = WS_WSP + MiB / 4, WS_RS = WS_WG + MiB / 4, WS_GLI = 22 * MiB, WS_GLF = WS_GLI + MiB / 2, WS_DA = 23 * MiB, WS_DR = WS_DA + MiB / 2, WS_DG = 24 * MiB, WS_DEM = WS_DG + MiB / 2,
    WS_DW = 25 * MiB, WS_QN = WS_DW + MiB / 2, WS_DENP = 26 * MiB, WS_DN = 27 * MiB, WS_VS = WS_DN + MiB / 2, WS_PB = 28 * MiB, WS_XB = 37 * MiB, WS_PROJA = 70 * MiB, WS_PROJB = 168 * MiB,
    WS_PQ = 266 * MiB, WS_VC = 330 * MiB, WS_Y = 394 * MiB, WS_XB2 = 460 * MiB, WS_DN4 = 493 * MiB, WS_END = 495 * MiB;
constexpr size_t WS_WGB = WS_RS + MiB / 8;
constexpr size_t WS_Q = WS_PROJA, WS_K = WS_Q + 33 * MiB, WS_WKT = WS_K + 33 * MiB;
constexpr size_t WS_X1B = WS_PROJA, WS_GB = WS_X1B + 33 * MiB, WS_EB = WS_GB + 33 * MiB;
static_assert(WS_WKT + 32 * MiB <= WS_PROJB && WS_EB + 33 * MiB <= WS_PQ, "ws map");

__device__ __forceinline__ unsigned cvt_pk_bf16(float lo, float hi) { unsigned r; asm volatile("v_cvt_pk_bf16_f32 %0, %1, %2" : "=v"(r) : "v"(lo), "v"(hi)); return r; }
__device__ __forceinline__ float bf_lo(unsigned w) { return __uint_as_float(w << 16); }
__device__ __forceinline__ float bf_hi(unsigned w) { return __uint_as_float(w & 0xffff0000u); }
__device__ __forceinline__ float bf2f(bf16_t b) { return __uint_as_float(((unsigned)b) << 16); }
__device__ __forceinline__ bf16_t f2bf(float f) { return (bf16_t)(cvt_pk_bf16(f, 0.f) & 0xffffu); }
__device__ __forceinline__ float fast_exp(float x) { return __builtin_amdgcn_exp2f(x * 1.4426950408889634f); }
__device__ __forceinline__ float sigmoidf_(float x) { return __builtin_amdgcn_rcpf(1.0f + fast_exp(-x)); }
__device__ __forceinline__ float siluf_(float x) { return x * sigmoidf_(x); }
__device__ __forceinline__ f32x2 gelu_pk(f32x2 v) {
    const f32x2 av = __builtin_elementwise_abs(v), d = av * 0.2316418882f + 1.0f;
    f32x2 t; t.x = __builtin_amdgcn_rcpf(d.x); t.y = __builtin_amdgcn_rcpf(d.y);
    f32x2 q = t * 0.5307027145f + (-0.7265760135f); q = q * t + 0.7107068705f; q = q * t + (-0.142248368f); q = q * t + 0.127414796f; q = q * t;
    const f32x2 s = (v * v) * (-0.72134752044f);
    f32x2 e; e.x = __builtin_amdgcn_exp2f(s.x); e.y = __builtin_amdgcn_exp2f(s.y);
    const f32x2 m = v * (q * e), r = v - m;
    f32x2 o; o.x = v.x < 0.f ? m.x : r.x; o.y = v.y < 0.f ? m.y : r.y; return o;
}
__device__ __forceinline__ float dpp_add(float v, const int ctrl_sel) {
    const int iv = __builtin_bit_cast(int, v); int r;
    if (ctrl_sel == 0) r = __builtin_amdgcn_update_dpp(0, iv, 0xB1, 0xF, 0xF, true);
    else if (ctrl_sel == 1) r = __builtin_amdgcn_update_dpp(0, iv, 0x4E, 0xF, 0xF, true);
    else if (ctrl_sel == 2) r = __builtin_amdgcn_update_dpp(0, iv, 0x141, 0xF, 0xF, true);
    else r = __builtin_amdgcn_update_dpp(0, iv, 0x140, 0xF, 0xF, true);
    return v + __builtin_bit_cast(float, r);
}
__device__ __forceinline__ float wave_sum(float v) {
    v = dpp_add(v, 0); v = dpp_add(v, 1); v = dpp_add(v, 2); v = dpp_add(v, 3);
    const int iv = __builtin_bit_cast(int, v);
    const float r0 = __builtin_bit_cast(float, __builtin_amdgcn_readlane(iv, 0)), r1 = __builtin_bit_cast(float, __builtin_amdgcn_readlane(iv, 16)),
                r2 = __builtin_bit_cast(float, __builtin_amdgcn_readlane(iv, 32)), r3 = __builtin_bit_cast(float, __builtin_amdgcn_readlane(iv, 48));
    return (r0 + r1) + (r2 + r3);
}
#define LDS_WAIT() asm volatile("s_waitcnt lgkmcnt(0)" ::: "memory")

namespace pg8 {
constexpr int BM = 256, BK = 64, HALF = 128, HTB = HALF * BK * 2, STAGE_BYTES = 8 * HTB;
__host__ __device__ __forceinline__ int lds_byte(int r, int c) { const int st = (r >> 4) * 2 + (c >> 5), rr = r & 15, cc = c & 31, ob = rr * 64 + cc * 2; return st * 1024 + (ob ^ (((ob >> 9) & 1) << 5)); }
__host__ __device__ __forceinline__ void stage_rc(int b, int& R, int& C) { const int st = b / 1024, sb = b % 1024, swz = sb ^ (((sb >> 9) & 1) << 5); R = (st >> 1) * 16 + swz / 64; C = (st & 1) * 32 + (swz % 64) / 2; }
__host__ __device__ __forceinline__ int perm32(int rho) { const int n = rho >> 4, i = rho & 15; return 8 * (i >> 2) + 4 * n + (i & 3); }

struct Unit { const char* a; const char* b; int pm, pn, aux; };
struct Gemm { int lda, ldb, K; };

template <class Epi, class Sched, bool ALIGN_EPI = true, bool SP2 = true>
__device__ __forceinline__ void gemm_phase(LAS unsigned char* lds, const Gemm g, const Sched& S, const Epi& E) {
    int tid_ = threadIdx.x; asm volatile("" : "+v"(tid_));
    const int tid = tid_, wid = __builtin_amdgcn_readfirstlane(tid >> 6), lane = tid & 63, wr = wid >> 2, wc = wid & 3, fr = lane & 15, fq = lane >> 4;
    int K_ = g.K; asm volatile("" : "+s"(K_)); const int K = K_, nt = K / BK; (void)K;
    unsigned voffA[2], voffB[2];
#pragma unroll
    for (int i = 0; i < 2; ++i) { int R, C; stage_rc(tid * 16 + i * 8192, R, C); const int Rb = Epi::PERM ? ((R & ~31) + perm32(R & 31)) : R;
        voffA[i] = (unsigned)(R * g.lda + C) * 2u; voffB[i] = (unsigned)(Rb * g.ldb + C) * 2u; }
    const size_t kstep = (size_t)(BK * 2);
    const size_t hstepA = (size_t)HALF * g.lda * 2, hstepB = (size_t)HALF * g.ldb * 2;
    const unsigned ldsw = (unsigned)wid * 1024u;
    const int aoff = lds_byte(wr * 64 + fr, fq * 8), boff = lds_byte(wc * 32 + fr, fq * 8);
#define PG8_SA(b, h) (((b) * 2 + (h)) * HTB)
#define PG8_SB(b, h) ((4 + (b) * 2 + (h)) * HTB)
#define PG8_STAGE(bufoff, gbase, voff) do { _Pragma("unroll") for (int _i = 0; _i < 2; ++_i) \
        __builtin_amdgcn_global_load_lds((const unsigned*)((const char*)(gbase) + (voff)[_i]), (LAS unsigned*)(lds + (bufoff) + ldsw + _i * 8192), 16, 0, 0); } while (0)
#define PG8_LDA(dst, b, h) do { _Pragma("unroll") for (int m = 0; m < 4; ++m) _Pragma("unroll") for (int k = 0; k < 2; ++k) dst[m][k] = *(const LAS bf16x8*)(lds + PG8_SA(b, h) + aoff + m * 2048 + k * 1024); } while (0)
#define PG8_LDB(dst, b, h) do { _Pragma("unroll") for (int n = 0; n < 2; ++n) _Pragma("unroll") for (int k = 0; k < 2; ++k) dst[n][k] = *(const LAS bf16x8*)(lds + PG8_SB(b, h) + boff + n * 2048 + k * 1024); } while (0)
#define PG8_MMA(ai, bj, At, Bt) do { __builtin_amdgcn_s_setprio(1); _Pragma("unroll") for (int m = 0; m < 4; ++m) _Pragma("unroll") for (int n = 0; n < 2; ++n) _Pragma("unroll") for (int k = 0; k < 2; ++k) \
        acc[ai][bj][m][n] = __builtin_amdgcn_mfma_f32_16x16x32_bf16(Bt[n][k], At[m][k], acc[ai][bj][m][n], 0, 0, 0); __builtin_amdgcn_s_setprio(0); } while (0)
#define PG8_WAIT_V(n) asm volatile("s_waitcnt vmcnt(" #n ")" ::: "memory")
#define PG8_WAIT_L(n) asm volatile("s_waitcnt lgkmcnt(" #n ")" ::: "memory")
#define PG8_BAR __builtin_amdgcn_s_barrier()
#define PG8_SCHED __builtin_amdgcn_sched_barrier(0)
    Unit cur, nxt; int ui = 0;
    if (!S.next(0, cur)) return;
    f32x4 acc[2][2][4][2];
#pragma unroll
    for (int a = 0; a < 2; ++a)
#pragma unroll
        for (int b = 0; b < 2; ++b)
#pragma unroll
            for (int m = 0; m < 4; ++m)
#pragma unroll
                for (int n = 0; n < 2; ++n) acc[a][b][m][n] = (f32x4){0.f, 0.f, 0.f, 0.f};
    bf16x8 At[4][2], B0[2][2], B1[2][2];
    const char* cA = cur.a; const char* cB = cur.b;
    if constexpr (SP2) {
        PG8_STAGE(PG8_SB(0, 0), cB, voffB); PG8_STAGE(PG8_SB(0, 1), cB + hstepB, voffB); PG8_STAGE(PG8_SA(0, 0), cA, voffA); PG8_STAGE(PG8_SA(0, 1), cA + hstepA, voffA);
        if (wr == 1) PG8_BAR;
        PG8_WAIT_V(2); PG8_BAR;
        PG8_STAGE(PG8_SB(1, 0), cB + kstep, voffB); PG8_STAGE(PG8_SA(1, 0), cA + kstep, voffA); PG8_STAGE(PG8_SB(1, 1), cB + hstepB + kstep, voffB);
        PG8_WAIT_V(6); PG8_BAR;
    } else {
        PG8_STAGE(PG8_SB(0, 0), cB, voffB); PG8_STAGE(PG8_SA(0, 0), cA, voffA); PG8_STAGE(PG8_SB(0, 1), cB + hstepB, voffB); PG8_STAGE(PG8_SA(0, 1), cA + hstepA, voffA);
        if (wr == 1) PG8_BAR;
        PG8_WAIT_V(4); PG8_BAR;
        PG8_STAGE(PG8_SB(1, 0), cB + kstep, voffB); PG8_STAGE(PG8_SA(1, 0), cA + kstep, voffA); PG8_STAGE(PG8_SB(1, 1), cB + hstepB + kstep, voffB);
        PG8_WAIT_V(6); PG8_BAR;
    }
    for (;;) {
        const bool has_next = S.next(ui + 1, nxt);
        const char* nA = has_next ? nxt.a : cA; const char* nB = has_next ? nxt.b : cB;
#pragma unroll 1
        for (int t = 0; t < nt; t += 2) {
            const bool last = (t == nt - 2);
            const char* a1 = cA + (size_t)(t + 1) * kstep;
            const char* a2 = last ? nA : cA + (size_t)(t + 2) * kstep; const char* b2 = last ? nB : cB + (size_t)(t + 2) * kstep;
            const char* a3 = a2 + kstep; const char* b3 = b2 + kstep;
            if constexpr (SP2) {
            PG8_LDB(B0, 0, 0); PG8_LDB(B1, 0, 1); PG8_SCHED; PG8_LDA(At, 0, 0); PG8_STAGE(PG8_SA(1, 1), a1 + hstepA, voffA);
            PG8_WAIT_V(8); PG8_WAIT_L(0); PG8_BAR; PG8_MMA(0, 0, At, B0); PG8_MMA(0, 1, At, B1); PG8_BAR; PG8_SCHED;
            PG8_LDA(At, 0, 1); PG8_STAGE(PG8_SB(0, 0), b2, voffB); PG8_STAGE(PG8_SB(0, 1), b2 + hstepB, voffB); PG8_STAGE(PG8_SA(0, 0), a2, voffA);
            PG8_WAIT_V(8); PG8_WAIT_L(0); PG8_BAR; PG8_MMA(1, 0, At, B0); PG8_MMA(1, 1, At, B1); PG8_BAR; PG8_SCHED;
            PG8_LDB(B0, 1, 0); PG8_LDB(B1, 1, 1); PG8_SCHED; PG8_LDA(At, 1, 0); PG8_STAGE(PG8_SA(0, 1), a2 + hstepA, voffA);
            PG8_WAIT_V(8); PG8_WAIT_L(0); PG8_BAR; PG8_MMA(0, 0, At, B0); PG8_MMA(0, 1, At, B1); PG8_BAR; PG8_SCHED;
            PG8_LDA(At, 1, 1); PG8_STAGE(PG8_SB(1, 0), b3, voffB); PG8_STAGE(PG8_SB(1, 1), b3 + hstepB, voffB); PG8_STAGE(PG8_SA(1, 0), a3, voffA);
            PG8_WAIT_V(8); PG8_WAIT_L(0); PG8_BAR; PG8_MMA(1, 0, At, B0); PG8_MMA(1, 1, At, B1); PG8_BAR; PG8_SCHED;
            } else {
            PG8_LDB(B0, 0, 0); PG8_SCHED; PG8_LDA(At, 0, 0); PG8_STAGE(PG8_SA(1, 1), a1 + hstepA, voffA);
            PG8_WAIT_L(8); PG8_BAR; PG8_WAIT_L(0); PG8_MMA(0, 0, At, B0); PG8_BAR; PG8_SCHED;
            PG8_LDB(B1, 0, 1); PG8_STAGE(PG8_SB(0, 0), b2, voffB);
            PG8_BAR; PG8_WAIT_L(0); PG8_MMA(0, 1, At, B1); PG8_BAR;
            PG8_LDA(At, 0, 1); PG8_STAGE(PG8_SA(0, 0), a2, voffA);
            PG8_BAR; PG8_WAIT_L(0); PG8_MMA(1, 0, At, B0); PG8_BAR; PG8_SCHED;
            PG8_STAGE(PG8_SB(0, 1), b2 + hstepB, voffB);
            PG8_WAIT_V(6); PG8_BAR; PG8_MMA(1, 1, At, B1); PG8_BAR;
            PG8_LDB(B0, 1, 0); PG8_SCHED; PG8_LDA(At, 1, 0); PG8_STAGE(PG8_SA(0, 1), a2 + hstepA, voffA);
            PG8_WAIT_L(8); PG8_BAR; PG8_WAIT_L(0); PG8_MMA(0, 0, At, B0); PG8_BAR; PG8_SCHED;
            PG8_LDB(B1, 1, 1); PG8_STAGE(PG8_SB(1, 0), b3, voffB);
            PG8_BAR; PG8_WAIT_L(0); PG8_MMA(0, 1, At, B1); PG8_BAR;
            PG8_LDA(At, 1, 1); PG8_STAGE(PG8_SA(1, 0), a3, voffA);
            PG8_BAR; PG8_WAIT_L(0); PG8_MMA(1, 0, At, B0); PG8_BAR; PG8_SCHED;
            PG8_STAGE(PG8_SB(1, 1), b3 + hstepB, voffB);
            PG8_WAIT_V(6); PG8_BAR; PG8_MMA(1, 1, At, B1); PG8_BAR;
            }
        }
        if constexpr (ALIGN_EPI) { if (wr == 0) PG8_BAR; }
        if constexpr (!Epi::AFTER_DRAIN) { E(acc, cur, wr, wc, fr, fq); }
        if (!has_next) break;
#pragma unroll
        for (int a = 0; a < 2; ++a)
#pragma unroll
            for (int b = 0; b < 2; ++b)
#pragma unroll
                for (int m = 0; m < 4; ++m)
#pragma unroll
                    for (int n = 0; n < 2; ++n) acc[a][b][m][n] = (f32x4){0.f, 0.f, 0.f, 0.f};
        cur = nxt; cA = nA; cB = nB; ++ui;
        if constexpr (ALIGN_EPI) { if (wr == 1) PG8_BAR; }
    }
    PG8_WAIT_V(0);
    if constexpr (!ALIGN_EPI) { if (wr == 0) PG8_BAR; }
    PG8_BAR;
    if constexpr (Epi::AFTER_DRAIN) { E.fused(acc, cur, wr, wc, fr, fq, lds, wid, lane); }
#undef PG8_SA
#undef PG8_SB
#undef PG8_STAGE
#undef PG8_LDA
#undef PG8_LDB
#undef PG8_MMA
#undef PG8_WAIT_V
#undef PG8_WAIT_L
#undef PG8_BAR
#undef PG8_SCHED
}
}
using pg8::Unit; using pg8::Gemm;

constexpr int LDS_BYTES = 147456;
struct Args { const float* in[29]; float* out; unsigned char* ws; };

struct Ctx {
    LAS unsigned char* lds; int tid, lane, wave, G, bid, gw, NGW;
    const float* const* in; float* out; unsigned char* ws;
};

struct TDesc { const float* W; bf16_t* WT; const float* ksc; int ldw, ldt, k0, n0; };
constexpr int I_WIN = 16 * 192, I_QKV = 12 * 4 * 8, I_WOUT = 32 * 32, I_WPG = 16 * 32, I_WPP = 4 * 32, I_T = I_WIN + I_QKV + I_WOUT + I_WPG + I_WPP;
__device__ __forceinline__ TDesc p0_decode(const Ctx& F, int r) {
    unsigned char* ws = F.ws; TDesc d; d.ksc = nullptr;
    if (r < I_WIN) { d.W = F.in[9]; d.ldw = NIN; d.WT = (bf16_t*)(ws + WS_WIN); d.ldt = DM; d.ksc = F.in[8]; d.k0 = 64 * (r / 192); d.n0 = 32 * (r % 192); return d; } r -= I_WIN;
    if (r < I_QKV) { const int mat = r / 32, rr = r % 32, which = mat / 4, h = mat % 4;
        d.W = F.in[16 + which] + (size_t)h * 65536; d.WT = (bf16_t*)(ws + (which == 0 ? WS_WQ : which == 1 ? WS_WK : WS_WV)) + (size_t)h * 65536; d.ldw = 256; d.ldt = 256; d.k0 = 64 * (rr / 8); d.n0 = 32 * (rr % 8); return d; } r -= I_QKV;
    if (r < I_WOUT) { d.W = F.in[23]; d.ldw = DM; d.WT = (bf16_t*)(ws + WS_WOUT); d.ldt = DMIX; d.k0 = 64 * (r / 32); d.n0 = 32 * (r % 32); return d; } r -= I_WOUT;
    if (r < I_WPG) { d.W = F.in[24]; d.ldw = DM; d.WT = (bf16_t*)(ws + WS_WPG); d.ldt = DM; d.k0 = 64 * (r / 32); d.n0 = 32 * (r % 32); return d; } r -= I_WPG;
    d.W = F.in[26]; d.ldw = DM; d.WT = (bf16_t*)(ws + WS_WPP); d.ldt = DPLE; d.k0 = 64 * (r / 32); d.n0 = 32 * (r % 32); return d;
}

__device__ __forceinline__ void p0_prologue(const Ctx& F0) { Ctx F = F0; asm volatile("" : "+v"(F.tid), "+v"(F.lane), "+s"(F.gw));
    LAS float* scr = (LAS float*)(F.lds + F.wave * 16384);
    unsigned char* ws = F.ws; const int lane = F.lane;
    {
        float wv[3][32]; f32x4 ks[3][2]; TDesc td[3];
#pragma unroll
        for (int k = 0; k < 3; ++k) { const int it = F.gw + k * F.NGW;
            if (it < I_T) { td[k] = p0_decode(F, it); const int c = lane & 7;
#pragma unroll
                for (int i = 0; i < 32; ++i) { const int kk = 2 * i + (lane >> 5); wv[k][i] = __builtin_nontemporal_load(td[k].W + (size_t)(td[k].k0 + kk) * td[k].ldw + td[k].n0 + (lane & 31)); }
                if (td[k].ksc) { ks[k][0] = *(const f32x4*)(td[k].ksc + td[k].k0 + 8 * c); ks[k][1] = *(const f32x4*)(td[k].ksc + td[k].k0 + 8 * c + 4); }
                else { ks[k][0] = (f32x4){1.f, 1.f, 1.f, 1.f}; ks[k][1] = ks[k][0]; } } }
#pragma unroll
        for (int k = 0; k < 3; ++k) { const int it = F.gw + k * F.NGW;
            if (it < I_T) { const int c = lane & 7;
#pragma unroll
                for (int i = 0; i < 32; ++i) { const int kk = 2 * i + (lane >> 5); scr[kk * 33 + (lane & 31)] = wv[k][i]; }
                LDS_WAIT(); asm volatile("" ::: "memory");
#pragma unroll
                for (int j = 0; j < 4; ++j) { const int n = (lane >> 3) + 8 * j; const LAS float* s = scr + (8 * c) * 33 + n;
                    u32x4 o; o.x = cvt_pk_bf16(s[0 * 33] * ks[k][0][0], s[1 * 33] * ks[k][0][1]); o.y = cvt_pk_bf16(s[2 * 33] * ks[k][0][2], s[3 * 33] * ks[k][0][3]);
                    o.z = cvt_pk_bf16(s[4 * 33] * ks[k][1][0], s[5 * 33] * ks[k][1][1]); o.w = cvt_pk_bf16(s[6 * 33] * ks[k][1][2], s[7 * 33] * ks[k][1][3]);
                    *(u32x4*)(td[k].WT + (size_t)(td[k].n0 + n) * td[k].ldt + td[k].k0 + 8 * c) = o; }
                LDS_WAIT(); asm volatile("" ::: "memory"); } }
    }
    constexpr int I_SP = 1024, I_WG = 1024, I_YPAD = 128;
    for (int r = F.gw; r < I_SP + I_WG + I_YPAD; r += F.NGW) {
        if (r < I_SP) {
            const int t = r & 127; const float* wrow = F.in[12] + (size_t)r * 128; const f32x2 v = ((const f32x2*)wrow)[lane];
            const int s0 = 2 * lane; ((unsigned*)((bf16_t*)(ws + WS_WSP) + (size_t)r * 128))[lane] = cvt_pk_bf16(s0 <= t ? v.x : 0.f, s0 + 1 <= t ? v.y : 0.f);
            continue;
        }
        if (r < I_SP + I_WG) {
            const int i = r - I_SP, h = i >> 8, d = i & 255; const float* wif = F.in[19];
            const f32x4 wq4 = *(const f32x4*)(F.in[16] + ((size_t)h * 256 + d) * 256 + 4 * lane), wk4 = *(const f32x4*)(F.in[17] + ((size_t)h * 256 + d) * 256 + 4 * lane), wv4 = *(const f32x4*)(F.in[18] + ((size_t)h * 256 + d) * 256 + 4 * lane);
            float sx[8], sb[8];
#pragma unroll
            for (int j = 0; j < 8; ++j) { sx[j] = 0.f; sb[j] = 0.f; }
#pragma unroll
            for (int e = 0; e < 4; ++e) { const size_t rq = (size_t)(h * 256 + 4 * lane + e) * 8;
                const f32x4 q0 = *(const f32x4*)(wif + rq), q1 = *(const f32x4*)(wif + rq + 4), k0 = *(const f32x4*)(wif + 8192 + rq), k1 = *(const f32x4*)(wif + 8192 + rq + 4), v0 = *(const f32x4*)(wif + 16384 + rq), v1 = *(const f32x4*)(wif + 16384 + rq + 4);
#pragma unroll
                for (int j = 0; j < 4; ++j) { sx[j] += wq4[e] * q0[j] + wk4[e] * k0[j]; sx[4 + j] += wq4[e] * q1[j] + wk4[e] * k1[j]; sb[j] += wv4[e] * v0[j]; sb[4 + j] += wv4[e] * v1[j]; } }
#pragma unroll
            for (int j = 0; j < 8; ++j) { sx[j] = wave_sum(sx[j]); sb[j] = wave_sum(sb[j]); }
            float s = 0.f;
#pragma unroll
            for (int j = 0; j < 8; ++j) { s = (lane == j) ? sx[j] : s; s = (lane == 8 + j) ? sb[j] : s; }
            if (lane < 16) ((float*)(ws + WS_WG))[(size_t)i * 16 + lane] = s;
            if (lane < 16) { bf16_t* wgb = (bf16_t*)(ws + WS_WGB) + (size_t)(lane >> 3) * 16384 + (size_t)(lane & 7) * 1024 + i; wgb[0] = f2bf(s); wgb[8 * 1024] = 0; }
            continue;
        }
        {
            u32x4* yrow = (u32x4*)((bf16_t*)(ws + WS_Y) + (size_t)(MP + MS + (r - I_SP - I_WG)) * DMIX) + lane;
#pragma unroll
            for (int j = 0; j < 4; ++j) yrow[64 * j] = (u32x4){0u, 0u, 0u, 0u};
        }
    }
    {
        float* rs = (float*)(ws + WS_RS);
        const int r0 = F.gw * 8; const bool smp = F.gw < MS;
        f32x4 v[8][4], vs[4], pv[8], ps;
#pragma unroll
        for (int q = 0; q < 8; ++q) { const float* xrow = F.in[0] + (size_t)(r0 + q) * DM;
#pragma unroll
            for (int j = 0; j < 4; ++j) v[q][j] = __builtin_nontemporal_load((const f32x4*)xrow + lane + 64 * j); }
#pragma unroll
        for (int q = 0; q < 8; ++q) pv[q] = __builtin_nontemporal_load((const f32x4*)(F.in[6] + (size_t)(r0 + q) * DPLE) + lane);
        if (smp) {
#pragma unroll
            for (int j = 0; j < 4; ++j) vs[j] = __builtin_nontemporal_load((const f32x4*)(F.in[1] + (size_t)F.gw * DM) + lane + 64 * j);
            ps = __builtin_nontemporal_load((const f32x4*)(F.in[7] + (size_t)F.gw * DPLE) + lane); }
        auto xrow_out = [&](int r, const f32x4 (&vv)[4]) { float sq = 0.f;
#pragma unroll
            for (int j = 0; j < 4; ++j) sq += (vv[j].x * vv[j].x + vv[j].y * vv[j].y) + (vv[j].z * vv[j].z + vv[j].w * vv[j].w);
            sq = wave_sum(sq); unsigned long long* o8 = (unsigned long long*)((bf16_t*)(ws + WS_XB) + (size_t)r * DM) + lane;
#pragma unroll
            for (int j = 0; j < 4; ++j) o8[64 * j] = (unsigned long long)cvt_pk_bf16(vv[j].x, vv[j].y) | ((unsigned long long)cvt_pk_bf16(vv[j].z, vv[j].w) << 32);
            if (lane == 0) rs[r] = 1.0f / sqrtf(sq * (1.0f / DM) + EPS); };
#pragma unroll
        for (int q = 0; q < 8; ++q) xrow_out(r0 + q, v[q]);
#pragma unroll
        for (int q = 0; q < 8; ++q) ((unsigned long long*)((bf16_t*)(ws + WS_PB) + (size_t)(r0 + q) * DPLE))[lane] = (unsigned long long)cvt_pk_bf16(pv[q].x, pv[q].y) | ((unsigned long long)cvt_pk_bf16(pv[q].z, pv[q].w) << 32);
        if (smp) { xrow_out(MP + F.gw, vs);
            ((unsigned long long*)((bf16_t*)(ws + WS_PB) + (size_t)(MP + F.gw) * DPLE))[lane] = (unsigned long long)cvt_pk_bf16(ps.x, ps.y) | ((unsigned long long)cvt_pk_bf16(ps.z, ps.w) << 32); }
        for (int r = MP + MS + (F.NGW - 1 - F.gw); r < MA; r += F.NGW) { unsigned long long* o8 = (unsigned long long*)((bf16_t*)(ws + WS_XB) + (size_t)r * DM) + lane;
#pragma unroll
            for (int j = 0; j < 4; ++j) o8[64 * j] = 0ull;
            if (lane == 0) rs[r] = 0.f; ((unsigned long long*)((bf16_t*)(ws + WS_PB) + (size_t)r * DPLE))[lane] = 0ull; }
    }
}

struct OrderRowMajor {
    int nM, nN, n, G, c; const char* A; const char* B; size_t astep, bstep;
    __device__ __forceinline__ bool next(int i, Unit& u) const {
        const int L = i * G + c; if (L >= n) return false;
        u.pm = L / nN; u.pn = L % nN; u.aux = 0; u.a = A + (size_t)u.pm * astep; u.b = B + (size_t)u.pn * bstep; return true;
    }
};
struct OrderPanel4 {
    int n, G, c; const char* A; const char* B; size_t astep, bstep;
    __device__ __forceinline__ bool next(int i, Unit& u) const {
        const int L = i * G + c; if (L >= n) return false;
        if (L < 256) { const int x = L & 7, j = L >> 3; u.pm = x * 8 + (j >> 2); u.pn = j & 3; } else { u.pm = 64; u.pn = L - 256; }
        u.aux = 0; u.a = A + (size_t)u.pm * astep; u.b = B + (size_t)u.pn * bstep; return true;
    }
};
struct OrderProjSkip {
    int G, c; const char* A; const char* B; size_t astep, bstep;
    __device__ __forceinline__ bool next(int i, Unit& u) const {
        if (c < 4) return false; const int cp = c - 4; const int L = i == 0 ? cp : (i == 1 && cp < 8 ? 252 + cp : -1); if (L < 0) return false;
        if (L < 256) { const int x = L & 7, j = L >> 3; u.pm = x * 8 + (j >> 2); u.pn = j & 3; } else { u.pm = 64; u.pn = L - 256; }
        u.aux = 0; u.a = A + (size_t)u.pm * astep; u.b = B + (size_t)u.pn * bstep; return true;
    }
};
struct OrderXcd {
    int nM, nN, n, G, c; const char* A; const char* B; size_t astep, bstep;
    __device__ __forceinline__ bool next(int i, Unit& u) const {
        const int L = i * G + c; if (L >= n) return false;
        int wgid = L; { const int q = n / 8, r = n % 8, xcd = wgid % 8, off = wgid / 8; wgid = (xcd < r ? xcd * (q + 1) : r * (q + 1) + (xcd - r) * q) + off; }
        const int nig = 8 * nN, gid = wgid / nig, fm = gid * 8, gsz = (nM - fm) < 8 ? (nM - fm) : 8;
        u.pm = fm + ((wgid % nig) % gsz); u.pn = (wgid % nig) / gsz; u.aux = 0; u.a = A + (size_t)u.pm * astep; u.b = B + (size_t)u.pn * bstep; return true;
    }
};
struct EpiInProj {
    static constexpr bool PERM = true, AFTER_DRAIN = false;
    bf16_t* PA; bf16_t* PB; const float* rs;
    template <int KIND> __device__ __forceinline__ void run(const f32x4 (&acc)[2][2][4][2], bf16_t* base, int row0, int col0) const {
#pragma unroll
        for (int ai = 0; ai < 2; ++ai)
#pragma unroll
            for (int m = 0; m < 4; ++m) { const int row = row0 + ai * 128 + m * 16; const float s = rs[row]; bf16_t* rowp = base + (size_t)row * 3072 + col0;
#pragma unroll
                for (int bj = 0; bj < 2; ++bj) { f32x4 v0 = acc[ai][bj][m][0] * s, v1 = acc[ai][bj][m][1] * s;
                    if (KIND == 0) { f32x2 a = gelu_pk((f32x2){v0[0], v0[1]}), b = gelu_pk((f32x2){v0[2], v0[3]}), c = gelu_pk((f32x2){v1[0], v1[1]}), d = gelu_pk((f32x2){v1[2], v1[3]});
                        v0 = (f32x4){a.x, a.y, b.x, b.y}; v1 = (f32x4){c.x, c.y, d.x, d.y}; }
                    if (KIND == 1) {
#pragma unroll
                        for (int j = 0; j < 4; ++j) { v0[j] = siluf_(v0[j]); v1[j] = siluf_(v1[j]); } }
                    if (KIND == 3) {
#pragma unroll
                        for (int j = 0; j < 4; ++j) { v0[j] = sigmoidf_(v0[j]); v1[j] = sigmoidf_(v1[j]); } }
                    u32x4 w; w.x = cvt_pk_bf16(v0[0], v0[1]); w.y = cvt_pk_bf16(v0[2], v0[3]); w.z = cvt_pk_bf16(v1[0], v1[1]); w.w = cvt_pk_bf16(v1[2], v1[3]);
                    *(u32x4*)(rowp + bj * 128) = w; } }
    }
    __device__ __forceinline__ void operator()(const f32x4 (&acc)[2][2][4][2], const Unit& u, int wr, int wc, int fr, int fq) const {
        const int row0 = u.pm * 256 + wr * 64 + fr, pn = u.pn;
        bf16_t* base = pn < 12 ? PA + pn * 256 : PB + (pn - 12) * 256; const int col0 = wc * 32 + 8 * fq;
        if (pn < 8) run<0>(acc, base, row0, col0);
        else if (pn < 12 || pn >= 20) run<1>(acc, base, row0, col0);
        else if (pn < 16) run<2>(acc, base, row0, col0);
        else run<3>(acc, base, row0, col0);
    }
};

__device__ __forceinline__ float logsigmoidf_(float x) { return fminf(x, 0.f) - log1pf(__expf(-fabsf(x))); }
__device__ __forceinline__ void unpack8(const u32x4 w, float (&f)[8]) { f[0] = bf_lo(w.x); f[1] = bf_hi(w.x); f[2] = bf_lo(w.y); f[3] = bf_hi(w.y); f[4] = bf_lo(w.z); f[5] = bf_hi(w.z); f[6] = bf_lo(w.w); f[7] = bf_hi(w.w); }
__device__ __forceinline__ u32x4 pack8(const float (&f)[8]) { u32x4 w; w.x = cvt_pk_bf16(f[0], f[1]); w.y = cvt_pk_bf16(f[2], f[3]); w.z = cvt_pk_bf16(f[4], f[5]); w.w = cvt_pk_bf16(f[6], f[7]); return w; }

__device__ __forceinline__ void p2a_conv_gates(const Ctx& F0) { Ctx F = F0; asm volatile("" : "+v"(F.tid), "+v"(F.lane), "+s"(F.gw));
    unsigned char* ws = F.ws;
    const bf16_t* PBX = (const bf16_t*)(ws + WS_XB2);
    bf16_t* XC = (bf16_t*)(ws + WS_XB);
    const float* Wg = (const float*)(ws + WS_WG);
    float* GLI = (float*)(ws + WS_GLI); float* GLF = (float*)(ws + WS_GLF);
    const float* convw = F.in[14]; const float* convb = F.in[15]; const float* bif = F.in[20];
    LAS float* cwl = (LAS float*)F.lds; LAS bf16_t* wgl = (LAS bf16_t*)(F.lds + 20480); LAS f32x4* comb = (LAS f32x4*)(F.lds + 20480 + 32 * 2064);
    {
        u32x4 t[11];
#pragma unroll
        for (int j = 0; j < 11; ++j) { const int i = min(F.tid + 512 * j, 5375);
            const u32x4* srcp = i < 1024 ? (const u32x4*)convw + i : (i < 1280 ? (const u32x4*)convb + (i - 1024) : (const u32x4*)(ws + WS_WGB) + (i - 1280));
            t[j] = *srcp; }
#pragma unroll
        for (int j = 0; j < 11; ++j) { const int i = F.tid + 512 * j; if (i < 1280) ((LAS u32x4*)F.lds)[i] = t[j]; else if (i < 5376) { const int p = i - 1280; *(LAS u32x4*)(F.lds + 20480 + (p >> 7) * 2064 + (p & 127) * 16) = t[j]; } }
    }
    __syncthreads();
    const int l15 = F.lane & 15, lq = F.lane >> 4, rgp = F.wave >> 1, hh = F.wave & 1;
    auto conv_core = [&](int row, const float (&w0)[8], const float (&w1)[8], const float (&w2)[8], const u32x4 x0, int ch0, f32x4& acc) {
        float cur[8], xc[8];
        unpack8(x0, cur);
#pragma unroll
        for (int q = 0; q < 2; ++q) { const f32x4 c0 = *(const LAS f32x4*)(cwl + ch0 + 4 * q), c1 = *(const LAS f32x4*)(cwl + 1024 + ch0 + 4 * q), c2 = *(const LAS f32x4*)(cwl + 2048 + ch0 + 4 * q), c3 = *(const LAS f32x4*)(cwl + 3072 + ch0 + 4 * q), cb = *(const LAS f32x4*)(cwl + 4096 + ch0 + 4 * q);
#pragma unroll
            for (int e = 0; e < 4; ++e) xc[4 * q + e] = siluf_(c0[e] * w0[4 * q + e] + c1[e] * w1[4 * q + e] + c2[e] * w2[4 * q + e] + c3[e] * cur[4 * q + e] + cb[e]); }
        const u32x4 xcp = pack8(xc);
        *(u32x4*)(XC + (size_t)row * DM + ch0) = xcp;
        const bf16x8 bc = *(const LAS bf16x8*)(wgl + l15 * 1032 + ch0), bx = *(const LAS bf16x8*)(wgl + 16 * 1032 + l15 * 1032 + ch0);
        acc = __builtin_amdgcn_mfma_f32_16x16x32_bf16(__builtin_bit_cast(bf16x8, xcp), bc, acc, 0, 0, 0);
        acc = __builtin_amdgcn_mfma_f32_16x16x32_bf16(__builtin_bit_cast(bf16x8, x0), bx, acc, 0, 0, 0);
    };
    for (int tile = F.bid; tile < MP / 64; tile += F.G) {
        const int row = tile * 64 + rgp * 16 + l15, seq0 = row & ~(SEQ - 1);
        const bool v1 = row - 1 >= seq0, v2 = row - 2 >= seq0, v3 = row - 3 >= seq0;
        const bf16_t* p0 = PBX + (size_t)row * DM + hh * 512 + 8 * lq;
        const bf16_t* p1 = p0 - (v1 ? DM : 0); const bf16_t* p2 = p0 - (v2 ? 2 * DM : 0); const bf16_t* p3 = p0 - (v3 ? 3 * DM : 0);
        f32x4 acc = (f32x4){0.f, 0.f, 0.f, 0.f};
        u32x4 X0[2][4], X1[2][4], X2[2][4], X3[2][4];
#pragma unroll
        for (int j = 0; j < 4; ++j) { const int off = j * 32; X0[0][j] = *(const u32x4*)(p0 + off); X1[0][j] = *(const u32x4*)(p1 + off); X2[0][j] = *(const u32x4*)(p2 + off); X3[0][j] = *(const u32x4*)(p3 + off); }
#pragma unroll
        for (int bt = 0; bt < 4; ++bt) {
            if (bt < 3) {
#pragma unroll
                for (int j = 0; j < 4; ++j) { const int off = ((bt + 1) * 4 + j) * 32; X0[(bt + 1) & 1][j] = *(const u32x4*)(p0 + off); X1[(bt + 1) & 1][j] = *(const u32x4*)(p1 + off); X2[(bt + 1) & 1][j] = *(const u32x4*)(p2 + off); X3[(bt + 1) & 1][j] = *(const u32x4*)(p3 + off); } }
#pragma unroll
            for (int j = 0; j < 4; ++j) { const u32x4 z = (u32x4){0u, 0u, 0u, 0u}; float w0[8], w1[8], w2[8];
                unpack8(v3 ? X3[bt & 1][j] : z, w0); unpack8(v2 ? X2[bt & 1][j] : z, w1); unpack8(v1 ? X1[bt & 1][j] : z, w2);
                conv_core(row, w0, w1, w2, X0[bt & 1][j], (hh * 16 + bt * 4 + j) * 32 + 8 * lq, acc); }
        }
        __syncthreads();
        if (hh == 1) comb[rgp * 64 + F.lane] = acc;
        __syncthreads();
        if (hh == 0 && l15 < 8) { const f32x4 o = comb[rgp * 64 + F.lane]; const float bj = bif[l15];
#pragma unroll
            for (int r = 0; r < 4; ++r) { const float g = acc[r] + o[r] + bj; const size_t rr = (size_t)(tile * 64 + rgp * 16 + 4 * lq + r);
                if (l15 < 4) GLI[(size_t)l15 * MA + rr] = g; else GLF[(size_t)(l15 - 4) * MA + rr] = logsigmoidf_(g); } }
    }
    for (int si = F.G - 1 - F.bid; si < MS / 16; si += F.G) {
        const int row = MP + si * 16 + l15; const float* st = F.in[5] + (size_t)(row - MP) * 3072;
        f32x4 acc = (f32x4){0.f, 0.f, 0.f, 0.f};
        u32x4 X0[4]; f32x4 S[4][3][2];
#pragma unroll
        for (int cbk = 0; cbk < 4; ++cbk) { const int ch0 = (F.wave * 4 + cbk) * 32 + 8 * lq; X0[cbk] = *(const u32x4*)(PBX + (size_t)row * DM + ch0);
#pragma unroll
            for (int q = 0; q < 2; ++q) { S[cbk][0][q] = *(const f32x4*)(st + ch0 + 4 * q); S[cbk][1][q] = *(const f32x4*)(st + 1024 + ch0 + 4 * q); S[cbk][2][q] = *(const f32x4*)(st + 2048 + ch0 + 4 * q); } }
#pragma unroll
        for (int cbk = 0; cbk < 4; ++cbk) { float w0[8], w1[8], w2[8];
#pragma unroll
            for (int q = 0; q < 2; ++q)
#pragma unroll
                for (int e = 0; e < 4; ++e) { w0[4 * q + e] = S[cbk][0][q][e]; w1[4 * q + e] = S[cbk][1][q][e]; w2[4 * q + e] = S[cbk][2][q][e]; }
            conv_core(row, w0, w1, w2, X0[cbk], (F.wave * 4 + cbk) * 32 + 8 * lq, acc); }
        __syncthreads();
        comb[F.wave * 64 + F.lane] = acc;
        __syncthreads();
        if (F.wave == 0 && l15 < 8) { f32x4 o = comb[F.lane];
#pragma unroll
            for (int ww = 1; ww < 8; ++ww) o = o + comb[ww * 64 + F.lane];
            const float bj = bif[l15];
#pragma unroll
            for (int r = 0; r < 4; ++r) { const float g = o[r] + bj; const size_t rr = (size_t)(MP + si * 16 + 4 * lq + r);
                if (l15 < 4) GLI[(size_t)l15 * MA + rr] = g; else GLF[(size_t)(l15 - 4) * MA + rr] = logsigmoidf_(g); } }
    }
}
__device__ __forceinline__ void p2c_sample_rows(const Ctx& F0) { Ctx F = F0; asm volatile("" : "+v"(F.tid), "+v"(F.lane), "+s"(F.gw));
    unsigned char* ws = F.ws;
    const bf16_t* PBX = (const bf16_t*)(ws + WS_XB2);
    if (F.bid >= 64 && F.bid < 112) { const int i = (F.bid - 64) * 512 + F.tid; const int b = i / 3072, j = (i / 1024) % 3, ch = i & 1023;
        F.out[O_CVP + i] = bf2f(PBX[(size_t)(b * SEQ + SEQ - 3 + j) * DM + ch]); }
    if (F.bid >= 112 && F.bid < 128) { const int i = (F.bid - 112) * 8 + F.wave;
        const int r = MP + i, ch0s = F.lane * 16; const float* st = F.in[5] + (size_t)i * 3 * 1024;
        const bf16_t* PA = (const bf16_t*)(ws + WS_PROJA) + (size_t)r * 3072;
        u32x4 xbw[2], gvw[2], uuw[2], zzw[2]; f32x4 s1[4], s2[4], lg[4], lb[4];
#pragma unroll
        for (int half = 0; half < 2; ++half) { xbw[half] = *(const u32x4*)(PBX + (size_t)r * DM + ch0s + 8 * half); gvw[half] = *(const u32x4*)(PA + 1024 + ch0s + 8 * half);
            uuw[half] = *(const u32x4*)(PA + ch0s + 8 * half); zzw[half] = *(const u32x4*)(PA + 2048 + ch0s + 8 * half); }
#pragma unroll
        for (int q4 = 0; q4 < 4; ++q4) { s1[q4] = *(const f32x4*)(st + 1024 + ch0s + 4 * q4); s2[q4] = *(const f32x4*)(st + 2048 + ch0s + 4 * q4);
            lg[q4] = *(const f32x4*)(F.in[10] + ch0s + 4 * q4); lb[q4] = *(const f32x4*)(F.in[11] + ch0s + 4 * q4); }
        const int h = F.lane >> 3; const float wsp = F.in[12][(size_t)h * 16384], bsp = F.in[13][h * 128];
#pragma unroll
        for (int half = 0; half < 2; ++half) { float xb[8]; unpack8(xbw[half], xb);
#pragma unroll
            for (int q = 0; q < 2; ++q) { const int q4 = half * 2 + q; *(f32x4*)(F.out + O_CVS + (size_t)i * 3072 + ch0s + 4 * q4) = s1[q4]; *(f32x4*)(F.out + O_CVS + (size_t)i * 3072 + 1024 + ch0s + 4 * q4) = s2[q4];
                *(f32x4*)(F.out + O_CVS + (size_t)i * 3072 + 2048 + ch0s + 4 * q4) = (f32x4){xb[4 * q], xb[4 * q + 1], xb[4 * q + 2], xb[4 * q + 3]}; } }
        float gv[16], s = 0.f;
        { float t8[8]; unpack8(gvw[0], t8);
#pragma unroll
          for (int c = 0; c < 8; ++c) gv[c] = t8[c];
          unpack8(gvw[1], t8);
#pragma unroll
          for (int c = 0; c < 8; ++c) gv[8 + c] = t8[c]; }
#pragma unroll
        for (int c = 0; c < 16; ++c) s += gv[c];
        s += __shfl_xor(s, 1); s += __shfl_xor(s, 2); s += __shfl_xor(s, 4);
        const float mu = s * (1.f / 128.f); float q = 0.f;
#pragma unroll
        for (int c = 0; c < 16; ++c) { const float d = gv[c] - mu; q += d * d; }
        q += __shfl_xor(q, 1); q += __shfl_xor(q, 2); q += __shfl_xor(q, 4);
        const float rstd = 1.0f / sqrtf(q * (1.f / 128.f) + EPS);
        float uu[16], zz[16];
        { float t8[8]; unpack8(uuw[0], t8);
#pragma unroll
          for (int c = 0; c < 8; ++c) uu[c] = t8[c];
          unpack8(uuw[1], t8);
#pragma unroll
          for (int c = 0; c < 8; ++c) uu[8 + c] = t8[c];
          unpack8(zzw[0], t8);
#pragma unroll
          for (int c = 0; c < 8; ++c) zz[c] = t8[c];
          unpack8(zzw[1], t8);
#pragma unroll
          for (int c = 0; c < 8; ++c) zz[8 + c] = t8[c]; }
        float ya[16];
#pragma unroll
        for (int q4 = 0; q4 < 4; ++q4) { f32x4 vv;
#pragma unroll
            for (int e = 0; e < 4; ++e) { const int c = 4 * q4 + e; const float vn = (gv[c] - mu) * rstd * lg[q4][e] + lb[q4][e]; vv[e] = vn; ya[c] = uu[c] * (wsp * vn + bsp) * zz[c]; }
            *(f32x4*)(F.out + O_VS + (size_t)i * 1024 + ch0s + 4 * q4) = vv; }
        bf16_t* yrow = (bf16_t*)(ws + WS_Y) + (size_t)r * DMIX + ch0s;
        { float t8[8];
#pragma unroll
          for (int c = 0; c < 8; ++c) t8[c] = ya[c];
          *(u32x4*)(yrow) = pack8(t8);
#pragma unroll
          for (int c = 0; c < 8; ++c) t8[c] = ya[8 + c];
          *(u32x4*)(yrow + 8) = pack8(t8); }
    }
}

__device__ __forceinline__ void mscan_wave(const Ctx& F, int bh) {
    unsigned char* ws = F.ws; const int b = bh >> 2, h = bh & 3, lane = F.lane;
    const float* li = (const float*)(ws + WS_GLI) + (size_t)h * MA + (size_t)b * SEQ + lane * 32;
    const float* lf = (const float*)(ws + WS_GLF) + (size_t)h * MA + (size_t)b * SEQ + lane * 32;
    float lfv[32], liv[32];
#pragma unroll
    for (int j = 0; j < 8; ++j) { const f32x4 a = *(const f32x4*)(lf + 4 * j), c = *(const f32x4*)(li + 4 * j);
#pragma unroll
        for (int e = 0; e < 4; ++e) { lfv[4 * j + e] = a[e]; liv[4 * j + e] = c[e]; } }
    float A = 0.f, Bv = -INFINITY;
#pragma unroll
    for (int i = 0; i < 32; ++i) { const float f = lfv[i], l = liv[i]; Bv = fmaxf(Bv + f, l); A += f; }
    float sA = A, sB = Bv;
#pragma unroll
    for (int o = 1; o < 64; o <<= 1) { const float pA = __shfl_up(sA, o), pB = __shfl_up(sB, o); if (lane >= o) { sB = fmaxf(pB + sA, sB); sA = pA + sA; } }
    float eA = __shfl_up(sA, 1), eB = __shfl_up(sB, 1); if (lane == 0) { eA = 0.f; eB = -INFINITY; }
    const float m_in = fmaxf(0.f + eA, eB);
    float cA = A;
#pragma unroll
    for (int o = 1; o < 8; o <<= 1) { const float p = __shfl_up(cA, o); if ((lane & 7) >= o) cA += p; }
    const float b_in = cA - A;
    const float m_prev = __shfl(m_in, lane & ~7);
    float* DA = (float*)(ws + WS_DA) + (size_t)h * MA + (size_t)b * SEQ + lane * 32; float* DR = (float*)(ws + WS_DR) + (size_t)h * MA + (size_t)b * SEQ + lane * 32;
    float* DG = (float*)(ws + WS_DG) + (size_t)h * MA + (size_t)b * SEQ + lane * 32; float* DEM = (float*)(ws + WS_DEM) + (size_t)h * MA + (size_t)b * SEQ + lane * 32;
    float* DW = (float*)(ws + WS_DW) + (size_t)h * MA + (size_t)b * SEQ + lane * 32;
    float m = m_in, bb = b_in, a_last = 0.f;
#pragma unroll
    for (int j = 0; j < 8; ++j) { f32x4 vA, vR, vG, vE;
#pragma unroll
        for (int e = 0; e < 4; ++e) { const float f = lfv[4 * j + e], l = liv[4 * j + e]; m = fmaxf(m + f, l); bb += f;
            a_last = bb - m; vA[e] = -m_prev; vR[e] = l - bb; vG[e] = __expf(bb + m_prev - m); vE[e] = __expf(-m); }
        *(f32x4*)(DA + 4 * j) = vA; *(f32x4*)(DR + 4 * j) = vR; *(f32x4*)(DG + 4 * j) = vG; *(f32x4*)(DEM + 4 * j) = vE; }
    const float a_end = __shfl(a_last, lane | 7);
    { float bb2 = b_in;
#pragma unroll
      for (int j = 0; j < 8; ++j) { f32x4 vW;
#pragma unroll
          for (int e = 0; e < 4; ++e) { bb2 += lfv[4 * j + e]; vW[e] = __expf(a_end + (liv[4 * j + e] - bb2)); }
          *(f32x4*)(DW + 4 * j) = vW; } }
    if (lane == 63) F.out[O_MP + bh] = m;
}

__device__ __forceinline__ void p9_final(const Ctx& F0) { Ctx F = F0; asm volatile("" : "+v"(F.tid), "+v"(F.lane), "+s"(F.gw));
    unsigned char* ws = F.ws; const bf16_t* GB = (const bf16_t*)(ws + WS_GB); const bf16_t* EB = (const bf16_t*)(ws + WS_EB);
    const float* pleg = F.in[27]; const float* fing = F.in[28];
    f32x4 pg[4], fg[4];
#pragma unroll
    for (int j = 0; j < 4; ++j) { pg[j] = ((const f32x4*)pleg)[F.lane + 64 * j]; fg[j] = ((const f32x4*)fing)[F.lane + 64 * j]; }
    for (int r0 = F.gw * 2; r0 < MP + MS; r0 += F.NGW * 2) {
        f32x4 x[2][4]; u32x2 g[2][4], e[2][4], xb[2][4]; float* xrow[2]; const bf16_t* X1B = (const bf16_t*)(ws + WS_X1B);
#pragma unroll
        for (int q = 0; q < 2; ++q) { const int r = r0 + q; xrow[q] = r < MP ? F.out + O_Y + (size_t)r * DM : F.out + O_YS + (size_t)(r - MP) * DM;
#pragma unroll
            for (int j = 0; j < 4; ++j) { xb[q][j] = __builtin_nontemporal_load((const u32x2*)(X1B + (size_t)r * DM) + F.lane + 64 * j); g[q][j] = __builtin_nontemporal_load((const u32x2*)(GB + (size_t)r * DM) + F.lane + 64 * j); e[q][j] = __builtin_nontemporal_load((const u32x2*)(EB + (size_t)r * DM) + F.lane + 64 * j); } }
#pragma unroll
        for (int q = 0; q < 2; ++q) { float s = 0.f; f32x4 ev[4];
#pragma unroll
            for (int j = 0; j < 4; ++j) { x[q][j] = (f32x4){bf_lo(xb[q][j].x), bf_hi(xb[q][j].x), bf_lo(xb[q][j].y), bf_hi(xb[q][j].y)}; ev[j] = (f32x4){bf_lo(e[q][j].x), bf_hi(e[q][j].x), bf_lo(e[q][j].y), bf_hi(e[q][j].y)}; s += (ev[j][0] * ev[j][0] + ev[j][1] * ev[j][1]) + (ev[j][2] * ev[j][2] + ev[j][3] * ev[j][3]); }
            s = wave_sum(s); const float rse = 1.0f / sqrtf(s * (1.f / DM) + EPS); float s2 = 0.f;
#pragma unroll
            for (int j = 0; j < 4; ++j) { const f32x4 gv = (f32x4){bf_lo(g[q][j].x), bf_hi(g[q][j].x), bf_lo(g[q][j].y), bf_hi(g[q][j].y)};
                x[q][j] = x[q][j] + gv * (ev[j] * rse * pg[j]); s2 += (x[q][j][0] * x[q][j][0] + x[q][j][1] * x[q][j][1]) + (x[q][j][2] * x[q][j][2] + x[q][j][3] * x[q][j][3]); }
            s2 = wave_sum(s2); const float rs2 = 1.0f / sqrtf(s2 * (1.f / DM) + EPS);
#pragma unroll
            for (int j = 0; j < 4; ++j) __builtin_nontemporal_store(x[q][j] * rs2 * fg[j], (f32x4*)xrow[q] + F.lane + 64 * j); }
    }
}
#define MAKE_CTX() extern __shared__ __attribute__((aligned(16))) unsigned char lds_raw[]; \
    Ctx F; F.lds = (LAS unsigned char*)lds_raw; F.tid = threadIdx.x; F.lane = F.tid & 63; F.wave = __builtin_amdgcn_readfirstlane(F.tid >> 6); \
    F.G = gridDim.x; F.bid = blockIdx.x; F.gw = F.bid * 8 + F.wave; F.NGW = F.G * 8; F.in = args.in; F.out = args.out; F.ws = args.ws; unsigned char* ws = args.ws; (void)ws

template <int KIND> struct EpiBf16Act {
    static constexpr bool PERM = false, AFTER_DRAIN = false;
    bf16_t* O; int ldo; const float* bias; float scale;
    __device__ __forceinline__ void operator()(const f32x4 (&acc)[2][2][4][2], const Unit& u, int wr, int wc, int fr, int fq) const {
        const int row0 = u.pm * 256 + wr * 64 + fr, col0 = u.pn * 256 + wc * 32 + 4 * fq;
        f32x4 bv[2][2];
#pragma unroll
        for (int bj = 0; bj < 2; ++bj)
#pragma unroll
            for (int n = 0; n < 2; ++n) bv[bj][n] = bias ? *(const f32x4*)(bias + col0 + bj * 128 + 16 * n) : (f32x4){0.f, 0.f, 0.f, 0.f};
#pragma unroll
        for (int ai = 0; ai < 2; ++ai)
#pragma unroll
            for (int m = 0; m < 4; ++m) { bf16_t* rowp = O + (size_t)(row0 + ai * 128 + m * 16) * ldo + col0;
#pragma unroll
                for (int bj = 0; bj < 2; ++bj)
#pragma unroll
                    for (int n = 0; n < 2; ++n) { f32x4 v = acc[ai][bj][m][n] * scale + bv[bj][n];
                        if (KIND == 3) {
#pragma unroll
                            for (int j = 0; j < 4; ++j) v[j] = sigmoidf_(v[j]); }
                        u32x2 w; w.x = cvt_pk_bf16(v[0], v[1]); w.y = cvt_pk_bf16(v[2], v[3]); *(u32x2*)(rowp + bj * 128 + n * 16) = w; } }
    }
};
struct EpiOutProj {
    static constexpr bool PERM = false, AFTER_DRAIN = false;
    const float* xp; const float* xs; float* out; bf16_t* X1B;
    __device__ __forceinline__ void operator()(const f32x4 (&acc)[2][2][4][2], const Unit& u, int wr, int wc, int fr, int fq) const {
        const int row0 = u.pm * 256 + wr * 64 + fr, col0 = u.pn * 256 + wc * 32 + 4 * fq;
#pragma unroll
        for (int ai = 0; ai < 2; ++ai) { f32x4 xv[4][2][2];
#pragma unroll
            for (int m = 0; m < 4; ++m) { const int row = row0 + ai * 128 + m * 16; const bool real = row < MP + MS; const float* xr = row < MP ? xp + (size_t)row * DM : xs + (size_t)(real ? row - MP : 0) * DM;
#pragma unroll
                for (int bj = 0; bj < 2; ++bj)
#pragma unroll
                    for (int n = 0; n < 2; ++n) xv[m][bj][n] = __builtin_nontemporal_load((const f32x4*)(xr + col0 + bj * 128 + n * 16)); }
#pragma unroll
            for (int m = 0; m < 4; ++m) { const int row = row0 + ai * 128 + m * 16; const bool real = row < MP + MS;
#pragma unroll
                for (int bj = 0; bj < 2; ++bj)
#pragma unroll
                    for (int n = 0; n < 2; ++n) { const int c = col0 + bj * 128 + n * 16; f32x4 v = acc[ai][bj][m][n];
                        if (real) v = v + xv[m][bj][n]; else v = (f32x4){0.f, 0.f, 0.f, 0.f};
                        u32x2 w; w.x = cvt_pk_bf16(v[0], v[1]); w.y = cvt_pk_bf16(v[2], v[3]); *(u32x2*)(X1B + (size_t)row * DM + c) = w; } } }
    }
};

struct EpiInProjNP {
    static constexpr bool PERM = false, AFTER_DRAIN = false;
    bf16_t* PA; bf16_t* PB; const float* rs; bf16_t* XB2;
    __device__ __forceinline__ void operator()(const f32x4 (&acc)[2][2][4][2], const Unit& u, int wr, int wc, int fr, int fq) const {
        const int row0 = u.pm * 256 + wr * 64 + fr, pn = u.pn; const int col0 = wc * 32 + 4 * fq;
        const int kind = pn < 8 ? 0 : ((pn < 12 || pn >= 20) ? 1 : (pn < 16 ? 2 : 3));
        bf16_t* base = pn < 12 ? PA + pn * 256 : (kind == 2 ? XB2 + (pn - 12) * 256 : PB + (pn - 12) * 256); const int pitch = kind == 2 ? DM : 3072;
        float rsv[2][4];
#pragma unroll
        for (int ai = 0; ai < 2; ++ai)
#pragma unroll
            for (int m = 0; m < 4; ++m) rsv[ai][m] = rs[row0 + ai * 128 + m * 16];
#pragma unroll
        for (int ai = 0; ai < 2; ++ai)
#pragma unroll
            for (int m = 0; m < 4; ++m) { const int row = row0 + ai * 128 + m * 16; const float s = rsv[ai][m];
#pragma unroll
                for (int bj = 0; bj < 2; ++bj)
#pragma unroll
                    for (int n = 0; n < 2; ++n) { f32x4 v = acc[ai][bj][m][n] * s;
                        if (kind == 0) { const f32x2 ga = gelu_pk((f32x2){v[0], v[1]}), gb = gelu_pk((f32x2){v[2], v[3]}); v = (f32x4){ga.x, ga.y, gb.x, gb.y}; }
                        else {
#pragma unroll
                        for (int j = 0; j < 4; ++j) { float x = v[j]; if (kind == 1) x = siluf_(x); else if (kind == 3) x = sigmoidf_(x); v[j] = x; } }
                        u32x2 w; w.x = cvt_pk_bf16(v[0], v[1]); w.y = cvt_pk_bf16(v[2], v[3]); *(u32x2*)(base + (size_t)row * pitch + col0 + bj * 128 + n * 16) = w; } }
    }
};
__device__ __forceinline__ void p1_inproj(const Ctx& F) {
    unsigned char* ws = F.ws; Gemm g{DM, DM, DM};
    OrderXcd S{64, 24, 64 * 24, F.G, F.bid, (const char*)(ws + WS_XB), (const char*)(ws + WS_WIN), (size_t)256 * DM * 2, (size_t)256 * DM * 2};
    EpiInProjNP E{(bf16_t*)(ws + WS_PROJA), (bf16_t*)(ws + WS_PROJB), (const float*)(ws + WS_RS), (bf16_t*)(ws + WS_XB2)};
    pg8::gemm_phase<EpiInProjNP, OrderXcd>(F.lds, g, S, E);
}
__device__ __forceinline__ void p7_outproj(const Ctx& F) {
    unsigned char* ws = F.ws; Gemm g{DMIX, DMIX, DMIX};
    OrderPanel4 S{64 * 4, F.G, F.bid, (const char*)(ws + WS_Y), (const char*)(ws + WS_WOUT), (size_t)256 * DMIX * 2, (size_t)256 * DMIX * 2};
    EpiOutProj E{F.in[0], F.in[1], F.out, (bf16_t*)(ws + WS_X1B)};
    pg8::gemm_phase<EpiOutProj, OrderPanel4>(F.lds, g, S, E);
}
__device__ __forceinline__ void p8_ple(const Ctx& F) {
    unsigned char* ws = F.ws;
    { Gemm g{DM, DM, DM}; OrderPanel4 S{NTILE * 4, F.G, F.bid, (const char*)(ws + WS_X1B), (const char*)(ws + WS_WPG), (size_t)256 * DM * 2, (size_t)256 * DM * 2};
      EpiBf16Act<3> E{(bf16_t*)(ws + WS_GB), DM, F.in[25], 1.0f}; pg8::gemm_phase<EpiBf16Act<3>, OrderPanel4>(F.lds, g, S, E); }
    { Gemm g{DPLE, DPLE, DPLE}; OrderProjSkip S{F.G, F.bid, (const char*)(ws + WS_PB), (const char*)(ws + WS_WPP), (size_t)256 * DPLE * 2, (size_t)256 * DPLE * 2};
      EpiBf16Act<0> E{(bf16_t*)(ws + WS_EB), DM, nullptr, 1.0f}; pg8::gemm_phase<EpiBf16Act<0>, OrderProjSkip>(F.lds, g, S, E); }
}
typedef float f32x4_t __attribute__((ext_vector_type(4)));
__device__ __forceinline__ void p2b_spatial_units(const Ctx& F0) { Ctx F = F0; asm volatile("" : "+v"(F.tid), "+v"(F.lane), "+s"(F.gw));
    unsigned char* ws = F.ws;
    const bf16_t* PA = (const bf16_t*)(ws + WS_PROJA); const bf16_t* WSP = (const bf16_t*)(ws + WS_WSP); bf16_t* Y = (bf16_t*)(ws + WS_Y);
    const float* lng = F.in[10]; const float* lnb = F.in[11]; const float* bsp = F.in[13];
    LAS bf16_t* vnT = (LAS bf16_t*)F.lds;
    const int lane = F.lane, w = F.wave, l15 = lane & 15, lq = lane >> 4;
    unsigned wav[8], wbv[8];
    auto load_v = [&](int unit) { const int b = unit >> 7, c = (unit >> 3) & 15, h = unit & 7, r0 = b * SEQ + c * 128;
#pragma unroll
        for (int p = 0; p < 8; ++p) { const int s0 = w * 16 + 2 * p; wav[p] = *(const unsigned*)(PA + (size_t)(r0 + s0) * 3072 + 1024 + h * 128 + 2 * lane); wbv[p] = *(const unsigned*)(PA + (size_t)(r0 + s0 + 1) * 3072 + 1024 + h * 128 + 2 * lane); } };
    if (F.bid < NB * 16 * HA) load_v(F.bid);
    for (int unit = F.bid; unit < NB * 16 * HA; unit += F.G) {
        const int b = unit >> 7, c = (unit >> 3) & 15, h = unit & 7, r0 = b * SEQ + c * 128;
        const float g0 = lng[h * 128 + 2 * lane], g1 = lng[h * 128 + 2 * lane + 1], b0 = lnb[h * 128 + 2 * lane], b1 = lnb[h * 128 + 2 * lane + 1];
        const int t0 = 16 * w, nks = (t0 + 15) / 32 + 1;
        bf16x8 wfr[4];
#pragma unroll
        for (int ks = 0; ks < 4; ++ks) wfr[ks] = *(const bf16x8*)(WSP + ((size_t)h * 128 + t0 + l15) * 128 + ks * 32 + 8 * lq);
        const int t = t0 + l15; const float bt = bsp[h * 128 + t]; const size_t row = (size_t)(r0 + t);
        u32x2 uuv[8], zzv[8];
#pragma unroll
        for (int nb = 0; nb < 8; ++nb) { const int d = nb * 16 + 4 * lq; uuv[nb] = *(const u32x2*)(PA + row * 3072 + h * 128 + d); zzv[nb] = *(const u32x2*)(PA + row * 3072 + 2048 + h * 128 + d); }
#pragma unroll
        for (int p = 0; p < 8; ++p) { const int s0 = w * 16 + 2 * p; const unsigned wa = wav[p], wb = wbv[p];
            float a0 = bf_lo(wa), a1 = bf_hi(wa), c0 = bf_lo(wb), c1 = bf_hi(wb);
            const float mua = wave_sum(a0 + a1) * (1.f / 128.f), mub = wave_sum(c0 + c1) * (1.f / 128.f);
            a0 -= mua; a1 -= mua; c0 -= mub; c1 -= mub;
            const float ra = 1.0f / sqrtf(wave_sum(a0 * a0 + a1 * a1) * (1.f / 128.f) + EPS), rb = 1.0f / sqrtf(wave_sum(c0 * c0 + c1 * c1) * (1.f / 128.f) + EPS);
            *(LAS unsigned*)(vnT + (2 * lane) * 136 + s0) = cvt_pk_bf16(a0 * ra * g0 + b0, c0 * rb * g0 + b0);
            *(LAS unsigned*)(vnT + (2 * lane + 1) * 136 + s0) = cvt_pk_bf16(a1 * ra * g1 + b1, c1 * rb * g1 + b1); }
        __syncthreads();
        if (unit + F.G < NB * 16 * HA) load_v(unit + F.G);
        f32x4 acc[8];
#pragma unroll
        for (int nb = 0; nb < 8; ++nb) acc[nb] = (f32x4){0.f, 0.f, 0.f, 0.f};
#pragma unroll
        for (int ks = 0; ks < 4; ++ks) { if (ks < nks) { const int k0 = ks * 32;
#pragma unroll
            for (int nb = 0; nb < 8; ++nb) { const bf16x8 vf = *(const LAS bf16x8*)(vnT + (nb * 16 + l15) * 136 + k0 + 8 * lq);
                acc[nb] = __builtin_amdgcn_mfma_f32_16x16x32_bf16(vf, wfr[ks], acc[nb], 0, 0, 0); } } }
#pragma unroll
        for (int nb = 0; nb < 8; ++nb) { const int d = nb * 16 + 4 * lq; const u32x2 uu = uuv[nb], zz = zzv[nb];
            u32x2 o; o.x = cvt_pk_bf16(bf_lo(uu.x) * (acc[nb][0] + bt) * bf_lo(zz.x), bf_hi(uu.x) * (acc[nb][1] + bt) * bf_hi(zz.x));
            o.y = cvt_pk_bf16(bf_lo(uu.y) * (acc[nb][2] + bt) * bf_lo(zz.y), bf_hi(uu.y) * (acc[nb][3] + bt) * bf_hi(zz.y));
            *(u32x2*)(Y + row * DMIX + h * 128 + d) = o; }
        __syncthreads();
    }
}
__device__ __forceinline__ void p2b_mscan(const Ctx& F) { if (F.bid < 32 && F.wave == 0) mscan_wave(F, F.bid); }

struct OrderQK {
    int G, c; const char* ws;
    __device__ __forceinline__ bool next(int i, Unit& u) const { const int L = i * G + c; if (L >= 512) return false; const char* XC = ws + WS_XB; const char* WQ = ws + WS_WQ; const char* WK = ws + WS_WK;
        const int kind = L >> 8, l = L & 255; u.pm = l >> 2; u.pn = kind; u.aux = l & 3; u.a = XC + (size_t)u.pm * (256 * DM * 2) + (size_t)u.aux * 512; u.b = (kind ? WK : WQ) + (size_t)u.aux * 131072; return true; }
};
struct EpiQK {
    static constexpr bool PERM = false, AFTER_DRAIN = false;
    bf16_t* K; bf16_t* PQ; const float* DG;
    __device__ __forceinline__ void operator()(const f32x4 (&acc)[2][2][4][2], const Unit& u, int wr, int wc, int fr, int fq) const {
        const int h = u.aux, rl0 = wr * 64 + fr, col0 = wc * 32 + 4 * fq; const bool isk = u.pn != 0;
        const int unit = ((u.pm >> 3) * 4 + h) * 8 + (u.pm & 7);
        float gv[2][4];
#pragma unroll
        for (int ai = 0; ai < 2; ++ai)
#pragma unroll
            for (int m = 0; m < 4; ++m) gv[ai][m] = isk ? 0.0625f : DG[(size_t)h * MA + u.pm * 256 + rl0 + ai * 128 + m * 16];
        bf16_t* base = isk ? K + (size_t)u.pm * 256 * 1024 + h * 256 : PQ + (size_t)unit * 256 * 512 + 256; const int ldo = isk ? 1024 : 512;
#pragma unroll
        for (int ai = 0; ai < 2; ++ai)
#pragma unroll
            for (int m = 0; m < 4; ++m) { const int rl = rl0 + ai * 128 + m * 16; const float g = gv[ai][m];
#pragma unroll
                for (int bj = 0; bj < 2; ++bj)
#pragma unroll
                    for (int n = 0; n < 2; ++n) { const int c = col0 + bj * 128 + n * 16; const f32x4 v = acc[ai][bj][m][n] * g;
                        u32x2 w; w.x = cvt_pk_bf16(v[0], v[1]); w.y = cvt_pk_bf16(v[2], v[3]); *(u32x2*)(base + (size_t)rl * ldo + c) = w; }
                asm volatile("" ::: "memory"); }
    }
};
struct OrderS12 {
    int G, c; const char* ws;
    __device__ __forceinline__ bool next(int i, Unit& u) const { const int L = i * G + c; if (L >= 12) return false; const char* XC = ws + WS_XB; const char* XB2 = ws + WS_XB2; const char* WQ = ws + WS_WQ; const char* WK = ws + WS_WK; const char* WV = ws + WS_WV;
        const int kind = L >> 2; u.pm = 64; u.pn = kind; u.aux = L & 3; u.a = (kind == 2 ? XB2 : XC) + (size_t)64 * (256 * DM * 2) + (size_t)u.aux * 512; u.b = (kind == 0 ? WQ : kind == 1 ? WK : WV) + (size_t)u.aux * 131072; return true; }
};
struct EpiS12 {
    static constexpr bool PERM = false, AFTER_DRAIN = false;
    bf16_t* Q; bf16_t* K; bf16_t* Vs;
    __device__ __forceinline__ void operator()(const f32x4 (&acc)[2][2][4][2], const Unit& u, int wr, int wc, int fr, int fq) const {
        const int h = u.aux, kind = u.pn; bf16_t* O = kind == 0 ? Q + (size_t)MP * 1024 : kind == 1 ? K + (size_t)MP * 1024 : Vs; const float sc = kind == 1 ? 0.0625f : 1.0f;
        const int row0 = wr * 64 + fr, col0 = h * 256 + wc * 32 + 4 * fq;
#pragma unroll
        for (int m = 0; m < 4; ++m) { bf16_t* rowp = O + (size_t)(row0 + m * 16) * 1024 + col0;
#pragma unroll
            for (int bj = 0; bj < 2; ++bj)
#pragma unroll
                for (int n = 0; n < 2; ++n) { const f32x4 v = acc[0][bj][m][n] * sc; u32x2 w; w.x = cvt_pk_bf16(v[0], v[1]); w.y = cvt_pk_bf16(v[2], v[3]); *(u32x2*)(rowp + bj * 128 + n * 16) = w; } }
    }
};
struct OrderVW {
    int G, c; const char* ws;
    __device__ __forceinline__ bool next(int i, Unit& u) const { const int L = i * G + c; if (L >= 512) return false; const char* XC = ws + WS_XB; const char* XB2 = ws + WS_XB2; const char* WK = ws + WS_WK; const char* WV = ws + WS_WV;
        const int kind = L >> 8, l = L & 255, b = l >> 5, h = (l >> 3) & 3, cc = l & 7; u.pm = b * 8 + cc; u.pn = l | (kind << 8); u.aux = h;
        u.a = (kind ? WK : WV) + (size_t)h * 131072; u.b = (kind ? XC : XB2) + (size_t)u.pm * (256 * DM * 2) + (size_t)h * 512; return true; }
};
struct EpiVW {
    static constexpr bool PERM = false, AFTER_DRAIN = false;
    bf16_t* VC; bf16_t* WKT; const float* DW; float* DNP;
    __device__ __forceinline__ void operator()(const f32x4 (&acc)[2][2][4][2], const Unit& u, int wr, int wc, int fr, int fq) const {
        const int h = u.aux, kind = u.pn >> 8, l = u.pn & 255, rl0 = wr * 64 + fr, col0 = wc * 32 + 4 * fq; const int ldo = kind ? 256 : 512; bf16_t* base = (kind ? WKT : VC) + (size_t)l * 256 * ldo;
        f32x4 scq[2][2];
#pragma unroll
        for (int bj = 0; bj < 2; ++bj)
#pragma unroll
            for (int n = 0; n < 2; ++n) scq[bj][n] = kind ? *(const f32x4*)(DW + (size_t)h * MA + u.pm * 256 + col0 + bj * 128 + n * 16) * 0.0625f : (f32x4){1.f, 1.f, 1.f, 1.f};
#pragma unroll
        for (int ai = 0; ai < 2; ++ai)
#pragma unroll
            for (int m = 0; m < 4; ++m) { bf16_t* rowp = base + (size_t)(rl0 + ai * 128 + m * 16) * ldo + col0; float rsum = 0.f;
#pragma unroll
                for (int bj = 0; bj < 2; ++bj)
#pragma unroll
                    for (int n = 0; n < 2; ++n) { const f32x4 v = acc[ai][bj][m][n] * scq[bj][n]; u32x2 w; w.x = cvt_pk_bf16(v[0], v[1]); w.y = cvt_pk_bf16(v[2], v[3]); *(u32x2*)(rowp + bj * 128 + n * 16) = w;
                        rsum += (bf_lo(w.x) + bf_hi(w.x)) + (bf_lo(w.y) + bf_hi(w.y)); }
                if (kind) { rsum += __shfl_xor(rsum, 16); rsum += __shfl_xor(rsum, 32); if (fq == 0) DNP[((size_t)l * 256 + rl0 + ai * 128 + m * 16) * 4 + wc] = rsum; }
                asm volatile("" ::: "memory"); }
    }
};
__device__ __forceinline__ void p3_qkv(const Ctx& F) {
    unsigned char* ws = F.ws;
    { Gemm g{DM, 256, 256}; OrderQK S{F.G, F.bid, (const char*)ws}; EpiQK E{(bf16_t*)(ws + WS_K), (bf16_t*)(ws + WS_PQ), (const float*)(ws + WS_DG)};
      pg8::gemm_phase<EpiQK, OrderQK>(F.lds, g, S, E); }
    { Gemm g{256, DM, 256}; OrderVW S{F.G, F.bid, (const char*)ws}; EpiVW E{(bf16_t*)(ws + WS_VC), (bf16_t*)(ws + WS_WKT), (const float*)(ws + WS_DW), (float*)(ws + WS_DN4)};
      pg8::gemm_phase<EpiVW, OrderVW>(F.lds, g, S, E); }
}

__device__ __forceinline__ void p3_s12(const Ctx& F) {
    unsigned char* ws = F.ws;
    { Gemm g{DM, 256, 256}; OrderS12 S{F.G, (F.bid - 32) & 255, (const char*)ws}; EpiS12 E{(bf16_t*)(ws + WS_Q), (bf16_t*)(ws + WS_K), (bf16_t*)(ws + WS_VS)};
      pg8::gemm_phase<EpiS12, OrderS12>(F.lds, g, S, E); }
}
struct OrderUnitNT {
    int n, G, c; const char* A; size_t astep_pm, astep_h, astep_u; const char* B; size_t bstep_pm, bstep_h, bstep_u;
    __device__ __forceinline__ bool next(int i, Unit& u) const { const int L = i * G + c; if (L >= n) return false;
        const int b = L >> 5, h = (L >> 3) & 3, cc = L & 7; u.pm = b * 8 + cc; u.pn = L; u.aux = h;
        u.a = A + (size_t)u.pm * astep_pm + (size_t)h * astep_h + (size_t)L * astep_u; u.b = B + (size_t)u.pm * bstep_pm + (size_t)h * bstep_h + (size_t)L * bstep_u; return true; }
};
struct EpiScore {
    static constexpr bool PERM = false, AFTER_DRAIN = false;
    bf16_t* PQ; const float* DA; const float* DR; float* DENP;
    __device__ __forceinline__ void operator()(const f32x4 (&acc)[2][2][4][2], const Unit& u, int wr, int wc, int fr, int fq) const {
        const int h = u.aux, rl0 = wr * 64 + fr, col0 = wc * 32 + 4 * fq; const size_t vb = (size_t)h * MA + (size_t)u.pm * 256;
        float atv[2][4]; f32x4 rrv[2][2];
#pragma unroll
        for (int ai = 0; ai < 2; ++ai)
#pragma unroll
            for (int m = 0; m < 4; ++m) atv[ai][m] = DA[vb + rl0 + ai * 128 + m * 16];
#pragma unroll
        for (int bj = 0; bj < 2; ++bj)
#pragma unroll
            for (int n = 0; n < 2; ++n) rrv[bj][n] = *(const f32x4*)(DR + vb + col0 + bj * 128 + n * 16);
#pragma unroll
        for (int ai = 0; ai < 2; ++ai)
#pragma unroll
            for (int m = 0; m < 4; ++m) { int t_ = rl0 + ai * 128 + m * 16; asm volatile("" : "+v"(t_)); const int t = t_; const float at = atv[ai][m]; float rs_ = 0.f; bf16_t* rowp = PQ + ((size_t)u.pn * 256 + t) * 512 + col0;
#pragma unroll
                for (int bj = 0; bj < 2; ++bj)
#pragma unroll
                    for (int n = 0; n < 2; ++n) { const int c = col0 + bj * 128 + n * 16; f32x4 v; const f32x4 rr = rrv[bj][n];
#pragma unroll
                        for (int j = 0; j < 4; ++j) { const float e = fast_exp(fminf(at + rr[j], 60.f)); v[j] = (c + j <= t) ? acc[ai][bj][m][n][j] * e : 0.f; rs_ += v[j]; }
                        u32x2 w; w.x = cvt_pk_bf16(v[0], v[1]); w.y = cvt_pk_bf16(v[2], v[3]); *(u32x2*)(rowp + bj * 128 + n * 16) = w; }
                rs_ += __shfl_xor(rs_, 16); rs_ += __shfl_xor(rs_, 32);
                if (fq == 0) DENP[(vb + t) * 4 + wc] = rs_; asm volatile("" ::: "memory"); }
    }
};
struct EpiF32Unit {
    static constexpr bool PERM = false, AFTER_DRAIN = false;
    bf16_t* O;
    __device__ __forceinline__ void operator()(const f32x4 (&acc)[2][2][4][2], const Unit& u, int wr, int wc, int fr, int fq) const {
        bf16_t* base = O + (size_t)u.pn * 65536 + (size_t)(wr * 64 + fr) * 256 + wc * 32 + 4 * fq;
#pragma unroll
        for (int ai = 0; ai < 2; ++ai)
#pragma unroll
            for (int m = 0; m < 4; ++m)
#pragma unroll
                for (int bj = 0; bj < 2; ++bj)
#pragma unroll
                    for (int n = 0; n < 2; ++n) { const f32x4 v = acc[ai][bj][m][n]; u32x2 w; w.x = cvt_pk_bf16(v[0], v[1]); w.y = cvt_pk_bf16(v[2], v[3]); *(u32x2*)(base + (size_t)(ai * 128 + m * 16) * 256 + bj * 128 + n * 16) = w; }
    }
};
__device__ __forceinline__ void p4_scores(const Ctx& F) {
    unsigned char* ws = F.ws;
    { Gemm g{512, DM, 256}; OrderUnitNT S{NUNIT, F.G, F.bid, (const char*)(ws + WS_PQ) + 512, 0, 0, (size_t)256 * 512 * 2, (const char*)(ws + WS_K), (size_t)256 * DM * 2, 512, 0};
      EpiScore E{(bf16_t*)(ws + WS_PQ), (const float*)(ws + WS_DA), (const float*)(ws + WS_DR), (float*)(ws + WS_DENP)}; pg8::gemm_phase<EpiScore, OrderUnitNT>(F.lds, g, S, E); }
}
__device__ __forceinline__ void p4_dc(const Ctx& F) {
    unsigned char* ws = F.ws;
    { Gemm g{512, 256, 256}; OrderUnitNT S{NUNIT, F.G, F.bid, (const char*)(ws + WS_VC), 0, 0, (size_t)256 * 512 * 2, (const char*)(ws + WS_WKT), 0, 0, (size_t)256 * 256 * 2};
      EpiF32Unit E{(bf16_t*)(F.out + O_Y)}; pg8::gemm_phase<EpiF32Unit, OrderUnitNT>(F.lds, g, S, E); }
}

template <int R> __device__ __forceinline__ void qn_rows(const u32x2 (&qq)[32], const f32x4 nv, int& sres) {
    if constexpr (R < 32) { const float s = wave_sum(bf_lo(qq[R].x) * nv[0] + bf_hi(qq[R].x) * nv[1] + bf_lo(qq[R].y) * nv[2] + bf_hi(qq[R].y) * nv[3]);
        const int sv = __builtin_amdgcn_readfirstlane(__builtin_bit_cast(int, s)); asm volatile("s_nop 3\n\tv_writelane_b32 %0, %1, %2" : "+v"(sres) : "s"(sv), "n"(R));
        qn_rows<R + 1>(qq, nv, sres); }
}
__device__ __forceinline__ void p5_scan_sample(const Ctx& F0) { Ctx F = F0; asm volatile("" : "+v"(F.tid), "+v"(F.lane), "+s"(F.gw));
    unsigned char* ws = F.ws; const float* DG = (const float*)(ws + WS_DG); const bf16_t* DCb = (const bf16_t*)(F.out + O_Y); bf16_t* VC = (bf16_t*)(ws + WS_VC);
    {   u32x4 dw[2][8]; float ge[2][8];
#pragma unroll
        for (int k = 0; k < 2; ++k) { const int idx = F.bid * 512 + F.tid + k * F.G * 512, bh = idx >> 13, q8 = idx & 8191, e = q8 >> 5, d8 = (q8 & 31) * 8, b = bh >> 2, h = bh & 3;
#pragma unroll
            for (int c = 0; c < 8; ++c) { dw[k][c] = __builtin_nontemporal_load((const u32x4*)(DCb + ((size_t)(bh * 8 + c) * 256 + e) * 256 + d8)); ge[k][c] = DG[(size_t)h * MA + b * SEQ + c * 256 + 255]; } }
#pragma unroll
        for (int k = 0; k < 2; ++k) { const int idx = F.bid * 512 + F.tid + k * F.G * 512, bh = idx >> 13, q8 = idx & 8191, e = q8 >> 5, d8 = (q8 & 31) * 8;
            float C[8];
#pragma unroll
            for (int j = 0; j < 8; ++j) C[j] = 0.f;
#pragma unroll
            for (int c = 0; c < 8; ++c) { float dc[8]; unpack8(dw[k][c], dc); *(u32x4*)(VC + ((size_t)(bh * 8 + c) * 256 + e) * 512 + 256 + d8) = pack8(C);
#pragma unroll
                for (int j = 0; j < 8; ++j) C[j] = C[j] * ge[k][c] + dc[j]; }
            __builtin_nontemporal_store((f32x4){C[0], C[1], C[2], C[3]}, (f32x4*)(F.out + O_CP + ((size_t)bh * 256 + e) * 256 + d8));
            __builtin_nontemporal_store((f32x4){C[4], C[5], C[6], C[7]}, (f32x4*)(F.out + O_CP + ((size_t)bh * 256 + e) * 256 + d8 + 4)); }
    }
    LAS float* npv = (LAS float*)F.lds;
    for (int u = F.bid; u < NUNIT; u += F.G) { const int bh = u >> 3, cc = u & 7, b = bh >> 2, h = bh & 3;
        const bf16_t* PQg = (const bf16_t*)(ws + WS_PQ);
        u32x2 qq[32];
        const bf16_t* qbase = PQg + ((size_t)u * 256 + F.wave * 32) * 512 + 256 + 4 * F.lane; asm volatile("" : "+v"(qbase));
#pragma unroll
        for (int r = 0; r < 32; ++r) qq[r] = *(const u32x2*)(qbase + r * 512);
        __syncthreads();
        if (F.tid < 256) { float n = 0.f; const float* DN = (const float*)(ws + WS_DN4);
            for (int j = 0; j < cc; ++j) { const f32x4 dp = *(const f32x4*)(DN + ((size_t)(bh * 8 + j) * 256 + F.tid) * 4); n = DG[(size_t)h * MA + b * SEQ + j * 256 + 255] * n + ((dp[0] + dp[1]) + (dp[2] + dp[3])); }
            npv[F.tid] = n; const f32x4 dl = *(const f32x4*)(DN + ((size_t)u * 256 + F.tid) * 4); if (cc == 7) F.out[O_NP + (size_t)bh * 256 + F.tid] = DG[(size_t)h * MA + b * SEQ + 7 * 256 + 255] * n + ((dl[0] + dl[1]) + (dl[2] + dl[3])); }
        __syncthreads();
        const f32x4 nv = *(const LAS f32x4*)(npv + 4 * F.lane); int sres = 0;
        qn_rows<0>(qq, nv, sres);
        if (F.lane < 32) ((float*)(ws + WS_QN))[(size_t)h * MA + (size_t)b * SEQ + cc * 256 + F.wave * 32 + F.lane] = __builtin_bit_cast(float, sres); }
}
__device__ __forceinline__ void p5s_sample(const Ctx& F0, int jk) { Ctx F = F0; asm volatile("" : "+v"(F.tid), "+v"(F.lane), "+s"(F.gw));
    unsigned char* ws = F.ws;
    LAS float* hs = (LAS float*)F.lds + 512; LAS float* red = (LAS float*)F.lds + 1024;
    for (int job = F.bid + jk * F.G; job < MS * HB; job += 2 * F.G) { const int i = job >> 2, h = job & 3; const size_t row = MP + i;
        const bf16_t* Q = (const bf16_t*)(ws + WS_Q) + row * 1024 + h * 256; const bf16_t* K = (const bf16_t*)(ws + WS_K) + row * 1024 + h * 256; const bf16_t* V = (const bf16_t*)(ws + WS_VS) + (size_t)i * 1024 + h * 256;
        const u32x2 qw = *(const u32x2*)(Q + 4 * F.lane), kw = *(const u32x2*)(K + 4 * F.lane);
        const f32x4 q4 = (f32x4){bf_lo(qw.x), bf_hi(qw.x), bf_lo(qw.y), bf_hi(qw.y)}, k4 = (f32x4){bf_lo(kw.x), bf_hi(kw.x), bf_lo(kw.y), bf_hi(kw.y)};
        const f32x4 n0 = *(const f32x4*)(F.in[3] + ((size_t)i * 4 + h) * 256 + 4 * F.lane);
        const float li = ((const float*)(ws + WS_GLI))[(size_t)h * MA + row], lf = ((const float*)(ws + WS_GLF))[(size_t)h * MA + row], m0 = F.in[4][i * 4 + h];
        const float mn = fmaxf(lf + m0, li), g = __expf(lf + m0 - mn), wi = __expf(li - mn);
        const float qk = wave_sum(q4[0] * k4[0] + q4[1] * k4[1] + q4[2] * k4[2] + q4[3] * k4[3]), nq = wave_sum(n0[0] * q4[0] + n0[1] * q4[1] + n0[2] * q4[2] + n0[3] * q4[3]);
        const float sc = wi * qk, den = sc + g * nq, dinv = 1.0f / fmaxf(fabsf(den), __expf(-mn));
        const float* C0 = F.in[2] + (((size_t)i * 4 + h) * 256 + F.wave * 32) * 256 + 4 * F.lane; float* C1 = F.out + O_CS + (((size_t)i * 4 + h) * 256 + F.wave * 32) * 256 + 4 * F.lane;
        __syncthreads();
#pragma unroll 1
        for (int r8 = 0; r8 < 32; r8 += 8) { f32x4 c[8]; float ve[8], cq[8];
#pragma unroll
            for (int r = 0; r < 8; ++r) { c[r] = __builtin_nontemporal_load((const f32x4*)(C0 + (size_t)(r8 + r) * 256)); ve[r] = bf2f(V[F.wave * 32 + r8 + r]); }
#pragma unroll
            for (int r = 0; r < 8; ++r) { cq[r] = c[r][0] * q4[0] + c[r][1] * q4[1] + c[r][2] * q4[2] + c[r][3] * q4[3]; const float wv = wi * ve[r]; __builtin_nontemporal_store(c[r] * g + k4 * wv, (f32x4*)(C1 + (size_t)(r8 + r) * 256)); }
#pragma unroll
            for (int r = 0; r < 8; ++r) { cq[r] = wave_sum(cq[r]); if (F.lane == 0) hs[F.wave * 32 + r8 + r] = (sc * ve[r] + g * cq[r]) * dinv; } }
        if (F.wave == 0) { *(f32x4*)(F.out + O_NS + ((size_t)i * 4 + h) * 256 + 4 * F.lane) = n0 * g + k4 * wi; if (F.lane == 0) F.out[O_MS + i * 4 + h] = mn; }
        __syncthreads();
        const bf16_t* PB = (const bf16_t*)(ws + WS_PROJB) + row * 3072; const bf16_t* XC = (const bf16_t*)(ws + WS_XB) + row * DM;
        float x = 0.f; const int ch = h * 256 + (F.tid & 255);
        if (F.tid < 256) x = hs[F.tid] * bf2f(PB[1024 + ch]);
        float p = wave_sum(x); if (F.lane == 0) red[F.wave] = p;
        __syncthreads();
        const float mu = (red[0] + red[1] + red[2] + red[3]) * (1.f / 256.f), dx = x - mu;
        __syncthreads();
        p = wave_sum(F.tid < 256 ? dx * dx : 0.f); if (F.lane == 0) red[F.wave] = p;
        __syncthreads();
        const float rstd = 1.0f / sqrtf((red[0] + red[1] + red[2] + red[3]) * (1.f / 256.f) + EPS);
        if (F.tid < 256) ((bf16_t*)(ws + WS_Y))[row * DMIX + 1024 + ch] = f2bf((dx * rstd * F.in[21][ch] + F.in[22][ch] * bf2f(XC[ch])) * bf2f(PB[2048 + ch]));
        __syncthreads();
    }
}
struct EpiHOut {
    static constexpr bool PERM = false, AFTER_DRAIN = true;
    const float* DENP; const float* DG; const float* QN; const float* DEM; const bf16_t* PB; const bf16_t* XC; bf16_t* Y; const float* gng; const float* skip;
    __device__ __forceinline__ void fused(f32x4 (&acc)[2][2][4][2], const Unit& u, int wr, int wc, int fr, int fq, LAS unsigned char* lds, int wid, int lane) const {
        const int h = u.aux, rl0 = wr * 64 + fr, col0 = wc * 32 + 4 * fq; const size_t vb = (size_t)h * MA + (size_t)u.pm * 256;
        LAS float* P1 = (LAS float*)lds; LAS float* P2 = (LAS float*)lds + 1024;
#pragma unroll
        for (int ai = 0; ai < 2; ++ai) { u32x2 ow[4][2][2]; f32x4 dp[4]; float dgq[4], dem[4];
#pragma unroll
            for (int m = 0; m < 4; ++m) { const int t = rl0 + ai * 128 + m * 16; const size_t row = (size_t)u.pm * 256 + t; dp[m] = *(const f32x4*)(DENP + (vb + t) * 4); dgq[m] = QN[vb + t]; dem[m] = DEM[vb + t];
#pragma unroll
                for (int bj = 0; bj < 2; ++bj)
#pragma unroll
                    for (int n = 0; n < 2; ++n) ow[m][bj][n] = *(const u32x2*)(PB + row * 3072 + 1024 + h * 256 + col0 + bj * 128 + n * 16); }
#pragma unroll
            for (int m = 0; m < 4; ++m) { const int t = rl0 + ai * 128 + m * 16; const float den = (dp[m][0] + dp[m][1]) + (dp[m][2] + dp[m][3]) + dgq[m];
                const float dinv = 1.0f / fmaxf(fabsf(den), dem[m]); float s = 0.f;
#pragma unroll
                for (int bj = 0; bj < 2; ++bj)
#pragma unroll
                    for (int n = 0; n < 2; ++n) { const u32x2 o2 = ow[m][bj][n];
                        f32x4 v = acc[ai][bj][m][n] * dinv; v[0] *= bf_lo(o2.x); v[1] *= bf_hi(o2.x); v[2] *= bf_lo(o2.y); v[3] *= bf_hi(o2.y); acc[ai][bj][m][n] = v; s += (v[0] + v[1]) + (v[2] + v[3]); }
                s += __shfl_xor(s, 16); s += __shfl_xor(s, 32); if (fq == 0) P1[t * 4 + wc] = s; } }
        asm volatile("s_waitcnt lgkmcnt(0)" ::: "memory"); __builtin_amdgcn_s_barrier(); asm volatile("" ::: "memory");
#pragma unroll
        for (int ai = 0; ai < 2; ++ai)
#pragma unroll
            for (int m = 0; m < 4; ++m) { const int t = rl0 + ai * 128 + m * 16; const f32x4 ps = *(const LAS f32x4*)(P1 + t * 4); const float mu = ((ps[0] + ps[1]) + (ps[2] + ps[3])) * (1.f / 256.f); float q = 0.f;
#pragma unroll
                for (int bj = 0; bj < 2; ++bj)
#pragma unroll
                    for (int n = 0; n < 2; ++n) { f32x4 v = acc[ai][bj][m][n] - mu; acc[ai][bj][m][n] = v; q += (v[0] * v[0] + v[1] * v[1]) + (v[2] * v[2] + v[3] * v[3]); }
                q += __shfl_xor(q, 16); q += __shfl_xor(q, 32); if (fq == 0) P2[t * 4 + wc] = q; }
        asm volatile("s_waitcnt lgkmcnt(0)" ::: "memory"); __builtin_amdgcn_s_barrier(); asm volatile("" ::: "memory");
#pragma unroll
        for (int ai = 0; ai < 2; ++ai) { u32x2 xw[4][2][2], zw[4][2][2];
#pragma unroll
            for (int m = 0; m < 4; ++m) { const int t = rl0 + ai * 128 + m * 16; const size_t row = (size_t)u.pm * 256 + t;
#pragma unroll
                for (int bj = 0; bj < 2; ++bj)
#pragma unroll
                    for (int n = 0; n < 2; ++n) { const int c = h * 256 + col0 + bj * 128 + n * 16; xw[m][bj][n] = *(const u32x2*)(XC + row * DM + c); zw[m][bj][n] = *(const u32x2*)(PB + row * 3072 + 2048 + c); } }
#pragma unroll
            for (int m = 0; m < 4; ++m) { const int t = rl0 + ai * 128 + m * 16; const size_t row = (size_t)u.pm * 256 + t; const f32x4 ps = *(const LAS f32x4*)(P2 + t * 4);
                const float rstd = 1.0f / sqrtf(((ps[0] + ps[1]) + (ps[2] + ps[3])) * (1.f / 256.f) + EPS);
#pragma unroll
                for (int bj = 0; bj < 2; ++bj)
#pragma unroll
                    for (int n = 0; n < 2; ++n) { const int c = h * 256 + col0 + bj * 128 + n * 16; const u32x2 x2 = xw[m][bj][n], z2 = zw[m][bj][n];
                        const f32x4 ggv = *(const f32x4*)(gng + c), skv = *(const f32x4*)(skip + c); const f32x4 v = acc[ai][bj][m][n] * rstd * ggv; u32x2 w;
                        w.x = cvt_pk_bf16((v[0] + skv[0] * bf_lo(x2.x)) * bf_lo(z2.x), (v[1] + skv[1] * bf_hi(x2.x)) * bf_hi(z2.x));
                        w.y = cvt_pk_bf16((v[2] + skv[2] * bf_lo(x2.y)) * bf_lo(z2.y), (v[3] + skv[3] * bf_hi(x2.y)) * bf_hi(z2.y));
                        *(u32x2*)(Y + row * DMIX + 1024 + c) = w; } } }
    }
};
__device__ __forceinline__ void p6_hout(const Ctx& F) {
    unsigned char* ws = F.ws; Gemm g{512, 512, 512};
    OrderUnitNT S{NUNIT, F.G, F.bid, (const char*)(ws + WS_PQ), 0, 0, (size_t)256 * 512 * 2, (const char*)(ws + WS_VC), 0, 0, (size_t)256 * 512 * 2};
    EpiHOut E{(const float*)(ws + WS_DENP), (const float*)(ws + WS_DG), (const float*)(ws + WS_QN), (const float*)(ws + WS_DEM), (const bf16_t*)(ws + WS_PROJB), (const bf16_t*)(ws + WS_XB), (bf16_t*)(ws + WS_Y), F.in[21], F.in[22]};
    pg8::gemm_phase<EpiHOut, OrderUnitNT, false, true>(F.lds, g, S, E);
}
template <class PtrF, class Ef>
__device__ __forceinline__ void sample_gemm(const Ctx& F, int nitems, int K, int lda, int ldb, const PtrF& P, const Ef& E) {
    int lane_ = F.lane; asm volatile("" : "+v"(lane_));
    const int l15 = lane_ & 15, lq = lane_ >> 4, w = F.wave;
    for (int item = F.bid; item < nitems; item += F.G) {
        const bf16_t* A; const bf16_t* B; P(item, A, B);
        const bf16_t* ap = A + (size_t)(16 * w + l15) * lda + 8 * lq; const bf16_t* bp = B + (size_t)l15 * ldb + 8 * lq;
        f32x4 acc = (f32x4){0.f, 0.f, 0.f, 0.f};
        for (int k0 = 0; k0 < K; k0 += 256) { bf16x8 a[8], b[8];
#pragma unroll
            for (int j = 0; j < 8; ++j) { a[j] = *(const bf16x8*)(ap + k0 + 32 * j); b[j] = *(const bf16x8*)(bp + k0 + 32 * j); }
#pragma unroll
            for (int j = 0; j < 8; ++j) acc = __builtin_amdgcn_mfma_f32_16x16x32_bf16(a[j], b[j], acc, 0, 0, 0); }
#pragma unroll
        for (int r = 0; r < 4; ++r) E(item, 16 * w + 4 * lq + r, l15, acc[r]);
    }
}
__device__ __forceinline__ void sample_inproj(const Ctx& F) {
    unsigned char* ws = F.ws; const bf16_t* XB = (const bf16_t*)(ws + WS_XB) + (size_t)MP * DM; const bf16_t* W = (const bf16_t*)(ws + WS_WIN);
    bf16_t* PA = (bf16_t*)(ws + WS_PROJA) + (size_t)MP * 3072; bf16_t* PB = (bf16_t*)(ws + WS_PROJB) + (size_t)MP * 3072; bf16_t* XB2 = (bf16_t*)(ws + WS_XB2) + (size_t)MP * DM; const float* rs = (const float*)(ws + WS_RS) + MP;
    int lane_ = F.lane; asm volatile("" : "+v"(lane_)); const int l15 = lane_ & 15, lq = lane_ >> 4, w = F.wave; LAS f32x4* red = (LAS f32x4*)F.lds;
    for (int item = F.bid; item < 256; item += F.G) { const int rb = item & 1, cb = item >> 1;
        const bf16_t* ap = XB + (size_t)(rb * 64 + l15) * DM + w * 128 + 8 * lq; const bf16_t* bp = W + (size_t)(cb * 48 + l15) * DM + w * 128 + 8 * lq;
        bf16x8 a[4][4], b[4][3]; float rsv[2][4];
#pragma unroll
        for (int j = 0; j < 4; ++j) {
#pragma unroll
            for (int m = 0; m < 4; ++m) a[j][m] = *(const bf16x8*)(ap + (size_t)(16 * m) * DM + 32 * j);
#pragma unroll
            for (int n = 0; n < 3; ++n) b[j][n] = *(const bf16x8*)(bp + (size_t)(16 * n) * DM + 32 * j); }
#pragma unroll
        for (int q = 0; q < 2; ++q) { const int t = w + 8 * q;
#pragma unroll
            for (int r = 0; r < 4; ++r) rsv[q][r] = t < 12 ? rs[rb * 64 + (t / 3) * 16 + 4 * lq + r] : 0.f; }
        f32x4 acc[4][3];
#pragma unroll
        for (int m = 0; m < 4; ++m)
#pragma unroll
            for (int n = 0; n < 3; ++n) acc[m][n] = (f32x4){0.f, 0.f, 0.f, 0.f};
#pragma unroll
        for (int j = 0; j < 4; ++j)
#pragma unroll
            for (int m = 0; m < 4; ++m)
#pragma unroll
                for (int n = 0; n < 3; ++n) acc[m][n] = __builtin_amdgcn_mfma_f32_16x16x32_bf16(a[j][m], b[j][n], acc[m][n], 0, 0, 0);
        __syncthreads();
#pragma unroll
        for (int m = 0; m < 4; ++m)
#pragma unroll
            for (int n = 0; n < 3; ++n) red[(w * 12 + m * 3 + n) * 64 + F.lane] = acc[m][n];
        __syncthreads();
#pragma unroll
        for (int q = 0; q < 2; ++q) { const int t = w + 8 * q;
            if (t < 12) { f32x4 s = red[(0 * 12 + t) * 64 + F.lane];
#pragma unroll
                for (int ww = 1; ww < 8; ++ww) s = s + red[(ww * 12 + t) * 64 + F.lane];
                const int mt = t / 3, nt = t - 3 * mt, col = cb * 48 + nt * 16 + l15, grp = col >> 10;
#pragma unroll
                for (int r = 0; r < 4; ++r) { const int row = rb * 64 + mt * 16 + 4 * lq + r; float v = s[r] * rsv[q][r];
                    if (grp < 2) { const f32x2 g2 = gelu_pk((f32x2){v, v}); v = g2.x; } else if (grp == 2 || grp == 5) v = siluf_(v); else if (grp == 4) v = sigmoidf_(v);
                    bf16_t* dst = col < 3072 ? PA + (size_t)row * 3072 + col : (col < 4096 ? XB2 + (size_t)row * DM + (col - 3072) : PB + (size_t)row * 3072 + (col - 3072)); *dst = f2bf(v); } } }
    }
    __syncthreads();
}
__device__ __forceinline__ void sample_qkv(const Ctx& F) {
    unsigned char* ws = F.ws; const bf16_t* XC = (const bf16_t*)(ws + WS_XB) + (size_t)MP * DM; const bf16_t* XBr = (const bf16_t*)(ws + WS_PROJB) + (size_t)MP * 3072;
    const bf16_t* WQ = (const bf16_t*)(ws + WS_WQ); const bf16_t* WK = (const bf16_t*)(ws + WS_WK); const bf16_t* WV = (const bf16_t*)(ws + WS_WV);
    bf16_t* Q = (bf16_t*)(ws + WS_Q) + (size_t)MP * 1024; bf16_t* Kk = (bf16_t*)(ws + WS_K) + (size_t)MP * 1024; bf16_t* Vs = (bf16_t*)(ws + WS_VS);
    sample_gemm(F, 128, 256, DM, 256,
        [=](int item, const bf16_t*& A, const bf16_t*& B) { const int which = item >> 6, it = item & 63, h = it >> 4; A = XC + h * 256; B = (which ? WK : WQ) + (size_t)h * 65536 + (size_t)(it & 15) * 16 * 256; },
        [=](int item, int r, int c, float acc) { const int which = item >> 6, it = item & 63; bf16_t* O = which ? Kk : Q; O[(size_t)r * 1024 + it * 16 + c] = f2bf(which ? acc * 0.0625f : acc); });
    sample_gemm(F, 64, 256, 3072, 256,
        [=](int item, const bf16_t*& A, const bf16_t*& B) { const int h = item >> 4; A = XBr + h * 256; B = WV + (size_t)h * 65536 + (size_t)(item & 15) * 16 * 256; },
        [=](int item, int r, int c, float acc) { Vs[(size_t)r * 1024 + item * 16 + c] = f2bf(acc); });
}
__device__ __forceinline__ void sample_outproj(const Ctx& F) {
    unsigned char* ws = F.ws; const bf16_t* Y = (const bf16_t*)(ws + WS_Y) + (size_t)MP * DMIX; const bf16_t* W = (const bf16_t*)(ws + WS_WOUT);
    const float* xs = F.in[1]; float* out = F.out + O_YS; bf16_t* X1B = (bf16_t*)(ws + WS_X1B) + (size_t)MP * DM;
    sample_gemm(F, DM / 16, DMIX, DMIX, DMIX,
        [=](int item, const bf16_t*& A, const bf16_t*& B) { A = Y; B = W + (size_t)item * 16 * DMIX; },
        [=](int item, int r, int c, float acc) { const int col = item * 16 + c; const float v = xs[(size_t)r * DM + col] + acc; out[(size_t)r * DM + col] = v; X1B[(size_t)r * DM + col] = f2bf(v); });
}
__device__ __forceinline__ void sample_ple(const Ctx& F) {
    unsigned char* ws = F.ws; const bf16_t* X1B = (const bf16_t*)(ws + WS_X1B) + (size_t)MP * DM; const bf16_t* PBs = (const bf16_t*)(ws + WS_PB) + (size_t)MP * DPLE;
    const bf16_t* WG = (const bf16_t*)(ws + WS_WPG); const bf16_t* WP = (const bf16_t*)(ws + WS_WPP); const float* bias = F.in[25];
    bf16_t* GB = (bf16_t*)(ws + WS_GB) + (size_t)MP * DM; bf16_t* EB = (bf16_t*)(ws + WS_EB) + (size_t)MP * DM;
    sample_gemm(F, DM / 16, DM, DM, DM,
        [=](int item, const bf16_t*& A, const bf16_t*& B) { A = X1B; B = WG + (size_t)item * 16 * DM; },
        [=](int item, int r, int c, float acc) { const int col = item * 16 + c; GB[(size_t)r * DM + col] = f2bf(sigmoidf_(acc + bias[col])); });
    sample_gemm(F, DM / 16, DPLE, DPLE, DPLE,
        [=](int item, const bf16_t*& A, const bf16_t*& B) { A = PBs; B = WP + (size_t)item * 16 * DPLE; },
        [=](int item, int r, int c, float acc) { EB[(size_t)r * DM + item * 16 + c] = f2bf(acc); });
}
template <class PtrF, class Ef>
__device__ __forceinline__ void sample_gemm_ks(const Ctx& F, int nitems, int K, int lda, int ldb, const PtrF& P, const Ef& E) {
    int lane_ = F.lane; asm volatile("" : "+v"(lane_)); const int l15 = lane_ & 15, lq = lane_ >> 4, w = F.wave; LAS f32x4* red = (LAS f32x4*)F.lds;
    const int ks = K >> 3;
    for (int item = F.bid; item < nitems; item += F.G) {
        const bf16_t* A; const bf16_t* B; P(item, A, B);
        const bf16_t* ap = A + (size_t)l15 * lda + w * ks + 8 * lq; const bf16_t* bp = B + (size_t)l15 * ldb + w * ks + 8 * lq;
        f32x4 acc[2][4];
#pragma unroll
        for (int m = 0; m < 2; ++m)
#pragma unroll
            for (int n = 0; n < 4; ++n) acc[m][n] = (f32x4){0.f, 0.f, 0.f, 0.f};
        for (int k0 = 0; k0 < ks; k0 += 128) { bf16x8 a[4][2], b[4][4];
#pragma unroll
            for (int j = 0; j < 4; ++j) {
#pragma unroll
                for (int m = 0; m < 2; ++m) a[j][m] = (k0 + 32 * j < ks) ? *(const bf16x8*)(ap + (size_t)(16 * m) * lda + k0 + 32 * j) : (bf16x8){0, 0, 0, 0, 0, 0, 0, 0};
#pragma unroll
                for (int n = 0; n < 4; ++n) b[j][n] = (k0 + 32 * j < ks) ? *(const bf16x8*)(bp + (size_t)(16 * n) * ldb + k0 + 32 * j) : (bf16x8){0, 0, 0, 0, 0, 0, 0, 0}; }
#pragma unroll
            for (int j = 0; j < 4; ++j)
#pragma unroll
                for (int m = 0; m < 2; ++m)
#pragma unroll
                    for (int n = 0; n < 4; ++n) acc[m][n] = __builtin_amdgcn_mfma_f32_16x16x32_bf16(a[j][m], b[j][n], acc[m][n], 0, 0, 0); }
        __syncthreads();
#pragma unroll
        for (int m = 0; m < 2; ++m)
#pragma unroll
            for (int n = 0; n < 4; ++n) red[(w * 8 + m * 4 + n) * 64 + F.lane] = acc[m][n];
        __syncthreads();
        f32x4 s = red[(0 * 8 + w) * 64 + F.lane];
#pragma unroll
        for (int ww = 1; ww < 8; ++ww) s = s + red[(ww * 8 + w) * 64 + F.lane];
        const int mt = w >> 2, nt = w & 3;
#pragma unroll
        for (int r = 0; r < 4; ++r) E(item, 16 * mt + 4 * lq + r, 16 * nt + l15, s[r]);
    }
    __syncthreads();
}
__device__ __forceinline__ void sample_outproj_ks(const Ctx& F) {
    unsigned char* ws = F.ws; const bf16_t* Y = (const bf16_t*)(ws + WS_Y) + (size_t)MP * DMIX; const bf16_t* W = (const bf16_t*)(ws + WS_WOUT);
    const float* xs = F.in[1]; bf16_t* X1B = (bf16_t*)(ws + WS_X1B) + (size_t)MP * DM;
    int lane_ = F.lane; asm volatile("" : "+v"(lane_)); const int l15 = lane_ & 15, lq = lane_ >> 4, w = F.wave; LAS f32x4* red = (LAS f32x4*)F.lds;
    for (int item = F.bid; item < 256; item += F.G) { const int rb = item & 3, cb = item >> 2;
        const bf16_t* ap = Y + (size_t)(rb * 32 + l15) * DMIX + w * 256 + 8 * lq; const bf16_t* bp = W + (size_t)(cb * 16 + l15) * DMIX + w * 256 + 8 * lq;
        bf16x8 a[8][2], b[8]; float xr[4] = {0.f, 0.f, 0.f, 0.f};
#pragma unroll
        for (int j = 0; j < 8; ++j) { a[j][0] = *(const bf16x8*)(ap + 32 * j); a[j][1] = *(const bf16x8*)(ap + (size_t)16 * DMIX + 32 * j); b[j] = *(const bf16x8*)(bp + 32 * j); }
        if (w < 2) {
#pragma unroll
            for (int r = 0; r < 4; ++r) xr[r] = xs[(size_t)(rb * 32 + 16 * w + 4 * lq + r) * DM + cb * 16 + l15]; }
        f32x4 acc[2] = {(f32x4){0.f, 0.f, 0.f, 0.f}, (f32x4){0.f, 0.f, 0.f, 0.f}};
#pragma unroll
        for (int j = 0; j < 8; ++j)
#pragma unroll
            for (int m = 0; m < 2; ++m) acc[m] = __builtin_amdgcn_mfma_f32_16x16x32_bf16(a[j][m], b[j], acc[m], 0, 0, 0);
        __syncthreads();
        red[(w * 2 + 0) * 64 + F.lane] = acc[0]; red[(w * 2 + 1) * 64 + F.lane] = acc[1];
        __syncthreads();
        if (w < 2) { f32x4 s = red[(0 * 2 + w) * 64 + F.lane];
#pragma unroll
            for (int ww = 1; ww < 8; ++ww) s = s + red[(ww * 2 + w) * 64 + F.lane];
#pragma unroll
            for (int r = 0; r < 4; ++r) X1B[(size_t)(rb * 32 + 16 * w + 4 * lq + r) * DM + cb * 16 + l15] = f2bf(xr[r] + s[r]); }
    }
    __syncthreads();
}
__device__ __forceinline__ void sample_ple_ks(const Ctx& F) {
    unsigned char* ws = F.ws; const bf16_t* X1B = (const bf16_t*)(ws + WS_X1B) + (size_t)MP * DM; const bf16_t* PBs = (const bf16_t*)(ws + WS_PB) + (size_t)MP * DPLE;
    const bf16_t* WG = (const bf16_t*)(ws + WS_WPG); const bf16_t* WP = (const bf16_t*)(ws + WS_WPP); const float* bias = F.in[25];
    bf16_t* GB = (bf16_t*)(ws + WS_GB) + (size_t)MP * DM; bf16_t* EB = (bf16_t*)(ws + WS_EB) + (size_t)MP * DM;
    sample_gemm_ks(F, 64, DM, DM, DM,
        [=](int item, const bf16_t*& A, const bf16_t*& B) { A = X1B + (size_t)(item & 3) * 32 * DM; B = WG + (size_t)(item >> 2) * 64 * DM; },
        [=](int item, int r, int c, float acc) { const int row = (item & 3) * 32 + r, col = (item >> 2) * 64 + c; GB[(size_t)row * DM + col] = f2bf(sigmoidf_(acc + bias[col])); });
    sample_gemm_ks(F, 64, DPLE, DPLE, DPLE,
        [=](int item, const bf16_t*& A, const bf16_t*& B) { A = PBs + (size_t)(item & 3) * 32 * DPLE; B = WP + (size_t)(item >> 2) * 64 * DPLE; },
        [=](int item, int r, int c, float acc) { const int row = (item & 3) * 32 + r, col = (item >> 2) * 64 + c; EB[(size_t)row * DM + col] = f2bf(acc); });
}
#define XB_TMO      128
#define XB_XCNT(j)  (256  + 64 * (j))
#define XB_XSUB(j)  (1280 + 64 * (j))
#define XB_XGEN(j)  (2304 + 64 * (j))
#define XB_TOP      3328
#define XB_TOPGEN   3392
#define XCD_BAR_WORDS 3456
#define XB_SPIN_CAP (1u << 18)
__device__ __forceinline__ unsigned xb_ld(unsigned* p)              { return __hip_atomic_load(p, __ATOMIC_RELAXED, __HIP_MEMORY_SCOPE_AGENT); }
__device__ __forceinline__ unsigned xb_add(unsigned* p, unsigned v) { return __hip_atomic_fetch_add(p, v, __ATOMIC_RELAXED, __HIP_MEMORY_SCOPE_AGENT); }
__device__ __forceinline__ unsigned xb_xcc_id() { return (unsigned)__builtin_amdgcn_s_getreg((3 << 11) | 20) & 0xFu; }
#define XB_SPIN(cond, bar) do { unsigned _sp = 0; while (cond) { __builtin_amdgcn_s_sleep(1); \
    if ((++_sp & 255u) == 0u) { if (xb_ld(&(bar)[XB_TMO])) break; if (_sp > XB_SPIN_CAP) { atomicAdd(&(bar)[XB_TMO], 1u); break; } } } } while (0)
struct XcdBarrier { unsigned* bar; unsigned x; volatile LAS unsigned* st; };
__device__ __forceinline__ XcdBarrier xcd_barrier_post(unsigned* bar, volatile LAS unsigned* st) {
    XcdBarrier b; b.bar = bar; b.x = xb_xcc_id(); b.st = st;
    if (threadIdx.x == 0) (void)xb_add(&bar[XB_XCNT(b.x)], 1u);
    return b;
}
__device__ __forceinline__ void xcd_barrier_complete(unsigned* bar, unsigned x, unsigned& nloc, unsigned& nx) {
    const unsigned G = gridDim.x * gridDim.y * gridDim.z;
    unsigned sum, cnt, mine, sp = 0u;
    for (;;) {
        sum = 0u; cnt = 0u; mine = 0u;
#pragma unroll
        for (unsigned j = 0; j < 16; ++j) { const unsigned c = xb_ld(&bar[XB_XCNT(j)]); sum += c; cnt += (c > 0u) ? 1u : 0u; mine = (j == x) ? c : mine; }
        if (sum == G) break;
        __builtin_amdgcn_s_sleep(1);
        if ((++sp & 255u) == 0u) { if (xb_ld(&bar[XB_TMO])) break; if (sp > XB_SPIN_CAP) { atomicAdd(&bar[XB_TMO], 1u); break; } }
    }
    nloc = mine > 0u ? mine : 1u; nx = cnt > 0u ? cnt : 1u;
}
__device__ __forceinline__ void xcd_barrier(const XcdBarrier& b) {
    asm volatile("s_waitcnt vmcnt(0)" ::: "memory");
    __syncthreads();
    if (threadIdx.x == 0) {
        unsigned* bar = b.bar;
        __builtin_amdgcn_s_waitcnt(0);
        unsigned nloc = b.st[0], nx = b.st[1];
        if (nloc == 0u) { xcd_barrier_complete(bar, b.x, nloc, nx); b.st[0] = nloc; b.st[1] = nx; }
        const unsigned old = xb_add(&bar[XB_XSUB(b.x)], 1u);
        const unsigned gen = old / nloc;
        if (old + 1u == (gen + 1u) * nloc) {
            __builtin_amdgcn_fence(__ATOMIC_RELEASE, "agent");
            asm volatile("s_waitcnt vmcnt(0)" ::: "memory");
            const unsigned og = xb_add(&bar[XB_TOP], 1u);
            const unsigned tg = og / nx;
            if (og + 1u == (tg + 1u) * nx) xb_add(&bar[XB_TOPGEN], 1u);
            else XB_SPIN(xb_ld(&bar[XB_TOPGEN]) == tg, bar);
            __builtin_amdgcn_fence(__ATOMIC_ACQUIRE, "agent");
            xb_add(&bar[XB_XGEN(b.x)], 1u);
            asm volatile("s_waitcnt vmcnt(0)" ::: "memory");
        } else {
            XB_SPIN(xb_ld(&bar[XB_XGEN(b.x)]) == gen, bar);
            __builtin_amdgcn_fence(__ATOMIC_ACQUIRE, "agent");
            asm volatile("s_waitcnt vmcnt(0)" ::: "memory");
        }
    }
    __syncthreads();
}
__global__ void __launch_bounds__(512, 2) mega(Args args) {
    MAKE_CTX();
    volatile LAS unsigned* MISC = (volatile LAS unsigned*)(F.lds + 131072 + 320);
    if (F.tid < 32) MISC[F.tid] = 0u;
    __syncthreads();
    const XcdBarrier bar = xcd_barrier_post((unsigned*)(ws + WS_CTL), MISC + 8);
#define GRID_SYNC() xcd_barrier(bar)
    p0_prologue(F);      GRID_SYNC();
    sample_inproj(F); p1_inproj(F); GRID_SYNC();
    p2a_conv_gates(F); p2b_spatial_units(F); GRID_SYNC();
    p2b_mscan(F); p3_s12(F); p2c_sample_rows(F); GRID_SYNC();
    p3_qkv(F);           GRID_SYNC();
    if (F.bid & 1) { p5s_sample(F, 0); p4_scores(F); p5s_sample(F, 1); p4_dc(F); } else { p4_scores(F); p5s_sample(F, 0); p4_dc(F); p5s_sample(F, 1); } GRID_SYNC();
    p5_scan_sample(F);   GRID_SYNC();
    p6_hout(F);          GRID_SYNC();
    sample_outproj_ks(F); p7_outproj(F); GRID_SYNC();
    p8_ple(F);           GRID_SYNC();
    p9_final(F);
}

extern "C" void kernel_launch(void* const* d_in, const int* in_sizes, int n_in, void* d_out, int out_size, void* d_ws, size_t ws_size, hipStream_t stream) {
    static int grid = 0;
    if (grid == 0) {
        if (n_in != 29 || (size_t)out_size != O_END || ws_size < WS_END) { fprintf(stderr, "kernel_launch: unexpected shapes (n_in %d out %d ws %zu)\n", n_in, out_size, ws_size); grid = -1; return; }
        int dev = 0, cus = 0, per_cu = 0;
        if (hipGetDevice(&dev) != hipSuccess || hipDeviceGetAttribute(&cus, hipDeviceAttributeMultiprocessorCount, dev) != hipSuccess) { grid = -1; return; }
        if (hipFuncSetAttribute((const void*)mega, hipFuncAttributeMaxDynamicSharedMemorySize, LDS_BYTES) != hipSuccess) { fprintf(stderr, "kernel_launch: hipFuncSetAttribute failed\n"); grid = -1; return; }
        if (hipOccupancyMaxActiveBlocksPerMultiprocessor(&per_cu, (const void*)mega, 512, LDS_BYTES) != hipSuccess || per_cu < 1) { fprintf(stderr, "kernel_launch: occupancy query says %d\n", per_cu); grid = -1; return; }
        (void)hipGetLastError();
        grid = cus;
        if (grid != 256) { fprintf(stderr, "kernel_launch: this kernel is laid out for 256 CUs, got %d\n", grid); grid = -1; return; }
    }
    if (grid < 0) return;
    if (hipMemsetAsync((unsigned char*)d_ws + WS_CTL, 0, 16384, stream) != hipSuccess) { fprintf(stderr, "kernel_launch: memset failed\n"); return; }
    Args a{};
    for (int i = 0; i < 29; ++i) a.in[i] = (const float*)d_in[i];
    a.out = (float*)d_out; a.ws = (unsigned char*)d_ws;
    void* kargs[] = {&a};
    hipError_t e = hipLaunchCooperativeKernel((const void*)mega, dim3(grid), dim3(512), kargs, LDS_BYTES, stream);
    if (e != hipSuccess) fprintf(stderr, "kernel_launch: cooperative launch failed: %s (grid %d)\n", hipGetErrorString(e), grid);
}
```

```cpp
#include <hip/hip_runtime.h>
#include <hip/hip_cooperative_groups.h>
#include <cstdio>
#include <cstdint>
namespace cg = cooperative_groups;

#define LAS __attribute__((address_space(3)))
typedef unsigned short bf16_t;
typedef short bf16x8 __attribute__((ext_vector_type(8)));
typedef float f32x4 __attribute__((ext_vector_type(4)));
typedef float f32x2 __attribute__((ext_vector_type(2)));
typedef unsigned u32x4 __attribute__((ext_vector_type(4)));
typedef unsigned u32x2 __attribute__((ext_vector_type(2)));

constexpr int DM = 1024, SEQ = 2048, NB = 8, MP = NB * SEQ, MS = 128, MA = MP + 256, NTILE = MA / 256;
constexpr int NIN = 6144, WA = 1024, WB = 1024, HA = 8, DHA = 128, HB = 4, DHB = 256, DPLE = 256, DMIX = 2048;
constexpr int LC = 256, NCH = SEQ / LC;
constexpr int NUNIT = NB * HB * NCH;
constexpr float EPS = 1e-6f;

constexpr size_t O_Y = 0, O_YS = 16777216, O_CP = 16908288, O_NP = 19005440, O_MP = 19013632, O_CVP = 19013664, O_CS = 19038240, O_NS = 52592672, O_MS = 52723744, O_CVS = 52724256, O_VS = 53117472, O_END = 53248544;

constexpr size_t MiB = 1u << 20;
constexpr size_t WS_CTL = 0, WS_WIN = 1 * MiB, WS_WQ = 13 * MiB, WS_WK = WS_WQ + MiB / 2, WS_WV = 14 * MiB, WS_WOUT = WS_WV + MiB / 2, WS_WPG = WS_WOUT + 4 * MiB, WS_WPP = WS_WPG + 2 * MiB,
    WS_WSP = 21 * MiB, WS_WG = WS_WSP + MiB / 4, WS_RS = WS_WG + MiB / 4, WS_GLI = 22 * MiB, WS_GLF = WS_GLI + MiB / 2, WS_DA = 23 * MiB, WS_DR = WS_DA + MiB / 2, WS_DG = 24 * MiB, WS_DEM = WS_DG + MiB / 2,
    WS_DW = 25 * MiB, WS_QN = WS_DW + MiB / 2, WS_DENP = 26 * MiB, WS_DN = 27 * MiB, WS_VS = WS_DN + MiB / 2, WS_PB = 28 * MiB, WS_XB = 37 * MiB, WS_PROJA = 70 * MiB, WS_PROJB = 168 * MiB,
    WS_PQ = 266 * MiB, WS_VC = 330 * MiB, WS_Y = 394 * MiB, WS_XB2 = 460 * MiB, WS_DN4 = 493 * MiB, WS_END = 495 * MiB;
constexpr size_t WS_WGB = WS_RS + MiB / 8;
constexpr size_t WS_Q = WS_PROJA, WS_K = WS_Q + 33 * MiB, WS_WKT = WS_K + 33 * MiB;
constexpr size_t WS_X1B = WS_PROJA, WS_GB = WS_X1B + 33 * MiB, WS_EB = WS_GB + 33 * MiB;
static_assert(WS_WKT + 32 * MiB <= WS_PROJB && WS_EB + 33 * MiB <= WS_PQ, "ws map");

__device__ __forceinline__ unsigned cvt_pk_bf16(float lo, float hi) { unsigned r; asm volatile("v_cvt_pk_bf16_f32 %0, %1, %2" : "=v"(r) : "v"(lo), "v"(hi)); return r; }
__device__ __forceinline__ float bf_lo(unsigned w) { return __uint_as_float(w << 16); }
__device__ __forceinline__ float bf_hi(unsigned w) { return __uint_as_float(w & 0xffff0000u); }
__device__ __forceinline__ float bf2f(bf16_t b) { return __uint_as_float(((unsigned)b) << 16); }
__device__ __forceinline__ bf16_t f2bf(float f) { return (bf16_t)(cvt_pk_bf16(f, 0.f) & 0xffffu); }
__device__ __forceinline__ float fast_exp(float x) { return __builtin_amdgcn_exp2f(x * 1.4426950408889634f); }
__device__ __forceinline__ float sigmoidf_(float x) { return __builtin_amdgcn_rcpf(1.0f + fast_exp(-x)); }
__device__ __forceinline__ float siluf_(float x) { return x * sigmoidf_(x); }
__device__ __forceinline__ f32x2 gelu_pk(f32x2 v) {
    const f32x2 av = __builtin_elementwise_abs(v), d = av * 0.2316418882f + 1.0f;
    f32x2 t; t.x = __builtin_amdgcn_rcpf(d.x); t.y = __builtin_amdgcn_rcpf(d.y);
    f32x2 q = t * 0.5307027145f + (-0.7265760135f); q = q * t + 0.7107068705f; q = q * t + (-0.142248368f); q = q * t + 0.127414796f; q = q * t;
    const f32x2 s = (v * v) * (-0.72134752044f);
    f32x2 e; e.x = __builtin_amdgcn_exp2f(s.x); e.y = __builtin_amdgcn_exp2f(s.y);
    const f32x2 m = v * (q * e), r = v - m;
    f32x2 o; o.x = v.x < 0.f ? m.x : r.x; o.y = v.y < 0.f ? m.y : r.y; return o;
}
__device__ __forceinline__ float dpp_add(float v, const int ctrl_sel) {
    const int iv = __builtin_bit_cast(int, v); int r;
    if (ctrl_sel == 0) r = __builtin_amdgcn_update_dpp(0, iv, 0xB1, 0xF, 0xF, true);
    else if (ctrl_sel == 1) r = __builtin_amdgcn_update_dpp(0, iv, 0x4E, 0xF, 0xF, true);
    else if (ctrl_sel == 2) r = __builtin_amdgcn_update_dpp(0, iv, 0x141, 0xF, 0xF, true);
    else r = __builtin_amdgcn_update_dpp(0, iv, 0x140, 0xF, 0xF, true);
    return v + __builtin_bit_cast(float, r);
}
__device__ __forceinline__ float wave_sum(float v) {
    v = dpp_add(v, 0); v = dpp_add(v, 1); v = dpp_add(v, 2); v = dpp_add(v, 3);
    const int iv = __builtin_bit_cast(int, v);
    const float r0 = __builtin_bit_cast(float, __builtin_amdgcn_readlane(iv, 0)), r1 = __builtin_bit_cast(float, __builtin_amdgcn_readlane(iv, 16)),
                r2 = __builtin_bit_cast(float, __builtin_amdgcn_readlane(iv, 32)), r3 = __builtin_bit_cast(float, __builtin_amdgcn_readlane(iv, 48));
    return (r0 + r1) + (r2 + r3);
}
__device__ __forceinline__ u32x4 lane_row_pair(const u32x2 w0, const u32x2 w1) {
    const auto sx = __builtin_amdgcn_permlane16_swap(w0.x, w1.x, false, false), sy = __builtin_amdgcn_permlane16_swap(w0.y, w1.y, false, false);
    u32x4 o; o.x = sx[0]; o.y = sy[0]; o.z = sx[1]; o.w = sy[1]; return o; }
__device__ __forceinline__ int lane_row_col(int fq) { return (fq & 1) ? 16 + 4 * (fq - 1) : 4 * fq; }
#define LDS_WAIT() asm volatile("s_waitcnt lgkmcnt(0)" ::: "memory")

namespace pg8 {
constexpr int BM = 256, BK = 64, HALF = 128, HTB = HALF * BK * 2, STAGE_BYTES = 8 * HTB;
__host__ __device__ __forceinline__ int lds_byte(int r, int c) { const int st = (r >> 4) * 2 + (c >> 5), rr = r & 15, cc = c & 31, ob = rr * 64 + cc * 2; return st * 1024 + (ob ^ (((ob >> 9) & 1) << 5)); }
__host__ __device__ __forceinline__ void stage_rc(int b, int& R, int& C) { const int st = b / 1024, sb = b % 1024, swz = sb ^ (((sb >> 9) & 1) << 5); R = (st >> 1) * 16 + swz / 64; C = (st & 1) * 32 + (swz % 64) / 2; }
__host__ __device__ __forceinline__ int perm32(int rho) { const int n = rho >> 4, i = rho & 15; return 8 * (i >> 2) + 4 * n + (i & 3); }

struct Unit { const char* a; const char* b; int pm, pn, aux; };
struct Gemm { int lda, ldb, K; };

template <class Epi, class Sched, bool ALIGN_EPI = true, bool SP2 = true>
__device__ __forceinline__ void gemm_phase(LAS unsigned char* lds, const Gemm g, const Sched& S, const Epi& E) {
    int tid_ = threadIdx.x; asm volatile("" : "+v"(tid_));
    const int tid = tid_, wid = __builtin_amdgcn_readfirstlane(tid >> 6), lane = tid & 63, wr = wid >> 2, wc = wid & 3, fr = lane & 15, fq = lane >> 4;
    int K_ = g.K; asm volatile("" : "+s"(K_)); const int K = K_, nt = K / BK; (void)K;
    unsigned voffA[2], voffB[2];
#pragma unroll
    for (int i = 0; i < 2; ++i) { int R, C; stage_rc(tid * 16 + i * 8192, R, C); const int Rb = Epi::PERM ? ((R & ~31) + perm32(R & 31)) : R;
        voffA[i] = (unsigned)(R * g.lda + C) * 2u; voffB[i] = (unsigned)(Rb * g.ldb + C) * 2u; }
    const size_t kstep = (size_t)(BK * 2);
    const size_t hstepA = (size_t)HALF * g.lda * 2, hstepB = (size_t)HALF * g.ldb * 2;
    const unsigned ldsw = (unsigned)wid * 1024u;
    const int aoff = lds_byte(wr * 64 + fr, fq * 8), boff = lds_byte(wc * 32 + fr, fq * 8);
#define PG8_SA(b, h) (((b) * 2 + (h)) * HTB)
#define PG8_SB(b, h) ((4 + (b) * 2 + (h)) * HTB)
#define PG8_STAGE(bufoff, gbase, voff) do { _Pragma("unroll") for (int _i = 0; _i < 2; ++_i) \
        __builtin_amdgcn_global_load_lds((const unsigned*)((const char*)(gbase) + (voff)[_i]), (LAS unsigned*)(lds + (bufoff) + ldsw + _i * 8192), 16, 0, 0); } while (0)
#define PG8_LDA(dst, b, h) do { _Pragma("unroll") for (int m = 0; m < 4; ++m) _Pragma("unroll") for (int k = 0; k < 2; ++k) dst[m][k] = *(const LAS bf16x8*)(lds + PG8_SA(b, h) + aoff + m * 2048 + k * 1024); } while (0)
#define PG8_LDB(dst, b, h) do { _Pragma("unroll") for (int n = 0; n < 2; ++n) _Pragma("unroll") for (int k = 0; k < 2; ++k) dst[n][k] = *(const LAS bf16x8*)(lds + PG8_SB(b, h) + boff + n * 2048 + k * 1024); } while (0)
#define PG8_MMA(ai, bj, At, Bt) do { __builtin_amdgcn_s_setprio(1); _Pragma("unroll") for (int m = 0; m < 4; ++m) _Pragma("unroll") for (int n = 0; n < 2; ++n) _Pragma("unroll") for (int k = 0; k < 2; ++k) \
        acc[ai][bj][m][n] = __builtin_amdgcn_mfma_f32_16x16x32_bf16(Bt[n][k], At[m][k], acc[ai][bj][m][n], 0, 0, 0); __builtin_amdgcn_s_setprio(0); } while (0)
#define PG8_WAIT_V(n) asm volatile("s_waitcnt vmcnt(" #n ")" ::: "memory")
#define PG8_WAIT_L(n) asm volatile("s_waitcnt lgkmcnt(" #n ")" ::: "memory")
#define PG8_BAR __builtin_amdgcn_s_barrier()
#define PG8_SCHED __builtin_amdgcn_sched_barrier(0)
    Unit cur, nxt; int ui = 0;
    if (!S.next(0, cur)) return;
    f32x4 acc[2][2][4][2];
#pragma unroll
    for (int a = 0; a < 2; ++a)
#pragma unroll
        for (int b = 0; b < 2; ++b)
#pragma unroll
            for (int m = 0; m < 4; ++m)
#pragma unroll
                for (int n = 0; n < 2; ++n) acc[a][b][m][n] = (f32x4){0.f, 0.f, 0.f, 0.f};
    bf16x8 At[4][2], B0[2][2], B1[2][2];
    const char* cA = cur.a; const char* cB = cur.b;
    if constexpr (SP2) {
        PG8_STAGE(PG8_SB(0, 0), cB, voffB); PG8_STAGE(PG8_SB(0, 1), cB + hstepB, voffB); PG8_STAGE(PG8_SA(0, 0), cA, voffA); PG8_STAGE(PG8_SA(0, 1), cA + hstepA, voffA);
        if (wr == 1) PG8_BAR;
        PG8_WAIT_V(2); PG8_BAR;
        PG8_STAGE(PG8_SB(1, 0), cB + kstep, voffB); PG8_STAGE(PG8_SA(1, 0), cA + kstep, voffA); PG8_STAGE(PG8_SB(1, 1), cB + hstepB + kstep, voffB);
        PG8_WAIT_V(6); PG8_BAR;
    } else {
        PG8_STAGE(PG8_SB(0, 0), cB, voffB); PG8_STAGE(PG8_SA(0, 0), cA, voffA); PG8_STAGE(PG8_SB(0, 1), cB + hstepB, voffB); PG8_STAGE(PG8_SA(0, 1), cA + hstepA, voffA);
        if (wr == 1) PG8_BAR;
        PG8_WAIT_V(4); PG8_BAR;
        PG8_STAGE(PG8_SB(1, 0), cB + kstep, voffB); PG8_STAGE(PG8_SA(1, 0), cA + kstep, voffA); PG8_STAGE(PG8_SB(1, 1), cB + hstepB + kstep, voffB);
        PG8_WAIT_V(6); PG8_BAR;
    }
    for (;;) {
        const bool has_next = S.next(ui + 1, nxt);
        const char* nA = has_next ? nxt.a : cA; const char* nB = has_next ? nxt.b : cB;
#pragma unroll 1
        for (int t = 0; t < nt; t += 2) {
            const bool last = (t == nt - 2);
            const char* a1 = cA + (size_t)(t + 1) * kstep;
            const char* a2 = last ? nA : cA + (size_t)(t + 2) * kstep; const char* b2 = last ? nB : cB + (size_t)(t + 2) * kstep;
            const char* a3 = a2 + kstep; const char* b3 = b2 + kstep;
            if constexpr (SP2) {
            PG8_LDB(B0, 0, 0); PG8_LDB(B1, 0, 1); PG8_SCHED; PG8_LDA(At, 0, 0); PG8_STAGE(PG8_SA(1, 1), a1 + hstepA, voffA);
            PG8_WAIT_V(8); PG8_WAIT_L(0); PG8_BAR; PG8_MMA(0, 0, At, B0); PG8_MMA(0, 1, At, B1); PG8_BAR; PG8_SCHED;
            PG8_LDA(At, 0, 1); PG8_STAGE(PG8_SB(0, 0), b2, voffB); PG8_STAGE(PG8_SB(0, 1), b2 + hstepB, voffB); PG8_STAGE(PG8_SA(0, 0), a2, voffA);
            PG8_WAIT_V(8); PG8_WAIT_L(0); PG8_BAR; PG8_MMA(1, 0, At, B0); PG8_MMA(1, 1, At, B1); PG8_BAR; PG8_SCHED;
            PG8_LDB(B0, 1, 0); PG8_LDB(B1, 1, 1); PG8_SCHED; PG8_LDA(At, 1, 0); PG8_STAGE(PG8_SA(0, 1), a2 + hstepA, voffA);
            PG8_WAIT_V(8); PG8_WAIT_L(0); PG8_BAR; PG8_MMA(0, 0, At, B0); PG8_MMA(0, 1, At, B1); PG8_BAR; PG8_SCHED;
            PG8_LDA(At, 1, 1); PG8_STAGE(PG8_SB(1, 0), b3, voffB); PG8_STAGE(PG8_SB(1, 1), b3 + hstepB, voffB); PG8_STAGE(PG8_SA(1, 0), a3, voffA);
            PG8_WAIT_V(8); PG8_WAIT_L(0); PG8_BAR; PG8_MMA(1, 0, At, B0); PG8_MMA(1, 1, At, B1); PG8_BAR; PG8_SCHED;
            } else {
            PG8_LDB(B0, 0, 0); PG8_SCHED; PG8_LDA(At, 0, 0); PG8_STAGE(PG8_SA(1, 1), a1 + hstepA, voffA);
            PG8_WAIT_L(8); PG8_BAR; PG8_WAIT_L(0); PG8_MMA(0, 0, At, B0); PG8_BAR; PG8_SCHED;
            PG8_LDB(B1, 0, 1); PG8_STAGE(PG8_SB(0, 0), b2, voffB);
            PG8_BAR; PG8_WAIT_L(0); PG8_MMA(0, 1, At, B1); PG8_BAR;
            PG8_LDA(At, 0, 1); PG8_STAGE(PG8_SA(0, 0), a2, voffA);
            PG8_BAR; PG8_WAIT_L(0); PG8_MMA(1, 0, At, B0); PG8_BAR; PG8_SCHED;
            PG8_STAGE(PG8_SB(0, 1), b2 + hstepB, voffB);
            PG8_WAIT_V(6); PG8_BAR; PG8_MMA(1, 1, At, B1); PG8_BAR;
            PG8_LDB(B0, 1, 0); PG8_SCHED; PG8_LDA(At, 1, 0); PG8_STAGE(PG8_SA(0, 1), a2 + hstepA, voffA);
            PG8_WAIT_L(8); PG8_BAR; PG8_WAIT_L(0); PG8_MMA(0, 0, At, B0); PG8_BAR; PG8_SCHED;
            PG8_LDB(B1, 1, 1); PG8_STAGE(PG8_SB(1, 0), b3, voffB);
            PG8_BAR; PG8_WAIT_L(0); PG8_MMA(0, 1, At, B1); PG8_BAR;
            PG8_LDA(At, 1, 1); PG8_STAGE(PG8_SA(1, 0), a3, voffA);
            PG8_BAR; PG8_WAIT_L(0); PG8_MMA(1, 0, At, B0); PG8_BAR; PG8_SCHED;
            PG8_STAGE(PG8_SB(1, 1), b3 + hstepB, voffB);
            PG8_WAIT_V(6); PG8_BAR; PG8_MMA(1, 1, At, B1); PG8_BAR;
            }
        }
        if constexpr (ALIGN_EPI) { if (wr == 0) PG8_BAR; }
        if constexpr (!Epi::AFTER_DRAIN) { E(acc, cur, wr, wc, fr, fq); }
        if (!has_next) break;
#pragma unroll
        for (int a = 0; a < 2; ++a)
#pragma unroll
            for (int b = 0; b < 2; ++b)
#pragma unroll
                for (int m = 0; m < 4; ++m)
#pragma unroll
                    for (int n = 0; n < 2; ++n) acc[a][b][m][n] = (f32x4){0.f, 0.f, 0.f, 0.f};
        cur = nxt; cA = nA; cB = nB; ++ui;
        if constexpr (ALIGN_EPI) { if (wr == 1) PG8_BAR; }
    }
    PG8_WAIT_V(0);
    if constexpr (!ALIGN_EPI) { if (wr == 0) PG8_BAR; }
    PG8_BAR;
    if constexpr (Epi::AFTER_DRAIN) { E.fused(acc, cur, wr, wc, fr, fq, lds, wid, lane); }
#undef PG8_SA
#undef PG8_SB
#undef PG8_STAGE
#undef PG8_LDA
#undef PG8_LDB
#undef PG8_MMA
#undef PG8_WAIT_V
#undef PG8_WAIT_L
#undef PG8_BAR
#undef PG8_SCHED
}
}
using pg8::Unit; using pg8::Gemm;

constexpr int LDS_BYTES = 147456;
struct Args { const float* in[29]; float* out; unsigned char* ws; };

struct Ctx {
    LAS unsigned char* lds; int tid, lane, wave, G, bid, gw, NGW;
    const float* const* in; float* out; unsigned char* ws;
};

struct TDesc { const float* W; bf16_t* WT; const float* ksc; int ldw, ldt, k0, n0; };
constexpr int I_WIN = 16 * 192, I_QKV = 12 * 4 * 8, I_WOUT = 32 * 32, I_WPG = 16 * 32, I_WPP = 4 * 32, I_T = I_WIN + I_QKV + I_WOUT + I_WPG + I_WPP;
__device__ __forceinline__ TDesc p0_decode(const Ctx& F, int r) {
    unsigned char* ws = F.ws; TDesc d; d.ksc = nullptr;
    if (r < I_WIN) { d.W = F.in[9]; d.ldw = NIN; d.WT = (bf16_t*)(ws + WS_WIN); d.ldt = DM; d.ksc = F.in[8]; d.k0 = 64 * (r / 192); d.n0 = 32 * (r % 192); return d; } r -= I_WIN;
    if (r < I_QKV) { const int mat = r / 32, rr = r % 32, which = mat / 4, h = mat % 4;
        d.W = F.in[16 + which] + (size_t)h * 65536; d.WT = (bf16_t*)(ws + (which == 0 ? WS_WQ : which == 1 ? WS_WK : WS_WV)) + (size_t)h * 65536; d.ldw = 256; d.ldt = 256; d.k0 = 64 * (rr / 8); d.n0 = 32 * (rr % 8); return d; } r -= I_QKV;
    if (r < I_WOUT) { d.W = F.in[23]; d.ldw = DM; d.WT = (bf16_t*)(ws + WS_WOUT); d.ldt = DMIX; d.k0 = 64 * (r / 32); d.n0 = 32 * (r % 32); return d; } r -= I_WOUT;
    if (r < I_WPG) { d.W = F.in[24]; d.ldw = DM; d.WT = (bf16_t*)(ws + WS_WPG); d.ldt = DM; d.k0 = 64 * (r / 32); d.n0 = 32 * (r % 32); return d; } r -= I_WPG;
    d.W = F.in[26]; d.ldw = DM; d.WT = (bf16_t*)(ws + WS_WPP); d.ldt = DPLE; d.k0 = 64 * (r / 32); d.n0 = 32 * (r % 32); return d;
}

__device__ __forceinline__ void p0_prologue(const Ctx& F0) { Ctx F = F0; asm volatile("" : "+v"(F.tid), "+v"(F.lane), "+s"(F.gw));
    LAS float* scr = (LAS float*)(F.lds + F.wave * 16384);
    unsigned char* ws = F.ws; const int lane = F.lane;
    {
        float wv[3][32]; f32x4 ks[3][2]; TDesc td[3];
#pragma unroll
        for (int k = 0; k < 3; ++k) { const int it = F.gw + k * F.NGW;
            if (it < I_T) { td[k] = p0_decode(F, it); const int c = lane & 7;
#pragma unroll
                for (int i = 0; i < 32; ++i) { const int kk = 2 * i + (lane >> 5); wv[k][i] = __builtin_nontemporal_load(td[k].W + (size_t)(td[k].k0 + kk) * td[k].ldw + td[k].n0 + (lane & 31)); }
                if (td[k].ksc) { ks[k][0] = *(const f32x4*)(td[k].ksc + td[k].k0 + 8 * c); ks[k][1] = *(const f32x4*)(td[k].ksc + td[k].k0 + 8 * c + 4); }
                else { ks[k][0] = (f32x4){1.f, 1.f, 1.f, 1.f}; ks[k][1] = ks[k][0]; } } }
#pragma unroll
        for (int k = 0; k < 3; ++k) { const int it = F.gw + k * F.NGW;
            if (it < I_T) { const int c = lane & 7;
#pragma unroll
                for (int i = 0; i < 32; ++i) { const int kk = 2 * i + (lane >> 5); scr[kk * 33 + (lane & 31)] = wv[k][i]; }
                LDS_WAIT(); asm volatile("" ::: "memory");
#pragma unroll
                for (int j = 0; j < 4; ++j) { const int n = (lane >> 3) + 8 * j; const LAS float* s = scr + (8 * c) * 33 + n;
                    u32x4 o; o.x = cvt_pk_bf16(s[0 * 33] * ks[k][0][0], s[1 * 33] * ks[k][0][1]); o.y = cvt_pk_bf16(s[2 * 33] * ks[k][0][2], s[3 * 33] * ks[k][0][3]);
                    o.z = cvt_pk_bf16(s[4 * 33] * ks[k][1][0], s[5 * 33] * ks[k][1][1]); o.w = cvt_pk_bf16(s[6 * 33] * ks[k][1][2], s[7 * 33] * ks[k][1][3]);
                    *(u32x4*)(td[k].WT + (size_t)(td[k].n0 + n) * td[k].ldt + td[k].k0 + 8 * c) = o; }
                LDS_WAIT(); asm volatile("" ::: "memory"); } }
    }
    constexpr int I_SP = 1024, I_WG = 1024, I_YPAD = 128;
    for (int r = F.gw; r < I_SP + I_WG + I_YPAD; r += F.NGW) {
        if (r < I_SP) {
            const int t = r & 127; const float* wrow = F.in[12] + (size_t)r * 128; const f32x2 v = ((const f32x2*)wrow)[lane];
            const int s0 = 2 * lane; ((unsigned*)((bf16_t*)(ws + WS_WSP) + (size_t)r * 128))[lane] = cvt_pk_bf16(s0 <= t ? v.x : 0.f, s0 + 1 <= t ? v.y : 0.f);
            continue;
        }
        if (r < I_SP + I_WG) {
            const int i = r - I_SP, h = i >> 8, d = i & 255; const float* wif = F.in[19];
            const f32x4 wq4 = *(const f32x4*)(F.in[16] + ((size_t)h * 256 + d) * 256 + 4 * lane), wk4 = *(const f32x4*)(F.in[17] + ((size_t)h * 256 + d) * 256 + 4 * lane), wv4 = *(const f32x4*)(F.in[18] + ((size_t)h * 256 + d) * 256 + 4 * lane);
            float sx[8], sb[8];
#pragma unroll
            for (int j = 0; j < 8; ++j) { sx[j] = 0.f; sb[j] = 0.f; }
#pragma unroll
            for (int e = 0; e < 4; ++e) { const size_t rq = (size_t)(h * 256 + 4 * lane + e) * 8;
                const f32x4 q0 = *(const f32x4*)(wif + rq), q1 = *(const f32x4*)(wif + rq + 4), k0 = *(const f32x4*)(wif + 8192 + rq), k1 = *(const f32x4*)(wif + 8192 + rq + 4), v0 = *(const f32x4*)(wif + 16384 + rq), v1 = *(const f32x4*)(wif + 16384 + rq + 4);
#pragma unroll
                for (int j = 0; j < 4; ++j) { sx[j] += wq4[e] * q0[j] + wk4[e] * k0[j]; sx[4 + j] += wq4[e] * q1[j] + wk4[e] * k1[j]; sb[j] += wv4[e] * v0[j]; sb[4 + j] += wv4[e] * v1[j]; } }
#pragma unroll
            for (int j = 0; j < 8; ++j) { sx[j] = wave_sum(sx[j]); sb[j] = wave_sum(sb[j]); }
            float s = 0.f;
#pragma unroll
            for (int j = 0; j < 8; ++j) { s = (lane == j) ? sx[j] : s; s = (lane == 8 + j) ? sb[j] : s; }
            if (lane < 16) ((float*)(ws + WS_WG))[(size_t)i * 16 + lane] = s;
            if (lane < 16) { bf16_t* wgb = (bf16_t*)(ws + WS_WGB) + (size_t)(lane >> 3) * 16384 + (size_t)(lane & 7) * 1024 + i; wgb[0] = f2bf(s); wgb[8 * 1024] = 0; }
            continue;
        }
        {
            u32x4* yrow = (u32x4*)((bf16_t*)(ws + WS_Y) + (size_t)(MP + MS + (r - I_SP - I_WG)) * DMIX) + lane;
#pragma unroll
            for (int j = 0; j < 4; ++j) yrow[64 * j] = (u32x4){0u, 0u, 0u, 0u};
        }
    }
    {
        float* rs = (float*)(ws + WS_RS);
        const int r0 = F.gw * 8; const bool smp = F.gw < MS;
        f32x4 v[8][4], vs[4], pv[8], ps;
#pragma unroll
        for (int q = 0; q < 8; ++q) { const float* xrow = F.in[0] + (size_t)(r0 + q) * DM;
#pragma unroll
            for (int j = 0; j < 4; ++j) v[q][j] = __builtin_nontemporal_load((const f32x4*)xrow + lane + 64 * j); }
#pragma unroll
        for (int q = 0; q < 8; ++q) pv[q] = __builtin_nontemporal_load((const f32x4*)(F.in[6] + (size_t)(r0 + q) * DPLE) + lane);
        if (smp) {
#pragma unroll
            for (int j = 0; j < 4; ++j) vs[j] = __builtin_nontemporal_load((const f32x4*)(F.in[1] + (size_t)F.gw * DM) + lane + 64 * j);
            ps = __builtin_nontemporal_load((const f32x4*)(F.in[7] + (size_t)F.gw * DPLE) + lane); }
        auto xrow_out = [&](int r, const f32x4 (&vv)[4]) { float sq = 0.f;
#pragma unroll
            for (int j = 0; j < 4; ++j) sq += (vv[j].x * vv[j].x + vv[j].y * vv[j].y) + (vv[j].z * vv[j].z + vv[j].w * vv[j].w);
            sq = wave_sum(sq); unsigned long long* o8 = (unsigned long long*)((bf16_t*)(ws + WS_XB) + (size_t)r * DM) + lane;
#pragma unroll
            for (int j = 0; j < 4; ++j) o8[64 * j] = (unsigned long long)cvt_pk_bf16(vv[j].x, vv[j].y) | ((unsigned long long)cvt_pk_bf16(vv[j].z, vv[j].w) << 32);
            if (lane == 0) rs[r] = 1.0f / sqrtf(sq * (1.0f / DM) + EPS); };
#pragma unroll
        for (int q = 0; q < 8; ++q) xrow_out(r0 + q, v[q]);
#pragma unroll
        for (int q = 0; q < 8; ++q) ((unsigned long long*)((bf16_t*)(ws + WS_PB) + (size_t)(r0 + q) * DPLE))[lane] = (unsigned long long)cvt_pk_bf16(pv[q].x, pv[q].y) | ((unsigned long long)cvt_pk_bf16(pv[q].z, pv[q].w) << 32);
        if (smp) { xrow_out(MP + F.gw, vs);
            ((unsigned long long*)((bf16_t*)(ws + WS_PB) + (size_t)(MP + F.gw) * DPLE))[lane] = (unsigned long long)cvt_pk_bf16(ps.x, ps.y) | ((unsigned long long)cvt_pk_bf16(ps.z, ps.w) << 32); }
        for (int r = MP + MS + (F.NGW - 1 - F.gw); r < MA; r += F.NGW) { unsigned long long* o8 = (unsigned long long*)((bf16_t*)(ws + WS_XB) + (size_t)r * DM) + lane;
#pragma unroll
            for (int j = 0; j < 4; ++j) o8[64 * j] = 0ull;
            if (lane == 0) rs[r] = 0.f; ((unsigned long long*)((bf16_t*)(ws + WS_PB) + (size_t)r * DPLE))[lane] = 0ull; }
    }
}

struct OrderRowMajor {
    int nM, nN, n, G, c; const char* A; const char* B; size_t astep, bstep;
    __device__ __forceinline__ bool next(int i, Unit& u) const {
        const int L = i * G + c; if (L >= n) return false;
        u.pm = L / nN; u.pn = L % nN; u.aux = 0; u.a = A + (size_t)u.pm * astep; u.b = B + (size_t)u.pn * bstep; return true;
    }
};
struct OrderPanel4 {
    int n, G, c; const char* A; const char* B; size_t astep, bstep;
    __device__ __forceinline__ bool next(int i, Unit& u) const {
        const int L = i * G + c; if (L >= n) return false;
        if (L < 256) { const int x = L & 7, j = L >> 3; u.pm = x * 8 + (j >> 2); u.pn = j & 3; } else { u.pm = 64; u.pn = L - 256; }
        u.aux = 0; u.a = A + (size_t)u.pm * astep; u.b = B + (size_t)u.pn * bstep; return true;
    }
};
struct OrderProjSkip {
    int G, c; const char* A; const char* B; size_t astep, bstep;
    __device__ __forceinline__ bool next(int i, Unit& u) const {
        if (c < 4) return false; const int cp = c - 4; const int L = i == 0 ? cp : (i == 1 && cp < 8 ? 252 + cp : -1); if (L < 0) return false;
        if (L < 256) { const int x = L & 7, j = L >> 3; u.pm = x * 8 + (j >> 2); u.pn = j & 3; } else { u.pm = 64; u.pn = L - 256; }
        u.aux = 0; u.a = A + (size_t)u.pm * astep; u.b = B + (size_t)u.pn * bstep; return true;
    }
};
struct OrderXcd {
    int nM, nN, n, G, c; const char* A; const char* B; size_t astep, bstep;
    __device__ __forceinline__ bool next(int i, Unit& u) const {
        const int L = i * G + c; if (L >= n) return false;
        int wgid = L; { const int q = n / 8, r = n % 8, xcd = wgid % 8, off = wgid / 8; wgid = (xcd < r ? xcd * (q + 1) : r * (q + 1) + (xcd - r) * q) + off; }
        const int nig = 8 * nN, gid = wgid / nig, fm = gid * 8, gsz = (nM - fm) < 8 ? (nM - fm) : 8;
        u.pm = fm + ((wgid % nig) % gsz); u.pn = (wgid % nig) / gsz; u.aux = 0; u.a = A + (size_t)u.pm * astep; u.b = B + (size_t)u.pn * bstep; return true;
    }
};
struct EpiInProj {
    static constexpr bool PERM = true, AFTER_DRAIN = false;
    bf16_t* PA; bf16_t* PB; const float* rs;
    template <int KIND> __device__ __forceinline__ void run(const f32x4 (&acc)[2][2][4][2], bf16_t* base, int row0, int col0) const {
#pragma unroll
        for (int ai = 0; ai < 2; ++ai)
#pragma unroll
            for (int m = 0; m < 4; ++m) { const int row = row0 + ai * 128 + m * 16; const float s = rs[row]; bf16_t* rowp = base + (size_t)row * 3072 + col0;
#pragma unroll
                for (int bj = 0; bj < 2; ++bj) { f32x4 v0 = acc[ai][bj][m][0] * s, v1 = acc[ai][bj][m][1] * s;
                    if (KIND == 0) { f32x2 a = gelu_pk((f32x2){v0[0], v0[1]}), b = gelu_pk((f32x2){v0[2], v0[3]}), c = gelu_pk((f32x2){v1[0], v1[1]}), d = gelu_pk((f32x2){v1[2], v1[3]});
                        v0 = (f32x4){a.x, a.y, b.x, b.y}; v1 = (f32x4){c.x, c.y, d.x, d.y}; }
                    if (KIND == 1) {
#pragma unroll
                        for (int j = 0; j < 4; ++j) { v0[j] = siluf_(v0[j]); v1[j] = siluf_(v1[j]); } }
                    if (KIND == 3) {
#pragma unroll
                        for (int j = 0; j < 4; ++j) { v0[j] = sigmoidf_(v0[j]); v1[j] = sigmoidf_(v1[j]); } }
                    u32x4 w; w.x = cvt_pk_bf16(v0[0], v0[1]); w.y = cvt_pk_bf16(v0[2], v0[3]); w.z = cvt_pk_bf16(v1[0], v1[1]); w.w = cvt_pk_bf16(v1[2], v1[3]);
                    *(u32x4*)(rowp + bj * 128) = w; } }
    }
    __device__ __forceinline__ void operator()(const f32x4 (&acc)[2][2][4][2], const Unit& u, int wr, int wc, int fr, int fq) const {
        const int row0 = u.pm * 256 + wr * 64 + fr, pn = u.pn;
        bf16_t* base = pn < 12 ? PA + pn * 256 : PB + (pn - 12) * 256; const int col0 = wc * 32 + 8 * fq;
        if (pn < 8) run<0>(acc, base, row0, col0);
        else if (pn < 12 || pn >= 20) run<1>(acc, base, row0, col0);
        else if (pn < 16) run<2>(acc, base, row0, col0);
        else run<3>(acc, base, row0, col0);
    }
};

__device__ __forceinline__ float logsigmoidf_(float x) { return fminf(x, 0.f) - log1pf(__expf(-fabsf(x))); }
__device__ __forceinline__ void unpack8(const u32x4 w, float (&f)[8]) { f[0] = bf_lo(w.x); f[1] = bf_hi(w.x); f[2] = bf_lo(w.y); f[3] = bf_hi(w.y); f[4] = bf_lo(w.z); f[5] = bf_hi(w.z); f[6] = bf_lo(w.w); f[7] = bf_hi(w.w); }
__device__ __forceinline__ u32x4 pack8(const float (&f)[8]) { u32x4 w; w.x = cvt_pk_bf16(f[0], f[1]); w.y = cvt_pk_bf16(f[2], f[3]); w.z = cvt_pk_bf16(f[4], f[5]); w.w = cvt_pk_bf16(f[6], f[7]); return w; }

__device__ __forceinline__ void p2a_conv_gates(const Ctx& F0) { Ctx F = F0; asm volatile("" : "+v"(F.tid), "+v"(F.lane), "+s"(F.gw));
    unsigned char* ws = F.ws;
    const bf16_t* PBX = (const bf16_t*)(ws + WS_XB2);
    bf16_t* XC = (bf16_t*)(ws + WS_XB);
    const float* Wg = (const float*)(ws + WS_WG);
    float* GLI = (float*)(ws + WS_GLI); float* GLF = (float*)(ws + WS_GLF);
    const float* convw = F.in[14]; const float* convb = F.in[15]; const float* bif = F.in[20];
    LAS float* cwl = (LAS float*)F.lds; LAS bf16_t* wgl = (LAS bf16_t*)(F.lds + 20480); LAS f32x4* comb = (LAS f32x4*)(F.lds + 20480 + 32 * 2064);
    {
        u32x4 t[11];
#pragma unroll
        for (int j = 0; j < 11; ++j) { const int i = min(F.tid + 512 * j, 5375);
            const u32x4* srcp = i < 1024 ? (const u32x4*)convw + i : (i < 1280 ? (const u32x4*)convb + (i - 1024) : (const u32x4*)(ws + WS_WGB) + (i - 1280));
            t[j] = *srcp; }
#pragma unroll
        for (int j = 0; j < 11; ++j) { const int i = F.tid + 512 * j; if (i < 1280) ((LAS u32x4*)F.lds)[i] = t[j]; else if (i < 5376) { const int p = i - 1280; *(LAS u32x4*)(F.lds + 20480 + (p >> 7) * 2064 + (p & 127) * 16) = t[j]; } }
    }
    __syncthreads();
    const int l15 = F.lane & 15, lq = F.lane >> 4, rgp = F.wave >> 1, hh = F.wave & 1;
    auto conv_core = [&](int row, const float (&w0)[8], const float (&w1)[8], const float (&w2)[8], const u32x4 x0, int ch0, f32x4& acc) {
        float cur[8], xc[8];
        unpack8(x0, cur);
#pragma unroll
        for (int q = 0; q < 2; ++q) { const f32x4 c0 = *(const LAS f32x4*)(cwl + ch0 + 4 * q), c1 = *(const LAS f32x4*)(cwl + 1024 + ch0 + 4 * q), c2 = *(const LAS f32x4*)(cwl + 2048 + ch0 + 4 * q), c3 = *(const LAS f32x4*)(cwl + 3072 + ch0 + 4 * q), cb = *(const LAS f32x4*)(cwl + 4096 + ch0 + 4 * q);
#pragma unroll
            for (int e = 0; e < 4; ++e) xc[4 * q + e] = siluf_(c0[e] * w0[4 * q + e] + c1[e] * w1[4 * q + e] + c2[e] * w2[4 * q + e] + c3[e] * cur[4 * q + e] + cb[e]); }
        const u32x4 xcp = pack8(xc);
        *(u32x4*)(XC + (size_t)row * DM + ch0) = xcp;
        const bf16x8 bc = *(const LAS bf16x8*)(wgl + l15 * 1032 + ch0), bx = *(const LAS bf16x8*)(wgl + 16 * 1032 + l15 * 1032 + ch0);
        acc = __builtin_amdgcn_mfma_f32_16x16x32_bf16(__builtin_bit_cast(bf16x8, xcp), bc, acc, 0, 0, 0);
        acc = __builtin_amdgcn_mfma_f32_16x16x32_bf16(__builtin_bit_cast(bf16x8, x0), bx, acc, 0, 0, 0);
    };
    for (int tile = F.bid; tile < MP / 64; tile += F.G) {
        const int row = tile * 64 + rgp * 16 + l15, seq0 = row & ~(SEQ - 1);
        const bool v1 = row - 1 >= seq0, v2 = row - 2 >= seq0, v3 = row - 3 >= seq0;
        const bf16_t* p0 = PBX + (size_t)row * DM + hh * 512 + 8 * lq;
        const bf16_t* p1 = p0 - (v1 ? DM : 0); const bf16_t* p2 = p0 - (v2 ? 2 * DM : 0); const bf16_t* p3 = p0 - (v3 ? 3 * DM : 0);
        f32x4 acc = (f32x4){0.f, 0.f, 0.f, 0.f};
        u32x4 X0[2][4], X1[2][4], X2[2][4], X3[2][4];
#pragma unroll
        for (int j = 0; j < 4; ++j) { const int off = j * 32; X0[0][j] = *(const u32x4*)(p0 + off); X1[0][j] = *(const u32x4*)(p1 + off); X2[0][j] = *(const u32x4*)(p2 + off); X3[0][j] = *(const u32x4*)(p3 + off); }
#pragma unroll
        for (int bt = 0; bt < 4; ++bt) {
            if (bt < 3) {
#pragma unroll
                for (int j = 0; j < 4; ++j) { const int off = ((bt + 1) * 4 + j) * 32; X0[(bt + 1) & 1][j] = *(const u32x4*)(p0 + off); X1[(bt + 1) & 1][j] = *(const u32x4*)(p1 + off); X2[(bt + 1) & 1][j] = *(const u32x4*)(p2 + off); X3[(bt + 1) & 1][j] = *(const u32x4*)(p3 + off); } }
#pragma unroll
            for (int j = 0; j < 4; ++j) { const u32x4 z = (u32x4){0u, 0u, 0u, 0u}; float w0[8], w1[8], w2[8];
                unpack8(v3 ? X3[bt & 1][j] : z, w0); unpack8(v2 ? X2[bt & 1][j] : z, w1); unpack8(v1 ? X1[bt & 1][j] : z, w2);
                conv_core(row, w0, w1, w2, X0[bt & 1][j], (hh * 16 + bt * 4 + j) * 32 + 8 * lq, acc); }
        }
        __syncthreads();
        if (hh == 1) comb[rgp * 64 + F.lane] = acc;
        __syncthreads();
        if (hh == 0 && l15 < 8) { const f32x4 o = comb[rgp * 64 + F.lane]; const float bj = bif[l15];
#pragma unroll
            for (int r = 0; r < 4; ++r) { const float g = acc[r] + o[r] + bj; const size_t rr = (size_t)(tile * 64 + rgp * 16 + 4 * lq + r);
                if (l15 < 4) GLI[(size_t)l15 * MA + rr] = g; else GLF[(size_t)(l15 - 4) * MA + rr] = logsigmoidf_(g); } }
    }
    for (int si = F.G - 1 - F.bid; si < MS / 16; si += F.G) {
        const int row = MP + si * 16 + l15; const float* st = F.in[5] + (size_t)(row - MP) * 3072;
        f32x4 acc = (f32x4){0.f, 0.f, 0.f, 0.f};
        u32x4 X0[4]; f32x4 S[4][3][2];
#pragma unroll
        for (int cbk = 0; cbk < 4; ++cbk) { const int ch0 = (F.wave * 4 + cbk) * 32 + 8 * lq; X0[cbk] = *(const u32x4*)(PBX + (size_t)row * DM + ch0);
#pragma unroll
            for (int q = 0; q < 2; ++q) { S[cbk][0][q] = *(const f32x4*)(st + ch0 + 4 * q); S[cbk][1][q] = *(const f32x4*)(st + 1024 + ch0 + 4 * q); S[cbk][2][q] = *(const f32x4*)(st + 2048 + ch0 + 4 * q); } }
#pragma unroll
        for (int cbk = 0; cbk < 4; ++cbk) { float w0[8], w1[8], w2[8];
#pragma unroll
            for (int q = 0; q < 2; ++q)
#pragma unroll
                for (int e = 0; e < 4; ++e) { w0[4 * q + e] = S[cbk][0][q][e]; w1[4 * q + e] = S[cbk][1][q][e]; w2[4 * q + e] = S[cbk][2][q][e]; }
            conv_core(row, w0, w1, w2, X0[cbk], (F.wave * 4 + cbk) * 32 + 8 * lq, acc); }
        __syncthreads();
        comb[F.wave * 64 + F.lane] = acc;
        __syncthreads();
        if (F.wave == 0 && l15 < 8) { f32x4 o = comb[F.lane];
#pragma unroll
            for (int ww = 1; ww < 8; ++ww) o = o + comb[ww * 64 + F.lane];
            const float bj = bif[l15];
#pragma unroll
            for (int r = 0; r < 4; ++r) { const float g = o[r] + bj; const size_t rr = (size_t)(MP + si * 16 + 4 * lq + r);
                if (l15 < 4) GLI[(size_t)l15 * MA + rr] = g; else GLF[(size_t)(l15 - 4) * MA + rr] = logsigmoidf_(g); } }
    }
}
__device__ __forceinline__ void p2c_sample_rows(const Ctx& F0) { Ctx F = F0; asm volatile("" : "+v"(F.tid), "+v"(F.lane), "+s"(F.gw));
    unsigned char* ws = F.ws;
    const bf16_t* PBX = (const bf16_t*)(ws + WS_XB2);
    if (F.bid >= 64 && F.bid < 112) { const int i = (F.bid - 64) * 512 + F.tid; const int b = i / 3072, j = (i / 1024) % 3, ch = i & 1023;
        F.out[O_CVP + i] = bf2f(PBX[(size_t)(b * SEQ + SEQ - 3 + j) * DM + ch]); }
    if (F.bid >= 112 && F.bid < 128) { const int i = (F.bid - 112) * 8 + F.wave;
        const int r = MP + i, ch0s = F.lane * 16; const float* st = F.in[5] + (size_t)i * 3 * 1024;
        const bf16_t* PA = (const bf16_t*)(ws + WS_PROJA) + (size_t)r * 3072;
        u32x4 xbw[2], gvw[2], uuw[2], zzw[2]; f32x4 s1[4], s2[4], lg[4], lb[4];
#pragma unroll
        for (int half = 0; half < 2; ++half) { xbw[half] = *(const u32x4*)(PBX + (size_t)r * DM + ch0s + 8 * half); gvw[half] = *(const u32x4*)(PA + 1024 + ch0s + 8 * half);
            uuw[half] = *(const u32x4*)(PA + ch0s + 8 * half); zzw[half] = *(const u32x4*)(PA + 2048 + ch0s + 8 * half); }
#pragma unroll
        for (int q4 = 0; q4 < 4; ++q4) { s1[q4] = *(const f32x4*)(st + 1024 + ch0s + 4 * q4); s2[q4] = *(const f32x4*)(st + 2048 + ch0s + 4 * q4);
            lg[q4] = *(const f32x4*)(F.in[10] + ch0s + 4 * q4); lb[q4] = *(const f32x4*)(F.in[11] + ch0s + 4 * q4); }
        const int h = F.lane >> 3; const float wsp = F.in[12][(size_t)h * 16384], bsp = F.in[13][h * 128];
#pragma unroll
        for (int half = 0; half < 2; ++half) { float xb[8]; unpack8(xbw[half], xb);
#pragma unroll
            for (int q = 0; q < 2; ++q) { const int q4 = half * 2 + q; *(f32x4*)(F.out + O_CVS + (size_t)i * 3072 + ch0s + 4 * q4) = s1[q4]; *(f32x4*)(F.out + O_CVS + (size_t)i * 3072 + 1024 + ch0s + 4 * q4) = s2[q4];
                *(f32x4*)(F.out + O_CVS + (size_t)i * 3072 + 2048 + ch0s + 4 * q4) = (f32x4){xb[4 * q], xb[4 * q + 1], xb[4 * q + 2], xb[4 * q + 3]}; } }
        float gv[16], s = 0.f;
        { float t8[8]; unpack8(gvw[0], t8);
#pragma unroll
          for (int c = 0; c < 8; ++c) gv[c] = t8[c];
          unpack8(gvw[1], t8);
#pragma unroll
          for (int c = 0; c < 8; ++c) gv[8 + c] = t8[c]; }
#pragma unroll
        for (int c = 0; c < 16; ++c) s += gv[c];
        s += __shfl_xor(s, 1); s += __shfl_xor(s, 2); s += __shfl_xor(s, 4);
        const float mu = s * (1.f / 128.f); float q = 0.f;
#pragma unroll
        for (int c = 0; c < 16; ++c) { const float d = gv[c] - mu; q += d * d; }
        q += __shfl_xor(q, 1); q += __shfl_xor(q, 2); q += __shfl_xor(q, 4);
        const float rstd = 1.0f / sqrtf(q * (1.f / 128.f) + EPS);
        float uu[16], zz[16];
        { float t8[8]; unpack8(uuw[0], t8);
#pragma unroll
          for (int c = 0; c < 8; ++c) uu[c] = t8[c];
          unpack8(uuw[1], t8);
#pragma unroll
          for (int c = 0; c < 8; ++c) uu[8 + c] = t8[c];
          unpack8(zzw[0], t8);
#pragma unroll
          for (int c = 0; c < 8; ++c) zz[c] = t8[c];
          unpack8(zzw[1], t8);
#pragma unroll
          for (int c = 0; c < 8; ++c) zz[8 + c] = t8[c]; }
        float ya[16];
#pragma unroll
        for (int q4 = 0; q4 < 4; ++q4) { f32x4 vv;
#pragma unroll
            for (int e = 0; e < 4; ++e) { const int c = 4 * q4 + e; const float vn = (gv[c] - mu) * rstd * lg[q4][e] + lb[q4][e]; vv[e] = vn; ya[c] = uu[c] * (wsp * vn + bsp) * zz[c]; }
            *(f32x4*)(F.out + O_VS + (size_t)i * 1024 + ch0s + 4 * q4) = vv; }
        bf16_t* yrow = (bf16_t*)(ws + WS_Y) + (size_t)r * DMIX + ch0s;
        { float t8[8];
#pragma unroll
          for (int c = 0; c < 8; ++c) t8[c] = ya[c];
          *(u32x4*)(yrow) = pack8(t8);
#pragma unroll
          for (int c = 0; c < 8; ++c) t8[c] = ya[8 + c];
          *(u32x4*)(yrow + 8) = pack8(t8); }
    }
}

__device__ __forceinline__ void mscan_wave(const Ctx& F, int bh) {
    unsigned char* ws = F.ws; const int b = bh >> 2, h = bh & 3, lane = F.lane;
    const float* li = (const float*)(ws + WS_GLI) + (size_t)h * MA + (size_t)b * SEQ + lane * 32;
    const float* lf = (const float*)(ws + WS_GLF) + (size_t)h * MA + (size_t)b * SEQ + lane * 32;
    float lfv[32], liv[32];
#pragma unroll
    for (int j = 0; j < 8; ++j) { const f32x4 a = *(const f32x4*)(lf + 4 * j), c = *(const f32x4*)(li + 4 * j);
#pragma unroll
        for (int e = 0; e < 4; ++e) { lfv[4 * j + e] = a[e]; liv[4 * j + e] = c[e]; } }
    float A = 0.f, Bv = -INFINITY;
#pragma unroll
    for (int i = 0; i < 32; ++i) { const float f = lfv[i], l = liv[i]; Bv = fmaxf(Bv + f, l); A += f; }
    float sA = A, sB = Bv;
#pragma unroll
    for (int o = 1; o < 64; o <<= 1) { const float pA = __shfl_up(sA, o), pB = __shfl_up(sB, o); if (lane >= o) { sB = fmaxf(pB + sA, sB); sA = pA + sA; } }
    float eA = __shfl_up(sA, 1), eB = __shfl_up(sB, 1); if (lane == 0) { eA = 0.f; eB = -INFINITY; }
    const float m_in = fmaxf(0.f + eA, eB);
    float cA = A;
#pragma unroll
    for (int o = 1; o < 8; o <<= 1) { const float p = __shfl_up(cA, o); if ((lane & 7) >= o) cA += p; }
    const float b_in = cA - A;
    const float m_prev = __shfl(m_in, lane & ~7);
    float* DA = (float*)(ws + WS_DA) + (size_t)h * MA + (size_t)b * SEQ + lane * 32; float* DR = (float*)(ws + WS_DR) + (size_t)h * MA + (size_t)b * SEQ + lane * 32;
    float* DG = (float*)(ws + WS_DG) + (size_t)h * MA + (size_t)b * SEQ + lane * 32; float* DEM = (float*)(ws + WS_DEM) + (size_t)h * MA + (size_t)b * SEQ + lane * 32;
    float* DW = (float*)(ws + WS_DW) + (size_t)h * MA + (size_t)b * SEQ + lane * 32;
    float m = m_in, bb = b_in, a_last = 0.f;
#pragma unroll
    for (int j = 0; j < 8; ++j) { f32x4 vA, vR, vG, vE;
#pragma unroll
        for (int e = 0; e < 4; ++e) { const float f = lfv[4 * j + e], l = liv[4 * j + e]; m = fmaxf(m + f, l); bb += f;
            a_last = bb - m; vA[e] = -m_prev; vR[e] = l - bb; vG[e] = __expf(bb + m_prev - m); vE[e] = __expf(-m); }
        *(f32x4*)(DA + 4 * j) = vA; *(f32x4*)(DR + 4 * j) = vR; *(f32x4*)(DG + 4 * j) = vG; *(f32x4*)(DEM + 4 * j) = vE; }
    const float a_end = __shfl(a_last, lane | 7);
    { float bb2 = b_in;
#pragma unroll
      for (int j = 0; j < 8; ++j) { f32x4 vW;
#pragma unroll
          for (int e = 0; e < 4; ++e) { bb2 += lfv[4 * j + e]; vW[e] = __expf(a_end + (liv[4 * j + e] - bb2)); }
          *(f32x4*)(DW + 4 * j) = vW; } }
    if (lane == 63) F.out[O_MP + bh] = m;
}

__device__ __forceinline__ void p9_final(const Ctx& F0) { Ctx F = F0; asm volatile("" : "+v"(F.tid), "+v"(F.lane), "+s"(F.gw));
    unsigned char* ws = F.ws; const bf16_t* GB = (const bf16_t*)(ws + WS_GB); const bf16_t* EB = (const bf16_t*)(ws + WS_EB);
    const float* pleg = F.in[27]; const float* fing = F.in[28];
    f32x4 pg[4], fg[4];
#pragma unroll
    for (int j = 0; j < 4; ++j) { pg[j] = ((const f32x4*)pleg)[F.lane + 64 * j]; fg[j] = ((const f32x4*)fing)[F.lane + 64 * j]; }
    for (int r0 = F.gw * 2; r0 < MP + MS; r0 += F.NGW * 2) {
        f32x4 x[2][4]; u32x2 g[2][4], e[2][4], xb[2][4]; float* xrow[2]; const bf16_t* X1B = (const bf16_t*)(ws + WS_X1B);
#pragma unroll
        for (int q = 0; q < 2; ++q) { const int r = r0 + q; xrow[q] = r < MP ? F.out + O_Y + (size_t)r * DM : F.out + O_YS + (size_t)(r - MP) * DM;
#pragma unroll
            for (int j = 0; j < 4; ++j) { xb[q][j] = __builtin_nontemporal_load((const u32x2*)(X1B + (size_t)r * DM) + F.lane + 64 * j); g[q][j] = __builtin_nontemporal_load((const u32x2*)(GB + (size_t)r * DM) + F.lane + 64 * j); e[q][j] = __builtin_nontemporal_load((const u32x2*)(EB + (size_t)r * DM) + F.lane + 64 * j); } }
#pragma unroll
        for (int q = 0; q < 2; ++q) { float s = 0.f; f32x4 ev[4];
#pragma unroll
            for (int j = 0; j < 4; ++j) { x[q][j] = (f32x4){bf_lo(xb[q][j].x), bf_hi(xb[q][j].x), bf_lo(xb[q][j].y), bf_hi(xb[q][j].y)}; ev[j] = (f32x4){bf_lo(e[q][j].x), bf_hi(e[q][j].x), bf_lo(e[q][j].y), bf_hi(e[q][j].y)}; s += (ev[j][0] * ev[j][0] + ev[j][1] * ev[j][1]) + (ev[j][2] * ev[j][2] + ev[j][3] * ev[j][3]); }
            s = wave_sum(s); const float rse = 1.0f / sqrtf(s * (1.f / DM) + EPS); float s2 = 0.f;
#pragma unroll
            for (int j = 0; j < 4; ++j) { const f32x4 gv = (f32x4){bf_lo(g[q][j].x), bf_hi(g[q][j].x), bf_lo(g[q][j].y), bf_hi(g[q][j].y)};
                x[q][j] = x[q][j] + gv * (ev[j] * rse * pg[j]); s2 += (x[q][j][0] * x[q][j][0] + x[q][j][1] * x[q][j][1]) + (x[q][j][2] * x[q][j][2] + x[q][j][3] * x[q][j][3]); }
            s2 = wave_sum(s2); const float rs2 = 1.0f / sqrtf(s2 * (1.f / DM) + EPS);
#pragma unroll
            for (int j = 0; j < 4; ++j) __builtin_nontemporal_store(x[q][j] * rs2 * fg[j], (f32x4*)xrow[q] + F.lane + 64 * j); }
    }
}
#define MAKE_CTX() extern __shared__ __attribute__((aligned(16))) unsigned char lds_raw[]; \
    Ctx F; F.lds = (LAS unsigned char*)lds_raw; F.tid = threadIdx.x; F.lane = F.tid & 63; F.wave = __builtin_amdgcn_readfirstlane(F.tid >> 6); \
    F.G = gridDim.x; F.bid = blockIdx.x; F.gw = F.bid * 8 + F.wave; F.NGW = F.G * 8; F.in = args.in; F.out = args.out; F.ws = args.ws; unsigned char* ws = args.ws; (void)ws

template <int KIND> struct EpiBf16Act {
    static constexpr bool PERM = false, AFTER_DRAIN = false;
    bf16_t* O; int ldo; const float* bias; float scale;
    __device__ __forceinline__ void operator()(const f32x4 (&acc)[2][2][4][2], const Unit& u, int wr, int wc, int fr, int fq) const {
        const int row0 = u.pm * 256 + wr * 64 + fr, col0 = u.pn * 256 + wc * 32 + 4 * fq;
        f32x4 bv[2][2];
#pragma unroll
        for (int bj = 0; bj < 2; ++bj)
#pragma unroll
            for (int n = 0; n < 2; ++n) bv[bj][n] = bias ? *(const f32x4*)(bias + col0 + bj * 128 + 16 * n) : (f32x4){0.f, 0.f, 0.f, 0.f};
#pragma unroll
        for (int ai = 0; ai < 2; ++ai)
#pragma unroll
            for (int m = 0; m < 4; ++m) { bf16_t* rowp = O + (size_t)(row0 + ai * 128 + m * 16) * ldo + u.pn * 256 + wc * 32 + lane_row_col(fq);
#pragma unroll
                for (int bj = 0; bj < 2; ++bj) { u32x2 wn[2];
#pragma unroll
                    for (int n = 0; n < 2; ++n) { f32x4 v = acc[ai][bj][m][n] * scale + bv[bj][n];
                        if (KIND == 3) {
#pragma unroll
                            for (int j = 0; j < 4; ++j) v[j] = sigmoidf_(v[j]); }
                        wn[n].x = cvt_pk_bf16(v[0], v[1]); wn[n].y = cvt_pk_bf16(v[2], v[3]); }
                    *(u32x4*)(rowp + bj * 128) = lane_row_pair(wn[0], wn[1]); } }
    }
};
struct EpiOutProj {
    static constexpr bool PERM = false, AFTER_DRAIN = false;
    const float* xp; const float* xs; float* out; bf16_t* X1B;
    __device__ __forceinline__ void operator()(const f32x4 (&acc)[2][2][4][2], const Unit& u, int wr, int wc, int fr, int fq) const {
        const int row0 = u.pm * 256 + wr * 64 + fr, col0 = u.pn * 256 + wc * 32 + 4 * fq;
#pragma unroll
        for (int ai = 0; ai < 2; ++ai) { f32x4 xv[4][2][2];
#pragma unroll
            for (int m = 0; m < 4; ++m) { const int row = row0 + ai * 128 + m * 16; const bool real = row < MP + MS; const float* xr = row < MP ? xp + (size_t)row * DM : xs + (size_t)(real ? row - MP : 0) * DM;
#pragma unroll
                for (int bj = 0; bj < 2; ++bj)
#pragma unroll
                    for (int n = 0; n < 2; ++n) xv[m][bj][n] = __builtin_nontemporal_load((const f32x4*)(xr + col0 + bj * 128 + n * 16)); }
#pragma unroll
            for (int m = 0; m < 4; ++m) { const int row = row0 + ai * 128 + m * 16; const bool real = row < MP + MS;
#pragma unroll
                for (int bj = 0; bj < 2; ++bj) { u32x2 wn[2];
#pragma unroll
                    for (int n = 0; n < 2; ++n) { f32x4 v = acc[ai][bj][m][n];
                        if (real) v = v + xv[m][bj][n]; else v = (f32x4){0.f, 0.f, 0.f, 0.f};
                        wn[n].x = cvt_pk_bf16(v[0], v[1]); wn[n].y = cvt_pk_bf16(v[2], v[3]); }
                    *(u32x4*)(X1B + (size_t)row * DM + u.pn * 256 + wc * 32 + lane_row_col(fq) + bj * 128) = lane_row_pair(wn[0], wn[1]); } } }
    }
};

struct EpiInProjNP {
    static constexpr bool PERM = false, AFTER_DRAIN = false;
    bf16_t* PA; bf16_t* PB; const float* rs; bf16_t* XB2;
    __device__ __forceinline__ void operator()(const f32x4 (&acc)[2][2][4][2], const Unit& u, int wr, int wc, int fr, int fq) const {
        const int row0 = u.pm * 256 + wr * 64 + fr, pn = u.pn; const int col0 = wc * 32 + 4 * fq;
        const int kind = pn < 8 ? 0 : ((pn < 12 || pn >= 20) ? 1 : (pn < 16 ? 2 : 3));
        const int cs = lane_row_col(fq);
        bf16_t* base = pn < 12 ? PA + pn * 256 : (kind == 2 ? XB2 + (pn - 12) * 256 : PB + (pn - 12) * 256); const int pitch = kind == 2 ? DM : 3072;
        float rsv[2][4];
#pragma unroll
        for (int ai = 0; ai < 2; ++ai)
#pragma unroll
            for (int m = 0; m < 4; ++m) rsv[ai][m] = rs[row0 + ai * 128 + m * 16];
#pragma unroll
        for (int ai = 0; ai < 2; ++ai)
#pragma unroll
            for (int m = 0; m < 4; ++m) { const int row = row0 + ai * 128 + m * 16; const float s = rsv[ai][m];
#pragma unroll
                for (int bj = 0; bj < 2; ++bj) { u32x2 wn[2];
#pragma unroll
                    for (int n = 0; n < 2; ++n) { f32x4 v = acc[ai][bj][m][n] * s;
                        if (kind == 0) { const f32x2 ga = gelu_pk((f32x2){v[0], v[1]}), gb = gelu_pk((f32x2){v[2], v[3]}); v = (f32x4){ga.x, ga.y, gb.x, gb.y}; }
                        else {
#pragma unroll
                        for (int j = 0; j < 4; ++j) { float x = v[j]; if (kind == 1) x = siluf_(x); else if (kind == 3) x = sigmoidf_(x); v[j] = x; } }
                        wn[n].x = cvt_pk_bf16(v[0], v[1]); wn[n].y = cvt_pk_bf16(v[2], v[3]); }
                    *(u32x4*)(base + (size_t)row * pitch + wc * 32 + cs + bj * 128) = lane_row_pair(wn[0], wn[1]); } }
    }
};
__device__ __forceinline__ void p1_inproj(const Ctx& F) {
    unsigned char* ws = F.ws; Gemm g{DM, DM, DM};
    OrderXcd S{64, 24, 64 * 24, F.G, F.bid, (const char*)(ws + WS_XB), (const char*)(ws + WS_WIN), (size_t)256 * DM * 2, (size_t)256 * DM * 2};
    EpiInProjNP E{(bf16_t*)(ws + WS_PROJA), (bf16_t*)(ws + WS_PROJB), (const float*)(ws + WS_RS), (bf16_t*)(ws + WS_XB2)};
    pg8::gemm_phase<EpiInProjNP, OrderXcd>(F.lds, g, S, E);
}
__device__ __forceinline__ void p7_outproj(const Ctx& F) {
    unsigned char* ws = F.ws; Gemm g{DMIX, DMIX, DMIX};
    OrderPanel4 S{64 * 4, F.G, F.bid, (const char*)(ws + WS_Y), (const char*)(ws + WS_WOUT), (size_t)256 * DMIX * 2, (size_t)256 * DMIX * 2};
    EpiOutProj E{F.in[0], F.in[1], F.out, (bf16_t*)(ws + WS_X1B)};
    pg8::gemm_phase<EpiOutProj, OrderPanel4>(F.lds, g, S, E);
}
__device__ __forceinline__ void p8_ple(const Ctx& F) {
    unsigned char* ws = F.ws;
    { Gemm g{DM, DM, DM}; OrderPanel4 S{NTILE * 4, F.G, F.bid, (const char*)(ws + WS_X1B), (const char*)(ws + WS_WPG), (size_t)256 * DM * 2, (size_t)256 * DM * 2};
      EpiBf16Act<3> E{(bf16_t*)(ws + WS_GB), DM, F.in[25], 1.0f}; pg8::gemm_phase<EpiBf16Act<3>, OrderPanel4>(F.lds, g, S, E); }
    { Gemm g{DPLE, DPLE, DPLE}; OrderProjSkip S{F.G, F.bid, (const char*)(ws + WS_PB), (const char*)(ws + WS_WPP), (size_t)256 * DPLE * 2, (size_t)256 * DPLE * 2};
      EpiBf16Act<0> E{(bf16_t*)(ws + WS_EB), DM, nullptr, 1.0f}; pg8::gemm_phase<EpiBf16Act<0>, OrderProjSkip>(F.lds, g, S, E); }
}
typedef float f32x4_t __attribute__((ext_vector_type(4)));
__device__ __forceinline__ void p2b_spatial_units(const Ctx& F0) { Ctx F = F0; asm volatile("" : "+v"(F.tid), "+v"(F.lane), "+s"(F.gw));
    unsigned char* ws = F.ws;
    const bf16_t* PA = (const bf16_t*)(ws + WS_PROJA); const bf16_t* WSP = (const bf16_t*)(ws + WS_WSP); bf16_t* Y = (bf16_t*)(ws + WS_Y);
    const float* lng = F.in[10]; const float* lnb = F.in[11]; const float* bsp = F.in[13];
    LAS bf16_t* vnT = (LAS bf16_t*)F.lds;
    const int lane = F.lane, w = F.wave, l15 = lane & 15, lq = lane >> 4;
    unsigned wav[8], wbv[8];
    auto load_v = [&](int unit) { const int b = unit >> 7, c = (unit >> 3) & 15, h = unit & 7, r0 = b * SEQ + c * 128;
#pragma unroll
        for (int p = 0; p < 8; ++p) { const int s0 = w * 16 + 2 * p; wav[p] = *(const unsigned*)(PA + (size_t)(r0 + s0) * 3072 + 1024 + h * 128 + 2 * lane); wbv[p] = *(const unsigned*)(PA + (size_t)(r0 + s0 + 1) * 3072 + 1024 + h * 128 + 2 * lane); } };
    if (F.bid < NB * 16 * HA) load_v(F.bid);
    for (int unit = F.bid; unit < NB * 16 * HA; unit += F.G) {
        const int b = unit >> 7, c = (unit >> 3) & 15, h = unit & 7, r0 = b * SEQ + c * 128;
        const float g0 = lng[h * 128 + 2 * lane], g1 = lng[h * 128 + 2 * lane + 1], b0 = lnb[h * 128 + 2 * lane], b1 = lnb[h * 128 + 2 * lane + 1];
        const int t0 = 16 * w, nks = (t0 + 15) / 32 + 1;
        bf16x8 wfr[4];
#pragma unroll
        for (int ks = 0; ks < 4; ++ks) wfr[ks] = *(const bf16x8*)(WSP + ((size_t)h * 128 + t0 + l15) * 128 + ks * 32 + 8 * lq);
        const int t = t0 + l15; const float bt = bsp[h * 128 + t]; const size_t row = (size_t)(r0 + t);
        u32x2 uuv[8], zzv[8];
#pragma unroll
        for (int nb = 0; nb < 8; ++nb) { const int d = nb * 16 + 4 * lq; uuv[nb] = *(const u32x2*)(PA + row * 3072 + h * 128 + d); zzv[nb] = *(const u32x2*)(PA + row * 3072 + 2048 + h * 128 + d); }
#pragma unroll
        for (int p = 0; p < 8; ++p) { const int s0 = w * 16 + 2 * p; const unsigned wa = wav[p], wb = wbv[p];
            float a0 = bf_lo(wa), a1 = bf_hi(wa), c0 = bf_lo(wb), c1 = bf_hi(wb);
            const float mua = wave_sum(a0 + a1) * (1.f / 128.f), mub = wave_sum(c0 + c1) * (1.f / 128.f);
            a0 -= mua; a1 -= mua; c0 -= mub; c1 -= mub;
            const float ra = 1.0f / sqrtf(wave_sum(a0 * a0 + a1 * a1) * (1.f / 128.f) + EPS), rb = 1.0f / sqrtf(wave_sum(c0 * c0 + c1 * c1) * (1.f / 128.f) + EPS);
            *(LAS unsigned*)(vnT + (2 * lane) * 136 + s0) = cvt_pk_bf16(a0 * ra * g0 + b0, c0 * rb * g0 + b0);
            *(LAS unsigned*)(vnT + (2 * lane + 1) * 136 + s0) = cvt_pk_bf16(a1 * ra * g1 + b1, c1 * rb * g1 + b1); }
        __syncthreads();
        if (unit + F.G < NB * 16 * HA) load_v(unit + F.G);
        f32x4 acc[8];
#pragma unroll
        for (int nb = 0; nb < 8; ++nb) acc[nb] = (f32x4){0.f, 0.f, 0.f, 0.f};
#pragma unroll
        for (int ks = 0; ks < 4; ++ks) { if (ks < nks) { const int k0 = ks * 32;
#pragma unroll
            for (int nb = 0; nb < 8; ++nb) { const bf16x8 vf = *(const LAS bf16x8*)(vnT + (nb * 16 + l15) * 136 + k0 + 8 * lq);
                acc[nb] = __builtin_amdgcn_mfma_f32_16x16x32_bf16(vf, wfr[ks], acc[nb], 0, 0, 0); } } }
#pragma unroll
        for (int nb = 0; nb < 8; ++nb) { const int d = nb * 16 + 4 * lq; const u32x2 uu = uuv[nb], zz = zzv[nb];
            u32x2 o; o.x = cvt_pk_bf16(bf_lo(uu.x) * (acc[nb][0] + bt) * bf_lo(zz.x), bf_hi(uu.x) * (acc[nb][1] + bt) * bf_hi(zz.x));
            o.y = cvt_pk_bf16(bf_lo(uu.y) * (acc[nb][2] + bt) * bf_lo(zz.y), bf_hi(uu.y) * (acc[nb][3] + bt) * bf_hi(zz.y));
            *(u32x2*)(Y + row * DMIX + h * 128 + d) = o; }
        __syncthreads();
    }
}
__device__ __forceinline__ void p2b_mscan(const Ctx& F) { if (F.bid < 32 && F.wave == 0) mscan_wave(F, F.bid); }

struct OrderQK {
    int G, c; const char* ws;
    __device__ __forceinline__ bool next(int i, Unit& u) const { const int L = i * G + c; if (L >= 512) return false; const char* XC = ws + WS_XB; const char* WQ = ws + WS_WQ; const char* WK = ws + WS_WK;
        const int kind = L >> 8, l = L & 255; u.pm = l >> 2; u.pn = kind; u.aux = l & 3; u.a = XC + (size_t)u.pm * (256 * DM * 2) + (size_t)u.aux * 512; u.b = (kind ? WK : WQ) + (size_t)u.aux * 131072; return true; }
};
struct EpiQK {
    static constexpr bool PERM = false, AFTER_DRAIN = false;
    bf16_t* K; bf16_t* PQ; const float* DG;
    __device__ __forceinline__ void operator()(const f32x4 (&acc)[2][2][4][2], const Unit& u, int wr, int wc, int fr, int fq) const {
        const int h = u.aux, rl0 = wr * 64 + fr, col0 = wc * 32 + 4 * fq; const bool isk = u.pn != 0;
        const int unit = ((u.pm >> 3) * 4 + h) * 8 + (u.pm & 7);
        float gv[2][4];
#pragma unroll
        for (int ai = 0; ai < 2; ++ai)
#pragma unroll
            for (int m = 0; m < 4; ++m) gv[ai][m] = isk ? 0.0625f : DG[(size_t)h * MA + u.pm * 256 + rl0 + ai * 128 + m * 16];
        bf16_t* base = isk ? K + (size_t)u.pm * 256 * 1024 + h * 256 : PQ + (size_t)unit * 256 * 512 + 256; const int ldo = isk ? 1024 : 512;
#pragma unroll
        for (int ai = 0; ai < 2; ++ai)
#pragma unroll
            for (int m = 0; m < 4; ++m) { const int rl = rl0 + ai * 128 + m * 16; const float g = gv[ai][m];
#pragma unroll
                for (int bj = 0; bj < 2; ++bj) { u32x2 wn[2];
#pragma unroll
                    for (int n = 0; n < 2; ++n) { const f32x4 v = acc[ai][bj][m][n] * g; wn[n].x = cvt_pk_bf16(v[0], v[1]); wn[n].y = cvt_pk_bf16(v[2], v[3]); }
                    *(u32x4*)(base + (size_t)rl * ldo + wc * 32 + lane_row_col(fq) + bj * 128) = lane_row_pair(wn[0], wn[1]); }
                asm volatile("" ::: "memory"); }
    }
};
struct OrderS12 {
    int G, c; const char* ws;
    __device__ __forceinline__ bool next(int i, Unit& u) const { const int L = i * G + c; if (L >= 12) return false; const char* XC = ws + WS_XB; const char* XB2 = ws + WS_XB2; const char* WQ = ws + WS_WQ; const char* WK = ws + WS_WK; const char* WV = ws + WS_WV;
        const int kind = L >> 2; u.pm = 64; u.pn = kind; u.aux = L & 3; u.a = (kind == 2 ? XB2 : XC) + (size_t)64 * (256 * DM * 2) + (size_t)u.aux * 512; u.b = (kind == 0 ? WQ : kind == 1 ? WK : WV) + (size_t)u.aux * 131072; return true; }
};
struct EpiS12 {
    static constexpr bool PERM = false, AFTER_DRAIN = false;
    bf16_t* Q; bf16_t* K; bf16_t* Vs;
    __device__ __forceinline__ void operator()(const f32x4 (&acc)[2][2][4][2], const Unit& u, int wr, int wc, int fr, int fq) const {
        const int h = u.aux, kind = u.pn; bf16_t* O = kind == 0 ? Q + (size_t)MP * 1024 : kind == 1 ? K + (size_t)MP * 1024 : Vs; const float sc = kind == 1 ? 0.0625f : 1.0f;
        const int row0 = wr * 64 + fr, col0 = h * 256 + wc * 32 + 4 * fq;
#pragma unroll
        for (int m = 0; m < 4; ++m) { bf16_t* rowp = O + (size_t)(row0 + m * 16) * 1024 + h * 256 + wc * 32 + lane_row_col(fq);
#pragma unroll
            for (int bj = 0; bj < 2; ++bj) { u32x2 wn[2];
#pragma unroll
                for (int n = 0; n < 2; ++n) { const f32x4 v = acc[0][bj][m][n] * sc; wn[n].x = cvt_pk_bf16(v[0], v[1]); wn[n].y = cvt_pk_bf16(v[2], v[3]); }
                *(u32x4*)(rowp + bj * 128) = lane_row_pair(wn[0], wn[1]); } }
    }
};
struct OrderVW {
    int G, c; const char* ws;
    __device__ __forceinline__ bool next(int i, Unit& u) const { const int L = i * G + c; if (L >= 512) return false; const char* XC = ws + WS_XB; const char* XB2 = ws + WS_XB2; const char* WK = ws + WS_WK; const char* WV = ws + WS_WV;
        const int kind = L >> 8, l = L & 255, b = l >> 5, h = (l >> 3) & 3, cc = l & 7; u.pm = b * 8 + cc; u.pn = l | (kind << 8); u.aux = h;
        u.a = (kind ? WK : WV) + (size_t)h * 131072; u.b = (kind ? XC : XB2) + (size_t)u.pm * (256 * DM * 2) + (size_t)h * 512; return true; }
};
struct EpiVW {
    static constexpr bool PERM = false, AFTER_DRAIN = false;
    bf16_t* VC; bf16_t* WKT; const float* DW; float* DNP;
    __device__ __forceinline__ void operator()(const f32x4 (&acc)[2][2][4][2], const Unit& u, int wr, int wc, int fr, int fq) const {
        const int h = u.aux, kind = u.pn >> 8, l = u.pn & 255, rl0 = wr * 64 + fr, col0 = wc * 32 + 4 * fq; const int ldo = kind ? 256 : 512; bf16_t* base = (kind ? WKT : VC) + (size_t)l * 256 * ldo;
        f32x4 scq[2][2];
#pragma unroll
        for (int bj = 0; bj < 2; ++bj)
#pragma unroll
            for (int n = 0; n < 2; ++n) scq[bj][n] = kind ? *(const f32x4*)(DW + (size_t)h * MA + u.pm * 256 + col0 + bj * 128 + n * 16) * 0.0625f : (f32x4){1.f, 1.f, 1.f, 1.f};
#pragma unroll
        for (int ai = 0; ai < 2; ++ai)
#pragma unroll
            for (int m = 0; m < 4; ++m) { bf16_t* rowp = base + (size_t)(rl0 + ai * 128 + m * 16) * ldo + wc * 32 + lane_row_col(fq); float rsum = 0.f;
#pragma unroll
                for (int bj = 0; bj < 2; ++bj) { u32x2 wn[2];
#pragma unroll
                    for (int n = 0; n < 2; ++n) { const f32x4 v = acc[ai][bj][m][n] * scq[bj][n]; u32x2 w; w.x = cvt_pk_bf16(v[0], v[1]); w.y = cvt_pk_bf16(v[2], v[3]); wn[n] = w;
                        rsum += (bf_lo(w.x) + bf_hi(w.x)) + (bf_lo(w.y) + bf_hi(w.y)); }
                    *(u32x4*)(rowp + bj * 128) = lane_row_pair(wn[0], wn[1]); }
                if (kind) { rsum += __shfl_xor(rsum, 16); rsum += __shfl_xor(rsum, 32); if (fq == 0) DNP[((size_t)l * 256 + rl0 + ai * 128 + m * 16) * 4 + wc] = rsum; }
                asm volatile("" ::: "memory"); }
    }
};
__device__ __forceinline__ void p3_qkv(const Ctx& F) {
    unsigned char* ws = F.ws;
    { Gemm g{DM, 256, 256}; OrderQK S{F.G, F.bid, (const char*)ws}; EpiQK E{(bf16_t*)(ws + WS_K), (bf16_t*)(ws + WS_PQ), (const float*)(ws + WS_DG)};
      pg8::gemm_phase<EpiQK, OrderQK>(F.lds, g, S, E); }
    { Gemm g{256, DM, 256}; OrderVW S{F.G, F.bid, (const char*)ws}; EpiVW E{(bf16_t*)(ws + WS_VC), (bf16_t*)(ws + WS_WKT), (const float*)(ws + WS_DW), (float*)(ws + WS_DN4)};
      pg8::gemm_phase<EpiVW, OrderVW>(F.lds, g, S, E); }
}

__device__ __forceinline__ void p3_s12(const Ctx& F) {
    unsigned char* ws = F.ws;
    { Gemm g{DM, 256, 256}; OrderS12 S{F.G, (F.bid - 32) & 255, (const char*)ws}; EpiS12 E{(bf16_t*)(ws + WS_Q), (bf16_t*)(ws + WS_K), (bf16_t*)(ws + WS_VS)};
      pg8::gemm_phase<EpiS12, OrderS12>(F.lds, g, S, E); }
}
struct OrderUnitNT {
    int n, G, c; const char* A; size_t astep_pm, astep_h, astep_u; const char* B; size_t bstep_pm, bstep_h, bstep_u;
    __device__ __forceinline__ bool next(int i, Unit& u) const { const int L = i * G + c; if (L >= n) return false;
        const int b = L >> 5, h = (L >> 3) & 3, cc = L & 7; u.pm = b * 8 + cc; u.pn = L; u.aux = h;
        u.a = A + (size_t)u.pm * astep_pm + (size_t)h * astep_h + (size_t)L * astep_u; u.b = B + (size_t)u.pm * bstep_pm + (size_t)h * bstep_h + (size_t)L * bstep_u; return true; }
};
struct EpiScore {
    static constexpr bool PERM = false, AFTER_DRAIN = false;
    bf16_t* PQ; const float* DA; const float* DR; float* DENP;
    __device__ __forceinline__ void operator()(const f32x4 (&acc)[2][2][4][2], const Unit& u, int wr, int wc, int fr, int fq) const {
        const int h = u.aux, rl0 = wr * 64 + fr, col0 = wc * 32 + 4 * fq; const size_t vb = (size_t)h * MA + (size_t)u.pm * 256;
        float atv[2][4]; f32x4 rrv[2][2];
#pragma unroll
        for (int ai = 0; ai < 2; ++ai)
#pragma unroll
            for (int m = 0; m < 4; ++m) atv[ai][m] = DA[vb + rl0 + ai * 128 + m * 16];
#pragma unroll
        for (int bj = 0; bj < 2; ++bj)
#pragma unroll
            for (int n = 0; n < 2; ++n) rrv[bj][n] = *(const f32x4*)(DR + vb + col0 + bj * 128 + n * 16);
#pragma unroll
        for (int ai = 0; ai < 2; ++ai)
#pragma unroll
            for (int m = 0; m < 4; ++m) { int t_ = rl0 + ai * 128 + m * 16; asm volatile("" : "+v"(t_)); const int t = t_; const float at = atv[ai][m]; float rs_ = 0.f; bf16_t* rowp = PQ + ((size_t)u.pn * 256 + t) * 512 + wc * 32 + lane_row_col(fq);
#pragma unroll
                for (int bj = 0; bj < 2; ++bj) { u32x2 wn[2];
#pragma unroll
                    for (int n = 0; n < 2; ++n) { const int c = col0 + bj * 128 + n * 16; f32x4 v; const f32x4 rr = rrv[bj][n];
#pragma unroll
                        for (int j = 0; j < 4; ++j) { const float e = fast_exp(fminf(at + rr[j], 60.f)); v[j] = (c + j <= t) ? acc[ai][bj][m][n][j] * e : 0.f; rs_ += v[j]; }
                        wn[n].x = cvt_pk_bf16(v[0], v[1]); wn[n].y = cvt_pk_bf16(v[2], v[3]); }
                    *(u32x4*)(rowp + bj * 128) = lane_row_pair(wn[0], wn[1]); }
                rs_ += __shfl_xor(rs_, 16); rs_ += __shfl_xor(rs_, 32);
                if (fq == 0) DENP[(vb + t) * 4 + wc] = rs_; asm volatile("" ::: "memory"); }
    }
};
struct EpiF32Unit {
    static constexpr bool PERM = false, AFTER_DRAIN = false;
    bf16_t* O;
    __device__ __forceinline__ void operator()(const f32x4 (&acc)[2][2][4][2], const Unit& u, int wr, int wc, int fr, int fq) const {
        bf16_t* base = O + (size_t)u.pn * 65536 + (size_t)(wr * 64 + fr) * 256 + wc * 32 + lane_row_col(fq);
#pragma unroll
        for (int ai = 0; ai < 2; ++ai)
#pragma unroll
            for (int m = 0; m < 4; ++m)
#pragma unroll
                for (int bj = 0; bj < 2; ++bj) { u32x2 wn[2];
#pragma unroll
                    for (int n = 0; n < 2; ++n) { const f32x4 v = acc[ai][bj][m][n]; wn[n].x = cvt_pk_bf16(v[0], v[1]); wn[n].y = cvt_pk_bf16(v[2], v[3]); }
                    *(u32x4*)(base + (size_t)(ai * 128 + m * 16) * 256 + bj * 128) = lane_row_pair(wn[0], wn[1]); }
    }
};
__device__ __forceinline__ void p4_scores(const Ctx& F) {
    unsigned char* ws = F.ws;
    { Gemm g{512, DM, 256}; OrderUnitNT S{NUNIT, F.G, F.bid, (const char*)(ws + WS_PQ) + 512, 0, 0, (size_t)256 * 512 * 2, (const char*)(ws + WS_K), (size_t)256 * DM * 2, 512, 0};
      EpiScore E{(bf16_t*)(ws + WS_PQ), (const float*)(ws + WS_DA), (const float*)(ws + WS_DR), (float*)(ws + WS_DENP)}; pg8::gemm_phase<EpiScore, OrderUnitNT>(F.lds, g, S, E); }
}
__device__ __forceinline__ void p4_dc(const Ctx& F) {
    unsigned char* ws = F.ws;
    { Gemm g{512, 256, 256}; OrderUnitNT S{NUNIT, F.G, F.bid, (const char*)(ws + WS_VC), 0, 0, (size_t)256 * 512 * 2, (const char*)(ws + WS_WKT), 0, 0, (size_t)256 * 256 * 2};
      EpiF32Unit E{(bf16_t*)(F.out + O_Y)}; pg8::gemm_phase<EpiF32Unit, OrderUnitNT>(F.lds, g, S, E); }
}

template <int R> __device__ __forceinline__ void qn_rows(const u32x2 (&qq)[32], const f32x4 nv, int& sres) {
    if constexpr (R < 32) { const float s = wave_sum(bf_lo(qq[R].x) * nv[0] + bf_hi(qq[R].x) * nv[1] + bf_lo(qq[R].y) * nv[2] + bf_hi(qq[R].y) * nv[3]);
        const int sv = __builtin_amdgcn_readfirstlane(__builtin_bit_cast(int, s)); asm volatile("s_nop 3\n\tv_writelane_b32 %0, %1, %2" : "+v"(sres) : "s"(sv), "n"(R));
        qn_rows<R + 1>(qq, nv, sres); }
}
__device__ __forceinline__ void p5_scan_sample(const Ctx& F0) { Ctx F = F0; asm volatile("" : "+v"(F.tid), "+v"(F.lane), "+s"(F.gw));
    unsigned char* ws = F.ws; const float* DG = (const float*)(ws + WS_DG); const bf16_t* DCb = (const bf16_t*)(F.out + O_Y); bf16_t* VC = (bf16_t*)(ws + WS_VC);
    {   u32x4 dw[2][8]; float ge[2][8];
#pragma unroll
        for (int k = 0; k < 2; ++k) { const int idx = F.bid * 512 + F.tid + k * F.G * 512, bh = idx >> 13, q8 = idx & 8191, e = q8 >> 5, d8 = (q8 & 31) * 8, b = bh >> 2, h = bh & 3;
#pragma unroll
            for (int c = 0; c < 8; ++c) { dw[k][c] = __builtin_nontemporal_load((const u32x4*)(DCb + ((size_t)(bh * 8 + c) * 256 + e) * 256 + d8)); ge[k][c] = DG[(size_t)h * MA + b * SEQ + c * 256 + 255]; } }
#pragma unroll
        for (int k = 0; k < 2; ++k) { const int idx = F.bid * 512 + F.tid + k * F.G * 512, bh = idx >> 13, q8 = idx & 8191, e = q8 >> 5, d8 = (q8 & 31) * 8;
            float C[8];
#pragma unroll
            for (int j = 0; j < 8; ++j) C[j] = 0.f;
#pragma unroll
            for (int c = 0; c < 8; ++c) { float dc[8]; unpack8(dw[k][c], dc); *(u32x4*)(VC + ((size_t)(bh * 8 + c) * 256 + e) * 512 + 256 + d8) = pack8(C);
#pragma unroll
                for (int j = 0; j < 8; ++j) C[j] = C[j] * ge[k][c] + dc[j]; }
            __builtin_nontemporal_store((f32x4){C[0], C[1], C[2], C[3]}, (f32x4*)(F.out + O_CP + ((size_t)bh * 256 + e) * 256 + d8));
            __builtin_nontemporal_store((f32x4){C[4], C[5], C[6], C[7]}, (f32x4*)(F.out + O_CP + ((size_t)bh * 256 + e) * 256 + d8 + 4)); }
    }
    LAS float* npv = (LAS float*)F.lds;
    for (int u = F.bid; u < NUNIT; u += F.G) { const int bh = u >> 3, cc = u & 7, b = bh >> 2, h = bh & 3;
        const bf16_t* PQg = (const bf16_t*)(ws + WS_PQ);
        u32x2 qq[32];
        const bf16_t* qbase = PQg + ((size_t)u * 256 + F.wave * 32) * 512 + 256 + 4 * F.lane; asm volatile("" : "+v"(qbase));
#pragma unroll
        for (int r = 0; r < 32; ++r) qq[r] = *(const u32x2*)(qbase + r * 512);
        __syncthreads();
        if (F.tid < 256) { float n = 0.f; const float* DN = (const float*)(ws + WS_DN4);
            for (int j = 0; j < cc; ++j) { const f32x4 dp = *(const f32x4*)(DN + ((size_t)(bh * 8 + j) * 256 + F.tid) * 4); n = DG[(size_t)h * MA + b * SEQ + j * 256 + 255] * n + ((dp[0] + dp[1]) + (dp[2] + dp[3])); }
            npv[F.tid] = n; const f32x4 dl = *(const f32x4*)(DN + ((size_t)u * 256 + F.tid) * 4); if (cc == 7) F.out[O_NP + (size_t)bh * 256 + F.tid] = DG[(size_t)h * MA + b * SEQ + 7 * 256 + 255] * n + ((dl[0] + dl[1]) + (dl[2] + dl[3])); }
        __syncthreads();
        const f32x4 nv = *(const LAS f32x4*)(npv + 4 * F.lane); int sres = 0;
        qn_rows<0>(qq, nv, sres);
        if (F.lane < 32) ((float*)(ws + WS_QN))[(size_t)h * MA + (size_t)b * SEQ + cc * 256 + F.wave * 32 + F.lane] = __builtin_bit_cast(float, sres); }
}
__device__ __forceinline__ void p5s_sample(const Ctx& F0, int jk) { Ctx F = F0; asm volatile("" : "+v"(F.tid), "+v"(F.lane), "+s"(F.gw));
    unsigned char* ws = F.ws;
    LAS float* hs = (LAS float*)F.lds + 512; LAS float* red = (LAS float*)F.lds + 1024;
    for (int job = F.bid + jk * F.G; job < MS * HB; job += 2 * F.G) { const int i = job >> 2, h = job & 3; const size_t row = MP + i;
        const bf16_t* Q = (const bf16_t*)(ws + WS_Q) + row * 1024 + h * 256; const bf16_t* K = (const bf16_t*)(ws + WS_K) + row * 1024 + h * 256; const bf16_t* V = (const bf16_t*)(ws + WS_VS) + (size_t)i * 1024 + h * 256;
        const u32x2 qw = *(const u32x2*)(Q + 4 * F.lane), kw = *(const u32x2*)(K + 4 * F.lane);
        const f32x4 q4 = (f32x4){bf_lo(qw.x), bf_hi(qw.x), bf_lo(qw.y), bf_hi(qw.y)}, k4 = (f32x4){bf_lo(kw.x), bf_hi(kw.x), bf_lo(kw.y), bf_hi(kw.y)};
        const f32x4 n0 = *(const f32x4*)(F.in[3] + ((size_t)i * 4 + h) * 256 + 4 * F.lane);
        const float li = ((const float*)(ws + WS_GLI))[(size_t)h * MA + row], lf = ((const float*)(ws + WS_GLF))[(size_t)h * MA + row], m0 = F.in[4][i * 4 + h];
        const float mn = fmaxf(lf + m0, li), g = __expf(lf + m0 - mn), wi = __expf(li - mn);
        const float qk = wave_sum(q4[0] * k4[0] + q4[1] * k4[1] + q4[2] * k4[2] + q4[3] * k4[3]), nq = wave_sum(n0[0] * q4[0] + n0[1] * q4[1] + n0[2] * q4[2] + n0[3] * q4[3]);
        const float sc = wi * qk, den = sc + g * nq, dinv = 1.0f / fmaxf(fabsf(den), __expf(-mn));
        const float* C0 = F.in[2] + (((size_t)i * 4 + h) * 256 + F.wave * 32) * 256 + 4 * F.lane; float* C1 = F.out + O_CS + (((size_t)i * 4 + h) * 256 + F.wave * 32) * 256 + 4 * F.lane;
        __syncthreads();
#pragma unroll 1
        for (int r8 = 0; r8 < 32; r8 += 8) { f32x4 c[8]; float ve[8], cq[8];
#pragma unroll
            for (int r = 0; r < 8; ++r) { c[r] = __builtin_nontemporal_load((const f32x4*)(C0 + (size_t)(r8 + r) * 256)); ve[r] = bf2f(V[F.wave * 32 + r8 + r]); }
#pragma unroll
            for (int r = 0; r < 8; ++r) { cq[r] = c[r][0] * q4[0] + c[r][1] * q4[1] + c[r][2] * q4[2] + c[r][3] * q4[3]; const float wv = wi * ve[r]; __builtin_nontemporal_store(c[r] * g + k4 * wv, (f32x4*)(C1 + (size_t)(r8 + r) * 256)); }
#pragma unroll
            for (int r = 0; r < 8; ++r) { cq[r] = wave_sum(cq[r]); if (F.lane == 0) hs[F.wave * 32 + r8 + r] = (sc * ve[r] + g * cq[r]) * dinv; } }
        if (F.wave == 0) { *(f32x4*)(F.out + O_NS + ((size_t)i * 4 + h) * 256 + 4 * F.lane) = n0 * g + k4 * wi; if (F.lane == 0) F.out[O_MS + i * 4 + h] = mn; }
        __syncthreads();
        const bf16_t* PB = (const bf16_t*)(ws + WS_PROJB) + row * 3072; const bf16_t* XC = (const bf16_t*)(ws + WS_XB) + row * DM;
        float x = 0.f; const int ch = h * 256 + (F.tid & 255);
        if (F.tid < 256) x = hs[F.tid] * bf2f(PB[1024 + ch]);
        float p = wave_sum(x); if (F.lane == 0) red[F.wave] = p;
        __syncthreads();
        const float mu = (red[0] + red[1] + red[2] + red[3]) * (1.f / 256.f), dx = x - mu;
        __syncthreads();
        p = wave_sum(F.tid < 256 ? dx * dx : 0.f); if (F.lane == 0) red[F.wave] = p;
        __syncthreads();
        const float rstd = 1.0f / sqrtf((red[0] + red[1] + red[2] + red[3]) * (1.f / 256.f) + EPS);
        if (F.tid < 256) ((bf16_t*)(ws + WS_Y))[row * DMIX + 1024 + ch] = f2bf((dx * rstd * F.in[21][ch] + F.in[22][ch] * bf2f(XC[ch])) * bf2f(PB[2048 + ch]));
        __syncthreads();
    }
}
struct EpiHOut {
    static constexpr bool PERM = false, AFTER_DRAIN = true;
    const float* DENP; const float* DG; const float* QN; const float* DEM; const bf16_t* PB; const bf16_t* XC; bf16_t* Y; const float* gng; const float* skip;
    __device__ __forceinline__ void fused(f32x4 (&acc)[2][2][4][2], const Unit& u, int wr, int wc, int fr, int fq, LAS unsigned char* lds, int wid, int lane) const {
        const int h = u.aux, rl0 = wr * 64 + fr, col0 = wc * 32 + 4 * fq; const size_t vb = (size_t)h * MA + (size_t)u.pm * 256;
        LAS float* P1 = (LAS float*)lds; LAS float* P2 = (LAS float*)lds + 1024;
#pragma unroll
        for (int ai = 0; ai < 2; ++ai) { u32x2 ow[4][2][2]; f32x4 dp[4]; float dgq[4], dem[4];
#pragma unroll
            for (int m = 0; m < 4; ++m) { const int t = rl0 + ai * 128 + m * 16; const size_t row = (size_t)u.pm * 256 + t; dp[m] = *(const f32x4*)(DENP + (vb + t) * 4); dgq[m] = QN[vb + t]; dem[m] = DEM[vb + t];
#pragma unroll
                for (int bj = 0; bj < 2; ++bj)
#pragma unroll
                    for (int n = 0; n < 2; ++n) ow[m][bj][n] = *(const u32x2*)(PB + row * 3072 + 1024 + h * 256 + col0 + bj * 128 + n * 16); }
#pragma unroll
            for (int m = 0; m < 4; ++m) { const int t = rl0 + ai * 128 + m * 16; const float den = (dp[m][0] + dp[m][1]) + (dp[m][2] + dp[m][3]) + dgq[m];
                const float dinv = 1.0f / fmaxf(fabsf(den), dem[m]); float s = 0.f;
#pragma unroll
                for (int bj = 0; bj < 2; ++bj)
#pragma unroll
                    for (int n = 0; n < 2; ++n) { const u32x2 o2 = ow[m][bj][n];
                        f32x4 v = acc[ai][bj][m][n] * dinv; v[0] *= bf_lo(o2.x); v[1] *= bf_hi(o2.x); v[2] *= bf_lo(o2.y); v[3] *= bf_hi(o2.y); acc[ai][bj][m][n] = v; s += (v[0] + v[1]) + (v[2] + v[3]); }
                s += __shfl_xor(s, 16); s += __shfl_xor(s, 32); if (fq == 0) P1[t * 4 + wc] = s; } }
        asm volatile("s_waitcnt lgkmcnt(0)" ::: "memory"); __builtin_amdgcn_s_barrier(); asm volatile("" ::: "memory");
#pragma unroll
        for (int ai = 0; ai < 2; ++ai)
#pragma unroll
            for (int m = 0; m < 4; ++m) { const int t = rl0 + ai * 128 + m * 16; const f32x4 ps = *(const LAS f32x4*)(P1 + t * 4); const float mu = ((ps[0] + ps[1]) + (ps[2] + ps[3])) * (1.f / 256.f); float q = 0.f;
#pragma unroll
                for (int bj = 0; bj < 2; ++bj)
#pragma unroll
                    for (int n = 0; n < 2; ++n) { f32x4 v = acc[ai][bj][m][n] - mu; acc[ai][bj][m][n] = v; q += (v[0] * v[0] + v[1] * v[1]) + (v[2] * v[2] + v[3] * v[3]); }
                q += __shfl_xor(q, 16); q += __shfl_xor(q, 32); if (fq == 0) P2[t * 4 + wc] = q; }
        asm volatile("s_waitcnt lgkmcnt(0)" ::: "memory"); __builtin_amdgcn_s_barrier(); asm volatile("" ::: "memory");
#pragma unroll
        for (int ai = 0; ai < 2; ++ai) { u32x2 xw[4][2][2], zw[4][2][2];
#pragma unroll
            for (int m = 0; m < 4; ++m) { const int t = rl0 + ai * 128 + m * 16; const size_t row = (size_t)u.pm * 256 + t;
#pragma unroll
                for (int bj = 0; bj < 2; ++bj)
#pragma unroll
                    for (int n = 0; n < 2; ++n) { const int c = h * 256 + col0 + bj * 128 + n * 16; xw[m][bj][n] = *(const u32x2*)(XC + row * DM + c); zw[m][bj][n] = *(const u32x2*)(PB + row * 3072 + 2048 + c); } }
#pragma unroll
            for (int m = 0; m < 4; ++m) { const int t = rl0 + ai * 128 + m * 16; const size_t row = (size_t)u.pm * 256 + t; const f32x4 ps = *(const LAS f32x4*)(P2 + t * 4);
                const float rstd = 1.0f / sqrtf(((ps[0] + ps[1]) + (ps[2] + ps[3])) * (1.f / 256.f) + EPS);
#pragma unroll
                for (int bj = 0; bj < 2; ++bj) { u32x2 wn[2];
#pragma unroll
                    for (int n = 0; n < 2; ++n) { const int c = h * 256 + col0 + bj * 128 + n * 16; const u32x2 x2 = xw[m][bj][n], z2 = zw[m][bj][n];
                        const f32x4 ggv = *(const f32x4*)(gng + c), skv = *(const f32x4*)(skip + c); const f32x4 v = acc[ai][bj][m][n] * rstd * ggv;
                        wn[n].x = cvt_pk_bf16((v[0] + skv[0] * bf_lo(x2.x)) * bf_lo(z2.x), (v[1] + skv[1] * bf_hi(x2.x)) * bf_hi(z2.x));
                        wn[n].y = cvt_pk_bf16((v[2] + skv[2] * bf_lo(x2.y)) * bf_lo(z2.y), (v[3] + skv[3] * bf_hi(x2.y)) * bf_hi(z2.y)); }
                    *(u32x4*)(Y + row * DMIX + 1024 + h * 256 + wc * 32 + lane_row_col(fq) + bj * 128) = lane_row_pair(wn[0], wn[1]); } } }
    }
};
__device__ __forceinline__ void p6_hout(const Ctx& F) {
    unsigned char* ws = F.ws; Gemm g{512, 512, 512};
    OrderUnitNT S{NUNIT, F.G, F.bid, (const char*)(ws + WS_PQ), 0, 0, (size_t)256 * 512 * 2, (const char*)(ws + WS_VC), 0, 0, (size_t)256 * 512 * 2};
    EpiHOut E{(const float*)(ws + WS_DENP), (const float*)(ws + WS_DG), (const float*)(ws + WS_QN), (const float*)(ws + WS_DEM), (const bf16_t*)(ws + WS_PROJB), (const bf16_t*)(ws + WS_XB), (bf16_t*)(ws + WS_Y), F.in[21], F.in[22]};
    pg8::gemm_phase<EpiHOut, OrderUnitNT, false, true>(F.lds, g, S, E);
}
template <class PtrF, class Ef>
__device__ __forceinline__ void sample_gemm(const Ctx& F, int nitems, int K, int lda, int ldb, const PtrF& P, const Ef& E) {
    int lane_ = F.lane; asm volatile("" : "+v"(lane_));
    const int l15 = lane_ & 15, lq = lane_ >> 4, w = F.wave;
    for (int item = F.bid; item < nitems; item += F.G) {
        const bf16_t* A; const bf16_t* B; P(item, A, B);
        const bf16_t* ap = A + (size_t)(16 * w + l15) * lda + 8 * lq; const bf16_t* bp = B + (size_t)l15 * ldb + 8 * lq;
        f32x4 acc = (f32x4){0.f, 0.f, 0.f, 0.f};
        for (int k0 = 0; k0 < K; k0 += 256) { bf16x8 a[8], b[8];
#pragma unroll
            for (int j = 0; j < 8; ++j) { a[j] = *(const bf16x8*)(ap + k0 + 32 * j); b[j] = *(const bf16x8*)(bp + k0 + 32 * j); }
#pragma unroll
            for (int j = 0; j < 8; ++j) acc = __builtin_amdgcn_mfma_f32_16x16x32_bf16(a[j], b[j], acc, 0, 0, 0); }
#pragma unroll
        for (int r = 0; r < 4; ++r) E(item, 16 * w + 4 * lq + r, l15, acc[r]);
    }
}
__device__ __forceinline__ void sample_inproj(const Ctx& F) {
    unsigned char* ws = F.ws; const bf16_t* XB = (const bf16_t*)(ws + WS_XB) + (size_t)MP * DM; const bf16_t* W = (const bf16_t*)(ws + WS_WIN);
    bf16_t* PA = (bf16_t*)(ws + WS_PROJA) + (size_t)MP * 3072; bf16_t* PB = (bf16_t*)(ws + WS_PROJB) + (size_t)MP * 3072; bf16_t* XB2 = (bf16_t*)(ws + WS_XB2) + (size_t)MP * DM; const float* rs = (const float*)(ws + WS_RS) + MP;
    int lane_ = F.lane; asm volatile("" : "+v"(lane_)); const int l15 = lane_ & 15, lq = lane_ >> 4, w = F.wave; LAS f32x4* red = (LAS f32x4*)F.lds;
    for (int item = F.bid; item < 256; item += F.G) { const int rb = item & 1, cb = item >> 1;
        const bf16_t* ap = XB + (size_t)(rb * 64 + l15) * DM + w * 128 + 8 * lq; const bf16_t* bp = W + (size_t)(cb * 48 + l15) * DM + w * 128 + 8 * lq;
        bf16x8 a[4][4], b[4][3]; float rsv[2][4];
#pragma unroll
        for (int j = 0; j < 4; ++j) {
#pragma unroll
            for (int m = 0; m < 4; ++m) a[j][m] = *(const bf16x8*)(ap + (size_t)(16 * m) * DM + 32 * j);
#pragma unroll
            for (int n = 0; n < 3; ++n) b[j][n] = *(const bf16x8*)(bp + (size_t)(16 * n) * DM + 32 * j); }
#pragma unroll
        for (int q = 0; q < 2; ++q) { const int t = w + 8 * q;
#pragma unroll
            for (int r = 0; r < 4; ++r) rsv[q][r] = t < 12 ? rs[rb * 64 + (t / 3) * 16 + 4 * lq + r] : 0.f; }
        f32x4 acc[4][3];
#pragma unroll
        for (int m = 0; m < 4; ++m)
#pragma unroll
            for (int n = 0; n < 3; ++n) acc[m][n] = (f32x4){0.f, 0.f, 0.f, 0.f};
#pragma unroll
        for (int j = 0; j < 4; ++j)
#pragma unroll
            for (int m = 0; m < 4; ++m)
#pragma unroll
                for (int n = 0; n < 3; ++n) acc[m][n] = __builtin_amdgcn_mfma_f32_16x16x32_bf16(a[j][m], b[j][n], acc[m][n], 0, 0, 0);
        __syncthreads();
#pragma unroll
        for (int m = 0; m < 4; ++m)
#pragma unroll
            for (int n = 0; n < 3; ++n) red[(w * 12 + m * 3 + n) * 64 + F.lane] = acc[m][n];
        __syncthreads();
#pragma unroll
        for (int q = 0; q < 2; ++q) { const int t = w + 8 * q;
            if (t < 12) { f32x4 s = red[(0 * 12 + t) * 64 + F.lane];
#pragma unroll
                for (int ww = 1; ww < 8; ++ww) s = s + red[(ww * 12 + t) * 64 + F.lane];
                const int mt = t / 3, nt = t - 3 * mt, col = cb * 48 + nt * 16 + l15, grp = col >> 10;
#pragma unroll
                for (int r = 0; r < 4; ++r) { const int row = rb * 64 + mt * 16 + 4 * lq + r; float v = s[r] * rsv[q][r];
                    if (grp < 2) { const f32x2 g2 = gelu_pk((f32x2){v, v}); v = g2.x; } else if (grp == 2 || grp == 5) v = siluf_(v); else if (grp == 4) v = sigmoidf_(v);
                    bf16_t* dst = col < 3072 ? PA + (size_t)row * 3072 + col : (col < 4096 ? XB2 + (size_t)row * DM + (col - 3072) : PB + (size_t)row * 3072 + (col - 3072)); *dst = f2bf(v); } } }
    }
    __syncthreads();
}
__device__ __forceinline__ void sample_qkv(const Ctx& F) {
    unsigned char* ws = F.ws; const bf16_t* XC = (const bf16_t*)(ws + WS_XB) + (size_t)MP * DM; const bf16_t* XBr = (const bf16_t*)(ws + WS_PROJB) + (size_t)MP * 3072;
    const bf16_t* WQ = (const bf16_t*)(ws + WS_WQ); const bf16_t* WK = (const bf16_t*)(ws + WS_WK); const bf16_t* WV = (const bf16_t*)(ws + WS_WV);
    bf16_t* Q = (bf16_t*)(ws + WS_Q) + (size_t)MP * 1024; bf16_t* Kk = (bf16_t*)(ws + WS_K) + (size_t)MP * 1024; bf16_t* Vs = (bf16_t*)(ws + WS_VS);
    sample_gemm(F, 128, 256, DM, 256,
        [=](int item, const bf16_t*& A, const bf16_t*& B) { const int which = item >> 6, it = item & 63, h = it >> 4; A = XC + h * 256; B = (which ? WK : WQ) + (size_t)h * 65536 + (size_t)(it & 15) * 16 * 256; },
        [=](int item, int r, int c, float acc) { const int which = item >> 6, it = item & 63; bf16_t* O = which ? Kk : Q; O[(size_t)r * 1024 + it * 16 + c] = f2bf(which ? acc * 0.0625f : acc); });
    sample_gemm(F, 64, 256, 3072, 256,
        [=](int item, const bf16_t*& A, const bf16_t*& B) { const int h = item >> 4; A = XBr + h * 256; B = WV + (size_t)h * 65536 + (size_t)(item & 15) * 16 * 256; },
        [=](int item, int r, int c, float acc) { Vs[(size_t)r * 1024 + item * 16 + c] = f2bf(acc); });
}
__device__ __forceinline__ void sample_outproj(const Ctx& F) {
    unsigned char* ws = F.ws; const bf16_t* Y = (const bf16_t*)(ws + WS_Y) + (size_t)MP * DMIX; const bf16_t* W = (const bf16_t*)(ws + WS_WOUT);
    const float* xs = F.in[1]; float* out = F.out + O_YS; bf16_t* X1B = (bf16_t*)(ws + WS_X1B) + (size_t)MP * DM;
    sample_gemm(F, DM / 16, DMIX, DMIX, DMIX,
        [=](int item, const bf16_t*& A, const bf16_t*& B) { A = Y; B = W + (size_t)item * 16 * DMIX; },
        [=](int item, int r, int c, float acc) { const int col = item * 16 + c; const float v = xs[(size_t)r * DM + col] + acc; out[(size_t)r * DM + col] = v; X1B[(size_t)r * DM + col] = f2bf(v); });
}
__device__ __forceinline__ void sample_ple(const Ctx& F) {
    unsigned char* ws = F.ws; const bf16_t* X1B = (const bf16_t*)(ws + WS_X1B) + (size_t)MP * DM; const bf16_t* PBs = (const bf16_t*)(ws + WS_PB) + (size_t)MP * DPLE;
    const bf16_t* WG = (const bf16_t*)(ws + WS_WPG); const bf16_t* WP = (const bf16_t*)(ws + WS_WPP); const float* bias = F.in[25];
    bf16_t* GB = (bf16_t*)(ws + WS_GB) + (size_t)MP * DM; bf16_t* EB = (bf16_t*)(ws + WS_EB) + (size_t)MP * DM;
    sample_gemm(F, DM / 16, DM, DM, DM,
        [=](int item, const bf16_t*& A, const bf16_t*& B) { A = X1B; B = WG + (size_t)item * 16 * DM; },
        [=](int item, int r, int c, float acc) { const int col = item * 16 + c; GB[(size_t)r * DM + col] = f2bf(sigmoidf_(acc + bias[col])); });
    sample_gemm(F, DM / 16, DPLE, DPLE, DPLE,
        [=](int item, const bf16_t*& A, const bf16_t*& B) { A = PBs; B = WP + (size_t)item * 16 * DPLE; },
        [=](int item, int r, int c, float acc) { EB[(size_t)r * DM + item * 16 + c] = f2bf(acc); });
}
template <class PtrF, class Ef>
__device__ __forceinline__ void sample_gemm_ks(const Ctx& F, int nitems, int K, int lda, int ldb, const PtrF& P, const Ef& E) {
    int lane_ = F.lane; asm volatile("" : "+v"(lane_)); const int l15 = lane_ & 15, lq = lane_ >> 4, w = F.wave; LAS f32x4* red = (LAS f32x4*)F.lds;
    const int ks = K >> 3;
    for (int item = F.bid; item < nitems; item += F.G) {
        const bf16_t* A; const bf16_t* B; P(item, A, B);
        const bf16_t* ap = A + (size_t)l15 * lda + w * ks + 8 * lq; const bf16_t* bp = B + (size_t)l15 * ldb + w * ks + 8 * lq;
        f32x4 acc[2][4];
#pragma unroll
        for (int m = 0; m < 2; ++m)
#pragma unroll
            for (int n = 0; n < 4; ++n) acc[m][n] = (f32x4){0.f, 0.f, 0.f, 0.f};
        for (int k0 = 0; k0 < ks; k0 += 128) { bf16x8 a[4][2], b[4][4];
#pragma unroll
            for (int j = 0; j < 4; ++j) {
#pragma unroll
                for (int m = 0; m < 2; ++m) a[j][m] = (k0 + 32 * j < ks) ? *(const bf16x8*)(ap + (size_t)(16 * m) * lda + k0 + 32 * j) : (bf16x8){0, 0, 0, 0, 0, 0, 0, 0};
#pragma unroll
                for (int n = 0; n < 4; ++n) b[j][n] = (k0 + 32 * j < ks) ? *(const bf16x8*)(bp + (size_t)(16 * n) * ldb + k0 + 32 * j) : (bf16x8){0, 0, 0, 0, 0, 0, 0, 0}; }
#pragma unroll
            for (int j = 0; j < 4; ++j)
#pragma unroll
                for (int m = 0; m < 2; ++m)
#pragma unroll
                    for (int n = 0; n < 4; ++n) acc[m][n] = __builtin_amdgcn_mfma_f32_16x16x32_bf16(a[j][m], b[j][n], acc[m][n], 0, 0, 0); }
        __syncthreads();
#pragma unroll
        for (int m = 0; m < 2; ++m)
#pragma unroll
            for (int n = 0; n < 4; ++n) red[(w * 8 + m * 4 + n) * 64 + F.lane] = acc[m][n];
        __syncthreads();
        f32x4 s = red[(0 * 8 + w) * 64 + F.lane];
#pragma unroll
        for (int ww = 1; ww < 8; ++ww) s = s + red[(ww * 8 + w) * 64 + F.lane];
        const int mt = w >> 2, nt = w & 3;
#pragma unroll
        for (int r = 0; r < 4; ++r) E(item, 16 * mt + 4 * lq + r, 16 * nt + l15, s[r]);
    }
    __syncthreads();
}
__device__ __forceinline__ void sample_outproj_ks(const Ctx& F) {
    unsigned char* ws = F.ws; const bf16_t* Y = (const bf16_t*)(ws + WS_Y) + (size_t)MP * DMIX; const bf16_t* W = (const bf16_t*)(ws + WS_WOUT);
    const float* xs = F.in[1]; bf16_t* X1B = (bf16_t*)(ws + WS_X1B) + (size_t)MP * DM;
    int lane_ = F.lane; asm volatile("" : "+v"(lane_)); const int l15 = lane_ & 15, lq = lane_ >> 4, w = F.wave; LAS f32x4* red = (LAS f32x4*)F.lds;
    for (int item = F.bid; item < 256; item += F.G) { const int rb = item & 3, cb = item >> 2;
        const bf16_t* ap = Y + (size_t)(rb * 32 + l15) * DMIX + w * 256 + 8 * lq; const bf16_t* bp = W + (size_t)(cb * 16 + l15) * DMIX + w * 256 + 8 * lq;
        bf16x8 a[8][2], b[8]; float xr[4] = {0.f, 0.f, 0.f, 0.f};
#pragma unroll
        for (int j = 0; j < 8; ++j) { a[j][0] = *(const bf16x8*)(ap + 32 * j); a[j][1] = *(const bf16x8*)(ap + (size_t)16 * DMIX + 32 * j); b[j] = *(const bf16x8*)(bp + 32 * j); }
        if (w < 2) {
#pragma unroll
            for (int r = 0; r < 4; ++r) xr[r] = xs[(size_t)(rb * 32 + 16 * w + 4 * lq + r) * DM + cb * 16 + l15]; }
        f32x4 acc[2] = {(f32x4){0.f, 0.f, 0.f, 0.f}, (f32x4){0.f, 0.f, 0.f, 0.f}};
#pragma unroll
        for (int j = 0; j < 8; ++j)
#pragma unroll
            for (int m = 0; m < 2; ++m) acc[m] = __builtin_amdgcn_mfma_f32_16x16x32_bf16(a[j][m], b[j], acc[m], 0, 0, 0);
        __syncthreads();
        red[(w * 2 + 0) * 64 + F.lane] = acc[0]; red[(w * 2 + 1) * 64 + F.lane] = acc[1];
        __syncthreads();
        if (w < 2) { f32x4 s = red[(0 * 2 + w) * 64 + F.lane];
#pragma unroll
            for (int ww = 1; ww < 8; ++ww) s = s + red[(ww * 2 + w) * 64 + F.lane];
#pragma unroll
            for (int r = 0; r < 4; ++r) X1B[(size_t)(rb * 32 + 16 * w + 4 * lq + r) * DM + cb * 16 + l15] = f2bf(xr[r] + s[r]); }
    }
    __syncthreads();
}
__device__ __forceinline__ void sample_ple_ks(const Ctx& F) {
    unsigned char* ws = F.ws; const bf16_t* X1B = (const bf16_t*)(ws + WS_X1B) + (size_t)MP * DM; const bf16_t* PBs = (const bf16_t*)(ws + WS_PB) + (size_t)MP * DPLE;
    const bf16_t* WG = (const bf16_t*)(ws + WS_WPG); const bf16_t* WP = (const bf16_t*)(ws + WS_WPP); const float* bias = F.in[25];
    bf16_t* GB = (bf16_t*)(ws + WS_GB) + (size_t)MP * DM; bf16_t* EB = (bf16_t*)(ws + WS_EB) + (size_t)MP * DM;
    sample_gemm_ks(F, 64, DM, DM, DM,
        [=](int item, const bf16_t*& A, const bf16_t*& B) { A = X1B + (size_t)(item & 3) * 32 * DM; B = WG + (size_t)(item >> 2) * 64 * DM; },
        [=](int item, int r, int c, float acc) { const int row = (item & 3) * 32 + r, col = (item >> 2) * 64 + c; GB[(size_t)row * DM + col] = f2bf(sigmoidf_(acc + bias[col])); });
    sample_gemm_ks(F, 64, DPLE, DPLE, DPLE,
        [=](int item, const bf16_t*& A, const bf16_t*& B) { A = PBs + (size_t)(item & 3) * 32 * DPLE; B = WP + (size_t)(item >> 2) * 64 * DPLE; },
        [=](int item, int r, int c, float acc) { const int row = (item & 3) * 32 + r, col = (item >> 2) * 64 + c; EB[(size_t)row * DM + col] = f2bf(acc); });
}
#define XB_TMO      128
#define XB_XCNT(j)  (256  + 64 * (j))
#define XB_XSUB(j)  (1280 + 64 * (j))
#define XB_XGEN(j)  (2304 + 64 * (j))
#define XB_TOP      3328
#define XB_TOPGEN   3392
#define XCD_BAR_WORDS 3456
#define XB_SPIN_CAP (1u << 18)
__device__ __forceinline__ unsigned xb_ld(unsigned* p)              { return __hip_atomic_load(p, __ATOMIC_RELAXED, __HIP_MEMORY_SCOPE_AGENT); }
__device__ __forceinline__ unsigned xb_add(unsigned* p, unsigned v) { return __hip_atomic_fetch_add(p, v, __ATOMIC_RELAXED, __HIP_MEMORY_SCOPE_AGENT); }
__device__ __forceinline__ unsigned xb_xcc_id() { return (unsigned)__builtin_amdgcn_s_getreg((3 << 11) | 20) & 0xFu; }
#define XB_SPIN(cond, bar) do { unsigned _sp = 0; while (cond) { __builtin_amdgcn_s_sleep(1); \
    if ((++_sp & 255u) == 0u) { if (xb_ld(&(bar)[XB_TMO])) break; if (_sp > XB_SPIN_CAP) { atomicAdd(&(bar)[XB_TMO], 1u); break; } } } } while (0)
struct XcdBarrier { unsigned* bar; unsigned x; volatile LAS unsigned* st; };
__device__ __forceinline__ XcdBarrier xcd_barrier_post(unsigned* bar, volatile LAS unsigned* st) {
    XcdBarrier b; b.bar = bar; b.x = xb_xcc_id(); b.st = st;
    if (threadIdx.x == 0) (void)xb_add(&bar[XB_XCNT(b.x)], 1u);
    return b;
}
__device__ __forceinline__ void xcd_barrier_complete(unsigned* bar, unsigned x, unsigned& nloc, unsigned& nx) {
    const unsigned G = gridDim.x * gridDim.y * gridDim.z;
    unsigned sum, cnt, mine, sp = 0u;
    for (;;) {
        sum = 0u; cnt = 0u; mine = 0u;
#pragma unroll
        for (unsigned j = 0; j < 16; ++j) { const unsigned c = xb_ld(&bar[XB_XCNT(j)]); sum += c; cnt += (c > 0u) ? 1u : 0u; mine = (j == x) ? c : mine; }
        if (sum == G) break;
        __builtin_amdgcn_s_sleep(1);
        if ((++sp & 255u) == 0u) { if (xb_ld(&bar[XB_TMO])) break; if (sp > XB_SPIN_CAP) { atomicAdd(&bar[XB_TMO], 1u); break; } }
    }
    nloc = mine > 0u ? mine : 1u; nx = cnt > 0u ? cnt : 1u;
}
__device__ __forceinline__ void xcd_barrier(const XcdBarrier& b) {
    asm volatile("s_waitcnt vmcnt(0)" ::: "memory");
    __syncthreads();
    if (threadIdx.x == 0) {
        unsigned* bar = b.bar;
        __builtin_amdgcn_s_waitcnt(0);
        unsigned nloc = b.st[0], nx = b.st[1];
        if (nloc == 0u) { xcd_barrier_complete(bar, b.x, nloc, nx); b.st[0] = nloc; b.st[1] = nx; }
        const unsigned old = xb_add(&bar[XB_XSUB(b.x)], 1u);
        const unsigned gen = old / nloc;
        if (old + 1u == (gen + 1u) * nloc) {
            __builtin_amdgcn_fence(__ATOMIC_RELEASE, "agent");
            asm volatile("s_waitcnt vmcnt(0)" ::: "memory");
            const unsigned og = xb_add(&bar[XB_TOP], 1u);
            const unsigned tg = og / nx;
            if (og + 1u == (tg + 1u) * nx) xb_add(&bar[XB_TOPGEN], 1u);
            else XB_SPIN(xb_ld(&bar[XB_TOPGEN]) == tg, bar);
            __builtin_amdgcn_fence(__ATOMIC_ACQUIRE, "agent");
            xb_add(&bar[XB_XGEN(b.x)], 1u);
            asm volatile("s_waitcnt vmcnt(0)" ::: "memory");
        } else {
            XB_SPIN(xb_ld(&bar[XB_XGEN(b.x)]) == gen, bar);
            __builtin_amdgcn_fence(__ATOMIC_ACQUIRE, "agent");
            asm volatile("s_waitcnt vmcnt(0)" ::: "memory");
        }
    }
    __syncthreads();
}
__global__ void __launch_bounds__(512, 2) mega(Args args) {
    MAKE_CTX();
    volatile LAS unsigned* MISC = (volatile LAS unsigned*)(F.lds + 131072 + 320);
    if (F.tid < 32) MISC[F.tid] = 0u;
    __syncthreads();
    const XcdBarrier bar = xcd_barrier_post((unsigned*)(ws + WS_CTL), MISC + 8);
#define GRID_SYNC() xcd_barrier(bar)
    p0_prologue(F);      GRID_SYNC();
    sample_inproj(F); p1_inproj(F); GRID_SYNC();
    p2a_conv_gates(F); p2b_spatial_units(F); GRID_SYNC();
    p2b_mscan(F); p3_s12(F); p2c_sample_rows(F); GRID_SYNC();
    p3_qkv(F);           GRID_SYNC();
    if (F.bid & 1) { p5s_sample(F, 0); p4_scores(F); p5s_sample(F, 1); p4_dc(F); } else { p4_scores(F); p5s_sample(F, 0); p4_dc(F); p5s_sample(F, 1); } GRID_SYNC();
    p5_scan_sample(F);   GRID_SYNC();
    p6_hout(F);          GRID_SYNC();
    sample_outproj_ks(F); p7_outproj(F); GRID_SYNC();
    p8_ple(F);           GRID_SYNC();
    p9_final(F);
}

extern "C" void kernel_launch(void* const* d_in, const int* in_sizes, int n_in, void* d_out, int out_size, void* d_ws, size_t ws_size, hipStream_t stream) {
    static int grid = 0;
    if (grid == 0) {
        if (n_in != 29 || (size_t)out_size != O_END || ws_size < WS_END) { fprintf(stderr, "kernel_launch: unexpected shapes (n_in %d out %d ws %zu)\n", n_in, out_size, ws_size); grid = -1; return; }
        int dev = 0, cus = 0, per_cu = 0;
        if (hipGetDevice(&dev) != hipSuccess || hipDeviceGetAttribute(&cus, hipDeviceAttributeMultiprocessorCount, dev) != hipSuccess) { grid = -1; return; }
        if (hipFuncSetAttribute((const void*)mega, hipFuncAttributeMaxDynamicSharedMemorySize, LDS_BYTES) != hipSuccess) { fprintf(stderr, "kernel_launch: hipFuncSetAttribute failed\n"); grid = -1; return; }
        if (hipOccupancyMaxActiveBlocksPerMultiprocessor(&per_cu, (const void*)mega, 512, LDS_BYTES) != hipSuccess || per_cu < 1) { fprintf(stderr, "kernel_launch: occupancy query says %d\n", per_cu); grid = -1; return; }
        (void)hipGetLastError();
        grid = cus;
        if (grid != 256) { fprintf(stderr, "kernel_launch: this kernel is laid out for 256 CUs, got %d\n", grid); grid = -1; return; }
    }
    if (grid < 0) return;
    if (hipMemsetAsync((unsigned char*)d_ws + WS_CTL, 0, 16384, stream) != hipSuccess) { fprintf(stderr, "kernel_launch: memset failed\n"); return; }
    Args a{};
    for (int i = 0; i < 29; ++i) a.in[i] = (const float*)d_in[i];
    a.out = (float*)d_out; a.ws = (unsigned char*)d_ws;
    void* kargs[] = {&a};
    hipError_t e = hipLaunchCooperativeKernel((const void*)mega, dim3(grid), dim3(512), kargs, LDS_BYTES, stream);
    if (e != hipSuccess) fprintf(stderr, "kernel_launch: cooperative launch failed: %s (grid %d)\n", hipGetErrorString(e), grid);
}
```

```cpp
#include <hip/hip_runtime.h>
#include <hip/hip_cooperative_groups.h>
#include <cstdio>
#include <cstdint>
namespace cg = cooperative_groups;

#define LAS __attribute__((address_space(3)))
typedef unsigned short bf16_t;
typedef short bf16x8 __attribute__((ext_vector_type(8)));
typedef float f32x4 __attribute__((ext_vector_type(4)));
typedef float f32x2 __attribute__((ext_vector_type(2)));
typedef unsigned u32x4 __attribute__((ext_vector_type(4)));
typedef unsigned u32x2 __attribute__((ext_vector_type(2)));

constexpr int DM = 1024, SEQ = 2048, NB = 8, MP = NB * SEQ, MS = 128, MA = MP + 256, NTILE = MA / 256;
constexpr int NIN = 6144, WA = 1024, WB = 1024, HA = 8, DHA = 128, HB = 4, DHB = 256, DPLE = 256, DMIX = 2048;
constexpr int LC = 256, NCH = SEQ / LC;
constexpr int NUNIT = NB * HB * NCH;
constexpr float EPS = 1e-6f;

constexpr size_t O_Y = 0, O_YS = 16777216, O_CP = 16908288, O_NP = 19005440, O_MP = 19013632, O_CVP = 19013664, O_CS = 19038240, O_NS = 52592672, O_MS = 52723744, O_CVS = 52724256, O_VS = 53117472, O_END = 53248544;

constexpr size_t MiB = 1u << 20;
constexpr size_t WS_CTL = 0, WS_WIN = 1 * MiB, WS_WQ = 13 * MiB, WS_WK = WS_WQ + MiB / 2, WS_WV = 14 * MiB, WS_WOUT = WS_WV + MiB / 2, WS_WPG = WS_WOUT + 4 * MiB, WS_WPP = WS_WPG + 2 * MiB,
    WS_WSP = 21 * MiB, WS_WG = WS_WSP + MiB / 4, WS_RS = WS_WG + MiB / 4, WS_GLI = 22 * MiB, WS_GLF = WS_GLI + MiB / 2, WS_DA = 23 * MiB, WS_DR = WS_DA + MiB / 2, WS_DG = 24 * MiB, WS_DEM = WS_DG + MiB / 2,
    WS_DW = 25 * MiB, WS_QN = WS_DW + MiB / 2, WS_DENP = 26 * MiB, WS_DN = 27 * MiB, WS_VS = WS_DN + MiB / 2, WS_PB = 28 * MiB, WS_XB = 37 * MiB, WS_PROJA = 70 * MiB, WS_PROJB = 168 * MiB,
    WS_PQ = 266 * MiB, WS_VC = 330 * MiB, WS_Y = 394 * MiB, WS_XB2 = 460 * MiB, WS_DN4 = 493 * MiB, WS_END = 495 * MiB;
constexpr size_t WS_WGB = WS_RS + MiB / 8;
constexpr size_t WS_Q = WS_PROJA, WS_K = WS_Q + 33 * MiB, WS_WKT = WS_K + 33 * MiB;
constexpr size_t WS_X1B = WS_PROJA, WS_GB = WS_X1B + 33 * MiB, WS_EB = WS_GB + 33 * MiB;
static_assert(WS_WKT + 32 * MiB <= WS_PROJB && WS_EB + 33 * MiB <= WS_PQ, "ws map");

__device__ __forceinline__ unsigned cvt_pk_bf16(float lo, float hi) { unsigned r; asm volatile("v_cvt_pk_bf16_f32 %0, %1, %2" : "=v"(r) : "v"(lo), "v"(hi)); return r; }
__device__ __forceinline__ float bf_lo(unsigned w) { return __uint_as_float(w << 16); }
__device__ __forceinline__ float bf_hi(unsigned w) { return __uint_as_float(w & 0xffff0000u); }
__device__ __forceinline__ float bf2f(bf16_t b) { return __uint_as_float(((unsigned)b) << 16); }
__device__ __forceinline__ bf16_t f2bf(float f) { return (bf16_t)(cvt_pk_bf16(f, 0.f) & 0xffffu); }
__device__ __forceinline__ float fast_exp(float x) { return __builtin_amdgcn_exp2f(x * 1.4426950408889634f); }
__device__ __forceinline__ float sigmoidf_(float x) { return __builtin_amdgcn_rcpf(1.0f + fast_exp(-x)); }
__device__ __forceinline__ float siluf_(float x) { return x * sigmoidf_(x); }
__device__ __forceinline__ f32x2 gelu_pk(f32x2 v) {
    const f32x2 av = __builtin_elementwise_abs(v), d = av * 0.2316418882f + 1.0f;
    f32x2 t; t.x = __builtin_amdgcn_rcpf(d.x); t.y = __builtin_amdgcn_rcpf(d.y);
    f32x2 q = t * 0.5307027145f + (-0.7265760135f); q = q * t + 0.7107068705f; q = q * t + (-0.142248368f); q = q * t + 0.127414796f; q = q * t;
    const f32x2 s = (v * v) * (-0.72134752044f);
    f32x2 e; e.x = __builtin_amdgcn_exp2f(s.x); e.y = __builtin_amdgcn_exp2f(s.y);
    const f32x2 m = v * (q * e), r = v - m;
    f32x2 o; o.x = v.x < 0.f ? m.x : r.x; o.y = v.y < 0.f ? m.y : r.y; return o;
}
__device__ __forceinline__ float dpp_add(float v, const int ctrl_sel) {
    const int iv = __builtin_bit_cast(int, v); int r;
    if (ctrl_sel == 0) r = __builtin_amdgcn_update_dpp(0, iv, 0xB1, 0xF, 0xF, true);
    else if (ctrl_sel == 1) r = __builtin_amdgcn_update_dpp(0, iv, 0x4E, 0xF, 0xF, true);
    else if (ctrl_sel == 2) r = __builtin_amdgcn_update_dpp(0, iv, 0x141, 0xF, 0xF, true);
    else r = __builtin_amdgcn_update_dpp(0, iv, 0x140, 0xF, 0xF, true);
    return v + __builtin_bit_cast(float, r);
}
__device__ __forceinline__ float wave_sum(float v) {
    v = dpp_add(v, 0); v = dpp_add(v, 1); v = dpp_add(v, 2); v = dpp_add(v, 3);
    const int iv = __builtin_bit_cast(int, v);
    const float r0 = __builtin_bit_cast(float, __builtin_amdgcn_readlane(iv, 0)), r1 = __builtin_bit_cast(float, __builtin_amdgcn_readlane(iv, 16)),
                r2 = __builtin_bit_cast(float, __builtin_amdgcn_readlane(iv, 32)), r3 = __builtin_bit_cast(float, __builtin_amdgcn_readlane(iv, 48));
    return (r0 + r1) + (r2 + r3);
}
__device__ __forceinline__ u32x4 lane_row_pair(const u32x2 w0, const u32x2 w1) {
    const auto sx = __builtin_amdgcn_permlane16_swap(w0.x, w1.x, false, false), sy = __builtin_amdgcn_permlane16_swap(w0.y, w1.y, false, false);
    u32x4 o; o.x = sx[0]; o.y = sy[0]; o.z = sx[1]; o.w = sy[1]; return o; }
__device__ __forceinline__ int lane_row_col(int fq) { return (fq & 1) ? 16 + 4 * (fq - 1) : 4 * fq; }
#define LDS_WAIT() asm volatile("s_waitcnt lgkmcnt(0)" ::: "memory")

namespace pg8 {
constexpr int BM = 256, BK = 64, HALF = 128, HTB = HALF * BK * 2, STAGE_BYTES = 8 * HTB;
__host__ __device__ __forceinline__ int lds_byte(int r, int c) { const int st = (r >> 4) * 2 + (c >> 5), rr = r & 15, cc = c & 31, ob = rr * 64 + cc * 2; return st * 1024 + (ob ^ (((ob >> 9) & 1) << 5)); }
__host__ __device__ __forceinline__ void stage_rc(int b, int& R, int& C) { const int st = b / 1024, sb = b % 1024, swz = sb ^ (((sb >> 9) & 1) << 5); R = (st >> 1) * 16 + swz / 64; C = (st & 1) * 32 + (swz % 64) / 2; }
__host__ __device__ __forceinline__ int perm32(int rho) { const int n = rho >> 4, i = rho & 15; return 8 * (i >> 2) + 4 * n + (i & 3); }

struct Unit { const char* a; const char* b; int pm, pn, aux; };
struct Gemm { int lda, ldb, K; };

template <class Epi, class Sched, bool ALIGN_EPI = true, bool SP2 = true>
__device__ __forceinline__ void gemm_phase(LAS unsigned char* lds, const Gemm g, const Sched& S, const Epi& E) {
    int tid_ = threadIdx.x; asm volatile("" : "+v"(tid_));
    const int tid = tid_, wid = __builtin_amdgcn_readfirstlane(tid >> 6), lane = tid & 63, wr = wid >> 2, wc = wid & 3, fr = lane & 15, fq = lane >> 4;
    int K_ = g.K; asm volatile("" : "+s"(K_)); const int K = K_, nt = K / BK; (void)K;
    unsigned voffA[2], voffB[2];
#pragma unroll
    for (int i = 0; i < 2; ++i) { int R, C; stage_rc(tid * 16 + i * 8192, R, C); const int Rb = Epi::PERM ? ((R & ~31) + perm32(R & 31)) : R;
        voffA[i] = (unsigned)(R * g.lda + C) * 2u; voffB[i] = (unsigned)(Rb * g.ldb + C) * 2u; }
    const size_t kstep = (size_t)(BK * 2);
    const size_t hstepA = (size_t)HALF * g.lda * 2, hstepB = (size_t)HALF * g.ldb * 2;
    const unsigned ldsw = (unsigned)wid * 1024u;
    const int aoff = lds_byte(wr * 64 + fr, fq * 8), boff = lds_byte(wc * 32 + fr, fq * 8);
#define PG8_SA(b, h) (((b) * 2 + (h)) * HTB)
#define PG8_SB(b, h) ((4 + (b) * 2 + (h)) * HTB)
#define PG8_STAGE(bufoff, gbase, voff) do { _Pragma("unroll") for (int _i = 0; _i < 2; ++_i) \
        __builtin_amdgcn_global_load_lds((const unsigned*)((const char*)(gbase) + (voff)[_i]), (LAS unsigned*)(lds + (bufoff) + ldsw + _i * 8192), 16, 0, 0); } while (0)
#define PG8_LDA(dst, b, h) do { _Pragma("unroll") for (int m = 0; m < 4; ++m) _Pragma("unroll") for (int k = 0; k < 2; ++k) dst[m][k] = *(const LAS bf16x8*)(lds + PG8_SA(b, h) + aoff + m * 2048 + k * 1024); } while (0)
#define PG8_LDB(dst, b, h) do { _Pragma("unroll") for (int n = 0; n < 2; ++n) _Pragma("unroll") for (int k = 0; k < 2; ++k) dst[n][k] = *(const LAS bf16x8*)(lds + PG8_SB(b, h) + boff + n * 2048 + k * 1024); } while (0)
#define PG8_MMA(ai, bj, At, Bt) do { __builtin_amdgcn_s_setprio(1); _Pragma("unroll") for (int m = 0; m < 4; ++m) _Pragma("unroll") for (int n = 0; n < 2; ++n) _Pragma("unroll") for (int k = 0; k < 2; ++k) \
        acc[ai][bj][m][n] = __builtin_amdgcn_mfma_f32_16x16x32_bf16(Bt[n][k], At[m][k], acc[ai][bj][m][n], 0, 0, 0); __builtin_amdgcn_s_setprio(0); } while (0)
#define PG8_WAIT_V(n) asm volatile("s_waitcnt vmcnt(" #n ")" ::: "memory")
#define PG8_WAIT_L(n) asm volatile("s_waitcnt lgkmcnt(" #n ")" ::: "memory")
#define PG8_BAR __builtin_amdgcn_s_barrier()
#define PG8_SCHED __builtin_amdgcn_sched_barrier(0)
    Unit cur, nxt; int ui = 0;
    if (!S.next(0, cur)) return;
    f32x4 acc[2][2][4][2];
#pragma unroll
    for (int a = 0; a < 2; ++a)
#pragma unroll
        for (int b = 0; b < 2; ++b)
#pragma unroll
            for (int m = 0; m < 4; ++m)
#pragma unroll
                for (int n = 0; n < 2; ++n) acc[a][b][m][n] = (f32x4){0.f, 0.f, 0.f, 0.f};
    bf16x8 At[4][2], B0[2][2], B1[2][2];
    const char* cA = cur.a; const char* cB = cur.b;
    if constexpr (SP2) {
        PG8_STAGE(PG8_SB(0, 0), cB, voffB); PG8_STAGE(PG8_SB(0, 1), cB + hstepB, voffB); PG8_STAGE(PG8_SA(0, 0), cA, voffA); PG8_STAGE(PG8_SA(0, 1), cA + hstepA, voffA);
        if (wr == 1) PG8_BAR;
        PG8_WAIT_V(2); PG8_BAR;
        PG8_STAGE(PG8_SB(1, 0), cB + kstep, voffB); PG8_STAGE(PG8_SA(1, 0), cA + kstep, voffA); PG8_STAGE(PG8_SB(1, 1), cB + hstepB + kstep, voffB);
        PG8_WAIT_V(6); PG8_BAR;
    } else {
        PG8_STAGE(PG8_SB(0, 0), cB, voffB); PG8_STAGE(PG8_SA(0, 0), cA, voffA); PG8_STAGE(PG8_SB(0, 1), cB + hstepB, voffB); PG8_STAGE(PG8_SA(0, 1), cA + hstepA, voffA);
        if (wr == 1) PG8_BAR;
        PG8_WAIT_V(4); PG8_BAR;
        PG8_STAGE(PG8_SB(1, 0), cB + kstep, voffB); PG8_STAGE(PG8_SA(1, 0), cA + kstep, voffA); PG8_STAGE(PG8_SB(1, 1), cB + hstepB + kstep, voffB);
        PG8_WAIT_V(6); PG8_BAR;
    }
    for (;;) {
        const bool has_next = S.next(ui + 1, nxt);
        const char* nA = has_next ? nxt.a : cA; const char* nB = has_next ? nxt.b : cB;
#pragma unroll 1
        for (int t = 0; t < nt; t += 2) {
            const bool last = (t == nt - 2);
            const char* a1 = cA + (size_t)(t + 1) * kstep;
            const char* a2 = last ? nA : cA + (size_t)(t + 2) * kstep; const char* b2 = last ? nB : cB + (size_t)(t + 2) * kstep;
            const char* a3 = a2 + kstep; const char* b3 = b2 + kstep;
            if constexpr (SP2) {
            PG8_LDB(B0, 0, 0); PG8_LDB(B1, 0, 1); PG8_SCHED; PG8_LDA(At, 0, 0); PG8_STAGE(PG8_SA(1, 1), a1 + hstepA, voffA);
            PG8_WAIT_V(8); PG8_WAIT_L(0); PG8_BAR; PG8_MMA(0, 0, At, B0); PG8_MMA(0, 1, At, B1); PG8_BAR; PG8_SCHED;
            PG8_LDA(At, 0, 1); PG8_STAGE(PG8_SB(0, 0), b2, voffB); PG8_STAGE(PG8_SB(0, 1), b2 + hstepB, voffB); PG8_STAGE(PG8_SA(0, 0), a2, voffA);
            PG8_WAIT_V(8); PG8_WAIT_L(0); PG8_BAR; PG8_MMA(1, 0, At, B0); PG8_MMA(1, 1, At, B1); PG8_BAR; PG8_SCHED;
            PG8_LDB(B0, 1, 0); PG8_LDB(B1, 1, 1); PG8_SCHED; PG8_LDA(At, 1, 0); PG8_STAGE(PG8_SA(0, 1), a2 + hstepA, voffA);
            PG8_WAIT_V(8); PG8_WAIT_L(0); PG8_BAR; PG8_MMA(0, 0, At, B0); PG8_MMA(0, 1, At, B1); PG8_BAR; PG8_SCHED;
            PG8_LDA(At, 1, 1); PG8_STAGE(PG8_SB(1, 0), b3, voffB); PG8_STAGE(PG8_SB(1, 1), b3 + hstepB, voffB); PG8_STAGE(PG8_SA(1, 0), a3, voffA);
            PG8_WAIT_V(8); PG8_WAIT_L(0); PG8_BAR; PG8_MMA(1, 0, At, B0); PG8_MMA(1, 1, At, B1); PG8_BAR; PG8_SCHED;
            } else {
            PG8_LDB(B0, 0, 0); PG8_SCHED; PG8_LDA(At, 0, 0); PG8_STAGE(PG8_SA(1, 1), a1 + hstepA, voffA);
            PG8_WAIT_L(8); PG8_BAR; PG8_WAIT_L(0); PG8_MMA(0, 0, At, B0); PG8_BAR; PG8_SCHED;
            PG8_LDB(B1, 0, 1); PG8_STAGE(PG8_SB(0, 0), b2, voffB);
            PG8_BAR; PG8_WAIT_L(0); PG8_MMA(0, 1, At, B1); PG8_BAR;
            PG8_LDA(At, 0, 1); PG8_STAGE(PG8_SA(0, 0), a2, voffA);
            PG8_BAR; PG8_WAIT_L(0); PG8_MMA(1, 0, At, B0); PG8_BAR; PG8_SCHED;
            PG8_STAGE(PG8_SB(0, 1), b2 + hstepB, voffB);
            PG8_WAIT_V(6); PG8_BAR; PG8_MMA(1, 1, At, B1); PG8_BAR;
            PG8_LDB(B0, 1, 0); PG8_SCHED; PG8_LDA(At, 1, 0); PG8_STAGE(PG8_SA(0, 1), a2 + hstepA, voffA);
            PG8_WAIT_L(8); PG8_BAR; PG8_WAIT_L(0); PG8_MMA(0, 0, At, B0); PG8_BAR; PG8_SCHED;
            PG8_LDB(B1, 1, 1); PG8_STAGE(PG8_SB(1, 0), b3, voffB);
            PG8_BAR; PG8_WAIT_L(0); PG8_MMA(0, 1, At, B1); PG8_BAR;
            PG8_LDA(At, 1, 1); PG8_STAGE(PG8_SA(1, 0), a3, voffA);
            PG8_BAR; PG8_WAIT_L(0); PG8_MMA(1, 0, At, B0); PG8_BAR; PG8_SCHED;
            PG8_STAGE(PG8_SB(1, 1), b3 + hstepB, voffB);
            PG8_WAIT_V(6); PG8_BAR; PG8_MMA(1, 1, At, B1); PG8_BAR;
            }
        }
        if constexpr (ALIGN_EPI) { if (wr == 0) PG8_BAR; }
        if constexpr (!Epi::AFTER_DRAIN) { E(acc, cur, wr, wc, fr, fq); }
        if (!has_next) break;
#pragma unroll
        for (int a = 0; a < 2; ++a)
#pragma unroll
            for (int b = 0; b < 2; ++b)
#pragma unroll
                for (int m = 0; m < 4; ++m)
#pragma unroll
                    for (int n = 0; n < 2; ++n) acc[a][b][m][n] = (f32x4){0.f, 0.f, 0.f, 0.f};
        cur = nxt; cA = nA; cB = nB; ++ui;
        if constexpr (ALIGN_EPI) { if (wr == 1) PG8_BAR; }
    }
    PG8_WAIT_V(0);
    if constexpr (!ALIGN_EPI) { if (wr == 0) PG8_BAR; }
    PG8_BAR;
    if constexpr (Epi::AFTER_DRAIN) { E.fused(acc, cur, wr, wc, fr, fq, lds, wid, lane); }
#undef PG8_SA
#undef PG8_SB
#undef PG8_STAGE
#undef PG8_LDA
#undef PG8_LDB
#undef PG8_MMA
#undef PG8_WAIT_V
#undef PG8_WAIT_L
#undef PG8_BAR
#undef PG8_SCHED
}
}
using pg8::Unit; using pg8::Gemm;

constexpr int LDS_BYTES = 147456;
struct Args { const float* in[29]; float* out; unsigned char* ws; };

struct Ctx {
    LAS unsigned char* lds; int tid, lane, wave, G, bid, gw, NGW;
    const float* const* in; float* out; unsigned char* ws;
};

struct TDesc { const float* W; bf16_t* WT; const float* ksc; int ldw, ldt, k0, n0; };
constexpr int I_WIN = 16 * 192, I_QKV = 12 * 4 * 8, I_WOUT = 32 * 32, I_WPG = 16 * 32, I_WPP = 4 * 32, I_T = I_WIN + I_QKV + I_WOUT + I_WPG + I_WPP;
__device__ __forceinline__ TDesc p0_decode(const Ctx& F, int r) {
    unsigned char* ws = F.ws; TDesc d; d.ksc = nullptr;
    if (r < I_WIN) { d.W = F.in[9]; d.ldw = NIN; d.WT = (bf16_t*)(ws + WS_WIN); d.ldt = DM; d.ksc = F.in[8]; d.k0 = 64 * (r / 192); d.n0 = 32 * (r % 192); return d; } r -= I_WIN;
    if (r < I_QKV) { const int mat = r / 32, rr = r % 32, which = mat / 4, h = mat % 4;
        d.W = F.in[16 + which] + (size_t)h * 65536; d.WT = (bf16_t*)(ws + (which == 0 ? WS_WQ : which == 1 ? WS_WK : WS_WV)) + (size_t)h * 65536; d.ldw = 256; d.ldt = 256; d.k0 = 64 * (rr / 8); d.n0 = 32 * (rr % 8); return d; } r -= I_QKV;
    if (r < I_WOUT) { d.W = F.in[23]; d.ldw = DM; d.WT = (bf16_t*)(ws + WS_WOUT); d.ldt = DMIX; d.k0 = 64 * (r / 32); d.n0 = 32 * (r % 32); return d; } r -= I_WOUT;
    if (r < I_WPG) { d.W = F.in[24]; d.ldw = DM; d.WT = (bf16_t*)(ws + WS_WPG); d.ldt = DM; d.k0 = 64 * (r / 32); d.n0 = 32 * (r % 32); return d; } r -= I_WPG;
    d.W = F.in[26]; d.ldw = DM; d.WT = (bf16_t*)(ws + WS_WPP); d.ldt = DPLE; d.k0 = 64 * (r / 32); d.n0 = 32 * (r % 32); return d;
}

__device__ __forceinline__ void p0_prologue(const Ctx& F0) { Ctx F = F0; asm volatile("" : "+v"(F.tid), "+v"(F.lane), "+s"(F.gw));
    LAS float* scr = (LAS float*)(F.lds + F.wave * 16384);
    unsigned char* ws = F.ws; const int lane = F.lane;
    {
        float wv[3][32]; f32x4 ks[3][2]; TDesc td[3];
#pragma unroll
        for (int k = 0; k < 3; ++k) { const int it = F.gw + k * F.NGW;
            if (it < I_T) { td[k] = p0_decode(F, it); const int c = lane & 7;
#pragma unroll
                for (int i = 0; i < 32; ++i) { const int kk = 2 * i + (lane >> 5); wv[k][i] = __builtin_nontemporal_load(td[k].W + (size_t)(td[k].k0 + kk) * td[k].ldw + td[k].n0 + (lane & 31)); }
                if (td[k].ksc) { ks[k][0] = *(const f32x4*)(td[k].ksc + td[k].k0 + 8 * c); ks[k][1] = *(const f32x4*)(td[k].ksc + td[k].k0 + 8 * c + 4); }
                else { ks[k][0] = (f32x4){1.f, 1.f, 1.f, 1.f}; ks[k][1] = ks[k][0]; } } }
#pragma unroll
        for (int k = 0; k < 3; ++k) { const int it = F.gw + k * F.NGW;
            if (it < I_T) { const int c = lane & 7;
#pragma unroll
                for (int i = 0; i < 32; ++i) { const int kk = 2 * i + (lane >> 5); scr[kk * 33 + (lane & 31)] = wv[k][i]; }
                LDS_WAIT(); asm volatile("" ::: "memory");
#pragma unroll
                for (int j = 0; j < 4; ++j) { const int n = (lane >> 3) + 8 * j; const LAS float* s = scr + (8 * c) * 33 + n;
                    u32x4 o; o.x = cvt_pk_bf16(s[0 * 33] * ks[k][0][0], s[1 * 33] * ks[k][0][1]); o.y = cvt_pk_bf16(s[2 * 33] * ks[k][0][2], s[3 * 33] * ks[k][0][3]);
                    o.z = cvt_pk_bf16(s[4 * 33] * ks[k][1][0], s[5 * 33] * ks[k][1][1]); o.w = cvt_pk_bf16(s[6 * 33] * ks[k][1][2], s[7 * 33] * ks[k][1][3]);
                    *(u32x4*)(td[k].WT + (size_t)(td[k].n0 + n) * td[k].ldt + td[k].k0 + 8 * c) = o; }
                LDS_WAIT(); asm volatile("" ::: "memory"); } }
    }
    constexpr int I_SP = 1024, I_WG = 1024, I_YPAD = 128;
    for (int r = F.gw; r < I_SP + I_WG + I_YPAD; r += F.NGW) {
        if (r < I_SP) {
            const int t = r & 127; const float* wrow = F.in[12] + (size_t)r * 128; const f32x2 v = ((const f32x2*)wrow)[lane];
            const int s0 = 2 * lane; ((unsigned*)((bf16_t*)(ws + WS_WSP) + (size_t)r * 128))[lane] = cvt_pk_bf16(s0 <= t ? v.x : 0.f, s0 + 1 <= t ? v.y : 0.f);
            continue;
        }
        if (r < I_SP + I_WG) {
            const int i = r - I_SP, h = i >> 8, d = i & 255; const float* wif = F.in[19];
            const f32x4 wq4 = *(const f32x4*)(F.in[16] + ((size_t)h * 256 + d) * 256 + 4 * lane), wk4 = *(const f32x4*)(F.in[17] + ((size_t)h * 256 + d) * 256 + 4 * lane), wv4 = *(const f32x4*)(F.in[18] + ((size_t)h * 256 + d) * 256 + 4 * lane);
            float sx[8], sb[8];
#pragma unroll
            for (int j = 0; j < 8; ++j) { sx[j] = 0.f; sb[j] = 0.f; }
#pragma unroll
            for (int e = 0; e < 4; ++e) { const size_t rq = (size_t)(h * 256 + 4 * lane + e) * 8;
                const f32x4 q0 = *(const f32x4*)(wif + rq), q1 = *(const f32x4*)(wif + rq + 4), k0 = *(const f32x4*)(wif + 8192 + rq), k1 = *(const f32x4*)(wif + 8192 + rq + 4), v0 = *(const f32x4*)(wif + 16384 + rq), v1 = *(const f32x4*)(wif + 16384 + rq + 4);
#pragma unroll
                for (int j = 0; j < 4; ++j) { sx[j] += wq4[e] * q0[j] + wk4[e] * k0[j]; sx[4 + j] += wq4[e] * q1[j] + wk4[e] * k1[j]; sb[j] += wv4[e] * v0[j]; sb[4 + j] += wv4[e] * v1[j]; } }
#pragma unroll
            for (int j = 0; j < 8; ++j) { sx[j] = wave_sum(sx[j]); sb[j] = wave_sum(sb[j]); }
            float s = 0.f;
#pragma unroll
            for (int j = 0; j < 8; ++j) { s = (lane == j) ? sx[j] : s; s = (lane == 8 + j) ? sb[j] : s; }
            if (lane < 16) ((float*)(ws + WS_WG))[(size_t)i * 16 + lane] = s;
            if (lane < 16) { bf16_t* wgb = (bf16_t*)(ws + WS_WGB) + (size_t)(lane >> 3) * 16384 + (size_t)(lane & 7) * 1024 + i; wgb[0] = f2bf(s); wgb[8 * 1024] = 0; }
            continue;
        }
        {
            u32x4* yrow = (u32x4*)((bf16_t*)(ws + WS_Y) + (size_t)(MP + MS + (r - I_SP - I_WG)) * DMIX) + lane;
#pragma unroll
            for (int j = 0; j < 4; ++j) yrow[64 * j] = (u32x4){0u, 0u, 0u, 0u};
        }
    }
    {
        float* rs = (float*)(ws + WS_RS);
        const int r0 = F.gw * 8; const bool smp = F.gw < MS;
        f32x4 v[8][4], vs[4], pv[8], ps;
#pragma unroll
        for (int q = 0; q < 8; ++q) { const float* xrow = F.in[0] + (size_t)(r0 + q) * DM;
#pragma unroll
            for (int j = 0; j < 4; ++j) v[q][j] = __builtin_nontemporal_load((const f32x4*)xrow + lane + 64 * j); }
#pragma unroll
        for (int q = 0; q < 8; ++q) pv[q] = __builtin_nontemporal_load((const f32x4*)(F.in[6] + (size_t)(r0 + q) * DPLE) + lane);
        if (smp) {
#pragma unroll
            for (int j = 0; j < 4; ++j) vs[j] = __builtin_nontemporal_load((const f32x4*)(F.in[1] + (size_t)F.gw * DM) + lane + 64 * j);
            ps = __builtin_nontemporal_load((const f32x4*)(F.in[7] + (size_t)F.gw * DPLE) + lane); }
        auto xrow_out = [&](int r, const f32x4 (&vv)[4]) { float sq = 0.f;
#pragma unroll
            for (int j = 0; j < 4; ++j) sq += (vv[j].x * vv[j].x + vv[j].y * vv[j].y) + (vv[j].z * vv[j].z + vv[j].w * vv[j].w);
            sq = wave_sum(sq); unsigned long long* o8 = (unsigned long long*)((bf16_t*)(ws + WS_XB) + (size_t)r * DM) + lane;
#pragma unroll
            for (int j = 0; j < 4; ++j) o8[64 * j] = (unsigned long long)cvt_pk_bf16(vv[j].x, vv[j].y) | ((unsigned long long)cvt_pk_bf16(vv[j].z, vv[j].w) << 32);
            if (lane == 0) rs[r] = 1.0f / sqrtf(sq * (1.0f / DM) + EPS); };
#pragma unroll
        for (int q = 0; q < 8; ++q) xrow_out(r0 + q, v[q]);
#pragma unroll
        for (int q = 0; q < 8; ++q) ((unsigned long long*)((bf16_t*)(ws + WS_PB) + (size_t)(r0 + q) * DPLE))[lane] = (unsigned long long)cvt_pk_bf16(pv[q].x, pv[q].y) | ((unsigned long long)cvt_pk_bf16(pv[q].z, pv[q].w) << 32);
        if (smp) { xrow_out(MP + F.gw, vs);
            ((unsigned long long*)((bf16_t*)(ws + WS_PB) + (size_t)(MP + F.gw) * DPLE))[lane] = (unsigned long long)cvt_pk_bf16(ps.x, ps.y) | ((unsigned long long)cvt_pk_bf16(ps.z, ps.w) << 32); }
        for (int r = MP + MS + (F.NGW - 1 - F.gw); r < MA; r += F.NGW) { unsigned long long* o8 = (unsigned long long*)((bf16_t*)(ws + WS_XB) + (size_t)r * DM) + lane;
#pragma unroll
            for (int j = 0; j < 4; ++j) o8[64 * j] = 0ull;
            if (lane == 0) rs[r] = 0.f; ((unsigned long long*)((bf16_t*)(ws + WS_PB) + (size_t)r * DPLE))[lane] = 0ull; }
    }
}

struct OrderRowMajor {
    int nM, nN, n, G, c; const char* A; const char* B; size_t astep, bstep;
    __device__ __forceinline__ bool next(int i, Unit& u) const {
        const int L = i * G + c; if (L >= n) return false;
        u.pm = L / nN; u.pn = L % nN; u.aux = 0; u.a = A + (size_t)u.pm * astep; u.b = B + (size_t)u.pn * bstep; return true;
    }
};
struct OrderPanel4 {
    int n, G, c; const char* A; const char* B; size_t astep, bstep;
    __device__ __forceinline__ bool next(int i, Unit& u) const {
        const int L = i * G + c; if (L >= n) return false;
        if (L < 256) { const int x = L & 7, j = L >> 3; u.pm = x * 8 + (j >> 2); u.pn = j & 3; } else { u.pm = 64; u.pn = L - 256; }
        u.aux = 0; u.a = A + (size_t)u.pm * astep; u.b = B + (size_t)u.pn * bstep; return true;
    }
};
struct OrderProjSkip {
    int G, c; const char* A; const char* B; size_t astep, bstep;
    __device__ __forceinline__ bool next(int i, Unit& u) const {
        if (c < 4) return false; const int cp = c - 4; const int L = i == 0 ? cp : (i == 1 && cp < 8 ? 252 + cp : -1); if (L < 0) return false;
        if (L < 256) { const int x = L & 7, j = L >> 3; u.pm = x * 8 + (j >> 2); u.pn = j & 3; } else { u.pm = 64; u.pn = L - 256; }
        u.aux = 0; u.a = A + (size_t)u.pm * astep; u.b = B + (size_t)u.pn * bstep; return true;
    }
};
struct OrderXcd {
    int nM, nN, n, G, c; const char* A; const char* B; size_t astep, bstep;
    __device__ __forceinline__ bool next(int i, Unit& u) const {
        const int L = i * G + c; if (L >= n) return false;
        int wgid = L; { const int q = n / 8, r = n % 8, xcd = wgid % 8, off = wgid / 8; wgid = (xcd < r ? xcd * (q + 1) : r * (q + 1) + (xcd - r) * q) + off; }
        const int nig = 8 * nN, gid = wgid / nig, fm = gid * 8, gsz = (nM - fm) < 8 ? (nM - fm) : 8;
        u.pm = fm + ((wgid % nig) % gsz); u.pn = (wgid % nig) / gsz; u.aux = 0; u.a = A + (size_t)u.pm * astep; u.b = B + (size_t)u.pn * bstep; return true;
    }
};
struct EpiInProj {
    static constexpr bool PERM = true, AFTER_DRAIN = false;
    bf16_t* PA; bf16_t* PB; const float* rs;
    template <int KIND> __device__ __forceinline__ void run(const f32x4 (&acc)[2][2][4][2], bf16_t* base, int row0, int col0) const {
#pragma unroll
        for (int ai = 0; ai < 2; ++ai)
#pragma unroll
            for (int m = 0; m < 4; ++m) { const int row = row0 + ai * 128 + m * 16; const float s = rs[row]; bf16_t* rowp = base + (size_t)row * 3072 + col0;
#pragma unroll
                for (int bj = 0; bj < 2; ++bj) { f32x4 v0 = acc[ai][bj][m][0] * s, v1 = acc[ai][bj][m][1] * s;
                    if (KIND == 0) { f32x2 a = gelu_pk((f32x2){v0[0], v0[1]}), b = gelu_pk((f32x2){v0[2], v0[3]}), c = gelu_pk((f32x2){v1[0], v1[1]}), d = gelu_pk((f32x2){v1[2], v1[3]});
                        v0 = (f32x4){a.x, a.y, b.x, b.y}; v1 = (f32x4){c.x, c.y, d.x, d.y}; }
                    if (KIND == 1) {
#pragma unroll
                        for (int j = 0; j < 4; ++j) { v0[j] = siluf_(v0[j]); v1[j] = siluf_(v1[j]); } }
                    if (KIND == 3) {
#pragma unroll
                        for (int j = 0; j < 4; ++j) { v0[j] = sigmoidf_(v0[j]); v1[j] = sigmoidf_(v1[j]); } }
                    u32x4 w; w.x = cvt_pk_bf16(v0[0], v0[1]); w.y = cvt_pk_bf16(v0[2], v0[3]); w.z = cvt_pk_bf16(v1[0], v1[1]); w.w = cvt_pk_bf16(v1[2], v1[3]);
                    *(u32x4*)(rowp + bj * 128) = w; } }
    }
    __device__ __forceinline__ void operator()(const f32x4 (&acc)[2][2][4][2], const Unit& u, int wr, int wc, int fr, int fq) const {
        const int row0 = u.pm * 256 + wr * 64 + fr, pn = u.pn;
        bf16_t* base = pn < 12 ? PA + pn * 256 : PB + (pn - 12) * 256; const int col0 = wc * 32 + 8 * fq;
        if (pn < 8) run<0>(acc, base, row0, col0);
        else if (pn < 12 || pn >= 20) run<1>(acc, base, row0, col0);
        else if (pn < 16) run<2>(acc, base, row0, col0);
        else run<3>(acc, base, row0, col0);
    }
};

__device__ __forceinline__ float logsigmoidf_(float x) { return fminf(x, 0.f) - log1pf(__expf(-fabsf(x))); }
__device__ __forceinline__ void unpack8(const u32x4 w, float (&f)[8]) { f[0] = bf_lo(w.x); f[1] = bf_hi(w.x); f[2] = bf_lo(w.y); f[3] = bf_hi(w.y); f[4] = bf_lo(w.z); f[5] = bf_hi(w.z); f[6] = bf_lo(w.w); f[7] = bf_hi(w.w); }
__device__ __forceinline__ u32x4 pack8(const float (&f)[8]) { u32x4 w; w.x = cvt_pk_bf16(f[0], f[1]); w.y = cvt_pk_bf16(f[2], f[3]); w.z = cvt_pk_bf16(f[4], f[5]); w.w = cvt_pk_bf16(f[6], f[7]); return w; }

__device__ __forceinline__ void p2a_conv_gates(const Ctx& F0) { Ctx F = F0; asm volatile("" : "+v"(F.tid), "+v"(F.lane), "+s"(F.gw));
    unsigned char* ws = F.ws;
    const bf16_t* PBX = (const bf16_t*)(ws + WS_XB2);
    bf16_t* XC = (bf16_t*)(ws + WS_XB);
    const float* Wg = (const float*)(ws + WS_WG);
    float* GLI = (float*)(ws + WS_GLI); float* GLF = (float*)(ws + WS_GLF);
    const float* convw = F.in[14]; const float* convb = F.in[15]; const float* bif = F.in[20];
    LAS float* cwl = (LAS float*)F.lds; LAS bf16_t* wgl = (LAS bf16_t*)(F.lds + 20480); LAS f32x4* comb = (LAS f32x4*)(F.lds + 20480 + 32 * 2064);
    {
        u32x4 t[11];
#pragma unroll
        for (int j = 0; j < 11; ++j) { const int i = min(F.tid + 512 * j, 5375);
            const u32x4* srcp = i < 1024 ? (const u32x4*)convw + i : (i < 1280 ? (const u32x4*)convb + (i - 1024) : (const u32x4*)(ws + WS_WGB) + (i - 1280));
            t[j] = *srcp; }
#pragma unroll
        for (int j = 0; j < 11; ++j) { const int i = F.tid + 512 * j; if (i < 1280) ((LAS u32x4*)F.lds)[i] = t[j]; else if (i < 5376) { const int p = i - 1280; *(LAS u32x4*)(F.lds + 20480 + (p >> 7) * 2064 + (p & 127) * 16) = t[j]; } }
    }
    __syncthreads();
    const int l15 = F.lane & 15, lq = F.lane >> 4, rgp = F.wave >> 1, hh = F.wave & 1;
    auto conv_core = [&](int row, const float (&w0)[8], const float (&w1)[8], const float (&w2)[8], const u32x4 x0, int ch0, f32x4& acc) {
        float cur[8], xc[8];
        unpack8(x0, cur);
#pragma unroll
        for (int q = 0; q < 2; ++q) { const f32x4 c0 = *(const LAS f32x4*)(cwl + ch0 + 4 * q), c1 = *(const LAS f32x4*)(cwl + 1024 + ch0 + 4 * q), c2 = *(const LAS f32x4*)(cwl + 2048 + ch0 + 4 * q), c3 = *(const LAS f32x4*)(cwl + 3072 + ch0 + 4 * q), cb = *(const LAS f32x4*)(cwl + 4096 + ch0 + 4 * q);
#pragma unroll
            for (int e = 0; e < 4; ++e) xc[4 * q + e] = siluf_(c0[e] * w0[4 * q + e] + c1[e] * w1[4 * q + e] + c2[e] * w2[4 * q + e] + c3[e] * cur[4 * q + e] + cb[e]); }
        const u32x4 xcp = pack8(xc);
        *(u32x4*)(XC + (size_t)row * DM + ch0) = xcp;
        const bf16x8 bc = *(const LAS bf16x8*)(wgl + l15 * 1032 + ch0), bx = *(const LAS bf16x8*)(wgl + 16 * 1032 + l15 * 1032 + ch0);
        acc = __builtin_amdgcn_mfma_f32_16x16x32_bf16(__builtin_bit_cast(bf16x8, xcp), bc, acc, 0, 0, 0);
        acc = __builtin_amdgcn_mfma_f32_16x16x32_bf16(__builtin_bit_cast(bf16x8, x0), bx, acc, 0, 0, 0);
    };
    for (int tile = F.bid; tile < MP / 64; tile += F.G) {
        const int row = tile * 64 + rgp * 16 + l15, seq0 = row & ~(SEQ - 1);
        const bool v1 = row - 1 >= seq0, v2 = row - 2 >= seq0, v3 = row - 3 >= seq0;
        const bf16_t* p0 = PBX + (size_t)row * DM + hh * 512 + 8 * lq;
        const bf16_t* p1 = p0 - (v1 ? DM : 0); const bf16_t* p2 = p0 - (v2 ? 2 * DM : 0); const bf16_t* p3 = p0 - (v3 ? 3 * DM : 0);
        f32x4 acc = (f32x4){0.f, 0.f, 0.f, 0.f};
        u32x4 X0[2][4], X1[2][4], X2[2][4], X3[2][4];
#pragma unroll
        for (int j = 0; j < 4; ++j) { const int off = j * 32; X0[0][j] = *(const u32x4*)(p0 + off); X1[0][j] = *(const u32x4*)(p1 + off); X2[0][j] = *(const u32x4*)(p2 + off); X3[0][j] = *(const u32x4*)(p3 + off); }
#pragma unroll
        for (int bt = 0; bt < 4; ++bt) {
            if (bt < 3) {
#pragma unroll
                for (int j = 0; j < 4; ++j) { const int off = ((bt + 1) * 4 + j) * 32; X0[(bt + 1) & 1][j] = *(const u32x4*)(p0 + off); X1[(bt + 1) & 1][j] = *(const u32x4*)(p1 + off); X2[(bt + 1) & 1][j] = *(const u32x4*)(p2 + off); X3[(bt + 1) & 1][j] = *(const u32x4*)(p3 + off); } }
#pragma unroll
            for (int j = 0; j < 4; ++j) { const u32x4 z = (u32x4){0u, 0u, 0u, 0u}; float w0[8], w1[8], w2[8];
                unpack8(v3 ? X3[bt & 1][j] : z, w0); unpack8(v2 ? X2[bt & 1][j] : z, w1); unpack8(v1 ? X1[bt & 1][j] : z, w2);
                conv_core(row, w0, w1, w2, X0[bt & 1][j], (hh * 16 + bt * 4 + j) * 32 + 8 * lq, acc); }
        }
        __syncthreads();
        if (hh == 1) comb[rgp * 64 + F.lane] = acc;
        __syncthreads();
        if (hh == 0 && l15 < 8) { const f32x4 o = comb[rgp * 64 + F.lane]; const float bj = bif[l15];
#pragma unroll
            for (int r = 0; r < 4; ++r) { const float g = acc[r] + o[r] + bj; const size_t rr = (size_t)(tile * 64 + rgp * 16 + 4 * lq + r);
                if (l15 < 4) GLI[(size_t)l15 * MA + rr] = g; else GLF[(size_t)(l15 - 4) * MA + rr] = logsigmoidf_(g); } }
    }
    for (int si = F.G - 1 - F.bid; si < MS / 16; si += F.G) {
        const int row = MP + si * 16 + l15; const float* st = F.in[5] + (size_t)(row - MP) * 3072;
        f32x4 acc = (f32x4){0.f, 0.f, 0.f, 0.f};
        u32x4 X0[4]; f32x4 S[4][3][2];
#pragma unroll
        for (int cbk = 0; cbk < 4; ++cbk) { const int ch0 = (F.wave * 4 + cbk) * 32 + 8 * lq; X0[cbk] = *(const u32x4*)(PBX + (size_t)row * DM + ch0);
#pragma unroll
            for (int q = 0; q < 2; ++q) { S[cbk][0][q] = *(const f32x4*)(st + ch0 + 4 * q); S[cbk][1][q] = *(const f32x4*)(st + 1024 + ch0 + 4 * q); S[cbk][2][q] = *(const f32x4*)(st + 2048 + ch0 + 4 * q); } }
#pragma unroll
        for (int cbk = 0; cbk < 4; ++cbk) { float w0[8], w1[8], w2[8];
#pragma unroll
            for (int q = 0; q < 2; ++q)
#pragma unroll
                for (int e = 0; e < 4; ++e) { w0[4 * q + e] = S[cbk][0][q][e]; w1[4 * q + e] = S[cbk][1][q][e]; w2[4 * q + e] = S[cbk][2][q][e]; }
            conv_core(row, w0, w1, w2, X0[cbk], (F.wave * 4 + cbk) * 32 + 8 * lq, acc); }
        __syncthreads();
        comb[F.wave * 64 + F.lane] = acc;
        __syncthreads();
        if (F.wave == 0 && l15 < 8) { f32x4 o = comb[F.lane];
#pragma unroll
            for (int ww = 1; ww < 8; ++ww) o = o + comb[ww * 64 + F.lane];
            const float bj = bif[l15];
#pragma unroll
            for (int r = 0; r < 4; ++r) { const float g = o[r] + bj; const size_t rr = (size_t)(MP + si * 16 + 4 * lq + r);
                if (l15 < 4) GLI[(size_t)l15 * MA + rr] = g; else GLF[(size_t)(l15 - 4) * MA + rr] = logsigmoidf_(g); } }
    }
}
__device__ __forceinline__ void p2c_sample_rows(const Ctx& F0) { Ctx F = F0; asm volatile("" : "+v"(F.tid), "+v"(F.lane), "+s"(F.gw));
    unsigned char* ws = F.ws;
    const bf16_t* PBX = (const bf16_t*)(ws + WS_XB2);
    if (F.bid >= 64 && F.bid < 112) { const int i = (F.bid - 64) * 512 + F.tid; const int b = i / 3072, j = (i / 1024) % 3, ch = i & 1023;
        F.out[O_CVP + i] = bf2f(PBX[(size_t)(b * SEQ + SEQ - 3 + j) * DM + ch]); }
    if (F.bid >= 112 && F.bid < 128) { const int i = (F.bid - 112) * 8 + F.wave;
        const int r = MP + i, ch0s = F.lane * 16; const float* st = F.in[5] + (size_t)i * 3 * 1024;
        const bf16_t* PA = (const bf16_t*)(ws + WS_PROJA) + (size_t)r * 3072;
        u32x4 xbw[2], gvw[2], uuw[2], zzw[2]; f32x4 s1[4], s2[4], lg[4], lb[4];
#pragma unroll
        for (int half = 0; half < 2; ++half) { xbw[half] = *(const u32x4*)(PBX + (size_t)r * DM + ch0s + 8 * half); gvw[half] = *(const u32x4*)(PA + 1024 + ch0s + 8 * half);
            uuw[half] = *(const u32x4*)(PA + ch0s + 8 * half); zzw[half] = *(const u32x4*)(PA + 2048 + ch0s + 8 * half); }
#pragma unroll
        for (int q4 = 0; q4 < 4; ++q4) { s1[q4] = *(const f32x4*)(st + 1024 + ch0s + 4 * q4); s2[q4] = *(const f32x4*)(st + 2048 + ch0s + 4 * q4);
            lg[q4] = *(const f32x4*)(F.in[10] + ch0s + 4 * q4); lb[q4] = *(const f32x4*)(F.in[11] + ch0s + 4 * q4); }
        const int h = F.lane >> 3; const float wsp = F.in[12][(size_t)h * 16384], bsp = F.in[13][h * 128];
#pragma unroll
        for (int half = 0; half < 2; ++half) { float xb[8]; unpack8(xbw[half], xb);
#pragma unroll
            for (int q = 0; q < 2; ++q) { const int q4 = half * 2 + q; *(f32x4*)(F.out + O_CVS + (size_t)i * 3072 + ch0s + 4 * q4) = s1[q4]; *(f32x4*)(F.out + O_CVS + (size_t)i * 3072 + 1024 + ch0s + 4 * q4) = s2[q4];
                *(f32x4*)(F.out + O_CVS + (size_t)i * 3072 + 2048 + ch0s + 4 * q4) = (f32x4){xb[4 * q], xb[4 * q + 1], xb[4 * q + 2], xb[4 * q + 3]}; } }
        float gv[16], s = 0.f;
        { float t8[8]; unpack8(gvw[0], t8);
#pragma unroll
          for (int c = 0; c < 8; ++c) gv[c] = t8[c];
          unpack8(gvw[1], t8);
#pragma unroll
          for (int c = 0; c < 8; ++c) gv[8 + c] = t8[c]; }
#pragma unroll
        for (int c = 0; c < 16; ++c) s += gv[c];
        s += __shfl_xor(s, 1); s += __shfl_xor(s, 2); s += __shfl_xor(s, 4);
        const float mu = s * (1.f / 128.f); float q = 0.f;
#pragma unroll
        for (int c = 0; c < 16; ++c) { const float d = gv[c] - mu; q += d * d; }
        q += __shfl_xor(q, 1); q += __shfl_xor(q, 2); q += __shfl_xor(q, 4);
        const float rstd = 1.0f / sqrtf(q * (1.f / 128.f) + EPS);
        float uu[16], zz[16];
        { float t8[8]; unpack8(uuw[0], t8);
#pragma unroll
          for (int c = 0; c < 8; ++c) uu[c] = t8[c];
          unpack8(uuw[1], t8);
#pragma unroll
          for (int c = 0; c < 8; ++c) uu[8 + c] = t8[c];
          unpack8(zzw[0], t8);
#pragma unroll
          for (int c = 0; c < 8; ++c) zz[c] = t8[c];
          unpack8(zzw[1], t8);
#pragma unroll
          for (int c = 0; c < 8; ++c) zz[8 + c] = t8[c]; }
        float ya[16];
#pragma unroll
        for (int q4 = 0; q4 < 4; ++q4) { f32x4 vv;
#pragma unroll
            for (int e = 0; e < 4; ++e) { const int c = 4 * q4 + e; const float vn = (gv[c] - mu) * rstd * lg[q4][e] + lb[q4][e]; vv[e] = vn; ya[c] = uu[c] * (wsp * vn + bsp) * zz[c]; }
            *(f32x4*)(F.out + O_VS + (size_t)i * 1024 + ch0s + 4 * q4) = vv; }
        bf16_t* yrow = (bf16_t*)(ws + WS_Y) + (size_t)r * DMIX + ch0s;
        { float t8[8];
#pragma unroll
          for (int c = 0; c < 8; ++c) t8[c] = ya[c];
          *(u32x4*)(yrow) = pack8(t8);
#pragma unroll
          for (int c = 0; c < 8; ++c) t8[c] = ya[8 + c];
          *(u32x4*)(yrow + 8) = pack8(t8); }
    }
}

__device__ __forceinline__ void mscan_wave(const Ctx& F, int bh) {
    unsigned char* ws = F.ws; const int b = bh >> 2, h = bh & 3, lane = F.lane;
    const float* li = (const float*)(ws + WS_GLI) + (size_t)h * MA + (size_t)b * SEQ + lane * 32;
    const float* lf = (const float*)(ws + WS_GLF) + (size_t)h * MA + (size_t)b * SEQ + lane * 32;
    float lfv[32], liv[32];
#pragma unroll
    for (int j = 0; j < 8; ++j) { const f32x4 a = *(const f32x4*)(lf + 4 * j), c = *(const f32x4*)(li + 4 * j);
#pragma unroll
        for (int e = 0; e < 4; ++e) { lfv[4 * j + e] = a[e]; liv[4 * j + e] = c[e]; } }
    float A = 0.f, Bv = -INFINITY;
#pragma unroll
    for (int i = 0; i < 32; ++i) { const float f = lfv[i], l = liv[i]; Bv = fmaxf(Bv + f, l); A += f; }
    float sA = A, sB = Bv;
#pragma unroll
    for (int o = 1; o < 64; o <<= 1) { const float pA = __shfl_up(sA, o), pB = __shfl_up(sB, o); if (lane >= o) { sB = fmaxf(pB + sA, sB); sA = pA + sA; } }
    float eA = __shfl_up(sA, 1), eB = __shfl_up(sB, 1); if (lane == 0) { eA = 0.f; eB = -INFINITY; }
    const float m_in = fmaxf(0.f + eA, eB);
    float cA = A;
#pragma unroll
    for (int o = 1; o < 8; o <<= 1) { const float p = __shfl_up(cA, o); if ((lane & 7) >= o) cA += p; }
    const float b_in = cA - A;
    const float m_prev = __shfl(m_in, lane & ~7);
    float* DA = (float*)(ws + WS_DA) + (size_t)h * MA + (size_t)b * SEQ + lane * 32; float* DR = (float*)(ws + WS_DR) + (size_t)h * MA + (size_t)b * SEQ + lane * 32;
    float* DG = (float*)(ws + WS_DG) + (size_t)h * MA + (size_t)b * SEQ + lane * 32; float* DEM = (float*)(ws + WS_DEM) + (size_t)h * MA + (size_t)b * SEQ + lane * 32;
    float* DW = (float*)(ws + WS_DW) + (size_t)h * MA + (size_t)b * SEQ + lane * 32;
    float m = m_in, bb = b_in, a_last = 0.f;
#pragma unroll
    for (int j = 0; j < 8; ++j) { f32x4 vA, vR, vG, vE;
#pragma unroll
        for (int e = 0; e < 4; ++e) { const float f = lfv[4 * j + e], l = liv[4 * j + e]; m = fmaxf(m + f, l); bb += f;
            a_last = bb - m; vA[e] = -m_prev; vR[e] = l - bb; vG[e] = __expf(bb + m_prev - m); vE[e] = __expf(-m); }
        *(f32x4*)(DA + 4 * j) = vA; *(f32x4*)(DR + 4 * j) = vR; *(f32x4*)(DG + 4 * j) = vG; *(f32x4*)(DEM + 4 * j) = vE; }
    const float a_end = __shfl(a_last, lane | 7);
    { float bb2 = b_in;
#pragma unroll
      for (int j = 0; j < 8; ++j) { f32x4 vW;
#pragma unroll
          for (int e = 0; e < 4; ++e) { bb2 += lfv[4 * j + e]; vW[e] = __expf(a_end + (liv[4 * j + e] - bb2)); }
          *(f32x4*)(DW + 4 * j) = vW; } }
    if (lane == 63) F.out[O_MP + bh] = m;
}

__device__ __forceinline__ void p9_final(const Ctx& F0) { Ctx F = F0; asm volatile("" : "+v"(F.tid), "+v"(F.lane), "+s"(F.gw));
    unsigned char* ws = F.ws; const bf16_t* GB = (const bf16_t*)(ws + WS_GB); const bf16_t* EB = (const bf16_t*)(ws + WS_EB);
    const float* pleg = F.in[27]; const float* fing = F.in[28];
    f32x4 pg[4], fg[4];
#pragma unroll
    for (int j = 0; j < 4; ++j) { pg[j] = ((const f32x4*)pleg)[F.lane + 64 * j]; fg[j] = ((const f32x4*)fing)[F.lane + 64 * j]; }
    for (int r0 = F.gw * 2; r0 < MP + MS; r0 += F.NGW * 2) {
        f32x4 x[2][4]; u32x2 g[2][4], e[2][4], xb[2][4]; float* xrow[2]; const bf16_t* X1B = (const bf16_t*)(ws + WS_X1B);
#pragma unroll
        for (int q = 0; q < 2; ++q) { const int r = r0 + q; xrow[q] = r < MP ? F.out + O_Y + (size_t)r * DM : F.out + O_YS + (size_t)(r - MP) * DM;
#pragma unroll
            for (int j = 0; j < 4; ++j) { xb[q][j] = __builtin_nontemporal_load((const u32x2*)(X1B + (size_t)r * DM) + F.lane + 64 * j); g[q][j] = __builtin_nontemporal_load((const u32x2*)(GB + (size_t)r * DM) + F.lane + 64 * j); e[q][j] = __builtin_nontemporal_load((const u32x2*)(EB + (size_t)r * DM) + F.lane + 64 * j); } }
#pragma unroll
        for (int q = 0; q < 2; ++q) { float s = 0.f; f32x4 ev[4];
#pragma unroll
            for (int j = 0; j < 4; ++j) { x[q][j] = (f32x4){bf_lo(xb[q][j].x), bf_hi(xb[q][j].x), bf_lo(xb[q][j].y), bf_hi(xb[q][j].y)}; ev[j] = (f32x4){bf_lo(e[q][j].x), bf_hi(e[q][j].x), bf_lo(e[q][j].y), bf_hi(e[q][j].y)}; s += (ev[j][0] * ev[j][0] + ev[j][1] * ev[j][1]) + (ev[j][2] * ev[j][2] + ev[j][3] * ev[j][3]); }
            s = wave_sum(s); const float rse = 1.0f / sqrtf(s * (1.f / DM) + EPS); float s2 = 0.f;
#pragma unroll
            for (int j = 0; j < 4; ++j) { const f32x4 gv = (f32x4){bf_lo(g[q][j].x), bf_hi(g[q][j].x), bf_lo(g[q][j].y), bf_hi(g[q][j].y)};
                x[q][j] = x[q][j] + gv * (ev[j] * rse * pg[j]); s2 += (x[q][j][0] * x[q][j][0] + x[q][j][1] * x[q][j][1]) + (x[q][j][2] * x[q][j][2] + x[q][j][3] * x[q][j][3]); }
            s2 = wave_sum(s2); const float rs2 = 1.0f / sqrtf(s2 * (1.f / DM) + EPS);
#pragma unroll
            for (int j = 0; j < 4; ++j) __builtin_nontemporal_store(x[q][j] * rs2 * fg[j], (f32x4*)xrow[q] + F.lane + 64 * j); }
    }
}
#define MAKE_CTX() extern __shared__ __attribute__((aligned(16))) unsigned char lds_raw[]; \
    Ctx F; F.lds = (LAS unsigned char*)lds_raw; F.tid = threadIdx.x; F.lane = F.tid & 63; F.wave = __builtin_amdgcn_readfirstlane(F.tid >> 6); \
    F.G = gridDim.x; F.bid = blockIdx.x; F.gw = F.bid * 8 + F.wave; F.NGW = F.G * 8; F.in = args.in; F.out = args.out; F.ws = args.ws; unsigned char* ws = args.ws; (void)ws

template <int KIND> struct EpiBf16Act {
    static constexpr bool PERM = false, AFTER_DRAIN = false;
    bf16_t* O; int ldo; const float* bias; float scale;
    __device__ __forceinline__ void operator()(const f32x4 (&acc)[2][2][4][2], const Unit& u, int wr, int wc, int fr, int fq) const {
        const int row0 = u.pm * 256 + wr * 64 + fr, col0 = u.pn * 256 + wc * 32 + 4 * fq;
        f32x4 bv[2][2];
#pragma unroll
        for (int bj = 0; bj < 2; ++bj)
#pragma unroll
            for (int n = 0; n < 2; ++n) bv[bj][n] = bias ? *(const f32x4*)(bias + col0 + bj * 128 + 16 * n) : (f32x4){0.f, 0.f, 0.f, 0.f};
#pragma unroll
        for (int ai = 0; ai < 2; ++ai)
#pragma unroll
            for (int m = 0; m < 4; ++m) { bf16_t* rowp = O + (size_t)(row0 + ai * 128 + m * 16) * ldo + u.pn * 256 + wc * 32 + lane_row_col(fq);
#pragma unroll
                for (int bj = 0; bj < 2; ++bj) { u32x2 wn[2];
#pragma unroll
                    for (int n = 0; n < 2; ++n) { f32x4 v = acc[ai][bj][m][n] * scale + bv[bj][n];
                        if (KIND == 3) {
#pragma unroll
                            for (int j = 0; j < 4; ++j) v[j] = sigmoidf_(v[j]); }
                        wn[n].x = cvt_pk_bf16(v[0], v[1]); wn[n].y = cvt_pk_bf16(v[2], v[3]); }
                    *(u32x4*)(rowp + bj * 128) = lane_row_pair(wn[0], wn[1]); } }
    }
};
struct EpiOutProj {
    static constexpr bool PERM = false, AFTER_DRAIN = false;
    const float* xp; const float* xs; float* out; bf16_t* X1B;
    __device__ __forceinline__ void operator()(const f32x4 (&acc)[2][2][4][2], const Unit& u, int wr, int wc, int fr, int fq) const {
        const int row0 = u.pm * 256 + wr * 64 + fr, col0 = u.pn * 256 + wc * 32 + 4 * fq;
#pragma unroll
        for (int ai = 0; ai < 2; ++ai) { f32x4 xv[4][2][2];
#pragma unroll
            for (int m = 0; m < 4; ++m) { const int row = row0 + ai * 128 + m * 16; const bool real = row < MP + MS; const float* xr = row < MP ? xp + (size_t)row * DM : xs + (size_t)(real ? row - MP : 0) * DM;
#pragma unroll
                for (int bj = 0; bj < 2; ++bj)
#pragma unroll
                    for (int n = 0; n < 2; ++n) xv[m][bj][n] = __builtin_nontemporal_load((const f32x4*)(xr + col0 + bj * 128 + n * 16)); }
#pragma unroll
            for (int m = 0; m < 4; ++m) { const int row = row0 + ai * 128 + m * 16; const bool real = row < MP + MS;
#pragma unroll
                for (int bj = 0; bj < 2; ++bj) { u32x2 wn[2];
#pragma unroll
                    for (int n = 0; n < 2; ++n) { f32x4 v = acc[ai][bj][m][n];
                        if (real) v = v + xv[m][bj][n]; else v = (f32x4){0.f, 0.f, 0.f, 0.f};
                        wn[n].x = cvt_pk_bf16(v[0], v[1]); wn[n].y = cvt_pk_bf16(v[2], v[3]); }
                    *(u32x4*)(X1B + (size_t)row * DM + u.pn * 256 + wc * 32 + lane_row_col(fq) + bj * 128) = lane_row_pair(wn[0], wn[1]); } } }
    }
};

struct EpiInProjNP {
    static constexpr bool PERM = false, AFTER_DRAIN = false;
    bf16_t* PA; bf16_t* PB; const float* rs; bf16_t* XB2;
    __device__ __forceinline__ void operator()(const f32x4 (&acc)[2][2][4][2], const Unit& u, int wr, int wc, int fr, int fq) const {
        const int row0 = u.pm * 256 + wr * 64 + fr, pn = u.pn; const int col0 = wc * 32 + 4 * fq;
        const int kind = pn < 8 ? 0 : ((pn < 12 || pn >= 20) ? 1 : (pn < 16 ? 2 : 3));
        const int cs = lane_row_col(fq);
        bf16_t* base = pn < 12 ? PA + pn * 256 : (kind == 2 ? XB2 + (pn - 12) * 256 : PB + (pn - 12) * 256); const int pitch = kind == 2 ? DM : 3072;
        float rsv[2][4];
#pragma unroll
        for (int ai = 0; ai < 2; ++ai)
#pragma unroll
            for (int m = 0; m < 4; ++m) rsv[ai][m] = rs[row0 + ai * 128 + m * 16];
#pragma unroll
        for (int ai = 0; ai < 2; ++ai)
#pragma unroll
            for (int m = 0; m < 4; ++m) { const int row = row0 + ai * 128 + m * 16; const float s = rsv[ai][m];
#pragma unroll
                for (int bj = 0; bj < 2; ++bj) { u32x2 wn[2];
#pragma unroll
                    for (int n = 0; n < 2; ++n) { f32x4 v = acc[ai][bj][m][n] * s;
                        if (kind == 0) { const f32x2 ga = gelu_pk((f32x2){v[0], v[1]}), gb = gelu_pk((f32x2){v[2], v[3]}); v = (f32x4){ga.x, ga.y, gb.x, gb.y}; }
                        else {
#pragma unroll
                        for (int j = 0; j < 4; ++j) { float x = v[j]; if (kind == 1) x = siluf_(x); else if (kind == 3) x = sigmoidf_(x); v[j] = x; } }
                        wn[n].x = cvt_pk_bf16(v[0], v[1]); wn[n].y = cvt_pk_bf16(v[2], v[3]); }
                    *(u32x4*)(base + (size_t)row * pitch + wc * 32 + cs + bj * 128) = lane_row_pair(wn[0], wn[1]); } }
    }
};
__device__ __forceinline__ void p1_inproj(const Ctx& F) {
    unsigned char* ws = F.ws; Gemm g{DM, DM, DM};
    OrderXcd S{64, 24, 64 * 24, F.G, F.bid, (const char*)(ws + WS_XB), (const char*)(ws + WS_WIN), (size_t)256 * DM * 2, (size_t)256 * DM * 2};
    EpiInProjNP E{(bf16_t*)(ws + WS_PROJA), (bf16_t*)(ws + WS_PROJB), (const float*)(ws + WS_RS), (bf16_t*)(ws + WS_XB2)};
    pg8::gemm_phase<EpiInProjNP, OrderXcd>(F.lds, g, S, E);
}
__device__ __forceinline__ void p7_outproj(const Ctx& F) {
    unsigned char* ws = F.ws; Gemm g{DMIX, DMIX, DMIX};
    OrderPanel4 S{64 * 4, F.G, F.bid, (const char*)(ws + WS_Y), (const char*)(ws + WS_WOUT), (size_t)256 * DMIX * 2, (size_t)256 * DMIX * 2};
    EpiOutProj E{F.in[0], F.in[1], F.out, (bf16_t*)(ws + WS_X1B)};
    pg8::gemm_phase<EpiOutProj, OrderPanel4>(F.lds, g, S, E);
}
__device__ __forceinline__ void p8_ple(const Ctx& F) {
    unsigned char* ws = F.ws;
    { Gemm g{DM, DM, DM}; OrderPanel4 S{NTILE * 4, F.G, F.bid, (const char*)(ws + WS_X1B), (const char*)(ws + WS_WPG), (size_t)256 * DM * 2, (size_t)256 * DM * 2};
      EpiBf16Act<3> E{(bf16_t*)(ws + WS_GB), DM, F.in[25], 1.0f}; pg8::gemm_phase<EpiBf16Act<3>, OrderPanel4>(F.lds, g, S, E); }
    { Gemm g{DPLE, DPLE, DPLE}; OrderProjSkip S{F.G, F.bid, (const char*)(ws + WS_PB), (const char*)(ws + WS_WPP), (size_t)256 * DPLE * 2, (size_t)256 * DPLE * 2};
      EpiBf16Act<0> E{(bf16_t*)(ws + WS_EB), DM, nullptr, 1.0f}; pg8::gemm_phase<EpiBf16Act<0>, OrderProjSkip>(F.lds, g, S, E); }
}
typedef float f32x4_t __attribute__((ext_vector_type(4)));
__device__ __forceinline__ void p2b_spatial_units(const Ctx& F0) { Ctx F = F0; asm volatile("" : "+v"(F.tid), "+v"(F.lane), "+s"(F.gw));
    unsigned char* ws = F.ws;
    const bf16_t* PA = (const bf16_t*)(ws + WS_PROJA); const bf16_t* WSP = (const bf16_t*)(ws + WS_WSP); bf16_t* Y = (bf16_t*)(ws + WS_Y);
    const float* lng = F.in[10]; const float* lnb = F.in[11]; const float* bsp = F.in[13];
    LAS bf16_t* vnT = (LAS bf16_t*)F.lds;
    const int lane = F.lane, w = F.wave, l15 = lane & 15, lq = lane >> 4;
    unsigned wav[8], wbv[8];
    auto load_v = [&](int unit) { const int b = unit >> 7, c = (unit >> 3) & 15, h = unit & 7, r0 = b * SEQ + c * 128;
#pragma unroll
        for (int p = 0; p < 8; ++p) { const int s0 = w * 16 + 2 * p; wav[p] = *(const unsigned*)(PA + (size_t)(r0 + s0) * 3072 + 1024 + h * 128 + 2 * lane); wbv[p] = *(const unsigned*)(PA + (size_t)(r0 + s0 + 1) * 3072 + 1024 + h * 128 + 2 * lane); } };
    if (F.bid < NB * 16 * HA) load_v(F.bid);
    for (int unit = F.bid; unit < NB * 16 * HA; unit += F.G) {
        const int b = unit >> 7, c = (unit >> 3) & 15, h = unit & 7, r0 = b * SEQ + c * 128;
        const float g0 = lng[h * 128 + 2 * lane], g1 = lng[h * 128 + 2 * lane + 1], b0 = lnb[h * 128 + 2 * lane], b1 = lnb[h * 128 + 2 * lane + 1];
        const int t0 = 16 * w, nks = (t0 + 15) / 32 + 1;
        bf16x8 wfr[4];
#pragma unroll
        for (int ks = 0; ks < 4; ++ks) wfr[ks] = *(const bf16x8*)(WSP + ((size_t)h * 128 + t0 + l15) * 128 + ks * 32 + 8 * lq);
        const int t = t0 + l15; const float bt = bsp[h * 128 + t]; const size_t row = (size_t)(r0 + t);
        u32x4 uuv[4], zzv[4]; const int lrc = lane_row_col(lq);
#pragma unroll
        for (int p = 0; p < 4; ++p) { uuv[p] = *(const u32x4*)(PA + row * 3072 + h * 128 + 32 * p + lrc); zzv[p] = *(const u32x4*)(PA + row * 3072 + 2048 + h * 128 + 32 * p + lrc); }
        unsigned vlo[8], vhi[8];
#pragma unroll
        for (int p = 0; p < 8; ++p) { const unsigned wa = wav[p], wb = wbv[p];
            float a0 = bf_lo(wa), a1 = bf_hi(wa), c0 = bf_lo(wb), c1 = bf_hi(wb);
            const float mua = wave_sum(a0 + a1) * (1.f / 128.f), mub = wave_sum(c0 + c1) * (1.f / 128.f);
            a0 -= mua; a1 -= mua; c0 -= mub; c1 -= mub;
            const float ra = 1.0f / sqrtf(wave_sum(a0 * a0 + a1 * a1) * (1.f / 128.f) + EPS), rb = 1.0f / sqrtf(wave_sum(c0 * c0 + c1 * c1) * (1.f / 128.f) + EPS);
            vlo[p] = cvt_pk_bf16(a0 * ra * g0 + b0, c0 * rb * g0 + b0); vhi[p] = cvt_pk_bf16(a1 * ra * g1 + b1, c1 * rb * g1 + b1); }
#pragma unroll
        for (int q = 0; q < 2; ++q) { *(LAS u32x4*)(vnT + (2 * lane) * 136 + w * 16 + 8 * q) = (u32x4){vlo[4 * q], vlo[4 * q + 1], vlo[4 * q + 2], vlo[4 * q + 3]};
            *(LAS u32x4*)(vnT + (2 * lane + 1) * 136 + w * 16 + 8 * q) = (u32x4){vhi[4 * q], vhi[4 * q + 1], vhi[4 * q + 2], vhi[4 * q + 3]}; }
        __syncthreads();
        if (unit + F.G < NB * 16 * HA) load_v(unit + F.G);
        f32x4 acc[8];
#pragma unroll
        for (int nb = 0; nb < 8; ++nb) acc[nb] = (f32x4){0.f, 0.f, 0.f, 0.f};
#pragma unroll
        for (int ks = 0; ks < 4; ++ks) { if (ks < nks) { const int k0 = ks * 32;
#pragma unroll
            for (int nb = 0; nb < 8; ++nb) { const bf16x8 vf = *(const LAS bf16x8*)(vnT + (nb * 16 + l15) * 136 + k0 + 8 * lq);
                acc[nb] = __builtin_amdgcn_mfma_f32_16x16x32_bf16(vf, wfr[ks], acc[nb], 0, 0, 0); } } }
#pragma unroll
        for (int p = 0; p < 4; ++p) { float u8[8], z8[8], o8[8]; unpack8(uuv[p], u8); unpack8(zzv[p], z8);
#pragma unroll
            for (int j = 0; j < 4; ++j) { const auto sw = __builtin_amdgcn_permlane16_swap(__float_as_uint(acc[2 * p][j]), __float_as_uint(acc[2 * p + 1][j]), false, false);
                o8[j] = u8[j] * (__uint_as_float(sw[0]) + bt) * z8[j]; o8[4 + j] = u8[4 + j] * (__uint_as_float(sw[1]) + bt) * z8[4 + j]; }
            *(u32x4*)(Y + row * DMIX + h * 128 + 32 * p + lrc) = pack8(o8); }
        __syncthreads();
    }
}
__device__ __forceinline__ void p2b_mscan(const Ctx& F) { if (F.bid < 32 && F.wave == 0) mscan_wave(F, F.bid); }

struct OrderQK {
    int G, c; const char* ws;
    __device__ __forceinline__ bool next(int i, Unit& u) const { const int L = i * G + c; if (L >= 512) return false; const char* XC = ws + WS_XB; const char* WQ = ws + WS_WQ; const char* WK = ws + WS_WK;
        const int kind = L >> 8, l = L & 255; u.pm = l >> 2; u.pn = kind; u.aux = l & 3; u.a = XC + (size_t)u.pm * (256 * DM * 2) + (size_t)u.aux * 512; u.b = (kind ? WK : WQ) + (size_t)u.aux * 131072; return true; }
};
struct EpiQK {
    static constexpr bool PERM = false, AFTER_DRAIN = false;
    bf16_t* K; bf16_t* PQ; const float* DG;
    __device__ __forceinline__ void operator()(const f32x4 (&acc)[2][2][4][2], const Unit& u, int wr, int wc, int fr, int fq) const {
        const int h = u.aux, rl0 = wr * 64 + fr, col0 = wc * 32 + 4 * fq; const bool isk = u.pn != 0;
        const int unit = ((u.pm >> 3) * 4 + h) * 8 + (u.pm & 7);
        float gv[2][4];
#pragma unroll
        for (int ai = 0; ai < 2; ++ai)
#pragma unroll
            for (int m = 0; m < 4; ++m) gv[ai][m] = isk ? 0.0625f : DG[(size_t)h * MA + u.pm * 256 + rl0 + ai * 128 + m * 16];
        bf16_t* base = isk ? K + (size_t)u.pm * 256 * 1024 + h * 256 : PQ + (size_t)unit * 256 * 512 + 256; const int ldo = isk ? 1024 : 512;
#pragma unroll
        for (int ai = 0; ai < 2; ++ai)
#pragma unroll
            for (int m = 0; m < 4; ++m) { const int rl = rl0 + ai * 128 + m * 16; const float g = gv[ai][m];
#pragma unroll
                for (int bj = 0; bj < 2; ++bj) { u32x2 wn[2];
#pragma unroll
                    for (int n = 0; n < 2; ++n) { const f32x4 v = acc[ai][bj][m][n] * g; wn[n].x = cvt_pk_bf16(v[0], v[1]); wn[n].y = cvt_pk_bf16(v[2], v[3]); }
                    *(u32x4*)(base + (size_t)rl * ldo + wc * 32 + lane_row_col(fq) + bj * 128) = lane_row_pair(wn[0], wn[1]); }
                asm volatile("" ::: "memory"); }
    }
};
struct OrderS12 {
    int G, c; const char* ws;
    __device__ __forceinline__ bool next(int i, Unit& u) const { const int L = i * G + c; if (L >= 12) return false; const char* XC = ws + WS_XB; const char* XB2 = ws + WS_XB2; const char* WQ = ws + WS_WQ; const char* WK = ws + WS_WK; const char* WV = ws + WS_WV;
        const int kind = L >> 2; u.pm = 64; u.pn = kind; u.aux = L & 3; u.a = (kind == 2 ? XB2 : XC) + (size_t)64 * (256 * DM * 2) + (size_t)u.aux * 512; u.b = (kind == 0 ? WQ : kind == 1 ? WK : WV) + (size_t)u.aux * 131072; return true; }
};
struct EpiS12 {
    static constexpr bool PERM = false, AFTER_DRAIN = false;
    bf16_t* Q; bf16_t* K; bf16_t* Vs;
    __device__ __forceinline__ void operator()(const f32x4 (&acc)[2][2][4][2], const Unit& u, int wr, int wc, int fr, int fq) const {
        const int h = u.aux, kind = u.pn; bf16_t* O = kind == 0 ? Q + (size_t)MP * 1024 : kind == 1 ? K + (size_t)MP * 1024 : Vs; const float sc = kind == 1 ? 0.0625f : 1.0f;
        const int row0 = wr * 64 + fr, col0 = h * 256 + wc * 32 + 4 * fq;
#pragma unroll
        for (int m = 0; m < 4; ++m) { bf16_t* rowp = O + (size_t)(row0 + m * 16) * 1024 + h * 256 + wc * 32 + lane_row_col(fq);
#pragma unroll
            for (int bj = 0; bj < 2; ++bj) { u32x2 wn[2];
#pragma unroll
                for (int n = 0; n < 2; ++n) { const f32x4 v = acc[0][bj][m][n] * sc; wn[n].x = cvt_pk_bf16(v[0], v[1]); wn[n].y = cvt_pk_bf16(v[2], v[3]); }
                *(u32x4*)(rowp + bj * 128) = lane_row_pair(wn[0], wn[1]); } }
    }
};
struct OrderVW {
    int G, c; const char* ws;
    __device__ __forceinline__ bool next(int i, Unit& u) const { const int L = i * G + c; if (L >= 512) return false; const char* XC = ws + WS_XB; const char* XB2 = ws + WS_XB2; const char* WK = ws + WS_WK; const char* WV = ws + WS_WV;
        const int kind = L >> 8, l = L & 255, b = l >> 5, h = (l >> 3) & 3, cc = l & 7; u.pm = b * 8 + cc; u.pn = l | (kind << 8); u.aux = h;
        u.a = (kind ? WK : WV) + (size_t)h * 131072; u.b = (kind ? XC : XB2) + (size_t)u.pm * (256 * DM * 2) + (size_t)h * 512; return true; }
};
struct EpiVW {
    static constexpr bool PERM = false, AFTER_DRAIN = false;
    bf16_t* VC; bf16_t* WKT; const float* DW; float* DNP;
    __device__ __forceinline__ void operator()(const f32x4 (&acc)[2][2][4][2], const Unit& u, int wr, int wc, int fr, int fq) const {
        const int h = u.aux, kind = u.pn >> 8, l = u.pn & 255, rl0 = wr * 64 + fr, col0 = wc * 32 + 4 * fq; const int ldo = kind ? 256 : 512; bf16_t* base = (kind ? WKT : VC) + (size_t)l * 256 * ldo;
        f32x4 scq[2][2];
#pragma unroll
        for (int bj = 0; bj < 2; ++bj)
#pragma unroll
            for (int n = 0; n < 2; ++n) scq[bj][n] = kind ? *(const f32x4*)(DW + (size_t)h * MA + u.pm * 256 + col0 + bj * 128 + n * 16) * 0.0625f : (f32x4){1.f, 1.f, 1.f, 1.f};
#pragma unroll
        for (int ai = 0; ai < 2; ++ai)
#pragma unroll
            for (int m = 0; m < 4; ++m) { bf16_t* rowp = base + (size_t)(rl0 + ai * 128 + m * 16) * ldo + wc * 32 + lane_row_col(fq); float rsum = 0.f;
#pragma unroll
                for (int bj = 0; bj < 2; ++bj) { u32x2 wn[2];
#pragma unroll
                    for (int n = 0; n < 2; ++n) { const f32x4 v = acc[ai][bj][m][n] * scq[bj][n]; u32x2 w; w.x = cvt_pk_bf16(v[0], v[1]); w.y = cvt_pk_bf16(v[2], v[3]); wn[n] = w;
                        rsum += (bf_lo(w.x) + bf_hi(w.x)) + (bf_lo(w.y) + bf_hi(w.y)); }
                    *(u32x4*)(rowp + bj * 128) = lane_row_pair(wn[0], wn[1]); }
                if (kind) { rsum += __shfl_xor(rsum, 16); rsum += __shfl_xor(rsum, 32); if (fq == 0) DNP[((size_t)l * 256 + rl0 + ai * 128 + m * 16) * 4 + wc] = rsum; }
                asm volatile("" ::: "memory"); }
    }
};
__device__ __forceinline__ void p3_qkv(const Ctx& F) {
    unsigned char* ws = F.ws;
    { Gemm g{DM, 256, 256}; OrderQK S{F.G, F.bid, (const char*)ws}; EpiQK E{(bf16_t*)(ws + WS_K), (bf16_t*)(ws + WS_PQ), (const float*)(ws + WS_DG)};
      pg8::gemm_phase<EpiQK, OrderQK>(F.lds, g, S, E); }
    { Gemm g{256, DM, 256}; OrderVW S{F.G, F.bid, (const char*)ws}; EpiVW E{(bf16_t*)(ws + WS_VC), (bf16_t*)(ws + WS_WKT), (const float*)(ws + WS_DW), (float*)(ws + WS_DN4)};
      pg8::gemm_phase<EpiVW, OrderVW>(F.lds, g, S, E); }
}

__device__ __forceinline__ void p3_s12(const Ctx& F) {
    unsigned char* ws = F.ws;
    { Gemm g{DM, 256, 256}; OrderS12 S{F.G, (F.bid - 32) & 255, (const char*)ws}; EpiS12 E{(bf16_t*)(ws + WS_Q), (bf16_t*)(ws + WS_K), (bf16_t*)(ws + WS_VS)};
      pg8::gemm_phase<EpiS12, OrderS12>(F.lds, g, S, E); }
}
struct OrderUnitNT {
    int n, G, c; const char* A; size_t astep_pm, astep_h, astep_u; const char* B; size_t bstep_pm, bstep_h, bstep_u;
    __device__ __forceinline__ bool next(int i, Unit& u) const { const int L = i * G + c; if (L >= n) return false;
        const int b = L >> 5, h = (L >> 3) & 3, cc = L & 7; u.pm = b * 8 + cc; u.pn = L; u.aux = h;
        u.a = A + (size_t)u.pm * astep_pm + (size_t)h * astep_h + (size_t)L * astep_u; u.b = B + (size_t)u.pm * bstep_pm + (size_t)h * bstep_h + (size_t)L * bstep_u; return true; }
};
struct EpiScore {
    static constexpr bool PERM = false, AFTER_DRAIN = false;
    bf16_t* PQ; const float* DA; const float* DR; float* DENP;
    __device__ __forceinline__ void operator()(const f32x4 (&acc)[2][2][4][2], const Unit& u, int wr, int wc, int fr, int fq) const {
        const int h = u.aux, rl0 = wr * 64 + fr, col0 = wc * 32 + 4 * fq; const size_t vb = (size_t)h * MA + (size_t)u.pm * 256;
        float atv[2][4]; f32x4 rrv[2][2];
#pragma unroll
        for (int ai = 0; ai < 2; ++ai)
#pragma unroll
            for (int m = 0; m < 4; ++m) atv[ai][m] = DA[vb + rl0 + ai * 128 + m * 16];
#pragma unroll
        for (int bj = 0; bj < 2; ++bj)
#pragma unroll
            for (int n = 0; n < 2; ++n) rrv[bj][n] = *(const f32x4*)(DR + vb + col0 + bj * 128 + n * 16);
#pragma unroll
        for (int ai = 0; ai < 2; ++ai)
#pragma unroll
            for (int m = 0; m < 4; ++m) { int t_ = rl0 + ai * 128 + m * 16; asm volatile("" : "+v"(t_)); const int t = t_; const float at = atv[ai][m]; float rs_ = 0.f; bf16_t* rowp = PQ + ((size_t)u.pn * 256 + t) * 512 + wc * 32 + lane_row_col(fq);
#pragma unroll
                for (int bj = 0; bj < 2; ++bj) { u32x2 wn[2];
#pragma unroll
                    for (int n = 0; n < 2; ++n) { const int c = col0 + bj * 128 + n * 16; f32x4 v; const f32x4 rr = rrv[bj][n];
#pragma unroll
                        for (int j = 0; j < 4; ++j) { const float e = fast_exp(fminf(at + rr[j], 60.f)); v[j] = (c + j <= t) ? acc[ai][bj][m][n][j] * e : 0.f; rs_ += v[j]; }
                        wn[n].x = cvt_pk_bf16(v[0], v[1]); wn[n].y = cvt_pk_bf16(v[2], v[3]); }
                    *(u32x4*)(rowp + bj * 128) = lane_row_pair(wn[0], wn[1]); }
                rs_ += __shfl_xor(rs_, 16); rs_ += __shfl_xor(rs_, 32);
                if (fq == 0) DENP[(vb + t) * 4 + wc] = rs_; asm volatile("" ::: "memory"); }
    }
};
struct EpiF32Unit {
    static constexpr bool PERM = false, AFTER_DRAIN = false;
    bf16_t* O;
    __device__ __forceinline__ void operator()(const f32x4 (&acc)[2][2][4][2], const Unit& u, int wr, int wc, int fr, int fq) const {
        bf16_t* base = O + (size_t)u.pn * 65536 + (size_t)(wr * 64 + fr) * 256 + wc * 32 + lane_row_col(fq);
#pragma unroll
        for (int ai = 0; ai < 2; ++ai)
#pragma unroll
            for (int m = 0; m < 4; ++m)
#pragma unroll
                for (int bj = 0; bj < 2; ++bj) { u32x2 wn[2];
#pragma unroll
                    for (int n = 0; n < 2; ++n) { const f32x4 v = acc[ai][bj][m][n]; wn[n].x = cvt_pk_bf16(v[0], v[1]); wn[n].y = cvt_pk_bf16(v[2], v[3]); }
                    *(u32x4*)(base + (size_t)(ai * 128 + m * 16) * 256 + bj * 128) = lane_row_pair(wn[0], wn[1]); }
    }
};
__device__ __forceinline__ void p4_scores(const Ctx& F) {
    unsigned char* ws = F.ws;
    { Gemm g{512, DM, 256}; OrderUnitNT S{NUNIT, F.G, F.bid, (const char*)(ws + WS_PQ) + 512, 0, 0, (size_t)256 * 512 * 2, (const char*)(ws + WS_K), (size_t)256 * DM * 2, 512, 0};
      EpiScore E{(bf16_t*)(ws + WS_PQ), (const float*)(ws + WS_DA), (const float*)(ws + WS_DR), (float*)(ws + WS_DENP)}; pg8::gemm_phase<EpiScore, OrderUnitNT>(F.lds, g, S, E); }
}
__device__ __forceinline__ void p4_dc(const Ctx& F) {
    unsigned char* ws = F.ws;
    { Gemm g{512, 256, 256}; OrderUnitNT S{NUNIT, F.G, F.bid, (const char*)(ws + WS_VC), 0, 0, (size_t)256 * 512 * 2, (const char*)(ws + WS_WKT), 0, 0, (size_t)256 * 256 * 2};
      EpiF32Unit E{(bf16_t*)(F.out + O_Y)}; pg8::gemm_phase<EpiF32Unit, OrderUnitNT>(F.lds, g, S, E); }
}

template <int R> __device__ __forceinline__ void qn_rows(const u32x2 (&qq)[32], const f32x4 nv, int& sres) {
    if constexpr (R < 32) { const float s = wave_sum(bf_lo(qq[R].x) * nv[0] + bf_hi(qq[R].x) * nv[1] + bf_lo(qq[R].y) * nv[2] + bf_hi(qq[R].y) * nv[3]);
        const int sv = __builtin_amdgcn_readfirstlane(__builtin_bit_cast(int, s)); asm volatile("s_nop 3\n\tv_writelane_b32 %0, %1, %2" : "+v"(sres) : "s"(sv), "n"(R));
        qn_rows<R + 1>(qq, nv, sres); }
}
__device__ __forceinline__ void p5_scan_sample(const Ctx& F0) { Ctx F = F0; asm volatile("" : "+v"(F.tid), "+v"(F.lane), "+s"(F.gw));
    unsigned char* ws = F.ws; const float* DG = (const float*)(ws + WS_DG); const bf16_t* DCb = (const bf16_t*)(F.out + O_Y); bf16_t* VC = (bf16_t*)(ws + WS_VC);
    {   u32x4 dw[2][8]; float ge[2][8];
#pragma unroll
        for (int k = 0; k < 2; ++k) { const int idx = F.bid * 512 + F.tid + k * F.G * 512, bh = idx >> 13, q8 = idx & 8191, e = q8 >> 5, d8 = (q8 & 31) * 8, b = bh >> 2, h = bh & 3;
#pragma unroll
            for (int c = 0; c < 8; ++c) { dw[k][c] = __builtin_nontemporal_load((const u32x4*)(DCb + ((size_t)(bh * 8 + c) * 256 + e) * 256 + d8)); ge[k][c] = DG[(size_t)h * MA + b * SEQ + c * 256 + 255]; } }
#pragma unroll
        for (int k = 0; k < 2; ++k) { const int idx = F.bid * 512 + F.tid + k * F.G * 512, bh = idx >> 13, q8 = idx & 8191, e = q8 >> 5, d8 = (q8 & 31) * 8;
            float C[8];
#pragma unroll
            for (int j = 0; j < 8; ++j) C[j] = 0.f;
#pragma unroll
            for (int c = 0; c < 8; ++c) { float dc[8]; unpack8(dw[k][c], dc); *(u32x4*)(VC + ((size_t)(bh * 8 + c) * 256 + e) * 512 + 256 + d8) = pack8(C);
#pragma unroll
                for (int j = 0; j < 8; ++j) C[j] = C[j] * ge[k][c] + dc[j]; }
            __builtin_nontemporal_store((f32x4){C[0], C[1], C[2], C[3]}, (f32x4*)(F.out + O_CP + ((size_t)bh * 256 + e) * 256 + d8));
            __builtin_nontemporal_store((f32x4){C[4], C[5], C[6], C[7]}, (f32x4*)(F.out + O_CP + ((size_t)bh * 256 + e) * 256 + d8 + 4)); }
    }
    LAS float* npv = (LAS float*)F.lds;
    for (int u = F.bid; u < NUNIT; u += F.G) { const int bh = u >> 3, cc = u & 7, b = bh >> 2, h = bh & 3;
        const bf16_t* PQg = (const bf16_t*)(ws + WS_PQ);
        u32x2 qq[32];
        const bf16_t* qbase = PQg + ((size_t)u * 256 + F.wave * 32) * 512 + 256 + 4 * F.lane; asm volatile("" : "+v"(qbase));
#pragma unroll
        for (int r = 0; r < 32; ++r) qq[r] = *(const u32x2*)(qbase + r * 512);
        __syncthreads();
        if (F.tid < 256) { float n = 0.f; const float* DN = (const float*)(ws + WS_DN4);
            for (int j = 0; j < cc; ++j) { const f32x4 dp = *(const f32x4*)(DN + ((size_t)(bh * 8 + j) * 256 + F.tid) * 4); n = DG[(size_t)h * MA + b * SEQ + j * 256 + 255] * n + ((dp[0] + dp[1]) + (dp[2] + dp[3])); }
            npv[F.tid] = n; const f32x4 dl = *(const f32x4*)(DN + ((size_t)u * 256 + F.tid) * 4); if (cc == 7) F.out[O_NP + (size_t)bh * 256 + F.tid] = DG[(size_t)h * MA + b * SEQ + 7 * 256 + 255] * n + ((dl[0] + dl[1]) + (dl[2] + dl[3])); }
        __syncthreads();
        const f32x4 nv = *(const LAS f32x4*)(npv + 4 * F.lane); int sres = 0;
        qn_rows<0>(qq, nv, sres);
        if (F.lane < 32) ((float*)(ws + WS_QN))[(size_t)h * MA + (size_t)b * SEQ + cc * 256 + F.wave * 32 + F.lane] = __builtin_bit_cast(float, sres); }
}
__device__ __forceinline__ void p5s_sample(const Ctx& F0, int jk) { Ctx F = F0; asm volatile("" : "+v"(F.tid), "+v"(F.lane), "+s"(F.gw));
    unsigned char* ws = F.ws;
    LAS float* hs = (LAS float*)F.lds + 512; LAS float* red = (LAS float*)F.lds + 1024;
    for (int job = F.bid + jk * F.G; job < MS * HB; job += 2 * F.G) { const int i = job >> 2, h = job & 3; const size_t row = MP + i;
        const bf16_t* Q = (const bf16_t*)(ws + WS_Q) + row * 1024 + h * 256; const bf16_t* K = (const bf16_t*)(ws + WS_K) + row * 1024 + h * 256; const bf16_t* V = (const bf16_t*)(ws + WS_VS) + (size_t)i * 1024 + h * 256;
        const u32x2 qw = *(const u32x2*)(Q + 4 * F.lane), kw = *(const u32x2*)(K + 4 * F.lane);
        const f32x4 q4 = (f32x4){bf_lo(qw.x), bf_hi(qw.x), bf_lo(qw.y), bf_hi(qw.y)}, k4 = (f32x4){bf_lo(kw.x), bf_hi(kw.x), bf_lo(kw.y), bf_hi(kw.y)};
        const f32x4 n0 = *(const f32x4*)(F.in[3] + ((size_t)i * 4 + h) * 256 + 4 * F.lane);
        const float li = ((const float*)(ws + WS_GLI))[(size_t)h * MA + row], lf = ((const float*)(ws + WS_GLF))[(size_t)h * MA + row], m0 = F.in[4][i * 4 + h];
        const float mn = fmaxf(lf + m0, li), g = __expf(lf + m0 - mn), wi = __expf(li - mn);
        const float qk = wave_sum(q4[0] * k4[0] + q4[1] * k4[1] + q4[2] * k4[2] + q4[3] * k4[3]), nq = wave_sum(n0[0] * q4[0] + n0[1] * q4[1] + n0[2] * q4[2] + n0[3] * q4[3]);
        const float sc = wi * qk, den = sc + g * nq, dinv = 1.0f / fmaxf(fabsf(den), __expf(-mn));
        const float* C0 = F.in[2] + (((size_t)i * 4 + h) * 256 + F.wave * 32) * 256 + 4 * F.lane; float* C1 = F.out + O_CS + (((size_t)i * 4 + h) * 256 + F.wave * 32) * 256 + 4 * F.lane;
        __syncthreads();
#pragma unroll 1
        for (int r8 = 0; r8 < 32; r8 += 8) { f32x4 c[8]; float ve[8], cq[8];
#pragma unroll
            for (int r = 0; r < 8; ++r) { c[r] = __builtin_nontemporal_load((const f32x4*)(C0 + (size_t)(r8 + r) * 256)); ve[r] = bf2f(V[F.wave * 32 + r8 + r]); }
#pragma unroll
            for (int r = 0; r < 8; ++r) { cq[r] = c[r][0] * q4[0] + c[r][1] * q4[1] + c[r][2] * q4[2] + c[r][3] * q4[3]; const float wv = wi * ve[r]; __builtin_nontemporal_store(c[r] * g + k4 * wv, (f32x4*)(C1 + (size_t)(r8 + r) * 256)); }
#pragma unroll
            for (int r = 0; r < 8; ++r) { cq[r] = wave_sum(cq[r]); if (F.lane == 0) hs[F.wave * 32 + r8 + r] = (sc * ve[r] + g * cq[r]) * dinv; } }
        if (F.wave == 0) { *(f32x4*)(F.out + O_NS + ((size_t)i * 4 + h) * 256 + 4 * F.lane) = n0 * g + k4 * wi; if (F.lane == 0) F.out[O_MS + i * 4 + h] = mn; }
        __syncthreads();
        const bf16_t* PB = (const bf16_t*)(ws + WS_PROJB) + row * 3072; const bf16_t* XC = (const bf16_t*)(ws + WS_XB) + row * DM;
        float x = 0.f; const int ch = h * 256 + (F.tid & 255);
        if (F.tid < 256) x = hs[F.tid] * bf2f(PB[1024 + ch]);
        float p = wave_sum(x); if (F.lane == 0) red[F.wave] = p;
        __syncthreads();
        const float mu = (red[0] + red[1] + red[2] + red[3]) * (1.f / 256.f), dx = x - mu;
        __syncthreads();
        p = wave_sum(F.tid < 256 ? dx * dx : 0.f); if (F.lane == 0) red[F.wave] = p;
        __syncthreads();
        const float rstd = 1.0f / sqrtf((red[0] + red[1] + red[2] + red[3]) * (1.f / 256.f) + EPS);
        if (F.tid < 256) ((bf16_t*)(ws + WS_Y))[row * DMIX + 1024 + ch] = f2bf((dx * rstd * F.in[21][ch] + F.in[22][ch] * bf2f(XC[ch])) * bf2f(PB[2048 + ch]));
        __syncthreads();
    }
}
struct EpiHOut {
    static constexpr bool PERM = false, AFTER_DRAIN = true;
    const float* DENP; const float* DG; const float* QN; const float* DEM; const bf16_t* PB; const bf16_t* XC; bf16_t* Y; const float* gng; const float* skip;
    __device__ __forceinline__ void fused(f32x4 (&acc)[2][2][4][2], const Unit& u, int wr, int wc, int fr, int fq, LAS unsigned char* lds, int wid, int lane) const {
        const int h = u.aux, rl0 = wr * 64 + fr, cb0 = h * 256 + wc * 32 + lane_row_col(fq); const size_t vb = (size_t)h * MA + (size_t)u.pm * 256;
        LAS float* P1 = (LAS float*)lds; LAS float* P2 = (LAS float*)lds + 1024;
#pragma unroll
        for (int ai = 0; ai < 2; ++ai)
#pragma unroll
            for (int bj = 0; bj < 2; ++bj)
#pragma unroll
                for (int m = 0; m < 4; ++m)
#pragma unroll
                    for (int j = 0; j < 4; ++j) { const auto sw = __builtin_amdgcn_permlane16_swap(__float_as_uint(acc[ai][bj][m][0][j]), __float_as_uint(acc[ai][bj][m][1][j]), false, false);
                        acc[ai][bj][m][0][j] = __uint_as_float(sw[0]); acc[ai][bj][m][1][j] = __uint_as_float(sw[1]); }
#pragma unroll
        for (int ai = 0; ai < 2; ++ai) { u32x4 ow[4][2]; f32x4 dp[4]; float dgq[4], dem[4];
#pragma unroll
            for (int m = 0; m < 4; ++m) { const int t = rl0 + ai * 128 + m * 16; const size_t row = (size_t)u.pm * 256 + t; dp[m] = *(const f32x4*)(DENP + (vb + t) * 4); dgq[m] = QN[vb + t]; dem[m] = DEM[vb + t];
#pragma unroll
                for (int bj = 0; bj < 2; ++bj) ow[m][bj] = *(const u32x4*)(PB + row * 3072 + 1024 + cb0 + bj * 128); }
#pragma unroll
            for (int m = 0; m < 4; ++m) { const int t = rl0 + ai * 128 + m * 16; const float den = (dp[m][0] + dp[m][1]) + (dp[m][2] + dp[m][3]) + dgq[m];
                const float dinv = 1.0f / fmaxf(fabsf(den), dem[m]); float s = 0.f;
#pragma unroll
                for (int bj = 0; bj < 2; ++bj) { float o8[8]; unpack8(ow[m][bj], o8);
#pragma unroll
                    for (int n = 0; n < 2; ++n) { f32x4 v = acc[ai][bj][m][n] * dinv; v[0] *= o8[4 * n]; v[1] *= o8[4 * n + 1]; v[2] *= o8[4 * n + 2]; v[3] *= o8[4 * n + 3]; acc[ai][bj][m][n] = v; s += (v[0] + v[1]) + (v[2] + v[3]); } }
                s += __shfl_xor(s, 16); s += __shfl_xor(s, 32); if (fq == 0) P1[t * 4 + wc] = s; } }
        asm volatile("s_waitcnt lgkmcnt(0)" ::: "memory"); __builtin_amdgcn_s_barrier(); asm volatile("" ::: "memory");
#pragma unroll
        for (int ai = 0; ai < 2; ++ai)
#pragma unroll
            for (int m = 0; m < 4; ++m) { const int t = rl0 + ai * 128 + m * 16; const f32x4 ps = *(const LAS f32x4*)(P1 + t * 4); const float mu = ((ps[0] + ps[1]) + (ps[2] + ps[3])) * (1.f / 256.f); float q = 0.f;
#pragma unroll
                for (int bj = 0; bj < 2; ++bj)
#pragma unroll
                    for (int n = 0; n < 2; ++n) { f32x4 v = acc[ai][bj][m][n] - mu; acc[ai][bj][m][n] = v; q += (v[0] * v[0] + v[1] * v[1]) + (v[2] * v[2] + v[3] * v[3]); }
                q += __shfl_xor(q, 16); q += __shfl_xor(q, 32); if (fq == 0) P2[t * 4 + wc] = q; }
        asm volatile("s_waitcnt lgkmcnt(0)" ::: "memory"); __builtin_amdgcn_s_barrier(); asm volatile("" ::: "memory");
#pragma unroll
        for (int ai = 0; ai < 2; ++ai) { float rstd[4];
#pragma unroll
            for (int m = 0; m < 4; ++m) { const int t = rl0 + ai * 128 + m * 16; const f32x4 ps = *(const LAS f32x4*)(P2 + t * 4); rstd[m] = 1.0f / sqrtf(((ps[0] + ps[1]) + (ps[2] + ps[3])) * (1.f / 256.f) + EPS); }
#pragma unroll
            for (int bj = 0; bj < 2; ++bj) { u32x4 xw[4], zw[4]; f32x4 gg[2], sk[2];
#pragma unroll
                for (int m = 0; m < 4; ++m) { const size_t row = (size_t)u.pm * 256 + rl0 + ai * 128 + m * 16; xw[m] = *(const u32x4*)(XC + row * DM + cb0 + bj * 128); zw[m] = *(const u32x4*)(PB + row * 3072 + 2048 + cb0 + bj * 128); }
#pragma unroll
                for (int n = 0; n < 2; ++n) { gg[n] = *(const f32x4*)(gng + cb0 + bj * 128 + 4 * n); sk[n] = *(const f32x4*)(skip + cb0 + bj * 128 + 4 * n); }
#pragma unroll
                for (int m = 0; m < 4; ++m) { const size_t row = (size_t)u.pm * 256 + rl0 + ai * 128 + m * 16; float x8[8], z8[8], o8[8]; unpack8(xw[m], x8); unpack8(zw[m], z8);
#pragma unroll
                    for (int n = 0; n < 2; ++n) { const f32x4 v = acc[ai][bj][m][n] * rstd[m] * gg[n];
#pragma unroll
                        for (int j = 0; j < 4; ++j) o8[4 * n + j] = (v[j] + sk[n][j] * x8[4 * n + j]) * z8[4 * n + j]; }
                    *(u32x4*)(Y + row * DMIX + 1024 + cb0 + bj * 128) = pack8(o8); } } }
    }
};
__device__ __forceinline__ void p6_hout(const Ctx& F) {
    unsigned char* ws = F.ws; Gemm g{512, 512, 512};
    OrderUnitNT S{NUNIT, F.G, F.bid, (const char*)(ws + WS_PQ), 0, 0, (size_t)256 * 512 * 2, (const char*)(ws + WS_VC), 0, 0, (size_t)256 * 512 * 2};
    EpiHOut E{(const float*)(ws + WS_DENP), (const float*)(ws + WS_DG), (const float*)(ws + WS_QN), (const float*)(ws + WS_DEM), (const bf16_t*)(ws + WS_PROJB), (const bf16_t*)(ws + WS_XB), (bf16_t*)(ws + WS_Y), F.in[21], F.in[22]};
    pg8::gemm_phase<EpiHOut, OrderUnitNT, false, true>(F.lds, g, S, E);
}
template <class PtrF, class Ef>
__device__ __forceinline__ void sample_gemm(const Ctx& F, int nitems, int K, int lda, int ldb, const PtrF& P, const Ef& E) {
    int lane_ = F.lane; asm volatile("" : "+v"(lane_));
    const int l15 = lane_ & 15, lq = lane_ >> 4, w = F.wave;
    for (int item = F.bid; item < nitems; item += F.G) {
        const bf16_t* A; const bf16_t* B; P(item, A, B);
        const bf16_t* ap = A + (size_t)(16 * w + l15) * lda + 8 * lq; const bf16_t* bp = B + (size_t)l15 * ldb + 8 * lq;
        f32x4 acc = (f32x4){0.f, 0.f, 0.f, 0.f};
        for (int k0 = 0; k0 < K; k0 += 256) { bf16x8 a[8], b[8];
#pragma unroll
            for (int j = 0; j < 8; ++j) { a[j] = *(const bf16x8*)(ap + k0 + 32 * j); b[j] = *(const bf16x8*)(bp + k0 + 32 * j); }
#pragma unroll
            for (int j = 0; j < 8; ++j) acc = __builtin_amdgcn_mfma_f32_16x16x32_bf16(a[j], b[j], acc, 0, 0, 0); }
#pragma unroll
        for (int r = 0; r < 4; ++r) E(item, 16 * w + 4 * lq + r, l15, acc[r]);
    }
}
__device__ __forceinline__ void sample_inproj(const Ctx& F) {
    unsigned char* ws = F.ws; const bf16_t* XB = (const bf16_t*)(ws + WS_XB) + (size_t)MP * DM; const bf16_t* W = (const bf16_t*)(ws + WS_WIN);
    bf16_t* PA = (bf16_t*)(ws + WS_PROJA) + (size_t)MP * 3072; bf16_t* PB = (bf16_t*)(ws + WS_PROJB) + (size_t)MP * 3072; bf16_t* XB2 = (bf16_t*)(ws + WS_XB2) + (size_t)MP * DM; const float* rs = (const float*)(ws + WS_RS) + MP;
    int lane_ = F.lane; asm volatile("" : "+v"(lane_)); const int l15 = lane_ & 15, lq = lane_ >> 4, w = F.wave; LAS f32x4* red = (LAS f32x4*)F.lds;
    for (int item = F.bid; item < 256; item += F.G) { const int rb = item & 1, cb = item >> 1;
        const bf16_t* ap = XB + (size_t)(rb * 64 + l15) * DM + w * 128 + 8 * lq; const bf16_t* bp = W + (size_t)(cb * 48 + l15) * DM + w * 128 + 8 * lq;
        bf16x8 a[4][4], b[4][3]; float rsv[2][4];
#pragma unroll
        for (int j = 0; j < 4; ++j) {
#pragma unroll
            for (int m = 0; m < 4; ++m) a[j][m] = *(const bf16x8*)(ap + (size_t)(16 * m) * DM + 32 * j);
#pragma unroll
            for (int n = 0; n < 3; ++n) b[j][n] = *(const bf16x8*)(bp + (size_t)(16 * n) * DM + 32 * j); }
#pragma unroll
        for (int q = 0; q < 2; ++q) { const int t = w + 8 * q;
#pragma unroll
            for (int r = 0; r < 4; ++r) rsv[q][r] = t < 12 ? rs[rb * 64 + (t / 3) * 16 + 4 * lq + r] : 0.f; }
        f32x4 acc[4][3];
#pragma unroll
        for (int m = 0; m < 4; ++m)
#pragma unroll
            for (int n = 0; n < 3; ++n) acc[m][n] = (f32x4){0.f, 0.f, 0.f, 0.f};
#pragma unroll
        for (int j = 0; j < 4; ++j)
#pragma unroll
            for (int m = 0; m < 4; ++m)
#pragma unroll
                for (int n = 0; n < 3; ++n) acc[m][n] = __builtin_amdgcn_mfma_f32_16x16x32_bf16(a[j][m], b[j][n], acc[m][n], 0, 0, 0);
        __syncthreads();
#pragma unroll
        for (int m = 0; m < 4; ++m)
#pragma unroll
            for (int n = 0; n < 3; ++n) red[(w * 12 + m * 3 + n) * 64 + F.lane] = acc[m][n];
        __syncthreads();
#pragma unroll
        for (int q = 0; q < 2; ++q) { const int t = w + 8 * q;
            if (t < 12) { f32x4 s = red[(0 * 12 + t) * 64 + F.lane];
#pragma unroll
                for (int ww = 1; ww < 8; ++ww) s = s + red[(ww * 12 + t) * 64 + F.lane];
                const int mt = t / 3, nt = t - 3 * mt, col = cb * 48 + nt * 16 + l15, grp = col >> 10;
#pragma unroll
                for (int r = 0; r < 4; ++r) { const int row = rb * 64 + mt * 16 + 4 * lq + r; float v = s[r] * rsv[q][r];
                    if (grp < 2) { const f32x2 g2 = gelu_pk((f32x2){v, v}); v = g2.x; } else if (grp == 2 || grp == 5) v = siluf_(v); else if (grp == 4) v = sigmoidf_(v);
                    bf16_t* dst = col < 3072 ? PA + (size_t)row * 3072 + col : (col < 4096 ? XB2 + (size_t)row * DM + (col - 3072) : PB + (size_t)row * 3072 + (col - 3072)); *dst = f2bf(v); } } }
    }
    __syncthreads();
}
__device__ __forceinline__ void sample_qkv(const Ctx& F) {
    unsigned char* ws = F.ws; const bf16_t* XC = (const bf16_t*)(ws + WS_XB) + (size_t)MP * DM; const bf16_t* XBr = (const bf16_t*)(ws + WS_PROJB) + (size_t)MP * 3072;
    const bf16_t* WQ = (const bf16_t*)(ws + WS_WQ); const bf16_t* WK = (const bf16_t*)(ws + WS_WK); const bf16_t* WV = (const bf16_t*)(ws + WS_WV);
    bf16_t* Q = (bf16_t*)(ws + WS_Q) + (size_t)MP * 1024; bf16_t* Kk = (bf16_t*)(ws + WS_K) + (size_t)MP * 1024; bf16_t* Vs = (bf16_t*)(ws + WS_VS);
    sample_gemm(F, 128, 256, DM, 256,
        [=](int item, const bf16_t*& A, const bf16_t*& B) { const int which = item >> 6, it = item & 63, h = it >> 4; A = XC + h * 256; B = (which ? WK : WQ) + (size_t)h * 65536 + (size_t)(it & 15) * 16 * 256; },
        [=](int item, int r, int c, float acc) { const int which = item >> 6, it = item & 63; bf16_t* O = which ? Kk : Q; O[(size_t)r * 1024 + it * 16 + c] = f2bf(which ? acc * 0.0625f : acc); });
    sample_gemm(F, 64, 256, 3072, 256,
        [=](int item, const bf16_t*& A, const bf16_t*& B) { const int h = item >> 4; A = XBr + h * 256; B = WV + (size_t)h * 65536 + (size_t)(item & 15) * 16 * 256; },
        [=](int item, int r, int c, float acc) { Vs[(size_t)r * 1024 + item * 16 + c] = f2bf(acc); });
}
__device__ __forceinline__ void sample_outproj(const Ctx& F) {
    unsigned char* ws = F.ws; const bf16_t* Y = (const bf16_t*)(ws + WS_Y) + (size_t)MP * DMIX; const bf16_t* W = (const bf16_t*)(ws + WS_WOUT);
    const float* xs = F.in[1]; float* out = F.out + O_YS; bf16_t* X1B = (bf16_t*)(ws + WS_X1B) + (size_t)MP * DM;
    sample_gemm(F, DM / 16, DMIX, DMIX, DMIX,
        [=](int item, const bf16_t*& A, const bf16_t*& B) { A = Y; B = W + (size_t)item * 16 * DMIX; },
        [=](int item, int r, int c, float acc) { const int col = item * 16 + c; const float v = xs[(size_t)r * DM + col] + acc; out[(size_t)r * DM + col] = v; X1B[(size_t)r * DM + col] = f2bf(v); });
}
__device__ __forceinline__ void sample_ple(const Ctx& F) {
    unsigned char* ws = F.ws; const bf16_t* X1B = (const bf16_t*)(ws + WS_X1B) + (size_t)MP * DM; const bf16_t* PBs = (const bf16_t*)(ws + WS_PB) + (size_t)MP * DPLE;
    const bf16_t* WG = (const bf16_t*)(ws + WS_WPG); const bf16_t* WP = (const bf16_t*)(ws + WS_WPP); const float* bias = F.in[25];
    bf16_t* GB = (bf16_t*)(ws + WS_GB) + (size_t)MP * DM; bf16_t* EB = (bf16_t*)(ws + WS_EB) + (size_t)MP * DM;
    sample_gemm(F, DM / 16, DM, DM, DM,
        [=](int item, const bf16_t*& A, const bf16_t*& B) { A = X1B; B = WG + (size_t)item * 16 * DM; },
        [=](int item, int r, int c, float acc) { const int col = item * 16 + c; GB[(size_t)r * DM + col] = f2bf(sigmoidf_(acc + bias[col])); });
    sample_gemm(F, DM / 16, DPLE, DPLE, DPLE,
        [=](int item, const bf16_t*& A, const bf16_t*& B) { A = PBs; B = WP + (size_t)item * 16 * DPLE; },
        [=](int item, int r, int c, float acc) { EB[(size_t)r * DM + item * 16 + c] = f2bf(acc); });
}
template <class PtrF, class Ef>
__device__ __forceinline__ void sample_gemm_ks(const Ctx& F, int nitems, int K, int lda, int ldb, const PtrF& P, const Ef& E) {
    int lane_ = F.lane; asm volatile("" : "+v"(lane_)); const int l15 = lane_ & 15, lq = lane_ >> 4, w = F.wave; LAS f32x4* red = (LAS f32x4*)F.lds;
    const int ks = K >> 3;
    for (int item = F.bid; item < nitems; item += F.G) {
        const bf16_t* A; const bf16_t* B; P(item, A, B);
        const bf16_t* ap = A + (size_t)l15 * lda + w * ks + 8 * lq; const bf16_t* bp = B + (size_t)l15 * ldb + w * ks + 8 * lq;
        f32x4 acc[2][4];
#pragma unroll
        for (int m = 0; m < 2; ++m)
#pragma unroll
            for (int n = 0; n < 4; ++n) acc[m][n] = (f32x4){0.f, 0.f, 0.f, 0.f};
        for (int k0 = 0; k0 < ks; k0 += 128) { bf16x8 a[4][2], b[4][4];
#pragma unroll
            for (int j = 0; j < 4; ++j) {
#pragma unroll
                for (int m = 0; m < 2; ++m) a[j][m] = (k0 + 32 * j < ks) ? *(const bf16x8*)(ap + (size_t)(16 * m) * lda + k0 + 32 * j) : (bf16x8){0, 0, 0, 0, 0, 0, 0, 0};
#pragma unroll
                for (int n = 0; n < 4; ++n) b[j][n] = (k0 + 32 * j < ks) ? *(const bf16x8*)(bp + (size_t)(16 * n) * ldb + k0 + 32 * j) : (bf16x8){0, 0, 0, 0, 0, 0, 0, 0}; }
#pragma unroll
            for (int j = 0; j < 4; ++j)
#pragma unroll
                for (int m = 0; m < 2; ++m)
#pragma unroll
                    for (int n = 0; n < 4; ++n) acc[m][n] = __builtin_amdgcn_mfma_f32_16x16x32_bf16(a[j][m], b[j][n], acc[m][n], 0, 0, 0); }
        __syncthreads();
#pragma unroll
        for (int m = 0; m < 2; ++m)
#pragma unroll
            for (int n = 0; n < 4; ++n) red[(w * 8 + m * 4 + n) * 64 + F.lane] = acc[m][n];
        __syncthreads();
        f32x4 s = red[(0 * 8 + w) * 64 + F.lane];
#pragma unroll
        for (int ww = 1; ww < 8; ++ww) s = s + red[(ww * 8 + w) * 64 + F.lane];
        const int mt = w >> 2, nt = w & 3;
#pragma unroll
        for (int r = 0; r < 4; ++r) E(item, 16 * mt + 4 * lq + r, 16 * nt + l15, s[r]);
    }
    __syncthreads();
}
__device__ __forceinline__ void sample_outproj_ks(const Ctx& F) {
    unsigned char* ws = F.ws; const bf16_t* Y = (const bf16_t*)(ws + WS_Y) + (size_t)MP * DMIX; const bf16_t* W = (const bf16_t*)(ws + WS_WOUT);
    const float* xs = F.in[1]; bf16_t* X1B = (bf16_t*)(ws + WS_X1B) + (size_t)MP * DM;
    int lane_ = F.lane; asm volatile("" : "+v"(lane_)); const int l15 = lane_ & 15, lq = lane_ >> 4, w = F.wave; LAS f32x4* red = (LAS f32x4*)F.lds;
    for (int item = F.bid; item < 256; item += F.G) { const int rb = item & 3, cb = item >> 2;
        const bf16_t* ap = Y + (size_t)(rb * 32 + l15) * DMIX + w * 256 + 8 * lq; const bf16_t* bp = W + (size_t)(cb * 16 + l15) * DMIX + w * 256 + 8 * lq;
        bf16x8 a[8][2], b[8]; float xr[4] = {0.f, 0.f, 0.f, 0.f};
#pragma unroll
        for (int j = 0; j < 8; ++j) { a[j][0] = *(const bf16x8*)(ap + 32 * j); a[j][1] = *(const bf16x8*)(ap + (size_t)16 * DMIX + 32 * j); b[j] = *(const bf16x8*)(bp + 32 * j); }
        if (w < 2) {
#pragma unroll
            for (int r = 0; r < 4; ++r) xr[r] = xs[(size_t)(rb * 32 + 16 * w + 4 * lq + r) * DM + cb * 16 + l15]; }
        f32x4 acc[2] = {(f32x4){0.f, 0.f, 0.f, 0.f}, (f32x4){0.f, 0.f, 0.f, 0.f}};
#pragma unroll
        for (int j = 0; j < 8; ++j)
#pragma unroll
            for (int m = 0; m < 2; ++m) acc[m] = __builtin_amdgcn_mfma_f32_16x16x32_bf16(a[j][m], b[j], acc[m], 0, 0, 0);
        __syncthreads();
        red[(w * 2 + 0) * 64 + F.lane] = acc[0]; red[(w * 2 + 1) * 64 + F.lane] = acc[1];
        __syncthreads();
        if (w < 2) { f32x4 s = red[(0 * 2 + w) * 64 + F.lane];
#pragma unroll
            for (int ww = 1; ww < 8; ++ww) s = s + red[(ww * 2 + w) * 64 + F.lane];
#pragma unroll
            for (int r = 0; r < 4; ++r) X1B[(size_t)(rb * 32 + 16 * w + 4 * lq + r) * DM + cb * 16 + l15] = f2bf(xr[r] + s[r]); }
    }
    __syncthreads();
}
__device__ __forceinline__ void sample_ple_ks(const Ctx& F) {
    unsigned char* ws = F.ws; const bf16_t* X1B = (const bf16_t*)(ws + WS_X1B) + (size_t)MP * DM; const bf16_t* PBs = (const bf16_t*)(ws + WS_PB) + (size_t)MP * DPLE;
    const bf16_t* WG = (const bf16_t*)(ws + WS_WPG); const bf16_t* WP = (const bf16_t*)(ws + WS_WPP); const float* bias = F.in[25];
    bf16_t* GB = (bf16_t*)(ws + WS_GB) + (size_t)MP * DM; bf16_t* EB = (bf16_t*)(ws + WS_EB) + (size_t)MP * DM;
    sample_gemm_ks(F, 64, DM, DM, DM,
        [=](int item, const bf16_t*& A, const bf16_t*& B) { A = X1B + (size_t)(item & 3) * 32 * DM; B = WG + (size_t)(item >> 2) * 64 * DM; },
        [=](int item, int r, int c, float acc) { const int row = (item & 3) * 32 + r, col = (item >> 2) * 64 + c; GB[(size_t)row * DM + col] = f2bf(sigmoidf_(acc + bias[col])); });
    sample_gemm_ks(F, 64, DPLE, DPLE, DPLE,
        [=](int item, const bf16_t*& A, const bf16_t*& B) { A = PBs + (size_t)(item & 3) * 32 * DPLE; B = WP + (size_t)(item >> 2) * 64 * DPLE; },
        [=](int item, int r, int c, float acc) { const int row = (item & 3) * 32 + r, col = (item >> 2) * 64 + c; EB[(size_t)row * DM + col] = f2bf(acc); });
}
#define XB_TMO      128
#define XB_XCNT(j)  (256  + 64 * (j))
#define XB_XSUB(j)  (1280 + 64 * (j))
#define XB_XGEN(j)  (2304 + 64 * (j))
#define XB_TOP      3328
#define XB_TOPGEN   3392
#define XCD_BAR_WORDS 3456
#define XB_SPIN_CAP (1u << 18)
__device__ __forceinline__ unsigned xb_ld(unsigned* p)              { return __hip_atomic_load(p, __ATOMIC_RELAXED, __HIP_MEMORY_SCOPE_AGENT); }
__device__ __forceinline__ unsigned xb_add(unsigned* p, unsigned v) { return __hip_atomic_fetch_add(p, v, __ATOMIC_RELAXED, __HIP_MEMORY_SCOPE_AGENT); }
__device__ __forceinline__ unsigned xb_xcc_id() { return (unsigned)__builtin_amdgcn_s_getreg((3 << 11) | 20) & 0xFu; }
#define XB_SPIN(cond, bar) do { unsigned _sp = 0; while (cond) { __builtin_amdgcn_s_sleep(1); \
    if ((++_sp & 255u) == 0u) { if (xb_ld(&(bar)[XB_TMO])) break; if (_sp > XB_SPIN_CAP) { atomicAdd(&(bar)[XB_TMO], 1u); break; } } } } while (0)
struct XcdBarrier { unsigned* bar; unsigned x; volatile LAS unsigned* st; };
__device__ __forceinline__ XcdBarrier xcd_barrier_post(unsigned* bar, volatile LAS unsigned* st) {
    XcdBarrier b; b.bar = bar; b.x = xb_xcc_id(); b.st = st;
    if (threadIdx.x == 0) (void)xb_add(&bar[XB_XCNT(b.x)], 1u);
    return b;
}
__device__ __forceinline__ void xcd_barrier_complete(unsigned* bar, unsigned x, unsigned& nloc, unsigned& nx) {
    const unsigned G = gridDim.x * gridDim.y * gridDim.z;
    unsigned sum, cnt, mine, sp = 0u;
    for (;;) {
        sum = 0u; cnt = 0u; mine = 0u;
#pragma unroll
        for (unsigned j = 0; j < 16; ++j) { const unsigned c = xb_ld(&bar[XB_XCNT(j)]); sum += c; cnt += (c > 0u) ? 1u : 0u; mine = (j == x) ? c : mine; }
        if (sum == G) break;
        __builtin_amdgcn_s_sleep(1);
        if ((++sp & 255u) == 0u) { if (xb_ld(&bar[XB_TMO])) break; if (sp > XB_SPIN_CAP) { atomicAdd(&bar[XB_TMO], 1u); break; } }
    }
    nloc = mine > 0u ? mine : 1u; nx = cnt > 0u ? cnt : 1u;
}
__device__ __forceinline__ void xcd_barrier(const XcdBarrier& b) {
    asm volatile("s_waitcnt vmcnt(0)" ::: "memory");
    __syncthreads();
    if (threadIdx.x == 0) {
        unsigned* bar = b.bar;
        __builtin_amdgcn_s_waitcnt(0);
        unsigned nloc = b.st[0], nx = b.st[1];
        if (nloc == 0u) { xcd_barrier_complete(bar, b.x, nloc, nx); b.st[0] = nloc; b.st[1] = nx; }
        const unsigned old = xb_add(&bar[XB_XSUB(b.x)], 1u);
        const unsigned gen = old / nloc;
        if (old + 1u == (gen + 1u) * nloc) {
            __builtin_amdgcn_fence(__ATOMIC_RELEASE, "agent");
            asm volatile("s_waitcnt vmcnt(0)" ::: "memory");
            const unsigned og = xb_add(&bar[XB_TOP], 1u);
            const unsigned tg = og / nx;
            if (og + 1u == (tg + 1u) * nx) xb_add(&bar[XB_TOPGEN], 1u);
            else XB_SPIN(xb_ld(&bar[XB_TOPGEN]) == tg, bar);
            __builtin_amdgcn_fence(__ATOMIC_ACQUIRE, "agent");
            xb_add(&bar[XB_XGEN(b.x)], 1u);
            asm volatile("s_waitcnt vmcnt(0)" ::: "memory");
        } else {
            XB_SPIN(xb_ld(&bar[XB_XGEN(b.x)]) == gen, bar);
            __builtin_amdgcn_fence(__ATOMIC_ACQUIRE, "agent");
            asm volatile("s_waitcnt vmcnt(0)" ::: "memory");
        }
    }
    __syncthreads();
}
__global__ void __launch_bounds__(512, 2) mega(Args args) {
    MAKE_CTX();
    volatile LAS unsigned* MISC = (volatile LAS unsigned*)(F.lds + 131072 + 320);
    if (F.tid < 32) MISC[F.tid] = 0u;
    __syncthreads();
    const XcdBarrier bar = xcd_barrier_post((unsigned*)(ws + WS_CTL), MISC + 8);
#define GRID_SYNC() xcd_barrier(bar)
    p0_prologue(F);      GRID_SYNC();
    sample_inproj(F); p1_inproj(F); GRID_SYNC();
    p2a_conv_gates(F); p2b_spatial_units(F); GRID_SYNC();
    p2b_mscan(F); p3_s12(F); p2c_sample_rows(F); GRID_SYNC();
    p3_qkv(F);           GRID_SYNC();
    if (F.bid & 1) { p5s_sample(F, 0); p4_scores(F); p5s_sample(F, 1); p4_dc(F); } else { p4_scores(F); p5s_sample(F, 0); p4_dc(F); p5s_sample(F, 1); } GRID_SYNC();
    p5_scan_sample(F);   GRID_SYNC();
    p6_hout(F);          GRID_SYNC();
    sample_outproj_ks(F); p7_outproj(F); GRID_SYNC();
    p8_ple(F);           GRID_SYNC();
    p9_final(F);
}

extern "C" void kernel_launch(void* const* d_in, const int* in_sizes, int n_in, void* d_out, int out_size, void* d_ws, size_t ws_size, hipStream_t stream) {
    static int grid = 0;
    if (grid == 0) {
        if (n_in != 29 || (size_t)out_size != O_END || ws_size < WS_END) { fprintf(stderr, "kernel_launch: unexpected shapes (n_in %d out %d ws %zu)\n", n_in, out_size, ws_size); grid = -1; return; }
        int dev = 0, cus = 0, per_cu = 0;
        if (hipGetDevice(&dev) != hipSuccess || hipDeviceGetAttribute(&cus, hipDeviceAttributeMultiprocessorCount, dev) != hipSuccess) { grid = -1; return; }
        if (hipFuncSetAttribute((const void*)mega, hipFuncAttributeMaxDynamicSharedMemorySize, LDS_BYTES) != hipSuccess) { fprintf(stderr, "kernel_launch: hipFuncSetAttribute failed\n"); grid = -1; return; }
        if (hipOccupancyMaxActiveBlocksPerMultiprocessor(&per_cu, (const void*)mega, 512, LDS_BYTES) != hipSuccess || per_cu < 1) { fprintf(stderr, "kernel_launch: occupancy query says %d\n", per_cu); grid = -1; return; }
        (void)hipGetLastError();
        grid = cus;
        if (grid != 256) { fprintf(stderr, "kernel_launch: this kernel is laid out for 256 CUs, got %d\n", grid); grid = -1; return; }
    }
    if (grid < 0) return;
    if (hipMemsetAsync((unsigned char*)d_ws + WS_CTL, 0, 16384, stream) != hipSuccess) { fprintf(stderr, "kernel_launch: memset failed\n"); return; }
    Args a{};
    for (int i = 0; i < 29; ++i) a.in[i] = (const float*)d_in[i];
    a.out = (float*)d_out; a.ws = (unsigned char*)d_ws;
    void* kargs[] = {&a};
    hipError_t e = hipLaunchCooperativeKernel((const void*)mega, dim3(grid), dim3(512), kargs, LDS_BYTES, stream);
    if (e != hipSuccess) fprintf(stderr, "kernel_launch: cooperative launch failed: %s (grid %d)\n", hipGetErrorString(e), grid);
}
```
